# Optimizing an MI355X kernel written in HIP

```python
import math
import jax, jax.numpy as jnp
from jax import lax
import numpy as np

D_MODEL = 1024
BATCH = 32
SEQ = 256
DEPTH = 2
DEC_BATCH = 4
DEC_SEQ = 2048
PAST_LEN = 512

GRID_W = 64
HEAD_DIM = 64
MIX_W = D_MODEL
SGU_W = MIX_W // 4
SGU_GROUPS = SGU_W // HEAD_DIM
SGU_CHUNK = 128
DIFF_HEADS = (MIX_W // 4) // HEAD_DIM
DIFF_DV = HEAD_DIM
DIFF_DQK = HEAD_DIM // 2
DIFF_SCALE = DIFF_DQK ** -0.5
GQA_HEADS = (MIX_W // 2) // HEAD_DIM
GQA_KV_HEADS = GQA_HEADS // 4
GQA_GROUP = GQA_HEADS // GQA_KV_HEADS
GQA_SCALE = HEAD_DIM ** -0.5
IN_SIZES = (SGU_W, SGU_W, DIFF_HEADS * 2 * DIFF_DQK, DIFF_HEADS * 2 * DIFF_DQK, DIFF_HEADS * DIFF_DV, GQA_HEADS * HEAD_DIM, GQA_KV_HEADS * HEAD_DIM, GQA_KV_HEADS * HEAD_DIM)
IN_W = 2 * SGU_W + 2 * DIFF_HEADS * 2 * DIFF_DQK + DIFF_HEADS * DIFF_DV + (GQA_HEADS + 2 * GQA_KV_HEADS) * HEAD_DIM
QBLOCK = 128
ADA_CHUNKS = 6
N_KEYS = 128
N_EXPERTS = N_KEYS * N_KEYS
PEER_HEADS = 8
PEER_TOPK = 16
PEER_QDIM = 128
PEER_HALF = PEER_QDIM // 2
TOKEN_BLOCK = 128
ROPE_THETA = 10000.0
EPS = 1e-6

kernel_name = 'hybrid_diffusion_prefix_step'


def rms_norm(x, g):
    xf = x.astype(jnp.float32)
    y = xf * lax.rsqrt(jnp.mean(xf * xf, axis=-1, keepdims=True) + EPS)
    return (y * g.astype(jnp.float32)).astype(x.dtype)


def axial_rope(n_tokens, dim):
    rows = n_tokens // GRID_W
    row = jnp.repeat(jnp.arange(rows, dtype=jnp.float32), GRID_W)
    col = jnp.tile(jnp.arange(GRID_W, dtype=jnp.float32), rows)
    quarter = dim // 4
    inv = ROPE_THETA ** (-jnp.arange(quarter, dtype=jnp.float32) / quarter)
    ang = jnp.concatenate([row[:, None] * inv, col[:, None] * inv], axis=-1)
    return jnp.cos(ang), jnp.sin(ang)


def apply_rope(x, cos, sin):
    shape = (cos.shape[0],) + (1,) * (x.ndim - 3) + (cos.shape[1],)
    c = cos.reshape(shape).astype(x.dtype)
    s = sin.reshape(shape).astype(x.dtype)
    x1, x2 = jnp.split(x, 2, axis=-1)
    return jnp.concatenate([x1 * c - x2 * s, x2 * c + x1 * s], axis=-1)


def sweep_query_blocks(fn, q):
    B, L = q.shape[0], q.shape[1]
    nb = L // QBLOCK
    qb = jnp.moveaxis(q.reshape((B, nb, QBLOCK) + q.shape[2:]), 1, 0)
    out = jnp.moveaxis(lax.map(fn, qb), 0, 1)
    return out.reshape((B, L) + out.shape[3:])


def peer_ffn(h, wq, subkeys, u_tab, v_tab):
    B, L, D = h.shape
    xt = h.reshape(B * L // TOKEN_BLOCK, TOKEN_BLOCK, D)

    def block(xb):
        T = xb.shape[0]
        q = (xb @ wq).reshape(T, PEER_HEADS, 2, PEER_HALF)
        s = jnp.einsum('thxk,xnk->thxn', q, subkeys).astype(jnp.float32)
        sv, si = lax.top_k(s, PEER_TOPK)
        cand = (sv[:, :, 0, :, None] + sv[:, :, 1, None, :]).reshape(T, PEER_HEADS, PEER_TOPK * PEER_TOPK)
        cidx = (si[:, :, 0, :, None] * N_KEYS + si[:, :, 1, None, :]).reshape(T, PEER_HEADS, PEER_TOPK * PEER_TOPK)
        top_s, top_i = lax.top_k(cand, PEER_TOPK)
        expert = jnp.take_along_axis(cidx, top_i, axis=-1)
        gate = jax.nn.softmax(top_s, axis=-1)
        act = jax.nn.gelu(jnp.einsum('thkd,td->thk', u_tab[expert], xb))
        return jnp.einsum('thk,thkd->td', (gate * act).astype(xb.dtype), v_tab[expert])

    return lax.map(block, xt).reshape(B, L, D)


def token_mixers(h, ctx, rope, lam_init, w_in, sgu_norm_g, sgu_w, sgu_b, lq1, lk1, lq2, lk2, subln_g, qn_g, kn_g, w_out):
    B, L, _ = h.shape
    splits = np.cumsum(IN_SIZES)[:-1].tolist()
    a_u, a_v, d_q, d_k, d_v, g_q, g_k, g_v = jnp.split(h @ w_in, splits, axis=-1)

    a_u = jax.nn.gelu(a_u)
    a_v = rms_norm(jax.nn.gelu(a_v), sgu_norm_g).reshape(B, L // SGU_CHUNK, SGU_CHUNK, SGU_GROUPS, HEAD_DIM)
    a_mix = jnp.einsum('gpq,bnqgc->bnpgc', sgu_w, a_v) + sgu_b.T[:, :, None]
    out_a = a_u * a_mix.reshape(B, L, SGU_W)

    d_q = d_q.reshape(B, L, DIFF_HEADS, 2, DIFF_DQK)
    d_k = d_k.reshape(B, L, DIFF_HEADS, 2, DIFF_DQK)
    d_v = d_v.reshape(B, L, DIFF_HEADS, DIFF_DV)
    g_q = rms_norm(g_q.reshape(B, L, GQA_HEADS, HEAD_DIM), qn_g)
    g_k = rms_norm(g_k.reshape(B, L, GQA_KV_HEADS, HEAD_DIM), kn_g)
    g_v = g_v.reshape(B, L, GQA_KV_HEADS, HEAD_DIM)
    ctx_out = (d_k, d_v, g_k, g_v)
    if ctx is None:
        dk_all, dv_all, gk_all, gv_all = ctx_out
    else:
        (cos_d, sin_d), (cos_g, sin_g) = rope
        c_dk, c_dv, c_gk, c_gv = ctx
        d_q = apply_rope(d_q, cos_d, sin_d)
        g_q = apply_rope(g_q, cos_g, sin_g)
        dk_all = jnp.concatenate([apply_rope(d_k, cos_d, sin_d), c_dk.astype(d_k.dtype)], axis=1)
        dv_all = jnp.concatenate([d_v, c_dv.astype(d_v.dtype)], axis=1)
        gk_all = jnp.concatenate([apply_rope(g_k, cos_g, sin_g), c_gk.astype(g_k.dtype)], axis=1)
        gv_all = jnp.concatenate([g_v, c_gv.astype(g_v.dtype)], axis=1)

    f32 = jnp.float32
    lam = (jnp.exp(jnp.sum(lq1.astype(f32) * lk1.astype(f32)))
           - jnp.exp(jnp.sum(lq2.astype(f32) * lk2.astype(f32))) + lam_init)

    def diff_block(qb):
        s = jnp.einsum('bqhxd,bkhxd->bhxqk', qb, dk_all).astype(f32) * DIFF_SCALE
        p = jax.nn.softmax(s, axis=-1)
        w = p[:, :, 0] - lam * p[:, :, 1]
        return jnp.einsum('bhqk,bkhd->bqhd', w.astype(dv_all.dtype), dv_all)

    out_b = sweep_query_blocks(diff_block, d_q)
    out_b = (rms_norm(out_b, subln_g) * (1.0 - lam_init)).reshape(B, L, DIFF_HEADS * DIFF_DV)

    g_q = g_q.reshape(B, L, GQA_KV_HEADS, GQA_GROUP, HEAD_DIM)

    def gqa_block(qb):
        s = jnp.einsum('bqhgd,bkhd->bhgqk', qb, gk_all).astype(f32) * GQA_SCALE
        p = jax.nn.softmax(s, axis=-1)
        return jnp.einsum('bhgqk,bkhd->bqhgd', p.astype(gv_all.dtype), gv_all)

    out_c = sweep_query_blocks(gqa_block, g_q).reshape(B, L, GQA_HEADS * HEAD_DIM)

    out = jnp.concatenate([out_a, out_b, out_c], axis=-1) @ w_out
    return out, ctx_out


def run_trunk(x, cvec, ctx_cache, rope, p):
    new_ctx = []
    for l in range(DEPTH):
        lam_init = 0.8 - 0.6 * math.exp(-0.3 * l)
        mod = jax.nn.silu(cvec) @ p['ada_w'][l] + p['ada_b'][l]
        sh1, sc1, g1, sh2, sc2, g2 = jnp.split(mod[:, None, :], ADA_CHUNKS, axis=-1)
        h = rms_norm(x, p['norm1_g'][l]) * (1.0 + sc1) + sh1
        ctx_l = None if ctx_cache is None else tuple(t[:, l] for t in ctx_cache)
        mix, kv = token_mixers(h, ctx_l, rope, lam_init, p['w_in'][l], p['sgu_norm_g'][l], p['sgu_w'][l], p['sgu_b'][l],
                               p['diff_lq1'][l], p['diff_lk1'][l], p['diff_lq2'][l], p['diff_lk2'][l], p['diff_subln_g'][l],
                               p['gqa_qnorm_g'][l], p['gqa_knorm_g'][l], p['w_out'][l])
        x = x + g1 * mix
        h = rms_norm(x, p['norm2_g'][l]) * (1.0 + sc2) + sh2
        x = x + g2 * peer_ffn(h, p['peer_wq'][l], p['peer_subkeys'][l], p['peer_u'][l], p['peer_v'][l])
        if ctx_cache is None:
            new_ctx.append(kv)
    return rms_norm(x, p['final_g']), new_ctx


def setup_inputs(seed: int = 0) -> dict:
    key = jax.random.key(seed)
    ks = list(jax.random.split(key, 32))

    def nrm(i, shape, scale=1.0):
        return scale * jax.random.normal(ks[i], shape, jnp.float32)

    def gain(i, shape):
        return 1.0 + 0.01 * jax.random.normal(ks[i], shape, jnp.float32)

    D = D_MODEL
    return {
        'x_prompt': nrm(0, (BATCH, SEQ, D)),
        'x_sample': nrm(1, (DEC_BATCH, DEC_SEQ, D)),
        'cache_diff_k': nrm(2, (DEC_BATCH, DEPTH, PAST_LEN, DIFF_HEADS, 2, DIFF_DQK)),
        'cache_diff_v': nrm(3, (DEC_BATCH, DEPTH, PAST_LEN, DIFF_HEADS, DIFF_DV)),
        'cache_gqa_k': nrm(4, (DEC_BATCH, DEPTH, PAST_LEN, GQA_KV_HEADS, HEAD_DIM)),
        'cache_gqa_v': nrm(5, (DEC_BATCH, DEPTH, PAST_LEN, GQA_KV_HEADS, HEAD_DIM)),
        'c': nrm(6, (DEC_BATCH, D)),
        'c_ctx': nrm(7, (D,)),
        'ada_w': nrm(8, (DEPTH, D, ADA_CHUNKS * D), 0.5 * D ** -0.5),
        'ada_b': nrm(9, (DEPTH, ADA_CHUNKS * D), 0.01),
        'norm1_g': gain(10, (DEPTH, D)),
        'norm2_g': gain(11, (DEPTH, D)),
        'w_in': nrm(12, (DEPTH, D, IN_W), D ** -0.5),
        'sgu_norm_g': gain(13, (DEPTH, SGU_W)),
        'sgu_w': nrm(14, (DEPTH, SGU_GROUPS, SGU_CHUNK, SGU_CHUNK), SGU_CHUNK ** -0.5),
        'sgu_b': gain(15, (DEPTH, SGU_GROUPS, SGU_CHUNK)),
        'diff_lq1': nrm(16, (DEPTH, DIFF_DQK), 0.1),
        'diff_lk1': nrm(17, (DEPTH, DIFF_DQK), 0.1),
        'diff_lq2': nrm(18, (DEPTH, DIFF_DQK), 0.1),
        'diff_lk2': nrm(19, (DEPTH, DIFF_DQK), 0.1),
        'diff_subln_g': gain(20, (DEPTH, DIFF_DV)),
        'gqa_qnorm_g': gain(21, (DEPTH, HEAD_DIM)),
        'gqa_knorm_g': gain(22, (DEPTH, HEAD_DIM)),
        'w_out': nrm(23, (DEPTH, MIX_W, D), MIX_W ** -0.5),
        'peer_wq': nrm(24, (DEPTH, D, PEER_HEADS * PEER_QDIM), D ** -0.5),
        'peer_subkeys': nrm(25, (DEPTH, 2, N_KEYS, PEER_HALF), PEER_HALF ** -0.5),
        'peer_u': nrm(26, (DEPTH, N_EXPERTS, D), D ** -0.5),
        'peer_v': nrm(27, (DEPTH, N_EXPERTS, D), 0.1),
        'final_g': gain(28, (D,)),
    }


def reference(x_prompt, x_sample, cache_diff_k, cache_diff_v, cache_gqa_k, cache_gqa_v, c, c_ctx,
              ada_w, ada_b, norm1_g, norm2_g, w_in, sgu_norm_g, sgu_w, sgu_b,
              diff_lq1, diff_lk1, diff_lq2, diff_lk2, diff_subln_g, gqa_qnorm_g, gqa_knorm_g, w_out,
              peer_wq, peer_subkeys, peer_u, peer_v, final_g):
    p = {'ada_w': ada_w, 'ada_b': ada_b, 'norm1_g': norm1_g, 'norm2_g': norm2_g, 'w_in': w_in,
         'sgu_norm_g': sgu_norm_g, 'sgu_w': sgu_w, 'sgu_b': sgu_b,
         'diff_lq1': diff_lq1, 'diff_lk1': diff_lk1, 'diff_lq2': diff_lq2, 'diff_lk2': diff_lk2,
         'diff_subln_g': diff_subln_g, 'gqa_qnorm_g': gqa_qnorm_g, 'gqa_knorm_g': gqa_knorm_g, 'w_out': w_out,
         'peer_wq': peer_wq, 'peer_subkeys': peer_subkeys, 'peer_u': peer_u, 'peer_v': peer_v, 'final_g': final_g}

    c_prompt = jnp.broadcast_to(c_ctx, (x_prompt.shape[0], c_ctx.shape[0]))
    y_prompt, ctx_layers = run_trunk(x_prompt, c_prompt, None, None, p)
    new_diff_k = jnp.stack([kv[0] for kv in ctx_layers], axis=1)
    new_diff_v = jnp.stack([kv[1] for kv in ctx_layers], axis=1)
    new_gqa_k = jnp.stack([kv[2] for kv in ctx_layers], axis=1)
    new_gqa_v = jnp.stack([kv[3] for kv in ctx_layers], axis=1)

    n_lat = x_sample.shape[1]
    rope = (axial_rope(n_lat, DIFF_DQK), axial_rope(n_lat, HEAD_DIM))
    y_sample, _ = run_trunk(x_sample, c, (cache_diff_k, cache_diff_v, cache_gqa_k, cache_gqa_v), rope, p)

    return (y_prompt, y_sample, new_diff_k, new_diff_v, new_gqa_k, new_gqa_v)
```

```cpp
#include <hip/hip_runtime.h>
#include <hip/hip_bf16.h>
#include <cstdio>
#include <cstdint>

typedef unsigned short bf16_t;
using bf16x8 = __attribute__((ext_vector_type(8))) short;
using f32x4  = __attribute__((ext_vector_type(4))) float;

constexpr int D      = 1024;
constexpr int NTOK   = 16384;
constexpr int NPT    = 8192;
constexpr int SEQ    = 256;
constexpr int DSEQ   = 2048;
constexpr int PAST   = 512;
constexpr int NKS    = DSEQ + PAST;
constexpr int INW    = 2048;
constexpr int NEXP   = 16384;
constexpr float EPS  = 1e-6f;

constexpr size_t MB = 1024 * 1024;
constexpr size_t OFF_BAR   = 0;
constexpr size_t OFF_MOD   = 64 * 1024;
constexpr size_t OFF_ROPE  = OFF_MOD + 256 * 1024;
constexpr size_t OFF_SUBK  = OFF_ROPE + 1 * MB;
constexpr size_t OFF_SGUW  = OFF_SUBK + 64 * 1024;
constexpr size_t OFF_WIN   = OFF_SGUW + 256 * 1024;
constexpr size_t OFF_WOUT  = OFF_WIN + 8 * MB;
constexpr size_t OFF_WQ    = OFF_WOUT + 4 * MB;
constexpr size_t OFF_UT    = OFF_WQ + 4 * MB;
constexpr size_t OFF_VT    = OFF_UT + 64 * MB;
constexpr size_t OFF_H     = OFF_VT + 64 * MB;
constexpr size_t OFF_XC    = OFF_H + 32 * MB;
constexpr size_t OFF_R1    = OFF_XC + 64 * MB;
constexpr size_t OFF_AU    = OFF_R1;
constexpr size_t OFF_AV    = OFF_AU + 8 * MB;
constexpr size_t OFF_AVN   = OFF_AV + 8 * MB;
constexpr size_t OFF_DQ    = OFF_AVN + 8 * MB;
constexpr size_t OFF_DKP   = OFF_DQ + 8 * MB;
constexpr size_t OFF_DKS   = OFF_DKP + 4 * MB;
constexpr size_t OFF_DVTP  = OFF_DKS + 5 * MB;
constexpr size_t OFF_DVTS  = OFF_DVTP + 4 * MB;
constexpr size_t OFF_GQ    = OFF_DVTS + 5 * MB;
constexpr size_t OFF_GKP   = OFF_GQ + 16 * MB;
constexpr size_t OFF_GKS   = OFF_GKP + 2 * MB;
constexpr size_t OFF_GVTP  = OFF_GKS + 3 * MB;
constexpr size_t OFF_GVTS  = OFF_GVTP + 2 * MB;
constexpr size_t OFF_MIX   = OFF_GVTS + 3 * MB;
constexpr size_t OFF_R1END = OFF_MIX + 32 * MB;
constexpr size_t OFF_Q     = OFF_R1;
constexpr size_t OFF_EIDX  = OFF_Q + 32 * MB;
constexpr size_t OFF_EGATE = OFF_EIDX + 8 * MB;
constexpr size_t OFF_TOPV  = OFF_EGATE + 8 * MB;
constexpr size_t OFF_TOPI  = OFF_TOPV + 16 * MB;
static_assert(OFF_TOPI + 16 * MB <= OFF_R1END, "peer buffers must fit region 1");
constexpr size_t OFF_PROJ  = OFF_R1END;
constexpr size_t WS_NEED   = OFF_PROJ + 128 * MB;
static_assert(WS_NEED <= 512 * MB, "workspace budget");

constexpr size_t OUT_YP  = 0;
constexpr size_t OUT_YS  = 8388608;
constexpr size_t OUT_NDK = 16777216;
constexpr size_t OUT_NDV = OUT_NDK + 4194304;
constexpr size_t OUT_NGK = OUT_NDV + 4194304;
constexpr size_t OUT_NGV = OUT_NGK + 2097152;

struct Params {
    const float* in[29];
    float* out;
    unsigned char* ws;
};
enum { I_XP = 0, I_XS, I_CDK, I_CDV, I_CGK, I_CGV, I_C, I_CCTX, I_ADAW, I_ADAB, I_N1G, I_N2G, I_WIN, I_SGUNG, I_SGUW, I_SGUB,
       I_LQ1, I_LK1, I_LQ2, I_LK2, I_SUBLN, I_QNG, I_KNG, I_WOUT, I_WQ, I_SUBK, I_PU, I_PV, I_FG };

__device__ __forceinline__ bf16_t f2bf(float f) {
    unsigned u = __float_as_uint(f);
    u += 0x7fffu + ((u >> 16) & 1u);
    return (bf16_t)(u >> 16);
}
__device__ __forceinline__ float bf2f(bf16_t h) { return __uint_as_float(((unsigned)h) << 16); }
__device__ __forceinline__ float gelu_f(float x) {
    const float k = 0.7978845608028654f;
    float u = k * (x + 0.044715f * x * x * x);
    return 0.5f * x * (1.f + tanhf(u));
}
__device__ __forceinline__ float wave_sum(float v) {
#pragma unroll
    for (int o = 32; o >= 1; o >>= 1) v += __shfl_xor(v, o);
    return v;
}
__device__ __forceinline__ int tok_cv(int t) { return t < NPT ? 0 : 1 + ((t - NPT) >> 11); }
__device__ __forceinline__ const float* x_in_row(const Params& p, int t) {
    return t < NPT ? p.in[I_XP] + (size_t)t * D : p.in[I_XS] + (size_t)(t - NPT) * D;
}
__device__ __forceinline__ float lam_init_of(int l) { return l == 0 ? 0.2f : (0.8f - 0.6f * 0.7408182206817179f); }
__device__ __forceinline__ float lam_of(const Params& p, int l) {
    float s1 = 0.f, s2 = 0.f;
    for (int i = 0; i < 32; ++i) {
        s1 += p.in[I_LQ1][l * 32 + i] * p.in[I_LK1][l * 32 + i];
        s2 += p.in[I_LQ2][l * 32 + i] * p.in[I_LK2][l * 32 + i];
    }
    return expf(s1) - expf(s2) + lam_init_of(l);
}

__global__ void k_transpose_bf16(const float* __restrict__ W, bf16_t* __restrict__ Wt, int K, int N) {
    size_t idx = (size_t)blockIdx.x * blockDim.x + threadIdx.x;
    if (idx >= (size_t)K * N) return;
    int n = (int)(idx / K), k = (int)(idx % K);
    Wt[idx] = f2bf(W[(size_t)k * N + n]);
}
__global__ void k_convert_bf16(const float* __restrict__ src, bf16_t* __restrict__ dst, size_t n) {
    size_t idx = (size_t)blockIdx.x * blockDim.x + threadIdx.x;
    if (idx < n) dst[idx] = f2bf(src[idx]);
}
__global__ void k_mod(Params p) {
    int idx = blockIdx.x * blockDim.x + threadIdx.x;
    if (idx >= 2 * 5 * 6144) return;
    int j = idx % 6144, cv = (idx / 6144) % 5, l = idx / (6144 * 5);
    const float* cvec = cv == 0 ? p.in[I_CCTX] : p.in[I_C] + (size_t)(cv - 1) * D;
    const float* W = p.in[I_ADAW] + (size_t)l * D * 6144;
    float acc = 0.f;
    for (int k = 0; k < D; ++k) {
        float c = cvec[k];
        float s = c / (1.f + expf(-c));
        acc += s * W[(size_t)k * 6144 + j];
    }
    ((float*)(p.ws + OFF_MOD))[idx] = acc + p.in[I_ADAB][l * 6144 + j];
}
__global__ void k_rope_tab(Params p) {
    int idx = blockIdx.x * blockDim.x + threadIdx.x;
    if (idx >= 2048 * 48) return;
    int s = idx / 48, i = idx % 48;
    float* R = (float*)(p.ws + OFF_ROPE);
    double row = (double)(s / 64), col = (double)(s % 64);
    if (i < 16) {
        int q = i & 7; double inv = pow(10000.0, -(double)q / 8.0);
        double ang = (i < 8 ? row : col) * inv;
        R[s * 16 + i] = (float)cos(ang); R[2048 * 16 + s * 16 + i] = (float)sin(ang);
    } else {
        int ii = i - 16; int q = ii & 15; double inv = pow(10000.0, -(double)q / 16.0);
        double ang = (ii < 16 ? row : col) * inv;
        R[2048 * 32 + s * 32 + ii] = (float)cos(ang); R[2048 * 32 + 2048 * 32 + s * 32 + ii] = (float)sin(ang);
    }
}
__global__ void k_cache_prep(Params p, int l) {
    int idx = blockIdx.x * blockDim.x + threadIdx.x;
    if (idx >= 4 * 512 * 256) return;
    int c = idx & 255, pp = (idx >> 8) & 511, b = idx >> 17;
    bf16_t* DKS = (bf16_t*)(p.ws + OFF_DKS); bf16_t* DVTS = (bf16_t*)(p.ws + OFF_DVTS);
    bf16_t* GKS = (bf16_t*)(p.ws + OFF_GKS); bf16_t* GVTS = (bf16_t*)(p.ws + OFF_GVTS);
    size_t src = (((size_t)b * 2 + l) * PAST + pp) * 256 + c;
    int h = c >> 6, r = c & 63;
    DKS[(((size_t)b * 4 + h) * NKS + DSEQ + pp) * 64 + r] = f2bf(p.in[I_CDK][src]);
    DVTS[(((size_t)b * 4 + h) * 64 + r) * NKS + DSEQ + pp] = f2bf(p.in[I_CDV][src]);
    if (c < 128) {
        size_t src2 = (((size_t)b * 2 + l) * PAST + pp) * 128 + c;
        int kv = c >> 6;
        GKS[(((size_t)b * 2 + kv) * NKS + DSEQ + pp) * 64 + r] = f2bf(p.in[I_CGK][src2]);
        GVTS[(((size_t)b * 2 + kv) * 64 + r) * NKS + DSEQ + pp] = f2bf(p.in[I_CGV][src2]);
    }
}
__global__ void __launch_bounds__(256) k_norm_mod(Params p, int l, int which, int from_input) {
    int t = blockIdx.x;
    const float* xr = from_input ? x_in_row(p, t) : (const float*)(p.ws + OFF_XC) + (size_t)t * D;
    const float* g = p.in[which ? I_N2G : I_N1G] + l * D;
    const float* mod = (const float*)(p.ws + OFF_MOD) + (size_t)(l * 5 + tok_cv(t)) * 6144 + which * 3072;
    __shared__ float red[4];
    float v[4]; float ss = 0.f;
#pragma unroll
    for (int i = 0; i < 4; ++i) { v[i] = xr[threadIdx.x + i * 256]; ss += v[i] * v[i]; }
    ss = wave_sum(ss);
    if ((threadIdx.x & 63) == 0) red[threadIdx.x >> 6] = ss;
    __syncthreads();
    float tot = red[0] + red[1] + red[2] + red[3];
    float r = rsqrtf(tot / D + EPS);
    bf16_t* H = (bf16_t*)(p.ws + OFF_H) + (size_t)t * D;
#pragma unroll
    for (int i = 0; i < 4; ++i) {
        int c = threadIdx.x + i * 256;
        H[c] = f2bf(v[i] * r * g[c] * (1.f + mod[1024 + c]) + mod[c]);
    }
}
__global__ void __launch_bounds__(256) k_gemm_ref(const bf16_t* __restrict__ A, const bf16_t* __restrict__ Bt, float* __restrict__ C, int M, int N, int K) {
    int wave = threadIdx.x >> 6, lane = threadIdx.x & 63;
    int bm = blockIdx.y * 64 + (wave >> 1) * 32, bn = blockIdx.x * 64 + (wave & 1) * 32;
    int fr = lane & 15, fq = lane >> 4;
    f32x4 acc[2][2];
#pragma unroll
    for (int i = 0; i < 2; ++i)
#pragma unroll
        for (int j = 0; j < 2; ++j) acc[i][j] = f32x4{0.f, 0.f, 0.f, 0.f};
    for (int k0 = 0; k0 < K; k0 += 32) {
        bf16x8 a[2], b[2];
#pragma unroll
        for (int i = 0; i < 2; ++i) {
            a[i] = *reinterpret_cast<const bf16x8*>(A + (size_t)(bm + i * 16 + fr) * K + k0 + fq * 8);
            b[i] = *reinterpret_cast<const bf16x8*>(Bt + (size_t)(bn + i * 16 + fr) * K + k0 + fq * 8);
        }
#pragma unroll
        for (int i = 0; i < 2; ++i)
#pragma unroll
            for (int j = 0; j < 2; ++j) acc[i][j] = __builtin_amdgcn_mfma_f32_16x16x32_bf16(a[i], b[j], acc[i][j], 0, 0, 0);
    }
#pragma unroll
    for (int i = 0; i < 2; ++i)
#pragma unroll
        for (int j = 0; j < 2; ++j)
#pragma unroll
            for (int r = 0; r < 4; ++r)
                C[(size_t)(bm + i * 16 + fq * 4 + r) * N + bn + j * 16 + fr] = acc[i][j][r];
}
__global__ void __launch_bounds__(256) k_inproj_epi(Params p, int l) {
    int t = blockIdx.x;
    const float* pr = (const float*)(p.ws + OFF_PROJ) + (size_t)t * INW;
    const bool prompt = t < NPT;
    const int b = prompt ? t / SEQ : (t - NPT) / DSEQ;
    const int s = prompt ? t % SEQ : (t - NPT) % DSEQ;
    const float* R = (const float*)(p.ws + OFF_ROPE);
    const float* cosd = R + s * 16, *sind = R + 2048 * 16 + s * 16;
    const float* cosg = R + 2048 * 32 + s * 32, *sing = R + 2048 * 64 + s * 32;
    bf16_t* AU = (bf16_t*)(p.ws + OFF_AU); bf16_t* AV = (bf16_t*)(p.ws + OFF_AV); bf16_t* DQ = (bf16_t*)(p.ws + OFF_DQ);
    bf16_t* GQ = (bf16_t*)(p.ws + OFF_GQ);
    for (int c = threadIdx.x; c < INW; c += 256) {
        float v = pr[c];
        if (c < 256) { AU[(size_t)t * 256 + c] = f2bf(gelu_f(v)); }
        else if (c < 512) { AV[(size_t)t * 256 + c - 256] = f2bf(gelu_f(v)); }
        else if (c < 1024) {
            int cc = (c - 512) & 255; int d = cc & 31; int base = c - d;
            float o = v;
            if (!prompt) {
                int i = d & 15; float x1 = pr[base + i], x2 = pr[base + 16 + i];
                o = d < 16 ? x1 * cosd[i] - x2 * sind[i] : x2 * cosd[i] + x1 * sind[i];
            }
            if (c < 768) DQ[(size_t)t * 256 + cc] = f2bf(o);
            else {
                int h = cc >> 6, r = cc & 63;
                if (prompt) {
                    p.out[OUT_NDK + (((size_t)b * 2 + l) * SEQ + s) * 256 + cc] = v;
                    ((bf16_t*)(p.ws + OFF_DKP))[(((size_t)b * 4 + h) * SEQ + s) * 64 + r] = f2bf(o);
                } else ((bf16_t*)(p.ws + OFF_DKS))[(((size_t)b * 4 + h) * NKS + s) * 64 + r] = f2bf(o);
            }
        } else if (c < 1280) {
            int cc = c - 1024; int h = cc >> 6, r = cc & 63;
            if (prompt) {
                p.out[OUT_NDV + (((size_t)b * 2 + l) * SEQ + s) * 256 + cc] = v;
                ((bf16_t*)(p.ws + OFF_DVTP))[(((size_t)b * 4 + h) * 64 + r) * SEQ + s] = f2bf(v);
            } else ((bf16_t*)(p.ws + OFF_DVTS))[(((size_t)b * 4 + h) * 64 + r) * NKS + s] = f2bf(v);
        } else if (c < 1920) {
            int d = c & 63; int base = c - d;
            const bool isq = c < 1792;
            const float* g = p.in[isq ? I_QNG : I_KNG] + l * 64;
            float ss = 0.f;
            for (int i = 0; i < 64; ++i) ss += pr[base + i] * pr[base + i];
            float rr = rsqrtf(ss / 64.f + EPS);
            float nv = v * rr * g[d];
            float o = nv;
            if (!prompt) {
                int i = d & 31;
                float x1 = pr[base + i] * rr * g[i], x2 = pr[base + 32 + i] * rr * g[32 + i];
                o = d < 32 ? x1 * cosg[i] - x2 * sing[i] : x2 * cosg[i] + x1 * sing[i];
            }
            if (isq) GQ[(size_t)t * 512 + c - 1280] = f2bf(o);
            else {
                int cc = c - 1792; int kv = cc >> 6;
                if (prompt) {
                    p.out[OUT_NGK + (((size_t)b * 2 + l) * SEQ + s) * 128 + cc] = nv;
                    ((bf16_t*)(p.ws + OFF_GKP))[(((size_t)b * 2 + kv) * SEQ + s) * 64 + d] = f2bf(o);
                } else ((bf16_t*)(p.ws + OFF_GKS))[(((size_t)b * 2 + kv) * NKS + s) * 64 + d] = f2bf(o);
            }
        } else {
            int cc = c - 1920; int kv = cc >> 6, d = cc & 63;
            if (prompt) {
                p.out[OUT_NGV + (((size_t)b * 2 + l) * SEQ + s) * 128 + cc] = v;
                ((bf16_t*)(p.ws + OFF_GVTP))[(((size_t)b * 2 + kv) * 64 + d) * SEQ + s] = f2bf(v);
            } else ((bf16_t*)(p.ws + OFF_GVTS))[(((size_t)b * 2 + kv) * 64 + d) * NKS + s] = f2bf(v);
        }
    }
}
__global__ void __launch_bounds__(256) k_sgu_norm(Params p, int l) {
    int t = blockIdx.x;
    const bf16_t* AV = (const bf16_t*)(p.ws + OFF_AV) + (size_t)t * 256;
    __shared__ float red[4];
    float v = bf2f(AV[threadIdx.x]);
    float ss = wave_sum(v * v);
    if ((threadIdx.x & 63) == 0) red[threadIdx.x >> 6] = ss;
    __syncthreads();
    float r = rsqrtf((red[0] + red[1] + red[2] + red[3]) / 256.f + EPS);
    ((bf16_t*)(p.ws + OFF_AVN))[(size_t)t * 256 + threadIdx.x] = f2bf(v * r * p.in[I_SGUNG][l * 256 + threadIdx.x]);
}
__global__ void __launch_bounds__(256) k_sgu_mix(Params p, int l) {
    int t = blockIdx.x, c = threadIdx.x;
    int t0 = t & ~127, pp = t & 127, g = c >> 6;
    const bf16_t* W = (const bf16_t*)(p.ws + OFF_SGUW) + (((size_t)l * 4 + g) * 128 + pp) * 128;
    const bf16_t* AVN = (const bf16_t*)(p.ws + OFF_AVN);
    float acc = 0.f;
    for (int q = 0; q < 128; ++q) acc += bf2f(W[q]) * bf2f(AVN[(size_t)(t0 + q) * 256 + c]);
    acc += p.in[I_SGUB][(l * 4 + g) * 128 + pp];
    float au = bf2f(((const bf16_t*)(p.ws + OFF_AU))[(size_t)t * 256 + c]);
    ((bf16_t*)(p.ws + OFF_MIX))[(size_t)t * D + c] = f2bf(au * acc);
}
__global__ void __launch_bounds__(64) k_attn_diff(Params p, int l) {
    int t = blockIdx.x >> 2, h = blockIdx.x & 3, lane = threadIdx.x;
    const bool prompt = t < NPT;
    const int b = prompt ? t / SEQ : (t - NPT) / DSEQ;
    const int nk = prompt ? SEQ : NKS;
    const bf16_t* K = prompt ? (const bf16_t*)(p.ws + OFF_DKP) + ((size_t)b * 4 + h) * SEQ * 64 : (const bf16_t*)(p.ws + OFF_DKS) + ((size_t)b * 4 + h) * NKS * 64;
    const bf16_t* Vt = prompt ? (const bf16_t*)(p.ws + OFF_DVTP) + ((size_t)b * 4 + h) * 64 * SEQ : (const bf16_t*)(p.ws + OFF_DVTS) + ((size_t)b * 4 + h) * 64 * NKS;
    float q = bf2f(((const bf16_t*)(p.ws + OFF_DQ))[(size_t)t * 256 + h * 64 + lane]);
    const float scale = 0.17677669529663687f;
    float m0 = -1e30f, m1 = -1e30f, l0 = 0.f, l1 = 0.f, a0 = 0.f, a1 = 0.f;
    for (int k = 0; k < nk; ++k) {
        float pr = q * bf2f(K[(size_t)k * 64 + lane]);
#pragma unroll
        for (int o = 16; o >= 1; o >>= 1) pr += __shfl_xor(pr, o);
        float s0 = __shfl(pr, 0) * scale, s1 = __shfl(pr, 32) * scale;
        float v = bf2f(Vt[(size_t)lane * nk + k]);
        float mn0 = fmaxf(m0, s0), mn1 = fmaxf(m1, s1);
        float c0 = expf(m0 - mn0), c1 = expf(m1 - mn1);
        float e0 = expf(s0 - mn0), e1 = expf(s1 - mn1);
        l0 = l0 * c0 + e0; l1 = l1 * c1 + e1;
        a0 = a0 * c0 + e0 * v; a1 = a1 * c1 + e1 * v;
        m0 = mn0; m1 = mn1;
    }
    float lam = lam_of(p, l);
    float o = a0 / l0 - lam * a1 / l1;
    float ss = wave_sum(o * o);
    float r = rsqrtf(ss / 64.f + EPS);
    o = o * r * p.in[I_SUBLN][l * 64 + lane] * (1.f - lam_init_of(l));
    ((bf16_t*)(p.ws + OFF_MIX))[(size_t)t * D + 256 + h * 64 + lane] = f2bf(o);
}
__global__ void __launch_bounds__(64) k_attn_gqa(Params p, int l) {
    int t = blockIdx.x >> 3, hq = blockIdx.x & 7, lane = threadIdx.x;
    int kv = hq >> 2;
    const bool prompt = t < NPT;
    const int b = prompt ? t / SEQ : (t - NPT) / DSEQ;
    const int nk = prompt ? SEQ : NKS;
    const bf16_t* K = prompt ? (const bf16_t*)(p.ws + OFF_GKP) + ((size_t)b * 2 + kv) * SEQ * 64 : (const bf16_t*)(p.ws + OFF_GKS) + ((size_t)b * 2 + kv) * NKS * 64;
    const bf16_t* Vt = prompt ? (const bf16_t*)(p.ws + OFF_GVTP) + ((size_t)b * 2 + kv) * 64 * SEQ : (const bf16_t*)(p.ws + OFF_GVTS) + ((size_t)b * 2 + kv) * 64 * NKS;
    float q = bf2f(((const bf16_t*)(p.ws + OFF_GQ))[(size_t)t * 512 + hq * 64 + lane]);
    float m = -1e30f, ls = 0.f, a = 0.f;
    for (int k = 0; k < nk; ++k) {
        float s = wave_sum(q * bf2f(K[(size_t)k * 64 + lane])) * 0.125f;
        float v = bf2f(Vt[(size_t)lane * nk + k]);
        float mn = fmaxf(m, s);
        float c = expf(m - mn), e = expf(s - mn);
        ls = ls * c + e; a = a * c + e * v; m = mn;
    }
    ((bf16_t*)(p.ws + OFF_MIX))[(size_t)t * D + 512 + hq * 64 + lane] = f2bf(a / ls);
}
__global__ void __launch_bounds__(256) k_resid(Params p, int l, int gsel, int from_input) {
    int t = blockIdx.x;
    const float* xr = from_input ? x_in_row(p, t) : (const float*)(p.ws + OFF_XC) + (size_t)t * D;
    const float* mod = (const float*)(p.ws + OFF_MOD) + (size_t)(l * 5 + tok_cv(t)) * 6144 + gsel * 1024;
    const float* C = (const float*)(p.ws + OFF_PROJ) + (size_t)t * D;
    float* XC = (float*)(p.ws + OFF_XC) + (size_t)t * D;
    for (int c = threadIdx.x; c < D; c += 256) XC[c] = xr[c] + mod[c] * C[c];
}
__global__ void k_store_q(Params p) {
    size_t idx = (size_t)blockIdx.x * blockDim.x + threadIdx.x;
    if (idx < (size_t)NTOK * D) ((bf16_t*)(p.ws + OFF_Q))[idx] = f2bf(((const float*)(p.ws + OFF_PROJ))[idx]);
}
__global__ void __launch_bounds__(256) k_peer_scores(Params p, int l) {
    int t = blockIdx.x;
    const bf16_t* Q = (const bf16_t*)(p.ws + OFF_Q) + (size_t)t * D;
    const bf16_t* SK = (const bf16_t*)(p.ws + OFF_SUBK) + (size_t)l * 2 * 128 * 64;
    float* SC = (float*)(p.ws + OFF_PROJ) + (size_t)t * 2048;
    for (int o = threadIdx.x; o < 2048; o += 256) {
        int n = o & 127, x = (o >> 7) & 1, h = o >> 8;
        float acc = 0.f;
        for (int k = 0; k < 64; ++k) acc += bf2f(Q[h * 128 + x * 64 + k]) * bf2f(SK[((size_t)x * 128 + n) * 64 + k]);
        SC[o] = acc;
    }
}
__global__ void __launch_bounds__(256) k_peer_top1(Params p) {
    size_t idx = (size_t)blockIdx.x * blockDim.x + threadIdx.x;
    if (idx >= (size_t)NTOK * 16) return;
    const float* SC = (const float*)(p.ws + OFF_PROJ) + idx * 128;
    float* TV = (float*)(p.ws + OFF_TOPV) + idx * 16; int* TI = (int*)(p.ws + OFF_TOPI) + idx * 16;
    float pv = 3.0e38f; int pi = -1;
    for (int r = 0; r < 16; ++r) {
        float bv = -3.0e38f; int bi = -1;
        for (int n = 0; n < 128; ++n) {
            float v = SC[n];
            bool after = (v < pv) || (v == pv && n > pi);
            if (after && (bi < 0 || v > bv)) { bv = v; bi = n; }
        }
        TV[r] = bv; TI[r] = bi; pv = bv; pi = bi;
    }
}
__global__ void __launch_bounds__(256) k_peer_top2(Params p) {
    size_t idx = (size_t)blockIdx.x * blockDim.x + threadIdx.x;
    if (idx >= (size_t)NTOK * 8) return;
    const float* TV = (const float*)(p.ws + OFF_TOPV) + idx * 32; const int* TI = (const int*)(p.ws + OFF_TOPI) + idx * 32;
    int* EI = (int*)(p.ws + OFF_EIDX) + idx * 16; float* EG = (float*)(p.ws + OFF_EGATE) + idx * 16;
    float pv = 3.0e38f; int pi = -1; float mx = 0.f, sum = 0.f;
    for (int r = 0; r < 16; ++r) {
        float bv = -3.0e38f; int bi = -1;
        for (int n = 0; n < 256; ++n) {
            float v = TV[n >> 4] + TV[16 + (n & 15)];
            bool after = (v < pv) || (v == pv && n > pi);
            if (after && (bi < 0 || v > bv)) { bv = v; bi = n; }
        }
        if (r == 0) mx = bv;
        float e = expf(bv - mx);
        sum += e;
        EG[r] = e; EI[r] = TI[bi >> 4] * 128 + TI[16 + (bi & 15)];
        pv = bv; pi = bi;
    }
    float inv = 1.f / sum;
    for (int r = 0; r < 16; ++r) EG[r] *= inv;
}
__global__ void __launch_bounds__(256) k_peer_apply(Params p, int l) {
    int t = blockIdx.x; int wave = threadIdx.x >> 6, lane = threadIdx.x & 63;
    __shared__ float wts[128]; __shared__ int eid[128];
    const bf16_t* H = (const bf16_t*)(p.ws + OFF_H) + (size_t)t * D;
    const bf16_t* UT = (const bf16_t*)(p.ws + OFF_UT) + (size_t)l * NEXP * D;
    const bf16_t* VT = (const bf16_t*)(p.ws + OFF_VT) + (size_t)l * NEXP * D;
    const int* EI = (const int*)(p.ws + OFF_EIDX) + (size_t)t * 128; const float* EG = (const float*)(p.ws + OFF_EGATE) + (size_t)t * 128;
    float hv[16];
#pragma unroll
    for (int i = 0; i < 16; ++i) hv[i] = bf2f(H[lane * 16 + i]);
    for (int jj = 0; jj < 32; ++jj) {
        int j = wave * 32 + jj; int e = EI[j];
        const bf16_t* ur = UT + (size_t)e * D + lane * 16;
        float acc = 0.f;
#pragma unroll
        for (int i = 0; i < 16; ++i) acc += hv[i] * bf2f(ur[i]);
        acc = wave_sum(acc);
        if (lane == 0) { wts[j] = EG[j] * gelu_f(acc); eid[j] = e; }
    }
    __syncthreads();
    float o[4] = {0.f, 0.f, 0.f, 0.f};
    for (int j = 0; j < 128; ++j) {
        const bf16_t* vr = VT + (size_t)eid[j] * D + threadIdx.x * 4; float w = wts[j];
#pragma unroll
        for (int i = 0; i < 4; ++i) o[i] += w * bf2f(vr[i]);
    }
    const float* mod = (const float*)(p.ws + OFF_MOD) + (size_t)(l * 5 + tok_cv(t)) * 6144 + 5 * 1024;
    float* XC = (float*)(p.ws + OFF_XC) + (size_t)t * D;
#pragma unroll
    for (int i = 0; i < 4; ++i) { int c = threadIdx.x * 4 + i; XC[c] += mod[c] * o[i]; }
}
__global__ void __launch_bounds__(256) k_final_norm(Params p) {
    int t = blockIdx.x;
    const float* xr = (const float*)(p.ws + OFF_XC) + (size_t)t * D;
    __shared__ float red[4];
    float v[4]; float ss = 0.f;
#pragma unroll
    for (int i = 0; i < 4; ++i) { v[i] = xr[threadIdx.x + i * 256]; ss += v[i] * v[i]; }
    ss = wave_sum(ss);
    if ((threadIdx.x & 63) == 0) red[threadIdx.x >> 6] = ss;
    __syncthreads();
    float r = rsqrtf((red[0] + red[1] + red[2] + red[3]) / D + EPS);
    float* y = p.out + (size_t)t * D;
#pragma unroll
    for (int i = 0; i < 4; ++i) { int c = threadIdx.x + i * 256; y[c] = v[i] * r * p.in[I_FG][c]; }
}

extern "C" void kernel_launch(void* const* d_in, const int* in_sizes, int n_in,
                              void* d_out, int out_size, void* d_ws, size_t ws_size,
                              hipStream_t stream) {
    if (ws_size < WS_NEED) { fprintf(stderr, "kernel_launch: workspace too small: %zu < %zu\n", ws_size, (size_t)WS_NEED); return; }
    Params p{};
    for (int i = 0; i < 29; ++i) p.in[i] = (const float*)d_in[i];
    p.out = (float*)d_out; p.ws = (unsigned char*)d_ws;
    unsigned char* ws = (unsigned char*)d_ws;
    auto cdiv = [](size_t a, size_t b) { return (unsigned)((a + b - 1) / b); };
    for (int l = 0; l < 2; ++l) {
        k_transpose_bf16<<<cdiv((size_t)D * INW, 256), 256, 0, stream>>>(p.in[I_WIN] + (size_t)l * D * INW, (bf16_t*)(ws + OFF_WIN) + (size_t)l * INW * D, D, INW);
        k_transpose_bf16<<<cdiv((size_t)D * D, 256), 256, 0, stream>>>(p.in[I_WOUT] + (size_t)l * D * D, (bf16_t*)(ws + OFF_WOUT) + (size_t)l * D * D, D, D);
        k_transpose_bf16<<<cdiv((size_t)D * D, 256), 256, 0, stream>>>(p.in[I_WQ] + (size_t)l * D * D, (bf16_t*)(ws + OFF_WQ) + (size_t)l * D * D, D, D);
    }
    k_convert_bf16<<<cdiv((size_t)2 * NEXP * D, 256), 256, 0, stream>>>(p.in[I_PU], (bf16_t*)(ws + OFF_UT), (size_t)2 * NEXP * D);
    k_convert_bf16<<<cdiv((size_t)2 * NEXP * D, 256), 256, 0, stream>>>(p.in[I_PV], (bf16_t*)(ws + OFF_VT), (size_t)2 * NEXP * D);
    k_convert_bf16<<<cdiv(2 * 2 * 128 * 64, 256), 256, 0, stream>>>(p.in[I_SUBK], (bf16_t*)(ws + OFF_SUBK), 2 * 2 * 128 * 64);
    k_convert_bf16<<<cdiv(2 * 4 * 128 * 128, 256), 256, 0, stream>>>(p.in[I_SGUW], (bf16_t*)(ws + OFF_SGUW), 2 * 4 * 128 * 128);
    k_mod<<<cdiv(2 * 5 * 6144, 256), 256, 0, stream>>>(p);
    k_rope_tab<<<cdiv(2048 * 48, 256), 256, 0, stream>>>(p);
    for (int l = 0; l < 2; ++l) {
        k_norm_mod<<<NTOK, 256, 0, stream>>>(p, l, 0, l == 0 ? 1 : 0);
        k_gemm_ref<<<dim3(INW / 64, NTOK / 64), 256, 0, stream>>>((const bf16_t*)(ws + OFF_H), (const bf16_t*)(ws + OFF_WIN) + (size_t)l * INW * D, (float*)(ws + OFF_PROJ), NTOK, INW, D);
        k_cache_prep<<<cdiv(4 * 512 * 256, 256), 256, 0, stream>>>(p, l);
        k_inproj_epi<<<NTOK, 256, 0, stream>>>(p, l);
        k_sgu_norm<<<NTOK, 256, 0, stream>>>(p, l);
        k_sgu_mix<<<NTOK, 256, 0, stream>>>(p, l);
        k_attn_diff<<<NTOK * 4, 64, 0, stream>>>(p, l);
        k_attn_gqa<<<NTOK * 8, 64, 0, stream>>>(p, l);
        k_gemm_ref<<<dim3(D / 64, NTOK / 64), 256, 0, stream>>>((const bf16_t*)(ws + OFF_MIX), (const bf16_t*)(ws + OFF_WOUT) + (size_t)l * D * D, (float*)(ws + OFF_PROJ), NTOK, D, D);
        k_resid<<<NTOK, 256, 0, stream>>>(p, l, 2, l == 0 ? 1 : 0);
        k_norm_mod<<<NTOK, 256, 0, stream>>>(p, l, 1, 0);
        k_gemm_ref<<<dim3(D / 64, NTOK / 64), 256, 0, stream>>>((const bf16_t*)(ws + OFF_H), (const bf16_t*)(ws + OFF_WQ) + (size_t)l * D * D, (float*)(ws + OFF_PROJ), NTOK, D, D);
        k_store_q<<<cdiv((size_t)NTOK * D, 256), 256, 0, stream>>>(p);
        k_peer_scores<<<NTOK, 256, 0, stream>>>(p, l);
        k_peer_top1<<<cdiv((size_t)NTOK * 16, 256), 256, 0, stream>>>(p);
        k_peer_top2<<<cdiv((size_t)NTOK * 8, 256), 256, 0, stream>>>(p);
        k_peer_apply<<<NTOK, 256, 0, stream>>>(p, l);
    }
    k_final_norm<<<NTOK, 256, 0, stream>>>(p);
}
```

```cpp
#include <hip/hip_runtime.h>
#include <hip/hip_bf16.h>
#include <cstdio>
#include <cstdint>
#include <hip/hip_cooperative_groups.h>
namespace cg = cooperative_groups;

typedef unsigned short bf16_t;
using bf16x8 = __attribute__((ext_vector_type(8))) short;
using f32x4  = __attribute__((ext_vector_type(4))) float;

constexpr int D      = 1024;
constexpr int NTOK   = 16384;
constexpr int NPT    = 8192;
constexpr int SEQ    = 256;
constexpr int DSEQ   = 2048;
constexpr int PAST   = 512;
constexpr int NKS    = DSEQ + PAST;
constexpr int INW    = 2048;
constexpr int NEXP   = 16384;
constexpr float EPS  = 1e-6f;

constexpr size_t MB = 1024 * 1024;
constexpr size_t OFF_BAR   = 0;
constexpr size_t OFF_MOD   = 64 * 1024;
constexpr size_t OFF_ROPE  = OFF_MOD + 256 * 1024;
constexpr size_t OFF_SUBK  = OFF_ROPE + 1 * MB;
constexpr size_t OFF_SGUW  = OFF_SUBK + 64 * 1024;
constexpr size_t OFF_WIN   = OFF_SGUW + 256 * 1024;
constexpr size_t OFF_WOUT  = OFF_WIN + 8 * MB;
constexpr size_t OFF_WQ    = OFF_WOUT + 4 * MB;
constexpr size_t OFF_UT    = OFF_WQ + 4 * MB;
constexpr size_t OFF_VT    = OFF_UT + 64 * MB;
constexpr size_t OFF_H     = OFF_VT + 64 * MB;
constexpr size_t OFF_XC    = OFF_H + 32 * MB;
constexpr size_t OFF_R1    = OFF_XC + 64 * MB;
constexpr size_t OFF_AU    = OFF_R1;
constexpr size_t OFF_AV    = OFF_AU + 8 * MB;
constexpr size_t OFF_AVN   = OFF_AV + 8 * MB;
constexpr size_t OFF_DQ    = OFF_AVN + 8 * MB;
constexpr size_t OFF_DKP   = OFF_DQ + 8 * MB;
constexpr size_t OFF_DKS   = OFF_DKP + 4 * MB;
constexpr size_t OFF_DVTP  = OFF_DKS + 5 * MB;
constexpr size_t OFF_DVTS  = OFF_DVTP + 4 * MB;
constexpr size_t OFF_GQ    = OFF_DVTS + 5 * MB;
constexpr size_t OFF_GKP   = OFF_GQ + 16 * MB;
constexpr size_t OFF_GKS   = OFF_GKP + 2 * MB;
constexpr size_t OFF_GVTP  = OFF_GKS + 3 * MB;
constexpr size_t OFF_GVTS  = OFF_GVTP + 2 * MB;
constexpr size_t OFF_MIX   = OFF_GVTS + 3 * MB;
constexpr size_t OFF_R1END = OFF_MIX + 32 * MB;
constexpr size_t OFF_Q     = OFF_R1;
constexpr size_t OFF_EIDX  = OFF_Q + 32 * MB;
constexpr size_t OFF_EGATE = OFF_EIDX + 8 * MB;
constexpr size_t OFF_TOPV  = OFF_EGATE + 8 * MB;
constexpr size_t OFF_TOPI  = OFF_TOPV + 16 * MB;
static_assert(OFF_TOPI + 16 * MB <= OFF_R1END, "peer buffers must fit region 1");
constexpr size_t OFF_PROJ  = OFF_R1END;
constexpr size_t WS_NEED   = OFF_PROJ + 128 * MB;
static_assert(WS_NEED <= 512 * MB, "workspace budget");

constexpr size_t OUT_YP  = 0;
constexpr size_t OUT_YS  = 8388608;
constexpr size_t OUT_NDK = 16777216;
constexpr size_t OUT_NDV = OUT_NDK + 4194304;
constexpr size_t OUT_NGK = OUT_NDV + 4194304;
constexpr size_t OUT_NGV = OUT_NGK + 2097152;

struct Params {
    const float* in[29];
    float* out;
    unsigned char* ws;
};
enum { I_XP = 0, I_XS, I_CDK, I_CDV, I_CGK, I_CGV, I_C, I_CCTX, I_ADAW, I_ADAB, I_N1G, I_N2G, I_WIN, I_SGUNG, I_SGUW, I_SGUB,
       I_LQ1, I_LK1, I_LQ2, I_LK2, I_SUBLN, I_QNG, I_KNG, I_WOUT, I_WQ, I_SUBK, I_PU, I_PV, I_FG };

__device__ __forceinline__ bf16_t f2bf(float f) {
    unsigned u = __float_as_uint(f);
    u += 0x7fffu + ((u >> 16) & 1u);
    return (bf16_t)(u >> 16);
}
__device__ __forceinline__ float bf2f(bf16_t h) { return __uint_as_float(((unsigned)h) << 16); }
__device__ __forceinline__ float gelu_f(float x) {
    const float k = 0.7978845608028654f;
    float u = k * (x + 0.044715f * x * x * x);
    return 0.5f * x * (1.f + tanhf(u));
}
__device__ __forceinline__ float wave_sum(float v) {
#pragma unroll
    for (int o = 32; o >= 1; o >>= 1) v += __shfl_xor(v, o);
    return v;
}
__device__ __forceinline__ int tok_cv(int t) { return t < NPT ? 0 : 1 + ((t - NPT) >> 11); }
__device__ __forceinline__ const float* x_in_row(const Params& p, int t) {
    return t < NPT ? p.in[I_XP] + (size_t)t * D : p.in[I_XS] + (size_t)(t - NPT) * D;
}
__device__ __forceinline__ float lam_init_of(int l) { return l == 0 ? 0.2f : (0.8f - 0.6f * 0.7408182206817179f); }
__device__ __forceinline__ float lam_of(const Params& p, int l) {
    float s1 = 0.f, s2 = 0.f;
    for (int i = 0; i < 32; ++i) {
        s1 += p.in[I_LQ1][l * 32 + i] * p.in[I_LK1][l * 32 + i];
        s2 += p.in[I_LQ2][l * 32 + i] * p.in[I_LK2][l * 32 + i];
    }
    return expf(s1) - expf(s2) + lam_init_of(l);
}


#define XB_TMO      128
#define XB_XCNT(j)  (256  + 64 * (j))
#define XB_XSUB(j)  (1280 + 64 * (j))
#define XB_XGEN(j)  (2304 + 64 * (j))
#define XB_TOP      3328
#define XB_TOPGEN   3392
#define XCD_BAR_WORDS 3456
#define XB_SPIN_CAP (1u << 20)
#define LAS __attribute__((address_space(3)))
__device__ __forceinline__ unsigned xb_ld(unsigned* p)              { return __hip_atomic_load(p, __ATOMIC_RELAXED, __HIP_MEMORY_SCOPE_AGENT); }
__device__ __forceinline__ unsigned xb_add(unsigned* p, unsigned v) { return __hip_atomic_fetch_add(p, v, __ATOMIC_RELAXED, __HIP_MEMORY_SCOPE_AGENT); }
__device__ __forceinline__ unsigned xb_xcc_id() { return (unsigned)__builtin_amdgcn_s_getreg((3 << 11) | 20) & 0xFu; }
#define XB_SPIN(cond, bar) do { unsigned _sp = 0; while (cond) { __builtin_amdgcn_s_sleep(1); \
    if ((++_sp & 255u) == 0u) { if (xb_ld(&(bar)[XB_TMO])) break; if (_sp > XB_SPIN_CAP) { atomicAdd(&(bar)[XB_TMO], 1u); break; } } } } while (0)
struct XcdBarrier { unsigned* bar; unsigned x; volatile LAS unsigned* st; };
__device__ __forceinline__ XcdBarrier xcd_barrier_post(unsigned* bar, volatile LAS unsigned* st) {
    XcdBarrier b; b.bar = bar; b.x = xb_xcc_id(); b.st = st;
    if (threadIdx.x == 0) (void)xb_add(&bar[XB_XCNT(b.x)], 1u);
    return b;
}
__device__ __forceinline__ void xcd_barrier_complete(unsigned* bar, unsigned x, unsigned& nloc, unsigned& nx) {
    const unsigned G = gridDim.x * gridDim.y * gridDim.z;
    unsigned sum, cnt, mine, sp = 0u;
    for (;;) {
        sum = 0u; cnt = 0u; mine = 0u;
#pragma unroll
        for (unsigned j = 0; j < 16; ++j) { const unsigned c = xb_ld(&bar[XB_XCNT(j)]); sum += c; cnt += (c > 0u) ? 1u : 0u; mine = (j == x) ? c : mine; }
        if (sum == G) break;
        __builtin_amdgcn_s_sleep(1);
        if ((++sp & 255u) == 0u) { if (xb_ld(&bar[XB_TMO])) break; if (sp > XB_SPIN_CAP) { atomicAdd(&bar[XB_TMO], 1u); break; } }
    }
    nloc = mine > 0u ? mine : 1u; nx = cnt > 0u ? cnt : 1u;
}
__device__ __forceinline__ void xcd_barrier(const XcdBarrier& b) {
    asm volatile("s_waitcnt vmcnt(0)" ::: "memory");
    __syncthreads();
    if (threadIdx.x == 0) {
        unsigned* bar = b.bar;
        __builtin_amdgcn_s_waitcnt(0);
        unsigned nloc = b.st[0], nx = b.st[1];
        if (nloc == 0u) { xcd_barrier_complete(bar, b.x, nloc, nx); b.st[0] = nloc; b.st[1] = nx; }
        const unsigned old = xb_add(&bar[XB_XSUB(b.x)], 1u);
        const unsigned gen = old / nloc;
        if (old + 1u == (gen + 1u) * nloc) {
            __builtin_amdgcn_fence(__ATOMIC_RELEASE, "agent");
            asm volatile("s_waitcnt vmcnt(0)" ::: "memory");
            const unsigned og = xb_add(&bar[XB_TOP], 1u);
            const unsigned tg = og / nx;
            if (og + 1u == (tg + 1u) * nx) xb_add(&bar[XB_TOPGEN], 1u);
            else XB_SPIN(xb_ld(&bar[XB_TOPGEN]) == tg, bar);
            __builtin_amdgcn_fence(__ATOMIC_ACQUIRE, "agent");
            xb_add(&bar[XB_XGEN(b.x)], 1u);
            asm volatile("s_waitcnt vmcnt(0)" ::: "memory");
        } else {
            XB_SPIN(xb_ld(&bar[XB_XGEN(b.x)]) == gen, bar);
            __builtin_amdgcn_fence(__ATOMIC_ACQUIRE, "agent");
            asm volatile("s_waitcnt vmcnt(0)" ::: "memory");
        }
    }
    __syncthreads();
}

constexpr int NT = 512;
#define GTID ((size_t)blockIdx.x * NT + threadIdx.x)
#define GNT  ((size_t)gridDim.x * NT)

__device__ void ph_transpose(const float* __restrict__ W, bf16_t* __restrict__ Wt, int K, int N) {
    for (size_t idx = GTID; idx < (size_t)K * N; idx += GNT) {
        int n = (int)(idx / K), k = (int)(idx % K);
        Wt[idx] = f2bf(W[(size_t)k * N + n]);
    }
}
__device__ void ph_convert(const float* __restrict__ src, bf16_t* __restrict__ dst, size_t n) {
    for (size_t idx = GTID; idx < n; idx += GNT) dst[idx] = f2bf(src[idx]);
}
__device__ void ph_mod(const Params& p) {
    for (size_t idx = GTID; idx < 2 * 5 * 6144; idx += GNT) {
        int j = idx % 6144, cv = (idx / 6144) % 5, l = idx / (6144 * 5);
        const float* cvec = cv == 0 ? p.in[I_CCTX] : p.in[I_C] + (size_t)(cv - 1) * D;
        const float* W = p.in[I_ADAW] + (size_t)l * D * 6144;
        float acc = 0.f;
        for (int k = 0; k < D; ++k) {
            float c = cvec[k];
            float s = c / (1.f + expf(-c));
            acc += s * W[(size_t)k * 6144 + j];
        }
        ((float*)(p.ws + OFF_MOD))[idx] = acc + p.in[I_ADAB][l * 6144 + j];
    }
}
__device__ void ph_rope_tab(const Params& p) {
    for (size_t idx = GTID; idx < 2048 * 48; idx += GNT) {
        int s = idx / 48, i = idx % 48;
        float* R = (float*)(p.ws + OFF_ROPE);
        double row = (double)(s / 64), col = (double)(s % 64);
        if (i < 16) {
            int q = i & 7; double inv = pow(10000.0, -(double)q / 8.0);
            double ang = (i < 8 ? row : col) * inv;
            R[s * 16 + i] = (float)cos(ang); R[2048 * 16 + s * 16 + i] = (float)sin(ang);
        } else {
            int ii = i - 16; int q = ii & 15; double inv = pow(10000.0, -(double)q / 16.0);
            double ang = (ii < 16 ? row : col) * inv;
            R[2048 * 32 + s * 32 + ii] = (float)cos(ang); R[2048 * 64 + s * 32 + ii] = (float)sin(ang);
        }
    }
}
__device__ void ph_cache_prep(const Params& p, int l) {
    bf16_t* DKS = (bf16_t*)(p.ws + OFF_DKS); bf16_t* DVTS = (bf16_t*)(p.ws + OFF_DVTS);
    bf16_t* GKS = (bf16_t*)(p.ws + OFF_GKS); bf16_t* GVTS = (bf16_t*)(p.ws + OFF_GVTS);
    for (size_t idx = GTID; idx < 4 * 512 * 256; idx += GNT) {
        int c = idx & 255, pp = (idx >> 8) & 511, b = idx >> 17;
        size_t src = (((size_t)b * 2 + l) * PAST + pp) * 256 + c;
        int h = c >> 6, r = c & 63;
        DKS[(((size_t)b * 4 + h) * NKS + DSEQ + pp) * 64 + r] = f2bf(p.in[I_CDK][src]);
        DVTS[(((size_t)b * 4 + h) * 64 + r) * NKS + DSEQ + pp] = f2bf(p.in[I_CDV][src]);
        if (c < 128) {
            size_t src2 = (((size_t)b * 2 + l) * PAST + pp) * 128 + c;
            int kv = c >> 6;
            GKS[(((size_t)b * 2 + kv) * NKS + DSEQ + pp) * 64 + r] = f2bf(p.in[I_CGK][src2]);
            GVTS[(((size_t)b * 2 + kv) * 64 + r) * NKS + DSEQ + pp] = f2bf(p.in[I_CGV][src2]);
        }
    }
}
__device__ void ph_norm_mod(const Params& p, int l, int which, int from_input) {
    const int lane = threadIdx.x & 63;
    const int gw = blockIdx.x * 8 + (threadIdx.x >> 6), nw = gridDim.x * 8;
    const float* g = p.in[which ? I_N2G : I_N1G] + l * D;
    for (int t = gw; t < NTOK; t += nw) {
        const float* xr = from_input ? x_in_row(p, t) : (const float*)(p.ws + OFF_XC) + (size_t)t * D;
        const float* mod = (const float*)(p.ws + OFF_MOD) + (size_t)(l * 5 + tok_cv(t)) * 6144 + which * 3072;
        float4 v[4]; float ss = 0.f;
#pragma unroll
        for (int i = 0; i < 4; ++i) { v[i] = *reinterpret_cast<const float4*>(xr + i * 256 + lane * 4); ss += v[i].x * v[i].x + v[i].y * v[i].y + v[i].z * v[i].z + v[i].w * v[i].w; }
        ss = wave_sum(ss);
        float r = rsqrtf(ss / D + EPS);
        bf16_t* H = (bf16_t*)(p.ws + OFF_H) + (size_t)t * D;
#pragma unroll
        for (int i = 0; i < 4; ++i) {
            int c = i * 256 + lane * 4;
            float4 gg = *reinterpret_cast<const float4*>(g + c), sh = *reinterpret_cast<const float4*>(mod + c), sc = *reinterpret_cast<const float4*>(mod + 1024 + c);
            ushort4 o;
            o.x = f2bf(v[i].x * r * gg.x * (1.f + sc.x) + sh.x); o.y = f2bf(v[i].y * r * gg.y * (1.f + sc.y) + sh.y);
            o.z = f2bf(v[i].z * r * gg.z * (1.f + sc.z) + sh.z); o.w = f2bf(v[i].w * r * gg.w * (1.f + sc.w) + sh.w);
            *reinterpret_cast<ushort4*>(H + c) = o;
        }
    }
}
__device__ void ph_gemm_ref(const bf16_t* __restrict__ A, const bf16_t* __restrict__ Bt, float* __restrict__ C, int M, int N, int K) {
    const int lane = threadIdx.x & 63;
    const int gw = blockIdx.x * 8 + (threadIdx.x >> 6), nw = gridDim.x * 8;
    const int fr = lane & 15, fq = lane >> 4;
    const int ntn = N / 32, ntiles = (M / 32) * ntn;
    for (int tile = gw; tile < ntiles; tile += nw) {
        const int bm = (tile / ntn) * 32, bn = (tile % ntn) * 32;
        f32x4 acc[2][2];
#pragma unroll
        for (int i = 0; i < 2; ++i)
#pragma unroll
            for (int j = 0; j < 2; ++j) acc[i][j] = f32x4{0.f, 0.f, 0.f, 0.f};
        for (int k0 = 0; k0 < K; k0 += 32) {
            bf16x8 a[2], b[2];
#pragma unroll
            for (int i = 0; i < 2; ++i) {
                a[i] = *reinterpret_cast<const bf16x8*>(A + (size_t)(bm + i * 16 + fr) * K + k0 + fq * 8);
                b[i] = *reinterpret_cast<const bf16x8*>(Bt + (size_t)(bn + i * 16 + fr) * K + k0 + fq * 8);
            }
#pragma unroll
            for (int i = 0; i < 2; ++i)
#pragma unroll
                for (int j = 0; j < 2; ++j) acc[i][j] = __builtin_amdgcn_mfma_f32_16x16x32_bf16(a[i], b[j], acc[i][j], 0, 0, 0);
        }
#pragma unroll
        for (int i = 0; i < 2; ++i)
#pragma unroll
            for (int j = 0; j < 2; ++j)
#pragma unroll
                for (int r = 0; r < 4; ++r)
                    C[(size_t)(bm + i * 16 + fq * 4 + r) * N + bn + j * 16 + fr] = acc[i][j][r];
    }
}
__device__ void ph_inproj_epi(const Params& p, int l) {
    const int sub = threadIdx.x >> 8, tid = threadIdx.x & 255;
    const float* R = (const float*)(p.ws + OFF_ROPE);
    bf16_t* AU = (bf16_t*)(p.ws + OFF_AU); bf16_t* AV = (bf16_t*)(p.ws + OFF_AV); bf16_t* DQ = (bf16_t*)(p.ws + OFF_DQ);
    bf16_t* GQ = (bf16_t*)(p.ws + OFF_GQ);
    for (int t = blockIdx.x * 2 + sub; t < NTOK; t += gridDim.x * 2) {
        const float* pr = (const float*)(p.ws + OFF_PROJ) + (size_t)t * INW;
        const bool prompt = t < NPT;
        const int b = prompt ? t / SEQ : (t - NPT) / DSEQ;
        const int s = prompt ? t % SEQ : (t - NPT) % DSEQ;
        const float* cosd = R + s * 16, *sind = R + 2048 * 16 + s * 16;
        const float* cosg = R + 2048 * 32 + s * 32, *sing = R + 2048 * 64 + s * 32;
        for (int c = tid; c < INW; c += 256) {
            float v = pr[c];
            if (c < 256) { AU[(size_t)t * 256 + c] = f2bf(gelu_f(v)); }
            else if (c < 512) { AV[(size_t)t * 256 + c - 256] = f2bf(gelu_f(v)); }
            else if (c < 1024) {
                int cc = (c - 512) & 255; int d = cc & 31; int base = c - d;
                float o = v;
                if (!prompt) {
                    int i = d & 15; float x1 = pr[base + i], x2 = pr[base + 16 + i];
                    o = d < 16 ? x1 * cosd[i] - x2 * sind[i] : x2 * cosd[i] + x1 * sind[i];
                }
                if (c < 768) DQ[(size_t)t * 256 + cc] = f2bf(o);
                else {
                    int h = cc >> 6, r = cc & 63;
                    if (prompt) {
                        p.out[OUT_NDK + (((size_t)b * 2 + l) * SEQ + s) * 256 + cc] = v;
                        ((bf16_t*)(p.ws + OFF_DKP))[(((size_t)b * 4 + h) * SEQ + s) * 64 + r] = f2bf(o);
                    } else ((bf16_t*)(p.ws + OFF_DKS))[(((size_t)b * 4 + h) * NKS + s) * 64 + r] = f2bf(o);
                }
            } else if (c < 1280) {
                int cc = c - 1024; int h = cc >> 6, r = cc & 63;
                if (prompt) {
                    p.out[OUT_NDV + (((size_t)b * 2 + l) * SEQ + s) * 256 + cc] = v;
                    ((bf16_t*)(p.ws + OFF_DVTP))[(((size_t)b * 4 + h) * 64 + r) * SEQ + s] = f2bf(v);
                } else ((bf16_t*)(p.ws + OFF_DVTS))[(((size_t)b * 4 + h) * 64 + r) * NKS + s] = f2bf(v);
            } else if (c < 1920) {
                int d = c & 63; int base = c - d;
                const bool isq = c < 1792;
                const float* g = p.in[isq ? I_QNG : I_KNG] + l * 64;
                float ss = 0.f;
                for (int i = 0; i < 64; ++i) ss += pr[base + i] * pr[base + i];
                float rr = rsqrtf(ss / 64.f + EPS);
                float nv = v * rr * g[d];
                float o = nv;
                if (!prompt) {
                    int i = d & 31;
                    float x1 = pr[base + i] * rr * g[i], x2 = pr[base + 32 + i] * rr * g[32 + i];
                    o = d < 32 ? x1 * cosg[i] - x2 * sing[i] : x2 * cosg[i] + x1 * sing[i];
                }
                if (isq) GQ[(size_t)t * 512 + c - 1280] = f2bf(o);
                else {
                    int cc = c - 1792; int kv = cc >> 6;
                    if (prompt) {
                        p.out[OUT_NGK + (((size_t)b * 2 + l) * SEQ + s) * 128 + cc] = nv;
                        ((bf16_t*)(p.ws + OFF_GKP))[(((size_t)b * 2 + kv) * SEQ + s) * 64 + d] = f2bf(o);
                    } else ((bf16_t*)(p.ws + OFF_GKS))[(((size_t)b * 2 + kv) * NKS + s) * 64 + d] = f2bf(o);
                }
            } else {
                int cc = c - 1920; int kv = cc >> 6, d = cc & 63;
                if (prompt) {
                    p.out[OUT_NGV + (((size_t)b * 2 + l) * SEQ + s) * 128 + cc] = v;
                    ((bf16_t*)(p.ws + OFF_GVTP))[(((size_t)b * 2 + kv) * 64 + d) * SEQ + s] = f2bf(v);
                } else ((bf16_t*)(p.ws + OFF_GVTS))[(((size_t)b * 2 + kv) * 64 + d) * NKS + s] = f2bf(v);
            }
        }
    }
}
__device__ void ph_sgu_norm(const Params& p, int l) {
    const int lane = threadIdx.x & 63;
    const int gw = blockIdx.x * 8 + (threadIdx.x >> 6), nw = gridDim.x * 8;
    for (int t = gw; t < NTOK; t += nw) {
        const bf16_t* AV = (const bf16_t*)(p.ws + OFF_AV) + (size_t)t * 256;
        float v[4]; float ss = 0.f;
#pragma unroll
        for (int i = 0; i < 4; ++i) { v[i] = bf2f(AV[i * 64 + lane]); ss += v[i] * v[i]; }
        ss = wave_sum(ss);
        float r = rsqrtf(ss / 256.f + EPS);
#pragma unroll
        for (int i = 0; i < 4; ++i) ((bf16_t*)(p.ws + OFF_AVN))[(size_t)t * 256 + i * 64 + lane] = f2bf(v[i] * r * p.in[I_SGUNG][l * 256 + i * 64 + lane]);
    }
}
__device__ void ph_sgu_mix(const Params& p, int l) {
    const bf16_t* AVN = (const bf16_t*)(p.ws + OFF_AVN);
    for (size_t idx = GTID; idx < (size_t)NTOK * 256; idx += GNT) {
        int t = (int)(idx >> 8), c = (int)(idx & 255);
        int t0 = t & ~127, pp = t & 127, g = c >> 6;
        const bf16_t* W = (const bf16_t*)(p.ws + OFF_SGUW) + (((size_t)l * 4 + g) * 128 + pp) * 128;
        float acc = 0.f;
        for (int q = 0; q < 128; ++q) acc += bf2f(W[q]) * bf2f(AVN[(size_t)(t0 + q) * 256 + c]);
        acc += p.in[I_SGUB][(l * 4 + g) * 128 + pp];
        float au = bf2f(((const bf16_t*)(p.ws + OFF_AU))[(size_t)t * 256 + c]);
        ((bf16_t*)(p.ws + OFF_MIX))[(size_t)t * D + c] = f2bf(au * acc);
    }
}
__device__ void ph_attn_ref(const Params& p, int l) {
    const int lane = threadIdx.x & 63;
    const int gw = blockIdx.x * 8 + (threadIdx.x >> 6), nw = gridDim.x * 8;
    const float lam = lam_of(p, l);
    for (int item = gw; item < NTOK * 12; item += nw) {
        const int t = item % NTOK, hh = item / NTOK;
        const bool prompt = t < NPT;
        const int b = prompt ? t / SEQ : (t - NPT) / DSEQ;
        const int nk = prompt ? SEQ : NKS;
        if (hh < 4) {
            const int h = hh;
            const bf16_t* K = prompt ? (const bf16_t*)(p.ws + OFF_DKP) + ((size_t)b * 4 + h) * SEQ * 64 : (const bf16_t*)(p.ws + OFF_DKS) + ((size_t)b * 4 + h) * NKS * 64;
            const bf16_t* Vt = prompt ? (const bf16_t*)(p.ws + OFF_DVTP) + ((size_t)b * 4 + h) * 64 * SEQ : (const bf16_t*)(p.ws + OFF_DVTS) + ((size_t)b * 4 + h) * 64 * NKS;
            float q = bf2f(((const bf16_t*)(p.ws + OFF_DQ))[(size_t)t * 256 + h * 64 + lane]);
            const float scale = 0.17677669529663687f;
            float m0 = -1e30f, m1 = -1e30f, l0 = 0.f, l1 = 0.f, a0 = 0.f, a1 = 0.f;
            for (int k = 0; k < nk; ++k) {
                float pr = q * bf2f(K[(size_t)k * 64 + lane]);
#pragma unroll
                for (int o = 16; o >= 1; o >>= 1) pr += __shfl_xor(pr, o);
                float s0 = __shfl(pr, 0) * scale, s1 = __shfl(pr, 32) * scale;
                float v = bf2f(Vt[(size_t)lane * nk + k]);
                float mn0 = fmaxf(m0, s0), mn1 = fmaxf(m1, s1);
                float c0 = expf(m0 - mn0), c1 = expf(m1 - mn1);
                float e0 = expf(s0 - mn0), e1 = expf(s1 - mn1);
                l0 = l0 * c0 + e0; l1 = l1 * c1 + e1;
                a0 = a0 * c0 + e0 * v; a1 = a1 * c1 + e1 * v;
                m0 = mn0; m1 = mn1;
            }
            float o = a0 / l0 - lam * a1 / l1;
            float ss = wave_sum(o * o);
            float r = rsqrtf(ss / 64.f + EPS);
            o = o * r * p.in[I_SUBLN][l * 64 + lane] * (1.f - lam_init_of(l));
            ((bf16_t*)(p.ws + OFF_MIX))[(size_t)t * D + 256 + h * 64 + lane] = f2bf(o);
        } else {
            const int hq = hh - 4, kv = hq >> 2;
            const bf16_t* K = prompt ? (const bf16_t*)(p.ws + OFF_GKP) + ((size_t)b * 2 + kv) * SEQ * 64 : (const bf16_t*)(p.ws + OFF_GKS) + ((size_t)b * 2 + kv) * NKS * 64;
            const bf16_t* Vt = prompt ? (const bf16_t*)(p.ws + OFF_GVTP) + ((size_t)b * 2 + kv) * 64 * SEQ : (const bf16_t*)(p.ws + OFF_GVTS) + ((size_t)b * 2 + kv) * 64 * NKS;
            float q = bf2f(((const bf16_t*)(p.ws + OFF_GQ))[(size_t)t * 512 + hq * 64 + lane]);
            float m = -1e30f, ls = 0.f, a = 0.f;
            for (int k = 0; k < nk; ++k) {
                float s = wave_sum(q * bf2f(K[(size_t)k * 64 + lane])) * 0.125f;
                float v = bf2f(Vt[(size_t)lane * nk + k]);
                float mn = fmaxf(m, s);
                float c = expf(m - mn), e = expf(s - mn);
                ls = ls * c + e; a = a * c + e * v; m = mn;
            }
            ((bf16_t*)(p.ws + OFF_MIX))[(size_t)t * D + 512 + hq * 64 + lane] = f2bf(a / ls);
        }
    }
}
__device__ void ph_resid(const Params& p, int l, int gsel, int from_input) {
    for (size_t idx = GTID; idx < (size_t)NTOK * D; idx += GNT) {
        int t = (int)(idx >> 10), c = (int)(idx & 1023);
        const float* xr = from_input ? x_in_row(p, t) : (const float*)(p.ws + OFF_XC) + (size_t)t * D;
        const float* mod = (const float*)(p.ws + OFF_MOD) + (size_t)(l * 5 + tok_cv(t)) * 6144 + gsel * 1024;
        ((float*)(p.ws + OFF_XC))[idx] = xr[c] + mod[c] * ((const float*)(p.ws + OFF_PROJ))[idx];
    }
}
__device__ void ph_store_q(const Params& p) {
    for (size_t idx = GTID; idx < (size_t)NTOK * D; idx += GNT) ((bf16_t*)(p.ws + OFF_Q))[idx] = f2bf(((const float*)(p.ws + OFF_PROJ))[idx]);
}
__device__ void ph_peer_scores(const Params& p, int l) {
    const bf16_t* SK = (const bf16_t*)(p.ws + OFF_SUBK) + (size_t)l * 2 * 128 * 64;
    for (size_t idx = GTID; idx < (size_t)NTOK * 2048; idx += GNT) {
        int t = (int)(idx >> 11), o = (int)(idx & 2047);
        const bf16_t* Q = (const bf16_t*)(p.ws + OFF_Q) + (size_t)t * D;
        int n = o & 127, x = (o >> 7) & 1, h = o >> 8;
        float acc = 0.f;
        for (int k = 0; k < 64; ++k) acc += bf2f(Q[h * 128 + x * 64 + k]) * bf2f(SK[((size_t)x * 128 + n) * 64 + k]);
        ((float*)(p.ws + OFF_PROJ))[idx] = acc;
    }
}
__device__ void ph_peer_top1(const Params& p) {
    for (size_t idx = GTID; idx < (size_t)NTOK * 16; idx += GNT) {
        const float* SC = (const float*)(p.ws + OFF_PROJ) + idx * 128;
        float* TV = (float*)(p.ws + OFF_TOPV) + idx * 16; int* TI = (int*)(p.ws + OFF_TOPI) + idx * 16;
        float pv = 3.0e38f; int pi = -1;
        for (int r = 0; r < 16; ++r) {
            float bv = -3.0e38f; int bi = -1;
            for (int n = 0; n < 128; ++n) {
                float v = SC[n];
                bool after = (v < pv) || (v == pv && n > pi);
                if (after && (bi < 0 || v > bv)) { bv = v; bi = n; }
            }
            TV[r] = bv; TI[r] = bi; pv = bv; pi = bi;
        }
    }
}
__device__ void ph_peer_top2(const Params& p) {
    for (size_t idx = GTID; idx < (size_t)NTOK * 8; idx += GNT) {
        const float* TV = (const float*)(p.ws + OFF_TOPV) + idx * 32; const int* TI = (const int*)(p.ws + OFF_TOPI) + idx * 32;
        int* EI = (int*)(p.ws + OFF_EIDX) + idx * 16; float* EG = (float*)(p.ws + OFF_EGATE) + idx * 16;
        float pv = 3.0e38f; int pi = -1; float mx = 0.f, sum = 0.f;
        for (int r = 0; r < 16; ++r) {
            float bv = -3.0e38f; int bi = -1;
            for (int n = 0; n < 256; ++n) {
                float v = TV[n >> 4] + TV[16 + (n & 15)];
                bool after = (v < pv) || (v == pv && n > pi);
                if (after && (bi < 0 || v > bv)) { bv = v; bi = n; }
            }
            if (r == 0) mx = bv;
            float e = expf(bv - mx);
            sum += e;
            EG[r] = e; EI[r] = TI[bi >> 4] * 128 + TI[16 + (bi & 15)];
            pv = bv; pi = bi;
        }
        float inv = 1.f / sum;
        for (int r = 0; r < 16; ++r) EG[r] *= inv;
    }
}
__device__ void ph_peer_apply(const Params& p, int l, unsigned char* lds) {
    const int sub = threadIdx.x >> 8, tid = threadIdx.x & 255;
    const int wave = tid >> 6, lane = tid & 63;
    float* wts = (float*)(lds + 64) + sub * 128; int* eid = (int*)(lds + 64 + 1024) + sub * 128;
    const bf16_t* UT = (const bf16_t*)(p.ws + OFF_UT) + (size_t)l * NEXP * D;
    const bf16_t* VT = (const bf16_t*)(p.ws + OFF_VT) + (size_t)l * NEXP * D;
    const int niter = (NTOK + gridDim.x * 2 - 1) / (gridDim.x * 2);
    for (int it = 0; it < niter; ++it) {
        int t = (it * gridDim.x + blockIdx.x) * 2 + sub;
        const bool valid = t < NTOK; if (!valid) t = NTOK - 1;
        const bf16_t* H = (const bf16_t*)(p.ws + OFF_H) + (size_t)t * D;
        const int* EI = (const int*)(p.ws + OFF_EIDX) + (size_t)t * 128; const float* EG = (const float*)(p.ws + OFF_EGATE) + (size_t)t * 128;
        float hv[16];
#pragma unroll
        for (int i = 0; i < 16; ++i) hv[i] = bf2f(H[lane * 16 + i]);
        for (int jj = 0; jj < 32; ++jj) {
            int j = wave * 32 + jj; int e = EI[j];
            const bf16_t* ur = UT + (size_t)e * D + lane * 16;
            float acc = 0.f;
#pragma unroll
            for (int i = 0; i < 16; ++i) acc += hv[i] * bf2f(ur[i]);
            acc = wave_sum(acc);
            if (lane == 0) { wts[j] = EG[j] * gelu_f(acc); eid[j] = e; }
        }
        __syncthreads();
        float o[4] = {0.f, 0.f, 0.f, 0.f};
        for (int j = 0; j < 128; ++j) {
            const bf16_t* vr = VT + (size_t)eid[j] * D + tid * 4; float w = wts[j];
#pragma unroll
            for (int i = 0; i < 4; ++i) o[i] += w * bf2f(vr[i]);
        }
        const float* mod = (const float*)(p.ws + OFF_MOD) + (size_t)(l * 5 + tok_cv(t)) * 6144 + 5 * 1024;
        float* XC = (float*)(p.ws + OFF_XC) + (size_t)t * D;
        if (valid) {
#pragma unroll
            for (int i = 0; i < 4; ++i) { int c = tid * 4 + i; XC[c] += mod[c] * o[i]; }
        }
        __syncthreads();
    }
}
__device__ void ph_final_norm(const Params& p) {
    const int lane = threadIdx.x & 63;
    const int gw = blockIdx.x * 8 + (threadIdx.x >> 6), nw = gridDim.x * 8;
    for (int t = gw; t < NTOK; t += nw) {
        const float* xr = (const float*)(p.ws + OFF_XC) + (size_t)t * D;
        float4 v[4]; float ss = 0.f;
#pragma unroll
        for (int i = 0; i < 4; ++i) { v[i] = *reinterpret_cast<const float4*>(xr + i * 256 + lane * 4); ss += v[i].x * v[i].x + v[i].y * v[i].y + v[i].z * v[i].z + v[i].w * v[i].w; }
        ss = wave_sum(ss);
        float r = rsqrtf(ss / D + EPS);
        float* y = p.out + (size_t)t * D;
#pragma unroll
        for (int i = 0; i < 4; ++i) {
            int c = i * 256 + lane * 4;
            float4 g = *reinterpret_cast<const float4*>(p.in[I_FG] + c);
            float4 o; o.x = v[i].x * r * g.x; o.y = v[i].y * r * g.y; o.z = v[i].z * r * g.z; o.w = v[i].w * r * g.w;
            *reinterpret_cast<float4*>(y + c) = o;
        }
    }
}

constexpr int LDS_BYTES = 128 * 1024;
__global__ void __launch_bounds__(NT, 2) mk_fwd(Params p) {
    extern __shared__ __attribute__((aligned(16))) unsigned char lds[];
    volatile LAS unsigned* st = (volatile LAS unsigned*)lds;
    if (threadIdx.x < 4) st[threadIdx.x] = 0u;
    __syncthreads();
    XcdBarrier xb = xcd_barrier_post((unsigned*)(p.ws + OFF_BAR), st);
#define GRID_BAR() xcd_barrier(xb)
    unsigned char* ws = p.ws;
    for (int l = 0; l < 2; ++l) {
        ph_transpose(p.in[I_WIN] + (size_t)l * D * INW, (bf16_t*)(ws + OFF_WIN) + (size_t)l * INW * D, D, INW);
        ph_transpose(p.in[I_WOUT] + (size_t)l * D * D, (bf16_t*)(ws + OFF_WOUT) + (size_t)l * D * D, D, D);
        ph_transpose(p.in[I_WQ] + (size_t)l * D * D, (bf16_t*)(ws + OFF_WQ) + (size_t)l * D * D, D, D);
    }
    ph_convert(p.in[I_PU], (bf16_t*)(ws + OFF_UT), (size_t)2 * NEXP * D);
    ph_convert(p.in[I_PV], (bf16_t*)(ws + OFF_VT), (size_t)2 * NEXP * D);
    ph_convert(p.in[I_SUBK], (bf16_t*)(ws + OFF_SUBK), 2 * 2 * 128 * 64);
    ph_convert(p.in[I_SGUW], (bf16_t*)(ws + OFF_SGUW), 2 * 4 * 128 * 128);
    ph_mod(p);
    ph_rope_tab(p);
    GRID_BAR();
    for (int l = 0; l < 2; ++l) {
        ph_norm_mod(p, l, 0, l == 0 ? 1 : 0);
        ph_cache_prep(p, l);
        GRID_BAR();
        ph_gemm_ref((const bf16_t*)(ws + OFF_H), (const bf16_t*)(ws + OFF_WIN) + (size_t)l * INW * D, (float*)(ws + OFF_PROJ), NTOK, INW, D);
        GRID_BAR();
        ph_inproj_epi(p, l);
        GRID_BAR();
        ph_sgu_norm(p, l);
        GRID_BAR();
        ph_sgu_mix(p, l);
        ph_attn_ref(p, l);
        GRID_BAR();
        ph_gemm_ref((const bf16_t*)(ws + OFF_MIX), (const bf16_t*)(ws + OFF_WOUT) + (size_t)l * D * D, (float*)(ws + OFF_PROJ), NTOK, D, D);
        GRID_BAR();
        ph_resid(p, l, 2, l == 0 ? 1 : 0);
        GRID_BAR();
        ph_norm_mod(p, l, 1, 0);
        GRID_BAR();
        ph_gemm_ref((const bf16_t*)(ws + OFF_H), (const bf16_t*)(ws + OFF_WQ) + (size_t)l * D * D, (float*)(ws + OFF_PROJ), NTOK, D, D);
        GRID_BAR();
        ph_store_q(p);
        GRID_BAR();
        ph_peer_scores(p, l);
        GRID_BAR();
        ph_peer_top1(p);
        GRID_BAR();
        ph_peer_top2(p);
        GRID_BAR();
        ph_peer_apply(p, l, lds);
        GRID_BAR();
    }
    ph_final_norm(p);
}

extern "C" void kernel_launch(void* const* d_in, const int* in_sizes, int n_in,
                              void* d_out, int out_size, void* d_ws, size_t ws_size,
                              hipStream_t stream) {
    static int grid = 0;
    if (grid == 0) {
        if (ws_size < WS_NEED) { fprintf(stderr, "kernel_launch: workspace too small: %zu < %zu\n", ws_size, (size_t)WS_NEED); grid = -1; return; }
        int dev = 0, cus = 0, per_cu = 0;
        (void)hipGetDevice(&dev);
        (void)hipDeviceGetAttribute(&cus, hipDeviceAttributeMultiprocessorCount, dev);
        (void)hipFuncSetAttribute((const void*)mk_fwd, hipFuncAttributeMaxDynamicSharedMemorySize, LDS_BYTES);
        (void)hipOccupancyMaxActiveBlocksPerMultiprocessor(&per_cu, (const void*)mk_fwd, NT, LDS_BYTES);
        if (per_cu < 1) { fprintf(stderr, "kernel_launch: occupancy query reports %d blocks per CU\n", per_cu); grid = -1; return; }
        grid = cus;
    }
    if (grid < 0) return;
    (void)hipMemsetAsync((unsigned char*)d_ws + OFF_BAR, 0, 64 * 1024, stream);
    Params p{};
    for (int i = 0; i < 29; ++i) p.in[i] = (const float*)d_in[i];
    p.out = (float*)d_out; p.ws = (unsigned char*)d_ws;
    void* args[] = {&p};
    hipError_t e = hipLaunchCooperativeKernel((const void*)mk_fwd, dim3(grid), dim3(NT), args, LDS_BYTES, stream);
    if (e != hipSuccess) fprintf(stderr, "kernel_launch: cooperative launch failed: %s (grid %d)\n", hipGetErrorString(e), grid);
}
```

```cpp
#include <hip/hip_runtime.h>
#include <hip/hip_bf16.h>
#include <cstdio>
#include <cstdint>
#include <hip/hip_cooperative_groups.h>
namespace cg = cooperative_groups;

typedef unsigned short bf16_t;
using bf16x8 = __attribute__((ext_vector_type(8))) short;
using f32x4  = __attribute__((ext_vector_type(4))) float;

constexpr int D      = 1024;
constexpr int NTOK   = 16384;
constexpr int NPT    = 8192;
constexpr int SEQ    = 256;
constexpr int DSEQ   = 2048;
constexpr int PAST   = 512;
constexpr int NKS    = DSEQ + PAST;
constexpr int INW    = 2048;
constexpr int NEXP   = 16384;
constexpr float EPS  = 1e-6f;

constexpr size_t MB = 1024 * 1024;
constexpr size_t OFF_BAR   = 0;
constexpr size_t OFF_MOD   = 64 * 1024;
constexpr size_t OFF_ROPE  = OFF_MOD + 256 * 1024;
constexpr size_t OFF_SUBK  = OFF_ROPE + 1 * MB;
constexpr size_t OFF_SGUW  = OFF_SUBK + 64 * 1024;
constexpr size_t OFF_WIN   = OFF_SGUW + 256 * 1024;
constexpr size_t OFF_WOUT  = OFF_WIN + 8 * MB;
constexpr size_t OFF_WQ    = OFF_WOUT + 4 * MB;
constexpr size_t OFF_UT    = OFF_WQ + 4 * MB;
constexpr size_t OFF_VT    = OFF_UT + 64 * MB;
constexpr size_t OFF_H     = OFF_VT + 64 * MB;
constexpr size_t OFF_XC    = OFF_H + 32 * MB;
constexpr size_t OFF_R1    = OFF_XC + 64 * MB;
constexpr size_t OFF_AU    = OFF_R1;
constexpr size_t OFF_AV    = OFF_AU + 8 * MB;
constexpr size_t OFF_AVN   = OFF_AV + 8 * MB;
constexpr size_t OFF_DQ    = OFF_AVN + 8 * MB;
constexpr size_t OFF_DKP   = OFF_DQ + 8 * MB;
constexpr size_t OFF_DKS   = OFF_DKP + 4 * MB;
constexpr size_t OFF_DVTP  = OFF_DKS + 5 * MB;
constexpr size_t OFF_DVTS  = OFF_DVTP + 4 * MB;
constexpr size_t OFF_GQ    = OFF_DVTS + 5 * MB;
constexpr size_t OFF_GKP   = OFF_GQ + 16 * MB;
constexpr size_t OFF_GKS   = OFF_GKP + 2 * MB;
constexpr size_t OFF_GVTP  = OFF_GKS + 3 * MB;
constexpr size_t OFF_GVTS  = OFF_GVTP + 2 * MB;
constexpr size_t OFF_MIX   = OFF_GVTS + 3 * MB;
constexpr size_t OFF_R1END = OFF_MIX + 32 * MB;
constexpr size_t OFF_Q     = OFF_R1;
constexpr size_t OFF_EIDX  = OFF_Q + 32 * MB;
constexpr size_t OFF_EGATE = OFF_EIDX + 8 * MB;
constexpr size_t OFF_TOPV  = OFF_EGATE + 8 * MB;
constexpr size_t OFF_TOPI  = OFF_TOPV + 16 * MB;
static_assert(OFF_TOPI + 16 * MB <= OFF_R1END, "peer buffers must fit region 1");
constexpr size_t OFF_PROJ  = OFF_R1END;
constexpr size_t WS_NEED   = OFF_PROJ + 128 * MB;
static_assert(WS_NEED <= 512 * MB, "workspace budget");

constexpr size_t OUT_YP  = 0;
constexpr size_t OUT_YS  = 8388608;
constexpr size_t OUT_NDK = 16777216;
constexpr size_t OUT_NDV = OUT_NDK + 4194304;
constexpr size_t OUT_NGK = OUT_NDV + 4194304;
constexpr size_t OUT_NGV = OUT_NGK + 2097152;

struct Params {
    const float* in[29];
    float* out;
    unsigned char* ws;
};
enum { I_XP = 0, I_XS, I_CDK, I_CDV, I_CGK, I_CGV, I_C, I_CCTX, I_ADAW, I_ADAB, I_N1G, I_N2G, I_WIN, I_SGUNG, I_SGUW, I_SGUB,
       I_LQ1, I_LK1, I_LQ2, I_LK2, I_SUBLN, I_QNG, I_KNG, I_WOUT, I_WQ, I_SUBK, I_PU, I_PV, I_FG };

__device__ __forceinline__ bf16_t f2bf(float f) {
    unsigned u = __float_as_uint(f);
    u += 0x7fffu + ((u >> 16) & 1u);
    return (bf16_t)(u >> 16);
}
__device__ __forceinline__ float bf2f(bf16_t h) { return __uint_as_float(((unsigned)h) << 16); }
__device__ __forceinline__ float gelu_f(float x) {
    const float k = 0.7978845608028654f;
    float u = k * (x + 0.044715f * x * x * x);
    return 0.5f * x * (1.f + tanhf(u));
}
__device__ __forceinline__ float wave_sum(float v) {
#pragma unroll
    for (int o = 32; o >= 1; o >>= 1) v += __shfl_xor(v, o);
    return v;
}
__device__ __forceinline__ int tok_cv(int t) { return t < NPT ? 0 : 1 + ((t - NPT) >> 11); }
__device__ __forceinline__ const float* x_in_row(const Params& p, int t) {
    return t < NPT ? p.in[I_XP] + (size_t)t * D : p.in[I_XS] + (size_t)(t - NPT) * D;
}
__device__ __forceinline__ float lam_init_of(int l) { return l == 0 ? 0.2f : (0.8f - 0.6f * 0.7408182206817179f); }
__device__ __forceinline__ float lam_of(const Params& p, int l) {
    float s1 = 0.f, s2 = 0.f;
    for (int i = 0; i < 32; ++i) {
        s1 += p.in[I_LQ1][l * 32 + i] * p.in[I_LK1][l * 32 + i];
        s2 += p.in[I_LQ2][l * 32 + i] * p.in[I_LK2][l * 32 + i];
    }
    return expf(s1) - expf(s2) + lam_init_of(l);
}


#define XB_TMO      128
#define XB_XCNT(j)  (256  + 64 * (j))
#define XB_XSUB(j)  (1280 + 64 * (j))
#define XB_XGEN(j)  (2304 + 64 * (j))
#define XB_TOP      3328
#define XB_TOPGEN   3392
#define XCD_BAR_WORDS 3456
#define XB_SPIN_CAP (1u << 20)
#define LAS __attribute__((address_space(3)))
__device__ __forceinline__ unsigned xb_ld(unsigned* p)              { return __hip_atomic_load(p, __ATOMIC_RELAXED, __HIP_MEMORY_SCOPE_AGENT); }
__device__ __forceinline__ unsigned xb_add(unsigned* p, unsigned v) { return __hip_atomic_fetch_add(p, v, __ATOMIC_RELAXED, __HIP_MEMORY_SCOPE_AGENT); }
__device__ __forceinline__ unsigned xb_xcc_id() { return (unsigned)__builtin_amdgcn_s_getreg((3 << 11) | 20) & 0xFu; }
#define XB_SPIN(cond, bar) do { unsigned _sp = 0; while (cond) { __builtin_amdgcn_s_sleep(1); \
    if ((++_sp & 255u) == 0u) { if (xb_ld(&(bar)[XB_TMO])) break; if (_sp > XB_SPIN_CAP) { atomicAdd(&(bar)[XB_TMO], 1u); break; } } } } while (0)
struct XcdBarrier { unsigned* bar; unsigned x; volatile LAS unsigned* st; };
__device__ __forceinline__ XcdBarrier xcd_barrier_post(unsigned* bar, volatile LAS unsigned* st) {
    XcdBarrier b; b.bar = bar; b.x = xb_xcc_id(); b.st = st;
    if (threadIdx.x == 0) (void)xb_add(&bar[XB_XCNT(b.x)], 1u);
    return b;
}
__device__ __forceinline__ void xcd_barrier_complete(unsigned* bar, unsigned x, unsigned& nloc, unsigned& nx) {
    const unsigned G = gridDim.x * gridDim.y * gridDim.z;
    unsigned sum, cnt, mine, sp = 0u;
    for (;;) {
        sum = 0u; cnt = 0u; mine = 0u;
#pragma unroll
        for (unsigned j = 0; j < 16; ++j) { const unsigned c = xb_ld(&bar[XB_XCNT(j)]); sum += c; cnt += (c > 0u) ? 1u : 0u; mine = (j == x) ? c : mine; }
        if (sum == G) break;
        __builtin_amdgcn_s_sleep(1);
        if ((++sp & 255u) == 0u) { if (xb_ld(&bar[XB_TMO])) break; if (sp > XB_SPIN_CAP) { atomicAdd(&bar[XB_TMO], 1u); break; } }
    }
    nloc = mine > 0u ? mine : 1u; nx = cnt > 0u ? cnt : 1u;
}
__device__ __forceinline__ void xcd_barrier(const XcdBarrier& b) {
    asm volatile("s_waitcnt vmcnt(0)" ::: "memory");
    __syncthreads();
    if (threadIdx.x == 0) {
        unsigned* bar = b.bar;
        const unsigned bx = xb_xcc_id();
        __builtin_amdgcn_s_waitcnt(0);
        unsigned nloc = b.st[0], nx = b.st[1];
        if (nloc == 0u) { xcd_barrier_complete(bar, bx, nloc, nx); b.st[0] = nloc; b.st[1] = nx; }
        const unsigned old = xb_add(&bar[XB_XSUB(bx)], 1u);
        const unsigned gen = old / nloc;
        if (old + 1u == (gen + 1u) * nloc) {
            __builtin_amdgcn_fence(__ATOMIC_RELEASE, "agent");
            asm volatile("s_waitcnt vmcnt(0)" ::: "memory");
            const unsigned og = xb_add(&bar[XB_TOP], 1u);
            const unsigned tg = og / nx;
            if (og + 1u == (tg + 1u) * nx) xb_add(&bar[XB_TOPGEN], 1u);
            else XB_SPIN(xb_ld(&bar[XB_TOPGEN]) == tg, bar);
            __builtin_amdgcn_fence(__ATOMIC_ACQUIRE, "agent");
            xb_add(&bar[XB_XGEN(bx)], 1u);
            asm volatile("s_waitcnt vmcnt(0)" ::: "memory");
        } else {
            XB_SPIN(xb_ld(&bar[XB_XGEN(bx)]) == gen, bar);
            __builtin_amdgcn_fence(__ATOMIC_ACQUIRE, "agent");
            asm volatile("s_waitcnt vmcnt(0)" ::: "memory");
        }
    }
    __syncthreads();
}

constexpr int NT = 512;
constexpr int LDS_HDR = 1024;
#define GTID ((size_t)blockIdx.x * NT + tid)
__device__ __forceinline__ int opaque_tid() { int t = threadIdx.x; asm volatile("" : "+v"(t)); return t; }
#define GNT  ((size_t)gridDim.x * NT)

__device__ void ph_transpose(const float* __restrict__ W, bf16_t* __restrict__ Wt, int K, int N) {
    const int tid = opaque_tid();
    for (size_t idx = GTID; idx < (size_t)K * N; idx += GNT) {
        int n = (int)(idx / K), k = (int)(idx % K);
        Wt[idx] = f2bf(W[(size_t)k * N + n]);
    }
}
__device__ void ph_convert(const float* __restrict__ src, bf16_t* __restrict__ dst, size_t n) {
    const int tid = opaque_tid();
    for (size_t idx = GTID; idx < n; idx += GNT) dst[idx] = f2bf(src[idx]);
}
__device__ void ph_mod(const Params& p) {
    const int tid = opaque_tid();
    for (size_t idx = GTID; idx < 2 * 5 * 6144; idx += GNT) {
        int j = idx % 6144, cv = (idx / 6144) % 5, l = idx / (6144 * 5);
        const float* cvec = cv == 0 ? p.in[I_CCTX] : p.in[I_C] + (size_t)(cv - 1) * D;
        const float* W = p.in[I_ADAW] + (size_t)l * D * 6144;
        float acc = 0.f;
        for (int k = 0; k < D; ++k) {
            float c = cvec[k];
            float s = c / (1.f + expf(-c));
            acc += s * W[(size_t)k * 6144 + j];
        }
        ((float*)(p.ws + OFF_MOD))[idx] = acc + p.in[I_ADAB][l * 6144 + j];
    }
}
__device__ void ph_rope_tab(const Params& p) {
    const int tid = opaque_tid();
    for (size_t idx = GTID; idx < 2048 * 48; idx += GNT) {
        int s = idx / 48, i = idx % 48;
        float* R = (float*)(p.ws + OFF_ROPE);
        double row = (double)(s / 64), col = (double)(s % 64);
        if (i < 16) {
            int q = i & 7; double inv = pow(10000.0, -(double)q / 8.0);
            double ang = (i < 8 ? row : col) * inv;
            R[s * 16 + i] = (float)cos(ang); R[2048 * 16 + s * 16 + i] = (float)sin(ang);
        } else {
            int ii = i - 16; int q = ii & 15; double inv = pow(10000.0, -(double)q / 16.0);
            double ang = (ii < 16 ? row : col) * inv;
            R[2048 * 32 + s * 32 + ii] = (float)cos(ang); R[2048 * 64 + s * 32 + ii] = (float)sin(ang);
        }
    }
}
__device__ void ph_cache_prep(const Params& p, int l) {
    const int tid = opaque_tid();
    bf16_t* DKS = (bf16_t*)(p.ws + OFF_DKS); bf16_t* DVTS = (bf16_t*)(p.ws + OFF_DVTS);
    bf16_t* GKS = (bf16_t*)(p.ws + OFF_GKS); bf16_t* GVTS = (bf16_t*)(p.ws + OFF_GVTS);
    for (size_t idx = GTID; idx < 4 * 512 * 256; idx += GNT) {
        int c = idx & 255, pp = (idx >> 8) & 511, b = idx >> 17;
        size_t src = (((size_t)b * 2 + l) * PAST + pp) * 256 + c;
        int h = c >> 6, r = c & 63;
        DKS[(((size_t)b * 4 + h) * NKS + DSEQ + pp) * 64 + r] = f2bf(p.in[I_CDK][src]);
        DVTS[(((size_t)b * 4 + h) * 64 + r) * NKS + DSEQ + pp] = f2bf(p.in[I_CDV][src]);
        if (c < 128) {
            size_t src2 = (((size_t)b * 2 + l) * PAST + pp) * 128 + c;
            int kv = c >> 6;
            GKS[(((size_t)b * 2 + kv) * NKS + DSEQ + pp) * 64 + r] = f2bf(p.in[I_CGK][src2]);
            GVTS[(((size_t)b * 2 + kv) * 64 + r) * NKS + DSEQ + pp] = f2bf(p.in[I_CGV][src2]);
        }
    }
}
__device__ void ph_norm_mod(const Params& p, int l, int which, int from_input) {
    const int tid = opaque_tid();
    const int lane = tid & 63;
    const int gw = blockIdx.x * 8 + (tid >> 6), nw = gridDim.x * 8;
    const float* g = p.in[which ? I_N2G : I_N1G] + l * D;
    for (int t = gw; t < NTOK; t += nw) {
        const float* xr = from_input ? x_in_row(p, t) : (const float*)(p.ws + OFF_XC) + (size_t)t * D;
        const float* mod = (const float*)(p.ws + OFF_MOD) + (size_t)(l * 5 + tok_cv(t)) * 6144 + which * 3072;
        float4 v[4]; float ss = 0.f;
#pragma unroll
        for (int i = 0; i < 4; ++i) { v[i] = *reinterpret_cast<const float4*>(xr + i * 256 + lane * 4); ss += v[i].x * v[i].x + v[i].y * v[i].y + v[i].z * v[i].z + v[i].w * v[i].w; }
        ss = wave_sum(ss);
        float r = rsqrtf(ss / D + EPS);
        bf16_t* H = (bf16_t*)(p.ws + OFF_H) + (size_t)t * D;
#pragma unroll
        for (int i = 0; i < 4; ++i) {
            int c = i * 256 + lane * 4;
            float4 gg = *reinterpret_cast<const float4*>(g + c), sh = *reinterpret_cast<const float4*>(mod + c), sc = *reinterpret_cast<const float4*>(mod + 1024 + c);
            ushort4 o;
            o.x = f2bf(v[i].x * r * gg.x * (1.f + sc.x) + sh.x); o.y = f2bf(v[i].y * r * gg.y * (1.f + sc.y) + sh.y);
            o.z = f2bf(v[i].z * r * gg.z * (1.f + sc.z) + sh.z); o.w = f2bf(v[i].w * r * gg.w * (1.f + sc.w) + sh.w);
            *reinterpret_cast<ushort4*>(H + c) = o;
        }
    }
}
__device__ void ph_sgu_norm(const Params& p, int l) {
    const int tid = opaque_tid();
    const int lane = tid & 63;
    const int gw = blockIdx.x * 8 + (tid >> 6), nw = gridDim.x * 8;
    for (int t = gw; t < NTOK; t += nw) {
        const bf16_t* AV = (const bf16_t*)(p.ws + OFF_AV) + (size_t)t * 256;
        float v[4]; float ss = 0.f;
#pragma unroll
        for (int i = 0; i < 4; ++i) { v[i] = bf2f(AV[i * 64 + lane]); ss += v[i] * v[i]; }
        ss = wave_sum(ss);
        float r = rsqrtf(ss / 256.f + EPS);
#pragma unroll
        for (int i = 0; i < 4; ++i) ((bf16_t*)(p.ws + OFF_AVN))[(size_t)t * 256 + i * 64 + lane] = f2bf(v[i] * r * p.in[I_SGUNG][l * 256 + i * 64 + lane]);
    }
}
__device__ void ph_sgu_mix(const Params& p, int l) {
    const int tid = opaque_tid();
    const bf16_t* AVN = (const bf16_t*)(p.ws + OFF_AVN);
    for (size_t idx = GTID; idx < (size_t)NTOK * 256; idx += GNT) {
        int t = (int)(idx >> 8), c = (int)(idx & 255);
        int t0 = t & ~127, pp = t & 127, g = c >> 6;
        const bf16_t* W = (const bf16_t*)(p.ws + OFF_SGUW) + (((size_t)l * 4 + g) * 128 + pp) * 128;
        float acc = 0.f;
        for (int q = 0; q < 128; ++q) acc += bf2f(W[q]) * bf2f(AVN[(size_t)(t0 + q) * 256 + c]);
        acc += p.in[I_SGUB][(l * 4 + g) * 128 + pp];
        float au = bf2f(((const bf16_t*)(p.ws + OFF_AU))[(size_t)t * 256 + c]);
        ((bf16_t*)(p.ws + OFF_MIX))[(size_t)t * D + c] = f2bf(au * acc);
    }
}
__device__ void ph_attn_ref(const Params& p, int l) {
    const int tid = opaque_tid();
    const int lane = tid & 63;
    const int gw = blockIdx.x * 8 + (tid >> 6), nw = gridDim.x * 8;
    const float lam = lam_of(p, l);
    for (int item = gw; item < NTOK * 12; item += nw) {
        const int t = item % NTOK, hh = item / NTOK;
        const bool prompt = t < NPT;
        const int b = prompt ? t / SEQ : (t - NPT) / DSEQ;
        const int nk = prompt ? SEQ : NKS;
        if (hh < 4) {
            const int h = hh;
            const bf16_t* K = prompt ? (const bf16_t*)(p.ws + OFF_DKP) + ((size_t)b * 4 + h) * SEQ * 64 : (const bf16_t*)(p.ws + OFF_DKS) + ((size_t)b * 4 + h) * NKS * 64;
            const bf16_t* Vt = prompt ? (const bf16_t*)(p.ws + OFF_DVTP) + ((size_t)b * 4 + h) * 64 * SEQ : (const bf16_t*)(p.ws + OFF_DVTS) + ((size_t)b * 4 + h) * 64 * NKS;
            float q = bf2f(((const bf16_t*)(p.ws + OFF_DQ))[(size_t)t * 256 + h * 64 + lane]);
            const float scale = 0.17677669529663687f;
            float m0 = -1e30f, m1 = -1e30f, l0 = 0.f, l1 = 0.f, a0 = 0.f, a1 = 0.f;
            for (int k = 0; k < nk; ++k) {
                float pr = q * bf2f(K[(size_t)k * 64 + lane]);
#pragma unroll
                for (int o = 16; o >= 1; o >>= 1) pr += __shfl_xor(pr, o);
                float s0 = __shfl(pr, 0) * scale, s1 = __shfl(pr, 32) * scale;
                float v = bf2f(Vt[(size_t)lane * nk + k]);
                float mn0 = fmaxf(m0, s0), mn1 = fmaxf(m1, s1);
                float c0 = expf(m0 - mn0), c1 = expf(m1 - mn1);
                float e0 = expf(s0 - mn0), e1 = expf(s1 - mn1);
                l0 = l0 * c0 + e0; l1 = l1 * c1 + e1;
                a0 = a0 * c0 + e0 * v; a1 = a1 * c1 + e1 * v;
                m0 = mn0; m1 = mn1;
            }
            float o = a0 / l0 - lam * a1 / l1;
            float ss = wave_sum(o * o);
            float r = rsqrtf(ss / 64.f + EPS);
            o = o * r * p.in[I_SUBLN][l * 64 + lane] * (1.f - lam_init_of(l));
            ((bf16_t*)(p.ws + OFF_MIX))[(size_t)t * D + 256 + h * 64 + lane] = f2bf(o);
        } else {
            const int hq = hh - 4, kv = hq >> 2;
            const bf16_t* K = prompt ? (const bf16_t*)(p.ws + OFF_GKP) + ((size_t)b * 2 + kv) * SEQ * 64 : (const bf16_t*)(p.ws + OFF_GKS) + ((size_t)b * 2 + kv) * NKS * 64;
            const bf16_t* Vt = prompt ? (const bf16_t*)(p.ws + OFF_GVTP) + ((size_t)b * 2 + kv) * 64 * SEQ : (const bf16_t*)(p.ws + OFF_GVTS) + ((size_t)b * 2 + kv) * 64 * NKS;
            float q = bf2f(((const bf16_t*)(p.ws + OFF_GQ))[(size_t)t * 512 + hq * 64 + lane]);
            float m = -1e30f, ls = 0.f, a = 0.f;
            for (int k = 0; k < nk; ++k) {
                float s = wave_sum(q * bf2f(K[(size_t)k * 64 + lane])) * 0.125f;
                float v = bf2f(Vt[(size_t)lane * nk + k]);
                float mn = fmaxf(m, s);
                float c = expf(m - mn), e = expf(s - mn);
                ls = ls * c + e; a = a * c + e * v; m = mn;
            }
            ((bf16_t*)(p.ws + OFF_MIX))[(size_t)t * D + 512 + hq * 64 + lane] = f2bf(a / ls);
        }
    }
}
__device__ void ph_peer_scores(const Params& p, int l) {
    const int tid = opaque_tid();
    const bf16_t* SK = (const bf16_t*)(p.ws + OFF_SUBK) + (size_t)l * 2 * 128 * 64;
    for (size_t idx = GTID; idx < (size_t)NTOK * 2048; idx += GNT) {
        int t = (int)(idx >> 11), o = (int)(idx & 2047);
        const bf16_t* Q = (const bf16_t*)(p.ws + OFF_Q) + (size_t)t * D;
        int n = o & 127, x = (o >> 7) & 1, h = o >> 8;
        float acc = 0.f;
        for (int k = 0; k < 64; ++k) acc += bf2f(Q[h * 128 + x * 64 + k]) * bf2f(SK[((size_t)x * 128 + n) * 64 + k]);
        ((float*)(p.ws + OFF_PROJ))[idx] = acc;
    }
}
__device__ void ph_peer_top1(const Params& p) {
    const int tid = opaque_tid();
    for (size_t idx = GTID; idx < (size_t)NTOK * 16; idx += GNT) {
        const float* SC = (const float*)(p.ws + OFF_PROJ) + idx * 128;
        float* TV = (float*)(p.ws + OFF_TOPV) + idx * 16; int* TI = (int*)(p.ws + OFF_TOPI) + idx * 16;
        float pv = 3.0e38f; int pi = -1;
        for (int r = 0; r < 16; ++r) {
            float bv = -3.0e38f; int bi = -1;
            for (int n = 0; n < 128; ++n) {
                float v = SC[n];
                bool after = (v < pv) || (v == pv && n > pi);
                if (after && (bi < 0 || v > bv)) { bv = v; bi = n; }
            }
            TV[r] = bv; TI[r] = bi; pv = bv; pi = bi;
        }
    }
}
__device__ void ph_peer_top2(const Params& p) {
    const int tid = opaque_tid();
    for (size_t idx = GTID; idx < (size_t)NTOK * 8; idx += GNT) {
        const float* TV = (const float*)(p.ws + OFF_TOPV) + idx * 32; const int* TI = (const int*)(p.ws + OFF_TOPI) + idx * 32;
        int* EI = (int*)(p.ws + OFF_EIDX) + idx * 16; float* EG = (float*)(p.ws + OFF_EGATE) + idx * 16;
        float pv = 3.0e38f; int pi = -1; float mx = 0.f, sum = 0.f;
        for (int r = 0; r < 16; ++r) {
            float bv = -3.0e38f; int bi = -1;
            for (int n = 0; n < 256; ++n) {
                float v = TV[n >> 4] + TV[16 + (n & 15)];
                bool after = (v < pv) || (v == pv && n > pi);
                if (after && (bi < 0 || v > bv)) { bv = v; bi = n; }
            }
            if (r == 0) mx = bv;
            float e = expf(bv - mx);
            sum += e;
            EG[r] = e; EI[r] = TI[bi >> 4] * 128 + TI[16 + (bi & 15)];
            pv = bv; pi = bi;
        }
        float inv = 1.f / sum;
        for (int r = 0; r < 16; ++r) EG[r] *= inv;
    }
}
__device__ void ph_peer_apply(const Params& p, int l, unsigned char* lds) {
    const int tid = opaque_tid();
    const int sub = tid >> 8, tl = tid & 255;
    const int wave = tl >> 6, lane = tl & 63;
    float* wts = (float*)(lds + 64) + sub * 128; int* eid = (int*)(lds + 64 + 1024) + sub * 128;
    const bf16_t* UT = (const bf16_t*)(p.ws + OFF_UT) + (size_t)l * NEXP * D;
    const bf16_t* VT = (const bf16_t*)(p.ws + OFF_VT) + (size_t)l * NEXP * D;
    const int niter = (NTOK + gridDim.x * 2 - 1) / (gridDim.x * 2);
    for (int it = 0; it < niter; ++it) {
        int t = (it * gridDim.x + blockIdx.x) * 2 + sub;
        const bool valid = t < NTOK; if (!valid) t = NTOK - 1;
        const bf16_t* H = (const bf16_t*)(p.ws + OFF_H) + (size_t)t * D;
        const int* EI = (const int*)(p.ws + OFF_EIDX) + (size_t)t * 128; const float* EG = (const float*)(p.ws + OFF_EGATE) + (size_t)t * 128;
        float hv[16];
#pragma unroll
        for (int i = 0; i < 16; ++i) hv[i] = bf2f(H[lane * 16 + i]);
        for (int jj = 0; jj < 32; ++jj) {
            int j = wave * 32 + jj; int e = EI[j];
            const bf16_t* ur = UT + (size_t)e * D + lane * 16;
            float acc = 0.f;
#pragma unroll
            for (int i = 0; i < 16; ++i) acc += hv[i] * bf2f(ur[i]);
            acc = wave_sum(acc);
            if (lane == 0) { wts[j] = EG[j] * gelu_f(acc); eid[j] = e; }
        }
        __syncthreads();
        float o[4] = {0.f, 0.f, 0.f, 0.f};
        for (int j = 0; j < 128; ++j) {
            const bf16_t* vr = VT + (size_t)eid[j] * D + tl * 4; float w = wts[j];
#pragma unroll
            for (int i = 0; i < 4; ++i) o[i] += w * bf2f(vr[i]);
        }
        const float* mod = (const float*)(p.ws + OFF_MOD) + (size_t)(l * 5 + tok_cv(t)) * 6144 + 5 * 1024;
        float* XC = (float*)(p.ws + OFF_XC) + (size_t)t * D;
        if (valid) {
#pragma unroll
            for (int i = 0; i < 4; ++i) { int c = tl * 4 + i; XC[c] += mod[c] * o[i]; }
        }
        __syncthreads();
    }
}
__device__ void ph_final_norm(const Params& p) {
    const int tid = opaque_tid();
    const int lane = tid & 63;
    const int gw = blockIdx.x * 8 + (tid >> 6), nw = gridDim.x * 8;
    for (int t = gw; t < NTOK; t += nw) {
        const float* xr = (const float*)(p.ws + OFF_XC) + (size_t)t * D;
        float4 v[4]; float ss = 0.f;
#pragma unroll
        for (int i = 0; i < 4; ++i) { v[i] = *reinterpret_cast<const float4*>(xr + i * 256 + lane * 4); ss += v[i].x * v[i].x + v[i].y * v[i].y + v[i].z * v[i].z + v[i].w * v[i].w; }
        ss = wave_sum(ss);
        float r = rsqrtf(ss / D + EPS);
        float* y = p.out + (size_t)t * D;
#pragma unroll
        for (int i = 0; i < 4; ++i) {
            int c = i * 256 + lane * 4;
            float4 g = *reinterpret_cast<const float4*>(p.in[I_FG] + c);
            float4 o; o.x = v[i].x * r * g.x; o.y = v[i].y * r * g.y; o.z = v[i].z * r * g.z; o.w = v[i].w * r * g.w;
            *reinterpret_cast<float4*>(y + c) = o;
        }
    }
}


namespace g8 {
constexpr int BM = 256, BK = 64, HALF = 128, HT = HALF * BK;
__device__ __forceinline__ int lds_byte(int r, int c) {
    int st = (r >> 4) * 2 + (c >> 5), rr = r & 15, cc = c & 31, ob = rr * 64 + cc * 2;
    return st * 1024 + (ob ^ (((ob >> 9) & 1) << 5));
}
__device__ __forceinline__ void stage_rc(int b, int& R, int& C) {
    int st = b / 1024, sb = b % 1024, swz = sb ^ (((sb >> 9) & 1) << 5);
    R = (st >> 1) * 16 + swz / 64; C = (st & 1) * 32 + (swz % 64) / 2;
}
}
enum { EPI_INPROJ = 0, EPI_WOUT = 1, EPI_WQ = 2 };
constexpr int STG = 132;

__device__ __forceinline__ unsigned pack_bf2(float a, float b) { return (unsigned)f2bf(a) | ((unsigned)f2bf(b) << 16); }
__device__ __forceinline__ void store_bf16x32(bf16_t* dst, const float (&v)[32]) {
#pragma unroll
    for (int i = 0; i < 4; ++i) {
        uint4 u;
        u.x = pack_bf2(v[i * 8 + 0], v[i * 8 + 1]); u.y = pack_bf2(v[i * 8 + 2], v[i * 8 + 3]);
        u.z = pack_bf2(v[i * 8 + 4], v[i * 8 + 5]); u.w = pack_bf2(v[i * 8 + 6], v[i * 8 + 7]);
        *reinterpret_cast<uint4*>(dst + i * 8) = u;
    }
}
__device__ __forceinline__ void store_f32x32(float* dst, const float (&v)[32]) {
#pragma unroll
    for (int i = 0; i < 8; ++i) *reinterpret_cast<float4*>(dst + i * 4) = make_float4(v[i * 4], v[i * 4 + 1], v[i * 4 + 2], v[i * 4 + 3]);
}

__device__ __forceinline__ void epi_inproj_row(const Params& p, int l, int t, int c0, float (&v)[32]) {
    const bool prompt = t < NPT;
    const int b = prompt ? (t >> 8) : ((t - NPT) >> 11);
    const int s = prompt ? (t & 255) : ((t - NPT) & 2047);
    unsigned char* ws = p.ws;
    const float* R = (const float*)(ws + OFF_ROPE);
    if (c0 < 512) {
        bf16_t* dst = (bf16_t*)(ws + (c0 < 256 ? OFF_AU : OFF_AV)) + (size_t)t * 256 + (c0 & 255);
#pragma unroll
        for (int i = 0; i < 32; ++i) v[i] = gelu_f(v[i]);
        store_bf16x32(dst, v);
    } else if (c0 < 1024) {
        const bool isq = c0 < 768;
        if (!isq && prompt) store_f32x32(p.out + OUT_NDK + (((size_t)b * 2 + l) * SEQ + s) * 256 + (c0 - 768), v);
        if (!prompt) {
            const float* cs = R + s * 16; const float* sn = R + 2048 * 16 + s * 16;
#pragma unroll
            for (int i = 0; i < 16; ++i) {
                float c = cs[i], sv = sn[i], x1 = v[i], x2 = v[i + 16];
                v[i] = x1 * c - x2 * sv; v[i + 16] = x2 * c + x1 * sv;
            }
        }
        bf16_t* dst;
        if (isq) dst = (bf16_t*)(ws + OFF_DQ) + (size_t)t * 256 + (c0 - 512);
        else {
            const int cc = c0 - 768, h = cc >> 6, r = cc & 63;
            dst = prompt ? (bf16_t*)(ws + OFF_DKP) + (((size_t)b * 4 + h) * SEQ + s) * 64 + r
                         : (bf16_t*)(ws + OFF_DKS) + (((size_t)b * 4 + h) * NKS + s) * 64 + r;
        }
        store_bf16x32(dst, v);
    } else if (c0 < 1280) {
        if (prompt) store_f32x32(p.out + OUT_NDV + (((size_t)b * 2 + l) * SEQ + s) * 256 + (c0 - 1024), v);
    } else if (c0 < 1920) {
        const bool isq = c0 < 1792;
        const int hi = c0 & 32;
        const float* g = p.in[isq ? I_QNG : I_KNG] + l * 64 + hi;
        float ss = 0.f;
#pragma unroll
        for (int i = 0; i < 32; ++i) ss += v[i] * v[i];
        ss += __shfl_xor(ss, 1);
        const float rr = rsqrtf(ss * (1.f / 64.f) + EPS);
#pragma unroll
        for (int i = 0; i < 32; ++i) v[i] = v[i] * rr * g[i];
        if (!isq && prompt) store_f32x32(p.out + OUT_NGK + (((size_t)b * 2 + l) * SEQ + s) * 128 + (c0 - 1792), v);
        if (!prompt) {
            const float* cs = R + 2048 * 32 + s * 32; const float* sn = R + 2048 * 64 + s * 32;
#pragma unroll
            for (int i = 0; i < 32; ++i) {
                float pv = __shfl_xor(v[i], 1);
                float c = cs[i], sv = sn[i];
                v[i] = hi ? (v[i] * c + pv * sv) : (v[i] * c - pv * sv);
            }
        }
        bf16_t* dst;
        if (isq) dst = (bf16_t*)(ws + OFF_GQ) + (size_t)t * 512 + (c0 - 1280);
        else {
            const int cc = c0 - 1792, kv = cc >> 6, r = cc & 63;
            dst = prompt ? (bf16_t*)(ws + OFF_GKP) + (((size_t)b * 2 + kv) * SEQ + s) * 64 + r
                         : (bf16_t*)(ws + OFF_GKS) + (((size_t)b * 2 + kv) * NKS + s) * 64 + r;
        }
        store_bf16x32(dst, v);
    } else {
        if (prompt) store_f32x32(p.out + OUT_NGV + (((size_t)b * 2 + l) * SEQ + s) * 128 + (c0 - 1920), v);
    }
}
__device__ __forceinline__ void epi_inproj_col(const Params& p, int t0, int c, const LAS float* stc) {
    float v[32];
#pragma unroll
    for (int i = 0; i < 32; ++i) v[i] = stc[i * STG];
    const bool prompt = t0 < NPT;
    const int b = prompt ? (t0 >> 8) : ((t0 - NPT) >> 11);
    const int s = prompt ? (t0 & 255) : ((t0 - NPT) & 2047);
    unsigned char* ws = p.ws;
    bf16_t* dst;
    if (c < 1280) {
        const int cc = c - 1024, h = cc >> 6, d = cc & 63;
        dst = prompt ? (bf16_t*)(ws + OFF_DVTP) + (((size_t)b * 4 + h) * 64 + d) * SEQ + s
                     : (bf16_t*)(ws + OFF_DVTS) + (((size_t)b * 4 + h) * 64 + d) * NKS + s;
    } else {
        const int cc = c - 1920, kv = cc >> 6, d = cc & 63;
        dst = prompt ? (bf16_t*)(ws + OFF_GVTP) + (((size_t)b * 2 + kv) * 64 + d) * SEQ + s
                     : (bf16_t*)(ws + OFF_GVTS) + (((size_t)b * 2 + kv) * 64 + d) * NKS + s;
    }
    store_bf16x32(dst, v);
}

template <int MODE>
__device__ __forceinline__ void gemm_phase(const Params& p, int l, const bf16_t* __restrict__ A, const bf16_t* __restrict__ Bt, const int N, unsigned char* ldsraw) {
    using namespace g8;
    constexpr int K = 1024, nt = K / BK, BN = 128, TILE_A = BM * BK * 2, TILE_B = BN * BK * 2, STAGE_B = TILE_A + TILE_B;
    LAS unsigned char* lds = (LAS unsigned char*)ldsraw;
    int tid_ = threadIdx.x; asm volatile("" : "+v"(tid_));
    const int tid = tid_, wid = __builtin_amdgcn_readfirstlane(tid >> 6), lane = tid & 63;
    const int wr = wid >> 1, wc = wid & 1, fr = lane & 15, fq = lane >> 4;
    unsigned voff[4];
#pragma unroll
    for (int i = 0; i < 4; ++i) { int R, C; stage_rc(wid * 1024 + i * 8192 + lane * 16, R, C); voff[i] = (unsigned)(R * K + C) * 2u; }
    const int aoff = lds_byte(wr * 64 + fr, fq * 8), boff = lds_byte(wc * 64 + fr, fq * 8);
    const unsigned ldsw = (unsigned)wid * 1024u;
#define G8_STAGE(buf, kt) do { \
        _Pragma("unroll") for (int _i = 0; _i < 4; ++_i) \
            __builtin_amdgcn_global_load_lds((const unsigned*)((const char*)(Ab + (kt) * BK) + voff[_i]), (LAS unsigned*)(lds + (buf) * STAGE_B + ldsw + _i * 8192), 16, 0, 0); \
        _Pragma("unroll") for (int _i = 0; _i < 2; ++_i) \
            __builtin_amdgcn_global_load_lds((const unsigned*)((const char*)(Bb + (kt) * BK) + voff[_i]), (LAS unsigned*)(lds + (buf) * STAGE_B + TILE_A + ldsw + _i * 8192), 16, 0, 0); } while (0)
#define G8_WAIT_V0() asm volatile("s_waitcnt vmcnt(0)" ::: "memory")
    const int nN = N / BN, nM = NTOK / BM, ntiles = nM * nN;
    const int G = gridDim.x;
    const int vb = (G % 8 == 0) ? (int)(blockIdx.x % 8) * (G / 8) + (int)(blockIdx.x / 8) : (int)blockIdx.x;
    const int tpb = (ntiles + G - 1) / G;
    for (int ti = 0; ti < tpb; ++ti) {
        const int tile = vb * tpb + ti;
        if (tile >= ntiles) break;
        const int pm = tile / nN, pn = tile % nN, brow = pm * BM, bcol = pn * BN;
        const bf16_t* Ab = A + (size_t)brow * K; const bf16_t* Bb = Bt + (size_t)bcol * K;
        f32x4 acc[4][4];
#pragma unroll
        for (int m = 0; m < 4; ++m)
#pragma unroll
            for (int n = 0; n < 4; ++n) acc[m][n] = f32x4{0.f, 0.f, 0.f, 0.f};
        G8_WAIT_V0();
        G8_STAGE(0, 0); G8_WAIT_V0(); __syncthreads();
        for (int t = 0; t < nt; ++t) {
            const int cur = t & 1;
            if (t + 1 < nt) G8_STAGE(cur ^ 1, t + 1);
#pragma unroll
            for (int ks = 0; ks < 2; ++ks) {
                bf16x8 At[4], Bf[4];
#pragma unroll
                for (int m = 0; m < 4; ++m) At[m] = *(const LAS bf16x8*)(lds + cur * STAGE_B + aoff + m * 2048 + ks * 1024);
#pragma unroll
                for (int n = 0; n < 4; ++n) Bf[n] = *(const LAS bf16x8*)(lds + cur * STAGE_B + TILE_A + boff + n * 2048 + ks * 1024);
#pragma unroll
                for (int m = 0; m < 4; ++m)
#pragma unroll
                    for (int n = 0; n < 4; ++n) acc[m][n] = __builtin_amdgcn_mfma_f32_16x16x32_bf16(At[m], Bf[n], acc[m][n], 0, 0, 0);
            }
            G8_WAIT_V0(); __syncthreads();
        }
        LAS float* st = (LAS float*)lds;
#pragma unroll
        for (int m = 0; m < 4; ++m)
#pragma unroll
            for (int n = 0; n < 4; ++n)
#pragma unroll
                for (int j = 0; j < 4; ++j)
                    st[(wr * 64 + m * 16 + fq * 4 + j) * STG + wc * 64 + n * 16 + fr] = acc[m][n][j];
        __syncthreads();
#pragma unroll 1
        for (int it = 0; it < 2; ++it) {
            const int item = it * NT + tid, erow = item >> 2, eseg = item & 3;
            const int t = brow + erow, c0 = bcol + eseg * 32;
            float v[32];
#pragma unroll
            for (int i = 0; i < 8; ++i) {
                const f32x4 f = *(const LAS f32x4*)(st + erow * STG + eseg * 32 + i * 4);
                v[i * 4] = f[0]; v[i * 4 + 1] = f[1]; v[i * 4 + 2] = f[2]; v[i * 4 + 3] = f[3];
            }
            if (MODE == EPI_INPROJ) {
                epi_inproj_row(p, l, t, c0, v);
            } else if (MODE == EPI_WOUT) {
                const float* xr = (l == 0 ? x_in_row(p, t) : (const float*)(p.ws + OFF_XC) + (size_t)t * D) + c0;
                const float* g1 = (const float*)(p.ws + OFF_MOD) + (size_t)(l * 5 + tok_cv(t)) * 6144 + 2048 + c0;
                float* xo = (float*)(p.ws + OFF_XC) + (size_t)t * D + c0;
#pragma unroll
                for (int i = 0; i < 8; ++i) {
                    const float4 x = *reinterpret_cast<const float4*>(xr + i * 4), g = *reinterpret_cast<const float4*>(g1 + i * 4);
                    *reinterpret_cast<float4*>(xo + i * 4) = make_float4(x.x + g.x * v[i * 4], x.y + g.y * v[i * 4 + 1], x.z + g.z * v[i * 4 + 2], x.w + g.w * v[i * 4 + 3]);
                }
            } else {
                store_bf16x32((bf16_t*)(p.ws + OFF_Q) + (size_t)t * D + c0, v);
            }
        }
        if (MODE == EPI_INPROJ && ((bcol >= 1024 && bcol < 1280) || bcol >= 1920)) {
#pragma unroll 1
            for (int it = 0; it < 2; ++it) {
                const int item = it * NT + tid, col = item >> 3, run = item & 7;
                epi_inproj_col(p, brow + run * 32, bcol + col, st + run * 32 * STG + col);
            }
        }
        __syncthreads();
    }
}


using f32x16 = __attribute__((ext_vector_type(16))) float;
using u32x4  = __attribute__((ext_vector_type(4))) unsigned;
using s16x4  = __attribute__((ext_vector_type(4))) short;
#define MFMA32(a, b, c) __builtin_amdgcn_mfma_f32_32x32x16_bf16((a), (b), (c), 0, 0, 0)
constexpr int ATT_ROWB = 144;
constexpr int ATT_TILEB = 64 * ATT_ROWB;
constexpr int QW_MIX = 4096;

__device__ __forceinline__ bf16x8 pack8(const f32x16& x, int s) {
    bf16x8 r;
#pragma unroll
    for (int j = 0; j < 8; ++j) r[j] = (short)f2bf(x[8 * s + j]);
    return r;
}
__device__ __forceinline__ void softmax_tile(f32x16& s0, f32x16& s1, const float sc, float& m, float& l, float& alpha) {
    float mx = fmaxf(s0[0], s1[0]);
#pragma unroll
    for (int i = 1; i < 16; ++i) mx = fmaxf(mx, fmaxf(s0[i], s1[i]));
    mx = fmaxf(mx, __shfl_xor(mx, 32));
    const float mnew = fmaxf(m, mx * sc);
    alpha = __builtin_amdgcn_exp2f(m - mnew);
    m = mnew;
    float ps = 0.f;
#pragma unroll
    for (int i = 0; i < 16; ++i) { s0[i] = __builtin_amdgcn_exp2f(s0[i] * sc - mnew); s1[i] = __builtin_amdgcn_exp2f(s1[i] * sc - mnew); ps += s0[i] + s1[i]; }
    l = l * alpha + ps;
}
__device__ __forceinline__ void pv_tile(const LAS unsigned char* vb, const f32x16& p0, const f32x16& p1, f32x16 (&O)[2], int r, int hh) {
#pragma unroll
    for (int u = 0; u < 2; ++u)
#pragma unroll
        for (int sk = 0; sk < 2; ++sk) {
            const bf16x8 pf = pack8(u ? p1 : p0, sk);
#pragma unroll
            for (int mt = 0; mt < 2; ++mt) {
                const LAS unsigned char* a = vb + (32 * mt + r) * ATT_ROWB + (32 * u + 16 * sk + 4 * hh) * 2;
                const s16x4 lo = *(const LAS s16x4*)a, hi = *(const LAS s16x4*)(a + 16);
                const bf16x8 af = {lo[0], lo[1], lo[2], lo[3], hi[0], hi[1], hi[2], hi[3]};
                O[mt] = MFMA32(af, pf, O[mt]);
            }
        }
}

template <bool DIFF>
__device__ __forceinline__ void attn_item(const Params& p, int l, LAS unsigned char* lds, const int tid,
                                          const bf16_t* __restrict__ Qg, const int qstride,
                                          const bf16_t* __restrict__ Kg, const bf16_t* __restrict__ Vtg, const int nk,
                                          bf16_t* __restrict__ Og, const float lam) {
    const int wave = tid >> 6, lane = tid & 63, r = lane & 31, hh = lane >> 5;
    const int lrow = tid >> 3, lchunk = tid & 7;
    LAS unsigned char* kbuf = lds; LAS unsigned char* vbuf = lds + 2 * ATT_TILEB;
    bf16x8 qf[4];
    const bf16_t* qrow = Qg + (size_t)(wave * 32 + r) * qstride;
#pragma unroll
    for (int ks = 0; ks < 4; ++ks) qf[ks] = *reinterpret_cast<const bf16x8*>(qrow + ks * 16 + hh * 8);
    const float sc = (DIFF ? 0.17677669529663687f : 0.125f) * 1.4426950408889634f;
    f32x16 O0[2], O1[2];
#pragma unroll
    for (int mt = 0; mt < 2; ++mt)
#pragma unroll
        for (int i = 0; i < 16; ++i) { O0[mt][i] = 0.f; O1[mt][i] = 0.f; }
    float m0 = -1e30f, l0 = 0.f, m1 = -1e30f, l1 = 0.f;
    const int ntl = nk / 64;
    u32x4 kr, vr;
    kr = *reinterpret_cast<const u32x4*>(Kg + (size_t)lrow * 64 + lchunk * 8);
    vr = *reinterpret_cast<const u32x4*>(Vtg + (size_t)lrow * nk + lchunk * 8);
    *(LAS u32x4*)(kbuf + lrow * ATT_ROWB + lchunk * 16) = kr;
    *(LAS u32x4*)(vbuf + lrow * ATT_ROWB + lchunk * 16) = vr;
    __syncthreads();
    for (int ti = 0; ti < ntl; ++ti) {
        const int cur = ti & 1;
        if (ti + 1 < ntl) {
            kr = *reinterpret_cast<const u32x4*>(Kg + (size_t)((ti + 1) * 64 + lrow) * 64 + lchunk * 8);
            vr = *reinterpret_cast<const u32x4*>(Vtg + (size_t)lrow * nk + (ti + 1) * 64 + lchunk * 8);
        }
        const LAS unsigned char* kb = kbuf + cur * ATT_TILEB; const LAS unsigned char* vb = vbuf + cur * ATT_TILEB;
        if (!DIFF) {
            f32x16 s0, s1;
#pragma unroll
            for (int i = 0; i < 16; ++i) { s0[i] = 0.f; s1[i] = 0.f; }
#pragma unroll
            for (int ks = 0; ks < 4; ++ks) {
                const bf16x8 a0 = *(const LAS bf16x8*)(kb + r * ATT_ROWB + (ks * 16 + hh * 8) * 2);
                const bf16x8 a1 = *(const LAS bf16x8*)(kb + (32 + r) * ATT_ROWB + (ks * 16 + hh * 8) * 2);
                s0 = MFMA32(a0, qf[ks], s0); s1 = MFMA32(a1, qf[ks], s1);
            }
            float alpha;
            softmax_tile(s0, s1, sc, m0, l0, alpha);
#pragma unroll
            for (int mt = 0; mt < 2; ++mt)
#pragma unroll
                for (int i = 0; i < 16; ++i) O0[mt][i] *= alpha;
            pv_tile(vb, s0, s1, O0, r, hh);
        } else {
#pragma unroll
            for (int x = 0; x < 2; ++x) {
                f32x16 s0, s1;
#pragma unroll
                for (int i = 0; i < 16; ++i) { s0[i] = 0.f; s1[i] = 0.f; }
#pragma unroll
                for (int ks = 0; ks < 2; ++ks) {
                    const bf16x8 a0 = *(const LAS bf16x8*)(kb + r * ATT_ROWB + (x * 32 + ks * 16 + hh * 8) * 2);
                    const bf16x8 a1 = *(const LAS bf16x8*)(kb + (32 + r) * ATT_ROWB + (x * 32 + ks * 16 + hh * 8) * 2);
                    s0 = MFMA32(a0, qf[x * 2 + ks], s0); s1 = MFMA32(a1, qf[x * 2 + ks], s1);
                }
                float alpha;
                if (x == 0) {
                    softmax_tile(s0, s1, sc, m0, l0, alpha);
#pragma unroll
                    for (int mt = 0; mt < 2; ++mt)
#pragma unroll
                        for (int i = 0; i < 16; ++i) O0[mt][i] *= alpha;
                    pv_tile(vb, s0, s1, O0, r, hh);
                } else {
                    softmax_tile(s0, s1, sc, m1, l1, alpha);
#pragma unroll
                    for (int mt = 0; mt < 2; ++mt)
#pragma unroll
                        for (int i = 0; i < 16; ++i) O1[mt][i] *= alpha;
                    pv_tile(vb, s0, s1, O1, r, hh);
                }
            }
        }
        if (ti + 1 < ntl) {
            *(LAS u32x4*)(kbuf + (cur ^ 1) * ATT_TILEB + lrow * ATT_ROWB + lchunk * 16) = kr;
            *(LAS u32x4*)(vbuf + (cur ^ 1) * ATT_TILEB + lrow * ATT_ROWB + lchunk * 16) = vr;
        }
        __syncthreads();
    }
    l0 += __shfl_xor(l0, 32);
    const float inv0 = 1.f / l0;
    bf16_t* orow = Og + (size_t)(wave * 32 + r) * D;
    if (!DIFF) {
#pragma unroll
        for (int mt = 0; mt < 2; ++mt)
#pragma unroll
            for (int g = 0; g < 4; ++g) {
                uint2 w;
                w.x = pack_bf2(O0[mt][4 * g] * inv0, O0[mt][4 * g + 1] * inv0);
                w.y = pack_bf2(O0[mt][4 * g + 2] * inv0, O0[mt][4 * g + 3] * inv0);
                *reinterpret_cast<uint2*>(orow + 32 * mt + 8 * g + 4 * hh) = w;
            }
    } else {
        l1 += __shfl_xor(l1, 32);
        const float inv1 = lam / l1;
        float ss = 0.f;
#pragma unroll
        for (int mt = 0; mt < 2; ++mt)
#pragma unroll
            for (int i = 0; i < 16; ++i) { const float o = O0[mt][i] * inv0 - O1[mt][i] * inv1; O0[mt][i] = o; ss += o * o; }
        ss += __shfl_xor(ss, 32);
        const float rr = rsqrtf(ss * (1.f / 64.f) + EPS) * (1.f - lam_init_of(l));
        const float* sg = p.in[I_SUBLN] + l * 64;
#pragma unroll
        for (int mt = 0; mt < 2; ++mt)
#pragma unroll
            for (int g = 0; g < 4; ++g) {
                const int d0 = 32 * mt + 8 * g + 4 * hh;
                const float4 gg = *reinterpret_cast<const float4*>(sg + d0);
                uint2 w;
                w.x = pack_bf2(O0[mt][4 * g] * rr * gg.x, O0[mt][4 * g + 1] * rr * gg.y);
                w.y = pack_bf2(O0[mt][4 * g + 2] * rr * gg.z, O0[mt][4 * g + 3] * rr * gg.w);
                *reinterpret_cast<uint2*>(orow + d0) = w;
            }
    }
}

constexpr int SGU_ROWB = 272;
__device__ __forceinline__ void sgu_item(const Params& p, int l, LAS unsigned char* lds, const int tid, const int t0) {
    const bf16_t* AV = (const bf16_t*)(p.ws + OFF_AV) + (size_t)t0 * 256;
    {
        const int q = tid >> 2, quarter = tid & 3;
        float v[64]; float ss = 0.f;
#pragma unroll
        for (int i = 0; i < 8; ++i) {
            const bf16x8 w = *reinterpret_cast<const bf16x8*>(AV + (size_t)q * 256 + quarter * 64 + i * 8);
#pragma unroll
            for (int j = 0; j < 8; ++j) { v[i * 8 + j] = bf2f((bf16_t)w[j]); ss += v[i * 8 + j] * v[i * 8 + j]; }
        }
        ss += __shfl_xor(ss, 1); ss += __shfl_xor(ss, 2);
        const float rstd = rsqrtf(ss * (1.f / 256.f) + EPS);
        const float* g = p.in[I_SGUNG] + l * 256 + quarter * 64;
#pragma unroll
        for (int i = 0; i < 64; ++i)
            *(LAS bf16_t*)(lds + (quarter * 64 + i) * SGU_ROWB + q * 2) = f2bf(v[i] * rstd * g[i]);
    }
    __syncthreads();
    {
        const int wave = tid >> 6, lane = tid & 63, r = lane & 31, hh = lane >> 5;
        const int g = wave >> 1, ph = wave & 1;
        const bf16_t* W = (const bf16_t*)(p.ws + OFF_SGUW) + ((size_t)l * 4 + g) * 128 * 128;
        f32x16 acc[2][2];
#pragma unroll
        for (int a = 0; a < 2; ++a)
#pragma unroll
            for (int b = 0; b < 2; ++b)
#pragma unroll
                for (int i = 0; i < 16; ++i) acc[a][b][i] = 0.f;
#pragma unroll
        for (int ks = 0; ks < 8; ++ks) {
            bf16x8 af[2], bfr[2];
#pragma unroll
            for (int pt = 0; pt < 2; ++pt) af[pt] = *reinterpret_cast<const bf16x8*>(W + (size_t)(ph * 64 + pt * 32 + r) * 128 + ks * 16 + hh * 8);
#pragma unroll
            for (int ct = 0; ct < 2; ++ct) bfr[ct] = *(const LAS bf16x8*)(lds + (g * 64 + ct * 32 + r) * SGU_ROWB + (ks * 16 + hh * 8) * 2);
#pragma unroll
            for (int pt = 0; pt < 2; ++pt)
#pragma unroll
                for (int ct = 0; ct < 2; ++ct) acc[pt][ct] = MFMA32(af[pt], bfr[ct], acc[pt][ct]);
        }
        const float* bias = p.in[I_SGUB] + (l * 4 + g) * 128;
        const bf16_t* AU = (const bf16_t*)(p.ws + OFF_AU);
        bf16_t* MIX = (bf16_t*)(p.ws + OFF_MIX);
#pragma unroll
        for (int pt = 0; pt < 2; ++pt)
#pragma unroll
            for (int ct = 0; ct < 2; ++ct)
#pragma unroll
                for (int i = 0; i < 16; ++i) {
                    const int pp = ph * 64 + pt * 32 + (i & 3) + 8 * (i >> 2) + 4 * hh, c = g * 64 + ct * 32 + r;
                    const float au = bf2f(AU[(size_t)(t0 + pp) * 256 + c]);
                    MIX[(size_t)(t0 + pp) * D + c] = f2bf(au * (acc[pt][ct][i] + bias[pp]));
                }
    }
    __syncthreads();
}

__device__ void ph_mixers(const Params& p, int l, unsigned char* ldsraw) {
    const int tid0 = opaque_tid();
    LAS unsigned char* lds = (LAS unsigned char*)ldsraw;
    volatile LAS int* qslot = (volatile LAS int*)(ldsraw - LDS_HDR + 64);
    unsigned* qw = (unsigned*)(p.ws + OFF_BAR) + QW_MIX + l;
    const float lam = lam_of(p, l);
    unsigned char* ws = p.ws;
    for (;;) {
        if (tid0 == 0) *qslot = (int)atomicAdd(qw, 1u);
        __syncthreads();
        const int item = *qslot;
        __syncthreads();
        if (item >= 896) break;
        int tid = tid0; asm volatile("" : "+v"(tid));
        if (item < 128) {
            const int qc = item & 7, h = (item >> 3) & 3, b = item >> 5;
            const int t0 = NPT + b * DSEQ + qc * 256;
            attn_item<true>(p, l, lds, tid, (const bf16_t*)(ws + OFF_DQ) + (size_t)t0 * 256 + h * 64, 256,
                            (const bf16_t*)(ws + OFF_DKS) + ((size_t)b * 4 + h) * NKS * 64, (const bf16_t*)(ws + OFF_DVTS) + ((size_t)b * 4 + h) * 64 * NKS, NKS,
                            (bf16_t*)(ws + OFF_MIX) + (size_t)t0 * D + 256 + h * 64, lam);
        } else if (item < 384) {
            const int it = item - 128, qc = it & 7, hq = (it >> 3) & 7, b = it >> 6, kv = hq >> 2;
            const int t0 = NPT + b * DSEQ + qc * 256;
            attn_item<false>(p, l, lds, tid, (const bf16_t*)(ws + OFF_GQ) + (size_t)t0 * 512 + hq * 64, 512,
                             (const bf16_t*)(ws + OFF_GKS) + ((size_t)b * 2 + kv) * NKS * 64, (const bf16_t*)(ws + OFF_GVTS) + ((size_t)b * 2 + kv) * 64 * NKS, NKS,
                             (bf16_t*)(ws + OFF_MIX) + (size_t)t0 * D + 512 + hq * 64, lam);
        } else if (item < 512) {
            sgu_item(p, l, lds, tid, (item - 384) * 128);
        } else if (item < 768) {
            const int it = item - 512, hq = it & 7, b = it >> 3, kv = hq >> 2;
            const int t0 = b * SEQ;
            attn_item<false>(p, l, lds, tid, (const bf16_t*)(ws + OFF_GQ) + (size_t)t0 * 512 + hq * 64, 512,
                             (const bf16_t*)(ws + OFF_GKP) + ((size_t)b * 2 + kv) * SEQ * 64, (const bf16_t*)(ws + OFF_GVTP) + ((size_t)b * 2 + kv) * 64 * SEQ, SEQ,
                             (bf16_t*)(ws + OFF_MIX) + (size_t)t0 * D + 512 + hq * 64, lam);
        } else {
            const int it = item - 768, h = it & 3, b = it >> 2;
            const int t0 = b * SEQ;
            attn_item<true>(p, l, lds, tid, (const bf16_t*)(ws + OFF_DQ) + (size_t)t0 * 256 + h * 64, 256,
                            (const bf16_t*)(ws + OFF_DKP) + ((size_t)b * 4 + h) * SEQ * 64, (const bf16_t*)(ws + OFF_DVTP) + ((size_t)b * 4 + h) * 64 * SEQ, SEQ,
                            (bf16_t*)(ws + OFF_MIX) + (size_t)t0 * D + 256 + h * 64, lam);
        }
    }
}

constexpr int LDS_BYTES = LDS_HDR + 256 * 132 * 4;
__global__ void __launch_bounds__(NT, 2) mk_fwd(Params p) {
    extern __shared__ __attribute__((aligned(16))) unsigned char lds[];
    volatile LAS unsigned* st = (volatile LAS unsigned*)lds;
    if (threadIdx.x < 4) st[threadIdx.x] = 0u;
    __syncthreads();
    XcdBarrier xb = xcd_barrier_post((unsigned*)(p.ws + OFF_BAR), st);
#define GRID_BAR() xcd_barrier(xb)
    unsigned char* ws = p.ws;
    for (int l = 0; l < 2; ++l) {
        ph_transpose(p.in[I_WIN] + (size_t)l * D * INW, (bf16_t*)(ws + OFF_WIN) + (size_t)l * INW * D, D, INW);
        ph_transpose(p.in[I_WOUT] + (size_t)l * D * D, (bf16_t*)(ws + OFF_WOUT) + (size_t)l * D * D, D, D);
        ph_transpose(p.in[I_WQ] + (size_t)l * D * D, (bf16_t*)(ws + OFF_WQ) + (size_t)l * D * D, D, D);
    }
    ph_convert(p.in[I_PU], (bf16_t*)(ws + OFF_UT), (size_t)2 * NEXP * D);
    ph_convert(p.in[I_PV], (bf16_t*)(ws + OFF_VT), (size_t)2 * NEXP * D);
    ph_convert(p.in[I_SUBK], (bf16_t*)(ws + OFF_SUBK), 2 * 2 * 128 * 64);
    ph_convert(p.in[I_SGUW], (bf16_t*)(ws + OFF_SGUW), 2 * 4 * 128 * 128);
    ph_mod(p);
    ph_rope_tab(p);
    GRID_BAR();
    for (int l = 0; l < 2; ++l) {
        ph_norm_mod(p, l, 0, l == 0 ? 1 : 0);
        ph_cache_prep(p, l);
        GRID_BAR();
        gemm_phase<EPI_INPROJ>(p, l, (const bf16_t*)(ws + OFF_H), (const bf16_t*)(ws + OFF_WIN) + (size_t)l * INW * D, INW, lds + LDS_HDR);
        GRID_BAR();
        ph_mixers(p, l, lds + LDS_HDR);
        GRID_BAR();
        gemm_phase<EPI_WOUT>(p, l, (const bf16_t*)(ws + OFF_MIX), (const bf16_t*)(ws + OFF_WOUT) + (size_t)l * D * D, D, lds + LDS_HDR);
        GRID_BAR();
        ph_norm_mod(p, l, 1, 0);
        GRID_BAR();
        gemm_phase<EPI_WQ>(p, l, (const bf16_t*)(ws + OFF_H), (const bf16_t*)(ws + OFF_WQ) + (size_t)l * D * D, D, lds + LDS_HDR);
        GRID_BAR();
        ph_peer_scores(p, l);
        GRID_BAR();
        ph_peer_top1(p);
        GRID_BAR();
        ph_peer_top2(p);
        GRID_BAR();
        ph_peer_apply(p, l, lds + LDS_HDR);
        GRID_BAR();
    }
    ph_final_norm(p);
}

extern "C" void kernel_launch(void* const* d_in, const int* in_sizes, int n_in,
                              void* d_out, int out_size, void* d_ws, size_t ws_size,
                              hipStream_t stream) {
    static int grid = 0;
    if (grid == 0) {
        if (ws_size < WS_NEED) { fprintf(stderr, "kernel_launch: workspace too small: %zu < %zu\n", ws_size, (size_t)WS_NEED); grid = -1; return; }
        int dev = 0, cus = 0, per_cu = 0;
        (void)hipGetDevice(&dev);
        (void)hipDeviceGetAttribute(&cus, hipDeviceAttributeMultiprocessorCount, dev);
        (void)hipFuncSetAttribute((const void*)mk_fwd, hipFuncAttributeMaxDynamicSharedMemorySize, LDS_BYTES);
        (void)hipOccupancyMaxActiveBlocksPerMultiprocessor(&per_cu, (const void*)mk_fwd, NT, LDS_BYTES);
        if (per_cu < 1) { fprintf(stderr, "kernel_launch: occupancy query reports %d blocks per CU\n", per_cu); grid = -1; return; }
        grid = cus;
    }
    if (grid < 0) return;
    (void)hipMemsetAsync((unsigned char*)d_ws + OFF_BAR, 0, 64 * 1024, stream);
    Params p{};
    for (int i = 0; i < 29; ++i) p.in[i] = (const float*)d_in[i];
    p.out = (float*)d_out; p.ws = (unsigned char*)d_ws;
    void* args[] = {&p};
    hipError_t e = hipLaunchCooperativeKernel((const void*)mk_fwd, dim3(grid), dim3(NT), args, LDS_BYTES, stream);
    if (e != hipSuccess) fprintf(stderr, "kernel_launch: cooperative launch failed: %s (grid %d)\n", hipGetErrorString(e), grid);
}
```

```cpp
#include <hip/hip_runtime.h>
#include <hip/hip_bf16.h>
#include <cstdio>
#include <cstdint>
#include <hip/hip_cooperative_groups.h>
namespace cg = cooperative_groups;

#define PROBE_DUP 0
typedef unsigned short bf16_t;
using bf16x8 = __attribute__((ext_vector_type(8))) short;
using f32x4  = __attribute__((ext_vector_type(4))) float;

constexpr int D      = 1024;
constexpr int NTOK   = 16384;
constexpr int NPT    = 8192;
constexpr int SEQ    = 256;
constexpr int DSEQ   = 2048;
constexpr int PAST   = 512;
constexpr int NKS    = DSEQ + PAST;
constexpr int INW    = 2048;
constexpr int NEXP   = 16384;
constexpr float EPS  = 1e-6f;

constexpr size_t MB = 1024 * 1024;
constexpr size_t OFF_BAR   = 0;
constexpr size_t OFF_MOD   = 64 * 1024;
constexpr size_t OFF_ROPE  = OFF_MOD + 256 * 1024;
constexpr size_t OFF_SUBK  = OFF_ROPE + 1 * MB;
constexpr size_t OFF_SGUW  = OFF_SUBK + 64 * 1024;
constexpr size_t OFF_WIN   = OFF_SGUW + 256 * 1024;
constexpr size_t OFF_WOUT  = OFF_WIN + 8 * MB;
constexpr size_t OFF_WQ    = OFF_WOUT + 4 * MB;
constexpr size_t OFF_UT    = OFF_WQ + 4 * MB;
constexpr size_t OFF_VT    = OFF_UT + 64 * MB;
constexpr size_t OFF_H     = OFF_VT + 64 * MB;
constexpr size_t OFF_XC    = OFF_H + 32 * MB;
constexpr size_t OFF_R1    = OFF_XC + 64 * MB;
constexpr size_t OFF_AU    = OFF_R1;
constexpr size_t OFF_AV    = OFF_AU + 8 * MB;
constexpr size_t OFF_AVN   = OFF_AV + 8 * MB;
constexpr size_t OFF_DQ    = OFF_AVN + 8 * MB;
constexpr size_t OFF_DKP   = OFF_DQ + 8 * MB;
constexpr size_t OFF_DKS   = OFF_DKP + 4 * MB;
constexpr size_t OFF_DVTP  = OFF_DKS + 5 * MB;
constexpr size_t OFF_DVTS  = OFF_DVTP + 4 * MB;
constexpr size_t OFF_GQ    = OFF_DVTS + 5 * MB;
constexpr size_t OFF_GKP   = OFF_GQ + 16 * MB;
constexpr size_t OFF_GKS   = OFF_GKP + 2 * MB;
constexpr size_t OFF_GVTP  = OFF_GKS + 3 * MB;
constexpr size_t OFF_GVTS  = OFF_GVTP + 2 * MB;
constexpr size_t OFF_MIX   = OFF_GVTS + 3 * MB;
constexpr size_t OFF_R1END = OFF_MIX + 32 * MB;
constexpr size_t OFF_Q     = OFF_R1;
constexpr size_t OFF_EIDX  = OFF_Q + 32 * MB;
constexpr size_t OFF_EGATE = OFF_EIDX + 8 * MB;
constexpr size_t OFF_TOPV  = OFF_EGATE + 8 * MB;
constexpr size_t OFF_TOPI  = OFF_TOPV + 16 * MB;
static_assert(OFF_TOPI + 16 * MB <= OFF_R1END, "peer buffers must fit region 1");
constexpr size_t OFF_PROJ  = OFF_R1END;
constexpr size_t WS_NEED   = OFF_PROJ + 128 * MB;
static_assert(WS_NEED <= 512 * MB, "workspace budget");

constexpr size_t OUT_YP  = 0;
constexpr size_t OUT_YS  = 8388608;
constexpr size_t OUT_NDK = 16777216;
constexpr size_t OUT_NDV = OUT_NDK + 4194304;
constexpr size_t OUT_NGK = OUT_NDV + 4194304;
constexpr size_t OUT_NGV = OUT_NGK + 2097152;

struct Params {
    const float* in[29];
    float* out;
    unsigned char* ws;
};
enum { I_XP = 0, I_XS, I_CDK, I_CDV, I_CGK, I_CGV, I_C, I_CCTX, I_ADAW, I_ADAB, I_N1G, I_N2G, I_WIN, I_SGUNG, I_SGUW, I_SGUB,
       I_LQ1, I_LK1, I_LQ2, I_LK2, I_SUBLN, I_QNG, I_KNG, I_WOUT, I_WQ, I_SUBK, I_PU, I_PV, I_FG };

__device__ __forceinline__ bf16_t f2bf(float f) {
    unsigned u = __float_as_uint(f);
    u += 0x7fffu + ((u >> 16) & 1u);
    return (bf16_t)(u >> 16);
}
__device__ __forceinline__ float bf2f(bf16_t h) { return __uint_as_float(((unsigned)h) << 16); }
__device__ __forceinline__ float gelu_f(float x) {
    const float k = 0.7978845608028654f;
    float u = k * (x + 0.044715f * x * x * x);
    return 0.5f * x * (1.f + tanhf(u));
}
__device__ __forceinline__ float wave_sum(float v) {
#pragma unroll
    for (int o = 32; o >= 1; o >>= 1) v += __shfl_xor(v, o);
    return v;
}
__device__ __forceinline__ int tok_cv(int t) { return t < NPT ? 0 : 1 + ((t - NPT) >> 11); }
__device__ __forceinline__ const float* x_in_row(const Params& p, int t) {
    return t < NPT ? p.in[I_XP] + (size_t)t * D : p.in[I_XS] + (size_t)(t - NPT) * D;
}
__device__ __forceinline__ float lam_init_of(int l) { return l == 0 ? 0.2f : (0.8f - 0.6f * 0.7408182206817179f); }
__device__ __forceinline__ float lam_of(const Params& p, int l) {
    float s1 = 0.f, s2 = 0.f;
    for (int i = 0; i < 32; ++i) {
        s1 += p.in[I_LQ1][l * 32 + i] * p.in[I_LK1][l * 32 + i];
        s2 += p.in[I_LQ2][l * 32 + i] * p.in[I_LK2][l * 32 + i];
    }
    return expf(s1) - expf(s2) + lam_init_of(l);
}


#define XB_TMO      128
#define XB_XCNT(j)  (256  + 64 * (j))
#define XB_XSUB(j)  (1280 + 64 * (j))
#define XB_XGEN(j)  (2304 + 64 * (j))
#define XB_TOP      3328
#define XB_TOPGEN   3392
#define XCD_BAR_WORDS 3456
#define XB_SPIN_CAP (1u << 20)
#define LAS __attribute__((address_space(3)))
__device__ __forceinline__ unsigned xb_ld(unsigned* p)              { return __hip_atomic_load(p, __ATOMIC_RELAXED, __HIP_MEMORY_SCOPE_AGENT); }
__device__ __forceinline__ unsigned xb_add(unsigned* p, unsigned v) { return __hip_atomic_fetch_add(p, v, __ATOMIC_RELAXED, __HIP_MEMORY_SCOPE_AGENT); }
__device__ __forceinline__ unsigned xb_xcc_id() { return (unsigned)__builtin_amdgcn_s_getreg((3 << 11) | 20) & 0xFu; }
#define XB_SPIN(cond, bar) do { unsigned _sp = 0; while (cond) { __builtin_amdgcn_s_sleep(1); \
    if ((++_sp & 255u) == 0u) { if (xb_ld(&(bar)[XB_TMO])) break; if (_sp > XB_SPIN_CAP) { atomicAdd(&(bar)[XB_TMO], 1u); break; } } } } while (0)
struct XcdBarrier { unsigned* bar; unsigned x; volatile LAS unsigned* st; };
__device__ __forceinline__ XcdBarrier xcd_barrier_post(unsigned* bar, volatile LAS unsigned* st) {
    XcdBarrier b; b.bar = bar; b.x = xb_xcc_id(); b.st = st;
    if (threadIdx.x == 0) (void)xb_add(&bar[XB_XCNT(b.x)], 1u);
    return b;
}
__device__ __forceinline__ void xcd_barrier_complete(unsigned* bar, unsigned x, unsigned& nloc, unsigned& nx) {
    const unsigned G = gridDim.x * gridDim.y * gridDim.z;
    unsigned sum, cnt, mine, sp = 0u;
    for (;;) {
        sum = 0u; cnt = 0u; mine = 0u;
#pragma unroll
        for (unsigned j = 0; j < 16; ++j) { const unsigned c = xb_ld(&bar[XB_XCNT(j)]); sum += c; cnt += (c > 0u) ? 1u : 0u; mine = (j == x) ? c : mine; }
        if (sum == G) break;
        __builtin_amdgcn_s_sleep(1);
        if ((++sp & 255u) == 0u) { if (xb_ld(&bar[XB_TMO])) break; if (sp > XB_SPIN_CAP) { atomicAdd(&bar[XB_TMO], 1u); break; } }
    }
    nloc = mine > 0u ? mine : 1u; nx = cnt > 0u ? cnt : 1u;
}
__device__ __forceinline__ void xcd_barrier(const XcdBarrier& b) {
    asm volatile("s_waitcnt vmcnt(0)" ::: "memory");
    __syncthreads();
    if (threadIdx.x == 0) {
        unsigned* bar = b.bar;
        const unsigned bx = xb_xcc_id();
        __builtin_amdgcn_s_waitcnt(0);
        unsigned nloc = b.st[0], nx = b.st[1];
        if (nloc == 0u) { xcd_barrier_complete(bar, bx, nloc, nx); b.st[0] = nloc; b.st[1] = nx; }
        const unsigned old = xb_add(&bar[XB_XSUB(bx)], 1u);
        const unsigned gen = old / nloc;
        if (old + 1u == (gen + 1u) * nloc) {
            __builtin_amdgcn_fence(__ATOMIC_RELEASE, "agent");
            asm volatile("s_waitcnt vmcnt(0)" ::: "memory");
            const unsigned og = xb_add(&bar[XB_TOP], 1u);
            const unsigned tg = og / nx;
            if (og + 1u == (tg + 1u) * nx) xb_add(&bar[XB_TOPGEN], 1u);
            else XB_SPIN(xb_ld(&bar[XB_TOPGEN]) == tg, bar);
            __builtin_amdgcn_fence(__ATOMIC_ACQUIRE, "agent");
            xb_add(&bar[XB_XGEN(bx)], 1u);
            asm volatile("s_waitcnt vmcnt(0)" ::: "memory");
        } else {
            XB_SPIN(xb_ld(&bar[XB_XGEN(bx)]) == gen, bar);
            __builtin_amdgcn_fence(__ATOMIC_ACQUIRE, "agent");
            asm volatile("s_waitcnt vmcnt(0)" ::: "memory");
        }
    }
    __syncthreads();
}

constexpr int NT = 512;
constexpr int LDS_HDR = 1024;
#define GTID ((size_t)blockIdx.x * NT + tid)
__device__ __forceinline__ int opaque_tid() { int t = threadIdx.x; asm volatile("" : "+v"(t)); return t; }
#define GNT  ((size_t)gridDim.x * NT)

__device__ void ph_transpose(const float* __restrict__ W, bf16_t* __restrict__ Wt, int K, int N) {
    const int tid = opaque_tid();
    for (size_t idx = GTID; idx < (size_t)K * N; idx += GNT) {
        int n = (int)(idx / K), k = (int)(idx % K);
        Wt[idx] = f2bf(W[(size_t)k * N + n]);
    }
}
__device__ void ph_convert(const float* __restrict__ src, bf16_t* __restrict__ dst, size_t n) {
    const int tid = opaque_tid();
    for (size_t idx = GTID; idx < n; idx += GNT) dst[idx] = f2bf(src[idx]);
}
__device__ void ph_mod(const Params& p) {
    const int tid = opaque_tid();
    for (size_t idx = GTID; idx < 2 * 5 * 6144; idx += GNT) {
        int j = idx % 6144, cv = (idx / 6144) % 5, l = idx / (6144 * 5);
        const float* cvec = cv == 0 ? p.in[I_CCTX] : p.in[I_C] + (size_t)(cv - 1) * D;
        const float* W = p.in[I_ADAW] + (size_t)l * D * 6144;
        float acc = 0.f;
        for (int k = 0; k < D; ++k) {
            float c = cvec[k];
            float s = c / (1.f + expf(-c));
            acc += s * W[(size_t)k * 6144 + j];
        }
        ((float*)(p.ws + OFF_MOD))[idx] = acc + p.in[I_ADAB][l * 6144 + j];
    }
}
__device__ void ph_rope_tab(const Params& p) {
    const int tid = opaque_tid();
    for (size_t idx = GTID; idx < 2048 * 48; idx += GNT) {
        int s = idx / 48, i = idx % 48;
        float* R = (float*)(p.ws + OFF_ROPE);
        double row = (double)(s / 64), col = (double)(s % 64);
        if (i < 16) {
            int q = i & 7; double inv = pow(10000.0, -(double)q / 8.0);
            double ang = (i < 8 ? row : col) * inv;
            R[s * 16 + i] = (float)cos(ang); R[2048 * 16 + s * 16 + i] = (float)sin(ang);
        } else {
            int ii = i - 16; int q = ii & 15; double inv = pow(10000.0, -(double)q / 16.0);
            double ang = (ii < 16 ? row : col) * inv;
            R[2048 * 32 + s * 32 + ii] = (float)cos(ang); R[2048 * 64 + s * 32 + ii] = (float)sin(ang);
        }
    }
}
__device__ void ph_cache_prep(const Params& p, int l) {
    const int tid = opaque_tid();
    bf16_t* DKS = (bf16_t*)(p.ws + OFF_DKS); bf16_t* DVTS = (bf16_t*)(p.ws + OFF_DVTS);
    bf16_t* GKS = (bf16_t*)(p.ws + OFF_GKS); bf16_t* GVTS = (bf16_t*)(p.ws + OFF_GVTS);
    for (size_t idx = GTID; idx < 4 * 512 * 256; idx += GNT) {
        int c = idx & 255, pp = (idx >> 8) & 511, b = idx >> 17;
        size_t src = (((size_t)b * 2 + l) * PAST + pp) * 256 + c;
        int h = c >> 6, r = c & 63;
        DKS[(((size_t)b * 4 + h) * NKS + DSEQ + pp) * 64 + r] = f2bf(p.in[I_CDK][src]);
        DVTS[(((size_t)b * 4 + h) * 64 + r) * NKS + DSEQ + pp] = f2bf(p.in[I_CDV][src]);
        if (c < 128) {
            size_t src2 = (((size_t)b * 2 + l) * PAST + pp) * 128 + c;
            int kv = c >> 6;
            GKS[(((size_t)b * 2 + kv) * NKS + DSEQ + pp) * 64 + r] = f2bf(p.in[I_CGK][src2]);
            GVTS[(((size_t)b * 2 + kv) * 64 + r) * NKS + DSEQ + pp] = f2bf(p.in[I_CGV][src2]);
        }
    }
}
__device__ void ph_norm_mod(const Params& p, int l, int which, int from_input) {
    const int tid = opaque_tid();
    const int lane = tid & 63;
    const int gw = blockIdx.x * 8 + (tid >> 6), nw = gridDim.x * 8;
    const float* g = p.in[which ? I_N2G : I_N1G] + l * D;
    for (int t = gw; t < NTOK; t += nw) {
        const float* xr = from_input ? x_in_row(p, t) : (const float*)(p.ws + OFF_XC) + (size_t)t * D;
        const float* mod = (const float*)(p.ws + OFF_MOD) + (size_t)(l * 5 + tok_cv(t)) * 6144 + which * 3072;
        float4 v[4]; float ss = 0.f;
#pragma unroll
        for (int i = 0; i < 4; ++i) { v[i] = *reinterpret_cast<const float4*>(xr + i * 256 + lane * 4); ss += v[i].x * v[i].x + v[i].y * v[i].y + v[i].z * v[i].z + v[i].w * v[i].w; }
        ss = wave_sum(ss);
        float r = rsqrtf(ss / D + EPS);
        bf16_t* H = (bf16_t*)(p.ws + OFF_H) + (size_t)t * D;
#pragma unroll
        for (int i = 0; i < 4; ++i) {
            int c = i * 256 + lane * 4;
            float4 gg = *reinterpret_cast<const float4*>(g + c), sh = *reinterpret_cast<const float4*>(mod + c), sc = *reinterpret_cast<const float4*>(mod + 1024 + c);
            ushort4 o;
            o.x = f2bf(v[i].x * r * gg.x * (1.f + sc.x) + sh.x); o.y = f2bf(v[i].y * r * gg.y * (1.f + sc.y) + sh.y);
            o.z = f2bf(v[i].z * r * gg.z * (1.f + sc.z) + sh.z); o.w = f2bf(v[i].w * r * gg.w * (1.f + sc.w) + sh.w);
            *reinterpret_cast<ushort4*>(H + c) = o;
        }
    }
}
__device__ void ph_sgu_norm(const Params& p, int l) {
    const int tid = opaque_tid();
    const int lane = tid & 63;
    const int gw = blockIdx.x * 8 + (tid >> 6), nw = gridDim.x * 8;
    for (int t = gw; t < NTOK; t += nw) {
        const bf16_t* AV = (const bf16_t*)(p.ws + OFF_AV) + (size_t)t * 256;
        float v[4]; float ss = 0.f;
#pragma unroll
        for (int i = 0; i < 4; ++i) { v[i] = bf2f(AV[i * 64 + lane]); ss += v[i] * v[i]; }
        ss = wave_sum(ss);
        float r = rsqrtf(ss / 256.f + EPS);
#pragma unroll
        for (int i = 0; i < 4; ++i) ((bf16_t*)(p.ws + OFF_AVN))[(size_t)t * 256 + i * 64 + lane] = f2bf(v[i] * r * p.in[I_SGUNG][l * 256 + i * 64 + lane]);
    }
}
__device__ void ph_sgu_mix(const Params& p, int l) {
    const int tid = opaque_tid();
    const bf16_t* AVN = (const bf16_t*)(p.ws + OFF_AVN);
    for (size_t idx = GTID; idx < (size_t)NTOK * 256; idx += GNT) {
        int t = (int)(idx >> 8), c = (int)(idx & 255);
        int t0 = t & ~127, pp = t & 127, g = c >> 6;
        const bf16_t* W = (const bf16_t*)(p.ws + OFF_SGUW) + (((size_t)l * 4 + g) * 128 + pp) * 128;
        float acc = 0.f;
        for (int q = 0; q < 128; ++q) acc += bf2f(W[q]) * bf2f(AVN[(size_t)(t0 + q) * 256 + c]);
        acc += p.in[I_SGUB][(l * 4 + g) * 128 + pp];
        float au = bf2f(((const bf16_t*)(p.ws + OFF_AU))[(size_t)t * 256 + c]);
        ((bf16_t*)(p.ws + OFF_MIX))[(size_t)t * D + c] = f2bf(au * acc);
    }
}
__device__ void ph_attn_ref(const Params& p, int l) {
    const int tid = opaque_tid();
    const int lane = tid & 63;
    const int gw = blockIdx.x * 8 + (tid >> 6), nw = gridDim.x * 8;
    const float lam = lam_of(p, l);
    for (int item = gw; item < NTOK * 12; item += nw) {
        const int t = item % NTOK, hh = item / NTOK;
        const bool prompt = t < NPT;
        const int b = prompt ? t / SEQ : (t - NPT) / DSEQ;
        const int nk = prompt ? SEQ : NKS;
        if (hh < 4) {
            const int h = hh;
            const bf16_t* K = prompt ? (const bf16_t*)(p.ws + OFF_DKP) + ((size_t)b * 4 + h) * SEQ * 64 : (const bf16_t*)(p.ws + OFF_DKS) + ((size_t)b * 4 + h) * NKS * 64;
            const bf16_t* Vt = prompt ? (const bf16_t*)(p.ws + OFF_DVTP) + ((size_t)b * 4 + h) * 64 * SEQ : (const bf16_t*)(p.ws + OFF_DVTS) + ((size_t)b * 4 + h) * 64 * NKS;
            float q = bf2f(((const bf16_t*)(p.ws + OFF_DQ))[(size_t)t * 256 + h * 64 + lane]);
            const float scale = 0.17677669529663687f;
            float m0 = -1e30f, m1 = -1e30f, l0 = 0.f, l1 = 0.f, a0 = 0.f, a1 = 0.f;
            for (int k = 0; k < nk; ++k) {
                float pr = q * bf2f(K[(size_t)k * 64 + lane]);
#pragma unroll
                for (int o = 16; o >= 1; o >>= 1) pr += __shfl_xor(pr, o);
                float s0 = __shfl(pr, 0) * scale, s1 = __shfl(pr, 32) * scale;
                float v = bf2f(Vt[(size_t)lane * nk + k]);
                float mn0 = fmaxf(m0, s0), mn1 = fmaxf(m1, s1);
                float c0 = expf(m0 - mn0), c1 = expf(m1 - mn1);
                float e0 = expf(s0 - mn0), e1 = expf(s1 - mn1);
                l0 = l0 * c0 + e0; l1 = l1 * c1 + e1;
                a0 = a0 * c0 + e0 * v; a1 = a1 * c1 + e1 * v;
                m0 = mn0; m1 = mn1;
            }
            float o = a0 / l0 - lam * a1 / l1;
            float ss = wave_sum(o * o);
            float r = rsqrtf(ss / 64.f + EPS);
            o = o * r * p.in[I_SUBLN][l * 64 + lane] * (1.f - lam_init_of(l));
            ((bf16_t*)(p.ws + OFF_MIX))[(size_t)t * D + 256 + h * 64 + lane] = f2bf(o);
        } else {
            const int hq = hh - 4, kv = hq >> 2;
            const bf16_t* K = prompt ? (const bf16_t*)(p.ws + OFF_GKP) + ((size_t)b * 2 + kv) * SEQ * 64 : (const bf16_t*)(p.ws + OFF_GKS) + ((size_t)b * 2 + kv) * NKS * 64;
            const bf16_t* Vt = prompt ? (const bf16_t*)(p.ws + OFF_GVTP) + ((size_t)b * 2 + kv) * 64 * SEQ : (const bf16_t*)(p.ws + OFF_GVTS) + ((size_t)b * 2 + kv) * 64 * NKS;
            float q = bf2f(((const bf16_t*)(p.ws + OFF_GQ))[(size_t)t * 512 + hq * 64 + lane]);
            float m = -1e30f, ls = 0.f, a = 0.f;
            for (int k = 0; k < nk; ++k) {
                float s = wave_sum(q * bf2f(K[(size_t)k * 64 + lane])) * 0.125f;
                float v = bf2f(Vt[(size_t)lane * nk + k]);
                float mn = fmaxf(m, s);
                float c = expf(m - mn), e = expf(s - mn);
                ls = ls * c + e; a = a * c + e * v; m = mn;
            }
            ((bf16_t*)(p.ws + OFF_MIX))[(size_t)t * D + 512 + hq * 64 + lane] = f2bf(a / ls);
        }
    }
}
__device__ void ph_peer_scores(const Params& p, int l) {
    const int tid = opaque_tid();
    const bf16_t* SK = (const bf16_t*)(p.ws + OFF_SUBK) + (size_t)l * 2 * 128 * 64;
    for (size_t idx = GTID; idx < (size_t)NTOK * 2048; idx += GNT) {
        int t = (int)(idx >> 11), o = (int)(idx & 2047);
        const bf16_t* Q = (const bf16_t*)(p.ws + OFF_Q) + (size_t)t * D;
        int n = o & 127, x = (o >> 7) & 1, h = o >> 8;
        float acc = 0.f;
        for (int k = 0; k < 64; ++k) acc += bf2f(Q[h * 128 + x * 64 + k]) * bf2f(SK[((size_t)x * 128 + n) * 64 + k]);
        ((float*)(p.ws + OFF_PROJ))[idx] = acc;
    }
}
__device__ void ph_peer_top1(const Params& p) {
    const int tid = opaque_tid();
    for (size_t idx = GTID; idx < (size_t)NTOK * 16; idx += GNT) {
        const float* SC = (const float*)(p.ws + OFF_PROJ) + idx * 128;
        float* TV = (float*)(p.ws + OFF_TOPV) + idx * 16; int* TI = (int*)(p.ws + OFF_TOPI) + idx * 16;
        float pv = 3.0e38f; int pi = -1;
        for (int r = 0; r < 16; ++r) {
            float bv = -3.0e38f; int bi = -1;
            for (int n = 0; n < 128; ++n) {
                float v = SC[n];
                bool after = (v < pv) || (v == pv && n > pi);
                if (after && (bi < 0 || v > bv)) { bv = v; bi = n; }
            }
            TV[r] = bv; TI[r] = bi; pv = bv; pi = bi;
        }
    }
}
__device__ void ph_peer_top2(const Params& p) {
    const int tid = opaque_tid();
    for (size_t idx = GTID; idx < (size_t)NTOK * 8; idx += GNT) {
        const float* TV = (const float*)(p.ws + OFF_TOPV) + idx * 32; const int* TI = (const int*)(p.ws + OFF_TOPI) + idx * 32;
        int* EI = (int*)(p.ws + OFF_EIDX) + idx * 16; float* EG = (float*)(p.ws + OFF_EGATE) + idx * 16;
        float pv = 3.0e38f; int pi = -1; float mx = 0.f, sum = 0.f;
        for (int r = 0; r < 16; ++r) {
            float bv = -3.0e38f; int bi = -1;
            for (int n = 0; n < 256; ++n) {
                float v = TV[n >> 4] + TV[16 + (n & 15)];
                bool after = (v < pv) || (v == pv && n > pi);
                if (after && (bi < 0 || v > bv)) { bv = v; bi = n; }
            }
            if (r == 0) mx = bv;
            float e = expf(bv - mx);
            sum += e;
            EG[r] = e; EI[r] = TI[bi >> 4] * 128 + TI[16 + (bi & 15)];
            pv = bv; pi = bi;
        }
        float inv = 1.f / sum;
        for (int r = 0; r < 16; ++r) EG[r] *= inv;
    }
}
__device__ void ph_peer_apply(const Params& p, int l, unsigned char* lds) {
    const int tid = opaque_tid();
    const int sub = tid >> 8, tl = tid & 255;
    const int wave = tl >> 6, lane = tl & 63;
    float* wts = (float*)(lds + 64) + sub * 128; int* eid = (int*)(lds + 64 + 1024) + sub * 128;
    const bf16_t* UT = (const bf16_t*)(p.ws + OFF_UT) + (size_t)l * NEXP * D;
    const bf16_t* VT = (const bf16_t*)(p.ws + OFF_VT) + (size_t)l * NEXP * D;
    const int niter = (NTOK + gridDim.x * 2 - 1) / (gridDim.x * 2);
    for (int it = 0; it < niter; ++it) {
        int t = (it * gridDim.x + blockIdx.x) * 2 + sub;
        const bool valid = t < NTOK; if (!valid) t = NTOK - 1;
        const bf16_t* H = (const bf16_t*)(p.ws + OFF_H) + (size_t)t * D;
        const int* EI = (const int*)(p.ws + OFF_EIDX) + (size_t)t * 128; const float* EG = (const float*)(p.ws + OFF_EGATE) + (size_t)t * 128;
        float hv[16];
#pragma unroll
        for (int i = 0; i < 16; ++i) hv[i] = bf2f(H[lane * 16 + i]);
        for (int jj = 0; jj < 32; ++jj) {
            int j = wave * 32 + jj; int e = EI[j];
            const bf16_t* ur = UT + (size_t)e * D + lane * 16;
            float acc = 0.f;
#pragma unroll
            for (int i = 0; i < 16; ++i) acc += hv[i] * bf2f(ur[i]);
            acc = wave_sum(acc);
            if (lane == 0) { wts[j] = EG[j] * gelu_f(acc); eid[j] = e; }
        }
        __syncthreads();
        float o[4] = {0.f, 0.f, 0.f, 0.f};
        for (int j = 0; j < 128; ++j) {
            const bf16_t* vr = VT + (size_t)eid[j] * D + tl * 4; float w = wts[j];
#pragma unroll
            for (int i = 0; i < 4; ++i) o[i] += w * bf2f(vr[i]);
        }
        const float* mod = (const float*)(p.ws + OFF_MOD) + (size_t)(l * 5 + tok_cv(t)) * 6144 + 5 * 1024;
        float* XC = (float*)(p.ws + OFF_XC) + (size_t)t * D;
        if (valid) {
#pragma unroll
            for (int i = 0; i < 4; ++i) { int c = tl * 4 + i; XC[c] += mod[c] * o[i]; }
        }
        __syncthreads();
    }
}
__device__ void ph_final_norm(const Params& p) {
    const int tid = opaque_tid();
    const int lane = tid & 63;
    const int gw = blockIdx.x * 8 + (tid >> 6), nw = gridDim.x * 8;
    for (int t = gw; t < NTOK; t += nw) {
        const float* xr = (const float*)(p.ws + OFF_XC) + (size_t)t * D;
        float4 v[4]; float ss = 0.f;
#pragma unroll
        for (int i = 0; i < 4; ++i) { v[i] = *reinterpret_cast<const float4*>(xr + i * 256 + lane * 4); ss += v[i].x * v[i].x + v[i].y * v[i].y + v[i].z * v[i].z + v[i].w * v[i].w; }
        ss = wave_sum(ss);
        float r = rsqrtf(ss / D + EPS);
        float* y = p.out + (size_t)t * D;
#pragma unroll
        for (int i = 0; i < 4; ++i) {
            int c = i * 256 + lane * 4;
            float4 g = *reinterpret_cast<const float4*>(p.in[I_FG] + c);
            float4 o; o.x = v[i].x * r * g.x; o.y = v[i].y * r * g.y; o.z = v[i].z * r * g.z; o.w = v[i].w * r * g.w;
            *reinterpret_cast<float4*>(y + c) = o;
        }
    }
}


namespace g8 {
constexpr int BM = 256, BK = 64, HALF = 128, HT = HALF * BK;
__device__ __forceinline__ int lds_byte(int r, int c) {
    int st = (r >> 4) * 2 + (c >> 5), rr = r & 15, cc = c & 31, ob = rr * 64 + cc * 2;
    return st * 1024 + (ob ^ (((ob >> 9) & 1) << 5));
}
__device__ __forceinline__ void stage_rc(int b, int& R, int& C) {
    int st = b / 1024, sb = b % 1024, swz = sb ^ (((sb >> 9) & 1) << 5);
    R = (st >> 1) * 16 + swz / 64; C = (st & 1) * 32 + (swz % 64) / 2;
}
}
enum { EPI_INPROJ = 0, EPI_WOUT = 1, EPI_WQ = 2 };
constexpr int STG = 132;

__device__ __forceinline__ unsigned pack_bf2(float a, float b) { return (unsigned)f2bf(a) | ((unsigned)f2bf(b) << 16); }
__device__ __forceinline__ void store_bf16x32(bf16_t* dst, const float (&v)[32]) {
#pragma unroll
    for (int i = 0; i < 4; ++i) {
        uint4 u;
        u.x = pack_bf2(v[i * 8 + 0], v[i * 8 + 1]); u.y = pack_bf2(v[i * 8 + 2], v[i * 8 + 3]);
        u.z = pack_bf2(v[i * 8 + 4], v[i * 8 + 5]); u.w = pack_bf2(v[i * 8 + 6], v[i * 8 + 7]);
        *reinterpret_cast<uint4*>(dst + i * 8) = u;
    }
}
__device__ __forceinline__ void store_f32x32(float* dst, const float (&v)[32]) {
#pragma unroll
    for (int i = 0; i < 8; ++i) *reinterpret_cast<float4*>(dst + i * 4) = make_float4(v[i * 4], v[i * 4 + 1], v[i * 4 + 2], v[i * 4 + 3]);
}

__device__ __forceinline__ void epi_inproj_row(const Params& p, int l, int t, int c0, float (&v)[32]) {
    const bool prompt = t < NPT;
    const int b = prompt ? (t >> 8) : ((t - NPT) >> 11);
    const int s = prompt ? (t & 255) : ((t - NPT) & 2047);
    unsigned char* ws = p.ws;
    const float* R = (const float*)(ws + OFF_ROPE);
    if (c0 < 512) {
        bf16_t* dst = (bf16_t*)(ws + (c0 < 256 ? OFF_AU : OFF_AV)) + (size_t)t * 256 + (c0 & 255);
#pragma unroll
        for (int i = 0; i < 32; ++i) v[i] = gelu_f(v[i]);
        store_bf16x32(dst, v);
    } else if (c0 < 1024) {
        const bool isq = c0 < 768;
        if (!isq && prompt) store_f32x32(p.out + OUT_NDK + (((size_t)b * 2 + l) * SEQ + s) * 256 + (c0 - 768), v);
        if (!prompt) {
            const float* cs = R + s * 16; const float* sn = R + 2048 * 16 + s * 16;
#pragma unroll
            for (int i = 0; i < 16; ++i) {
                float c = cs[i], sv = sn[i], x1 = v[i], x2 = v[i + 16];
                v[i] = x1 * c - x2 * sv; v[i + 16] = x2 * c + x1 * sv;
            }
        }
        bf16_t* dst;
        if (isq) dst = (bf16_t*)(ws + OFF_DQ) + (size_t)t * 256 + (c0 - 512);
        else {
            const int cc = c0 - 768, h = cc >> 6, r = cc & 63;
            dst = prompt ? (bf16_t*)(ws + OFF_DKP) + (((size_t)b * 4 + h) * SEQ + s) * 64 + r
                         : (bf16_t*)(ws + OFF_DKS) + (((size_t)b * 4 + h) * NKS + s) * 64 + r;
        }
        store_bf16x32(dst, v);
    } else if (c0 < 1280) {
        if (prompt) store_f32x32(p.out + OUT_NDV + (((size_t)b * 2 + l) * SEQ + s) * 256 + (c0 - 1024), v);
    } else if (c0 < 1920) {
        const bool isq = c0 < 1792;
        const int hi = c0 & 32;
        const float* g = p.in[isq ? I_QNG : I_KNG] + l * 64 + hi;
        float ss = 0.f;
#pragma unroll
        for (int i = 0; i < 32; ++i) ss += v[i] * v[i];
        ss += __shfl_xor(ss, 1);
        const float rr = rsqrtf(ss * (1.f / 64.f) + EPS);
#pragma unroll
        for (int i = 0; i < 32; ++i) v[i] = v[i] * rr * g[i];
        if (!isq && prompt) store_f32x32(p.out + OUT_NGK + (((size_t)b * 2 + l) * SEQ + s) * 128 + (c0 - 1792), v);
        if (!prompt) {
            const float* cs = R + 2048 * 32 + s * 32; const float* sn = R + 2048 * 64 + s * 32;
#pragma unroll
            for (int i = 0; i < 32; ++i) {
                float pv = __shfl_xor(v[i], 1);
                float c = cs[i], sv = sn[i];
                v[i] = hi ? (v[i] * c + pv * sv) : (v[i] * c - pv * sv);
            }
        }
        bf16_t* dst;
        if (isq) dst = (bf16_t*)(ws + OFF_GQ) + (size_t)t * 512 + (c0 - 1280);
        else {
            const int cc = c0 - 1792, kv = cc >> 6, r = cc & 63;
            dst = prompt ? (bf16_t*)(ws + OFF_GKP) + (((size_t)b * 2 + kv) * SEQ + s) * 64 + r
                         : (bf16_t*)(ws + OFF_GKS) + (((size_t)b * 2 + kv) * NKS + s) * 64 + r;
        }
        store_bf16x32(dst, v);
    } else {
        if (prompt) store_f32x32(p.out + OUT_NGV + (((size_t)b * 2 + l) * SEQ + s) * 128 + (c0 - 1920), v);
    }
}
__device__ __forceinline__ void epi_inproj_col(const Params& p, int t0, int c, const LAS float* stc) {
    float v[32];
#pragma unroll
    for (int i = 0; i < 32; ++i) v[i] = stc[i * STG];
    const bool prompt = t0 < NPT;
    const int b = prompt ? (t0 >> 8) : ((t0 - NPT) >> 11);
    const int s = prompt ? (t0 & 255) : ((t0 - NPT) & 2047);
    unsigned char* ws = p.ws;
    bf16_t* dst;
    if (c < 1280) {
        const int cc = c - 1024, h = cc >> 6, d = cc & 63;
        dst = prompt ? (bf16_t*)(ws + OFF_DVTP) + (((size_t)b * 4 + h) * 64 + d) * SEQ + s
                     : (bf16_t*)(ws + OFF_DVTS) + (((size_t)b * 4 + h) * 64 + d) * NKS + s;
    } else {
        const int cc = c - 1920, kv = cc >> 6, d = cc & 63;
        dst = prompt ? (bf16_t*)(ws + OFF_GVTP) + (((size_t)b * 2 + kv) * 64 + d) * SEQ + s
                     : (bf16_t*)(ws + OFF_GVTS) + (((size_t)b * 2 + kv) * 64 + d) * NKS + s;
    }
    store_bf16x32(dst, v);
}

template <int MODE>
__device__ __forceinline__ void gemm_phase(const Params& p, int l, const bf16_t* __restrict__ A, const bf16_t* __restrict__ Bt, const int N, unsigned char* ldsraw) {
    using namespace g8;
    constexpr int K = 1024, nt = K / BK, BN = 128, TILE_A = BM * BK * 2, TILE_B = BN * BK * 2, STAGE_B = TILE_A + TILE_B;
    LAS unsigned char* lds = (LAS unsigned char*)ldsraw;
    int tid_ = threadIdx.x; asm volatile("" : "+v"(tid_));
    const int tid = tid_, wid = __builtin_amdgcn_readfirstlane(tid >> 6), lane = tid & 63;
    const int wr = wid >> 1, wc = wid & 1, fr = lane & 15, fq = lane >> 4;
    unsigned voff[4];
#pragma unroll
    for (int i = 0; i < 4; ++i) { int R, C; stage_rc(wid * 1024 + i * 8192 + lane * 16, R, C); voff[i] = (unsigned)(R * K + C) * 2u; }
    const int aoff = lds_byte(wr * 64 + fr, fq * 8), boff = lds_byte(wc * 64 + fr, fq * 8);
    const unsigned ldsw = (unsigned)wid * 1024u;
#define G8_STAGE(buf, kt) do { \
        _Pragma("unroll") for (int _i = 0; _i < 4; ++_i) \
            __builtin_amdgcn_global_load_lds((const unsigned*)((const char*)(Ab + (kt) * BK) + voff[_i]), (LAS unsigned*)(lds + (buf) * STAGE_B + ldsw + _i * 8192), 16, 0, 0); \
        _Pragma("unroll") for (int _i = 0; _i < 2; ++_i) \
            __builtin_amdgcn_global_load_lds((const unsigned*)((const char*)(Bb + (kt) * BK) + voff[_i]), (LAS unsigned*)(lds + (buf) * STAGE_B + TILE_A + ldsw + _i * 8192), 16, 0, 0); } while (0)
#define G8_WAIT_V0() asm volatile("s_waitcnt vmcnt(0)" ::: "memory")
    const int nN = N / BN, nM = NTOK / BM, ntiles = nM * nN;
    const int G = gridDim.x;
    const int vb = (G % 8 == 0) ? (int)(blockIdx.x % 8) * (G / 8) + (int)(blockIdx.x / 8) : (int)blockIdx.x;
    const int tpb = (ntiles + G - 1) / G;
    for (int ti = 0; ti < tpb; ++ti) {
        const int tile = vb * tpb + ti;
        if (tile >= ntiles) break;
        const int pm = tile / nN, pn = tile % nN, brow = pm * BM, bcol = pn * BN;
        const bf16_t* Ab = A + (size_t)brow * K; const bf16_t* Bb = Bt + (size_t)bcol * K;
        f32x4 acc[4][4];
#pragma unroll
        for (int m = 0; m < 4; ++m)
#pragma unroll
            for (int n = 0; n < 4; ++n) acc[m][n] = f32x4{0.f, 0.f, 0.f, 0.f};
        G8_WAIT_V0();
        G8_STAGE(0, 0); G8_WAIT_V0(); __syncthreads();
        for (int t = 0; t < nt; ++t) {
            const int cur = t & 1;
            if (t + 1 < nt) G8_STAGE(cur ^ 1, t + 1);
#pragma unroll
            for (int ks = 0; ks < 2; ++ks) {
                bf16x8 At[4], Bf[4];
#pragma unroll
                for (int m = 0; m < 4; ++m) At[m] = *(const LAS bf16x8*)(lds + cur * STAGE_B + aoff + m * 2048 + ks * 1024);
#pragma unroll
                for (int n = 0; n < 4; ++n) Bf[n] = *(const LAS bf16x8*)(lds + cur * STAGE_B + TILE_A + boff + n * 2048 + ks * 1024);
#pragma unroll
                for (int m = 0; m < 4; ++m)
#pragma unroll
                    for (int n = 0; n < 4; ++n) acc[m][n] = __builtin_amdgcn_mfma_f32_16x16x32_bf16(At[m], Bf[n], acc[m][n], 0, 0, 0);
            }
            G8_WAIT_V0(); __syncthreads();
        }
        LAS float* st = (LAS float*)lds;
#pragma unroll
        for (int m = 0; m < 4; ++m)
#pragma unroll
            for (int n = 0; n < 4; ++n)
#pragma unroll
                for (int j = 0; j < 4; ++j)
                    st[(wr * 64 + m * 16 + fq * 4 + j) * STG + wc * 64 + n * 16 + fr] = acc[m][n][j];
        __syncthreads();
#pragma unroll 1
        for (int it = 0; it < 2; ++it) {
            const int item = it * NT + tid, erow = item >> 2, eseg = item & 3;
            const int t = brow + erow, c0 = bcol + eseg * 32;
            float v[32];
#pragma unroll
            for (int i = 0; i < 8; ++i) {
                const f32x4 f = *(const LAS f32x4*)(st + erow * STG + eseg * 32 + i * 4);
                v[i * 4] = f[0]; v[i * 4 + 1] = f[1]; v[i * 4 + 2] = f[2]; v[i * 4 + 3] = f[3];
            }
            if (MODE == EPI_INPROJ) {
                epi_inproj_row(p, l, t, c0, v);
            } else if (MODE == EPI_WOUT) {
                const float* xr = (l == 0 ? x_in_row(p, t) : (const float*)(p.ws + OFF_XC) + (size_t)t * D) + c0;
                const float* g1 = (const float*)(p.ws + OFF_MOD) + (size_t)(l * 5 + tok_cv(t)) * 6144 + 2048 + c0;
                float* xo = (float*)(p.ws + OFF_XC) + (size_t)t * D + c0;
#pragma unroll
                for (int i = 0; i < 8; ++i) {
                    const float4 x = *reinterpret_cast<const float4*>(xr + i * 4), g = *reinterpret_cast<const float4*>(g1 + i * 4);
                    *reinterpret_cast<float4*>(xo + i * 4) = make_float4(x.x + g.x * v[i * 4], x.y + g.y * v[i * 4 + 1], x.z + g.z * v[i * 4 + 2], x.w + g.w * v[i * 4 + 3]);
                }
            } else {
                store_bf16x32((bf16_t*)(p.ws + OFF_Q) + (size_t)t * D + c0, v);
            }
        }
        if (MODE == EPI_INPROJ && ((bcol >= 1024 && bcol < 1280) || bcol >= 1920)) {
#pragma unroll 1
            for (int it = 0; it < 2; ++it) {
                const int item = it * NT + tid, col = item >> 3, run = item & 7;
                epi_inproj_col(p, brow + run * 32, bcol + col, st + run * 32 * STG + col);
            }
        }
        __syncthreads();
    }
}


using f32x16 = __attribute__((ext_vector_type(16))) float;
using u32x4  = __attribute__((ext_vector_type(4))) unsigned;
using s16x4  = __attribute__((ext_vector_type(4))) short;
#define MFMA32(a, b, c) __builtin_amdgcn_mfma_f32_32x32x16_bf16((a), (b), (c), 0, 0, 0)
constexpr int ATT_ROWB = 144;
constexpr int ATT_TILEB = 64 * ATT_ROWB;
constexpr int QW_MIX = 4096;

__device__ __forceinline__ bf16x8 pack8(const f32x16& x, int s) {
    bf16x8 r;
#pragma unroll
    for (int j = 0; j < 8; ++j) r[j] = (short)f2bf(x[8 * s + j]);
    return r;
}
__device__ __forceinline__ void softmax_tile(f32x16& s0, f32x16& s1, const float sc, float& m, float& l, float& alpha) {
    float mx = fmaxf(s0[0], s1[0]);
#pragma unroll
    for (int i = 1; i < 16; ++i) mx = fmaxf(mx, fmaxf(s0[i], s1[i]));
    mx = fmaxf(mx, __shfl_xor(mx, 32));
    const float mnew = fmaxf(m, mx * sc);
    alpha = __builtin_amdgcn_exp2f(m - mnew);
    m = mnew;
    float ps = 0.f;
#pragma unroll
    for (int i = 0; i < 16; ++i) { s0[i] = __builtin_amdgcn_exp2f(s0[i] * sc - mnew); s1[i] = __builtin_amdgcn_exp2f(s1[i] * sc - mnew); ps += s0[i] + s1[i]; }
    l = l * alpha + ps;
}
__device__ __forceinline__ void pv_tile(const LAS unsigned char* vb, const f32x16& p0, const f32x16& p1, f32x16 (&O)[2], int r, int hh) {
#pragma unroll
    for (int u = 0; u < 2; ++u)
#pragma unroll
        for (int sk = 0; sk < 2; ++sk) {
            const bf16x8 pf = pack8(u ? p1 : p0, sk);
#pragma unroll
            for (int mt = 0; mt < 2; ++mt) {
                const LAS unsigned char* a = vb + (32 * mt + r) * ATT_ROWB + (32 * u + 16 * sk + 4 * hh) * 2;
                const s16x4 lo = *(const LAS s16x4*)a, hi = *(const LAS s16x4*)(a + 16);
                const bf16x8 af = {lo[0], lo[1], lo[2], lo[3], hi[0], hi[1], hi[2], hi[3]};
                O[mt] = MFMA32(af, pf, O[mt]);
            }
        }
}

template <bool DIFF>
__device__ __forceinline__ void attn_item(const Params& p, int l, LAS unsigned char* lds, const int tid,
                                          const bf16_t* __restrict__ Qg, const int qstride,
                                          const bf16_t* __restrict__ Kg, const bf16_t* __restrict__ Vtg, const int nk,
                                          bf16_t* __restrict__ Og, const float lam) {
    const int wave = tid >> 6, lane = tid & 63, r = lane & 31, hh = lane >> 5;
    const int lrow = tid >> 3, lchunk = tid & 7;
    LAS unsigned char* kbuf = lds; LAS unsigned char* vbuf = lds + 2 * ATT_TILEB;
    bf16x8 qf[4];
    const bf16_t* qrow = Qg + (size_t)(wave * 32 + r) * qstride;
#pragma unroll
    for (int ks = 0; ks < 4; ++ks) qf[ks] = *reinterpret_cast<const bf16x8*>(qrow + ks * 16 + hh * 8);
    const float sc = (DIFF ? 0.17677669529663687f : 0.125f) * 1.4426950408889634f;
    f32x16 O0[2], O1[2];
#pragma unroll
    for (int mt = 0; mt < 2; ++mt)
#pragma unroll
        for (int i = 0; i < 16; ++i) { O0[mt][i] = 0.f; O1[mt][i] = 0.f; }
    float m0 = -1e30f, l0 = 0.f, m1 = -1e30f, l1 = 0.f;
    const int ntl = nk / 64;
    u32x4 kr, vr;
    kr = *reinterpret_cast<const u32x4*>(Kg + (size_t)lrow * 64 + lchunk * 8);
    vr = *reinterpret_cast<const u32x4*>(Vtg + (size_t)lrow * nk + lchunk * 8);
    *(LAS u32x4*)(kbuf + lrow * ATT_ROWB + lchunk * 16) = kr;
    *(LAS u32x4*)(vbuf + lrow * ATT_ROWB + lchunk * 16) = vr;
    __syncthreads();
    for (int ti = 0; ti < ntl; ++ti) {
        const int cur = ti & 1;
        if (ti + 1 < ntl) {
            kr = *reinterpret_cast<const u32x4*>(Kg + (size_t)((ti + 1) * 64 + lrow) * 64 + lchunk * 8);
            vr = *reinterpret_cast<const u32x4*>(Vtg + (size_t)lrow * nk + (ti + 1) * 64 + lchunk * 8);
        }
        const LAS unsigned char* kb = kbuf + cur * ATT_TILEB; const LAS unsigned char* vb = vbuf + cur * ATT_TILEB;
        if (!DIFF) {
            f32x16 s0, s1;
#pragma unroll
            for (int i = 0; i < 16; ++i) { s0[i] = 0.f; s1[i] = 0.f; }
#pragma unroll
            for (int ks = 0; ks < 4; ++ks) {
                const bf16x8 a0 = *(const LAS bf16x8*)(kb + r * ATT_ROWB + (ks * 16 + hh * 8) * 2);
                const bf16x8 a1 = *(const LAS bf16x8*)(kb + (32 + r) * ATT_ROWB + (ks * 16 + hh * 8) * 2);
                s0 = MFMA32(a0, qf[ks], s0); s1 = MFMA32(a1, qf[ks], s1);
            }
            float alpha;
            softmax_tile(s0, s1, sc, m0, l0, alpha);
#pragma unroll
            for (int mt = 0; mt < 2; ++mt)
#pragma unroll
                for (int i = 0; i < 16; ++i) O0[mt][i] *= alpha;
            pv_tile(vb, s0, s1, O0, r, hh);
        } else {
#pragma unroll
            for (int x = 0; x < 2; ++x) {
                f32x16 s0, s1;
#pragma unroll
                for (int i = 0; i < 16; ++i) { s0[i] = 0.f; s1[i] = 0.f; }
#pragma unroll
                for (int ks = 0; ks < 2; ++ks) {
                    const bf16x8 a0 = *(const LAS bf16x8*)(kb + r * ATT_ROWB + (x * 32 + ks * 16 + hh * 8) * 2);
                    const bf16x8 a1 = *(const LAS bf16x8*)(kb + (32 + r) * ATT_ROWB + (x * 32 + ks * 16 + hh * 8) * 2);
                    s0 = MFMA32(a0, qf[x * 2 + ks], s0); s1 = MFMA32(a1, qf[x * 2 + ks], s1);
                }
                float alpha;
                if (x == 0) {
                    softmax_tile(s0, s1, sc, m0, l0, alpha);
#pragma unroll
                    for (int mt = 0; mt < 2; ++mt)
#pragma unroll
                        for (int i = 0; i < 16; ++i) O0[mt][i] *= alpha;
                    pv_tile(vb, s0, s1, O0, r, hh);
                } else {
                    softmax_tile(s0, s1, sc, m1, l1, alpha);
#pragma unroll
                    for (int mt = 0; mt < 2; ++mt)
#pragma unroll
                        for (int i = 0; i < 16; ++i) O1[mt][i] *= alpha;
                    pv_tile(vb, s0, s1, O1, r, hh);
                }
            }
        }
        if (ti + 1 < ntl) {
            *(LAS u32x4*)(kbuf + (cur ^ 1) * ATT_TILEB + lrow * ATT_ROWB + lchunk * 16) = kr;
            *(LAS u32x4*)(vbuf + (cur ^ 1) * ATT_TILEB + lrow * ATT_ROWB + lchunk * 16) = vr;
        }
        __syncthreads();
    }
    l0 += __shfl_xor(l0, 32);
    const float inv0 = 1.f / l0;
    bf16_t* orow = Og + (size_t)(wave * 32 + r) * D;
    if (!DIFF) {
#pragma unroll
        for (int mt = 0; mt < 2; ++mt)
#pragma unroll
            for (int g = 0; g < 4; ++g) {
                uint2 w;
                w.x = pack_bf2(O0[mt][4 * g] * inv0, O0[mt][4 * g + 1] * inv0);
                w.y = pack_bf2(O0[mt][4 * g + 2] * inv0, O0[mt][4 * g + 3] * inv0);
                *reinterpret_cast<uint2*>(orow + 32 * mt + 8 * g + 4 * hh) = w;
            }
    } else {
        l1 += __shfl_xor(l1, 32);
        const float inv1 = lam / l1;
        float ss = 0.f;
#pragma unroll
        for (int mt = 0; mt < 2; ++mt)
#pragma unroll
            for (int i = 0; i < 16; ++i) { const float o = O0[mt][i] * inv0 - O1[mt][i] * inv1; O0[mt][i] = o; ss += o * o; }
        ss += __shfl_xor(ss, 32);
        const float rr = rsqrtf(ss * (1.f / 64.f) + EPS) * (1.f - lam_init_of(l));
        const float* sg = p.in[I_SUBLN] + l * 64;
#pragma unroll
        for (int mt = 0; mt < 2; ++mt)
#pragma unroll
            for (int g = 0; g < 4; ++g) {
                const int d0 = 32 * mt + 8 * g + 4 * hh;
                const float4 gg = *reinterpret_cast<const float4*>(sg + d0);
                uint2 w;
                w.x = pack_bf2(O0[mt][4 * g] * rr * gg.x, O0[mt][4 * g + 1] * rr * gg.y);
                w.y = pack_bf2(O0[mt][4 * g + 2] * rr * gg.z, O0[mt][4 * g + 3] * rr * gg.w);
                *reinterpret_cast<uint2*>(orow + d0) = w;
            }
    }
}

constexpr int SGU_ROWB = 272;
__device__ __forceinline__ void sgu_item(const Params& p, int l, LAS unsigned char* lds, const int tid, const int t0) {
    const bf16_t* AV = (const bf16_t*)(p.ws + OFF_AV) + (size_t)t0 * 256;
    {
        const int q = tid >> 2, quarter = tid & 3;
        float v[64]; float ss = 0.f;
#pragma unroll
        for (int i = 0; i < 8; ++i) {
            const bf16x8 w = *reinterpret_cast<const bf16x8*>(AV + (size_t)q * 256 + quarter * 64 + i * 8);
#pragma unroll
            for (int j = 0; j < 8; ++j) { v[i * 8 + j] = bf2f((bf16_t)w[j]); ss += v[i * 8 + j] * v[i * 8 + j]; }
        }
        ss += __shfl_xor(ss, 1); ss += __shfl_xor(ss, 2);
        const float rstd = rsqrtf(ss * (1.f / 256.f) + EPS);
        const float* g = p.in[I_SGUNG] + l * 256 + quarter * 64;
#pragma unroll
        for (int i = 0; i < 64; ++i)
            *(LAS bf16_t*)(lds + (quarter * 64 + i) * SGU_ROWB + q * 2) = f2bf(v[i] * rstd * g[i]);
    }
    __syncthreads();
    {
        const int wave = tid >> 6, lane = tid & 63, r = lane & 31, hh = lane >> 5;
        const int g = wave >> 1, ph = wave & 1;
        const bf16_t* W = (const bf16_t*)(p.ws + OFF_SGUW) + ((size_t)l * 4 + g) * 128 * 128;
        f32x16 acc[2][2];
#pragma unroll
        for (int a = 0; a < 2; ++a)
#pragma unroll
            for (int b = 0; b < 2; ++b)
#pragma unroll
                for (int i = 0; i < 16; ++i) acc[a][b][i] = 0.f;
#pragma unroll
        for (int ks = 0; ks < 8; ++ks) {
            bf16x8 af[2], bfr[2];
#pragma unroll
            for (int pt = 0; pt < 2; ++pt) af[pt] = *reinterpret_cast<const bf16x8*>(W + (size_t)(ph * 64 + pt * 32 + r) * 128 + ks * 16 + hh * 8);
#pragma unroll
            for (int ct = 0; ct < 2; ++ct) bfr[ct] = *(const LAS bf16x8*)(lds + (g * 64 + ct * 32 + r) * SGU_ROWB + (ks * 16 + hh * 8) * 2);
#pragma unroll
            for (int pt = 0; pt < 2; ++pt)
#pragma unroll
                for (int ct = 0; ct < 2; ++ct) acc[pt][ct] = MFMA32(af[pt], bfr[ct], acc[pt][ct]);
        }
        const float* bias = p.in[I_SGUB] + (l * 4 + g) * 128;
        const bf16_t* AU = (const bf16_t*)(p.ws + OFF_AU);
        bf16_t* MIX = (bf16_t*)(p.ws + OFF_MIX);
#pragma unroll
        for (int pt = 0; pt < 2; ++pt)
#pragma unroll
            for (int ct = 0; ct < 2; ++ct)
#pragma unroll
                for (int i = 0; i < 16; ++i) {
                    const int pp = ph * 64 + pt * 32 + (i & 3) + 8 * (i >> 2) + 4 * hh, c = g * 64 + ct * 32 + r;
                    const float au = bf2f(AU[(size_t)(t0 + pp) * 256 + c]);
                    MIX[(size_t)(t0 + pp) * D + c] = f2bf(au * (acc[pt][ct][i] + bias[pp]));
                }
    }
    __syncthreads();
}

__device__ void ph_mixers(const Params& p, int l, unsigned char* ldsraw) {
    const int tid0 = opaque_tid();
    LAS unsigned char* lds = (LAS unsigned char*)ldsraw;
    volatile LAS int* qslot = (volatile LAS int*)(ldsraw - LDS_HDR + 64);
    unsigned* qw = (unsigned*)(p.ws + OFF_BAR) + QW_MIX + l;
    const float lam = lam_of(p, l);
    unsigned char* ws = p.ws;
    for (;;) {
        if (tid0 == 0) *qslot = (int)atomicAdd(qw, 1u);
        __syncthreads();
        const int item = *qslot;
        __syncthreads();
        if (item >= 896) break;
        int tid = tid0; asm volatile("" : "+v"(tid));
        if (item < 128) {
            const int qc = item & 7, h = (item >> 3) & 3, b = item >> 5;
            const int t0 = NPT + b * DSEQ + qc * 256;
            attn_item<true>(p, l, lds, tid, (const bf16_t*)(ws + OFF_DQ) + (size_t)t0 * 256 + h * 64, 256,
                            (const bf16_t*)(ws + OFF_DKS) + ((size_t)b * 4 + h) * NKS * 64, (const bf16_t*)(ws + OFF_DVTS) + ((size_t)b * 4 + h) * 64 * NKS, NKS,
                            (bf16_t*)(ws + OFF_MIX) + (size_t)t0 * D + 256 + h * 64, lam);
        } else if (item < 384) {
            const int it = item - 128, qc = it & 7, hq = (it >> 3) & 7, b = it >> 6, kv = hq >> 2;
            const int t0 = NPT + b * DSEQ + qc * 256;
            attn_item<false>(p, l, lds, tid, (const bf16_t*)(ws + OFF_GQ) + (size_t)t0 * 512 + hq * 64, 512,
                             (const bf16_t*)(ws + OFF_GKS) + ((size_t)b * 2 + kv) * NKS * 64, (const bf16_t*)(ws + OFF_GVTS) + ((size_t)b * 2 + kv) * 64 * NKS, NKS,
                             (bf16_t*)(ws + OFF_MIX) + (size_t)t0 * D + 512 + hq * 64, lam);
        } else if (item < 512) {
            sgu_item(p, l, lds, tid, (item - 384) * 128);
        } else if (item < 768) {
            const int it = item - 512, hq = it & 7, b = it >> 3, kv = hq >> 2;
            const int t0 = b * SEQ;
            attn_item<false>(p, l, lds, tid, (const bf16_t*)(ws + OFF_GQ) + (size_t)t0 * 512 + hq * 64, 512,
                             (const bf16_t*)(ws + OFF_GKP) + ((size_t)b * 2 + kv) * SEQ * 64, (const bf16_t*)(ws + OFF_GVTP) + ((size_t)b * 2 + kv) * 64 * SEQ, SEQ,
                             (bf16_t*)(ws + OFF_MIX) + (size_t)t0 * D + 512 + hq * 64, lam);
        } else {
            const int it = item - 768, h = it & 3, b = it >> 2;
            const int t0 = b * SEQ;
            attn_item<true>(p, l, lds, tid, (const bf16_t*)(ws + OFF_DQ) + (size_t)t0 * 256 + h * 64, 256,
                            (const bf16_t*)(ws + OFF_DKP) + ((size_t)b * 4 + h) * SEQ * 64, (const bf16_t*)(ws + OFF_DVTP) + ((size_t)b * 4 + h) * 64 * SEQ, SEQ,
                            (bf16_t*)(ws + OFF_MIX) + (size_t)t0 * D + 256 + h * 64, lam);
        }
    }
}


using bf16x2 = __attribute__((ext_vector_type(2))) __bf16;
__device__ __forceinline__ float dot2bf(unsigned a, unsigned b, float c) {
    return __builtin_amdgcn_fdot2_f32_bf16(__builtin_bit_cast(bf16x2, a), __builtin_bit_cast(bf16x2, b), c, false);
}
template <int W>
__device__ __forceinline__ void bfly_stage(float (&part)[64], const int lane) {
    const bool hi = (lane & W) != 0;
#pragma unroll
    for (int k = 0; k < W; ++k) {
        const float keep = hi ? part[k + W] : part[k];
        const float send = hi ? part[k] : part[k + W];
        part[k] = keep + __shfl_xor(send, W);
    }
}
__device__ void ph_peer_apply_fast(const Params& p, int l, bool last) {
    const int tid = opaque_tid();
    const int lane = tid & 63;
    const int gw = blockIdx.x * 8 + (tid >> 6), nw = gridDim.x * 8;
    const bf16_t* UT = (const bf16_t*)(p.ws + OFF_UT) + (size_t)l * NEXP * D;
    const bf16_t* VT = (const bf16_t*)(p.ws + OFF_VT) + (size_t)l * NEXP * D;
    for (int t = gw; t < NTOK; t += nw) {
        const bf16_t* Hr = (const bf16_t*)(p.ws + OFF_H) + (size_t)t * D + lane * 8;
        const u32x4 h0 = *reinterpret_cast<const u32x4*>(Hr), h1 = *reinterpret_cast<const u32x4*>(Hr + 512);
        const int* EI = (const int*)(p.ws + OFF_EIDX) + (size_t)t * 128; const float* EG = (const float*)(p.ws + OFF_EGATE) + (size_t)t * 128;
        const int e0 = EI[lane], e1 = EI[64 + lane];
        float w0, w1;
#pragma unroll 1
        for (int batch = 0; batch < 2; ++batch) {
            const int eb = batch ? e1 : e0;
            float part[64];
#pragma unroll
            for (int j0 = 0; j0 < 64; j0 += 8) {
                u32x4 a[8], b[8];
#pragma unroll
                for (int jj = 0; jj < 8; ++jj) {
                    const int e = __builtin_amdgcn_readlane(eb, j0 + jj);
                    const bf16_t* ur = UT + (size_t)e * D + lane * 8;
                    a[jj] = *reinterpret_cast<const u32x4*>(ur); b[jj] = *reinterpret_cast<const u32x4*>(ur + 512);
                }
                __builtin_amdgcn_sched_barrier(0);
#pragma unroll
                for (int jj = 0; jj < 8; ++jj) {
                    float acc = 0.f;
                    acc = dot2bf(a[jj][0], h0[0], acc); acc = dot2bf(a[jj][1], h0[1], acc); acc = dot2bf(a[jj][2], h0[2], acc); acc = dot2bf(a[jj][3], h0[3], acc);
                    acc = dot2bf(b[jj][0], h1[0], acc); acc = dot2bf(b[jj][1], h1[1], acc); acc = dot2bf(b[jj][2], h1[2], acc); acc = dot2bf(b[jj][3], h1[3], acc);
                    part[j0 + jj] = acc;
                }
                __builtin_amdgcn_sched_barrier(0);
            }
            bfly_stage<32>(part, lane); bfly_stage<16>(part, lane); bfly_stage<8>(part, lane);
            bfly_stage<4>(part, lane); bfly_stage<2>(part, lane); bfly_stage<1>(part, lane);
            const float w = EG[batch * 64 + lane] * gelu_f(part[0]);
            if (batch) w1 = w; else w0 = w;
        }
        float o[16];
#pragma unroll
        for (int i = 0; i < 16; ++i) o[i] = 0.f;
#pragma unroll 1
        for (int batch = 0; batch < 2; ++batch) {
            const int eb = batch ? e1 : e0; const float wb = batch ? w1 : w0;
#pragma unroll 1
            for (int j0 = 0; j0 < 64; j0 += 8) {
                u32x4 a[8], b[8]; float w[8];
#pragma unroll
                for (int jj = 0; jj < 8; ++jj) {
                    const int e = __builtin_amdgcn_readlane(eb, j0 + jj);
                    w[jj] = __builtin_bit_cast(float, __builtin_amdgcn_readlane(__builtin_bit_cast(int, wb), j0 + jj));
                    const bf16_t* vr = VT + (size_t)e * D + lane * 8;
                    a[jj] = *reinterpret_cast<const u32x4*>(vr); b[jj] = *reinterpret_cast<const u32x4*>(vr + 512);
                }
                __builtin_amdgcn_sched_barrier(0);
#pragma unroll
                for (int jj = 0; jj < 8; ++jj) {
#pragma unroll
                    for (int k = 0; k < 4; ++k) {
                        o[2 * k]     += w[jj] * __uint_as_float(a[jj][k] << 16);
                        o[2 * k + 1] += w[jj] * __uint_as_float(a[jj][k] & 0xffff0000u);
                        o[8 + 2 * k]     += w[jj] * __uint_as_float(b[jj][k] << 16);
                        o[8 + 2 * k + 1] += w[jj] * __uint_as_float(b[jj][k] & 0xffff0000u);
                    }
                }
                __builtin_amdgcn_sched_barrier(0);
            }
        }
        const float* g2 = (const float*)(p.ws + OFF_MOD) + (size_t)(l * 5 + tok_cv(t)) * 6144 + 5 * 1024 + lane * 8;
        float* XC = (float*)(p.ws + OFF_XC) + (size_t)t * D + lane * 8;
        float xv[16];
#pragma unroll
        for (int i = 0; i < 4; ++i) {
            const int off = (i >> 1) * 512 + (i & 1) * 4;
            const float4 x = *reinterpret_cast<const float4*>(XC + off), g = *reinterpret_cast<const float4*>(g2 + off);
            xv[i * 4] = x.x + g.x * o[i * 4]; xv[i * 4 + 1] = x.y + g.y * o[i * 4 + 1]; xv[i * 4 + 2] = x.z + g.z * o[i * 4 + 2]; xv[i * 4 + 3] = x.w + g.w * o[i * 4 + 3];
        }
        if (!last) {
#pragma unroll
            for (int i = 0; i < 4; ++i) *reinterpret_cast<float4*>(XC + (i >> 1) * 512 + (i & 1) * 4) = make_float4(xv[i * 4], xv[i * 4 + 1], xv[i * 4 + 2], xv[i * 4 + 3]);
        } else {
            float ss = 0.f;
#pragma unroll
            for (int i = 0; i < 16; ++i) ss += xv[i] * xv[i];
            ss = wave_sum(ss);
            const float r = rsqrtf(ss / D + EPS);
            const float* fg = p.in[I_FG] + lane * 8;
            float* y = p.out + (size_t)t * D + lane * 8;
#pragma unroll
            for (int i = 0; i < 4; ++i) {
                const int off = (i >> 1) * 512 + (i & 1) * 4;
                const float4 g = *reinterpret_cast<const float4*>(fg + off);
                *reinterpret_cast<float4*>(y + off) = make_float4(xv[i * 4] * r * g.x, xv[i * 4 + 1] * r * g.y, xv[i * 4 + 2] * r * g.z, xv[i * 4 + 3] * r * g.w);
            }
        }
    }
}


#define CE_DESC(a, b) do { const float _mx = fmaxf((a), (b)); const float _mn = fminf((a), (b)); (a) = _mx; (b) = _mn; } while (0)
__device__ __forceinline__ void sort16_desc(float (&v)[16]) {
#pragma unroll
    for (int k = 2; k <= 16; k <<= 1)
#pragma unroll
        for (int j = k >> 1; j > 0; j >>= 1)
#pragma unroll
            for (int i = 0; i < 16; ++i) {
                const int m = i ^ j;
                if (m > i) { if ((i & k) == 0) CE_DESC(v[i], v[m]); else CE_DESC(v[m], v[i]); }
            }
}
__device__ __forceinline__ void merge_top16(float (&a)[16], const float (&b)[16]) {
#pragma unroll
    for (int i = 0; i < 16; ++i) a[i] = fmaxf(a[i], b[15 - i]);
#pragma unroll
    for (int j = 8; j > 0; j >>= 1)
#pragma unroll
        for (int i = 0; i < 16; ++i) { const int m = i ^ j; if (m > i) CE_DESC(a[i], a[m]); }
}
__device__ __forceinline__ float key_embed(float v, unsigned lowmask, unsigned idxbits) { return __uint_as_float((__float_as_uint(v) & ~lowmask) | idxbits); }

constexpr int SK_ROWB = 144;
__device__ __forceinline__ void peer_stage1(const LAS unsigned char* SK  , const bf16_t* __restrict__ Qrow  ,
                                            const int r, const int hh, float (&out)[16]) {
    bf16x8 qb[4];
#pragma unroll
    for (int ks = 0; ks < 4; ++ks) qb[ks] = *reinterpret_cast<const bf16x8*>(Qrow + ks * 16 + hh * 8);
    float grp[4][16];
#pragma unroll
    for (int mt = 0; mt < 4; ++mt) {
        f32x16 acc;
#pragma unroll
        for (int i = 0; i < 16; ++i) acc[i] = 0.f;
#pragma unroll
        for (int ks = 0; ks < 4; ++ks) {
            const bf16x8 a = *(const LAS bf16x8*)(SK + (mt * 32 + r) * SK_ROWB + (ks * 16 + hh * 8) * 2);
            acc = MFMA32(a, qb[ks], acc);
        }
        const unsigned hx = (unsigned)hh << 2;
#pragma unroll
        for (int i = 0; i < 16; ++i) {
            const unsigned cn = 32u * mt + (i & 3) + 8u * (i >> 2);
            grp[mt][i] = key_embed(acc[i], 127u, (127u - cn) ^ hx);
        }
        sort16_desc(grp[mt]);
    }
    merge_top16(grp[0], grp[1]); merge_top16(grp[2], grp[3]); merge_top16(grp[0], grp[2]);
    float pb[16];
#pragma unroll
    for (int i = 0; i < 16; ++i) pb[i] = __shfl_xor(grp[0][i], 32);
    merge_top16(grp[0], pb);
#pragma unroll
    for (int i = 0; i < 16; ++i) out[i] = grp[0][i];
}

__device__ void ph_peer_select(const Params& p, int l, unsigned char* ldsraw) {
    const int tid = opaque_tid();
    const int wave = tid >> 6, lane = tid & 63, r = lane & 31, hh = lane >> 5;
    const int gw = blockIdx.x * 8 + wave, nw = gridDim.x * 8;
    LAS unsigned char* skl = (LAS unsigned char*)ldsraw;
    LAS unsigned char* myl = skl + 2 * 128 * SK_ROWB + wave * 2048 + lane * 32;
    {
        const bf16_t* SKg = (const bf16_t*)(p.ws + OFF_SUBK) + (size_t)l * 2 * 128 * 64;
        for (int i = tid; i < 2 * 128 * 8; i += NT) {
            const int row = i >> 3, ch = i & 7;
            *(LAS u32x4*)(skl + row * SK_ROWB + ch * 16) = *reinterpret_cast<const u32x4*>(SKg + (size_t)row * 64 + ch * 8);
        }
        __syncthreads();
    }
    for (int task = gw; task < (NTOK / 32) * 4; task += nw) {
        const int tg = task >> 2, k = task & 3;
        const int t = tg * 32 + r;
        const bf16_t* Qt = (const bf16_t*)(p.ws + OFF_Q) + (size_t)t * D;
        float sv[2][16];
#pragma unroll
        for (int x = 0; x < 2; ++x) {
            float la[16], lb[16];
            peer_stage1(skl + x * 128 * SK_ROWB, Qt + k * 128 + x * 64, r, hh, la);
            peer_stage1(skl + x * 128 * SK_ROWB, Qt + (k + 4) * 128 + x * 64, r, hh, lb);
#pragma unroll
            for (int i = 0; i < 16; ++i) sv[x][i] = hh ? lb[i] : la[i];
        }
        {
            unsigned w[8];
#pragma unroll
            for (int q = 0; q < 8; ++q) {
                w[q] = 0u;
#pragma unroll
                for (int b = 0; b < 4; ++b) {
                    const int i = q * 4 + b;
                    const unsigned key = __float_as_uint(i < 16 ? sv[0][i] : sv[1][i - 16]);
                    w[q] |= (127u - (key & 127u)) << (8 * b);
                }
            }
            *(LAS u32x4*)(myl) = u32x4{w[0], w[1], w[2], w[3]};
            *(LAS u32x4*)(myl + 16) = u32x4{w[4], w[5], w[6], w[7]};
        }
        float val0[16], val1[16];
#pragma unroll
        for (int i = 0; i < 16; ++i) { val0[i] = __uint_as_float(__float_as_uint(sv[0][i]) & ~127u); val1[i] = __uint_as_float(__float_as_uint(sv[1][i]) & ~127u); }
        float g0[16], g1[16], g2[16], g3[16];
#pragma unroll
        for (int b = 0; b < 16; ++b) g0[b] = key_embed(val0[0] + val1[b], 255u, 255u - (unsigned)b);
#pragma unroll
        for (int b = 0; b < 8; ++b) g1[b] = key_embed(val0[1] + val1[b], 255u, 255u - (16u + b));
#pragma unroll
        for (int b = 0; b < 5; ++b) g1[8 + b] = key_embed(val0[2] + val1[b], 255u, 255u - (32u + b));
#pragma unroll
        for (int b = 0; b < 3; ++b) g1[13 + b] = key_embed(val0[4] + val1[b], 255u, 255u - (64u + b));
#pragma unroll
        for (int b = 0; b < 4; ++b) g2[b] = key_embed(val0[3] + val1[b], 255u, 255u - (48u + b));
#pragma unroll
        for (int a = 5; a < 8; ++a)
#pragma unroll
            for (int b = 0; b < 2; ++b) g2[4 + (a - 5) * 2 + b] = key_embed(val0[a] + val1[b], 255u, 255u - (16u * a + b));
#pragma unroll
        for (int a = 8; a < 14; ++a) g2[10 + (a - 8)] = key_embed(val0[a] + val1[0], 255u, 255u - 16u * a);
        g3[0] = key_embed(val0[14] + val1[0], 255u, 255u - 16u * 14); g3[1] = key_embed(val0[15] + val1[0], 255u, 255u - 16u * 15);
#pragma unroll
        for (int i = 2; i < 16; ++i) g3[i] = -3.0e38f;
        sort16_desc(g1); sort16_desc(g2); sort16_desc(g3);
        merge_top16(g0, g1); merge_top16(g2, g3); merge_top16(g0, g2);
        float gate[16]; int eid[16];
        const float mx = __uint_as_float(__float_as_uint(g0[0]) & ~255u);
        float sum = 0.f;
#pragma unroll
        for (int i = 0; i < 16; ++i) {
            const unsigned key = __float_as_uint(g0[i]);
            gate[i] = __expf(__uint_as_float(key & ~255u) - mx); sum += gate[i];
            const unsigned id = 255u - (key & 255u);
            const unsigned n0 = *(const LAS unsigned char*)(myl + (id >> 4));
            const unsigned n1 = *(const LAS unsigned char*)(myl + 16 + (id & 15u));
            eid[i] = (int)(n0 * 128u + n1);
        }
        const float inv = 1.f / sum;
        const int h = k + 4 * hh;
        int* EI = (int*)(p.ws + OFF_EIDX) + (size_t)t * 128 + h * 16; float* EG = (float*)(p.ws + OFF_EGATE) + (size_t)t * 128 + h * 16;
#pragma unroll
        for (int q = 0; q < 4; ++q) {
            *reinterpret_cast<int4*>(EI + q * 4) = make_int4(eid[q * 4], eid[q * 4 + 1], eid[q * 4 + 2], eid[q * 4 + 3]);
            *reinterpret_cast<float4*>(EG + q * 4) = make_float4(gate[q * 4] * inv, gate[q * 4 + 1] * inv, gate[q * 4 + 2] * inv, gate[q * 4 + 3] * inv);
        }
    }
}

constexpr int LDS_BYTES = LDS_HDR + 256 * 132 * 4;
__global__ void __launch_bounds__(NT, 2) mk_fwd(Params p) {
    extern __shared__ __attribute__((aligned(16))) unsigned char lds[];
    volatile LAS unsigned* st = (volatile LAS unsigned*)lds;
    if (threadIdx.x < 4) st[threadIdx.x] = 0u;
    __syncthreads();
    XcdBarrier xb = xcd_barrier_post((unsigned*)(p.ws + OFF_BAR), st);
#define GRID_BAR() xcd_barrier(xb)
    unsigned char* ws = p.ws;
    for (int rep = 0; rep < (PROBE_DUP == 1 ? 2 : 1); ++rep) {
    for (int l = 0; l < 2; ++l) {
        ph_transpose(p.in[I_WIN] + (size_t)l * D * INW, (bf16_t*)(ws + OFF_WIN) + (size_t)l * INW * D, D, INW);
        ph_transpose(p.in[I_WOUT] + (size_t)l * D * D, (bf16_t*)(ws + OFF_WOUT) + (size_t)l * D * D, D, D);
        ph_transpose(p.in[I_WQ] + (size_t)l * D * D, (bf16_t*)(ws + OFF_WQ) + (size_t)l * D * D, D, D);
    }
    ph_convert(p.in[I_PU], (bf16_t*)(ws + OFF_UT), (size_t)2 * NEXP * D);
    ph_convert(p.in[I_PV], (bf16_t*)(ws + OFF_VT), (size_t)2 * NEXP * D);
    ph_convert(p.in[I_SUBK], (bf16_t*)(ws + OFF_SUBK), 2 * 2 * 128 * 64);
    ph_convert(p.in[I_SGUW], (bf16_t*)(ws + OFF_SGUW), 2 * 4 * 128 * 128);
    ph_mod(p);
    ph_rope_tab(p);
    GRID_BAR();
    }
    for (int l = 0; l < 2; ++l) {
        ph_norm_mod(p, l, 0, l == 0 ? 1 : 0);
        ph_cache_prep(p, l);
        GRID_BAR();
        gemm_phase<EPI_INPROJ>(p, l, (const bf16_t*)(ws + OFF_H), (const bf16_t*)(ws + OFF_WIN) + (size_t)l * INW * D, INW, lds + LDS_HDR);
        GRID_BAR();
        ph_mixers(p, l, lds + LDS_HDR);
        GRID_BAR();
        gemm_phase<EPI_WOUT>(p, l, (const bf16_t*)(ws + OFF_MIX), (const bf16_t*)(ws + OFF_WOUT) + (size_t)l * D * D, D, lds + LDS_HDR);
        GRID_BAR();
        ph_norm_mod(p, l, 1, 0);
        GRID_BAR();
        gemm_phase<EPI_WQ>(p, l, (const bf16_t*)(ws + OFF_H), (const bf16_t*)(ws + OFF_WQ) + (size_t)l * D * D, D, lds + LDS_HDR);
        GRID_BAR();
        for (int rep = 0; rep < (PROBE_DUP == 2 ? 2 : 1); ++rep) {
        ph_peer_select(p, l, lds + LDS_HDR);
        GRID_BAR();
        }
        ph_peer_apply_fast(p, l, l == 1);
        if (l == 0) GRID_BAR();
    }
}

extern "C" void kernel_launch(void* const* d_in, const int* in_sizes, int n_in,
                              void* d_out, int out_size, void* d_ws, size_t ws_size,
                              hipStream_t stream) {
    static int grid = 0;
    if (grid == 0) {
        if (ws_size < WS_NEED) { fprintf(stderr, "kernel_launch: workspace too small: %zu < %zu\n", ws_size, (size_t)WS_NEED); grid = -1; return; }
        int dev = 0, cus = 0, per_cu = 0;
        (void)hipGetDevice(&dev);
        (void)hipDeviceGetAttribute(&cus, hipDeviceAttributeMultiprocessorCount, dev);
        (void)hipFuncSetAttribute((const void*)mk_fwd, hipFuncAttributeMaxDynamicSharedMemorySize, LDS_BYTES);
        (void)hipOccupancyMaxActiveBlocksPerMultiprocessor(&per_cu, (const void*)mk_fwd, NT, LDS_BYTES);
        if (per_cu < 1) { fprintf(stderr, "kernel_launch: occupancy query reports %d blocks per CU\n", per_cu); grid = -1; return; }
        grid = cus;
    }
    if (grid < 0) return;
    (void)hipMemsetAsync((unsigned char*)d_ws + OFF_BAR, 0, 64 * 1024, stream);
    Params p{};
    for (int i = 0; i < 29; ++i) p.in[i] = (const float*)d_in[i];
    p.out = (float*)d_out; p.ws = (unsigned char*)d_ws;
    void* args[] = {&p};
    hipError_t e = hipLaunchCooperativeKernel((const void*)mk_fwd, dim3(grid), dim3(NT), args, LDS_BYTES, stream);
    if (e != hipSuccess) fprintf(stderr, "kernel_launch: cooperative launch failed: %s (grid %d)\n", hipGetErrorString(e), grid);
}
```

```cpp
#include <hip/hip_runtime.h>
#include <hip/hip_bf16.h>
#include <cstdio>
#include <cstdint>
#include <hip/hip_cooperative_groups.h>
namespace cg = cooperative_groups;

#define PROBE_DUP 0
typedef unsigned short bf16_t;
using bf16x8 = __attribute__((ext_vector_type(8))) short;
using f32x4  = __attribute__((ext_vector_type(4))) float;
using f32x16 = __attribute__((ext_vector_type(16))) float;
using f32x2  = __attribute__((ext_vector_type(2))) float;
using u32x4  = __attribute__((ext_vector_type(4))) unsigned;
using s16x4  = __attribute__((ext_vector_type(4))) short;

constexpr int D      = 1024;
constexpr int NTOK   = 16384;
constexpr int NPT    = 8192;
constexpr int SEQ    = 256;
constexpr int DSEQ   = 2048;
constexpr int PAST   = 512;
constexpr int NKS    = DSEQ + PAST;
constexpr int INW    = 2048;
constexpr int NEXP   = 16384;
constexpr float EPS  = 1e-6f;

constexpr size_t MB = 1024 * 1024;
constexpr size_t OFF_BAR   = 0;
constexpr size_t OFF_MOD   = 64 * 1024;
constexpr size_t OFF_ROPE  = OFF_MOD + 256 * 1024;
constexpr size_t OFF_SUBK  = OFF_ROPE + 1 * MB;
constexpr size_t OFF_SGUW  = OFF_SUBK + 64 * 1024;
constexpr size_t OFF_WIN   = OFF_SGUW + 256 * 1024;
constexpr size_t OFF_WOUT  = OFF_WIN + 8 * MB;
constexpr size_t OFF_WQ    = OFF_WOUT + 4 * MB;
constexpr size_t OFF_UT    = OFF_WQ + 4 * MB;
constexpr size_t OFF_USC   = OFF_UT + 32 * MB;
constexpr size_t OFF_VT    = OFF_UT + 64 * MB;
constexpr size_t OFF_VSC   = OFF_VT + 32 * MB;
constexpr size_t OFF_H     = OFF_VT + 64 * MB;
constexpr size_t OFF_XC    = OFF_H + 32 * MB;
constexpr size_t OFF_R1    = OFF_XC + 64 * MB;
constexpr size_t OFF_AU    = OFF_R1;
constexpr size_t OFF_AV    = OFF_AU + 8 * MB;
constexpr size_t OFF_AVN   = OFF_AV + 8 * MB;
constexpr size_t OFF_DQ    = OFF_AVN + 8 * MB;
constexpr size_t OFF_DKP   = OFF_DQ + 8 * MB;
constexpr size_t OFF_DKS   = OFF_DKP + 4 * MB;
constexpr size_t OFF_DVTP  = OFF_DKS + 5 * MB;
constexpr size_t OFF_DVTS  = OFF_DVTP + 4 * MB;
constexpr size_t OFF_GQ    = OFF_DVTS + 5 * MB;
constexpr size_t OFF_GKP   = OFF_GQ + 16 * MB;
constexpr size_t OFF_GKS   = OFF_GKP + 2 * MB;
constexpr size_t OFF_GVTP  = OFF_GKS + 3 * MB;
constexpr size_t OFF_GVTS  = OFF_GVTP + 2 * MB;
constexpr size_t OFF_MIX   = OFF_GVTS + 3 * MB;
constexpr size_t OFF_R1END = OFF_MIX + 32 * MB;
constexpr size_t OFF_Q     = OFF_R1;
constexpr size_t OFF_EIDX  = OFF_Q + 32 * MB;
constexpr size_t OFF_EGATE = OFF_EIDX + 8 * MB;
constexpr size_t OFF_TOPV  = OFF_EGATE + 8 * MB;
constexpr size_t OFF_TOPI  = OFF_TOPV + 16 * MB;
static_assert(OFF_TOPI + 16 * MB <= OFF_R1END, "peer buffers must fit region 1");
constexpr size_t OFF_PROJ  = OFF_R1END;
constexpr size_t WS_NEED   = OFF_PROJ + 128 * MB;
static_assert(WS_NEED <= 512 * MB, "workspace budget");

constexpr size_t OUT_YP  = 0;
constexpr size_t OUT_YS  = 8388608;
constexpr size_t OUT_NDK = 16777216;
constexpr size_t OUT_NDV = OUT_NDK + 4194304;
constexpr size_t OUT_NGK = OUT_NDV + 4194304;
constexpr size_t OUT_NGV = OUT_NGK + 2097152;

struct Params {
    const float* in[29];
    float* out;
    unsigned char* ws;
};
enum { I_XP = 0, I_XS, I_CDK, I_CDV, I_CGK, I_CGV, I_C, I_CCTX, I_ADAW, I_ADAB, I_N1G, I_N2G, I_WIN, I_SGUNG, I_SGUW, I_SGUB,
       I_LQ1, I_LK1, I_LQ2, I_LK2, I_SUBLN, I_QNG, I_KNG, I_WOUT, I_WQ, I_SUBK, I_PU, I_PV, I_FG };

__device__ __forceinline__ bf16_t f2bf(float f) {
    unsigned u = __float_as_uint(f);
    u += 0x7fffu + ((u >> 16) & 1u);
    return (bf16_t)(u >> 16);
}
__device__ __forceinline__ float bf2f(bf16_t h) { return __uint_as_float(((unsigned)h) << 16); }
__device__ __forceinline__ float gelu_f(float x) {
    const float k = 0.7978845608028654f;
    float u = k * (x + 0.044715f * x * x * x);
    return 0.5f * x * (1.f + tanhf(u));
}
__device__ __forceinline__ float wave_sum(float v) {
#pragma unroll
    for (int o = 32; o >= 1; o >>= 1) v += __shfl_xor(v, o);
    return v;
}
__device__ __forceinline__ int tok_cv(int t) { return t < NPT ? 0 : 1 + ((t - NPT) >> 11); }
__device__ __forceinline__ const float* x_in_row(const Params& p, int t) {
    return t < NPT ? p.in[I_XP] + (size_t)t * D : p.in[I_XS] + (size_t)(t - NPT) * D;
}
__device__ __forceinline__ float lam_init_of(int l) { return l == 0 ? 0.2f : (0.8f - 0.6f * 0.7408182206817179f); }
__device__ __forceinline__ float lam_of(const Params& p, int l) {
    float s1 = 0.f, s2 = 0.f;
    for (int i = 0; i < 32; ++i) {
        s1 += p.in[I_LQ1][l * 32 + i] * p.in[I_LK1][l * 32 + i];
        s2 += p.in[I_LQ2][l * 32 + i] * p.in[I_LK2][l * 32 + i];
    }
    return expf(s1) - expf(s2) + lam_init_of(l);
}


#define XB_TMO      128
#define XB_XCNT(j)  (256  + 64 * (j))
#define XB_XSUB(j)  (1280 + 64 * (j))
#define XB_XGEN(j)  (2304 + 64 * (j))
#define XB_TOP      3328
#define XB_TOPGEN   3392
#define XCD_BAR_WORDS 3456
#define XB_SPIN_CAP (1u << 20)
#define LAS __attribute__((address_space(3)))
__device__ __forceinline__ unsigned xb_ld(unsigned* p)              { return __hip_atomic_load(p, __ATOMIC_RELAXED, __HIP_MEMORY_SCOPE_AGENT); }
__device__ __forceinline__ unsigned xb_add(unsigned* p, unsigned v) { return __hip_atomic_fetch_add(p, v, __ATOMIC_RELAXED, __HIP_MEMORY_SCOPE_AGENT); }
__device__ __forceinline__ unsigned xb_xcc_id() { return (unsigned)__builtin_amdgcn_s_getreg((3 << 11) | 20) & 0xFu; }
#define XB_SPIN(cond, bar) do { unsigned _sp = 0; while (cond) { __builtin_amdgcn_s_sleep(1); \
    if ((++_sp & 255u) == 0u) { if (xb_ld(&(bar)[XB_TMO])) break; if (_sp > XB_SPIN_CAP) { atomicAdd(&(bar)[XB_TMO], 1u); break; } } } } while (0)
struct XcdBarrier { unsigned* bar; unsigned x; volatile LAS unsigned* st; };
__device__ __forceinline__ XcdBarrier xcd_barrier_post(unsigned* bar, volatile LAS unsigned* st) {
    XcdBarrier b; b.bar = bar; b.x = xb_xcc_id(); b.st = st;
    if (threadIdx.x == 0) (void)xb_add(&bar[XB_XCNT(b.x)], 1u);
    return b;
}
__device__ __forceinline__ void xcd_barrier_complete(unsigned* bar, unsigned x, unsigned& nloc, unsigned& nx) {
    const unsigned G = gridDim.x * gridDim.y * gridDim.z;
    unsigned sum, cnt, mine, sp = 0u;
    for (;;) {
        sum = 0u; cnt = 0u; mine = 0u;
#pragma unroll
        for (unsigned j = 0; j < 16; ++j) { const unsigned c = xb_ld(&bar[XB_XCNT(j)]); sum += c; cnt += (c > 0u) ? 1u : 0u; mine = (j == x) ? c : mine; }
        if (sum == G) break;
        __builtin_amdgcn_s_sleep(1);
        if ((++sp & 255u) == 0u) { if (xb_ld(&bar[XB_TMO])) break; if (sp > XB_SPIN_CAP) { atomicAdd(&bar[XB_TMO], 1u); break; } }
    }
    nloc = mine > 0u ? mine : 1u; nx = cnt > 0u ? cnt : 1u;
}
__device__ __forceinline__ void xcd_barrier(const XcdBarrier& b) {
    asm volatile("s_waitcnt vmcnt(0)" ::: "memory");
    __syncthreads();
    if (threadIdx.x == 0) {
        unsigned* bar = b.bar;
        const unsigned bx = xb_xcc_id();
        __builtin_amdgcn_s_waitcnt(0);
        unsigned nloc = b.st[0], nx = b.st[1];
        if (nloc == 0u) { xcd_barrier_complete(bar, bx, nloc, nx); b.st[0] = nloc; b.st[1] = nx; }
        const unsigned old = xb_add(&bar[XB_XSUB(bx)], 1u);
        const unsigned gen = old / nloc;
        if (old + 1u == (gen + 1u) * nloc) {
            __builtin_amdgcn_fence(__ATOMIC_RELEASE, "agent");
            asm volatile("s_waitcnt vmcnt(0)" ::: "memory");
            const unsigned og = xb_add(&bar[XB_TOP], 1u);
            const unsigned tg = og / nx;
            if (og + 1u == (tg + 1u) * nx) xb_add(&bar[XB_TOPGEN], 1u);
            else XB_SPIN(xb_ld(&bar[XB_TOPGEN]) == tg, bar);
            __builtin_amdgcn_fence(__ATOMIC_ACQUIRE, "agent");
            xb_add(&bar[XB_XGEN(bx)], 1u);
            asm volatile("s_waitcnt vmcnt(0)" ::: "memory");
        } else {
            XB_SPIN(xb_ld(&bar[XB_XGEN(bx)]) == gen, bar);
            __builtin_amdgcn_fence(__ATOMIC_ACQUIRE, "agent");
            asm volatile("s_waitcnt vmcnt(0)" ::: "memory");
        }
    }
    __syncthreads();
}

constexpr int NT = 512;
constexpr int LDS_HDR = 1024;
#define GTID ((size_t)blockIdx.x * NT + tid)
__device__ __forceinline__ int opaque_tid() { int t = threadIdx.x; asm volatile("" : "+v"(t)); return t; }
#define GNT  ((size_t)gridDim.x * NT)

__device__ void ph_transpose(const float* __restrict__ W, bf16_t* __restrict__ Wt, int K, int N) {
    const int tid = opaque_tid();
    for (size_t idx = GTID; idx < (size_t)K * N; idx += GNT) {
        int n = (int)(idx / K), k = (int)(idx % K);
        Wt[idx] = f2bf(W[(size_t)k * N + n]);
    }
}
__device__ void ph_convert(const float* __restrict__ src, bf16_t* __restrict__ dst, size_t n) {
    const int tid = opaque_tid();
    for (size_t idx = GTID; idx < n; idx += GNT) dst[idx] = f2bf(src[idx]);
}
__device__ void ph_convert_fp8_rows(const float* __restrict__ src, unsigned char* __restrict__ dst, float* __restrict__ scl, int nrows) {
    const int tid = opaque_tid();
    const int lane = tid & 63;
    const int gw = blockIdx.x * 8 + (tid >> 6), nw = gridDim.x * 8;
    for (int row = gw; row < nrows; row += nw) {
        const float* sr = src + (size_t)row * D + lane * 16;
        float v[16];
#pragma unroll
        for (int i = 0; i < 4; ++i) { const float4 f = *reinterpret_cast<const float4*>(sr + i * 4); v[i * 4] = f.x; v[i * 4 + 1] = f.y; v[i * 4 + 2] = f.z; v[i * 4 + 3] = f.w; }
        float am = 0.f;
#pragma unroll
        for (int i = 0; i < 16; ++i) am = fmaxf(am, fabsf(v[i]));
#pragma unroll
        for (int o = 32; o >= 1; o >>= 1) am = fmaxf(am, __shfl_xor(am, o));
        const float sc = am > 0.f ? 224.f / am : 1.f;
        unsigned w[4];
#pragma unroll
        for (int i = 0; i < 4; ++i) {
            int pk = 0;
            pk = __builtin_amdgcn_cvt_pk_fp8_f32(v[i * 4] * sc, v[i * 4 + 1] * sc, pk, false);
            pk = __builtin_amdgcn_cvt_pk_fp8_f32(v[i * 4 + 2] * sc, v[i * 4 + 3] * sc, pk, true);
            w[i] = (unsigned)pk;
        }
        *reinterpret_cast<u32x4*>(dst + (size_t)row * D + lane * 16) = u32x4{w[0], w[1], w[2], w[3]};
        if (lane == 0) scl[row] = am > 0.f ? am * (1.f / 224.f) : 1.f;
    }
}
__device__ void ph_mod(const Params& p) {
    const int tid = opaque_tid();
    for (size_t idx = GTID; idx < 2 * 5 * 6144; idx += GNT) {
        int j = idx % 6144, cv = (idx / 6144) % 5, l = idx / (6144 * 5);
        const float* cvec = cv == 0 ? p.in[I_CCTX] : p.in[I_C] + (size_t)(cv - 1) * D;
        const float* W = p.in[I_ADAW] + (size_t)l * D * 6144;
        float acc = 0.f;
        for (int k = 0; k < D; ++k) {
            float c = cvec[k];
            float s = c / (1.f + expf(-c));
            acc += s * W[(size_t)k * 6144 + j];
        }
        ((float*)(p.ws + OFF_MOD))[idx] = acc + p.in[I_ADAB][l * 6144 + j];
    }
}
__device__ void ph_rope_tab(const Params& p) {
    const int tid = opaque_tid();
    for (size_t idx = GTID; idx < 2048 * 48; idx += GNT) {
        int s = idx / 48, i = idx % 48;
        float* R = (float*)(p.ws + OFF_ROPE);
        double row = (double)(s / 64), col = (double)(s % 64);
        if (i < 16) {
            int q = i & 7; double inv = pow(10000.0, -(double)q / 8.0);
            double ang = (i < 8 ? row : col) * inv;
            R[s * 16 + i] = (float)cos(ang); R[2048 * 16 + s * 16 + i] = (float)sin(ang);
        } else {
            int ii = i - 16; int q = ii & 15; double inv = pow(10000.0, -(double)q / 16.0);
            double ang = (ii < 16 ? row : col) * inv;
            R[2048 * 32 + s * 32 + ii] = (float)cos(ang); R[2048 * 64 + s * 32 + ii] = (float)sin(ang);
        }
    }
}
__device__ void ph_cache_prep(const Params& p, int l) {
    const int tid = opaque_tid();
    bf16_t* DKS = (bf16_t*)(p.ws + OFF_DKS); bf16_t* DVTS = (bf16_t*)(p.ws + OFF_DVTS);
    bf16_t* GKS = (bf16_t*)(p.ws + OFF_GKS); bf16_t* GVTS = (bf16_t*)(p.ws + OFF_GVTS);
    for (size_t idx = GTID; idx < 4 * 512 * 256; idx += GNT) {
        int c = idx & 255, pp = (idx >> 8) & 511, b = idx >> 17;
        size_t src = (((size_t)b * 2 + l) * PAST + pp) * 256 + c;
        int h = c >> 6, r = c & 63;
        DKS[(((size_t)b * 4 + h) * NKS + DSEQ + pp) * 64 + r] = f2bf(p.in[I_CDK][src]);
        DVTS[(((size_t)b * 4 + h) * 64 + r) * NKS + DSEQ + pp] = f2bf(p.in[I_CDV][src]);
        if (c < 128) {
            size_t src2 = (((size_t)b * 2 + l) * PAST + pp) * 128 + c;
            int kv = c >> 6;
            GKS[(((size_t)b * 2 + kv) * NKS + DSEQ + pp) * 64 + r] = f2bf(p.in[I_CGK][src2]);
            GVTS[(((size_t)b * 2 + kv) * 64 + r) * NKS + DSEQ + pp] = f2bf(p.in[I_CGV][src2]);
        }
    }
}
__device__ void ph_norm_mod(const Params& p, int l, int which, int from_input) {
    const int tid = opaque_tid();
    const int lane = tid & 63;
    const int gw = blockIdx.x * 8 + (tid >> 6), nw = gridDim.x * 8;
    const float* g = p.in[which ? I_N2G : I_N1G] + l * D;
    for (int t = gw; t < NTOK; t += nw) {
        const float* xr = from_input ? x_in_row(p, t) : (const float*)(p.ws + OFF_XC) + (size_t)t * D;
        const float* mod = (const float*)(p.ws + OFF_MOD) + (size_t)(l * 5 + tok_cv(t)) * 6144 + which * 3072;
        float4 v[4]; float ss = 0.f;
#pragma unroll
        for (int i = 0; i < 4; ++i) { v[i] = *reinterpret_cast<const float4*>(xr + i * 256 + lane * 4); ss += v[i].x * v[i].x + v[i].y * v[i].y + v[i].z * v[i].z + v[i].w * v[i].w; }
        ss = wave_sum(ss);
        float r = rsqrtf(ss / D + EPS);
        bf16_t* H = (bf16_t*)(p.ws + OFF_H) + (size_t)t * D;
#pragma unroll
        for (int i = 0; i < 4; ++i) {
            int c = i * 256 + lane * 4;
            float4 gg = *reinterpret_cast<const float4*>(g + c), sh = *reinterpret_cast<const float4*>(mod + c), sc = *reinterpret_cast<const float4*>(mod + 1024 + c);
            ushort4 o;
            o.x = f2bf(v[i].x * r * gg.x * (1.f + sc.x) + sh.x); o.y = f2bf(v[i].y * r * gg.y * (1.f + sc.y) + sh.y);
            o.z = f2bf(v[i].z * r * gg.z * (1.f + sc.z) + sh.z); o.w = f2bf(v[i].w * r * gg.w * (1.f + sc.w) + sh.w);
            *reinterpret_cast<ushort4*>(H + c) = o;
        }
    }
}
__device__ void ph_sgu_norm(const Params& p, int l) {
    const int tid = opaque_tid();
    const int lane = tid & 63;
    const int gw = blockIdx.x * 8 + (tid >> 6), nw = gridDim.x * 8;
    for (int t = gw; t < NTOK; t += nw) {
        const bf16_t* AV = (const bf16_t*)(p.ws + OFF_AV) + (size_t)t * 256;
        float v[4]; float ss = 0.f;
#pragma unroll
        for (int i = 0; i < 4; ++i) { v[i] = bf2f(AV[i * 64 + lane]); ss += v[i] * v[i]; }
        ss = wave_sum(ss);
        float r = rsqrtf(ss / 256.f + EPS);
#pragma unroll
        for (int i = 0; i < 4; ++i) ((bf16_t*)(p.ws + OFF_AVN))[(size_t)t * 256 + i * 64 + lane] = f2bf(v[i] * r * p.in[I_SGUNG][l * 256 + i * 64 + lane]);
    }
}
__device__ void ph_sgu_mix(const Params& p, int l) {
    const int tid = opaque_tid();
    const bf16_t* AVN = (const bf16_t*)(p.ws + OFF_AVN);
    for (size_t idx = GTID; idx < (size_t)NTOK * 256; idx += GNT) {
        int t = (int)(idx >> 8), c = (int)(idx & 255);
        int t0 = t & ~127, pp = t & 127, g = c >> 6;
        const bf16_t* W = (const bf16_t*)(p.ws + OFF_SGUW) + (((size_t)l * 4 + g) * 128 + pp) * 128;
        float acc = 0.f;
        for (int q = 0; q < 128; ++q) acc += bf2f(W[q]) * bf2f(AVN[(size_t)(t0 + q) * 256 + c]);
        acc += p.in[I_SGUB][(l * 4 + g) * 128 + pp];
        float au = bf2f(((const bf16_t*)(p.ws + OFF_AU))[(size_t)t * 256 + c]);
        ((bf16_t*)(p.ws + OFF_MIX))[(size_t)t * D + c] = f2bf(au * acc);
    }
}
__device__ void ph_attn_ref(const Params& p, int l) {
    const int tid = opaque_tid();
    const int lane = tid & 63;
    const int gw = blockIdx.x * 8 + (tid >> 6), nw = gridDim.x * 8;
    const float lam = lam_of(p, l);
    for (int item = gw; item < NTOK * 12; item += nw) {
        const int t = item % NTOK, hh = item / NTOK;
        const bool prompt = t < NPT;
        const int b = prompt ? t / SEQ : (t - NPT) / DSEQ;
        const int nk = prompt ? SEQ : NKS;
        if (hh < 4) {
            const int h = hh;
            const bf16_t* K = prompt ? (const bf16_t*)(p.ws + OFF_DKP) + ((size_t)b * 4 + h) * SEQ * 64 : (const bf16_t*)(p.ws + OFF_DKS) + ((size_t)b * 4 + h) * NKS * 64;
            const bf16_t* Vt = prompt ? (const bf16_t*)(p.ws + OFF_DVTP) + ((size_t)b * 4 + h) * 64 * SEQ : (const bf16_t*)(p.ws + OFF_DVTS) + ((size_t)b * 4 + h) * 64 * NKS;
            float q = bf2f(((const bf16_t*)(p.ws + OFF_DQ))[(size_t)t * 256 + h * 64 + lane]);
            const float scale = 0.17677669529663687f;
            float m0 = -1e30f, m1 = -1e30f, l0 = 0.f, l1 = 0.f, a0 = 0.f, a1 = 0.f;
            for (int k = 0; k < nk; ++k) {
                float pr = q * bf2f(K[(size_t)k * 64 + lane]);
#pragma unroll
                for (int o = 16; o >= 1; o >>= 1) pr += __shfl_xor(pr, o);
                float s0 = __shfl(pr, 0) * scale, s1 = __shfl(pr, 32) * scale;
                float v = bf2f(Vt[(size_t)lane * nk + k]);
                float mn0 = fmaxf(m0, s0), mn1 = fmaxf(m1, s1);
                float c0 = expf(m0 - mn0), c1 = expf(m1 - mn1);
                float e0 = expf(s0 - mn0), e1 = expf(s1 - mn1);
                l0 = l0 * c0 + e0; l1 = l1 * c1 + e1;
                a0 = a0 * c0 + e0 * v; a1 = a1 * c1 + e1 * v;
                m0 = mn0; m1 = mn1;
            }
            float o = a0 / l0 - lam * a1 / l1;
            float ss = wave_sum(o * o);
            float r = rsqrtf(ss / 64.f + EPS);
            o = o * r * p.in[I_SUBLN][l * 64 + lane] * (1.f - lam_init_of(l));
            ((bf16_t*)(p.ws + OFF_MIX))[(size_t)t * D + 256 + h * 64 + lane] = f2bf(o);
        } else {
            const int hq = hh - 4, kv = hq >> 2;
            const bf16_t* K = prompt ? (const bf16_t*)(p.ws + OFF_GKP) + ((size_t)b * 2 + kv) * SEQ * 64 : (const bf16_t*)(p.ws + OFF_GKS) + ((size_t)b * 2 + kv) * NKS * 64;
            const bf16_t* Vt = prompt ? (const bf16_t*)(p.ws + OFF_GVTP) + ((size_t)b * 2 + kv) * 64 * SEQ : (const bf16_t*)(p.ws + OFF_GVTS) + ((size_t)b * 2 + kv) * 64 * NKS;
            float q = bf2f(((const bf16_t*)(p.ws + OFF_GQ))[(size_t)t * 512 + hq * 64 + lane]);
            float m = -1e30f, ls = 0.f, a = 0.f;
            for (int k = 0; k < nk; ++k) {
                float s = wave_sum(q * bf2f(K[(size_t)k * 64 + lane])) * 0.125f;
                float v = bf2f(Vt[(size_t)lane * nk + k]);
                float mn = fmaxf(m, s);
                float c = expf(m - mn), e = expf(s - mn);
                ls = ls * c + e; a = a * c + e * v; m = mn;
            }
            ((bf16_t*)(p.ws + OFF_MIX))[(size_t)t * D + 512 + hq * 64 + lane] = f2bf(a / ls);
        }
    }
}
__device__ void ph_peer_scores(const Params& p, int l) {
    const int tid = opaque_tid();
    const bf16_t* SK = (const bf16_t*)(p.ws + OFF_SUBK) + (size_t)l * 2 * 128 * 64;
    for (size_t idx = GTID; idx < (size_t)NTOK * 2048; idx += GNT) {
        int t = (int)(idx >> 11), o = (int)(idx & 2047);
        const bf16_t* Q = (const bf16_t*)(p.ws + OFF_Q) + (size_t)t * D;
        int n = o & 127, x = (o >> 7) & 1, h = o >> 8;
        float acc = 0.f;
        for (int k = 0; k < 64; ++k) acc += bf2f(Q[h * 128 + x * 64 + k]) * bf2f(SK[((size_t)x * 128 + n) * 64 + k]);
        ((float*)(p.ws + OFF_PROJ))[idx] = acc;
    }
}
__device__ void ph_peer_top1(const Params& p) {
    const int tid = opaque_tid();
    for (size_t idx = GTID; idx < (size_t)NTOK * 16; idx += GNT) {
        const float* SC = (const float*)(p.ws + OFF_PROJ) + idx * 128;
        float* TV = (float*)(p.ws + OFF_TOPV) + idx * 16; int* TI = (int*)(p.ws + OFF_TOPI) + idx * 16;
        float pv = 3.0e38f; int pi = -1;
        for (int r = 0; r < 16; ++r) {
            float bv = -3.0e38f; int bi = -1;
            for (int n = 0; n < 128; ++n) {
                float v = SC[n];
                bool after = (v < pv) || (v == pv && n > pi);
                if (after && (bi < 0 || v > bv)) { bv = v; bi = n; }
            }
            TV[r] = bv; TI[r] = bi; pv = bv; pi = bi;
        }
    }
}
__device__ void ph_peer_top2(const Params& p) {
    const int tid = opaque_tid();
    for (size_t idx = GTID; idx < (size_t)NTOK * 8; idx += GNT) {
        const float* TV = (const float*)(p.ws + OFF_TOPV) + idx * 32; const int* TI = (const int*)(p.ws + OFF_TOPI) + idx * 32;
        int* EI = (int*)(p.ws + OFF_EIDX) + idx * 16; float* EG = (float*)(p.ws + OFF_EGATE) + idx * 16;
        float pv = 3.0e38f; int pi = -1; float mx = 0.f, sum = 0.f;
        for (int r = 0; r < 16; ++r) {
            float bv = -3.0e38f; int bi = -1;
            for (int n = 0; n < 256; ++n) {
                float v = TV[n >> 4] + TV[16 + (n & 15)];
                bool after = (v < pv) || (v == pv && n > pi);
                if (after && (bi < 0 || v > bv)) { bv = v; bi = n; }
            }
            if (r == 0) mx = bv;
            float e = expf(bv - mx);
            sum += e;
            EG[r] = e; EI[r] = TI[bi >> 4] * 128 + TI[16 + (bi & 15)];
            pv = bv; pi = bi;
        }
        float inv = 1.f / sum;
        for (int r = 0; r < 16; ++r) EG[r] *= inv;
    }
}
__device__ void ph_peer_apply(const Params& p, int l, unsigned char* lds) {
    const int tid = opaque_tid();
    const int sub = tid >> 8, tl = tid & 255;
    const int wave = tl >> 6, lane = tl & 63;
    float* wts = (float*)(lds + 64) + sub * 128; int* eid = (int*)(lds + 64 + 1024) + sub * 128;
    const bf16_t* UT = (const bf16_t*)(p.ws + OFF_UT) + (size_t)l * NEXP * D;
    const bf16_t* VT = (const bf16_t*)(p.ws + OFF_VT) + (size_t)l * NEXP * D;
    const int niter = (NTOK + gridDim.x * 2 - 1) / (gridDim.x * 2);
    for (int it = 0; it < niter; ++it) {
        int t = (it * gridDim.x + blockIdx.x) * 2 + sub;
        const bool valid = t < NTOK; if (!valid) t = NTOK - 1;
        const bf16_t* H = (const bf16_t*)(p.ws + OFF_H) + (size_t)t * D;
        const int* EI = (const int*)(p.ws + OFF_EIDX) + (size_t)t * 128; const float* EG = (const float*)(p.ws + OFF_EGATE) + (size_t)t * 128;
        float hv[16];
#pragma unroll
        for (int i = 0; i < 16; ++i) hv[i] = bf2f(H[lane * 16 + i]);
        for (int jj = 0; jj < 32; ++jj) {
            int j = wave * 32 + jj; int e = EI[j];
            const bf16_t* ur = UT + (size_t)e * D + lane * 16;
            float acc = 0.f;
#pragma unroll
            for (int i = 0; i < 16; ++i) acc += hv[i] * bf2f(ur[i]);
            acc = wave_sum(acc);
            if (lane == 0) { wts[j] = EG[j] * gelu_f(acc); eid[j] = e; }
        }
        __syncthreads();
        float o[4] = {0.f, 0.f, 0.f, 0.f};
        for (int j = 0; j < 128; ++j) {
            const bf16_t* vr = VT + (size_t)eid[j] * D + tl * 4; float w = wts[j];
#pragma unroll
            for (int i = 0; i < 4; ++i) o[i] += w * bf2f(vr[i]);
        }
        const float* mod = (const float*)(p.ws + OFF_MOD) + (size_t)(l * 5 + tok_cv(t)) * 6144 + 5 * 1024;
        float* XC = (float*)(p.ws + OFF_XC) + (size_t)t * D;
        if (valid) {
#pragma unroll
            for (int i = 0; i < 4; ++i) { int c = tl * 4 + i; XC[c] += mod[c] * o[i]; }
        }
        __syncthreads();
    }
}
__device__ void ph_final_norm(const Params& p) {
    const int tid = opaque_tid();
    const int lane = tid & 63;
    const int gw = blockIdx.x * 8 + (tid >> 6), nw = gridDim.x * 8;
    for (int t = gw; t < NTOK; t += nw) {
        const float* xr = (const float*)(p.ws + OFF_XC) + (size_t)t * D;
        float4 v[4]; float ss = 0.f;
#pragma unroll
        for (int i = 0; i < 4; ++i) { v[i] = *reinterpret_cast<const float4*>(xr + i * 256 + lane * 4); ss += v[i].x * v[i].x + v[i].y * v[i].y + v[i].z * v[i].z + v[i].w * v[i].w; }
        ss = wave_sum(ss);
        float r = rsqrtf(ss / D + EPS);
        float* y = p.out + (size_t)t * D;
#pragma unroll
        for (int i = 0; i < 4; ++i) {
            int c = i * 256 + lane * 4;
            float4 g = *reinterpret_cast<const float4*>(p.in[I_FG] + c);
            float4 o; o.x = v[i].x * r * g.x; o.y = v[i].y * r * g.y; o.z = v[i].z * r * g.z; o.w = v[i].w * r * g.w;
            *reinterpret_cast<float4*>(y + c) = o;
        }
    }
}


namespace g8 {
constexpr int BM = 256, BK = 64, HALF = 128, HT = HALF * BK;
__device__ __forceinline__ int lds_byte(int r, int c) {
    int st = (r >> 4) * 2 + (c >> 5), rr = r & 15, cc = c & 31, ob = rr * 64 + cc * 2;
    return st * 1024 + (ob ^ (((ob >> 9) & 1) << 5));
}
__device__ __forceinline__ void stage_rc(int b, int& R, int& C) {
    int st = b / 1024, sb = b % 1024, swz = sb ^ (((sb >> 9) & 1) << 5);
    R = (st >> 1) * 16 + swz / 64; C = (st & 1) * 32 + (swz % 64) / 2;
}
}
enum { EPI_INPROJ = 0, EPI_WOUT = 1, EPI_WQ = 2 };
constexpr int STG = 132;

__device__ __forceinline__ unsigned pack_bf2(float a, float b) { return (unsigned)f2bf(a) | ((unsigned)f2bf(b) << 16); }
__device__ __forceinline__ void store_bf16x32(bf16_t* dst, const float (&v)[32]) {
#pragma unroll
    for (int i = 0; i < 4; ++i) {
        uint4 u;
        u.x = pack_bf2(v[i * 8 + 0], v[i * 8 + 1]); u.y = pack_bf2(v[i * 8 + 2], v[i * 8 + 3]);
        u.z = pack_bf2(v[i * 8 + 4], v[i * 8 + 5]); u.w = pack_bf2(v[i * 8 + 6], v[i * 8 + 7]);
        *reinterpret_cast<uint4*>(dst + i * 8) = u;
    }
}
__device__ __forceinline__ void store_f32x32(float* dst, const float (&v)[32]) {
#pragma unroll
    for (int i = 0; i < 8; ++i) *reinterpret_cast<float4*>(dst + i * 4) = make_float4(v[i * 4], v[i * 4 + 1], v[i * 4 + 2], v[i * 4 + 3]);
}

__device__ __forceinline__ void epi_inproj_row(const Params& p, int l, int t, int c0, float (&v)[32]) {
    const bool prompt = t < NPT;
    const int b = prompt ? (t >> 8) : ((t - NPT) >> 11);
    const int s = prompt ? (t & 255) : ((t - NPT) & 2047);
    unsigned char* ws = p.ws;
    const float* R = (const float*)(ws + OFF_ROPE);
    if (c0 < 512) {
        bf16_t* dst = (bf16_t*)(ws + (c0 < 256 ? OFF_AU : OFF_AV)) + (size_t)t * 256 + (c0 & 255);
#pragma unroll
        for (int i = 0; i < 32; ++i) v[i] = gelu_f(v[i]);
        store_bf16x32(dst, v);
    } else if (c0 < 1024) {
        const bool isq = c0 < 768;
        if (!isq && prompt) store_f32x32(p.out + OUT_NDK + (((size_t)b * 2 + l) * SEQ + s) * 256 + (c0 - 768), v);
        if (!prompt) {
            const float* cs = R + s * 16; const float* sn = R + 2048 * 16 + s * 16;
#pragma unroll
            for (int i = 0; i < 16; ++i) {
                float c = cs[i], sv = sn[i], x1 = v[i], x2 = v[i + 16];
                v[i] = x1 * c - x2 * sv; v[i + 16] = x2 * c + x1 * sv;
            }
        }
        bf16_t* dst;
        if (isq) dst = (bf16_t*)(ws + OFF_DQ) + (size_t)t * 256 + (c0 - 512);
        else {
            const int cc = c0 - 768, h = cc >> 6, r = cc & 63;
            dst = prompt ? (bf16_t*)(ws + OFF_DKP) + (((size_t)b * 4 + h) * SEQ + s) * 64 + r
                         : (bf16_t*)(ws + OFF_DKS) + (((size_t)b * 4 + h) * NKS + s) * 64 + r;
        }
        store_bf16x32(dst, v);
    } else if (c0 < 1280) {
        if (prompt) store_f32x32(p.out + OUT_NDV + (((size_t)b * 2 + l) * SEQ + s) * 256 + (c0 - 1024), v);
    } else if (c0 < 1920) {
        const bool isq = c0 < 1792;
        const int hi = c0 & 32;
        const float* g = p.in[isq ? I_QNG : I_KNG] + l * 64 + hi;
        float ss = 0.f;
#pragma unroll
        for (int i = 0; i < 32; ++i) ss += v[i] * v[i];
        ss += __shfl_xor(ss, 1);
        const float rr = rsqrtf(ss * (1.f / 64.f) + EPS);
#pragma unroll
        for (int i = 0; i < 32; ++i) v[i] = v[i] * rr * g[i];
        if (!isq && prompt) store_f32x32(p.out + OUT_NGK + (((size_t)b * 2 + l) * SEQ + s) * 128 + (c0 - 1792), v);
        if (!prompt) {
            const float* cs = R + 2048 * 32 + s * 32; const float* sn = R + 2048 * 64 + s * 32;
#pragma unroll
            for (int i = 0; i < 32; ++i) {
                float pv = __shfl_xor(v[i], 1);
                float c = cs[i], sv = sn[i];
                v[i] = hi ? (v[i] * c + pv * sv) : (v[i] * c - pv * sv);
            }
        }
        bf16_t* dst;
        if (isq) dst = (bf16_t*)(ws + OFF_GQ) + (size_t)t * 512 + (c0 - 1280);
        else {
            const int cc = c0 - 1792, kv = cc >> 6, r = cc & 63;
            dst = prompt ? (bf16_t*)(ws + OFF_GKP) + (((size_t)b * 2 + kv) * SEQ + s) * 64 + r
                         : (bf16_t*)(ws + OFF_GKS) + (((size_t)b * 2 + kv) * NKS + s) * 64 + r;
        }
        store_bf16x32(dst, v);
    } else {
        if (prompt) store_f32x32(p.out + OUT_NGV + (((size_t)b * 2 + l) * SEQ + s) * 128 + (c0 - 1920), v);
    }
}
__device__ __forceinline__ void epi_inproj_col(const Params& p, int t0, int c, const LAS float* stc) {
    float v[32];
#pragma unroll
    for (int i = 0; i < 32; ++i) v[i] = stc[i * STG];
    const bool prompt = t0 < NPT;
    const int b = prompt ? (t0 >> 8) : ((t0 - NPT) >> 11);
    const int s = prompt ? (t0 & 255) : ((t0 - NPT) & 2047);
    unsigned char* ws = p.ws;
    bf16_t* dst;
    if (c < 1280) {
        const int cc = c - 1024, h = cc >> 6, d = cc & 63;
        dst = prompt ? (bf16_t*)(ws + OFF_DVTP) + (((size_t)b * 4 + h) * 64 + d) * SEQ + s
                     : (bf16_t*)(ws + OFF_DVTS) + (((size_t)b * 4 + h) * 64 + d) * NKS + s;
    } else {
        const int cc = c - 1920, kv = cc >> 6, d = cc & 63;
        dst = prompt ? (bf16_t*)(ws + OFF_GVTP) + (((size_t)b * 2 + kv) * 64 + d) * SEQ + s
                     : (bf16_t*)(ws + OFF_GVTS) + (((size_t)b * 2 + kv) * 64 + d) * NKS + s;
    }
    store_bf16x32(dst, v);
}

template <int MODE>
__device__ __forceinline__ void gemm_phase(const Params& p, int l, const bf16_t* __restrict__ A, const bf16_t* __restrict__ Bt, const int N, unsigned char* ldsraw) {
    using namespace g8;
    constexpr int K = 1024, nt = K / BK, BN = 128, TILE_A = BM * BK * 2, TILE_B = BN * BK * 2, STAGE_B = TILE_A + TILE_B;
    LAS unsigned char* lds = (LAS unsigned char*)ldsraw;
    int tid_ = threadIdx.x; asm volatile("" : "+v"(tid_));
    const int tid = tid_, wid = __builtin_amdgcn_readfirstlane(tid >> 6), lane = tid & 63;
    const int wr = wid >> 1, wc = wid & 1, fr = lane & 15, fq = lane >> 4;
    unsigned voff[4];
#pragma unroll
    for (int i = 0; i < 4; ++i) { int R, C; stage_rc(wid * 1024 + i * 8192 + lane * 16, R, C); voff[i] = (unsigned)(R * K + C) * 2u; }
    const int aoff = lds_byte(wr * 64 + fr, fq * 8), boff = lds_byte(wc * 64 + fr, fq * 8);
    const unsigned ldsw = (unsigned)wid * 1024u;
#define G8_STAGE(buf, kt) do { \
        _Pragma("unroll") for (int _i = 0; _i < 4; ++_i) \
            __builtin_amdgcn_global_load_lds((const unsigned*)((const char*)(Ab + (kt) * BK) + voff[_i]), (LAS unsigned*)(lds + (buf) * STAGE_B + ldsw + _i * 8192), 16, 0, 0); \
        _Pragma("unroll") for (int _i = 0; _i < 2; ++_i) \
            __builtin_amdgcn_global_load_lds((const unsigned*)((const char*)(Bb + (kt) * BK) + voff[_i]), (LAS unsigned*)(lds + (buf) * STAGE_B + TILE_A + ldsw + _i * 8192), 16, 0, 0); } while (0)
#define G8_WAIT_V0() asm volatile("s_waitcnt vmcnt(0)" ::: "memory")
    const int nN = N / BN, nM = NTOK / BM, ntiles = nM * nN;
    const int G = gridDim.x;
    const int vb = (G % 8 == 0) ? (int)(blockIdx.x % 8) * (G / 8) + (int)(blockIdx.x / 8) : (int)blockIdx.x;
    const int tpb = (ntiles + G - 1) / G;
    for (int ti = 0; ti < tpb; ++ti) {
        const int tile = vb * tpb + ti;
        if (tile >= ntiles) break;
        const int pm = tile / nN, pn = tile % nN, brow = pm * BM, bcol = pn * BN;
        const bf16_t* Ab = A + (size_t)brow * K; const bf16_t* Bb = Bt + (size_t)bcol * K;
        f32x4 acc[4][4];
#pragma unroll
        for (int m = 0; m < 4; ++m)
#pragma unroll
            for (int n = 0; n < 4; ++n) acc[m][n] = f32x4{0.f, 0.f, 0.f, 0.f};
        G8_WAIT_V0();
        G8_STAGE(0, 0); G8_WAIT_V0(); __syncthreads();
        for (int t = 0; t < nt; ++t) {
            const int cur = t & 1;
            if (t + 1 < nt) G8_STAGE(cur ^ 1, t + 1);
#pragma unroll
            for (int ks = 0; ks < 2; ++ks) {
                bf16x8 At[4], Bf[4];
#pragma unroll
                for (int m = 0; m < 4; ++m) At[m] = *(const LAS bf16x8*)(lds + cur * STAGE_B + aoff + m * 2048 + ks * 1024);
#pragma unroll
                for (int n = 0; n < 4; ++n) Bf[n] = *(const LAS bf16x8*)(lds + cur * STAGE_B + TILE_A + boff + n * 2048 + ks * 1024);
#pragma unroll
                for (int m = 0; m < 4; ++m)
#pragma unroll
                    for (int n = 0; n < 4; ++n) acc[m][n] = __builtin_amdgcn_mfma_f32_16x16x32_bf16(At[m], Bf[n], acc[m][n], 0, 0, 0);
            }
            G8_WAIT_V0(); __syncthreads();
        }
        LAS float* st = (LAS float*)lds;
#pragma unroll
        for (int m = 0; m < 4; ++m)
#pragma unroll
            for (int n = 0; n < 4; ++n)
#pragma unroll
                for (int j = 0; j < 4; ++j)
                    st[(wr * 64 + m * 16 + fq * 4 + j) * STG + wc * 64 + n * 16 + fr] = acc[m][n][j];
        __syncthreads();
#pragma unroll 1
        for (int it = 0; it < 2; ++it) {
            const int item = it * NT + tid, erow = item >> 2, eseg = item & 3;
            const int t = brow + erow, c0 = bcol + eseg * 32;
            float v[32];
#pragma unroll
            for (int i = 0; i < 8; ++i) {
                const f32x4 f = *(const LAS f32x4*)(st + erow * STG + eseg * 32 + i * 4);
                v[i * 4] = f[0]; v[i * 4 + 1] = f[1]; v[i * 4 + 2] = f[2]; v[i * 4 + 3] = f[3];
            }
            if (MODE == EPI_INPROJ) {
                epi_inproj_row(p, l, t, c0, v);
            } else if (MODE == EPI_WOUT) {
                const float* xr = (l == 0 ? x_in_row(p, t) : (const float*)(p.ws + OFF_XC) + (size_t)t * D) + c0;
                const float* g1 = (const float*)(p.ws + OFF_MOD) + (size_t)(l * 5 + tok_cv(t)) * 6144 + 2048 + c0;
                float* xo = (float*)(p.ws + OFF_XC) + (size_t)t * D + c0;
#pragma unroll
                for (int i = 0; i < 8; ++i) {
                    const float4 x = *reinterpret_cast<const float4*>(xr + i * 4), g = *reinterpret_cast<const float4*>(g1 + i * 4);
                    *reinterpret_cast<float4*>(xo + i * 4) = make_float4(x.x + g.x * v[i * 4], x.y + g.y * v[i * 4 + 1], x.z + g.z * v[i * 4 + 2], x.w + g.w * v[i * 4 + 3]);
                }
            } else {
                store_bf16x32((bf16_t*)(p.ws + OFF_Q) + (size_t)t * D + c0, v);
            }
        }
        if (MODE == EPI_INPROJ && ((bcol >= 1024 && bcol < 1280) || bcol >= 1920)) {
#pragma unroll 1
            for (int it = 0; it < 2; ++it) {
                const int item = it * NT + tid, col = item >> 3, run = item & 7;
                epi_inproj_col(p, brow + run * 32, bcol + col, st + run * 32 * STG + col);
            }
        }
        __syncthreads();
    }
}


#define MFMA32(a, b, c) __builtin_amdgcn_mfma_f32_32x32x16_bf16((a), (b), (c), 0, 0, 0)
constexpr int ATT_ROWB = 144;
constexpr int ATT_TILEB = 64 * ATT_ROWB;
constexpr int QW_MIX = 4096;

__device__ __forceinline__ bf16x8 pack8(const f32x16& x, int s) {
    bf16x8 r;
#pragma unroll
    for (int j = 0; j < 8; ++j) r[j] = (short)f2bf(x[8 * s + j]);
    return r;
}
__device__ __forceinline__ void softmax_tile(f32x16& s0, f32x16& s1, const float sc, float& m, float& l, float& alpha) {
    float mx = fmaxf(s0[0], s1[0]);
#pragma unroll
    for (int i = 1; i < 16; ++i) mx = fmaxf(mx, fmaxf(s0[i], s1[i]));
    mx = fmaxf(mx, __shfl_xor(mx, 32));
    const float mnew = fmaxf(m, mx * sc);
    alpha = __builtin_amdgcn_exp2f(m - mnew);
    m = mnew;
    float ps = 0.f;
#pragma unroll
    for (int i = 0; i < 16; ++i) { s0[i] = __builtin_amdgcn_exp2f(s0[i] * sc - mnew); s1[i] = __builtin_amdgcn_exp2f(s1[i] * sc - mnew); ps += s0[i] + s1[i]; }
    l = l * alpha + ps;
}
__device__ __forceinline__ void pv_tile(const LAS unsigned char* vb, const f32x16& p0, const f32x16& p1, f32x16 (&O)[2], int r, int hh) {
#pragma unroll
    for (int u = 0; u < 2; ++u)
#pragma unroll
        for (int sk = 0; sk < 2; ++sk) {
            const bf16x8 pf = pack8(u ? p1 : p0, sk);
#pragma unroll
            for (int mt = 0; mt < 2; ++mt) {
                const LAS unsigned char* a = vb + (32 * mt + r) * ATT_ROWB + (32 * u + 16 * sk + 4 * hh) * 2;
                const s16x4 lo = *(const LAS s16x4*)a, hi = *(const LAS s16x4*)(a + 16);
                const bf16x8 af = {lo[0], lo[1], lo[2], lo[3], hi[0], hi[1], hi[2], hi[3]};
                O[mt] = MFMA32(af, pf, O[mt]);
            }
        }
}

template <bool DIFF>
__device__ __forceinline__ void attn_item(const Params& p, int l, LAS unsigned char* lds, const int tid,
                                          const bf16_t* __restrict__ Qg, const int qstride,
                                          const bf16_t* __restrict__ Kg, const bf16_t* __restrict__ Vtg, const int nk,
                                          bf16_t* __restrict__ Og, const float lam) {
    const int wave = tid >> 6, lane = tid & 63, r = lane & 31, hh = lane >> 5;
    const int lrow = tid >> 3, lchunk = tid & 7;
    LAS unsigned char* kbuf = lds; LAS unsigned char* vbuf = lds + 2 * ATT_TILEB;
    bf16x8 qf[4];
    const bf16_t* qrow = Qg + (size_t)(wave * 32 + r) * qstride;
#pragma unroll
    for (int ks = 0; ks < 4; ++ks) qf[ks] = *reinterpret_cast<const bf16x8*>(qrow + ks * 16 + hh * 8);
    const float sc = (DIFF ? 0.17677669529663687f : 0.125f) * 1.4426950408889634f;
    f32x16 O0[2], O1[2];
#pragma unroll
    for (int mt = 0; mt < 2; ++mt)
#pragma unroll
        for (int i = 0; i < 16; ++i) { O0[mt][i] = 0.f; O1[mt][i] = 0.f; }
    float m0 = -1e30f, l0 = 0.f, m1 = -1e30f, l1 = 0.f;
    const int ntl = nk / 64;
    u32x4 kr, vr;
    kr = *reinterpret_cast<const u32x4*>(Kg + (size_t)lrow * 64 + lchunk * 8);
    vr = *reinterpret_cast<const u32x4*>(Vtg + (size_t)lrow * nk + lchunk * 8);
    *(LAS u32x4*)(kbuf + lrow * ATT_ROWB + lchunk * 16) = kr;
    *(LAS u32x4*)(vbuf + lrow * ATT_ROWB + lchunk * 16) = vr;
    __syncthreads();
    for (int ti = 0; ti < ntl; ++ti) {
        const int cur = ti & 1;
        if (ti + 1 < ntl) {
            kr = *reinterpret_cast<const u32x4*>(Kg + (size_t)((ti + 1) * 64 + lrow) * 64 + lchunk * 8);
            vr = *reinterpret_cast<const u32x4*>(Vtg + (size_t)lrow * nk + (ti + 1) * 64 + lchunk * 8);
        }
        const LAS unsigned char* kb = kbuf + cur * ATT_TILEB; const LAS unsigned char* vb = vbuf + cur * ATT_TILEB;
        if (!DIFF) {
            f32x16 s0, s1;
#pragma unroll
            for (int i = 0; i < 16; ++i) { s0[i] = 0.f; s1[i] = 0.f; }
#pragma unroll
            for (int ks = 0; ks < 4; ++ks) {
                const bf16x8 a0 = *(const LAS bf16x8*)(kb + r * ATT_ROWB + (ks * 16 + hh * 8) * 2);
                const bf16x8 a1 = *(const LAS bf16x8*)(kb + (32 + r) * ATT_ROWB + (ks * 16 + hh * 8) * 2);
                s0 = MFMA32(a0, qf[ks], s0); s1 = MFMA32(a1, qf[ks], s1);
            }
            float alpha;
            softmax_tile(s0, s1, sc, m0, l0, alpha);
#pragma unroll
            for (int mt = 0; mt < 2; ++mt)
#pragma unroll
                for (int i = 0; i < 16; ++i) O0[mt][i] *= alpha;
            pv_tile(vb, s0, s1, O0, r, hh);
        } else {
#pragma unroll
            for (int x = 0; x < 2; ++x) {
                f32x16 s0, s1;
#pragma unroll
                for (int i = 0; i < 16; ++i) { s0[i] = 0.f; s1[i] = 0.f; }
#pragma unroll
                for (int ks = 0; ks < 2; ++ks) {
                    const bf16x8 a0 = *(const LAS bf16x8*)(kb + r * ATT_ROWB + (x * 32 + ks * 16 + hh * 8) * 2);
                    const bf16x8 a1 = *(const LAS bf16x8*)(kb + (32 + r) * ATT_ROWB + (x * 32 + ks * 16 + hh * 8) * 2);
                    s0 = MFMA32(a0, qf[x * 2 + ks], s0); s1 = MFMA32(a1, qf[x * 2 + ks], s1);
                }
                float alpha;
                if (x == 0) {
                    softmax_tile(s0, s1, sc, m0, l0, alpha);
#pragma unroll
                    for (int mt = 0; mt < 2; ++mt)
#pragma unroll
                        for (int i = 0; i < 16; ++i) O0[mt][i] *= alpha;
                    pv_tile(vb, s0, s1, O0, r, hh);
                } else {
                    softmax_tile(s0, s1, sc, m1, l1, alpha);
#pragma unroll
                    for (int mt = 0; mt < 2; ++mt)
#pragma unroll
                        for (int i = 0; i < 16; ++i) O1[mt][i] *= alpha;
                    pv_tile(vb, s0, s1, O1, r, hh);
                }
            }
        }
        if (ti + 1 < ntl) {
            *(LAS u32x4*)(kbuf + (cur ^ 1) * ATT_TILEB + lrow * ATT_ROWB + lchunk * 16) = kr;
            *(LAS u32x4*)(vbuf + (cur ^ 1) * ATT_TILEB + lrow * ATT_ROWB + lchunk * 16) = vr;
        }
        __syncthreads();
    }
    l0 += __shfl_xor(l0, 32);
    const float inv0 = 1.f / l0;
    bf16_t* orow = Og + (size_t)(wave * 32 + r) * D;
    if (!DIFF) {
#pragma unroll
        for (int mt = 0; mt < 2; ++mt)
#pragma unroll
            for (int g = 0; g < 4; ++g) {
                uint2 w;
                w.x = pack_bf2(O0[mt][4 * g] * inv0, O0[mt][4 * g + 1] * inv0);
                w.y = pack_bf2(O0[mt][4 * g + 2] * inv0, O0[mt][4 * g + 3] * inv0);
                *reinterpret_cast<uint2*>(orow + 32 * mt + 8 * g + 4 * hh) = w;
            }
    } else {
        l1 += __shfl_xor(l1, 32);
        const float inv1 = lam / l1;
        float ss = 0.f;
#pragma unroll
        for (int mt = 0; mt < 2; ++mt)
#pragma unroll
            for (int i = 0; i < 16; ++i) { const float o = O0[mt][i] * inv0 - O1[mt][i] * inv1; O0[mt][i] = o; ss += o * o; }
        ss += __shfl_xor(ss, 32);
        const float rr = rsqrtf(ss * (1.f / 64.f) + EPS) * (1.f - lam_init_of(l));
        const float* sg = p.in[I_SUBLN] + l * 64;
#pragma unroll
        for (int mt = 0; mt < 2; ++mt)
#pragma unroll
            for (int g = 0; g < 4; ++g) {
                const int d0 = 32 * mt + 8 * g + 4 * hh;
                const float4 gg = *reinterpret_cast<const float4*>(sg + d0);
                uint2 w;
                w.x = pack_bf2(O0[mt][4 * g] * rr * gg.x, O0[mt][4 * g + 1] * rr * gg.y);
                w.y = pack_bf2(O0[mt][4 * g + 2] * rr * gg.z, O0[mt][4 * g + 3] * rr * gg.w);
                *reinterpret_cast<uint2*>(orow + d0) = w;
            }
    }
}

constexpr int SGU_ROWB = 272;
__device__ __forceinline__ void sgu_item(const Params& p, int l, LAS unsigned char* lds, const int tid, const int t0) {
    const bf16_t* AV = (const bf16_t*)(p.ws + OFF_AV) + (size_t)t0 * 256;
    {
        const int q = tid >> 2, quarter = tid & 3;
        float v[64]; float ss = 0.f;
#pragma unroll
        for (int i = 0; i < 8; ++i) {
            const bf16x8 w = *reinterpret_cast<const bf16x8*>(AV + (size_t)q * 256 + quarter * 64 + i * 8);
#pragma unroll
            for (int j = 0; j < 8; ++j) { v[i * 8 + j] = bf2f((bf16_t)w[j]); ss += v[i * 8 + j] * v[i * 8 + j]; }
        }
        ss += __shfl_xor(ss, 1); ss += __shfl_xor(ss, 2);
        const float rstd = rsqrtf(ss * (1.f / 256.f) + EPS);
        const float* g = p.in[I_SGUNG] + l * 256 + quarter * 64;
#pragma unroll
        for (int i = 0; i < 64; ++i)
            *(LAS bf16_t*)(lds + (quarter * 64 + i) * SGU_ROWB + q * 2) = f2bf(v[i] * rstd * g[i]);
    }
    __syncthreads();
    {
        const int wave = tid >> 6, lane = tid & 63, r = lane & 31, hh = lane >> 5;
        const int g = wave >> 1, ph = wave & 1;
        const bf16_t* W = (const bf16_t*)(p.ws + OFF_SGUW) + ((size_t)l * 4 + g) * 128 * 128;
        f32x16 acc[2][2];
#pragma unroll
        for (int a = 0; a < 2; ++a)
#pragma unroll
            for (int b = 0; b < 2; ++b)
#pragma unroll
                for (int i = 0; i < 16; ++i) acc[a][b][i] = 0.f;
#pragma unroll
        for (int ks = 0; ks < 8; ++ks) {
            bf16x8 af[2], bfr[2];
#pragma unroll
            for (int pt = 0; pt < 2; ++pt) af[pt] = *reinterpret_cast<const bf16x8*>(W + (size_t)(ph * 64 + pt * 32 + r) * 128 + ks * 16 + hh * 8);
#pragma unroll
            for (int ct = 0; ct < 2; ++ct) bfr[ct] = *(const LAS bf16x8*)(lds + (g * 64 + ct * 32 + r) * SGU_ROWB + (ks * 16 + hh * 8) * 2);
#pragma unroll
            for (int pt = 0; pt < 2; ++pt)
#pragma unroll
                for (int ct = 0; ct < 2; ++ct) acc[pt][ct] = MFMA32(af[pt], bfr[ct], acc[pt][ct]);
        }
        const float* bias = p.in[I_SGUB] + (l * 4 + g) * 128;
        const bf16_t* AU = (const bf16_t*)(p.ws + OFF_AU);
        bf16_t* MIX = (bf16_t*)(p.ws + OFF_MIX);
#pragma unroll
        for (int pt = 0; pt < 2; ++pt)
#pragma unroll
            for (int ct = 0; ct < 2; ++ct)
#pragma unroll
                for (int i = 0; i < 16; ++i) {
                    const int pp = ph * 64 + pt * 32 + (i & 3) + 8 * (i >> 2) + 4 * hh, c = g * 64 + ct * 32 + r;
                    const float au = bf2f(AU[(size_t)(t0 + pp) * 256 + c]);
                    MIX[(size_t)(t0 + pp) * D + c] = f2bf(au * (acc[pt][ct][i] + bias[pp]));
                }
    }
    __syncthreads();
}

__device__ void ph_mixers(const Params& p, int lq, unsigned char* ldsraw) {
    const int l = lq & 1;
    const int tid0 = opaque_tid();
    LAS unsigned char* lds = (LAS unsigned char*)ldsraw;
    volatile LAS int* qslot = (volatile LAS int*)(ldsraw - LDS_HDR + 64);
    unsigned* qw = (unsigned*)(p.ws + OFF_BAR) + QW_MIX + lq;
    const float lam = lam_of(p, l);
    unsigned char* ws = p.ws;
    for (;;) {
        if (tid0 == 0) *qslot = (int)atomicAdd(qw, 1u);
        __syncthreads();
        const int item = *qslot;
        __syncthreads();
        if (item >= 896) break;
        int tid = tid0; asm volatile("" : "+v"(tid));
        if (item < 128) {
            const int qc = item & 7, h = (item >> 3) & 3, b = item >> 5;
            const int t0 = NPT + b * DSEQ + qc * 256;
            attn_item<true>(p, l, lds, tid, (const bf16_t*)(ws + OFF_DQ) + (size_t)t0 * 256 + h * 64, 256,
                            (const bf16_t*)(ws + OFF_DKS) + ((size_t)b * 4 + h) * NKS * 64, (const bf16_t*)(ws + OFF_DVTS) + ((size_t)b * 4 + h) * 64 * NKS, NKS,
                            (bf16_t*)(ws + OFF_MIX) + (size_t)t0 * D + 256 + h * 64, lam);
        } else if (item < 384) {
            const int it = item - 128, qc = it & 7, hq = (it >> 3) & 7, b = it >> 6, kv = hq >> 2;
            const int t0 = NPT + b * DSEQ + qc * 256;
            attn_item<false>(p, l, lds, tid, (const bf16_t*)(ws + OFF_GQ) + (size_t)t0 * 512 + hq * 64, 512,
                             (const bf16_t*)(ws + OFF_GKS) + ((size_t)b * 2 + kv) * NKS * 64, (const bf16_t*)(ws + OFF_GVTS) + ((size_t)b * 2 + kv) * 64 * NKS, NKS,
                             (bf16_t*)(ws + OFF_MIX) + (size_t)t0 * D + 512 + hq * 64, lam);
        } else if (item < 512) {
            sgu_item(p, l, lds, tid, (item - 384) * 128);
        } else if (item < 768) {
            const int it = item - 512, hq = it & 7, b = it >> 3, kv = hq >> 2;
            const int t0 = b * SEQ;
            attn_item<false>(p, l, lds, tid, (const bf16_t*)(ws + OFF_GQ) + (size_t)t0 * 512 + hq * 64, 512,
                             (const bf16_t*)(ws + OFF_GKP) + ((size_t)b * 2 + kv) * SEQ * 64, (const bf16_t*)(ws + OFF_GVTP) + ((size_t)b * 2 + kv) * 64 * SEQ, SEQ,
                             (bf16_t*)(ws + OFF_MIX) + (size_t)t0 * D + 512 + hq * 64, lam);
        } else {
            const int it = item - 768, h = it & 3, b = it >> 2;
            const int t0 = b * SEQ;
            attn_item<true>(p, l, lds, tid, (const bf16_t*)(ws + OFF_DQ) + (size_t)t0 * 256 + h * 64, 256,
                            (const bf16_t*)(ws + OFF_DKP) + ((size_t)b * 4 + h) * SEQ * 64, (const bf16_t*)(ws + OFF_DVTP) + ((size_t)b * 4 + h) * 64 * SEQ, SEQ,
                            (bf16_t*)(ws + OFF_MIX) + (size_t)t0 * D + 256 + h * 64, lam);
        }
    }
}


using bf16x2 = __attribute__((ext_vector_type(2))) __bf16;
__device__ __forceinline__ float dot2bf(unsigned a, unsigned b, float c) {
    return __builtin_amdgcn_fdot2_f32_bf16(__builtin_bit_cast(bf16x2, a), __builtin_bit_cast(bf16x2, b), c, false);
}
template <int W>
__device__ __forceinline__ void bfly_stage(float (&part)[64], const int lane) {
    const bool hi = (lane & W) != 0;
#pragma unroll
    for (int k = 0; k < W; ++k) {
        const float keep = hi ? part[k + W] : part[k];
        const float send = hi ? part[k] : part[k + W];
        part[k] = keep + __shfl_xor(send, W);
    }
}
__device__ void ph_peer_apply_fast(const Params& p, int l, bool last, bool dry) {
    const int tid = opaque_tid();
    const int lane = tid & 63;
    const int gw = blockIdx.x * 8 + (tid >> 6), nw = gridDim.x * 8;
    const unsigned char* UT = p.ws + OFF_UT + (size_t)l * NEXP * D;
    const unsigned char* VT = p.ws + OFF_VT + (size_t)l * NEXP * D;
    const float* USC = (const float*)(p.ws + OFF_USC) + l * NEXP; const float* VSC = (const float*)(p.ws + OFF_VSC) + l * NEXP;
    for (int t = gw; t < NTOK; t += nw) {
        const bf16_t* Hr = (const bf16_t*)(p.ws + OFF_H) + (size_t)t * D + lane * 16;
        float hf[16];
        {
            const u32x4 h0 = *reinterpret_cast<const u32x4*>(Hr), h1 = *reinterpret_cast<const u32x4*>(Hr + 8);
#pragma unroll
            for (int k = 0; k < 4; ++k) {
                hf[2 * k] = __uint_as_float(h0[k] << 16); hf[2 * k + 1] = __uint_as_float(h0[k] & 0xffff0000u);
                hf[8 + 2 * k] = __uint_as_float(h1[k] << 16); hf[8 + 2 * k + 1] = __uint_as_float(h1[k] & 0xffff0000u);
            }
        }
        const int* EI = (const int*)(p.ws + OFF_EIDX) + (size_t)t * 128; const float* EG = (const float*)(p.ws + OFF_EGATE) + (size_t)t * 128;
        const int e0 = EI[lane], e1 = EI[64 + lane];
        float w0, w1;
#pragma unroll 1
        for (int batch = 0; batch < 2; ++batch) {
            const int eb = batch ? e1 : e0;
            float part[64];
#pragma unroll
            for (int j0 = 0; j0 < 64; j0 += 16) {
                u32x4 a[16];
#pragma unroll
                for (int jj = 0; jj < 16; ++jj) {
                    const int e = __builtin_amdgcn_readlane(eb, j0 + jj);
                    a[jj] = *reinterpret_cast<const u32x4*>(UT + (size_t)e * D + lane * 16);
                }
                __builtin_amdgcn_sched_barrier(0);
#pragma unroll
                for (int jj = 0; jj < 16; ++jj) {
                    float acc = 0.f;
#pragma unroll
                    for (int k = 0; k < 4; ++k) {
                        const f32x2 lo = __builtin_amdgcn_cvt_pk_f32_fp8((int)a[jj][k], false), hi = __builtin_amdgcn_cvt_pk_f32_fp8((int)a[jj][k], true);
                        acc += lo[0] * hf[4 * k] + lo[1] * hf[4 * k + 1] + hi[0] * hf[4 * k + 2] + hi[1] * hf[4 * k + 3];
                    }
                    part[j0 + jj] = acc;
                }
                __builtin_amdgcn_sched_barrier(0);
            }
            bfly_stage<32>(part, lane); bfly_stage<16>(part, lane); bfly_stage<8>(part, lane);
            bfly_stage<4>(part, lane); bfly_stage<2>(part, lane); bfly_stage<1>(part, lane);
            const float w = EG[batch * 64 + lane] * gelu_f(part[0] * USC[eb]) * VSC[eb];
            if (batch) w1 = w; else w0 = w;
        }
        float o[16];
#pragma unroll
        for (int i = 0; i < 16; ++i) o[i] = 0.f;
#pragma unroll 1
        for (int batch = 0; batch < 2; ++batch) {
            const int eb = batch ? e1 : e0; const float wb = batch ? w1 : w0;
#pragma unroll 1
            for (int j0 = 0; j0 < 64; j0 += 16) {
                u32x4 a[16]; float w[16];
#pragma unroll
                for (int jj = 0; jj < 16; ++jj) {
                    const int e = __builtin_amdgcn_readlane(eb, j0 + jj);
                    w[jj] = __builtin_bit_cast(float, __builtin_amdgcn_readlane(__builtin_bit_cast(int, wb), j0 + jj));
                    a[jj] = *reinterpret_cast<const u32x4*>(VT + (size_t)e * D + lane * 16);
                }
                __builtin_amdgcn_sched_barrier(0);
#pragma unroll
                for (int jj = 0; jj < 16; ++jj) {
#pragma unroll
                    for (int k = 0; k < 4; ++k) {
                        const f32x2 lo = __builtin_amdgcn_cvt_pk_f32_fp8((int)a[jj][k], false), hi = __builtin_amdgcn_cvt_pk_f32_fp8((int)a[jj][k], true);
                        o[4 * k] += w[jj] * lo[0]; o[4 * k + 1] += w[jj] * lo[1]; o[4 * k + 2] += w[jj] * hi[0]; o[4 * k + 3] += w[jj] * hi[1];
                    }
                }
                __builtin_amdgcn_sched_barrier(0);
            }
        }
        const float* g2 = (const float*)(p.ws + OFF_MOD) + (size_t)(l * 5 + tok_cv(t)) * 6144 + 5 * 1024 + lane * 16;
        float* XC = (float*)(p.ws + OFF_XC) + (size_t)t * D + lane * 16;
        float xv[16];
#pragma unroll
        for (int i = 0; i < 4; ++i) {
            const float4 x = *reinterpret_cast<const float4*>(XC + i * 4), g = *reinterpret_cast<const float4*>(g2 + i * 4);
            xv[i * 4] = x.x + g.x * o[i * 4]; xv[i * 4 + 1] = x.y + g.y * o[i * 4 + 1]; xv[i * 4 + 2] = x.z + g.z * o[i * 4 + 2]; xv[i * 4 + 3] = x.w + g.w * o[i * 4 + 3];
        }
        if (dry) { if (xv[0] == 1.2345e30f) XC[0] = xv[1]; }
        else if (!last) {
#pragma unroll
            for (int i = 0; i < 4; ++i) *reinterpret_cast<float4*>(XC + i * 4) = make_float4(xv[i * 4], xv[i * 4 + 1], xv[i * 4 + 2], xv[i * 4 + 3]);
        } else {
            float ss = 0.f;
#pragma unroll
            for (int i = 0; i < 16; ++i) ss += xv[i] * xv[i];
            ss = wave_sum(ss);
            const float r = rsqrtf(ss / D + EPS);
            const float* fg = p.in[I_FG] + lane * 16;
            float* y = p.out + (size_t)t * D + lane * 16;
#pragma unroll
            for (int i = 0; i < 4; ++i) {
                const float4 g = *reinterpret_cast<const float4*>(fg + i * 4);
                *reinterpret_cast<float4*>(y + i * 4) = make_float4(xv[i * 4] * r * g.x, xv[i * 4 + 1] * r * g.y, xv[i * 4 + 2] * r * g.z, xv[i * 4 + 3] * r * g.w);
            }
        }
    }
}

#define CE_DESC(a, b) do { const float _mx = fmaxf((a), (b)); const float _mn = fminf((a), (b)); (a) = _mx; (b) = _mn; } while (0)
__device__ __forceinline__ void sort16_desc(float (&v)[16]) {
#pragma unroll
    for (int k = 2; k <= 16; k <<= 1)
#pragma unroll
        for (int j = k >> 1; j > 0; j >>= 1)
#pragma unroll
            for (int i = 0; i < 16; ++i) {
                const int m = i ^ j;
                if (m > i) { if ((i & k) == 0) CE_DESC(v[i], v[m]); else CE_DESC(v[m], v[i]); }
            }
}
__device__ __forceinline__ void merge_top16(float (&a)[16], const float (&b)[16]) {
#pragma unroll
    for (int i = 0; i < 16; ++i) a[i] = fmaxf(a[i], b[15 - i]);
#pragma unroll
    for (int j = 8; j > 0; j >>= 1)
#pragma unroll
        for (int i = 0; i < 16; ++i) { const int m = i ^ j; if (m > i) CE_DESC(a[i], a[m]); }
}
__device__ __forceinline__ float key_embed(float v, unsigned lowmask, unsigned idxbits) { return __uint_as_float((__float_as_uint(v) & ~lowmask) | idxbits); }

constexpr int SK_ROWB = 144;
__device__ __forceinline__ void peer_stage1(const LAS unsigned char* SK  , const bf16_t* __restrict__ Qrow  ,
                                            const int r, const int hh, float (&out)[16]) {
    bf16x8 qb[4];
#pragma unroll
    for (int ks = 0; ks < 4; ++ks) qb[ks] = *reinterpret_cast<const bf16x8*>(Qrow + ks * 16 + hh * 8);
    float grp[4][16];
#pragma unroll
    for (int mt = 0; mt < 4; ++mt) {
        f32x16 acc;
#pragma unroll
        for (int i = 0; i < 16; ++i) acc[i] = 0.f;
#pragma unroll
        for (int ks = 0; ks < 4; ++ks) {
            const bf16x8 a = *(const LAS bf16x8*)(SK + (mt * 32 + r) * SK_ROWB + (ks * 16 + hh * 8) * 2);
            acc = MFMA32(a, qb[ks], acc);
        }
        const unsigned hx = (unsigned)hh << 2;
#pragma unroll
        for (int i = 0; i < 16; ++i) {
            const unsigned cn = 32u * mt + (i & 3) + 8u * (i >> 2);
            grp[mt][i] = key_embed(acc[i], 127u, (127u - cn) ^ hx);
        }
        sort16_desc(grp[mt]);
    }
    merge_top16(grp[0], grp[1]); merge_top16(grp[2], grp[3]); merge_top16(grp[0], grp[2]);
    float pb[16];
#pragma unroll
    for (int i = 0; i < 16; ++i) pb[i] = __shfl_xor(grp[0][i], 32);
    merge_top16(grp[0], pb);
#pragma unroll
    for (int i = 0; i < 16; ++i) out[i] = grp[0][i];
}

__device__ void ph_peer_select(const Params& p, int l, unsigned char* ldsraw) {
    const int tid = opaque_tid();
    const int wave = tid >> 6, lane = tid & 63, r = lane & 31, hh = lane >> 5;
    const int gw = blockIdx.x * 8 + wave, nw = gridDim.x * 8;
    LAS unsigned char* skl = (LAS unsigned char*)ldsraw;
    LAS unsigned char* myl = skl + 2 * 128 * SK_ROWB + wave * 2048 + lane * 32;
    {
        const bf16_t* SKg = (const bf16_t*)(p.ws + OFF_SUBK) + (size_t)l * 2 * 128 * 64;
        for (int i = tid; i < 2 * 128 * 8; i += NT) {
            const int row = i >> 3, ch = i & 7;
            *(LAS u32x4*)(skl + row * SK_ROWB + ch * 16) = *reinterpret_cast<const u32x4*>(SKg + (size_t)row * 64 + ch * 8);
        }
        __syncthreads();
    }
    for (int task = gw; task < (NTOK / 32) * 4; task += nw) {
        const int tg = task >> 2, k = task & 3;
        const int t = tg * 32 + r;
        const bf16_t* Qt = (const bf16_t*)(p.ws + OFF_Q) + (size_t)t * D;
        float sv[2][16];
#pragma unroll
        for (int x = 0; x < 2; ++x) {
            float la[16], lb[16];
            peer_stage1(skl + x * 128 * SK_ROWB, Qt + k * 128 + x * 64, r, hh, la);
            peer_stage1(skl + x * 128 * SK_ROWB, Qt + (k + 4) * 128 + x * 64, r, hh, lb);
#pragma unroll
            for (int i = 0; i < 16; ++i) sv[x][i] = hh ? lb[i] : la[i];
        }
        {
            unsigned w[8];
#pragma unroll
            for (int q = 0; q < 8; ++q) {
                w[q] = 0u;
#pragma unroll
                for (int b = 0; b < 4; ++b) {
                    const int i = q * 4 + b;
                    const unsigned key = __float_as_uint(i < 16 ? sv[0][i] : sv[1][i - 16]);
                    w[q] |= (127u - (key & 127u)) << (8 * b);
                }
            }
            *(LAS u32x4*)(myl) = u32x4{w[0], w[1], w[2], w[3]};
            *(LAS u32x4*)(myl + 16) = u32x4{w[4], w[5], w[6], w[7]};
        }
        float val0[16], val1[16];
#pragma unroll
        for (int i = 0; i < 16; ++i) { val0[i] = __uint_as_float(__float_as_uint(sv[0][i]) & ~127u); val1[i] = __uint_as_float(__float_as_uint(sv[1][i]) & ~127u); }
        float g0[16], g1[16], g2[16], g3[16];
#pragma unroll
        for (int b = 0; b < 16; ++b) g0[b] = key_embed(val0[0] + val1[b], 255u, 255u - (unsigned)b);
#pragma unroll
        for (int b = 0; b < 8; ++b) g1[b] = key_embed(val0[1] + val1[b], 255u, 255u - (16u + b));
#pragma unroll
        for (int b = 0; b < 5; ++b) g1[8 + b] = key_embed(val0[2] + val1[b], 255u, 255u - (32u + b));
#pragma unroll
        for (int b = 0; b < 3; ++b) g1[13 + b] = key_embed(val0[4] + val1[b], 255u, 255u - (64u + b));
#pragma unroll
        for (int b = 0; b < 4; ++b) g2[b] = key_embed(val0[3] + val1[b], 255u, 255u - (48u + b));
#pragma unroll
        for (int a = 5; a < 8; ++a)
#pragma unroll
            for (int b = 0; b < 2; ++b) g2[4 + (a - 5) * 2 + b] = key_embed(val0[a] + val1[b], 255u, 255u - (16u * a + b));
#pragma unroll
        for (int a = 8; a < 14; ++a) g2[10 + (a - 8)] = key_embed(val0[a] + val1[0], 255u, 255u - 16u * a);
        g3[0] = key_embed(val0[14] + val1[0], 255u, 255u - 16u * 14); g3[1] = key_embed(val0[15] + val1[0], 255u, 255u - 16u * 15);
#pragma unroll
        for (int i = 2; i < 16; ++i) g3[i] = -3.0e38f;
        sort16_desc(g1); sort16_desc(g2); sort16_desc(g3);
        merge_top16(g0, g1); merge_top16(g2, g3); merge_top16(g0, g2);
        float gate[16]; int eid[16];
        const float mx = __uint_as_float(__float_as_uint(g0[0]) & ~255u);
        float sum = 0.f;
#pragma unroll
        for (int i = 0; i < 16; ++i) {
            const unsigned key = __float_as_uint(g0[i]);
            gate[i] = __expf(__uint_as_float(key & ~255u) - mx); sum += gate[i];
            const unsigned id = 255u - (key & 255u);
            const unsigned n0 = *(const LAS unsigned char*)(myl + (id >> 4));
            const unsigned n1 = *(const LAS unsigned char*)(myl + 16 + (id & 15u));
            eid[i] = (int)(n0 * 128u + n1);
        }
        const float inv = 1.f / sum;
        const int h = k + 4 * hh;
        int* EI = (int*)(p.ws + OFF_EIDX) + (size_t)t * 128 + h * 16; float* EG = (float*)(p.ws + OFF_EGATE) + (size_t)t * 128 + h * 16;
#pragma unroll
        for (int q = 0; q < 4; ++q) {
            *reinterpret_cast<int4*>(EI + q * 4) = make_int4(eid[q * 4], eid[q * 4 + 1], eid[q * 4 + 2], eid[q * 4 + 3]);
            *reinterpret_cast<float4*>(EG + q * 4) = make_float4(gate[q * 4] * inv, gate[q * 4 + 1] * inv, gate[q * 4 + 2] * inv, gate[q * 4 + 3] * inv);
        }
    }
}

constexpr int LDS_BYTES = LDS_HDR + 256 * 132 * 4;
__global__ void __launch_bounds__(NT, 2) mk_fwd(Params p) {
    extern __shared__ __attribute__((aligned(16))) unsigned char lds[];
    volatile LAS unsigned* st = (volatile LAS unsigned*)lds;
    if (threadIdx.x < 4) st[threadIdx.x] = 0u;
    __syncthreads();
    XcdBarrier xb = xcd_barrier_post((unsigned*)(p.ws + OFF_BAR), st);
#define GRID_BAR() xcd_barrier(xb)
    unsigned char* ws = p.ws;
    for (int rep = 0; rep < (PROBE_DUP == 1 ? 2 : 1); ++rep) {
    for (int l = 0; l < 2; ++l) {
        ph_transpose(p.in[I_WIN] + (size_t)l * D * INW, (bf16_t*)(ws + OFF_WIN) + (size_t)l * INW * D, D, INW);
        ph_transpose(p.in[I_WOUT] + (size_t)l * D * D, (bf16_t*)(ws + OFF_WOUT) + (size_t)l * D * D, D, D);
        ph_transpose(p.in[I_WQ] + (size_t)l * D * D, (bf16_t*)(ws + OFF_WQ) + (size_t)l * D * D, D, D);
    }
    ph_convert_fp8_rows(p.in[I_PU], ws + OFF_UT, (float*)(ws + OFF_USC), 2 * NEXP);
    ph_convert_fp8_rows(p.in[I_PV], ws + OFF_VT, (float*)(ws + OFF_VSC), 2 * NEXP);
    ph_convert(p.in[I_SUBK], (bf16_t*)(ws + OFF_SUBK), 2 * 2 * 128 * 64);
    ph_convert(p.in[I_SGUW], (bf16_t*)(ws + OFF_SGUW), 2 * 4 * 128 * 128);
    ph_mod(p);
    ph_rope_tab(p);
    GRID_BAR();
    }
    for (int l = 0; l < 2; ++l) {
        for (int rep = 0; rep < (PROBE_DUP == 3 ? 2 : 1); ++rep) {
        ph_norm_mod(p, l, 0, l == 0 ? 1 : 0);
        ph_cache_prep(p, l);
        GRID_BAR();
        }
        for (int rep = 0; rep < (PROBE_DUP == 5 ? 2 : 1); ++rep) {
        gemm_phase<EPI_INPROJ>(p, l, (const bf16_t*)(ws + OFF_H), (const bf16_t*)(ws + OFF_WIN) + (size_t)l * INW * D, INW, lds + LDS_HDR);
        GRID_BAR();
        }
        for (int rep = 0; rep < (PROBE_DUP == 4 ? 2 : 1); ++rep) {
        ph_mixers(p, l + 2 * rep, lds + LDS_HDR);
        GRID_BAR();
        }
        gemm_phase<EPI_WOUT>(p, l, (const bf16_t*)(ws + OFF_MIX), (const bf16_t*)(ws + OFF_WOUT) + (size_t)l * D * D, D, lds + LDS_HDR);
        GRID_BAR();
        ph_norm_mod(p, l, 1, 0);
        GRID_BAR();
        gemm_phase<EPI_WQ>(p, l, (const bf16_t*)(ws + OFF_H), (const bf16_t*)(ws + OFF_WQ) + (size_t)l * D * D, D, lds + LDS_HDR);
        GRID_BAR();
        for (int rep = 0; rep < (PROBE_DUP == 2 ? 2 : 1); ++rep) {
        ph_peer_select(p, l, lds + LDS_HDR);
        GRID_BAR();
        }
        if (PROBE_DUP == 6) ph_peer_apply_fast(p, l, false, true);
        ph_peer_apply_fast(p, l, l == 1, false);
        if (l == 0) GRID_BAR();
    }
}

extern "C" void kernel_launch(void* const* d_in, const int* in_sizes, int n_in,
                              void* d_out, int out_size, void* d_ws, size_t ws_size,
                              hipStream_t stream) {
    static int grid = 0;
    if (grid == 0) {
        if (ws_size < WS_NEED) { fprintf(stderr, "kernel_launch: workspace too small: %zu < %zu\n", ws_size, (size_t)WS_NEED); grid = -1; return; }
        int dev = 0, cus = 0, per_cu = 0;
        (void)hipGetDevice(&dev);
        (void)hipDeviceGetAttribute(&cus, hipDeviceAttributeMultiprocessorCount, dev);
        (void)hipFuncSetAttribute((const void*)mk_fwd, hipFuncAttributeMaxDynamicSharedMemorySize, LDS_BYTES);
        (void)hipOccupancyMaxActiveBlocksPerMultiprocessor(&per_cu, (const void*)mk_fwd, NT, LDS_BYTES);
        if (per_cu < 1) { fprintf(stderr, "kernel_launch: occupancy query reports %d blocks per CU\n", per_cu); grid = -1; return; }
        grid = cus;
    }
    if (grid < 0) return;
    (void)hipMemsetAsync((unsigned char*)d_ws + OFF_BAR, 0, 64 * 1024, stream);
    Params p{};
    for (int i = 0; i < 29; ++i) p.in[i] = (const float*)d_in[i];
    p.out = (float*)d_out; p.ws = (unsigned char*)d_ws;
    void* args[] = {&p};
    hipError_t e = hipLaunchCooperativeKernel((const void*)mk_fwd, dim3(grid), dim3(NT), args, LDS_BYTES, stream);
    if (e != hipSuccess) fprintf(stderr, "kernel_launch: cooperative launch failed: %s (grid %d)\n", hipGetErrorString(e), grid);
}
```

```cpp
#include <hip/hip_runtime.h>
#include <hip/hip_bf16.h>
#include <cstdio>
#include <cstdint>
#include <hip/hip_cooperative_groups.h>
namespace cg = cooperative_groups;

#define PROBE_DUP 0
typedef unsigned short bf16_t;
using bf16x8 = __attribute__((ext_vector_type(8))) short;
using f32x4  = __attribute__((ext_vector_type(4))) float;
using f32x16 = __attribute__((ext_vector_type(16))) float;
using f32x2  = __attribute__((ext_vector_type(2))) float;
using u32x4  = __attribute__((ext_vector_type(4))) unsigned;
using s16x4  = __attribute__((ext_vector_type(4))) short;

constexpr int D      = 1024;
constexpr int NTOK   = 16384;
constexpr int NPT    = 8192;
constexpr int SEQ    = 256;
constexpr int DSEQ   = 2048;
constexpr int PAST   = 512;
constexpr int NKS    = DSEQ + PAST;
constexpr int INW    = 2048;
constexpr int NEXP   = 16384;
constexpr float EPS  = 1e-6f;

constexpr size_t MB = 1024 * 1024;
constexpr size_t OFF_BAR   = 0;
constexpr size_t OFF_MOD   = 64 * 1024;
constexpr size_t OFF_ROPE  = OFF_MOD + 256 * 1024;
constexpr size_t OFF_SUBK  = OFF_ROPE + 1 * MB;
constexpr size_t OFF_SGUW  = OFF_SUBK + 64 * 1024;
constexpr size_t OFF_WIN   = OFF_SGUW + 256 * 1024;
constexpr size_t OFF_WOUT  = OFF_WIN + 8 * MB;
constexpr size_t OFF_WQ    = OFF_WOUT + 4 * MB;
constexpr size_t OFF_UT    = OFF_WQ + 4 * MB;
constexpr size_t OFF_USC   = OFF_UT + 32 * MB;
constexpr size_t OFF_VT    = OFF_UT + 64 * MB;
constexpr size_t OFF_VSC   = OFF_VT + 32 * MB;
constexpr size_t OFF_H     = OFF_VT + 64 * MB;
constexpr size_t OFF_XC    = OFF_H + 32 * MB;
constexpr size_t OFF_R1    = OFF_XC + 64 * MB;
constexpr size_t OFF_AU    = OFF_R1;
constexpr size_t OFF_AV    = OFF_AU + 8 * MB;
constexpr size_t OFF_AVN   = OFF_AV + 8 * MB;
constexpr size_t OFF_DQ    = OFF_AVN + 8 * MB;
constexpr size_t OFF_DKP   = OFF_DQ + 8 * MB;
constexpr size_t OFF_DKS   = OFF_DKP + 4 * MB;
constexpr size_t OFF_DVTP  = OFF_DKS + 5 * MB;
constexpr size_t OFF_DVTS  = OFF_DVTP + 4 * MB;
constexpr size_t OFF_GQ    = OFF_DVTS + 5 * MB;
constexpr size_t OFF_GKP   = OFF_GQ + 16 * MB;
constexpr size_t OFF_GKS   = OFF_GKP + 2 * MB;
constexpr size_t OFF_GVTP  = OFF_GKS + 3 * MB;
constexpr size_t OFF_GVTS  = OFF_GVTP + 2 * MB;
constexpr size_t OFF_MIX   = OFF_GVTS + 3 * MB;
constexpr size_t OFF_R1END = OFF_MIX + 32 * MB;
constexpr size_t OFF_Q     = OFF_R1;
constexpr size_t OFF_EIDX  = OFF_Q + 32 * MB;
constexpr size_t OFF_EGATE = OFF_EIDX + 8 * MB;
constexpr size_t OFF_TOPV  = OFF_EGATE + 8 * MB;
constexpr size_t OFF_TOPI  = OFF_TOPV + 16 * MB;
static_assert(OFF_TOPI + 16 * MB <= OFF_R1END, "peer buffers must fit region 1");
constexpr size_t OFF_PROJ  = OFF_R1END;
constexpr size_t OFF_PART  = OFF_PROJ;
constexpr size_t OFF_WPAIR = OFF_PART + 64 * MB;
constexpr size_t WS_NEED   = OFF_PROJ + 128 * MB;
static_assert(WS_NEED <= 512 * MB, "workspace budget");

constexpr size_t OUT_YP  = 0;
constexpr size_t OUT_YS  = 8388608;
constexpr size_t OUT_NDK = 16777216;
constexpr size_t OUT_NDV = OUT_NDK + 4194304;
constexpr size_t OUT_NGK = OUT_NDV + 4194304;
constexpr size_t OUT_NGV = OUT_NGK + 2097152;

struct Params {
    const float* in[29];
    float* out;
    unsigned char* ws;
};
enum { I_XP = 0, I_XS, I_CDK, I_CDV, I_CGK, I_CGV, I_C, I_CCTX, I_ADAW, I_ADAB, I_N1G, I_N2G, I_WIN, I_SGUNG, I_SGUW, I_SGUB,
       I_LQ1, I_LK1, I_LQ2, I_LK2, I_SUBLN, I_QNG, I_KNG, I_WOUT, I_WQ, I_SUBK, I_PU, I_PV, I_FG };

__device__ __forceinline__ bf16_t f2bf(float f) {
    unsigned u = __float_as_uint(f);
    u += 0x7fffu + ((u >> 16) & 1u);
    return (bf16_t)(u >> 16);
}
__device__ __forceinline__ float bf2f(bf16_t h) { return __uint_as_float(((unsigned)h) << 16); }
__device__ __forceinline__ float gelu_f(float x) {
    const float k = 0.7978845608028654f;
    float u = k * (x + 0.044715f * x * x * x);
    return 0.5f * x * (1.f + tanhf(u));
}
__device__ __forceinline__ int lane_id() { return (int)__builtin_amdgcn_mbcnt_hi(~0u, __builtin_amdgcn_mbcnt_lo(~0u, 0u)); }
__device__ __forceinline__ int lane_id_op() { int l = lane_id(); asm volatile("" : "+v"(l)); return l; }
__device__ __forceinline__ float shfl_i(float v, int src) { return __builtin_bit_cast(float, __builtin_amdgcn_ds_bpermute(src << 2, __builtin_bit_cast(int, v))); }
__device__ __forceinline__ int shfl_i(int v, int src) { return __builtin_amdgcn_ds_bpermute(src << 2, v); }
__device__ __forceinline__ float shfl_x(float v, int lane, int m) { return shfl_i(v, lane ^ m); }
__device__ __forceinline__ float wave_sum(float v) {
    const int ln = lane_id_op();
#pragma unroll
    for (int o = 32; o >= 1; o >>= 1) v += shfl_x(v, ln, o);
    return v;
}
__device__ __forceinline__ int tok_cv(int t) { return t < NPT ? 0 : 1 + ((t - NPT) >> 11); }
__device__ __forceinline__ const float* x_in_row(const Params& p, int t) {
    return t < NPT ? p.in[I_XP] + (size_t)t * D : p.in[I_XS] + (size_t)(t - NPT) * D;
}
__device__ __forceinline__ float lam_init_of(int l) { return l == 0 ? 0.2f : (0.8f - 0.6f * 0.7408182206817179f); }
__device__ __forceinline__ float lam_of(const Params& p, int l) {
    float s1 = 0.f, s2 = 0.f;
    for (int i = 0; i < 32; ++i) {
        s1 += p.in[I_LQ1][l * 32 + i] * p.in[I_LK1][l * 32 + i];
        s2 += p.in[I_LQ2][l * 32 + i] * p.in[I_LK2][l * 32 + i];
    }
    return expf(s1) - expf(s2) + lam_init_of(l);
}


#define XB_TMO      128
#define XB_XCNT(j)  (256  + 64 * (j))
#define XB_XSUB(j)  (1280 + 64 * (j))
#define XB_XGEN(j)  (2304 + 64 * (j))
#define XB_TOP      3328
#define XB_TOPGEN   3392
#define XCD_BAR_WORDS 3456
#define XB_SPIN_CAP (1u << 20)
#define LAS __attribute__((address_space(3)))
__device__ __forceinline__ unsigned xb_ld(unsigned* p)              { return __hip_atomic_load(p, __ATOMIC_RELAXED, __HIP_MEMORY_SCOPE_AGENT); }
__device__ __forceinline__ unsigned xb_add(unsigned* p, unsigned v) { return __hip_atomic_fetch_add(p, v, __ATOMIC_RELAXED, __HIP_MEMORY_SCOPE_AGENT); }
__device__ __forceinline__ unsigned xb_xcc_id() { return (unsigned)__builtin_amdgcn_s_getreg((3 << 11) | 20) & 0xFu; }
#define XB_SPIN(cond, bar) do { unsigned _sp = 0; while (cond) { __builtin_amdgcn_s_sleep(1); \
    if ((++_sp & 255u) == 0u) { if (xb_ld(&(bar)[XB_TMO])) break; if (_sp > XB_SPIN_CAP) { atomicAdd(&(bar)[XB_TMO], 1u); break; } } } } while (0)
struct XcdBarrier { unsigned* bar; unsigned x; volatile LAS unsigned* st; };
__device__ __forceinline__ XcdBarrier xcd_barrier_post(unsigned* bar, volatile LAS unsigned* st) {
    XcdBarrier b; b.bar = bar; b.x = xb_xcc_id(); b.st = st;
    if (threadIdx.x == 0) (void)xb_add(&bar[XB_XCNT(b.x)], 1u);
    return b;
}
__device__ __forceinline__ void xcd_barrier_complete(unsigned* bar, unsigned x, unsigned& nloc, unsigned& nx) {
    const unsigned G = gridDim.x * gridDim.y * gridDim.z;
    unsigned sum, cnt, mine, sp = 0u;
    for (;;) {
        sum = 0u; cnt = 0u; mine = 0u;
#pragma unroll
        for (unsigned j = 0; j < 16; ++j) { const unsigned c = xb_ld(&bar[XB_XCNT(j)]); sum += c; cnt += (c > 0u) ? 1u : 0u; mine = (j == x) ? c : mine; }
        if (sum == G) break;
        __builtin_amdgcn_s_sleep(1);
        if ((++sp & 255u) == 0u) { if (xb_ld(&bar[XB_TMO])) break; if (sp > XB_SPIN_CAP) { atomicAdd(&bar[XB_TMO], 1u); break; } }
    }
    nloc = mine > 0u ? mine : 1u; nx = cnt > 0u ? cnt : 1u;
}
__device__ __forceinline__ void xcd_barrier(const XcdBarrier& b) {
    asm volatile("s_waitcnt vmcnt(0)" ::: "memory");
    __syncthreads();
    if (threadIdx.x == 0) {
        unsigned* bar = b.bar;
        const unsigned bx = xb_xcc_id();
        __builtin_amdgcn_s_waitcnt(0);
        unsigned nloc = b.st[0], nx = b.st[1];
        if (nloc == 0u) { xcd_barrier_complete(bar, bx, nloc, nx); b.st[0] = nloc; b.st[1] = nx; }
        const unsigned old = xb_add(&bar[XB_XSUB(bx)], 1u);
        const unsigned gen = old / nloc;
        if (old + 1u == (gen + 1u) * nloc) {
            __builtin_amdgcn_fence(__ATOMIC_RELEASE, "agent");
            asm volatile("s_waitcnt vmcnt(0)" ::: "memory");
            const unsigned og = xb_add(&bar[XB_TOP], 1u);
            const unsigned tg = og / nx;
            if (og + 1u == (tg + 1u) * nx) xb_add(&bar[XB_TOPGEN], 1u);
            else XB_SPIN(xb_ld(&bar[XB_TOPGEN]) == tg, bar);
            __builtin_amdgcn_fence(__ATOMIC_ACQUIRE, "agent");
            xb_add(&bar[XB_XGEN(bx)], 1u);
            asm volatile("s_waitcnt vmcnt(0)" ::: "memory");
        } else {
            XB_SPIN(xb_ld(&bar[XB_XGEN(bx)]) == gen, bar);
            __builtin_amdgcn_fence(__ATOMIC_ACQUIRE, "agent");
            asm volatile("s_waitcnt vmcnt(0)" ::: "memory");
        }
    }
    __syncthreads();
}

constexpr int NT = 512;
constexpr int LDS_HDR = 1024;
#define GTID ((size_t)blockIdx.x * NT + tid)
__device__ __forceinline__ int opaque_tid(int wv) { int t = (wv << 6) | lane_id(); asm volatile("" : "+v"(t)); return t; }
#define GNT  ((size_t)gridDim.x * NT)

__device__ void ph_transpose(const float* __restrict__ W, bf16_t* __restrict__ Wt, int K, int N, unsigned char* ldsraw, const int wv) {
    const int tid = opaque_tid(wv);
    LAS bf16_t* T = (LAS bf16_t*)ldsraw;
    const int tk = K / 128, tn = N / 64, ntiles = tk * tn;
    for (int tile = blockIdx.x; tile < ntiles; tile += gridDim.x) {
        const int k0 = (tile % tk) * 128, n0 = (tile / tk) * 64;
#pragma unroll 4
        for (int i = 0; i < 16; ++i) {
            const int kl = i * 8 + (tid >> 6), nl = tid & 63;
            T[nl * 130 + kl] = f2bf(W[(size_t)(k0 + kl) * N + n0 + nl]);
        }
        __syncthreads();
        {
            const int nl = tid >> 3, kc = tid & 7;
            unsigned w[8];
#pragma unroll
            for (int i = 0; i < 8; ++i) w[i] = (unsigned)T[nl * 130 + kc * 16 + 2 * i] | ((unsigned)T[nl * 130 + kc * 16 + 2 * i + 1] << 16);
            bf16_t* dst = Wt + (size_t)(n0 + nl) * K + k0 + kc * 16;
            *reinterpret_cast<u32x4*>(dst) = u32x4{w[0], w[1], w[2], w[3]};
            *reinterpret_cast<u32x4*>(dst + 8) = u32x4{w[4], w[5], w[6], w[7]};
        }
        __syncthreads();
    }
}
__device__ void ph_convert(const float* __restrict__ src, bf16_t* __restrict__ dst, size_t n, const int wv) {
    const int tid = opaque_tid(wv);
    for (size_t idx = GTID; idx < n; idx += GNT) dst[idx] = f2bf(src[idx]);
}
__device__ void ph_convert_fp8_rows(const float* __restrict__ src, unsigned char* __restrict__ dst, float* __restrict__ scl, int nrows, const int wv) {
    const int tid = opaque_tid(wv);
    const int lane = tid & 63;
    const int gw = blockIdx.x * 8 + (tid >> 6), nw = gridDim.x * 8;
    for (int row = gw; row < nrows; row += nw) {
        const float* sr = src + (size_t)row * D + lane * 16;
        float v[16];
#pragma unroll
        for (int i = 0; i < 4; ++i) { const float4 f = *reinterpret_cast<const float4*>(sr + i * 4); v[i * 4] = f.x; v[i * 4 + 1] = f.y; v[i * 4 + 2] = f.z; v[i * 4 + 3] = f.w; }
        float am = 0.f;
#pragma unroll
        for (int i = 0; i < 16; ++i) am = fmaxf(am, fabsf(v[i]));
#pragma unroll
        for (int o = 32; o >= 1; o >>= 1) am = fmaxf(am, shfl_x(am, lane, o));
        const float sc = am > 0.f ? 224.f / am : 1.f;
        unsigned w[4];
#pragma unroll
        for (int i = 0; i < 4; ++i) {
            int pk = 0;
            pk = __builtin_amdgcn_cvt_pk_fp8_f32(v[i * 4] * sc, v[i * 4 + 1] * sc, pk, false);
            pk = __builtin_amdgcn_cvt_pk_fp8_f32(v[i * 4 + 2] * sc, v[i * 4 + 3] * sc, pk, true);
            w[i] = (unsigned)pk;
        }
        {
            const int lyr = row >> 14, e = row & (NEXP - 1);
            *reinterpret_cast<u32x4*>(dst + (((size_t)lyr * 8 + (lane >> 3)) * NEXP + e) * 128 + (lane & 7) * 16) = u32x4{w[0], w[1], w[2], w[3]};
        }
        if (lane == 0) scl[row] = am > 0.f ? am * (1.f / 224.f) : 1.f;
    }
}
__device__ void ph_mod(const Params& p, unsigned char* ldsraw, const int wv) {
    const int tid = opaque_tid(wv);
    LAS float* sl = (LAS float*)ldsraw;
    LAS float* red = sl + 5 * 1024;
    for (int i = tid; i < 5 * 1024; i += NT) {
        const int cv = i >> 10, k = i & 1023;
        const float c = cv == 0 ? p.in[I_CCTX][k] : p.in[I_C][(size_t)(cv - 1) * D + k];
        sl[i] = c / (1.f + __expf(-c));
    }
    __syncthreads();
    const int c = tid & 63, ks = tid >> 6;
    for (int item = blockIdx.x; item < 2 * 96; item += gridDim.x) {
        const int l = item / 96, j = (item % 96) * 64 + c;
        const float* W = p.in[I_ADAW] + (size_t)l * D * 6144 + (size_t)(ks * 128) * 6144 + j;
        float acc[5] = {0.f, 0.f, 0.f, 0.f, 0.f};
#pragma unroll 8
        for (int k = 0; k < 128; ++k) {
            const float w = W[(size_t)k * 6144];
#pragma unroll
            for (int cv = 0; cv < 5; ++cv) acc[cv] += sl[cv * 1024 + ks * 128 + k] * w;
        }
#pragma unroll
        for (int cv = 0; cv < 5; ++cv) red[(ks * 5 + cv) * 64 + c] = acc[cv];
        __syncthreads();
        if (tid < 320) {
            const int cv = tid >> 6;
            float sum = p.in[I_ADAB][l * 6144 + j];
#pragma unroll
            for (int q = 0; q < 8; ++q) sum += red[(q * 5 + cv) * 64 + c];
            ((float*)(p.ws + OFF_MOD))[(size_t)(l * 5 + cv) * 6144 + j] = sum;
        }
        __syncthreads();
    }
}
__device__ void ph_rope_tab(const Params& p, const int wv) {
    const int tid = opaque_tid(wv);
    for (size_t idx = GTID; idx < 2048 * 48; idx += GNT) {
        int s = idx / 48, i = idx % 48;
        float* R = (float*)(p.ws + OFF_ROPE);
        double row = (double)(s / 64), col = (double)(s % 64);
        if (i < 16) {
            int q = i & 7; double inv = pow(10000.0, -(double)q / 8.0);
            double ang = (i < 8 ? row : col) * inv;
            R[s * 16 + i] = (float)cos(ang); R[2048 * 16 + s * 16 + i] = (float)sin(ang);
        } else {
            int ii = i - 16; int q = ii & 15; double inv = pow(10000.0, -(double)q / 16.0);
            double ang = (ii < 16 ? row : col) * inv;
            R[2048 * 32 + s * 32 + ii] = (float)cos(ang); R[2048 * 64 + s * 32 + ii] = (float)sin(ang);
        }
    }
}
__device__ void ph_cache_prep(const Params& p, int l, const int wv) {
    const int tid = opaque_tid(wv);
    bf16_t* DKS = (bf16_t*)(p.ws + OFF_DKS); bf16_t* DVTS = (bf16_t*)(p.ws + OFF_DVTS);
    bf16_t* GKS = (bf16_t*)(p.ws + OFF_GKS); bf16_t* GVTS = (bf16_t*)(p.ws + OFF_GVTS);
    for (size_t idx = GTID; idx < 4 * 512 * 256; idx += GNT) {
        int c = idx & 255, pp = (idx >> 8) & 511, b = idx >> 17;
        size_t src = (((size_t)b * 2 + l) * PAST + pp) * 256 + c;
        int h = c >> 6, r = c & 63;
        DKS[(((size_t)b * 4 + h) * NKS + DSEQ + pp) * 64 + r] = f2bf(p.in[I_CDK][src]);
        DVTS[(((size_t)b * 4 + h) * 64 + r) * NKS + DSEQ + pp] = f2bf(p.in[I_CDV][src]);
        if (c < 128) {
            size_t src2 = (((size_t)b * 2 + l) * PAST + pp) * 128 + c;
            int kv = c >> 6;
            GKS[(((size_t)b * 2 + kv) * NKS + DSEQ + pp) * 64 + r] = f2bf(p.in[I_CGK][src2]);
            GVTS[(((size_t)b * 2 + kv) * 64 + r) * NKS + DSEQ + pp] = f2bf(p.in[I_CGV][src2]);
        }
    }
}
__device__ void ph_norm_mod(const Params& p, int l, int which, int from_input, const int wv) {
    const int tid = opaque_tid(wv);
    const int lane = tid & 63;
    const int gw = blockIdx.x * 8 + (tid >> 6), nw = gridDim.x * 8;
    const float* g = p.in[which ? I_N2G : I_N1G] + l * D;
    for (int t = gw; t < NTOK; t += nw) {
        const float* xr = from_input ? x_in_row(p, t) : (const float*)(p.ws + OFF_XC) + (size_t)t * D;
        const float* mod = (const float*)(p.ws + OFF_MOD) + (size_t)(l * 5 + tok_cv(t)) * 6144 + which * 3072;
        float4 v[4]; float ss = 0.f;
#pragma unroll
        for (int i = 0; i < 4; ++i) { v[i] = *reinterpret_cast<const float4*>(xr + i * 256 + lane * 4); ss += v[i].x * v[i].x + v[i].y * v[i].y + v[i].z * v[i].z + v[i].w * v[i].w; }
        ss = wave_sum(ss);
        float r = rsqrtf(ss / D + EPS);
        bf16_t* H = (bf16_t*)(p.ws + OFF_H) + (size_t)t * D;
#pragma unroll
        for (int i = 0; i < 4; ++i) {
            int c = i * 256 + lane * 4;
            float4 gg = *reinterpret_cast<const float4*>(g + c), sh = *reinterpret_cast<const float4*>(mod + c), sc = *reinterpret_cast<const float4*>(mod + 1024 + c);
            ushort4 o;
            o.x = f2bf(v[i].x * r * gg.x * (1.f + sc.x) + sh.x); o.y = f2bf(v[i].y * r * gg.y * (1.f + sc.y) + sh.y);
            o.z = f2bf(v[i].z * r * gg.z * (1.f + sc.z) + sh.z); o.w = f2bf(v[i].w * r * gg.w * (1.f + sc.w) + sh.w);
            *reinterpret_cast<ushort4*>(H + c) = o;
        }
    }
}
__device__ void ph_sgu_norm(const Params& p, int l, const int wv) {
    const int tid = opaque_tid(wv);
    const int lane = tid & 63;
    const int gw = blockIdx.x * 8 + (tid >> 6), nw = gridDim.x * 8;
    for (int t = gw; t < NTOK; t += nw) {
        const bf16_t* AV = (const bf16_t*)(p.ws + OFF_AV) + (size_t)t * 256;
        float v[4]; float ss = 0.f;
#pragma unroll
        for (int i = 0; i < 4; ++i) { v[i] = bf2f(AV[i * 64 + lane]); ss += v[i] * v[i]; }
        ss = wave_sum(ss);
        float r = rsqrtf(ss / 256.f + EPS);
#pragma unroll
        for (int i = 0; i < 4; ++i) ((bf16_t*)(p.ws + OFF_AVN))[(size_t)t * 256 + i * 64 + lane] = f2bf(v[i] * r * p.in[I_SGUNG][l * 256 + i * 64 + lane]);
    }
}
__device__ void ph_sgu_mix(const Params& p, int l, const int wv) {
    const int tid = opaque_tid(wv);
    const bf16_t* AVN = (const bf16_t*)(p.ws + OFF_AVN);
    for (size_t idx = GTID; idx < (size_t)NTOK * 256; idx += GNT) {
        int t = (int)(idx >> 8), c = (int)(idx & 255);
        int t0 = t & ~127, pp = t & 127, g = c >> 6;
        const bf16_t* W = (const bf16_t*)(p.ws + OFF_SGUW) + (((size_t)l * 4 + g) * 128 + pp) * 128;
        float acc = 0.f;
        for (int q = 0; q < 128; ++q) acc += bf2f(W[q]) * bf2f(AVN[(size_t)(t0 + q) * 256 + c]);
        acc += p.in[I_SGUB][(l * 4 + g) * 128 + pp];
        float au = bf2f(((const bf16_t*)(p.ws + OFF_AU))[(size_t)t * 256 + c]);
        ((bf16_t*)(p.ws + OFF_MIX))[(size_t)t * D + c] = f2bf(au * acc);
    }
}
__device__ void ph_attn_ref(const Params& p, int l, const int wv) {
    const int tid = opaque_tid(wv);
    const int lane = tid & 63;
    const int gw = blockIdx.x * 8 + (tid >> 6), nw = gridDim.x * 8;
    const float lam = lam_of(p, l);
    for (int item = gw; item < NTOK * 12; item += nw) {
        const int t = item % NTOK, hh = item / NTOK;
        const bool prompt = t < NPT;
        const int b = prompt ? t / SEQ : (t - NPT) / DSEQ;
        const int nk = prompt ? SEQ : NKS;
        if (hh < 4) {
            const int h = hh;
            const bf16_t* K = prompt ? (const bf16_t*)(p.ws + OFF_DKP) + ((size_t)b * 4 + h) * SEQ * 64 : (const bf16_t*)(p.ws + OFF_DKS) + ((size_t)b * 4 + h) * NKS * 64;
            const bf16_t* Vt = prompt ? (const bf16_t*)(p.ws + OFF_DVTP) + ((size_t)b * 4 + h) * 64 * SEQ : (const bf16_t*)(p.ws + OFF_DVTS) + ((size_t)b * 4 + h) * 64 * NKS;
            float q = bf2f(((const bf16_t*)(p.ws + OFF_DQ))[(size_t)t * 256 + h * 64 + lane]);
            const float scale = 0.17677669529663687f;
            float m0 = -1e30f, m1 = -1e30f, l0 = 0.f, l1 = 0.f, a0 = 0.f, a1 = 0.f;
            for (int k = 0; k < nk; ++k) {
                float pr = q * bf2f(K[(size_t)k * 64 + lane]);
#pragma unroll
                for (int o = 16; o >= 1; o >>= 1) pr += shfl_x(pr, lane, o);
                float s0 = shfl_i(pr, 0) * scale, s1 = shfl_i(pr, 32) * scale;
                float v = bf2f(Vt[(size_t)lane * nk + k]);
                float mn0 = fmaxf(m0, s0), mn1 = fmaxf(m1, s1);
                float c0 = expf(m0 - mn0), c1 = expf(m1 - mn1);
                float e0 = expf(s0 - mn0), e1 = expf(s1 - mn1);
                l0 = l0 * c0 + e0; l1 = l1 * c1 + e1;
                a0 = a0 * c0 + e0 * v; a1 = a1 * c1 + e1 * v;
                m0 = mn0; m1 = mn1;
            }
            float o = a0 / l0 - lam * a1 / l1;
            float ss = wave_sum(o * o);
            float r = rsqrtf(ss / 64.f + EPS);
            o = o * r * p.in[I_SUBLN][l * 64 + lane] * (1.f - lam_init_of(l));
            ((bf16_t*)(p.ws + OFF_MIX))[(size_t)t * D + 256 + h * 64 + lane] = f2bf(o);
        } else {
            const int hq = hh - 4, kv = hq >> 2;
            const bf16_t* K = prompt ? (const bf16_t*)(p.ws + OFF_GKP) + ((size_t)b * 2 + kv) * SEQ * 64 : (const bf16_t*)(p.ws + OFF_GKS) + ((size_t)b * 2 + kv) * NKS * 64;
            const bf16_t* Vt = prompt ? (const bf16_t*)(p.ws + OFF_GVTP) + ((size_t)b * 2 + kv) * 64 * SEQ : (const bf16_t*)(p.ws + OFF_GVTS) + ((size_t)b * 2 + kv) * 64 * NKS;
            float q = bf2f(((const bf16_t*)(p.ws + OFF_GQ))[(size_t)t * 512 + hq * 64 + lane]);
            float m = -1e30f, ls = 0.f, a = 0.f;
            for (int k = 0; k < nk; ++k) {
                float s = wave_sum(q * bf2f(K[(size_t)k * 64 + lane])) * 0.125f;
                float v = bf2f(Vt[(size_t)lane * nk + k]);
                float mn = fmaxf(m, s);
                float c = expf(m - mn), e = expf(s - mn);
                ls = ls * c + e; a = a * c + e * v; m = mn;
            }
            ((bf16_t*)(p.ws + OFF_MIX))[(size_t)t * D + 512 + hq * 64 + lane] = f2bf(a / ls);
        }
    }
}
__device__ void ph_peer_scores(const Params& p, int l, const int wv) {
    const int tid = opaque_tid(wv);
    const bf16_t* SK = (const bf16_t*)(p.ws + OFF_SUBK) + (size_t)l * 2 * 128 * 64;
    for (size_t idx = GTID; idx < (size_t)NTOK * 2048; idx += GNT) {
        int t = (int)(idx >> 11), o = (int)(idx & 2047);
        const bf16_t* Q = (const bf16_t*)(p.ws + OFF_Q) + (size_t)t * D;
        int n = o & 127, x = (o >> 7) & 1, h = o >> 8;
        float acc = 0.f;
        for (int k = 0; k < 64; ++k) acc += bf2f(Q[h * 128 + x * 64 + k]) * bf2f(SK[((size_t)x * 128 + n) * 64 + k]);
        ((float*)(p.ws + OFF_PROJ))[idx] = acc;
    }
}
__device__ void ph_peer_top1(const Params& p, const int wv) {
    const int tid = opaque_tid(wv);
    for (size_t idx = GTID; idx < (size_t)NTOK * 16; idx += GNT) {
        const float* SC = (const float*)(p.ws + OFF_PROJ) + idx * 128;
        float* TV = (float*)(p.ws + OFF_TOPV) + idx * 16; int* TI = (int*)(p.ws + OFF_TOPI) + idx * 16;
        float pv = 3.0e38f; int pi = -1;
        for (int r = 0; r < 16; ++r) {
            float bv = -3.0e38f; int bi = -1;
            for (int n = 0; n < 128; ++n) {
                float v = SC[n];
                bool after = (v < pv) || (v == pv && n > pi);
                if (after && (bi < 0 || v > bv)) { bv = v; bi = n; }
            }
            TV[r] = bv; TI[r] = bi; pv = bv; pi = bi;
        }
    }
}
__device__ void ph_peer_top2(const Params& p, const int wv) {
    const int tid = opaque_tid(wv);
    for (size_t idx = GTID; idx < (size_t)NTOK * 8; idx += GNT) {
        const float* TV = (const float*)(p.ws + OFF_TOPV) + idx * 32; const int* TI = (const int*)(p.ws + OFF_TOPI) + idx * 32;
        int* EI = (int*)(p.ws + OFF_EIDX) + idx * 16; float* EG = (float*)(p.ws + OFF_EGATE) + idx * 16;
        float pv = 3.0e38f; int pi = -1; float mx = 0.f, sum = 0.f;
        for (int r = 0; r < 16; ++r) {
            float bv = -3.0e38f; int bi = -1;
            for (int n = 0; n < 256; ++n) {
                float v = TV[n >> 4] + TV[16 + (n & 15)];
                bool after = (v < pv) || (v == pv && n > pi);
                if (after && (bi < 0 || v > bv)) { bv = v; bi = n; }
            }
            if (r == 0) mx = bv;
            float e = expf(bv - mx);
            sum += e;
            EG[r] = e; EI[r] = TI[bi >> 4] * 128 + TI[16 + (bi & 15)];
            pv = bv; pi = bi;
        }
        float inv = 1.f / sum;
        for (int r = 0; r < 16; ++r) EG[r] *= inv;
    }
}
__device__ void ph_peer_apply(const Params& p, int l, unsigned char* lds, const int wv) {
    const int tid = opaque_tid(wv);
    const int sub = tid >> 8, tl = tid & 255;
    const int wave = tl >> 6, lane = tl & 63;
    float* wts = (float*)(lds + 64) + sub * 128; int* eid = (int*)(lds + 64 + 1024) + sub * 128;
    const bf16_t* UT = (const bf16_t*)(p.ws + OFF_UT) + (size_t)l * NEXP * D;
    const bf16_t* VT = (const bf16_t*)(p.ws + OFF_VT) + (size_t)l * NEXP * D;
    const int niter = (NTOK + gridDim.x * 2 - 1) / (gridDim.x * 2);
    for (int it = 0; it < niter; ++it) {
        int t = (it * gridDim.x + blockIdx.x) * 2 + sub;
        const bool valid = t < NTOK; if (!valid) t = NTOK - 1;
        const bf16_t* H = (const bf16_t*)(p.ws + OFF_H) + (size_t)t * D;
        const int* EI = (const int*)(p.ws + OFF_EIDX) + (size_t)t * 128; const float* EG = (const float*)(p.ws + OFF_EGATE) + (size_t)t * 128;
        float hv[16];
#pragma unroll
        for (int i = 0; i < 16; ++i) hv[i] = bf2f(H[lane * 16 + i]);
        for (int jj = 0; jj < 32; ++jj) {
            int j = wave * 32 + jj; int e = EI[j];
            const bf16_t* ur = UT + (size_t)e * D + lane * 16;
            float acc = 0.f;
#pragma unroll
            for (int i = 0; i < 16; ++i) acc += hv[i] * bf2f(ur[i]);
            acc = wave_sum(acc);
            if (lane == 0) { wts[j] = EG[j] * gelu_f(acc); eid[j] = e; }
        }
        __syncthreads();
        float o[4] = {0.f, 0.f, 0.f, 0.f};
        for (int j = 0; j < 128; ++j) {
            const bf16_t* vr = VT + (size_t)eid[j] * D + tl * 4; float w = wts[j];
#pragma unroll
            for (int i = 0; i < 4; ++i) o[i] += w * bf2f(vr[i]);
        }
        const float* mod = (const float*)(p.ws + OFF_MOD) + (size_t)(l * 5 + tok_cv(t)) * 6144 + 5 * 1024;
        float* XC = (float*)(p.ws + OFF_XC) + (size_t)t * D;
        if (valid) {
#pragma unroll
            for (int i = 0; i < 4; ++i) { int c = tl * 4 + i; XC[c] += mod[c] * o[i]; }
        }
        __syncthreads();
    }
}
__device__ void ph_final_norm(const Params& p, const int wv) {
    const int tid = opaque_tid(wv);
    const int lane = tid & 63;
    const int gw = blockIdx.x * 8 + (tid >> 6), nw = gridDim.x * 8;
    for (int t = gw; t < NTOK; t += nw) {
        const float* xr = (const float*)(p.ws + OFF_XC) + (size_t)t * D;
        float4 v[4]; float ss = 0.f;
#pragma unroll
        for (int i = 0; i < 4; ++i) { v[i] = *reinterpret_cast<const float4*>(xr + i * 256 + lane * 4); ss += v[i].x * v[i].x + v[i].y * v[i].y + v[i].z * v[i].z + v[i].w * v[i].w; }
        ss = wave_sum(ss);
        float r = rsqrtf(ss / D + EPS);
        float* y = p.out + (size_t)t * D;
#pragma unroll
        for (int i = 0; i < 4; ++i) {
            int c = i * 256 + lane * 4;
            float4 g = *reinterpret_cast<const float4*>(p.in[I_FG] + c);
            float4 o; o.x = v[i].x * r * g.x; o.y = v[i].y * r * g.y; o.z = v[i].z * r * g.z; o.w = v[i].w * r * g.w;
            *reinterpret_cast<float4*>(y + c) = o;
        }
    }
}


namespace g8 {
constexpr int BM = 256, BK = 64, HALF = 128, HT = HALF * BK;
__device__ __forceinline__ int lds_byte(int r, int c) {
    int st = (r >> 4) * 2 + (c >> 5), rr = r & 15, cc = c & 31, ob = rr * 64 + cc * 2;
    return st * 1024 + (ob ^ (((ob >> 9) & 1) << 5));
}
__device__ __forceinline__ void stage_rc(int b, int& R, int& C) {
    int st = b / 1024, sb = b % 1024, swz = sb ^ (((sb >> 9) & 1) << 5);
    R = (st >> 1) * 16 + swz / 64; C = (st & 1) * 32 + (swz % 64) / 2;
}
}
enum { EPI_INPROJ = 0, EPI_WOUT = 1, EPI_WQ = 2 };
constexpr int STG = 132;

__device__ __forceinline__ unsigned pack_bf2(float a, float b) { return (unsigned)f2bf(a) | ((unsigned)f2bf(b) << 16); }
__device__ __forceinline__ void store_bf16x32(bf16_t* dst, const float (&v)[32]) {
#pragma unroll
    for (int i = 0; i < 4; ++i) {
        uint4 u;
        u.x = pack_bf2(v[i * 8 + 0], v[i * 8 + 1]); u.y = pack_bf2(v[i * 8 + 2], v[i * 8 + 3]);
        u.z = pack_bf2(v[i * 8 + 4], v[i * 8 + 5]); u.w = pack_bf2(v[i * 8 + 6], v[i * 8 + 7]);
        *reinterpret_cast<uint4*>(dst + i * 8) = u;
    }
}
__device__ __forceinline__ void store_f32x32(float* dst, const float (&v)[32]) {
#pragma unroll
    for (int i = 0; i < 8; ++i) *reinterpret_cast<float4*>(dst + i * 4) = make_float4(v[i * 4], v[i * 4 + 1], v[i * 4 + 2], v[i * 4 + 3]);
}

__device__ __forceinline__ void epi_inproj_row(const Params& p, int l, int t, int c0, float (&v)[32]) {
    const bool prompt = t < NPT;
    const int b = prompt ? (t >> 8) : ((t - NPT) >> 11);
    const int s = prompt ? (t & 255) : ((t - NPT) & 2047);
    unsigned char* ws = p.ws;
    const float* R = (const float*)(ws + OFF_ROPE);
    if (c0 < 512) {
        bf16_t* dst = (bf16_t*)(ws + (c0 < 256 ? OFF_AU : OFF_AV)) + (size_t)t * 256 + (c0 & 255);
#pragma unroll
        for (int i = 0; i < 32; ++i) v[i] = gelu_f(v[i]);
        store_bf16x32(dst, v);
    } else if (c0 < 1024) {
        const bool isq = c0 < 768;
        if (!isq && prompt) store_f32x32(p.out + OUT_NDK + (((size_t)b * 2 + l) * SEQ + s) * 256 + (c0 - 768), v);
        if (!prompt) {
            const float* cs = R + s * 16; const float* sn = R + 2048 * 16 + s * 16;
#pragma unroll
            for (int i = 0; i < 16; ++i) {
                float c = cs[i], sv = sn[i], x1 = v[i], x2 = v[i + 16];
                v[i] = x1 * c - x2 * sv; v[i + 16] = x2 * c + x1 * sv;
            }
        }
        bf16_t* dst;
        if (isq) dst = (bf16_t*)(ws + OFF_DQ) + (size_t)t * 256 + (c0 - 512);
        else {
            const int cc = c0 - 768, h = cc >> 6, r = cc & 63;
            dst = prompt ? (bf16_t*)(ws + OFF_DKP) + (((size_t)b * 4 + h) * SEQ + s) * 64 + r
                         : (bf16_t*)(ws + OFF_DKS) + (((size_t)b * 4 + h) * NKS + s) * 64 + r;
        }
        store_bf16x32(dst, v);
    } else if (c0 < 1280) {
        if (prompt) store_f32x32(p.out + OUT_NDV + (((size_t)b * 2 + l) * SEQ + s) * 256 + (c0 - 1024), v);
    } else if (c0 < 1920) {
        const bool isq = c0 < 1792;
        const int hi = c0 & 32;
        const float* g = p.in[isq ? I_QNG : I_KNG] + l * 64 + hi;
        float ss = 0.f;
#pragma unroll
        for (int i = 0; i < 32; ++i) ss += v[i] * v[i];
        const int ln = lane_id_op();
        ss += shfl_x(ss, ln, 1);
        const float rr = rsqrtf(ss * (1.f / 64.f) + EPS);
#pragma unroll
        for (int i = 0; i < 32; ++i) v[i] = v[i] * rr * g[i];
        if (!isq && prompt) store_f32x32(p.out + OUT_NGK + (((size_t)b * 2 + l) * SEQ + s) * 128 + (c0 - 1792), v);
        if (!prompt) {
            const float* cs = R + 2048 * 32 + s * 32; const float* sn = R + 2048 * 64 + s * 32;
#pragma unroll
            for (int i = 0; i < 32; ++i) {
                float pv = shfl_x(v[i], ln, 1);
                float c = cs[i], sv = sn[i];
                v[i] = hi ? (v[i] * c + pv * sv) : (v[i] * c - pv * sv);
            }
        }
        bf16_t* dst;
        if (isq) dst = (bf16_t*)(ws + OFF_GQ) + (size_t)t * 512 + (c0 - 1280);
        else {
            const int cc = c0 - 1792, kv = cc >> 6, r = cc & 63;
            dst = prompt ? (bf16_t*)(ws + OFF_GKP) + (((size_t)b * 2 + kv) * SEQ + s) * 64 + r
                         : (bf16_t*)(ws + OFF_GKS) + (((size_t)b * 2 + kv) * NKS + s) * 64 + r;
        }
        store_bf16x32(dst, v);
    } else {
        if (prompt) store_f32x32(p.out + OUT_NGV + (((size_t)b * 2 + l) * SEQ + s) * 128 + (c0 - 1920), v);
    }
}
__device__ __forceinline__ void epi_inproj_col(const Params& p, int t0, int c, const LAS float* stc) {
    float v[32];
#pragma unroll
    for (int i = 0; i < 32; ++i) v[i] = stc[i * STG];
    const bool prompt = t0 < NPT;
    const int b = prompt ? (t0 >> 8) : ((t0 - NPT) >> 11);
    const int s = prompt ? (t0 & 255) : ((t0 - NPT) & 2047);
    unsigned char* ws = p.ws;
    bf16_t* dst;
    if (c < 1280) {
        const int cc = c - 1024, h = cc >> 6, d = cc & 63;
        dst = prompt ? (bf16_t*)(ws + OFF_DVTP) + (((size_t)b * 4 + h) * 64 + d) * SEQ + s
                     : (bf16_t*)(ws + OFF_DVTS) + (((size_t)b * 4 + h) * 64 + d) * NKS + s;
    } else {
        const int cc = c - 1920, kv = cc >> 6, d = cc & 63;
        dst = prompt ? (bf16_t*)(ws + OFF_GVTP) + (((size_t)b * 2 + kv) * 64 + d) * SEQ + s
                     : (bf16_t*)(ws + OFF_GVTS) + (((size_t)b * 2 + kv) * 64 + d) * NKS + s;
    }
    store_bf16x32(dst, v);
}

template <int MODE>
__device__ __forceinline__ void gemm_phase(const Params& p, int l, const bf16_t* __restrict__ A, const bf16_t* __restrict__ Bt, const int N, unsigned char* ldsraw, const int wv) {
    using namespace g8;
    constexpr int K = 1024, nt = K / BK, BN = 128, TILE_A = BM * BK * 2, TILE_B = BN * BK * 2, STAGE_B = TILE_A + TILE_B;
    LAS unsigned char* lds = (LAS unsigned char*)ldsraw;
    const int tid = opaque_tid(wv), wid = wv, lane = tid & 63;
    const int wr = wid >> 1, wc = wid & 1, fr = lane & 15, fq = lane >> 4;
    unsigned voff[4];
#pragma unroll
    for (int i = 0; i < 4; ++i) { int R, C; stage_rc(wid * 1024 + i * 8192 + lane * 16, R, C); voff[i] = (unsigned)(R * K + C) * 2u; }
    const int aoff = lds_byte(wr * 64 + fr, fq * 8), boff = lds_byte(wc * 64 + fr, fq * 8);
    const unsigned ldsw = (unsigned)wid * 1024u;
#define G8_STAGE(buf, kt) do { \
        _Pragma("unroll") for (int _i = 0; _i < 4; ++_i) \
            __builtin_amdgcn_global_load_lds((const unsigned*)((const char*)(Ab + (kt) * BK) + voff[_i]), (LAS unsigned*)(lds + (buf) * STAGE_B + ldsw + _i * 8192), 16, 0, 0); \
        _Pragma("unroll") for (int _i = 0; _i < 2; ++_i) \
            __builtin_amdgcn_global_load_lds((const unsigned*)((const char*)(Bb + (kt) * BK) + voff[_i]), (LAS unsigned*)(lds + (buf) * STAGE_B + TILE_A + ldsw + _i * 8192), 16, 0, 0); } while (0)
#define G8_WAIT_V0() asm volatile("s_waitcnt vmcnt(0)" ::: "memory")
    const int nN = N / BN, nM = NTOK / BM, ntiles = nM * nN;
    const int G = gridDim.x;
    const int vb = (G % 8 == 0) ? (int)(blockIdx.x % 8) * (G / 8) + (int)(blockIdx.x / 8) : (int)blockIdx.x;
    const int tpb = (ntiles + G - 1) / G;
    for (int ti = 0; ti < tpb; ++ti) {
        const int tile = vb * tpb + ti;
        if (tile >= ntiles) break;
        const int pm = tile / nN, pn = tile % nN, brow = pm * BM, bcol = pn * BN;
        const bf16_t* Ab = A + (size_t)brow * K; const bf16_t* Bb = Bt + (size_t)bcol * K;
        f32x4 acc[4][4];
#pragma unroll
        for (int m = 0; m < 4; ++m)
#pragma unroll
            for (int n = 0; n < 4; ++n) acc[m][n] = f32x4{0.f, 0.f, 0.f, 0.f};
        G8_WAIT_V0();
        G8_STAGE(0, 0); G8_WAIT_V0(); __syncthreads();
        for (int t = 0; t < nt; ++t) {
            const int cur = t & 1;
            if (t + 1 < nt) G8_STAGE(cur ^ 1, t + 1);
#pragma unroll
            for (int ks = 0; ks < 2; ++ks) {
                bf16x8 At[4], Bf[4];
#pragma unroll
                for (int m = 0; m < 4; ++m) At[m] = *(const LAS bf16x8*)(lds + cur * STAGE_B + aoff + m * 2048 + ks * 1024);
#pragma unroll
                for (int n = 0; n < 4; ++n) Bf[n] = *(const LAS bf16x8*)(lds + cur * STAGE_B + TILE_A + boff + n * 2048 + ks * 1024);
#pragma unroll
                for (int m = 0; m < 4; ++m)
#pragma unroll
                    for (int n = 0; n < 4; ++n) acc[m][n] = __builtin_amdgcn_mfma_f32_16x16x32_bf16(At[m], Bf[n], acc[m][n], 0, 0, 0);
            }
            G8_WAIT_V0(); __syncthreads();
        }
        LAS float* st = (LAS float*)lds;
#pragma unroll
        for (int m = 0; m < 4; ++m)
#pragma unroll
            for (int n = 0; n < 4; ++n)
#pragma unroll
                for (int j = 0; j < 4; ++j)
                    st[(wr * 64 + m * 16 + fq * 4 + j) * STG + wc * 64 + n * 16 + fr] = acc[m][n][j];
        __syncthreads();
#pragma unroll 1
        for (int it = 0; it < 2; ++it) {
            const int item = it * NT + tid, erow = item >> 2, eseg = item & 3;
            const int t = brow + erow, c0 = bcol + eseg * 32;
            float v[32];
#pragma unroll
            for (int i = 0; i < 8; ++i) {
                const f32x4 f = *(const LAS f32x4*)(st + erow * STG + eseg * 32 + i * 4);
                v[i * 4] = f[0]; v[i * 4 + 1] = f[1]; v[i * 4 + 2] = f[2]; v[i * 4 + 3] = f[3];
            }
            if (MODE == EPI_INPROJ) {
                epi_inproj_row(p, l, t, c0, v);
            } else if (MODE == EPI_WOUT) {
                const float* xr = (l == 0 ? x_in_row(p, t) : (const float*)(p.ws + OFF_XC) + (size_t)t * D) + c0;
                const float* g1 = (const float*)(p.ws + OFF_MOD) + (size_t)(l * 5 + tok_cv(t)) * 6144 + 2048 + c0;
                float* xo = (float*)(p.ws + OFF_XC) + (size_t)t * D + c0;
#pragma unroll
                for (int i = 0; i < 8; ++i) {
                    const float4 x = *reinterpret_cast<const float4*>(xr + i * 4), g = *reinterpret_cast<const float4*>(g1 + i * 4);
                    *reinterpret_cast<float4*>(xo + i * 4) = make_float4(x.x + g.x * v[i * 4], x.y + g.y * v[i * 4 + 1], x.z + g.z * v[i * 4 + 2], x.w + g.w * v[i * 4 + 3]);
                }
            } else {
                store_bf16x32((bf16_t*)(p.ws + OFF_Q) + (size_t)t * D + c0, v);
            }
        }
        if (MODE == EPI_INPROJ && ((bcol >= 1024 && bcol < 1280) || bcol >= 1920)) {
#pragma unroll 1
            for (int it = 0; it < 2; ++it) {
                const int item = it * NT + tid, col = item >> 3, run = item & 7;
                epi_inproj_col(p, brow + run * 32, bcol + col, st + run * 32 * STG + col);
            }
        }
        __syncthreads();
    }
}


#define MFMA32(a, b, c) __builtin_amdgcn_mfma_f32_32x32x16_bf16((a), (b), (c), 0, 0, 0)
constexpr int ATT_ROWB = 144;
constexpr int ATT_TILEB = 64 * ATT_ROWB;
constexpr int QW_MIX = 4096;

__device__ __forceinline__ bf16x8 pack8(const f32x16& x, int s) {
    bf16x8 r;
#pragma unroll
    for (int j = 0; j < 8; ++j) r[j] = (short)f2bf(x[8 * s + j]);
    return r;
}
__device__ __forceinline__ void softmax_tile(f32x16& s0, f32x16& s1, const float sc, float& m, float& l, float& alpha, const int lane) {
    float mx = fmaxf(s0[0], s1[0]);
#pragma unroll
    for (int i = 1; i < 16; ++i) mx = fmaxf(mx, fmaxf(s0[i], s1[i]));
    mx = fmaxf(mx, shfl_x(mx, lane, 32));
    const float mnew = fmaxf(m, mx * sc);
    alpha = __builtin_amdgcn_exp2f(m - mnew);
    m = mnew;
    float ps = 0.f;
#pragma unroll
    for (int i = 0; i < 16; ++i) { s0[i] = __builtin_amdgcn_exp2f(s0[i] * sc - mnew); s1[i] = __builtin_amdgcn_exp2f(s1[i] * sc - mnew); ps += s0[i] + s1[i]; }
    l = l * alpha + ps;
}
__device__ __forceinline__ void pv_tile(const LAS unsigned char* vb, const f32x16& p0, const f32x16& p1, f32x16 (&O)[2], int r, int hh) {
#pragma unroll
    for (int u = 0; u < 2; ++u)
#pragma unroll
        for (int sk = 0; sk < 2; ++sk) {
            const bf16x8 pf = pack8(u ? p1 : p0, sk);
#pragma unroll
            for (int mt = 0; mt < 2; ++mt) {
                const LAS unsigned char* a = vb + (32 * mt + r) * ATT_ROWB + (32 * u + 16 * sk + 4 * hh) * 2;
                const s16x4 lo = *(const LAS s16x4*)a, hi = *(const LAS s16x4*)(a + 16);
                const bf16x8 af = {lo[0], lo[1], lo[2], lo[3], hi[0], hi[1], hi[2], hi[3]};
                O[mt] = MFMA32(af, pf, O[mt]);
            }
        }
}

template <bool DIFF>
__device__ __forceinline__ void attn_item(const Params& p, int l, LAS unsigned char* lds, const int tid,
                                          const bf16_t* __restrict__ Qg, const int qstride,
                                          const bf16_t* __restrict__ Kg, const bf16_t* __restrict__ Vtg, const int nk,
                                          bf16_t* __restrict__ Og, const float lam) {
    const int wave = tid >> 6, lane = tid & 63, r = lane & 31, hh = lane >> 5;
    const int lrow = tid >> 3, lchunk = tid & 7;
    LAS unsigned char* kbuf = lds; LAS unsigned char* vbuf = lds + 2 * ATT_TILEB;
    bf16x8 qf[4];
    const bf16_t* qrow = Qg + (size_t)(wave * 32 + r) * qstride;
#pragma unroll
    for (int ks = 0; ks < 4; ++ks) qf[ks] = *reinterpret_cast<const bf16x8*>(qrow + ks * 16 + hh * 8);
    const float sc = (DIFF ? 0.17677669529663687f : 0.125f) * 1.4426950408889634f;
    f32x16 O0[2], O1[2];
#pragma unroll
    for (int mt = 0; mt < 2; ++mt)
#pragma unroll
        for (int i = 0; i < 16; ++i) { O0[mt][i] = 0.f; O1[mt][i] = 0.f; }
    float m0 = -1e30f, l0 = 0.f, m1 = -1e30f, l1 = 0.f;
    const int ntl = nk / 64;
    u32x4 kr, vr;
    kr = *reinterpret_cast<const u32x4*>(Kg + (size_t)lrow * 64 + lchunk * 8);
    vr = *reinterpret_cast<const u32x4*>(Vtg + (size_t)lrow * nk + lchunk * 8);
    *(LAS u32x4*)(kbuf + lrow * ATT_ROWB + lchunk * 16) = kr;
    *(LAS u32x4*)(vbuf + lrow * ATT_ROWB + lchunk * 16) = vr;
    __syncthreads();
    for (int ti = 0; ti < ntl; ++ti) {
        const int cur = ti & 1;
        if (ti + 1 < ntl) {
            kr = *reinterpret_cast<const u32x4*>(Kg + (size_t)((ti + 1) * 64 + lrow) * 64 + lchunk * 8);
            vr = *reinterpret_cast<const u32x4*>(Vtg + (size_t)lrow * nk + (ti + 1) * 64 + lchunk * 8);
        }
        const LAS unsigned char* kb = kbuf + cur * ATT_TILEB; const LAS unsigned char* vb = vbuf + cur * ATT_TILEB;
        if (!DIFF) {
            f32x16 s0, s1;
#pragma unroll
            for (int i = 0; i < 16; ++i) { s0[i] = 0.f; s1[i] = 0.f; }
#pragma unroll
            for (int ks = 0; ks < 4; ++ks) {
                const bf16x8 a0 = *(const LAS bf16x8*)(kb + r * ATT_ROWB + (ks * 16 + hh * 8) * 2);
                const bf16x8 a1 = *(const LAS bf16x8*)(kb + (32 + r) * ATT_ROWB + (ks * 16 + hh * 8) * 2);
                s0 = MFMA32(a0, qf[ks], s0); s1 = MFMA32(a1, qf[ks], s1);
            }
            float alpha;
            softmax_tile(s0, s1, sc, m0, l0, alpha, lane);
#pragma unroll
            for (int mt = 0; mt < 2; ++mt)
#pragma unroll
                for (int i = 0; i < 16; ++i) O0[mt][i] *= alpha;
            pv_tile(vb, s0, s1, O0, r, hh);
        } else {
#pragma unroll
            for (int x = 0; x < 2; ++x) {
                f32x16 s0, s1;
#pragma unroll
                for (int i = 0; i < 16; ++i) { s0[i] = 0.f; s1[i] = 0.f; }
#pragma unroll
                for (int ks = 0; ks < 2; ++ks) {
                    const bf16x8 a0 = *(const LAS bf16x8*)(kb + r * ATT_ROWB + (x * 32 + ks * 16 + hh * 8) * 2);
                    const bf16x8 a1 = *(const LAS bf16x8*)(kb + (32 + r) * ATT_ROWB + (x * 32 + ks * 16 + hh * 8) * 2);
                    s0 = MFMA32(a0, qf[x * 2 + ks], s0); s1 = MFMA32(a1, qf[x * 2 + ks], s1);
                }
                float alpha;
                if (x == 0) {
                    softmax_tile(s0, s1, sc, m0, l0, alpha, lane);
#pragma unroll
                    for (int mt = 0; mt < 2; ++mt)
#pragma unroll
                        for (int i = 0; i < 16; ++i) O0[mt][i] *= alpha;
                    pv_tile(vb, s0, s1, O0, r, hh);
                } else {
                    softmax_tile(s0, s1, sc, m1, l1, alpha, lane);
#pragma unroll
                    for (int mt = 0; mt < 2; ++mt)
#pragma unroll
                        for (int i = 0; i < 16; ++i) O1[mt][i] *= alpha;
                    pv_tile(vb, s0, s1, O1, r, hh);
                }
            }
        }
        if (ti + 1 < ntl) {
            *(LAS u32x4*)(kbuf + (cur ^ 1) * ATT_TILEB + lrow * ATT_ROWB + lchunk * 16) = kr;
            *(LAS u32x4*)(vbuf + (cur ^ 1) * ATT_TILEB + lrow * ATT_ROWB + lchunk * 16) = vr;
        }
        __syncthreads();
    }
    l0 += shfl_x(l0, lane, 32);
    const float inv0 = 1.f / l0;
    bf16_t* orow = Og + (size_t)(wave * 32 + r) * D;
    if (!DIFF) {
#pragma unroll
        for (int mt = 0; mt < 2; ++mt)
#pragma unroll
            for (int g = 0; g < 4; ++g) {
                uint2 w;
                w.x = pack_bf2(O0[mt][4 * g] * inv0, O0[mt][4 * g + 1] * inv0);
                w.y = pack_bf2(O0[mt][4 * g + 2] * inv0, O0[mt][4 * g + 3] * inv0);
                *reinterpret_cast<uint2*>(orow + 32 * mt + 8 * g + 4 * hh) = w;
            }
    } else {
        l1 += shfl_x(l1, lane, 32);
        const float inv1 = lam / l1;
        float ss = 0.f;
#pragma unroll
        for (int mt = 0; mt < 2; ++mt)
#pragma unroll
            for (int i = 0; i < 16; ++i) { const float o = O0[mt][i] * inv0 - O1[mt][i] * inv1; O0[mt][i] = o; ss += o * o; }
        ss += shfl_x(ss, lane, 32);
        const float rr = rsqrtf(ss * (1.f / 64.f) + EPS) * __builtin_bit_cast(float, __builtin_amdgcn_readfirstlane(__builtin_bit_cast(int, 1.f - lam_init_of(l))));
        const float* sg = p.in[I_SUBLN] + l * 64;
#pragma unroll
        for (int mt = 0; mt < 2; ++mt)
#pragma unroll
            for (int g = 0; g < 4; ++g) {
                const int d0 = 32 * mt + 8 * g + 4 * hh;
                const float4 gg = *reinterpret_cast<const float4*>(sg + d0);
                uint2 w;
                w.x = pack_bf2(O0[mt][4 * g] * rr * gg.x, O0[mt][4 * g + 1] * rr * gg.y);
                w.y = pack_bf2(O0[mt][4 * g + 2] * rr * gg.z, O0[mt][4 * g + 3] * rr * gg.w);
                *reinterpret_cast<uint2*>(orow + d0) = w;
            }
    }
}

constexpr int SGU_ROWB = 272;
__device__ __forceinline__ void sgu_item(const Params& p, int l, LAS unsigned char* lds, const int tid, const int t0) {
    const bf16_t* AV = (const bf16_t*)(p.ws + OFF_AV) + (size_t)t0 * 256;
    {
        const int q = tid >> 2, quarter = tid & 3;
        float v[64]; float ss = 0.f;
#pragma unroll
        for (int i = 0; i < 8; ++i) {
            const bf16x8 w = *reinterpret_cast<const bf16x8*>(AV + (size_t)q * 256 + quarter * 64 + i * 8);
#pragma unroll
            for (int j = 0; j < 8; ++j) { v[i * 8 + j] = bf2f((bf16_t)w[j]); ss += v[i * 8 + j] * v[i * 8 + j]; }
        }
        { const int ln = tid & 63; ss += shfl_x(ss, ln, 1); ss += shfl_x(ss, ln, 2); }
        const float rstd = rsqrtf(ss * (1.f / 256.f) + EPS);
        const float* g = p.in[I_SGUNG] + l * 256 + quarter * 64;
#pragma unroll
        for (int i = 0; i < 64; ++i)
            *(LAS bf16_t*)(lds + (quarter * 64 + i) * SGU_ROWB + q * 2) = f2bf(v[i] * rstd * g[i]);
    }
    __syncthreads();
    {
        const int wave = tid >> 6, lane = tid & 63, r = lane & 31, hh = lane >> 5;
        const int g = wave >> 1, ph = wave & 1;
        const bf16_t* W = (const bf16_t*)(p.ws + OFF_SGUW) + ((size_t)l * 4 + g) * 128 * 128;
        f32x16 acc[2][2];
#pragma unroll
        for (int a = 0; a < 2; ++a)
#pragma unroll
            for (int b = 0; b < 2; ++b)
#pragma unroll
                for (int i = 0; i < 16; ++i) acc[a][b][i] = 0.f;
#pragma unroll
        for (int ks = 0; ks < 8; ++ks) {
            bf16x8 af[2], bfr[2];
#pragma unroll
            for (int pt = 0; pt < 2; ++pt) af[pt] = *reinterpret_cast<const bf16x8*>(W + (size_t)(ph * 64 + pt * 32 + r) * 128 + ks * 16 + hh * 8);
#pragma unroll
            for (int ct = 0; ct < 2; ++ct) bfr[ct] = *(const LAS bf16x8*)(lds + (g * 64 + ct * 32 + r) * SGU_ROWB + (ks * 16 + hh * 8) * 2);
#pragma unroll
            for (int pt = 0; pt < 2; ++pt)
#pragma unroll
                for (int ct = 0; ct < 2; ++ct) acc[pt][ct] = MFMA32(af[pt], bfr[ct], acc[pt][ct]);
        }
        const float* bias = p.in[I_SGUB] + (l * 4 + g) * 128;
        const bf16_t* AU = (const bf16_t*)(p.ws + OFF_AU);
        bf16_t* MIX = (bf16_t*)(p.ws + OFF_MIX);
#pragma unroll
        for (int pt = 0; pt < 2; ++pt)
#pragma unroll
            for (int ct = 0; ct < 2; ++ct)
#pragma unroll
                for (int i = 0; i < 16; ++i) {
                    const int pp = ph * 64 + pt * 32 + (i & 3) + 8 * (i >> 2) + 4 * hh, c = g * 64 + ct * 32 + r;
                    const float au = bf2f(AU[(size_t)(t0 + pp) * 256 + c]);
                    MIX[(size_t)(t0 + pp) * D + c] = f2bf(au * (acc[pt][ct][i] + bias[pp]));
                }
    }
    __syncthreads();
}

__device__ void ph_mixers(const Params& p, int lq, unsigned char* ldsraw, const int wv) {
    const int l = lq & 1;
    const int tid0 = opaque_tid(wv);
    LAS unsigned char* lds = (LAS unsigned char*)ldsraw;
    volatile LAS int* qslot = (volatile LAS int*)(ldsraw - LDS_HDR + 64);
    unsigned* qw = (unsigned*)(p.ws + OFF_BAR) + QW_MIX + lq;
    const float lam = __builtin_bit_cast(float, __builtin_amdgcn_readfirstlane(__builtin_bit_cast(int, lam_of(p, l))));
    unsigned char* ws = p.ws;
    for (;;) {
        if (tid0 == 0) *qslot = (int)atomicAdd(qw, 1u);
        __syncthreads();
        const int item = *qslot;
        __syncthreads();
        if (item >= 896) break;
        int tid = tid0; asm volatile("" : "+v"(tid));
        if (item < 128) {
            const int qc = item & 7, h = (item >> 3) & 3, b = item >> 5;
            const int t0 = NPT + b * DSEQ + qc * 256;
            attn_item<true>(p, l, lds, tid, (const bf16_t*)(ws + OFF_DQ) + (size_t)t0 * 256 + h * 64, 256,
                            (const bf16_t*)(ws + OFF_DKS) + ((size_t)b * 4 + h) * NKS * 64, (const bf16_t*)(ws + OFF_DVTS) + ((size_t)b * 4 + h) * 64 * NKS, NKS,
                            (bf16_t*)(ws + OFF_MIX) + (size_t)t0 * D + 256 + h * 64, lam);
        } else if (item < 384) {
            const int it = item - 128, qc = it & 7, hq = (it >> 3) & 7, b = it >> 6, kv = hq >> 2;
            const int t0 = NPT + b * DSEQ + qc * 256;
            attn_item<false>(p, l, lds, tid, (const bf16_t*)(ws + OFF_GQ) + (size_t)t0 * 512 + hq * 64, 512,
                             (const bf16_t*)(ws + OFF_GKS) + ((size_t)b * 2 + kv) * NKS * 64, (const bf16_t*)(ws + OFF_GVTS) + ((size_t)b * 2 + kv) * 64 * NKS, NKS,
                             (bf16_t*)(ws + OFF_MIX) + (size_t)t0 * D + 512 + hq * 64, lam);
        } else if (item < 512) {
            sgu_item(p, l, lds, tid, (item - 384) * 128);
        } else if (item < 768) {
            const int it = item - 512, hq = it & 7, b = it >> 3, kv = hq >> 2;
            const int t0 = b * SEQ;
            attn_item<false>(p, l, lds, tid, (const bf16_t*)(ws + OFF_GQ) + (size_t)t0 * 512 + hq * 64, 512,
                             (const bf16_t*)(ws + OFF_GKP) + ((size_t)b * 2 + kv) * SEQ * 64, (const bf16_t*)(ws + OFF_GVTP) + ((size_t)b * 2 + kv) * 64 * SEQ, SEQ,
                             (bf16_t*)(ws + OFF_MIX) + (size_t)t0 * D + 512 + hq * 64, lam);
        } else {
            const int it = item - 768, h = it & 3, b = it >> 2;
            const int t0 = b * SEQ;
            attn_item<true>(p, l, lds, tid, (const bf16_t*)(ws + OFF_DQ) + (size_t)t0 * 256 + h * 64, 256,
                            (const bf16_t*)(ws + OFF_DKP) + ((size_t)b * 4 + h) * SEQ * 64, (const bf16_t*)(ws + OFF_DVTP) + ((size_t)b * 4 + h) * 64 * SEQ, SEQ,
                            (bf16_t*)(ws + OFF_MIX) + (size_t)t0 * D + 256 + h * 64, lam);
        }
    }
}


using bf16x2 = __attribute__((ext_vector_type(2))) __bf16;
__device__ __forceinline__ float dot2bf(unsigned a, unsigned b, float c) {
    return __builtin_amdgcn_fdot2_f32_bf16(__builtin_bit_cast(bf16x2, a), __builtin_bit_cast(bf16x2, b), c, false);
}
template <int W>
__device__ __forceinline__ void bfly_stage(float (&part)[64], const int lane) {
    const bool hi = (lane & W) != 0;
#pragma unroll
    for (int k = 0; k < W; ++k) {
        const float keep = hi ? part[k + W] : part[k];
        const float send = hi ? part[k] : part[k + W];
        part[k] = keep + shfl_x(send, lane, W);
    }
}
constexpr int QW_PEER = 4160;
template <int W>
__device__ __forceinline__ void bfly16_stage(float (&v)[16], const int lane, const int bit) {
    const bool hi = (lane & bit) != 0;
#pragma unroll
    for (int k = 0; k < W; ++k) {
        const float keep = hi ? v[k + W] : v[k];
        const float send = hi ? v[k] : v[k + W];
        v[k] = keep + shfl_x(send, lane, bit);
    }
}
template <bool VSIDE> struct PeerTok {
    static __device__ __forceinline__ void issue(const Params& p, const unsigned char* Tslice, const int elo, const int ehi, const int t, const int s,
                                                 const int sub, const int c16, u32x4 (&a)[16], u32x4 (&h)[2]) {
#pragma unroll
        for (int i = 0; i < 16; ++i) {
            const int e = shfl_i(i < 8 ? elo : ehi, (i * 8 + sub) & 63);
            a[i] = *reinterpret_cast<const u32x4*>(Tslice + (((unsigned)e << 7) + (unsigned)c16 * 16u));
        }
        if (!VSIDE) {
            const bf16_t* Hr = (const bf16_t*)(p.ws + OFF_H) + (size_t)t * D + s * 128 + c16 * 16;
            h[0] = *reinterpret_cast<const u32x4*>(Hr); h[1] = *reinterpret_cast<const u32x4*>(Hr + 8);
        }
    }
    static __device__ __forceinline__ void compute(const Params& p, const int l, const float wlo, const float whi, const int t, const int s,
                                                   const int lane, const int sub, const int c16, const u32x4 (&a)[16], const u32x4 (&h)[2]) {
        if (!VSIDE) {
            f32x2 hf[8];
#pragma unroll
            for (int k = 0; k < 4; ++k) {
                hf[k] = f32x2{__uint_as_float(h[0][k] << 16), __uint_as_float(h[0][k] & 0xffff0000u)};
                hf[4 + k] = f32x2{__uint_as_float(h[1][k] << 16), __uint_as_float(h[1][k] & 0xffff0000u)};
            }
            float d[16];
#pragma unroll
            for (int i = 0; i < 16; ++i) {
                f32x2 acc = f32x2{0.f, 0.f};
#pragma unroll
                for (int k = 0; k < 4; ++k) {
                    acc += __builtin_amdgcn_cvt_pk_f32_fp8((int)a[i][k], false) * hf[2 * k];
                    acc += __builtin_amdgcn_cvt_pk_f32_fp8((int)a[i][k], true) * hf[2 * k + 1];
                }
                d[i] = acc[0] + acc[1];
            }
            bfly16_stage<8>(d, lane, 4); bfly16_stage<4>(d, lane, 2); bfly16_stage<2>(d, lane, 1);
            const int i0 = ((lane & 4) << 1) + ((lane & 2) << 1) + ((lane & 1) << 1);
            float* PART = (float*)(p.ws + OFF_PART) + ((size_t)s * NTOK + t) * 128;
            PART[i0 * 8 + sub] = d[0]; PART[(i0 + 1) * 8 + sub] = d[1];
        } else {
            f32x2 o[8];
#pragma unroll
            for (int k = 0; k < 8; ++k) o[k] = f32x2{0.f, 0.f};
#pragma unroll
            for (int i = 0; i < 16; ++i) {
                const float w = shfl_i(i < 8 ? wlo : whi, (i * 8 + sub) & 63);
                const f32x2 ww = f32x2{w, w};
#pragma unroll
                for (int k = 0; k < 4; ++k) {
                    o[2 * k] += __builtin_amdgcn_cvt_pk_f32_fp8((int)a[i][k], false) * ww;
                    o[2 * k + 1] += __builtin_amdgcn_cvt_pk_f32_fp8((int)a[i][k], true) * ww;
                }
            }
            float ov[16];
#pragma unroll
            for (int k = 0; k < 8; ++k) { ov[2 * k] = o[k][0]; ov[2 * k + 1] = o[k][1]; }
            bfly16_stage<8>(ov, lane, 32); bfly16_stage<4>(ov, lane, 16); bfly16_stage<2>(ov, lane, 8);
            const int col = s * 128 + c16 * 16 + ((lane & 32) >> 2) + ((lane & 16) >> 2) + ((lane & 8) >> 2);
            const float* g2 = (const float*)(p.ws + OFF_MOD) + (size_t)(l * 5 + tok_cv(t)) * 6144 + 5 * 1024 + col;
            float* XC = (float*)(p.ws + OFF_XC) + (size_t)t * D + col;
            const float2 x = *reinterpret_cast<const float2*>(XC), g = *reinterpret_cast<const float2*>(g2);
            *reinterpret_cast<float2*>(XC) = make_float2(x.x + g.x * ov[0], x.y + g.y * ov[1]);
        }
    }
};
template <bool VSIDE>
__device__ __forceinline__ void peer_slice_stream(const Params& p, const int l, const int s, const int first, const int stride, const int lane) {
    const int sub = lane >> 3, c16 = lane & 7;
    const unsigned char* Ts = p.ws + (VSIDE ? OFF_VT : OFF_UT) + ((size_t)l * 8 + s) * NEXP * 128;
    const int* EIb = (const int*)(p.ws + OFF_EIDX); const float* WPb = (const float*)(p.ws + OFF_WPAIR);
    if (first >= NTOK) return;
    const int cnt = (NTOK - first + stride - 1) / stride;
#define PEER_LOADE(k, elo, ehi, wlo, whi) do { const int _t = min(first + (k) * stride, NTOK - 1); \
        elo = EIb[(size_t)_t * 128 + lane]; ehi = EIb[(size_t)_t * 128 + 64 + lane]; \
        if (VSIDE) { wlo = WPb[(size_t)_t * 128 + lane]; whi = WPb[(size_t)_t * 128 + 64 + lane]; } } while (0)
    int e0l, e0h, e1l, e1h, e2l, e2h; float w0l = 0.f, w0h = 0.f, w1l = 0.f, w1h = 0.f, w2l = 0.f, w2h = 0.f;
    u32x4 A[16], B[16], hA[2], hB[2];
    PEER_LOADE(0, e0l, e0h, w0l, w0h);
    PEER_LOADE(1, e1l, e1h, w1l, w1h);
    PeerTok<VSIDE>::issue(p, Ts, e0l, e0h, first, s, sub, c16, A, hA);
    for (int k = 0; k < cnt; k += 2) {
        const int ta = first + k * stride, tb = min(ta + stride, NTOK - 1), tc = min(ta + 2 * stride, NTOK - 1);
        __builtin_amdgcn_sched_barrier(0);
        PEER_LOADE(k + 2, e2l, e2h, w2l, w2h);
        PeerTok<VSIDE>::issue(p, Ts, e1l, e1h, tb, s, sub, c16, B, hB);
        __builtin_amdgcn_sched_barrier(0);
        PeerTok<VSIDE>::compute(p, l, w0l, w0h, ta, s, lane, sub, c16, A, hA);
        __builtin_amdgcn_sched_barrier(0);
        e0l = e2l; e0h = e2h; w0l = w2l; w0h = w2h;
        PEER_LOADE(k + 3, e2l, e2h, w2l, w2h);
        PeerTok<VSIDE>::issue(p, Ts, e0l, e0h, tc, s, sub, c16, A, hA);
        __builtin_amdgcn_sched_barrier(0);
        if (k + 1 < cnt) PeerTok<VSIDE>::compute(p, l, w1l, w1h, tb, s, lane, sub, c16, B, hB);
        e1l = e2l; e1h = e2h; w1l = w2l; w1h = w2h;
    }
#undef PEER_LOADE
}
template <bool VSIDE>
__device__ void ph_peer_sliced(const Params& p, int l, unsigned char* ldsraw, const int wv) {
    const int tid = opaque_tid(wv);
    const int wave = tid >> 6, lane = tid & 63;
    volatile LAS int* hdr = (volatile LAS int*)(ldsraw - LDS_HDR);
    unsigned* bar = (unsigned*)(p.ws + OFF_BAR);
    const int myx = (int)(xb_xcc_id() & 15u);
    if (tid == 0) hdr[16] = (int)atomicAdd(bar + QW_PEER + (l * 2 + (VSIDE ? 1 : 0)) * 16 + myx, 1u);
    __syncthreads();
    const int rank = hdr[16], nloc = (int)hdr[0];
    __syncthreads();
    if (myx < 8) peer_slice_stream<VSIDE>(p, l, myx, rank * 8 + wave, nloc * 8, lane);
    for (int j = 0; j < 8; ++j) {
        if (xb_ld(&bar[XB_XCNT(j)]) == 0u) peer_slice_stream<VSIDE>(p, l, j, (int)blockIdx.x * 8 + wave, (int)gridDim.x * 8, lane);
    }
}
__device__ void ph_peer_pairw(const Params& p, int l, const int wv) {
    const int tid = opaque_tid(wv);
    const float* USC = (const float*)(p.ws + OFF_USC) + l * NEXP; const float* VSC = (const float*)(p.ws + OFF_VSC) + l * NEXP;
    const float* PART = (const float*)(p.ws + OFF_PART);
    for (size_t idx = GTID; idx < (size_t)NTOK * 128; idx += GNT) {
        float sum = 0.f;
#pragma unroll
        for (int s = 0; s < 8; ++s) sum += PART[(size_t)s * NTOK * 128 + idx];
        const int e = ((const int*)(p.ws + OFF_EIDX))[idx];
        ((float*)(p.ws + OFF_WPAIR))[idx] = ((const float*)(p.ws + OFF_EGATE))[idx] * gelu_f(sum * USC[e]) * VSC[e];
    }
}

#define CE_DESC(a, b) do { const float _mx = fmaxf((a), (b)); const float _mn = fminf((a), (b)); (a) = _mx; (b) = _mn; } while (0)
__device__ __forceinline__ void sort16_desc(float (&v)[16]) {
#pragma unroll
    for (int k = 2; k <= 16; k <<= 1)
#pragma unroll
        for (int j = k >> 1; j > 0; j >>= 1)
#pragma unroll
            for (int i = 0; i < 16; ++i) {
                const int m = i ^ j;
                if (m > i) { if ((i & k) == 0) CE_DESC(v[i], v[m]); else CE_DESC(v[m], v[i]); }
            }
}
__device__ __forceinline__ void merge_top16(float (&a)[16], const float (&b)[16]) {
#pragma unroll
    for (int i = 0; i < 16; ++i) a[i] = fmaxf(a[i], b[15 - i]);
#pragma unroll
    for (int j = 8; j > 0; j >>= 1)
#pragma unroll
        for (int i = 0; i < 16; ++i) { const int m = i ^ j; if (m > i) CE_DESC(a[i], a[m]); }
}
__device__ __forceinline__ float key_embed(float v, unsigned lowmask, unsigned idxbits) { return __uint_as_float((__float_as_uint(v) & ~lowmask) | idxbits); }

constexpr int SK_ROWB = 144;
__device__ __forceinline__ void peer_stage1(const LAS unsigned char* SK  , const bf16_t* __restrict__ Qrow  ,
                                            const int r, const int hh, float (&out)[16]) {
    bf16x8 qb[4];
#pragma unroll
    for (int ks = 0; ks < 4; ++ks) qb[ks] = *reinterpret_cast<const bf16x8*>(Qrow + ks * 16 + hh * 8);
    float grp[4][16];
#pragma unroll
    for (int mt = 0; mt < 4; ++mt) {
        f32x16 acc;
#pragma unroll
        for (int i = 0; i < 16; ++i) acc[i] = 0.f;
#pragma unroll
        for (int ks = 0; ks < 4; ++ks) {
            const bf16x8 a = *(const LAS bf16x8*)(SK + (mt * 32 + r) * SK_ROWB + (ks * 16 + hh * 8) * 2);
            acc = MFMA32(a, qb[ks], acc);
        }
        const unsigned hx = (unsigned)hh << 2;
#pragma unroll
        for (int i = 0; i < 16; ++i) {
            const unsigned cn = 32u * mt + (i & 3) + 8u * (i >> 2);
            grp[mt][i] = key_embed(acc[i], 127u, (127u - cn) ^ hx);
        }
        sort16_desc(grp[mt]);
    }
    merge_top16(grp[0], grp[1]); merge_top16(grp[2], grp[3]); merge_top16(grp[0], grp[2]);
    float pb[16];
#pragma unroll
    for (int i = 0; i < 16; ++i) pb[i] = shfl_x(grp[0][i], (hh << 5) | r, 32);
    merge_top16(grp[0], pb);
#pragma unroll
    for (int i = 0; i < 16; ++i) out[i] = grp[0][i];
}

__device__ void ph_peer_select(const Params& p, int l, unsigned char* ldsraw, const int wv) {
    const int tid = opaque_tid(wv);
    const int wave = tid >> 6, lane = tid & 63, r = lane & 31, hh = lane >> 5;
    const int gw = blockIdx.x * 8 + wave, nw = gridDim.x * 8;
    LAS unsigned char* skl = (LAS unsigned char*)ldsraw;
    LAS unsigned char* myl = skl + 2 * 128 * SK_ROWB + wave * 2048 + lane * 32;
    {
        const bf16_t* SKg = (const bf16_t*)(p.ws + OFF_SUBK) + (size_t)l * 2 * 128 * 64;
        for (int i = tid; i < 2 * 128 * 8; i += NT) {
            const int row = i >> 3, ch = i & 7;
            *(LAS u32x4*)(skl + row * SK_ROWB + ch * 16) = *reinterpret_cast<const u32x4*>(SKg + (size_t)row * 64 + ch * 8);
        }
        __syncthreads();
    }
    for (int task = gw; task < (NTOK / 32) * 4; task += nw) {
        const int tg = task >> 2, k = task & 3;
        const int t = tg * 32 + r;
        const bf16_t* Qt = (const bf16_t*)(p.ws + OFF_Q) + (size_t)t * D;
        float sv[2][16];
#pragma unroll
        for (int x = 0; x < 2; ++x) {
            float la[16], lb[16];
            peer_stage1(skl + x * 128 * SK_ROWB, Qt + k * 128 + x * 64, r, hh, la);
            peer_stage1(skl + x * 128 * SK_ROWB, Qt + (k + 4) * 128 + x * 64, r, hh, lb);
#pragma unroll
            for (int i = 0; i < 16; ++i) sv[x][i] = hh ? lb[i] : la[i];
        }
        {
            unsigned w[8];
#pragma unroll
            for (int q = 0; q < 8; ++q) {
                w[q] = 0u;
#pragma unroll
                for (int b = 0; b < 4; ++b) {
                    const int i = q * 4 + b;
                    const unsigned key = __float_as_uint(i < 16 ? sv[0][i] : sv[1][i - 16]);
                    w[q] |= (127u - (key & 127u)) << (8 * b);
                }
            }
            *(LAS u32x4*)(myl) = u32x4{w[0], w[1], w[2], w[3]};
            *(LAS u32x4*)(myl + 16) = u32x4{w[4], w[5], w[6], w[7]};
        }
        float val0[16], val1[16];
#pragma unroll
        for (int i = 0; i < 16; ++i) { val0[i] = __uint_as_float(__float_as_uint(sv[0][i]) & ~127u); val1[i] = __uint_as_float(__float_as_uint(sv[1][i]) & ~127u); }
        float g0[16], g1[16], g2[16], g3[16];
#pragma unroll
        for (int b = 0; b < 16; ++b) g0[b] = key_embed(val0[0] + val1[b], 255u, 255u - (unsigned)b);
#pragma unroll
        for (int b = 0; b < 8; ++b) g1[b] = key_embed(val0[1] + val1[b], 255u, 255u - (16u + b));
#pragma unroll
        for (int b = 0; b < 5; ++b) g1[8 + b] = key_embed(val0[2] + val1[b], 255u, 255u - (32u + b));
#pragma unroll
        for (int b = 0; b < 3; ++b) g1[13 + b] = key_embed(val0[4] + val1[b], 255u, 255u - (64u + b));
#pragma unroll
        for (int b = 0; b < 4; ++b) g2[b] = key_embed(val0[3] + val1[b], 255u, 255u - (48u + b));
#pragma unroll
        for (int a = 5; a < 8; ++a)
#pragma unroll
            for (int b = 0; b < 2; ++b) g2[4 + (a - 5) * 2 + b] = key_embed(val0[a] + val1[b], 255u, 255u - (16u * a + b));
#pragma unroll
        for (int a = 8; a < 14; ++a) g2[10 + (a - 8)] = key_embed(val0[a] + val1[0], 255u, 255u - 16u * a);
        g3[0] = key_embed(val0[14] + val1[0], 255u, 255u - 16u * 14); g3[1] = key_embed(val0[15] + val1[0], 255u, 255u - 16u * 15);
#pragma unroll
        for (int i = 2; i < 16; ++i) g3[i] = -3.0e38f;
        sort16_desc(g1); sort16_desc(g2); sort16_desc(g3);
        merge_top16(g0, g1); merge_top16(g2, g3); merge_top16(g0, g2);
        float gate[16]; int eid[16];
        const float mx = __uint_as_float(__float_as_uint(g0[0]) & ~255u);
        float sum = 0.f;
#pragma unroll
        for (int i = 0; i < 16; ++i) {
            const unsigned key = __float_as_uint(g0[i]);
            gate[i] = __expf(__uint_as_float(key & ~255u) - mx); sum += gate[i];
            const unsigned id = 255u - (key & 255u);
            const unsigned n0 = *(const LAS unsigned char*)(myl + (id >> 4));
            const unsigned n1 = *(const LAS unsigned char*)(myl + 16 + (id & 15u));
            eid[i] = (int)(n0 * 128u + n1);
        }
        const float inv = 1.f / sum;
        const int h = k + 4 * hh;
        int* EI = (int*)(p.ws + OFF_EIDX) + (size_t)t * 128 + h * 16; float* EG = (float*)(p.ws + OFF_EGATE) + (size_t)t * 128 + h * 16;
#pragma unroll
        for (int q = 0; q < 4; ++q) {
            *reinterpret_cast<int4*>(EI + q * 4) = make_int4(eid[q * 4], eid[q * 4 + 1], eid[q * 4 + 2], eid[q * 4 + 3]);
            *reinterpret_cast<float4*>(EG + q * 4) = make_float4(gate[q * 4] * inv, gate[q * 4 + 1] * inv, gate[q * 4 + 2] * inv, gate[q * 4 + 3] * inv);
        }
    }
}

constexpr int LDS_BYTES = LDS_HDR + 256 * 132 * 4;
__global__ void __launch_bounds__(NT, 2) mk_fwd(Params p) {
    extern __shared__ __attribute__((aligned(16))) unsigned char lds[];
    const int wv = __builtin_amdgcn_readfirstlane((int)(threadIdx.x >> 6));
    volatile LAS unsigned* st = (volatile LAS unsigned*)lds;
    if (threadIdx.x < 4) st[threadIdx.x] = 0u;
    __syncthreads();
    XcdBarrier xb = xcd_barrier_post((unsigned*)(p.ws + OFF_BAR), st);
#define GRID_BAR() xcd_barrier(xb)
    unsigned char* ws = p.ws;
    for (int rep = 0; rep < (PROBE_DUP == 1 ? 2 : 1); ++rep) {
    for (int l = 0; l < 2; ++l) {
        ph_transpose(p.in[I_WIN] + (size_t)l * D * INW, (bf16_t*)(ws + OFF_WIN) + (size_t)l * INW * D, D, INW, lds + LDS_HDR, wv);
        ph_transpose(p.in[I_WOUT] + (size_t)l * D * D, (bf16_t*)(ws + OFF_WOUT) + (size_t)l * D * D, D, D, lds + LDS_HDR, wv);
        ph_transpose(p.in[I_WQ] + (size_t)l * D * D, (bf16_t*)(ws + OFF_WQ) + (size_t)l * D * D, D, D, lds + LDS_HDR, wv);
    }
    ph_convert_fp8_rows(p.in[I_PU], ws + OFF_UT, (float*)(ws + OFF_USC), 2 * NEXP, wv);
    ph_convert_fp8_rows(p.in[I_PV], ws + OFF_VT, (float*)(ws + OFF_VSC), 2 * NEXP, wv);
    ph_convert(p.in[I_SUBK], (bf16_t*)(ws + OFF_SUBK), 2 * 2 * 128 * 64, wv);
    ph_convert(p.in[I_SGUW], (bf16_t*)(ws + OFF_SGUW), 2 * 4 * 128 * 128, wv);
    ph_mod(p, lds + LDS_HDR, wv);
    ph_rope_tab(p, wv);
    GRID_BAR();
    }
    for (int l = 0; l < 2; ++l) {
        for (int rep = 0; rep < (PROBE_DUP == 3 ? 2 : 1); ++rep) {
        ph_norm_mod(p, l, 0, l == 0 ? 1 : 0, wv);
        ph_cache_prep(p, l, wv);
        GRID_BAR();
        }
        for (int rep = 0; rep < (PROBE_DUP == 5 ? 2 : 1); ++rep) {
        gemm_phase<EPI_INPROJ>(p, l, (const bf16_t*)(ws + OFF_H), (const bf16_t*)(ws + OFF_WIN) + (size_t)l * INW * D, INW, lds + LDS_HDR, wv);
        GRID_BAR();
        }
        for (int rep = 0; rep < (PROBE_DUP == 4 ? 2 : 1); ++rep) {
        ph_mixers(p, l + 2 * rep, lds + LDS_HDR, wv);
        GRID_BAR();
        }
        gemm_phase<EPI_WOUT>(p, l, (const bf16_t*)(ws + OFF_MIX), (const bf16_t*)(ws + OFF_WOUT) + (size_t)l * D * D, D, lds + LDS_HDR, wv);
        GRID_BAR();
        ph_norm_mod(p, l, 1, 0, wv);
        GRID_BAR();
        for (int rep = 0; rep < (PROBE_DUP == 7 ? 2 : 1); ++rep) {
        gemm_phase<EPI_WQ>(p, l, (const bf16_t*)(ws + OFF_H), (const bf16_t*)(ws + OFF_WQ) + (size_t)l * D * D, D, lds + LDS_HDR, wv);
        GRID_BAR();
        }
        if (PROBE_DUP == 8) { for (int rep = 0; rep < 10; ++rep) GRID_BAR(); }
        for (int rep = 0; rep < (PROBE_DUP == 2 ? 2 : 1); ++rep) {
        ph_peer_select(p, l, lds + LDS_HDR, wv);
        GRID_BAR();
        }
        ph_peer_sliced<false>(p, l, lds + LDS_HDR, wv);
        GRID_BAR();
        ph_peer_pairw(p, l, wv);
        GRID_BAR();
        ph_peer_sliced<true>(p, l, lds + LDS_HDR, wv);
        GRID_BAR();
    }
    ph_final_norm(p, wv);
}

extern "C" void kernel_launch(void* const* d_in, const int* in_sizes, int n_in,
                              void* d_out, int out_size, void* d_ws, size_t ws_size,
                              hipStream_t stream) {
    static int grid = 0;
    if (grid == 0) {
        if (ws_size < WS_NEED) { fprintf(stderr, "kernel_launch: workspace too small: %zu < %zu\n", ws_size, (size_t)WS_NEED); grid = -1; return; }
        int dev = 0, cus = 0, per_cu = 0;
        (void)hipGetDevice(&dev);
        (void)hipDeviceGetAttribute(&cus, hipDeviceAttributeMultiprocessorCount, dev);
        (void)hipFuncSetAttribute((const void*)mk_fwd, hipFuncAttributeMaxDynamicSharedMemorySize, LDS_BYTES);
        (void)hipOccupancyMaxActiveBlocksPerMultiprocessor(&per_cu, (const void*)mk_fwd, NT, LDS_BYTES);
        if (per_cu < 1) { fprintf(stderr, "kernel_launch: occupancy query reports %d blocks per CU\n", per_cu); grid = -1; return; }
        grid = cus;
    }
    if (grid < 0) return;
    (void)hipMemsetAsync((unsigned char*)d_ws + OFF_BAR, 0, 64 * 1024, stream);
    Params p{};
    for (int i = 0; i < 29; ++i) p.in[i] = (const float*)d_in[i];
    p.out = (float*)d_out; p.ws = (unsigned char*)d_ws;
    void* args[] = {&p};
    hipError_t e = hipLaunchCooperativeKernel((const void*)mk_fwd, dim3(grid), dim3(NT), args, LDS_BYTES, stream);
    if (e != hipSuccess) fprintf(stderr, "kernel_launch: cooperative launch failed: %s (grid %d)\n", hipGetErrorString(e), grid);
}
```

```cpp
#include <hip/hip_runtime.h>
#include <hip/hip_bf16.h>
#include <cstdio>
#include <cstdint>
#include <hip/hip_cooperative_groups.h>
namespace cg = cooperative_groups;

#define PROBE_DUP 0
#define PROBE_TS -1
typedef unsigned short bf16_t;
using bf16x8 = __attribute__((ext_vector_type(8))) short;
using f32x4  = __attribute__((ext_vector_type(4))) float;
using f32x16 = __attribute__((ext_vector_type(16))) float;
using f32x2  = __attribute__((ext_vector_type(2))) float;
using u32x4  = __attribute__((ext_vector_type(4))) unsigned;
using s16x4  = __attribute__((ext_vector_type(4))) short;

constexpr int D      = 1024;
constexpr int NTOK   = 16384;
constexpr int NPT    = 8192;
constexpr int SEQ    = 256;
constexpr int DSEQ   = 2048;
constexpr int PAST   = 512;
constexpr int NKS    = DSEQ + PAST;
constexpr int INW    = 2048;
constexpr int NEXP   = 16384;
constexpr float EPS  = 1e-6f;

constexpr size_t MB = 1024 * 1024;
constexpr size_t OFF_BAR   = 0;
constexpr size_t OFF_MOD   = 64 * 1024;
constexpr size_t OFF_ROPE  = OFF_MOD + 256 * 1024;
constexpr size_t OFF_SUBK  = OFF_ROPE + 1 * MB;
constexpr size_t OFF_SGUW  = OFF_SUBK + 64 * 1024;
constexpr size_t OFF_WIN   = OFF_SGUW + 256 * 1024;
constexpr size_t OFF_WOUT  = OFF_WIN + 8 * MB;
constexpr size_t OFF_WQ    = OFF_WOUT + 4 * MB;
constexpr size_t OFF_UT    = OFF_WQ + 4 * MB;
constexpr size_t OFF_USC   = OFF_UT + 32 * MB;
constexpr size_t OFF_VT    = OFF_UT + 64 * MB;
constexpr size_t OFF_VSC   = OFF_VT + 32 * MB;
constexpr size_t OFF_H     = OFF_VT + 64 * MB;
constexpr size_t OFF_XC    = OFF_H + 32 * MB;
constexpr size_t OFF_R1    = OFF_XC + 64 * MB;
constexpr size_t OFF_AU    = OFF_R1;
constexpr size_t OFF_AV    = OFF_AU + 8 * MB;
constexpr size_t OFF_AVN   = OFF_AV + 8 * MB;
constexpr size_t OFF_DQ    = OFF_AVN + 8 * MB;
constexpr size_t OFF_DKP   = OFF_DQ + 8 * MB;
constexpr size_t OFF_DKS   = OFF_DKP + 4 * MB;
constexpr size_t OFF_DVTP  = OFF_DKS + 5 * MB;
constexpr size_t OFF_DVTS  = OFF_DVTP + 4 * MB;
constexpr size_t OFF_GQ    = OFF_DVTS + 5 * MB;
constexpr size_t OFF_GKP   = OFF_GQ + 16 * MB;
constexpr size_t OFF_GKS   = OFF_GKP + 2 * MB;
constexpr size_t OFF_GVTP  = OFF_GKS + 3 * MB;
constexpr size_t OFF_GVTS  = OFF_GVTP + 2 * MB;
constexpr size_t OFF_MIX   = OFF_GVTS + 3 * MB;
constexpr size_t OFF_R1END = OFF_MIX + 32 * MB;
constexpr size_t OFF_Q     = OFF_R1;
constexpr size_t OFF_EIDX  = OFF_Q + 32 * MB;
constexpr size_t OFF_EGATE = OFF_EIDX + 8 * MB;
constexpr size_t OFF_TOPV  = OFF_EGATE + 8 * MB;
constexpr size_t OFF_TOPI  = OFF_TOPV + 16 * MB;
static_assert(OFF_TOPI + 16 * MB <= OFF_R1END, "peer buffers must fit region 1");
constexpr size_t OFF_PROJ  = OFF_R1END;
constexpr size_t OFF_PART  = OFF_PROJ;
constexpr size_t OFF_WPAIR = OFF_PART + 64 * MB;
constexpr size_t WS_NEED   = OFF_PROJ + 128 * MB;
static_assert(WS_NEED <= 512 * MB, "workspace budget");

constexpr size_t OUT_YP  = 0;
constexpr size_t OUT_YS  = 8388608;
constexpr size_t OUT_NDK = 16777216;
constexpr size_t OUT_NDV = OUT_NDK + 4194304;
constexpr size_t OUT_NGK = OUT_NDV + 4194304;
constexpr size_t OUT_NGV = OUT_NGK + 2097152;

struct Params {
    const float* in[29];
    float* out;
    unsigned char* ws;
};
enum { I_XP = 0, I_XS, I_CDK, I_CDV, I_CGK, I_CGV, I_C, I_CCTX, I_ADAW, I_ADAB, I_N1G, I_N2G, I_WIN, I_SGUNG, I_SGUW, I_SGUB,
       I_LQ1, I_LK1, I_LQ2, I_LK2, I_SUBLN, I_QNG, I_KNG, I_WOUT, I_WQ, I_SUBK, I_PU, I_PV, I_FG };

typedef __bf16 hwbf2 __attribute__((ext_vector_type(2)));
__device__ __forceinline__ unsigned pack_bf2(float a, float b) {
    const f32x2 v = {a, b};
    return __builtin_bit_cast(unsigned, __builtin_convertvector(v, hwbf2));
}
__device__ __forceinline__ bf16_t f2bf(float f) { return (bf16_t)(pack_bf2(f, 0.f) & 0xffffu); }
__device__ __forceinline__ float bf2f(bf16_t h) { return __uint_as_float(((unsigned)h) << 16); }
__device__ __forceinline__ float gelu_f(float x) {
    const float k2 = 2.f * 0.7978845608028654f * 1.4426950408889634f;
    const float e = __builtin_amdgcn_exp2f(k2 * (x + 0.044715f * x * x * x));
    return x - x * __builtin_amdgcn_rcpf(e + 1.f);
}
__device__ __forceinline__ int lane_id() { return (int)__builtin_amdgcn_mbcnt_hi(~0u, __builtin_amdgcn_mbcnt_lo(~0u, 0u)); }
__device__ __forceinline__ int lane_id_op() { int l = lane_id(); asm volatile("" : "+v"(l)); return l; }
__device__ __forceinline__ float shfl_i(float v, int src) { return __builtin_bit_cast(float, __builtin_amdgcn_ds_bpermute(src << 2, __builtin_bit_cast(int, v))); }
__device__ __forceinline__ int shfl_i(int v, int src) { return __builtin_amdgcn_ds_bpermute(src << 2, v); }
__device__ __forceinline__ float shfl_x(float v, int lane, int m) { return shfl_i(v, lane ^ m); }
__device__ __forceinline__ float wave_sum(float v) {
    const int ln = lane_id_op();
#pragma unroll
    for (int o = 32; o >= 1; o >>= 1) v += shfl_x(v, ln, o);
    return v;
}
__device__ __forceinline__ int tok_cv(int t) { return t < NPT ? 0 : 1 + ((t - NPT) >> 11); }
__device__ __forceinline__ const float* x_in_row(const Params& p, int t) {
    return t < NPT ? p.in[I_XP] + (size_t)t * D : p.in[I_XS] + (size_t)(t - NPT) * D;
}
__device__ __forceinline__ float lam_init_of(int l) { return l == 0 ? 0.2f : (0.8f - 0.6f * 0.7408182206817179f); }
__device__ __forceinline__ float lam_of(const Params& p, int l) {
    float s1 = 0.f, s2 = 0.f;
    for (int i = 0; i < 32; ++i) {
        s1 += p.in[I_LQ1][l * 32 + i] * p.in[I_LK1][l * 32 + i];
        s2 += p.in[I_LQ2][l * 32 + i] * p.in[I_LK2][l * 32 + i];
    }
    return expf(s1) - expf(s2) + lam_init_of(l);
}


#define XB_TMO      128
#define XB_XCNT(j)  (256  + 64 * (j))
#define XB_XSUB(j)  (1280 + 64 * (j))
#define XB_XGEN(j)  (2304 + 64 * (j))
#define XB_TOP      3328
#define XB_TOPGEN   3392
#define XCD_BAR_WORDS 3456
#define XB_SPIN_CAP (1u << 20)
#define LAS __attribute__((address_space(3)))
__device__ __forceinline__ unsigned xb_ld(unsigned* p)              { return __hip_atomic_load(p, __ATOMIC_RELAXED, __HIP_MEMORY_SCOPE_AGENT); }
__device__ __forceinline__ unsigned xb_add(unsigned* p, unsigned v) { return __hip_atomic_fetch_add(p, v, __ATOMIC_RELAXED, __HIP_MEMORY_SCOPE_AGENT); }
__device__ __forceinline__ unsigned xb_xcc_id() { return (unsigned)__builtin_amdgcn_s_getreg((3 << 11) | 20) & 0xFu; }
#define XB_SPIN(cond, bar) do { unsigned _sp = 0; while (cond) { __builtin_amdgcn_s_sleep(1); \
    if ((++_sp & 255u) == 0u) { if (xb_ld(&(bar)[XB_TMO])) break; if (_sp > XB_SPIN_CAP) { atomicAdd(&(bar)[XB_TMO], 1u); break; } } } } while (0)
struct XcdBarrier { unsigned* bar; unsigned x; volatile LAS unsigned* st; };
__device__ __forceinline__ XcdBarrier xcd_barrier_post(unsigned* bar, volatile LAS unsigned* st) {
    XcdBarrier b; b.bar = bar; b.x = xb_xcc_id(); b.st = st;
    if (threadIdx.x == 0) (void)xb_add(&bar[XB_XCNT(b.x)], 1u);
    return b;
}
__device__ __forceinline__ void xcd_barrier_complete(unsigned* bar, unsigned x, unsigned& nloc, unsigned& nx) {
    const unsigned G = gridDim.x * gridDim.y * gridDim.z;
    unsigned sum, cnt, mine, sp = 0u;
    for (;;) {
        sum = 0u; cnt = 0u; mine = 0u;
#pragma unroll
        for (unsigned j = 0; j < 16; ++j) { const unsigned c = xb_ld(&bar[XB_XCNT(j)]); sum += c; cnt += (c > 0u) ? 1u : 0u; mine = (j == x) ? c : mine; }
        if (sum == G) break;
        __builtin_amdgcn_s_sleep(1);
        if ((++sp & 255u) == 0u) { if (xb_ld(&bar[XB_TMO])) break; if (sp > XB_SPIN_CAP) { atomicAdd(&bar[XB_TMO], 1u); break; } }
    }
    nloc = mine > 0u ? mine : 1u; nx = cnt > 0u ? cnt : 1u;
}
__device__ __forceinline__ void xcd_barrier(const XcdBarrier& b) {
    asm volatile("s_waitcnt vmcnt(0)" ::: "memory");
    __syncthreads();
    if (threadIdx.x == 0) {
        unsigned* bar = b.bar;
        const unsigned bx = xb_xcc_id();
        __builtin_amdgcn_s_waitcnt(0);
        unsigned nloc = b.st[0], nx = b.st[1];
        if (nloc == 0u) { xcd_barrier_complete(bar, bx, nloc, nx); b.st[0] = nloc; b.st[1] = nx; }
        const unsigned old = xb_add(&bar[XB_XSUB(bx)], 1u);
        const unsigned gen = old / nloc;
        if (old + 1u == (gen + 1u) * nloc) {
            __builtin_amdgcn_fence(__ATOMIC_RELEASE, "agent");
            asm volatile("s_waitcnt vmcnt(0)" ::: "memory");
            const unsigned og = xb_add(&bar[XB_TOP], 1u);
            const unsigned tg = og / nx;
            if (og + 1u == (tg + 1u) * nx) xb_add(&bar[XB_TOPGEN], 1u);
            else XB_SPIN(xb_ld(&bar[XB_TOPGEN]) == tg, bar);
            __builtin_amdgcn_fence(__ATOMIC_ACQUIRE, "agent");
            xb_add(&bar[XB_XGEN(bx)], 1u);
            asm volatile("s_waitcnt vmcnt(0)" ::: "memory");
        } else {
            XB_SPIN(xb_ld(&bar[XB_XGEN(bx)]) == gen, bar);
            __builtin_amdgcn_fence(__ATOMIC_ACQUIRE, "agent");
            asm volatile("s_waitcnt vmcnt(0)" ::: "memory");
        }
    }
    __syncthreads();
}

constexpr int NT = 512;
constexpr int LDS_HDR = 1024;
#define GTID ((size_t)blockIdx.x * NT + tid)
__device__ __forceinline__ int opaque_tid(int wv) { int t = (wv << 6) | lane_id(); asm volatile("" : "+v"(t)); return t; }
#define GNT  ((size_t)gridDim.x * NT)

__device__ void ph_transpose(const float* __restrict__ W, bf16_t* __restrict__ Wt, int K, int N, unsigned char* ldsraw, const int wv) {
    const int tid = opaque_tid(wv);
    LAS bf16_t* T = (LAS bf16_t*)ldsraw;
    const int tk = K / 128, tn = N / 64, ntiles = tk * tn;
    for (int tile = blockIdx.x; tile < ntiles; tile += gridDim.x) {
        const int k0 = (tile % tk) * 128, n0 = (tile / tk) * 64;
#pragma unroll 4
        for (int i = 0; i < 16; ++i) {
            const int kl = i * 8 + (tid >> 6), nl = tid & 63;
            T[nl * 130 + kl] = f2bf(W[(size_t)(k0 + kl) * N + n0 + nl]);
        }
        __syncthreads();
        {
            const int nl = tid >> 3, kc = tid & 7;
            unsigned w[8];
#pragma unroll
            for (int i = 0; i < 8; ++i) w[i] = (unsigned)T[nl * 130 + kc * 16 + 2 * i] | ((unsigned)T[nl * 130 + kc * 16 + 2 * i + 1] << 16);
            bf16_t* dst = Wt + (size_t)(n0 + nl) * K + k0 + kc * 16;
            *reinterpret_cast<u32x4*>(dst) = u32x4{w[0], w[1], w[2], w[3]};
            *reinterpret_cast<u32x4*>(dst + 8) = u32x4{w[4], w[5], w[6], w[7]};
        }
        __syncthreads();
    }
}
__device__ void ph_convert(const float* __restrict__ src, bf16_t* __restrict__ dst, size_t n, const int wv) {
    const int tid = opaque_tid(wv);
    for (size_t idx = GTID; idx < n; idx += GNT) dst[idx] = f2bf(src[idx]);
}
__device__ void ph_convert_fp8_rows(const float* __restrict__ src, unsigned char* __restrict__ dst, float* __restrict__ scl, int nrows, const int wv) {
    const int tid = opaque_tid(wv);
    const int lane = tid & 63;
    const int gw = blockIdx.x * 8 + (tid >> 6), nw = gridDim.x * 8;
    for (int row0 = gw * 4; row0 < nrows; row0 += nw * 4) {
        float4 f[4][4];
#pragma unroll
        for (int q = 0; q < 4; ++q)
#pragma unroll
            for (int i = 0; i < 4; ++i) f[q][i] = *reinterpret_cast<const float4*>(src + (size_t)(row0 + q) * D + lane * 16 + i * 4);
#pragma unroll
        for (int q = 0; q < 4; ++q) {
            const int row = row0 + q;
            float v[16];
#pragma unroll
            for (int i = 0; i < 4; ++i) { v[i * 4] = f[q][i].x; v[i * 4 + 1] = f[q][i].y; v[i * 4 + 2] = f[q][i].z; v[i * 4 + 3] = f[q][i].w; }
            float am = 0.f;
#pragma unroll
            for (int i = 0; i < 16; ++i) am = fmaxf(am, fabsf(v[i]));
#pragma unroll
            for (int o = 32; o >= 1; o >>= 1) am = fmaxf(am, shfl_x(am, lane, o));
            const float sc = am > 0.f ? 224.f / am : 1.f;
            unsigned w[4];
#pragma unroll
            for (int i = 0; i < 4; ++i) {
                int pk = 0;
                pk = __builtin_amdgcn_cvt_pk_fp8_f32(v[i * 4] * sc, v[i * 4 + 1] * sc, pk, false);
                pk = __builtin_amdgcn_cvt_pk_fp8_f32(v[i * 4 + 2] * sc, v[i * 4 + 3] * sc, pk, true);
                w[i] = (unsigned)pk;
            }
            {
                const int lyr = row >> 14, e = row & (NEXP - 1);
                *reinterpret_cast<u32x4*>(dst + (((size_t)lyr * 8 + (lane >> 3)) * NEXP + e) * 128 + (lane & 7) * 16) = u32x4{w[0], w[1], w[2], w[3]};
            }
            if (lane == 0) scl[row] = am > 0.f ? am * (1.f / 224.f) : 1.f;
        }
    }
}
__device__ void ph_mod(const Params& p, unsigned char* ldsraw, const int wv) {
    const int tid = opaque_tid(wv);
    LAS float* sl = (LAS float*)ldsraw;
    LAS float* red = sl + 5 * 1024;
    for (int i = tid; i < 5 * 1024; i += NT) {
        const int cv = i >> 10, k = i & 1023;
        const float c = cv == 0 ? p.in[I_CCTX][k] : p.in[I_C][(size_t)(cv - 1) * D + k];
        sl[i] = c / (1.f + __expf(-c));
    }
    __syncthreads();
    const int c = tid & 63, ks = tid >> 6;
    for (int item = blockIdx.x; item < 2 * 96; item += gridDim.x) {
        const int l = item / 96, j = (item % 96) * 64 + c;
        const float* W = p.in[I_ADAW] + (size_t)l * D * 6144 + (size_t)(ks * 128) * 6144 + j;
        float acc[5] = {0.f, 0.f, 0.f, 0.f, 0.f};
#pragma unroll 8
        for (int k = 0; k < 128; ++k) {
            const float w = W[(size_t)k * 6144];
#pragma unroll
            for (int cv = 0; cv < 5; ++cv) acc[cv] += sl[cv * 1024 + ks * 128 + k] * w;
        }
#pragma unroll
        for (int cv = 0; cv < 5; ++cv) red[(ks * 5 + cv) * 64 + c] = acc[cv];
        __syncthreads();
        if (tid < 320) {
            const int cv = tid >> 6;
            float sum = p.in[I_ADAB][l * 6144 + j];
#pragma unroll
            for (int q = 0; q < 8; ++q) sum += red[(q * 5 + cv) * 64 + c];
            ((float*)(p.ws + OFF_MOD))[(size_t)(l * 5 + cv) * 6144 + j] = sum;
        }
        __syncthreads();
    }
}
__device__ void ph_rope_tab(const Params& p, const int wv) {
    const int tid = opaque_tid(wv);
    for (size_t idx = GTID; idx < 2048 * 48; idx += GNT) {
        int s = idx / 48, i = idx % 48;
        float* R = (float*)(p.ws + OFF_ROPE);
        double row = (double)(s / 64), col = (double)(s % 64);
        if (i < 16) {
            int q = i & 7; double inv = pow(10000.0, -(double)q / 8.0);
            double ang = (i < 8 ? row : col) * inv;
            R[s * 16 + i] = (float)cos(ang); R[2048 * 16 + s * 16 + i] = (float)sin(ang);
        } else {
            int ii = i - 16; int q = ii & 15; double inv = pow(10000.0, -(double)q / 16.0);
            double ang = (ii < 16 ? row : col) * inv;
            R[2048 * 32 + s * 32 + ii] = (float)cos(ang); R[2048 * 64 + s * 32 + ii] = (float)sin(ang);
        }
    }
}
__device__ void ph_cache_prep(const Params& p, int l, const int wv) {
    const int tid = opaque_tid(wv);
    bf16_t* DKS = (bf16_t*)(p.ws + OFF_DKS); bf16_t* DVTS = (bf16_t*)(p.ws + OFF_DVTS);
    bf16_t* GKS = (bf16_t*)(p.ws + OFF_GKS); bf16_t* GVTS = (bf16_t*)(p.ws + OFF_GVTS);
    for (size_t idx = GTID; idx < 4 * 512 * 256; idx += GNT) {
        int c = idx & 255, pp = (idx >> 8) & 511, b = idx >> 17;
        size_t src = (((size_t)b * 2 + l) * PAST + pp) * 256 + c;
        int h = c >> 6, r = c & 63;
        DKS[(((size_t)b * 4 + h) * NKS + DSEQ + pp) * 64 + r] = f2bf(p.in[I_CDK][src]);
        DVTS[(((size_t)b * 4 + h) * 64 + r) * NKS + DSEQ + pp] = f2bf(p.in[I_CDV][src]);
        if (c < 128) {
            size_t src2 = (((size_t)b * 2 + l) * PAST + pp) * 128 + c;
            int kv = c >> 6;
            GKS[(((size_t)b * 2 + kv) * NKS + DSEQ + pp) * 64 + r] = f2bf(p.in[I_CGK][src2]);
            GVTS[(((size_t)b * 2 + kv) * 64 + r) * NKS + DSEQ + pp] = f2bf(p.in[I_CGV][src2]);
        }
    }
}
__device__ void ph_norm_mod(const Params& p, int l, int which, int from_input, const int wv) {
    const int tid = opaque_tid(wv);
    const int lane = tid & 63;
    const int gw = blockIdx.x * 8 + (tid >> 6), nw = gridDim.x * 8;
    const float* g = p.in[which ? I_N2G : I_N1G] + l * D;
    if (from_input) {
        float4 nx[4];
        {
            const int t = gw < NTOK ? gw : NTOK - 1;
            const float* xr = x_in_row(p, t);
#pragma unroll
            for (int i = 0; i < 4; ++i) nx[i] = *reinterpret_cast<const float4*>(xr + i * 256 + lane * 4);
        }
        for (int t = gw; t < NTOK; t += nw) {
            float4 v[4];
#pragma unroll
            for (int i = 0; i < 4; ++i) v[i] = nx[i];
            {
                const int tn = t + nw < NTOK ? t + nw : t;
                const float* xn = x_in_row(p, tn);
#pragma unroll
                for (int i = 0; i < 4; ++i) nx[i] = *reinterpret_cast<const float4*>(xn + i * 256 + lane * 4);
            }
            const float* mod = (const float*)(p.ws + OFF_MOD) + (size_t)(l * 5 + tok_cv(t)) * 6144 + which * 3072;
            float ss = 0.f;
#pragma unroll
            for (int i = 0; i < 4; ++i) ss += v[i].x * v[i].x + v[i].y * v[i].y + v[i].z * v[i].z + v[i].w * v[i].w;
            ss = wave_sum(ss);
            float r = rsqrtf(ss / D + EPS);
            bf16_t* H = (bf16_t*)(p.ws + OFF_H) + (size_t)t * D;
#pragma unroll
            for (int i = 0; i < 4; ++i) {
                int c = i * 256 + lane * 4;
                float4 gg = *reinterpret_cast<const float4*>(g + c), sh = *reinterpret_cast<const float4*>(mod + c), sc = *reinterpret_cast<const float4*>(mod + 1024 + c);
                uint2 o;
                o.x = pack_bf2(v[i].x * r * gg.x * (1.f + sc.x) + sh.x, v[i].y * r * gg.y * (1.f + sc.y) + sh.y);
                o.y = pack_bf2(v[i].z * r * gg.z * (1.f + sc.z) + sh.z, v[i].w * r * gg.w * (1.f + sc.w) + sh.w);
                *reinterpret_cast<uint2*>(H + c) = o;
            }
        }
    } else {
        u32x4 nx[2];
        {
            const int t = gw < NTOK ? gw : NTOK - 1;
            const bf16_t* xr = (const bf16_t*)(p.ws + OFF_XC) + (size_t)t * D + lane * 8;
            nx[0] = *reinterpret_cast<const u32x4*>(xr); nx[1] = *reinterpret_cast<const u32x4*>(xr + 512);
        }
        for (int t = gw; t < NTOK; t += nw) {
            float v[16];
#pragma unroll
            for (int h = 0; h < 2; ++h)
#pragma unroll
                for (int k = 0; k < 4; ++k) { v[h * 8 + 2 * k] = __uint_as_float(nx[h][k] << 16); v[h * 8 + 2 * k + 1] = __uint_as_float(nx[h][k] & 0xffff0000u); }
            {
                const int tn = t + nw < NTOK ? t + nw : t;
                const bf16_t* xn = (const bf16_t*)(p.ws + OFF_XC) + (size_t)tn * D + lane * 8;
                nx[0] = *reinterpret_cast<const u32x4*>(xn); nx[1] = *reinterpret_cast<const u32x4*>(xn + 512);
            }
            const float* mod = (const float*)(p.ws + OFF_MOD) + (size_t)(l * 5 + tok_cv(t)) * 6144 + which * 3072;
            float ss = 0.f;
#pragma unroll
            for (int i = 0; i < 16; ++i) ss += v[i] * v[i];
            ss = wave_sum(ss);
            float r = rsqrtf(ss / D + EPS);
            bf16_t* H = (bf16_t*)(p.ws + OFF_H) + (size_t)t * D;
#pragma unroll
            for (int h = 0; h < 2; ++h) {
                const int c = h * 512 + lane * 8;
                float o[8];
#pragma unroll
                for (int q = 0; q < 2; ++q) {
                    const float4 gg = *reinterpret_cast<const float4*>(g + c + q * 4), sh = *reinterpret_cast<const float4*>(mod + c + q * 4), sc = *reinterpret_cast<const float4*>(mod + 1024 + c + q * 4);
                    o[q * 4] = v[h * 8 + q * 4] * r * gg.x * (1.f + sc.x) + sh.x; o[q * 4 + 1] = v[h * 8 + q * 4 + 1] * r * gg.y * (1.f + sc.y) + sh.y;
                    o[q * 4 + 2] = v[h * 8 + q * 4 + 2] * r * gg.z * (1.f + sc.z) + sh.z; o[q * 4 + 3] = v[h * 8 + q * 4 + 3] * r * gg.w * (1.f + sc.w) + sh.w;
                }
                *reinterpret_cast<u32x4*>(H + c) = u32x4{pack_bf2(o[0], o[1]), pack_bf2(o[2], o[3]), pack_bf2(o[4], o[5]), pack_bf2(o[6], o[7])};
            }
        }
    }
}
__device__ void ph_sgu_norm(const Params& p, int l, const int wv) {
    const int tid = opaque_tid(wv);
    const int lane = tid & 63;
    const int gw = blockIdx.x * 8 + (tid >> 6), nw = gridDim.x * 8;
    for (int t = gw; t < NTOK; t += nw) {
        const bf16_t* AV = (const bf16_t*)(p.ws + OFF_AV) + (size_t)t * 256;
        float v[4]; float ss = 0.f;
#pragma unroll
        for (int i = 0; i < 4; ++i) { v[i] = bf2f(AV[i * 64 + lane]); ss += v[i] * v[i]; }
        ss = wave_sum(ss);
        float r = rsqrtf(ss / 256.f + EPS);
#pragma unroll
        for (int i = 0; i < 4; ++i) ((bf16_t*)(p.ws + OFF_AVN))[(size_t)t * 256 + i * 64 + lane] = f2bf(v[i] * r * p.in[I_SGUNG][l * 256 + i * 64 + lane]);
    }
}
__device__ void ph_sgu_mix(const Params& p, int l, const int wv) {
    const int tid = opaque_tid(wv);
    const bf16_t* AVN = (const bf16_t*)(p.ws + OFF_AVN);
    for (size_t idx = GTID; idx < (size_t)NTOK * 256; idx += GNT) {
        int t = (int)(idx >> 8), c = (int)(idx & 255);
        int t0 = t & ~127, pp = t & 127, g = c >> 6;
        const bf16_t* W = (const bf16_t*)(p.ws + OFF_SGUW) + (((size_t)l * 4 + g) * 128 + pp) * 128;
        float acc = 0.f;
        for (int q = 0; q < 128; ++q) acc += bf2f(W[q]) * bf2f(AVN[(size_t)(t0 + q) * 256 + c]);
        acc += p.in[I_SGUB][(l * 4 + g) * 128 + pp];
        float au = bf2f(((const bf16_t*)(p.ws + OFF_AU))[(size_t)t * 256 + c]);
        ((bf16_t*)(p.ws + OFF_MIX))[(size_t)t * D + c] = f2bf(au * acc);
    }
}
__device__ void ph_attn_ref(const Params& p, int l, const int wv) {
    const int tid = opaque_tid(wv);
    const int lane = tid & 63;
    const int gw = blockIdx.x * 8 + (tid >> 6), nw = gridDim.x * 8;
    const float lam = lam_of(p, l);
    for (int item = gw; item < NTOK * 12; item += nw) {
        const int t = item % NTOK, hh = item / NTOK;
        const bool prompt = t < NPT;
        const int b = prompt ? t / SEQ : (t - NPT) / DSEQ;
        const int nk = prompt ? SEQ : NKS;
        if (hh < 4) {
            const int h = hh;
            const bf16_t* K = prompt ? (const bf16_t*)(p.ws + OFF_DKP) + ((size_t)b * 4 + h) * SEQ * 64 : (const bf16_t*)(p.ws + OFF_DKS) + ((size_t)b * 4 + h) * NKS * 64;
            const bf16_t* Vt = prompt ? (const bf16_t*)(p.ws + OFF_DVTP) + ((size_t)b * 4 + h) * 64 * SEQ : (const bf16_t*)(p.ws + OFF_DVTS) + ((size_t)b * 4 + h) * 64 * NKS;
            float q = bf2f(((const bf16_t*)(p.ws + OFF_DQ))[(size_t)t * 256 + h * 64 + lane]);
            const float scale = 0.17677669529663687f;
            float m0 = -1e30f, m1 = -1e30f, l0 = 0.f, l1 = 0.f, a0 = 0.f, a1 = 0.f;
            for (int k = 0; k < nk; ++k) {
                float pr = q * bf2f(K[(size_t)k * 64 + lane]);
#pragma unroll
                for (int o = 16; o >= 1; o >>= 1) pr += shfl_x(pr, lane, o);
                float s0 = shfl_i(pr, 0) * scale, s1 = shfl_i(pr, 32) * scale;
                float v = bf2f(Vt[(size_t)lane * nk + k]);
                float mn0 = fmaxf(m0, s0), mn1 = fmaxf(m1, s1);
                float c0 = expf(m0 - mn0), c1 = expf(m1 - mn1);
                float e0 = expf(s0 - mn0), e1 = expf(s1 - mn1);
                l0 = l0 * c0 + e0; l1 = l1 * c1 + e1;
                a0 = a0 * c0 + e0 * v; a1 = a1 * c1 + e1 * v;
                m0 = mn0; m1 = mn1;
            }
            float o = a0 / l0 - lam * a1 / l1;
            float ss = wave_sum(o * o);
            float r = rsqrtf(ss / 64.f + EPS);
            o = o * r * p.in[I_SUBLN][l * 64 + lane] * (1.f - lam_init_of(l));
            ((bf16_t*)(p.ws + OFF_MIX))[(size_t)t * D + 256 + h * 64 + lane] = f2bf(o);
        } else {
            const int hq = hh - 4, kv = hq >> 2;
            const bf16_t* K = prompt ? (const bf16_t*)(p.ws + OFF_GKP) + ((size_t)b * 2 + kv) * SEQ * 64 : (const bf16_t*)(p.ws + OFF_GKS) + ((size_t)b * 2 + kv) * NKS * 64;
            const bf16_t* Vt = prompt ? (const bf16_t*)(p.ws + OFF_GVTP) + ((size_t)b * 2 + kv) * 64 * SEQ : (const bf16_t*)(p.ws + OFF_GVTS) + ((size_t)b * 2 + kv) * 64 * NKS;
            float q = bf2f(((const bf16_t*)(p.ws + OFF_GQ))[(size_t)t * 512 + hq * 64 + lane]);
            float m = -1e30f, ls = 0.f, a = 0.f;
            for (int k = 0; k < nk; ++k) {
                float s = wave_sum(q * bf2f(K[(size_t)k * 64 + lane])) * 0.125f;
                float v = bf2f(Vt[(size_t)lane * nk + k]);
                float mn = fmaxf(m, s);
                float c = expf(m - mn), e = expf(s - mn);
                ls = ls * c + e; a = a * c + e * v; m = mn;
            }
            ((bf16_t*)(p.ws + OFF_MIX))[(size_t)t * D + 512 + hq * 64 + lane] = f2bf(a / ls);
        }
    }
}
__device__ void ph_peer_scores(const Params& p, int l, const int wv) {
    const int tid = opaque_tid(wv);
    const bf16_t* SK = (const bf16_t*)(p.ws + OFF_SUBK) + (size_t)l * 2 * 128 * 64;
    for (size_t idx = GTID; idx < (size_t)NTOK * 2048; idx += GNT) {
        int t = (int)(idx >> 11), o = (int)(idx & 2047);
        const bf16_t* Q = (const bf16_t*)(p.ws + OFF_Q) + (size_t)t * D;
        int n = o & 127, x = (o >> 7) & 1, h = o >> 8;
        float acc = 0.f;
        for (int k = 0; k < 64; ++k) acc += bf2f(Q[h * 128 + x * 64 + k]) * bf2f(SK[((size_t)x * 128 + n) * 64 + k]);
        ((float*)(p.ws + OFF_PROJ))[idx] = acc;
    }
}
__device__ void ph_peer_top1(const Params& p, const int wv) {
    const int tid = opaque_tid(wv);
    for (size_t idx = GTID; idx < (size_t)NTOK * 16; idx += GNT) {
        const float* SC = (const float*)(p.ws + OFF_PROJ) + idx * 128;
        float* TV = (float*)(p.ws + OFF_TOPV) + idx * 16; int* TI = (int*)(p.ws + OFF_TOPI) + idx * 16;
        float pv = 3.0e38f; int pi = -1;
        for (int r = 0; r < 16; ++r) {
            float bv = -3.0e38f; int bi = -1;
            for (int n = 0; n < 128; ++n) {
                float v = SC[n];
                bool after = (v < pv) || (v == pv && n > pi);
                if (after && (bi < 0 || v > bv)) { bv = v; bi = n; }
            }
            TV[r] = bv; TI[r] = bi; pv = bv; pi = bi;
        }
    }
}
__device__ void ph_peer_top2(const Params& p, const int wv) {
    const int tid = opaque_tid(wv);
    for (size_t idx = GTID; idx < (size_t)NTOK * 8; idx += GNT) {
        const float* TV = (const float*)(p.ws + OFF_TOPV) + idx * 32; const int* TI = (const int*)(p.ws + OFF_TOPI) + idx * 32;
        int* EI = (int*)(p.ws + OFF_EIDX) + idx * 16; float* EG = (float*)(p.ws + OFF_EGATE) + idx * 16;
        float pv = 3.0e38f; int pi = -1; float mx = 0.f, sum = 0.f;
        for (int r = 0; r < 16; ++r) {
            float bv = -3.0e38f; int bi = -1;
            for (int n = 0; n < 256; ++n) {
                float v = TV[n >> 4] + TV[16 + (n & 15)];
                bool after = (v < pv) || (v == pv && n > pi);
                if (after && (bi < 0 || v > bv)) { bv = v; bi = n; }
            }
            if (r == 0) mx = bv;
            float e = expf(bv - mx);
            sum += e;
            EG[r] = e; EI[r] = TI[bi >> 4] * 128 + TI[16 + (bi & 15)];
            pv = bv; pi = bi;
        }
        float inv = 1.f / sum;
        for (int r = 0; r < 16; ++r) EG[r] *= inv;
    }
}
__device__ void ph_peer_apply(const Params& p, int l, unsigned char* lds, const int wv) {
    const int tid = opaque_tid(wv);
    const int sub = tid >> 8, tl = tid & 255;
    const int wave = tl >> 6, lane = tl & 63;
    float* wts = (float*)(lds + 64) + sub * 128; int* eid = (int*)(lds + 64 + 1024) + sub * 128;
    const bf16_t* UT = (const bf16_t*)(p.ws + OFF_UT) + (size_t)l * NEXP * D;
    const bf16_t* VT = (const bf16_t*)(p.ws + OFF_VT) + (size_t)l * NEXP * D;
    const int niter = (NTOK + gridDim.x * 2 - 1) / (gridDim.x * 2);
    for (int it = 0; it < niter; ++it) {
        int t = (it * gridDim.x + blockIdx.x) * 2 + sub;
        const bool valid = t < NTOK; if (!valid) t = NTOK - 1;
        const bf16_t* H = (const bf16_t*)(p.ws + OFF_H) + (size_t)t * D;
        const int* EI = (const int*)(p.ws + OFF_EIDX) + (size_t)t * 128; const float* EG = (const float*)(p.ws + OFF_EGATE) + (size_t)t * 128;
        float hv[16];
#pragma unroll
        for (int i = 0; i < 16; ++i) hv[i] = bf2f(H[lane * 16 + i]);
        for (int jj = 0; jj < 32; ++jj) {
            int j = wave * 32 + jj; int e = EI[j];
            const bf16_t* ur = UT + (size_t)e * D + lane * 16;
            float acc = 0.f;
#pragma unroll
            for (int i = 0; i < 16; ++i) acc += hv[i] * bf2f(ur[i]);
            acc = wave_sum(acc);
            if (lane == 0) { wts[j] = EG[j] * gelu_f(acc); eid[j] = e; }
        }
        __syncthreads();
        float o[4] = {0.f, 0.f, 0.f, 0.f};
        for (int j = 0; j < 128; ++j) {
            const bf16_t* vr = VT + (size_t)eid[j] * D + tl * 4; float w = wts[j];
#pragma unroll
            for (int i = 0; i < 4; ++i) o[i] += w * bf2f(vr[i]);
        }
        const float* mod = (const float*)(p.ws + OFF_MOD) + (size_t)(l * 5 + tok_cv(t)) * 6144 + 5 * 1024;
        float* XC = (float*)(p.ws + OFF_XC) + (size_t)t * D;
        if (valid) {
#pragma unroll
            for (int i = 0; i < 4; ++i) { int c = tl * 4 + i; XC[c] += mod[c] * o[i]; }
        }
        __syncthreads();
    }
}
__device__ void ph_final_norm(const Params& p, const int wv) {
    const int tid = opaque_tid(wv);
    const int lane = tid & 63;
    const int gw = blockIdx.x * 8 + (tid >> 6), nw = gridDim.x * 8;
    u32x4 nx[2];
    {
        const int t = gw < NTOK ? gw : NTOK - 1;
        const bf16_t* xr = (const bf16_t*)(p.ws + OFF_XC) + (size_t)t * D + lane * 8;
        nx[0] = *reinterpret_cast<const u32x4*>(xr); nx[1] = *reinterpret_cast<const u32x4*>(xr + 512);
    }
    for (int t = gw; t < NTOK; t += nw) {
        float v[16];
#pragma unroll
        for (int h = 0; h < 2; ++h)
#pragma unroll
            for (int k = 0; k < 4; ++k) { v[h * 8 + 2 * k] = __uint_as_float(nx[h][k] << 16); v[h * 8 + 2 * k + 1] = __uint_as_float(nx[h][k] & 0xffff0000u); }
        {
            const int tn = t + nw < NTOK ? t + nw : t;
            const bf16_t* xn = (const bf16_t*)(p.ws + OFF_XC) + (size_t)tn * D + lane * 8;
            nx[0] = *reinterpret_cast<const u32x4*>(xn); nx[1] = *reinterpret_cast<const u32x4*>(xn + 512);
        }
        float ss = 0.f;
#pragma unroll
        for (int i = 0; i < 16; ++i) ss += v[i] * v[i];
        ss = wave_sum(ss);
        float r = rsqrtf(ss / D + EPS);
        float* y = p.out + (size_t)t * D;
#pragma unroll
        for (int h = 0; h < 2; ++h) {
            const int c = h * 512 + lane * 8;
#pragma unroll
            for (int q = 0; q < 2; ++q) {
                const float4 g = *reinterpret_cast<const float4*>(p.in[I_FG] + c + q * 4);
                *reinterpret_cast<float4*>(y + c + q * 4) = make_float4(v[h * 8 + q * 4] * r * g.x, v[h * 8 + q * 4 + 1] * r * g.y, v[h * 8 + q * 4 + 2] * r * g.z, v[h * 8 + q * 4 + 3] * r * g.w);
            }
        }
    }
}


namespace g8 {
constexpr int BM = 256, BK = 64, HALF = 128, HT = HALF * BK;
__device__ __forceinline__ int lds_byte(int r, int c) {
    int st = (r >> 4) * 2 + (c >> 5), rr = r & 15, cc = c & 31, ob = rr * 64 + cc * 2;
    return st * 1024 + (ob ^ (((ob >> 9) & 1) << 5));
}
__device__ __forceinline__ void stage_rc(int b, int& R, int& C) {
    int st = b / 1024, sb = b % 1024, swz = sb ^ (((sb >> 9) & 1) << 5);
    R = (st >> 1) * 16 + swz / 64; C = (st & 1) * 32 + (swz % 64) / 2;
}
}
enum { EPI_INPROJ = 0, EPI_WOUT = 1, EPI_WQ = 2 };
constexpr int STG = 132;

__device__ __forceinline__ void store_bf16x32(bf16_t* dst, const float (&v)[32]) {
#pragma unroll
    for (int i = 0; i < 4; ++i) {
        uint4 u;
        u.x = pack_bf2(v[i * 8 + 0], v[i * 8 + 1]); u.y = pack_bf2(v[i * 8 + 2], v[i * 8 + 3]);
        u.z = pack_bf2(v[i * 8 + 4], v[i * 8 + 5]); u.w = pack_bf2(v[i * 8 + 6], v[i * 8 + 7]);
        *reinterpret_cast<uint4*>(dst + i * 8) = u;
    }
}
__device__ __forceinline__ void store_f32x32(float* dst, const float (&v)[32]) {
#pragma unroll
    for (int i = 0; i < 8; ++i) *reinterpret_cast<float4*>(dst + i * 4) = make_float4(v[i * 4], v[i * 4 + 1], v[i * 4 + 2], v[i * 4 + 3]);
}

__device__ __forceinline__ void epi_inproj_row(const Params& p, int l, int t, int c0, float (&v)[32]) {
    const bool prompt = t < NPT;
    const int b = prompt ? (t >> 8) : ((t - NPT) >> 11);
    const int s = prompt ? (t & 255) : ((t - NPT) & 2047);
    unsigned char* ws = p.ws;
    const float* R = (const float*)(ws + OFF_ROPE);
    if (c0 < 512) {
        bf16_t* dst = (bf16_t*)(ws + (c0 < 256 ? OFF_AU : OFF_AV)) + (size_t)t * 256 + (c0 & 255);
#pragma unroll
        for (int i = 0; i < 32; ++i) v[i] = gelu_f(v[i]);
        store_bf16x32(dst, v);
    } else if (c0 < 1024) {
        const bool isq = c0 < 768;
        if (!isq && prompt) store_f32x32(p.out + OUT_NDK + (((size_t)b * 2 + l) * SEQ + s) * 256 + (c0 - 768), v);
        if (!prompt) {
            const float* cs = R + s * 16; const float* sn = R + 2048 * 16 + s * 16;
#pragma unroll
            for (int i = 0; i < 16; ++i) {
                float c = cs[i], sv = sn[i], x1 = v[i], x2 = v[i + 16];
                v[i] = x1 * c - x2 * sv; v[i + 16] = x2 * c + x1 * sv;
            }
        }
        bf16_t* dst;
        if (isq) dst = (bf16_t*)(ws + OFF_DQ) + (size_t)t * 256 + (c0 - 512);
        else {
            const int cc = c0 - 768, h = cc >> 6, r = cc & 63;
            dst = prompt ? (bf16_t*)(ws + OFF_DKP) + (((size_t)b * 4 + h) * SEQ + s) * 64 + r
                         : (bf16_t*)(ws + OFF_DKS) + (((size_t)b * 4 + h) * NKS + s) * 64 + r;
        }
        store_bf16x32(dst, v);
    } else if (c0 < 1280) {
        if (prompt) store_f32x32(p.out + OUT_NDV + (((size_t)b * 2 + l) * SEQ + s) * 256 + (c0 - 1024), v);
    } else if (c0 < 1920) {
        const bool isq = c0 < 1792;
        const int hi = c0 & 32;
        const float* g = p.in[isq ? I_QNG : I_KNG] + l * 64 + hi;
        float ss = 0.f;
#pragma unroll
        for (int i = 0; i < 32; ++i) ss += v[i] * v[i];
        const int ln = lane_id_op();
        ss += shfl_x(ss, ln, 1);
        const float rr = rsqrtf(ss * (1.f / 64.f) + EPS);
#pragma unroll
        for (int i = 0; i < 32; ++i) v[i] = v[i] * rr * g[i];
        if (!isq && prompt) store_f32x32(p.out + OUT_NGK + (((size_t)b * 2 + l) * SEQ + s) * 128 + (c0 - 1792), v);
        if (!prompt) {
            const float* cs = R + 2048 * 32 + s * 32; const float* sn = R + 2048 * 64 + s * 32;
#pragma unroll
            for (int i = 0; i < 32; ++i) {
                float pv = shfl_x(v[i], ln, 1);
                float c = cs[i], sv = sn[i];
                v[i] = hi ? (v[i] * c + pv * sv) : (v[i] * c - pv * sv);
            }
        }
        bf16_t* dst;
        if (isq) dst = (bf16_t*)(ws + OFF_GQ) + (size_t)t * 512 + (c0 - 1280);
        else {
            const int cc = c0 - 1792, kv = cc >> 6, r = cc & 63;
            dst = prompt ? (bf16_t*)(ws + OFF_GKP) + (((size_t)b * 2 + kv) * SEQ + s) * 64 + r
                         : (bf16_t*)(ws + OFF_GKS) + (((size_t)b * 2 + kv) * NKS + s) * 64 + r;
        }
        store_bf16x32(dst, v);
    } else {
        if (prompt) store_f32x32(p.out + OUT_NGV + (((size_t)b * 2 + l) * SEQ + s) * 128 + (c0 - 1920), v);
    }
}
__device__ __forceinline__ void epi_inproj_col(const Params& p, int t0, int c, const LAS float* stc) {
    float v[32];
#pragma unroll
    for (int i = 0; i < 32; ++i) v[i] = stc[i * STG];
    const bool prompt = t0 < NPT;
    const int b = prompt ? (t0 >> 8) : ((t0 - NPT) >> 11);
    const int s = prompt ? (t0 & 255) : ((t0 - NPT) & 2047);
    unsigned char* ws = p.ws;
    bf16_t* dst;
    if (c < 1280) {
        const int cc = c - 1024, h = cc >> 6, d = cc & 63;
        dst = prompt ? (bf16_t*)(ws + OFF_DVTP) + (((size_t)b * 4 + h) * 64 + d) * SEQ + s
                     : (bf16_t*)(ws + OFF_DVTS) + (((size_t)b * 4 + h) * 64 + d) * NKS + s;
    } else {
        const int cc = c - 1920, kv = cc >> 6, d = cc & 63;
        dst = prompt ? (bf16_t*)(ws + OFF_GVTP) + (((size_t)b * 2 + kv) * 64 + d) * SEQ + s
                     : (bf16_t*)(ws + OFF_GVTS) + (((size_t)b * 2 + kv) * 64 + d) * NKS + s;
    }
    store_bf16x32(dst, v);
}

template <int MODE>
__device__ __forceinline__ void gemm_phase(const Params& p, int l, const bf16_t* __restrict__ A, const bf16_t* __restrict__ Bt, const int N, unsigned char* ldsraw, const int wv) {
    using namespace g8;
    constexpr int K = 1024, nt = K / BK, BN = 128, TILE_A = BM * BK * 2, TILE_B = BN * BK * 2, STAGE_B = TILE_A + TILE_B;
    LAS unsigned char* lds = (LAS unsigned char*)ldsraw;
    const int tid = opaque_tid(wv), wid = wv, lane = tid & 63;
    const int wr = wid >> 1, wc = wid & 1, fr = lane & 15, fq = lane >> 4;
    unsigned voff[4];
#pragma unroll
    for (int i = 0; i < 4; ++i) voff[i] = (unsigned)((i * 64 + wid * 8 + (lane >> 3)) * K + (((lane & 7) ^ (lane >> 3)) * 8)) * 2u;
    const int aoff = (wr * 64 + fr) * 128 + ((fq ^ (fr & 7)) * 16), boff = (wc * 64 + fr) * 128 + ((fq ^ (fr & 7)) * 16);
    const unsigned ldsw = (unsigned)wid * 1024u;
#define G8_STAGE(buf, kt) do { \
        _Pragma("unroll") for (int _i = 0; _i < 4; ++_i) \
            __builtin_amdgcn_global_load_lds((const unsigned*)((const char*)(Ab + (kt) * BK) + voff[_i]), (LAS unsigned*)(lds + (buf) * STAGE_B + ldsw + _i * 8192), 16, 0, 0); \
        _Pragma("unroll") for (int _i = 0; _i < 2; ++_i) \
            __builtin_amdgcn_global_load_lds((const unsigned*)((const char*)(Bb + (kt) * BK) + voff[_i]), (LAS unsigned*)(lds + (buf) * STAGE_B + TILE_A + ldsw + _i * 8192), 16, 0, 0); } while (0)
#define G8_WAIT_V0() asm volatile("s_waitcnt vmcnt(0)" ::: "memory")
    const int nN = N / BN, nM = NTOK / BM, ntiles = nM * nN;
    const int G = gridDim.x;
    const int vb = (G % 8 == 0) ? (int)(blockIdx.x % 8) * (G / 8) + (int)(blockIdx.x / 8) : (int)blockIdx.x;
    const int tpb = (ntiles + G - 1) / G;
    const bool paneled = (G == 256) && (nN == 8 || nN == 16) && (nM == 64);
    for (int ti = 0; ti < tpb; ++ti) {
        int tile = vb * tpb + ti;
        if (paneled) {
            const int x = vb >> 5, j = vb & 31;
            const int mpx = nN == 16 ? 16 : 8;
            const int m0 = nN == 16 ? (x >> 1) * 16 : x * 8, n0 = nN == 16 ? (x & 1) * 8 : 0;
            const int pm_ = m0 + ti * 4 + (j >> 3), pn_ = n0 + (j & 7);
            tile = (ti * 4 < mpx) ? pm_ * nN + pn_ : ntiles;
        }
        if (tile >= ntiles) break;
        const int pm = tile / nN, pn = tile % nN, brow = pm * BM, bcol = pn * BN;
        const bf16_t* Ab = A + (size_t)brow * K; const bf16_t* Bb = Bt + (size_t)bcol * K;
        f32x4 acc[4][4];
#pragma unroll
        for (int m = 0; m < 4; ++m)
#pragma unroll
            for (int n = 0; n < 4; ++n) acc[m][n] = f32x4{0.f, 0.f, 0.f, 0.f};
        G8_WAIT_V0();
        G8_STAGE(0, 0); G8_STAGE(1, 1);
        int cur = 0;
        for (int t = 0; t < nt; ++t) {
            if (t + 1 < nt) asm volatile("s_waitcnt vmcnt(6)" ::: "memory"); else asm volatile("s_waitcnt vmcnt(0)" ::: "memory");
            __builtin_amdgcn_s_barrier();
            if (t + 2 < nt) { const int nb = cur >= 1 ? cur - 1 : 2; G8_STAGE(nb, t + 2); }
            {
                bf16x8 At[2][4], Bf[2][4];
#pragma unroll
                for (int ks = 0; ks < 2; ++ks) {
#pragma unroll
                    for (int m = 0; m < 4; ++m) At[ks][m] = *(const LAS bf16x8*)(lds + cur * STAGE_B + ((aoff + m * 2048) ^ (ks * 64)));
#pragma unroll
                    for (int n = 0; n < 4; ++n) Bf[ks][n] = *(const LAS bf16x8*)(lds + cur * STAGE_B + TILE_A + ((boff + n * 2048) ^ (ks * 64)));
                }
                __builtin_amdgcn_sched_barrier(0);
#pragma unroll
                for (int ks = 0; ks < 2; ++ks)
#pragma unroll
                    for (int m = 0; m < 4; ++m)
#pragma unroll
                        for (int n = 0; n < 4; ++n) acc[m][n] = __builtin_amdgcn_mfma_f32_16x16x32_bf16(At[ks][m], Bf[ks][n], acc[m][n], 0, 0, 0);
                __builtin_amdgcn_sched_barrier(0);
            }
            cur = cur == 2 ? 0 : cur + 1;
        }
        __syncthreads();
        LAS float* st = (LAS float*)lds;
#pragma unroll
        for (int m = 0; m < 4; ++m)
#pragma unroll
            for (int n = 0; n < 4; ++n)
#pragma unroll
                for (int j = 0; j < 4; ++j)
                    st[(wr * 64 + m * 16 + fq * 4 + j) * STG + wc * 64 + n * 16 + fr] = acc[m][n][j];
        __syncthreads();
#pragma unroll 1
        for (int it = 0; it < 2; ++it) {
            const int item = it * NT + tid, erow = item >> 2, eseg = item & 3;
            const int t = brow + erow, c0 = bcol + eseg * 32;
            float v[32];
#pragma unroll
            for (int i = 0; i < 8; ++i) {
                const f32x4 f = *(const LAS f32x4*)(st + erow * STG + eseg * 32 + i * 4);
                v[i * 4] = f[0]; v[i * 4 + 1] = f[1]; v[i * 4 + 2] = f[2]; v[i * 4 + 3] = f[3];
            }
            if (MODE == EPI_INPROJ) {
                epi_inproj_row(p, l, t, c0, v);
            } else if (MODE == EPI_WOUT) {
                const float* g1 = (const float*)(p.ws + OFF_MOD) + (size_t)(l * 5 + tok_cv(t)) * 6144 + 2048 + c0;
                bf16_t* xo = (bf16_t*)(p.ws + OFF_XC) + (size_t)t * D + c0;
                float xin[32];
                if (l == 0) {
                    const float* xr = x_in_row(p, t) + c0;
#pragma unroll
                    for (int i = 0; i < 8; ++i) { const float4 x = *reinterpret_cast<const float4*>(xr + i * 4); xin[i * 4] = x.x; xin[i * 4 + 1] = x.y; xin[i * 4 + 2] = x.z; xin[i * 4 + 3] = x.w; }
                } else {
#pragma unroll
                    for (int i = 0; i < 4; ++i) {
                        const u32x4 x = *reinterpret_cast<const u32x4*>(xo + i * 8);
#pragma unroll
                        for (int k = 0; k < 4; ++k) { xin[i * 8 + 2 * k] = __uint_as_float(x[k] << 16); xin[i * 8 + 2 * k + 1] = __uint_as_float(x[k] & 0xffff0000u); }
                    }
                }
#pragma unroll
                for (int i = 0; i < 8; ++i) {
                    const float4 g = *reinterpret_cast<const float4*>(g1 + i * 4);
                    v[i * 4] = xin[i * 4] + g.x * v[i * 4]; v[i * 4 + 1] = xin[i * 4 + 1] + g.y * v[i * 4 + 1];
                    v[i * 4 + 2] = xin[i * 4 + 2] + g.z * v[i * 4 + 2]; v[i * 4 + 3] = xin[i * 4 + 3] + g.w * v[i * 4 + 3];
                }
                store_bf16x32(xo, v);
            } else {
                store_bf16x32((bf16_t*)(p.ws + OFF_Q) + (size_t)t * D + c0, v);
            }
        }
        if (MODE == EPI_INPROJ && ((bcol >= 1024 && bcol < 1280) || bcol >= 1920)) {
#pragma unroll 1
            for (int it = 0; it < 2; ++it) {
                const int item = it * NT + tid, col = item >> 3, run = item & 7;
                epi_inproj_col(p, brow + run * 32, bcol + col, st + run * 32 * STG + col);
            }
        }
        __syncthreads();
    }
}


#define MFMA32(a, b, c) __builtin_amdgcn_mfma_f32_32x32x16_bf16((a), (b), (c), 0, 0, 0)
constexpr int ATT_ROWB = 144;
constexpr int ATT_TILEB = 64 * ATT_ROWB;
constexpr int QW_MIX = 4096;

__device__ __forceinline__ bf16x8 pack8(const f32x16& x, int s) {
    const u32x4 w = {pack_bf2(x[8 * s], x[8 * s + 1]), pack_bf2(x[8 * s + 2], x[8 * s + 3]), pack_bf2(x[8 * s + 4], x[8 * s + 5]), pack_bf2(x[8 * s + 6], x[8 * s + 7])};
    return __builtin_bit_cast(bf16x8, w);
}
__device__ __forceinline__ void softmax_tile(f32x16& s0, f32x16& s1, const float sc, float& m, float& l, float& alpha, const int lane) {
    float mx = fmaxf(s0[0], s1[0]);
#pragma unroll
    for (int i = 1; i < 16; ++i) mx = fmaxf(mx, fmaxf(s0[i], s1[i]));
    mx = fmaxf(mx, shfl_x(mx, lane, 32));
    const float mnew = fmaxf(m, mx * sc);
    alpha = __builtin_amdgcn_exp2f(m - mnew);
    m = mnew;
    float ps = 0.f;
#pragma unroll
    for (int i = 0; i < 16; ++i) { s0[i] = __builtin_amdgcn_exp2f(s0[i] * sc - mnew); s1[i] = __builtin_amdgcn_exp2f(s1[i] * sc - mnew); ps += s0[i] + s1[i]; }
    l = l * alpha + ps;
}
__device__ __forceinline__ void v_frags(const LAS unsigned char* vb, bf16x8 (&vf)[8], int r, int hh) {
#pragma unroll
    for (int u = 0; u < 2; ++u)
#pragma unroll
        for (int sk = 0; sk < 2; ++sk)
#pragma unroll
            for (int mt = 0; mt < 2; ++mt) {
                const LAS unsigned char* a = vb + (32 * mt + r) * ATT_ROWB + (32 * u + 16 * sk + 4 * hh) * 2;
                const s16x4 lo = *(const LAS s16x4*)a, hi = *(const LAS s16x4*)(a + 16);
                vf[(u * 2 + sk) * 2 + mt] = bf16x8{lo[0], lo[1], lo[2], lo[3], hi[0], hi[1], hi[2], hi[3]};
            }
}
__device__ __forceinline__ void pv_tile(const bf16x8 (&vf)[8], const f32x16& p0, const f32x16& p1, f32x16 (&O)[2]) {
#pragma unroll
    for (int u = 0; u < 2; ++u)
#pragma unroll
        for (int sk = 0; sk < 2; ++sk) {
            const bf16x8 pf = pack8(u ? p1 : p0, sk);
#pragma unroll
            for (int mt = 0; mt < 2; ++mt) O[mt] = MFMA32(vf[(u * 2 + sk) * 2 + mt], pf, O[mt]);
        }
}

template <bool DIFF>
__device__ __forceinline__ void attn_item(const Params& p, int l, LAS unsigned char* lds, const int tid,
                                          const bf16_t* __restrict__ Qg, const int qstride,
                                          const bf16_t* __restrict__ Kg, const bf16_t* __restrict__ Vtg, const int nk,
                                          bf16_t* __restrict__ Og, const float lam) {
    const int wave = tid >> 6, lane = tid & 63, r = lane & 31, hh = lane >> 5;
    const int lrow = tid >> 3, lchunk = tid & 7;
    LAS unsigned char* kbuf = lds; LAS unsigned char* vbuf = lds + 2 * ATT_TILEB;
    bf16x8 qf[4];
    const bf16_t* qrow = Qg + (size_t)(wave * 32 + r) * qstride;
#pragma unroll
    for (int ks = 0; ks < 4; ++ks) qf[ks] = *reinterpret_cast<const bf16x8*>(qrow + ks * 16 + hh * 8);
    const float sc = (DIFF ? 0.17677669529663687f : 0.125f) * 1.4426950408889634f;
    f32x16 O0[2], O1[2];
#pragma unroll
    for (int mt = 0; mt < 2; ++mt)
#pragma unroll
        for (int i = 0; i < 16; ++i) { O0[mt][i] = 0.f; O1[mt][i] = 0.f; }
    float m0 = -1e30f, l0 = 0.f, m1 = -1e30f, l1 = 0.f;
    const int ntl = nk / 64;
    u32x4 kr, vr, kn, vn;
    kr = *reinterpret_cast<const u32x4*>(Kg + (size_t)lrow * 64 + lchunk * 8);
    vr = *reinterpret_cast<const u32x4*>(Vtg + (size_t)lrow * nk + lchunk * 8);
    *(LAS u32x4*)(kbuf + lrow * ATT_ROWB + lchunk * 16) = kr;
    *(LAS u32x4*)(vbuf + lrow * ATT_ROWB + lchunk * 16) = vr;
    {
        const int t1 = ntl > 1 ? 1 : 0;
        kr = *reinterpret_cast<const u32x4*>(Kg + (size_t)(t1 * 64 + lrow) * 64 + lchunk * 8);
        vr = *reinterpret_cast<const u32x4*>(Vtg + (size_t)lrow * nk + t1 * 64 + lchunk * 8);
    }
    __syncthreads();
    for (int ti = 0; ti < ntl; ++ti) {
        const int cur = ti & 1;
        {
            const int t2 = ti + 2 < ntl ? ti + 2 : ntl - 1;
            kn = *reinterpret_cast<const u32x4*>(Kg + (size_t)(t2 * 64 + lrow) * 64 + lchunk * 8);
            vn = *reinterpret_cast<const u32x4*>(Vtg + (size_t)lrow * nk + t2 * 64 + lchunk * 8);
        }
        const LAS unsigned char* kb = kbuf + cur * ATT_TILEB; const LAS unsigned char* vb = vbuf + cur * ATT_TILEB;
        bf16x8 ka[2][4];
#pragma unroll
        for (int u = 0; u < 2; ++u)
#pragma unroll
            for (int ks = 0; ks < 4; ++ks) ka[u][ks] = *(const LAS bf16x8*)(kb + (32 * u + r) * ATT_ROWB + (ks * 16 + hh * 8) * 2);
        __builtin_amdgcn_sched_barrier(0);
        bf16x8 vf[8];
        if (!DIFF) {
            f32x16 s0, s1;
#pragma unroll
            for (int i = 0; i < 16; ++i) { s0[i] = 0.f; s1[i] = 0.f; }
#pragma unroll
            for (int ks = 0; ks < 4; ++ks) { s0 = MFMA32(ka[0][ks], qf[ks], s0); s1 = MFMA32(ka[1][ks], qf[ks], s1); }
            v_frags(vb, vf, r, hh);
            __builtin_amdgcn_sched_barrier(0);
            float alpha;
            softmax_tile(s0, s1, sc, m0, l0, alpha, lane);
            if (__builtin_amdgcn_ballot_w64(alpha != 1.f) != 0ull) {
#pragma unroll
                for (int mt = 0; mt < 2; ++mt)
#pragma unroll
                    for (int i = 0; i < 16; ++i) O0[mt][i] *= alpha;
            }
            pv_tile(vf, s0, s1, O0);
        } else {
            f32x16 s0, s1, t0, t1;
#pragma unroll
            for (int i = 0; i < 16; ++i) { s0[i] = 0.f; s1[i] = 0.f; t0[i] = 0.f; t1[i] = 0.f; }
#pragma unroll
            for (int ks = 0; ks < 2; ++ks) {
                s0 = MFMA32(ka[0][ks], qf[ks], s0); s1 = MFMA32(ka[1][ks], qf[ks], s1);
                t0 = MFMA32(ka[0][2 + ks], qf[2 + ks], t0); t1 = MFMA32(ka[1][2 + ks], qf[2 + ks], t1);
            }
            v_frags(vb, vf, r, hh);
            __builtin_amdgcn_sched_barrier(0);
            float alpha;
            softmax_tile(s0, s1, sc, m0, l0, alpha, lane);
            if (__builtin_amdgcn_ballot_w64(alpha != 1.f) != 0ull) {
#pragma unroll
                for (int mt = 0; mt < 2; ++mt)
#pragma unroll
                    for (int i = 0; i < 16; ++i) O0[mt][i] *= alpha;
            }
            pv_tile(vf, s0, s1, O0);
            softmax_tile(t0, t1, sc, m1, l1, alpha, lane);
            if (__builtin_amdgcn_ballot_w64(alpha != 1.f) != 0ull) {
#pragma unroll
                for (int mt = 0; mt < 2; ++mt)
#pragma unroll
                    for (int i = 0; i < 16; ++i) O1[mt][i] *= alpha;
            }
            pv_tile(vf, t0, t1, O1);
        }
        if (ti + 1 < ntl) {
            *(LAS u32x4*)(kbuf + (cur ^ 1) * ATT_TILEB + lrow * ATT_ROWB + lchunk * 16) = kr;
            *(LAS u32x4*)(vbuf + (cur ^ 1) * ATT_TILEB + lrow * ATT_ROWB + lchunk * 16) = vr;
        }
        kr = kn; vr = vn;
        __syncthreads();
    }
    l0 += shfl_x(l0, lane, 32);
    const float inv0 = 1.f / l0;
    bf16_t* orow = Og + (size_t)(wave * 32 + r) * D;
    if (!DIFF) {
#pragma unroll
        for (int mt = 0; mt < 2; ++mt)
#pragma unroll
            for (int g = 0; g < 4; ++g) {
                uint2 w;
                w.x = pack_bf2(O0[mt][4 * g] * inv0, O0[mt][4 * g + 1] * inv0);
                w.y = pack_bf2(O0[mt][4 * g + 2] * inv0, O0[mt][4 * g + 3] * inv0);
                *reinterpret_cast<uint2*>(orow + 32 * mt + 8 * g + 4 * hh) = w;
            }
    } else {
        l1 += shfl_x(l1, lane, 32);
        const float inv1 = lam / l1;
        float ss = 0.f;
#pragma unroll
        for (int mt = 0; mt < 2; ++mt)
#pragma unroll
            for (int i = 0; i < 16; ++i) { const float o = O0[mt][i] * inv0 - O1[mt][i] * inv1; O0[mt][i] = o; ss += o * o; }
        ss += shfl_x(ss, lane, 32);
        const float rr = rsqrtf(ss * (1.f / 64.f) + EPS) * __builtin_bit_cast(float, __builtin_amdgcn_readfirstlane(__builtin_bit_cast(int, 1.f - lam_init_of(l))));
        const float* sg = p.in[I_SUBLN] + l * 64;
#pragma unroll
        for (int mt = 0; mt < 2; ++mt)
#pragma unroll
            for (int g = 0; g < 4; ++g) {
                const int d0 = 32 * mt + 8 * g + 4 * hh;
                const float4 gg = *reinterpret_cast<const float4*>(sg + d0);
                uint2 w;
                w.x = pack_bf2(O0[mt][4 * g] * rr * gg.x, O0[mt][4 * g + 1] * rr * gg.y);
                w.y = pack_bf2(O0[mt][4 * g + 2] * rr * gg.z, O0[mt][4 * g + 3] * rr * gg.w);
                *reinterpret_cast<uint2*>(orow + d0) = w;
            }
    }
}

constexpr int SGU_ROWB = 272;
__device__ __forceinline__ void sgu_item(const Params& p, int l, LAS unsigned char* lds, const int tid, const int t0) {
    const bf16_t* AV = (const bf16_t*)(p.ws + OFF_AV) + (size_t)t0 * 256;
    {
        const int q = tid >> 2, quarter = tid & 3;
        float v[64]; float ss = 0.f;
#pragma unroll
        for (int i = 0; i < 8; ++i) {
            const bf16x8 w = *reinterpret_cast<const bf16x8*>(AV + (size_t)q * 256 + quarter * 64 + i * 8);
#pragma unroll
            for (int j = 0; j < 8; ++j) { v[i * 8 + j] = bf2f((bf16_t)w[j]); ss += v[i * 8 + j] * v[i * 8 + j]; }
        }
        { const int ln = tid & 63; ss += shfl_x(ss, ln, 1); ss += shfl_x(ss, ln, 2); }
        const float rstd = rsqrtf(ss * (1.f / 256.f) + EPS);
        const float* g = p.in[I_SGUNG] + l * 256 + quarter * 64;
#pragma unroll
        for (int i = 0; i < 64; ++i)
            *(LAS bf16_t*)(lds + (quarter * 64 + i) * SGU_ROWB + q * 2) = f2bf(v[i] * rstd * g[i]);
    }
    __syncthreads();
    {
        const int wave = tid >> 6, lane = tid & 63, r = lane & 31, hh = lane >> 5;
        const int g = wave >> 1, ph = wave & 1;
        const bf16_t* W = (const bf16_t*)(p.ws + OFF_SGUW) + ((size_t)l * 4 + g) * 128 * 128;
        f32x16 acc[2][2];
#pragma unroll
        for (int a = 0; a < 2; ++a)
#pragma unroll
            for (int b = 0; b < 2; ++b)
#pragma unroll
                for (int i = 0; i < 16; ++i) acc[a][b][i] = 0.f;
#pragma unroll
        for (int ks = 0; ks < 8; ++ks) {
            bf16x8 af[2], bfr[2];
#pragma unroll
            for (int pt = 0; pt < 2; ++pt) af[pt] = *reinterpret_cast<const bf16x8*>(W + (size_t)(ph * 64 + pt * 32 + r) * 128 + ks * 16 + hh * 8);
#pragma unroll
            for (int ct = 0; ct < 2; ++ct) bfr[ct] = *(const LAS bf16x8*)(lds + (g * 64 + ct * 32 + r) * SGU_ROWB + (ks * 16 + hh * 8) * 2);
#pragma unroll
            for (int pt = 0; pt < 2; ++pt)
#pragma unroll
                for (int ct = 0; ct < 2; ++ct) acc[pt][ct] = MFMA32(af[pt], bfr[ct], acc[pt][ct]);
        }
        const float* bias = p.in[I_SGUB] + (l * 4 + g) * 128;
        const bf16_t* AU = (const bf16_t*)(p.ws + OFF_AU);
        bf16_t* MIX = (bf16_t*)(p.ws + OFF_MIX);
#pragma unroll
        for (int pt = 0; pt < 2; ++pt)
#pragma unroll
            for (int ct = 0; ct < 2; ++ct)
#pragma unroll
                for (int i = 0; i < 16; ++i) {
                    const int pp = ph * 64 + pt * 32 + (i & 3) + 8 * (i >> 2) + 4 * hh, c = g * 64 + ct * 32 + r;
                    const float au = bf2f(AU[(size_t)(t0 + pp) * 256 + c]);
                    MIX[(size_t)(t0 + pp) * D + c] = f2bf(au * (acc[pt][ct][i] + bias[pp]));
                }
    }
    __syncthreads();
}

__device__ void ph_mixers(const Params& p, int lq, unsigned char* ldsraw, const int wv) {
    const int l = lq & 1;
    const int tid0 = opaque_tid(wv);
    LAS unsigned char* lds = (LAS unsigned char*)ldsraw;
    volatile LAS int* qslot = (volatile LAS int*)(ldsraw - LDS_HDR + 64);
    unsigned* qw = (unsigned*)(p.ws + OFF_BAR) + QW_MIX + lq;
    const float lam = __builtin_bit_cast(float, __builtin_amdgcn_readfirstlane(__builtin_bit_cast(int, lam_of(p, l))));
    unsigned char* ws = p.ws;
    for (;;) {
        if (tid0 == 0) *qslot = (int)atomicAdd(qw, 1u);
        __syncthreads();
        const int item = *qslot;
        __syncthreads();
        if (item >= 896) break;
        if (lq >= 2 && PROBE_DUP >= 10) {
            const int cls = item < 128 ? 10 : (item < 384 ? 11 : 12);
            if (cls != PROBE_DUP) continue;
        }
        int tid = tid0; asm volatile("" : "+v"(tid));
        if (item < 128) {
            const int qc = item & 7, h = (item >> 3) & 3, b = item >> 5;
            const int t0 = NPT + b * DSEQ + qc * 256;
            attn_item<true>(p, l, lds, tid, (const bf16_t*)(ws + OFF_DQ) + (size_t)t0 * 256 + h * 64, 256,
                            (const bf16_t*)(ws + OFF_DKS) + ((size_t)b * 4 + h) * NKS * 64, (const bf16_t*)(ws + OFF_DVTS) + ((size_t)b * 4 + h) * 64 * NKS, NKS,
                            (bf16_t*)(ws + OFF_MIX) + (size_t)t0 * D + 256 + h * 64, lam);
        } else if (item < 384) {
            const int it = item - 128, qc = it & 7, hq = (it >> 3) & 7, b = it >> 6, kv = hq >> 2;
            const int t0 = NPT + b * DSEQ + qc * 256;
            attn_item<false>(p, l, lds, tid, (const bf16_t*)(ws + OFF_GQ) + (size_t)t0 * 512 + hq * 64, 512,
                             (const bf16_t*)(ws + OFF_GKS) + ((size_t)b * 2 + kv) * NKS * 64, (const bf16_t*)(ws + OFF_GVTS) + ((size_t)b * 2 + kv) * 64 * NKS, NKS,
                             (bf16_t*)(ws + OFF_MIX) + (size_t)t0 * D + 512 + hq * 64, lam);
        } else if (item < 512) {
            sgu_item(p, l, lds, tid, (item - 384) * 128);
        } else if (item < 768) {
            const int it = item - 512, hq = it & 7, b = it >> 3, kv = hq >> 2;
            const int t0 = b * SEQ;
            attn_item<false>(p, l, lds, tid, (const bf16_t*)(ws + OFF_GQ) + (size_t)t0 * 512 + hq * 64, 512,
                             (const bf16_t*)(ws + OFF_GKP) + ((size_t)b * 2 + kv) * SEQ * 64, (const bf16_t*)(ws + OFF_GVTP) + ((size_t)b * 2 + kv) * 64 * SEQ, SEQ,
                             (bf16_t*)(ws + OFF_MIX) + (size_t)t0 * D + 512 + hq * 64, lam);
        } else {
            const int it = item - 768, h = it & 3, b = it >> 2;
            const int t0 = b * SEQ;
            attn_item<true>(p, l, lds, tid, (const bf16_t*)(ws + OFF_DQ) + (size_t)t0 * 256 + h * 64, 256,
                            (const bf16_t*)(ws + OFF_DKP) + ((size_t)b * 4 + h) * SEQ * 64, (const bf16_t*)(ws + OFF_DVTP) + ((size_t)b * 4 + h) * 64 * SEQ, SEQ,
                            (bf16_t*)(ws + OFF_MIX) + (size_t)t0 * D + 256 + h * 64, lam);
        }
    }
}


using bf16x2 = __attribute__((ext_vector_type(2))) __bf16;
__device__ __forceinline__ float dot2bf(unsigned a, unsigned b, float c) {
    return __builtin_amdgcn_fdot2_f32_bf16(__builtin_bit_cast(bf16x2, a), __builtin_bit_cast(bf16x2, b), c, false);
}
template <int W>
__device__ __forceinline__ void bfly_stage(float (&part)[64], const int lane) {
    const bool hi = (lane & W) != 0;
#pragma unroll
    for (int k = 0; k < W; ++k) {
        const float keep = hi ? part[k + W] : part[k];
        const float send = hi ? part[k] : part[k + W];
        part[k] = keep + shfl_x(send, lane, W);
    }
}
constexpr int QW_PEER = 4160;
template <int W>
__device__ __forceinline__ void bfly16_stage(float (&v)[16], const int lane, const int bit) {
    const bool hi = (lane & bit) != 0;
#pragma unroll
    for (int k = 0; k < W; ++k) {
        const float keep = hi ? v[k + W] : v[k];
        const float send = hi ? v[k] : v[k + W];
        v[k] = keep + shfl_x(send, lane, bit);
    }
}
template <bool VSIDE> struct PeerTok {
    static __device__ __forceinline__ void issue(const Params& p, const unsigned char* Tslice, const int elo, const int ehi, const int t, const int s,
                                                 const int sub, const int c16, u32x4 (&a)[16], u32x4 (&h)[2]) {
#pragma unroll
        for (int i = 0; i < 16; ++i) {
            const int e = shfl_i(i < 8 ? elo : ehi, (i * 8 + sub) & 63);
            a[i] = *reinterpret_cast<const u32x4*>(Tslice + (((unsigned)e << 7) + (unsigned)c16 * 16u));
        }
        if (!VSIDE) {
            const bf16_t* Hr = (const bf16_t*)(p.ws + OFF_H) + (size_t)t * D + s * 128 + c16 * 16;
            h[0] = *reinterpret_cast<const u32x4*>(Hr); h[1] = *reinterpret_cast<const u32x4*>(Hr + 8);
        }
    }
    static __device__ __forceinline__ void compute(const Params& p, const int l, const float wlo, const float whi, const int t, const int s,
                                                   const int lane, const int sub, const int c16, const u32x4 (&a)[16], const u32x4 (&h)[2]) {
        if (!VSIDE) {
            f32x2 hf[8];
#pragma unroll
            for (int k = 0; k < 4; ++k) {
                hf[k] = f32x2{__uint_as_float(h[0][k] << 16), __uint_as_float(h[0][k] & 0xffff0000u)};
                hf[4 + k] = f32x2{__uint_as_float(h[1][k] << 16), __uint_as_float(h[1][k] & 0xffff0000u)};
            }
            float d[16];
#pragma unroll
            for (int i = 0; i < 16; ++i) {
                f32x2 acc = f32x2{0.f, 0.f};
#pragma unroll
                for (int k = 0; k < 4; ++k) {
                    acc += __builtin_amdgcn_cvt_pk_f32_fp8((int)a[i][k], false) * hf[2 * k];
                    acc += __builtin_amdgcn_cvt_pk_f32_fp8((int)a[i][k], true) * hf[2 * k + 1];
                }
                d[i] = acc[0] + acc[1];
            }
            bfly16_stage<8>(d, lane, 4); bfly16_stage<4>(d, lane, 2); bfly16_stage<2>(d, lane, 1);
            const int i0 = ((lane & 4) << 1) + ((lane & 2) << 1) + ((lane & 1) << 1);
            float* PART = (float*)(p.ws + OFF_PART) + ((size_t)s * NTOK + t) * 128;
            PART[i0 * 8 + sub] = d[0]; PART[(i0 + 1) * 8 + sub] = d[1];
        } else {
            f32x2 o[8];
#pragma unroll
            for (int k = 0; k < 8; ++k) o[k] = f32x2{0.f, 0.f};
#pragma unroll
            for (int i = 0; i < 16; ++i) {
                const float w = shfl_i(i < 8 ? wlo : whi, (i * 8 + sub) & 63);
                const f32x2 ww = f32x2{w, w};
#pragma unroll
                for (int k = 0; k < 4; ++k) {
                    o[2 * k] += __builtin_amdgcn_cvt_pk_f32_fp8((int)a[i][k], false) * ww;
                    o[2 * k + 1] += __builtin_amdgcn_cvt_pk_f32_fp8((int)a[i][k], true) * ww;
                }
            }
            float ov[16];
#pragma unroll
            for (int k = 0; k < 8; ++k) { ov[2 * k] = o[k][0]; ov[2 * k + 1] = o[k][1]; }
            bfly16_stage<8>(ov, lane, 32); bfly16_stage<4>(ov, lane, 16); bfly16_stage<2>(ov, lane, 8);
            const int col = s * 128 + c16 * 16 + ((lane & 32) >> 2) + ((lane & 16) >> 2) + ((lane & 8) >> 2);
            const float* g2 = (const float*)(p.ws + OFF_MOD) + (size_t)(l * 5 + tok_cv(t)) * 6144 + 5 * 1024 + col;
            unsigned* XC = reinterpret_cast<unsigned*>((bf16_t*)(p.ws + OFF_XC) + (size_t)t * D + col);
            const unsigned x = *XC; const float2 g = *reinterpret_cast<const float2*>(g2);
            *XC = pack_bf2(__uint_as_float(x << 16) + g.x * ov[0], __uint_as_float(x & 0xffff0000u) + g.y * ov[1]);
        }
    }
};
template <bool VSIDE>
__device__ __forceinline__ void peer_slice_stream(const Params& p, const int l, const int s, const int first, const int stride, const int lane) {
    const int sub = lane >> 3, c16 = lane & 7;
    const unsigned char* Ts = p.ws + (VSIDE ? OFF_VT : OFF_UT) + ((size_t)l * 8 + s) * NEXP * 128;
    const int* EIb = (const int*)(p.ws + OFF_EIDX); const float* WPb = (const float*)(p.ws + OFF_WPAIR);
    if (first >= NTOK) return;
    const int cnt = (NTOK - first + stride - 1) / stride;
#define PEER_LOADE(k, elo, ehi, wlo, whi) do { const int _t = min(first + (k) * stride, NTOK - 1); \
        elo = EIb[(size_t)_t * 128 + lane]; ehi = EIb[(size_t)_t * 128 + 64 + lane]; \
        if (VSIDE) { wlo = WPb[(size_t)_t * 128 + lane]; whi = WPb[(size_t)_t * 128 + 64 + lane]; } } while (0)
    int e0l, e0h, e1l, e1h, e2l, e2h; float w0l = 0.f, w0h = 0.f, w1l = 0.f, w1h = 0.f, w2l = 0.f, w2h = 0.f;
    u32x4 A[16], B[16], hA[2], hB[2];
    PEER_LOADE(0, e0l, e0h, w0l, w0h);
    PEER_LOADE(1, e1l, e1h, w1l, w1h);
    PeerTok<VSIDE>::issue(p, Ts, e0l, e0h, first, s, sub, c16, A, hA);
    for (int k = 0; k < cnt; k += 2) {
        const int ta = first + k * stride, tb = min(ta + stride, NTOK - 1), tc = min(ta + 2 * stride, NTOK - 1);
        __builtin_amdgcn_sched_barrier(0);
        PEER_LOADE(k + 2, e2l, e2h, w2l, w2h);
        PeerTok<VSIDE>::issue(p, Ts, e1l, e1h, tb, s, sub, c16, B, hB);
        __builtin_amdgcn_sched_barrier(0);
        PeerTok<VSIDE>::compute(p, l, w0l, w0h, ta, s, lane, sub, c16, A, hA);
        __builtin_amdgcn_sched_barrier(0);
        e0l = e2l; e0h = e2h; w0l = w2l; w0h = w2h;
        PEER_LOADE(k + 3, e2l, e2h, w2l, w2h);
        PeerTok<VSIDE>::issue(p, Ts, e0l, e0h, tc, s, sub, c16, A, hA);
        __builtin_amdgcn_sched_barrier(0);
        if (k + 1 < cnt) PeerTok<VSIDE>::compute(p, l, w1l, w1h, tb, s, lane, sub, c16, B, hB);
        e1l = e2l; e1h = e2h; w1l = w2l; w1h = w2h;
    }
#undef PEER_LOADE
}
template <bool VSIDE>
__device__ void ph_peer_sliced(const Params& p, int l, unsigned char* ldsraw, const int wv) {
    const int tid = opaque_tid(wv);
    const int wave = tid >> 6, lane = tid & 63;
    volatile LAS int* hdr = (volatile LAS int*)(ldsraw - LDS_HDR);
    unsigned* bar = (unsigned*)(p.ws + OFF_BAR);
    const int myx = (int)(xb_xcc_id() & 15u);
    if (tid == 0) hdr[16] = (int)atomicAdd(bar + QW_PEER + (l * 2 + (VSIDE ? 1 : 0)) * 16 + myx, 1u);
    __syncthreads();
    const int rank = hdr[16], nloc = (int)hdr[0];
    __syncthreads();
    if (myx < 8) peer_slice_stream<VSIDE>(p, l, myx, rank * 8 + wave, nloc * 8, lane);
    for (int j = 0; j < 8; ++j) {
        if (xb_ld(&bar[XB_XCNT(j)]) == 0u) peer_slice_stream<VSIDE>(p, l, j, (int)blockIdx.x * 8 + wave, (int)gridDim.x * 8, lane);
    }
}
__device__ void ph_peer_pairw(const Params& p, int l, const int wv) {
    const int tid = opaque_tid(wv);
    const float* USC = (const float*)(p.ws + OFF_USC) + l * NEXP; const float* VSC = (const float*)(p.ws + OFF_VSC) + l * NEXP;
    const float* PART = (const float*)(p.ws + OFF_PART);
    for (size_t i4 = GTID; i4 < (size_t)NTOK * 32; i4 += GNT) {
        const size_t idx = i4 * 4;
        float4 ps[8];
#pragma unroll
        for (int s = 0; s < 8; ++s) ps[s] = *reinterpret_cast<const float4*>(PART + (size_t)s * NTOK * 128 + idx);
        const int4 e = *reinterpret_cast<const int4*>((const int*)(p.ws + OFF_EIDX) + idx);
        const float4 g = *reinterpret_cast<const float4*>((const float*)(p.ws + OFF_EGATE) + idx);
        float4 sum = ps[0];
#pragma unroll
        for (int s = 1; s < 8; ++s) { sum.x += ps[s].x; sum.y += ps[s].y; sum.z += ps[s].z; sum.w += ps[s].w; }
        float4 o;
        o.x = g.x * gelu_f(sum.x * USC[e.x]) * VSC[e.x]; o.y = g.y * gelu_f(sum.y * USC[e.y]) * VSC[e.y];
        o.z = g.z * gelu_f(sum.z * USC[e.z]) * VSC[e.z]; o.w = g.w * gelu_f(sum.w * USC[e.w]) * VSC[e.w];
        *reinterpret_cast<float4*>((float*)(p.ws + OFF_WPAIR) + idx) = o;
    }
}

#define CE_DESC(a, b) do { const float _mx = fmaxf((a), (b)); const float _mn = fminf((a), (b)); (a) = _mx; (b) = _mn; } while (0)
__device__ __forceinline__ void sort16_desc(float (&v)[16]) {
#pragma unroll
    for (int k = 2; k <= 16; k <<= 1)
#pragma unroll
        for (int j = k >> 1; j > 0; j >>= 1)
#pragma unroll
            for (int i = 0; i < 16; ++i) {
                const int m = i ^ j;
                if (m > i) { if ((i & k) == 0) CE_DESC(v[i], v[m]); else CE_DESC(v[m], v[i]); }
            }
}
__device__ __forceinline__ void merge_top16(float (&a)[16], const float (&b)[16]) {
#pragma unroll
    for (int i = 0; i < 16; ++i) a[i] = fmaxf(a[i], b[15 - i]);
#pragma unroll
    for (int j = 8; j > 0; j >>= 1)
#pragma unroll
        for (int i = 0; i < 16; ++i) { const int m = i ^ j; if (m > i) CE_DESC(a[i], a[m]); }
}
__device__ __forceinline__ float key_embed(float v, unsigned lowmask, unsigned idxbits) { return __uint_as_float((__float_as_uint(v) & ~lowmask) | idxbits); }

constexpr int SK_ROWB = 144;
__device__ __forceinline__ void peer_stage1(const LAS unsigned char* SK  , const bf16_t* __restrict__ Qrow  ,
                                            const int r, const int hh, float (&out)[16]) {
    bf16x8 qb[4];
#pragma unroll
    for (int ks = 0; ks < 4; ++ks) qb[ks] = *reinterpret_cast<const bf16x8*>(Qrow + ks * 16 + hh * 8);
    float grp[4][16];
#pragma unroll
    for (int mt = 0; mt < 4; ++mt) {
        f32x16 acc;
#pragma unroll
        for (int i = 0; i < 16; ++i) acc[i] = 0.f;
#pragma unroll
        for (int ks = 0; ks < 4; ++ks) {
            const bf16x8 a = *(const LAS bf16x8*)(SK + (mt * 32 + r) * SK_ROWB + (ks * 16 + hh * 8) * 2);
            acc = MFMA32(a, qb[ks], acc);
        }
        const unsigned hx = (unsigned)hh << 2;
#pragma unroll
        for (int i = 0; i < 16; ++i) {
            const unsigned cn = 32u * mt + (i & 3) + 8u * (i >> 2);
            grp[mt][i] = key_embed(acc[i], 127u, (127u - cn) ^ hx);
        }
        sort16_desc(grp[mt]);
    }
    merge_top16(grp[0], grp[1]); merge_top16(grp[2], grp[3]); merge_top16(grp[0], grp[2]);
    float pb[16];
#pragma unroll
    for (int i = 0; i < 16; ++i) pb[i] = shfl_x(grp[0][i], (hh << 5) | r, 32);
    merge_top16(grp[0], pb);
#pragma unroll
    for (int i = 0; i < 16; ++i) out[i] = grp[0][i];
}

__device__ void ph_peer_select(const Params& p, int l, unsigned char* ldsraw, const int wv) {
    const int tid = opaque_tid(wv);
    const int wave = tid >> 6, lane = tid & 63, r = lane & 31, hh = lane >> 5;
    const int gw = blockIdx.x * 8 + wave, nw = gridDim.x * 8;
    LAS unsigned char* skl = (LAS unsigned char*)ldsraw;
    LAS unsigned char* myl = skl + 2 * 128 * SK_ROWB + wave * 2048 + lane * 32;
    {
        const bf16_t* SKg = (const bf16_t*)(p.ws + OFF_SUBK) + (size_t)l * 2 * 128 * 64;
        for (int i = tid; i < 2 * 128 * 8; i += NT) {
            const int row = i >> 3, ch = i & 7;
            *(LAS u32x4*)(skl + row * SK_ROWB + ch * 16) = *reinterpret_cast<const u32x4*>(SKg + (size_t)row * 64 + ch * 8);
        }
        __syncthreads();
    }
    for (int task = gw; task < (NTOK / 32) * 4; task += nw) {
        const int tg = task >> 2, k = task & 3;
        const int t = tg * 32 + r;
        const bf16_t* Qt = (const bf16_t*)(p.ws + OFF_Q) + (size_t)t * D;
        float sv[2][16];
#pragma unroll
        for (int x = 0; x < 2; ++x) {
            float la[16], lb[16];
            peer_stage1(skl + x * 128 * SK_ROWB, Qt + k * 128 + x * 64, r, hh, la);
            peer_stage1(skl + x * 128 * SK_ROWB, Qt + (k + 4) * 128 + x * 64, r, hh, lb);
#pragma unroll
            for (int i = 0; i < 16; ++i) sv[x][i] = hh ? lb[i] : la[i];
        }
        {
            unsigned w[8];
#pragma unroll
            for (int q = 0; q < 8; ++q) {
                w[q] = 0u;
#pragma unroll
                for (int b = 0; b < 4; ++b) {
                    const int i = q * 4 + b;
                    const unsigned key = __float_as_uint(i < 16 ? sv[0][i] : sv[1][i - 16]);
                    w[q] |= (127u - (key & 127u)) << (8 * b);
                }
            }
            *(LAS u32x4*)(myl) = u32x4{w[0], w[1], w[2], w[3]};
            *(LAS u32x4*)(myl + 16) = u32x4{w[4], w[5], w[6], w[7]};
        }
        float val0[16], val1[16];
#pragma unroll
        for (int i = 0; i < 16; ++i) { val0[i] = __uint_as_float(__float_as_uint(sv[0][i]) & ~127u); val1[i] = __uint_as_float(__float_as_uint(sv[1][i]) & ~127u); }
        float g0[16], g1[16], g2[16], g3[16];
#pragma unroll
        for (int b = 0; b < 16; ++b) g0[b] = key_embed(val0[0] + val1[b], 255u, 255u - (unsigned)b);
#pragma unroll
        for (int b = 0; b < 8; ++b) g1[b] = key_embed(val0[1] + val1[b], 255u, 255u - (16u + b));
#pragma unroll
        for (int b = 0; b < 5; ++b) g1[8 + b] = key_embed(val0[2] + val1[b], 255u, 255u - (32u + b));
#pragma unroll
        for (int b = 0; b < 3; ++b) g1[13 + b] = key_embed(val0[4] + val1[b], 255u, 255u - (64u + b));
#pragma unroll
        for (int b = 0; b < 4; ++b) g2[b] = key_embed(val0[3] + val1[b], 255u, 255u - (48u + b));
#pragma unroll
        for (int a = 5; a < 8; ++a)
#pragma unroll
            for (int b = 0; b < 2; ++b) g2[4 + (a - 5) * 2 + b] = key_embed(val0[a] + val1[b], 255u, 255u - (16u * a + b));
#pragma unroll
        for (int a = 8; a < 14; ++a) g2[10 + (a - 8)] = key_embed(val0[a] + val1[0], 255u, 255u - 16u * a);
        g3[0] = key_embed(val0[14] + val1[0], 255u, 255u - 16u * 14); g3[1] = key_embed(val0[15] + val1[0], 255u, 255u - 16u * 15);
#pragma unroll
        for (int i = 2; i < 16; ++i) g3[i] = -3.0e38f;
        sort16_desc(g1); sort16_desc(g2); sort16_desc(g3);
        merge_top16(g0, g1); merge_top16(g2, g3); merge_top16(g0, g2);
        float gate[16]; int eid[16];
        const float mx = __uint_as_float(__float_as_uint(g0[0]) & ~255u);
        float sum = 0.f;
#pragma unroll
        for (int i = 0; i < 16; ++i) {
            const unsigned key = __float_as_uint(g0[i]);
            gate[i] = __expf(__uint_as_float(key & ~255u) - mx); sum += gate[i];
            const unsigned id = 255u - (key & 255u);
            const unsigned n0 = *(const LAS unsigned char*)(myl + (id >> 4));
            const unsigned n1 = *(const LAS unsigned char*)(myl + 16 + (id & 15u));
            eid[i] = (int)(n0 * 128u + n1);
        }
        const float inv = 1.f / sum;
        const int h = k + 4 * hh;
        int* EI = (int*)(p.ws + OFF_EIDX) + (size_t)t * 128 + h * 16; float* EG = (float*)(p.ws + OFF_EGATE) + (size_t)t * 128 + h * 16;
#pragma unroll
        for (int q = 0; q < 4; ++q) {
            *reinterpret_cast<int4*>(EI + q * 4) = make_int4(eid[q * 4], eid[q * 4 + 1], eid[q * 4 + 2], eid[q * 4 + 3]);
            *reinterpret_cast<float4*>(EG + q * 4) = make_float4(gate[q * 4] * inv, gate[q * 4 + 1] * inv, gate[q * 4 + 2] * inv, gate[q * 4 + 3] * inv);
        }
    }
}

constexpr int LDS_BYTES = LDS_HDR + 3 * 48 * 1024;
__global__ void __launch_bounds__(NT, 2) mk_fwd(Params p) {
    extern __shared__ __attribute__((aligned(16))) unsigned char lds[];
    const int wv = __builtin_amdgcn_readfirstlane((int)(threadIdx.x >> 6));
    volatile LAS unsigned* st = (volatile LAS unsigned*)lds;
    if (threadIdx.x < 4) st[threadIdx.x] = 0u;
    __syncthreads();
    XcdBarrier xb = xcd_barrier_post((unsigned*)(p.ws + OFF_BAR), st);
    int bar_idx = 0;
#define GRID_BAR() do { xcd_barrier(xb); \
        if (PROBE_TS >= 0 && blockIdx.x == 0 && threadIdx.x == 0 && (bar_idx == PROBE_TS - 1 || bar_idx == PROBE_TS)) \
            ((volatile LAS unsigned long long*)(lds + 128))[bar_idx - (PROBE_TS - 1)] = __builtin_amdgcn_s_memrealtime(); \
        ++bar_idx; } while (0)
    if (PROBE_TS == 0 && blockIdx.x == 0 && threadIdx.x == 0) ((volatile LAS unsigned long long*)(lds + 128))[0] = __builtin_amdgcn_s_memrealtime();
    unsigned char* ws = p.ws;
    for (int rep = 0; rep < (PROBE_DUP == 1 ? 2 : 1); ++rep) {
    for (int l = 0; l < 2; ++l) {
        ph_transpose(p.in[I_WIN] + (size_t)l * D * INW, (bf16_t*)(ws + OFF_WIN) + (size_t)l * INW * D, D, INW, lds + LDS_HDR, wv);
        ph_transpose(p.in[I_WOUT] + (size_t)l * D * D, (bf16_t*)(ws + OFF_WOUT) + (size_t)l * D * D, D, D, lds + LDS_HDR, wv);
        ph_transpose(p.in[I_WQ] + (size_t)l * D * D, (bf16_t*)(ws + OFF_WQ) + (size_t)l * D * D, D, D, lds + LDS_HDR, wv);
    }
    ph_convert_fp8_rows(p.in[I_PU], ws + OFF_UT, (float*)(ws + OFF_USC), 2 * NEXP, wv);
    ph_convert_fp8_rows(p.in[I_PV], ws + OFF_VT, (float*)(ws + OFF_VSC), 2 * NEXP, wv);
    ph_convert(p.in[I_SUBK], (bf16_t*)(ws + OFF_SUBK), 2 * 2 * 128 * 64, wv);
    ph_convert(p.in[I_SGUW], (bf16_t*)(ws + OFF_SGUW), 2 * 4 * 128 * 128, wv);
    ph_mod(p, lds + LDS_HDR, wv);
    ph_rope_tab(p, wv);
    GRID_BAR();
    }
    for (int l = 0; l < 2; ++l) {
        for (int rep = 0; rep < (PROBE_DUP == 3 ? 2 : 1); ++rep) {
        ph_norm_mod(p, l, 0, l == 0 ? 1 : 0, wv);
        ph_cache_prep(p, l, wv);
        GRID_BAR();
        }
        for (int rep = 0; rep < (PROBE_DUP == 5 ? 2 : 1); ++rep) {
        gemm_phase<EPI_INPROJ>(p, l, (const bf16_t*)(ws + OFF_H), (const bf16_t*)(ws + OFF_WIN) + (size_t)l * INW * D, INW, lds + LDS_HDR, wv);
        GRID_BAR();
        }
        for (int rep = 0; rep < ((PROBE_DUP == 4 || (PROBE_DUP >= 10 && PROBE_DUP <= 12)) ? 2 : 1); ++rep) {
        ph_mixers(p, l + 2 * rep, lds + LDS_HDR, wv);
        GRID_BAR();
        }
        gemm_phase<EPI_WOUT>(p, l, (const bf16_t*)(ws + OFF_MIX), (const bf16_t*)(ws + OFF_WOUT) + (size_t)l * D * D, D, lds + LDS_HDR, wv);
        GRID_BAR();
        ph_norm_mod(p, l, 1, 0, wv);
        GRID_BAR();
        for (int rep = 0; rep < (PROBE_DUP == 7 ? 2 : 1); ++rep) {
        gemm_phase<EPI_WQ>(p, l, (const bf16_t*)(ws + OFF_H), (const bf16_t*)(ws + OFF_WQ) + (size_t)l * D * D, D, lds + LDS_HDR, wv);
        GRID_BAR();
        }
        if (PROBE_DUP == 8) { for (int rep = 0; rep < 10; ++rep) GRID_BAR(); }
        for (int rep = 0; rep < (PROBE_DUP == 2 ? 2 : 1); ++rep) {
        ph_peer_select(p, l, lds + LDS_HDR, wv);
        GRID_BAR();
        }
        ph_peer_sliced<false>(p, l, lds + LDS_HDR, wv);
        GRID_BAR();
        ph_peer_pairw(p, l, wv);
        GRID_BAR();
        ph_peer_sliced<true>(p, l, lds + LDS_HDR, wv);
        GRID_BAR();
    }
    ph_final_norm(p, wv);
    if (PROBE_TS >= 0 && blockIdx.x == 0 && threadIdx.x == 0) {
        asm volatile("s_waitcnt vmcnt(0)" ::: "memory");
        volatile LAS unsigned long long* tsl = (volatile LAS unsigned long long*)(lds + 128);
        p.out[0] += (float)(tsl[1] - tsl[0]) * 0.01f;
    }
}

extern "C" void kernel_launch(void* const* d_in, const int* in_sizes, int n_in,
                              void* d_out, int out_size, void* d_ws, size_t ws_size,
                              hipStream_t stream) {
    static int grid = 0;
    if (grid == 0) {
        if (ws_size < WS_NEED) { fprintf(stderr, "kernel_launch: workspace too small: %zu < %zu\n", ws_size, (size_t)WS_NEED); grid = -1; return; }
        int dev = 0, cus = 0, per_cu = 0;
        (void)hipGetDevice(&dev);
        (void)hipDeviceGetAttribute(&cus, hipDeviceAttributeMultiprocessorCount, dev);
        (void)hipFuncSetAttribute((const void*)mk_fwd, hipFuncAttributeMaxDynamicSharedMemorySize, LDS_BYTES);
        (void)hipOccupancyMaxActiveBlocksPerMultiprocessor(&per_cu, (const void*)mk_fwd, NT, LDS_BYTES);
        if (per_cu < 1) { fprintf(stderr, "kernel_launch: occupancy query reports %d blocks per CU\n", per_cu); grid = -1; return; }
        grid = cus;
    }
    if (grid < 0) return;
    (void)hipMemsetAsync((unsigned char*)d_ws + OFF_BAR, 0, 64 * 1024, stream);
    Params p{};
    for (int i = 0; i < 29; ++i) p.in[i] = (const float*)d_in[i];
    p.out = (float*)d_out; p.ws = (unsigned char*)d_ws;
    void* args[] = {&p};
    hipError_t e = hipLaunchCooperativeKernel((const void*)mk_fwd, dim3(grid), dim3(NT), args, LDS_BYTES, stream);
    if (e != hipSuccess) fprintf(stderr, "kernel_launch: cooperative launch failed: %s (grid %d)\n", hipGetErrorString(e), grid);
}
```

```cpp
#include <hip/hip_runtime.h>
#include <hip/hip_bf16.h>
#include <cstdio>
#include <cstdint>
#include <hip/hip_cooperative_groups.h>
namespace cg = cooperative_groups;

#define PROBE_DUP 0
#define PROBE_TS -1
typedef unsigned short bf16_t;
using bf16x8 = __attribute__((ext_vector_type(8))) short;
using f32x4  = __attribute__((ext_vector_type(4))) float;
using f32x16 = __attribute__((ext_vector_type(16))) float;
using f32x2  = __attribute__((ext_vector_type(2))) float;
using u32x4  = __attribute__((ext_vector_type(4))) unsigned;
using s16x4  = __attribute__((ext_vector_type(4))) short;

constexpr int D      = 1024;
constexpr int NTOK   = 16384;
constexpr int NPT    = 8192;
constexpr int SEQ    = 256;
constexpr int DSEQ   = 2048;
constexpr int PAST   = 512;
constexpr int NKS    = DSEQ + PAST;
constexpr int INW    = 2048;
constexpr int NEXP   = 16384;
constexpr float EPS  = 1e-6f;

constexpr size_t MB = 1024 * 1024;
constexpr size_t OFF_BAR   = 0;
constexpr size_t OFF_MOD   = 64 * 1024;
constexpr size_t OFF_ROPE  = OFF_MOD + 256 * 1024;
constexpr size_t OFF_SUBK  = OFF_ROPE + 1 * MB;
constexpr size_t OFF_SGUW  = OFF_SUBK + 64 * 1024;
constexpr size_t OFF_WIN   = OFF_SGUW + 256 * 1024;
constexpr size_t OFF_WOUT  = OFF_WIN + 8 * MB;
constexpr size_t OFF_WQ    = OFF_WOUT + 4 * MB;
constexpr size_t OFF_UT    = OFF_WQ + 4 * MB;
constexpr size_t OFF_USC   = OFF_UT + 32 * MB;
constexpr size_t OFF_VT    = OFF_UT + 64 * MB;
constexpr size_t OFF_VSC   = OFF_VT + 32 * MB;
constexpr size_t OFF_H     = OFF_VT + 64 * MB;
constexpr size_t OFF_XC    = OFF_H + 32 * MB;
constexpr size_t OFF_R1    = OFF_XC + 64 * MB;
constexpr size_t OFF_AU    = OFF_R1;
constexpr size_t OFF_AV    = OFF_AU + 8 * MB;
constexpr size_t OFF_AVN   = OFF_AV + 8 * MB;
constexpr size_t OFF_DQ    = OFF_AVN + 8 * MB;
constexpr size_t OFF_DKP   = OFF_DQ + 8 * MB;
constexpr size_t OFF_DKS   = OFF_DKP + 4 * MB;
constexpr size_t OFF_DVTP  = OFF_DKS + 5 * MB;
constexpr size_t OFF_DVTS  = OFF_DVTP + 4 * MB;
constexpr size_t OFF_GQ    = OFF_DVTS + 5 * MB;
constexpr size_t OFF_GKP   = OFF_GQ + 16 * MB;
constexpr size_t OFF_GKS   = OFF_GKP + 2 * MB;
constexpr size_t OFF_GVTP  = OFF_GKS + 3 * MB;
constexpr size_t OFF_GVTS  = OFF_GVTP + 2 * MB;
constexpr size_t OFF_MIX   = OFF_GVTS + 3 * MB;
constexpr size_t OFF_R1END = OFF_MIX + 32 * MB;
constexpr size_t OFF_Q     = OFF_R1;
constexpr size_t OFF_EIDX  = OFF_Q + 32 * MB;
constexpr size_t OFF_EGATE = OFF_EIDX + 8 * MB;
constexpr size_t OFF_TOPV  = OFF_EGATE + 8 * MB;
constexpr size_t OFF_TOPI  = OFF_TOPV + 16 * MB;
static_assert(OFF_TOPI + 16 * MB <= OFF_R1END, "peer buffers must fit region 1");
constexpr size_t OFF_PROJ  = OFF_R1END;
constexpr size_t OFF_PART  = OFF_PROJ;
constexpr size_t OFF_WPAIR = OFF_PART + 64 * MB;
constexpr size_t OFF_H8I   = OFF_WPAIR + 8 * MB;
constexpr size_t OFF_HSC   = OFF_H8I + 16 * MB;
constexpr size_t OFF_WSC   = OFF_HSC + 64 * 1024;
constexpr size_t WS_NEED   = OFF_PROJ + 128 * MB;
static_assert(WS_NEED <= 512 * MB, "workspace budget");

constexpr size_t OUT_YP  = 0;
constexpr size_t OUT_YS  = 8388608;
constexpr size_t OUT_NDK = 16777216;
constexpr size_t OUT_NDV = OUT_NDK + 4194304;
constexpr size_t OUT_NGK = OUT_NDV + 4194304;
constexpr size_t OUT_NGV = OUT_NGK + 2097152;

struct Params {
    const float* in[29];
    float* out;
    unsigned char* ws;
};
enum { I_XP = 0, I_XS, I_CDK, I_CDV, I_CGK, I_CGV, I_C, I_CCTX, I_ADAW, I_ADAB, I_N1G, I_N2G, I_WIN, I_SGUNG, I_SGUW, I_SGUB,
       I_LQ1, I_LK1, I_LQ2, I_LK2, I_SUBLN, I_QNG, I_KNG, I_WOUT, I_WQ, I_SUBK, I_PU, I_PV, I_FG };

typedef __bf16 hwbf2 __attribute__((ext_vector_type(2)));
__device__ __forceinline__ unsigned pack_bf2(float a, float b) {
    const f32x2 v = {a, b};
    return __builtin_bit_cast(unsigned, __builtin_convertvector(v, hwbf2));
}
__device__ __forceinline__ bf16_t f2bf(float f) { return (bf16_t)(pack_bf2(f, 0.f) & 0xffffu); }
__device__ __forceinline__ float bf2f(bf16_t h) { return __uint_as_float(((unsigned)h) << 16); }
__device__ __forceinline__ float gelu_f(float x) {
    const float k2 = 2.f * 0.7978845608028654f * 1.4426950408889634f;
    const float e = __builtin_amdgcn_exp2f(k2 * (x + 0.044715f * x * x * x));
    return x - x * __builtin_amdgcn_rcpf(e + 1.f);
}
__device__ __forceinline__ int lane_id() { return (int)__builtin_amdgcn_mbcnt_hi(~0u, __builtin_amdgcn_mbcnt_lo(~0u, 0u)); }
__device__ __forceinline__ int lane_id_op() { int l = lane_id(); asm volatile("" : "+v"(l)); return l; }
__device__ __forceinline__ float shfl_i(float v, int src) { return __builtin_bit_cast(float, __builtin_amdgcn_ds_bpermute(src << 2, __builtin_bit_cast(int, v))); }
__device__ __forceinline__ int shfl_i(int v, int src) { return __builtin_amdgcn_ds_bpermute(src << 2, v); }
__device__ __forceinline__ float shfl_x(float v, int lane, int m) { return shfl_i(v, lane ^ m); }
__device__ __forceinline__ int shfl_x(int v, int lane, int m) { return shfl_i(v, lane ^ m); }
__device__ __forceinline__ int q8(float x) { return (int)fminf(fmaxf(rintf(x), -127.f), 127.f); }
__device__ __forceinline__ unsigned pack4_i8(int a, int b, int c, int d) { return (unsigned)(a & 255) | ((unsigned)(b & 255) << 8) | ((unsigned)(c & 255) << 16) | ((unsigned)d << 24); }
__device__ __forceinline__ float wave_sum(float v) {
    const int ln = lane_id_op();
#pragma unroll
    for (int o = 32; o >= 1; o >>= 1) v += shfl_x(v, ln, o);
    return v;
}
__device__ __forceinline__ int tok_cv(int t) { return t < NPT ? 0 : 1 + ((t - NPT) >> 11); }
__device__ __forceinline__ const float* x_in_row(const Params& p, int t) {
    return t < NPT ? p.in[I_XP] + (size_t)t * D : p.in[I_XS] + (size_t)(t - NPT) * D;
}
__device__ __forceinline__ float lam_init_of(int l) { return l == 0 ? 0.2f : (0.8f - 0.6f * 0.7408182206817179f); }
__device__ __forceinline__ float lam_of(const Params& p, int l) {
    float s1 = 0.f, s2 = 0.f;
    for (int i = 0; i < 32; ++i) {
        s1 += p.in[I_LQ1][l * 32 + i] * p.in[I_LK1][l * 32 + i];
        s2 += p.in[I_LQ2][l * 32 + i] * p.in[I_LK2][l * 32 + i];
    }
    return expf(s1) - expf(s2) + lam_init_of(l);
}


#define XB_TMO      128
#define XB_XCNT(j)  (256  + 64 * (j))
#define XB_XSUB(j)  (1280 + 64 * (j))
#define XB_XGEN(j)  (2304 + 64 * (j))
#define XB_TOP      3328
#define XB_TOPGEN   3392
#define XCD_BAR_WORDS 3456
#define XB_SPIN_CAP (1u << 20)
#define LAS __attribute__((address_space(3)))
__device__ __forceinline__ unsigned xb_ld(unsigned* p)              { return __hip_atomic_load(p, __ATOMIC_RELAXED, __HIP_MEMORY_SCOPE_AGENT); }
__device__ __forceinline__ unsigned xb_add(unsigned* p, unsigned v) { return __hip_atomic_fetch_add(p, v, __ATOMIC_RELAXED, __HIP_MEMORY_SCOPE_AGENT); }
__device__ __forceinline__ unsigned xb_xcc_id() { return (unsigned)__builtin_amdgcn_s_getreg((3 << 11) | 20) & 0xFu; }
#define XB_SPIN(cond, bar) do { unsigned _sp = 0; while (cond) { __builtin_amdgcn_s_sleep(1); \
    if ((++_sp & 255u) == 0u) { if (xb_ld(&(bar)[XB_TMO])) break; if (_sp > XB_SPIN_CAP) { atomicAdd(&(bar)[XB_TMO], 1u); break; } } } } while (0)
struct XcdBarrier { unsigned* bar; unsigned x; volatile LAS unsigned* st; };
__device__ __forceinline__ XcdBarrier xcd_barrier_post(unsigned* bar, volatile LAS unsigned* st) {
    XcdBarrier b; b.bar = bar; b.x = xb_xcc_id(); b.st = st;
    if (threadIdx.x == 0) (void)xb_add(&bar[XB_XCNT(b.x)], 1u);
    return b;
}
__device__ __forceinline__ void xcd_barrier_complete(unsigned* bar, unsigned x, unsigned& nloc, unsigned& nx) {
    const unsigned G = gridDim.x * gridDim.y * gridDim.z;
    unsigned sum, cnt, mine, sp = 0u;
    for (;;) {
        sum = 0u; cnt = 0u; mine = 0u;
#pragma unroll
        for (unsigned j = 0; j < 16; ++j) { const unsigned c = xb_ld(&bar[XB_XCNT(j)]); sum += c; cnt += (c > 0u) ? 1u : 0u; mine = (j == x) ? c : mine; }
        if (sum == G) break;
        __builtin_amdgcn_s_sleep(1);
        if ((++sp & 255u) == 0u) { if (xb_ld(&bar[XB_TMO])) break; if (sp > XB_SPIN_CAP) { atomicAdd(&bar[XB_TMO], 1u); break; } }
    }
    nloc = mine > 0u ? mine : 1u; nx = cnt > 0u ? cnt : 1u;
}
__device__ __forceinline__ void xcd_barrier(const XcdBarrier& b) {
    asm volatile("s_waitcnt vmcnt(0)" ::: "memory");
    __syncthreads();
    if (threadIdx.x == 0) {
        unsigned* bar = b.bar;
        const unsigned bx = xb_xcc_id();
        __builtin_amdgcn_s_waitcnt(0);
        unsigned nloc = b.st[0], nx = b.st[1];
        if (nloc == 0u) { xcd_barrier_complete(bar, bx, nloc, nx); b.st[0] = nloc; b.st[1] = nx; }
        const unsigned old = xb_add(&bar[XB_XSUB(bx)], 1u);
        const unsigned gen = old / nloc;
        if (old + 1u == (gen + 1u) * nloc) {
            __builtin_amdgcn_fence(__ATOMIC_RELEASE, "agent");
            asm volatile("s_waitcnt vmcnt(0)" ::: "memory");
            const unsigned og = xb_add(&bar[XB_TOP], 1u);
            const unsigned tg = og / nx;
            if (og + 1u == (tg + 1u) * nx) xb_add(&bar[XB_TOPGEN], 1u);
            else XB_SPIN(xb_ld(&bar[XB_TOPGEN]) == tg, bar);
            __builtin_amdgcn_fence(__ATOMIC_ACQUIRE, "agent");
            xb_add(&bar[XB_XGEN(bx)], 1u);
            asm volatile("s_waitcnt vmcnt(0)" ::: "memory");
        } else {
            XB_SPIN(xb_ld(&bar[XB_XGEN(bx)]) == gen, bar);
            __builtin_amdgcn_fence(__ATOMIC_ACQUIRE, "agent");
            asm volatile("s_waitcnt vmcnt(0)" ::: "memory");
        }
    }
    __syncthreads();
}

constexpr int NT = 512;
constexpr int LDS_HDR = 1024;
#define GTID ((size_t)blockIdx.x * NT + tid)
__device__ __forceinline__ int opaque_tid(int wv) { int t = (wv << 6) | lane_id(); asm volatile("" : "+v"(t)); return t; }
#define GNT  ((size_t)gridDim.x * NT)

__device__ void ph_transpose(const float* __restrict__ W, bf16_t* __restrict__ Wt, int K, int N, unsigned char* ldsraw, const int wv) {
    const int tid = opaque_tid(wv);
    LAS bf16_t* T = (LAS bf16_t*)ldsraw;
    const int tk = K / 128, tn = N / 64, ntiles = tk * tn;
    for (int tile = blockIdx.x; tile < ntiles; tile += gridDim.x) {
        const int k0 = (tile % tk) * 128, n0 = (tile / tk) * 64;
#pragma unroll 4
        for (int i = 0; i < 16; ++i) {
            const int kl = i * 8 + (tid >> 6), nl = tid & 63;
            T[nl * 130 + kl] = f2bf(W[(size_t)(k0 + kl) * N + n0 + nl]);
        }
        __syncthreads();
        {
            const int nl = tid >> 3, kc = tid & 7;
            unsigned w[8];
#pragma unroll
            for (int i = 0; i < 8; ++i) w[i] = (unsigned)T[nl * 130 + kc * 16 + 2 * i] | ((unsigned)T[nl * 130 + kc * 16 + 2 * i + 1] << 16);
            bf16_t* dst = Wt + (size_t)(n0 + nl) * K + k0 + kc * 16;
            *reinterpret_cast<u32x4*>(dst) = u32x4{w[0], w[1], w[2], w[3]};
            *reinterpret_cast<u32x4*>(dst + 8) = u32x4{w[4], w[5], w[6], w[7]};
        }
        __syncthreads();
    }
}
__device__ void ph_convert(const float* __restrict__ src, bf16_t* __restrict__ dst, size_t n, const int wv) {
    const int tid = opaque_tid(wv);
    for (size_t idx = GTID; idx < n; idx += GNT) dst[idx] = f2bf(src[idx]);
}
__device__ void ph_convert_i8_rows(const float* __restrict__ src, unsigned char* __restrict__ dst, float* __restrict__ scl, int nrows, const int wv) {
    const int tid = opaque_tid(wv);
    const int lane = tid & 63;
    const int gw = blockIdx.x * 8 + (tid >> 6), nw = gridDim.x * 8;
    for (int row0 = gw * 4; row0 < nrows; row0 += nw * 4) {
        float4 f[4][4];
#pragma unroll
        for (int q = 0; q < 4; ++q)
#pragma unroll
            for (int i = 0; i < 4; ++i) f[q][i] = *reinterpret_cast<const float4*>(src + (size_t)(row0 + q) * D + lane * 16 + i * 4);
#pragma unroll
        for (int q = 0; q < 4; ++q) {
            const int row = row0 + q;
            float v[16];
#pragma unroll
            for (int i = 0; i < 4; ++i) { v[i * 4] = f[q][i].x; v[i * 4 + 1] = f[q][i].y; v[i * 4 + 2] = f[q][i].z; v[i * 4 + 3] = f[q][i].w; }
            float am = 0.f;
#pragma unroll
            for (int i = 0; i < 16; ++i) am = fmaxf(am, fabsf(v[i]));
#pragma unroll
            for (int o = 32; o >= 1; o >>= 1) am = fmaxf(am, shfl_x(am, lane, o));
            const float sc = am > 0.f ? 127.f / am : 1.f;
            unsigned w[4];
#pragma unroll
            for (int i = 0; i < 4; ++i) w[i] = pack4_i8(q8(v[i * 4] * sc), q8(v[i * 4 + 1] * sc), q8(v[i * 4 + 2] * sc), q8(v[i * 4 + 3] * sc));
            {
                const int lyr = row >> 14, e = row & (NEXP - 1);
                *reinterpret_cast<u32x4*>(dst + (((size_t)lyr * 8 + (lane >> 3)) * NEXP + e) * 128 + (lane & 7) * 16) = u32x4{w[0], w[1], w[2], w[3]};
            }
            if (lane == 0) scl[row] = am > 0.f ? am * (1.f / 127.f) : 1.f;
        }
    }
}
__device__ void ph_mod(const Params& p, unsigned char* ldsraw, const int wv) {
    const int tid = opaque_tid(wv);
    LAS float* sl = (LAS float*)ldsraw;
    LAS float* red = sl + 5 * 1024;
    for (int i = tid; i < 5 * 1024; i += NT) {
        const int cv = i >> 10, k = i & 1023;
        const float c = cv == 0 ? p.in[I_CCTX][k] : p.in[I_C][(size_t)(cv - 1) * D + k];
        sl[i] = c / (1.f + __expf(-c));
    }
    __syncthreads();
    const int c = tid & 63, ks = tid >> 6;
    for (int item = blockIdx.x; item < 2 * 96; item += gridDim.x) {
        const int l = item / 96, j = (item % 96) * 64 + c;
        const float* W = p.in[I_ADAW] + (size_t)l * D * 6144 + (size_t)(ks * 128) * 6144 + j;
        float acc[5] = {0.f, 0.f, 0.f, 0.f, 0.f};
#pragma unroll 8
        for (int k = 0; k < 128; ++k) {
            const float w = W[(size_t)k * 6144];
#pragma unroll
            for (int cv = 0; cv < 5; ++cv) acc[cv] += sl[cv * 1024 + ks * 128 + k] * w;
        }
#pragma unroll
        for (int cv = 0; cv < 5; ++cv) red[(ks * 5 + cv) * 64 + c] = acc[cv];
        __syncthreads();
        if (tid < 320) {
            const int cv = tid >> 6;
            float sum = p.in[I_ADAB][l * 6144 + j];
#pragma unroll
            for (int q = 0; q < 8; ++q) sum += red[(q * 5 + cv) * 64 + c];
            ((float*)(p.ws + OFF_MOD))[(size_t)(l * 5 + cv) * 6144 + j] = sum;
        }
        __syncthreads();
    }
}
__device__ void ph_rope_tab(const Params& p, const int wv) {
    const int tid = opaque_tid(wv);
    for (size_t idx = GTID; idx < 2048 * 48; idx += GNT) {
        int s = idx / 48, i = idx % 48;
        float* R = (float*)(p.ws + OFF_ROPE);
        double row = (double)(s / 64), col = (double)(s % 64);
        if (i < 16) {
            int q = i & 7; double inv = pow(10000.0, -(double)q / 8.0);
            double ang = (i < 8 ? row : col) * inv;
            R[s * 16 + i] = (float)cos(ang); R[2048 * 16 + s * 16 + i] = (float)sin(ang);
        } else {
            int ii = i - 16; int q = ii & 15; double inv = pow(10000.0, -(double)q / 16.0);
            double ang = (ii < 16 ? row : col) * inv;
            R[2048 * 32 + s * 32 + ii] = (float)cos(ang); R[2048 * 64 + s * 32 + ii] = (float)sin(ang);
        }
    }
}
__device__ void ph_cache_prep(const Params& p, int l, const int wv) {
    const int tid = opaque_tid(wv);
    bf16_t* DKS = (bf16_t*)(p.ws + OFF_DKS); bf16_t* DVTS = (bf16_t*)(p.ws + OFF_DVTS);
    bf16_t* GKS = (bf16_t*)(p.ws + OFF_GKS); bf16_t* GVTS = (bf16_t*)(p.ws + OFF_GVTS);
    for (size_t idx = GTID; idx < 4 * 512 * 256; idx += GNT) {
        int c = idx & 255, pp = (idx >> 8) & 511, b = idx >> 17;
        size_t src = (((size_t)b * 2 + l) * PAST + pp) * 256 + c;
        int h = c >> 6, r = c & 63;
        DKS[(((size_t)b * 4 + h) * NKS + DSEQ + pp) * 64 + r] = f2bf(p.in[I_CDK][src]);
        DVTS[(((size_t)b * 4 + h) * 64 + r) * NKS + DSEQ + pp] = f2bf(p.in[I_CDV][src]);
        if (c < 128) {
            size_t src2 = (((size_t)b * 2 + l) * PAST + pp) * 128 + c;
            int kv = c >> 6;
            GKS[(((size_t)b * 2 + kv) * NKS + DSEQ + pp) * 64 + r] = f2bf(p.in[I_CGK][src2]);
            GVTS[(((size_t)b * 2 + kv) * 64 + r) * NKS + DSEQ + pp] = f2bf(p.in[I_CGV][src2]);
        }
    }
}
__device__ void ph_norm_mod(const Params& p, int l, int which, int from_input, const int wv) {
    const int tid = opaque_tid(wv);
    const int lane = tid & 63;
    const int gw = blockIdx.x * 8 + (tid >> 6), nw = gridDim.x * 8;
    const float* g = p.in[which ? I_N2G : I_N1G] + l * D;
    if (from_input) {
        float4 nx[4];
        {
            const int t = gw < NTOK ? gw : NTOK - 1;
            const float* xr = x_in_row(p, t);
#pragma unroll
            for (int i = 0; i < 4; ++i) nx[i] = *reinterpret_cast<const float4*>(xr + i * 256 + lane * 4);
        }
        for (int t = gw; t < NTOK; t += nw) {
            float4 v[4];
#pragma unroll
            for (int i = 0; i < 4; ++i) v[i] = nx[i];
            {
                const int tn = t + nw < NTOK ? t + nw : t;
                const float* xn = x_in_row(p, tn);
#pragma unroll
                for (int i = 0; i < 4; ++i) nx[i] = *reinterpret_cast<const float4*>(xn + i * 256 + lane * 4);
            }
            const float* mod = (const float*)(p.ws + OFF_MOD) + (size_t)(l * 5 + tok_cv(t)) * 6144 + which * 3072;
            float ss = 0.f;
#pragma unroll
            for (int i = 0; i < 4; ++i) ss += v[i].x * v[i].x + v[i].y * v[i].y + v[i].z * v[i].z + v[i].w * v[i].w;
            ss = wave_sum(ss);
            float r = rsqrtf(ss / D + EPS);
            bf16_t* H = (bf16_t*)(p.ws + OFF_H) + (size_t)t * D;
#pragma unroll
            for (int i = 0; i < 4; ++i) {
                int c = i * 256 + lane * 4;
                float4 gg = *reinterpret_cast<const float4*>(g + c), sh = *reinterpret_cast<const float4*>(mod + c), sc = *reinterpret_cast<const float4*>(mod + 1024 + c);
                uint2 o;
                o.x = pack_bf2(v[i].x * r * gg.x * (1.f + sc.x) + sh.x, v[i].y * r * gg.y * (1.f + sc.y) + sh.y);
                o.y = pack_bf2(v[i].z * r * gg.z * (1.f + sc.z) + sh.z, v[i].w * r * gg.w * (1.f + sc.w) + sh.w);
                *reinterpret_cast<uint2*>(H + c) = o;
            }
        }
    } else {
        u32x4 nx[2];
        {
            const int t = gw < NTOK ? gw : NTOK - 1;
            const bf16_t* xr = (const bf16_t*)(p.ws + OFF_XC) + (size_t)t * D + lane * 8;
            nx[0] = *reinterpret_cast<const u32x4*>(xr); nx[1] = *reinterpret_cast<const u32x4*>(xr + 512);
        }
        for (int t = gw; t < NTOK; t += nw) {
            float v[16];
#pragma unroll
            for (int h = 0; h < 2; ++h)
#pragma unroll
                for (int k = 0; k < 4; ++k) { v[h * 8 + 2 * k] = __uint_as_float(nx[h][k] << 16); v[h * 8 + 2 * k + 1] = __uint_as_float(nx[h][k] & 0xffff0000u); }
            {
                const int tn = t + nw < NTOK ? t + nw : t;
                const bf16_t* xn = (const bf16_t*)(p.ws + OFF_XC) + (size_t)tn * D + lane * 8;
                nx[0] = *reinterpret_cast<const u32x4*>(xn); nx[1] = *reinterpret_cast<const u32x4*>(xn + 512);
            }
            const float* mod = (const float*)(p.ws + OFF_MOD) + (size_t)(l * 5 + tok_cv(t)) * 6144 + which * 3072;
            float ss = 0.f;
#pragma unroll
            for (int i = 0; i < 16; ++i) ss += v[i] * v[i];
            ss = wave_sum(ss);
            float r = rsqrtf(ss / D + EPS);
            bf16_t* H = (bf16_t*)(p.ws + OFF_H) + (size_t)t * D;
            float hq[16];
#pragma unroll
            for (int h = 0; h < 2; ++h) {
                const int c = h * 512 + lane * 8;
                float o[8];
#pragma unroll
                for (int q = 0; q < 2; ++q) {
                    const float4 gg = *reinterpret_cast<const float4*>(g + c + q * 4), sh = *reinterpret_cast<const float4*>(mod + c + q * 4), sc = *reinterpret_cast<const float4*>(mod + 1024 + c + q * 4);
                    o[q * 4] = v[h * 8 + q * 4] * r * gg.x * (1.f + sc.x) + sh.x; o[q * 4 + 1] = v[h * 8 + q * 4 + 1] * r * gg.y * (1.f + sc.y) + sh.y;
                    o[q * 4 + 2] = v[h * 8 + q * 4 + 2] * r * gg.z * (1.f + sc.z) + sh.z; o[q * 4 + 3] = v[h * 8 + q * 4 + 3] * r * gg.w * (1.f + sc.w) + sh.w;
                }
                *reinterpret_cast<u32x4*>(H + c) = u32x4{pack_bf2(o[0], o[1]), pack_bf2(o[2], o[3]), pack_bf2(o[4], o[5]), pack_bf2(o[6], o[7])};
#pragma unroll
                for (int q = 0; q < 8; ++q) hq[h * 8 + q] = o[q];
            }
            if (which) {
                float am = 0.f;
#pragma unroll
                for (int i = 0; i < 16; ++i) am = fmaxf(am, fabsf(hq[i]));
#pragma unroll
                for (int o2 = 32; o2 >= 1; o2 >>= 1) am = fmaxf(am, shfl_x(am, lane, o2));
                const float sc8 = am > 0.f ? 127.f / am : 1.f;
#pragma unroll
                for (int h = 0; h < 2; ++h) {
                    uint2 w;
                    w.x = pack4_i8(q8(hq[h * 8] * sc8), q8(hq[h * 8 + 1] * sc8), q8(hq[h * 8 + 2] * sc8), q8(hq[h * 8 + 3] * sc8));
                    w.y = pack4_i8(q8(hq[h * 8 + 4] * sc8), q8(hq[h * 8 + 5] * sc8), q8(hq[h * 8 + 6] * sc8), q8(hq[h * 8 + 7] * sc8));
                    *reinterpret_cast<uint2*>(p.ws + OFF_H8I + (size_t)t * D + h * 512 + lane * 8) = w;
                }
                if (lane == 0) ((float*)(p.ws + OFF_HSC))[t] = am > 0.f ? am * (1.f / 127.f) : 1.f;
            }
        }
    }
}
__device__ void ph_sgu_norm(const Params& p, int l, const int wv) {
    const int tid = opaque_tid(wv);
    const int lane = tid & 63;
    const int gw = blockIdx.x * 8 + (tid >> 6), nw = gridDim.x * 8;
    for (int t = gw; t < NTOK; t += nw) {
        const bf16_t* AV = (const bf16_t*)(p.ws + OFF_AV) + (size_t)t * 256;
        float v[4]; float ss = 0.f;
#pragma unroll
        for (int i = 0; i < 4; ++i) { v[i] = bf2f(AV[i * 64 + lane]); ss += v[i] * v[i]; }
        ss = wave_sum(ss);
        float r = rsqrtf(ss / 256.f + EPS);
#pragma unroll
        for (int i = 0; i < 4; ++i) ((bf16_t*)(p.ws + OFF_AVN))[(size_t)t * 256 + i * 64 + lane] = f2bf(v[i] * r * p.in[I_SGUNG][l * 256 + i * 64 + lane]);
    }
}
__device__ void ph_sgu_mix(const Params& p, int l, const int wv) {
    const int tid = opaque_tid(wv);
    const bf16_t* AVN = (const bf16_t*)(p.ws + OFF_AVN);
    for (size_t idx = GTID; idx < (size_t)NTOK * 256; idx += GNT) {
        int t = (int)(idx >> 8), c = (int)(idx & 255);
        int t0 = t & ~127, pp = t & 127, g = c >> 6;
        const bf16_t* W = (const bf16_t*)(p.ws + OFF_SGUW) + (((size_t)l * 4 + g) * 128 + pp) * 128;
        float acc = 0.f;
        for (int q = 0; q < 128; ++q) acc += bf2f(W[q]) * bf2f(AVN[(size_t)(t0 + q) * 256 + c]);
        acc += p.in[I_SGUB][(l * 4 + g) * 128 + pp];
        float au = bf2f(((const bf16_t*)(p.ws + OFF_AU))[(size_t)t * 256 + c]);
        ((bf16_t*)(p.ws + OFF_MIX))[(size_t)t * D + c] = f2bf(au * acc);
    }
}
__device__ void ph_attn_ref(const Params& p, int l, const int wv) {
    const int tid = opaque_tid(wv);
    const int lane = tid & 63;
    const int gw = blockIdx.x * 8 + (tid >> 6), nw = gridDim.x * 8;
    const float lam = lam_of(p, l);
    for (int item = gw; item < NTOK * 12; item += nw) {
        const int t = item % NTOK, hh = item / NTOK;
        const bool prompt = t < NPT;
        const int b = prompt ? t / SEQ : (t - NPT) / DSEQ;
        const int nk = prompt ? SEQ : NKS;
        if (hh < 4) {
            const int h = hh;
            const bf16_t* K = prompt ? (const bf16_t*)(p.ws + OFF_DKP) + ((size_t)b * 4 + h) * SEQ * 64 : (const bf16_t*)(p.ws + OFF_DKS) + ((size_t)b * 4 + h) * NKS * 64;
            const bf16_t* Vt = prompt ? (const bf16_t*)(p.ws + OFF_DVTP) + ((size_t)b * 4 + h) * 64 * SEQ : (const bf16_t*)(p.ws + OFF_DVTS) + ((size_t)b * 4 + h) * 64 * NKS;
            float q = bf2f(((const bf16_t*)(p.ws + OFF_DQ))[(size_t)t * 256 + h * 64 + lane]);
            const float scale = 0.17677669529663687f;
            float m0 = -1e30f, m1 = -1e30f, l0 = 0.f, l1 = 0.f, a0 = 0.f, a1 = 0.f;
            for (int k = 0; k < nk; ++k) {
                float pr = q * bf2f(K[(size_t)k * 64 + lane]);
#pragma unroll
                for (int o = 16; o >= 1; o >>= 1) pr += shfl_x(pr, lane, o);
                float s0 = shfl_i(pr, 0) * scale, s1 = shfl_i(pr, 32) * scale;
                float v = bf2f(Vt[(size_t)lane * nk + k]);
                float mn0 = fmaxf(m0, s0), mn1 = fmaxf(m1, s1);
                float c0 = expf(m0 - mn0), c1 = expf(m1 - mn1);
                float e0 = expf(s0 - mn0), e1 = expf(s1 - mn1);
                l0 = l0 * c0 + e0; l1 = l1 * c1 + e1;
                a0 = a0 * c0 + e0 * v; a1 = a1 * c1 + e1 * v;
                m0 = mn0; m1 = mn1;
            }
            float o = a0 / l0 - lam * a1 / l1;
            float ss = wave_sum(o * o);
            float r = rsqrtf(ss / 64.f + EPS);
            o = o * r * p.in[I_SUBLN][l * 64 + lane] * (1.f - lam_init_of(l));
            ((bf16_t*)(p.ws + OFF_MIX))[(size_t)t * D + 256 + h * 64 + lane] = f2bf(o);
        } else {
            const int hq = hh - 4, kv = hq >> 2;
            const bf16_t* K = prompt ? (const bf16_t*)(p.ws + OFF_GKP) + ((size_t)b * 2 + kv) * SEQ * 64 : (const bf16_t*)(p.ws + OFF_GKS) + ((size_t)b * 2 + kv) * NKS * 64;
            const bf16_t* Vt = prompt ? (const bf16_t*)(p.ws + OFF_GVTP) + ((size_t)b * 2 + kv) * 64 * SEQ : (const bf16_t*)(p.ws + OFF_GVTS) + ((size_t)b * 2 + kv) * 64 * NKS;
            float q = bf2f(((const bf16_t*)(p.ws + OFF_GQ))[(size_t)t * 512 + hq * 64 + lane]);
            float m = -1e30f, ls = 0.f, a = 0.f;
            for (int k = 0; k < nk; ++k) {
                float s = wave_sum(q * bf2f(K[(size_t)k * 64 + lane])) * 0.125f;
                float v = bf2f(Vt[(size_t)lane * nk + k]);
                float mn = fmaxf(m, s);
                float c = expf(m - mn), e = expf(s - mn);
                ls = ls * c + e; a = a * c + e * v; m = mn;
            }
            ((bf16_t*)(p.ws + OFF_MIX))[(size_t)t * D + 512 + hq * 64 + lane] = f2bf(a / ls);
        }
    }
}
__device__ void ph_peer_scores(const Params& p, int l, const int wv) {
    const int tid = opaque_tid(wv);
    const bf16_t* SK = (const bf16_t*)(p.ws + OFF_SUBK) + (size_t)l * 2 * 128 * 64;
    for (size_t idx = GTID; idx < (size_t)NTOK * 2048; idx += GNT) {
        int t = (int)(idx >> 11), o = (int)(idx & 2047);
        const bf16_t* Q = (const bf16_t*)(p.ws + OFF_Q) + (size_t)t * D;
        int n = o & 127, x = (o >> 7) & 1, h = o >> 8;
        float acc = 0.f;
        for (int k = 0; k < 64; ++k) acc += bf2f(Q[h * 128 + x * 64 + k]) * bf2f(SK[((size_t)x * 128 + n) * 64 + k]);
        ((float*)(p.ws + OFF_PROJ))[idx] = acc;
    }
}
__device__ void ph_peer_top1(const Params& p, const int wv) {
    const int tid = opaque_tid(wv);
    for (size_t idx = GTID; idx < (size_t)NTOK * 16; idx += GNT) {
        const float* SC = (const float*)(p.ws + OFF_PROJ) + idx * 128;
        float* TV = (float*)(p.ws + OFF_TOPV) + idx * 16; int* TI = (int*)(p.ws + OFF_TOPI) + idx * 16;
        float pv = 3.0e38f; int pi = -1;
        for (int r = 0; r < 16; ++r) {
            float bv = -3.0e38f; int bi = -1;
            for (int n = 0; n < 128; ++n) {
                float v = SC[n];
                bool after = (v < pv) || (v == pv && n > pi);
                if (after && (bi < 0 || v > bv)) { bv = v; bi = n; }
            }
            TV[r] = bv; TI[r] = bi; pv = bv; pi = bi;
        }
    }
}
__device__ void ph_peer_top2(const Params& p, const int wv) {
    const int tid = opaque_tid(wv);
    for (size_t idx = GTID; idx < (size_t)NTOK * 8; idx += GNT) {
        const float* TV = (const float*)(p.ws + OFF_TOPV) + idx * 32; const int* TI = (const int*)(p.ws + OFF_TOPI) + idx * 32;
        int* EI = (int*)(p.ws + OFF_EIDX) + idx * 16; float* EG = (float*)(p.ws + OFF_EGATE) + idx * 16;
        float pv = 3.0e38f; int pi = -1; float mx = 0.f, sum = 0.f;
        for (int r = 0; r < 16; ++r) {
            float bv = -3.0e38f; int bi = -1;
            for (int n = 0; n < 256; ++n) {
                float v = TV[n >> 4] + TV[16 + (n & 15)];
                bool after = (v < pv) || (v == pv && n > pi);
                if (after && (bi < 0 || v > bv)) { bv = v; bi = n; }
            }
            if (r == 0) mx = bv;
            float e = expf(bv - mx);
            sum += e;
            EG[r] = e; EI[r] = TI[bi >> 4] * 128 + TI[16 + (bi & 15)];
            pv = bv; pi = bi;
        }
        float inv = 1.f / sum;
        for (int r = 0; r < 16; ++r) EG[r] *= inv;
    }
}
__device__ void ph_peer_apply(const Params& p, int l, unsigned char* lds, const int wv) {
    const int tid = opaque_tid(wv);
    const int sub = tid >> 8, tl = tid & 255;
    const int wave = tl >> 6, lane = tl & 63;
    float* wts = (float*)(lds + 64) + sub * 128; int* eid = (int*)(lds + 64 + 1024) + sub * 128;
    const bf16_t* UT = (const bf16_t*)(p.ws + OFF_UT) + (size_t)l * NEXP * D;
    const bf16_t* VT = (const bf16_t*)(p.ws + OFF_VT) + (size_t)l * NEXP * D;
    const int niter = (NTOK + gridDim.x * 2 - 1) / (gridDim.x * 2);
    for (int it = 0; it < niter; ++it) {
        int t = (it * gridDim.x + blockIdx.x) * 2 + sub;
        const bool valid = t < NTOK; if (!valid) t = NTOK - 1;
        const bf16_t* H = (const bf16_t*)(p.ws + OFF_H) + (size_t)t * D;
        const int* EI = (const int*)(p.ws + OFF_EIDX) + (size_t)t * 128; const float* EG = (const float*)(p.ws + OFF_EGATE) + (size_t)t * 128;
        float hv[16];
#pragma unroll
        for (int i = 0; i < 16; ++i) hv[i] = bf2f(H[lane * 16 + i]);
        for (int jj = 0; jj < 32; ++jj) {
            int j = wave * 32 + jj; int e = EI[j];
            const bf16_t* ur = UT + (size_t)e * D + lane * 16;
            float acc = 0.f;
#pragma unroll
            for (int i = 0; i < 16; ++i) acc += hv[i] * bf2f(ur[i]);
            acc = wave_sum(acc);
            if (lane == 0) { wts[j] = EG[j] * gelu_f(acc); eid[j] = e; }
        }
        __syncthreads();
        float o[4] = {0.f, 0.f, 0.f, 0.f};
        for (int j = 0; j < 128; ++j) {
            const bf16_t* vr = VT + (size_t)eid[j] * D + tl * 4; float w = wts[j];
#pragma unroll
            for (int i = 0; i < 4; ++i) o[i] += w * bf2f(vr[i]);
        }
        const float* mod = (const float*)(p.ws + OFF_MOD) + (size_t)(l * 5 + tok_cv(t)) * 6144 + 5 * 1024;
        float* XC = (float*)(p.ws + OFF_XC) + (size_t)t * D;
        if (valid) {
#pragma unroll
            for (int i = 0; i < 4; ++i) { int c = tl * 4 + i; XC[c] += mod[c] * o[i]; }
        }
        __syncthreads();
    }
}
__device__ void ph_final_norm(const Params& p, const int wv) {
    const int tid = opaque_tid(wv);
    const int lane = tid & 63;
    const int gw = blockIdx.x * 8 + (tid >> 6), nw = gridDim.x * 8;
    u32x4 nx[2];
    {
        const int t = gw < NTOK ? gw : NTOK - 1;
        const bf16_t* xr = (const bf16_t*)(p.ws + OFF_XC) + (size_t)t * D + lane * 8;
        nx[0] = *reinterpret_cast<const u32x4*>(xr); nx[1] = *reinterpret_cast<const u32x4*>(xr + 512);
    }
    for (int t = gw; t < NTOK; t += nw) {
        float v[16];
#pragma unroll
        for (int h = 0; h < 2; ++h)
#pragma unroll
            for (int k = 0; k < 4; ++k) { v[h * 8 + 2 * k] = __uint_as_float(nx[h][k] << 16); v[h * 8 + 2 * k + 1] = __uint_as_float(nx[h][k] & 0xffff0000u); }
        {
            const int tn = t + nw < NTOK ? t + nw : t;
            const bf16_t* xn = (const bf16_t*)(p.ws + OFF_XC) + (size_t)tn * D + lane * 8;
            nx[0] = *reinterpret_cast<const u32x4*>(xn); nx[1] = *reinterpret_cast<const u32x4*>(xn + 512);
        }
        float ss = 0.f;
#pragma unroll
        for (int i = 0; i < 16; ++i) ss += v[i] * v[i];
        ss = wave_sum(ss);
        float r = rsqrtf(ss / D + EPS);
        float* y = p.out + (size_t)t * D;
#pragma unroll
        for (int h = 0; h < 2; ++h) {
            const int c = h * 512 + lane * 8;
#pragma unroll
            for (int q = 0; q < 2; ++q) {
                const float4 g = *reinterpret_cast<const float4*>(p.in[I_FG] + c + q * 4);
                *reinterpret_cast<float4*>(y + c + q * 4) = make_float4(v[h * 8 + q * 4] * r * g.x, v[h * 8 + q * 4 + 1] * r * g.y, v[h * 8 + q * 4 + 2] * r * g.z, v[h * 8 + q * 4 + 3] * r * g.w);
            }
        }
    }
}


namespace g8 {
constexpr int BM = 256, BK = 64, HALF = 128, HT = HALF * BK;
__device__ __forceinline__ int lds_byte(int r, int c) {
    int st = (r >> 4) * 2 + (c >> 5), rr = r & 15, cc = c & 31, ob = rr * 64 + cc * 2;
    return st * 1024 + (ob ^ (((ob >> 9) & 1) << 5));
}
__device__ __forceinline__ void stage_rc(int b, int& R, int& C) {
    int st = b / 1024, sb = b % 1024, swz = sb ^ (((sb >> 9) & 1) << 5);
    R = (st >> 1) * 16 + swz / 64; C = (st & 1) * 32 + (swz % 64) / 2;
}
}
enum { EPI_INPROJ = 0, EPI_WOUT = 1, EPI_WQ = 2 };
constexpr int STG = 132;

__device__ __forceinline__ void store_bf16x32(bf16_t* dst, const float (&v)[32]) {
#pragma unroll
    for (int i = 0; i < 4; ++i) {
        uint4 u;
        u.x = pack_bf2(v[i * 8 + 0], v[i * 8 + 1]); u.y = pack_bf2(v[i * 8 + 2], v[i * 8 + 3]);
        u.z = pack_bf2(v[i * 8 + 4], v[i * 8 + 5]); u.w = pack_bf2(v[i * 8 + 6], v[i * 8 + 7]);
        *reinterpret_cast<uint4*>(dst + i * 8) = u;
    }
}
__device__ __forceinline__ void store_f32x32(float* dst, const float (&v)[32]) {
#pragma unroll
    for (int i = 0; i < 8; ++i) *reinterpret_cast<float4*>(dst + i * 4) = make_float4(v[i * 4], v[i * 4 + 1], v[i * 4 + 2], v[i * 4 + 3]);
}

__device__ __forceinline__ void epi_inproj_row(const Params& p, int l, int t, int c0, float (&v)[32]) {
    const bool prompt = t < NPT;
    const int b = prompt ? (t >> 8) : ((t - NPT) >> 11);
    const int s = prompt ? (t & 255) : ((t - NPT) & 2047);
    unsigned char* ws = p.ws;
    const float* R = (const float*)(ws + OFF_ROPE);
    if (c0 < 512) {
        bf16_t* dst = (bf16_t*)(ws + (c0 < 256 ? OFF_AU : OFF_AV)) + (size_t)t * 256 + (c0 & 255);
#pragma unroll
        for (int i = 0; i < 32; ++i) v[i] = gelu_f(v[i]);
        store_bf16x32(dst, v);
    } else if (c0 < 1024) {
        const bool isq = c0 < 768;
        if (!isq && prompt) store_f32x32(p.out + OUT_NDK + (((size_t)b * 2 + l) * SEQ + s) * 256 + (c0 - 768), v);
        if (!prompt) {
            const float* cs = R + s * 16; const float* sn = R + 2048 * 16 + s * 16;
#pragma unroll
            for (int i = 0; i < 16; ++i) {
                float c = cs[i], sv = sn[i], x1 = v[i], x2 = v[i + 16];
                v[i] = x1 * c - x2 * sv; v[i + 16] = x2 * c + x1 * sv;
            }
        }
        bf16_t* dst;
        if (isq) dst = (bf16_t*)(ws + OFF_DQ) + (size_t)t * 256 + (c0 - 512);
        else {
            const int cc = c0 - 768, h = cc >> 6, r = cc & 63;
            dst = prompt ? (bf16_t*)(ws + OFF_DKP) + (((size_t)b * 4 + h) * SEQ + s) * 64 + r
                         : (bf16_t*)(ws + OFF_DKS) + (((size_t)b * 4 + h) * NKS + s) * 64 + r;
        }
        store_bf16x32(dst, v);
    } else if (c0 < 1280) {
        if (prompt) store_f32x32(p.out + OUT_NDV + (((size_t)b * 2 + l) * SEQ + s) * 256 + (c0 - 1024), v);
    } else if (c0 < 1920) {
        const bool isq = c0 < 1792;
        const int hi = c0 & 32;
        const float* g = p.in[isq ? I_QNG : I_KNG] + l * 64 + hi;
        float ss = 0.f;
#pragma unroll
        for (int i = 0; i < 32; ++i) ss += v[i] * v[i];
        const int ln = lane_id_op();
        ss += shfl_x(ss, ln, 1);
        const float rr = rsqrtf(ss * (1.f / 64.f) + EPS);
#pragma unroll
        for (int i = 0; i < 32; ++i) v[i] = v[i] * rr * g[i];
        if (!isq && prompt) store_f32x32(p.out + OUT_NGK + (((size_t)b * 2 + l) * SEQ + s) * 128 + (c0 - 1792), v);
        if (!prompt) {
            const float* cs = R + 2048 * 32 + s * 32; const float* sn = R + 2048 * 64 + s * 32;
#pragma unroll
            for (int i = 0; i < 32; ++i) {
                float pv = shfl_x(v[i], ln, 1);
                float c = cs[i], sv = sn[i];
                v[i] = hi ? (v[i] * c + pv * sv) : (v[i] * c - pv * sv);
            }
        }
        bf16_t* dst;
        if (isq) dst = (bf16_t*)(ws + OFF_GQ) + (size_t)t * 512 + (c0 - 1280);
        else {
            const int cc = c0 - 1792, kv = cc >> 6, r = cc & 63;
            dst = prompt ? (bf16_t*)(ws + OFF_GKP) + (((size_t)b * 2 + kv) * SEQ + s) * 64 + r
                         : (bf16_t*)(ws + OFF_GKS) + (((size_t)b * 2 + kv) * NKS + s) * 64 + r;
        }
        store_bf16x32(dst, v);
    } else {
        if (prompt) store_f32x32(p.out + OUT_NGV + (((size_t)b * 2 + l) * SEQ + s) * 128 + (c0 - 1920), v);
    }
}
__device__ __forceinline__ void epi_inproj_col(const Params& p, int t0, int c, const LAS float* stc) {
    float v[32];
#pragma unroll
    for (int i = 0; i < 32; ++i) v[i] = stc[i * STG];
    const bool prompt = t0 < NPT;
    const int b = prompt ? (t0 >> 8) : ((t0 - NPT) >> 11);
    const int s = prompt ? (t0 & 255) : ((t0 - NPT) & 2047);
    unsigned char* ws = p.ws;
    bf16_t* dst;
    if (c < 1280) {
        const int cc = c - 1024, h = cc >> 6, d = cc & 63;
        dst = prompt ? (bf16_t*)(ws + OFF_DVTP) + (((size_t)b * 4 + h) * 64 + d) * SEQ + s
                     : (bf16_t*)(ws + OFF_DVTS) + (((size_t)b * 4 + h) * 64 + d) * NKS + s;
    } else {
        const int cc = c - 1920, kv = cc >> 6, d = cc & 63;
        dst = prompt ? (bf16_t*)(ws + OFF_GVTP) + (((size_t)b * 2 + kv) * 64 + d) * SEQ + s
                     : (bf16_t*)(ws + OFF_GVTS) + (((size_t)b * 2 + kv) * 64 + d) * NKS + s;
    }
    store_bf16x32(dst, v);
}

template <int MODE>
__device__ __forceinline__ void gemm_phase(const Params& p, int l, const bf16_t* __restrict__ A, const bf16_t* __restrict__ Bt, const int N, unsigned char* ldsraw, const int wv) {
    using namespace g8;
    constexpr int K = 1024, nt = K / BK, BN = 128, TILE_A = BM * BK * 2, TILE_B = BN * BK * 2, STAGE_B = TILE_A + TILE_B;
    LAS unsigned char* lds = (LAS unsigned char*)ldsraw;
    const int tid = opaque_tid(wv), wid = wv, lane = tid & 63;
    const int wr = wid >> 1, wc = wid & 1, fr = lane & 15, fq = lane >> 4;
    unsigned voff[4];
#pragma unroll
    for (int i = 0; i < 4; ++i) voff[i] = (unsigned)((i * 64 + wid * 8 + (lane >> 3)) * K + (((lane & 7) ^ (lane >> 3)) * 8)) * 2u;
    const int aoff = (wr * 64 + fr) * 128 + ((fq ^ (fr & 7)) * 16), boff = (wc * 64 + fr) * 128 + ((fq ^ (fr & 7)) * 16);
    const unsigned ldsw = (unsigned)wid * 1024u;
#define G8_STAGE(buf, kt) do { \
        _Pragma("unroll") for (int _i = 0; _i < 4; ++_i) \
            __builtin_amdgcn_global_load_lds((const unsigned*)((const char*)(Ab + (kt) * BK) + voff[_i]), (LAS unsigned*)(lds + (buf) * STAGE_B + ldsw + _i * 8192), 16, 0, 0); \
        _Pragma("unroll") for (int _i = 0; _i < 2; ++_i) \
            __builtin_amdgcn_global_load_lds((const unsigned*)((const char*)(Bb + (kt) * BK) + voff[_i]), (LAS unsigned*)(lds + (buf) * STAGE_B + TILE_A + ldsw + _i * 8192), 16, 0, 0); } while (0)
#define G8_WAIT_V0() asm volatile("s_waitcnt vmcnt(0)" ::: "memory")
    const int nN = N / BN, nM = NTOK / BM, ntiles = nM * nN;
    const int G = gridDim.x;
    const int vb = (G % 8 == 0) ? (int)(blockIdx.x % 8) * (G / 8) + (int)(blockIdx.x / 8) : (int)blockIdx.x;
    const int tpb = (ntiles + G - 1) / G;
    const bool paneled = (G == 256) && (nN == 8 || nN == 16) && (nM == 64);
    for (int ti = 0; ti < tpb; ++ti) {
        int tile = vb * tpb + ti;
        if (paneled) {
            const int x = vb >> 5, j = vb & 31;
            const int mpx = nN == 16 ? 16 : 8;
            const int m0 = nN == 16 ? (x >> 1) * 16 : x * 8, n0 = nN == 16 ? (x & 1) * 8 : 0;
            const int pm_ = m0 + ti * 4 + (j >> 3), pn_ = n0 + (j & 7);
            tile = (ti * 4 < mpx) ? pm_ * nN + pn_ : ntiles;
        }
        if (tile >= ntiles) break;
        const int pm = tile / nN, pn = tile % nN, brow = pm * BM, bcol = pn * BN;
        const bf16_t* Ab = A + (size_t)brow * K; const bf16_t* Bb = Bt + (size_t)bcol * K;
        f32x4 acc[4][4];
#pragma unroll
        for (int m = 0; m < 4; ++m)
#pragma unroll
            for (int n = 0; n < 4; ++n) acc[m][n] = f32x4{0.f, 0.f, 0.f, 0.f};
        G8_WAIT_V0();
        G8_STAGE(0, 0); G8_STAGE(1, 1);
        int cur = 0;
        for (int t = 0; t < nt; ++t) {
            if (t + 1 < nt) asm volatile("s_waitcnt vmcnt(6)" ::: "memory"); else asm volatile("s_waitcnt vmcnt(0)" ::: "memory");
            __builtin_amdgcn_s_barrier();
            if (t + 2 < nt) { const int nb = cur >= 1 ? cur - 1 : 2; G8_STAGE(nb, t + 2); }
            {
                bf16x8 At[2][4], Bf[2][4];
#pragma unroll
                for (int ks = 0; ks < 2; ++ks) {
#pragma unroll
                    for (int m = 0; m < 4; ++m) At[ks][m] = *(const LAS bf16x8*)(lds + cur * STAGE_B + ((aoff + m * 2048) ^ (ks * 64)));
#pragma unroll
                    for (int n = 0; n < 4; ++n) Bf[ks][n] = *(const LAS bf16x8*)(lds + cur * STAGE_B + TILE_A + ((boff + n * 2048) ^ (ks * 64)));
                }
                __builtin_amdgcn_sched_barrier(0);
#pragma unroll
                for (int ks = 0; ks < 2; ++ks)
#pragma unroll
                    for (int m = 0; m < 4; ++m)
#pragma unroll
                        for (int n = 0; n < 4; ++n) acc[m][n] = __builtin_amdgcn_mfma_f32_16x16x32_bf16(At[ks][m], Bf[ks][n], acc[m][n], 0, 0, 0);
                __builtin_amdgcn_sched_barrier(0);
            }
            cur = cur == 2 ? 0 : cur + 1;
        }
        __syncthreads();
        LAS float* st = (LAS float*)lds;
#pragma unroll
        for (int m = 0; m < 4; ++m)
#pragma unroll
            for (int n = 0; n < 4; ++n)
#pragma unroll
                for (int j = 0; j < 4; ++j)
                    st[(wr * 64 + m * 16 + fq * 4 + j) * STG + wc * 64 + n * 16 + fr] = acc[m][n][j];
        __syncthreads();
#pragma unroll 1
        for (int it = 0; it < 2; ++it) {
            const int item = it * NT + tid, erow = item >> 2, eseg = item & 3;
            const int t = brow + erow, c0 = bcol + eseg * 32;
            float v[32];
#pragma unroll
            for (int i = 0; i < 8; ++i) {
                const f32x4 f = *(const LAS f32x4*)(st + erow * STG + eseg * 32 + i * 4);
                v[i * 4] = f[0]; v[i * 4 + 1] = f[1]; v[i * 4 + 2] = f[2]; v[i * 4 + 3] = f[3];
            }
            if (MODE == EPI_INPROJ) {
                epi_inproj_row(p, l, t, c0, v);
            } else if (MODE == EPI_WOUT) {
                const float* g1 = (const float*)(p.ws + OFF_MOD) + (size_t)(l * 5 + tok_cv(t)) * 6144 + 2048 + c0;
                bf16_t* xo = (bf16_t*)(p.ws + OFF_XC) + (size_t)t * D + c0;
                float xin[32];
                if (l == 0) {
                    const float* xr = x_in_row(p, t) + c0;
#pragma unroll
                    for (int i = 0; i < 8; ++i) { const float4 x = *reinterpret_cast<const float4*>(xr + i * 4); xin[i * 4] = x.x; xin[i * 4 + 1] = x.y; xin[i * 4 + 2] = x.z; xin[i * 4 + 3] = x.w; }
                } else {
#pragma unroll
                    for (int i = 0; i < 4; ++i) {
                        const u32x4 x = *reinterpret_cast<const u32x4*>(xo + i * 8);
#pragma unroll
                        for (int k = 0; k < 4; ++k) { xin[i * 8 + 2 * k] = __uint_as_float(x[k] << 16); xin[i * 8 + 2 * k + 1] = __uint_as_float(x[k] & 0xffff0000u); }
                    }
                }
#pragma unroll
                for (int i = 0; i < 8; ++i) {
                    const float4 g = *reinterpret_cast<const float4*>(g1 + i * 4);
                    v[i * 4] = xin[i * 4] + g.x * v[i * 4]; v[i * 4 + 1] = xin[i * 4 + 1] + g.y * v[i * 4 + 1];
                    v[i * 4 + 2] = xin[i * 4 + 2] + g.z * v[i * 4 + 2]; v[i * 4 + 3] = xin[i * 4 + 3] + g.w * v[i * 4 + 3];
                }
                store_bf16x32(xo, v);
            } else {
                store_bf16x32((bf16_t*)(p.ws + OFF_Q) + (size_t)t * D + c0, v);
            }
        }
        if (MODE == EPI_INPROJ && ((bcol >= 1024 && bcol < 1280) || bcol >= 1920)) {
#pragma unroll 1
            for (int it = 0; it < 2; ++it) {
                const int item = it * NT + tid, col = item >> 3, run = item & 7;
                epi_inproj_col(p, brow + run * 32, bcol + col, st + run * 32 * STG + col);
            }
        }
        __syncthreads();
    }
}


#define MFMA32(a, b, c) __builtin_amdgcn_mfma_f32_32x32x16_bf16((a), (b), (c), 0, 0, 0)
constexpr int ATT_ROWB = 144;
constexpr int ATT_TILEB = 64 * ATT_ROWB;
constexpr int QW_MIX = 4096;

__device__ __forceinline__ bf16x8 pack8(const f32x16& x, int s) {
    const u32x4 w = {pack_bf2(x[8 * s], x[8 * s + 1]), pack_bf2(x[8 * s + 2], x[8 * s + 3]), pack_bf2(x[8 * s + 4], x[8 * s + 5]), pack_bf2(x[8 * s + 6], x[8 * s + 7])};
    return __builtin_bit_cast(bf16x8, w);
}
__device__ __forceinline__ void softmax_tile(f32x16& s0, f32x16& s1, const float sc, float& m, float& l, float& alpha, const int lane) {
    float mx = fmaxf(s0[0], s1[0]);
#pragma unroll
    for (int i = 1; i < 16; ++i) mx = fmaxf(mx, fmaxf(s0[i], s1[i]));
    mx = fmaxf(mx, shfl_x(mx, lane, 32));
    const float mnew = fmaxf(m, mx * sc);
    alpha = __builtin_amdgcn_exp2f(m - mnew);
    m = mnew;
    float ps = 0.f;
#pragma unroll
    for (int i = 0; i < 16; ++i) { s0[i] = __builtin_amdgcn_exp2f(s0[i] * sc - mnew); s1[i] = __builtin_amdgcn_exp2f(s1[i] * sc - mnew); ps += s0[i] + s1[i]; }
    l = l * alpha + ps;
}
__device__ __forceinline__ void v_frags(const LAS unsigned char* vb, bf16x8 (&vf)[8], int r, int hh) {
#pragma unroll
    for (int u = 0; u < 2; ++u)
#pragma unroll
        for (int sk = 0; sk < 2; ++sk)
#pragma unroll
            for (int mt = 0; mt < 2; ++mt) {
                const LAS unsigned char* a = vb + (32 * mt + r) * ATT_ROWB + (32 * u + 16 * sk + 4 * hh) * 2;
                const s16x4 lo = *(const LAS s16x4*)a, hi = *(const LAS s16x4*)(a + 16);
                vf[(u * 2 + sk) * 2 + mt] = bf16x8{lo[0], lo[1], lo[2], lo[3], hi[0], hi[1], hi[2], hi[3]};
            }
}
__device__ __forceinline__ void pv_tile(const bf16x8 (&vf)[8], const f32x16& p0, const f32x16& p1, f32x16 (&O)[2]) {
#pragma unroll
    for (int u = 0; u < 2; ++u)
#pragma unroll
        for (int sk = 0; sk < 2; ++sk) {
            const bf16x8 pf = pack8(u ? p1 : p0, sk);
#pragma unroll
            for (int mt = 0; mt < 2; ++mt) O[mt] = MFMA32(vf[(u * 2 + sk) * 2 + mt], pf, O[mt]);
        }
}

template <bool DIFF>
__device__ __forceinline__ void attn_item(const Params& p, int l, LAS unsigned char* lds, const int tid,
                                          const bf16_t* __restrict__ Qg, const int qstride,
                                          const bf16_t* __restrict__ Kg, const bf16_t* __restrict__ Vtg, const int nk,
                                          bf16_t* __restrict__ Og, const float lam) {
    const int wave = tid >> 6, lane = tid & 63, r = lane & 31, hh = lane >> 5;
    const int lrow = tid >> 3, lchunk = tid & 7;
    LAS unsigned char* kbuf = lds; LAS unsigned char* vbuf = lds + 2 * ATT_TILEB;
    bf16x8 qf[4];
    const bf16_t* qrow = Qg + (size_t)(wave * 32 + r) * qstride;
#pragma unroll
    for (int ks = 0; ks < 4; ++ks) qf[ks] = *reinterpret_cast<const bf16x8*>(qrow + ks * 16 + hh * 8);
    const float sc = (DIFF ? 0.17677669529663687f : 0.125f) * 1.4426950408889634f;
    f32x16 O0[2], O1[2];
#pragma unroll
    for (int mt = 0; mt < 2; ++mt)
#pragma unroll
        for (int i = 0; i < 16; ++i) { O0[mt][i] = 0.f; O1[mt][i] = 0.f; }
    float m0 = -1e30f, l0 = 0.f, m1 = -1e30f, l1 = 0.f;
    const int ntl = nk / 64;
    u32x4 kr, vr, kn, vn;
    kr = *reinterpret_cast<const u32x4*>(Kg + (size_t)lrow * 64 + lchunk * 8);
    vr = *reinterpret_cast<const u32x4*>(Vtg + (size_t)lrow * nk + lchunk * 8);
    *(LAS u32x4*)(kbuf + lrow * ATT_ROWB + lchunk * 16) = kr;
    *(LAS u32x4*)(vbuf + lrow * ATT_ROWB + lchunk * 16) = vr;
    {
        const int t1 = ntl > 1 ? 1 : 0;
        kr = *reinterpret_cast<const u32x4*>(Kg + (size_t)(t1 * 64 + lrow) * 64 + lchunk * 8);
        vr = *reinterpret_cast<const u32x4*>(Vtg + (size_t)lrow * nk + t1 * 64 + lchunk * 8);
    }
    __syncthreads();
    for (int ti = 0; ti < ntl; ++ti) {
        const int cur = ti & 1;
        {
            const int t2 = ti + 2 < ntl ? ti + 2 : ntl - 1;
            kn = *reinterpret_cast<const u32x4*>(Kg + (size_t)(t2 * 64 + lrow) * 64 + lchunk * 8);
            vn = *reinterpret_cast<const u32x4*>(Vtg + (size_t)lrow * nk + t2 * 64 + lchunk * 8);
        }
        const LAS unsigned char* kb = kbuf + cur * ATT_TILEB; const LAS unsigned char* vb = vbuf + cur * ATT_TILEB;
        bf16x8 ka[2][4];
#pragma unroll
        for (int u = 0; u < 2; ++u)
#pragma unroll
            for (int ks = 0; ks < 4; ++ks) ka[u][ks] = *(const LAS bf16x8*)(kb + (32 * u + r) * ATT_ROWB + (ks * 16 + hh * 8) * 2);
        __builtin_amdgcn_sched_barrier(0);
        bf16x8 vf[8];
        if (!DIFF) {
            f32x16 s0, s1;
#pragma unroll
            for (int i = 0; i < 16; ++i) { s0[i] = 0.f; s1[i] = 0.f; }
#pragma unroll
            for (int ks = 0; ks < 4; ++ks) { s0 = MFMA32(ka[0][ks], qf[ks], s0); s1 = MFMA32(ka[1][ks], qf[ks], s1); }
            v_frags(vb, vf, r, hh);
            __builtin_amdgcn_sched_barrier(0);
            float alpha;
            softmax_tile(s0, s1, sc, m0, l0, alpha, lane);
            if (__builtin_amdgcn_ballot_w64(alpha != 1.f) != 0ull) {
#pragma unroll
                for (int mt = 0; mt < 2; ++mt)
#pragma unroll
                    for (int i = 0; i < 16; ++i) O0[mt][i] *= alpha;
            }
            pv_tile(vf, s0, s1, O0);
        } else {
            f32x16 s0, s1, t0, t1;
#pragma unroll
            for (int i = 0; i < 16; ++i) { s0[i] = 0.f; s1[i] = 0.f; t0[i] = 0.f; t1[i] = 0.f; }
#pragma unroll
            for (int ks = 0; ks < 2; ++ks) {
                s0 = MFMA32(ka[0][ks], qf[ks], s0); s1 = MFMA32(ka[1][ks], qf[ks], s1);
                t0 = MFMA32(ka[0][2 + ks], qf[2 + ks], t0); t1 = MFMA32(ka[1][2 + ks], qf[2 + ks], t1);
            }
            v_frags(vb, vf, r, hh);
            __builtin_amdgcn_sched_barrier(0);
            float alpha;
            softmax_tile(s0, s1, sc, m0, l0, alpha, lane);
            if (__builtin_amdgcn_ballot_w64(alpha != 1.f) != 0ull) {
#pragma unroll
                for (int mt = 0; mt < 2; ++mt)
#pragma unroll
                    for (int i = 0; i < 16; ++i) O0[mt][i] *= alpha;
            }
            pv_tile(vf, s0, s1, O0);
            softmax_tile(t0, t1, sc, m1, l1, alpha, lane);
            if (__builtin_amdgcn_ballot_w64(alpha != 1.f) != 0ull) {
#pragma unroll
                for (int mt = 0; mt < 2; ++mt)
#pragma unroll
                    for (int i = 0; i < 16; ++i) O1[mt][i] *= alpha;
            }
            pv_tile(vf, t0, t1, O1);
        }
        if (ti + 1 < ntl) {
            *(LAS u32x4*)(kbuf + (cur ^ 1) * ATT_TILEB + lrow * ATT_ROWB + lchunk * 16) = kr;
            *(LAS u32x4*)(vbuf + (cur ^ 1) * ATT_TILEB + lrow * ATT_ROWB + lchunk * 16) = vr;
        }
        kr = kn; vr = vn;
        __syncthreads();
    }
    l0 += shfl_x(l0, lane, 32);
    const float inv0 = 1.f / l0;
    bf16_t* orow = Og + (size_t)(wave * 32 + r) * D;
    if (!DIFF) {
#pragma unroll
        for (int mt = 0; mt < 2; ++mt)
#pragma unroll
            for (int g = 0; g < 4; ++g) {
                uint2 w;
                w.x = pack_bf2(O0[mt][4 * g] * inv0, O0[mt][4 * g + 1] * inv0);
                w.y = pack_bf2(O0[mt][4 * g + 2] * inv0, O0[mt][4 * g + 3] * inv0);
                *reinterpret_cast<uint2*>(orow + 32 * mt + 8 * g + 4 * hh) = w;
            }
    } else {
        l1 += shfl_x(l1, lane, 32);
        const float inv1 = lam / l1;
        float ss = 0.f;
#pragma unroll
        for (int mt = 0; mt < 2; ++mt)
#pragma unroll
            for (int i = 0; i < 16; ++i) { const float o = O0[mt][i] * inv0 - O1[mt][i] * inv1; O0[mt][i] = o; ss += o * o; }
        ss += shfl_x(ss, lane, 32);
        const float rr = rsqrtf(ss * (1.f / 64.f) + EPS) * __builtin_bit_cast(float, __builtin_amdgcn_readfirstlane(__builtin_bit_cast(int, 1.f - lam_init_of(l))));
        const float* sg = p.in[I_SUBLN] + l * 64;
#pragma unroll
        for (int mt = 0; mt < 2; ++mt)
#pragma unroll
            for (int g = 0; g < 4; ++g) {
                const int d0 = 32 * mt + 8 * g + 4 * hh;
                const float4 gg = *reinterpret_cast<const float4*>(sg + d0);
                uint2 w;
                w.x = pack_bf2(O0[mt][4 * g] * rr * gg.x, O0[mt][4 * g + 1] * rr * gg.y);
                w.y = pack_bf2(O0[mt][4 * g + 2] * rr * gg.z, O0[mt][4 * g + 3] * rr * gg.w);
                *reinterpret_cast<uint2*>(orow + d0) = w;
            }
    }
}

constexpr int SGU_ROWB = 272;
__device__ __forceinline__ void sgu_item(const Params& p, int l, LAS unsigned char* lds, const int tid, const int t0) {
    const bf16_t* AV = (const bf16_t*)(p.ws + OFF_AV) + (size_t)t0 * 256;
    {
        const int q = tid >> 2, quarter = tid & 3;
        float v[64]; float ss = 0.f;
#pragma unroll
        for (int i = 0; i < 8; ++i) {
            const bf16x8 w = *reinterpret_cast<const bf16x8*>(AV + (size_t)q * 256 + quarter * 64 + i * 8);
#pragma unroll
            for (int j = 0; j < 8; ++j) { v[i * 8 + j] = bf2f((bf16_t)w[j]); ss += v[i * 8 + j] * v[i * 8 + j]; }
        }
        { const int ln = tid & 63; ss += shfl_x(ss, ln, 1); ss += shfl_x(ss, ln, 2); }
        const float rstd = rsqrtf(ss * (1.f / 256.f) + EPS);
        const float* g = p.in[I_SGUNG] + l * 256 + quarter * 64;
#pragma unroll
        for (int i = 0; i < 64; ++i)
            *(LAS bf16_t*)(lds + (quarter * 64 + i) * SGU_ROWB + q * 2) = f2bf(v[i] * rstd * g[i]);
    }
    __syncthreads();
    {
        const int wave = tid >> 6, lane = tid & 63, r = lane & 31, hh = lane >> 5;
        const int g = wave >> 1, ph = wave & 1;
        const bf16_t* W = (const bf16_t*)(p.ws + OFF_SGUW) + ((size_t)l * 4 + g) * 128 * 128;
        f32x16 acc[2][2];
#pragma unroll
        for (int a = 0; a < 2; ++a)
#pragma unroll
            for (int b = 0; b < 2; ++b)
#pragma unroll
                for (int i = 0; i < 16; ++i) acc[a][b][i] = 0.f;
#pragma unroll
        for (int ks = 0; ks < 8; ++ks) {
            bf16x8 af[2], bfr[2];
#pragma unroll
            for (int pt = 0; pt < 2; ++pt) af[pt] = *reinterpret_cast<const bf16x8*>(W + (size_t)(ph * 64 + pt * 32 + r) * 128 + ks * 16 + hh * 8);
#pragma unroll
            for (int ct = 0; ct < 2; ++ct) bfr[ct] = *(const LAS bf16x8*)(lds + (g * 64 + ct * 32 + r) * SGU_ROWB + (ks * 16 + hh * 8) * 2);
#pragma unroll
            for (int pt = 0; pt < 2; ++pt)
#pragma unroll
                for (int ct = 0; ct < 2; ++ct) acc[pt][ct] = MFMA32(af[pt], bfr[ct], acc[pt][ct]);
        }
        const float* bias = p.in[I_SGUB] + (l * 4 + g) * 128;
        const bf16_t* AU = (const bf16_t*)(p.ws + OFF_AU);
        bf16_t* MIX = (bf16_t*)(p.ws + OFF_MIX);
#pragma unroll
        for (int pt = 0; pt < 2; ++pt)
#pragma unroll
            for (int ct = 0; ct < 2; ++ct)
#pragma unroll
                for (int i = 0; i < 16; ++i) {
                    const int pp = ph * 64 + pt * 32 + (i & 3) + 8 * (i >> 2) + 4 * hh, c = g * 64 + ct * 32 + r;
                    const float au = bf2f(AU[(size_t)(t0 + pp) * 256 + c]);
                    MIX[(size_t)(t0 + pp) * D + c] = f2bf(au * (acc[pt][ct][i] + bias[pp]));
                }
    }
    __syncthreads();
}

__device__ void ph_mixers(const Params& p, int lq, unsigned char* ldsraw, const int wv) {
    const int l = lq & 1;
    const int tid0 = opaque_tid(wv);
    LAS unsigned char* lds = (LAS unsigned char*)ldsraw;
    volatile LAS int* qslot = (volatile LAS int*)(ldsraw - LDS_HDR + 64);
    unsigned* qw = (unsigned*)(p.ws + OFF_BAR) + QW_MIX + lq;
    const float lam = __builtin_bit_cast(float, __builtin_amdgcn_readfirstlane(__builtin_bit_cast(int, lam_of(p, l))));
    unsigned char* ws = p.ws;
    for (;;) {
        if (tid0 == 0) *qslot = (int)atomicAdd(qw, 1u);
        __syncthreads();
        const int item = *qslot;
        __syncthreads();
        if (item >= 896) break;
        if (lq >= 2 && PROBE_DUP >= 10) {
            const int cls = item < 128 ? 10 : (item < 384 ? 11 : 12);
            if (cls != PROBE_DUP) continue;
        }
        int tid = tid0; asm volatile("" : "+v"(tid));
        if (item < 128) {
            const int qc = item & 7, h = (item >> 3) & 3, b = item >> 5;
            const int t0 = NPT + b * DSEQ + qc * 256;
            attn_item<true>(p, l, lds, tid, (const bf16_t*)(ws + OFF_DQ) + (size_t)t0 * 256 + h * 64, 256,
                            (const bf16_t*)(ws + OFF_DKS) + ((size_t)b * 4 + h) * NKS * 64, (const bf16_t*)(ws + OFF_DVTS) + ((size_t)b * 4 + h) * 64 * NKS, NKS,
                            (bf16_t*)(ws + OFF_MIX) + (size_t)t0 * D + 256 + h * 64, lam);
        } else if (item < 384) {
            const int it = item - 128, qc = it & 7, hq = (it >> 3) & 7, b = it >> 6, kv = hq >> 2;
            const int t0 = NPT + b * DSEQ + qc * 256;
            attn_item<false>(p, l, lds, tid, (const bf16_t*)(ws + OFF_GQ) + (size_t)t0 * 512 + hq * 64, 512,
                             (const bf16_t*)(ws + OFF_GKS) + ((size_t)b * 2 + kv) * NKS * 64, (const bf16_t*)(ws + OFF_GVTS) + ((size_t)b * 2 + kv) * 64 * NKS, NKS,
                             (bf16_t*)(ws + OFF_MIX) + (size_t)t0 * D + 512 + hq * 64, lam);
        } else if (item < 512) {
            sgu_item(p, l, lds, tid, (item - 384) * 128);
        } else if (item < 768) {
            const int it = item - 512, hq = it & 7, b = it >> 3, kv = hq >> 2;
            const int t0 = b * SEQ;
            attn_item<false>(p, l, lds, tid, (const bf16_t*)(ws + OFF_GQ) + (size_t)t0 * 512 + hq * 64, 512,
                             (const bf16_t*)(ws + OFF_GKP) + ((size_t)b * 2 + kv) * SEQ * 64, (const bf16_t*)(ws + OFF_GVTP) + ((size_t)b * 2 + kv) * 64 * SEQ, SEQ,
                             (bf16_t*)(ws + OFF_MIX) + (size_t)t0 * D + 512 + hq * 64, lam);
        } else {
            const int it = item - 768, h = it & 3, b = it >> 2;
            const int t0 = b * SEQ;
            attn_item<true>(p, l, lds, tid, (const bf16_t*)(ws + OFF_DQ) + (size_t)t0 * 256 + h * 64, 256,
                            (const bf16_t*)(ws + OFF_DKP) + ((size_t)b * 4 + h) * SEQ * 64, (const bf16_t*)(ws + OFF_DVTP) + ((size_t)b * 4 + h) * 64 * SEQ, SEQ,
                            (bf16_t*)(ws + OFF_MIX) + (size_t)t0 * D + 256 + h * 64, lam);
        }
    }
}


using bf16x2 = __attribute__((ext_vector_type(2))) __bf16;
__device__ __forceinline__ float dot2bf(unsigned a, unsigned b, float c) {
    return __builtin_amdgcn_fdot2_f32_bf16(__builtin_bit_cast(bf16x2, a), __builtin_bit_cast(bf16x2, b), c, false);
}
template <int W>
__device__ __forceinline__ void bfly_stage(float (&part)[64], const int lane) {
    const bool hi = (lane & W) != 0;
#pragma unroll
    for (int k = 0; k < W; ++k) {
        const float keep = hi ? part[k + W] : part[k];
        const float send = hi ? part[k] : part[k + W];
        part[k] = keep + shfl_x(send, lane, W);
    }
}
constexpr int QW_PEER = 4160;
template <int W>
__device__ __forceinline__ void bfly16_stage(float (&v)[16], const int lane, const int bit) {
    const bool hi = (lane & bit) != 0;
#pragma unroll
    for (int k = 0; k < W; ++k) {
        const float keep = hi ? v[k + W] : v[k];
        const float send = hi ? v[k] : v[k + W];
        v[k] = keep + shfl_x(send, lane, bit);
    }
}
template <int W>
__device__ __forceinline__ void bfly16i_stage(int (&v)[16], const int lane, const int bit) {
    const bool hi = (lane & bit) != 0;
#pragma unroll
    for (int k = 0; k < W; ++k) {
        const int keep = hi ? v[k + W] : v[k];
        const int send = hi ? v[k] : v[k + W];
        v[k] = keep + shfl_x(send, lane, bit);
    }
}
template <bool VSIDE> struct PeerTok {
    static __device__ __forceinline__ void issue(const Params& p, const unsigned char* Tslice, const int elo, const int ehi, const int t, const int s,
                                                 const int sub, const int c16, u32x4 (&a)[16], u32x4 (&h)[2]) {
#pragma unroll
        for (int i = 0; i < 16; ++i) {
            const int e = shfl_i(i < 8 ? elo : ehi, (i * 8 + sub) & 63);
            a[i] = *reinterpret_cast<const u32x4*>(Tslice + (((unsigned)e << 7) + (unsigned)c16 * 16u));
        }
        if (!VSIDE) h[0] = *reinterpret_cast<const u32x4*>(p.ws + OFF_H8I + (size_t)t * D + s * 128 + c16 * 16);
    }
    static __device__ __forceinline__ void compute(const Params& p, const int l, const u32x4 w4, const float wsc, const int t, const int s,
                                                   const int lane, const int sub, const int c16, const u32x4 (&a)[16], const u32x4 (&h)[2]) {
        if (!VSIDE) {
            int d[16];
#pragma unroll
            for (int i = 0; i < 16; ++i) {
                int acc = 0;
#pragma unroll
                for (int k = 0; k < 4; ++k) acc = __builtin_amdgcn_sdot4((int)a[i][k], (int)h[0][k], acc, false);
                d[i] = acc;
            }
            bfly16i_stage<8>(d, lane, 4); bfly16i_stage<4>(d, lane, 2); bfly16i_stage<2>(d, lane, 1);
            const int i0 = ((lane & 4) << 1) + ((lane & 2) << 1) + ((lane & 1) << 1);
            int* PART = (int*)(p.ws + OFF_PART) + ((size_t)s * NTOK + t) * 128 + sub * 16 + i0;
            *reinterpret_cast<int2*>(PART) = make_int2(d[0], d[1]);
        } else {
            int acc[16];
#pragma unroll
            for (int i = 0; i < 16; ++i) acc[i] = 0;
#pragma unroll
            for (int g = 0; g < 4; ++g) {
                const int wg = (int)w4[g];
#pragma unroll
                for (int k = 0; k < 4; ++k) {
                    const unsigned r0 = a[4 * g][k], r1 = a[4 * g + 1][k], r2 = a[4 * g + 2][k], r3 = a[4 * g + 3][k];
                    const unsigned x01l = __builtin_amdgcn_perm(r1, r0, 0x05010400u), x01h = __builtin_amdgcn_perm(r1, r0, 0x07030602u);
                    const unsigned x23l = __builtin_amdgcn_perm(r3, r2, 0x05010400u), x23h = __builtin_amdgcn_perm(r3, r2, 0x07030602u);
                    const unsigned t0 = __builtin_amdgcn_perm(x23l, x01l, 0x05040100u), t1 = __builtin_amdgcn_perm(x23l, x01l, 0x07060302u);
                    const unsigned t2 = __builtin_amdgcn_perm(x23h, x01h, 0x05040100u), t3 = __builtin_amdgcn_perm(x23h, x01h, 0x07060302u);
                    acc[4 * k]     = __builtin_amdgcn_sdot4((int)t0, wg, acc[4 * k], false);
                    acc[4 * k + 1] = __builtin_amdgcn_sdot4((int)t1, wg, acc[4 * k + 1], false);
                    acc[4 * k + 2] = __builtin_amdgcn_sdot4((int)t2, wg, acc[4 * k + 2], false);
                    acc[4 * k + 3] = __builtin_amdgcn_sdot4((int)t3, wg, acc[4 * k + 3], false);
                }
            }
            bfly16i_stage<8>(acc, lane, 32); bfly16i_stage<4>(acc, lane, 16); bfly16i_stage<2>(acc, lane, 8);
            const int col = s * 128 + c16 * 16 + ((lane & 32) >> 2) + ((lane & 16) >> 2) + ((lane & 8) >> 2);
            const float* g2 = (const float*)(p.ws + OFF_MOD) + (size_t)(l * 5 + tok_cv(t)) * 6144 + 5 * 1024 + col;
            unsigned* XC = reinterpret_cast<unsigned*>((bf16_t*)(p.ws + OFF_XC) + (size_t)t * D + col);
            const unsigned x = *XC; const float2 g = *reinterpret_cast<const float2*>(g2);
            *XC = pack_bf2(__uint_as_float(x << 16) + g.x * wsc * (float)acc[0], __uint_as_float(x & 0xffff0000u) + g.y * wsc * (float)acc[1]);
        }
    }
};
template <bool VSIDE>
__device__ __forceinline__ void peer_slice_stream(const Params& p, const int l, const int s, const int first, const int stride, const int lane) {
    const int sub = lane >> 3, c16 = lane & 7;
    const unsigned char* Ts = p.ws + (VSIDE ? OFF_VT : OFF_UT) + ((size_t)l * 8 + s) * NEXP * 128;
    const int* EIb = (const int*)(p.ws + OFF_EIDX); const unsigned char* WPb = p.ws + OFF_WPAIR; const float* WSb = (const float*)(p.ws + OFF_WSC);
    if (first >= NTOK) return;
    const int cnt = (NTOK - first + stride - 1) / stride;
#define PEER_LOADE(k, elo, ehi, w4, wsc) do { const int _t = min(first + (k) * stride, NTOK - 1); \
        elo = EIb[(size_t)_t * 128 + lane]; ehi = EIb[(size_t)_t * 128 + 64 + lane]; \
        if (VSIDE) { w4 = *reinterpret_cast<const u32x4*>(WPb + (size_t)_t * 128 + sub * 16); wsc = WSb[_t]; } } while (0)
    int e0l, e0h, e1l, e1h, e2l, e2h;
    u32x4 w0 = {0u, 0u, 0u, 0u}, w1 = {0u, 0u, 0u, 0u}, w2 = {0u, 0u, 0u, 0u}; float s0 = 0.f, s1 = 0.f, s2 = 0.f;
    u32x4 A[16], B[16], hA[2], hB[2];
    PEER_LOADE(0, e0l, e0h, w0, s0);
    PEER_LOADE(1, e1l, e1h, w1, s1);
    PeerTok<VSIDE>::issue(p, Ts, e0l, e0h, first, s, sub, c16, A, hA);
    for (int k = 0; k < cnt; k += 2) {
        const int ta = first + k * stride, tb = min(ta + stride, NTOK - 1), tc = min(ta + 2 * stride, NTOK - 1);
        __builtin_amdgcn_sched_barrier(0);
        PEER_LOADE(k + 2, e2l, e2h, w2, s2);
        PeerTok<VSIDE>::issue(p, Ts, e1l, e1h, tb, s, sub, c16, B, hB);
        __builtin_amdgcn_sched_barrier(0);
        PeerTok<VSIDE>::compute(p, l, w0, s0, ta, s, lane, sub, c16, A, hA);
        __builtin_amdgcn_sched_barrier(0);
        e0l = e2l; e0h = e2h; w0 = w2; s0 = s2;
        PEER_LOADE(k + 3, e2l, e2h, w2, s2);
        PeerTok<VSIDE>::issue(p, Ts, e0l, e0h, tc, s, sub, c16, A, hA);
        __builtin_amdgcn_sched_barrier(0);
        if (k + 1 < cnt) PeerTok<VSIDE>::compute(p, l, w1, s1, tb, s, lane, sub, c16, B, hB);
        e1l = e2l; e1h = e2h; w1 = w2; s1 = s2;
    }
#undef PEER_LOADE
}
template <bool VSIDE>
__device__ void ph_peer_sliced(const Params& p, int l, unsigned char* ldsraw, const int wv) {
    const int tid = opaque_tid(wv);
    const int wave = tid >> 6, lane = tid & 63;
    volatile LAS int* hdr = (volatile LAS int*)(ldsraw - LDS_HDR);
    unsigned* bar = (unsigned*)(p.ws + OFF_BAR);
    const int myx = (int)(xb_xcc_id() & 15u);
    if (tid == 0) hdr[16] = (int)atomicAdd(bar + QW_PEER + (l * 2 + (VSIDE ? 1 : 0)) * 16 + myx, 1u);
    __syncthreads();
    const int rank = hdr[16], nloc = (int)hdr[0];
    __syncthreads();
    if (myx < 8) peer_slice_stream<VSIDE>(p, l, myx, rank * 8 + wave, nloc * 8, lane);
    for (int j = 0; j < 8; ++j) {
        if (xb_ld(&bar[XB_XCNT(j)]) == 0u) peer_slice_stream<VSIDE>(p, l, j, (int)blockIdx.x * 8 + wave, (int)gridDim.x * 8, lane);
    }
}
__device__ void ph_peer_pairw(const Params& p, int l, const int wv) {
    const int tid = opaque_tid(wv);
    const int lane = tid & 63;
    const float* USC = (const float*)(p.ws + OFF_USC) + l * NEXP; const float* VSC = (const float*)(p.ws + OFF_VSC) + l * NEXP;
    const int* PART = (const int*)(p.ws + OFF_PART);
    const float* HSC = (const float*)(p.ws + OFF_HSC);
    for (size_t i4 = GTID; i4 < (size_t)NTOK * 32; i4 += GNT) {
        const size_t idx = i4 * 4;
        const int t = (int)(idx >> 7), pp = (int)(idx & 127), sub = pp >> 4, i = pp & 15;
        int4 ps[8];
#pragma unroll
        for (int s = 0; s < 8; ++s) ps[s] = *reinterpret_cast<const int4*>(PART + (size_t)s * NTOK * 128 + idx);
        int e[4]; float g[4];
#pragma unroll
        for (int q = 0; q < 4; ++q) {
            const int j = (i + q) * 8 + sub;
            e[q] = ((const int*)(p.ws + OFF_EIDX))[(size_t)t * 128 + j]; g[q] = ((const float*)(p.ws + OFF_EGATE))[(size_t)t * 128 + j];
        }
        int4 sum = ps[0];
#pragma unroll
        for (int s = 1; s < 8; ++s) { sum.x += ps[s].x; sum.y += ps[s].y; sum.z += ps[s].z; sum.w += ps[s].w; }
        const float hs = HSC[t];
        float w[4];
        w[0] = g[0] * gelu_f((float)sum.x * (USC[e[0]] * hs)) * VSC[e[0]]; w[1] = g[1] * gelu_f((float)sum.y * (USC[e[1]] * hs)) * VSC[e[1]];
        w[2] = g[2] * gelu_f((float)sum.z * (USC[e[2]] * hs)) * VSC[e[2]]; w[3] = g[3] * gelu_f((float)sum.w * (USC[e[3]] * hs)) * VSC[e[3]];
        float am = fmaxf(fmaxf(fabsf(w[0]), fabsf(w[1])), fmaxf(fabsf(w[2]), fabsf(w[3])));
#pragma unroll
        for (int o = 16; o >= 1; o >>= 1) am = fmaxf(am, shfl_x(am, lane, o));
        const float sc = am > 0.f ? 127.f / am : 1.f;
        *reinterpret_cast<unsigned*>(p.ws + OFF_WPAIR + idx) = pack4_i8(q8(w[0] * sc), q8(w[1] * sc), q8(w[2] * sc), q8(w[3] * sc));
        if (pp == 0) ((float*)(p.ws + OFF_WSC))[t] = am > 0.f ? am * (1.f / 127.f) : 1.f;
    }
}

#define CE_DESC(a, b) do { const float _mx = fmaxf((a), (b)); const float _mn = fminf((a), (b)); (a) = _mx; (b) = _mn; } while (0)
__device__ __forceinline__ void sort16_desc(float (&v)[16]) {
#pragma unroll
    for (int k = 2; k <= 16; k <<= 1)
#pragma unroll
        for (int j = k >> 1; j > 0; j >>= 1)
#pragma unroll
            for (int i = 0; i < 16; ++i) {
                const int m = i ^ j;
                if (m > i) { if ((i & k) == 0) CE_DESC(v[i], v[m]); else CE_DESC(v[m], v[i]); }
            }
}
__device__ __forceinline__ void merge_top16(float (&a)[16], const float (&b)[16]) {
#pragma unroll
    for (int i = 0; i < 16; ++i) a[i] = fmaxf(a[i], b[15 - i]);
#pragma unroll
    for (int j = 8; j > 0; j >>= 1)
#pragma unroll
        for (int i = 0; i < 16; ++i) { const int m = i ^ j; if (m > i) CE_DESC(a[i], a[m]); }
}
__device__ __forceinline__ float key_embed(float v, unsigned lowmask, unsigned idxbits) { return __uint_as_float((__float_as_uint(v) & ~lowmask) | idxbits); }

constexpr int SK_ROWB = 144;
__device__ __forceinline__ void peer_stage1(const LAS unsigned char* SK  , const bf16_t* __restrict__ Qrow  ,
                                            const int r, const int hh, float (&out)[16]) {
    bf16x8 qb[4];
#pragma unroll
    for (int ks = 0; ks < 4; ++ks) qb[ks] = *reinterpret_cast<const bf16x8*>(Qrow + ks * 16 + hh * 8);
    float grp[4][16];
#pragma unroll
    for (int mt = 0; mt < 4; ++mt) {
        f32x16 acc;
#pragma unroll
        for (int i = 0; i < 16; ++i) acc[i] = 0.f;
#pragma unroll
        for (int ks = 0; ks < 4; ++ks) {
            const bf16x8 a = *(const LAS bf16x8*)(SK + (mt * 32 + r) * SK_ROWB + (ks * 16 + hh * 8) * 2);
            acc = MFMA32(a, qb[ks], acc);
        }
        const unsigned hx = (unsigned)hh << 2;
#pragma unroll
        for (int i = 0; i < 16; ++i) {
            const unsigned cn = 32u * mt + (i & 3) + 8u * (i >> 2);
            grp[mt][i] = key_embed(acc[i], 127u, (127u - cn) ^ hx);
        }
        sort16_desc(grp[mt]);
    }
    merge_top16(grp[0], grp[1]); merge_top16(grp[2], grp[3]); merge_top16(grp[0], grp[2]);
    float pb[16];
#pragma unroll
    for (int i = 0; i < 16; ++i) pb[i] = shfl_x(grp[0][i], (hh << 5) | r, 32);
    merge_top16(grp[0], pb);
#pragma unroll
    for (int i = 0; i < 16; ++i) out[i] = grp[0][i];
}

__device__ void ph_peer_select(const Params& p, int l, unsigned char* ldsraw, const int wv) {
    const int tid = opaque_tid(wv);
    const int wave = tid >> 6, lane = tid & 63, r = lane & 31, hh = lane >> 5;
    const int gw = blockIdx.x * 8 + wave, nw = gridDim.x * 8;
    LAS unsigned char* skl = (LAS unsigned char*)ldsraw;
    LAS unsigned char* myl = skl + 2 * 128 * SK_ROWB + wave * 2048 + lane * 32;
    {
        const bf16_t* SKg = (const bf16_t*)(p.ws + OFF_SUBK) + (size_t)l * 2 * 128 * 64;
        for (int i = tid; i < 2 * 128 * 8; i += NT) {
            const int row = i >> 3, ch = i & 7;
            *(LAS u32x4*)(skl + row * SK_ROWB + ch * 16) = *reinterpret_cast<const u32x4*>(SKg + (size_t)row * 64 + ch * 8);
        }
        __syncthreads();
    }
    for (int task = gw; task < (NTOK / 32) * 4; task += nw) {
        const int tg = task >> 2, k = task & 3;
        const int t = tg * 32 + r;
        const bf16_t* Qt = (const bf16_t*)(p.ws + OFF_Q) + (size_t)t * D;
        float sv[2][16];
#pragma unroll
        for (int x = 0; x < 2; ++x) {
            float la[16], lb[16];
            peer_stage1(skl + x * 128 * SK_ROWB, Qt + k * 128 + x * 64, r, hh, la);
            peer_stage1(skl + x * 128 * SK_ROWB, Qt + (k + 4) * 128 + x * 64, r, hh, lb);
#pragma unroll
            for (int i = 0; i < 16; ++i) sv[x][i] = hh ? lb[i] : la[i];
        }
        {
            unsigned w[8];
#pragma unroll
            for (int q = 0; q < 8; ++q) {
                w[q] = 0u;
#pragma unroll
                for (int b = 0; b < 4; ++b) {
                    const int i = q * 4 + b;
                    const unsigned key = __float_as_uint(i < 16 ? sv[0][i] : sv[1][i - 16]);
                    w[q] |= (127u - (key & 127u)) << (8 * b);
                }
            }
            *(LAS u32x4*)(myl) = u32x4{w[0], w[1], w[2], w[3]};
            *(LAS u32x4*)(myl + 16) = u32x4{w[4], w[5], w[6], w[7]};
        }
        float val0[16], val1[16];
#pragma unroll
        for (int i = 0; i < 16; ++i) { val0[i] = __uint_as_float(__float_as_uint(sv[0][i]) & ~127u); val1[i] = __uint_as_float(__float_as_uint(sv[1][i]) & ~127u); }
        float g0[16], g1[16], g2[16], g3[16];
#pragma unroll
        for (int b = 0; b < 16; ++b) g0[b] = key_embed(val0[0] + val1[b], 255u, 255u - (unsigned)b);
#pragma unroll
        for (int b = 0; b < 8; ++b) g1[b] = key_embed(val0[1] + val1[b], 255u, 255u - (16u + b));
#pragma unroll
        for (int b = 0; b < 5; ++b) g1[8 + b] = key_embed(val0[2] + val1[b], 255u, 255u - (32u + b));
#pragma unroll
        for (int b = 0; b < 3; ++b) g1[13 + b] = key_embed(val0[4] + val1[b], 255u, 255u - (64u + b));
#pragma unroll
        for (int b = 0; b < 4; ++b) g2[b] = key_embed(val0[3] + val1[b], 255u, 255u - (48u + b));
#pragma unroll
        for (int a = 5; a < 8; ++a)
#pragma unroll
            for (int b = 0; b < 2; ++b) g2[4 + (a - 5) * 2 + b] = key_embed(val0[a] + val1[b], 255u, 255u - (16u * a + b));
#pragma unroll
        for (int a = 8; a < 14; ++a) g2[10 + (a - 8)] = key_embed(val0[a] + val1[0], 255u, 255u - 16u * a);
        g3[0] = key_embed(val0[14] + val1[0], 255u, 255u - 16u * 14); g3[1] = key_embed(val0[15] + val1[0], 255u, 255u - 16u * 15);
#pragma unroll
        for (int i = 2; i < 16; ++i) g3[i] = -3.0e38f;
        sort16_desc(g1); sort16_desc(g2); sort16_desc(g3);
        merge_top16(g0, g1); merge_top16(g2, g3); merge_top16(g0, g2);
        float gate[16]; int eid[16];
        const float mx = __uint_as_float(__float_as_uint(g0[0]) & ~255u);
        float sum = 0.f;
#pragma unroll
        for (int i = 0; i < 16; ++i) {
            const unsigned key = __float_as_uint(g0[i]);
            gate[i] = __expf(__uint_as_float(key & ~255u) - mx); sum += gate[i];
            const unsigned id = 255u - (key & 255u);
            const unsigned n0 = *(const LAS unsigned char*)(myl + (id >> 4));
            const unsigned n1 = *(const LAS unsigned char*)(myl + 16 + (id & 15u));
            eid[i] = (int)(n0 * 128u + n1);
        }
        const float inv = 1.f / sum;
        const int h = k + 4 * hh;
        int* EI = (int*)(p.ws + OFF_EIDX) + (size_t)t * 128 + h * 16; float* EG = (float*)(p.ws + OFF_EGATE) + (size_t)t * 128 + h * 16;
#pragma unroll
        for (int q = 0; q < 4; ++q) {
            *reinterpret_cast<int4*>(EI + q * 4) = make_int4(eid[q * 4], eid[q * 4 + 1], eid[q * 4 + 2], eid[q * 4 + 3]);
            *reinterpret_cast<float4*>(EG + q * 4) = make_float4(gate[q * 4] * inv, gate[q * 4 + 1] * inv, gate[q * 4 + 2] * inv, gate[q * 4 + 3] * inv);
        }
    }
}

constexpr int LDS_BYTES = LDS_HDR + 3 * 48 * 1024;
__global__ void __launch_bounds__(NT, 2) mk_fwd(Params p) {
    extern __shared__ __attribute__((aligned(16))) unsigned char lds[];
    const int wv = __builtin_amdgcn_readfirstlane((int)(threadIdx.x >> 6));
    volatile LAS unsigned* st = (volatile LAS unsigned*)lds;
    if (threadIdx.x < 4) st[threadIdx.x] = 0u;
    __syncthreads();
    XcdBarrier xb = xcd_barrier_post((unsigned*)(p.ws + OFF_BAR), st);
    int bar_idx = 0;
#define GRID_BAR() do { xcd_barrier(xb); \
        if (PROBE_TS >= 0 && blockIdx.x == 0 && threadIdx.x == 0 && (bar_idx == PROBE_TS - 1 || bar_idx == PROBE_TS)) \
            ((volatile LAS unsigned long long*)(lds + 128))[bar_idx - (PROBE_TS - 1)] = __builtin_amdgcn_s_memrealtime(); \
        ++bar_idx; } while (0)
    if (PROBE_TS == 0 && blockIdx.x == 0 && threadIdx.x == 0) ((volatile LAS unsigned long long*)(lds + 128))[0] = __builtin_amdgcn_s_memrealtime();
    unsigned char* ws = p.ws;
    for (int rep = 0; rep < (PROBE_DUP == 1 ? 2 : 1); ++rep) {
    for (int l = 0; l < 2; ++l) {
        ph_transpose(p.in[I_WIN] + (size_t)l * D * INW, (bf16_t*)(ws + OFF_WIN) + (size_t)l * INW * D, D, INW, lds + LDS_HDR, wv);
        ph_transpose(p.in[I_WOUT] + (size_t)l * D * D, (bf16_t*)(ws + OFF_WOUT) + (size_t)l * D * D, D, D, lds + LDS_HDR, wv);
        ph_transpose(p.in[I_WQ] + (size_t)l * D * D, (bf16_t*)(ws + OFF_WQ) + (size_t)l * D * D, D, D, lds + LDS_HDR, wv);
    }
    ph_convert_i8_rows(p.in[I_PU], ws + OFF_UT, (float*)(ws + OFF_USC), 2 * NEXP, wv);
    ph_convert_i8_rows(p.in[I_PV], ws + OFF_VT, (float*)(ws + OFF_VSC), 2 * NEXP, wv);
    ph_convert(p.in[I_SUBK], (bf16_t*)(ws + OFF_SUBK), 2 * 2 * 128 * 64, wv);
    ph_convert(p.in[I_SGUW], (bf16_t*)(ws + OFF_SGUW), 2 * 4 * 128 * 128, wv);
    ph_mod(p, lds + LDS_HDR, wv);
    ph_rope_tab(p, wv);
    GRID_BAR();
    }
    for (int l = 0; l < 2; ++l) {
        for (int rep = 0; rep < (PROBE_DUP == 3 ? 2 : 1); ++rep) {
        ph_norm_mod(p, l, 0, l == 0 ? 1 : 0, wv);
        ph_cache_prep(p, l, wv);
        GRID_BAR();
        }
        for (int rep = 0; rep < (PROBE_DUP == 5 ? 2 : 1); ++rep) {
        gemm_phase<EPI_INPROJ>(p, l, (const bf16_t*)(ws + OFF_H), (const bf16_t*)(ws + OFF_WIN) + (size_t)l * INW * D, INW, lds + LDS_HDR, wv);
        GRID_BAR();
        }
        for (int rep = 0; rep < ((PROBE_DUP == 4 || (PROBE_DUP >= 10 && PROBE_DUP <= 12)) ? 2 : 1); ++rep) {
        ph_mixers(p, l + 2 * rep, lds + LDS_HDR, wv);
        GRID_BAR();
        }
        gemm_phase<EPI_WOUT>(p, l, (const bf16_t*)(ws + OFF_MIX), (const bf16_t*)(ws + OFF_WOUT) + (size_t)l * D * D, D, lds + LDS_HDR, wv);
        GRID_BAR();
        ph_norm_mod(p, l, 1, 0, wv);
        GRID_BAR();
        for (int rep = 0; rep < (PROBE_DUP == 7 ? 2 : 1); ++rep) {
        gemm_phase<EPI_WQ>(p, l, (const bf16_t*)(ws + OFF_H), (const bf16_t*)(ws + OFF_WQ) + (size_t)l * D * D, D, lds + LDS_HDR, wv);
        GRID_BAR();
        }
        if (PROBE_DUP == 8) { for (int rep = 0; rep < 10; ++rep) GRID_BAR(); }
        for (int rep = 0; rep < (PROBE_DUP == 2 ? 2 : 1); ++rep) {
        ph_peer_select(p, l, lds + LDS_HDR, wv);
        GRID_BAR();
        }
        ph_peer_sliced<false>(p, l, lds + LDS_HDR, wv);
        GRID_BAR();
        ph_peer_pairw(p, l, wv);
        GRID_BAR();
        ph_peer_sliced<true>(p, l, lds + LDS_HDR, wv);
        GRID_BAR();
    }
    ph_final_norm(p, wv);
    if (PROBE_TS >= 0 && blockIdx.x == 0 && threadIdx.x == 0) {
        asm volatile("s_waitcnt vmcnt(0)" ::: "memory");
        volatile LAS unsigned long long* tsl = (volatile LAS unsigned long long*)(lds + 128);
        p.out[0] += (float)(tsl[1] - tsl[0]) * 0.01f;
    }
}

extern "C" void kernel_launch(void* const* d_in, const int* in_sizes, int n_in,
                              void* d_out, int out_size, void* d_ws, size_t ws_size,
                              hipStream_t stream) {
    static int grid = 0;
    if (grid == 0) {
        if (ws_size < WS_NEED) { fprintf(stderr, "kernel_launch: workspace too small: %zu < %zu\n", ws_size, (size_t)WS_NEED); grid = -1; return; }
        int dev = 0, cus = 0, per_cu = 0;
        (void)hipGetDevice(&dev);
        (void)hipDeviceGetAttribute(&cus, hipDeviceAttributeMultiprocessorCount, dev);
        (void)hipFuncSetAttribute((const void*)mk_fwd, hipFuncAttributeMaxDynamicSharedMemorySize, LDS_BYTES);
        (void)hipOccupancyMaxActiveBlocksPerMultiprocessor(&per_cu, (const void*)mk_fwd, NT, LDS_BYTES);
        if (per_cu < 1) { fprintf(stderr, "kernel_launch: occupancy query reports %d blocks per CU\n", per_cu); grid = -1; return; }
        grid = cus;
    }
    if (grid < 0) return;
    (void)hipMemsetAsync((unsigned char*)d_ws + OFF_BAR, 0, 64 * 1024, stream);
    Params p{};
    for (int i = 0; i < 29; ++i) p.in[i] = (const float*)d_in[i];
    p.out = (float*)d_out; p.ws = (unsigned char*)d_ws;
    void* args[] = {&p};
    hipError_t e = hipLaunchCooperativeKernel((const void*)mk_fwd, dim3(grid), dim3(NT), args, LDS_BYTES, stream);
    if (e != hipSuccess) fprintf(stderr, "kernel_launch: cooperative launch failed: %s (grid %d)\n", hipGetErrorString(e), grid);
}
```

```cpp
#include <hip/hip_runtime.h>
#include <hip/hip_bf16.h>
#include <cstdio>
#include <cstdint>
#include <hip/hip_cooperative_groups.h>
namespace cg = cooperative_groups;

#define PROBE_DUP 0
#define PROBE_TS -1
typedef unsigned short bf16_t;
using bf16x8 = __attribute__((ext_vector_type(8))) short;
using f32x4  = __attribute__((ext_vector_type(4))) float;
using f32x16 = __attribute__((ext_vector_type(16))) float;
using f32x2  = __attribute__((ext_vector_type(2))) float;
using u32x4  = __attribute__((ext_vector_type(4))) unsigned;
using s16x4  = __attribute__((ext_vector_type(4))) short;

constexpr int D      = 1024;
constexpr int NTOK   = 16384;
constexpr int NPT    = 8192;
constexpr int SEQ    = 256;
constexpr int DSEQ   = 2048;
constexpr int PAST   = 512;
constexpr int NKS    = DSEQ + PAST;
constexpr int INW    = 2048;
constexpr int NEXP   = 16384;
constexpr float EPS  = 1e-6f;

constexpr size_t MB = 1024 * 1024;
constexpr size_t OFF_BAR   = 0;
constexpr size_t OFF_MOD   = 64 * 1024;
constexpr size_t OFF_ROPE  = OFF_MOD + 256 * 1024;
constexpr size_t OFF_SUBK  = OFF_ROPE + 1 * MB;
constexpr size_t OFF_SGUW  = OFF_SUBK + 64 * 1024;
constexpr size_t OFF_WIN   = OFF_SGUW + 256 * 1024;
constexpr size_t OFF_WOUT  = OFF_WIN + 8 * MB;
constexpr size_t OFF_WQ    = OFF_WOUT + 4 * MB;
constexpr size_t OFF_UT    = OFF_WQ + 4 * MB;
constexpr size_t OFF_USC   = OFF_UT + 32 * MB;
constexpr size_t OFF_VT    = OFF_UT + 64 * MB;
constexpr size_t OFF_VSC   = OFF_VT + 32 * MB;
constexpr size_t OFF_H     = OFF_VT + 64 * MB;
constexpr size_t OFF_XC    = OFF_H + 32 * MB;
constexpr size_t OFF_R1    = OFF_XC + 64 * MB;
constexpr size_t OFF_AU    = OFF_R1;
constexpr size_t OFF_AV    = OFF_AU + 8 * MB;
constexpr size_t OFF_AVN   = OFF_AV + 8 * MB;
constexpr size_t OFF_DQ    = OFF_AVN + 8 * MB;
constexpr size_t OFF_DKP   = OFF_DQ + 8 * MB;
constexpr size_t OFF_DKS   = OFF_DKP + 4 * MB;
constexpr size_t OFF_DVTP  = OFF_DKS + 5 * MB;
constexpr size_t OFF_DVTS  = OFF_DVTP + 4 * MB;
constexpr size_t OFF_GQ    = OFF_DVTS + 5 * MB;
constexpr size_t OFF_GKP   = OFF_GQ + 16 * MB;
constexpr size_t OFF_GKS   = OFF_GKP + 2 * MB;
constexpr size_t OFF_GVTP  = OFF_GKS + 3 * MB;
constexpr size_t OFF_GVTS  = OFF_GVTP + 2 * MB;
constexpr size_t OFF_MIX   = OFF_GVTS + 3 * MB;
constexpr size_t OFF_R1END = OFF_MIX + 32 * MB;
constexpr size_t OFF_Q     = OFF_R1;
constexpr size_t OFF_EIDX  = OFF_Q + 32 * MB;
constexpr size_t OFF_EGATE = OFF_EIDX + 8 * MB;
constexpr size_t OFF_TOPV  = OFF_EGATE + 8 * MB;
constexpr size_t OFF_TOPI  = OFF_TOPV + 16 * MB;
static_assert(OFF_TOPI + 16 * MB <= OFF_R1END, "peer buffers must fit region 1");
constexpr size_t OFF_PROJ  = OFF_R1END;
constexpr size_t OFF_PART  = OFF_PROJ;
constexpr size_t OFF_WPAIR = OFF_PART + 64 * MB;
constexpr size_t OFF_H8I   = OFF_WPAIR + 8 * MB;
constexpr size_t OFF_HSC   = OFF_H8I + 16 * MB;
constexpr size_t OFF_WSC   = OFF_HSC + 64 * 1024;
constexpr size_t WS_NEED   = OFF_PROJ + 128 * MB;
static_assert(WS_NEED <= 512 * MB, "workspace budget");

constexpr size_t OUT_YP  = 0;
constexpr size_t OUT_YS  = 8388608;
constexpr size_t OUT_NDK = 16777216;
constexpr size_t OUT_NDV = OUT_NDK + 4194304;
constexpr size_t OUT_NGK = OUT_NDV + 4194304;
constexpr size_t OUT_NGV = OUT_NGK + 2097152;

struct Params {
    const float* in[29];
    float* out;
    unsigned char* ws;
};
enum { I_XP = 0, I_XS, I_CDK, I_CDV, I_CGK, I_CGV, I_C, I_CCTX, I_ADAW, I_ADAB, I_N1G, I_N2G, I_WIN, I_SGUNG, I_SGUW, I_SGUB,
       I_LQ1, I_LK1, I_LQ2, I_LK2, I_SUBLN, I_QNG, I_KNG, I_WOUT, I_WQ, I_SUBK, I_PU, I_PV, I_FG };

typedef __bf16 hwbf2 __attribute__((ext_vector_type(2)));
__device__ __forceinline__ unsigned pack_bf2(float a, float b) {
    const f32x2 v = {a, b};
    return __builtin_bit_cast(unsigned, __builtin_convertvector(v, hwbf2));
}
__device__ __forceinline__ bf16_t f2bf(float f) { return (bf16_t)(pack_bf2(f, 0.f) & 0xffffu); }
__device__ __forceinline__ float bf2f(bf16_t h) { return __uint_as_float(((unsigned)h) << 16); }
__device__ __forceinline__ float gelu_f(float x) {
    const float k2 = 2.f * 0.7978845608028654f * 1.4426950408889634f;
    const float e = __builtin_amdgcn_exp2f(k2 * (x + 0.044715f * x * x * x));
    return x - x * __builtin_amdgcn_rcpf(e + 1.f);
}
__device__ __forceinline__ int lane_id() { return (int)__builtin_amdgcn_mbcnt_hi(~0u, __builtin_amdgcn_mbcnt_lo(~0u, 0u)); }
__device__ __forceinline__ int lane_id_op() { int l = lane_id(); asm volatile("" : "+v"(l)); return l; }
__device__ __forceinline__ float shfl_i(float v, int src) { return __builtin_bit_cast(float, __builtin_amdgcn_ds_bpermute(src << 2, __builtin_bit_cast(int, v))); }
__device__ __forceinline__ int shfl_i(int v, int src) { return __builtin_amdgcn_ds_bpermute(src << 2, v); }
__device__ __forceinline__ float shfl_x(float v, int lane, int m) { return shfl_i(v, lane ^ m); }
__device__ __forceinline__ int shfl_x(int v, int lane, int m) { return shfl_i(v, lane ^ m); }
__device__ __forceinline__ int q8(float x) { return (int)fminf(fmaxf(rintf(x), -127.f), 127.f); }
__device__ __forceinline__ unsigned pack4_i8(int a, int b, int c, int d) { return (unsigned)(a & 255) | ((unsigned)(b & 255) << 8) | ((unsigned)(c & 255) << 16) | ((unsigned)d << 24); }
__device__ __forceinline__ float wave_sum(float v) {
    const int ln = lane_id_op();
#pragma unroll
    for (int o = 32; o >= 1; o >>= 1) v += shfl_x(v, ln, o);
    return v;
}
__device__ __forceinline__ int tok_cv(int t) { return t < NPT ? 0 : 1 + ((t - NPT) >> 11); }
__device__ __forceinline__ const float* x_in_row(const Params& p, int t) {
    return t < NPT ? p.in[I_XP] + (size_t)t * D : p.in[I_XS] + (size_t)(t - NPT) * D;
}
__device__ __forceinline__ float lam_init_of(int l) { return l == 0 ? 0.2f : (0.8f - 0.6f * 0.7408182206817179f); }
__device__ __forceinline__ float lam_of(const Params& p, int l) {
    float s1 = 0.f, s2 = 0.f;
    for (int i = 0; i < 32; ++i) {
        s1 += p.in[I_LQ1][l * 32 + i] * p.in[I_LK1][l * 32 + i];
        s2 += p.in[I_LQ2][l * 32 + i] * p.in[I_LK2][l * 32 + i];
    }
    return expf(s1) - expf(s2) + lam_init_of(l);
}


#define XB_TMO      128
#define XB_XCNT(j)  (256  + 64 * (j))
#define XB_XSUB(j)  (1280 + 64 * (j))
#define XB_XGEN(j)  (2304 + 64 * (j))
#define XB_TOP      3328
#define XB_TOPGEN   3392
#define XCD_BAR_WORDS 3456
#define XB_SPIN_CAP (1u << 20)
#define LAS __attribute__((address_space(3)))
__device__ __forceinline__ unsigned xb_ld(unsigned* p)              { return __hip_atomic_load(p, __ATOMIC_RELAXED, __HIP_MEMORY_SCOPE_AGENT); }
__device__ __forceinline__ unsigned xb_add(unsigned* p, unsigned v) { return __hip_atomic_fetch_add(p, v, __ATOMIC_RELAXED, __HIP_MEMORY_SCOPE_AGENT); }
__device__ __forceinline__ unsigned xb_xcc_id() { return (unsigned)__builtin_amdgcn_s_getreg((3 << 11) | 20) & 0xFu; }
#define XB_SPIN(cond, bar) do { unsigned _sp = 0; while (cond) { __builtin_amdgcn_s_sleep(1); \
    if ((++_sp & 255u) == 0u) { if (xb_ld(&(bar)[XB_TMO])) break; if (_sp > XB_SPIN_CAP) { atomicAdd(&(bar)[XB_TMO], 1u); break; } } } } while (0)
struct XcdBarrier { unsigned* bar; unsigned x; volatile LAS unsigned* st; };
__device__ __forceinline__ XcdBarrier xcd_barrier_post(unsigned* bar, volatile LAS unsigned* st) {
    XcdBarrier b; b.bar = bar; b.x = xb_xcc_id(); b.st = st;
    if (threadIdx.x == 0) (void)xb_add(&bar[XB_XCNT(b.x)], 1u);
    return b;
}
__device__ __forceinline__ void xcd_barrier_complete(unsigned* bar, unsigned x, unsigned& nloc, unsigned& nx) {
    const unsigned G = gridDim.x * gridDim.y * gridDim.z;
    unsigned sum, cnt, mine, sp = 0u;
    for (;;) {
        sum = 0u; cnt = 0u; mine = 0u;
#pragma unroll
        for (unsigned j = 0; j < 16; ++j) { const unsigned c = xb_ld(&bar[XB_XCNT(j)]); sum += c; cnt += (c > 0u) ? 1u : 0u; mine = (j == x) ? c : mine; }
        if (sum == G) break;
        __builtin_amdgcn_s_sleep(1);
        if ((++sp & 255u) == 0u) { if (xb_ld(&bar[XB_TMO])) break; if (sp > XB_SPIN_CAP) { atomicAdd(&bar[XB_TMO], 1u); break; } }
    }
    nloc = mine > 0u ? mine : 1u; nx = cnt > 0u ? cnt : 1u;
}
__device__ __forceinline__ void xcd_barrier(const XcdBarrier& b) {
    asm volatile("s_waitcnt vmcnt(0)" ::: "memory");
    __syncthreads();
    if (threadIdx.x == 0) {
        unsigned* bar = b.bar;
        const unsigned bx = xb_xcc_id();
        __builtin_amdgcn_s_waitcnt(0);
        unsigned nloc = b.st[0], nx = b.st[1];
        if (nloc == 0u) { xcd_barrier_complete(bar, bx, nloc, nx); b.st[0] = nloc; b.st[1] = nx; }
        const unsigned old = xb_add(&bar[XB_XSUB(bx)], 1u);
        const unsigned gen = old / nloc;
        if (old + 1u == (gen + 1u) * nloc) {
            __builtin_amdgcn_fence(__ATOMIC_RELEASE, "agent");
            asm volatile("s_waitcnt vmcnt(0)" ::: "memory");
            const unsigned og = xb_add(&bar[XB_TOP], 1u);
            const unsigned tg = og / nx;
            if (og + 1u == (tg + 1u) * nx) xb_add(&bar[XB_TOPGEN], 1u);
            else XB_SPIN(xb_ld(&bar[XB_TOPGEN]) == tg, bar);
            __builtin_amdgcn_fence(__ATOMIC_ACQUIRE, "agent");
            xb_add(&bar[XB_XGEN(bx)], 1u);
            asm volatile("s_waitcnt vmcnt(0)" ::: "memory");
        } else {
            XB_SPIN(xb_ld(&bar[XB_XGEN(bx)]) == gen, bar);
            __builtin_amdgcn_fence(__ATOMIC_ACQUIRE, "agent");
            asm volatile("s_waitcnt vmcnt(0)" ::: "memory");
        }
    }
    __syncthreads();
}

constexpr int NT = 512;
constexpr int LDS_HDR = 1024;
#define GTID ((size_t)blockIdx.x * NT + tid)
__device__ __forceinline__ int opaque_tid(int wv) { int t = (wv << 6) | lane_id(); asm volatile("" : "+v"(t)); return t; }
#define GNT  ((size_t)gridDim.x * NT)

__device__ void ph_transpose(const float* __restrict__ W, bf16_t* __restrict__ Wt, int K, int N, unsigned char* ldsraw, const int wv) {
    const int tid = opaque_tid(wv);
    LAS bf16_t* T = (LAS bf16_t*)ldsraw;
    const int tk = K / 128, tn = N / 64, ntiles = tk * tn;
    for (int tile = blockIdx.x; tile < ntiles; tile += gridDim.x) {
        const int k0 = (tile % tk) * 128, n0 = (tile / tk) * 64;
#pragma unroll 4
        for (int i = 0; i < 16; ++i) {
            const int kl = i * 8 + (tid >> 6), nl = tid & 63;
            T[nl * 130 + kl] = f2bf(W[(size_t)(k0 + kl) * N + n0 + nl]);
        }
        __syncthreads();
        {
            const int nl = tid >> 3, kc = tid & 7;
            unsigned w[8];
#pragma unroll
            for (int i = 0; i < 8; ++i) w[i] = (unsigned)T[nl * 130 + kc * 16 + 2 * i] | ((unsigned)T[nl * 130 + kc * 16 + 2 * i + 1] << 16);
            bf16_t* dst = Wt + (size_t)(n0 + nl) * K + k0 + kc * 16;
            *reinterpret_cast<u32x4*>(dst) = u32x4{w[0], w[1], w[2], w[3]};
            *reinterpret_cast<u32x4*>(dst + 8) = u32x4{w[4], w[5], w[6], w[7]};
        }
        __syncthreads();
    }
}
__device__ void ph_convert(const float* __restrict__ src, bf16_t* __restrict__ dst, size_t n, const int wv) {
    const int tid = opaque_tid(wv);
    for (size_t idx = GTID; idx < n; idx += GNT) dst[idx] = f2bf(src[idx]);
}
__device__ void ph_convert_i8_rows(const float* __restrict__ src, unsigned char* __restrict__ dst, float* __restrict__ scl, int nrows, const int wv) {
    const int tid = opaque_tid(wv);
    const int lane = tid & 63;
    const int gw = blockIdx.x * 8 + (tid >> 6), nw = gridDim.x * 8;
    for (int row0 = gw * 4; row0 < nrows; row0 += nw * 4) {
        float4 f[4][4];
#pragma unroll
        for (int q = 0; q < 4; ++q)
#pragma unroll
            for (int i = 0; i < 4; ++i) f[q][i] = *reinterpret_cast<const float4*>(src + (size_t)(row0 + q) * D + lane * 16 + i * 4);
#pragma unroll
        for (int q = 0; q < 4; ++q) {
            const int row = row0 + q;
            float v[16];
#pragma unroll
            for (int i = 0; i < 4; ++i) { v[i * 4] = f[q][i].x; v[i * 4 + 1] = f[q][i].y; v[i * 4 + 2] = f[q][i].z; v[i * 4 + 3] = f[q][i].w; }
            float am = 0.f;
#pragma unroll
            for (int i = 0; i < 16; ++i) am = fmaxf(am, fabsf(v[i]));
#pragma unroll
            for (int o = 32; o >= 1; o >>= 1) am = fmaxf(am, shfl_x(am, lane, o));
            const float sc = am > 0.f ? 127.f / am : 1.f;
            unsigned w[4];
#pragma unroll
            for (int i = 0; i < 4; ++i) w[i] = pack4_i8(q8(v[i * 4] * sc), q8(v[i * 4 + 1] * sc), q8(v[i * 4 + 2] * sc), q8(v[i * 4 + 3] * sc));
            {
                const int lyr = row >> 14, e = row & (NEXP - 1);
                *reinterpret_cast<u32x4*>(dst + (((size_t)lyr * 8 + (lane >> 3)) * NEXP + e) * 128 + (lane & 7) * 16) = u32x4{w[0], w[1], w[2], w[3]};
            }
            if (lane == 0) scl[row] = am > 0.f ? am * (1.f / 127.f) : 1.f;
        }
    }
}
__device__ void ph_mod(const Params& p, unsigned char* ldsraw, const int wv) {
    const int tid = opaque_tid(wv);
    LAS float* sl = (LAS float*)ldsraw;
    LAS float* red = sl + 5 * 1024;
    for (int i = tid; i < 5 * 1024; i += NT) {
        const int cv = i >> 10, k = i & 1023;
        const float c = cv == 0 ? p.in[I_CCTX][k] : p.in[I_C][(size_t)(cv - 1) * D + k];
        sl[i] = c / (1.f + __expf(-c));
    }
    __syncthreads();
    const int c = tid & 63, ks = tid >> 6;
    for (int item = blockIdx.x; item < 2 * 96; item += gridDim.x) {
        const int l = item / 96, j = (item % 96) * 64 + c;
        const float* W = p.in[I_ADAW] + (size_t)l * D * 6144 + (size_t)(ks * 128) * 6144 + j;
        float acc[5] = {0.f, 0.f, 0.f, 0.f, 0.f};
#pragma unroll 8
        for (int k = 0; k < 128; ++k) {
            const float w = W[(size_t)k * 6144];
#pragma unroll
            for (int cv = 0; cv < 5; ++cv) acc[cv] += sl[cv * 1024 + ks * 128 + k] * w;
        }
#pragma unroll
        for (int cv = 0; cv < 5; ++cv) red[(ks * 5 + cv) * 64 + c] = acc[cv];
        __syncthreads();
        if (tid < 320) {
            const int cv = tid >> 6;
            float sum = p.in[I_ADAB][l * 6144 + j];
#pragma unroll
            for (int q = 0; q < 8; ++q) sum += red[(q * 5 + cv) * 64 + c];
            ((float*)(p.ws + OFF_MOD))[(size_t)(l * 5 + cv) * 6144 + j] = sum;
        }
        __syncthreads();
    }
}
__device__ void ph_rope_tab(const Params& p, const int wv) {
    const int tid = opaque_tid(wv);
    for (size_t idx = GTID; idx < 2048 * 48; idx += GNT) {
        int s = idx / 48, i = idx % 48;
        float* R = (float*)(p.ws + OFF_ROPE);
        double row = (double)(s / 64), col = (double)(s % 64);
        if (i < 16) {
            int q = i & 7; double inv = pow(10000.0, -(double)q / 8.0);
            double ang = (i < 8 ? row : col) * inv;
            R[s * 16 + i] = (float)cos(ang); R[2048 * 16 + s * 16 + i] = (float)sin(ang);
        } else {
            int ii = i - 16; int q = ii & 15; double inv = pow(10000.0, -(double)q / 16.0);
            double ang = (ii < 16 ? row : col) * inv;
            R[2048 * 32 + s * 32 + ii] = (float)cos(ang); R[2048 * 64 + s * 32 + ii] = (float)sin(ang);
        }
    }
}
__device__ void ph_cache_prep(const Params& p, int l, const int wv) {
    const int tid = opaque_tid(wv);
    bf16_t* DKS = (bf16_t*)(p.ws + OFF_DKS); bf16_t* DVTS = (bf16_t*)(p.ws + OFF_DVTS);
    bf16_t* GKS = (bf16_t*)(p.ws + OFF_GKS); bf16_t* GVTS = (bf16_t*)(p.ws + OFF_GVTS);
    for (size_t idx = GTID; idx < 4 * 512 * 256; idx += GNT) {
        int c = idx & 255, pp = (idx >> 8) & 511, b = idx >> 17;
        size_t src = (((size_t)b * 2 + l) * PAST + pp) * 256 + c;
        int h = c >> 6, r = c & 63;
        DKS[(((size_t)b * 4 + h) * NKS + DSEQ + pp) * 64 + r] = f2bf(p.in[I_CDK][src]);
        DVTS[(((size_t)b * 4 + h) * 64 + r) * NKS + DSEQ + pp] = f2bf(p.in[I_CDV][src]);
        if (c < 128) {
            size_t src2 = (((size_t)b * 2 + l) * PAST + pp) * 128 + c;
            int kv = c >> 6;
            GKS[(((size_t)b * 2 + kv) * NKS + DSEQ + pp) * 64 + r] = f2bf(p.in[I_CGK][src2]);
            GVTS[(((size_t)b * 2 + kv) * 64 + r) * NKS + DSEQ + pp] = f2bf(p.in[I_CGV][src2]);
        }
    }
}
__device__ void ph_norm_mod(const Params& p, int l, int which, int from_input, const int wv) {
    const int tid = opaque_tid(wv);
    const int lane = tid & 63;
    const int gw = blockIdx.x * 8 + (tid >> 6), nw = gridDim.x * 8;
    const float* g = p.in[which ? I_N2G : I_N1G] + l * D;
    if (from_input) {
        float4 nx[4];
        {
            const int t = gw < NTOK ? gw : NTOK - 1;
            const float* xr = x_in_row(p, t);
#pragma unroll
            for (int i = 0; i < 4; ++i) nx[i] = *reinterpret_cast<const float4*>(xr + i * 256 + lane * 4);
        }
        for (int t = gw; t < NTOK; t += nw) {
            float4 v[4];
#pragma unroll
            for (int i = 0; i < 4; ++i) v[i] = nx[i];
            {
                const int tn = t + nw < NTOK ? t + nw : t;
                const float* xn = x_in_row(p, tn);
#pragma unroll
                for (int i = 0; i < 4; ++i) nx[i] = *reinterpret_cast<const float4*>(xn + i * 256 + lane * 4);
            }
            const float* mod = (const float*)(p.ws + OFF_MOD) + (size_t)(l * 5 + tok_cv(t)) * 6144 + which * 3072;
            float ss = 0.f;
#pragma unroll
            for (int i = 0; i < 4; ++i) ss += v[i].x * v[i].x + v[i].y * v[i].y + v[i].z * v[i].z + v[i].w * v[i].w;
            ss = wave_sum(ss);
            float r = rsqrtf(ss / D + EPS);
            bf16_t* H = (bf16_t*)(p.ws + OFF_H) + (size_t)t * D;
#pragma unroll
            for (int i = 0; i < 4; ++i) {
                int c = i * 256 + lane * 4;
                float4 gg = *reinterpret_cast<const float4*>(g + c), sh = *reinterpret_cast<const float4*>(mod + c), sc = *reinterpret_cast<const float4*>(mod + 1024 + c);
                uint2 o;
                o.x = pack_bf2(v[i].x * r * gg.x * (1.f + sc.x) + sh.x, v[i].y * r * gg.y * (1.f + sc.y) + sh.y);
                o.y = pack_bf2(v[i].z * r * gg.z * (1.f + sc.z) + sh.z, v[i].w * r * gg.w * (1.f + sc.w) + sh.w);
                *reinterpret_cast<uint2*>(H + c) = o;
            }
        }
    } else {
        u32x4 nx[2];
        {
            const int t = gw < NTOK ? gw : NTOK - 1;
            const bf16_t* xr = (const bf16_t*)(p.ws + OFF_XC) + (size_t)t * D + lane * 8;
            nx[0] = *reinterpret_cast<const u32x4*>(xr); nx[1] = *reinterpret_cast<const u32x4*>(xr + 512);
        }
        for (int t = gw; t < NTOK; t += nw) {
            float v[16];
#pragma unroll
            for (int h = 0; h < 2; ++h)
#pragma unroll
                for (int k = 0; k < 4; ++k) { v[h * 8 + 2 * k] = __uint_as_float(nx[h][k] << 16); v[h * 8 + 2 * k + 1] = __uint_as_float(nx[h][k] & 0xffff0000u); }
            {
                const int tn = t + nw < NTOK ? t + nw : t;
                const bf16_t* xn = (const bf16_t*)(p.ws + OFF_XC) + (size_t)tn * D + lane * 8;
                nx[0] = *reinterpret_cast<const u32x4*>(xn); nx[1] = *reinterpret_cast<const u32x4*>(xn + 512);
            }
            const float* mod = (const float*)(p.ws + OFF_MOD) + (size_t)(l * 5 + tok_cv(t)) * 6144 + which * 3072;
            float ss = 0.f;
#pragma unroll
            for (int i = 0; i < 16; ++i) ss += v[i] * v[i];
            ss = wave_sum(ss);
            float r = rsqrtf(ss / D + EPS);
            bf16_t* H = (bf16_t*)(p.ws + OFF_H) + (size_t)t * D;
            float hq[16];
#pragma unroll
            for (int h = 0; h < 2; ++h) {
                const int c = h * 512 + lane * 8;
                float o[8];
#pragma unroll
                for (int q = 0; q < 2; ++q) {
                    const float4 gg = *reinterpret_cast<const float4*>(g + c + q * 4), sh = *reinterpret_cast<const float4*>(mod + c + q * 4), sc = *reinterpret_cast<const float4*>(mod + 1024 + c + q * 4);
                    o[q * 4] = v[h * 8 + q * 4] * r * gg.x * (1.f + sc.x) + sh.x; o[q * 4 + 1] = v[h * 8 + q * 4 + 1] * r * gg.y * (1.f + sc.y) + sh.y;
                    o[q * 4 + 2] = v[h * 8 + q * 4 + 2] * r * gg.z * (1.f + sc.z) + sh.z; o[q * 4 + 3] = v[h * 8 + q * 4 + 3] * r * gg.w * (1.f + sc.w) + sh.w;
                }
                *reinterpret_cast<u32x4*>(H + c) = u32x4{pack_bf2(o[0], o[1]), pack_bf2(o[2], o[3]), pack_bf2(o[4], o[5]), pack_bf2(o[6], o[7])};
#pragma unroll
                for (int q = 0; q < 8; ++q) hq[h * 8 + q] = o[q];
            }
            if (which) {
                float am = 0.f;
#pragma unroll
                for (int i = 0; i < 16; ++i) am = fmaxf(am, fabsf(hq[i]));
#pragma unroll
                for (int o2 = 32; o2 >= 1; o2 >>= 1) am = fmaxf(am, shfl_x(am, lane, o2));
                const float sc8 = am > 0.f ? 127.f / am : 1.f;
#pragma unroll
                for (int h = 0; h < 2; ++h) {
                    uint2 w;
                    w.x = pack4_i8(q8(hq[h * 8] * sc8), q8(hq[h * 8 + 1] * sc8), q8(hq[h * 8 + 2] * sc8), q8(hq[h * 8 + 3] * sc8));
                    w.y = pack4_i8(q8(hq[h * 8 + 4] * sc8), q8(hq[h * 8 + 5] * sc8), q8(hq[h * 8 + 6] * sc8), q8(hq[h * 8 + 7] * sc8));
                    *reinterpret_cast<uint2*>(p.ws + OFF_H8I + (size_t)t * D + h * 512 + lane * 8) = w;
                }
                if (lane == 0) ((float*)(p.ws + OFF_HSC))[t] = am > 0.f ? am * (1.f / 127.f) : 1.f;
            }
        }
    }
}
__device__ void ph_sgu_norm(const Params& p, int l, const int wv) {
    const int tid = opaque_tid(wv);
    const int lane = tid & 63;
    const int gw = blockIdx.x * 8 + (tid >> 6), nw = gridDim.x * 8;
    for (int t = gw; t < NTOK; t += nw) {
        const bf16_t* AV = (const bf16_t*)(p.ws + OFF_AV) + (size_t)t * 256;
        float v[4]; float ss = 0.f;
#pragma unroll
        for (int i = 0; i < 4; ++i) { v[i] = bf2f(AV[i * 64 + lane]); ss += v[i] * v[i]; }
        ss = wave_sum(ss);
        float r = rsqrtf(ss / 256.f + EPS);
#pragma unroll
        for (int i = 0; i < 4; ++i) ((bf16_t*)(p.ws + OFF_AVN))[(size_t)t * 256 + i * 64 + lane] = f2bf(v[i] * r * p.in[I_SGUNG][l * 256 + i * 64 + lane]);
    }
}
__device__ void ph_sgu_mix(const Params& p, int l, const int wv) {
    const int tid = opaque_tid(wv);
    const bf16_t* AVN = (const bf16_t*)(p.ws + OFF_AVN);
    for (size_t idx = GTID; idx < (size_t)NTOK * 256; idx += GNT) {
        int t = (int)(idx >> 8), c = (int)(idx & 255);
        int t0 = t & ~127, pp = t & 127, g = c >> 6;
        const bf16_t* W = (const bf16_t*)(p.ws + OFF_SGUW) + (((size_t)l * 4 + g) * 128 + pp) * 128;
        float acc = 0.f;
        for (int q = 0; q < 128; ++q) acc += bf2f(W[q]) * bf2f(AVN[(size_t)(t0 + q) * 256 + c]);
        acc += p.in[I_SGUB][(l * 4 + g) * 128 + pp];
        float au = bf2f(((const bf16_t*)(p.ws + OFF_AU))[(size_t)t * 256 + c]);
        ((bf16_t*)(p.ws + OFF_MIX))[(size_t)t * D + c] = f2bf(au * acc);
    }
}
__device__ void ph_attn_ref(const Params& p, int l, const int wv) {
    const int tid = opaque_tid(wv);
    const int lane = tid & 63;
    const int gw = blockIdx.x * 8 + (tid >> 6), nw = gridDim.x * 8;
    const float lam = lam_of(p, l);
    for (int item = gw; item < NTOK * 12; item += nw) {
        const int t = item % NTOK, hh = item / NTOK;
        const bool prompt = t < NPT;
        const int b = prompt ? t / SEQ : (t - NPT) / DSEQ;
        const int nk = prompt ? SEQ : NKS;
        if (hh < 4) {
            const int h = hh;
            const bf16_t* K = prompt ? (const bf16_t*)(p.ws + OFF_DKP) + ((size_t)b * 4 + h) * SEQ * 64 : (const bf16_t*)(p.ws + OFF_DKS) + ((size_t)b * 4 + h) * NKS * 64;
            const bf16_t* Vt = prompt ? (const bf16_t*)(p.ws + OFF_DVTP) + ((size_t)b * 4 + h) * 64 * SEQ : (const bf16_t*)(p.ws + OFF_DVTS) + ((size_t)b * 4 + h) * 64 * NKS;
            float q = bf2f(((const bf16_t*)(p.ws + OFF_DQ))[(size_t)t * 256 + h * 64 + lane]);
            const float scale = 0.17677669529663687f;
            float m0 = -1e30f, m1 = -1e30f, l0 = 0.f, l1 = 0.f, a0 = 0.f, a1 = 0.f;
            for (int k = 0; k < nk; ++k) {
                float pr = q * bf2f(K[(size_t)k * 64 + lane]);
#pragma unroll
                for (int o = 16; o >= 1; o >>= 1) pr += shfl_x(pr, lane, o);
                float s0 = shfl_i(pr, 0) * scale, s1 = shfl_i(pr, 32) * scale;
                float v = bf2f(Vt[(size_t)lane * nk + k]);
                float mn0 = fmaxf(m0, s0), mn1 = fmaxf(m1, s1);
                float c0 = expf(m0 - mn0), c1 = expf(m1 - mn1);
                float e0 = expf(s0 - mn0), e1 = expf(s1 - mn1);
                l0 = l0 * c0 + e0; l1 = l1 * c1 + e1;
                a0 = a0 * c0 + e0 * v; a1 = a1 * c1 + e1 * v;
                m0 = mn0; m1 = mn1;
            }
            float o = a0 / l0 - lam * a1 / l1;
            float ss = wave_sum(o * o);
            float r = rsqrtf(ss / 64.f + EPS);
            o = o * r * p.in[I_SUBLN][l * 64 + lane] * (1.f - lam_init_of(l));
            ((bf16_t*)(p.ws + OFF_MIX))[(size_t)t * D + 256 + h * 64 + lane] = f2bf(o);
        } else {
            const int hq = hh - 4, kv = hq >> 2;
            const bf16_t* K = prompt ? (const bf16_t*)(p.ws + OFF_GKP) + ((size_t)b * 2 + kv) * SEQ * 64 : (const bf16_t*)(p.ws + OFF_GKS) + ((size_t)b * 2 + kv) * NKS * 64;
            const bf16_t* Vt = prompt ? (const bf16_t*)(p.ws + OFF_GVTP) + ((size_t)b * 2 + kv) * 64 * SEQ : (const bf16_t*)(p.ws + OFF_GVTS) + ((size_t)b * 2 + kv) * 64 * NKS;
            float q = bf2f(((const bf16_t*)(p.ws + OFF_GQ))[(size_t)t * 512 + hq * 64 + lane]);
            float m = -1e30f, ls = 0.f, a = 0.f;
            for (int k = 0; k < nk; ++k) {
                float s = wave_sum(q * bf2f(K[(size_t)k * 64 + lane])) * 0.125f;
                float v = bf2f(Vt[(size_t)lane * nk + k]);
                float mn = fmaxf(m, s);
                float c = expf(m - mn), e = expf(s - mn);
                ls = ls * c + e; a = a * c + e * v; m = mn;
            }
            ((bf16_t*)(p.ws + OFF_MIX))[(size_t)t * D + 512 + hq * 64 + lane] = f2bf(a / ls);
        }
    }
}
__device__ void ph_peer_scores(const Params& p, int l, const int wv) {
    const int tid = opaque_tid(wv);
    const bf16_t* SK = (const bf16_t*)(p.ws + OFF_SUBK) + (size_t)l * 2 * 128 * 64;
    for (size_t idx = GTID; idx < (size_t)NTOK * 2048; idx += GNT) {
        int t = (int)(idx >> 11), o = (int)(idx & 2047);
        const bf16_t* Q = (const bf16_t*)(p.ws + OFF_Q) + (size_t)t * D;
        int n = o & 127, x = (o >> 7) & 1, h = o >> 8;
        float acc = 0.f;
        for (int k = 0; k < 64; ++k) acc += bf2f(Q[h * 128 + x * 64 + k]) * bf2f(SK[((size_t)x * 128 + n) * 64 + k]);
        ((float*)(p.ws + OFF_PROJ))[idx] = acc;
    }
}
__device__ void ph_peer_top1(const Params& p, const int wv) {
    const int tid = opaque_tid(wv);
    for (size_t idx = GTID; idx < (size_t)NTOK * 16; idx += GNT) {
        const float* SC = (const float*)(p.ws + OFF_PROJ) + idx * 128;
        float* TV = (float*)(p.ws + OFF_TOPV) + idx * 16; int* TI = (int*)(p.ws + OFF_TOPI) + idx * 16;
        float pv = 3.0e38f; int pi = -1;
        for (int r = 0; r < 16; ++r) {
            float bv = -3.0e38f; int bi = -1;
            for (int n = 0; n < 128; ++n) {
                float v = SC[n];
                bool after = (v < pv) || (v == pv && n > pi);
                if (after && (bi < 0 || v > bv)) { bv = v; bi = n; }
            }
            TV[r] = bv; TI[r] = bi; pv = bv; pi = bi;
        }
    }
}
__device__ void ph_peer_top2(const Params& p, const int wv) {
    const int tid = opaque_tid(wv);
    for (size_t idx = GTID; idx < (size_t)NTOK * 8; idx += GNT) {
        const float* TV = (const float*)(p.ws + OFF_TOPV) + idx * 32; const int* TI = (const int*)(p.ws + OFF_TOPI) + idx * 32;
        int* EI = (int*)(p.ws + OFF_EIDX) + idx * 16; float* EG = (float*)(p.ws + OFF_EGATE) + idx * 16;
        float pv = 3.0e38f; int pi = -1; float mx = 0.f, sum = 0.f;
        for (int r = 0; r < 16; ++r) {
            float bv = -3.0e38f; int bi = -1;
            for (int n = 0; n < 256; ++n) {
                float v = TV[n >> 4] + TV[16 + (n & 15)];
                bool after = (v < pv) || (v == pv && n > pi);
                if (after && (bi < 0 || v > bv)) { bv = v; bi = n; }
            }
            if (r == 0) mx = bv;
            float e = expf(bv - mx);
            sum += e;
            EG[r] = e; EI[r] = TI[bi >> 4] * 128 + TI[16 + (bi & 15)];
            pv = bv; pi = bi;
        }
        float inv = 1.f / sum;
        for (int r = 0; r < 16; ++r) EG[r] *= inv;
    }
}
__device__ void ph_peer_apply(const Params& p, int l, unsigned char* lds, const int wv) {
    const int tid = opaque_tid(wv);
    const int sub = tid >> 8, tl = tid & 255;
    const int wave = tl >> 6, lane = tl & 63;
    float* wts = (float*)(lds + 64) + sub * 128; int* eid = (int*)(lds + 64 + 1024) + sub * 128;
    const bf16_t* UT = (const bf16_t*)(p.ws + OFF_UT) + (size_t)l * NEXP * D;
    const bf16_t* VT = (const bf16_t*)(p.ws + OFF_VT) + (size_t)l * NEXP * D;
    const int niter = (NTOK + gridDim.x * 2 - 1) / (gridDim.x * 2);
    for (int it = 0; it < niter; ++it) {
        int t = (it * gridDim.x + blockIdx.x) * 2 + sub;
        const bool valid = t < NTOK; if (!valid) t = NTOK - 1;
        const bf16_t* H = (const bf16_t*)(p.ws + OFF_H) + (size_t)t * D;
        const int* EI = (const int*)(p.ws + OFF_EIDX) + (size_t)t * 128; const float* EG = (const float*)(p.ws + OFF_EGATE) + (size_t)t * 128;
        float hv[16];
#pragma unroll
        for (int i = 0; i < 16; ++i) hv[i] = bf2f(H[lane * 16 + i]);
        for (int jj = 0; jj < 32; ++jj) {
            int j = wave * 32 + jj; int e = EI[j];
            const bf16_t* ur = UT + (size_t)e * D + lane * 16;
            float acc = 0.f;
#pragma unroll
            for (int i = 0; i < 16; ++i) acc += hv[i] * bf2f(ur[i]);
            acc = wave_sum(acc);
            if (lane == 0) { wts[j] = EG[j] * gelu_f(acc); eid[j] = e; }
        }
        __syncthreads();
        float o[4] = {0.f, 0.f, 0.f, 0.f};
        for (int j = 0; j < 128; ++j) {
            const bf16_t* vr = VT + (size_t)eid[j] * D + tl * 4; float w = wts[j];
#pragma unroll
            for (int i = 0; i < 4; ++i) o[i] += w * bf2f(vr[i]);
        }
        const float* mod = (const float*)(p.ws + OFF_MOD) + (size_t)(l * 5 + tok_cv(t)) * 6144 + 5 * 1024;
        float* XC = (float*)(p.ws + OFF_XC) + (size_t)t * D;
        if (valid) {
#pragma unroll
            for (int i = 0; i < 4; ++i) { int c = tl * 4 + i; XC[c] += mod[c] * o[i]; }
        }
        __syncthreads();
    }
}
__device__ void ph_final_norm(const Params& p, const int wv) {
    const int tid = opaque_tid(wv);
    const int lane = tid & 63;
    const int gw = blockIdx.x * 8 + (tid >> 6), nw = gridDim.x * 8;
    u32x4 nx[2];
    {
        const int t = gw < NTOK ? gw : NTOK - 1;
        const bf16_t* xr = (const bf16_t*)(p.ws + OFF_XC) + (size_t)t * D + lane * 8;
        nx[0] = *reinterpret_cast<const u32x4*>(xr); nx[1] = *reinterpret_cast<const u32x4*>(xr + 512);
    }
    for (int t = gw; t < NTOK; t += nw) {
        float v[16];
#pragma unroll
        for (int h = 0; h < 2; ++h)
#pragma unroll
            for (int k = 0; k < 4; ++k) { v[h * 8 + 2 * k] = __uint_as_float(nx[h][k] << 16); v[h * 8 + 2 * k + 1] = __uint_as_float(nx[h][k] & 0xffff0000u); }
        {
            const int tn = t + nw < NTOK ? t + nw : t;
            const bf16_t* xn = (const bf16_t*)(p.ws + OFF_XC) + (size_t)tn * D + lane * 8;
            nx[0] = *reinterpret_cast<const u32x4*>(xn); nx[1] = *reinterpret_cast<const u32x4*>(xn + 512);
        }
        float ss = 0.f;
#pragma unroll
        for (int i = 0; i < 16; ++i) ss += v[i] * v[i];
        ss = wave_sum(ss);
        float r = rsqrtf(ss / D + EPS);
        float* y = p.out + (size_t)t * D;
#pragma unroll
        for (int h = 0; h < 2; ++h) {
            const int c = h * 512 + lane * 8;
#pragma unroll
            for (int q = 0; q < 2; ++q) {
                const float4 g = *reinterpret_cast<const float4*>(p.in[I_FG] + c + q * 4);
                *reinterpret_cast<float4*>(y + c + q * 4) = make_float4(v[h * 8 + q * 4] * r * g.x, v[h * 8 + q * 4 + 1] * r * g.y, v[h * 8 + q * 4 + 2] * r * g.z, v[h * 8 + q * 4 + 3] * r * g.w);
            }
        }
    }
}


namespace g8 {
constexpr int BM = 256, BK = 64, HALF = 128, HT = HALF * BK;
__device__ __forceinline__ int lds_byte(int r, int c) {
    int st = (r >> 4) * 2 + (c >> 5), rr = r & 15, cc = c & 31, ob = rr * 64 + cc * 2;
    return st * 1024 + (ob ^ (((ob >> 9) & 1) << 5));
}
__device__ __forceinline__ void stage_rc(int b, int& R, int& C) {
    int st = b / 1024, sb = b % 1024, swz = sb ^ (((sb >> 9) & 1) << 5);
    R = (st >> 1) * 16 + swz / 64; C = (st & 1) * 32 + (swz % 64) / 2;
}
}
enum { EPI_INPROJ = 0, EPI_WOUT = 1, EPI_WQ = 2 };
constexpr int STG = 132;

__device__ __forceinline__ void store_bf16x32(bf16_t* dst, const float (&v)[32]) {
#pragma unroll
    for (int i = 0; i < 4; ++i) {
        uint4 u;
        u.x = pack_bf2(v[i * 8 + 0], v[i * 8 + 1]); u.y = pack_bf2(v[i * 8 + 2], v[i * 8 + 3]);
        u.z = pack_bf2(v[i * 8 + 4], v[i * 8 + 5]); u.w = pack_bf2(v[i * 8 + 6], v[i * 8 + 7]);
        *reinterpret_cast<uint4*>(dst + i * 8) = u;
    }
}
__device__ __forceinline__ void store_f32x32(float* dst, const float (&v)[32]) {
#pragma unroll
    for (int i = 0; i < 8; ++i) *reinterpret_cast<float4*>(dst + i * 4) = make_float4(v[i * 4], v[i * 4 + 1], v[i * 4 + 2], v[i * 4 + 3]);
}

__device__ __forceinline__ void epi_inproj_xform(const Params& p, int l, int t, int c0, float (&v)[32]) {
    const bool prompt = t < NPT;
    const int s = prompt ? (t & 255) : ((t - NPT) & 2047);
    const float* R = (const float*)(p.ws + OFF_ROPE);
    if (c0 < 512) {
#pragma unroll
        for (int i = 0; i < 32; ++i) v[i] = gelu_f(v[i]);
    } else if (c0 < 1024) {
        if (!prompt) {
            const float* cs = R + s * 16; const float* sn = R + 2048 * 16 + s * 16;
#pragma unroll
            for (int i = 0; i < 16; ++i) {
                float c = cs[i], sv = sn[i], x1 = v[i], x2 = v[i + 16];
                v[i] = x1 * c - x2 * sv; v[i + 16] = x2 * c + x1 * sv;
            }
        }
    } else if (c0 >= 1280 && c0 < 1920) {
        const bool isq = c0 < 1792;
        const int hi = c0 & 32;
        const float* g = p.in[isq ? I_QNG : I_KNG] + l * 64 + hi;
        float ss = 0.f;
#pragma unroll
        for (int i = 0; i < 32; ++i) ss += v[i] * v[i];
        const int ln = lane_id_op();
        ss += shfl_x(ss, ln, 1);
        const float rr = rsqrtf(ss * (1.f / 64.f) + EPS);
#pragma unroll
        for (int i = 0; i < 32; ++i) v[i] = v[i] * rr * g[i];
        if (!prompt) {
            const float* cs = R + 2048 * 32 + s * 32; const float* sn = R + 2048 * 64 + s * 32;
#pragma unroll
            for (int i = 0; i < 32; ++i) {
                float pv = shfl_x(v[i], ln, 1);
                float c = cs[i], sv = sn[i];
                v[i] = hi ? (v[i] * c + pv * sv) : (v[i] * c - pv * sv);
            }
        }
    }
}
__device__ __forceinline__ void epi_inproj_col(const Params& p, int t0, int c, const LAS float* stc) {
    float v[32];
#pragma unroll
    for (int i = 0; i < 32; ++i) v[i] = stc[i * STG];
    const bool prompt = t0 < NPT;
    const int b = prompt ? (t0 >> 8) : ((t0 - NPT) >> 11);
    const int s = prompt ? (t0 & 255) : ((t0 - NPT) & 2047);
    unsigned char* ws = p.ws;
    bf16_t* dst;
    if (c < 1280) {
        const int cc = c - 1024, h = cc >> 6, d = cc & 63;
        dst = prompt ? (bf16_t*)(ws + OFF_DVTP) + (((size_t)b * 4 + h) * 64 + d) * SEQ + s
                     : (bf16_t*)(ws + OFF_DVTS) + (((size_t)b * 4 + h) * 64 + d) * NKS + s;
    } else {
        const int cc = c - 1920, kv = cc >> 6, d = cc & 63;
        dst = prompt ? (bf16_t*)(ws + OFF_GVTP) + (((size_t)b * 2 + kv) * 64 + d) * SEQ + s
                     : (bf16_t*)(ws + OFF_GVTS) + (((size_t)b * 2 + kv) * 64 + d) * NKS + s;
    }
    store_bf16x32(dst, v);
}

template <int MODE>
__device__ __forceinline__ void gemm_phase(const Params& p, int l, const bf16_t* __restrict__ A, const bf16_t* __restrict__ Bt, const int N, unsigned char* ldsraw, const int wv) {
    using namespace g8;
    constexpr int K = 1024, nt = K / BK, BN = 128, TILE_A = BM * BK * 2, TILE_B = BN * BK * 2, STAGE_B = TILE_A + TILE_B;
    LAS unsigned char* lds = (LAS unsigned char*)ldsraw;
    const int tid = opaque_tid(wv), wid = wv, lane = tid & 63;
    const int wr = wid >> 1, wc = wid & 1, fr = lane & 15, fq = lane >> 4;
    unsigned voff[4];
#pragma unroll
    for (int i = 0; i < 4; ++i) voff[i] = (unsigned)((i * 64 + wid * 8 + (lane >> 3)) * K + (((lane & 7) ^ (lane >> 3)) * 8)) * 2u;
    const int aoff = (wr * 64 + fr) * 128 + ((fq ^ (fr & 7)) * 16), boff = (wc * 64 + fr) * 128 + ((fq ^ (fr & 7)) * 16);
    const unsigned ldsw = (unsigned)wid * 1024u;
#define G8_STAGE(buf, kt) do { \
        _Pragma("unroll") for (int _i = 0; _i < 4; ++_i) \
            __builtin_amdgcn_global_load_lds((const unsigned*)((const char*)(Ab + (kt) * BK) + voff[_i]), (LAS unsigned*)(lds + (buf) * STAGE_B + ldsw + _i * 8192), 16, 0, 0); \
        _Pragma("unroll") for (int _i = 0; _i < 2; ++_i) \
            __builtin_amdgcn_global_load_lds((const unsigned*)((const char*)(Bb + (kt) * BK) + voff[_i]), (LAS unsigned*)(lds + (buf) * STAGE_B + TILE_A + ldsw + _i * 8192), 16, 0, 0); } while (0)
#define G8_WAIT_V0() asm volatile("s_waitcnt vmcnt(0)" ::: "memory")
    const int nN = N / BN, nM = NTOK / BM, ntiles = nM * nN;
    const int G = gridDim.x;
    const int vb = (G % 8 == 0) ? (int)(blockIdx.x % 8) * (G / 8) + (int)(blockIdx.x / 8) : (int)blockIdx.x;
    const int tpb = (ntiles + G - 1) / G;
    const bool paneled = (G == 256) && (nN == 8 || nN == 16) && (nM == 64);
    for (int ti = 0; ti < tpb; ++ti) {
        int tile = vb * tpb + ti;
        if (paneled) {
            const int x = vb >> 5, j = vb & 31;
            const int mpx = nN == 16 ? 16 : 8;
            const int m0 = nN == 16 ? (x >> 1) * 16 : x * 8, n0 = nN == 16 ? (x & 1) * 8 : 0;
            const int pm_ = m0 + ti * 4 + (j >> 3), pn_ = n0 + (j & 7);
            tile = (ti * 4 < mpx) ? pm_ * nN + pn_ : ntiles;
        }
        if (tile >= ntiles) break;
        const int pm = tile / nN, pn = tile % nN, brow = pm * BM, bcol = pn * BN;
        const bf16_t* Ab = A + (size_t)brow * K; const bf16_t* Bb = Bt + (size_t)bcol * K;
        f32x4 acc[4][4];
#pragma unroll
        for (int m = 0; m < 4; ++m)
#pragma unroll
            for (int n = 0; n < 4; ++n) acc[m][n] = f32x4{0.f, 0.f, 0.f, 0.f};
        G8_WAIT_V0();
        G8_STAGE(0, 0); G8_STAGE(1, 1);
        int cur = 0;
        for (int t = 0; t < nt; ++t) {
            if (t + 1 < nt) asm volatile("s_waitcnt vmcnt(6)" ::: "memory"); else asm volatile("s_waitcnt vmcnt(0)" ::: "memory");
            __builtin_amdgcn_s_barrier();
            if (t + 2 < nt) { const int nb = cur >= 1 ? cur - 1 : 2; G8_STAGE(nb, t + 2); }
            {
                bf16x8 At[2][4], Bf[2][4];
#pragma unroll
                for (int ks = 0; ks < 2; ++ks) {
#pragma unroll
                    for (int m = 0; m < 4; ++m) At[ks][m] = *(const LAS bf16x8*)(lds + cur * STAGE_B + ((aoff + m * 2048) ^ (ks * 64)));
#pragma unroll
                    for (int n = 0; n < 4; ++n) Bf[ks][n] = *(const LAS bf16x8*)(lds + cur * STAGE_B + TILE_A + ((boff + n * 2048) ^ (ks * 64)));
                }
                __builtin_amdgcn_sched_barrier(0);
#pragma unroll
                for (int ks = 0; ks < 2; ++ks)
#pragma unroll
                    for (int m = 0; m < 4; ++m)
#pragma unroll
                        for (int n = 0; n < 4; ++n) acc[m][n] = __builtin_amdgcn_mfma_f32_16x16x32_bf16(At[ks][m], Bf[ks][n], acc[m][n], 0, 0, 0);
                __builtin_amdgcn_sched_barrier(0);
            }
            cur = cur == 2 ? 0 : cur + 1;
        }
        __syncthreads();
        LAS float* st = (LAS float*)lds;
#pragma unroll
        for (int m = 0; m < 4; ++m)
#pragma unroll
            for (int n = 0; n < 4; ++n)
#pragma unroll
                for (int j = 0; j < 4; ++j)
                    st[(wr * 64 + m * 16 + fq * 4 + j) * STG + wc * 64 + n * 16 + fr] = acc[m][n][j];
        __syncthreads();
        const bool tprompt = brow < NPT;
        const int tb_ = tprompt ? (brow >> 8) : ((brow - NPT) >> 11), ts0 = tprompt ? 0 : ((brow - NPT) & 2047);
        if (MODE == EPI_INPROJ) {
            const bool vtile = (bcol >= 1024 && bcol < 1280) || bcol >= 1920;
            if (!vtile) {
#pragma unroll 1
                for (int it = 0; it < 2; ++it) {
                    const int item = it * NT + tid, erow = item >> 2, eseg = item & 3;
                    float v[32];
#pragma unroll
                    for (int i = 0; i < 8; ++i) {
                        const f32x4 f = *(const LAS f32x4*)(st + erow * STG + eseg * 32 + i * 4);
                        v[i * 4] = f[0]; v[i * 4 + 1] = f[1]; v[i * 4 + 2] = f[2]; v[i * 4 + 3] = f[3];
                    }
                    epi_inproj_xform(p, l, brow + erow, bcol + eseg * 32, v);
#pragma unroll
                    for (int i = 0; i < 8; ++i) *(LAS f32x4*)(st + erow * STG + eseg * 32 + i * 4) = f32x4{v[i * 4], v[i * 4 + 1], v[i * 4 + 2], v[i * 4 + 3]};
                }
                __syncthreads();
#pragma unroll 1
                for (int it = 0; it < 8; ++it) {
                    const int item = it * NT + tid, r = item >> 4, c = (item & 15) * 8;
                    const f32x4 f0 = *(const LAS f32x4*)(st + r * STG + c), f1 = *(const LAS f32x4*)(st + r * STG + c + 4);
                    const int t = brow + r, sp = ts0 + r;
                    bf16_t* dst;
                    if (bcol < 512)        dst = (bf16_t*)(p.ws + (bcol < 256 ? OFF_AU : OFF_AV)) + (size_t)t * 256 + (bcol & 255) + c;
                    else if (bcol < 768)   dst = (bf16_t*)(p.ws + OFF_DQ) + (size_t)t * 256 + (bcol - 512) + c;
                    else if (bcol < 1024) { const int cc = bcol - 768 + c, h = cc >> 6;
                                            dst = tprompt ? (bf16_t*)(p.ws + OFF_DKP) + (((size_t)tb_ * 4 + h) * SEQ + sp) * 64 + (cc & 63)
                                                          : (bf16_t*)(p.ws + OFF_DKS) + (((size_t)tb_ * 4 + h) * NKS + sp) * 64 + (cc & 63); }
                    else if (bcol < 1792)  dst = (bf16_t*)(p.ws + OFF_GQ) + (size_t)t * 512 + (bcol - 1280) + c;
                    else                 { const int kv = c >> 6;
                                            dst = tprompt ? (bf16_t*)(p.ws + OFF_GKP) + (((size_t)tb_ * 2 + kv) * SEQ + sp) * 64 + (c & 63)
                                                          : (bf16_t*)(p.ws + OFF_GKS) + (((size_t)tb_ * 2 + kv) * NKS + sp) * 64 + (c & 63); }
                    *reinterpret_cast<u32x4*>(dst) = u32x4{pack_bf2(f0[0], f0[1]), pack_bf2(f0[2], f0[3]), pack_bf2(f1[0], f1[1]), pack_bf2(f1[2], f1[3])};
                }
            }
            if (tprompt && ((bcol >= 768 && bcol < 1280) || bcol >= 1792)) {
                float* ob; int rs;
                if (bcol < 1024)      { ob = p.out + OUT_NDK + (((size_t)tb_ * 2 + l) * SEQ) * 256 + (bcol - 768);  rs = 256; }
                else if (bcol < 1280) { ob = p.out + OUT_NDV + (((size_t)tb_ * 2 + l) * SEQ) * 256 + (bcol - 1024); rs = 256; }
                else if (bcol < 1920) { ob = p.out + OUT_NGK + (((size_t)tb_ * 2 + l) * SEQ) * 128;                 rs = 128; }
                else                  { ob = p.out + OUT_NGV + (((size_t)tb_ * 2 + l) * SEQ) * 128;                 rs = 128; }
#pragma unroll 1
                for (int it = 0; it < 16; ++it) {
                    const int item = it * NT + tid, r = item >> 5, c = (item & 31) * 4;
                    *reinterpret_cast<f32x4*>(ob + (size_t)r * rs + c) = *(const LAS f32x4*)(st + r * STG + c);
                }
            }
            if (vtile) {
#pragma unroll 1
                for (int it = 0; it < 2; ++it) {
                    const int item = it * NT + tid, col = item >> 3, run = item & 7;
                    epi_inproj_col(p, brow + run * 32, bcol + col, st + run * 32 * STG + col);
                }
            }
        } else {
#pragma unroll 1
            for (int it = 0; it < 8; ++it) {
                const int item = it * NT + tid, r = item >> 4, c = (item & 15) * 8;
                const f32x4 f0 = *(const LAS f32x4*)(st + r * STG + c), f1 = *(const LAS f32x4*)(st + r * STG + c + 4);
                const int t = brow + r;
                float o[8] = {f0[0], f0[1], f0[2], f0[3], f1[0], f1[1], f1[2], f1[3]};
                if (MODE == EPI_WOUT) {
                    const float* g1 = (const float*)(p.ws + OFF_MOD) + (size_t)(l * 5 + tok_cv(t)) * 6144 + 2048 + bcol + c;
                    const float4 ga = *reinterpret_cast<const float4*>(g1), gb = *reinterpret_cast<const float4*>(g1 + 4);
                    float x[8];
                    if (l == 0) {
                        const float* xr = x_in_row(p, t) + bcol + c;
                        const float4 xa = *reinterpret_cast<const float4*>(xr), xb2 = *reinterpret_cast<const float4*>(xr + 4);
                        x[0] = xa.x; x[1] = xa.y; x[2] = xa.z; x[3] = xa.w; x[4] = xb2.x; x[5] = xb2.y; x[6] = xb2.z; x[7] = xb2.w;
                    } else {
                        const u32x4 xw = *reinterpret_cast<const u32x4*>((const bf16_t*)(p.ws + OFF_XC) + (size_t)t * D + bcol + c);
#pragma unroll
                        for (int k = 0; k < 4; ++k) { x[2 * k] = __uint_as_float(xw[k] << 16); x[2 * k + 1] = __uint_as_float(xw[k] & 0xffff0000u); }
                    }
                    o[0] = x[0] + ga.x * o[0]; o[1] = x[1] + ga.y * o[1]; o[2] = x[2] + ga.z * o[2]; o[3] = x[3] + ga.w * o[3];
                    o[4] = x[4] + gb.x * o[4]; o[5] = x[5] + gb.y * o[5]; o[6] = x[6] + gb.z * o[6]; o[7] = x[7] + gb.w * o[7];
                }
                bf16_t* dst = (bf16_t*)(p.ws + (MODE == EPI_WOUT ? OFF_XC : OFF_Q)) + (size_t)t * D + bcol + c;
                *reinterpret_cast<u32x4*>(dst) = u32x4{pack_bf2(o[0], o[1]), pack_bf2(o[2], o[3]), pack_bf2(o[4], o[5]), pack_bf2(o[6], o[7])};
            }
        }
        __syncthreads();
    }
}


#define MFMA32(a, b, c) __builtin_amdgcn_mfma_f32_32x32x16_bf16((a), (b), (c), 0, 0, 0)
constexpr int ATT_ROWB = 144;
constexpr int ATT_TILEB = 64 * ATT_ROWB;
constexpr int QW_MIX = 4096;

__device__ __forceinline__ bf16x8 pack8(const f32x16& x, int s) {
    const u32x4 w = {pack_bf2(x[8 * s], x[8 * s + 1]), pack_bf2(x[8 * s + 2], x[8 * s + 3]), pack_bf2(x[8 * s + 4], x[8 * s + 5]), pack_bf2(x[8 * s + 6], x[8 * s + 7])};
    return __builtin_bit_cast(bf16x8, w);
}
__device__ __forceinline__ void softmax_tile(f32x16& s0, f32x16& s1, const float sc, float& m, float& l, float& alpha, const int lane) {
    float mx = fmaxf(s0[0], s1[0]);
#pragma unroll
    for (int i = 1; i < 16; ++i) mx = fmaxf(mx, fmaxf(s0[i], s1[i]));
    mx = fmaxf(mx, shfl_x(mx, lane, 32));
    const float mnew = fmaxf(m, mx * sc);
    alpha = __builtin_amdgcn_exp2f(m - mnew);
    m = mnew;
    float ps = 0.f;
#pragma unroll
    for (int i = 0; i < 16; ++i) { s0[i] = __builtin_amdgcn_exp2f(s0[i] * sc - mnew); s1[i] = __builtin_amdgcn_exp2f(s1[i] * sc - mnew); ps += s0[i] + s1[i]; }
    l = l * alpha + ps;
}
__device__ __forceinline__ void v_frags(const LAS unsigned char* vb, bf16x8 (&vf)[8], int r, int hh) {
#pragma unroll
    for (int u = 0; u < 2; ++u)
#pragma unroll
        for (int sk = 0; sk < 2; ++sk)
#pragma unroll
            for (int mt = 0; mt < 2; ++mt) {
                const LAS unsigned char* a = vb + (32 * mt + r) * ATT_ROWB + (32 * u + 16 * sk + 4 * hh) * 2;
                const s16x4 lo = *(const LAS s16x4*)a, hi = *(const LAS s16x4*)(a + 16);
                vf[(u * 2 + sk) * 2 + mt] = bf16x8{lo[0], lo[1], lo[2], lo[3], hi[0], hi[1], hi[2], hi[3]};
            }
}
__device__ __forceinline__ void pv_tile(const bf16x8 (&vf)[8], const f32x16& p0, const f32x16& p1, f32x16 (&O)[2]) {
#pragma unroll
    for (int u = 0; u < 2; ++u)
#pragma unroll
        for (int sk = 0; sk < 2; ++sk) {
            const bf16x8 pf = pack8(u ? p1 : p0, sk);
#pragma unroll
            for (int mt = 0; mt < 2; ++mt) O[mt] = MFMA32(vf[(u * 2 + sk) * 2 + mt], pf, O[mt]);
        }
}

template <bool DIFF>
__device__ __forceinline__ void attn_item(const Params& p, int l, LAS unsigned char* lds, const int tid,
                                          const bf16_t* __restrict__ Qg, const int qstride,
                                          const bf16_t* __restrict__ Kg, const bf16_t* __restrict__ Vtg, const int nk,
                                          bf16_t* __restrict__ Og, const float lam) {
    const int wave = tid >> 6, lane = tid & 63, r = lane & 31, hh = lane >> 5;
    const int lrow = tid >> 3, lchunk = tid & 7;
    LAS unsigned char* kbuf = lds; LAS unsigned char* vbuf = lds + 2 * ATT_TILEB;
    bf16x8 qf[4];
    const bf16_t* qrow = Qg + (size_t)(wave * 32 + r) * qstride;
#pragma unroll
    for (int ks = 0; ks < 4; ++ks) qf[ks] = *reinterpret_cast<const bf16x8*>(qrow + ks * 16 + hh * 8);
    const float sc = (DIFF ? 0.17677669529663687f : 0.125f) * 1.4426950408889634f;
    f32x16 O0[2], O1[2];
#pragma unroll
    for (int mt = 0; mt < 2; ++mt)
#pragma unroll
        for (int i = 0; i < 16; ++i) { O0[mt][i] = 0.f; O1[mt][i] = 0.f; }
    float m0 = -1e30f, l0 = 0.f, m1 = -1e30f, l1 = 0.f;
    const int ntl = nk / 64;
    u32x4 kr, vr, kn, vn;
    kr = *reinterpret_cast<const u32x4*>(Kg + (size_t)lrow * 64 + lchunk * 8);
    vr = *reinterpret_cast<const u32x4*>(Vtg + (size_t)lrow * nk + lchunk * 8);
    *(LAS u32x4*)(kbuf + lrow * ATT_ROWB + lchunk * 16) = kr;
    *(LAS u32x4*)(vbuf + lrow * ATT_ROWB + lchunk * 16) = vr;
    {
        const int t1 = ntl > 1 ? 1 : 0;
        kr = *reinterpret_cast<const u32x4*>(Kg + (size_t)(t1 * 64 + lrow) * 64 + lchunk * 8);
        vr = *reinterpret_cast<const u32x4*>(Vtg + (size_t)lrow * nk + t1 * 64 + lchunk * 8);
    }
    __syncthreads();
    for (int ti = 0; ti < ntl; ++ti) {
        const int cur = ti & 1;
        {
            const int t2 = ti + 2 < ntl ? ti + 2 : ntl - 1;
            kn = *reinterpret_cast<const u32x4*>(Kg + (size_t)(t2 * 64 + lrow) * 64 + lchunk * 8);
            vn = *reinterpret_cast<const u32x4*>(Vtg + (size_t)lrow * nk + t2 * 64 + lchunk * 8);
        }
        const LAS unsigned char* kb = kbuf + cur * ATT_TILEB; const LAS unsigned char* vb = vbuf + cur * ATT_TILEB;
        bf16x8 ka[2][4];
#pragma unroll
        for (int u = 0; u < 2; ++u)
#pragma unroll
            for (int ks = 0; ks < 4; ++ks) ka[u][ks] = *(const LAS bf16x8*)(kb + (32 * u + r) * ATT_ROWB + (ks * 16 + hh * 8) * 2);
        __builtin_amdgcn_sched_barrier(0);
        bf16x8 vf[8];
        if (!DIFF) {
            f32x16 s0, s1;
#pragma unroll
            for (int i = 0; i < 16; ++i) { s0[i] = 0.f; s1[i] = 0.f; }
#pragma unroll
            for (int ks = 0; ks < 4; ++ks) { s0 = MFMA32(ka[0][ks], qf[ks], s0); s1 = MFMA32(ka[1][ks], qf[ks], s1); }
            v_frags(vb, vf, r, hh);
            __builtin_amdgcn_sched_barrier(0);
            float alpha;
            softmax_tile(s0, s1, sc, m0, l0, alpha, lane);
            if (__builtin_amdgcn_ballot_w64(alpha != 1.f) != 0ull) {
#pragma unroll
                for (int mt = 0; mt < 2; ++mt)
#pragma unroll
                    for (int i = 0; i < 16; ++i) O0[mt][i] *= alpha;
            }
            pv_tile(vf, s0, s1, O0);
        } else {
            f32x16 s0, s1, t0, t1;
#pragma unroll
            for (int i = 0; i < 16; ++i) { s0[i] = 0.f; s1[i] = 0.f; t0[i] = 0.f; t1[i] = 0.f; }
#pragma unroll
            for (int ks = 0; ks < 2; ++ks) {
                s0 = MFMA32(ka[0][ks], qf[ks], s0); s1 = MFMA32(ka[1][ks], qf[ks], s1);
                t0 = MFMA32(ka[0][2 + ks], qf[2 + ks], t0); t1 = MFMA32(ka[1][2 + ks], qf[2 + ks], t1);
            }
            v_frags(vb, vf, r, hh);
            __builtin_amdgcn_sched_barrier(0);
            float alpha;
            softmax_tile(s0, s1, sc, m0, l0, alpha, lane);
            if (__builtin_amdgcn_ballot_w64(alpha != 1.f) != 0ull) {
#pragma unroll
                for (int mt = 0; mt < 2; ++mt)
#pragma unroll
                    for (int i = 0; i < 16; ++i) O0[mt][i] *= alpha;
            }
            pv_tile(vf, s0, s1, O0);
            softmax_tile(t0, t1, sc, m1, l1, alpha, lane);
            if (__builtin_amdgcn_ballot_w64(alpha != 1.f) != 0ull) {
#pragma unroll
                for (int mt = 0; mt < 2; ++mt)
#pragma unroll
                    for (int i = 0; i < 16; ++i) O1[mt][i] *= alpha;
            }
            pv_tile(vf, t0, t1, O1);
        }
        if (ti + 1 < ntl) {
            *(LAS u32x4*)(kbuf + (cur ^ 1) * ATT_TILEB + lrow * ATT_ROWB + lchunk * 16) = kr;
            *(LAS u32x4*)(vbuf + (cur ^ 1) * ATT_TILEB + lrow * ATT_ROWB + lchunk * 16) = vr;
        }
        kr = kn; vr = vn;
        __syncthreads();
    }
    l0 += shfl_x(l0, lane, 32);
    const float inv0 = 1.f / l0;
    bf16_t* orow = Og + (size_t)(wave * 32 + r) * D;
    if (!DIFF) {
#pragma unroll
        for (int mt = 0; mt < 2; ++mt)
#pragma unroll
            for (int g = 0; g < 4; ++g) {
                uint2 w;
                w.x = pack_bf2(O0[mt][4 * g] * inv0, O0[mt][4 * g + 1] * inv0);
                w.y = pack_bf2(O0[mt][4 * g + 2] * inv0, O0[mt][4 * g + 3] * inv0);
                *reinterpret_cast<uint2*>(orow + 32 * mt + 8 * g + 4 * hh) = w;
            }
    } else {
        l1 += shfl_x(l1, lane, 32);
        const float inv1 = lam / l1;
        float ss = 0.f;
#pragma unroll
        for (int mt = 0; mt < 2; ++mt)
#pragma unroll
            for (int i = 0; i < 16; ++i) { const float o = O0[mt][i] * inv0 - O1[mt][i] * inv1; O0[mt][i] = o; ss += o * o; }
        ss += shfl_x(ss, lane, 32);
        const float rr = rsqrtf(ss * (1.f / 64.f) + EPS) * __builtin_bit_cast(float, __builtin_amdgcn_readfirstlane(__builtin_bit_cast(int, 1.f - lam_init_of(l))));
        const float* sg = p.in[I_SUBLN] + l * 64;
#pragma unroll
        for (int mt = 0; mt < 2; ++mt)
#pragma unroll
            for (int g = 0; g < 4; ++g) {
                const int d0 = 32 * mt + 8 * g + 4 * hh;
                const float4 gg = *reinterpret_cast<const float4*>(sg + d0);
                uint2 w;
                w.x = pack_bf2(O0[mt][4 * g] * rr * gg.x, O0[mt][4 * g + 1] * rr * gg.y);
                w.y = pack_bf2(O0[mt][4 * g + 2] * rr * gg.z, O0[mt][4 * g + 3] * rr * gg.w);
                *reinterpret_cast<uint2*>(orow + d0) = w;
            }
    }
}

constexpr int SGU_ROWB = 272;
__device__ __forceinline__ void sgu_item(const Params& p, int l, LAS unsigned char* lds, const int tid, const int t0) {
    const bf16_t* AV = (const bf16_t*)(p.ws + OFF_AV) + (size_t)t0 * 256;
    {
        const int q = tid >> 2, quarter = tid & 3;
        float v[64]; float ss = 0.f;
#pragma unroll
        for (int i = 0; i < 8; ++i) {
            const bf16x8 w = *reinterpret_cast<const bf16x8*>(AV + (size_t)q * 256 + quarter * 64 + i * 8);
#pragma unroll
            for (int j = 0; j < 8; ++j) { v[i * 8 + j] = bf2f((bf16_t)w[j]); ss += v[i * 8 + j] * v[i * 8 + j]; }
        }
        { const int ln = tid & 63; ss += shfl_x(ss, ln, 1); ss += shfl_x(ss, ln, 2); }
        const float rstd = rsqrtf(ss * (1.f / 256.f) + EPS);
        const float* g = p.in[I_SGUNG] + l * 256 + quarter * 64;
#pragma unroll
        for (int i = 0; i < 64; ++i)
            *(LAS bf16_t*)(lds + (quarter * 64 + i) * SGU_ROWB + q * 2) = f2bf(v[i] * rstd * g[i]);
    }
    __syncthreads();
    {
        const int wave = tid >> 6, lane = tid & 63, r = lane & 31, hh = lane >> 5;
        const int g = wave >> 1, ph = wave & 1;
        const bf16_t* W = (const bf16_t*)(p.ws + OFF_SGUW) + ((size_t)l * 4 + g) * 128 * 128;
        f32x16 acc[2][2];
#pragma unroll
        for (int a = 0; a < 2; ++a)
#pragma unroll
            for (int b = 0; b < 2; ++b)
#pragma unroll
                for (int i = 0; i < 16; ++i) acc[a][b][i] = 0.f;
#pragma unroll
        for (int ks = 0; ks < 8; ++ks) {
            bf16x8 af[2], bfr[2];
#pragma unroll
            for (int pt = 0; pt < 2; ++pt) af[pt] = *reinterpret_cast<const bf16x8*>(W + (size_t)(ph * 64 + pt * 32 + r) * 128 + ks * 16 + hh * 8);
#pragma unroll
            for (int ct = 0; ct < 2; ++ct) bfr[ct] = *(const LAS bf16x8*)(lds + (g * 64 + ct * 32 + r) * SGU_ROWB + (ks * 16 + hh * 8) * 2);
#pragma unroll
            for (int pt = 0; pt < 2; ++pt)
#pragma unroll
                for (int ct = 0; ct < 2; ++ct) acc[pt][ct] = MFMA32(af[pt], bfr[ct], acc[pt][ct]);
        }
        const float* bias = p.in[I_SGUB] + (l * 4 + g) * 128;
        const bf16_t* AU = (const bf16_t*)(p.ws + OFF_AU);
        bf16_t* MIX = (bf16_t*)(p.ws + OFF_MIX);
#pragma unroll
        for (int pt = 0; pt < 2; ++pt)
#pragma unroll
            for (int ct = 0; ct < 2; ++ct)
#pragma unroll
                for (int i = 0; i < 16; ++i) {
                    const int pp = ph * 64 + pt * 32 + (i & 3) + 8 * (i >> 2) + 4 * hh, c = g * 64 + ct * 32 + r;
                    const float au = bf2f(AU[(size_t)(t0 + pp) * 256 + c]);
                    MIX[(size_t)(t0 + pp) * D + c] = f2bf(au * (acc[pt][ct][i] + bias[pp]));
                }
    }
    __syncthreads();
}

__device__ void ph_mixers(const Params& p, int lq, unsigned char* ldsraw, const int wv) {
    const int l = lq & 1;
    const int tid0 = opaque_tid(wv);
    LAS unsigned char* lds = (LAS unsigned char*)ldsraw;
    volatile LAS int* qslot = (volatile LAS int*)(ldsraw - LDS_HDR + 64);
    unsigned* qw = (unsigned*)(p.ws + OFF_BAR) + QW_MIX + lq;
    const float lam = __builtin_bit_cast(float, __builtin_amdgcn_readfirstlane(__builtin_bit_cast(int, lam_of(p, l))));
    unsigned char* ws = p.ws;
    for (;;) {
        if (tid0 == 0) *qslot = (int)atomicAdd(qw, 1u);
        __syncthreads();
        const int item = *qslot;
        __syncthreads();
        if (item >= 896) break;
        if (lq >= 2 && PROBE_DUP >= 10) {
            const int cls = item < 128 ? 10 : (item < 384 ? 11 : 12);
            if (cls != PROBE_DUP) continue;
        }
        int tid = tid0; asm volatile("" : "+v"(tid));
        if (item < 128) {
            const int qc = item & 7, h = (item >> 3) & 3, b = item >> 5;
            const int t0 = NPT + b * DSEQ + qc * 256;
            attn_item<true>(p, l, lds, tid, (const bf16_t*)(ws + OFF_DQ) + (size_t)t0 * 256 + h * 64, 256,
                            (const bf16_t*)(ws + OFF_DKS) + ((size_t)b * 4 + h) * NKS * 64, (const bf16_t*)(ws + OFF_DVTS) + ((size_t)b * 4 + h) * 64 * NKS, NKS,
                            (bf16_t*)(ws + OFF_MIX) + (size_t)t0 * D + 256 + h * 64, lam);
        } else if (item < 384) {
            const int it = item - 128, qc = it & 7, hq = (it >> 3) & 7, b = it >> 6, kv = hq >> 2;
            const int t0 = NPT + b * DSEQ + qc * 256;
            attn_item<false>(p, l, lds, tid, (const bf16_t*)(ws + OFF_GQ) + (size_t)t0 * 512 + hq * 64, 512,
                             (const bf16_t*)(ws + OFF_GKS) + ((size_t)b * 2 + kv) * NKS * 64, (const bf16_t*)(ws + OFF_GVTS) + ((size_t)b * 2 + kv) * 64 * NKS, NKS,
                             (bf16_t*)(ws + OFF_MIX) + (size_t)t0 * D + 512 + hq * 64, lam);
        } else if (item < 512) {
            sgu_item(p, l, lds, tid, (item - 384) * 128);
        } else if (item < 768) {
            const int it = item - 512, hq = it & 7, b = it >> 3, kv = hq >> 2;
            const int t0 = b * SEQ;
            attn_item<false>(p, l, lds, tid, (const bf16_t*)(ws + OFF_GQ) + (size_t)t0 * 512 + hq * 64, 512,
                             (const bf16_t*)(ws + OFF_GKP) + ((size_t)b * 2 + kv) * SEQ * 64, (const bf16_t*)(ws + OFF_GVTP) + ((size_t)b * 2 + kv) * 64 * SEQ, SEQ,
                             (bf16_t*)(ws + OFF_MIX) + (size_t)t0 * D + 512 + hq * 64, lam);
        } else {
            const int it = item - 768, h = it & 3, b = it >> 2;
            const int t0 = b * SEQ;
            attn_item<true>(p, l, lds, tid, (const bf16_t*)(ws + OFF_DQ) + (size_t)t0 * 256 + h * 64, 256,
                            (const bf16_t*)(ws + OFF_DKP) + ((size_t)b * 4 + h) * SEQ * 64, (const bf16_t*)(ws + OFF_DVTP) + ((size_t)b * 4 + h) * 64 * SEQ, SEQ,
                            (bf16_t*)(ws + OFF_MIX) + (size_t)t0 * D + 256 + h * 64, lam);
        }
    }
}


using bf16x2 = __attribute__((ext_vector_type(2))) __bf16;
__device__ __forceinline__ float dot2bf(unsigned a, unsigned b, float c) {
    return __builtin_amdgcn_fdot2_f32_bf16(__builtin_bit_cast(bf16x2, a), __builtin_bit_cast(bf16x2, b), c, false);
}
template <int W>
__device__ __forceinline__ void bfly_stage(float (&part)[64], const int lane) {
    const bool hi = (lane & W) != 0;
#pragma unroll
    for (int k = 0; k < W; ++k) {
        const float keep = hi ? part[k + W] : part[k];
        const float send = hi ? part[k] : part[k + W];
        part[k] = keep + shfl_x(send, lane, W);
    }
}
constexpr int QW_PEER = 4160;
template <int W>
__device__ __forceinline__ void bfly16_stage(float (&v)[16], const int lane, const int bit) {
    const bool hi = (lane & bit) != 0;
#pragma unroll
    for (int k = 0; k < W; ++k) {
        const float keep = hi ? v[k + W] : v[k];
        const float send = hi ? v[k] : v[k + W];
        v[k] = keep + shfl_x(send, lane, bit);
    }
}
template <int W>
__device__ __forceinline__ void bfly16i_stage(int (&v)[16], const int lane, const int bit) {
    const bool hi = (lane & bit) != 0;
#pragma unroll
    for (int k = 0; k < W; ++k) {
        const int keep = hi ? v[k + W] : v[k];
        const int send = hi ? v[k] : v[k + W];
        v[k] = keep + shfl_x(send, lane, bit);
    }
}
template <bool VSIDE> struct PeerTok {
    static __device__ __forceinline__ void issue(const Params& p, const unsigned char* Tslice, const int elo, const int ehi, const int t, const int s,
                                                 const int sub, const int c16, u32x4 (&a)[16], u32x4 (&h)[2]) {
#pragma unroll
        for (int i = 0; i < 16; ++i) {
            const int e = shfl_i(i < 8 ? elo : ehi, (i * 8 + sub) & 63);
            a[i] = *reinterpret_cast<const u32x4*>(Tslice + (((unsigned)e << 7) + (unsigned)c16 * 16u));
        }
        if (!VSIDE) h[0] = *reinterpret_cast<const u32x4*>(p.ws + OFF_H8I + (size_t)t * D + s * 128 + c16 * 16);
    }
    static __device__ __forceinline__ void compute(const Params& p, const int l, const u32x4 w4, const float wsc, const int t, const int s,
                                                   const int lane, const int sub, const int c16, const u32x4 (&a)[16], const u32x4 (&h)[2]) {
        if (!VSIDE) {
            int d[16];
#pragma unroll
            for (int i = 0; i < 16; ++i) {
                int acc = 0;
#pragma unroll
                for (int k = 0; k < 4; ++k) acc = __builtin_amdgcn_sdot4((int)a[i][k], (int)h[0][k], acc, false);
                d[i] = acc;
            }
            bfly16i_stage<8>(d, lane, 4); bfly16i_stage<4>(d, lane, 2); bfly16i_stage<2>(d, lane, 1);
            const int i0 = ((lane & 4) << 1) + ((lane & 2) << 1) + ((lane & 1) << 1);
            int* PART = (int*)(p.ws + OFF_PART) + ((size_t)s * NTOK + t) * 128 + sub * 16 + i0;
            *reinterpret_cast<int2*>(PART) = make_int2(d[0], d[1]);
        } else {
            int acc[16];
#pragma unroll
            for (int i = 0; i < 16; ++i) acc[i] = 0;
#pragma unroll
            for (int g = 0; g < 4; ++g) {
                const int wg = (int)w4[g];
#pragma unroll
                for (int k = 0; k < 4; ++k) {
                    const unsigned r0 = a[4 * g][k], r1 = a[4 * g + 1][k], r2 = a[4 * g + 2][k], r3 = a[4 * g + 3][k];
                    const unsigned x01l = __builtin_amdgcn_perm(r1, r0, 0x05010400u), x01h = __builtin_amdgcn_perm(r1, r0, 0x07030602u);
                    const unsigned x23l = __builtin_amdgcn_perm(r3, r2, 0x05010400u), x23h = __builtin_amdgcn_perm(r3, r2, 0x07030602u);
                    const unsigned t0 = __builtin_amdgcn_perm(x23l, x01l, 0x05040100u), t1 = __builtin_amdgcn_perm(x23l, x01l, 0x07060302u);
                    const unsigned t2 = __builtin_amdgcn_perm(x23h, x01h, 0x05040100u), t3 = __builtin_amdgcn_perm(x23h, x01h, 0x07060302u);
                    acc[4 * k]     = __builtin_amdgcn_sdot4((int)t0, wg, acc[4 * k], false);
                    acc[4 * k + 1] = __builtin_amdgcn_sdot4((int)t1, wg, acc[4 * k + 1], false);
                    acc[4 * k + 2] = __builtin_amdgcn_sdot4((int)t2, wg, acc[4 * k + 2], false);
                    acc[4 * k + 3] = __builtin_amdgcn_sdot4((int)t3, wg, acc[4 * k + 3], false);
                }
            }
            bfly16i_stage<8>(acc, lane, 32); bfly16i_stage<4>(acc, lane, 16); bfly16i_stage<2>(acc, lane, 8);
            const int col = s * 128 + c16 * 16 + ((lane & 32) >> 2) + ((lane & 16) >> 2) + ((lane & 8) >> 2);
            const float* g2 = (const float*)(p.ws + OFF_MOD) + (size_t)(l * 5 + tok_cv(t)) * 6144 + 5 * 1024 + col;
            unsigned* XC = reinterpret_cast<unsigned*>((bf16_t*)(p.ws + OFF_XC) + (size_t)t * D + col);
            const unsigned x = *XC; const float2 g = *reinterpret_cast<const float2*>(g2);
            *XC = pack_bf2(__uint_as_float(x << 16) + g.x * wsc * (float)acc[0], __uint_as_float(x & 0xffff0000u) + g.y * wsc * (float)acc[1]);
        }
    }
};
template <bool VSIDE>
__device__ __forceinline__ void peer_slice_stream(const Params& p, const int l, const int s, const int first, const int stride, const int lane) {
    const int sub = lane >> 3, c16 = lane & 7;
    const unsigned char* Ts = p.ws + (VSIDE ? OFF_VT : OFF_UT) + ((size_t)l * 8 + s) * NEXP * 128;
    const int* EIb = (const int*)(p.ws + OFF_EIDX); const unsigned char* WPb = p.ws + OFF_WPAIR; const float* WSb = (const float*)(p.ws + OFF_WSC);
    if (first >= NTOK) return;
    const int cnt = (NTOK - first + stride - 1) / stride;
#define PEER_LOADE(k, elo, ehi, w4, wsc) do { const int _t = min(first + (k) * stride, NTOK - 1); \
        elo = EIb[(size_t)_t * 128 + lane]; ehi = EIb[(size_t)_t * 128 + 64 + lane]; \
        if (VSIDE) { w4 = *reinterpret_cast<const u32x4*>(WPb + (size_t)_t * 128 + sub * 16); wsc = WSb[_t]; } } while (0)
    int e0l, e0h, e1l, e1h, e2l, e2h;
    u32x4 w0 = {0u, 0u, 0u, 0u}, w1 = {0u, 0u, 0u, 0u}, w2 = {0u, 0u, 0u, 0u}; float s0 = 0.f, s1 = 0.f, s2 = 0.f;
    u32x4 A[16], B[16], hA[2], hB[2];
    PEER_LOADE(0, e0l, e0h, w0, s0);
    PEER_LOADE(1, e1l, e1h, w1, s1);
    PeerTok<VSIDE>::issue(p, Ts, e0l, e0h, first, s, sub, c16, A, hA);
    for (int k = 0; k < cnt; k += 2) {
        const int ta = first + k * stride, tb = min(ta + stride, NTOK - 1), tc = min(ta + 2 * stride, NTOK - 1);
        __builtin_amdgcn_sched_barrier(0);
        PEER_LOADE(k + 2, e2l, e2h, w2, s2);
        PeerTok<VSIDE>::issue(p, Ts, e1l, e1h, tb, s, sub, c16, B, hB);
        __builtin_amdgcn_sched_barrier(0);
        PeerTok<VSIDE>::compute(p, l, w0, s0, ta, s, lane, sub, c16, A, hA);
        __builtin_amdgcn_sched_barrier(0);
        e0l = e2l; e0h = e2h; w0 = w2; s0 = s2;
        PEER_LOADE(k + 3, e2l, e2h, w2, s2);
        PeerTok<VSIDE>::issue(p, Ts, e0l, e0h, tc, s, sub, c16, A, hA);
        __builtin_amdgcn_sched_barrier(0);
        if (k + 1 < cnt) PeerTok<VSIDE>::compute(p, l, w1, s1, tb, s, lane, sub, c16, B, hB);
        e1l = e2l; e1h = e2h; w1 = w2; s1 = s2;
    }
#undef PEER_LOADE
}
template <bool VSIDE>
__device__ void ph_peer_sliced(const Params& p, int l, unsigned char* ldsraw, const int wv) {
    const int tid = opaque_tid(wv);
    const int wave = tid >> 6, lane = tid & 63;
    volatile LAS int* hdr = (volatile LAS int*)(ldsraw - LDS_HDR);
    unsigned* bar = (unsigned*)(p.ws + OFF_BAR);
    const int myx = (int)(xb_xcc_id() & 15u);
    if (tid == 0) hdr[16] = (int)atomicAdd(bar + QW_PEER + (l * 2 + (VSIDE ? 1 : 0)) * 16 + myx, 1u);
    __syncthreads();
    const int rank = hdr[16], nloc = (int)hdr[0];
    __syncthreads();
    if (myx < 8) peer_slice_stream<VSIDE>(p, l, myx, rank * 8 + wave, nloc * 8, lane);
    for (int j = 0; j < 8; ++j) {
        if (xb_ld(&bar[XB_XCNT(j)]) == 0u) peer_slice_stream<VSIDE>(p, l, j, (int)blockIdx.x * 8 + wave, (int)gridDim.x * 8, lane);
    }
}
__device__ void ph_peer_pairw(const Params& p, int l, const int wv) {
    const int tid = opaque_tid(wv);
    const int lane = tid & 63;
    const float* USC = (const float*)(p.ws + OFF_USC) + l * NEXP; const float* VSC = (const float*)(p.ws + OFF_VSC) + l * NEXP;
    const int* PART = (const int*)(p.ws + OFF_PART);
    const float* HSC = (const float*)(p.ws + OFF_HSC);
    for (size_t i4 = GTID; i4 < (size_t)NTOK * 32; i4 += GNT) {
        const size_t idx = i4 * 4;
        const int t = (int)(idx >> 7), pp = (int)(idx & 127), sub = pp >> 4, i = pp & 15;
        int4 ps[8];
#pragma unroll
        for (int s = 0; s < 8; ++s) ps[s] = *reinterpret_cast<const int4*>(PART + (size_t)s * NTOK * 128 + idx);
        int e[4]; float g[4];
#pragma unroll
        for (int q = 0; q < 4; ++q) {
            const int j = (i + q) * 8 + sub;
            e[q] = ((const int*)(p.ws + OFF_EIDX))[(size_t)t * 128 + j]; g[q] = ((const float*)(p.ws + OFF_EGATE))[(size_t)t * 128 + j];
        }
        int4 sum = ps[0];
#pragma unroll
        for (int s = 1; s < 8; ++s) { sum.x += ps[s].x; sum.y += ps[s].y; sum.z += ps[s].z; sum.w += ps[s].w; }
        const float hs = HSC[t];
        float w[4];
        w[0] = g[0] * gelu_f((float)sum.x * (USC[e[0]] * hs)) * VSC[e[0]]; w[1] = g[1] * gelu_f((float)sum.y * (USC[e[1]] * hs)) * VSC[e[1]];
        w[2] = g[2] * gelu_f((float)sum.z * (USC[e[2]] * hs)) * VSC[e[2]]; w[3] = g[3] * gelu_f((float)sum.w * (USC[e[3]] * hs)) * VSC[e[3]];
        float am = fmaxf(fmaxf(fabsf(w[0]), fabsf(w[1])), fmaxf(fabsf(w[2]), fabsf(w[3])));
#pragma unroll
        for (int o = 16; o >= 1; o >>= 1) am = fmaxf(am, shfl_x(am, lane, o));
        const float sc = am > 0.f ? 127.f / am : 1.f;
        *reinterpret_cast<unsigned*>(p.ws + OFF_WPAIR + idx) = pack4_i8(q8(w[0] * sc), q8(w[1] * sc), q8(w[2] * sc), q8(w[3] * sc));
        if (pp == 0) ((float*)(p.ws + OFF_WSC))[t] = am > 0.f ? am * (1.f / 127.f) : 1.f;
    }
}

#define CE_DESC(a, b) do { const float _mx = fmaxf((a), (b)); const float _mn = fminf((a), (b)); (a) = _mx; (b) = _mn; } while (0)
__device__ __forceinline__ void sort16_desc(float (&v)[16]) {
#pragma unroll
    for (int k = 2; k <= 16; k <<= 1)
#pragma unroll
        for (int j = k >> 1; j > 0; j >>= 1)
#pragma unroll
            for (int i = 0; i < 16; ++i) {
                const int m = i ^ j;
                if (m > i) { if ((i & k) == 0) CE_DESC(v[i], v[m]); else CE_DESC(v[m], v[i]); }
            }
}
__device__ __forceinline__ void merge_top16(float (&a)[16], const float (&b)[16]) {
#pragma unroll
    for (int i = 0; i < 16; ++i) a[i] = fmaxf(a[i], b[15 - i]);
#pragma unroll
    for (int j = 8; j > 0; j >>= 1)
#pragma unroll
        for (int i = 0; i < 16; ++i) { const int m = i ^ j; if (m > i) CE_DESC(a[i], a[m]); }
}
__device__ __forceinline__ float key_embed(float v, unsigned lowmask, unsigned idxbits) { return __uint_as_float((__float_as_uint(v) & ~lowmask) | idxbits); }

constexpr int SK_ROWB = 144;
__device__ __forceinline__ void peer_stage1(const LAS unsigned char* SK  , const bf16_t* __restrict__ Qrow  ,
                                            const int r, const int hh, float (&out)[16]) {
    bf16x8 qb[4];
#pragma unroll
    for (int ks = 0; ks < 4; ++ks) qb[ks] = *reinterpret_cast<const bf16x8*>(Qrow + ks * 16 + hh * 8);
    float grp[4][16];
#pragma unroll
    for (int mt = 0; mt < 4; ++mt) {
        f32x16 acc;
#pragma unroll
        for (int i = 0; i < 16; ++i) acc[i] = 0.f;
#pragma unroll
        for (int ks = 0; ks < 4; ++ks) {
            const bf16x8 a = *(const LAS bf16x8*)(SK + (mt * 32 + r) * SK_ROWB + (ks * 16 + hh * 8) * 2);
            acc = MFMA32(a, qb[ks], acc);
        }
        const unsigned hx = (unsigned)hh << 2;
#pragma unroll
        for (int i = 0; i < 16; ++i) {
            const unsigned cn = 32u * mt + (i & 3) + 8u * (i >> 2);
            grp[mt][i] = key_embed(acc[i], 127u, (127u - cn) ^ hx);
        }
        sort16_desc(grp[mt]);
    }
    merge_top16(grp[0], grp[1]); merge_top16(grp[2], grp[3]); merge_top16(grp[0], grp[2]);
    float pb[16];
#pragma unroll
    for (int i = 0; i < 16; ++i) pb[i] = shfl_x(grp[0][i], (hh << 5) | r, 32);
    merge_top16(grp[0], pb);
#pragma unroll
    for (int i = 0; i < 16; ++i) out[i] = grp[0][i];
}

__device__ void ph_peer_select(const Params& p, int l, unsigned char* ldsraw, const int wv) {
    const int tid = opaque_tid(wv);
    const int wave = tid >> 6, lane = tid & 63, r = lane & 31, hh = lane >> 5;
    const int gw = blockIdx.x * 8 + wave, nw = gridDim.x * 8;
    LAS unsigned char* skl = (LAS unsigned char*)ldsraw;
    LAS unsigned char* myl = skl + 2 * 128 * SK_ROWB + wave * 2048 + lane * 32;
    {
        const bf16_t* SKg = (const bf16_t*)(p.ws + OFF_SUBK) + (size_t)l * 2 * 128 * 64;
        for (int i = tid; i < 2 * 128 * 8; i += NT) {
            const int row = i >> 3, ch = i & 7;
            *(LAS u32x4*)(skl + row * SK_ROWB + ch * 16) = *reinterpret_cast<const u32x4*>(SKg + (size_t)row * 64 + ch * 8);
        }
        __syncthreads();
    }
    for (int task = gw; task < (NTOK / 32) * 4; task += nw) {
        const int tg = task >> 2, k = task & 3;
        const int t = tg * 32 + r;
        const bf16_t* Qt = (const bf16_t*)(p.ws + OFF_Q) + (size_t)t * D;
        float sv[2][16];
#pragma unroll
        for (int x = 0; x < 2; ++x) {
            float la[16], lb[16];
            peer_stage1(skl + x * 128 * SK_ROWB, Qt + k * 128 + x * 64, r, hh, la);
            peer_stage1(skl + x * 128 * SK_ROWB, Qt + (k + 4) * 128 + x * 64, r, hh, lb);
#pragma unroll
            for (int i = 0; i < 16; ++i) sv[x][i] = hh ? lb[i] : la[i];
        }
        {
            unsigned w[8];
#pragma unroll
            for (int q = 0; q < 8; ++q) {
                w[q] = 0u;
#pragma unroll
                for (int b = 0; b < 4; ++b) {
                    const int i = q * 4 + b;
                    const unsigned key = __float_as_uint(i < 16 ? sv[0][i] : sv[1][i - 16]);
                    w[q] |= (127u - (key & 127u)) << (8 * b);
                }
            }
            *(LAS u32x4*)(myl) = u32x4{w[0], w[1], w[2], w[3]};
            *(LAS u32x4*)(myl + 16) = u32x4{w[4], w[5], w[6], w[7]};
        }
        float val0[16], val1[16];
#pragma unroll
        for (int i = 0; i < 16; ++i) { val0[i] = __uint_as_float(__float_as_uint(sv[0][i]) & ~127u); val1[i] = __uint_as_float(__float_as_uint(sv[1][i]) & ~127u); }
        float g0[16], g1[16], g2[16], g3[16];
#pragma unroll
        for (int b = 0; b < 16; ++b) g0[b] = key_embed(val0[0] + val1[b], 255u, 255u - (unsigned)b);
#pragma unroll
        for (int b = 0; b < 8; ++b) g1[b] = key_embed(val0[1] + val1[b], 255u, 255u - (16u + b));
#pragma unroll
        for (int b = 0; b < 5; ++b) g1[8 + b] = key_embed(val0[2] + val1[b], 255u, 255u - (32u + b));
#pragma unroll
        for (int b = 0; b < 3; ++b) g1[13 + b] = key_embed(val0[4] + val1[b], 255u, 255u - (64u + b));
#pragma unroll
        for (int b = 0; b < 4; ++b) g2[b] = key_embed(val0[3] + val1[b], 255u, 255u - (48u + b));
#pragma unroll
        for (int a = 5; a < 8; ++a)
#pragma unroll
            for (int b = 0; b < 2; ++b) g2[4 + (a - 5) * 2 + b] = key_embed(val0[a] + val1[b], 255u, 255u - (16u * a + b));
#pragma unroll
        for (int a = 8; a < 14; ++a) g2[10 + (a - 8)] = key_embed(val0[a] + val1[0], 255u, 255u - 16u * a);
        g3[0] = key_embed(val0[14] + val1[0], 255u, 255u - 16u * 14); g3[1] = key_embed(val0[15] + val1[0], 255u, 255u - 16u * 15);
#pragma unroll
        for (int i = 2; i < 16; ++i) g3[i] = -3.0e38f;
        sort16_desc(g1); sort16_desc(g2); sort16_desc(g3);
        merge_top16(g0, g1); merge_top16(g2, g3); merge_top16(g0, g2);
        float gate[16]; int eid[16];
        const float mx = __uint_as_float(__float_as_uint(g0[0]) & ~255u);
        float sum = 0.f;
#pragma unroll
        for (int i = 0; i < 16; ++i) {
            const unsigned key = __float_as_uint(g0[i]);
            gate[i] = __expf(__uint_as_float(key & ~255u) - mx); sum += gate[i];
            const unsigned id = 255u - (key & 255u);
            const unsigned n0 = *(const LAS unsigned char*)(myl + (id >> 4));
            const unsigned n1 = *(const LAS unsigned char*)(myl + 16 + (id & 15u));
            eid[i] = (int)(n0 * 128u + n1);
        }
        const float inv = 1.f / sum;
        const int h = k + 4 * hh;
        int* EI = (int*)(p.ws + OFF_EIDX) + (size_t)t * 128 + h * 16; float* EG = (float*)(p.ws + OFF_EGATE) + (size_t)t * 128 + h * 16;
#pragma unroll
        for (int q = 0; q < 4; ++q) {
            *reinterpret_cast<int4*>(EI + q * 4) = make_int4(eid[q * 4], eid[q * 4 + 1], eid[q * 4 + 2], eid[q * 4 + 3]);
            *reinterpret_cast<float4*>(EG + q * 4) = make_float4(gate[q * 4] * inv, gate[q * 4 + 1] * inv, gate[q * 4 + 2] * inv, gate[q * 4 + 3] * inv);
        }
    }
}

constexpr int LDS_BYTES = LDS_HDR + 3 * 48 * 1024;
__global__ void __launch_bounds__(NT, 2) mk_fwd(Params p) {
    extern __shared__ __attribute__((aligned(16))) unsigned char lds[];
    const int wv = __builtin_amdgcn_readfirstlane((int)(threadIdx.x >> 6));
    volatile LAS unsigned* st = (volatile LAS unsigned*)lds;
    if (threadIdx.x < 4) st[threadIdx.x] = 0u;
    __syncthreads();
    XcdBarrier xb = xcd_barrier_post((unsigned*)(p.ws + OFF_BAR), st);
    int bar_idx = 0;
#define GRID_BAR() do { xcd_barrier(xb); \
        if (PROBE_TS >= 0 && blockIdx.x == 0 && threadIdx.x == 0 && (bar_idx == PROBE_TS - 1 || bar_idx == PROBE_TS)) \
            ((volatile LAS unsigned long long*)(lds + 128))[bar_idx - (PROBE_TS - 1)] = __builtin_amdgcn_s_memrealtime(); \
        ++bar_idx; } while (0)
    if (PROBE_TS == 0 && blockIdx.x == 0 && threadIdx.x == 0) ((volatile LAS unsigned long long*)(lds + 128))[0] = __builtin_amdgcn_s_memrealtime();
    unsigned char* ws = p.ws;
    for (int rep = 0; rep < (PROBE_DUP == 1 ? 2 : 1); ++rep) {
    for (int l = 0; l < 2; ++l) {
        ph_transpose(p.in[I_WIN] + (size_t)l * D * INW, (bf16_t*)(ws + OFF_WIN) + (size_t)l * INW * D, D, INW, lds + LDS_HDR, wv);
        ph_transpose(p.in[I_WOUT] + (size_t)l * D * D, (bf16_t*)(ws + OFF_WOUT) + (size_t)l * D * D, D, D, lds + LDS_HDR, wv);
        ph_transpose(p.in[I_WQ] + (size_t)l * D * D, (bf16_t*)(ws + OFF_WQ) + (size_t)l * D * D, D, D, lds + LDS_HDR, wv);
    }
    ph_convert_i8_rows(p.in[I_PU], ws + OFF_UT, (float*)(ws + OFF_USC), 2 * NEXP, wv);
    ph_convert_i8_rows(p.in[I_PV], ws + OFF_VT, (float*)(ws + OFF_VSC), 2 * NEXP, wv);
    ph_convert(p.in[I_SUBK], (bf16_t*)(ws + OFF_SUBK), 2 * 2 * 128 * 64, wv);
    ph_convert(p.in[I_SGUW], (bf16_t*)(ws + OFF_SGUW), 2 * 4 * 128 * 128, wv);
    ph_mod(p, lds + LDS_HDR, wv);
    ph_rope_tab(p, wv);
    GRID_BAR();
    }
    for (int l = 0; l < 2; ++l) {
        for (int rep = 0; rep < (PROBE_DUP == 3 ? 2 : 1); ++rep) {
        ph_norm_mod(p, l, 0, l == 0 ? 1 : 0, wv);
        ph_cache_prep(p, l, wv);
        GRID_BAR();
        }
        for (int rep = 0; rep < (PROBE_DUP == 5 ? 2 : 1); ++rep) {
        gemm_phase<EPI_INPROJ>(p, l, (const bf16_t*)(ws + OFF_H), (const bf16_t*)(ws + OFF_WIN) + (size_t)l * INW * D, INW, lds + LDS_HDR, wv);
        GRID_BAR();
        }
        for (int rep = 0; rep < ((PROBE_DUP == 4 || (PROBE_DUP >= 10 && PROBE_DUP <= 12)) ? 2 : 1); ++rep) {
        ph_mixers(p, l + 2 * rep, lds + LDS_HDR, wv);
        GRID_BAR();
        }
        gemm_phase<EPI_WOUT>(p, l, (const bf16_t*)(ws + OFF_MIX), (const bf16_t*)(ws + OFF_WOUT) + (size_t)l * D * D, D, lds + LDS_HDR, wv);
        GRID_BAR();
        ph_norm_mod(p, l, 1, 0, wv);
        GRID_BAR();
        for (int rep = 0; rep < (PROBE_DUP == 7 ? 2 : 1); ++rep) {
        gemm_phase<EPI_WQ>(p, l, (const bf16_t*)(ws + OFF_H), (const bf16_t*)(ws + OFF_WQ) + (size_t)l * D * D, D, lds + LDS_HDR, wv);
        GRID_BAR();
        }
        if (PROBE_DUP == 8) { for (int rep = 0; rep < 10; ++rep) GRID_BAR(); }
        for (int rep = 0; rep < (PROBE_DUP == 2 ? 2 : 1); ++rep) {
        ph_peer_select(p, l, lds + LDS_HDR, wv);
        GRID_BAR();
        }
        ph_peer_sliced<false>(p, l, lds + LDS_HDR, wv);
        GRID_BAR();
        ph_peer_pairw(p, l, wv);
        GRID_BAR();
        ph_peer_sliced<true>(p, l, lds + LDS_HDR, wv);
        GRID_BAR();
    }
    ph_final_norm(p, wv);
    if (PROBE_TS >= 0 && blockIdx.x == 0 && threadIdx.x == 0) {
        asm volatile("s_waitcnt vmcnt(0)" ::: "memory");
        volatile LAS unsigned long long* tsl = (volatile LAS unsigned long long*)(lds + 128);
        p.out[0] += (float)(tsl[1] - tsl[0]) * 0.01f;
    }
}

extern "C" void kernel_launch(void* const* d_in, const int* in_sizes, int n_in,
                              void* d_out, int out_size, void* d_ws, size_t ws_size,
                              hipStream_t stream) {
    static int grid = 0;
    if (grid == 0) {
        if (ws_size < WS_NEED) { fprintf(stderr, "kernel_launch: workspace too small: %zu < %zu\n", ws_size, (size_t)WS_NEED); grid = -1; return; }
        int dev = 0, cus = 0, per_cu = 0;
        (void)hipGetDevice(&dev);
        (void)hipDeviceGetAttribute(&cus, hipDeviceAttributeMultiprocessorCount, dev);
        (void)hipFuncSetAttribute((const void*)mk_fwd, hipFuncAttributeMaxDynamicSharedMemorySize, LDS_BYTES);
        (void)hipOccupancyMaxActiveBlocksPerMultiprocessor(&per_cu, (const void*)mk_fwd, NT, LDS_BYTES);
        if (per_cu < 1) { fprintf(stderr, "kernel_launch: occupancy query reports %d blocks per CU\n", per_cu); grid = -1; return; }
        grid = cus;
    }
    if (grid < 0) return;
    (void)hipMemsetAsync((unsigned char*)d_ws + OFF_BAR, 0, 64 * 1024, stream);
    Params p{};
    for (int i = 0; i < 29; ++i) p.in[i] = (const float*)d_in[i];
    p.out = (float*)d_out; p.ws = (unsigned char*)d_ws;
    void* args[] = {&p};
    hipError_t e = hipLaunchCooperativeKernel((const void*)mk_fwd, dim3(grid), dim3(NT), args, LDS_BYTES, stream);
    if (e != hipSuccess) fprintf(stderr, "kernel_launch: cooperative launch failed: %s (grid %d)\n", hipGetErrorString(e), grid);
}
```

```cpp
#include <hip/hip_runtime.h>
#include <hip/hip_bf16.h>
#include <cstdio>
#include <cstdint>
#include <hip/hip_cooperative_groups.h>
namespace cg = cooperative_groups;

#define PROBE_DUP 0
#define PROBE_TS -1
typedef unsigned short bf16_t;
using bf16x8 = __attribute__((ext_vector_type(8))) short;
using f32x4  = __attribute__((ext_vector_type(4))) float;
using f32x16 = __attribute__((ext_vector_type(16))) float;
using f32x2  = __attribute__((ext_vector_type(2))) float;
using u32x4  = __attribute__((ext_vector_type(4))) unsigned;
using u32x2  = __attribute__((ext_vector_type(2))) unsigned;
using s16x4  = __attribute__((ext_vector_type(4))) short;

constexpr int D      = 1024;
constexpr int NTOK   = 16384;
constexpr int NPT    = 8192;
constexpr int SEQ    = 256;
constexpr int DSEQ   = 2048;
constexpr int PAST   = 512;
constexpr int NKS    = DSEQ + PAST;
constexpr int INW    = 2048;
constexpr int NEXP   = 16384;
constexpr float EPS  = 1e-6f;

constexpr size_t MB = 1024 * 1024;
constexpr size_t OFF_BAR   = 0;
constexpr size_t OFF_MOD   = 64 * 1024;
constexpr size_t OFF_ROPE  = OFF_MOD + 256 * 1024;
constexpr size_t OFF_SUBK  = OFF_ROPE + 1 * MB;
constexpr size_t OFF_SGUW  = OFF_SUBK + 64 * 1024;
constexpr size_t OFF_WIN   = OFF_SGUW + 256 * 1024;
constexpr size_t OFF_WOUT  = OFF_WIN + 8 * MB;
constexpr size_t OFF_WQ    = OFF_WOUT + 4 * MB;
constexpr size_t OFF_UT    = OFF_WQ + 4 * MB;
constexpr size_t OFF_USC   = OFF_UT + 32 * MB;
constexpr size_t OFF_VT    = OFF_UT + 64 * MB;
constexpr size_t OFF_VSC   = OFF_VT + 32 * MB;
constexpr size_t OFF_H     = OFF_VT + 64 * MB;
constexpr size_t OFF_XC    = OFF_H + 32 * MB;
constexpr size_t OFF_R1    = OFF_XC + 64 * MB;
constexpr size_t OFF_AU    = OFF_R1;
constexpr size_t OFF_AV    = OFF_AU + 8 * MB;
constexpr size_t OFF_AVN   = OFF_AV + 8 * MB;
constexpr size_t OFF_DQ    = OFF_AVN + 8 * MB;
constexpr size_t OFF_DKP   = OFF_DQ + 8 * MB;
constexpr size_t OFF_DKS   = OFF_DKP + 4 * MB;
constexpr size_t OFF_DVTP  = OFF_DKS + 5 * MB;
constexpr size_t OFF_DVTS  = OFF_DVTP + 4 * MB;
constexpr size_t OFF_GQ    = OFF_DVTS + 5 * MB;
constexpr size_t OFF_GKP   = OFF_GQ + 16 * MB;
constexpr size_t OFF_GKS   = OFF_GKP + 2 * MB;
constexpr size_t OFF_GVTP  = OFF_GKS + 3 * MB;
constexpr size_t OFF_GVTS  = OFF_GVTP + 2 * MB;
constexpr size_t OFF_MIX   = OFF_GVTS + 3 * MB;
constexpr size_t OFF_R1END = OFF_MIX + 32 * MB;
constexpr size_t OFF_Q     = OFF_R1;
constexpr size_t OFF_EIDX  = OFF_Q + 32 * MB;
constexpr size_t OFF_EGATE = OFF_EIDX + 8 * MB;
constexpr size_t OFF_TOPV  = OFF_EGATE + 8 * MB;
constexpr size_t OFF_TOPI  = OFF_TOPV + 16 * MB;
static_assert(OFF_TOPI + 16 * MB <= OFF_R1END, "peer buffers must fit region 1");
constexpr size_t OFF_PROJ  = OFF_R1END;
constexpr size_t OFF_PART  = OFF_PROJ;
constexpr size_t OFF_WPAIR = OFF_PART + 64 * MB;
constexpr size_t OFF_H8I   = OFF_WPAIR + 8 * MB;
constexpr size_t OFF_HSC   = OFF_H8I + 16 * MB;
constexpr size_t OFF_WSC   = OFF_HSC + 64 * 1024;
constexpr size_t WS_NEED   = OFF_PROJ + 128 * MB;
static_assert(WS_NEED <= 512 * MB, "workspace budget");

constexpr size_t OUT_YP  = 0;
constexpr size_t OUT_YS  = 8388608;
constexpr size_t OUT_NDK = 16777216;
constexpr size_t OUT_NDV = OUT_NDK + 4194304;
constexpr size_t OUT_NGK = OUT_NDV + 4194304;
constexpr size_t OUT_NGV = OUT_NGK + 2097152;

struct Params {
    const float* in[29];
    float* out;
    unsigned char* ws;
};
enum { I_XP = 0, I_XS, I_CDK, I_CDV, I_CGK, I_CGV, I_C, I_CCTX, I_ADAW, I_ADAB, I_N1G, I_N2G, I_WIN, I_SGUNG, I_SGUW, I_SGUB,
       I_LQ1, I_LK1, I_LQ2, I_LK2, I_SUBLN, I_QNG, I_KNG, I_WOUT, I_WQ, I_SUBK, I_PU, I_PV, I_FG };

typedef __bf16 hwbf2 __attribute__((ext_vector_type(2)));
__device__ __forceinline__ unsigned pack_bf2(float a, float b) {
    const f32x2 v = {a, b};
    return __builtin_bit_cast(unsigned, __builtin_convertvector(v, hwbf2));
}
__device__ __forceinline__ bf16_t f2bf(float f) { return (bf16_t)(pack_bf2(f, 0.f) & 0xffffu); }
__device__ __forceinline__ float bf2f(bf16_t h) { return __uint_as_float(((unsigned)h) << 16); }
__device__ __forceinline__ float gelu_f(float x) {
    const float k2 = 2.f * 0.7978845608028654f * 1.4426950408889634f;
    const float e = __builtin_amdgcn_exp2f(k2 * (x + 0.044715f * x * x * x));
    return x - x * __builtin_amdgcn_rcpf(e + 1.f);
}
__device__ __forceinline__ int lane_id() { return (int)__builtin_amdgcn_mbcnt_hi(~0u, __builtin_amdgcn_mbcnt_lo(~0u, 0u)); }
__device__ __forceinline__ int lane_id_op() { int l = lane_id(); asm volatile("" : "+v"(l)); return l; }
__device__ __forceinline__ float shfl_i(float v, int src) { return __builtin_bit_cast(float, __builtin_amdgcn_ds_bpermute(src << 2, __builtin_bit_cast(int, v))); }
__device__ __forceinline__ int shfl_i(int v, int src) { return __builtin_amdgcn_ds_bpermute(src << 2, v); }
__device__ __forceinline__ float shfl_x(float v, int lane, int m) { return shfl_i(v, lane ^ m); }
__device__ __forceinline__ int shfl_x(int v, int lane, int m) { return shfl_i(v, lane ^ m); }
__device__ __forceinline__ int q8(float x) { return (int)fminf(fmaxf(rintf(x), -127.f), 127.f); }
__device__ __forceinline__ unsigned pack4_i8(int a, int b, int c, int d) { return (unsigned)(a & 255) | ((unsigned)(b & 255) << 8) | ((unsigned)(c & 255) << 16) | ((unsigned)d << 24); }
__device__ __forceinline__ float wave_sum(float v) {
    const int ln = lane_id_op();
#pragma unroll
    for (int o = 32; o >= 1; o >>= 1) v += shfl_x(v, ln, o);
    return v;
}
__device__ __forceinline__ int tok_cv(int t) { return t < NPT ? 0 : 1 + ((t - NPT) >> 11); }
__device__ __forceinline__ const float* x_in_row(const Params& p, int t) {
    return t < NPT ? p.in[I_XP] + (size_t)t * D : p.in[I_XS] + (size_t)(t - NPT) * D;
}
__device__ __forceinline__ float lam_init_of(int l) { return l == 0 ? 0.2f : (0.8f - 0.6f * 0.7408182206817179f); }
__device__ __forceinline__ float lam_of(const Params& p, int l) {
    float s1 = 0.f, s2 = 0.f;
    for (int i = 0; i < 32; ++i) {
        s1 += p.in[I_LQ1][l * 32 + i] * p.in[I_LK1][l * 32 + i];
        s2 += p.in[I_LQ2][l * 32 + i] * p.in[I_LK2][l * 32 + i];
    }
    return expf(s1) - expf(s2) + lam_init_of(l);
}


#define XB_TMO      128
#define XB_XCNT(j)  (256  + 64 * (j))
#define XB_XSUB(j)  (1280 + 64 * (j))
#define XB_XGEN(j)  (2304 + 64 * (j))
#define XB_TOP      3328
#define XB_TOPGEN   3392
#define XCD_BAR_WORDS 3456
#define XB_SPIN_CAP (1u << 20)
#define LAS __attribute__((address_space(3)))
__device__ __forceinline__ unsigned xb_ld(unsigned* p)              { return __hip_atomic_load(p, __ATOMIC_RELAXED, __HIP_MEMORY_SCOPE_AGENT); }
__device__ __forceinline__ unsigned xb_add(unsigned* p, unsigned v) { return __hip_atomic_fetch_add(p, v, __ATOMIC_RELAXED, __HIP_MEMORY_SCOPE_AGENT); }
__device__ __forceinline__ unsigned xb_xcc_id() { return (unsigned)__builtin_amdgcn_s_getreg((3 << 11) | 20) & 0xFu; }
#define XB_SPIN(cond, bar) do { unsigned _sp = 0; while (cond) { __builtin_amdgcn_s_sleep(1); \
    if ((++_sp & 255u) == 0u) { if (xb_ld(&(bar)[XB_TMO])) break; if (_sp > XB_SPIN_CAP) { atomicAdd(&(bar)[XB_TMO], 1u); break; } } } } while (0)
struct XcdBarrier { unsigned* bar; unsigned x; volatile LAS unsigned* st; };
__device__ __forceinline__ XcdBarrier xcd_barrier_post(unsigned* bar, volatile LAS unsigned* st) {
    XcdBarrier b; b.bar = bar; b.x = xb_xcc_id(); b.st = st;
    if (threadIdx.x == 0) (void)xb_add(&bar[XB_XCNT(b.x)], 1u);
    return b;
}
__device__ __forceinline__ void xcd_barrier_complete(unsigned* bar, unsigned x, unsigned& nloc, unsigned& nx) {
    const unsigned G = gridDim.x * gridDim.y * gridDim.z;
    unsigned sum, cnt, mine, sp = 0u;
    for (;;) {
        sum = 0u; cnt = 0u; mine = 0u;
#pragma unroll
        for (unsigned j = 0; j < 16; ++j) { const unsigned c = xb_ld(&bar[XB_XCNT(j)]); sum += c; cnt += (c > 0u) ? 1u : 0u; mine = (j == x) ? c : mine; }
        if (sum == G) break;
        __builtin_amdgcn_s_sleep(1);
        if ((++sp & 255u) == 0u) { if (xb_ld(&bar[XB_TMO])) break; if (sp > XB_SPIN_CAP) { atomicAdd(&bar[XB_TMO], 1u); break; } }
    }
    nloc = mine > 0u ? mine : 1u; nx = cnt > 0u ? cnt : 1u;
}
__device__ __forceinline__ void xcd_barrier(const XcdBarrier& b) {
    asm volatile("s_waitcnt vmcnt(0)" ::: "memory");
    __syncthreads();
    if (threadIdx.x == 0) {
        unsigned* bar = b.bar;
        const unsigned bx = xb_xcc_id();
        __builtin_amdgcn_s_waitcnt(0);
        unsigned nloc = b.st[0], nx = b.st[1];
        if (nloc == 0u) { xcd_barrier_complete(bar, bx, nloc, nx); b.st[0] = nloc; b.st[1] = nx; }
        const unsigned old = xb_add(&bar[XB_XSUB(bx)], 1u);
        const unsigned gen = old / nloc;
        if (old + 1u == (gen + 1u) * nloc) {
            __builtin_amdgcn_fence(__ATOMIC_RELEASE, "agent");
            asm volatile("s_waitcnt vmcnt(0)" ::: "memory");
            const unsigned og = xb_add(&bar[XB_TOP], 1u);
            const unsigned tg = og / nx;
            if (og + 1u == (tg + 1u) * nx) xb_add(&bar[XB_TOPGEN], 1u);
            else XB_SPIN(xb_ld(&bar[XB_TOPGEN]) == tg, bar);
            __builtin_amdgcn_fence(__ATOMIC_ACQUIRE, "agent");
            xb_add(&bar[XB_XGEN(bx)], 1u);
            asm volatile("s_waitcnt vmcnt(0)" ::: "memory");
        } else {
            XB_SPIN(xb_ld(&bar[XB_XGEN(bx)]) == gen, bar);
            __builtin_amdgcn_fence(__ATOMIC_ACQUIRE, "agent");
            asm volatile("s_waitcnt vmcnt(0)" ::: "memory");
        }
    }
    __syncthreads();
}

constexpr int NT = 512;
constexpr int LDS_HDR = 1024;
#define GTID ((size_t)blockIdx.x * NT + tid)
__device__ __forceinline__ int opaque_tid(int wv) { int t = (wv << 6) | lane_id(); asm volatile("" : "+v"(t)); return t; }
#define GNT  ((size_t)gridDim.x * NT)

__device__ void ph_transpose(const float* __restrict__ W, bf16_t* __restrict__ Wt, int K, int N, unsigned char* ldsraw, const int wv) {
    const int tid = opaque_tid(wv);
    LAS bf16_t* T = (LAS bf16_t*)ldsraw;
    const int tk = K / 128, tn = N / 64, ntiles = tk * tn;
    for (int tile = blockIdx.x; tile < ntiles; tile += gridDim.x) {
        const int k0 = (tile % tk) * 128, n0 = (tile / tk) * 64;
#pragma unroll 4
        for (int i = 0; i < 16; ++i) {
            const int kl = i * 8 + (tid >> 6), nl = tid & 63;
            T[nl * 130 + kl] = f2bf(W[(size_t)(k0 + kl) * N + n0 + nl]);
        }
        __syncthreads();
        {
            const int nl = tid >> 3, kc = tid & 7;
            unsigned w[8];
#pragma unroll
            for (int i = 0; i < 8; ++i) w[i] = (unsigned)T[nl * 130 + kc * 16 + 2 * i] | ((unsigned)T[nl * 130 + kc * 16 + 2 * i + 1] << 16);
            bf16_t* dst = Wt + (size_t)(n0 + nl) * K + k0 + kc * 16;
            *reinterpret_cast<u32x4*>(dst) = u32x4{w[0], w[1], w[2], w[3]};
            *reinterpret_cast<u32x4*>(dst + 8) = u32x4{w[4], w[5], w[6], w[7]};
        }
        __syncthreads();
    }
}
__device__ void ph_convert(const float* __restrict__ src, bf16_t* __restrict__ dst, size_t n, const int wv) {
    const int tid = opaque_tid(wv);
    for (size_t idx = GTID; idx < n; idx += GNT) dst[idx] = f2bf(src[idx]);
}
__device__ void ph_convert_i8_rows(const float* __restrict__ src, unsigned char* __restrict__ dst, float* __restrict__ scl, int nrows, const int wv) {
    const int tid = opaque_tid(wv);
    const int lane = tid & 63;
    const int gw = blockIdx.x * 8 + (tid >> 6), nw = gridDim.x * 8;
    for (int row0 = gw * 4; row0 < nrows; row0 += nw * 4) {
        float4 f[4][4];
#pragma unroll
        for (int q = 0; q < 4; ++q)
#pragma unroll
            for (int i = 0; i < 4; ++i) f[q][i] = *reinterpret_cast<const float4*>(src + (size_t)(row0 + q) * D + lane * 16 + i * 4);
#pragma unroll
        for (int q = 0; q < 4; ++q) {
            const int row = row0 + q;
            float v[16];
#pragma unroll
            for (int i = 0; i < 4; ++i) { v[i * 4] = f[q][i].x; v[i * 4 + 1] = f[q][i].y; v[i * 4 + 2] = f[q][i].z; v[i * 4 + 3] = f[q][i].w; }
            float am = 0.f;
#pragma unroll
            for (int i = 0; i < 16; ++i) am = fmaxf(am, fabsf(v[i]));
#pragma unroll
            for (int o = 32; o >= 1; o >>= 1) am = fmaxf(am, shfl_x(am, lane, o));
            const float sc = am > 0.f ? 127.f / am : 1.f;
            unsigned w[4];
#pragma unroll
            for (int i = 0; i < 4; ++i) w[i] = pack4_i8(q8(v[i * 4] * sc), q8(v[i * 4 + 1] * sc), q8(v[i * 4 + 2] * sc), q8(v[i * 4 + 3] * sc));
            {
                const int lyr = row >> 14, e = row & (NEXP - 1);
                *reinterpret_cast<u32x4*>(dst + (((size_t)lyr * 8 + (lane >> 3)) * NEXP + e) * 128 + (lane & 7) * 16) = u32x4{w[0], w[1], w[2], w[3]};
            }
            if (lane == 0) scl[row] = am > 0.f ? am * (1.f / 127.f) : 1.f;
        }
    }
}
__device__ void ph_mod(const Params& p, unsigned char* ldsraw, const int wv) {
    const int tid = opaque_tid(wv);
    LAS float* sl = (LAS float*)ldsraw;
    LAS float* red = sl + 5 * 1024;
    for (int i = tid; i < 5 * 1024; i += NT) {
        const int cv = i >> 10, k = i & 1023;
        const float c = cv == 0 ? p.in[I_CCTX][k] : p.in[I_C][(size_t)(cv - 1) * D + k];
        sl[i] = c / (1.f + __expf(-c));
    }
    __syncthreads();
    const int c = tid & 63, ks = tid >> 6;
    for (int item = blockIdx.x; item < 2 * 96; item += gridDim.x) {
        const int l = item / 96, j = (item % 96) * 64 + c;
        const float* W = p.in[I_ADAW] + (size_t)l * D * 6144 + (size_t)(ks * 128) * 6144 + j;
        float acc[5] = {0.f, 0.f, 0.f, 0.f, 0.f};
#pragma unroll 8
        for (int k = 0; k < 128; ++k) {
            const float w = W[(size_t)k * 6144];
#pragma unroll
            for (int cv = 0; cv < 5; ++cv) acc[cv] += sl[cv * 1024 + ks * 128 + k] * w;
        }
#pragma unroll
        for (int cv = 0; cv < 5; ++cv) red[(ks * 5 + cv) * 64 + c] = acc[cv];
        __syncthreads();
        if (tid < 320) {
            const int cv = tid >> 6;
            float sum = p.in[I_ADAB][l * 6144 + j];
#pragma unroll
            for (int q = 0; q < 8; ++q) sum += red[(q * 5 + cv) * 64 + c];
            ((float*)(p.ws + OFF_MOD))[(size_t)(l * 5 + cv) * 6144 + j] = sum;
        }
        __syncthreads();
    }
}
__device__ void ph_rope_tab(const Params& p, const int wv) {
    const int tid = opaque_tid(wv);
    for (size_t idx = GTID; idx < 2048 * 48; idx += GNT) {
        int s = idx / 48, i = idx % 48;
        float* R = (float*)(p.ws + OFF_ROPE);
        double row = (double)(s / 64), col = (double)(s % 64);
        if (i < 16) {
            int q = i & 7; double inv = pow(10000.0, -(double)q / 8.0);
            double ang = (i < 8 ? row : col) * inv;
            R[s * 16 + i] = (float)cos(ang); R[2048 * 16 + s * 16 + i] = (float)sin(ang);
        } else {
            int ii = i - 16; int q = ii & 15; double inv = pow(10000.0, -(double)q / 16.0);
            double ang = (ii < 16 ? row : col) * inv;
            R[2048 * 32 + s * 32 + ii] = (float)cos(ang); R[2048 * 64 + s * 32 + ii] = (float)sin(ang);
        }
    }
}
__device__ void ph_cache_prep(const Params& p, int l, const int wv) {
    const int tid = opaque_tid(wv);
    bf16_t* DKS = (bf16_t*)(p.ws + OFF_DKS); bf16_t* DVTS = (bf16_t*)(p.ws + OFF_DVTS);
    bf16_t* GKS = (bf16_t*)(p.ws + OFF_GKS); bf16_t* GVTS = (bf16_t*)(p.ws + OFF_GVTS);
    for (size_t idx = GTID; idx < 4 * 512 * 256; idx += GNT) {
        int c = idx & 255, pp = (idx >> 8) & 511, b = idx >> 17;
        size_t src = (((size_t)b * 2 + l) * PAST + pp) * 256 + c;
        int h = c >> 6, r = c & 63;
        DKS[(((size_t)b * 4 + h) * NKS + DSEQ + pp) * 64 + r] = f2bf(p.in[I_CDK][src]);
        DVTS[(((size_t)b * 4 + h) * 64 + r) * NKS + DSEQ + pp] = f2bf(p.in[I_CDV][src]);
        if (c < 128) {
            size_t src2 = (((size_t)b * 2 + l) * PAST + pp) * 128 + c;
            int kv = c >> 6;
            GKS[(((size_t)b * 2 + kv) * NKS + DSEQ + pp) * 64 + r] = f2bf(p.in[I_CGK][src2]);
            GVTS[(((size_t)b * 2 + kv) * 64 + r) * NKS + DSEQ + pp] = f2bf(p.in[I_CGV][src2]);
        }
    }
}
__device__ void ph_norm_mod(const Params& p, int l, int which, int from_input, const int wv) {
    const int tid = opaque_tid(wv);
    const int lane = tid & 63;
    const int gw = blockIdx.x * 8 + (tid >> 6), nw = gridDim.x * 8;
    const float* g = p.in[which ? I_N2G : I_N1G] + l * D;
    if (from_input) {
        float4 nx[4];
        {
            const int t = gw < NTOK ? gw : NTOK - 1;
            const float* xr = x_in_row(p, t);
#pragma unroll
            for (int i = 0; i < 4; ++i) nx[i] = *reinterpret_cast<const float4*>(xr + i * 256 + lane * 4);
        }
        for (int t = gw; t < NTOK; t += nw) {
            float4 v[4];
#pragma unroll
            for (int i = 0; i < 4; ++i) v[i] = nx[i];
            {
                const int tn = t + nw < NTOK ? t + nw : t;
                const float* xn = x_in_row(p, tn);
#pragma unroll
                for (int i = 0; i < 4; ++i) nx[i] = *reinterpret_cast<const float4*>(xn + i * 256 + lane * 4);
            }
            const float* mod = (const float*)(p.ws + OFF_MOD) + (size_t)(l * 5 + tok_cv(t)) * 6144 + which * 3072;
            float ss = 0.f;
#pragma unroll
            for (int i = 0; i < 4; ++i) ss += v[i].x * v[i].x + v[i].y * v[i].y + v[i].z * v[i].z + v[i].w * v[i].w;
            ss = wave_sum(ss);
            float r = rsqrtf(ss / D + EPS);
            bf16_t* H = (bf16_t*)(p.ws + OFF_H) + (size_t)t * D;
#pragma unroll
            for (int i = 0; i < 4; ++i) {
                int c = i * 256 + lane * 4;
                float4 gg = *reinterpret_cast<const float4*>(g + c), sh = *reinterpret_cast<const float4*>(mod + c), sc = *reinterpret_cast<const float4*>(mod + 1024 + c);
                uint2 o;
                o.x = pack_bf2(v[i].x * r * gg.x * (1.f + sc.x) + sh.x, v[i].y * r * gg.y * (1.f + sc.y) + sh.y);
                o.y = pack_bf2(v[i].z * r * gg.z * (1.f + sc.z) + sh.z, v[i].w * r * gg.w * (1.f + sc.w) + sh.w);
                *reinterpret_cast<uint2*>(H + c) = o;
            }
        }
    } else {
        u32x4 nx[2];
        {
            const int t = gw < NTOK ? gw : NTOK - 1;
            const bf16_t* xr = (const bf16_t*)(p.ws + OFF_XC) + (size_t)t * D + lane * 8;
            nx[0] = *reinterpret_cast<const u32x4*>(xr); nx[1] = *reinterpret_cast<const u32x4*>(xr + 512);
        }
        for (int t = gw; t < NTOK; t += nw) {
            float v[16];
#pragma unroll
            for (int h = 0; h < 2; ++h)
#pragma unroll
                for (int k = 0; k < 4; ++k) { v[h * 8 + 2 * k] = __uint_as_float(nx[h][k] << 16); v[h * 8 + 2 * k + 1] = __uint_as_float(nx[h][k] & 0xffff0000u); }
            {
                const int tn = t + nw < NTOK ? t + nw : t;
                const bf16_t* xn = (const bf16_t*)(p.ws + OFF_XC) + (size_t)tn * D + lane * 8;
                nx[0] = *reinterpret_cast<const u32x4*>(xn); nx[1] = *reinterpret_cast<const u32x4*>(xn + 512);
            }
            const float* mod = (const float*)(p.ws + OFF_MOD) + (size_t)(l * 5 + tok_cv(t)) * 6144 + which * 3072;
            float ss = 0.f;
#pragma unroll
            for (int i = 0; i < 16; ++i) ss += v[i] * v[i];
            ss = wave_sum(ss);
            float r = rsqrtf(ss / D + EPS);
            bf16_t* H = (bf16_t*)(p.ws + OFF_H) + (size_t)t * D;
            float hq[16];
#pragma unroll
            for (int h = 0; h < 2; ++h) {
                const int c = h * 512 + lane * 8;
                float o[8];
#pragma unroll
                for (int q = 0; q < 2; ++q) {
                    const float4 gg = *reinterpret_cast<const float4*>(g + c + q * 4), sh = *reinterpret_cast<const float4*>(mod + c + q * 4), sc = *reinterpret_cast<const float4*>(mod + 1024 + c + q * 4);
                    o[q * 4] = v[h * 8 + q * 4] * r * gg.x * (1.f + sc.x) + sh.x; o[q * 4 + 1] = v[h * 8 + q * 4 + 1] * r * gg.y * (1.f + sc.y) + sh.y;
                    o[q * 4 + 2] = v[h * 8 + q * 4 + 2] * r * gg.z * (1.f + sc.z) + sh.z; o[q * 4 + 3] = v[h * 8 + q * 4 + 3] * r * gg.w * (1.f + sc.w) + sh.w;
                }
                *reinterpret_cast<u32x4*>(H + c) = u32x4{pack_bf2(o[0], o[1]), pack_bf2(o[2], o[3]), pack_bf2(o[4], o[5]), pack_bf2(o[6], o[7])};
#pragma unroll
                for (int q = 0; q < 8; ++q) hq[h * 8 + q] = o[q];
            }
            if (which) {
                float am = 0.f;
#pragma unroll
                for (int i = 0; i < 16; ++i) am = fmaxf(am, fabsf(hq[i]));
#pragma unroll
                for (int o2 = 32; o2 >= 1; o2 >>= 1) am = fmaxf(am, shfl_x(am, lane, o2));
                const float sc8 = am > 0.f ? 127.f / am : 1.f;
#pragma unroll
                for (int h = 0; h < 2; ++h) {
                    uint2 w;
                    w.x = pack4_i8(q8(hq[h * 8] * sc8), q8(hq[h * 8 + 1] * sc8), q8(hq[h * 8 + 2] * sc8), q8(hq[h * 8 + 3] * sc8));
                    w.y = pack4_i8(q8(hq[h * 8 + 4] * sc8), q8(hq[h * 8 + 5] * sc8), q8(hq[h * 8 + 6] * sc8), q8(hq[h * 8 + 7] * sc8));
                    *reinterpret_cast<uint2*>(p.ws + OFF_H8I + (size_t)t * D + h * 512 + lane * 8) = w;
                }
                if (lane == 0) ((float*)(p.ws + OFF_HSC))[t] = am > 0.f ? am * (1.f / 127.f) : 1.f;
            }
        }
    }
}
__device__ void ph_sgu_norm(const Params& p, int l, const int wv) {
    const int tid = opaque_tid(wv);
    const int lane = tid & 63;
    const int gw = blockIdx.x * 8 + (tid >> 6), nw = gridDim.x * 8;
    for (int t = gw; t < NTOK; t += nw) {
        const bf16_t* AV = (const bf16_t*)(p.ws + OFF_AV) + (size_t)t * 256;
        float v[4]; float ss = 0.f;
#pragma unroll
        for (int i = 0; i < 4; ++i) { v[i] = bf2f(AV[i * 64 + lane]); ss += v[i] * v[i]; }
        ss = wave_sum(ss);
        float r = rsqrtf(ss / 256.f + EPS);
#pragma unroll
        for (int i = 0; i < 4; ++i) ((bf16_t*)(p.ws + OFF_AVN))[(size_t)t * 256 + i * 64 + lane] = f2bf(v[i] * r * p.in[I_SGUNG][l * 256 + i * 64 + lane]);
    }
}
__device__ void ph_sgu_mix(const Params& p, int l, const int wv) {
    const int tid = opaque_tid(wv);
    const bf16_t* AVN = (const bf16_t*)(p.ws + OFF_AVN);
    for (size_t idx = GTID; idx < (size_t)NTOK * 256; idx += GNT) {
        int t = (int)(idx >> 8), c = (int)(idx & 255);
        int t0 = t & ~127, pp = t & 127, g = c >> 6;
        const bf16_t* W = (const bf16_t*)(p.ws + OFF_SGUW) + (((size_t)l * 4 + g) * 128 + pp) * 128;
        float acc = 0.f;
        for (int q = 0; q < 128; ++q) acc += bf2f(W[q]) * bf2f(AVN[(size_t)(t0 + q) * 256 + c]);
        acc += p.in[I_SGUB][(l * 4 + g) * 128 + pp];
        float au = bf2f(((const bf16_t*)(p.ws + OFF_AU))[(size_t)t * 256 + c]);
        ((bf16_t*)(p.ws + OFF_MIX))[(size_t)t * D + c] = f2bf(au * acc);
    }
}
__device__ void ph_attn_ref(const Params& p, int l, const int wv) {
    const int tid = opaque_tid(wv);
    const int lane = tid & 63;
    const int gw = blockIdx.x * 8 + (tid >> 6), nw = gridDim.x * 8;
    const float lam = lam_of(p, l);
    for (int item = gw; item < NTOK * 12; item += nw) {
        const int t = item % NTOK, hh = item / NTOK;
        const bool prompt = t < NPT;
        const int b = prompt ? t / SEQ : (t - NPT) / DSEQ;
        const int nk = prompt ? SEQ : NKS;
        if (hh < 4) {
            const int h = hh;
            const bf16_t* K = prompt ? (const bf16_t*)(p.ws + OFF_DKP) + ((size_t)b * 4 + h) * SEQ * 64 : (const bf16_t*)(p.ws + OFF_DKS) + ((size_t)b * 4 + h) * NKS * 64;
            const bf16_t* Vt = prompt ? (const bf16_t*)(p.ws + OFF_DVTP) + ((size_t)b * 4 + h) * 64 * SEQ : (const bf16_t*)(p.ws + OFF_DVTS) + ((size_t)b * 4 + h) * 64 * NKS;
            float q = bf2f(((const bf16_t*)(p.ws + OFF_DQ))[(size_t)t * 256 + h * 64 + lane]);
            const float scale = 0.17677669529663687f;
            float m0 = -1e30f, m1 = -1e30f, l0 = 0.f, l1 = 0.f, a0 = 0.f, a1 = 0.f;
            for (int k = 0; k < nk; ++k) {
                float pr = q * bf2f(K[(size_t)k * 64 + lane]);
#pragma unroll
                for (int o = 16; o >= 1; o >>= 1) pr += shfl_x(pr, lane, o);
                float s0 = shfl_i(pr, 0) * scale, s1 = shfl_i(pr, 32) * scale;
                float v = bf2f(Vt[(size_t)lane * nk + k]);
                float mn0 = fmaxf(m0, s0), mn1 = fmaxf(m1, s1);
                float c0 = expf(m0 - mn0), c1 = expf(m1 - mn1);
                float e0 = expf(s0 - mn0), e1 = expf(s1 - mn1);
                l0 = l0 * c0 + e0; l1 = l1 * c1 + e1;
                a0 = a0 * c0 + e0 * v; a1 = a1 * c1 + e1 * v;
                m0 = mn0; m1 = mn1;
            }
            float o = a0 / l0 - lam * a1 / l1;
            float ss = wave_sum(o * o);
            float r = rsqrtf(ss / 64.f + EPS);
            o = o * r * p.in[I_SUBLN][l * 64 + lane] * (1.f - lam_init_of(l));
            ((bf16_t*)(p.ws + OFF_MIX))[(size_t)t * D + 256 + h * 64 + lane] = f2bf(o);
        } else {
            const int hq = hh - 4, kv = hq >> 2;
            const bf16_t* K = prompt ? (const bf16_t*)(p.ws + OFF_GKP) + ((size_t)b * 2 + kv) * SEQ * 64 : (const bf16_t*)(p.ws + OFF_GKS) + ((size_t)b * 2 + kv) * NKS * 64;
            const bf16_t* Vt = prompt ? (const bf16_t*)(p.ws + OFF_GVTP) + ((size_t)b * 2 + kv) * 64 * SEQ : (const bf16_t*)(p.ws + OFF_GVTS) + ((size_t)b * 2 + kv) * 64 * NKS;
            float q = bf2f(((const bf16_t*)(p.ws + OFF_GQ))[(size_t)t * 512 + hq * 64 + lane]);
            float m = -1e30f, ls = 0.f, a = 0.f;
            for (int k = 0; k < nk; ++k) {
                float s = wave_sum(q * bf2f(K[(size_t)k * 64 + lane])) * 0.125f;
                float v = bf2f(Vt[(size_t)lane * nk + k]);
                float mn = fmaxf(m, s);
                float c = expf(m - mn), e = expf(s - mn);
                ls = ls * c + e; a = a * c + e * v; m = mn;
            }
            ((bf16_t*)(p.ws + OFF_MIX))[(size_t)t * D + 512 + hq * 64 + lane] = f2bf(a / ls);
        }
    }
}
__device__ void ph_peer_scores(const Params& p, int l, const int wv) {
    const int tid = opaque_tid(wv);
    const bf16_t* SK = (const bf16_t*)(p.ws + OFF_SUBK) + (size_t)l * 2 * 128 * 64;
    for (size_t idx = GTID; idx < (size_t)NTOK * 2048; idx += GNT) {
        int t = (int)(idx >> 11), o = (int)(idx & 2047);
        const bf16_t* Q = (const bf16_t*)(p.ws + OFF_Q) + (size_t)t * D;
        int n = o & 127, x = (o >> 7) & 1, h = o >> 8;
        float acc = 0.f;
        for (int k = 0; k < 64; ++k) acc += bf2f(Q[h * 128 + x * 64 + k]) * bf2f(SK[((size_t)x * 128 + n) * 64 + k]);
        ((float*)(p.ws + OFF_PROJ))[idx] = acc;
    }
}
__device__ void ph_peer_top1(const Params& p, const int wv) {
    const int tid = opaque_tid(wv);
    for (size_t idx = GTID; idx < (size_t)NTOK * 16; idx += GNT) {
        const float* SC = (const float*)(p.ws + OFF_PROJ) + idx * 128;
        float* TV = (float*)(p.ws + OFF_TOPV) + idx * 16; int* TI = (int*)(p.ws + OFF_TOPI) + idx * 16;
        float pv = 3.0e38f; int pi = -1;
        for (int r = 0; r < 16; ++r) {
            float bv = -3.0e38f; int bi = -1;
            for (int n = 0; n < 128; ++n) {
                float v = SC[n];
                bool after = (v < pv) || (v == pv && n > pi);
                if (after && (bi < 0 || v > bv)) { bv = v; bi = n; }
            }
            TV[r] = bv; TI[r] = bi; pv = bv; pi = bi;
        }
    }
}
__device__ void ph_peer_top2(const Params& p, const int wv) {
    const int tid = opaque_tid(wv);
    for (size_t idx = GTID; idx < (size_t)NTOK * 8; idx += GNT) {
        const float* TV = (const float*)(p.ws + OFF_TOPV) + idx * 32; const int* TI = (const int*)(p.ws + OFF_TOPI) + idx * 32;
        int* EI = (int*)(p.ws + OFF_EIDX) + idx * 16; float* EG = (float*)(p.ws + OFF_EGATE) + idx * 16;
        float pv = 3.0e38f; int pi = -1; float mx = 0.f, sum = 0.f;
        for (int r = 0; r < 16; ++r) {
            float bv = -3.0e38f; int bi = -1;
            for (int n = 0; n < 256; ++n) {
                float v = TV[n >> 4] + TV[16 + (n & 15)];
                bool after = (v < pv) || (v == pv && n > pi);
                if (after && (bi < 0 || v > bv)) { bv = v; bi = n; }
            }
            if (r == 0) mx = bv;
            float e = expf(bv - mx);
            sum += e;
            EG[r] = e; EI[r] = TI[bi >> 4] * 128 + TI[16 + (bi & 15)];
            pv = bv; pi = bi;
        }
        float inv = 1.f / sum;
        for (int r = 0; r < 16; ++r) EG[r] *= inv;
    }
}
__device__ void ph_peer_apply(const Params& p, int l, unsigned char* lds, const int wv) {
    const int tid = opaque_tid(wv);
    const int sub = tid >> 8, tl = tid & 255;
    const int wave = tl >> 6, lane = tl & 63;
    float* wts = (float*)(lds + 64) + sub * 128; int* eid = (int*)(lds + 64 + 1024) + sub * 128;
    const bf16_t* UT = (const bf16_t*)(p.ws + OFF_UT) + (size_t)l * NEXP * D;
    const bf16_t* VT = (const bf16_t*)(p.ws + OFF_VT) + (size_t)l * NEXP * D;
    const int niter = (NTOK + gridDim.x * 2 - 1) / (gridDim.x * 2);
    for (int it = 0; it < niter; ++it) {
        int t = (it * gridDim.x + blockIdx.x) * 2 + sub;
        const bool valid = t < NTOK; if (!valid) t = NTOK - 1;
        const bf16_t* H = (const bf16_t*)(p.ws + OFF_H) + (size_t)t * D;
        const int* EI = (const int*)(p.ws + OFF_EIDX) + (size_t)t * 128; const float* EG = (const float*)(p.ws + OFF_EGATE) + (size_t)t * 128;
        float hv[16];
#pragma unroll
        for (int i = 0; i < 16; ++i) hv[i] = bf2f(H[lane * 16 + i]);
        for (int jj = 0; jj < 32; ++jj) {
            int j = wave * 32 + jj; int e = EI[j];
            const bf16_t* ur = UT + (size_t)e * D + lane * 16;
            float acc = 0.f;
#pragma unroll
            for (int i = 0; i < 16; ++i) acc += hv[i] * bf2f(ur[i]);
            acc = wave_sum(acc);
            if (lane == 0) { wts[j] = EG[j] * gelu_f(acc); eid[j] = e; }
        }
        __syncthreads();
        float o[4] = {0.f, 0.f, 0.f, 0.f};
        for (int j = 0; j < 128; ++j) {
            const bf16_t* vr = VT + (size_t)eid[j] * D + tl * 4; float w = wts[j];
#pragma unroll
            for (int i = 0; i < 4; ++i) o[i] += w * bf2f(vr[i]);
        }
        const float* mod = (const float*)(p.ws + OFF_MOD) + (size_t)(l * 5 + tok_cv(t)) * 6144 + 5 * 1024;
        float* XC = (float*)(p.ws + OFF_XC) + (size_t)t * D;
        if (valid) {
#pragma unroll
            for (int i = 0; i < 4; ++i) { int c = tl * 4 + i; XC[c] += mod[c] * o[i]; }
        }
        __syncthreads();
    }
}
__device__ void ph_final_norm(const Params& p, const int wv) {
    const int tid = opaque_tid(wv);
    const int lane = tid & 63;
    const int gw = blockIdx.x * 8 + (tid >> 6), nw = gridDim.x * 8;
    u32x4 nx[2];
    {
        const int t = gw < NTOK ? gw : NTOK - 1;
        const bf16_t* xr = (const bf16_t*)(p.ws + OFF_XC) + (size_t)t * D + lane * 8;
        nx[0] = *reinterpret_cast<const u32x4*>(xr); nx[1] = *reinterpret_cast<const u32x4*>(xr + 512);
    }
    for (int t = gw; t < NTOK; t += nw) {
        float v[16];
#pragma unroll
        for (int h = 0; h < 2; ++h)
#pragma unroll
            for (int k = 0; k < 4; ++k) { v[h * 8 + 2 * k] = __uint_as_float(nx[h][k] << 16); v[h * 8 + 2 * k + 1] = __uint_as_float(nx[h][k] & 0xffff0000u); }
        {
            const int tn = t + nw < NTOK ? t + nw : t;
            const bf16_t* xn = (const bf16_t*)(p.ws + OFF_XC) + (size_t)tn * D + lane * 8;
            nx[0] = *reinterpret_cast<const u32x4*>(xn); nx[1] = *reinterpret_cast<const u32x4*>(xn + 512);
        }
        float ss = 0.f;
#pragma unroll
        for (int i = 0; i < 16; ++i) ss += v[i] * v[i];
        ss = wave_sum(ss);
        float r = rsqrtf(ss / D + EPS);
        float* y = p.out + (size_t)t * D;
#pragma unroll
        for (int h = 0; h < 2; ++h) {
            const int c = h * 512 + lane * 8;
#pragma unroll
            for (int q = 0; q < 2; ++q) {
                const float4 g = *reinterpret_cast<const float4*>(p.in[I_FG] + c + q * 4);
                *reinterpret_cast<float4*>(y + c + q * 4) = make_float4(v[h * 8 + q * 4] * r * g.x, v[h * 8 + q * 4 + 1] * r * g.y, v[h * 8 + q * 4 + 2] * r * g.z, v[h * 8 + q * 4 + 3] * r * g.w);
            }
        }
    }
}


namespace g8 {
constexpr int BM = 256, BK = 64, HALF = 128, HT = HALF * BK;
__device__ __forceinline__ int lds_byte(int r, int c) {
    int st = (r >> 4) * 2 + (c >> 5), rr = r & 15, cc = c & 31, ob = rr * 64 + cc * 2;
    return st * 1024 + (ob ^ (((ob >> 9) & 1) << 5));
}
__device__ __forceinline__ void stage_rc(int b, int& R, int& C) {
    int st = b / 1024, sb = b % 1024, swz = sb ^ (((sb >> 9) & 1) << 5);
    R = (st >> 1) * 16 + swz / 64; C = (st & 1) * 32 + (swz % 64) / 2;
}
}
enum { EPI_INPROJ = 0, EPI_WOUT = 1, EPI_WQ = 2 };
constexpr int STG = 132;

__device__ __forceinline__ void store_bf16x32(bf16_t* dst, const float (&v)[32]) {
#pragma unroll
    for (int i = 0; i < 4; ++i) {
        uint4 u;
        u.x = pack_bf2(v[i * 8 + 0], v[i * 8 + 1]); u.y = pack_bf2(v[i * 8 + 2], v[i * 8 + 3]);
        u.z = pack_bf2(v[i * 8 + 4], v[i * 8 + 5]); u.w = pack_bf2(v[i * 8 + 6], v[i * 8 + 7]);
        *reinterpret_cast<uint4*>(dst + i * 8) = u;
    }
}
__device__ __forceinline__ void store_f32x32(float* dst, const float (&v)[32]) {
#pragma unroll
    for (int i = 0; i < 8; ++i) *reinterpret_cast<float4*>(dst + i * 4) = make_float4(v[i * 4], v[i * 4 + 1], v[i * 4 + 2], v[i * 4 + 3]);
}

__device__ __forceinline__ void epi_inproj_xform(const Params& p, int l, int t, int c0, float (&v)[32]) {
    const bool prompt = t < NPT;
    const int s = prompt ? (t & 255) : ((t - NPT) & 2047);
    const float* R = (const float*)(p.ws + OFF_ROPE);
    if (c0 < 512) {
#pragma unroll
        for (int i = 0; i < 32; ++i) v[i] = gelu_f(v[i]);
    } else if (c0 < 1024) {
        if (!prompt) {
            const float* cs = R + s * 16; const float* sn = R + 2048 * 16 + s * 16;
#pragma unroll
            for (int i = 0; i < 16; ++i) {
                float c = cs[i], sv = sn[i], x1 = v[i], x2 = v[i + 16];
                v[i] = x1 * c - x2 * sv; v[i + 16] = x2 * c + x1 * sv;
            }
        }
    } else if (c0 >= 1280 && c0 < 1920) {
        const bool isq = c0 < 1792;
        const int hi = c0 & 32;
        const float* g = p.in[isq ? I_QNG : I_KNG] + l * 64 + hi;
        float ss = 0.f;
#pragma unroll
        for (int i = 0; i < 32; ++i) ss += v[i] * v[i];
        const int ln = lane_id_op();
        ss += shfl_x(ss, ln, 1);
        const float rr = rsqrtf(ss * (1.f / 64.f) + EPS);
#pragma unroll
        for (int i = 0; i < 32; ++i) v[i] = v[i] * rr * g[i];
        if (!prompt) {
            const float* cs = R + 2048 * 32 + s * 32; const float* sn = R + 2048 * 64 + s * 32;
#pragma unroll
            for (int i = 0; i < 32; ++i) {
                float pv = shfl_x(v[i], ln, 1);
                float c = cs[i], sv = sn[i];
                v[i] = hi ? (v[i] * c + pv * sv) : (v[i] * c - pv * sv);
            }
        }
    }
}
__device__ __forceinline__ void epi_inproj_col(const Params& p, int t0, int c, const LAS float* stc) {
    float v[32];
#pragma unroll
    for (int i = 0; i < 32; ++i) v[i] = stc[i * STG];
    const bool prompt = t0 < NPT;
    const int b = prompt ? (t0 >> 8) : ((t0 - NPT) >> 11);
    const int s = prompt ? (t0 & 255) : ((t0 - NPT) & 2047);
    unsigned char* ws = p.ws;
    bf16_t* dst;
    if (c < 1280) {
        const int cc = c - 1024, h = cc >> 6, d = cc & 63;
        dst = prompt ? (bf16_t*)(ws + OFF_DVTP) + (((size_t)b * 4 + h) * 64 + d) * SEQ + s
                     : (bf16_t*)(ws + OFF_DVTS) + (((size_t)b * 4 + h) * 64 + d) * NKS + s;
    } else {
        const int cc = c - 1920, kv = cc >> 6, d = cc & 63;
        dst = prompt ? (bf16_t*)(ws + OFF_GVTP) + (((size_t)b * 2 + kv) * 64 + d) * SEQ + s
                     : (bf16_t*)(ws + OFF_GVTS) + (((size_t)b * 2 + kv) * 64 + d) * NKS + s;
    }
    store_bf16x32(dst, v);
}

template <int MODE>
__device__ __forceinline__ void gemm_phase(const Params& p, int l, const bf16_t* __restrict__ A, const bf16_t* __restrict__ Bt, const int N, unsigned char* ldsraw, const int wv) {
    using namespace g8;
    constexpr int K = 1024, nt = K / BK, BN = 128, TILE_A = BM * BK * 2, TILE_B = BN * BK * 2, STAGE_B = TILE_A + TILE_B;
    LAS unsigned char* lds = (LAS unsigned char*)ldsraw;
    const int tid = opaque_tid(wv), wid = wv, lane = tid & 63;
    const int wr = wid >> 1, wc = wid & 1, fr = lane & 15, fq = lane >> 4;
    unsigned voff[4];
#pragma unroll
    for (int i = 0; i < 4; ++i) voff[i] = (unsigned)((i * 64 + wid * 8 + (lane >> 3)) * K + (((lane & 7) ^ (lane >> 3)) * 8)) * 2u;
    const int aoff = (wr * 64 + fr) * 128 + ((fq ^ (fr & 7)) * 16), boff = (wc * 64 + fr) * 128 + ((fq ^ (fr & 7)) * 16);
    const unsigned ldsw = (unsigned)wid * 1024u;
#define G8_STAGE(buf, kt) do { \
        _Pragma("unroll") for (int _i = 0; _i < 4; ++_i) \
            __builtin_amdgcn_global_load_lds((const unsigned*)((const char*)(Ab + (kt) * BK) + voff[_i]), (LAS unsigned*)(lds + (buf) * STAGE_B + ldsw + _i * 8192), 16, 0, 0); \
        _Pragma("unroll") for (int _i = 0; _i < 2; ++_i) \
            __builtin_amdgcn_global_load_lds((const unsigned*)((const char*)(Bb + (kt) * BK) + voff[_i]), (LAS unsigned*)(lds + (buf) * STAGE_B + TILE_A + ldsw + _i * 8192), 16, 0, 0); } while (0)
#define G8_WAIT_V0() asm volatile("s_waitcnt vmcnt(0)" ::: "memory")
    const int nN = N / BN, nM = NTOK / BM, ntiles = nM * nN;
    const int G = gridDim.x;
    const int vb = (G % 8 == 0) ? (int)(blockIdx.x % 8) * (G / 8) + (int)(blockIdx.x / 8) : (int)blockIdx.x;
    const int tpb = (ntiles + G - 1) / G;
    const bool paneled = (G == 256) && (nN == 8 || nN == 16) && (nM == 64);
    for (int ti = 0; ti < tpb; ++ti) {
        int tile = vb * tpb + ti;
        if (paneled) {
            const int x = vb >> 5, j = vb & 31;
            const int mpx = nN == 16 ? 16 : 8;
            const int m0 = nN == 16 ? (x >> 1) * 16 : x * 8, n0 = nN == 16 ? (x & 1) * 8 : 0;
            const int pm_ = m0 + ti * 4 + (j >> 3), pn_ = n0 + (j & 7);
            tile = (ti * 4 < mpx) ? pm_ * nN + pn_ : ntiles;
        }
        if (tile >= ntiles) break;
        const int pm = tile / nN, pn = tile % nN, brow = pm * BM, bcol = pn * BN;
        const bf16_t* Ab = A + (size_t)brow * K; const bf16_t* Bb = Bt + (size_t)bcol * K;
        f32x4 acc[4][4];
#pragma unroll
        for (int m = 0; m < 4; ++m)
#pragma unroll
            for (int n = 0; n < 4; ++n) acc[m][n] = f32x4{0.f, 0.f, 0.f, 0.f};
        G8_WAIT_V0();
        G8_STAGE(0, 0); G8_STAGE(1, 1);
        int cur = 0;
        for (int t = 0; t < nt; ++t) {
            if (t + 1 < nt) asm volatile("s_waitcnt vmcnt(6)" ::: "memory"); else asm volatile("s_waitcnt vmcnt(0)" ::: "memory");
            __builtin_amdgcn_s_barrier();
            if (t + 2 < nt) { const int nb = cur >= 1 ? cur - 1 : 2; G8_STAGE(nb, t + 2); }
            {
                bf16x8 At[2][4], Bf[2][4];
#pragma unroll
                for (int ks = 0; ks < 2; ++ks) {
#pragma unroll
                    for (int m = 0; m < 4; ++m) At[ks][m] = *(const LAS bf16x8*)(lds + cur * STAGE_B + ((aoff + m * 2048) ^ (ks * 64)));
#pragma unroll
                    for (int n = 0; n < 4; ++n) Bf[ks][n] = *(const LAS bf16x8*)(lds + cur * STAGE_B + TILE_A + ((boff + n * 2048) ^ (ks * 64)));
                }
                __builtin_amdgcn_sched_barrier(0);
#pragma unroll
                for (int ks = 0; ks < 2; ++ks)
#pragma unroll
                    for (int m = 0; m < 4; ++m)
#pragma unroll
                        for (int n = 0; n < 4; ++n) acc[m][n] = __builtin_amdgcn_mfma_f32_16x16x32_bf16(At[ks][m], Bf[ks][n], acc[m][n], 0, 0, 0);
                __builtin_amdgcn_sched_barrier(0);
            }
            cur = cur == 2 ? 0 : cur + 1;
        }
        __syncthreads();
        LAS float* st = (LAS float*)lds;
#pragma unroll
        for (int m = 0; m < 4; ++m)
#pragma unroll
            for (int n = 0; n < 4; ++n)
#pragma unroll
                for (int j = 0; j < 4; ++j)
                    st[(wr * 64 + m * 16 + fq * 4 + j) * STG + wc * 64 + n * 16 + fr] = acc[m][n][j];
        __syncthreads();
        const bool tprompt = brow < NPT;
        const int tb_ = tprompt ? (brow >> 8) : ((brow - NPT) >> 11), ts0 = tprompt ? 0 : ((brow - NPT) & 2047);
        if (MODE == EPI_INPROJ) {
            const bool vtile = (bcol >= 1024 && bcol < 1280) || bcol >= 1920;
            if (!vtile) {
#pragma unroll 1
                for (int it = 0; it < 2; ++it) {
                    const int item = it * NT + tid, erow = item >> 2, eseg = item & 3;
                    float v[32];
#pragma unroll
                    for (int i = 0; i < 8; ++i) {
                        const f32x4 f = *(const LAS f32x4*)(st + erow * STG + eseg * 32 + i * 4);
                        v[i * 4] = f[0]; v[i * 4 + 1] = f[1]; v[i * 4 + 2] = f[2]; v[i * 4 + 3] = f[3];
                    }
                    epi_inproj_xform(p, l, brow + erow, bcol + eseg * 32, v);
#pragma unroll
                    for (int i = 0; i < 8; ++i) *(LAS f32x4*)(st + erow * STG + eseg * 32 + i * 4) = f32x4{v[i * 4], v[i * 4 + 1], v[i * 4 + 2], v[i * 4 + 3]};
                }
                __syncthreads();
#pragma unroll 1
                for (int it = 0; it < 8; ++it) {
                    const int item = it * NT + tid, r = item >> 4, c = (item & 15) * 8;
                    const f32x4 f0 = *(const LAS f32x4*)(st + r * STG + c), f1 = *(const LAS f32x4*)(st + r * STG + c + 4);
                    const int t = brow + r, sp = ts0 + r;
                    bf16_t* dst;
                    if (bcol < 512)        dst = (bf16_t*)(p.ws + (bcol < 256 ? OFF_AU : OFF_AV)) + (size_t)t * 256 + (bcol & 255) + c;
                    else if (bcol < 768)   dst = (bf16_t*)(p.ws + OFF_DQ) + (size_t)t * 256 + (bcol - 512) + c;
                    else if (bcol < 1024) { const int cc = bcol - 768 + c, h = cc >> 6;
                                            dst = tprompt ? (bf16_t*)(p.ws + OFF_DKP) + (((size_t)tb_ * 4 + h) * SEQ + sp) * 64 + (cc & 63)
                                                          : (bf16_t*)(p.ws + OFF_DKS) + (((size_t)tb_ * 4 + h) * NKS + sp) * 64 + (cc & 63); }
                    else if (bcol < 1792)  dst = (bf16_t*)(p.ws + OFF_GQ) + (size_t)t * 512 + (bcol - 1280) + c;
                    else                 { const int kv = c >> 6;
                                            dst = tprompt ? (bf16_t*)(p.ws + OFF_GKP) + (((size_t)tb_ * 2 + kv) * SEQ + sp) * 64 + (c & 63)
                                                          : (bf16_t*)(p.ws + OFF_GKS) + (((size_t)tb_ * 2 + kv) * NKS + sp) * 64 + (c & 63); }
                    *reinterpret_cast<u32x4*>(dst) = u32x4{pack_bf2(f0[0], f0[1]), pack_bf2(f0[2], f0[3]), pack_bf2(f1[0], f1[1]), pack_bf2(f1[2], f1[3])};
                }
            }
            if (tprompt && ((bcol >= 768 && bcol < 1280) || bcol >= 1792)) {
                float* ob; int rs;
                if (bcol < 1024)      { ob = p.out + OUT_NDK + (((size_t)tb_ * 2 + l) * SEQ) * 256 + (bcol - 768);  rs = 256; }
                else if (bcol < 1280) { ob = p.out + OUT_NDV + (((size_t)tb_ * 2 + l) * SEQ) * 256 + (bcol - 1024); rs = 256; }
                else if (bcol < 1920) { ob = p.out + OUT_NGK + (((size_t)tb_ * 2 + l) * SEQ) * 128;                 rs = 128; }
                else                  { ob = p.out + OUT_NGV + (((size_t)tb_ * 2 + l) * SEQ) * 128;                 rs = 128; }
#pragma unroll 1
                for (int it = 0; it < 16; ++it) {
                    const int item = it * NT + tid, r = item >> 5, c = (item & 31) * 4;
                    *reinterpret_cast<f32x4*>(ob + (size_t)r * rs + c) = *(const LAS f32x4*)(st + r * STG + c);
                }
            }
            if (vtile) {
#pragma unroll 1
                for (int it = 0; it < 2; ++it) {
                    const int item = it * NT + tid, col = item >> 3, run = item & 7;
                    epi_inproj_col(p, brow + run * 32, bcol + col, st + run * 32 * STG + col);
                }
            }
        } else {
#pragma unroll 1
            for (int it = 0; it < 8; ++it) {
                const int item = it * NT + tid, r = item >> 4, c = (item & 15) * 8;
                const f32x4 f0 = *(const LAS f32x4*)(st + r * STG + c), f1 = *(const LAS f32x4*)(st + r * STG + c + 4);
                const int t = brow + r;
                float o[8] = {f0[0], f0[1], f0[2], f0[3], f1[0], f1[1], f1[2], f1[3]};
                if (MODE == EPI_WOUT) {
                    const float* g1 = (const float*)(p.ws + OFF_MOD) + (size_t)(l * 5 + tok_cv(t)) * 6144 + 2048 + bcol + c;
                    const float4 ga = *reinterpret_cast<const float4*>(g1), gb = *reinterpret_cast<const float4*>(g1 + 4);
                    float x[8];
                    if (l == 0) {
                        const float* xr = x_in_row(p, t) + bcol + c;
                        const float4 xa = *reinterpret_cast<const float4*>(xr), xb2 = *reinterpret_cast<const float4*>(xr + 4);
                        x[0] = xa.x; x[1] = xa.y; x[2] = xa.z; x[3] = xa.w; x[4] = xb2.x; x[5] = xb2.y; x[6] = xb2.z; x[7] = xb2.w;
                    } else {
                        const u32x4 xw = *reinterpret_cast<const u32x4*>((const bf16_t*)(p.ws + OFF_XC) + (size_t)t * D + bcol + c);
#pragma unroll
                        for (int k = 0; k < 4; ++k) { x[2 * k] = __uint_as_float(xw[k] << 16); x[2 * k + 1] = __uint_as_float(xw[k] & 0xffff0000u); }
                    }
                    o[0] = x[0] + ga.x * o[0]; o[1] = x[1] + ga.y * o[1]; o[2] = x[2] + ga.z * o[2]; o[3] = x[3] + ga.w * o[3];
                    o[4] = x[4] + gb.x * o[4]; o[5] = x[5] + gb.y * o[5]; o[6] = x[6] + gb.z * o[6]; o[7] = x[7] + gb.w * o[7];
                }
                bf16_t* dst = (bf16_t*)(p.ws + (MODE == EPI_WOUT ? OFF_XC : OFF_Q)) + (size_t)t * D + bcol + c;
                *reinterpret_cast<u32x4*>(dst) = u32x4{pack_bf2(o[0], o[1]), pack_bf2(o[2], o[3]), pack_bf2(o[4], o[5]), pack_bf2(o[6], o[7])};
            }
        }
        __syncthreads();
    }
}


#define MFMA32(a, b, c) __builtin_amdgcn_mfma_f32_32x32x16_bf16((a), (b), (c), 0, 0, 0)
constexpr int ATT_ROWB = 144;
constexpr int ATT_TILEB = 64 * ATT_ROWB;
constexpr int QW_MIX = 4096;

__device__ __forceinline__ bf16x8 pack8(const f32x16& x, int s) {
    const u32x4 w = {pack_bf2(x[8 * s], x[8 * s + 1]), pack_bf2(x[8 * s + 2], x[8 * s + 3]), pack_bf2(x[8 * s + 4], x[8 * s + 5]), pack_bf2(x[8 * s + 6], x[8 * s + 7])};
    return __builtin_bit_cast(bf16x8, w);
}
__device__ __forceinline__ void softmax_tile(f32x16& s0, f32x16& s1, const float sc, float& m, float& l, float& alpha, const int lane) {
    float mx = fmaxf(s0[0], s1[0]);
#pragma unroll
    for (int i = 1; i < 16; ++i) mx = fmaxf(mx, fmaxf(s0[i], s1[i]));
    mx = fmaxf(mx, shfl_x(mx, lane, 32));
    const float mnew = fmaxf(m, mx * sc);
    alpha = __builtin_amdgcn_exp2f(m - mnew);
    m = mnew;
    float ps = 0.f;
#pragma unroll
    for (int i = 0; i < 16; ++i) { s0[i] = __builtin_amdgcn_exp2f(s0[i] * sc - mnew); s1[i] = __builtin_amdgcn_exp2f(s1[i] * sc - mnew); ps += s0[i] + s1[i]; }
    l = l * alpha + ps;
}
__device__ __forceinline__ void v_frags(const LAS unsigned char* vb, bf16x8 (&vf)[8], int r, int hh) {
#pragma unroll
    for (int u = 0; u < 2; ++u)
#pragma unroll
        for (int sk = 0; sk < 2; ++sk)
#pragma unroll
            for (int mt = 0; mt < 2; ++mt) {
                const LAS unsigned char* a = vb + (32 * mt + r) * ATT_ROWB + (32 * u + 16 * sk + 4 * hh) * 2;
                const s16x4 lo = *(const LAS s16x4*)a, hi = *(const LAS s16x4*)(a + 16);
                vf[(u * 2 + sk) * 2 + mt] = bf16x8{lo[0], lo[1], lo[2], lo[3], hi[0], hi[1], hi[2], hi[3]};
            }
}
__device__ __forceinline__ void pv_tile(const bf16x8 (&vf)[8], const f32x16& p0, const f32x16& p1, f32x16 (&O)[2]) {
#pragma unroll
    for (int u = 0; u < 2; ++u)
#pragma unroll
        for (int sk = 0; sk < 2; ++sk) {
            const bf16x8 pf = pack8(u ? p1 : p0, sk);
#pragma unroll
            for (int mt = 0; mt < 2; ++mt) O[mt] = MFMA32(vf[(u * 2 + sk) * 2 + mt], pf, O[mt]);
        }
}

template <bool DIFF>
__device__ __forceinline__ void attn_item(const Params& p, int l, LAS unsigned char* lds, const int tid,
                                          const bf16_t* __restrict__ Qg, const int qstride,
                                          const bf16_t* __restrict__ Kg, const bf16_t* __restrict__ Vtg, const int nk,
                                          bf16_t* __restrict__ Og, const float lam) {
    const int wave = tid >> 6, lane = tid & 63, r = lane & 31, hh = lane >> 5;
    const int lrow = tid >> 3, lchunk = tid & 7;
    LAS unsigned char* kbuf = lds; LAS unsigned char* vbuf = lds + 2 * ATT_TILEB;
    bf16x8 qf[4];
    const bf16_t* qrow = Qg + (size_t)(wave * 32 + r) * qstride;
#pragma unroll
    for (int ks = 0; ks < 4; ++ks) qf[ks] = *reinterpret_cast<const bf16x8*>(qrow + ks * 16 + hh * 8);
    const float sc = (DIFF ? 0.17677669529663687f : 0.125f) * 1.4426950408889634f;
    f32x16 O0[2], O1[2];
#pragma unroll
    for (int mt = 0; mt < 2; ++mt)
#pragma unroll
        for (int i = 0; i < 16; ++i) { O0[mt][i] = 0.f; O1[mt][i] = 0.f; }
    float m0 = -1e30f, l0 = 0.f, m1 = -1e30f, l1 = 0.f;
    const int ntl = nk / 64;
    u32x4 kr, vr, kn, vn;
    kr = *reinterpret_cast<const u32x4*>(Kg + (size_t)lrow * 64 + lchunk * 8);
    vr = *reinterpret_cast<const u32x4*>(Vtg + (size_t)lrow * nk + lchunk * 8);
    *(LAS u32x4*)(kbuf + lrow * ATT_ROWB + lchunk * 16) = kr;
    *(LAS u32x4*)(vbuf + lrow * ATT_ROWB + lchunk * 16) = vr;
    {
        const int t1 = ntl > 1 ? 1 : 0;
        kr = *reinterpret_cast<const u32x4*>(Kg + (size_t)(t1 * 64 + lrow) * 64 + lchunk * 8);
        vr = *reinterpret_cast<const u32x4*>(Vtg + (size_t)lrow * nk + t1 * 64 + lchunk * 8);
    }
    __syncthreads();
    for (int ti = 0; ti < ntl; ++ti) {
        const int cur = ti & 1;
        {
            const int t2 = ti + 2 < ntl ? ti + 2 : ntl - 1;
            kn = *reinterpret_cast<const u32x4*>(Kg + (size_t)(t2 * 64 + lrow) * 64 + lchunk * 8);
            vn = *reinterpret_cast<const u32x4*>(Vtg + (size_t)lrow * nk + t2 * 64 + lchunk * 8);
        }
        const LAS unsigned char* kb = kbuf + cur * ATT_TILEB; const LAS unsigned char* vb = vbuf + cur * ATT_TILEB;
        bf16x8 ka[2][4];
#pragma unroll
        for (int u = 0; u < 2; ++u)
#pragma unroll
            for (int ks = 0; ks < 4; ++ks) ka[u][ks] = *(const LAS bf16x8*)(kb + (32 * u + r) * ATT_ROWB + (ks * 16 + hh * 8) * 2);
        __builtin_amdgcn_sched_barrier(0);
        bf16x8 vf[8];
        if (!DIFF) {
            f32x16 s0, s1;
#pragma unroll
            for (int i = 0; i < 16; ++i) { s0[i] = 0.f; s1[i] = 0.f; }
#pragma unroll
            for (int ks = 0; ks < 4; ++ks) { s0 = MFMA32(ka[0][ks], qf[ks], s0); s1 = MFMA32(ka[1][ks], qf[ks], s1); }
            v_frags(vb, vf, r, hh);
            __builtin_amdgcn_sched_barrier(0);
            float alpha;
            softmax_tile(s0, s1, sc, m0, l0, alpha, lane);
            if (__builtin_amdgcn_ballot_w64(alpha != 1.f) != 0ull) {
#pragma unroll
                for (int mt = 0; mt < 2; ++mt)
#pragma unroll
                    for (int i = 0; i < 16; ++i) O0[mt][i] *= alpha;
            }
            pv_tile(vf, s0, s1, O0);
        } else {
            f32x16 s0, s1, t0, t1;
#pragma unroll
            for (int i = 0; i < 16; ++i) { s0[i] = 0.f; s1[i] = 0.f; t0[i] = 0.f; t1[i] = 0.f; }
#pragma unroll
            for (int ks = 0; ks < 2; ++ks) {
                s0 = MFMA32(ka[0][ks], qf[ks], s0); s1 = MFMA32(ka[1][ks], qf[ks], s1);
                t0 = MFMA32(ka[0][2 + ks], qf[2 + ks], t0); t1 = MFMA32(ka[1][2 + ks], qf[2 + ks], t1);
            }
            v_frags(vb, vf, r, hh);
            __builtin_amdgcn_sched_barrier(0);
            float alpha;
            softmax_tile(s0, s1, sc, m0, l0, alpha, lane);
            if (__builtin_amdgcn_ballot_w64(alpha != 1.f) != 0ull) {
#pragma unroll
                for (int mt = 0; mt < 2; ++mt)
#pragma unroll
                    for (int i = 0; i < 16; ++i) O0[mt][i] *= alpha;
            }
            pv_tile(vf, s0, s1, O0);
            softmax_tile(t0, t1, sc, m1, l1, alpha, lane);
            if (__builtin_amdgcn_ballot_w64(alpha != 1.f) != 0ull) {
#pragma unroll
                for (int mt = 0; mt < 2; ++mt)
#pragma unroll
                    for (int i = 0; i < 16; ++i) O1[mt][i] *= alpha;
            }
            pv_tile(vf, t0, t1, O1);
        }
        if (ti + 1 < ntl) {
            *(LAS u32x4*)(kbuf + (cur ^ 1) * ATT_TILEB + lrow * ATT_ROWB + lchunk * 16) = kr;
            *(LAS u32x4*)(vbuf + (cur ^ 1) * ATT_TILEB + lrow * ATT_ROWB + lchunk * 16) = vr;
        }
        kr = kn; vr = vn;
        __syncthreads();
    }
    l0 += shfl_x(l0, lane, 32);
    const float inv0 = 1.f / l0;
    LAS unsigned char* ob = lds + wave * 4608;
    if (!DIFF) {
#pragma unroll
        for (int mt = 0; mt < 2; ++mt)
#pragma unroll
            for (int g = 0; g < 4; ++g) {
                u32x2 w;
                w[0] = pack_bf2(O0[mt][4 * g] * inv0, O0[mt][4 * g + 1] * inv0);
                w[1] = pack_bf2(O0[mt][4 * g + 2] * inv0, O0[mt][4 * g + 3] * inv0);
                *(LAS u32x2*)(ob + r * 144 + (32 * mt + 8 * g + 4 * hh) * 2) = w;
            }
    } else {
        l1 += shfl_x(l1, lane, 32);
        const float inv1 = lam / l1;
        float ss = 0.f;
#pragma unroll
        for (int mt = 0; mt < 2; ++mt)
#pragma unroll
            for (int i = 0; i < 16; ++i) { const float o = O0[mt][i] * inv0 - O1[mt][i] * inv1; O0[mt][i] = o; ss += o * o; }
        ss += shfl_x(ss, lane, 32);
        const float rr = rsqrtf(ss * (1.f / 64.f) + EPS) * __builtin_bit_cast(float, __builtin_amdgcn_readfirstlane(__builtin_bit_cast(int, 1.f - lam_init_of(l))));
        const float* sg = p.in[I_SUBLN] + l * 64;
#pragma unroll
        for (int mt = 0; mt < 2; ++mt)
#pragma unroll
            for (int g = 0; g < 4; ++g) {
                const int d0 = 32 * mt + 8 * g + 4 * hh;
                const float4 gg = *reinterpret_cast<const float4*>(sg + d0);
                u32x2 w;
                w[0] = pack_bf2(O0[mt][4 * g] * rr * gg.x, O0[mt][4 * g + 1] * rr * gg.y);
                w[1] = pack_bf2(O0[mt][4 * g + 2] * rr * gg.z, O0[mt][4 * g + 3] * rr * gg.w);
                *(LAS u32x2*)(ob + r * 144 + d0 * 2) = w;
            }
    }
#pragma unroll
    for (int ps = 0; ps < 4; ++ps) {
        const int row = ps * 8 + (lane >> 3), ch = lane & 7;
        *reinterpret_cast<u32x4*>(Og + (size_t)(wave * 32 + row) * D + ch * 8) = *(const LAS u32x4*)(ob + row * 144 + ch * 16);
    }
}

constexpr int SGU_ROWB = 272;
__device__ __forceinline__ void sgu_item(const Params& p, int l, LAS unsigned char* lds, const int tid, const int t0) {
    const bf16_t* AV = (const bf16_t*)(p.ws + OFF_AV) + (size_t)t0 * 256;
    {
        const int q = tid >> 2, quarter = tid & 3;
        float v[64]; float ss = 0.f;
#pragma unroll
        for (int i = 0; i < 8; ++i) {
            const bf16x8 w = *reinterpret_cast<const bf16x8*>(AV + (size_t)q * 256 + quarter * 64 + i * 8);
#pragma unroll
            for (int j = 0; j < 8; ++j) { v[i * 8 + j] = bf2f((bf16_t)w[j]); ss += v[i * 8 + j] * v[i * 8 + j]; }
        }
        { const int ln = tid & 63; ss += shfl_x(ss, ln, 1); ss += shfl_x(ss, ln, 2); }
        const float rstd = rsqrtf(ss * (1.f / 256.f) + EPS);
        const float* g = p.in[I_SGUNG] + l * 256 + quarter * 64;
#pragma unroll
        for (int i = 0; i < 64; ++i)
            *(LAS bf16_t*)(lds + (quarter * 64 + i) * SGU_ROWB + q * 2) = f2bf(v[i] * rstd * g[i]);
    }
    __syncthreads();
    {
        const int wave = tid >> 6, lane = tid & 63, r = lane & 31, hh = lane >> 5;
        const int g = wave >> 1, ph = wave & 1;
        const bf16_t* W = (const bf16_t*)(p.ws + OFF_SGUW) + ((size_t)l * 4 + g) * 128 * 128;
        f32x16 acc[2][2];
#pragma unroll
        for (int a = 0; a < 2; ++a)
#pragma unroll
            for (int b = 0; b < 2; ++b)
#pragma unroll
                for (int i = 0; i < 16; ++i) acc[a][b][i] = 0.f;
#pragma unroll
        for (int ks = 0; ks < 8; ++ks) {
            bf16x8 af[2], bfr[2];
#pragma unroll
            for (int pt = 0; pt < 2; ++pt) af[pt] = *reinterpret_cast<const bf16x8*>(W + (size_t)(ph * 64 + pt * 32 + r) * 128 + ks * 16 + hh * 8);
#pragma unroll
            for (int ct = 0; ct < 2; ++ct) bfr[ct] = *(const LAS bf16x8*)(lds + (g * 64 + ct * 32 + r) * SGU_ROWB + (ks * 16 + hh * 8) * 2);
#pragma unroll
            for (int pt = 0; pt < 2; ++pt)
#pragma unroll
                for (int ct = 0; ct < 2; ++ct) acc[pt][ct] = MFMA32(af[pt], bfr[ct], acc[pt][ct]);
        }
        const float* bias = p.in[I_SGUB] + (l * 4 + g) * 128;
        const bf16_t* AU = (const bf16_t*)(p.ws + OFF_AU);
        bf16_t* MIX = (bf16_t*)(p.ws + OFF_MIX);
#pragma unroll
        for (int pt = 0; pt < 2; ++pt)
#pragma unroll
            for (int ct = 0; ct < 2; ++ct)
#pragma unroll
                for (int i = 0; i < 16; ++i) {
                    const int pp = ph * 64 + pt * 32 + (i & 3) + 8 * (i >> 2) + 4 * hh, c = g * 64 + ct * 32 + r;
                    const float au = bf2f(AU[(size_t)(t0 + pp) * 256 + c]);
                    MIX[(size_t)(t0 + pp) * D + c] = f2bf(au * (acc[pt][ct][i] + bias[pp]));
                }
    }
    __syncthreads();
}

__device__ void ph_mixers(const Params& p, int lq, unsigned char* ldsraw, const int wv) {
    const int l = lq & 1;
    const int tid0 = opaque_tid(wv);
    LAS unsigned char* lds = (LAS unsigned char*)ldsraw;
    volatile LAS int* qslot = (volatile LAS int*)(ldsraw - LDS_HDR + 64);
    unsigned* qw = (unsigned*)(p.ws + OFF_BAR) + QW_MIX + lq;
    const float lam = __builtin_bit_cast(float, __builtin_amdgcn_readfirstlane(__builtin_bit_cast(int, lam_of(p, l))));
    unsigned char* ws = p.ws;
    for (;;) {
        if (tid0 == 0) *qslot = (int)atomicAdd(qw, 1u);
        __syncthreads();
        const int item = *qslot;
        __syncthreads();
        if (item >= 896) break;
        if (lq >= 2 && PROBE_DUP >= 10) {
            const int cls = item < 128 ? 10 : (item < 384 ? 11 : 12);
            if (cls != PROBE_DUP) continue;
        }
        int tid = tid0; asm volatile("" : "+v"(tid));
        if (item < 128) {
            const int qc = item & 7, h = (item >> 3) & 3, b = item >> 5;
            const int t0 = NPT + b * DSEQ + qc * 256;
            attn_item<true>(p, l, lds, tid, (const bf16_t*)(ws + OFF_DQ) + (size_t)t0 * 256 + h * 64, 256,
                            (const bf16_t*)(ws + OFF_DKS) + ((size_t)b * 4 + h) * NKS * 64, (const bf16_t*)(ws + OFF_DVTS) + ((size_t)b * 4 + h) * 64 * NKS, NKS,
                            (bf16_t*)(ws + OFF_MIX) + (size_t)t0 * D + 256 + h * 64, lam);
        } else if (item < 384) {
            const int it = item - 128, qc = it & 7, hq = (it >> 3) & 7, b = it >> 6, kv = hq >> 2;
            const int t0 = NPT + b * DSEQ + qc * 256;
            attn_item<false>(p, l, lds, tid, (const bf16_t*)(ws + OFF_GQ) + (size_t)t0 * 512 + hq * 64, 512,
                             (const bf16_t*)(ws + OFF_GKS) + ((size_t)b * 2 + kv) * NKS * 64, (const bf16_t*)(ws + OFF_GVTS) + ((size_t)b * 2 + kv) * 64 * NKS, NKS,
                             (bf16_t*)(ws + OFF_MIX) + (size_t)t0 * D + 512 + hq * 64, lam);
        } else if (item < 512) {
            sgu_item(p, l, lds, tid, (item - 384) * 128);
        } else if (item < 768) {
            const int it = item - 512, hq = it & 7, b = it >> 3, kv = hq >> 2;
            const int t0 = b * SEQ;
            attn_item<false>(p, l, lds, tid, (const bf16_t*)(ws + OFF_GQ) + (size_t)t0 * 512 + hq * 64, 512,
                             (const bf16_t*)(ws + OFF_GKP) + ((size_t)b * 2 + kv) * SEQ * 64, (const bf16_t*)(ws + OFF_GVTP) + ((size_t)b * 2 + kv) * 64 * SEQ, SEQ,
                             (bf16_t*)(ws + OFF_MIX) + (size_t)t0 * D + 512 + hq * 64, lam);
        } else {
            const int it = item - 768, h = it & 3, b = it >> 2;
            const int t0 = b * SEQ;
            attn_item<true>(p, l, lds, tid, (const bf16_t*)(ws + OFF_DQ) + (size_t)t0 * 256 + h * 64, 256,
                            (const bf16_t*)(ws + OFF_DKP) + ((size_t)b * 4 + h) * SEQ * 64, (const bf16_t*)(ws + OFF_DVTP) + ((size_t)b * 4 + h) * 64 * SEQ, SEQ,
                            (bf16_t*)(ws + OFF_MIX) + (size_t)t0 * D + 256 + h * 64, lam);
        }
    }
}


using bf16x2 = __attribute__((ext_vector_type(2))) __bf16;
__device__ __forceinline__ float dot2bf(unsigned a, unsigned b, float c) {
    return __builtin_amdgcn_fdot2_f32_bf16(__builtin_bit_cast(bf16x2, a), __builtin_bit_cast(bf16x2, b), c, false);
}
template <int W>
__device__ __forceinline__ void bfly_stage(float (&part)[64], const int lane) {
    const bool hi = (lane & W) != 0;
#pragma unroll
    for (int k = 0; k < W; ++k) {
        const float keep = hi ? part[k + W] : part[k];
        const float send = hi ? part[k] : part[k + W];
        part[k] = keep + shfl_x(send, lane, W);
    }
}
constexpr int QW_PEER = 4160;
template <int W>
__device__ __forceinline__ void bfly16_stage(float (&v)[16], const int lane, const int bit) {
    const bool hi = (lane & bit) != 0;
#pragma unroll
    for (int k = 0; k < W; ++k) {
        const float keep = hi ? v[k + W] : v[k];
        const float send = hi ? v[k] : v[k + W];
        v[k] = keep + shfl_x(send, lane, bit);
    }
}
template <int W>
__device__ __forceinline__ void bfly16i_stage(int (&v)[16], const int lane, const int bit) {
    const bool hi = (lane & bit) != 0;
#pragma unroll
    for (int k = 0; k < W; ++k) {
        const int keep = hi ? v[k + W] : v[k];
        const int send = hi ? v[k] : v[k + W];
        v[k] = keep + shfl_x(send, lane, bit);
    }
}
template <bool VSIDE> struct PeerTok {
    static __device__ __forceinline__ void issue(const Params& p, const unsigned char* Tslice, const int elo, const int ehi, const int t, const int s,
                                                 const int sub, const int c16, u32x4 (&a)[16], u32x4 (&h)[2]) {
#pragma unroll
        for (int i = 0; i < 16; ++i) {
            const int e = shfl_i(i < 8 ? elo : ehi, (i * 8 + sub) & 63);
            a[i] = *reinterpret_cast<const u32x4*>(Tslice + (((unsigned)e << 7) + (unsigned)c16 * 16u));
        }
        if (!VSIDE) h[0] = *reinterpret_cast<const u32x4*>(p.ws + OFF_H8I + (size_t)t * D + s * 128 + c16 * 16);
    }
    static __device__ __forceinline__ void compute(const Params& p, const int l, const u32x4 w4, const float wsc, const int t, const int s,
                                                   const int lane, const int sub, const int c16, const u32x4 (&a)[16], const u32x4 (&h)[2]) {
        if (!VSIDE) {
            int d[16];
#pragma unroll
            for (int i = 0; i < 16; ++i) {
                int acc = 0;
#pragma unroll
                for (int k = 0; k < 4; ++k) acc = __builtin_amdgcn_sdot4((int)a[i][k], (int)h[0][k], acc, false);
                d[i] = acc;
            }
            bfly16i_stage<8>(d, lane, 4); bfly16i_stage<4>(d, lane, 2); bfly16i_stage<2>(d, lane, 1);
            const int i0 = ((lane & 4) << 1) + ((lane & 2) << 1) + ((lane & 1) << 1);
            int* PART = (int*)(p.ws + OFF_PART) + ((size_t)s * NTOK + t) * 128 + sub * 16 + i0;
            *reinterpret_cast<int2*>(PART) = make_int2(d[0], d[1]);
        } else {
            int acc[16];
#pragma unroll
            for (int i = 0; i < 16; ++i) acc[i] = 0;
#pragma unroll
            for (int g = 0; g < 4; ++g) {
                const int wg = (int)w4[g];
#pragma unroll
                for (int k = 0; k < 4; ++k) {
                    const unsigned r0 = a[4 * g][k], r1 = a[4 * g + 1][k], r2 = a[4 * g + 2][k], r3 = a[4 * g + 3][k];
                    const unsigned x01l = __builtin_amdgcn_perm(r1, r0, 0x05010400u), x01h = __builtin_amdgcn_perm(r1, r0, 0x07030602u);
                    const unsigned x23l = __builtin_amdgcn_perm(r3, r2, 0x05010400u), x23h = __builtin_amdgcn_perm(r3, r2, 0x07030602u);
                    const unsigned t0 = __builtin_amdgcn_perm(x23l, x01l, 0x05040100u), t1 = __builtin_amdgcn_perm(x23l, x01l, 0x07060302u);
                    const unsigned t2 = __builtin_amdgcn_perm(x23h, x01h, 0x05040100u), t3 = __builtin_amdgcn_perm(x23h, x01h, 0x07060302u);
                    acc[4 * k]     = __builtin_amdgcn_sdot4((int)t0, wg, acc[4 * k], false);
                    acc[4 * k + 1] = __builtin_amdgcn_sdot4((int)t1, wg, acc[4 * k + 1], false);
                    acc[4 * k + 2] = __builtin_amdgcn_sdot4((int)t2, wg, acc[4 * k + 2], false);
                    acc[4 * k + 3] = __builtin_amdgcn_sdot4((int)t3, wg, acc[4 * k + 3], false);
                }
            }
            bfly16i_stage<8>(acc, lane, 32); bfly16i_stage<4>(acc, lane, 16); bfly16i_stage<2>(acc, lane, 8);
            const int col = s * 128 + c16 * 16 + ((lane & 32) >> 2) + ((lane & 16) >> 2) + ((lane & 8) >> 2);
            const float* g2 = (const float*)(p.ws + OFF_MOD) + (size_t)(l * 5 + tok_cv(t)) * 6144 + 5 * 1024 + col;
            unsigned* XC = reinterpret_cast<unsigned*>((bf16_t*)(p.ws + OFF_XC) + (size_t)t * D + col);
            const unsigned x = *XC; const float2 g = *reinterpret_cast<const float2*>(g2);
            *XC = pack_bf2(__uint_as_float(x << 16) + g.x * wsc * (float)acc[0], __uint_as_float(x & 0xffff0000u) + g.y * wsc * (float)acc[1]);
        }
    }
};
template <bool VSIDE>
__device__ __forceinline__ void peer_slice_stream(const Params& p, const int l, const int s, const int first, const int stride, const int lane) {
    const int sub = lane >> 3, c16 = lane & 7;
    const unsigned char* Ts = p.ws + (VSIDE ? OFF_VT : OFF_UT) + ((size_t)l * 8 + s) * NEXP * 128;
    const int* EIb = (const int*)(p.ws + OFF_EIDX); const unsigned char* WPb = p.ws + OFF_WPAIR; const float* WSb = (const float*)(p.ws + OFF_WSC);
    if (first >= NTOK) return;
    const int cnt = (NTOK - first + stride - 1) / stride;
#define PEER_LOADE(k, elo, ehi, w4, wsc) do { const int _t = min(first + (k) * stride, NTOK - 1); \
        elo = EIb[(size_t)_t * 128 + lane]; ehi = EIb[(size_t)_t * 128 + 64 + lane]; \
        if (VSIDE) { w4 = *reinterpret_cast<const u32x4*>(WPb + (size_t)_t * 128 + sub * 16); wsc = WSb[_t]; } } while (0)
    int e0l, e0h, e1l, e1h, e2l, e2h;
    u32x4 w0 = {0u, 0u, 0u, 0u}, w1 = {0u, 0u, 0u, 0u}, w2 = {0u, 0u, 0u, 0u}; float s0 = 0.f, s1 = 0.f, s2 = 0.f;
    u32x4 A[16], B[16], hA[2], hB[2];
    PEER_LOADE(0, e0l, e0h, w0, s0);
    PEER_LOADE(1, e1l, e1h, w1, s1);
    PeerTok<VSIDE>::issue(p, Ts, e0l, e0h, first, s, sub, c16, A, hA);
    for (int k = 0; k < cnt; k += 2) {
        const int ta = first + k * stride, tb = min(ta + stride, NTOK - 1), tc = min(ta + 2 * stride, NTOK - 1);
        __builtin_amdgcn_sched_barrier(0);
        PEER_LOADE(k + 2, e2l, e2h, w2, s2);
        PeerTok<VSIDE>::issue(p, Ts, e1l, e1h, tb, s, sub, c16, B, hB);
        __builtin_amdgcn_sched_barrier(0);
        PeerTok<VSIDE>::compute(p, l, w0, s0, ta, s, lane, sub, c16, A, hA);
        __builtin_amdgcn_sched_barrier(0);
        e0l = e2l; e0h = e2h; w0 = w2; s0 = s2;
        PEER_LOADE(k + 3, e2l, e2h, w2, s2);
        PeerTok<VSIDE>::issue(p, Ts, e0l, e0h, tc, s, sub, c16, A, hA);
        __builtin_amdgcn_sched_barrier(0);
        if (k + 1 < cnt) PeerTok<VSIDE>::compute(p, l, w1, s1, tb, s, lane, sub, c16, B, hB);
        e1l = e2l; e1h = e2h; w1 = w2; s1 = s2;
    }
#undef PEER_LOADE
}
template <bool VSIDE>
__device__ void ph_peer_sliced(const Params& p, int l, unsigned char* ldsraw, const int wv) {
    const int tid = opaque_tid(wv);
    const int wave = tid >> 6, lane = tid & 63;
    volatile LAS int* hdr = (volatile LAS int*)(ldsraw - LDS_HDR);
    unsigned* bar = (unsigned*)(p.ws + OFF_BAR);
    const int myx = (int)(xb_xcc_id() & 15u);
    if (tid == 0) hdr[16] = (int)atomicAdd(bar + QW_PEER + (l * 2 + (VSIDE ? 1 : 0)) * 16 + myx, 1u);
    __syncthreads();
    const int rank = hdr[16], nloc = (int)hdr[0];
    __syncthreads();
    if (myx < 8) peer_slice_stream<VSIDE>(p, l, myx, rank * 8 + wave, nloc * 8, lane);
    for (int j = 0; j < 8; ++j) {
        if (xb_ld(&bar[XB_XCNT(j)]) == 0u) peer_slice_stream<VSIDE>(p, l, j, (int)blockIdx.x * 8 + wave, (int)gridDim.x * 8, lane);
    }
}
__device__ void ph_peer_pairw(const Params& p, int l, const int wv) {
    const int tid = opaque_tid(wv);
    const int lane = tid & 63;
    const float* USC = (const float*)(p.ws + OFF_USC) + l * NEXP; const float* VSC = (const float*)(p.ws + OFF_VSC) + l * NEXP;
    const int* PART = (const int*)(p.ws + OFF_PART);
    const float* HSC = (const float*)(p.ws + OFF_HSC);
    for (size_t i4 = GTID; i4 < (size_t)NTOK * 32; i4 += GNT) {
        const size_t idx = i4 * 4;
        const int t = (int)(idx >> 7), pp = (int)(idx & 127), sub = pp >> 4, i = pp & 15;
        int4 ps[8];
#pragma unroll
        for (int s = 0; s < 8; ++s) ps[s] = *reinterpret_cast<const int4*>(PART + (size_t)s * NTOK * 128 + idx);
        int e[4]; float g[4];
#pragma unroll
        for (int q = 0; q < 4; ++q) {
            const int j = (i + q) * 8 + sub;
            e[q] = ((const int*)(p.ws + OFF_EIDX))[(size_t)t * 128 + j]; g[q] = ((const float*)(p.ws + OFF_EGATE))[(size_t)t * 128 + j];
        }
        int4 sum = ps[0];
#pragma unroll
        for (int s = 1; s < 8; ++s) { sum.x += ps[s].x; sum.y += ps[s].y; sum.z += ps[s].z; sum.w += ps[s].w; }
        const float hs = HSC[t];
        float w[4];
        w[0] = g[0] * gelu_f((float)sum.x * (USC[e[0]] * hs)) * VSC[e[0]]; w[1] = g[1] * gelu_f((float)sum.y * (USC[e[1]] * hs)) * VSC[e[1]];
        w[2] = g[2] * gelu_f((float)sum.z * (USC[e[2]] * hs)) * VSC[e[2]]; w[3] = g[3] * gelu_f((float)sum.w * (USC[e[3]] * hs)) * VSC[e[3]];
        float am = fmaxf(fmaxf(fabsf(w[0]), fabsf(w[1])), fmaxf(fabsf(w[2]), fabsf(w[3])));
#pragma unroll
        for (int o = 16; o >= 1; o >>= 1) am = fmaxf(am, shfl_x(am, lane, o));
        const float sc = am > 0.f ? 127.f / am : 1.f;
        *reinterpret_cast<unsigned*>(p.ws + OFF_WPAIR + idx) = pack4_i8(q8(w[0] * sc), q8(w[1] * sc), q8(w[2] * sc), q8(w[3] * sc));
        if (pp == 0) ((float*)(p.ws + OFF_WSC))[t] = am > 0.f ? am * (1.f / 127.f) : 1.f;
    }
}

#define CE_DESC(a, b) do { const float _mx = fmaxf((a), (b)); const float _mn = fminf((a), (b)); (a) = _mx; (b) = _mn; } while (0)
__device__ __forceinline__ void sort16_desc(float (&v)[16]) {
#pragma unroll
    for (int k = 2; k <= 16; k <<= 1)
#pragma unroll
        for (int j = k >> 1; j > 0; j >>= 1)
#pragma unroll
            for (int i = 0; i < 16; ++i) {
                const int m = i ^ j;
                if (m > i) { if ((i & k) == 0) CE_DESC(v[i], v[m]); else CE_DESC(v[m], v[i]); }
            }
}
__device__ __forceinline__ void merge_top16(float (&a)[16], const float (&b)[16]) {
#pragma unroll
    for (int i = 0; i < 16; ++i) a[i] = fmaxf(a[i], b[15 - i]);
#pragma unroll
    for (int j = 8; j > 0; j >>= 1)
#pragma unroll
        for (int i = 0; i < 16; ++i) { const int m = i ^ j; if (m > i) CE_DESC(a[i], a[m]); }
}
__device__ __forceinline__ float key_embed(float v, unsigned lowmask, unsigned idxbits) { return __uint_as_float((__float_as_uint(v) & ~lowmask) | idxbits); }

constexpr int SK_ROWB = 144;
__device__ __forceinline__ void peer_stage1(const LAS unsigned char* SK  , const bf16_t* __restrict__ Qrow  ,
                                            const int r, const int hh, float (&out)[16]) {
    bf16x8 qb[4];
#pragma unroll
    for (int ks = 0; ks < 4; ++ks) qb[ks] = *reinterpret_cast<const bf16x8*>(Qrow + ks * 16 + hh * 8);
    float grp[4][16];
#pragma unroll
    for (int mt = 0; mt < 4; ++mt) {
        f32x16 acc;
#pragma unroll
        for (int i = 0; i < 16; ++i) acc[i] = 0.f;
#pragma unroll
        for (int ks = 0; ks < 4; ++ks) {
            const bf16x8 a = *(const LAS bf16x8*)(SK + (mt * 32 + r) * SK_ROWB + (ks * 16 + hh * 8) * 2);
            acc = MFMA32(a, qb[ks], acc);
        }
        const unsigned hx = (unsigned)hh << 2;
#pragma unroll
        for (int i = 0; i < 16; ++i) {
            const unsigned cn = 32u * mt + (i & 3) + 8u * (i >> 2);
            grp[mt][i] = key_embed(acc[i], 127u, (127u - cn) ^ hx);
        }
        sort16_desc(grp[mt]);
    }
    merge_top16(grp[0], grp[1]); merge_top16(grp[2], grp[3]); merge_top16(grp[0], grp[2]);
    float pb[16];
#pragma unroll
    for (int i = 0; i < 16; ++i) pb[i] = shfl_x(grp[0][i], (hh << 5) | r, 32);
    merge_top16(grp[0], pb);
#pragma unroll
    for (int i = 0; i < 16; ++i) out[i] = grp[0][i];
}

__device__ void ph_peer_select(const Params& p, int l, unsigned char* ldsraw, const int wv) {
    const int tid = opaque_tid(wv);
    const int wave = tid >> 6, lane = tid & 63, r = lane & 31, hh = lane >> 5;
    const int gw = blockIdx.x * 8 + wave, nw = gridDim.x * 8;
    LAS unsigned char* skl = (LAS unsigned char*)ldsraw;
    LAS unsigned char* myl = skl + 2 * 128 * SK_ROWB + wave * 2048 + lane * 32;
    {
        const bf16_t* SKg = (const bf16_t*)(p.ws + OFF_SUBK) + (size_t)l * 2 * 128 * 64;
        for (int i = tid; i < 2 * 128 * 8; i += NT) {
            const int row = i >> 3, ch = i & 7;
            *(LAS u32x4*)(skl + row * SK_ROWB + ch * 16) = *reinterpret_cast<const u32x4*>(SKg + (size_t)row * 64 + ch * 8);
        }
        __syncthreads();
    }
    for (int task = gw; task < (NTOK / 32) * 4; task += nw) {
        const int tg = task >> 2, k = task & 3;
        const int t = tg * 32 + r;
        const bf16_t* Qt = (const bf16_t*)(p.ws + OFF_Q) + (size_t)t * D;
        float sv[2][16];
#pragma unroll
        for (int x = 0; x < 2; ++x) {
            float la[16], lb[16];
            peer_stage1(skl + x * 128 * SK_ROWB, Qt + k * 128 + x * 64, r, hh, la);
            peer_stage1(skl + x * 128 * SK_ROWB, Qt + (k + 4) * 128 + x * 64, r, hh, lb);
#pragma unroll
            for (int i = 0; i < 16; ++i) sv[x][i] = hh ? lb[i] : la[i];
        }
        {
            unsigned w[8];
#pragma unroll
            for (int q = 0; q < 8; ++q) {
                w[q] = 0u;
#pragma unroll
                for (int b = 0; b < 4; ++b) {
                    const int i = q * 4 + b;
                    const unsigned key = __float_as_uint(i < 16 ? sv[0][i] : sv[1][i - 16]);
                    w[q] |= (127u - (key & 127u)) << (8 * b);
                }
            }
            *(LAS u32x4*)(myl) = u32x4{w[0], w[1], w[2], w[3]};
            *(LAS u32x4*)(myl + 16) = u32x4{w[4], w[5], w[6], w[7]};
        }
        float val0[16], val1[16];
#pragma unroll
        for (int i = 0; i < 16; ++i) { val0[i] = __uint_as_float(__float_as_uint(sv[0][i]) & ~127u); val1[i] = __uint_as_float(__float_as_uint(sv[1][i]) & ~127u); }
        float g0[16], g1[16], g2[16], g3[16];
#pragma unroll
        for (int b = 0; b < 16; ++b) g0[b] = key_embed(val0[0] + val1[b], 255u, 255u - (unsigned)b);
#pragma unroll
        for (int b = 0; b < 8; ++b) g1[b] = key_embed(val0[1] + val1[b], 255u, 255u - (16u + b));
#pragma unroll
        for (int b = 0; b < 5; ++b) g1[8 + b] = key_embed(val0[2] + val1[b], 255u, 255u - (32u + b));
#pragma unroll
        for (int b = 0; b < 3; ++b) g1[13 + b] = key_embed(val0[4] + val1[b], 255u, 255u - (64u + b));
#pragma unroll
        for (int b = 0; b < 4; ++b) g2[b] = key_embed(val0[3] + val1[b], 255u, 255u - (48u + b));
#pragma unroll
        for (int a = 5; a < 8; ++a)
#pragma unroll
            for (int b = 0; b < 2; ++b) g2[4 + (a - 5) * 2 + b] = key_embed(val0[a] + val1[b], 255u, 255u - (16u * a + b));
#pragma unroll
        for (int a = 8; a < 14; ++a) g2[10 + (a - 8)] = key_embed(val0[a] + val1[0], 255u, 255u - 16u * a);
        g3[0] = key_embed(val0[14] + val1[0], 255u, 255u - 16u * 14); g3[1] = key_embed(val0[15] + val1[0], 255u, 255u - 16u * 15);
#pragma unroll
        for (int i = 2; i < 16; ++i) g3[i] = -3.0e38f;
        sort16_desc(g1); sort16_desc(g2); sort16_desc(g3);
        merge_top16(g0, g1); merge_top16(g2, g3); merge_top16(g0, g2);
        float gate[16]; int eid[16];
        const float mx = __uint_as_float(__float_as_uint(g0[0]) & ~255u);
        float sum = 0.f;
#pragma unroll
        for (int i = 0; i < 16; ++i) {
            const unsigned key = __float_as_uint(g0[i]);
            gate[i] = __expf(__uint_as_float(key & ~255u) - mx); sum += gate[i];
            const unsigned id = 255u - (key & 255u);
            const unsigned n0 = *(const LAS unsigned char*)(myl + (id >> 4));
            const unsigned n1 = *(const LAS unsigned char*)(myl + 16 + (id & 15u));
            eid[i] = (int)(n0 * 128u + n1);
        }
        const float inv = 1.f / sum;
        const int h = k + 4 * hh;
        int* EI = (int*)(p.ws + OFF_EIDX) + (size_t)t * 128 + h * 16; float* EG = (float*)(p.ws + OFF_EGATE) + (size_t)t * 128 + h * 16;
#pragma unroll
        for (int q = 0; q < 4; ++q) {
            *reinterpret_cast<int4*>(EI + q * 4) = make_int4(eid[q * 4], eid[q * 4 + 1], eid[q * 4 + 2], eid[q * 4 + 3]);
            *reinterpret_cast<float4*>(EG + q * 4) = make_float4(gate[q * 4] * inv, gate[q * 4 + 1] * inv, gate[q * 4 + 2] * inv, gate[q * 4 + 3] * inv);
        }
    }
}

constexpr int LDS_BYTES = LDS_HDR + 3 * 48 * 1024;
__global__ void __launch_bounds__(NT, 2) mk_fwd(Params p) {
    extern __shared__ __attribute__((aligned(16))) unsigned char lds[];
    const int wv = __builtin_amdgcn_readfirstlane((int)(threadIdx.x >> 6));
    volatile LAS unsigned* st = (volatile LAS unsigned*)lds;
    if (threadIdx.x < 4) st[threadIdx.x] = 0u;
    __syncthreads();
    XcdBarrier xb = xcd_barrier_post((unsigned*)(p.ws + OFF_BAR), st);
    int bar_idx = 0;
#define GRID_BAR() do { xcd_barrier(xb); \
        if (PROBE_TS >= 0 && blockIdx.x == 0 && threadIdx.x == 0 && (bar_idx == PROBE_TS - 1 || bar_idx == PROBE_TS)) \
            ((volatile LAS unsigned long long*)(lds + 128))[bar_idx - (PROBE_TS - 1)] = __builtin_amdgcn_s_memrealtime(); \
        ++bar_idx; } while (0)
    if (PROBE_TS == 0 && blockIdx.x == 0 && threadIdx.x == 0) ((volatile LAS unsigned long long*)(lds + 128))[0] = __builtin_amdgcn_s_memrealtime();
    unsigned char* ws = p.ws;
    for (int rep = 0; rep < (PROBE_DUP == 1 ? 2 : 1); ++rep) {
    for (int l = 0; l < 2; ++l) {
        ph_transpose(p.in[I_WIN] + (size_t)l * D * INW, (bf16_t*)(ws + OFF_WIN) + (size_t)l * INW * D, D, INW, lds + LDS_HDR, wv);
        ph_transpose(p.in[I_WOUT] + (size_t)l * D * D, (bf16_t*)(ws + OFF_WOUT) + (size_t)l * D * D, D, D, lds + LDS_HDR, wv);
        ph_transpose(p.in[I_WQ] + (size_t)l * D * D, (bf16_t*)(ws + OFF_WQ) + (size_t)l * D * D, D, D, lds + LDS_HDR, wv);
    }
    ph_convert_i8_rows(p.in[I_PU], ws + OFF_UT, (float*)(ws + OFF_USC), 2 * NEXP, wv);
    ph_convert_i8_rows(p.in[I_PV], ws + OFF_VT, (float*)(ws + OFF_VSC), 2 * NEXP, wv);
    ph_convert(p.in[I_SUBK], (bf16_t*)(ws + OFF_SUBK), 2 * 2 * 128 * 64, wv);
    ph_convert(p.in[I_SGUW], (bf16_t*)(ws + OFF_SGUW), 2 * 4 * 128 * 128, wv);
    ph_mod(p, lds + LDS_HDR, wv);
    ph_rope_tab(p, wv);
    GRID_BAR();
    }
    for (int l = 0; l < 2; ++l) {
        for (int rep = 0; rep < (PROBE_DUP == 3 ? 2 : 1); ++rep) {
        ph_norm_mod(p, l, 0, l == 0 ? 1 : 0, wv);
        ph_cache_prep(p, l, wv);
        GRID_BAR();
        }
        for (int rep = 0; rep < (PROBE_DUP == 5 ? 2 : 1); ++rep) {
        gemm_phase<EPI_INPROJ>(p, l, (const bf16_t*)(ws + OFF_H), (const bf16_t*)(ws + OFF_WIN) + (size_t)l * INW * D, INW, lds + LDS_HDR, wv);
        GRID_BAR();
        }
        for (int rep = 0; rep < ((PROBE_DUP == 4 || (PROBE_DUP >= 10 && PROBE_DUP <= 12)) ? 2 : 1); ++rep) {
        ph_mixers(p, l + 2 * rep, lds + LDS_HDR, wv);
        GRID_BAR();
        }
        gemm_phase<EPI_WOUT>(p, l, (const bf16_t*)(ws + OFF_MIX), (const bf16_t*)(ws + OFF_WOUT) + (size_t)l * D * D, D, lds + LDS_HDR, wv);
        GRID_BAR();
        ph_norm_mod(p, l, 1, 0, wv);
        GRID_BAR();
        for (int rep = 0; rep < (PROBE_DUP == 7 ? 2 : 1); ++rep) {
        gemm_phase<EPI_WQ>(p, l, (const bf16_t*)(ws + OFF_H), (const bf16_t*)(ws + OFF_WQ) + (size_t)l * D * D, D, lds + LDS_HDR, wv);
        GRID_BAR();
        }
        if (PROBE_DUP == 8) { for (int rep = 0; rep < 10; ++rep) GRID_BAR(); }
        for (int rep = 0; rep < (PROBE_DUP == 2 ? 2 : 1); ++rep) {
        ph_peer_select(p, l, lds + LDS_HDR, wv);
        GRID_BAR();
        }
        ph_peer_sliced<false>(p, l, lds + LDS_HDR, wv);
        GRID_BAR();
        ph_peer_pairw(p, l, wv);
        GRID_BAR();
        ph_peer_sliced<true>(p, l, lds + LDS_HDR, wv);
        GRID_BAR();
    }
    ph_final_norm(p, wv);
    if (PROBE_TS >= 0 && blockIdx.x == 0 && threadIdx.x == 0) {
        asm volatile("s_waitcnt vmcnt(0)" ::: "memory");
        volatile LAS unsigned long long* tsl = (volatile LAS unsigned long long*)(lds + 128);
        p.out[0] += (float)(tsl[1] - tsl[0]) * 0.01f;
    }
}

extern "C" void kernel_launch(void* const* d_in, const int* in_sizes, int n_in,
                              void* d_out, int out_size, void* d_ws, size_t ws_size,
                              hipStream_t stream) {
    static int grid = 0;
    if (grid == 0) {
        if (ws_size < WS_NEED) { fprintf(stderr, "kernel_launch: workspace too small: %zu < %zu\n", ws_size, (size_t)WS_NEED); grid = -1; return; }
        int dev = 0, cus = 0, per_cu = 0;
        (void)hipGetDevice(&dev);
        (void)hipDeviceGetAttribute(&cus, hipDeviceAttributeMultiprocessorCount, dev);
        (void)hipFuncSetAttribute((const void*)mk_fwd, hipFuncAttributeMaxDynamicSharedMemorySize, LDS_BYTES);
        (void)hipOccupancyMaxActiveBlocksPerMultiprocessor(&per_cu, (const void*)mk_fwd, NT, LDS_BYTES);
        if (per_cu < 1) { fprintf(stderr, "kernel_launch: occupancy query reports %d blocks per CU\n", per_cu); grid = -1; return; }
        grid = cus;
    }
    if (grid < 0) return;
    (void)hipMemsetAsync((unsigned char*)d_ws + OFF_BAR, 0, 64 * 1024, stream);
    Params p{};
    for (int i = 0; i < 29; ++i) p.in[i] = (const float*)d_in[i];
    p.out = (float*)d_out; p.ws = (unsigned char*)d_ws;
    void* args[] = {&p};
    hipError_t e = hipLaunchCooperativeKernel((const void*)mk_fwd, dim3(grid), dim3(NT), args, LDS_BYTES, stream);
    if (e != hipSuccess) fprintf(stderr, "kernel_launch: cooperative launch failed: %s (grid %d)\n", hipGetErrorString(e), grid);
}
```

```cpp
#include <hip/hip_runtime.h>
#include <hip/hip_bf16.h>
#include <cstdio>
#include <cstdint>
#include <hip/hip_cooperative_groups.h>
namespace cg = cooperative_groups;

#define PROBE_DUP 0
#define PROBE_TS -1
typedef unsigned short bf16_t;
using bf16x8 = __attribute__((ext_vector_type(8))) short;
using f32x4  = __attribute__((ext_vector_type(4))) float;
using f32x16 = __attribute__((ext_vector_type(16))) float;
using f32x2  = __attribute__((ext_vector_type(2))) float;
using u32x4  = __attribute__((ext_vector_type(4))) unsigned;
using u32x2  = __attribute__((ext_vector_type(2))) unsigned;
using s16x4  = __attribute__((ext_vector_type(4))) short;

constexpr int D      = 1024;
constexpr int NTOK   = 16384;
constexpr int NPT    = 8192;
constexpr int SEQ    = 256;
constexpr int DSEQ   = 2048;
constexpr int PAST   = 512;
constexpr int NKS    = DSEQ + PAST;
constexpr int INW    = 2048;
constexpr int NEXP   = 16384;
constexpr float EPS  = 1e-6f;

constexpr size_t MB = 1024 * 1024;
constexpr size_t OFF_BAR   = 0;
constexpr size_t OFF_MOD   = 64 * 1024;
constexpr size_t OFF_ROPE  = OFF_MOD + 256 * 1024;
constexpr size_t OFF_SUBK  = OFF_ROPE + 1 * MB;
constexpr size_t OFF_SGUW  = OFF_SUBK + 64 * 1024;
constexpr size_t OFF_WIN   = OFF_SGUW + 256 * 1024;
constexpr size_t OFF_WOUT  = OFF_WIN + 8 * MB;
constexpr size_t OFF_WQ    = OFF_WOUT + 4 * MB;
constexpr size_t OFF_UT    = OFF_WQ + 4 * MB;
constexpr size_t OFF_USC   = OFF_UT + 32 * MB;
constexpr size_t OFF_VT    = OFF_UT + 64 * MB;
constexpr size_t OFF_VSC   = OFF_VT + 32 * MB;
constexpr size_t OFF_H     = OFF_VT + 64 * MB;
constexpr size_t OFF_XC    = OFF_H + 32 * MB;
constexpr size_t OFF_R1    = OFF_XC + 64 * MB;
constexpr size_t OFF_AU    = OFF_R1;
constexpr size_t OFF_AV    = OFF_AU + 8 * MB;
constexpr size_t OFF_AVN   = OFF_AV + 8 * MB;
constexpr size_t OFF_DQ    = OFF_AVN + 8 * MB;
constexpr size_t OFF_DKP   = OFF_DQ + 8 * MB;
constexpr size_t OFF_DKS   = OFF_DKP + 4 * MB;
constexpr size_t OFF_DVTP  = OFF_DKS + 5 * MB;
constexpr size_t OFF_DVTS  = OFF_DVTP + 4 * MB;
constexpr size_t OFF_GQ    = OFF_DVTS + 5 * MB;
constexpr size_t OFF_GKP   = OFF_GQ + 16 * MB;
constexpr size_t OFF_GKS   = OFF_GKP + 2 * MB;
constexpr size_t OFF_GVTP  = OFF_GKS + 3 * MB;
constexpr size_t OFF_GVTS  = OFF_GVTP + 2 * MB;
constexpr size_t OFF_MIX   = OFF_GVTS + 3 * MB;
constexpr size_t OFF_R1END = OFF_MIX + 32 * MB;
constexpr size_t OFF_Q     = OFF_R1;
constexpr size_t OFF_EIDX  = OFF_Q + 32 * MB;
constexpr size_t OFF_EGATE = OFF_EIDX + 8 * MB;
constexpr size_t OFF_TOPV  = OFF_EGATE + 8 * MB;
constexpr size_t OFF_TOPI  = OFF_TOPV + 16 * MB;
static_assert(OFF_TOPI + 16 * MB <= OFF_R1END, "peer buffers must fit region 1");
constexpr size_t OFF_PROJ  = OFF_R1END;
constexpr size_t OFF_PART  = OFF_PROJ;
constexpr size_t OFF_WPAIR = OFF_PART + 64 * MB;
constexpr size_t OFF_H8I   = OFF_WPAIR + 8 * MB;
constexpr size_t OFF_HSC   = OFF_H8I + 16 * MB;
constexpr size_t OFF_WSC   = OFF_HSC + 64 * 1024;
constexpr size_t OFF_XGS   = OFF_WSC + 64 * 1024;
constexpr size_t OFF_RSS2  = OFF_XGS + 512 * 1024;
constexpr size_t OFF_RSS1  = OFF_RSS2 + 1 * MB;
constexpr size_t OFF_USH   = OFF_RSS1 + 512 * 1024;
constexpr size_t OFF_BQ    = OFF_USH + 1 * MB;
constexpr size_t OFF_BIN   = OFF_BQ + 64 * 1024;
constexpr size_t OFF_WQS   = OFF_BIN + 64 * 1024;
constexpr size_t OFF_WINS  = OFF_XC + 32 * MB;
static_assert(OFF_WQS + 20 * MB <= OFF_PROJ + 128 * MB, "folded tables must fit");
constexpr size_t WS_NEED   = OFF_PROJ + 128 * MB;
static_assert(WS_NEED <= 512 * MB, "workspace budget");

constexpr size_t OUT_YP  = 0;
constexpr size_t OUT_YS  = 8388608;
constexpr size_t OUT_NDK = 16777216;
constexpr size_t OUT_NDV = OUT_NDK + 4194304;
constexpr size_t OUT_NGK = OUT_NDV + 4194304;
constexpr size_t OUT_NGV = OUT_NGK + 2097152;

struct Params {
    const float* in[29];
    float* out;
    unsigned char* ws;
};
enum { I_XP = 0, I_XS, I_CDK, I_CDV, I_CGK, I_CGV, I_C, I_CCTX, I_ADAW, I_ADAB, I_N1G, I_N2G, I_WIN, I_SGUNG, I_SGUW, I_SGUB,
       I_LQ1, I_LK1, I_LQ2, I_LK2, I_SUBLN, I_QNG, I_KNG, I_WOUT, I_WQ, I_SUBK, I_PU, I_PV, I_FG };

typedef __bf16 hwbf2 __attribute__((ext_vector_type(2)));
__device__ __forceinline__ unsigned pack_bf2(float a, float b) {
    const f32x2 v = {a, b};
    return __builtin_bit_cast(unsigned, __builtin_convertvector(v, hwbf2));
}
__device__ __forceinline__ bf16_t f2bf(float f) { return (bf16_t)(pack_bf2(f, 0.f) & 0xffffu); }
__device__ __forceinline__ float bf2f(bf16_t h) { return __uint_as_float(((unsigned)h) << 16); }
__device__ __forceinline__ float gelu_f(float x) {
    const float k2 = 2.f * 0.7978845608028654f * 1.4426950408889634f;
    const float e = __builtin_amdgcn_exp2f(k2 * (x + 0.044715f * x * x * x));
    return x - x * __builtin_amdgcn_rcpf(e + 1.f);
}
__device__ __forceinline__ int lane_id() { return (int)__builtin_amdgcn_mbcnt_hi(~0u, __builtin_amdgcn_mbcnt_lo(~0u, 0u)); }
__device__ __forceinline__ int lane_id_op() { int l = lane_id(); asm volatile("" : "+v"(l)); return l; }
__device__ __forceinline__ float shfl_i(float v, int src) { return __builtin_bit_cast(float, __builtin_amdgcn_ds_bpermute(src << 2, __builtin_bit_cast(int, v))); }
__device__ __forceinline__ int shfl_i(int v, int src) { return __builtin_amdgcn_ds_bpermute(src << 2, v); }
__device__ __forceinline__ float shfl_x(float v, int lane, int m) { return shfl_i(v, lane ^ m); }
__device__ __forceinline__ int shfl_x(int v, int lane, int m) { return shfl_i(v, lane ^ m); }
__device__ __forceinline__ int q8(float x) { return (int)fminf(fmaxf(rintf(x), -127.f), 127.f); }
__device__ __forceinline__ unsigned pack4_i8(int a, int b, int c, int d) { return (unsigned)(a & 255) | ((unsigned)(b & 255) << 8) | ((unsigned)(c & 255) << 16) | ((unsigned)d << 24); }
#define DPP_F(v, ctrl) __builtin_bit_cast(float, __builtin_amdgcn_update_dpp(0, __builtin_bit_cast(int, (v)), (ctrl), 0xF, 0xF, false))
__device__ __forceinline__ float row16_sum(float v) {
    v += DPP_F(v, 0xB1); v += DPP_F(v, 0x4E); v += DPP_F(v, 0x141); v += DPP_F(v, 0x140);
    return v;
}
__device__ __forceinline__ float row16_max(float v) {
    v = fmaxf(v, DPP_F(v, 0xB1)); v = fmaxf(v, DPP_F(v, 0x4E)); v = fmaxf(v, DPP_F(v, 0x141)); v = fmaxf(v, DPP_F(v, 0x140));
    return v;
}
__device__ __forceinline__ float rdlane_f(float v, int l) { return __builtin_bit_cast(float, __builtin_amdgcn_readlane(__builtin_bit_cast(int, v), l)); }
__device__ __forceinline__ float wave_sum(float v) {
    v = row16_sum(v);
    return (rdlane_f(v, 0) + rdlane_f(v, 16)) + (rdlane_f(v, 32) + rdlane_f(v, 48));
}
__device__ __forceinline__ float wave_max(float v) {
    v = row16_max(v);
    return fmaxf(fmaxf(rdlane_f(v, 0), rdlane_f(v, 16)), fmaxf(rdlane_f(v, 32), rdlane_f(v, 48)));
}
__device__ __forceinline__ int tok_cv(int t) { return t < NPT ? 0 : 1 + ((t - NPT) >> 11); }
__device__ __forceinline__ const float* x_in_row(const Params& p, int t) {
    return t < NPT ? p.in[I_XP] + (size_t)t * D : p.in[I_XS] + (size_t)(t - NPT) * D;
}
__device__ __forceinline__ float lam_init_of(int l) { return l == 0 ? 0.2f : (0.8f - 0.6f * 0.7408182206817179f); }
__device__ __forceinline__ float lam_of(const Params& p, int l) {
    float s1 = 0.f, s2 = 0.f;
    for (int i = 0; i < 32; ++i) {
        s1 += p.in[I_LQ1][l * 32 + i] * p.in[I_LK1][l * 32 + i];
        s2 += p.in[I_LQ2][l * 32 + i] * p.in[I_LK2][l * 32 + i];
    }
    return expf(s1) - expf(s2) + lam_init_of(l);
}


#define XB_TMO      128
#define XB_XCNT(j)  (256  + 64 * (j))
#define XB_XSUB(j)  (1280 + 64 * (j))
#define XB_XGEN(j)  (2304 + 64 * (j))
#define XB_TOP      3328
#define XB_TOPGEN   3392
#define XCD_BAR_WORDS 3456
#define XB_SPIN_CAP (1u << 20)
#define LAS __attribute__((address_space(3)))
typedef int i32x4 __attribute__((ext_vector_type(4)));
__device__ __forceinline__ unsigned xb_ld(unsigned* p)              { return __hip_atomic_load(p, __ATOMIC_RELAXED, __HIP_MEMORY_SCOPE_AGENT); }
__device__ __forceinline__ unsigned xb_add(unsigned* p, unsigned v) { return __hip_atomic_fetch_add(p, v, __ATOMIC_RELAXED, __HIP_MEMORY_SCOPE_AGENT); }
__device__ __forceinline__ unsigned xb_xcc_id() { return (unsigned)__builtin_amdgcn_s_getreg((3 << 11) | 20) & 0xFu; }
#define XB_SPIN(cond, bar) do { unsigned _sp = 0; while (cond) { __builtin_amdgcn_s_sleep(1); \
    if ((++_sp & 255u) == 0u) { if (xb_ld(&(bar)[XB_TMO])) break; if (_sp > XB_SPIN_CAP) { atomicAdd(&(bar)[XB_TMO], 1u); break; } } } } while (0)
struct XcdBarrier { unsigned* bar; unsigned x; volatile LAS unsigned* st; };
__device__ __forceinline__ XcdBarrier xcd_barrier_post(unsigned* bar, volatile LAS unsigned* st) {
    XcdBarrier b; b.bar = bar; b.x = xb_xcc_id(); b.st = st;
    if (threadIdx.x == 0) (void)xb_add(&bar[XB_XCNT(b.x)], 1u);
    return b;
}
__device__ __forceinline__ void xcd_barrier_complete(unsigned* bar, unsigned x, unsigned& nloc, unsigned& nx) {
    const unsigned G = gridDim.x * gridDim.y * gridDim.z;
    unsigned sum, cnt, mine, sp = 0u;
    for (;;) {
        sum = 0u; cnt = 0u; mine = 0u;
#pragma unroll
        for (unsigned j = 0; j < 16; ++j) { const unsigned c = xb_ld(&bar[XB_XCNT(j)]); sum += c; cnt += (c > 0u) ? 1u : 0u; mine = (j == x) ? c : mine; }
        if (sum == G) break;
        __builtin_amdgcn_s_sleep(1);
        if ((++sp & 255u) == 0u) { if (xb_ld(&bar[XB_TMO])) break; if (sp > XB_SPIN_CAP) { atomicAdd(&bar[XB_TMO], 1u); break; } }
    }
    nloc = mine > 0u ? mine : 1u; nx = cnt > 0u ? cnt : 1u;
}
__device__ __forceinline__ void xcd_barrier(const XcdBarrier& b) {
    asm volatile("s_waitcnt vmcnt(0)" ::: "memory");
    __syncthreads();
    if (threadIdx.x == 0) {
        unsigned* bar = b.bar;
        const unsigned bx = xb_xcc_id();
        __builtin_amdgcn_s_waitcnt(0);
        unsigned nloc = b.st[0], nx = b.st[1];
        if (nloc == 0u) { xcd_barrier_complete(bar, bx, nloc, nx); b.st[0] = nloc; b.st[1] = nx; }
        const unsigned old = xb_add(&bar[XB_XSUB(bx)], 1u);
        const unsigned gen = old / nloc;
        if (old + 1u == (gen + 1u) * nloc) {
            __builtin_amdgcn_fence(__ATOMIC_RELEASE, "agent");
            asm volatile("s_waitcnt vmcnt(0)" ::: "memory");
            const unsigned og = xb_add(&bar[XB_TOP], 1u);
            const unsigned tg = og / nx;
            if (og + 1u == (tg + 1u) * nx) xb_add(&bar[XB_TOPGEN], 1u);
            else XB_SPIN(xb_ld(&bar[XB_TOPGEN]) == tg, bar);
            __builtin_amdgcn_fence(__ATOMIC_ACQUIRE, "agent");
            xb_add(&bar[XB_XGEN(bx)], 1u);
            asm volatile("s_waitcnt vmcnt(0)" ::: "memory");
        } else {
            XB_SPIN(xb_ld(&bar[XB_XGEN(bx)]) == gen, bar);
            __builtin_amdgcn_fence(__ATOMIC_ACQUIRE, "agent");
            asm volatile("s_waitcnt vmcnt(0)" ::: "memory");
        }
    }
    __syncthreads();
}

constexpr int NT = 512;
constexpr int LDS_HDR = 1024;
#define GTID ((size_t)blockIdx.x * NT + tid)
__device__ __forceinline__ int opaque_tid(int wv) { int t = (wv << 6) | lane_id(); asm volatile("" : "+v"(t)); return t; }
#define GNT  ((size_t)gridDim.x * NT)

__device__ void ph_transpose(const float* __restrict__ W, bf16_t* __restrict__ Wt, int K, int N, unsigned char* ldsraw, const int wv) {
    const int tid = opaque_tid(wv);
    LAS bf16_t* T = (LAS bf16_t*)ldsraw;
    const int tk = K / 128, tn = N / 64, ntiles = tk * tn;
    for (int tile = blockIdx.x; tile < ntiles; tile += gridDim.x) {
        const int k0 = (tile % tk) * 128, n0 = (tile / tk) * 64;
#pragma unroll 4
        for (int i = 0; i < 16; ++i) {
            const int kl = i * 8 + (tid >> 6), nl = tid & 63;
            T[nl * 130 + kl] = f2bf(W[(size_t)(k0 + kl) * N + n0 + nl]);
        }
        __syncthreads();
        {
            const int nl = tid >> 3, kc = tid & 7;
            unsigned w[8];
#pragma unroll
            for (int i = 0; i < 8; ++i) w[i] = (unsigned)T[nl * 130 + kc * 16 + 2 * i] | ((unsigned)T[nl * 130 + kc * 16 + 2 * i + 1] << 16);
            bf16_t* dst = Wt + (size_t)(n0 + nl) * K + k0 + kc * 16;
            *reinterpret_cast<u32x4*>(dst) = u32x4{w[0], w[1], w[2], w[3]};
            *reinterpret_cast<u32x4*>(dst + 8) = u32x4{w[4], w[5], w[6], w[7]};
        }
        __syncthreads();
    }
}
__device__ void ph_convert(const float* __restrict__ src, bf16_t* __restrict__ dst, size_t n, const int wv) {
    const int tid = opaque_tid(wv);
    for (size_t idx = GTID; idx < n; idx += GNT) dst[idx] = f2bf(src[idx]);
}
__device__ void ph_convert_i8_rows(const float* __restrict__ src, unsigned char* __restrict__ dst, float* __restrict__ scl, int nrows, const int wv) {
    const int tid = opaque_tid(wv);
    const int lane = tid & 63;
    const int gw = blockIdx.x * 8 + (tid >> 6), nw = gridDim.x * 8;
    for (int row0 = gw * 4; row0 < nrows; row0 += nw * 4) {
        float4 f[4][4];
#pragma unroll
        for (int q = 0; q < 4; ++q)
#pragma unroll
            for (int i = 0; i < 4; ++i) f[q][i] = *reinterpret_cast<const float4*>(src + (size_t)(row0 + q) * D + lane * 16 + i * 4);
#pragma unroll
        for (int q = 0; q < 4; ++q) {
            const int row = row0 + q;
            float v[16];
#pragma unroll
            for (int i = 0; i < 4; ++i) { v[i * 4] = f[q][i].x; v[i * 4 + 1] = f[q][i].y; v[i * 4 + 2] = f[q][i].z; v[i * 4 + 3] = f[q][i].w; }
            float am = 0.f;
#pragma unroll
            for (int i = 0; i < 16; ++i) am = fmaxf(am, fabsf(v[i]));
#pragma unroll
            for (int o = 32; o >= 1; o >>= 1) am = fmaxf(am, shfl_x(am, lane, o));
            const float sc = am > 0.f ? 127.f / am : 1.f;
            unsigned w[4];
#pragma unroll
            for (int i = 0; i < 4; ++i) w[i] = pack4_i8(q8(v[i * 4] * sc), q8(v[i * 4 + 1] * sc), q8(v[i * 4 + 2] * sc), q8(v[i * 4 + 3] * sc));
            {
                const int lyr = row >> 14, e = row & (NEXP - 1);
                *reinterpret_cast<u32x4*>(dst + (((size_t)lyr * 8 + (lane >> 3)) * NEXP + e) * 128 + (lane & 7) * 16) = u32x4{w[0], w[1], w[2], w[3]};
            }
            if (lane == 0) scl[row] = am > 0.f ? am * (1.f / 127.f) : 1.f;
        }
    }
}
__device__ void ph_mod(const Params& p, unsigned char* ldsraw, const int wv) {
    const int tid = opaque_tid(wv);
    LAS float* sl = (LAS float*)ldsraw;
    LAS float* red = sl + 5 * 1024;
    for (int i = tid; i < 5 * 1024; i += NT) {
        const int cv = i >> 10, k = i & 1023;
        const float c = cv == 0 ? p.in[I_CCTX][k] : p.in[I_C][(size_t)(cv - 1) * D + k];
        sl[i] = c / (1.f + __expf(-c));
    }
    __syncthreads();
    const int c = tid & 63, ks = tid >> 6;
    for (int item = blockIdx.x; item < 2 * 96; item += gridDim.x) {
        const int l = item / 96, j = (item % 96) * 64 + c;
        const float* W = p.in[I_ADAW] + (size_t)l * D * 6144 + (size_t)(ks * 128) * 6144 + j;
        float acc[5] = {0.f, 0.f, 0.f, 0.f, 0.f};
#pragma unroll 8
        for (int k = 0; k < 128; ++k) {
            const float w = W[(size_t)k * 6144];
#pragma unroll
            for (int cv = 0; cv < 5; ++cv) acc[cv] += sl[cv * 1024 + ks * 128 + k] * w;
        }
#pragma unroll
        for (int cv = 0; cv < 5; ++cv) red[(ks * 5 + cv) * 64 + c] = acc[cv];
        __syncthreads();
        if (tid < 320) {
            const int cv = tid >> 6;
            float sum = p.in[I_ADAB][l * 6144 + j];
#pragma unroll
            for (int q = 0; q < 8; ++q) sum += red[(q * 5 + cv) * 64 + c];
            ((float*)(p.ws + OFF_MOD))[(size_t)(l * 5 + cv) * 6144 + j] = sum;
        }
        __syncthreads();
    }
}
__device__ void ph_rope_tab(const Params& p, const int wv) {
    const int tid = opaque_tid(wv);
    for (size_t idx = GTID; idx < 2048 * 48; idx += GNT) {
        int s = idx / 48, i = idx % 48;
        float* R = (float*)(p.ws + OFF_ROPE);
        double row = (double)(s / 64), col = (double)(s % 64);
        if (i < 16) {
            int q = i & 7; double inv = pow(10000.0, -(double)q / 8.0);
            double ang = (i < 8 ? row : col) * inv;
            R[s * 16 + i] = (float)cos(ang); R[2048 * 16 + s * 16 + i] = (float)sin(ang);
        } else {
            int ii = i - 16; int q = ii & 15; double inv = pow(10000.0, -(double)q / 16.0);
            double ang = (ii < 16 ? row : col) * inv;
            R[2048 * 32 + s * 32 + ii] = (float)cos(ang); R[2048 * 64 + s * 32 + ii] = (float)sin(ang);
        }
    }
}
__device__ void ph_cache_prep(const Params& p, int l, const int wv) {
    const int tid = opaque_tid(wv);
    bf16_t* DKS = (bf16_t*)(p.ws + OFF_DKS); bf16_t* DVTS = (bf16_t*)(p.ws + OFF_DVTS);
    bf16_t* GKS = (bf16_t*)(p.ws + OFF_GKS); bf16_t* GVTS = (bf16_t*)(p.ws + OFF_GVTS);
    for (size_t idx = GTID; idx < 4 * 512 * 256; idx += GNT) {
        int c = idx & 255, pp = (idx >> 8) & 511, b = idx >> 17;
        size_t src = (((size_t)b * 2 + l) * PAST + pp) * 256 + c;
        int h = c >> 6, r = c & 63;
        DKS[(((size_t)b * 4 + h) * NKS + DSEQ + pp) * 64 + r] = f2bf(p.in[I_CDK][src]);
        DVTS[(((size_t)b * 4 + h) * 64 + r) * NKS + DSEQ + pp] = f2bf(p.in[I_CDV][src]);
        if (c < 128) {
            size_t src2 = (((size_t)b * 2 + l) * PAST + pp) * 128 + c;
            int kv = c >> 6;
            GKS[(((size_t)b * 2 + kv) * NKS + DSEQ + pp) * 64 + r] = f2bf(p.in[I_CGK][src2]);
            GVTS[(((size_t)b * 2 + kv) * 64 + r) * NKS + DSEQ + pp] = f2bf(p.in[I_CGV][src2]);
        }
    }
}
__device__ void ph_fold_tables(const Params& p, unsigned char* ldsraw, const int wv) {
    const int tid = opaque_tid(wv);
    const int lane = tid & 63;
    const int gw = blockIdx.x * 8 + (tid >> 6), nw = gridDim.x * 8;
    const float* MOD = (const float*)(p.ws + OFF_MOD);
    for (size_t idx = GTID; idx < (size_t)(1024 + 1024 + 2048) * 128; idx += GNT) {
        const int row = (int)(idx >> 7), k0 = (int)(idx & 127) * 8;
        const int which = row < 2048 ? 1 : 0, l = row < 1024 ? 0 : 1;
        const int n = row < 2048 ? (row & 1023) : row - 2048, N = row < 2048 ? 1024 : 2048;
        const bf16_t* src = row < 2048 ? (const bf16_t*)(p.ws + OFF_WQ) + ((size_t)l * D + n) * D + k0 : (const bf16_t*)(p.ws + OFF_WIN) + ((size_t)INW + n) * D + k0;
        bf16_t* dst = row < 2048 ? (bf16_t*)(p.ws + OFF_WQS) + ((size_t)l * 5 * D + n) * D + k0 : (bf16_t*)(p.ws + OFF_WINS) + (size_t)n * D + k0;
        const u32x4 w = *reinterpret_cast<const u32x4*>(src);
        const float* gn = p.in[which ? I_N2G : I_N1G] + l * D + k0;
        const float4 ga = *reinterpret_cast<const float4*>(gn), gb = *reinterpret_cast<const float4*>(gn + 4);
        float wf[8];
#pragma unroll
        for (int k = 0; k < 4; ++k) { wf[2 * k] = __uint_as_float(w[k] << 16); wf[2 * k + 1] = __uint_as_float(w[k] & 0xffff0000u); }
        wf[0] *= ga.x; wf[1] *= ga.y; wf[2] *= ga.z; wf[3] *= ga.w; wf[4] *= gb.x; wf[5] *= gb.y; wf[6] *= gb.z; wf[7] *= gb.w;
#pragma unroll
        for (int cv = 0; cv < 5; ++cv) {
            const float* sc = MOD + (size_t)(l * 5 + cv) * 6144 + which * 3072 + 1024 + k0;
            const float4 sa = *reinterpret_cast<const float4*>(sc), sb = *reinterpret_cast<const float4*>(sc + 4);
            *reinterpret_cast<u32x4*>(dst + (size_t)cv * N * D) = u32x4{pack_bf2(wf[0] * (1.f + sa.x), wf[1] * (1.f + sa.y)), pack_bf2(wf[2] * (1.f + sa.z), wf[3] * (1.f + sa.w)),
                                                                         pack_bf2(wf[4] * (1.f + sb.x), wf[5] * (1.f + sb.y)), pack_bf2(wf[6] * (1.f + sb.z), wf[7] * (1.f + sb.w))};
        }
    }
    for (int row = gw; row < 1024 + 1024 + 2048; row += nw) {
        const int which = row < 2048 ? 1 : 0, l = row < 1024 ? 0 : 1;
        const int n = row < 2048 ? (row & 1023) : row - 2048;
        const bf16_t* src = row < 2048 ? (const bf16_t*)(p.ws + OFF_WQ) + ((size_t)l * D + n) * D + lane * 16 : (const bf16_t*)(p.ws + OFF_WIN) + ((size_t)INW + n) * D + lane * 16;
        const u32x4 w0 = *reinterpret_cast<const u32x4*>(src), w1 = *reinterpret_cast<const u32x4*>(src + 8);
        float wf[16];
#pragma unroll
        for (int k = 0; k < 4; ++k) { wf[2 * k] = __uint_as_float(w0[k] << 16); wf[2 * k + 1] = __uint_as_float(w0[k] & 0xffff0000u);
                                      wf[8 + 2 * k] = __uint_as_float(w1[k] << 16); wf[8 + 2 * k + 1] = __uint_as_float(w1[k] & 0xffff0000u); }
#pragma unroll
        for (int cv = 0; cv < 5; ++cv) {
            const float* sh = MOD + (size_t)(l * 5 + cv) * 6144 + which * 3072 + lane * 16;
            float acc = 0.f;
#pragma unroll
            for (int q = 0; q < 4; ++q) {
                const float4 a = *reinterpret_cast<const float4*>(sh + q * 4);
                acc += wf[q * 4] * a.x + wf[q * 4 + 1] * a.y + wf[q * 4 + 2] * a.z + wf[q * 4 + 3] * a.w;
            }
            acc = wave_sum(acc);
            if (lane == 0) {
                if (row < 2048) ((float*)(p.ws + OFF_BQ))[(size_t)(l * 5 + cv) * D + n] = acc;
                else            ((float*)(p.ws + OFF_BIN))[(size_t)cv * INW + n] = acc;
            }
        }
    }
    {
        LAS signed char* s8 = (LAS signed char*)ldsraw;
        LAS float* s8s = (LAS float*)(ldsraw + 10 * 1024);
        const int wave = tid >> 6;
        for (int r = wave; r < 10; r += 8) {
            const float* sh = MOD + (size_t)r * 6144 + 3072 + lane * 16;
            float v[16];
#pragma unroll
            for (int q = 0; q < 4; ++q) { const float4 a = *reinterpret_cast<const float4*>(sh + q * 4); v[q * 4] = a.x; v[q * 4 + 1] = a.y; v[q * 4 + 2] = a.z; v[q * 4 + 3] = a.w; }
            float am = 0.f;
#pragma unroll
            for (int i = 0; i < 16; ++i) am = fmaxf(am, fabsf(v[i]));
            am = wave_max(am);
            const float sc = am > 0.f ? 127.f / am : 1.f;
            u32x4 w;
#pragma unroll
            for (int q = 0; q < 4; ++q) w[q] = pack4_i8(q8(v[q * 4] * sc), q8(v[q * 4 + 1] * sc), q8(v[q * 4 + 2] * sc), q8(v[q * 4 + 3] * sc));
            *(LAS u32x4*)(s8 + r * 1024 + lane * 16) = w;
            if (lane == 0) s8s[r] = am > 0.f ? am * (1.f / 127.f) : 1.f;
        }
        __syncthreads();
        const int fr = lane & 15, fq = lane >> 4;
        for (int task = gw; task < 2 * (NEXP / 16); task += nw) {
            const int l = task >> 10, e0 = (task & 1023) * 16;
            const unsigned char* up = p.ws + OFF_UT + ((size_t)l * 8 * NEXP + e0 + fr) * 128 + fq * 16;
            i32x4 acc = {0, 0, 0, 0};
#pragma unroll
            for (int st = 0; st < 16; ++st) {
                const i32x4 a = *reinterpret_cast<const i32x4*>(up + (size_t)(st >> 1) * NEXP * 128 + (st & 1) * 64);
                i32x4 b = {0, 0, 0, 0};
                if (fr < 5) b = *(const LAS i32x4*)(s8 + (l * 5 + fr) * 1024 + st * 64 + fq * 16);
                acc = __builtin_amdgcn_mfma_i32_16x16x64_i8(a, b, acc, 0, 0, 0);
            }
            if (fr < 5) {
                const float ss = s8s[l * 5 + fr];
#pragma unroll
                for (int r = 0; r < 4; ++r) {
                    const int e = e0 + fq * 4 + r;
                    ((float*)(p.ws + OFF_USH))[(size_t)(l * 5 + fr) * NEXP + e] = (float)acc[r] * ss * ((const float*)(p.ws + OFF_USC))[l * NEXP + e];
                }
            }
        }
        __syncthreads();
    }
}
__device__ void ph_norm_mod(const Params& p, int l, int which, int from_input, const int wv) {
    const int tid = opaque_tid(wv);
    const int lane = tid & 63;
    const int gw = blockIdx.x * 8 + (tid >> 6), nw = gridDim.x * 8;
    const float* g = p.in[which ? I_N2G : I_N1G] + l * D;
    if (from_input) {
        float4 nx[4];
        {
            const int t = gw < NTOK ? gw : NTOK - 1;
            const float* xr = x_in_row(p, t);
#pragma unroll
            for (int i = 0; i < 4; ++i) nx[i] = *reinterpret_cast<const float4*>(xr + i * 256 + lane * 4);
        }
        for (int t = gw; t < NTOK; t += nw) {
            float4 v[4];
#pragma unroll
            for (int i = 0; i < 4; ++i) v[i] = nx[i];
            {
                const int tn = t + nw < NTOK ? t + nw : t;
                const float* xn = x_in_row(p, tn);
#pragma unroll
                for (int i = 0; i < 4; ++i) nx[i] = *reinterpret_cast<const float4*>(xn + i * 256 + lane * 4);
            }
            const float* mod = (const float*)(p.ws + OFF_MOD) + (size_t)(l * 5 + tok_cv(t)) * 6144 + which * 3072;
            float ss = 0.f;
#pragma unroll
            for (int i = 0; i < 4; ++i) ss += v[i].x * v[i].x + v[i].y * v[i].y + v[i].z * v[i].z + v[i].w * v[i].w;
            ss = wave_sum(ss);
            float r = rsqrtf(ss / D + EPS);
            bf16_t* H = (bf16_t*)(p.ws + OFF_H) + (size_t)t * D;
#pragma unroll
            for (int i = 0; i < 4; ++i) {
                int c = i * 256 + lane * 4;
                float4 gg = *reinterpret_cast<const float4*>(g + c), sh = *reinterpret_cast<const float4*>(mod + c), sc = *reinterpret_cast<const float4*>(mod + 1024 + c);
                uint2 o;
                o.x = pack_bf2(v[i].x * r * gg.x * (1.f + sc.x) + sh.x, v[i].y * r * gg.y * (1.f + sc.y) + sh.y);
                o.y = pack_bf2(v[i].z * r * gg.z * (1.f + sc.z) + sh.z, v[i].w * r * gg.w * (1.f + sc.w) + sh.w);
                *reinterpret_cast<uint2*>(H + c) = o;
            }
        }
    } else {
        u32x4 nx[2];
        {
            const int t = gw < NTOK ? gw : NTOK - 1;
            const bf16_t* xr = (const bf16_t*)(p.ws + OFF_XC) + (size_t)t * D + lane * 8;
            nx[0] = *reinterpret_cast<const u32x4*>(xr); nx[1] = *reinterpret_cast<const u32x4*>(xr + 512);
        }
        for (int t = gw; t < NTOK; t += nw) {
            float v[16];
#pragma unroll
            for (int h = 0; h < 2; ++h)
#pragma unroll
                for (int k = 0; k < 4; ++k) { v[h * 8 + 2 * k] = __uint_as_float(nx[h][k] << 16); v[h * 8 + 2 * k + 1] = __uint_as_float(nx[h][k] & 0xffff0000u); }
            {
                const int tn = t + nw < NTOK ? t + nw : t;
                const bf16_t* xn = (const bf16_t*)(p.ws + OFF_XC) + (size_t)tn * D + lane * 8;
                nx[0] = *reinterpret_cast<const u32x4*>(xn); nx[1] = *reinterpret_cast<const u32x4*>(xn + 512);
            }
            const float* mod = (const float*)(p.ws + OFF_MOD) + (size_t)(l * 5 + tok_cv(t)) * 6144 + which * 3072;
            float ss = 0.f;
#pragma unroll
            for (int i = 0; i < 16; ++i) ss += v[i] * v[i];
            ss = wave_sum(ss);
            float r = rsqrtf(ss / D + EPS);
            bf16_t* H = (bf16_t*)(p.ws + OFF_H) + (size_t)t * D;
            float hq[16];
#pragma unroll
            for (int h = 0; h < 2; ++h) {
                const int c = h * 512 + lane * 8;
                float o[8];
#pragma unroll
                for (int q = 0; q < 2; ++q) {
                    const float4 gg = *reinterpret_cast<const float4*>(g + c + q * 4), sh = *reinterpret_cast<const float4*>(mod + c + q * 4), sc = *reinterpret_cast<const float4*>(mod + 1024 + c + q * 4);
                    o[q * 4] = v[h * 8 + q * 4] * r * gg.x * (1.f + sc.x) + sh.x; o[q * 4 + 1] = v[h * 8 + q * 4 + 1] * r * gg.y * (1.f + sc.y) + sh.y;
                    o[q * 4 + 2] = v[h * 8 + q * 4 + 2] * r * gg.z * (1.f + sc.z) + sh.z; o[q * 4 + 3] = v[h * 8 + q * 4 + 3] * r * gg.w * (1.f + sc.w) + sh.w;
                }
                *reinterpret_cast<u32x4*>(H + c) = u32x4{pack_bf2(o[0], o[1]), pack_bf2(o[2], o[3]), pack_bf2(o[4], o[5]), pack_bf2(o[6], o[7])};
#pragma unroll
                for (int q = 0; q < 8; ++q) hq[h * 8 + q] = o[q];
            }
            if (which) {
                float am = 0.f;
#pragma unroll
                for (int i = 0; i < 16; ++i) am = fmaxf(am, fabsf(hq[i]));
#pragma unroll
                for (int o2 = 32; o2 >= 1; o2 >>= 1) am = fmaxf(am, shfl_x(am, lane, o2));
                const float sc8 = am > 0.f ? 127.f / am : 1.f;
#pragma unroll
                for (int h = 0; h < 2; ++h) {
                    uint2 w;
                    w.x = pack4_i8(q8(hq[h * 8] * sc8), q8(hq[h * 8 + 1] * sc8), q8(hq[h * 8 + 2] * sc8), q8(hq[h * 8 + 3] * sc8));
                    w.y = pack4_i8(q8(hq[h * 8 + 4] * sc8), q8(hq[h * 8 + 5] * sc8), q8(hq[h * 8 + 6] * sc8), q8(hq[h * 8 + 7] * sc8));
                    *reinterpret_cast<uint2*>(p.ws + OFF_H8I + (size_t)t * D + h * 512 + lane * 8) = w;
                }
                if (lane == 0) ((float*)(p.ws + OFF_HSC))[t] = am > 0.f ? am * (1.f / 127.f) : 1.f;
            }
        }
    }
}
__device__ void ph_sgu_norm(const Params& p, int l, const int wv) {
    const int tid = opaque_tid(wv);
    const int lane = tid & 63;
    const int gw = blockIdx.x * 8 + (tid >> 6), nw = gridDim.x * 8;
    for (int t = gw; t < NTOK; t += nw) {
        const bf16_t* AV = (const bf16_t*)(p.ws + OFF_AV) + (size_t)t * 256;
        float v[4]; float ss = 0.f;
#pragma unroll
        for (int i = 0; i < 4; ++i) { v[i] = bf2f(AV[i * 64 + lane]); ss += v[i] * v[i]; }
        ss = wave_sum(ss);
        float r = rsqrtf(ss / 256.f + EPS);
#pragma unroll
        for (int i = 0; i < 4; ++i) ((bf16_t*)(p.ws + OFF_AVN))[(size_t)t * 256 + i * 64 + lane] = f2bf(v[i] * r * p.in[I_SGUNG][l * 256 + i * 64 + lane]);
    }
}
__device__ void ph_sgu_mix(const Params& p, int l, const int wv) {
    const int tid = opaque_tid(wv);
    const bf16_t* AVN = (const bf16_t*)(p.ws + OFF_AVN);
    for (size_t idx = GTID; idx < (size_t)NTOK * 256; idx += GNT) {
        int t = (int)(idx >> 8), c = (int)(idx & 255);
        int t0 = t & ~127, pp = t & 127, g = c >> 6;
        const bf16_t* W = (const bf16_t*)(p.ws + OFF_SGUW) + (((size_t)l * 4 + g) * 128 + pp) * 128;
        float acc = 0.f;
        for (int q = 0; q < 128; ++q) acc += bf2f(W[q]) * bf2f(AVN[(size_t)(t0 + q) * 256 + c]);
        acc += p.in[I_SGUB][(l * 4 + g) * 128 + pp];
        float au = bf2f(((const bf16_t*)(p.ws + OFF_AU))[(size_t)t * 256 + c]);
        ((bf16_t*)(p.ws + OFF_MIX))[(size_t)t * D + c] = f2bf(au * acc);
    }
}
__device__ void ph_attn_ref(const Params& p, int l, const int wv) {
    const int tid = opaque_tid(wv);
    const int lane = tid & 63;
    const int gw = blockIdx.x * 8 + (tid >> 6), nw = gridDim.x * 8;
    const float lam = lam_of(p, l);
    for (int item = gw; item < NTOK * 12; item += nw) {
        const int t = item % NTOK, hh = item / NTOK;
        const bool prompt = t < NPT;
        const int b = prompt ? t / SEQ : (t - NPT) / DSEQ;
        const int nk = prompt ? SEQ : NKS;
        if (hh < 4) {
            const int h = hh;
            const bf16_t* K = prompt ? (const bf16_t*)(p.ws + OFF_DKP) + ((size_t)b * 4 + h) * SEQ * 64 : (const bf16_t*)(p.ws + OFF_DKS) + ((size_t)b * 4 + h) * NKS * 64;
            const bf16_t* Vt = prompt ? (const bf16_t*)(p.ws + OFF_DVTP) + ((size_t)b * 4 + h) * 64 * SEQ : (const bf16_t*)(p.ws + OFF_DVTS) + ((size_t)b * 4 + h) * 64 * NKS;
            float q = bf2f(((const bf16_t*)(p.ws + OFF_DQ))[(size_t)t * 256 + h * 64 + lane]);
            const float scale = 0.17677669529663687f;
            float m0 = -1e30f, m1 = -1e30f, l0 = 0.f, l1 = 0.f, a0 = 0.f, a1 = 0.f;
            for (int k = 0; k < nk; ++k) {
                float pr = q * bf2f(K[(size_t)k * 64 + lane]);
#pragma unroll
                for (int o = 16; o >= 1; o >>= 1) pr += shfl_x(pr, lane, o);
                float s0 = shfl_i(pr, 0) * scale, s1 = shfl_i(pr, 32) * scale;
                float v = bf2f(Vt[(size_t)lane * nk + k]);
                float mn0 = fmaxf(m0, s0), mn1 = fmaxf(m1, s1);
                float c0 = expf(m0 - mn0), c1 = expf(m1 - mn1);
                float e0 = expf(s0 - mn0), e1 = expf(s1 - mn1);
                l0 = l0 * c0 + e0; l1 = l1 * c1 + e1;
                a0 = a0 * c0 + e0 * v; a1 = a1 * c1 + e1 * v;
                m0 = mn0; m1 = mn1;
            }
            float o = a0 / l0 - lam * a1 / l1;
            float ss = wave_sum(o * o);
            float r = rsqrtf(ss / 64.f + EPS);
            o = o * r * p.in[I_SUBLN][l * 64 + lane] * (1.f - lam_init_of(l));
            ((bf16_t*)(p.ws + OFF_MIX))[(size_t)t * D + 256 + h * 64 + lane] = f2bf(o);
        } else {
            const int hq = hh - 4, kv = hq >> 2;
            const bf16_t* K = prompt ? (const bf16_t*)(p.ws + OFF_GKP) + ((size_t)b * 2 + kv) * SEQ * 64 : (const bf16_t*)(p.ws + OFF_GKS) + ((size_t)b * 2 + kv) * NKS * 64;
            const bf16_t* Vt = prompt ? (const bf16_t*)(p.ws + OFF_GVTP) + ((size_t)b * 2 + kv) * 64 * SEQ : (const bf16_t*)(p.ws + OFF_GVTS) + ((size_t)b * 2 + kv) * 64 * NKS;
            float q = bf2f(((const bf16_t*)(p.ws + OFF_GQ))[(size_t)t * 512 + hq * 64 + lane]);
            float m = -1e30f, ls = 0.f, a = 0.f;
            for (int k = 0; k < nk; ++k) {
                float s = wave_sum(q * bf2f(K[(size_t)k * 64 + lane])) * 0.125f;
                float v = bf2f(Vt[(size_t)lane * nk + k]);
                float mn = fmaxf(m, s);
                float c = expf(m - mn), e = expf(s - mn);
                ls = ls * c + e; a = a * c + e * v; m = mn;
            }
            ((bf16_t*)(p.ws + OFF_MIX))[(size_t)t * D + 512 + hq * 64 + lane] = f2bf(a / ls);
        }
    }
}
__device__ void ph_peer_scores(const Params& p, int l, const int wv) {
    const int tid = opaque_tid(wv);
    const bf16_t* SK = (const bf16_t*)(p.ws + OFF_SUBK) + (size_t)l * 2 * 128 * 64;
    for (size_t idx = GTID; idx < (size_t)NTOK * 2048; idx += GNT) {
        int t = (int)(idx >> 11), o = (int)(idx & 2047);
        const bf16_t* Q = (const bf16_t*)(p.ws + OFF_Q) + (size_t)t * D;
        int n = o & 127, x = (o >> 7) & 1, h = o >> 8;
        float acc = 0.f;
        for (int k = 0; k < 64; ++k) acc += bf2f(Q[h * 128 + x * 64 + k]) * bf2f(SK[((size_t)x * 128 + n) * 64 + k]);
        ((float*)(p.ws + OFF_PROJ))[idx] = acc;
    }
}
__device__ void ph_peer_top1(const Params& p, const int wv) {
    const int tid = opaque_tid(wv);
    for (size_t idx = GTID; idx < (size_t)NTOK * 16; idx += GNT) {
        const float* SC = (const float*)(p.ws + OFF_PROJ) + idx * 128;
        float* TV = (float*)(p.ws + OFF_TOPV) + idx * 16; int* TI = (int*)(p.ws + OFF_TOPI) + idx * 16;
        float pv = 3.0e38f; int pi = -1;
        for (int r = 0; r < 16; ++r) {
            float bv = -3.0e38f; int bi = -1;
            for (int n = 0; n < 128; ++n) {
                float v = SC[n];
                bool after = (v < pv) || (v == pv && n > pi);
                if (after && (bi < 0 || v > bv)) { bv = v; bi = n; }
            }
            TV[r] = bv; TI[r] = bi; pv = bv; pi = bi;
        }
    }
}
__device__ void ph_peer_top2(const Params& p, const int wv) {
    const int tid = opaque_tid(wv);
    for (size_t idx = GTID; idx < (size_t)NTOK * 8; idx += GNT) {
        const float* TV = (const float*)(p.ws + OFF_TOPV) + idx * 32; const int* TI = (const int*)(p.ws + OFF_TOPI) + idx * 32;
        int* EI = (int*)(p.ws + OFF_EIDX) + idx * 16; float* EG = (float*)(p.ws + OFF_EGATE) + idx * 16;
        float pv = 3.0e38f; int pi = -1; float mx = 0.f, sum = 0.f;
        for (int r = 0; r < 16; ++r) {
            float bv = -3.0e38f; int bi = -1;
            for (int n = 0; n < 256; ++n) {
                float v = TV[n >> 4] + TV[16 + (n & 15)];
                bool after = (v < pv) || (v == pv && n > pi);
                if (after && (bi < 0 || v > bv)) { bv = v; bi = n; }
            }
            if (r == 0) mx = bv;
            float e = expf(bv - mx);
            sum += e;
            EG[r] = e; EI[r] = TI[bi >> 4] * 128 + TI[16 + (bi & 15)];
            pv = bv; pi = bi;
        }
        float inv = 1.f / sum;
        for (int r = 0; r < 16; ++r) EG[r] *= inv;
    }
}
__device__ void ph_peer_apply(const Params& p, int l, unsigned char* lds, const int wv) {
    const int tid = opaque_tid(wv);
    const int sub = tid >> 8, tl = tid & 255;
    const int wave = tl >> 6, lane = tl & 63;
    float* wts = (float*)(lds + 64) + sub * 128; int* eid = (int*)(lds + 64 + 1024) + sub * 128;
    const bf16_t* UT = (const bf16_t*)(p.ws + OFF_UT) + (size_t)l * NEXP * D;
    const bf16_t* VT = (const bf16_t*)(p.ws + OFF_VT) + (size_t)l * NEXP * D;
    const int niter = (NTOK + gridDim.x * 2 - 1) / (gridDim.x * 2);
    for (int it = 0; it < niter; ++it) {
        int t = (it * gridDim.x + blockIdx.x) * 2 + sub;
        const bool valid = t < NTOK; if (!valid) t = NTOK - 1;
        const bf16_t* H = (const bf16_t*)(p.ws + OFF_H) + (size_t)t * D;
        const int* EI = (const int*)(p.ws + OFF_EIDX) + (size_t)t * 128; const float* EG = (const float*)(p.ws + OFF_EGATE) + (size_t)t * 128;
        float hv[16];
#pragma unroll
        for (int i = 0; i < 16; ++i) hv[i] = bf2f(H[lane * 16 + i]);
        for (int jj = 0; jj < 32; ++jj) {
            int j = wave * 32 + jj; int e = EI[j];
            const bf16_t* ur = UT + (size_t)e * D + lane * 16;
            float acc = 0.f;
#pragma unroll
            for (int i = 0; i < 16; ++i) acc += hv[i] * bf2f(ur[i]);
            acc = wave_sum(acc);
            if (lane == 0) { wts[j] = EG[j] * gelu_f(acc); eid[j] = e; }
        }
        __syncthreads();
        float o[4] = {0.f, 0.f, 0.f, 0.f};
        for (int j = 0; j < 128; ++j) {
            const bf16_t* vr = VT + (size_t)eid[j] * D + tl * 4; float w = wts[j];
#pragma unroll
            for (int i = 0; i < 4; ++i) o[i] += w * bf2f(vr[i]);
        }
        const float* mod = (const float*)(p.ws + OFF_MOD) + (size_t)(l * 5 + tok_cv(t)) * 6144 + 5 * 1024;
        float* XC = (float*)(p.ws + OFF_XC) + (size_t)t * D;
        if (valid) {
#pragma unroll
            for (int i = 0; i < 4; ++i) { int c = tl * 4 + i; XC[c] += mod[c] * o[i]; }
        }
        __syncthreads();
    }
}
__device__ void ph_final_norm(const Params& p, const int wv) {
    const int tid = opaque_tid(wv);
    const int lane = tid & 63;
    const int gw = blockIdx.x * 8 + (tid >> 6), nw = gridDim.x * 8;
    u32x4 nx[2];
    {
        const int t = gw < NTOK ? gw : NTOK - 1;
        const bf16_t* xr = (const bf16_t*)(p.ws + OFF_XC) + (size_t)t * D + lane * 8;
        nx[0] = *reinterpret_cast<const u32x4*>(xr); nx[1] = *reinterpret_cast<const u32x4*>(xr + 512);
    }
    for (int t = gw; t < NTOK; t += nw) {
        float v[16];
#pragma unroll
        for (int h = 0; h < 2; ++h)
#pragma unroll
            for (int k = 0; k < 4; ++k) { v[h * 8 + 2 * k] = __uint_as_float(nx[h][k] << 16); v[h * 8 + 2 * k + 1] = __uint_as_float(nx[h][k] & 0xffff0000u); }
        {
            const int tn = t + nw < NTOK ? t + nw : t;
            const bf16_t* xn = (const bf16_t*)(p.ws + OFF_XC) + (size_t)tn * D + lane * 8;
            nx[0] = *reinterpret_cast<const u32x4*>(xn); nx[1] = *reinterpret_cast<const u32x4*>(xn + 512);
        }
        float ss = 0.f;
#pragma unroll
        for (int i = 0; i < 16; ++i) ss += v[i] * v[i];
        ss = wave_sum(ss);
        float r = rsqrtf(ss / D + EPS);
        float* y = p.out + (size_t)t * D;
#pragma unroll
        for (int h = 0; h < 2; ++h) {
            const int c = h * 512 + lane * 8;
#pragma unroll
            for (int q = 0; q < 2; ++q) {
                const float4 g = *reinterpret_cast<const float4*>(p.in[I_FG] + c + q * 4);
                *reinterpret_cast<float4*>(y + c + q * 4) = make_float4(v[h * 8 + q * 4] * r * g.x, v[h * 8 + q * 4 + 1] * r * g.y, v[h * 8 + q * 4 + 2] * r * g.z, v[h * 8 + q * 4 + 3] * r * g.w);
            }
        }
    }
}


namespace g8 {
constexpr int BM = 256, BK = 64, HALF = 128, HT = HALF * BK;
__device__ __forceinline__ int lds_byte(int r, int c) {
    int st = (r >> 4) * 2 + (c >> 5), rr = r & 15, cc = c & 31, ob = rr * 64 + cc * 2;
    return st * 1024 + (ob ^ (((ob >> 9) & 1) << 5));
}
__device__ __forceinline__ void stage_rc(int b, int& R, int& C) {
    int st = b / 1024, sb = b % 1024, swz = sb ^ (((sb >> 9) & 1) << 5);
    R = (st >> 1) * 16 + swz / 64; C = (st & 1) * 32 + (swz % 64) / 2;
}
}
enum { EPI_INPROJ = 0, EPI_WOUT = 1, EPI_WQ = 2 };
constexpr int STG = 132;

__device__ __forceinline__ void store_bf16x32(bf16_t* dst, const float (&v)[32]) {
#pragma unroll
    for (int i = 0; i < 4; ++i) {
        uint4 u;
        u.x = pack_bf2(v[i * 8 + 0], v[i * 8 + 1]); u.y = pack_bf2(v[i * 8 + 2], v[i * 8 + 3]);
        u.z = pack_bf2(v[i * 8 + 4], v[i * 8 + 5]); u.w = pack_bf2(v[i * 8 + 6], v[i * 8 + 7]);
        *reinterpret_cast<uint4*>(dst + i * 8) = u;
    }
}
__device__ __forceinline__ void store_f32x32(float* dst, const float (&v)[32]) {
#pragma unroll
    for (int i = 0; i < 8; ++i) *reinterpret_cast<float4*>(dst + i * 4) = make_float4(v[i * 4], v[i * 4 + 1], v[i * 4 + 2], v[i * 4 + 3]);
}

__device__ __forceinline__ void epi_inproj_xform(const Params& p, int l, int t, int c0, float (&v)[32]) {
    const bool prompt = t < NPT;
    const int s = prompt ? (t & 255) : ((t - NPT) & 2047);
    const float* R = (const float*)(p.ws + OFF_ROPE);
    if (c0 < 512) {
#pragma unroll
        for (int i = 0; i < 32; ++i) v[i] = gelu_f(v[i]);
    } else if (c0 < 1024) {
        if (!prompt) {
            const float* cs = R + s * 16; const float* sn = R + 2048 * 16 + s * 16;
#pragma unroll
            for (int i = 0; i < 16; ++i) {
                float c = cs[i], sv = sn[i], x1 = v[i], x2 = v[i + 16];
                v[i] = x1 * c - x2 * sv; v[i + 16] = x2 * c + x1 * sv;
            }
        }
    } else if (c0 >= 1280 && c0 < 1920) {
        const bool isq = c0 < 1792;
        const int hi = c0 & 32;
        const float* g = p.in[isq ? I_QNG : I_KNG] + l * 64 + hi;
        float ss = 0.f;
#pragma unroll
        for (int i = 0; i < 32; ++i) ss += v[i] * v[i];
        const int ln = lane_id_op();
        ss += shfl_x(ss, ln, 1);
        const float rr = rsqrtf(ss * (1.f / 64.f) + EPS);
#pragma unroll
        for (int i = 0; i < 32; ++i) v[i] = v[i] * rr * g[i];
        if (!prompt) {
            const float* cs = R + 2048 * 32 + s * 32; const float* sn = R + 2048 * 64 + s * 32;
#pragma unroll
            for (int i = 0; i < 32; ++i) {
                float pv = shfl_x(v[i], ln, 1);
                float c = cs[i], sv = sn[i];
                v[i] = hi ? (v[i] * c + pv * sv) : (v[i] * c - pv * sv);
            }
        }
    }
}
__device__ __forceinline__ void epi_inproj_col(const Params& p, int t0, int c, const LAS float* stc) {
    float v[32];
#pragma unroll
    for (int i = 0; i < 32; ++i) v[i] = stc[i * STG];
    const bool prompt = t0 < NPT;
    const int b = prompt ? (t0 >> 8) : ((t0 - NPT) >> 11);
    const int s = prompt ? (t0 & 255) : ((t0 - NPT) & 2047);
    unsigned char* ws = p.ws;
    bf16_t* dst;
    if (c < 1280) {
        const int cc = c - 1024, h = cc >> 6, d = cc & 63;
        dst = prompt ? (bf16_t*)(ws + OFF_DVTP) + (((size_t)b * 4 + h) * 64 + d) * SEQ + s
                     : (bf16_t*)(ws + OFF_DVTS) + (((size_t)b * 4 + h) * 64 + d) * NKS + s;
    } else {
        const int cc = c - 1920, kv = cc >> 6, d = cc & 63;
        dst = prompt ? (bf16_t*)(ws + OFF_GVTP) + (((size_t)b * 2 + kv) * 64 + d) * SEQ + s
                     : (bf16_t*)(ws + OFF_GVTS) + (((size_t)b * 2 + kv) * 64 + d) * NKS + s;
    }
    store_bf16x32(dst, v);
}

template <int MODE>
__device__ __forceinline__ void gemm_phase(const Params& p, int l, const bf16_t* __restrict__ A, const bf16_t* __restrict__ Bt, const int N, unsigned char* ldsraw, const int wv,
                                           const size_t cvstride = 0, const float* __restrict__ RSS = nullptr, const float* __restrict__ BIAS = nullptr) {
    using namespace g8;
    constexpr int K = 1024, nt = K / BK, BN = 128, TILE_A = BM * BK * 2, TILE_B = BN * BK * 2, STAGE_B = TILE_A + TILE_B;
    LAS unsigned char* lds = (LAS unsigned char*)ldsraw;
    const int tid = opaque_tid(wv), wid = wv, lane = tid & 63;
    const int wr = wid >> 1, wc = wid & 1, fr = lane & 15, fq = lane >> 4;
    unsigned voff[4];
#pragma unroll
    for (int i = 0; i < 4; ++i) voff[i] = (unsigned)((i * 64 + wid * 8 + (lane >> 3)) * K + (((lane & 7) ^ (lane >> 3)) * 8)) * 2u;
    const int aoff = (wr * 64 + fr) * 128 + ((fq ^ (fr & 7)) * 16), boff = (wc * 64 + fr) * 128 + ((fq ^ (fr & 7)) * 16);
    const unsigned ldsw = (unsigned)wid * 1024u;
#define G8_STAGE(buf, kt) do { \
        _Pragma("unroll") for (int _i = 0; _i < 4; ++_i) \
            __builtin_amdgcn_global_load_lds((const unsigned*)((const char*)(Ab + (kt) * BK) + voff[_i]), (LAS unsigned*)(lds + (buf) * STAGE_B + ldsw + _i * 8192), 16, 0, 0); \
        _Pragma("unroll") for (int _i = 0; _i < 2; ++_i) \
            __builtin_amdgcn_global_load_lds((const unsigned*)((const char*)(Bb + (kt) * BK) + voff[_i]), (LAS unsigned*)(lds + (buf) * STAGE_B + TILE_A + ldsw + _i * 8192), 16, 0, 0); } while (0)
#define G8_WAIT_V0() asm volatile("s_waitcnt vmcnt(0)" ::: "memory")
    const int nN = N / BN, nM = NTOK / BM, ntiles = nM * nN;
    const int G = gridDim.x;
    const int vb = (G % 8 == 0) ? (int)(blockIdx.x % 8) * (G / 8) + (int)(blockIdx.x / 8) : (int)blockIdx.x;
    const int tpb = (ntiles + G - 1) / G;
    const bool paneled = (G == 256) && (nN == 8 || nN == 16) && (nM == 64);
    for (int ti = 0; ti < tpb; ++ti) {
        int tile = vb * tpb + ti;
        if (paneled) {
            const int x = vb >> 5, j = vb & 31;
            const int mpx = nN == 16 ? 16 : 8;
            const int m0 = nN == 16 ? (x >> 1) * 16 : x * 8, n0 = nN == 16 ? (x & 1) * 8 : 0;
            const int pm_ = m0 + ti * 4 + (j >> 3), pn_ = n0 + (j & 7);
            tile = (ti * 4 < mpx) ? pm_ * nN + pn_ : ntiles;
        }
        if (tile >= ntiles) break;
        const int pm = tile / nN, pn = tile % nN, brow = pm * BM, bcol = pn * BN;
        const bf16_t* Ab = A + (size_t)brow * K; const bf16_t* Bb = Bt + (size_t)tok_cv(brow) * cvstride + (size_t)bcol * K;
        f32x4 acc[4][4];
#pragma unroll
        for (int m = 0; m < 4; ++m)
#pragma unroll
            for (int n = 0; n < 4; ++n) acc[m][n] = f32x4{0.f, 0.f, 0.f, 0.f};
        G8_WAIT_V0();
        G8_STAGE(0, 0); G8_STAGE(1, 1);
        int cur = 0;
        for (int t = 0; t < nt; ++t) {
            if (t + 1 < nt) asm volatile("s_waitcnt vmcnt(6)" ::: "memory"); else asm volatile("s_waitcnt vmcnt(0)" ::: "memory");
            __builtin_amdgcn_s_barrier();
            if (t + 2 < nt) { const int nb = cur >= 1 ? cur - 1 : 2; G8_STAGE(nb, t + 2); }
            {
                bf16x8 At[2][4], Bf[2][4];
#pragma unroll
                for (int ks = 0; ks < 2; ++ks) {
#pragma unroll
                    for (int m = 0; m < 4; ++m) At[ks][m] = *(const LAS bf16x8*)(lds + cur * STAGE_B + ((aoff + m * 2048) ^ (ks * 64)));
#pragma unroll
                    for (int n = 0; n < 4; ++n) Bf[ks][n] = *(const LAS bf16x8*)(lds + cur * STAGE_B + TILE_A + ((boff + n * 2048) ^ (ks * 64)));
                }
                __builtin_amdgcn_sched_barrier(0);
#pragma unroll
                for (int ks = 0; ks < 2; ++ks)
#pragma unroll
                    for (int m = 0; m < 4; ++m)
#pragma unroll
                        for (int n = 0; n < 4; ++n) acc[m][n] = __builtin_amdgcn_mfma_f32_16x16x32_bf16(At[ks][m], Bf[ks][n], acc[m][n], 0, 0, 0);
                __builtin_amdgcn_sched_barrier(0);
            }
            cur = cur == 2 ? 0 : cur + 1;
        }
        __syncthreads();
        LAS float* st = (LAS float*)lds;
        if (MODE != EPI_WOUT && cvstride != 0) {
            LAS float* rs = st + 256 * STG;
            if (tid < 256) {
                const float* rp = RSS + (size_t)(brow + tid) * 8;
                const float4 a = *reinterpret_cast<const float4*>(rp), b = *reinterpret_cast<const float4*>(rp + 4);
                rs[tid] = rsqrtf((((a.x + a.y) + (a.z + a.w)) + ((b.x + b.y) + (b.z + b.w))) * (1.f / D) + EPS);
            }
            __syncthreads();
            float bz[4];
#pragma unroll
            for (int n = 0; n < 4; ++n) bz[n] = BIAS[(size_t)tok_cv(brow) * N + bcol + wc * 64 + n * 16 + fr];
#pragma unroll
            for (int m = 0; m < 4; ++m)
#pragma unroll
                for (int j = 0; j < 4; ++j) {
                    const float r = rs[wr * 64 + m * 16 + fq * 4 + j];
#pragma unroll
                    for (int n = 0; n < 4; ++n) st[(wr * 64 + m * 16 + fq * 4 + j) * STG + wc * 64 + n * 16 + fr] = acc[m][n][j] * r + bz[n];
                }
        } else {
#pragma unroll
        for (int m = 0; m < 4; ++m)
#pragma unroll
            for (int n = 0; n < 4; ++n)
#pragma unroll
                for (int j = 0; j < 4; ++j)
                    st[(wr * 64 + m * 16 + fq * 4 + j) * STG + wc * 64 + n * 16 + fr] = acc[m][n][j];
        }
        __syncthreads();
        const bool tprompt = brow < NPT;
        const int tb_ = tprompt ? (brow >> 8) : ((brow - NPT) >> 11), ts0 = tprompt ? 0 : ((brow - NPT) & 2047);
        if (MODE == EPI_INPROJ) {
            const bool vtile = (bcol >= 1024 && bcol < 1280) || bcol >= 1920;
            if (!vtile) {
#pragma unroll 1
                for (int it = 0; it < 2; ++it) {
                    const int item = it * NT + tid, erow = item >> 2, eseg = item & 3;
                    float v[32];
#pragma unroll
                    for (int i = 0; i < 8; ++i) {
                        const f32x4 f = *(const LAS f32x4*)(st + erow * STG + eseg * 32 + i * 4);
                        v[i * 4] = f[0]; v[i * 4 + 1] = f[1]; v[i * 4 + 2] = f[2]; v[i * 4 + 3] = f[3];
                    }
                    epi_inproj_xform(p, l, brow + erow, bcol + eseg * 32, v);
#pragma unroll
                    for (int i = 0; i < 8; ++i) *(LAS f32x4*)(st + erow * STG + eseg * 32 + i * 4) = f32x4{v[i * 4], v[i * 4 + 1], v[i * 4 + 2], v[i * 4 + 3]};
                }
                __syncthreads();
#pragma unroll 1
                for (int it = 0; it < 8; ++it) {
                    const int item = it * NT + tid, r = item >> 4, c = (item & 15) * 8;
                    const f32x4 f0 = *(const LAS f32x4*)(st + r * STG + c), f1 = *(const LAS f32x4*)(st + r * STG + c + 4);
                    const int t = brow + r, sp = ts0 + r;
                    bf16_t* dst;
                    if (bcol < 512)        dst = (bf16_t*)(p.ws + (bcol < 256 ? OFF_AU : OFF_AV)) + (size_t)t * 256 + (bcol & 255) + c;
                    else if (bcol < 768)   dst = (bf16_t*)(p.ws + OFF_DQ) + (size_t)t * 256 + (bcol - 512) + c;
                    else if (bcol < 1024) { const int cc = bcol - 768 + c, h = cc >> 6;
                                            dst = tprompt ? (bf16_t*)(p.ws + OFF_DKP) + (((size_t)tb_ * 4 + h) * SEQ + sp) * 64 + (cc & 63)
                                                          : (bf16_t*)(p.ws + OFF_DKS) + (((size_t)tb_ * 4 + h) * NKS + sp) * 64 + (cc & 63); }
                    else if (bcol < 1792)  dst = (bf16_t*)(p.ws + OFF_GQ) + (size_t)t * 512 + (bcol - 1280) + c;
                    else                 { const int kv = c >> 6;
                                            dst = tprompt ? (bf16_t*)(p.ws + OFF_GKP) + (((size_t)tb_ * 2 + kv) * SEQ + sp) * 64 + (c & 63)
                                                          : (bf16_t*)(p.ws + OFF_GKS) + (((size_t)tb_ * 2 + kv) * NKS + sp) * 64 + (c & 63); }
                    *reinterpret_cast<u32x4*>(dst) = u32x4{pack_bf2(f0[0], f0[1]), pack_bf2(f0[2], f0[3]), pack_bf2(f1[0], f1[1]), pack_bf2(f1[2], f1[3])};
                }
            }
            if (tprompt && ((bcol >= 768 && bcol < 1280) || bcol >= 1792)) {
                float* ob; int rs;
                if (bcol < 1024)      { ob = p.out + OUT_NDK + (((size_t)tb_ * 2 + l) * SEQ) * 256 + (bcol - 768);  rs = 256; }
                else if (bcol < 1280) { ob = p.out + OUT_NDV + (((size_t)tb_ * 2 + l) * SEQ) * 256 + (bcol - 1024); rs = 256; }
                else if (bcol < 1920) { ob = p.out + OUT_NGK + (((size_t)tb_ * 2 + l) * SEQ) * 128;                 rs = 128; }
                else                  { ob = p.out + OUT_NGV + (((size_t)tb_ * 2 + l) * SEQ) * 128;                 rs = 128; }
#pragma unroll 1
                for (int it = 0; it < 16; ++it) {
                    const int item = it * NT + tid, r = item >> 5, c = (item & 31) * 4;
                    *reinterpret_cast<f32x4*>(ob + (size_t)r * rs + c) = *(const LAS f32x4*)(st + r * STG + c);
                }
            }
            if (vtile) {
#pragma unroll 1
                for (int it = 0; it < 2; ++it) {
                    const int item = it * NT + tid, col = item >> 3, run = item & 7;
                    epi_inproj_col(p, brow + run * 32, bcol + col, st + run * 32 * STG + col);
                }
            }
        } else {
#pragma unroll 1
            for (int it = 0; it < 8; ++it) {
                const int item = it * NT + tid, r = item >> 4, c = (item & 15) * 8;
                const f32x4 f0 = *(const LAS f32x4*)(st + r * STG + c), f1 = *(const LAS f32x4*)(st + r * STG + c + 4);
                const int t = brow + r;
                float o[8] = {f0[0], f0[1], f0[2], f0[3], f1[0], f1[1], f1[2], f1[3]};
                if (MODE == EPI_WOUT) {
                    const float* g1 = (const float*)(p.ws + OFF_MOD) + (size_t)(l * 5 + tok_cv(t)) * 6144 + 2048 + bcol + c;
                    const float4 ga = *reinterpret_cast<const float4*>(g1), gb = *reinterpret_cast<const float4*>(g1 + 4);
                    float x[8];
                    if (l == 0) {
                        const float* xr = x_in_row(p, t) + bcol + c;
                        const float4 xa = *reinterpret_cast<const float4*>(xr), xb2 = *reinterpret_cast<const float4*>(xr + 4);
                        x[0] = xa.x; x[1] = xa.y; x[2] = xa.z; x[3] = xa.w; x[4] = xb2.x; x[5] = xb2.y; x[6] = xb2.z; x[7] = xb2.w;
                    } else {
                        const u32x4 xw = *reinterpret_cast<const u32x4*>((const bf16_t*)(p.ws + OFF_XC) + (size_t)t * D + bcol + c);
#pragma unroll
                        for (int k = 0; k < 4; ++k) { x[2 * k] = __uint_as_float(xw[k] << 16); x[2 * k + 1] = __uint_as_float(xw[k] & 0xffff0000u); }
                    }
                    o[0] = x[0] + ga.x * o[0]; o[1] = x[1] + ga.y * o[1]; o[2] = x[2] + ga.z * o[2]; o[3] = x[3] + ga.w * o[3];
                    o[4] = x[4] + gb.x * o[4]; o[5] = x[5] + gb.y * o[5]; o[6] = x[6] + gb.z * o[6]; o[7] = x[7] + gb.w * o[7];
                    const float* gn = p.in[I_N2G] + l * D + bcol + c;
                    const float4 na = *reinterpret_cast<const float4*>(gn), nb = *reinterpret_cast<const float4*>(gn + 4);
                    const float4 sa = *reinterpret_cast<const float4*>(g1 + 2048), sb = *reinterpret_cast<const float4*>(g1 + 2048 + 4);
                    float xg[8] = {o[0] * na.x * (1.f + sa.x), o[1] * na.y * (1.f + sa.y), o[2] * na.z * (1.f + sa.z), o[3] * na.w * (1.f + sa.w),
                                   o[4] * nb.x * (1.f + sb.x), o[5] * nb.y * (1.f + sb.y), o[6] * nb.z * (1.f + sb.z), o[7] * nb.w * (1.f + sb.w)};
                    float ss = 0.f, am = 0.f;
#pragma unroll
                    for (int i = 0; i < 8; ++i) { ss += o[i] * o[i]; am = fmaxf(am, fabsf(xg[i])); }
                    ss = row16_sum(ss); am = row16_max(am);
                    const float sc8 = am > 0.f ? 127.f / am : 1.f;
                    uint2 w8;
                    w8.x = pack4_i8(q8(xg[0] * sc8), q8(xg[1] * sc8), q8(xg[2] * sc8), q8(xg[3] * sc8));
                    w8.y = pack4_i8(q8(xg[4] * sc8), q8(xg[5] * sc8), q8(xg[6] * sc8), q8(xg[7] * sc8));
                    *reinterpret_cast<uint2*>(p.ws + OFF_H8I + (size_t)t * D + bcol + c) = w8;
                    if ((item & 15) == 0) {
                        ((float*)(p.ws + OFF_RSS2))[((size_t)l * NTOK + t) * 8 + pn] = ss;
                        ((float*)(p.ws + OFF_XGS))[(size_t)t * 8 + pn] = am > 0.f ? am * (1.f / 127.f) : 1.f;
                    }
                }
                bf16_t* dst = (bf16_t*)(p.ws + (MODE == EPI_WOUT ? OFF_XC : OFF_Q)) + (size_t)t * D + bcol + c;
                *reinterpret_cast<u32x4*>(dst) = u32x4{pack_bf2(o[0], o[1]), pack_bf2(o[2], o[3]), pack_bf2(o[4], o[5]), pack_bf2(o[6], o[7])};
            }
        }
        __syncthreads();
    }
}


#define MFMA32(a, b, c) __builtin_amdgcn_mfma_f32_32x32x16_bf16((a), (b), (c), 0, 0, 0)
constexpr int ATT_ROWB = 144;
constexpr int ATT_TILEB = 64 * ATT_ROWB;
constexpr int QW_MIX = 4096;

__device__ __forceinline__ bf16x8 pack8(const f32x16& x, int s) {
    const u32x4 w = {pack_bf2(x[8 * s], x[8 * s + 1]), pack_bf2(x[8 * s + 2], x[8 * s + 3]), pack_bf2(x[8 * s + 4], x[8 * s + 5]), pack_bf2(x[8 * s + 6], x[8 * s + 7])};
    return __builtin_bit_cast(bf16x8, w);
}
__device__ __forceinline__ void softmax_tile(f32x16& s0, f32x16& s1, const float sc, float& m, float& l, float& alpha, const int lane) {
    float mx = fmaxf(s0[0], s1[0]);
#pragma unroll
    for (int i = 1; i < 16; ++i) mx = fmaxf(mx, fmaxf(s0[i], s1[i]));
    mx = fmaxf(mx, shfl_x(mx, lane, 32));
    const float mnew = fmaxf(m, mx * sc);
    alpha = __builtin_amdgcn_exp2f(m - mnew);
    m = mnew;
    float ps = 0.f;
#pragma unroll
    for (int i = 0; i < 16; ++i) { s0[i] = __builtin_amdgcn_exp2f(s0[i] * sc - mnew); s1[i] = __builtin_amdgcn_exp2f(s1[i] * sc - mnew); ps += s0[i] + s1[i]; }
    l = l * alpha + ps;
}
__device__ __forceinline__ void v_frags(const LAS unsigned char* vb, bf16x8 (&vf)[8], int r, int hh) {
#pragma unroll
    for (int u = 0; u < 2; ++u)
#pragma unroll
        for (int sk = 0; sk < 2; ++sk)
#pragma unroll
            for (int mt = 0; mt < 2; ++mt) {
                const LAS unsigned char* a = vb + (32 * mt + r) * ATT_ROWB + (32 * u + 16 * sk + 4 * hh) * 2;
                const s16x4 lo = *(const LAS s16x4*)a, hi = *(const LAS s16x4*)(a + 16);
                vf[(u * 2 + sk) * 2 + mt] = bf16x8{lo[0], lo[1], lo[2], lo[3], hi[0], hi[1], hi[2], hi[3]};
            }
}
__device__ __forceinline__ void pv_tile(const bf16x8 (&vf)[8], const f32x16& p0, const f32x16& p1, f32x16 (&O)[2]) {
#pragma unroll
    for (int u = 0; u < 2; ++u)
#pragma unroll
        for (int sk = 0; sk < 2; ++sk) {
            const bf16x8 pf = pack8(u ? p1 : p0, sk);
#pragma unroll
            for (int mt = 0; mt < 2; ++mt) O[mt] = MFMA32(vf[(u * 2 + sk) * 2 + mt], pf, O[mt]);
        }
}

template <bool DIFF>
__device__ __forceinline__ void attn_item(const Params& p, int l, LAS unsigned char* lds, const int tid,
                                          const bf16_t* __restrict__ Qg, const int qstride,
                                          const bf16_t* __restrict__ Kg, const bf16_t* __restrict__ Vtg, const int nk,
                                          bf16_t* __restrict__ Og, const float lam) {
    const int wave = tid >> 6, lane = tid & 63, r = lane & 31, hh = lane >> 5;
    const int lrow = tid >> 3, lchunk = tid & 7;
    LAS unsigned char* kbuf = lds; LAS unsigned char* vbuf = lds + 2 * ATT_TILEB;
    bf16x8 qf[4];
    const bf16_t* qrow = Qg + (size_t)(wave * 32 + r) * qstride;
#pragma unroll
    for (int ks = 0; ks < 4; ++ks) qf[ks] = *reinterpret_cast<const bf16x8*>(qrow + ks * 16 + hh * 8);
    const float sc = (DIFF ? 0.17677669529663687f : 0.125f) * 1.4426950408889634f;
    f32x16 O0[2], O1[2];
#pragma unroll
    for (int mt = 0; mt < 2; ++mt)
#pragma unroll
        for (int i = 0; i < 16; ++i) { O0[mt][i] = 0.f; O1[mt][i] = 0.f; }
    float m0 = -1e30f, l0 = 0.f, m1 = -1e30f, l1 = 0.f;
    const int ntl = nk / 64;
    u32x4 kr, vr, kn, vn;
    kr = *reinterpret_cast<const u32x4*>(Kg + (size_t)lrow * 64 + lchunk * 8);
    vr = *reinterpret_cast<const u32x4*>(Vtg + (size_t)lrow * nk + lchunk * 8);
    *(LAS u32x4*)(kbuf + lrow * ATT_ROWB + lchunk * 16) = kr;
    *(LAS u32x4*)(vbuf + lrow * ATT_ROWB + lchunk * 16) = vr;
    {
        const int t1 = ntl > 1 ? 1 : 0;
        kr = *reinterpret_cast<const u32x4*>(Kg + (size_t)(t1 * 64 + lrow) * 64 + lchunk * 8);
        vr = *reinterpret_cast<const u32x4*>(Vtg + (size_t)lrow * nk + t1 * 64 + lchunk * 8);
    }
    __syncthreads();
    for (int ti = 0; ti < ntl; ++ti) {
        const int cur = ti & 1;
        {
            const int t2 = ti + 2 < ntl ? ti + 2 : ntl - 1;
            kn = *reinterpret_cast<const u32x4*>(Kg + (size_t)(t2 * 64 + lrow) * 64 + lchunk * 8);
            vn = *reinterpret_cast<const u32x4*>(Vtg + (size_t)lrow * nk + t2 * 64 + lchunk * 8);
        }
        const LAS unsigned char* kb = kbuf + cur * ATT_TILEB; const LAS unsigned char* vb = vbuf + cur * ATT_TILEB;
        bf16x8 ka[2][4];
#pragma unroll
        for (int u = 0; u < 2; ++u)
#pragma unroll
            for (int ks = 0; ks < 4; ++ks) ka[u][ks] = *(const LAS bf16x8*)(kb + (32 * u + r) * ATT_ROWB + (ks * 16 + hh * 8) * 2);
        __builtin_amdgcn_sched_barrier(0);
        bf16x8 vf[8];
        if (!DIFF) {
            f32x16 s0, s1;
#pragma unroll
            for (int i = 0; i < 16; ++i) { s0[i] = 0.f; s1[i] = 0.f; }
#pragma unroll
            for (int ks = 0; ks < 4; ++ks) { s0 = MFMA32(ka[0][ks], qf[ks], s0); s1 = MFMA32(ka[1][ks], qf[ks], s1); }
            v_frags(vb, vf, r, hh);
            __builtin_amdgcn_sched_barrier(0);
            float alpha;
            softmax_tile(s0, s1, sc, m0, l0, alpha, lane);
            if (__builtin_amdgcn_ballot_w64(alpha != 1.f) != 0ull) {
#pragma unroll
                for (int mt = 0; mt < 2; ++mt)
#pragma unroll
                    for (int i = 0; i < 16; ++i) O0[mt][i] *= alpha;
            }
            pv_tile(vf, s0, s1, O0);
        } else {
            f32x16 s0, s1, t0, t1;
#pragma unroll
            for (int i = 0; i < 16; ++i) { s0[i] = 0.f; s1[i] = 0.f; t0[i] = 0.f; t1[i] = 0.f; }
#pragma unroll
            for (int ks = 0; ks < 2; ++ks) {
                s0 = MFMA32(ka[0][ks], qf[ks], s0); s1 = MFMA32(ka[1][ks], qf[ks], s1);
                t0 = MFMA32(ka[0][2 + ks], qf[2 + ks], t0); t1 = MFMA32(ka[1][2 + ks], qf[2 + ks], t1);
            }
            v_frags(vb, vf, r, hh);
            __builtin_amdgcn_sched_barrier(0);
            float alpha;
            softmax_tile(s0, s1, sc, m0, l0, alpha, lane);
            if (__builtin_amdgcn_ballot_w64(alpha != 1.f) != 0ull) {
#pragma unroll
                for (int mt = 0; mt < 2; ++mt)
#pragma unroll
                    for (int i = 0; i < 16; ++i) O0[mt][i] *= alpha;
            }
            pv_tile(vf, s0, s1, O0);
            softmax_tile(t0, t1, sc, m1, l1, alpha, lane);
            if (__builtin_amdgcn_ballot_w64(alpha != 1.f) != 0ull) {
#pragma unroll
                for (int mt = 0; mt < 2; ++mt)
#pragma unroll
                    for (int i = 0; i < 16; ++i) O1[mt][i] *= alpha;
            }
            pv_tile(vf, t0, t1, O1);
        }
        if (ti + 1 < ntl) {
            *(LAS u32x4*)(kbuf + (cur ^ 1) * ATT_TILEB + lrow * ATT_ROWB + lchunk * 16) = kr;
            *(LAS u32x4*)(vbuf + (cur ^ 1) * ATT_TILEB + lrow * ATT_ROWB + lchunk * 16) = vr;
        }
        kr = kn; vr = vn;
        __syncthreads();
    }
    l0 += shfl_x(l0, lane, 32);
    const float inv0 = 1.f / l0;
    LAS unsigned char* ob = lds + wave * 4608;
    if (!DIFF) {
#pragma unroll
        for (int mt = 0; mt < 2; ++mt)
#pragma unroll
            for (int g = 0; g < 4; ++g) {
                u32x2 w;
                w[0] = pack_bf2(O0[mt][4 * g] * inv0, O0[mt][4 * g + 1] * inv0);
                w[1] = pack_bf2(O0[mt][4 * g + 2] * inv0, O0[mt][4 * g + 3] * inv0);
                *(LAS u32x2*)(ob + r * 144 + (32 * mt + 8 * g + 4 * hh) * 2) = w;
            }
    } else {
        l1 += shfl_x(l1, lane, 32);
        const float inv1 = lam / l1;
        float ss = 0.f;
#pragma unroll
        for (int mt = 0; mt < 2; ++mt)
#pragma unroll
            for (int i = 0; i < 16; ++i) { const float o = O0[mt][i] * inv0 - O1[mt][i] * inv1; O0[mt][i] = o; ss += o * o; }
        ss += shfl_x(ss, lane, 32);
        const float rr = rsqrtf(ss * (1.f / 64.f) + EPS) * __builtin_bit_cast(float, __builtin_amdgcn_readfirstlane(__builtin_bit_cast(int, 1.f - lam_init_of(l))));
        const float* sg = p.in[I_SUBLN] + l * 64;
#pragma unroll
        for (int mt = 0; mt < 2; ++mt)
#pragma unroll
            for (int g = 0; g < 4; ++g) {
                const int d0 = 32 * mt + 8 * g + 4 * hh;
                const float4 gg = *reinterpret_cast<const float4*>(sg + d0);
                u32x2 w;
                w[0] = pack_bf2(O0[mt][4 * g] * rr * gg.x, O0[mt][4 * g + 1] * rr * gg.y);
                w[1] = pack_bf2(O0[mt][4 * g + 2] * rr * gg.z, O0[mt][4 * g + 3] * rr * gg.w);
                *(LAS u32x2*)(ob + r * 144 + d0 * 2) = w;
            }
    }
#pragma unroll
    for (int ps = 0; ps < 4; ++ps) {
        const int row = ps * 8 + (lane >> 3), ch = lane & 7;
        *reinterpret_cast<u32x4*>(Og + (size_t)(wave * 32 + row) * D + ch * 8) = *(const LAS u32x4*)(ob + row * 144 + ch * 16);
    }
}

constexpr int SGU_ROWB = 272;
__device__ __forceinline__ void sgu_item(const Params& p, int l, LAS unsigned char* lds, const int tid, const int t0) {
    const bf16_t* AV = (const bf16_t*)(p.ws + OFF_AV) + (size_t)t0 * 256;
    {
        const int q = tid >> 2, quarter = tid & 3;
        float v[64]; float ss = 0.f;
#pragma unroll
        for (int i = 0; i < 8; ++i) {
            const bf16x8 w = *reinterpret_cast<const bf16x8*>(AV + (size_t)q * 256 + quarter * 64 + i * 8);
#pragma unroll
            for (int j = 0; j < 8; ++j) { v[i * 8 + j] = bf2f((bf16_t)w[j]); ss += v[i * 8 + j] * v[i * 8 + j]; }
        }
        { const int ln = tid & 63; ss += shfl_x(ss, ln, 1); ss += shfl_x(ss, ln, 2); }
        const float rstd = rsqrtf(ss * (1.f / 256.f) + EPS);
        const float* g = p.in[I_SGUNG] + l * 256 + quarter * 64;
#pragma unroll
        for (int i = 0; i < 64; ++i)
            *(LAS bf16_t*)(lds + (quarter * 64 + i) * SGU_ROWB + q * 2) = f2bf(v[i] * rstd * g[i]);
    }
    __syncthreads();
    {
        const int wave = tid >> 6, lane = tid & 63, r = lane & 31, hh = lane >> 5;
        const int g = wave >> 1, ph = wave & 1;
        const bf16_t* W = (const bf16_t*)(p.ws + OFF_SGUW) + ((size_t)l * 4 + g) * 128 * 128;
        f32x16 acc[2][2];
#pragma unroll
        for (int a = 0; a < 2; ++a)
#pragma unroll
            for (int b = 0; b < 2; ++b)
#pragma unroll
                for (int i = 0; i < 16; ++i) acc[a][b][i] = 0.f;
#pragma unroll
        for (int ks = 0; ks < 8; ++ks) {
            bf16x8 af[2], bfr[2];
#pragma unroll
            for (int pt = 0; pt < 2; ++pt) af[pt] = *reinterpret_cast<const bf16x8*>(W + (size_t)(ph * 64 + pt * 32 + r) * 128 + ks * 16 + hh * 8);
#pragma unroll
            for (int ct = 0; ct < 2; ++ct) bfr[ct] = *(const LAS bf16x8*)(lds + (g * 64 + ct * 32 + r) * SGU_ROWB + (ks * 16 + hh * 8) * 2);
#pragma unroll
            for (int pt = 0; pt < 2; ++pt)
#pragma unroll
                for (int ct = 0; ct < 2; ++ct) acc[pt][ct] = MFMA32(af[pt], bfr[ct], acc[pt][ct]);
        }
        const float* bias = p.in[I_SGUB] + (l * 4 + g) * 128;
        const bf16_t* AU = (const bf16_t*)(p.ws + OFF_AU);
        bf16_t* MIX = (bf16_t*)(p.ws + OFF_MIX);
#pragma unroll
        for (int pt = 0; pt < 2; ++pt)
#pragma unroll
            for (int ct = 0; ct < 2; ++ct)
#pragma unroll
                for (int i = 0; i < 16; ++i) {
                    const int pp = ph * 64 + pt * 32 + (i & 3) + 8 * (i >> 2) + 4 * hh, c = g * 64 + ct * 32 + r;
                    const float au = bf2f(AU[(size_t)(t0 + pp) * 256 + c]);
                    MIX[(size_t)(t0 + pp) * D + c] = f2bf(au * (acc[pt][ct][i] + bias[pp]));
                }
    }
    __syncthreads();
}

__device__ void ph_mixers(const Params& p, int lq, unsigned char* ldsraw, const int wv) {
    const int l = lq & 1;
    const int tid0 = opaque_tid(wv);
    LAS unsigned char* lds = (LAS unsigned char*)ldsraw;
    volatile LAS int* qslot = (volatile LAS int*)(ldsraw - LDS_HDR + 64);
    unsigned* qw = (unsigned*)(p.ws + OFF_BAR) + QW_MIX + lq;
    const float lam = __builtin_bit_cast(float, __builtin_amdgcn_readfirstlane(__builtin_bit_cast(int, lam_of(p, l))));
    unsigned char* ws = p.ws;
    for (;;) {
        if (tid0 == 0) *qslot = (int)atomicAdd(qw, 1u);
        __syncthreads();
        const int item = *qslot;
        __syncthreads();
        if (item >= 896) break;
        if (lq >= 2 && PROBE_DUP >= 10) {
            const int cls = item < 128 ? 10 : (item < 384 ? 11 : 12);
            if (cls != PROBE_DUP) continue;
        }
        int tid = tid0; asm volatile("" : "+v"(tid));
        if (item < 128) {
            const int qc = item & 7, h = (item >> 3) & 3, b = item >> 5;
            const int t0 = NPT + b * DSEQ + qc * 256;
            attn_item<true>(p, l, lds, tid, (const bf16_t*)(ws + OFF_DQ) + (size_t)t0 * 256 + h * 64, 256,
                            (const bf16_t*)(ws + OFF_DKS) + ((size_t)b * 4 + h) * NKS * 64, (const bf16_t*)(ws + OFF_DVTS) + ((size_t)b * 4 + h) * 64 * NKS, NKS,
                            (bf16_t*)(ws + OFF_MIX) + (size_t)t0 * D + 256 + h * 64, lam);
        } else if (item < 384) {
            const int it = item - 128, qc = it & 7, hq = (it >> 3) & 7, b = it >> 6, kv = hq >> 2;
            const int t0 = NPT + b * DSEQ + qc * 256;
            attn_item<false>(p, l, lds, tid, (const bf16_t*)(ws + OFF_GQ) + (size_t)t0 * 512 + hq * 64, 512,
                             (const bf16_t*)(ws + OFF_GKS) + ((size_t)b * 2 + kv) * NKS * 64, (const bf16_t*)(ws + OFF_GVTS) + ((size_t)b * 2 + kv) * 64 * NKS, NKS,
                             (bf16_t*)(ws + OFF_MIX) + (size_t)t0 * D + 512 + hq * 64, lam);
        } else if (item < 512) {
            sgu_item(p, l, lds, tid, (item - 384) * 128);
        } else if (item < 768) {
            const int it = item - 512, hq = it & 7, b = it >> 3, kv = hq >> 2;
            const int t0 = b * SEQ;
            attn_item<false>(p, l, lds, tid, (const bf16_t*)(ws + OFF_GQ) + (size_t)t0 * 512 + hq * 64, 512,
                             (const bf16_t*)(ws + OFF_GKP) + ((size_t)b * 2 + kv) * SEQ * 64, (const bf16_t*)(ws + OFF_GVTP) + ((size_t)b * 2 + kv) * 64 * SEQ, SEQ,
                             (bf16_t*)(ws + OFF_MIX) + (size_t)t0 * D + 512 + hq * 64, lam);
        } else {
            const int it = item - 768, h = it & 3, b = it >> 2;
            const int t0 = b * SEQ;
            attn_item<true>(p, l, lds, tid, (const bf16_t*)(ws + OFF_DQ) + (size_t)t0 * 256 + h * 64, 256,
                            (const bf16_t*)(ws + OFF_DKP) + ((size_t)b * 4 + h) * SEQ * 64, (const bf16_t*)(ws + OFF_DVTP) + ((size_t)b * 4 + h) * 64 * SEQ, SEQ,
                            (bf16_t*)(ws + OFF_MIX) + (size_t)t0 * D + 256 + h * 64, lam);
        }
    }
}


using bf16x2 = __attribute__((ext_vector_type(2))) __bf16;
__device__ __forceinline__ float dot2bf(unsigned a, unsigned b, float c) {
    return __builtin_amdgcn_fdot2_f32_bf16(__builtin_bit_cast(bf16x2, a), __builtin_bit_cast(bf16x2, b), c, false);
}
template <int W>
__device__ __forceinline__ void bfly_stage(float (&part)[64], const int lane) {
    const bool hi = (lane & W) != 0;
#pragma unroll
    for (int k = 0; k < W; ++k) {
        const float keep = hi ? part[k + W] : part[k];
        const float send = hi ? part[k] : part[k + W];
        part[k] = keep + shfl_x(send, lane, W);
    }
}
constexpr int QW_PEER = 4160;
template <int W>
__device__ __forceinline__ void bfly16_stage(float (&v)[16], const int lane, const int bit) {
    const bool hi = (lane & bit) != 0;
#pragma unroll
    for (int k = 0; k < W; ++k) {
        const float keep = hi ? v[k + W] : v[k];
        const float send = hi ? v[k] : v[k + W];
        v[k] = keep + shfl_x(send, lane, bit);
    }
}
template <int W>
__device__ __forceinline__ void bfly16i_stage(int (&v)[16], const int lane, const int bit) {
    const bool hi = (lane & bit) != 0;
#pragma unroll
    for (int k = 0; k < W; ++k) {
        const int keep = hi ? v[k + W] : v[k];
        const int send = hi ? v[k] : v[k + W];
        v[k] = keep + shfl_x(send, lane, bit);
    }
}
template <bool VSIDE> struct PeerTok {
    static __device__ __forceinline__ void issue(const Params& p, const unsigned char* Tslice, const int elo, const int ehi, const int t, const int s,
                                                 const int sub, const int c16, u32x4 (&a)[16], u32x4 (&h)[2]) {
#pragma unroll
        for (int i = 0; i < 16; ++i) {
            const int e = shfl_i(i < 8 ? elo : ehi, (i * 8 + sub) & 63);
            a[i] = *reinterpret_cast<const u32x4*>(Tslice + (((unsigned)e << 7) + (unsigned)c16 * 16u));
        }
        if (!VSIDE) h[0] = *reinterpret_cast<const u32x4*>(p.ws + OFF_H8I + (size_t)t * D + s * 128 + c16 * 16);
    }
    static __device__ __forceinline__ void compute(const Params& p, const int l, const u32x4 w4, const float wsc, const int t, const int s,
                                                   const int lane, const int sub, const int c16, const u32x4 (&a)[16], const u32x4 (&h)[2]) {
        if (!VSIDE) {
            int d[16];
#pragma unroll
            for (int i = 0; i < 16; ++i) {
                int acc = 0;
#pragma unroll
                for (int k = 0; k < 4; ++k) acc = __builtin_amdgcn_sdot4((int)a[i][k], (int)h[0][k], acc, false);
                d[i] = acc;
            }
            bfly16i_stage<8>(d, lane, 4); bfly16i_stage<4>(d, lane, 2); bfly16i_stage<2>(d, lane, 1);
            const int i0 = ((lane & 4) << 1) + ((lane & 2) << 1) + ((lane & 1) << 1);
            int* PART = (int*)(p.ws + OFF_PART) + ((size_t)s * NTOK + t) * 128 + sub * 16 + i0;
            *reinterpret_cast<int2*>(PART) = make_int2(d[0], d[1]);
        } else {
            int acc[16];
#pragma unroll
            for (int i = 0; i < 16; ++i) acc[i] = 0;
#pragma unroll
            for (int g = 0; g < 4; ++g) {
                const int wg = (int)w4[g];
#pragma unroll
                for (int k = 0; k < 4; ++k) {
                    const unsigned r0 = a[4 * g][k], r1 = a[4 * g + 1][k], r2 = a[4 * g + 2][k], r3 = a[4 * g + 3][k];
                    const unsigned x01l = __builtin_amdgcn_perm(r1, r0, 0x05010400u), x01h = __builtin_amdgcn_perm(r1, r0, 0x07030602u);
                    const unsigned x23l = __builtin_amdgcn_perm(r3, r2, 0x05010400u), x23h = __builtin_amdgcn_perm(r3, r2, 0x07030602u);
                    const unsigned t0 = __builtin_amdgcn_perm(x23l, x01l, 0x05040100u), t1 = __builtin_amdgcn_perm(x23l, x01l, 0x07060302u);
                    const unsigned t2 = __builtin_amdgcn_perm(x23h, x01h, 0x05040100u), t3 = __builtin_amdgcn_perm(x23h, x01h, 0x07060302u);
                    acc[4 * k]     = __builtin_amdgcn_sdot4((int)t0, wg, acc[4 * k], false);
                    acc[4 * k + 1] = __builtin_amdgcn_sdot4((int)t1, wg, acc[4 * k + 1], false);
                    acc[4 * k + 2] = __builtin_amdgcn_sdot4((int)t2, wg, acc[4 * k + 2], false);
                    acc[4 * k + 3] = __builtin_amdgcn_sdot4((int)t3, wg, acc[4 * k + 3], false);
                }
            }
            bfly16i_stage<8>(acc, lane, 32); bfly16i_stage<4>(acc, lane, 16); bfly16i_stage<2>(acc, lane, 8);
            const int col = s * 128 + c16 * 16 + ((lane & 32) >> 2) + ((lane & 16) >> 2) + ((lane & 8) >> 2);
            const float* g2 = (const float*)(p.ws + OFF_MOD) + (size_t)(l * 5 + tok_cv(t)) * 6144 + 5 * 1024 + col;
            unsigned* XC = reinterpret_cast<unsigned*>((bf16_t*)(p.ws + OFF_XC) + (size_t)t * D + col);
            const unsigned x = *XC; const float2 g = *reinterpret_cast<const float2*>(g2);
            const float xa = __uint_as_float(x << 16) + g.x * wsc * (float)acc[0], xb = __uint_as_float(x & 0xffff0000u) + g.y * wsc * (float)acc[1];
            *XC = pack_bf2(xa, xb);
            if (l == 0) {
                const float ss = wave_sum(xa * xa + xb * xb);
                if (lane == 0) ((float*)(p.ws + OFF_RSS1))[(size_t)t * 8 + s] = ss;
            }
        }
    }
};
template <bool VSIDE>
__device__ __forceinline__ void peer_slice_stream(const Params& p, const int l, const int s, const int first, const int stride, const int lane) {
    const int sub = lane >> 3, c16 = lane & 7;
    const unsigned char* Ts = p.ws + (VSIDE ? OFF_VT : OFF_UT) + ((size_t)l * 8 + s) * NEXP * 128;
    const int* EIb = (const int*)(p.ws + OFF_EIDX); const unsigned char* WPb = p.ws + OFF_WPAIR; const float* WSb = (const float*)(p.ws + OFF_WSC);
    if (first >= NTOK) return;
    const int cnt = (NTOK - first + stride - 1) / stride;
#define PEER_LOADE(k, elo, ehi, w4, wsc) do { const int _t = min(first + (k) * stride, NTOK - 1); \
        elo = EIb[(size_t)_t * 128 + lane]; ehi = EIb[(size_t)_t * 128 + 64 + lane]; \
        if (VSIDE) { w4 = *reinterpret_cast<const u32x4*>(WPb + (size_t)_t * 128 + sub * 16); wsc = WSb[_t]; } } while (0)
    int e0l, e0h, e1l, e1h, e2l, e2h;
    u32x4 w0 = {0u, 0u, 0u, 0u}, w1 = {0u, 0u, 0u, 0u}, w2 = {0u, 0u, 0u, 0u}; float s0 = 0.f, s1 = 0.f, s2 = 0.f;
    u32x4 A[16], B[16], hA[2], hB[2];
    PEER_LOADE(0, e0l, e0h, w0, s0);
    PEER_LOADE(1, e1l, e1h, w1, s1);
    PeerTok<VSIDE>::issue(p, Ts, e0l, e0h, first, s, sub, c16, A, hA);
    for (int k = 0; k < cnt; k += 2) {
        const int ta = first + k * stride, tb = min(ta + stride, NTOK - 1), tc = min(ta + 2 * stride, NTOK - 1);
        __builtin_amdgcn_sched_barrier(0);
        PEER_LOADE(k + 2, e2l, e2h, w2, s2);
        PeerTok<VSIDE>::issue(p, Ts, e1l, e1h, tb, s, sub, c16, B, hB);
        __builtin_amdgcn_sched_barrier(0);
        PeerTok<VSIDE>::compute(p, l, w0, s0, ta, s, lane, sub, c16, A, hA);
        __builtin_amdgcn_sched_barrier(0);
        e0l = e2l; e0h = e2h; w0 = w2; s0 = s2;
        PEER_LOADE(k + 3, e2l, e2h, w2, s2);
        PeerTok<VSIDE>::issue(p, Ts, e0l, e0h, tc, s, sub, c16, A, hA);
        __builtin_amdgcn_sched_barrier(0);
        if (k + 1 < cnt) PeerTok<VSIDE>::compute(p, l, w1, s1, tb, s, lane, sub, c16, B, hB);
        e1l = e2l; e1h = e2h; w1 = w2; s1 = s2;
    }
#undef PEER_LOADE
}
template <bool VSIDE>
__device__ void ph_peer_sliced(const Params& p, int l, unsigned char* ldsraw, const int wv) {
    const int tid = opaque_tid(wv);
    const int wave = tid >> 6, lane = tid & 63;
    volatile LAS int* hdr = (volatile LAS int*)(ldsraw - LDS_HDR);
    unsigned* bar = (unsigned*)(p.ws + OFF_BAR);
    const int myx = (int)(xb_xcc_id() & 15u);
    if (tid == 0) hdr[16] = (int)atomicAdd(bar + QW_PEER + (l * 2 + (VSIDE ? 1 : 0)) * 16 + myx, 1u);
    __syncthreads();
    const int rank = hdr[16], nloc = (int)hdr[0];
    __syncthreads();
    if (myx < 8) peer_slice_stream<VSIDE>(p, l, myx, rank * 8 + wave, nloc * 8, lane);
    for (int j = 0; j < 8; ++j) {
        if (xb_ld(&bar[XB_XCNT(j)]) == 0u) peer_slice_stream<VSIDE>(p, l, j, (int)blockIdx.x * 8 + wave, (int)gridDim.x * 8, lane);
    }
}
__device__ void ph_peer_pairw(const Params& p, int l, const int wv) {
    const int tid = opaque_tid(wv);
    const int lane = tid & 63;
    const float* USC = (const float*)(p.ws + OFF_USC) + l * NEXP; const float* VSC = (const float*)(p.ws + OFF_VSC) + l * NEXP;
    const int* PART = (const int*)(p.ws + OFF_PART);
    for (size_t i4 = GTID; i4 < (size_t)NTOK * 32; i4 += GNT) {
        const size_t idx = i4 * 4;
        const int t = (int)(idx >> 7), pp = (int)(idx & 127), sub = pp >> 4, i = pp & 15;
        int4 ps[8];
#pragma unroll
        for (int s = 0; s < 8; ++s) ps[s] = *reinterpret_cast<const int4*>(PART + (size_t)s * NTOK * 128 + idx);
        int e[4]; float g[4];
#pragma unroll
        for (int q = 0; q < 4; ++q) {
            const int j = (i + q) * 8 + sub;
            e[q] = ((const int*)(p.ws + OFF_EIDX))[(size_t)t * 128 + j]; g[q] = ((const float*)(p.ws + OFF_EGATE))[(size_t)t * 128 + j];
        }
        const float* rp = (const float*)(p.ws + OFF_RSS2) + ((size_t)l * NTOK + t) * 8;
        const float4 ra = *reinterpret_cast<const float4*>(rp), rb = *reinterpret_cast<const float4*>(rp + 4);
        const float hs = rsqrtf((((ra.x + ra.y) + (ra.z + ra.w)) + ((rb.x + rb.y) + (rb.z + rb.w))) * (1.f / D) + EPS);
        const float* xp = (const float*)(p.ws + OFF_XGS) + (size_t)t * 8;
        const float4 xa = *reinterpret_cast<const float4*>(xp), xb = *reinterpret_cast<const float4*>(xp + 4);
        const float xs[8] = {xa.x, xa.y, xa.z, xa.w, xb.x, xb.y, xb.z, xb.w};
        float sm[4] = {0.f, 0.f, 0.f, 0.f};
#pragma unroll
        for (int s = 0; s < 8; ++s) { sm[0] += xs[s] * (float)ps[s].x; sm[1] += xs[s] * (float)ps[s].y; sm[2] += xs[s] * (float)ps[s].z; sm[3] += xs[s] * (float)ps[s].w; }
        const float* USH = (const float*)(p.ws + OFF_USH) + (size_t)(l * 5 + tok_cv(t)) * NEXP;
        float w[4];
#pragma unroll
        for (int q = 0; q < 4; ++q) w[q] = g[q] * gelu_f(sm[q] * (USC[e[q]] * hs) + USH[e[q]]) * VSC[e[q]];
        float am = fmaxf(fmaxf(fabsf(w[0]), fabsf(w[1])), fmaxf(fabsf(w[2]), fabsf(w[3])));
#pragma unroll
        for (int o = 16; o >= 1; o >>= 1) am = fmaxf(am, shfl_x(am, lane, o));
        const float sc = am > 0.f ? 127.f / am : 1.f;
        *reinterpret_cast<unsigned*>(p.ws + OFF_WPAIR + idx) = pack4_i8(q8(w[0] * sc), q8(w[1] * sc), q8(w[2] * sc), q8(w[3] * sc));
        if (pp == 0) ((float*)(p.ws + OFF_WSC))[t] = am > 0.f ? am * (1.f / 127.f) : 1.f;
    }
}

#define CE_DESC(a, b) do { const float _mx = fmaxf((a), (b)); const float _mn = fminf((a), (b)); (a) = _mx; (b) = _mn; } while (0)
__device__ __forceinline__ void sort16_desc(float (&v)[16]) {
#pragma unroll
    for (int k = 2; k <= 16; k <<= 1)
#pragma unroll
        for (int j = k >> 1; j > 0; j >>= 1)
#pragma unroll
            for (int i = 0; i < 16; ++i) {
                const int m = i ^ j;
                if (m > i) { if ((i & k) == 0) CE_DESC(v[i], v[m]); else CE_DESC(v[m], v[i]); }
            }
}
__device__ __forceinline__ void merge_top16(float (&a)[16], const float (&b)[16]) {
#pragma unroll
    for (int i = 0; i < 16; ++i) a[i] = fmaxf(a[i], b[15 - i]);
#pragma unroll
    for (int j = 8; j > 0; j >>= 1)
#pragma unroll
        for (int i = 0; i < 16; ++i) { const int m = i ^ j; if (m > i) CE_DESC(a[i], a[m]); }
}
__device__ __forceinline__ float key_embed(float v, unsigned lowmask, unsigned idxbits) { return __uint_as_float((__float_as_uint(v) & ~lowmask) | idxbits); }

constexpr int SK_ROWB = 144;
__device__ __forceinline__ void peer_stage1(const LAS unsigned char* SK  , const bf16_t* __restrict__ Qrow  ,
                                            const int r, const int hh, float (&out)[16]) {
    bf16x8 qb[4];
#pragma unroll
    for (int ks = 0; ks < 4; ++ks) qb[ks] = *reinterpret_cast<const bf16x8*>(Qrow + ks * 16 + hh * 8);
    float grp[4][16];
#pragma unroll
    for (int mt = 0; mt < 4; ++mt) {
        f32x16 acc;
#pragma unroll
        for (int i = 0; i < 16; ++i) acc[i] = 0.f;
#pragma unroll
        for (int ks = 0; ks < 4; ++ks) {
            const bf16x8 a = *(const LAS bf16x8*)(SK + (mt * 32 + r) * SK_ROWB + (ks * 16 + hh * 8) * 2);
            acc = MFMA32(a, qb[ks], acc);
        }
        const unsigned hx = (unsigned)hh << 2;
#pragma unroll
        for (int i = 0; i < 16; ++i) {
            const unsigned cn = 32u * mt + (i & 3) + 8u * (i >> 2);
            grp[mt][i] = key_embed(acc[i], 127u, (127u - cn) ^ hx);
        }
        sort16_desc(grp[mt]);
    }
    merge_top16(grp[0], grp[1]); merge_top16(grp[2], grp[3]); merge_top16(grp[0], grp[2]);
    float pb[16];
#pragma unroll
    for (int i = 0; i < 16; ++i) pb[i] = shfl_x(grp[0][i], (hh << 5) | r, 32);
    merge_top16(grp[0], pb);
#pragma unroll
    for (int i = 0; i < 16; ++i) out[i] = grp[0][i];
}

__device__ void ph_peer_select(const Params& p, int l, unsigned char* ldsraw, const int wv) {
    const int tid = opaque_tid(wv);
    const int wave = tid >> 6, lane = tid & 63, r = lane & 31, hh = lane >> 5;
    const int gw = blockIdx.x * 8 + wave, nw = gridDim.x * 8;
    LAS unsigned char* skl = (LAS unsigned char*)ldsraw;
    LAS unsigned char* myl = skl + 2 * 128 * SK_ROWB + wave * 2048 + lane * 32;
    {
        const bf16_t* SKg = (const bf16_t*)(p.ws + OFF_SUBK) + (size_t)l * 2 * 128 * 64;
        for (int i = tid; i < 2 * 128 * 8; i += NT) {
            const int row = i >> 3, ch = i & 7;
            *(LAS u32x4*)(skl + row * SK_ROWB + ch * 16) = *reinterpret_cast<const u32x4*>(SKg + (size_t)row * 64 + ch * 8);
        }
        __syncthreads();
    }
    for (int task = gw; task < (NTOK / 32) * 4; task += nw) {
        const int tg = task >> 2, k = task & 3;
        const int t = tg * 32 + r;
        const bf16_t* Qt = (const bf16_t*)(p.ws + OFF_Q) + (size_t)t * D;
        float sv[2][16];
#pragma unroll
        for (int x = 0; x < 2; ++x) {
            float la[16], lb[16];
            peer_stage1(skl + x * 128 * SK_ROWB, Qt + k * 128 + x * 64, r, hh, la);
            peer_stage1(skl + x * 128 * SK_ROWB, Qt + (k + 4) * 128 + x * 64, r, hh, lb);
#pragma unroll
            for (int i = 0; i < 16; ++i) sv[x][i] = hh ? lb[i] : la[i];
        }
        {
            unsigned w[8];
#pragma unroll
            for (int q = 0; q < 8; ++q) {
                w[q] = 0u;
#pragma unroll
                for (int b = 0; b < 4; ++b) {
                    const int i = q * 4 + b;
                    const unsigned key = __float_as_uint(i < 16 ? sv[0][i] : sv[1][i - 16]);
                    w[q] |= (127u - (key & 127u)) << (8 * b);
                }
            }
            *(LAS u32x4*)(myl) = u32x4{w[0], w[1], w[2], w[3]};
            *(LAS u32x4*)(myl + 16) = u32x4{w[4], w[5], w[6], w[7]};
        }
        float val0[16], val1[16];
#pragma unroll
        for (int i = 0; i < 16; ++i) { val0[i] = __uint_as_float(__float_as_uint(sv[0][i]) & ~127u); val1[i] = __uint_as_float(__float_as_uint(sv[1][i]) & ~127u); }
        float g0[16], g1[16], g2[16], g3[16];
#pragma unroll
        for (int b = 0; b < 16; ++b) g0[b] = key_embed(val0[0] + val1[b], 255u, 255u - (unsigned)b);
#pragma unroll
        for (int b = 0; b < 8; ++b) g1[b] = key_embed(val0[1] + val1[b], 255u, 255u - (16u + b));
#pragma unroll
        for (int b = 0; b < 5; ++b) g1[8 + b] = key_embed(val0[2] + val1[b], 255u, 255u - (32u + b));
#pragma unroll
        for (int b = 0; b < 3; ++b) g1[13 + b] = key_embed(val0[4] + val1[b], 255u, 255u - (64u + b));
#pragma unroll
        for (int b = 0; b < 4; ++b) g2[b] = key_embed(val0[3] + val1[b], 255u, 255u - (48u + b));
#pragma unroll
        for (int a = 5; a < 8; ++a)
#pragma unroll
            for (int b = 0; b < 2; ++b) g2[4 + (a - 5) * 2 + b] = key_embed(val0[a] + val1[b], 255u, 255u - (16u * a + b));
#pragma unroll
        for (int a = 8; a < 14; ++a) g2[10 + (a - 8)] = key_embed(val0[a] + val1[0], 255u, 255u - 16u * a);
        g3[0] = key_embed(val0[14] + val1[0], 255u, 255u - 16u * 14); g3[1] = key_embed(val0[15] + val1[0], 255u, 255u - 16u * 15);
#pragma unroll
        for (int i = 2; i < 16; ++i) g3[i] = -3.0e38f;
        sort16_desc(g1); sort16_desc(g2); sort16_desc(g3);
        merge_top16(g0, g1); merge_top16(g2, g3); merge_top16(g0, g2);
        float gate[16]; int eid[16];
        const float mx = __uint_as_float(__float_as_uint(g0[0]) & ~255u);
        float sum = 0.f;
#pragma unroll
        for (int i = 0; i < 16; ++i) {
            const unsigned key = __float_as_uint(g0[i]);
            gate[i] = __expf(__uint_as_float(key & ~255u) - mx); sum += gate[i];
            const unsigned id = 255u - (key & 255u);
            const unsigned n0 = *(const LAS unsigned char*)(myl + (id >> 4));
            const unsigned n1 = *(const LAS unsigned char*)(myl + 16 + (id & 15u));
            eid[i] = (int)(n0 * 128u + n1);
        }
        const float inv = 1.f / sum;
        const int h = k + 4 * hh;
        int* EI = (int*)(p.ws + OFF_EIDX) + (size_t)t * 128 + h * 16; float* EG = (float*)(p.ws + OFF_EGATE) + (size_t)t * 128 + h * 16;
#pragma unroll
        for (int q = 0; q < 4; ++q) {
            *reinterpret_cast<int4*>(EI + q * 4) = make_int4(eid[q * 4], eid[q * 4 + 1], eid[q * 4 + 2], eid[q * 4 + 3]);
            *reinterpret_cast<float4*>(EG + q * 4) = make_float4(gate[q * 4] * inv, gate[q * 4 + 1] * inv, gate[q * 4 + 2] * inv, gate[q * 4 + 3] * inv);
        }
    }
}

constexpr int LDS_BYTES = LDS_HDR + 3 * 48 * 1024;
__global__ void __launch_bounds__(NT, 2) mk_fwd(Params p) {
    extern __shared__ __attribute__((aligned(16))) unsigned char lds[];
    const int wv = __builtin_amdgcn_readfirstlane((int)(threadIdx.x >> 6));
    volatile LAS unsigned* st = (volatile LAS unsigned*)lds;
    if (threadIdx.x < 4) st[threadIdx.x] = 0u;
    __syncthreads();
    XcdBarrier xb = xcd_barrier_post((unsigned*)(p.ws + OFF_BAR), st);
    int bar_idx = 0;
#define GRID_BAR() do { xcd_barrier(xb); \
        if (PROBE_TS >= 0 && blockIdx.x == 0 && threadIdx.x == 0 && (bar_idx == PROBE_TS - 1 || bar_idx == PROBE_TS)) \
            ((volatile LAS unsigned long long*)(lds + 128))[bar_idx - (PROBE_TS - 1)] = __builtin_amdgcn_s_memrealtime(); \
        ++bar_idx; } while (0)
    if (PROBE_TS == 0 && blockIdx.x == 0 && threadIdx.x == 0) ((volatile LAS unsigned long long*)(lds + 128))[0] = __builtin_amdgcn_s_memrealtime();
    unsigned char* ws = p.ws;
    for (int rep = 0; rep < (PROBE_DUP == 1 ? 2 : 1); ++rep) {
    for (int l = 0; l < 2; ++l) {
        ph_transpose(p.in[I_WIN] + (size_t)l * D * INW, (bf16_t*)(ws + OFF_WIN) + (size_t)l * INW * D, D, INW, lds + LDS_HDR, wv);
        ph_transpose(p.in[I_WOUT] + (size_t)l * D * D, (bf16_t*)(ws + OFF_WOUT) + (size_t)l * D * D, D, D, lds + LDS_HDR, wv);
        ph_transpose(p.in[I_WQ] + (size_t)l * D * D, (bf16_t*)(ws + OFF_WQ) + (size_t)l * D * D, D, D, lds + LDS_HDR, wv);
    }
    ph_convert_i8_rows(p.in[I_PU], ws + OFF_UT, (float*)(ws + OFF_USC), 2 * NEXP, wv);
    ph_convert_i8_rows(p.in[I_PV], ws + OFF_VT, (float*)(ws + OFF_VSC), 2 * NEXP, wv);
    ph_convert(p.in[I_SUBK], (bf16_t*)(ws + OFF_SUBK), 2 * 2 * 128 * 64, wv);
    ph_convert(p.in[I_SGUW], (bf16_t*)(ws + OFF_SGUW), 2 * 4 * 128 * 128, wv);
    ph_mod(p, lds + LDS_HDR, wv);
    ph_rope_tab(p, wv);
    GRID_BAR();
    }
    for (int l = 0; l < 2; ++l) {
        for (int rep = 0; rep < (PROBE_DUP == 3 ? 2 : 1); ++rep) {
        if (l == 0) {
            ph_norm_mod(p, 0, 0, 1, wv);
            ph_cache_prep(p, 0, wv);
            ph_fold_tables(p, lds + LDS_HDR, wv);
            GRID_BAR();
        }
        }
        for (int rep = 0; rep < (PROBE_DUP == 5 ? 2 : 1); ++rep) {
        if (l == 0) gemm_phase<EPI_INPROJ>(p, 0, (const bf16_t*)(ws + OFF_H), (const bf16_t*)(ws + OFF_WIN), INW, lds + LDS_HDR, wv);
        else {
            ph_cache_prep(p, 1, wv);
            gemm_phase<EPI_INPROJ>(p, 1, (const bf16_t*)(ws + OFF_XC), (const bf16_t*)(ws + OFF_WINS), INW, lds + LDS_HDR, wv,
                                   (size_t)INW * D, (const float*)(ws + OFF_RSS1), (const float*)(ws + OFF_BIN));
        }
        GRID_BAR();
        }
        for (int rep = 0; rep < ((PROBE_DUP == 4 || (PROBE_DUP >= 10 && PROBE_DUP <= 12)) ? 2 : 1); ++rep) {
        ph_mixers(p, l + 2 * rep, lds + LDS_HDR, wv);
        GRID_BAR();
        }
        gemm_phase<EPI_WOUT>(p, l, (const bf16_t*)(ws + OFF_MIX), (const bf16_t*)(ws + OFF_WOUT) + (size_t)l * D * D, D, lds + LDS_HDR, wv);
        GRID_BAR();
        for (int rep = 0; rep < (PROBE_DUP == 7 ? 2 : 1); ++rep) {
        gemm_phase<EPI_WQ>(p, l, (const bf16_t*)(ws + OFF_XC), (const bf16_t*)(ws + OFF_WQS) + (size_t)l * 5 * D * D, D, lds + LDS_HDR, wv,
                           (size_t)D * D, (const float*)(ws + OFF_RSS2) + (size_t)l * NTOK * 8, (const float*)(ws + OFF_BQ) + (size_t)l * 5 * D);
        GRID_BAR();
        }
        if (PROBE_DUP == 8) { for (int rep = 0; rep < 10; ++rep) GRID_BAR(); }
        for (int rep = 0; rep < (PROBE_DUP == 2 ? 2 : 1); ++rep) {
        ph_peer_select(p, l, lds + LDS_HDR, wv);
        GRID_BAR();
        }
        ph_peer_sliced<false>(p, l, lds + LDS_HDR, wv);
        GRID_BAR();
        ph_peer_pairw(p, l, wv);
        GRID_BAR();
        ph_peer_sliced<true>(p, l, lds + LDS_HDR, wv);
        GRID_BAR();
    }
    ph_final_norm(p, wv);
    if (PROBE_TS >= 0 && blockIdx.x == 0 && threadIdx.x == 0) {
        asm volatile("s_waitcnt vmcnt(0)" ::: "memory");
        volatile LAS unsigned long long* tsl = (volatile LAS unsigned long long*)(lds + 128);
        p.out[0] += (float)(tsl[1] - tsl[0]) * 0.01f;
    }
}

extern "C" void kernel_launch(void* const* d_in, const int* in_sizes, int n_in,
                              void* d_out, int out_size, void* d_ws, size_t ws_size,
                              hipStream_t stream) {
    static int grid = 0;
    if (grid == 0) {
        if (ws_size < WS_NEED) { fprintf(stderr, "kernel_launch: workspace too small: %zu < %zu\n", ws_size, (size_t)WS_NEED); grid = -1; return; }
        int dev = 0, cus = 0, per_cu = 0;
        (void)hipGetDevice(&dev);
        (void)hipDeviceGetAttribute(&cus, hipDeviceAttributeMultiprocessorCount, dev);
        (void)hipFuncSetAttribute((const void*)mk_fwd, hipFuncAttributeMaxDynamicSharedMemorySize, LDS_BYTES);
        (void)hipOccupancyMaxActiveBlocksPerMultiprocessor(&per_cu, (const void*)mk_fwd, NT, LDS_BYTES);
        if (per_cu < 1) { fprintf(stderr, "kernel_launch: occupancy query reports %d blocks per CU\n", per_cu); grid = -1; return; }
        grid = cus;
    }
    if (grid < 0) return;
    (void)hipMemsetAsync((unsigned char*)d_ws + OFF_BAR, 0, 64 * 1024, stream);
    Params p{};
    for (int i = 0; i < 29; ++i) p.in[i] = (const float*)d_in[i];
    p.out = (float*)d_out; p.ws = (unsigned char*)d_ws;
    void* args[] = {&p};
    hipError_t e = hipLaunchCooperativeKernel((const void*)mk_fwd, dim3(grid), dim3(NT), args, LDS_BYTES, stream);
    if (e != hipSuccess) fprintf(stderr, "kernel_launch: cooperative launch failed: %s (grid %d)\n", hipGetErrorString(e), grid);
}
```

```cpp
#include <hip/hip_runtime.h>
#include <hip/hip_bf16.h>
#include <cstdio>
#include <cstdint>
#include <hip/hip_cooperative_groups.h>
namespace cg = cooperative_groups;

#define PROBE_DUP 0
#define PROBE_TS -1
typedef unsigned short bf16_t;
using bf16x8 = __attribute__((ext_vector_type(8))) short;
using f32x4  = __attribute__((ext_vector_type(4))) float;
using f32x16 = __attribute__((ext_vector_type(16))) float;
using f32x2  = __attribute__((ext_vector_type(2))) float;
using u32x4  = __attribute__((ext_vector_type(4))) unsigned;
using u32x2  = __attribute__((ext_vector_type(2))) unsigned;
using s16x4  = __attribute__((ext_vector_type(4))) short;

constexpr int D      = 1024;
constexpr int NTOK   = 16384;
constexpr int NPT    = 8192;
constexpr int SEQ    = 256;
constexpr int DSEQ   = 2048;
constexpr int PAST   = 512;
constexpr int NKS    = DSEQ + PAST;
constexpr int INW    = 2048;
constexpr int NEXP   = 16384;
constexpr float EPS  = 1e-6f;

constexpr size_t MB = 1024 * 1024;
constexpr size_t OFF_BAR   = 0;
constexpr size_t OFF_MOD   = 64 * 1024;
constexpr size_t OFF_ROPE  = OFF_MOD + 256 * 1024;
constexpr size_t OFF_SUBK  = OFF_ROPE + 1 * MB;
constexpr size_t OFF_SGUW  = OFF_SUBK + 64 * 1024;
constexpr size_t OFF_WIN   = OFF_SGUW + 256 * 1024;
constexpr size_t OFF_WOUT  = OFF_WIN + 8 * MB;
constexpr size_t OFF_WQ    = OFF_WOUT + 4 * MB;
constexpr size_t OFF_UT    = OFF_WQ + 4 * MB;
constexpr size_t OFF_USC   = OFF_UT + 32 * MB;
constexpr size_t OFF_VT    = OFF_UT + 64 * MB;
constexpr size_t OFF_VSC   = OFF_VT + 32 * MB;
constexpr size_t OFF_H     = OFF_VT + 64 * MB;
constexpr size_t OFF_XC    = OFF_H + 32 * MB;
constexpr size_t OFF_R1    = OFF_XC + 64 * MB;
constexpr size_t OFF_AU    = OFF_R1;
constexpr size_t OFF_AV    = OFF_AU + 8 * MB;
constexpr size_t OFF_AVN   = OFF_AV + 8 * MB;
constexpr size_t OFF_DQ    = OFF_AVN + 8 * MB;
constexpr size_t OFF_DKP   = OFF_DQ + 8 * MB;
constexpr size_t OFF_DKS   = OFF_DKP + 4 * MB;
constexpr size_t OFF_DVTP  = OFF_DKS + 5 * MB;
constexpr size_t OFF_DVTS  = OFF_DVTP + 4 * MB;
constexpr size_t OFF_GQ    = OFF_DVTS + 5 * MB;
constexpr size_t OFF_GKP   = OFF_GQ + 16 * MB;
constexpr size_t OFF_GKS   = OFF_GKP + 2 * MB;
constexpr size_t OFF_GVTP  = OFF_GKS + 3 * MB;
constexpr size_t OFF_GVTS  = OFF_GVTP + 2 * MB;
constexpr size_t OFF_MIX   = OFF_GVTS + 3 * MB;
constexpr size_t OFF_R1END = OFF_MIX + 32 * MB;
constexpr size_t OFF_Q     = OFF_R1;
constexpr size_t OFF_EIDX  = OFF_Q + 32 * MB;
constexpr size_t OFF_EGATE = OFF_EIDX + 8 * MB;
constexpr size_t OFF_TOPV  = OFF_EGATE + 8 * MB;
constexpr size_t OFF_TOPI  = OFF_TOPV + 16 * MB;
static_assert(OFF_TOPI + 16 * MB <= OFF_R1END, "peer buffers must fit region 1");
constexpr size_t OFF_PROJ  = OFF_R1END;
constexpr size_t OFF_PART  = OFF_PROJ;
constexpr size_t OFF_WPAIR = OFF_PART + 64 * MB;
constexpr size_t OFF_H8I   = OFF_WPAIR + 8 * MB;
constexpr size_t OFF_HSC   = OFF_H8I + 16 * MB;
constexpr size_t OFF_WSC   = OFF_HSC + 64 * 1024;
constexpr size_t OFF_XGS   = OFF_WSC + 64 * 1024;
constexpr size_t OFF_RSS2  = OFF_XGS + 512 * 1024;
constexpr size_t OFF_RSS1  = OFF_RSS2 + 1 * MB;
constexpr size_t OFF_USH   = OFF_RSS1 + 512 * 1024;
constexpr size_t OFF_BQ    = OFF_USH + 1 * MB;
constexpr size_t OFF_BIN   = OFF_BQ + 64 * 1024;
constexpr size_t OFF_WQS   = OFF_BIN + 64 * 1024;
constexpr size_t OFF_WINS  = OFF_XC + 32 * MB;
static_assert(OFF_WQS + 20 * MB <= OFF_PROJ + 128 * MB, "folded tables must fit");
constexpr size_t WS_NEED   = OFF_PROJ + 128 * MB;
static_assert(WS_NEED <= 512 * MB, "workspace budget");

constexpr size_t OUT_YP  = 0;
constexpr size_t OUT_YS  = 8388608;
constexpr size_t OUT_NDK = 16777216;
constexpr size_t OUT_NDV = OUT_NDK + 4194304;
constexpr size_t OUT_NGK = OUT_NDV + 4194304;
constexpr size_t OUT_NGV = OUT_NGK + 2097152;

struct Params {
    const float* in[29];
    float* out;
    unsigned char* ws;
};
enum { I_XP = 0, I_XS, I_CDK, I_CDV, I_CGK, I_CGV, I_C, I_CCTX, I_ADAW, I_ADAB, I_N1G, I_N2G, I_WIN, I_SGUNG, I_SGUW, I_SGUB,
       I_LQ1, I_LK1, I_LQ2, I_LK2, I_SUBLN, I_QNG, I_KNG, I_WOUT, I_WQ, I_SUBK, I_PU, I_PV, I_FG };

typedef __bf16 hwbf2 __attribute__((ext_vector_type(2)));
__device__ __forceinline__ unsigned pack_bf2(float a, float b) {
    const f32x2 v = {a, b};
    return __builtin_bit_cast(unsigned, __builtin_convertvector(v, hwbf2));
}
__device__ __forceinline__ bf16_t f2bf(float f) { return (bf16_t)(pack_bf2(f, 0.f) & 0xffffu); }
__device__ __forceinline__ float bf2f(bf16_t h) { return __uint_as_float(((unsigned)h) << 16); }
__device__ __forceinline__ float gelu_f(float x) {
    const float k2 = 2.f * 0.7978845608028654f * 1.4426950408889634f;
    const float e = __builtin_amdgcn_exp2f(k2 * (x + 0.044715f * x * x * x));
    return x - x * __builtin_amdgcn_rcpf(e + 1.f);
}
__device__ __forceinline__ int lane_id() { return (int)__builtin_amdgcn_mbcnt_hi(~0u, __builtin_amdgcn_mbcnt_lo(~0u, 0u)); }
__device__ __forceinline__ int lane_id_op() { int l = lane_id(); asm volatile("" : "+v"(l)); return l; }
__device__ __forceinline__ float shfl_i(float v, int src) { return __builtin_bit_cast(float, __builtin_amdgcn_ds_bpermute(src << 2, __builtin_bit_cast(int, v))); }
__device__ __forceinline__ int shfl_i(int v, int src) { return __builtin_amdgcn_ds_bpermute(src << 2, v); }
__device__ __forceinline__ float shfl_x(float v, int lane, int m) { return shfl_i(v, lane ^ m); }
__device__ __forceinline__ int shfl_x(int v, int lane, int m) { return shfl_i(v, lane ^ m); }
__device__ __forceinline__ int q8(float x) { return (int)fminf(fmaxf(rintf(x), -127.f), 127.f); }
__device__ __forceinline__ unsigned pack4_i8(int a, int b, int c, int d) { return (unsigned)(a & 255) | ((unsigned)(b & 255) << 8) | ((unsigned)(c & 255) << 16) | ((unsigned)d << 24); }
#define DPP_F(v, ctrl) __builtin_bit_cast(float, __builtin_amdgcn_update_dpp(0, __builtin_bit_cast(int, (v)), (ctrl), 0xF, 0xF, false))
__device__ __forceinline__ float row16_sum(float v) {
    v += DPP_F(v, 0xB1); v += DPP_F(v, 0x4E); v += DPP_F(v, 0x141); v += DPP_F(v, 0x140);
    return v;
}
__device__ __forceinline__ float row16_max(float v) {
    v = fmaxf(v, DPP_F(v, 0xB1)); v = fmaxf(v, DPP_F(v, 0x4E)); v = fmaxf(v, DPP_F(v, 0x141)); v = fmaxf(v, DPP_F(v, 0x140));
    return v;
}
__device__ __forceinline__ float rdlane_f(float v, int l) { return __builtin_bit_cast(float, __builtin_amdgcn_readlane(__builtin_bit_cast(int, v), l)); }
__device__ __forceinline__ float wave_sum(float v) {
    v = row16_sum(v);
    return (rdlane_f(v, 0) + rdlane_f(v, 16)) + (rdlane_f(v, 32) + rdlane_f(v, 48));
}
__device__ __forceinline__ float wave_max(float v) {
    v = row16_max(v);
    return fmaxf(fmaxf(rdlane_f(v, 0), rdlane_f(v, 16)), fmaxf(rdlane_f(v, 32), rdlane_f(v, 48)));
}
__device__ __forceinline__ int tok_cv(int t) { return t < NPT ? 0 : 1 + ((t - NPT) >> 11); }
__device__ __forceinline__ const float* x_in_row(const Params& p, int t) {
    return t < NPT ? p.in[I_XP] + (size_t)t * D : p.in[I_XS] + (size_t)(t - NPT) * D;
}
__device__ __forceinline__ float lam_init_of(int l) { return l == 0 ? 0.2f : (0.8f - 0.6f * 0.7408182206817179f); }
__device__ __forceinline__ float lam_of(const Params& p, int l) {
    float s1 = 0.f, s2 = 0.f;
    for (int i = 0; i < 32; ++i) {
        s1 += p.in[I_LQ1][l * 32 + i] * p.in[I_LK1][l * 32 + i];
        s2 += p.in[I_LQ2][l * 32 + i] * p.in[I_LK2][l * 32 + i];
    }
    return expf(s1) - expf(s2) + lam_init_of(l);
}


#define XB_TMO      128
#define XB_XCNT(j)  (256  + 64 * (j))
#define XB_XSUB(j)  (1280 + 64 * (j))
#define XB_XGEN(j)  (2304 + 64 * (j))
#define XB_TOP      3328
#define XB_TOPGEN   3392
#define XCD_BAR_WORDS 3456
#define XB_SPIN_CAP (1u << 20)
#define LAS __attribute__((address_space(3)))
typedef int i32x4 __attribute__((ext_vector_type(4)));
__device__ __forceinline__ unsigned xb_ld(unsigned* p)              { return __hip_atomic_load(p, __ATOMIC_RELAXED, __HIP_MEMORY_SCOPE_AGENT); }
__device__ __forceinline__ unsigned xb_add(unsigned* p, unsigned v) { return __hip_atomic_fetch_add(p, v, __ATOMIC_RELAXED, __HIP_MEMORY_SCOPE_AGENT); }
__device__ __forceinline__ unsigned xb_xcc_id() { return (unsigned)__builtin_amdgcn_s_getreg((3 << 11) | 20) & 0xFu; }
#define XB_SPIN(cond, bar) do { unsigned _sp = 0; while (cond) { __builtin_amdgcn_s_sleep(1); \
    if ((++_sp & 255u) == 0u) { if (xb_ld(&(bar)[XB_TMO])) break; if (_sp > XB_SPIN_CAP) { atomicAdd(&(bar)[XB_TMO], 1u); break; } } } } while (0)
struct XcdBarrier { unsigned* bar; unsigned x; volatile LAS unsigned* st; };
__device__ __forceinline__ XcdBarrier xcd_barrier_post(unsigned* bar, volatile LAS unsigned* st) {
    XcdBarrier b; b.bar = bar; b.x = xb_xcc_id(); b.st = st;
    if (threadIdx.x == 0) (void)xb_add(&bar[XB_XCNT(b.x)], 1u);
    return b;
}
__device__ __forceinline__ void xcd_barrier_complete(unsigned* bar, unsigned x, unsigned& nloc, unsigned& nx) {
    const unsigned G = gridDim.x * gridDim.y * gridDim.z;
    unsigned sum, cnt, mine, sp = 0u;
    for (;;) {
        sum = 0u; cnt = 0u; mine = 0u;
#pragma unroll
        for (unsigned j = 0; j < 16; ++j) { const unsigned c = xb_ld(&bar[XB_XCNT(j)]); sum += c; cnt += (c > 0u) ? 1u : 0u; mine = (j == x) ? c : mine; }
        if (sum == G) break;
        __builtin_amdgcn_s_sleep(1);
        if ((++sp & 255u) == 0u) { if (xb_ld(&bar[XB_TMO])) break; if (sp > XB_SPIN_CAP) { atomicAdd(&bar[XB_TMO], 1u); break; } }
    }
    nloc = mine > 0u ? mine : 1u; nx = cnt > 0u ? cnt : 1u;
}
__device__ __forceinline__ void xcd_barrier(const XcdBarrier& b) {
    asm volatile("s_waitcnt vmcnt(0)" ::: "memory");
    __syncthreads();
    if (threadIdx.x == 0) {
        unsigned* bar = b.bar;
        const unsigned bx = xb_xcc_id();
        __builtin_amdgcn_s_waitcnt(0);
        unsigned nloc = b.st[0], nx = b.st[1];
        if (nloc == 0u) { xcd_barrier_complete(bar, bx, nloc, nx); b.st[0] = nloc; b.st[1] = nx; }
        const unsigned old = xb_add(&bar[XB_XSUB(bx)], 1u);
        const unsigned gen = old / nloc;
        if (old + 1u == (gen + 1u) * nloc) {
            __builtin_amdgcn_fence(__ATOMIC_RELEASE, "agent");
            asm volatile("s_waitcnt vmcnt(0)" ::: "memory");
            const unsigned og = xb_add(&bar[XB_TOP], 1u);
            const unsigned tg = og / nx;
            if (og + 1u == (tg + 1u) * nx) xb_add(&bar[XB_TOPGEN], 1u);
            else XB_SPIN(xb_ld(&bar[XB_TOPGEN]) == tg, bar);
            __builtin_amdgcn_fence(__ATOMIC_ACQUIRE, "agent");
            xb_add(&bar[XB_XGEN(bx)], 1u);
            asm volatile("s_waitcnt vmcnt(0)" ::: "memory");
        } else {
            XB_SPIN(xb_ld(&bar[XB_XGEN(bx)]) == gen, bar);
            __builtin_amdgcn_fence(__ATOMIC_ACQUIRE, "agent");
            asm volatile("s_waitcnt vmcnt(0)" ::: "memory");
        }
    }
    __syncthreads();
}

constexpr int NT = 512;
constexpr int LDS_HDR = 1024;
#define GTID ((size_t)blockIdx.x * NT + tid)
__device__ __forceinline__ int opaque_tid(int wv) { int t = (wv << 6) | lane_id(); asm volatile("" : "+v"(t)); return t; }
#define GNT  ((size_t)gridDim.x * NT)

__device__ void ph_transpose(const float* __restrict__ W, bf16_t* __restrict__ Wt, int K, int N, unsigned char* ldsraw, const int wv) {
    const int tid = opaque_tid(wv);
    LAS bf16_t* T = (LAS bf16_t*)ldsraw;
    const int tk = K / 128, tn = N / 64, ntiles = tk * tn;
    for (int tile = blockIdx.x; tile < ntiles; tile += gridDim.x) {
        const int k0 = (tile % tk) * 128, n0 = (tile / tk) * 64;
#pragma unroll 4
        for (int i = 0; i < 16; ++i) {
            const int kl = i * 8 + (tid >> 6), nl = tid & 63;
            T[nl * 130 + kl] = f2bf(W[(size_t)(k0 + kl) * N + n0 + nl]);
        }
        __syncthreads();
        {
            const int nl = tid >> 3, kc = tid & 7;
            unsigned w[8];
#pragma unroll
            for (int i = 0; i < 8; ++i) w[i] = (unsigned)T[nl * 130 + kc * 16 + 2 * i] | ((unsigned)T[nl * 130 + kc * 16 + 2 * i + 1] << 16);
            bf16_t* dst = Wt + (size_t)(n0 + nl) * K + k0 + kc * 16;
            *reinterpret_cast<u32x4*>(dst) = u32x4{w[0], w[1], w[2], w[3]};
            *reinterpret_cast<u32x4*>(dst + 8) = u32x4{w[4], w[5], w[6], w[7]};
        }
        __syncthreads();
    }
}
__device__ void ph_convert(const float* __restrict__ src, bf16_t* __restrict__ dst, size_t n, const int wv) {
    const int tid = opaque_tid(wv);
    for (size_t idx = GTID; idx < n; idx += GNT) dst[idx] = f2bf(src[idx]);
}
__device__ void ph_convert_i8_rows(const float* __restrict__ src, unsigned char* __restrict__ dst, float* __restrict__ scl, int nrows, const int wv) {
    const int tid = opaque_tid(wv);
    const int lane = tid & 63;
    const int gw = blockIdx.x * 8 + (tid >> 6), nw = gridDim.x * 8;
    for (int row0 = gw * 4; row0 < nrows; row0 += nw * 4) {
        float4 f[4][4];
#pragma unroll
        for (int q = 0; q < 4; ++q)
#pragma unroll
            for (int i = 0; i < 4; ++i) f[q][i] = *reinterpret_cast<const float4*>(src + (size_t)(row0 + q) * D + lane * 16 + i * 4);
#pragma unroll
        for (int q = 0; q < 4; ++q) {
            const int row = row0 + q;
            float v[16];
#pragma unroll
            for (int i = 0; i < 4; ++i) { v[i * 4] = f[q][i].x; v[i * 4 + 1] = f[q][i].y; v[i * 4 + 2] = f[q][i].z; v[i * 4 + 3] = f[q][i].w; }
            float am = 0.f;
#pragma unroll
            for (int i = 0; i < 16; ++i) am = fmaxf(am, fabsf(v[i]));
#pragma unroll
            for (int o = 32; o >= 1; o >>= 1) am = fmaxf(am, shfl_x(am, lane, o));
            const float sc = am > 0.f ? 127.f / am : 1.f;
            unsigned w[4];
#pragma unroll
            for (int i = 0; i < 4; ++i) w[i] = pack4_i8(q8(v[i * 4] * sc), q8(v[i * 4 + 1] * sc), q8(v[i * 4 + 2] * sc), q8(v[i * 4 + 3] * sc));
            {
                const int lyr = row >> 14, e = row & (NEXP - 1);
                *reinterpret_cast<u32x4*>(dst + (((size_t)lyr * 8 + (lane >> 3)) * NEXP + e) * 128 + (lane & 7) * 16) = u32x4{w[0], w[1], w[2], w[3]};
            }
            if (lane == 0) scl[row] = am > 0.f ? am * (1.f / 127.f) : 1.f;
        }
    }
}
__device__ void ph_mod(const Params& p, unsigned char* ldsraw, const int wv) {
    const int tid = opaque_tid(wv);
    LAS float* sl = (LAS float*)ldsraw;
    LAS float* red = sl + 5 * 1024;
    for (int i = tid; i < 5 * 1024; i += NT) {
        const int cv = i >> 10, k = i & 1023;
        const float c = cv == 0 ? p.in[I_CCTX][k] : p.in[I_C][(size_t)(cv - 1) * D + k];
        sl[i] = c / (1.f + __expf(-c));
    }
    __syncthreads();
    const int c = tid & 63, ks = tid >> 6;
    for (int item = blockIdx.x; item < 2 * 96; item += gridDim.x) {
        const int l = item / 96, j = (item % 96) * 64 + c;
        const float* W = p.in[I_ADAW] + (size_t)l * D * 6144 + (size_t)(ks * 128) * 6144 + j;
        float acc[5] = {0.f, 0.f, 0.f, 0.f, 0.f};
#pragma unroll 8
        for (int k = 0; k < 128; ++k) {
            const float w = W[(size_t)k * 6144];
#pragma unroll
            for (int cv = 0; cv < 5; ++cv) acc[cv] += sl[cv * 1024 + ks * 128 + k] * w;
        }
#pragma unroll
        for (int cv = 0; cv < 5; ++cv) red[(ks * 5 + cv) * 64 + c] = acc[cv];
        __syncthreads();
        if (tid < 320) {
            const int cv = tid >> 6;
            float sum = p.in[I_ADAB][l * 6144 + j];
#pragma unroll
            for (int q = 0; q < 8; ++q) sum += red[(q * 5 + cv) * 64 + c];
            ((float*)(p.ws + OFF_MOD))[(size_t)(l * 5 + cv) * 6144 + j] = sum;
        }
        __syncthreads();
    }
}
__device__ void ph_rope_tab(const Params& p, const int wv) {
    const int tid = opaque_tid(wv);
    for (size_t idx = GTID; idx < 2048 * 48; idx += GNT) {
        int s = idx / 48, i = idx % 48;
        float* R = (float*)(p.ws + OFF_ROPE);
        double row = (double)(s / 64), col = (double)(s % 64);
        if (i < 16) {
            int q = i & 7; double inv = pow(10000.0, -(double)q / 8.0);
            double ang = (i < 8 ? row : col) * inv;
            R[s * 16 + i] = (float)cos(ang); R[2048 * 16 + s * 16 + i] = (float)sin(ang);
        } else {
            int ii = i - 16; int q = ii & 15; double inv = pow(10000.0, -(double)q / 16.0);
            double ang = (ii < 16 ? row : col) * inv;
            R[2048 * 32 + s * 32 + ii] = (float)cos(ang); R[2048 * 64 + s * 32 + ii] = (float)sin(ang);
        }
    }
}
__device__ void ph_cache_prep(const Params& p, int l, const int wv) {
    const int tid = opaque_tid(wv);
    bf16_t* DKS = (bf16_t*)(p.ws + OFF_DKS); bf16_t* DVTS = (bf16_t*)(p.ws + OFF_DVTS);
    bf16_t* GKS = (bf16_t*)(p.ws + OFF_GKS); bf16_t* GVTS = (bf16_t*)(p.ws + OFF_GVTS);
    for (size_t idx = GTID; idx < 4 * 512 * 256; idx += GNT) {
        int c = idx & 255, pp = (idx >> 8) & 511, b = idx >> 17;
        size_t src = (((size_t)b * 2 + l) * PAST + pp) * 256 + c;
        int h = c >> 6, r = c & 63;
        DKS[(((size_t)b * 4 + h) * NKS + DSEQ + pp) * 64 + r] = f2bf(p.in[I_CDK][src]);
        DVTS[(((size_t)b * 4 + h) * 64 + r) * NKS + DSEQ + pp] = f2bf(p.in[I_CDV][src]);
        if (c < 128) {
            size_t src2 = (((size_t)b * 2 + l) * PAST + pp) * 128 + c;
            int kv = c >> 6;
            const int sq = DSEQ + pp;
            const size_t hb = ((size_t)b * 2 + kv) * NKS * 64 + (size_t)(sq >> 6) * 4096;
            GKS[hb + (r >> 3) * 512 + (sq & 63) * 8 + (r & 7)] = f2bf(p.in[I_CGK][src2]);
            GVTS[hb + (r >> 5) * 2048 + (sq & 63) * 32 + (r & 31)] = f2bf(p.in[I_CGV][src2]);
        }
    }
}
__device__ void ph_fold_tables(const Params& p, unsigned char* ldsraw, const int wv) {
    const int tid = opaque_tid(wv);
    const int lane = tid & 63;
    const int gw = blockIdx.x * 8 + (tid >> 6), nw = gridDim.x * 8;
    const float* MOD = (const float*)(p.ws + OFF_MOD);
    for (size_t idx = GTID; idx < (size_t)(1024 + 1024 + 2048) * 128; idx += GNT) {
        const int row = (int)(idx >> 7), k0 = (int)(idx & 127) * 8;
        const int which = row < 2048 ? 1 : 0, l = row < 1024 ? 0 : 1;
        const int n = row < 2048 ? (row & 1023) : row - 2048, N = row < 2048 ? 1024 : 2048;
        const bf16_t* src = row < 2048 ? (const bf16_t*)(p.ws + OFF_WQ) + ((size_t)l * D + n) * D + k0 : (const bf16_t*)(p.ws + OFF_WIN) + ((size_t)INW + n) * D + k0;
        bf16_t* dst = row < 2048 ? (bf16_t*)(p.ws + OFF_WQS) + ((size_t)l * 5 * D + n) * D + k0 : (bf16_t*)(p.ws + OFF_WINS) + (size_t)n * D + k0;
        const u32x4 w = *reinterpret_cast<const u32x4*>(src);
        const float* gn = p.in[which ? I_N2G : I_N1G] + l * D + k0;
        const float4 ga = *reinterpret_cast<const float4*>(gn), gb = *reinterpret_cast<const float4*>(gn + 4);
        float wf[8];
#pragma unroll
        for (int k = 0; k < 4; ++k) { wf[2 * k] = __uint_as_float(w[k] << 16); wf[2 * k + 1] = __uint_as_float(w[k] & 0xffff0000u); }
        wf[0] *= ga.x; wf[1] *= ga.y; wf[2] *= ga.z; wf[3] *= ga.w; wf[4] *= gb.x; wf[5] *= gb.y; wf[6] *= gb.z; wf[7] *= gb.w;
#pragma unroll
        for (int cv = 0; cv < 5; ++cv) {
            const float* sc = MOD + (size_t)(l * 5 + cv) * 6144 + which * 3072 + 1024 + k0;
            const float4 sa = *reinterpret_cast<const float4*>(sc), sb = *reinterpret_cast<const float4*>(sc + 4);
            *reinterpret_cast<u32x4*>(dst + (size_t)cv * N * D) = u32x4{pack_bf2(wf[0] * (1.f + sa.x), wf[1] * (1.f + sa.y)), pack_bf2(wf[2] * (1.f + sa.z), wf[3] * (1.f + sa.w)),
                                                                         pack_bf2(wf[4] * (1.f + sb.x), wf[5] * (1.f + sb.y)), pack_bf2(wf[6] * (1.f + sb.z), wf[7] * (1.f + sb.w))};
        }
    }
    for (int row = gw; row < 1024 + 1024 + 2048; row += nw) {
        const int which = row < 2048 ? 1 : 0, l = row < 1024 ? 0 : 1;
        const int n = row < 2048 ? (row & 1023) : row - 2048;
        const bf16_t* src = row < 2048 ? (const bf16_t*)(p.ws + OFF_WQ) + ((size_t)l * D + n) * D + lane * 16 : (const bf16_t*)(p.ws + OFF_WIN) + ((size_t)INW + n) * D + lane * 16;
        const u32x4 w0 = *reinterpret_cast<const u32x4*>(src), w1 = *reinterpret_cast<const u32x4*>(src + 8);
        float wf[16];
#pragma unroll
        for (int k = 0; k < 4; ++k) { wf[2 * k] = __uint_as_float(w0[k] << 16); wf[2 * k + 1] = __uint_as_float(w0[k] & 0xffff0000u);
                                      wf[8 + 2 * k] = __uint_as_float(w1[k] << 16); wf[8 + 2 * k + 1] = __uint_as_float(w1[k] & 0xffff0000u); }
#pragma unroll
        for (int cv = 0; cv < 5; ++cv) {
            const float* sh = MOD + (size_t)(l * 5 + cv) * 6144 + which * 3072 + lane * 16;
            float acc = 0.f;
#pragma unroll
            for (int q = 0; q < 4; ++q) {
                const float4 a = *reinterpret_cast<const float4*>(sh + q * 4);
                acc += wf[q * 4] * a.x + wf[q * 4 + 1] * a.y + wf[q * 4 + 2] * a.z + wf[q * 4 + 3] * a.w;
            }
            acc = wave_sum(acc);
            if (lane == 0) {
                if (row < 2048) ((float*)(p.ws + OFF_BQ))[(size_t)(l * 5 + cv) * D + n] = acc;
                else            ((float*)(p.ws + OFF_BIN))[(size_t)cv * INW + n] = acc;
            }
        }
    }
    {
        LAS signed char* s8 = (LAS signed char*)ldsraw;
        LAS float* s8s = (LAS float*)(ldsraw + 10 * 1024);
        const int wave = tid >> 6;
        for (int r = wave; r < 10; r += 8) {
            const float* sh = MOD + (size_t)r * 6144 + 3072 + lane * 16;
            float v[16];
#pragma unroll
            for (int q = 0; q < 4; ++q) { const float4 a = *reinterpret_cast<const float4*>(sh + q * 4); v[q * 4] = a.x; v[q * 4 + 1] = a.y; v[q * 4 + 2] = a.z; v[q * 4 + 3] = a.w; }
            float am = 0.f;
#pragma unroll
            for (int i = 0; i < 16; ++i) am = fmaxf(am, fabsf(v[i]));
            am = wave_max(am);
            const float sc = am > 0.f ? 127.f / am : 1.f;
            u32x4 w;
#pragma unroll
            for (int q = 0; q < 4; ++q) w[q] = pack4_i8(q8(v[q * 4] * sc), q8(v[q * 4 + 1] * sc), q8(v[q * 4 + 2] * sc), q8(v[q * 4 + 3] * sc));
            *(LAS u32x4*)(s8 + r * 1024 + lane * 16) = w;
            if (lane == 0) s8s[r] = am > 0.f ? am * (1.f / 127.f) : 1.f;
        }
        __syncthreads();
        const int fr = lane & 15, fq = lane >> 4;
        for (int task = gw; task < 2 * (NEXP / 16); task += nw) {
            const int l = task >> 10, e0 = (task & 1023) * 16;
            const unsigned char* up = p.ws + OFF_UT + ((size_t)l * 8 * NEXP + e0 + fr) * 128 + fq * 16;
            i32x4 acc = {0, 0, 0, 0};
#pragma unroll
            for (int st = 0; st < 16; ++st) {
                const i32x4 a = *reinterpret_cast<const i32x4*>(up + (size_t)(st >> 1) * NEXP * 128 + (st & 1) * 64);
                i32x4 b = {0, 0, 0, 0};
                if (fr < 5) b = *(const LAS i32x4*)(s8 + (l * 5 + fr) * 1024 + st * 64 + fq * 16);
                acc = __builtin_amdgcn_mfma_i32_16x16x64_i8(a, b, acc, 0, 0, 0);
            }
            if (fr < 5) {
                const float ss = s8s[l * 5 + fr];
#pragma unroll
                for (int r = 0; r < 4; ++r) {
                    const int e = e0 + fq * 4 + r;
                    ((float*)(p.ws + OFF_USH))[(size_t)(l * 5 + fr) * NEXP + e] = (float)acc[r] * ss * ((const float*)(p.ws + OFF_USC))[l * NEXP + e];
                }
            }
        }
        __syncthreads();
    }
}
__device__ void ph_norm_mod(const Params& p, int l, int which, int from_input, const int wv) {
    const int tid = opaque_tid(wv);
    const int lane = tid & 63;
    const int gw = blockIdx.x * 8 + (tid >> 6), nw = gridDim.x * 8;
    const float* g = p.in[which ? I_N2G : I_N1G] + l * D;
    if (from_input) {
        float4 nx[4];
        {
            const int t = gw < NTOK ? gw : NTOK - 1;
            const float* xr = x_in_row(p, t);
#pragma unroll
            for (int i = 0; i < 4; ++i) nx[i] = *reinterpret_cast<const float4*>(xr + i * 256 + lane * 4);
        }
        for (int t = gw; t < NTOK; t += nw) {
            float4 v[4];
#pragma unroll
            for (int i = 0; i < 4; ++i) v[i] = nx[i];
            {
                const int tn = t + nw < NTOK ? t + nw : t;
                const float* xn = x_in_row(p, tn);
#pragma unroll
                for (int i = 0; i < 4; ++i) nx[i] = *reinterpret_cast<const float4*>(xn + i * 256 + lane * 4);
            }
            const float* mod = (const float*)(p.ws + OFF_MOD) + (size_t)(l * 5 + tok_cv(t)) * 6144 + which * 3072;
            float ss = 0.f;
#pragma unroll
            for (int i = 0; i < 4; ++i) ss += v[i].x * v[i].x + v[i].y * v[i].y + v[i].z * v[i].z + v[i].w * v[i].w;
            ss = wave_sum(ss);
            float r = rsqrtf(ss / D + EPS);
            bf16_t* H = (bf16_t*)(p.ws + OFF_H) + (size_t)t * D;
#pragma unroll
            for (int i = 0; i < 4; ++i) {
                int c = i * 256 + lane * 4;
                float4 gg = *reinterpret_cast<const float4*>(g + c), sh = *reinterpret_cast<const float4*>(mod + c), sc = *reinterpret_cast<const float4*>(mod + 1024 + c);
                uint2 o;
                o.x = pack_bf2(v[i].x * r * gg.x * (1.f + sc.x) + sh.x, v[i].y * r * gg.y * (1.f + sc.y) + sh.y);
                o.y = pack_bf2(v[i].z * r * gg.z * (1.f + sc.z) + sh.z, v[i].w * r * gg.w * (1.f + sc.w) + sh.w);
                *reinterpret_cast<uint2*>(H + c) = o;
            }
        }
    } else {
        u32x4 nx[2];
        {
            const int t = gw < NTOK ? gw : NTOK - 1;
            const bf16_t* xr = (const bf16_t*)(p.ws + OFF_XC) + (size_t)t * D + lane * 8;
            nx[0] = *reinterpret_cast<const u32x4*>(xr); nx[1] = *reinterpret_cast<const u32x4*>(xr + 512);
        }
        for (int t = gw; t < NTOK; t += nw) {
            float v[16];
#pragma unroll
            for (int h = 0; h < 2; ++h)
#pragma unroll
                for (int k = 0; k < 4; ++k) { v[h * 8 + 2 * k] = __uint_as_float(nx[h][k] << 16); v[h * 8 + 2 * k + 1] = __uint_as_float(nx[h][k] & 0xffff0000u); }
            {
                const int tn = t + nw < NTOK ? t + nw : t;
                const bf16_t* xn = (const bf16_t*)(p.ws + OFF_XC) + (size_t)tn * D + lane * 8;
                nx[0] = *reinterpret_cast<const u32x4*>(xn); nx[1] = *reinterpret_cast<const u32x4*>(xn + 512);
            }
            const float* mod = (const float*)(p.ws + OFF_MOD) + (size_t)(l * 5 + tok_cv(t)) * 6144 + which * 3072;
            float ss = 0.f;
#pragma unroll
            for (int i = 0; i < 16; ++i) ss += v[i] * v[i];
            ss = wave_sum(ss);
            float r = rsqrtf(ss / D + EPS);
            bf16_t* H = (bf16_t*)(p.ws + OFF_H) + (size_t)t * D;
            float hq[16];
#pragma unroll
            for (int h = 0; h < 2; ++h) {
                const int c = h * 512 + lane * 8;
                float o[8];
#pragma unroll
                for (int q = 0; q < 2; ++q) {
                    const float4 gg = *reinterpret_cast<const float4*>(g + c + q * 4), sh = *reinterpret_cast<const float4*>(mod + c + q * 4), sc = *reinterpret_cast<const float4*>(mod + 1024 + c + q * 4);
                    o[q * 4] = v[h * 8 + q * 4] * r * gg.x * (1.f + sc.x) + sh.x; o[q * 4 + 1] = v[h * 8 + q * 4 + 1] * r * gg.y * (1.f + sc.y) + sh.y;
                    o[q * 4 + 2] = v[h * 8 + q * 4 + 2] * r * gg.z * (1.f + sc.z) + sh.z; o[q * 4 + 3] = v[h * 8 + q * 4 + 3] * r * gg.w * (1.f + sc.w) + sh.w;
                }
                *reinterpret_cast<u32x4*>(H + c) = u32x4{pack_bf2(o[0], o[1]), pack_bf2(o[2], o[3]), pack_bf2(o[4], o[5]), pack_bf2(o[6], o[7])};
#pragma unroll
                for (int q = 0; q < 8; ++q) hq[h * 8 + q] = o[q];
            }
            if (which) {
                float am = 0.f;
#pragma unroll
                for (int i = 0; i < 16; ++i) am = fmaxf(am, fabsf(hq[i]));
#pragma unroll
                for (int o2 = 32; o2 >= 1; o2 >>= 1) am = fmaxf(am, shfl_x(am, lane, o2));
                const float sc8 = am > 0.f ? 127.f / am : 1.f;
#pragma unroll
                for (int h = 0; h < 2; ++h) {
                    uint2 w;
                    w.x = pack4_i8(q8(hq[h * 8] * sc8), q8(hq[h * 8 + 1] * sc8), q8(hq[h * 8 + 2] * sc8), q8(hq[h * 8 + 3] * sc8));
                    w.y = pack4_i8(q8(hq[h * 8 + 4] * sc8), q8(hq[h * 8 + 5] * sc8), q8(hq[h * 8 + 6] * sc8), q8(hq[h * 8 + 7] * sc8));
                    *reinterpret_cast<uint2*>(p.ws + OFF_H8I + (size_t)t * D + h * 512 + lane * 8) = w;
                }
                if (lane == 0) ((float*)(p.ws + OFF_HSC))[t] = am > 0.f ? am * (1.f / 127.f) : 1.f;
            }
        }
    }
}
__device__ void ph_sgu_norm(const Params& p, int l, const int wv) {
    const int tid = opaque_tid(wv);
    const int lane = tid & 63;
    const int gw = blockIdx.x * 8 + (tid >> 6), nw = gridDim.x * 8;
    for (int t = gw; t < NTOK; t += nw) {
        const bf16_t* AV = (const bf16_t*)(p.ws + OFF_AV) + (size_t)t * 256;
        float v[4]; float ss = 0.f;
#pragma unroll
        for (int i = 0; i < 4; ++i) { v[i] = bf2f(AV[i * 64 + lane]); ss += v[i] * v[i]; }
        ss = wave_sum(ss);
        float r = rsqrtf(ss / 256.f + EPS);
#pragma unroll
        for (int i = 0; i < 4; ++i) ((bf16_t*)(p.ws + OFF_AVN))[(size_t)t * 256 + i * 64 + lane] = f2bf(v[i] * r * p.in[I_SGUNG][l * 256 + i * 64 + lane]);
    }
}
__device__ void ph_sgu_mix(const Params& p, int l, const int wv) {
    const int tid = opaque_tid(wv);
    const bf16_t* AVN = (const bf16_t*)(p.ws + OFF_AVN);
    for (size_t idx = GTID; idx < (size_t)NTOK * 256; idx += GNT) {
        int t = (int)(idx >> 8), c = (int)(idx & 255);
        int t0 = t & ~127, pp = t & 127, g = c >> 6;
        const bf16_t* W = (const bf16_t*)(p.ws + OFF_SGUW) + (((size_t)l * 4 + g) * 128 + pp) * 128;
        float acc = 0.f;
        for (int q = 0; q < 128; ++q) acc += bf2f(W[q]) * bf2f(AVN[(size_t)(t0 + q) * 256 + c]);
        acc += p.in[I_SGUB][(l * 4 + g) * 128 + pp];
        float au = bf2f(((const bf16_t*)(p.ws + OFF_AU))[(size_t)t * 256 + c]);
        ((bf16_t*)(p.ws + OFF_MIX))[(size_t)t * D + c] = f2bf(au * acc);
    }
}
__device__ void ph_attn_ref(const Params& p, int l, const int wv) {
    const int tid = opaque_tid(wv);
    const int lane = tid & 63;
    const int gw = blockIdx.x * 8 + (tid >> 6), nw = gridDim.x * 8;
    const float lam = lam_of(p, l);
    for (int item = gw; item < NTOK * 12; item += nw) {
        const int t = item % NTOK, hh = item / NTOK;
        const bool prompt = t < NPT;
        const int b = prompt ? t / SEQ : (t - NPT) / DSEQ;
        const int nk = prompt ? SEQ : NKS;
        if (hh < 4) {
            const int h = hh;
            const bf16_t* K = prompt ? (const bf16_t*)(p.ws + OFF_DKP) + ((size_t)b * 4 + h) * SEQ * 64 : (const bf16_t*)(p.ws + OFF_DKS) + ((size_t)b * 4 + h) * NKS * 64;
            const bf16_t* Vt = prompt ? (const bf16_t*)(p.ws + OFF_DVTP) + ((size_t)b * 4 + h) * 64 * SEQ : (const bf16_t*)(p.ws + OFF_DVTS) + ((size_t)b * 4 + h) * 64 * NKS;
            float q = bf2f(((const bf16_t*)(p.ws + OFF_DQ))[(size_t)t * 256 + h * 64 + lane]);
            const float scale = 0.17677669529663687f;
            float m0 = -1e30f, m1 = -1e30f, l0 = 0.f, l1 = 0.f, a0 = 0.f, a1 = 0.f;
            for (int k = 0; k < nk; ++k) {
                float pr = q * bf2f(K[(size_t)k * 64 + lane]);
#pragma unroll
                for (int o = 16; o >= 1; o >>= 1) pr += shfl_x(pr, lane, o);
                float s0 = shfl_i(pr, 0) * scale, s1 = shfl_i(pr, 32) * scale;
                float v = bf2f(Vt[(size_t)lane * nk + k]);
                float mn0 = fmaxf(m0, s0), mn1 = fmaxf(m1, s1);
                float c0 = expf(m0 - mn0), c1 = expf(m1 - mn1);
                float e0 = expf(s0 - mn0), e1 = expf(s1 - mn1);
                l0 = l0 * c0 + e0; l1 = l1 * c1 + e1;
                a0 = a0 * c0 + e0 * v; a1 = a1 * c1 + e1 * v;
                m0 = mn0; m1 = mn1;
            }
            float o = a0 / l0 - lam * a1 / l1;
            float ss = wave_sum(o * o);
            float r = rsqrtf(ss / 64.f + EPS);
            o = o * r * p.in[I_SUBLN][l * 64 + lane] * (1.f - lam_init_of(l));
            ((bf16_t*)(p.ws + OFF_MIX))[(size_t)t * D + 256 + h * 64 + lane] = f2bf(o);
        } else {
            const int hq = hh - 4, kv = hq >> 2;
            const bf16_t* K = prompt ? (const bf16_t*)(p.ws + OFF_GKP) + ((size_t)b * 2 + kv) * SEQ * 64 : (const bf16_t*)(p.ws + OFF_GKS) + ((size_t)b * 2 + kv) * NKS * 64;
            const bf16_t* Vt = prompt ? (const bf16_t*)(p.ws + OFF_GVTP) + ((size_t)b * 2 + kv) * 64 * SEQ : (const bf16_t*)(p.ws + OFF_GVTS) + ((size_t)b * 2 + kv) * 64 * NKS;
            float q = bf2f(((const bf16_t*)(p.ws + OFF_GQ))[(size_t)t * 512 + hq * 64 + lane]);
            float m = -1e30f, ls = 0.f, a = 0.f;
            for (int k = 0; k < nk; ++k) {
                float s = wave_sum(q * bf2f(K[(size_t)k * 64 + lane])) * 0.125f;
                float v = bf2f(Vt[(size_t)lane * nk + k]);
                float mn = fmaxf(m, s);
                float c = expf(m - mn), e = expf(s - mn);
                ls = ls * c + e; a = a * c + e * v; m = mn;
            }
            ((bf16_t*)(p.ws + OFF_MIX))[(size_t)t * D + 512 + hq * 64 + lane] = f2bf(a / ls);
        }
    }
}
__device__ void ph_peer_scores(const Params& p, int l, const int wv) {
    const int tid = opaque_tid(wv);
    const bf16_t* SK = (const bf16_t*)(p.ws + OFF_SUBK) + (size_t)l * 2 * 128 * 64;
    for (size_t idx = GTID; idx < (size_t)NTOK * 2048; idx += GNT) {
        int t = (int)(idx >> 11), o = (int)(idx & 2047);
        const bf16_t* Q = (const bf16_t*)(p.ws + OFF_Q) + (size_t)t * D;
        int n = o & 127, x = (o >> 7) & 1, h = o >> 8;
        float acc = 0.f;
        for (int k = 0; k < 64; ++k) acc += bf2f(Q[h * 128 + x * 64 + k]) * bf2f(SK[((size_t)x * 128 + n) * 64 + k]);
        ((float*)(p.ws + OFF_PROJ))[idx] = acc;
    }
}
__device__ void ph_peer_top1(const Params& p, const int wv) {
    const int tid = opaque_tid(wv);
    for (size_t idx = GTID; idx < (size_t)NTOK * 16; idx += GNT) {
        const float* SC = (const float*)(p.ws + OFF_PROJ) + idx * 128;
        float* TV = (float*)(p.ws + OFF_TOPV) + idx * 16; int* TI = (int*)(p.ws + OFF_TOPI) + idx * 16;
        float pv = 3.0e38f; int pi = -1;
        for (int r = 0; r < 16; ++r) {
            float bv = -3.0e38f; int bi = -1;
            for (int n = 0; n < 128; ++n) {
                float v = SC[n];
                bool after = (v < pv) || (v == pv && n > pi);
                if (after && (bi < 0 || v > bv)) { bv = v; bi = n; }
            }
            TV[r] = bv; TI[r] = bi; pv = bv; pi = bi;
        }
    }
}
__device__ void ph_peer_top2(const Params& p, const int wv) {
    const int tid = opaque_tid(wv);
    for (size_t idx = GTID; idx < (size_t)NTOK * 8; idx += GNT) {
        const float* TV = (const float*)(p.ws + OFF_TOPV) + idx * 32; const int* TI = (const int*)(p.ws + OFF_TOPI) + idx * 32;
        int* EI = (int*)(p.ws + OFF_EIDX) + idx * 16; float* EG = (float*)(p.ws + OFF_EGATE) + idx * 16;
        float pv = 3.0e38f; int pi = -1; float mx = 0.f, sum = 0.f;
        for (int r = 0; r < 16; ++r) {
            float bv = -3.0e38f; int bi = -1;
            for (int n = 0; n < 256; ++n) {
                float v = TV[n >> 4] + TV[16 + (n & 15)];
                bool after = (v < pv) || (v == pv && n > pi);
                if (after && (bi < 0 || v > bv)) { bv = v; bi = n; }
            }
            if (r == 0) mx = bv;
            float e = expf(bv - mx);
            sum += e;
            EG[r] = e; EI[r] = TI[bi >> 4] * 128 + TI[16 + (bi & 15)];
            pv = bv; pi = bi;
        }
        float inv = 1.f / sum;
        for (int r = 0; r < 16; ++r) EG[r] *= inv;
    }
}
__device__ void ph_peer_apply(const Params& p, int l, unsigned char* lds, const int wv) {
    const int tid = opaque_tid(wv);
    const int sub = tid >> 8, tl = tid & 255;
    const int wave = tl >> 6, lane = tl & 63;
    float* wts = (float*)(lds + 64) + sub * 128; int* eid = (int*)(lds + 64 + 1024) + sub * 128;
    const bf16_t* UT = (const bf16_t*)(p.ws + OFF_UT) + (size_t)l * NEXP * D;
    const bf16_t* VT = (const bf16_t*)(p.ws + OFF_VT) + (size_t)l * NEXP * D;
    const int niter = (NTOK + gridDim.x * 2 - 1) / (gridDim.x * 2);
    for (int it = 0; it < niter; ++it) {
        int t = (it * gridDim.x + blockIdx.x) * 2 + sub;
        const bool valid = t < NTOK; if (!valid) t = NTOK - 1;
        const bf16_t* H = (const bf16_t*)(p.ws + OFF_H) + (size_t)t * D;
        const int* EI = (const int*)(p.ws + OFF_EIDX) + (size_t)t * 128; const float* EG = (const float*)(p.ws + OFF_EGATE) + (size_t)t * 128;
        float hv[16];
#pragma unroll
        for (int i = 0; i < 16; ++i) hv[i] = bf2f(H[lane * 16 + i]);
        for (int jj = 0; jj < 32; ++jj) {
            int j = wave * 32 + jj; int e = EI[j];
            const bf16_t* ur = UT + (size_t)e * D + lane * 16;
            float acc = 0.f;
#pragma unroll
            for (int i = 0; i < 16; ++i) acc += hv[i] * bf2f(ur[i]);
            acc = wave_sum(acc);
            if (lane == 0) { wts[j] = EG[j] * gelu_f(acc); eid[j] = e; }
        }
        __syncthreads();
        float o[4] = {0.f, 0.f, 0.f, 0.f};
        for (int j = 0; j < 128; ++j) {
            const bf16_t* vr = VT + (size_t)eid[j] * D + tl * 4; float w = wts[j];
#pragma unroll
            for (int i = 0; i < 4; ++i) o[i] += w * bf2f(vr[i]);
        }
        const float* mod = (const float*)(p.ws + OFF_MOD) + (size_t)(l * 5 + tok_cv(t)) * 6144 + 5 * 1024;
        float* XC = (float*)(p.ws + OFF_XC) + (size_t)t * D;
        if (valid) {
#pragma unroll
            for (int i = 0; i < 4; ++i) { int c = tl * 4 + i; XC[c] += mod[c] * o[i]; }
        }
        __syncthreads();
    }
}
__device__ void ph_final_norm(const Params& p, const int wv) {
    const int tid = opaque_tid(wv);
    const int lane = tid & 63;
    const int gw = blockIdx.x * 8 + (tid >> 6), nw = gridDim.x * 8;
    u32x4 nx[2];
    {
        const int t = gw < NTOK ? gw : NTOK - 1;
        const bf16_t* xr = (const bf16_t*)(p.ws + OFF_XC) + (size_t)t * D + lane * 8;
        nx[0] = *reinterpret_cast<const u32x4*>(xr); nx[1] = *reinterpret_cast<const u32x4*>(xr + 512);
    }
    for (int t = gw; t < NTOK; t += nw) {
        float v[16];
#pragma unroll
        for (int h = 0; h < 2; ++h)
#pragma unroll
            for (int k = 0; k < 4; ++k) { v[h * 8 + 2 * k] = __uint_as_float(nx[h][k] << 16); v[h * 8 + 2 * k + 1] = __uint_as_float(nx[h][k] & 0xffff0000u); }
        {
            const int tn = t + nw < NTOK ? t + nw : t;
            const bf16_t* xn = (const bf16_t*)(p.ws + OFF_XC) + (size_t)tn * D + lane * 8;
            nx[0] = *reinterpret_cast<const u32x4*>(xn); nx[1] = *reinterpret_cast<const u32x4*>(xn + 512);
        }
        float ss = 0.f;
#pragma unroll
        for (int i = 0; i < 16; ++i) ss += v[i] * v[i];
        ss = wave_sum(ss);
        float r = rsqrtf(ss / D + EPS);
        float* y = p.out + (size_t)t * D;
#pragma unroll
        for (int h = 0; h < 2; ++h) {
            const int c = h * 512 + lane * 8;
#pragma unroll
            for (int q = 0; q < 2; ++q) {
                const float4 g = *reinterpret_cast<const float4*>(p.in[I_FG] + c + q * 4);
                *reinterpret_cast<float4*>(y + c + q * 4) = make_float4(v[h * 8 + q * 4] * r * g.x, v[h * 8 + q * 4 + 1] * r * g.y, v[h * 8 + q * 4 + 2] * r * g.z, v[h * 8 + q * 4 + 3] * r * g.w);
            }
        }
    }
}


namespace g8 {
constexpr int BM = 256, BK = 64, HALF = 128, HT = HALF * BK;
__device__ __forceinline__ int lds_byte(int r, int c) {
    int st = (r >> 4) * 2 + (c >> 5), rr = r & 15, cc = c & 31, ob = rr * 64 + cc * 2;
    return st * 1024 + (ob ^ (((ob >> 9) & 1) << 5));
}
__device__ __forceinline__ void stage_rc(int b, int& R, int& C) {
    int st = b / 1024, sb = b % 1024, swz = sb ^ (((sb >> 9) & 1) << 5);
    R = (st >> 1) * 16 + swz / 64; C = (st & 1) * 32 + (swz % 64) / 2;
}
}
enum { EPI_INPROJ = 0, EPI_WOUT = 1, EPI_WQ = 2 };
constexpr int STG = 132;

__device__ __forceinline__ void store_bf16x32(bf16_t* dst, const float (&v)[32]) {
#pragma unroll
    for (int i = 0; i < 4; ++i) {
        uint4 u;
        u.x = pack_bf2(v[i * 8 + 0], v[i * 8 + 1]); u.y = pack_bf2(v[i * 8 + 2], v[i * 8 + 3]);
        u.z = pack_bf2(v[i * 8 + 4], v[i * 8 + 5]); u.w = pack_bf2(v[i * 8 + 6], v[i * 8 + 7]);
        *reinterpret_cast<uint4*>(dst + i * 8) = u;
    }
}
__device__ __forceinline__ void store_f32x32(float* dst, const float (&v)[32]) {
#pragma unroll
    for (int i = 0; i < 8; ++i) *reinterpret_cast<float4*>(dst + i * 4) = make_float4(v[i * 4], v[i * 4 + 1], v[i * 4 + 2], v[i * 4 + 3]);
}

__device__ __forceinline__ void epi_inproj_xform(const Params& p, int l, int t, int c0, float (&v)[32]) {
    const bool prompt = t < NPT;
    const int s = prompt ? (t & 255) : ((t - NPT) & 2047);
    const float* R = (const float*)(p.ws + OFF_ROPE);
    if (c0 < 512) {
#pragma unroll
        for (int i = 0; i < 32; ++i) v[i] = gelu_f(v[i]);
    } else if (c0 < 1024) {
        if (!prompt) {
            const float* cs = R + s * 16; const float* sn = R + 2048 * 16 + s * 16;
#pragma unroll
            for (int i = 0; i < 16; ++i) {
                float c = cs[i], sv = sn[i], x1 = v[i], x2 = v[i + 16];
                v[i] = x1 * c - x2 * sv; v[i + 16] = x2 * c + x1 * sv;
            }
        }
    } else if (c0 >= 1280 && c0 < 1920) {
        const bool isq = c0 < 1792;
        const int hi = c0 & 32;
        const float* g = p.in[isq ? I_QNG : I_KNG] + l * 64 + hi;
        float ss = 0.f;
#pragma unroll
        for (int i = 0; i < 32; ++i) ss += v[i] * v[i];
        const int ln = lane_id_op();
        ss += shfl_x(ss, ln, 1);
        const float rr = rsqrtf(ss * (1.f / 64.f) + EPS);
#pragma unroll
        for (int i = 0; i < 32; ++i) v[i] = v[i] * rr * g[i];
        if (!prompt) {
            const float* cs = R + 2048 * 32 + s * 32; const float* sn = R + 2048 * 64 + s * 32;
#pragma unroll
            for (int i = 0; i < 32; ++i) {
                float pv = shfl_x(v[i], ln, 1);
                float c = cs[i], sv = sn[i];
                v[i] = hi ? (v[i] * c + pv * sv) : (v[i] * c - pv * sv);
            }
        }
    }
}
__device__ __forceinline__ void epi_inproj_col(const Params& p, int t0, int c, const LAS float* stc) {
    float v[32];
#pragma unroll
    for (int i = 0; i < 32; ++i) v[i] = stc[i * STG];
    const bool prompt = t0 < NPT;
    const int b = prompt ? (t0 >> 8) : ((t0 - NPT) >> 11);
    const int s = prompt ? (t0 & 255) : ((t0 - NPT) & 2047);
    unsigned char* ws = p.ws;
    bf16_t* dst;
    if (c < 1280) {
        const int cc = c - 1024, h = cc >> 6, d = cc & 63;
        dst = prompt ? (bf16_t*)(ws + OFF_DVTP) + (((size_t)b * 4 + h) * 64 + d) * SEQ + s
                     : (bf16_t*)(ws + OFF_DVTS) + (((size_t)b * 4 + h) * 64 + d) * NKS + s;
    } else {
        const int cc = c - 1920, kv = cc >> 6, d = cc & 63;
        dst = prompt ? (bf16_t*)(ws + OFF_GVTP) + (((size_t)b * 2 + kv) * 64 + d) * SEQ + s
                     : (bf16_t*)(ws + OFF_GVTS) + (((size_t)b * 2 + kv) * 64 + d) * NKS + s;
    }
    store_bf16x32(dst, v);
}

template <int MODE>
__device__ __forceinline__ void gemm_phase(const Params& p, int l, const bf16_t* __restrict__ A, const bf16_t* __restrict__ Bt, const int N, unsigned char* ldsraw, const int wv,
                                           const size_t cvstride = 0, const float* __restrict__ RSS = nullptr, const float* __restrict__ BIAS = nullptr) {
    using namespace g8;
    constexpr int K = 1024, nt = K / BK, BN = 128, TILE_A = BM * BK * 2, TILE_B = BN * BK * 2, STAGE_B = TILE_A + TILE_B;
    LAS unsigned char* lds = (LAS unsigned char*)ldsraw;
    const int tid = opaque_tid(wv), wid = wv, lane = tid & 63;
    const int wr = wid >> 1, wc = wid & 1, fr = lane & 15, fq = lane >> 4;
    unsigned voff[4];
#pragma unroll
    for (int i = 0; i < 4; ++i) voff[i] = (unsigned)((i * 64 + wid * 8 + (lane >> 3)) * K + (((lane & 7) ^ (lane >> 3)) * 8)) * 2u;
    const int aoff = (wr * 64 + fr) * 128 + ((fq ^ (fr & 7)) * 16), boff = (wc * 64 + fr) * 128 + ((fq ^ (fr & 7)) * 16);
    const unsigned ldsw = (unsigned)wid * 1024u;
#define G8_STAGE(buf, kt) do { \
        _Pragma("unroll") for (int _i = 0; _i < 4; ++_i) \
            __builtin_amdgcn_global_load_lds((const unsigned*)((const char*)(Ab + (kt) * BK) + voff[_i]), (LAS unsigned*)(lds + (buf) * STAGE_B + ldsw + _i * 8192), 16, 0, 0); \
        _Pragma("unroll") for (int _i = 0; _i < 2; ++_i) \
            __builtin_amdgcn_global_load_lds((const unsigned*)((const char*)(Bb + (kt) * BK) + voff[_i]), (LAS unsigned*)(lds + (buf) * STAGE_B + TILE_A + ldsw + _i * 8192), 16, 0, 0); } while (0)
#define G8_WAIT_V0() asm volatile("s_waitcnt vmcnt(0)" ::: "memory")
    const int nN = N / BN, nM = NTOK / BM, ntiles = nM * nN;
    const int G = gridDim.x;
    const int vb = (G % 8 == 0) ? (int)(blockIdx.x % 8) * (G / 8) + (int)(blockIdx.x / 8) : (int)blockIdx.x;
    const int tpb = (ntiles + G - 1) / G;
    const bool paneled = (G == 256) && (nN == 8 || nN == 16) && (nM == 64);
    for (int ti = 0; ti < tpb; ++ti) {
        int tile = vb * tpb + ti;
        if (paneled) {
            const int x = vb >> 5, j = vb & 31;
            const int mpx = nN == 16 ? 16 : 8;
            const int m0 = nN == 16 ? (x >> 1) * 16 : x * 8, n0 = nN == 16 ? (x & 1) * 8 : 0;
            const int pm_ = m0 + ti * 4 + (j >> 3), pn_ = n0 + (j & 7);
            tile = (ti * 4 < mpx) ? pm_ * nN + pn_ : ntiles;
        }
        if (tile >= ntiles) break;
        const int pm = tile / nN, pn = tile % nN, brow = pm * BM, bcol = pn * BN;
        const bf16_t* Ab = A + (size_t)brow * K; const bf16_t* Bb = Bt + (size_t)tok_cv(brow) * cvstride + (size_t)bcol * K;
        f32x4 acc[4][4];
#pragma unroll
        for (int m = 0; m < 4; ++m)
#pragma unroll
            for (int n = 0; n < 4; ++n) acc[m][n] = f32x4{0.f, 0.f, 0.f, 0.f};
        G8_WAIT_V0();
        G8_STAGE(0, 0); G8_STAGE(1, 1);
        int cur = 0;
        for (int t = 0; t < nt; ++t) {
            if (t + 1 < nt) asm volatile("s_waitcnt vmcnt(6)" ::: "memory"); else asm volatile("s_waitcnt vmcnt(0)" ::: "memory");
            __builtin_amdgcn_s_barrier();
            if (t + 2 < nt) { const int nb = cur >= 1 ? cur - 1 : 2; G8_STAGE(nb, t + 2); }
            {
                bf16x8 At[2][4], Bf[2][4];
#pragma unroll
                for (int ks = 0; ks < 2; ++ks) {
#pragma unroll
                    for (int m = 0; m < 4; ++m) At[ks][m] = *(const LAS bf16x8*)(lds + cur * STAGE_B + ((aoff + m * 2048) ^ (ks * 64)));
#pragma unroll
                    for (int n = 0; n < 4; ++n) Bf[ks][n] = *(const LAS bf16x8*)(lds + cur * STAGE_B + TILE_A + ((boff + n * 2048) ^ (ks * 64)));
                }
                __builtin_amdgcn_sched_barrier(0);
#pragma unroll
                for (int ks = 0; ks < 2; ++ks)
#pragma unroll
                    for (int m = 0; m < 4; ++m)
#pragma unroll
                        for (int n = 0; n < 4; ++n) acc[m][n] = __builtin_amdgcn_mfma_f32_16x16x32_bf16(At[ks][m], Bf[ks][n], acc[m][n], 0, 0, 0);
                __builtin_amdgcn_sched_barrier(0);
            }
            cur = cur == 2 ? 0 : cur + 1;
        }
        __syncthreads();
        LAS float* st = (LAS float*)lds;
        if (MODE != EPI_WOUT && cvstride != 0) {
            LAS float* rs = st + 256 * STG;
            if (tid < 256) {
                const float* rp = RSS + (size_t)(brow + tid) * 8;
                const float4 a = *reinterpret_cast<const float4*>(rp), b = *reinterpret_cast<const float4*>(rp + 4);
                rs[tid] = rsqrtf((((a.x + a.y) + (a.z + a.w)) + ((b.x + b.y) + (b.z + b.w))) * (1.f / D) + EPS);
            }
            __syncthreads();
            float bz[4];
#pragma unroll
            for (int n = 0; n < 4; ++n) bz[n] = BIAS[(size_t)tok_cv(brow) * N + bcol + wc * 64 + n * 16 + fr];
#pragma unroll
            for (int m = 0; m < 4; ++m)
#pragma unroll
                for (int j = 0; j < 4; ++j) {
                    const float r = rs[wr * 64 + m * 16 + fq * 4 + j];
#pragma unroll
                    for (int n = 0; n < 4; ++n) st[(wr * 64 + m * 16 + fq * 4 + j) * STG + wc * 64 + n * 16 + fr] = acc[m][n][j] * r + bz[n];
                }
        } else {
#pragma unroll
        for (int m = 0; m < 4; ++m)
#pragma unroll
            for (int n = 0; n < 4; ++n)
#pragma unroll
                for (int j = 0; j < 4; ++j)
                    st[(wr * 64 + m * 16 + fq * 4 + j) * STG + wc * 64 + n * 16 + fr] = acc[m][n][j];
        }
        __syncthreads();
        const bool tprompt = brow < NPT;
        const int tb_ = tprompt ? (brow >> 8) : ((brow - NPT) >> 11), ts0 = tprompt ? 0 : ((brow - NPT) & 2047);
        if (MODE == EPI_INPROJ) {
            const bool vtile = (bcol >= 1024 && bcol < 1280);
            if (!vtile) {
#pragma unroll 1
                for (int it = 0; it < 2; ++it) {
                    const int item = it * NT + tid, erow = item >> 2, eseg = item & 3;
                    float v[32];
#pragma unroll
                    for (int i = 0; i < 8; ++i) {
                        const f32x4 f = *(const LAS f32x4*)(st + erow * STG + eseg * 32 + i * 4);
                        v[i * 4] = f[0]; v[i * 4 + 1] = f[1]; v[i * 4 + 2] = f[2]; v[i * 4 + 3] = f[3];
                    }
                    epi_inproj_xform(p, l, brow + erow, bcol + eseg * 32, v);
#pragma unroll
                    for (int i = 0; i < 8; ++i) *(LAS f32x4*)(st + erow * STG + eseg * 32 + i * 4) = f32x4{v[i * 4], v[i * 4 + 1], v[i * 4 + 2], v[i * 4 + 3]};
                }
                __syncthreads();
#pragma unroll 1
                for (int it = 0; it < 8; ++it) {
                    const int item = it * NT + tid, r = item >> 4, c = (item & 15) * 8;
                    const f32x4 f0 = *(const LAS f32x4*)(st + r * STG + c), f1 = *(const LAS f32x4*)(st + r * STG + c + 4);
                    const int t = brow + r, sp = ts0 + r;
                    bf16_t* dst;
                    if (bcol < 512)        dst = (bf16_t*)(p.ws + (bcol < 256 ? OFF_AU : OFF_AV)) + (size_t)t * 256 + (bcol & 255) + c;
                    else if (bcol < 768)   dst = (bf16_t*)(p.ws + OFF_DQ) + (size_t)t * 256 + (bcol - 512) + c;
                    else if (bcol < 1024) { const int cc = bcol - 768 + c, h = cc >> 6;
                                            dst = tprompt ? (bf16_t*)(p.ws + OFF_DKP) + (((size_t)tb_ * 4 + h) * SEQ + sp) * 64 + (cc & 63)
                                                          : (bf16_t*)(p.ws + OFF_DKS) + (((size_t)tb_ * 4 + h) * NKS + sp) * 64 + (cc & 63); }
                    else if (bcol < 1792)  dst = (bf16_t*)(p.ws + OFF_GQ) + (size_t)t * 512 + (bcol - 1280) + c;
                    else                 { const int kv = c >> 6, d0 = c & 63;
                                            const size_t hb = (tprompt ? ((size_t)tb_ * 2 + kv) * SEQ * 64 : ((size_t)tb_ * 2 + kv) * NKS * 64) + (size_t)(sp >> 6) * 4096;
                                            dst = bcol < 1920 ? (bf16_t*)(p.ws + (tprompt ? OFF_GKP : OFF_GKS)) + hb + (d0 >> 3) * 512 + (sp & 63) * 8
                                                              : (bf16_t*)(p.ws + (tprompt ? OFF_GVTP : OFF_GVTS)) + hb + (d0 >> 5) * 2048 + (sp & 63) * 32 + (d0 & 31); }
                    *reinterpret_cast<u32x4*>(dst) = u32x4{pack_bf2(f0[0], f0[1]), pack_bf2(f0[2], f0[3]), pack_bf2(f1[0], f1[1]), pack_bf2(f1[2], f1[3])};
                }
            }
            if (tprompt && ((bcol >= 768 && bcol < 1280) || bcol >= 1792)) {
                float* ob; int rs;
                if (bcol < 1024)      { ob = p.out + OUT_NDK + (((size_t)tb_ * 2 + l) * SEQ) * 256 + (bcol - 768);  rs = 256; }
                else if (bcol < 1280) { ob = p.out + OUT_NDV + (((size_t)tb_ * 2 + l) * SEQ) * 256 + (bcol - 1024); rs = 256; }
                else if (bcol < 1920) { ob = p.out + OUT_NGK + (((size_t)tb_ * 2 + l) * SEQ) * 128;                 rs = 128; }
                else                  { ob = p.out + OUT_NGV + (((size_t)tb_ * 2 + l) * SEQ) * 128;                 rs = 128; }
#pragma unroll 1
                for (int it = 0; it < 16; ++it) {
                    const int item = it * NT + tid, r = item >> 5, c = (item & 31) * 4;
                    *reinterpret_cast<f32x4*>(ob + (size_t)r * rs + c) = *(const LAS f32x4*)(st + r * STG + c);
                }
            }
            if (vtile) {
#pragma unroll 1
                for (int it = 0; it < 2; ++it) {
                    const int item = it * NT + tid, col = item >> 3, run = item & 7;
                    epi_inproj_col(p, brow + run * 32, bcol + col, st + run * 32 * STG + col);
                }
            }
        } else {
#pragma unroll 1
            for (int it = 0; it < 8; ++it) {
                const int item = it * NT + tid, r = item >> 4, c = (item & 15) * 8;
                const f32x4 f0 = *(const LAS f32x4*)(st + r * STG + c), f1 = *(const LAS f32x4*)(st + r * STG + c + 4);
                const int t = brow + r;
                float o[8] = {f0[0], f0[1], f0[2], f0[3], f1[0], f1[1], f1[2], f1[3]};
                if (MODE == EPI_WOUT) {
                    const float* g1 = (const float*)(p.ws + OFF_MOD) + (size_t)(l * 5 + tok_cv(t)) * 6144 + 2048 + bcol + c;
                    const float4 ga = *reinterpret_cast<const float4*>(g1), gb = *reinterpret_cast<const float4*>(g1 + 4);
                    float x[8];
                    if (l == 0) {
                        const float* xr = x_in_row(p, t) + bcol + c;
                        const float4 xa = *reinterpret_cast<const float4*>(xr), xb2 = *reinterpret_cast<const float4*>(xr + 4);
                        x[0] = xa.x; x[1] = xa.y; x[2] = xa.z; x[3] = xa.w; x[4] = xb2.x; x[5] = xb2.y; x[6] = xb2.z; x[7] = xb2.w;
                    } else {
                        const u32x4 xw = *reinterpret_cast<const u32x4*>((const bf16_t*)(p.ws + OFF_XC) + (size_t)t * D + bcol + c);
#pragma unroll
                        for (int k = 0; k < 4; ++k) { x[2 * k] = __uint_as_float(xw[k] << 16); x[2 * k + 1] = __uint_as_float(xw[k] & 0xffff0000u); }
                    }
                    o[0] = x[0] + ga.x * o[0]; o[1] = x[1] + ga.y * o[1]; o[2] = x[2] + ga.z * o[2]; o[3] = x[3] + ga.w * o[3];
                    o[4] = x[4] + gb.x * o[4]; o[5] = x[5] + gb.y * o[5]; o[6] = x[6] + gb.z * o[6]; o[7] = x[7] + gb.w * o[7];
                    const float* gn = p.in[I_N2G] + l * D + bcol + c;
                    const float4 na = *reinterpret_cast<const float4*>(gn), nb = *reinterpret_cast<const float4*>(gn + 4);
                    const float4 sa = *reinterpret_cast<const float4*>(g1 + 2048), sb = *reinterpret_cast<const float4*>(g1 + 2048 + 4);
                    float xg[8] = {o[0] * na.x * (1.f + sa.x), o[1] * na.y * (1.f + sa.y), o[2] * na.z * (1.f + sa.z), o[3] * na.w * (1.f + sa.w),
                                   o[4] * nb.x * (1.f + sb.x), o[5] * nb.y * (1.f + sb.y), o[6] * nb.z * (1.f + sb.z), o[7] * nb.w * (1.f + sb.w)};
                    float ss = 0.f, am = 0.f;
#pragma unroll
                    for (int i = 0; i < 8; ++i) { ss += o[i] * o[i]; am = fmaxf(am, fabsf(xg[i])); }
                    ss = row16_sum(ss); am = row16_max(am);
                    const float sc8 = am > 0.f ? 127.f / am : 1.f;
                    uint2 w8;
                    w8.x = pack4_i8(q8(xg[0] * sc8), q8(xg[1] * sc8), q8(xg[2] * sc8), q8(xg[3] * sc8));
                    w8.y = pack4_i8(q8(xg[4] * sc8), q8(xg[5] * sc8), q8(xg[6] * sc8), q8(xg[7] * sc8));
                    *reinterpret_cast<uint2*>(p.ws + OFF_H8I + (size_t)t * D + bcol + c) = w8;
                    if ((item & 15) == 0) {
                        ((float*)(p.ws + OFF_RSS2))[((size_t)l * NTOK + t) * 8 + pn] = ss;
                        ((float*)(p.ws + OFF_XGS))[(size_t)t * 8 + pn] = am > 0.f ? am * (1.f / 127.f) : 1.f;
                    }
                }
                bf16_t* dst = (bf16_t*)(p.ws + (MODE == EPI_WOUT ? OFF_XC : OFF_Q)) + (size_t)t * D + bcol + c;
                *reinterpret_cast<u32x4*>(dst) = u32x4{pack_bf2(o[0], o[1]), pack_bf2(o[2], o[3]), pack_bf2(o[4], o[5]), pack_bf2(o[6], o[7])};
            }
        }
        __syncthreads();
    }
}


#define MFMA32(a, b, c) __builtin_amdgcn_mfma_f32_32x32x16_bf16((a), (b), (c), 0, 0, 0)
constexpr int ATT_ROWB = 144;
constexpr int ATT_TILEB = 64 * ATT_ROWB;
constexpr int QW_MIX = 4096;

__device__ __forceinline__ bf16x8 pack8(const f32x16& x, int s) {
    const u32x4 w = {pack_bf2(x[8 * s], x[8 * s + 1]), pack_bf2(x[8 * s + 2], x[8 * s + 3]), pack_bf2(x[8 * s + 4], x[8 * s + 5]), pack_bf2(x[8 * s + 6], x[8 * s + 7])};
    return __builtin_bit_cast(bf16x8, w);
}
__device__ __forceinline__ void softmax_tile(f32x16& s0, f32x16& s1, const float sc, float& m, float& l, float& alpha, const int lane) {
    float mx = fmaxf(s0[0], s1[0]);
#pragma unroll
    for (int i = 1; i < 16; ++i) mx = fmaxf(mx, fmaxf(s0[i], s1[i]));
    mx = fmaxf(mx, shfl_x(mx, lane, 32));
    const float mnew = fmaxf(m, mx * sc);
    alpha = __builtin_amdgcn_exp2f(m - mnew);
    m = mnew;
    float ps = 0.f;
#pragma unroll
    for (int i = 0; i < 16; ++i) { s0[i] = __builtin_amdgcn_exp2f(s0[i] * sc - mnew); s1[i] = __builtin_amdgcn_exp2f(s1[i] * sc - mnew); ps += s0[i] + s1[i]; }
    l = l * alpha + ps;
}
__device__ __forceinline__ void v_frags(const LAS unsigned char* vb, bf16x8 (&vf)[8], int r, int hh) {
#pragma unroll
    for (int u = 0; u < 2; ++u)
#pragma unroll
        for (int sk = 0; sk < 2; ++sk)
#pragma unroll
            for (int mt = 0; mt < 2; ++mt) {
                const LAS unsigned char* a = vb + (32 * mt + r) * ATT_ROWB + (32 * u + 16 * sk + 4 * hh) * 2;
                const s16x4 lo = *(const LAS s16x4*)a, hi = *(const LAS s16x4*)(a + 16);
                vf[(u * 2 + sk) * 2 + mt] = bf16x8{lo[0], lo[1], lo[2], lo[3], hi[0], hi[1], hi[2], hi[3]};
            }
}
__device__ __forceinline__ void pv_tile(const bf16x8 (&vf)[8], const f32x16& p0, const f32x16& p1, f32x16 (&O)[2]) {
#pragma unroll
    for (int u = 0; u < 2; ++u)
#pragma unroll
        for (int sk = 0; sk < 2; ++sk) {
            const bf16x8 pf = pack8(u ? p1 : p0, sk);
#pragma unroll
            for (int mt = 0; mt < 2; ++mt) O[mt] = MFMA32(vf[(u * 2 + sk) * 2 + mt], pf, O[mt]);
        }
}

template <bool DIFF>
__device__ __forceinline__ void attn_item(const Params& p, int l, LAS unsigned char* lds, const int tid,
                                          const bf16_t* __restrict__ Qg, const int qstride,
                                          const bf16_t* __restrict__ Kg, const bf16_t* __restrict__ Vtg, const int nk,
                                          bf16_t* __restrict__ Og, const float lam) {
    const int wave = tid >> 6, lane = tid & 63, r = lane & 31, hh = lane >> 5;
    const int lrow = tid >> 3, lchunk = tid & 7;
    LAS unsigned char* kbuf = lds; LAS unsigned char* vbuf = lds + 2 * ATT_TILEB;
    bf16x8 qf[4];
    const bf16_t* qrow = Qg + (size_t)(wave * 32 + r) * qstride;
#pragma unroll
    for (int ks = 0; ks < 4; ++ks) qf[ks] = *reinterpret_cast<const bf16x8*>(qrow + ks * 16 + hh * 8);
    const float sc = (DIFF ? 0.17677669529663687f : 0.125f) * 1.4426950408889634f;
    f32x16 O0[2], O1[2];
#pragma unroll
    for (int mt = 0; mt < 2; ++mt)
#pragma unroll
        for (int i = 0; i < 16; ++i) { O0[mt][i] = 0.f; O1[mt][i] = 0.f; }
    float m0 = -1e30f, l0 = 0.f, m1 = -1e30f, l1 = 0.f;
    const int ntl = nk / 64;
    u32x4 kr, vr, kn, vn;
    kr = *reinterpret_cast<const u32x4*>(Kg + (size_t)lrow * 64 + lchunk * 8);
    vr = *reinterpret_cast<const u32x4*>(Vtg + (size_t)lrow * nk + lchunk * 8);
    *(LAS u32x4*)(kbuf + lrow * ATT_ROWB + lchunk * 16) = kr;
    *(LAS u32x4*)(vbuf + lrow * ATT_ROWB + lchunk * 16) = vr;
    {
        const int t1 = ntl > 1 ? 1 : 0;
        kr = *reinterpret_cast<const u32x4*>(Kg + (size_t)(t1 * 64 + lrow) * 64 + lchunk * 8);
        vr = *reinterpret_cast<const u32x4*>(Vtg + (size_t)lrow * nk + t1 * 64 + lchunk * 8);
    }
    __syncthreads();
    for (int ti = 0; ti < ntl; ++ti) {
        const int cur = ti & 1;
        {
            const int t2 = ti + 2 < ntl ? ti + 2 : ntl - 1;
            kn = *reinterpret_cast<const u32x4*>(Kg + (size_t)(t2 * 64 + lrow) * 64 + lchunk * 8);
            vn = *reinterpret_cast<const u32x4*>(Vtg + (size_t)lrow * nk + t2 * 64 + lchunk * 8);
        }
        const LAS unsigned char* kb = kbuf + cur * ATT_TILEB; const LAS unsigned char* vb = vbuf + cur * ATT_TILEB;
        bf16x8 ka[2][4];
#pragma unroll
        for (int u = 0; u < 2; ++u)
#pragma unroll
            for (int ks = 0; ks < 4; ++ks) ka[u][ks] = *(const LAS bf16x8*)(kb + (32 * u + r) * ATT_ROWB + (ks * 16 + hh * 8) * 2);
        __builtin_amdgcn_sched_barrier(0);
        bf16x8 vf[8];
        if (!DIFF) {
            f32x16 s0, s1;
#pragma unroll
            for (int i = 0; i < 16; ++i) { s0[i] = 0.f; s1[i] = 0.f; }
#pragma unroll
            for (int ks = 0; ks < 4; ++ks) { s0 = MFMA32(ka[0][ks], qf[ks], s0); s1 = MFMA32(ka[1][ks], qf[ks], s1); }
            v_frags(vb, vf, r, hh);
            __builtin_amdgcn_sched_barrier(0);
            float alpha;
            softmax_tile(s0, s1, sc, m0, l0, alpha, lane);
            if (__builtin_amdgcn_ballot_w64(alpha != 1.f) != 0ull) {
#pragma unroll
                for (int mt = 0; mt < 2; ++mt)
#pragma unroll
                    for (int i = 0; i < 16; ++i) O0[mt][i] *= alpha;
            }
            pv_tile(vf, s0, s1, O0);
        } else {
            f32x16 s0, s1, t0, t1;
#pragma unroll
            for (int i = 0; i < 16; ++i) { s0[i] = 0.f; s1[i] = 0.f; t0[i] = 0.f; t1[i] = 0.f; }
#pragma unroll
            for (int ks = 0; ks < 2; ++ks) {
                s0 = MFMA32(ka[0][ks], qf[ks], s0); s1 = MFMA32(ka[1][ks], qf[ks], s1);
                t0 = MFMA32(ka[0][2 + ks], qf[2 + ks], t0); t1 = MFMA32(ka[1][2 + ks], qf[2 + ks], t1);
            }
            v_frags(vb, vf, r, hh);
            __builtin_amdgcn_sched_barrier(0);
            float alpha;
            softmax_tile(s0, s1, sc, m0, l0, alpha, lane);
            if (__builtin_amdgcn_ballot_w64(alpha != 1.f) != 0ull) {
#pragma unroll
                for (int mt = 0; mt < 2; ++mt)
#pragma unroll
                    for (int i = 0; i < 16; ++i) O0[mt][i] *= alpha;
            }
            pv_tile(vf, s0, s1, O0);
            softmax_tile(t0, t1, sc, m1, l1, alpha, lane);
            if (__builtin_amdgcn_ballot_w64(alpha != 1.f) != 0ull) {
#pragma unroll
                for (int mt = 0; mt < 2; ++mt)
#pragma unroll
                    for (int i = 0; i < 16; ++i) O1[mt][i] *= alpha;
            }
            pv_tile(vf, t0, t1, O1);
        }
        if (ti + 1 < ntl) {
            *(LAS u32x4*)(kbuf + (cur ^ 1) * ATT_TILEB + lrow * ATT_ROWB + lchunk * 16) = kr;
            *(LAS u32x4*)(vbuf + (cur ^ 1) * ATT_TILEB + lrow * ATT_ROWB + lchunk * 16) = vr;
        }
        kr = kn; vr = vn;
        __syncthreads();
    }
    l0 += shfl_x(l0, lane, 32);
    const float inv0 = 1.f / l0;
    LAS unsigned char* ob = lds + wave * 4608;
    if (!DIFF) {
#pragma unroll
        for (int mt = 0; mt < 2; ++mt)
#pragma unroll
            for (int g = 0; g < 4; ++g) {
                u32x2 w;
                w[0] = pack_bf2(O0[mt][4 * g] * inv0, O0[mt][4 * g + 1] * inv0);
                w[1] = pack_bf2(O0[mt][4 * g + 2] * inv0, O0[mt][4 * g + 3] * inv0);
                *(LAS u32x2*)(ob + r * 144 + (32 * mt + 8 * g + 4 * hh) * 2) = w;
            }
    } else {
        l1 += shfl_x(l1, lane, 32);
        const float inv1 = lam / l1;
        float ss = 0.f;
#pragma unroll
        for (int mt = 0; mt < 2; ++mt)
#pragma unroll
            for (int i = 0; i < 16; ++i) { const float o = O0[mt][i] * inv0 - O1[mt][i] * inv1; O0[mt][i] = o; ss += o * o; }
        ss += shfl_x(ss, lane, 32);
        const float rr = rsqrtf(ss * (1.f / 64.f) + EPS) * __builtin_bit_cast(float, __builtin_amdgcn_readfirstlane(__builtin_bit_cast(int, 1.f - lam_init_of(l))));
        const float* sg = p.in[I_SUBLN] + l * 64;
#pragma unroll
        for (int mt = 0; mt < 2; ++mt)
#pragma unroll
            for (int g = 0; g < 4; ++g) {
                const int d0 = 32 * mt + 8 * g + 4 * hh;
                const float4 gg = *reinterpret_cast<const float4*>(sg + d0);
                u32x2 w;
                w[0] = pack_bf2(O0[mt][4 * g] * rr * gg.x, O0[mt][4 * g + 1] * rr * gg.y);
                w[1] = pack_bf2(O0[mt][4 * g + 2] * rr * gg.z, O0[mt][4 * g + 3] * rr * gg.w);
                *(LAS u32x2*)(ob + r * 144 + d0 * 2) = w;
            }
    }
#pragma unroll
    for (int ps = 0; ps < 4; ++ps) {
        const int row = ps * 8 + (lane >> 3), ch = lane & 7;
        *reinterpret_cast<u32x4*>(Og + (size_t)(wave * 32 + row) * D + ch * 8) = *(const LAS u32x4*)(ob + row * 144 + ch * 16);
    }
}

namespace ga {
constexpr float C2 = 0.125f * 1.4426950408889634f;
constexpr int SLOTB = 8192, LDS_K = 0, LDS_V = 3 * SLOTB, LDS_WS = 6 * SLOTB, LDS_OST = LDS_WS + 8 * 256;
typedef __attribute__((address_space(3))) const char* lds_cptr;
typedef short v4i16_t __attribute__((ext_vector_type(4)));
using s16x4 = __attribute__((ext_vector_type(4))) short;
__device__ __forceinline__ int crow(int r, int hi) { return (r & 3) + 8 * (r >> 2) + 4 * hi; }
__device__ __forceinline__ void glds16(const void* g, unsigned lds_base) {
    unsigned sv; asm volatile("s_mov_b32 %0, m0\n\ts_mov_b32 m0, %2\n\ts_nop 0\n\tglobal_load_lds_dwordx4 %1, off\n\ts_mov_b32 m0, %0" : "=&s"(sv) : "v"(g), "s"(lds_base) : "memory"); }
__device__ __forceinline__ void kload2(bf16x8* kf, lds_cptr kp, int d0) { kf[2 * d0] = *(const LAS bf16x8*)(kp + d0 * 2048); kf[2 * d0 + 1] = *(const LAS bf16x8*)(kp + d0 * 2048 + 512); }
__device__ __forceinline__ s16x4 vtr(lds_cptr p) { return __builtin_bit_cast(s16x4, __builtin_amdgcn_ds_read_tr16_b64_v4i16((LAS v4i16_t*)p)); }
#define GA_MX3(a, b, c) __builtin_fmaxf(__builtin_fmaxf((a), (b)), (c))
__device__ __forceinline__ float rowmax(const f32x16& p0, const f32x16& p1) {
    float a = GA_MX3(p0[0], p0[1], p1[0]), b = GA_MX3(p0[2], p0[3], p1[1]); a = GA_MX3(a, p1[2], p1[3]);
#pragma unroll
    for (int r = 4; r < 16; r += 4) { a = GA_MX3(a, p0[r], p0[r + 1]); b = GA_MX3(b, p0[r + 2], p0[r + 3]); a = GA_MX3(a, p1[r], p1[r + 1]); b = GA_MX3(b, p1[r + 2], p1[r + 3]); }
    float m = __builtin_fmaxf(a, b); auto rr = __builtin_amdgcn_permlane32_swap(__float_as_uint(m), __float_as_uint(m), false, false);
    return __builtin_fmaxf(__uint_as_float(rr[0]), __uint_as_float(rr[1])); }
}
#define GA_SBAR() __builtin_amdgcn_sched_barrier(0)
#define GA_PIN(x) asm volatile("" : "+v"(x))
#define GA_WAIT_BAR(N) asm volatile("s_waitcnt vmcnt(" #N ") lgkmcnt(0)\n\ts_barrier" ::: "memory")
#define GA_THR 8
__device__ __forceinline__ void gqa_unit(LAS unsigned char* ldsl, const int tid, const int wid, const bf16_t* __restrict__ Qw0, const int qstride,
                                         const unsigned char* __restrict__ Kimg, const unsigned char* __restrict__ Vimg, const int NT, bf16_t* __restrict__ Og) {
    using namespace ga;
    const int lane = tid & 63, r32 = lane & 31, hi = lane >> 5;
    const bf16_t* Qw = Qw0 + (size_t)(wid * 32) * qstride;
    const unsigned lds0 = (unsigned)(size_t)ldsl; LAS float* wsf = (LAS float*)(ldsl + LDS_WS) + wid * 64;
    const unsigned char* ksrc = Kimg + wid * 1024 + lane * 16;
    const unsigned char* vsrc = Vimg + wid * 1024 + lane * 16;
    const unsigned kdst = lds0 + LDS_K + wid * 1024, vdst = lds0 + LDS_V + wid * 1024;
#define DMA_K(t, slot) glds16(ksrc + (size_t)(t) * SLOTB, (unsigned)__builtin_amdgcn_readfirstlane(kdst + (slot)))
#define DMA_V(t, slot) glds16(vsrc + (size_t)(t) * SLOTB, (unsigned)__builtin_amdgcn_readfirstlane(vdst + (slot)))
    const lds_cptr vp0 = (lds_cptr)ldsl + LDS_V + ((lane >> 4) & 1) * 32 + (lane & 3) * 8 + (4 * hi + ((lane & 15) >> 2)) * 64;
    const lds_cptr kp0 = (lds_cptr)ldsl + LDS_K + hi * 1024 + r32 * 16;
    DMA_K(0, 0); DMA_V(0, 0); DMA_K(1, SLOTB);
    bf16x8 qr[4];
#pragma unroll
    for (int d0 = 0; d0 < 4; ++d0) qr[d0] = *reinterpret_cast<const bf16x8*>(&Qw[(size_t)r32 * qstride + d0 * 16 + hi * 8]);
    float mhat = 0.f, l_reg = 0.f; f32x16 o[2];
#pragma unroll
    for (int i = 0; i < 16; ++i) { o[0][i] = 0.f; o[1][i] = 0.f; }
    f32x16 zero16;
#pragma unroll
    for (int i = 0; i < 16; ++i) zero16[i] = 0.f;
    GA_PIN(zero16);
    bool resc = false;
    f32x16 pA0, pA1, pB0, pB1; bf16x8 kf[8]; s16x4 vlo[8], vhi[8]; u32x4 pw0, pw1, pw2, pw3;
    int sl_prev = 0, sl_cur = 0, sl_next = SLOTB;
#define ROT() do { sl_prev = sl_cur; sl_cur = sl_next; sl_next = (sl_next == 2 * SLOTB) ? 0 : sl_next + SLOTB; } while (0)
#define EX(v) __builtin_amdgcn_exp2f(__builtin_fmaf((v), C2, nmh))
#define RESC() do { if (resc) { _Pragma("unroll") for (int d_ = 0; d_ < 2; ++d_) _Pragma("unroll") for (int r = 0; r < 16; ++r) o[d_][r] *= wsf[crow(r, hi)]; } } while (0)
    DMA_K(2, 2 * SLOTB);
    GA_WAIT_BAR(3);
    _Pragma("unroll") for (int d0 = 0; d0 < 4; ++d0) kload2(kf, kp0, d0);
    pA0 = MFMA32(kf[0], qr[0], zero16); pA1 = MFMA32(kf[1], qr[0], zero16); pA0 = MFMA32(kf[2], qr[1], pA0); pA1 = MFMA32(kf[3], qr[1], pA1);
    pA0 = MFMA32(kf[4], qr[2], pA0); pA1 = MFMA32(kf[5], qr[2], pA1); pA0 = MFMA32(kf[6], qr[3], pA0); pA1 = MFMA32(kf[7], qr[3], pA1);
    { const float rm = rowmax(pA0, pA1); mhat = rm * C2; const float nmh = -mhat;
#pragma unroll
      for (int r = 0; r < 16; ++r) { pA0[r] = EX(pA0[r]); pA1[r] = EX(pA1[r]); } }
    GA_WAIT_BAR(0);
    DMA_K(3, 0); DMA_V(1, SLOTB); ROT();
    _Pragma("unroll") for (int d0 = 0; d0 < 4; ++d0) kload2(kf, kp0 + sl_cur, d0);
    GA_WAIT_BAR(2);
#define PKW(P, i) pack_bf2(P[i], P[i + 1])
#define PAF(k) __builtin_bit_cast(bf16x8, pw##k)
#define VFR(i) (bf16x8){vlo[i][0], vlo[i][1], vlo[i][2], vlo[i][3], vhi[i][0], vhi[i][1], vhi[i][2], vhi[i][3]}
#define VRD(i) do { vlo[i] = vtr(vp_ + (((i) >> 2) * 4096 + ((i) & 3) * 1024)); vhi[i] = vtr(vp_ + (((i) >> 2) * 4096 + ((i) & 3) * 1024 + 512)); } while (0)
#define KRD(G, d0) do { if (G) { kload2(kf, kp0 + sl_next, d0); GA_SBAR(); } } while (0)
#define GAPA(MF, a0, a1, a2, a3, W0, W1, PW) do { MF; sacc += a0; sacc += a1; sacc += a2; sacc += a3; W0; W1; GA_PIN(PW); GA_PIN(sacc); GA_SBAR(); } while (0)
#define GAPB(MF, X, i) do { MF; X[i] = EX(X[i]); X[i + 1] = EX(X[i + 1]); X[i + 2] = EX(X[i + 2]); X[i + 3] = EX(X[i + 3]); GA_PIN(X); GA_SBAR(); } while (0)
#define STEP(C0, C1, P0, P1, t, GK, GV, GL) do { GA_SBAR(); \
    const lds_cptr vp_ = vp0 + sl_prev; \
    VRD(0); GA_SBAR(); float sacc = P0[0] + P0[1]; \
                       GAPA(C0 = MFMA32(kf[0], qr[0], zero16), P0[2], P0[3], P0[4], P0[5],     pw0[0] = PKW(P0, 0),  pw0[1] = PKW(P0, 2),  pw0); \
    VRD(4); GA_SBAR(); GAPA(C1 = MFMA32(kf[1], qr[0], zero16), P0[6], P0[7], P0[8], P0[9],     pw0[2] = PKW(P0, 4),  pw0[3] = PKW(P0, 6),  pw0); \
    VRD(1); GA_SBAR(); GAPA(C0 = MFMA32(kf[2], qr[1], C0),    P0[10], P0[11], P0[12], P0[13], pw1[0] = PKW(P0, 8),  pw1[1] = PKW(P0, 10), pw1); \
    VRD(5); GA_SBAR(); GAPA(C1 = MFMA32(kf[3], qr[1], C1),    P0[14], P0[15], P1[0], P1[1],   pw1[2] = PKW(P0, 12), pw1[3] = PKW(P0, 14), pw1); \
    VRD(2); GA_SBAR(); GAPA(C0 = MFMA32(kf[4], qr[2], C0),    P1[2], P1[3], P1[4], P1[5],     pw2[0] = PKW(P1, 0),  pw2[1] = PKW(P1, 2),  pw2); \
    VRD(6); GA_SBAR(); GAPA(C1 = MFMA32(kf[5], qr[2], C1),    P1[6], P1[7], P1[8], P1[9],     pw2[2] = PKW(P1, 4),  pw2[3] = PKW(P1, 6),  pw2); \
    VRD(3); GA_SBAR(); GAPA(C0 = MFMA32(kf[6], qr[3], C0),    P1[10], P1[11], P1[12], P1[13], pw3[0] = PKW(P1, 8),  pw3[1] = PKW(P1, 10), pw3); \
    VRD(7); GA_SBAR(); GAPA(C1 = MFMA32(kf[7], qr[3], C1),    P1[14], P1[15], 0.f, 0.f,       pw3[2] = PKW(P1, 12), pw3[3] = PKW(P1, 14), pw3); \
    l_reg += sacc; \
    if (GK) DMA_K((t) + 3, sl_cur); if (GV) DMA_V((t) + 1, sl_next); \
    { const float rm = __builtin_fmaf(rowmax(C0, C1), C2, -mhat); resc = false; \
      if (__builtin_expect(__any(rm > (float)GA_THR), 0)) { const float dl = __builtin_fmaxf(rm, 0.f); mhat += dl; \
          const float f = __builtin_amdgcn_exp2f(-dl); l_reg *= f; if (hi == 0) wsf[r32] = f; resc = true; } } \
    const float nmh = -mhat; GA_SBAR(); \
    GAPB(o[0] = MFMA32(PAF(0), VFR(0), o[0]), C0, 0);              GAPB(o[1] = MFMA32(PAF(0), VFR(4), o[1]), C0, 4); \
    KRD(GL, 0); GAPB(o[0] = MFMA32(PAF(1), VFR(1), o[0]), C0, 8);  KRD(GL, 1); GAPB(o[1] = MFMA32(PAF(1), VFR(5), o[1]), C0, 12); \
    KRD(GL, 2); GAPB(o[0] = MFMA32(PAF(2), VFR(2), o[0]), C1, 0);  KRD(GL, 3); GAPB(o[1] = MFMA32(PAF(2), VFR(6), o[1]), C1, 4); \
    GAPB(o[0] = MFMA32(PAF(3), VFR(3), o[0]), C1, 8);              GAPB(o[1] = MFMA32(PAF(3), VFR(7), o[1]), C1, 12); \
    } while (0)
    int t = 1;
    for (; t + 5 < NT; t += 2) {
        STEP(pB0, pB1, pA0, pA1, t, true, true, true);     GA_WAIT_BAR(2); RESC(); ROT();
        STEP(pA0, pA1, pB0, pB1, t + 1, true, true, true); GA_WAIT_BAR(2); RESC(); ROT();
    }
#define ENDW(tt) do { if ((tt) + 3 < NT) { GA_WAIT_BAR(2); } else if ((tt) + 2 < NT) { GA_WAIT_BAR(1); } else { GA_WAIT_BAR(0); } } while (0)
    for (; t + 1 < NT; t += 2) {
        STEP(pB0, pB1, pA0, pA1, t, (t + 3 < NT), (t + 1 < NT), (t + 1 < NT));         ENDW(t);     RESC(); ROT();
        STEP(pA0, pA1, pB0, pB1, t + 1, (t + 4 < NT), (t + 2 < NT), (t + 2 < NT));     ENDW(t + 1); RESC(); ROT();
    }
    STEP(pB0, pB1, pA0, pA1, NT - 1, false, false, false); RESC();
    { float sacc = pB0[0] + pB0[1];
#pragma unroll
      for (int r = 2; r < 16; ++r) sacc += pB0[r];
#pragma unroll
      for (int r = 0; r < 16; ++r) sacc += pB1[r];
      l_reg += sacc;
      pw0 = (u32x4){PKW(pB0, 0), PKW(pB0, 2), PKW(pB0, 4), PKW(pB0, 6)}; pw1 = (u32x4){PKW(pB0, 8), PKW(pB0, 10), PKW(pB0, 12), PKW(pB0, 14)};
      pw2 = (u32x4){PKW(pB1, 0), PKW(pB1, 2), PKW(pB1, 4), PKW(pB1, 6)}; pw3 = (u32x4){PKW(pB1, 8), PKW(pB1, 10), PKW(pB1, 12), PKW(pB1, 14)};
      const lds_cptr vp_ = vp0 + sl_cur; _Pragma("unroll") for (int i = 0; i < 8; ++i) VRD(i);
      o[0] = MFMA32(PAF(0), VFR(0), o[0]); o[1] = MFMA32(PAF(0), VFR(4), o[1]); o[0] = MFMA32(PAF(1), VFR(1), o[0]); o[1] = MFMA32(PAF(1), VFR(5), o[1]);
      o[0] = MFMA32(PAF(2), VFR(2), o[0]); o[1] = MFMA32(PAF(2), VFR(6), o[1]); o[0] = MFMA32(PAF(3), VFR(3), o[0]); o[1] = MFMA32(PAF(3), VFR(7), o[1]); }
    { auto rr = __builtin_amdgcn_permlane32_swap(__float_as_uint(l_reg), __float_as_uint(l_reg), false, false); l_reg = __uint_as_float(rr[0]) + __uint_as_float(rr[1]); }
    if (hi == 0) wsf[32 + r32] = l_reg;
    asm volatile("s_waitcnt lgkmcnt(0)" ::: "memory");
    float rli[16];
#pragma unroll
    for (int r = 0; r < 16; ++r) rli[r] = __builtin_amdgcn_rcpf(wsf[32 + crow(r, hi)]);
    bf16_t* Ow = Og + (size_t)(wid * 32) * D; LAS bf16_t* stg = (LAS bf16_t*)(ldsl + LDS_OST) + wid * 2048;
#pragma unroll
    for (int r = 0; r < 16; ++r) { const int orow = crow(r, hi);
#pragma unroll
        for (int d0 = 0; d0 < 2; ++d0) stg[orow * 64 + d0 * 32 + r32] = f2bf(o[d0][r] * rli[r]); }
    asm volatile("s_waitcnt lgkmcnt(0)" ::: "memory");
#pragma unroll
    for (int i = 0; i < 4; ++i) { const int row = i * 8 + (lane >> 3), ch = lane & 7; *reinterpret_cast<u32x4*>(Ow + (size_t)row * D + ch * 8) = *(const LAS u32x4*)(stg + row * 64 + ch * 8); }
    asm volatile("s_waitcnt lgkmcnt(0)\n\ts_barrier" ::: "memory");
#undef DMA_K
#undef DMA_V
#undef ROT
#undef EX
#undef RESC
#undef PKW
#undef PAF
#undef VFR
#undef VRD
#undef KRD
#undef ENDW
#undef GAPA
#undef GAPB
#undef STEP
}

constexpr int SGU_ROWB = 272;
__device__ __forceinline__ void sgu_item(const Params& p, int l, LAS unsigned char* lds, const int tid, const int t0) {
    const bf16_t* AV = (const bf16_t*)(p.ws + OFF_AV) + (size_t)t0 * 256;
    {
        const int q = tid >> 2, quarter = tid & 3;
        float v[64]; float ss = 0.f;
#pragma unroll
        for (int i = 0; i < 8; ++i) {
            const bf16x8 w = *reinterpret_cast<const bf16x8*>(AV + (size_t)q * 256 + quarter * 64 + i * 8);
#pragma unroll
            for (int j = 0; j < 8; ++j) { v[i * 8 + j] = bf2f((bf16_t)w[j]); ss += v[i * 8 + j] * v[i * 8 + j]; }
        }
        { const int ln = tid & 63; ss += shfl_x(ss, ln, 1); ss += shfl_x(ss, ln, 2); }
        const float rstd = rsqrtf(ss * (1.f / 256.f) + EPS);
        const float* g = p.in[I_SGUNG] + l * 256 + quarter * 64;
#pragma unroll
        for (int i = 0; i < 64; ++i)
            *(LAS bf16_t*)(lds + (quarter * 64 + i) * SGU_ROWB + q * 2) = f2bf(v[i] * rstd * g[i]);
    }
    __syncthreads();
    {
        const int wave = tid >> 6, lane = tid & 63, r = lane & 31, hh = lane >> 5;
        const int g = wave >> 1, ph = wave & 1;
        const bf16_t* W = (const bf16_t*)(p.ws + OFF_SGUW) + ((size_t)l * 4 + g) * 128 * 128;
        f32x16 acc[2][2];
#pragma unroll
        for (int a = 0; a < 2; ++a)
#pragma unroll
            for (int b = 0; b < 2; ++b)
#pragma unroll
                for (int i = 0; i < 16; ++i) acc[a][b][i] = 0.f;
#pragma unroll
        for (int ks = 0; ks < 8; ++ks) {
            bf16x8 af[2], bfr[2];
#pragma unroll
            for (int pt = 0; pt < 2; ++pt) af[pt] = *reinterpret_cast<const bf16x8*>(W + (size_t)(ph * 64 + pt * 32 + r) * 128 + ks * 16 + hh * 8);
#pragma unroll
            for (int ct = 0; ct < 2; ++ct) bfr[ct] = *(const LAS bf16x8*)(lds + (g * 64 + ct * 32 + r) * SGU_ROWB + (ks * 16 + hh * 8) * 2);
#pragma unroll
            for (int pt = 0; pt < 2; ++pt)
#pragma unroll
                for (int ct = 0; ct < 2; ++ct) acc[pt][ct] = MFMA32(af[pt], bfr[ct], acc[pt][ct]);
        }
        const float* bias = p.in[I_SGUB] + (l * 4 + g) * 128;
        const bf16_t* AU = (const bf16_t*)(p.ws + OFF_AU);
        bf16_t* MIX = (bf16_t*)(p.ws + OFF_MIX);
#pragma unroll
        for (int pt = 0; pt < 2; ++pt)
#pragma unroll
            for (int ct = 0; ct < 2; ++ct)
#pragma unroll
                for (int i = 0; i < 16; ++i) {
                    const int pp = ph * 64 + pt * 32 + (i & 3) + 8 * (i >> 2) + 4 * hh, c = g * 64 + ct * 32 + r;
                    const float au = bf2f(AU[(size_t)(t0 + pp) * 256 + c]);
                    MIX[(size_t)(t0 + pp) * D + c] = f2bf(au * (acc[pt][ct][i] + bias[pp]));
                }
    }
    __syncthreads();
}

__device__ void ph_mixers(const Params& p, int lq, unsigned char* ldsraw, const int wv) {
    const int l = lq & 1;
    const int tid0 = opaque_tid(wv);
    LAS unsigned char* lds = (LAS unsigned char*)ldsraw;
    volatile LAS int* qslot = (volatile LAS int*)(ldsraw - LDS_HDR + 64);
    unsigned* qw = (unsigned*)(p.ws + OFF_BAR) + QW_MIX + lq;
    const float lam = __builtin_bit_cast(float, __builtin_amdgcn_readfirstlane(__builtin_bit_cast(int, lam_of(p, l))));
    unsigned char* ws = p.ws;
    for (;;) {
        if (tid0 == 0) *qslot = (int)atomicAdd(qw, 1u);
        __syncthreads();
        const int item = *qslot;
        __syncthreads();
        if (item >= 896) break;
        if (lq >= 2 && PROBE_DUP >= 10) {
            const int cls = item < 128 ? 10 : (item < 384 ? 11 : 12);
            if (cls != PROBE_DUP) continue;
        }
        int tid = tid0; asm volatile("" : "+v"(tid));
        if (item < 128) {
            const int qc = item & 7, h = (item >> 3) & 3, b = item >> 5;
            const int t0 = NPT + b * DSEQ + qc * 256;
            attn_item<true>(p, l, lds, tid, (const bf16_t*)(ws + OFF_DQ) + (size_t)t0 * 256 + h * 64, 256,
                            (const bf16_t*)(ws + OFF_DKS) + ((size_t)b * 4 + h) * NKS * 64, (const bf16_t*)(ws + OFF_DVTS) + ((size_t)b * 4 + h) * 64 * NKS, NKS,
                            (bf16_t*)(ws + OFF_MIX) + (size_t)t0 * D + 256 + h * 64, lam);
        } else if (item < 384) {
            const int it = item - 128, qc = it & 7, hq = (it >> 3) & 7, b = it >> 6, kv = hq >> 2;
            const int t0 = NPT + b * DSEQ + qc * 256;
            gqa_unit(lds, tid, wv, (const bf16_t*)(ws + OFF_GQ) + (size_t)t0 * 512 + hq * 64, 512,
                     ws + OFF_GKS + ((size_t)b * 2 + kv) * NKS * 128, ws + OFF_GVTS + ((size_t)b * 2 + kv) * NKS * 128, NKS / 64,
                     (bf16_t*)(ws + OFF_MIX) + (size_t)t0 * D + 512 + hq * 64);
        } else if (item < 512) {
            sgu_item(p, l, lds, tid, (item - 384) * 128);
        } else if (item < 768) {
            const int it = item - 512, hq = it & 7, b = it >> 3, kv = hq >> 2;
            const int t0 = b * SEQ;
            gqa_unit(lds, tid, wv, (const bf16_t*)(ws + OFF_GQ) + (size_t)t0 * 512 + hq * 64, 512,
                     ws + OFF_GKP + ((size_t)b * 2 + kv) * SEQ * 128, ws + OFF_GVTP + ((size_t)b * 2 + kv) * SEQ * 128, SEQ / 64,
                     (bf16_t*)(ws + OFF_MIX) + (size_t)t0 * D + 512 + hq * 64);
        } else {
            const int it = item - 768, h = it & 3, b = it >> 2;
            const int t0 = b * SEQ;
            attn_item<true>(p, l, lds, tid, (const bf16_t*)(ws + OFF_DQ) + (size_t)t0 * 256 + h * 64, 256,
                            (const bf16_t*)(ws + OFF_DKP) + ((size_t)b * 4 + h) * SEQ * 64, (const bf16_t*)(ws + OFF_DVTP) + ((size_t)b * 4 + h) * 64 * SEQ, SEQ,
                            (bf16_t*)(ws + OFF_MIX) + (size_t)t0 * D + 256 + h * 64, lam);
        }
    }
}


using bf16x2 = __attribute__((ext_vector_type(2))) __bf16;
__device__ __forceinline__ float dot2bf(unsigned a, unsigned b, float c) {
    return __builtin_amdgcn_fdot2_f32_bf16(__builtin_bit_cast(bf16x2, a), __builtin_bit_cast(bf16x2, b), c, false);
}
template <int W>
__device__ __forceinline__ void bfly_stage(float (&part)[64], const int lane) {
    const bool hi = (lane & W) != 0;
#pragma unroll
    for (int k = 0; k < W; ++k) {
        const float keep = hi ? part[k + W] : part[k];
        const float send = hi ? part[k] : part[k + W];
        part[k] = keep + shfl_x(send, lane, W);
    }
}
constexpr int QW_PEER = 4160;
template <int W>
__device__ __forceinline__ void bfly16_stage(float (&v)[16], const int lane, const int bit) {
    const bool hi = (lane & bit) != 0;
#pragma unroll
    for (int k = 0; k < W; ++k) {
        const float keep = hi ? v[k + W] : v[k];
        const float send = hi ? v[k] : v[k + W];
        v[k] = keep + shfl_x(send, lane, bit);
    }
}
template <int W>
__device__ __forceinline__ void bfly16i_stage(int (&v)[16], const int lane, const int bit) {
    const bool hi = (lane & bit) != 0;
#pragma unroll
    for (int k = 0; k < W; ++k) {
        const int keep = hi ? v[k + W] : v[k];
        const int send = hi ? v[k] : v[k + W];
        v[k] = keep + shfl_x(send, lane, bit);
    }
}
template <bool VSIDE> struct PeerTok {
    static __device__ __forceinline__ void issue(const Params& p, const unsigned char* Tslice, const int elo, const int ehi, const int t, const int s,
                                                 const int sub, const int c16, u32x4 (&a)[16], u32x4 (&h)[2]) {
#pragma unroll
        for (int i = 0; i < 16; ++i) {
            const int e = shfl_i(i < 8 ? elo : ehi, (i * 8 + sub) & 63);
            a[i] = *reinterpret_cast<const u32x4*>(Tslice + (((unsigned)e << 7) + (unsigned)c16 * 16u));
        }
        if (!VSIDE) h[0] = *reinterpret_cast<const u32x4*>(p.ws + OFF_H8I + (size_t)t * D + s * 128 + c16 * 16);
    }
    static __device__ __forceinline__ void compute(const Params& p, const int l, const u32x4 w4, const float wsc, const int t, const int s,
                                                   const int lane, const int sub, const int c16, const u32x4 (&a)[16], const u32x4 (&h)[2]) {
        if (!VSIDE) {
            int d[16];
#pragma unroll
            for (int i = 0; i < 16; ++i) {
                int acc = 0;
#pragma unroll
                for (int k = 0; k < 4; ++k) acc = __builtin_amdgcn_sdot4((int)a[i][k], (int)h[0][k], acc, false);
                d[i] = acc;
            }
            bfly16i_stage<8>(d, lane, 4); bfly16i_stage<4>(d, lane, 2); bfly16i_stage<2>(d, lane, 1);
            const int i0 = ((lane & 4) << 1) + ((lane & 2) << 1) + ((lane & 1) << 1);
            int* PART = (int*)(p.ws + OFF_PART) + ((size_t)s * NTOK + t) * 128 + sub * 16 + i0;
            *reinterpret_cast<int2*>(PART) = make_int2(d[0], d[1]);
        } else {
            int acc[16];
#pragma unroll
            for (int i = 0; i < 16; ++i) acc[i] = 0;
#pragma unroll
            for (int g = 0; g < 4; ++g) {
                const int wg = (int)w4[g];
#pragma unroll
                for (int k = 0; k < 4; ++k) {
                    const unsigned r0 = a[4 * g][k], r1 = a[4 * g + 1][k], r2 = a[4 * g + 2][k], r3 = a[4 * g + 3][k];
                    const unsigned x01l = __builtin_amdgcn_perm(r1, r0, 0x05010400u), x01h = __builtin_amdgcn_perm(r1, r0, 0x07030602u);
                    const unsigned x23l = __builtin_amdgcn_perm(r3, r2, 0x05010400u), x23h = __builtin_amdgcn_perm(r3, r2, 0x07030602u);
                    const unsigned t0 = __builtin_amdgcn_perm(x23l, x01l, 0x05040100u), t1 = __builtin_amdgcn_perm(x23l, x01l, 0x07060302u);
                    const unsigned t2 = __builtin_amdgcn_perm(x23h, x01h, 0x05040100u), t3 = __builtin_amdgcn_perm(x23h, x01h, 0x07060302u);
                    acc[4 * k]     = __builtin_amdgcn_sdot4((int)t0, wg, acc[4 * k], false);
                    acc[4 * k + 1] = __builtin_amdgcn_sdot4((int)t1, wg, acc[4 * k + 1], false);
                    acc[4 * k + 2] = __builtin_amdgcn_sdot4((int)t2, wg, acc[4 * k + 2], false);
                    acc[4 * k + 3] = __builtin_amdgcn_sdot4((int)t3, wg, acc[4 * k + 3], false);
                }
            }
            bfly16i_stage<8>(acc, lane, 32); bfly16i_stage<4>(acc, lane, 16); bfly16i_stage<2>(acc, lane, 8);
            const int col = s * 128 + c16 * 16 + ((lane & 32) >> 2) + ((lane & 16) >> 2) + ((lane & 8) >> 2);
            const float* g2 = (const float*)(p.ws + OFF_MOD) + (size_t)(l * 5 + tok_cv(t)) * 6144 + 5 * 1024 + col;
            unsigned* XC = reinterpret_cast<unsigned*>((bf16_t*)(p.ws + OFF_XC) + (size_t)t * D + col);
            const unsigned x = *XC; const float2 g = *reinterpret_cast<const float2*>(g2);
            const float xa = __uint_as_float(x << 16) + g.x * wsc * (float)acc[0], xb = __uint_as_float(x & 0xffff0000u) + g.y * wsc * (float)acc[1];
            *XC = pack_bf2(xa, xb);
            if (l == 0) {
                const float ss = wave_sum(xa * xa + xb * xb);
                if (lane == 0) ((float*)(p.ws + OFF_RSS1))[(size_t)t * 8 + s] = ss;
            }
        }
    }
};
template <bool VSIDE>
__device__ __forceinline__ void peer_slice_stream(const Params& p, const int l, const int s, const int first, const int stride, const int lane) {
    const int sub = lane >> 3, c16 = lane & 7;
    const unsigned char* Ts = p.ws + (VSIDE ? OFF_VT : OFF_UT) + ((size_t)l * 8 + s) * NEXP * 128;
    const int* EIb = (const int*)(p.ws + OFF_EIDX); const unsigned char* WPb = p.ws + OFF_WPAIR; const float* WSb = (const float*)(p.ws + OFF_WSC);
    if (first >= NTOK) return;
    const int cnt = (NTOK - first + stride - 1) / stride;
#define PEER_LOADE(k, elo, ehi, w4, wsc) do { const int _t = min(first + (k) * stride, NTOK - 1); \
        elo = EIb[(size_t)_t * 128 + lane]; ehi = EIb[(size_t)_t * 128 + 64 + lane]; \
        if (VSIDE) { w4 = *reinterpret_cast<const u32x4*>(WPb + (size_t)_t * 128 + sub * 16); wsc = WSb[_t]; } } while (0)
    int e0l, e0h, e1l, e1h, e2l, e2h;
    u32x4 w0 = {0u, 0u, 0u, 0u}, w1 = {0u, 0u, 0u, 0u}, w2 = {0u, 0u, 0u, 0u}; float s0 = 0.f, s1 = 0.f, s2 = 0.f;
    u32x4 A[16], B[16], hA[2], hB[2];
    PEER_LOADE(0, e0l, e0h, w0, s0);
    PEER_LOADE(1, e1l, e1h, w1, s1);
    PeerTok<VSIDE>::issue(p, Ts, e0l, e0h, first, s, sub, c16, A, hA);
    for (int k = 0; k < cnt; k += 2) {
        const int ta = first + k * stride, tb = min(ta + stride, NTOK - 1), tc = min(ta + 2 * stride, NTOK - 1);
        __builtin_amdgcn_sched_barrier(0);
        PEER_LOADE(k + 2, e2l, e2h, w2, s2);
        PeerTok<VSIDE>::issue(p, Ts, e1l, e1h, tb, s, sub, c16, B, hB);
        __builtin_amdgcn_sched_barrier(0);
        PeerTok<VSIDE>::compute(p, l, w0, s0, ta, s, lane, sub, c16, A, hA);
        __builtin_amdgcn_sched_barrier(0);
        e0l = e2l; e0h = e2h; w0 = w2; s0 = s2;
        PEER_LOADE(k + 3, e2l, e2h, w2, s2);
        PeerTok<VSIDE>::issue(p, Ts, e0l, e0h, tc, s, sub, c16, A, hA);
        __builtin_amdgcn_sched_barrier(0);
        if (k + 1 < cnt) PeerTok<VSIDE>::compute(p, l, w1, s1, tb, s, lane, sub, c16, B, hB);
        e1l = e2l; e1h = e2h; w1 = w2; s1 = s2;
    }
#undef PEER_LOADE
}
template <bool VSIDE>
__device__ void ph_peer_sliced(const Params& p, int l, unsigned char* ldsraw, const int wv) {
    const int tid = opaque_tid(wv);
    const int wave = tid >> 6, lane = tid & 63;
    volatile LAS int* hdr = (volatile LAS int*)(ldsraw - LDS_HDR);
    unsigned* bar = (unsigned*)(p.ws + OFF_BAR);
    const int myx = (int)(xb_xcc_id() & 15u);
    if (tid == 0) hdr[16] = (int)atomicAdd(bar + QW_PEER + (l * 2 + (VSIDE ? 1 : 0)) * 16 + myx, 1u);
    __syncthreads();
    const int rank = hdr[16], nloc = (int)hdr[0];
    __syncthreads();
    if (myx < 8) peer_slice_stream<VSIDE>(p, l, myx, rank * 8 + wave, nloc * 8, lane);
    for (int j = 0; j < 8; ++j) {
        if (xb_ld(&bar[XB_XCNT(j)]) == 0u) peer_slice_stream<VSIDE>(p, l, j, (int)blockIdx.x * 8 + wave, (int)gridDim.x * 8, lane);
    }
}
__device__ void ph_peer_pairw(const Params& p, int l, const int wv) {
    const int tid = opaque_tid(wv);
    const int lane = tid & 63;
    const float* USC = (const float*)(p.ws + OFF_USC) + l * NEXP; const float* VSC = (const float*)(p.ws + OFF_VSC) + l * NEXP;
    const int* PART = (const int*)(p.ws + OFF_PART);
    for (size_t i4 = GTID; i4 < (size_t)NTOK * 32; i4 += GNT) {
        const size_t idx = i4 * 4;
        const int t = (int)(idx >> 7), pp = (int)(idx & 127), sub = pp >> 4, i = pp & 15;
        int4 ps[8];
#pragma unroll
        for (int s = 0; s < 8; ++s) ps[s] = *reinterpret_cast<const int4*>(PART + (size_t)s * NTOK * 128 + idx);
        int e[4]; float g[4];
#pragma unroll
        for (int q = 0; q < 4; ++q) {
            const int j = (i + q) * 8 + sub;
            e[q] = ((const int*)(p.ws + OFF_EIDX))[(size_t)t * 128 + j]; g[q] = ((const float*)(p.ws + OFF_EGATE))[(size_t)t * 128 + j];
        }
        const float* rp = (const float*)(p.ws + OFF_RSS2) + ((size_t)l * NTOK + t) * 8;
        const float4 ra = *reinterpret_cast<const float4*>(rp), rb = *reinterpret_cast<const float4*>(rp + 4);
        const float hs = rsqrtf((((ra.x + ra.y) + (ra.z + ra.w)) + ((rb.x + rb.y) + (rb.z + rb.w))) * (1.f / D) + EPS);
        const float* xp = (const float*)(p.ws + OFF_XGS) + (size_t)t * 8;
        const float4 xa = *reinterpret_cast<const float4*>(xp), xb = *reinterpret_cast<const float4*>(xp + 4);
        const float xs[8] = {xa.x, xa.y, xa.z, xa.w, xb.x, xb.y, xb.z, xb.w};
        float sm[4] = {0.f, 0.f, 0.f, 0.f};
#pragma unroll
        for (int s = 0; s < 8; ++s) { sm[0] += xs[s] * (float)ps[s].x; sm[1] += xs[s] * (float)ps[s].y; sm[2] += xs[s] * (float)ps[s].z; sm[3] += xs[s] * (float)ps[s].w; }
        const float* USH = (const float*)(p.ws + OFF_USH) + (size_t)(l * 5 + tok_cv(t)) * NEXP;
        float w[4];
#pragma unroll
        for (int q = 0; q < 4; ++q) w[q] = g[q] * gelu_f(sm[q] * (USC[e[q]] * hs) + USH[e[q]]) * VSC[e[q]];
        float am = fmaxf(fmaxf(fabsf(w[0]), fabsf(w[1])), fmaxf(fabsf(w[2]), fabsf(w[3])));
#pragma unroll
        for (int o = 16; o >= 1; o >>= 1) am = fmaxf(am, shfl_x(am, lane, o));
        const float sc = am > 0.f ? 127.f / am : 1.f;
        *reinterpret_cast<unsigned*>(p.ws + OFF_WPAIR + idx) = pack4_i8(q8(w[0] * sc), q8(w[1] * sc), q8(w[2] * sc), q8(w[3] * sc));
        if (pp == 0) ((float*)(p.ws + OFF_WSC))[t] = am > 0.f ? am * (1.f / 127.f) : 1.f;
    }
}

#define CE_DESC(a, b) do { const float _mx = fmaxf((a), (b)); const float _mn = fminf((a), (b)); (a) = _mx; (b) = _mn; } while (0)
__device__ __forceinline__ void sort16_desc(float (&v)[16]) {
#pragma unroll
    for (int k = 2; k <= 16; k <<= 1)
#pragma unroll
        for (int j = k >> 1; j > 0; j >>= 1)
#pragma unroll
            for (int i = 0; i < 16; ++i) {
                const int m = i ^ j;
                if (m > i) { if ((i & k) == 0) CE_DESC(v[i], v[m]); else CE_DESC(v[m], v[i]); }
            }
}
__device__ __forceinline__ void merge_top16(float (&a)[16], const float (&b)[16]) {
#pragma unroll
    for (int i = 0; i < 16; ++i) a[i] = fmaxf(a[i], b[15 - i]);
#pragma unroll
    for (int j = 8; j > 0; j >>= 1)
#pragma unroll
        for (int i = 0; i < 16; ++i) { const int m = i ^ j; if (m > i) CE_DESC(a[i], a[m]); }
}
__device__ __forceinline__ float key_embed(float v, unsigned lowmask, unsigned idxbits) { return __uint_as_float((__float_as_uint(v) & ~lowmask) | idxbits); }

constexpr int SK_ROWB = 144;
__device__ __forceinline__ void peer_stage1(const LAS unsigned char* SK  , const bf16_t* __restrict__ Qrow  ,
                                            const int r, const int hh, float (&out)[16]) {
    bf16x8 qb[4];
#pragma unroll
    for (int ks = 0; ks < 4; ++ks) qb[ks] = *reinterpret_cast<const bf16x8*>(Qrow + ks * 16 + hh * 8);
    float grp[4][16];
#pragma unroll
    for (int mt = 0; mt < 4; ++mt) {
        f32x16 acc;
#pragma unroll
        for (int i = 0; i < 16; ++i) acc[i] = 0.f;
#pragma unroll
        for (int ks = 0; ks < 4; ++ks) {
            const bf16x8 a = *(const LAS bf16x8*)(SK + (mt * 32 + r) * SK_ROWB + (ks * 16 + hh * 8) * 2);
            acc = MFMA32(a, qb[ks], acc);
        }
        const unsigned hx = (unsigned)hh << 2;
#pragma unroll
        for (int i = 0; i < 16; ++i) {
            const unsigned cn = 32u * mt + (i & 3) + 8u * (i >> 2);
            grp[mt][i] = key_embed(acc[i], 127u, (127u - cn) ^ hx);
        }
        sort16_desc(grp[mt]);
    }
    merge_top16(grp[0], grp[1]); merge_top16(grp[2], grp[3]); merge_top16(grp[0], grp[2]);
    float pb[16];
#pragma unroll
    for (int i = 0; i < 16; ++i) pb[i] = shfl_x(grp[0][i], (hh << 5) | r, 32);
    merge_top16(grp[0], pb);
#pragma unroll
    for (int i = 0; i < 16; ++i) out[i] = grp[0][i];
}

__device__ void ph_peer_select(const Params& p, int l, unsigned char* ldsraw, const int wv) {
    const int tid = opaque_tid(wv);
    const int wave = tid >> 6, lane = tid & 63, r = lane & 31, hh = lane >> 5;
    const int gw = blockIdx.x * 8 + wave, nw = gridDim.x * 8;
    LAS unsigned char* skl = (LAS unsigned char*)ldsraw;
    LAS unsigned char* myl = skl + 2 * 128 * SK_ROWB + wave * 2048 + lane * 32;
    {
        const bf16_t* SKg = (const bf16_t*)(p.ws + OFF_SUBK) + (size_t)l * 2 * 128 * 64;
        for (int i = tid; i < 2 * 128 * 8; i += NT) {
            const int row = i >> 3, ch = i & 7;
            *(LAS u32x4*)(skl + row * SK_ROWB + ch * 16) = *reinterpret_cast<const u32x4*>(SKg + (size_t)row * 64 + ch * 8);
        }
        __syncthreads();
    }
    for (int task = gw; task < (NTOK / 32) * 4; task += nw) {
        const int tg = task >> 2, k = task & 3;
        const int t = tg * 32 + r;
        const bf16_t* Qt = (const bf16_t*)(p.ws + OFF_Q) + (size_t)t * D;
        float sv[2][16];
#pragma unroll
        for (int x = 0; x < 2; ++x) {
            float la[16], lb[16];
            peer_stage1(skl + x * 128 * SK_ROWB, Qt + k * 128 + x * 64, r, hh, la);
            peer_stage1(skl + x * 128 * SK_ROWB, Qt + (k + 4) * 128 + x * 64, r, hh, lb);
#pragma unroll
            for (int i = 0; i < 16; ++i) sv[x][i] = hh ? lb[i] : la[i];
        }
        {
            unsigned w[8];
#pragma unroll
            for (int q = 0; q < 8; ++q) {
                w[q] = 0u;
#pragma unroll
                for (int b = 0; b < 4; ++b) {
                    const int i = q * 4 + b;
                    const unsigned key = __float_as_uint(i < 16 ? sv[0][i] : sv[1][i - 16]);
                    w[q] |= (127u - (key & 127u)) << (8 * b);
                }
            }
            *(LAS u32x4*)(myl) = u32x4{w[0], w[1], w[2], w[3]};
            *(LAS u32x4*)(myl + 16) = u32x4{w[4], w[5], w[6], w[7]};
        }
        float val0[16], val1[16];
#pragma unroll
        for (int i = 0; i < 16; ++i) { val0[i] = __uint_as_float(__float_as_uint(sv[0][i]) & ~127u); val1[i] = __uint_as_float(__float_as_uint(sv[1][i]) & ~127u); }
        float g0[16], g1[16], g2[16], g3[16];
#pragma unroll
        for (int b = 0; b < 16; ++b) g0[b] = key_embed(val0[0] + val1[b], 255u, 255u - (unsigned)b);
#pragma unroll
        for (int b = 0; b < 8; ++b) g1[b] = key_embed(val0[1] + val1[b], 255u, 255u - (16u + b));
#pragma unroll
        for (int b = 0; b < 5; ++b) g1[8 + b] = key_embed(val0[2] + val1[b], 255u, 255u - (32u + b));
#pragma unroll
        for (int b = 0; b < 3; ++b) g1[13 + b] = key_embed(val0[4] + val1[b], 255u, 255u - (64u + b));
#pragma unroll
        for (int b = 0; b < 4; ++b) g2[b] = key_embed(val0[3] + val1[b], 255u, 255u - (48u + b));
#pragma unroll
        for (int a = 5; a < 8; ++a)
#pragma unroll
            for (int b = 0; b < 2; ++b) g2[4 + (a - 5) * 2 + b] = key_embed(val0[a] + val1[b], 255u, 255u - (16u * a + b));
#pragma unroll
        for (int a = 8; a < 14; ++a) g2[10 + (a - 8)] = key_embed(val0[a] + val1[0], 255u, 255u - 16u * a);
        g3[0] = key_embed(val0[14] + val1[0], 255u, 255u - 16u * 14); g3[1] = key_embed(val0[15] + val1[0], 255u, 255u - 16u * 15);
#pragma unroll
        for (int i = 2; i < 16; ++i) g3[i] = -3.0e38f;
        sort16_desc(g1); sort16_desc(g2); sort16_desc(g3);
        merge_top16(g0, g1); merge_top16(g2, g3); merge_top16(g0, g2);
        float gate[16]; int eid[16];
        const float mx = __uint_as_float(__float_as_uint(g0[0]) & ~255u);
        float sum = 0.f;
#pragma unroll
        for (int i = 0; i < 16; ++i) {
            const unsigned key = __float_as_uint(g0[i]);
            gate[i] = __expf(__uint_as_float(key & ~255u) - mx); sum += gate[i];
            const unsigned id = 255u - (key & 255u);
            const unsigned n0 = *(const LAS unsigned char*)(myl + (id >> 4));
            const unsigned n1 = *(const LAS unsigned char*)(myl + 16 + (id & 15u));
            eid[i] = (int)(n0 * 128u + n1);
        }
        const float inv = 1.f / sum;
        const int h = k + 4 * hh;
        int* EI = (int*)(p.ws + OFF_EIDX) + (size_t)t * 128 + h * 16; float* EG = (float*)(p.ws + OFF_EGATE) + (size_t)t * 128 + h * 16;
#pragma unroll
        for (int q = 0; q < 4; ++q) {
            *reinterpret_cast<int4*>(EI + q * 4) = make_int4(eid[q * 4], eid[q * 4 + 1], eid[q * 4 + 2], eid[q * 4 + 3]);
            *reinterpret_cast<float4*>(EG + q * 4) = make_float4(gate[q * 4] * inv, gate[q * 4 + 1] * inv, gate[q * 4 + 2] * inv, gate[q * 4 + 3] * inv);
        }
    }
}

constexpr int LDS_BYTES = LDS_HDR + 3 * 48 * 1024;
__global__ void __launch_bounds__(NT, 2) mk_fwd(Params p) {
    extern __shared__ __attribute__((aligned(16))) unsigned char lds[];
    const int wv = __builtin_amdgcn_readfirstlane((int)(threadIdx.x >> 6));
    volatile LAS unsigned* st = (volatile LAS unsigned*)lds;
    if (threadIdx.x < 4) st[threadIdx.x] = 0u;
    __syncthreads();
    XcdBarrier xb = xcd_barrier_post((unsigned*)(p.ws + OFF_BAR), st);
    int bar_idx = 0;
#define GRID_BAR() do { xcd_barrier(xb); \
        if (PROBE_TS >= 0 && blockIdx.x == 0 && threadIdx.x == 0 && (bar_idx == PROBE_TS - 1 || bar_idx == PROBE_TS)) \
            ((volatile LAS unsigned long long*)(lds + 128))[bar_idx - (PROBE_TS - 1)] = __builtin_amdgcn_s_memrealtime(); \
        ++bar_idx; } while (0)
    if (PROBE_TS == 0 && blockIdx.x == 0 && threadIdx.x == 0) ((volatile LAS unsigned long long*)(lds + 128))[0] = __builtin_amdgcn_s_memrealtime();
    unsigned char* ws = p.ws;
    for (int rep = 0; rep < (PROBE_DUP == 1 ? 2 : 1); ++rep) {
    for (int l = 0; l < 2; ++l) {
        ph_transpose(p.in[I_WIN] + (size_t)l * D * INW, (bf16_t*)(ws + OFF_WIN) + (size_t)l * INW * D, D, INW, lds + LDS_HDR, wv);
        ph_transpose(p.in[I_WOUT] + (size_t)l * D * D, (bf16_t*)(ws + OFF_WOUT) + (size_t)l * D * D, D, D, lds + LDS_HDR, wv);
        ph_transpose(p.in[I_WQ] + (size_t)l * D * D, (bf16_t*)(ws + OFF_WQ) + (size_t)l * D * D, D, D, lds + LDS_HDR, wv);
    }
    ph_convert_i8_rows(p.in[I_PU], ws + OFF_UT, (float*)(ws + OFF_USC), 2 * NEXP, wv);
    ph_convert_i8_rows(p.in[I_PV], ws + OFF_VT, (float*)(ws + OFF_VSC), 2 * NEXP, wv);
    ph_convert(p.in[I_SUBK], (bf16_t*)(ws + OFF_SUBK), 2 * 2 * 128 * 64, wv);
    ph_convert(p.in[I_SGUW], (bf16_t*)(ws + OFF_SGUW), 2 * 4 * 128 * 128, wv);
    ph_mod(p, lds + LDS_HDR, wv);
    ph_rope_tab(p, wv);
    GRID_BAR();
    }
    for (int l = 0; l < 2; ++l) {
        for (int rep = 0; rep < (PROBE_DUP == 3 ? 2 : 1); ++rep) {
        if (l == 0) {
            ph_norm_mod(p, 0, 0, 1, wv);
            ph_cache_prep(p, 0, wv);
            ph_fold_tables(p, lds + LDS_HDR, wv);
            GRID_BAR();
        }
        }
        for (int rep = 0; rep < (PROBE_DUP == 5 ? 2 : 1); ++rep) {
        if (l == 0) gemm_phase<EPI_INPROJ>(p, 0, (const bf16_t*)(ws + OFF_H), (const bf16_t*)(ws + OFF_WIN), INW, lds + LDS_HDR, wv);
        else {
            ph_cache_prep(p, 1, wv);
            gemm_phase<EPI_INPROJ>(p, 1, (const bf16_t*)(ws + OFF_XC), (const bf16_t*)(ws + OFF_WINS), INW, lds + LDS_HDR, wv,
                                   (size_t)INW * D, (const float*)(ws + OFF_RSS1), (const float*)(ws + OFF_BIN));
        }
        GRID_BAR();
        }
        for (int rep = 0; rep < ((PROBE_DUP == 4 || (PROBE_DUP >= 10 && PROBE_DUP <= 12)) ? 2 : 1); ++rep) {
        ph_mixers(p, l + 2 * rep, lds + LDS_HDR, wv);
        GRID_BAR();
        }
        gemm_phase<EPI_WOUT>(p, l, (const bf16_t*)(ws + OFF_MIX), (const bf16_t*)(ws + OFF_WOUT) + (size_t)l * D * D, D, lds + LDS_HDR, wv);
        GRID_BAR();
        for (int rep = 0; rep < (PROBE_DUP == 7 ? 2 : 1); ++rep) {
        gemm_phase<EPI_WQ>(p, l, (const bf16_t*)(ws + OFF_XC), (const bf16_t*)(ws + OFF_WQS) + (size_t)l * 5 * D * D, D, lds + LDS_HDR, wv,
                           (size_t)D * D, (const float*)(ws + OFF_RSS2) + (size_t)l * NTOK * 8, (const float*)(ws + OFF_BQ) + (size_t)l * 5 * D);
        GRID_BAR();
        }
        if (PROBE_DUP == 8) { for (int rep = 0; rep < 10; ++rep) GRID_BAR(); }
        for (int rep = 0; rep < (PROBE_DUP == 2 ? 2 : 1); ++rep) {
        ph_peer_select(p, l, lds + LDS_HDR, wv);
        GRID_BAR();
        }
        ph_peer_sliced<false>(p, l, lds + LDS_HDR, wv);
        GRID_BAR();
        ph_peer_pairw(p, l, wv);
        GRID_BAR();
        ph_peer_sliced<true>(p, l, lds + LDS_HDR, wv);
        GRID_BAR();
    }
    ph_final_norm(p, wv);
    if (PROBE_TS >= 0 && blockIdx.x == 0 && threadIdx.x == 0) {
        asm volatile("s_waitcnt vmcnt(0)" ::: "memory");
        volatile LAS unsigned long long* tsl = (volatile LAS unsigned long long*)(lds + 128);
        p.out[0] += (float)(tsl[1] - tsl[0]) * 0.01f;
    }
}

extern "C" void kernel_launch(void* const* d_in, const int* in_sizes, int n_in,
                              void* d_out, int out_size, void* d_ws, size_t ws_size,
                              hipStream_t stream) {
    static int grid = 0;
    if (grid == 0) {
        if (ws_size < WS_NEED) { fprintf(stderr, "kernel_launch: workspace too small: %zu < %zu\n", ws_size, (size_t)WS_NEED); grid = -1; return; }
        int dev = 0, cus = 0, per_cu = 0;
        (void)hipGetDevice(&dev);
        (void)hipDeviceGetAttribute(&cus, hipDeviceAttributeMultiprocessorCount, dev);
        (void)hipFuncSetAttribute((const void*)mk_fwd, hipFuncAttributeMaxDynamicSharedMemorySize, LDS_BYTES);
        (void)hipOccupancyMaxActiveBlocksPerMultiprocessor(&per_cu, (const void*)mk_fwd, NT, LDS_BYTES);
        if (per_cu < 1) { fprintf(stderr, "kernel_launch: occupancy query reports %d blocks per CU\n", per_cu); grid = -1; return; }
        grid = cus;
    }
    if (grid < 0) return;
    (void)hipMemsetAsync((unsigned char*)d_ws + OFF_BAR, 0, 64 * 1024, stream);
    Params p{};
    for (int i = 0; i < 29; ++i) p.in[i] = (const float*)d_in[i];
    p.out = (float*)d_out; p.ws = (unsigned char*)d_ws;
    void* args[] = {&p};
    hipError_t e = hipLaunchCooperativeKernel((const void*)mk_fwd, dim3(grid), dim3(NT), args, LDS_BYTES, stream);
    if (e != hipSuccess) fprintf(stderr, "kernel_launch: cooperative launch failed: %s (grid %d)\n", hipGetErrorString(e), grid);
}
```

```cpp
#include <hip/hip_runtime.h>
#include <hip/hip_bf16.h>
#include <cstdio>
#include <cstdint>
#include <hip/hip_cooperative_groups.h>
namespace cg = cooperative_groups;

#define PROBE_DUP 0
#define PROBE_TS -1
typedef unsigned short bf16_t;
using bf16x8 = __attribute__((ext_vector_type(8))) short;
using f32x4  = __attribute__((ext_vector_type(4))) float;
using f32x16 = __attribute__((ext_vector_type(16))) float;
using f32x2  = __attribute__((ext_vector_type(2))) float;
using u32x4  = __attribute__((ext_vector_type(4))) unsigned;
using u32x2  = __attribute__((ext_vector_type(2))) unsigned;
using s16x4  = __attribute__((ext_vector_type(4))) short;

constexpr int D      = 1024;
constexpr int NTOK   = 16384;
constexpr int NPT    = 8192;
constexpr int SEQ    = 256;
constexpr int DSEQ   = 2048;
constexpr int PAST   = 512;
constexpr int NKS    = DSEQ + PAST;
constexpr int INW    = 2048;
constexpr int NEXP   = 16384;
constexpr float EPS  = 1e-6f;

constexpr size_t MB = 1024 * 1024;
constexpr size_t OFF_BAR   = 0;
constexpr size_t OFF_MOD   = 64 * 1024;
constexpr size_t OFF_ROPE  = OFF_MOD + 256 * 1024;
constexpr size_t OFF_SUBK  = OFF_ROPE + 1 * MB;
constexpr size_t OFF_SGUW  = OFF_SUBK + 64 * 1024;
constexpr size_t OFF_WIN   = OFF_SGUW + 256 * 1024;
constexpr size_t OFF_WOUT  = OFF_WIN + 8 * MB;
constexpr size_t OFF_WQ    = OFF_WOUT + 4 * MB;
constexpr size_t OFF_UT    = OFF_WQ + 4 * MB;
constexpr size_t OFF_USC   = OFF_UT + 32 * MB;
constexpr size_t OFF_VT    = OFF_UT + 64 * MB;
constexpr size_t OFF_VSC   = OFF_VT + 32 * MB;
constexpr size_t OFF_H     = OFF_VT + 64 * MB;
constexpr size_t OFF_XC    = OFF_H + 32 * MB;
constexpr size_t OFF_R1    = OFF_XC + 64 * MB;
constexpr size_t OFF_AU    = OFF_R1;
constexpr size_t OFF_AV    = OFF_AU + 8 * MB;
constexpr size_t OFF_AVN   = OFF_AV + 8 * MB;
constexpr size_t OFF_DQ    = OFF_AVN + 8 * MB;
constexpr size_t OFF_DKP   = OFF_DQ + 8 * MB;
constexpr size_t OFF_DKS   = OFF_DKP + 4 * MB;
constexpr size_t OFF_DVTP  = OFF_DKS + 5 * MB;
constexpr size_t OFF_DVTS  = OFF_DVTP + 4 * MB;
constexpr size_t OFF_GQ    = OFF_DVTS + 5 * MB;
constexpr size_t OFF_GKP   = OFF_GQ + 16 * MB;
constexpr size_t OFF_GKS   = OFF_GKP + 2 * MB;
constexpr size_t OFF_GVTP  = OFF_GKS + 3 * MB;
constexpr size_t OFF_GVTS  = OFF_GVTP + 2 * MB;
constexpr size_t OFF_MIX   = OFF_GVTS + 3 * MB;
constexpr size_t OFF_R1END = OFF_MIX + 32 * MB;
constexpr size_t OFF_Q     = OFF_R1;
constexpr size_t OFF_EIDX  = OFF_Q + 32 * MB;
constexpr size_t OFF_EGATE = OFF_EIDX + 8 * MB;
constexpr size_t OFF_TOPV  = OFF_EGATE + 8 * MB;
constexpr size_t OFF_TOPI  = OFF_TOPV + 16 * MB;
static_assert(OFF_TOPI + 16 * MB <= OFF_R1END, "peer buffers must fit region 1");
constexpr size_t OFF_PROJ  = OFF_R1END;
constexpr size_t OFF_PART  = OFF_PROJ;
constexpr size_t OFF_WPAIR = OFF_PART + 64 * MB;
constexpr size_t OFF_H8I   = OFF_WPAIR + 8 * MB;
constexpr size_t OFF_HSC   = OFF_H8I + 16 * MB;
constexpr size_t OFF_WSC   = OFF_HSC + 64 * 1024;
constexpr size_t OFF_XGS   = OFF_WSC + 64 * 1024;
constexpr size_t OFF_RSS2  = OFF_XGS + 512 * 1024;
constexpr size_t OFF_RSS1  = OFF_RSS2 + 1 * MB;
constexpr size_t OFF_USH   = OFF_RSS1 + 512 * 1024;
constexpr size_t OFF_BQ    = OFF_USH + 1 * MB;
constexpr size_t OFF_BIN   = OFF_BQ + 64 * 1024;
constexpr size_t OFF_WQS   = OFF_BIN + 64 * 1024;
constexpr size_t OFF_WINS  = OFF_XC + 32 * MB;
static_assert(OFF_WQS + 20 * MB <= OFF_PROJ + 128 * MB, "folded tables must fit");
constexpr size_t WS_NEED   = OFF_PROJ + 128 * MB;
static_assert(WS_NEED <= 512 * MB, "workspace budget");

constexpr size_t OUT_YP  = 0;
constexpr size_t OUT_YS  = 8388608;
constexpr size_t OUT_NDK = 16777216;
constexpr size_t OUT_NDV = OUT_NDK + 4194304;
constexpr size_t OUT_NGK = OUT_NDV + 4194304;
constexpr size_t OUT_NGV = OUT_NGK + 2097152;

struct Params {
    const float* in[29];
    float* out;
    unsigned char* ws;
};
enum { I_XP = 0, I_XS, I_CDK, I_CDV, I_CGK, I_CGV, I_C, I_CCTX, I_ADAW, I_ADAB, I_N1G, I_N2G, I_WIN, I_SGUNG, I_SGUW, I_SGUB,
       I_LQ1, I_LK1, I_LQ2, I_LK2, I_SUBLN, I_QNG, I_KNG, I_WOUT, I_WQ, I_SUBK, I_PU, I_PV, I_FG };

typedef __bf16 hwbf2 __attribute__((ext_vector_type(2)));
__device__ __forceinline__ unsigned pack_bf2(float a, float b) {
    const f32x2 v = {a, b};
    return __builtin_bit_cast(unsigned, __builtin_convertvector(v, hwbf2));
}
__device__ __forceinline__ bf16_t f2bf(float f) { return (bf16_t)(pack_bf2(f, 0.f) & 0xffffu); }
__device__ __forceinline__ float bf2f(bf16_t h) { return __uint_as_float(((unsigned)h) << 16); }
__device__ __forceinline__ float gelu_f(float x) {
    const float k2 = 2.f * 0.7978845608028654f * 1.4426950408889634f;
    const float e = __builtin_amdgcn_exp2f(k2 * (x + 0.044715f * x * x * x));
    return x - x * __builtin_amdgcn_rcpf(e + 1.f);
}
__device__ __forceinline__ int lane_id() { return (int)__builtin_amdgcn_mbcnt_hi(~0u, __builtin_amdgcn_mbcnt_lo(~0u, 0u)); }
__device__ __forceinline__ int lane_id_op() { int l = lane_id(); asm volatile("" : "+v"(l)); return l; }
__device__ __forceinline__ float shfl_i(float v, int src) { return __builtin_bit_cast(float, __builtin_amdgcn_ds_bpermute(src << 2, __builtin_bit_cast(int, v))); }
__device__ __forceinline__ int shfl_i(int v, int src) { return __builtin_amdgcn_ds_bpermute(src << 2, v); }
__device__ __forceinline__ float shfl_x(float v, int lane, int m) { return shfl_i(v, lane ^ m); }
__device__ __forceinline__ int shfl_x(int v, int lane, int m) { return shfl_i(v, lane ^ m); }
__device__ __forceinline__ int q8(float x) { return (int)fminf(fmaxf(rintf(x), -127.f), 127.f); }
__device__ __forceinline__ unsigned pack4_i8(int a, int b, int c, int d) { return (unsigned)(a & 255) | ((unsigned)(b & 255) << 8) | ((unsigned)(c & 255) << 16) | ((unsigned)d << 24); }
#define DPP_F(v, ctrl) __builtin_bit_cast(float, __builtin_amdgcn_update_dpp(0, __builtin_bit_cast(int, (v)), (ctrl), 0xF, 0xF, false))
__device__ __forceinline__ float row16_sum(float v) {
    v += DPP_F(v, 0xB1); v += DPP_F(v, 0x4E); v += DPP_F(v, 0x141); v += DPP_F(v, 0x140);
    return v;
}
__device__ __forceinline__ float row16_max(float v) {
    v = fmaxf(v, DPP_F(v, 0xB1)); v = fmaxf(v, DPP_F(v, 0x4E)); v = fmaxf(v, DPP_F(v, 0x141)); v = fmaxf(v, DPP_F(v, 0x140));
    return v;
}
__device__ __forceinline__ float rdlane_f(float v, int l) { return __builtin_bit_cast(float, __builtin_amdgcn_readlane(__builtin_bit_cast(int, v), l)); }
__device__ __forceinline__ float wave_sum(float v) {
    v = row16_sum(v);
    return (rdlane_f(v, 0) + rdlane_f(v, 16)) + (rdlane_f(v, 32) + rdlane_f(v, 48));
}
__device__ __forceinline__ float wave_max(float v) {
    v = row16_max(v);
    return fmaxf(fmaxf(rdlane_f(v, 0), rdlane_f(v, 16)), fmaxf(rdlane_f(v, 32), rdlane_f(v, 48)));
}
__device__ __forceinline__ int tok_cv(int t) { return t < NPT ? 0 : 1 + ((t - NPT) >> 11); }
__device__ __forceinline__ const float* x_in_row(const Params& p, int t) {
    return t < NPT ? p.in[I_XP] + (size_t)t * D : p.in[I_XS] + (size_t)(t - NPT) * D;
}
__device__ __forceinline__ float lam_init_of(int l) { return l == 0 ? 0.2f : (0.8f - 0.6f * 0.7408182206817179f); }
__device__ __forceinline__ float lam_of(const Params& p, int l) {
    float s1 = 0.f, s2 = 0.f;
    for (int i = 0; i < 32; ++i) {
        s1 += p.in[I_LQ1][l * 32 + i] * p.in[I_LK1][l * 32 + i];
        s2 += p.in[I_LQ2][l * 32 + i] * p.in[I_LK2][l * 32 + i];
    }
    return expf(s1) - expf(s2) + lam_init_of(l);
}


#define XB_TMO      128
#define XB_XCNT(j)  (256  + 64 * (j))
#define XB_XSUB(j)  (1280 + 64 * (j))
#define XB_XGEN(j)  (2304 + 64 * (j))
#define XB_TOP      3328
#define XB_TOPGEN   3392
#define XCD_BAR_WORDS 3456
#define XB_SPIN_CAP (1u << 20)
#define LAS __attribute__((address_space(3)))
typedef int i32x4 __attribute__((ext_vector_type(4)));
__device__ __forceinline__ unsigned xb_ld(unsigned* p)              { return __hip_atomic_load(p, __ATOMIC_RELAXED, __HIP_MEMORY_SCOPE_AGENT); }
__device__ __forceinline__ unsigned xb_add(unsigned* p, unsigned v) { return __hip_atomic_fetch_add(p, v, __ATOMIC_RELAXED, __HIP_MEMORY_SCOPE_AGENT); }
__device__ __forceinline__ unsigned xb_xcc_id() { return (unsigned)__builtin_amdgcn_s_getreg((3 << 11) | 20) & 0xFu; }
#define XB_SPIN(cond, bar) do { unsigned _sp = 0; while (cond) { __builtin_amdgcn_s_sleep(1); \
    if ((++_sp & 255u) == 0u) { if (xb_ld(&(bar)[XB_TMO])) break; if (_sp > XB_SPIN_CAP) { atomicAdd(&(bar)[XB_TMO], 1u); break; } } } } while (0)
struct XcdBarrier { unsigned* bar; unsigned x; volatile LAS unsigned* st; };
__device__ __forceinline__ XcdBarrier xcd_barrier_post(unsigned* bar, volatile LAS unsigned* st) {
    XcdBarrier b; b.bar = bar; b.x = xb_xcc_id(); b.st = st;
    if (threadIdx.x == 0) (void)xb_add(&bar[XB_XCNT(b.x)], 1u);
    return b;
}
__device__ __forceinline__ void xcd_barrier_complete(unsigned* bar, unsigned x, unsigned& nloc, unsigned& nx) {
    const unsigned G = gridDim.x * gridDim.y * gridDim.z;
    unsigned sum, cnt, mine, sp = 0u;
    for (;;) {
        sum = 0u; cnt = 0u; mine = 0u;
#pragma unroll
        for (unsigned j = 0; j < 16; ++j) { const unsigned c = xb_ld(&bar[XB_XCNT(j)]); sum += c; cnt += (c > 0u) ? 1u : 0u; mine = (j == x) ? c : mine; }
        if (sum == G) break;
        __builtin_amdgcn_s_sleep(1);
        if ((++sp & 255u) == 0u) { if (xb_ld(&bar[XB_TMO])) break; if (sp > XB_SPIN_CAP) { atomicAdd(&bar[XB_TMO], 1u); break; } }
    }
    nloc = mine > 0u ? mine : 1u; nx = cnt > 0u ? cnt : 1u;
}
__device__ __forceinline__ void xcd_barrier(const XcdBarrier& b) {
    asm volatile("s_waitcnt vmcnt(0)" ::: "memory");
    __syncthreads();
    if (threadIdx.x == 0) {
        unsigned* bar = b.bar;
        const unsigned bx = xb_xcc_id();
        __builtin_amdgcn_s_waitcnt(0);
        unsigned nloc = b.st[0], nx = b.st[1];
        if (nloc == 0u) { xcd_barrier_complete(bar, bx, nloc, nx); b.st[0] = nloc; b.st[1] = nx; }
        const unsigned old = xb_add(&bar[XB_XSUB(bx)], 1u);
        const unsigned gen = old / nloc;
        if (old + 1u == (gen + 1u) * nloc) {
            __builtin_amdgcn_fence(__ATOMIC_RELEASE, "agent");
            asm volatile("s_waitcnt vmcnt(0)" ::: "memory");
            const unsigned og = xb_add(&bar[XB_TOP], 1u);
            const unsigned tg = og / nx;
            if (og + 1u == (tg + 1u) * nx) xb_add(&bar[XB_TOPGEN], 1u);
            else XB_SPIN(xb_ld(&bar[XB_TOPGEN]) == tg, bar);
            __builtin_amdgcn_fence(__ATOMIC_ACQUIRE, "agent");
            xb_add(&bar[XB_XGEN(bx)], 1u);
            asm volatile("s_waitcnt vmcnt(0)" ::: "memory");
        } else {
            XB_SPIN(xb_ld(&bar[XB_XGEN(bx)]) == gen, bar);
            __builtin_amdgcn_fence(__ATOMIC_ACQUIRE, "agent");
            asm volatile("s_waitcnt vmcnt(0)" ::: "memory");
        }
    }
    __syncthreads();
}

constexpr int NT = 512;
constexpr int LDS_HDR = 1024;
#define GTID ((size_t)blockIdx.x * NT + tid)
__device__ __forceinline__ int opaque_tid(int wv) { int t = (wv << 6) | lane_id(); asm volatile("" : "+v"(t)); return t; }
#define GNT  ((size_t)gridDim.x * NT)

__device__ void ph_transpose(const float* __restrict__ W, bf16_t* __restrict__ Wt, int K, int N, unsigned char* ldsraw, const int wv) {
    const int tid = opaque_tid(wv);
    LAS bf16_t* T = (LAS bf16_t*)ldsraw;
    const int tk = K / 128, tn = N / 64, ntiles = tk * tn;
    for (int tile = blockIdx.x; tile < ntiles; tile += gridDim.x) {
        const int k0 = (tile % tk) * 128, n0 = (tile / tk) * 64;
#pragma unroll 4
        for (int i = 0; i < 16; ++i) {
            const int kl = i * 8 + (tid >> 6), nl = tid & 63;
            T[nl * 130 + kl] = f2bf(W[(size_t)(k0 + kl) * N + n0 + nl]);
        }
        __syncthreads();
        {
            const int nl = tid >> 3, kc = tid & 7;
            unsigned w[8];
#pragma unroll
            for (int i = 0; i < 8; ++i) w[i] = (unsigned)T[nl * 130 + kc * 16 + 2 * i] | ((unsigned)T[nl * 130 + kc * 16 + 2 * i + 1] << 16);
            bf16_t* dst = Wt + (size_t)(n0 + nl) * K + k0 + kc * 16;
            *reinterpret_cast<u32x4*>(dst) = u32x4{w[0], w[1], w[2], w[3]};
            *reinterpret_cast<u32x4*>(dst + 8) = u32x4{w[4], w[5], w[6], w[7]};
        }
        __syncthreads();
    }
}
__device__ void ph_convert(const float* __restrict__ src, bf16_t* __restrict__ dst, size_t n, const int wv) {
    const int tid = opaque_tid(wv);
    for (size_t idx = GTID; idx < n; idx += GNT) dst[idx] = f2bf(src[idx]);
}
__device__ void ph_convert_i8_rows(const float* __restrict__ src, unsigned char* __restrict__ dst, float* __restrict__ scl, int nrows, const int wv) {
    const int tid = opaque_tid(wv);
    const int lane = tid & 63;
    const int gw = blockIdx.x * 8 + (tid >> 6), nw = gridDim.x * 8;
    for (int row0 = gw * 4; row0 < nrows; row0 += nw * 4) {
        float4 f[4][4];
#pragma unroll
        for (int q = 0; q < 4; ++q)
#pragma unroll
            for (int i = 0; i < 4; ++i) f[q][i] = *reinterpret_cast<const float4*>(src + (size_t)(row0 + q) * D + lane * 16 + i * 4);
#pragma unroll
        for (int q = 0; q < 4; ++q) {
            const int row = row0 + q;
            float v[16];
#pragma unroll
            for (int i = 0; i < 4; ++i) { v[i * 4] = f[q][i].x; v[i * 4 + 1] = f[q][i].y; v[i * 4 + 2] = f[q][i].z; v[i * 4 + 3] = f[q][i].w; }
            float am = 0.f;
#pragma unroll
            for (int i = 0; i < 16; ++i) am = fmaxf(am, fabsf(v[i]));
#pragma unroll
            for (int o = 32; o >= 1; o >>= 1) am = fmaxf(am, shfl_x(am, lane, o));
            const float sc = am > 0.f ? 127.f / am : 1.f;
            unsigned w[4];
#pragma unroll
            for (int i = 0; i < 4; ++i) w[i] = pack4_i8(q8(v[i * 4] * sc), q8(v[i * 4 + 1] * sc), q8(v[i * 4 + 2] * sc), q8(v[i * 4 + 3] * sc));
            {
                const int lyr = row >> 14, e = row & (NEXP - 1);
                *reinterpret_cast<u32x4*>(dst + (((size_t)lyr * 8 + (lane >> 3)) * NEXP + e) * 128 + (lane & 7) * 16) = u32x4{w[0], w[1], w[2], w[3]};
            }
            if (lane == 0) scl[row] = am > 0.f ? am * (1.f / 127.f) : 1.f;
        }
    }
}
__device__ void ph_mod(const Params& p, unsigned char* ldsraw, const int wv) {
    const int tid = opaque_tid(wv);
    LAS float* sl = (LAS float*)ldsraw;
    LAS float* red = sl + 5 * 1024;
    for (int i = tid; i < 5 * 1024; i += NT) {
        const int cv = i >> 10, k = i & 1023;
        const float c = cv == 0 ? p.in[I_CCTX][k] : p.in[I_C][(size_t)(cv - 1) * D + k];
        sl[i] = c / (1.f + __expf(-c));
    }
    __syncthreads();
    const int c = tid & 63, ks = tid >> 6;
    for (int item = blockIdx.x; item < 2 * 96; item += gridDim.x) {
        const int l = item / 96, j = (item % 96) * 64 + c;
        const float* W = p.in[I_ADAW] + (size_t)l * D * 6144 + (size_t)(ks * 128) * 6144 + j;
        float acc[5] = {0.f, 0.f, 0.f, 0.f, 0.f};
#pragma unroll 8
        for (int k = 0; k < 128; ++k) {
            const float w = W[(size_t)k * 6144];
#pragma unroll
            for (int cv = 0; cv < 5; ++cv) acc[cv] += sl[cv * 1024 + ks * 128 + k] * w;
        }
#pragma unroll
        for (int cv = 0; cv < 5; ++cv) red[(ks * 5 + cv) * 64 + c] = acc[cv];
        __syncthreads();
        if (tid < 320) {
            const int cv = tid >> 6;
            float sum = p.in[I_ADAB][l * 6144 + j];
#pragma unroll
            for (int q = 0; q < 8; ++q) sum += red[(q * 5 + cv) * 64 + c];
            ((float*)(p.ws + OFF_MOD))[(size_t)(l * 5 + cv) * 6144 + j] = sum;
        }
        __syncthreads();
    }
}
__device__ void ph_rope_tab(const Params& p, const int wv) {
    const int tid = opaque_tid(wv);
    for (size_t idx = GTID; idx < 2048 * 48; idx += GNT) {
        int s = idx / 48, i = idx % 48;
        float* R = (float*)(p.ws + OFF_ROPE);
        double row = (double)(s / 64), col = (double)(s % 64);
        if (i < 16) {
            int q = i & 7; double inv = pow(10000.0, -(double)q / 8.0);
            double ang = (i < 8 ? row : col) * inv;
            R[s * 16 + i] = (float)cos(ang); R[2048 * 16 + s * 16 + i] = (float)sin(ang);
        } else {
            int ii = i - 16; int q = ii & 15; double inv = pow(10000.0, -(double)q / 16.0);
            double ang = (ii < 16 ? row : col) * inv;
            R[2048 * 32 + s * 32 + ii] = (float)cos(ang); R[2048 * 64 + s * 32 + ii] = (float)sin(ang);
        }
    }
}
__device__ void ph_cache_prep(const Params& p, int l, const int wv) {
    const int tid = opaque_tid(wv);
    bf16_t* DKS = (bf16_t*)(p.ws + OFF_DKS); bf16_t* DVTS = (bf16_t*)(p.ws + OFF_DVTS);
    bf16_t* GKS = (bf16_t*)(p.ws + OFF_GKS); bf16_t* GVTS = (bf16_t*)(p.ws + OFF_GVTS);
    for (size_t idx = GTID; idx < 4 * 512 * 256; idx += GNT) {
        int c = idx & 255, pp = (idx >> 8) & 511, b = idx >> 17;
        size_t src = (((size_t)b * 2 + l) * PAST + pp) * 256 + c;
        int h = c >> 6, r = c & 63;
        DKS[(((size_t)b * 4 + h) * NKS + DSEQ + pp) * 64 + r] = f2bf(p.in[I_CDK][src]);
        DVTS[(((size_t)b * 4 + h) * 64 + r) * NKS + DSEQ + pp] = f2bf(p.in[I_CDV][src]);
        if (c < 128) {
            size_t src2 = (((size_t)b * 2 + l) * PAST + pp) * 128 + c;
            int kv = c >> 6;
            const int sq = DSEQ + pp;
            const size_t hb = ((size_t)b * 2 + kv) * NKS * 64 + (size_t)(sq >> 6) * 4096;
            GKS[hb + (r >> 3) * 512 + (sq & 63) * 8 + (r & 7)] = f2bf(p.in[I_CGK][src2]);
            GVTS[hb + (r >> 5) * 2048 + (sq & 63) * 32 + (r & 31)] = f2bf(p.in[I_CGV][src2]);
        }
    }
}
__device__ void ph_fold_tables(const Params& p, unsigned char* ldsraw, const int wv) {
    const int tid = opaque_tid(wv);
    const int lane = tid & 63;
    const int gw = blockIdx.x * 8 + (tid >> 6), nw = gridDim.x * 8;
    const float* MOD = (const float*)(p.ws + OFF_MOD);
    for (size_t idx = GTID; idx < (size_t)(1024 + 1024 + 2048) * 128; idx += GNT) {
        const int row = (int)(idx >> 7), k0 = (int)(idx & 127) * 8;
        const int which = row < 2048 ? 1 : 0, l = row < 1024 ? 0 : 1;
        const int n = row < 2048 ? (row & 1023) : row - 2048, N = row < 2048 ? 1024 : 2048;
        const bf16_t* src = row < 2048 ? (const bf16_t*)(p.ws + OFF_WQ) + ((size_t)l * D + n) * D + k0 : (const bf16_t*)(p.ws + OFF_WIN) + ((size_t)INW + n) * D + k0;
        bf16_t* dst = row < 2048 ? (bf16_t*)(p.ws + OFF_WQS) + ((size_t)l * 5 * D + n) * D + k0 : (bf16_t*)(p.ws + OFF_WINS) + (size_t)n * D + k0;
        const u32x4 w = *reinterpret_cast<const u32x4*>(src);
        const float* gn = p.in[which ? I_N2G : I_N1G] + l * D + k0;
        const float4 ga = *reinterpret_cast<const float4*>(gn), gb = *reinterpret_cast<const float4*>(gn + 4);
        float wf[8];
#pragma unroll
        for (int k = 0; k < 4; ++k) { wf[2 * k] = __uint_as_float(w[k] << 16); wf[2 * k + 1] = __uint_as_float(w[k] & 0xffff0000u); }
        wf[0] *= ga.x; wf[1] *= ga.y; wf[2] *= ga.z; wf[3] *= ga.w; wf[4] *= gb.x; wf[5] *= gb.y; wf[6] *= gb.z; wf[7] *= gb.w;
#pragma unroll
        for (int cv = 0; cv < 5; ++cv) {
            const float* sc = MOD + (size_t)(l * 5 + cv) * 6144 + which * 3072 + 1024 + k0;
            const float4 sa = *reinterpret_cast<const float4*>(sc), sb = *reinterpret_cast<const float4*>(sc + 4);
            *reinterpret_cast<u32x4*>(dst + (size_t)cv * N * D) = u32x4{pack_bf2(wf[0] * (1.f + sa.x), wf[1] * (1.f + sa.y)), pack_bf2(wf[2] * (1.f + sa.z), wf[3] * (1.f + sa.w)),
                                                                         pack_bf2(wf[4] * (1.f + sb.x), wf[5] * (1.f + sb.y)), pack_bf2(wf[6] * (1.f + sb.z), wf[7] * (1.f + sb.w))};
        }
    }
    for (int row = gw; row < 1024 + 1024 + 2048; row += nw) {
        const int which = row < 2048 ? 1 : 0, l = row < 1024 ? 0 : 1;
        const int n = row < 2048 ? (row & 1023) : row - 2048;
        const bf16_t* src = row < 2048 ? (const bf16_t*)(p.ws + OFF_WQ) + ((size_t)l * D + n) * D + lane * 16 : (const bf16_t*)(p.ws + OFF_WIN) + ((size_t)INW + n) * D + lane * 16;
        const u32x4 w0 = *reinterpret_cast<const u32x4*>(src), w1 = *reinterpret_cast<const u32x4*>(src + 8);
        float wf[16];
#pragma unroll
        for (int k = 0; k < 4; ++k) { wf[2 * k] = __uint_as_float(w0[k] << 16); wf[2 * k + 1] = __uint_as_float(w0[k] & 0xffff0000u);
                                      wf[8 + 2 * k] = __uint_as_float(w1[k] << 16); wf[8 + 2 * k + 1] = __uint_as_float(w1[k] & 0xffff0000u); }
#pragma unroll
        for (int cv = 0; cv < 5; ++cv) {
            const float* sh = MOD + (size_t)(l * 5 + cv) * 6144 + which * 3072 + lane * 16;
            float acc = 0.f;
#pragma unroll
            for (int q = 0; q < 4; ++q) {
                const float4 a = *reinterpret_cast<const float4*>(sh + q * 4);
                acc += wf[q * 4] * a.x + wf[q * 4 + 1] * a.y + wf[q * 4 + 2] * a.z + wf[q * 4 + 3] * a.w;
            }
            acc = wave_sum(acc);
            if (lane == 0) {
                if (row < 2048) ((float*)(p.ws + OFF_BQ))[(size_t)(l * 5 + cv) * D + n] = acc;
                else            ((float*)(p.ws + OFF_BIN))[(size_t)cv * INW + n] = acc;
            }
        }
    }
    {
        LAS signed char* s8 = (LAS signed char*)ldsraw;
        LAS float* s8s = (LAS float*)(ldsraw + 10 * 1024);
        const int wave = tid >> 6;
        for (int r = wave; r < 10; r += 8) {
            const float* sh = MOD + (size_t)r * 6144 + 3072 + lane * 16;
            float v[16];
#pragma unroll
            for (int q = 0; q < 4; ++q) { const float4 a = *reinterpret_cast<const float4*>(sh + q * 4); v[q * 4] = a.x; v[q * 4 + 1] = a.y; v[q * 4 + 2] = a.z; v[q * 4 + 3] = a.w; }
            float am = 0.f;
#pragma unroll
            for (int i = 0; i < 16; ++i) am = fmaxf(am, fabsf(v[i]));
            am = wave_max(am);
            const float sc = am > 0.f ? 127.f / am : 1.f;
            u32x4 w;
#pragma unroll
            for (int q = 0; q < 4; ++q) w[q] = pack4_i8(q8(v[q * 4] * sc), q8(v[q * 4 + 1] * sc), q8(v[q * 4 + 2] * sc), q8(v[q * 4 + 3] * sc));
            *(LAS u32x4*)(s8 + r * 1024 + lane * 16) = w;
            if (lane == 0) s8s[r] = am > 0.f ? am * (1.f / 127.f) : 1.f;
        }
        __syncthreads();
        const int fr = lane & 15, fq = lane >> 4;
        for (int task = gw; task < 2 * (NEXP / 16); task += nw) {
            const int l = task >> 10, e0 = (task & 1023) * 16;
            const unsigned char* up = p.ws + OFF_UT + ((size_t)l * 8 * NEXP + e0 + fr) * 128 + fq * 16;
            i32x4 acc = {0, 0, 0, 0};
#pragma unroll
            for (int st = 0; st < 16; ++st) {
                const i32x4 a = *reinterpret_cast<const i32x4*>(up + (size_t)(st >> 1) * NEXP * 128 + (st & 1) * 64);
                i32x4 b = {0, 0, 0, 0};
                if (fr < 5) b = *(const LAS i32x4*)(s8 + (l * 5 + fr) * 1024 + st * 64 + fq * 16);
                acc = __builtin_amdgcn_mfma_i32_16x16x64_i8(a, b, acc, 0, 0, 0);
            }
            if (fr < 5) {
                const float ss = s8s[l * 5 + fr];
#pragma unroll
                for (int r = 0; r < 4; ++r) {
                    const int e = e0 + fq * 4 + r;
                    ((float*)(p.ws + OFF_USH))[(size_t)(l * 5 + fr) * NEXP + e] = (float)acc[r] * ss * ((const float*)(p.ws + OFF_USC))[l * NEXP + e];
                }
            }
        }
        __syncthreads();
    }
}
__device__ void ph_norm_mod(const Params& p, int l, int which, int from_input, const int wv) {
    const int tid = opaque_tid(wv);
    const int lane = tid & 63;
    const int gw = blockIdx.x * 8 + (tid >> 6), nw = gridDim.x * 8;
    const float* g = p.in[which ? I_N2G : I_N1G] + l * D;
    if (from_input) {
        float4 nx[4];
        {
            const int t = gw < NTOK ? gw : NTOK - 1;
            const float* xr = x_in_row(p, t);
#pragma unroll
            for (int i = 0; i < 4; ++i) nx[i] = *reinterpret_cast<const float4*>(xr + i * 256 + lane * 4);
        }
        for (int t = gw; t < NTOK; t += nw) {
            float4 v[4];
#pragma unroll
            for (int i = 0; i < 4; ++i) v[i] = nx[i];
            {
                const int tn = t + nw < NTOK ? t + nw : t;
                const float* xn = x_in_row(p, tn);
#pragma unroll
                for (int i = 0; i < 4; ++i) nx[i] = *reinterpret_cast<const float4*>(xn + i * 256 + lane * 4);
            }
            const float* mod = (const float*)(p.ws + OFF_MOD) + (size_t)(l * 5 + tok_cv(t)) * 6144 + which * 3072;
            float ss = 0.f;
#pragma unroll
            for (int i = 0; i < 4; ++i) ss += v[i].x * v[i].x + v[i].y * v[i].y + v[i].z * v[i].z + v[i].w * v[i].w;
            ss = wave_sum(ss);
            float r = rsqrtf(ss / D + EPS);
            bf16_t* H = (bf16_t*)(p.ws + OFF_H) + (size_t)t * D;
#pragma unroll
            for (int i = 0; i < 4; ++i) {
                int c = i * 256 + lane * 4;
                float4 gg = *reinterpret_cast<const float4*>(g + c), sh = *reinterpret_cast<const float4*>(mod + c), sc = *reinterpret_cast<const float4*>(mod + 1024 + c);
                uint2 o;
                o.x = pack_bf2(v[i].x * r * gg.x * (1.f + sc.x) + sh.x, v[i].y * r * gg.y * (1.f + sc.y) + sh.y);
                o.y = pack_bf2(v[i].z * r * gg.z * (1.f + sc.z) + sh.z, v[i].w * r * gg.w * (1.f + sc.w) + sh.w);
                *reinterpret_cast<uint2*>(H + c) = o;
            }
        }
    } else {
        u32x4 nx[2];
        {
            const int t = gw < NTOK ? gw : NTOK - 1;
            const bf16_t* xr = (const bf16_t*)(p.ws + OFF_XC) + (size_t)t * D + lane * 8;
            nx[0] = *reinterpret_cast<const u32x4*>(xr); nx[1] = *reinterpret_cast<const u32x4*>(xr + 512);
        }
        for (int t = gw; t < NTOK; t += nw) {
            float v[16];
#pragma unroll
            for (int h = 0; h < 2; ++h)
#pragma unroll
                for (int k = 0; k < 4; ++k) { v[h * 8 + 2 * k] = __uint_as_float(nx[h][k] << 16); v[h * 8 + 2 * k + 1] = __uint_as_float(nx[h][k] & 0xffff0000u); }
            {
                const int tn = t + nw < NTOK ? t + nw : t;
                const bf16_t* xn = (const bf16_t*)(p.ws + OFF_XC) + (size_t)tn * D + lane * 8;
                nx[0] = *reinterpret_cast<const u32x4*>(xn); nx[1] = *reinterpret_cast<const u32x4*>(xn + 512);
            }
            const float* mod = (const float*)(p.ws + OFF_MOD) + (size_t)(l * 5 + tok_cv(t)) * 6144 + which * 3072;
            float ss = 0.f;
#pragma unroll
            for (int i = 0; i < 16; ++i) ss += v[i] * v[i];
            ss = wave_sum(ss);
            float r = rsqrtf(ss / D + EPS);
            bf16_t* H = (bf16_t*)(p.ws + OFF_H) + (size_t)t * D;
            float hq[16];
#pragma unroll
            for (int h = 0; h < 2; ++h) {
                const int c = h * 512 + lane * 8;
                float o[8];
#pragma unroll
                for (int q = 0; q < 2; ++q) {
                    const float4 gg = *reinterpret_cast<const float4*>(g + c + q * 4), sh = *reinterpret_cast<const float4*>(mod + c + q * 4), sc = *reinterpret_cast<const float4*>(mod + 1024 + c + q * 4);
                    o[q * 4] = v[h * 8 + q * 4] * r * gg.x * (1.f + sc.x) + sh.x; o[q * 4 + 1] = v[h * 8 + q * 4 + 1] * r * gg.y * (1.f + sc.y) + sh.y;
                    o[q * 4 + 2] = v[h * 8 + q * 4 + 2] * r * gg.z * (1.f + sc.z) + sh.z; o[q * 4 + 3] = v[h * 8 + q * 4 + 3] * r * gg.w * (1.f + sc.w) + sh.w;
                }
                *reinterpret_cast<u32x4*>(H + c) = u32x4{pack_bf2(o[0], o[1]), pack_bf2(o[2], o[3]), pack_bf2(o[4], o[5]), pack_bf2(o[6], o[7])};
#pragma unroll
                for (int q = 0; q < 8; ++q) hq[h * 8 + q] = o[q];
            }
            if (which) {
                float am = 0.f;
#pragma unroll
                for (int i = 0; i < 16; ++i) am = fmaxf(am, fabsf(hq[i]));
#pragma unroll
                for (int o2 = 32; o2 >= 1; o2 >>= 1) am = fmaxf(am, shfl_x(am, lane, o2));
                const float sc8 = am > 0.f ? 127.f / am : 1.f;
#pragma unroll
                for (int h = 0; h < 2; ++h) {
                    uint2 w;
                    w.x = pack4_i8(q8(hq[h * 8] * sc8), q8(hq[h * 8 + 1] * sc8), q8(hq[h * 8 + 2] * sc8), q8(hq[h * 8 + 3] * sc8));
                    w.y = pack4_i8(q8(hq[h * 8 + 4] * sc8), q8(hq[h * 8 + 5] * sc8), q8(hq[h * 8 + 6] * sc8), q8(hq[h * 8 + 7] * sc8));
                    *reinterpret_cast<uint2*>(p.ws + OFF_H8I + (size_t)t * D + h * 512 + lane * 8) = w;
                }
                if (lane == 0) ((float*)(p.ws + OFF_HSC))[t] = am > 0.f ? am * (1.f / 127.f) : 1.f;
            }
        }
    }
}
__device__ void ph_sgu_norm(const Params& p, int l, const int wv) {
    const int tid = opaque_tid(wv);
    const int lane = tid & 63;
    const int gw = blockIdx.x * 8 + (tid >> 6), nw = gridDim.x * 8;
    for (int t = gw; t < NTOK; t += nw) {
        const bf16_t* AV = (const bf16_t*)(p.ws + OFF_AV) + (size_t)t * 256;
        float v[4]; float ss = 0.f;
#pragma unroll
        for (int i = 0; i < 4; ++i) { v[i] = bf2f(AV[i * 64 + lane]); ss += v[i] * v[i]; }
        ss = wave_sum(ss);
        float r = rsqrtf(ss / 256.f + EPS);
#pragma unroll
        for (int i = 0; i < 4; ++i) ((bf16_t*)(p.ws + OFF_AVN))[(size_t)t * 256 + i * 64 + lane] = f2bf(v[i] * r * p.in[I_SGUNG][l * 256 + i * 64 + lane]);
    }
}
__device__ void ph_sgu_mix(const Params& p, int l, const int wv) {
    const int tid = opaque_tid(wv);
    const bf16_t* AVN = (const bf16_t*)(p.ws + OFF_AVN);
    for (size_t idx = GTID; idx < (size_t)NTOK * 256; idx += GNT) {
        int t = (int)(idx >> 8), c = (int)(idx & 255);
        int t0 = t & ~127, pp = t & 127, g = c >> 6;
        const bf16_t* W = (const bf16_t*)(p.ws + OFF_SGUW) + (((size_t)l * 4 + g) * 128 + pp) * 128;
        float acc = 0.f;
        for (int q = 0; q < 128; ++q) acc += bf2f(W[q]) * bf2f(AVN[(size_t)(t0 + q) * 256 + c]);
        acc += p.in[I_SGUB][(l * 4 + g) * 128 + pp];
        float au = bf2f(((const bf16_t*)(p.ws + OFF_AU))[(size_t)t * 256 + c]);
        ((bf16_t*)(p.ws + OFF_MIX))[(size_t)t * D + c] = f2bf(au * acc);
    }
}
__device__ void ph_attn_ref(const Params& p, int l, const int wv) {
    const int tid = opaque_tid(wv);
    const int lane = tid & 63;
    const int gw = blockIdx.x * 8 + (tid >> 6), nw = gridDim.x * 8;
    const float lam = lam_of(p, l);
    for (int item = gw; item < NTOK * 12; item += nw) {
        const int t = item % NTOK, hh = item / NTOK;
        const bool prompt = t < NPT;
        const int b = prompt ? t / SEQ : (t - NPT) / DSEQ;
        const int nk = prompt ? SEQ : NKS;
        if (hh < 4) {
            const int h = hh;
            const bf16_t* K = prompt ? (const bf16_t*)(p.ws + OFF_DKP) + ((size_t)b * 4 + h) * SEQ * 64 : (const bf16_t*)(p.ws + OFF_DKS) + ((size_t)b * 4 + h) * NKS * 64;
            const bf16_t* Vt = prompt ? (const bf16_t*)(p.ws + OFF_DVTP) + ((size_t)b * 4 + h) * 64 * SEQ : (const bf16_t*)(p.ws + OFF_DVTS) + ((size_t)b * 4 + h) * 64 * NKS;
            float q = bf2f(((const bf16_t*)(p.ws + OFF_DQ))[(size_t)t * 256 + h * 64 + lane]);
            const float scale = 0.17677669529663687f;
            float m0 = -1e30f, m1 = -1e30f, l0 = 0.f, l1 = 0.f, a0 = 0.f, a1 = 0.f;
            for (int k = 0; k < nk; ++k) {
                float pr = q * bf2f(K[(size_t)k * 64 + lane]);
#pragma unroll
                for (int o = 16; o >= 1; o >>= 1) pr += shfl_x(pr, lane, o);
                float s0 = shfl_i(pr, 0) * scale, s1 = shfl_i(pr, 32) * scale;
                float v = bf2f(Vt[(size_t)lane * nk + k]);
                float mn0 = fmaxf(m0, s0), mn1 = fmaxf(m1, s1);
                float c0 = expf(m0 - mn0), c1 = expf(m1 - mn1);
                float e0 = expf(s0 - mn0), e1 = expf(s1 - mn1);
                l0 = l0 * c0 + e0; l1 = l1 * c1 + e1;
                a0 = a0 * c0 + e0 * v; a1 = a1 * c1 + e1 * v;
                m0 = mn0; m1 = mn1;
            }
            float o = a0 / l0 - lam * a1 / l1;
            float ss = wave_sum(o * o);
            float r = rsqrtf(ss / 64.f + EPS);
            o = o * r * p.in[I_SUBLN][l * 64 + lane] * (1.f - lam_init_of(l));
            ((bf16_t*)(p.ws + OFF_MIX))[(size_t)t * D + 256 + h * 64 + lane] = f2bf(o);
        } else {
            const int hq = hh - 4, kv = hq >> 2;
            const bf16_t* K = prompt ? (const bf16_t*)(p.ws + OFF_GKP) + ((size_t)b * 2 + kv) * SEQ * 64 : (const bf16_t*)(p.ws + OFF_GKS) + ((size_t)b * 2 + kv) * NKS * 64;
            const bf16_t* Vt = prompt ? (const bf16_t*)(p.ws + OFF_GVTP) + ((size_t)b * 2 + kv) * 64 * SEQ : (const bf16_t*)(p.ws + OFF_GVTS) + ((size_t)b * 2 + kv) * 64 * NKS;
            float q = bf2f(((const bf16_t*)(p.ws + OFF_GQ))[(size_t)t * 512 + hq * 64 + lane]);
            float m = -1e30f, ls = 0.f, a = 0.f;
            for (int k = 0; k < nk; ++k) {
                float s = wave_sum(q * bf2f(K[(size_t)k * 64 + lane])) * 0.125f;
                float v = bf2f(Vt[(size_t)lane * nk + k]);
                float mn = fmaxf(m, s);
                float c = expf(m - mn), e = expf(s - mn);
                ls = ls * c + e; a = a * c + e * v; m = mn;
            }
            ((bf16_t*)(p.ws + OFF_MIX))[(size_t)t * D + 512 + hq * 64 + lane] = f2bf(a / ls);
        }
    }
}
__device__ void ph_peer_scores(const Params& p, int l, const int wv) {
    const int tid = opaque_tid(wv);
    const bf16_t* SK = (const bf16_t*)(p.ws + OFF_SUBK) + (size_t)l * 2 * 128 * 64;
    for (size_t idx = GTID; idx < (size_t)NTOK * 2048; idx += GNT) {
        int t = (int)(idx >> 11), o = (int)(idx & 2047);
        const bf16_t* Q = (const bf16_t*)(p.ws + OFF_Q) + (size_t)t * D;
        int n = o & 127, x = (o >> 7) & 1, h = o >> 8;
        float acc = 0.f;
        for (int k = 0; k < 64; ++k) acc += bf2f(Q[h * 128 + x * 64 + k]) * bf2f(SK[((size_t)x * 128 + n) * 64 + k]);
        ((float*)(p.ws + OFF_PROJ))[idx] = acc;
    }
}
__device__ void ph_peer_top1(const Params& p, const int wv) {
    const int tid = opaque_tid(wv);
    for (size_t idx = GTID; idx < (size_t)NTOK * 16; idx += GNT) {
        const float* SC = (const float*)(p.ws + OFF_PROJ) + idx * 128;
        float* TV = (float*)(p.ws + OFF_TOPV) + idx * 16; int* TI = (int*)(p.ws + OFF_TOPI) + idx * 16;
        float pv = 3.0e38f; int pi = -1;
        for (int r = 0; r < 16; ++r) {
            float bv = -3.0e38f; int bi = -1;
            for (int n = 0; n < 128; ++n) {
                float v = SC[n];
                bool after = (v < pv) || (v == pv && n > pi);
                if (after && (bi < 0 || v > bv)) { bv = v; bi = n; }
            }
            TV[r] = bv; TI[r] = bi; pv = bv; pi = bi;
        }
    }
}
__device__ void ph_peer_top2(const Params& p, const int wv) {
    const int tid = opaque_tid(wv);
    for (size_t idx = GTID; idx < (size_t)NTOK * 8; idx += GNT) {
        const float* TV = (const float*)(p.ws + OFF_TOPV) + idx * 32; const int* TI = (const int*)(p.ws + OFF_TOPI) + idx * 32;
        int* EI = (int*)(p.ws + OFF_EIDX) + idx * 16; float* EG = (float*)(p.ws + OFF_EGATE) + idx * 16;
        float pv = 3.0e38f; int pi = -1; float mx = 0.f, sum = 0.f;
        for (int r = 0; r < 16; ++r) {
            float bv = -3.0e38f; int bi = -1;
            for (int n = 0; n < 256; ++n) {
                float v = TV[n >> 4] + TV[16 + (n & 15)];
                bool after = (v < pv) || (v == pv && n > pi);
                if (after && (bi < 0 || v > bv)) { bv = v; bi = n; }
            }
            if (r == 0) mx = bv;
            float e = expf(bv - mx);
            sum += e;
            EG[r] = e; EI[r] = TI[bi >> 4] * 128 + TI[16 + (bi & 15)];
            pv = bv; pi = bi;
        }
        float inv = 1.f / sum;
        for (int r = 0; r < 16; ++r) EG[r] *= inv;
    }
}
__device__ void ph_peer_apply(const Params& p, int l, unsigned char* lds, const int wv) {
    const int tid = opaque_tid(wv);
    const int sub = tid >> 8, tl = tid & 255;
    const int wave = tl >> 6, lane = tl & 63;
    float* wts = (float*)(lds + 64) + sub * 128; int* eid = (int*)(lds + 64 + 1024) + sub * 128;
    const bf16_t* UT = (const bf16_t*)(p.ws + OFF_UT) + (size_t)l * NEXP * D;
    const bf16_t* VT = (const bf16_t*)(p.ws + OFF_VT) + (size_t)l * NEXP * D;
    const int niter = (NTOK + gridDim.x * 2 - 1) / (gridDim.x * 2);
    for (int it = 0; it < niter; ++it) {
        int t = (it * gridDim.x + blockIdx.x) * 2 + sub;
        const bool valid = t < NTOK; if (!valid) t = NTOK - 1;
        const bf16_t* H = (const bf16_t*)(p.ws + OFF_H) + (size_t)t * D;
        const int* EI = (const int*)(p.ws + OFF_EIDX) + (size_t)t * 128; const float* EG = (const float*)(p.ws + OFF_EGATE) + (size_t)t * 128;
        float hv[16];
#pragma unroll
        for (int i = 0; i < 16; ++i) hv[i] = bf2f(H[lane * 16 + i]);
        for (int jj = 0; jj < 32; ++jj) {
            int j = wave * 32 + jj; int e = EI[j];
            const bf16_t* ur = UT + (size_t)e * D + lane * 16;
            float acc = 0.f;
#pragma unroll
            for (int i = 0; i < 16; ++i) acc += hv[i] * bf2f(ur[i]);
            acc = wave_sum(acc);
            if (lane == 0) { wts[j] = EG[j] * gelu_f(acc); eid[j] = e; }
        }
        __syncthreads();
        float o[4] = {0.f, 0.f, 0.f, 0.f};
        for (int j = 0; j < 128; ++j) {
            const bf16_t* vr = VT + (size_t)eid[j] * D + tl * 4; float w = wts[j];
#pragma unroll
            for (int i = 0; i < 4; ++i) o[i] += w * bf2f(vr[i]);
        }
        const float* mod = (const float*)(p.ws + OFF_MOD) + (size_t)(l * 5 + tok_cv(t)) * 6144 + 5 * 1024;
        float* XC = (float*)(p.ws + OFF_XC) + (size_t)t * D;
        if (valid) {
#pragma unroll
            for (int i = 0; i < 4; ++i) { int c = tl * 4 + i; XC[c] += mod[c] * o[i]; }
        }
        __syncthreads();
    }
}
__device__ void ph_final_norm(const Params& p, const int wv) {
    const int tid = opaque_tid(wv);
    const int lane = tid & 63;
    const int gw = blockIdx.x * 8 + (tid >> 6), nw = gridDim.x * 8;
    u32x4 nx[2];
    {
        const int t = gw < NTOK ? gw : NTOK - 1;
        const bf16_t* xr = (const bf16_t*)(p.ws + OFF_XC) + (size_t)t * D + lane * 8;
        nx[0] = *reinterpret_cast<const u32x4*>(xr); nx[1] = *reinterpret_cast<const u32x4*>(xr + 512);
    }
    for (int t = gw; t < NTOK; t += nw) {
        float v[16];
#pragma unroll
        for (int h = 0; h < 2; ++h)
#pragma unroll
            for (int k = 0; k < 4; ++k) { v[h * 8 + 2 * k] = __uint_as_float(nx[h][k] << 16); v[h * 8 + 2 * k + 1] = __uint_as_float(nx[h][k] & 0xffff0000u); }
        {
            const int tn = t + nw < NTOK ? t + nw : t;
            const bf16_t* xn = (const bf16_t*)(p.ws + OFF_XC) + (size_t)tn * D + lane * 8;
            nx[0] = *reinterpret_cast<const u32x4*>(xn); nx[1] = *reinterpret_cast<const u32x4*>(xn + 512);
        }
        float ss = 0.f;
#pragma unroll
        for (int i = 0; i < 16; ++i) ss += v[i] * v[i];
        ss = wave_sum(ss);
        float r = rsqrtf(ss / D + EPS);
        float* y = p.out + (size_t)t * D;
#pragma unroll
        for (int h = 0; h < 2; ++h) {
            const int c = h * 512 + lane * 8;
#pragma unroll
            for (int q = 0; q < 2; ++q) {
                const float4 g = *reinterpret_cast<const float4*>(p.in[I_FG] + c + q * 4);
                *reinterpret_cast<float4*>(y + c + q * 4) = make_float4(v[h * 8 + q * 4] * r * g.x, v[h * 8 + q * 4 + 1] * r * g.y, v[h * 8 + q * 4 + 2] * r * g.z, v[h * 8 + q * 4 + 3] * r * g.w);
            }
        }
    }
}


namespace g8 {
constexpr int BM = 256, BK = 64, HALF = 128, HT = HALF * BK;
__device__ __forceinline__ int lds_byte(int r, int c) {
    int st = (r >> 4) * 2 + (c >> 5), rr = r & 15, cc = c & 31, ob = rr * 64 + cc * 2;
    return st * 1024 + (ob ^ (((ob >> 9) & 1) << 5));
}
__device__ __forceinline__ void stage_rc(int b, int& R, int& C) {
    int st = b / 1024, sb = b % 1024, swz = sb ^ (((sb >> 9) & 1) << 5);
    R = (st >> 1) * 16 + swz / 64; C = (st & 1) * 32 + (swz % 64) / 2;
}
}
enum { EPI_INPROJ = 0, EPI_WOUT = 1, EPI_WQ = 2 };
constexpr int STG = 132;

__device__ __forceinline__ void store_bf16x32(bf16_t* dst, const float (&v)[32]) {
#pragma unroll
    for (int i = 0; i < 4; ++i) {
        uint4 u;
        u.x = pack_bf2(v[i * 8 + 0], v[i * 8 + 1]); u.y = pack_bf2(v[i * 8 + 2], v[i * 8 + 3]);
        u.z = pack_bf2(v[i * 8 + 4], v[i * 8 + 5]); u.w = pack_bf2(v[i * 8 + 6], v[i * 8 + 7]);
        *reinterpret_cast<uint4*>(dst + i * 8) = u;
    }
}
__device__ __forceinline__ void store_f32x32(float* dst, const float (&v)[32]) {
#pragma unroll
    for (int i = 0; i < 8; ++i) *reinterpret_cast<float4*>(dst + i * 4) = make_float4(v[i * 4], v[i * 4 + 1], v[i * 4 + 2], v[i * 4 + 3]);
}

__device__ __forceinline__ void epi_inproj_xform(const Params& p, int l, int t, int c0, float (&v)[32]) {
    const bool prompt = t < NPT;
    const int s = prompt ? (t & 255) : ((t - NPT) & 2047);
    const float* R = (const float*)(p.ws + OFF_ROPE);
    if (c0 < 512) {
#pragma unroll
        for (int i = 0; i < 32; ++i) v[i] = gelu_f(v[i]);
    } else if (c0 < 1024) {
        if (!prompt) {
            const float* cs = R + s * 16; const float* sn = R + 2048 * 16 + s * 16;
#pragma unroll
            for (int i = 0; i < 16; ++i) {
                float c = cs[i], sv = sn[i], x1 = v[i], x2 = v[i + 16];
                v[i] = x1 * c - x2 * sv; v[i + 16] = x2 * c + x1 * sv;
            }
        }
    } else if (c0 >= 1280 && c0 < 1920) {
        const bool isq = c0 < 1792;
        const int hi = c0 & 32;
        const float* g = p.in[isq ? I_QNG : I_KNG] + l * 64 + hi;
        float ss = 0.f;
#pragma unroll
        for (int i = 0; i < 32; ++i) ss += v[i] * v[i];
        const int ln = lane_id_op();
        ss += shfl_x(ss, ln, 1);
        const float rr = rsqrtf(ss * (1.f / 64.f) + EPS);
#pragma unroll
        for (int i = 0; i < 32; ++i) v[i] = v[i] * rr * g[i];
        if (!prompt) {
            const float* cs = R + 2048 * 32 + s * 32; const float* sn = R + 2048 * 64 + s * 32;
#pragma unroll
            for (int i = 0; i < 32; ++i) {
                float pv = shfl_x(v[i], ln, 1);
                float c = cs[i], sv = sn[i];
                v[i] = hi ? (v[i] * c + pv * sv) : (v[i] * c - pv * sv);
            }
        }
        if (isq) {
#pragma unroll
            for (int i = 0; i < 32; ++i) v[i] *= 0.125f * 1.4426950408889634f;
        }
    }
}
__device__ __forceinline__ void epi_inproj_col(const Params& p, int t0, int c, const LAS float* stc) {
    float v[32];
#pragma unroll
    for (int i = 0; i < 32; ++i) v[i] = stc[i * STG];
    const bool prompt = t0 < NPT;
    const int b = prompt ? (t0 >> 8) : ((t0 - NPT) >> 11);
    const int s = prompt ? (t0 & 255) : ((t0 - NPT) & 2047);
    unsigned char* ws = p.ws;
    bf16_t* dst;
    if (c < 1280) {
        const int cc = c - 1024, h = cc >> 6, d = cc & 63;
        dst = prompt ? (bf16_t*)(ws + OFF_DVTP) + (((size_t)b * 4 + h) * 64 + d) * SEQ + s
                     : (bf16_t*)(ws + OFF_DVTS) + (((size_t)b * 4 + h) * 64 + d) * NKS + s;
    } else {
        const int cc = c - 1920, kv = cc >> 6, d = cc & 63;
        dst = prompt ? (bf16_t*)(ws + OFF_GVTP) + (((size_t)b * 2 + kv) * 64 + d) * SEQ + s
                     : (bf16_t*)(ws + OFF_GVTS) + (((size_t)b * 2 + kv) * 64 + d) * NKS + s;
    }
    store_bf16x32(dst, v);
}

template <int MODE>
__device__ __forceinline__ void gemm_phase(const Params& p, int l, const bf16_t* __restrict__ A, const bf16_t* __restrict__ Bt, const int N, unsigned char* ldsraw, const int wv,
                                           const size_t cvstride = 0, const float* __restrict__ RSS = nullptr, const float* __restrict__ BIAS = nullptr) {
    using namespace g8;
    constexpr int K = 1024, nt = K / BK, BN = 128, TILE_A = BM * BK * 2, TILE_B = BN * BK * 2, STAGE_B = TILE_A + TILE_B;
    LAS unsigned char* lds = (LAS unsigned char*)ldsraw;
    const int tid = opaque_tid(wv), wid = wv, lane = tid & 63;
    const int wr = wid >> 1, wc = wid & 1, fr = lane & 15, fq = lane >> 4;
    unsigned voff[4];
#pragma unroll
    for (int i = 0; i < 4; ++i) voff[i] = (unsigned)((i * 64 + wid * 8 + (lane >> 3)) * K + (((lane & 7) ^ (lane >> 3)) * 8)) * 2u;
    const int aoff = (wr * 64 + fr) * 128 + ((fq ^ (fr & 7)) * 16), boff = (wc * 64 + fr) * 128 + ((fq ^ (fr & 7)) * 16);
    const unsigned ldsw = (unsigned)wid * 1024u;
#define G8_STAGE(buf, kt) do { \
        _Pragma("unroll") for (int _i = 0; _i < 4; ++_i) \
            __builtin_amdgcn_global_load_lds((const unsigned*)((const char*)(Ab + (kt) * BK) + voff[_i]), (LAS unsigned*)(lds + (buf) * STAGE_B + ldsw + _i * 8192), 16, 0, 0); \
        _Pragma("unroll") for (int _i = 0; _i < 2; ++_i) \
            __builtin_amdgcn_global_load_lds((const unsigned*)((const char*)(Bb + (kt) * BK) + voff[_i]), (LAS unsigned*)(lds + (buf) * STAGE_B + TILE_A + ldsw + _i * 8192), 16, 0, 0); } while (0)
#define G8_WAIT_V0() asm volatile("s_waitcnt vmcnt(0)" ::: "memory")
    const int nN = N / BN, nM = NTOK / BM, ntiles = nM * nN;
    const int G = gridDim.x;
    const int vb = (G % 8 == 0) ? (int)(blockIdx.x % 8) * (G / 8) + (int)(blockIdx.x / 8) : (int)blockIdx.x;
    const int tpb = (ntiles + G - 1) / G;
    const bool paneled = (G == 256) && (nN == 8 || nN == 16) && (nM == 64);
    for (int ti = 0; ti < tpb; ++ti) {
        int tile = vb * tpb + ti;
        if (paneled) {
            const int x = vb >> 5, j = vb & 31;
            const int mpx = nN == 16 ? 16 : 8;
            const int m0 = nN == 16 ? (x >> 1) * 16 : x * 8, n0 = nN == 16 ? (x & 1) * 8 : 0;
            const int pm_ = m0 + ti * 4 + (j >> 3), pn_ = n0 + (j & 7);
            tile = (ti * 4 < mpx) ? pm_ * nN + pn_ : ntiles;
        }
        if (tile >= ntiles) break;
        const int pm = tile / nN, pn = tile % nN, brow = pm * BM, bcol = pn * BN;
        const bf16_t* Ab = A + (size_t)brow * K; const bf16_t* Bb = Bt + (size_t)tok_cv(brow) * cvstride + (size_t)bcol * K;
        f32x4 acc[4][4];
#pragma unroll
        for (int m = 0; m < 4; ++m)
#pragma unroll
            for (int n = 0; n < 4; ++n) acc[m][n] = f32x4{0.f, 0.f, 0.f, 0.f};
        G8_WAIT_V0();
        G8_STAGE(0, 0); G8_STAGE(1, 1);
        int cur = 0;
        for (int t = 0; t < nt; ++t) {
            if (t + 1 < nt) asm volatile("s_waitcnt vmcnt(6)" ::: "memory"); else asm volatile("s_waitcnt vmcnt(0)" ::: "memory");
            __builtin_amdgcn_s_barrier();
            if (t + 2 < nt) { const int nb = cur >= 1 ? cur - 1 : 2; G8_STAGE(nb, t + 2); }
            {
                bf16x8 At[2][4], Bf[2][4];
#pragma unroll
                for (int ks = 0; ks < 2; ++ks) {
#pragma unroll
                    for (int m = 0; m < 4; ++m) At[ks][m] = *(const LAS bf16x8*)(lds + cur * STAGE_B + ((aoff + m * 2048) ^ (ks * 64)));
#pragma unroll
                    for (int n = 0; n < 4; ++n) Bf[ks][n] = *(const LAS bf16x8*)(lds + cur * STAGE_B + TILE_A + ((boff + n * 2048) ^ (ks * 64)));
                }
                __builtin_amdgcn_sched_barrier(0);
#pragma unroll
                for (int ks = 0; ks < 2; ++ks)
#pragma unroll
                    for (int m = 0; m < 4; ++m)
#pragma unroll
                        for (int n = 0; n < 4; ++n) acc[m][n] = __builtin_amdgcn_mfma_f32_16x16x32_bf16(At[ks][m], Bf[ks][n], acc[m][n], 0, 0, 0);
                __builtin_amdgcn_sched_barrier(0);
            }
            cur = cur == 2 ? 0 : cur + 1;
        }
        __syncthreads();
        LAS float* st = (LAS float*)lds;
        if (MODE != EPI_WOUT && cvstride != 0) {
            LAS float* rs = st + 256 * STG;
            if (tid < 256) {
                const float* rp = RSS + (size_t)(brow + tid) * 8;
                const float4 a = *reinterpret_cast<const float4*>(rp), b = *reinterpret_cast<const float4*>(rp + 4);
                rs[tid] = rsqrtf((((a.x + a.y) + (a.z + a.w)) + ((b.x + b.y) + (b.z + b.w))) * (1.f / D) + EPS);
            }
            __syncthreads();
            float bz[4];
#pragma unroll
            for (int n = 0; n < 4; ++n) bz[n] = BIAS[(size_t)tok_cv(brow) * N + bcol + wc * 64 + n * 16 + fr];
#pragma unroll
            for (int m = 0; m < 4; ++m)
#pragma unroll
                for (int j = 0; j < 4; ++j) {
                    const float r = rs[wr * 64 + m * 16 + fq * 4 + j];
#pragma unroll
                    for (int n = 0; n < 4; ++n) st[(wr * 64 + m * 16 + fq * 4 + j) * STG + wc * 64 + n * 16 + fr] = acc[m][n][j] * r + bz[n];
                }
        } else {
#pragma unroll
        for (int m = 0; m < 4; ++m)
#pragma unroll
            for (int n = 0; n < 4; ++n)
#pragma unroll
                for (int j = 0; j < 4; ++j)
                    st[(wr * 64 + m * 16 + fq * 4 + j) * STG + wc * 64 + n * 16 + fr] = acc[m][n][j];
        }
        __syncthreads();
        const bool tprompt = brow < NPT;
        const int tb_ = tprompt ? (brow >> 8) : ((brow - NPT) >> 11), ts0 = tprompt ? 0 : ((brow - NPT) & 2047);
        if (MODE == EPI_INPROJ) {
            const bool vtile = (bcol >= 1024 && bcol < 1280);
            if (!vtile) {
#pragma unroll 1
                for (int it = 0; it < 2; ++it) {
                    const int item = it * NT + tid, erow = item >> 2, eseg = item & 3;
                    float v[32];
#pragma unroll
                    for (int i = 0; i < 8; ++i) {
                        const f32x4 f = *(const LAS f32x4*)(st + erow * STG + eseg * 32 + i * 4);
                        v[i * 4] = f[0]; v[i * 4 + 1] = f[1]; v[i * 4 + 2] = f[2]; v[i * 4 + 3] = f[3];
                    }
                    epi_inproj_xform(p, l, brow + erow, bcol + eseg * 32, v);
#pragma unroll
                    for (int i = 0; i < 8; ++i) *(LAS f32x4*)(st + erow * STG + eseg * 32 + i * 4) = f32x4{v[i * 4], v[i * 4 + 1], v[i * 4 + 2], v[i * 4 + 3]};
                }
                __syncthreads();
#pragma unroll 1
                for (int it = 0; it < 8; ++it) {
                    const int item = it * NT + tid, r = item >> 4, c = (item & 15) * 8;
                    const f32x4 f0 = *(const LAS f32x4*)(st + r * STG + c), f1 = *(const LAS f32x4*)(st + r * STG + c + 4);
                    const int t = brow + r, sp = ts0 + r;
                    bf16_t* dst;
                    if (bcol < 512)        dst = (bf16_t*)(p.ws + (bcol < 256 ? OFF_AU : OFF_AV)) + (size_t)t * 256 + (bcol & 255) + c;
                    else if (bcol < 768)   dst = (bf16_t*)(p.ws + OFF_DQ) + (size_t)t * 256 + (bcol - 512) + c;
                    else if (bcol < 1024) { const int cc = bcol - 768 + c, h = cc >> 6;
                                            dst = tprompt ? (bf16_t*)(p.ws + OFF_DKP) + (((size_t)tb_ * 4 + h) * SEQ + sp) * 64 + (cc & 63)
                                                          : (bf16_t*)(p.ws + OFF_DKS) + (((size_t)tb_ * 4 + h) * NKS + sp) * 64 + (cc & 63); }
                    else if (bcol < 1792)  dst = (bf16_t*)(p.ws + OFF_GQ) + (size_t)t * 512 + (bcol - 1280) + c;
                    else                 { const int kv = c >> 6, d0 = c & 63;
                                            const size_t hb = (tprompt ? ((size_t)tb_ * 2 + kv) * SEQ * 64 : ((size_t)tb_ * 2 + kv) * NKS * 64) + (size_t)(sp >> 6) * 4096;
                                            dst = bcol < 1920 ? (bf16_t*)(p.ws + (tprompt ? OFF_GKP : OFF_GKS)) + hb + (d0 >> 3) * 512 + (sp & 63) * 8
                                                              : (bf16_t*)(p.ws + (tprompt ? OFF_GVTP : OFF_GVTS)) + hb + (d0 >> 5) * 2048 + (sp & 63) * 32 + (d0 & 31); }
                    *reinterpret_cast<u32x4*>(dst) = u32x4{pack_bf2(f0[0], f0[1]), pack_bf2(f0[2], f0[3]), pack_bf2(f1[0], f1[1]), pack_bf2(f1[2], f1[3])};
                }
            }
            if (tprompt && ((bcol >= 768 && bcol < 1280) || bcol >= 1792)) {
                float* ob; int rs;
                if (bcol < 1024)      { ob = p.out + OUT_NDK + (((size_t)tb_ * 2 + l) * SEQ) * 256 + (bcol - 768);  rs = 256; }
                else if (bcol < 1280) { ob = p.out + OUT_NDV + (((size_t)tb_ * 2 + l) * SEQ) * 256 + (bcol - 1024); rs = 256; }
                else if (bcol < 1920) { ob = p.out + OUT_NGK + (((size_t)tb_ * 2 + l) * SEQ) * 128;                 rs = 128; }
                else                  { ob = p.out + OUT_NGV + (((size_t)tb_ * 2 + l) * SEQ) * 128;                 rs = 128; }
#pragma unroll 1
                for (int it = 0; it < 16; ++it) {
                    const int item = it * NT + tid, r = item >> 5, c = (item & 31) * 4;
                    *reinterpret_cast<f32x4*>(ob + (size_t)r * rs + c) = *(const LAS f32x4*)(st + r * STG + c);
                }
            }
            if (vtile) {
#pragma unroll 1
                for (int it = 0; it < 2; ++it) {
                    const int item = it * NT + tid, col = item >> 3, run = item & 7;
                    epi_inproj_col(p, brow + run * 32, bcol + col, st + run * 32 * STG + col);
                }
            }
        } else {
#pragma unroll 1
            for (int it = 0; it < 8; ++it) {
                const int item = it * NT + tid, r = item >> 4, c = (item & 15) * 8;
                const f32x4 f0 = *(const LAS f32x4*)(st + r * STG + c), f1 = *(const LAS f32x4*)(st + r * STG + c + 4);
                const int t = brow + r;
                float o[8] = {f0[0], f0[1], f0[2], f0[3], f1[0], f1[1], f1[2], f1[3]};
                if (MODE == EPI_WOUT) {
                    const float* g1 = (const float*)(p.ws + OFF_MOD) + (size_t)(l * 5 + tok_cv(t)) * 6144 + 2048 + bcol + c;
                    const float4 ga = *reinterpret_cast<const float4*>(g1), gb = *reinterpret_cast<const float4*>(g1 + 4);
                    float x[8];
                    if (l == 0) {
                        const float* xr = x_in_row(p, t) + bcol + c;
                        const float4 xa = *reinterpret_cast<const float4*>(xr), xb2 = *reinterpret_cast<const float4*>(xr + 4);
                        x[0] = xa.x; x[1] = xa.y; x[2] = xa.z; x[3] = xa.w; x[4] = xb2.x; x[5] = xb2.y; x[6] = xb2.z; x[7] = xb2.w;
                    } else {
                        const u32x4 xw = *reinterpret_cast<const u32x4*>((const bf16_t*)(p.ws + OFF_XC) + (size_t)t * D + bcol + c);
#pragma unroll
                        for (int k = 0; k < 4; ++k) { x[2 * k] = __uint_as_float(xw[k] << 16); x[2 * k + 1] = __uint_as_float(xw[k] & 0xffff0000u); }
                    }
                    o[0] = x[0] + ga.x * o[0]; o[1] = x[1] + ga.y * o[1]; o[2] = x[2] + ga.z * o[2]; o[3] = x[3] + ga.w * o[3];
                    o[4] = x[4] + gb.x * o[4]; o[5] = x[5] + gb.y * o[5]; o[6] = x[6] + gb.z * o[6]; o[7] = x[7] + gb.w * o[7];
                    const float* gn = p.in[I_N2G] + l * D + bcol + c;
                    const float4 na = *reinterpret_cast<const float4*>(gn), nb = *reinterpret_cast<const float4*>(gn + 4);
                    const float4 sa = *reinterpret_cast<const float4*>(g1 + 2048), sb = *reinterpret_cast<const float4*>(g1 + 2048 + 4);
                    float xg[8] = {o[0] * na.x * (1.f + sa.x), o[1] * na.y * (1.f + sa.y), o[2] * na.z * (1.f + sa.z), o[3] * na.w * (1.f + sa.w),
                                   o[4] * nb.x * (1.f + sb.x), o[5] * nb.y * (1.f + sb.y), o[6] * nb.z * (1.f + sb.z), o[7] * nb.w * (1.f + sb.w)};
                    float ss = 0.f, am = 0.f;
#pragma unroll
                    for (int i = 0; i < 8; ++i) { ss += o[i] * o[i]; am = fmaxf(am, fabsf(xg[i])); }
                    ss = row16_sum(ss); am = row16_max(am);
                    const float sc8 = am > 0.f ? 127.f / am : 1.f;
                    uint2 w8;
                    w8.x = pack4_i8(q8(xg[0] * sc8), q8(xg[1] * sc8), q8(xg[2] * sc8), q8(xg[3] * sc8));
                    w8.y = pack4_i8(q8(xg[4] * sc8), q8(xg[5] * sc8), q8(xg[6] * sc8), q8(xg[7] * sc8));
                    *reinterpret_cast<uint2*>(p.ws + OFF_H8I + (size_t)t * D + bcol + c) = w8;
                    if ((item & 15) == 0) {
                        ((float*)(p.ws + OFF_RSS2))[((size_t)l * NTOK + t) * 8 + pn] = ss;
                        ((float*)(p.ws + OFF_XGS))[(size_t)t * 8 + pn] = am > 0.f ? am * (1.f / 127.f) : 1.f;
                    }
                }
                bf16_t* dst = (bf16_t*)(p.ws + (MODE == EPI_WOUT ? OFF_XC : OFF_Q)) + (size_t)t * D + bcol + c;
                *reinterpret_cast<u32x4*>(dst) = u32x4{pack_bf2(o[0], o[1]), pack_bf2(o[2], o[3]), pack_bf2(o[4], o[5]), pack_bf2(o[6], o[7])};
            }
        }
        __syncthreads();
    }
}


#define MFMA32(a, b, c) __builtin_amdgcn_mfma_f32_32x32x16_bf16((a), (b), (c), 0, 0, 0)
constexpr int ATT_ROWB = 144;
constexpr int ATT_TILEB = 64 * ATT_ROWB;
constexpr int QW_MIX = 4096;

__device__ __forceinline__ bf16x8 pack8(const f32x16& x, int s) {
    const u32x4 w = {pack_bf2(x[8 * s], x[8 * s + 1]), pack_bf2(x[8 * s + 2], x[8 * s + 3]), pack_bf2(x[8 * s + 4], x[8 * s + 5]), pack_bf2(x[8 * s + 6], x[8 * s + 7])};
    return __builtin_bit_cast(bf16x8, w);
}
__device__ __forceinline__ void softmax_tile(f32x16& s0, f32x16& s1, const float sc, float& m, float& l, float& alpha, const int lane) {
    float mx = fmaxf(s0[0], s1[0]);
#pragma unroll
    for (int i = 1; i < 16; ++i) mx = fmaxf(mx, fmaxf(s0[i], s1[i]));
    mx = fmaxf(mx, shfl_x(mx, lane, 32));
    const float mnew = fmaxf(m, mx * sc);
    alpha = __builtin_amdgcn_exp2f(m - mnew);
    m = mnew;
    float ps = 0.f;
#pragma unroll
    for (int i = 0; i < 16; ++i) { s0[i] = __builtin_amdgcn_exp2f(s0[i] * sc - mnew); s1[i] = __builtin_amdgcn_exp2f(s1[i] * sc - mnew); ps += s0[i] + s1[i]; }
    l = l * alpha + ps;
}
__device__ __forceinline__ void v_frags(const LAS unsigned char* vb, bf16x8 (&vf)[8], int r, int hh) {
#pragma unroll
    for (int u = 0; u < 2; ++u)
#pragma unroll
        for (int sk = 0; sk < 2; ++sk)
#pragma unroll
            for (int mt = 0; mt < 2; ++mt) {
                const LAS unsigned char* a = vb + (32 * mt + r) * ATT_ROWB + (32 * u + 16 * sk + 4 * hh) * 2;
                const s16x4 lo = *(const LAS s16x4*)a, hi = *(const LAS s16x4*)(a + 16);
                vf[(u * 2 + sk) * 2 + mt] = bf16x8{lo[0], lo[1], lo[2], lo[3], hi[0], hi[1], hi[2], hi[3]};
            }
}
__device__ __forceinline__ void pv_tile(const bf16x8 (&vf)[8], const f32x16& p0, const f32x16& p1, f32x16 (&O)[2]) {
#pragma unroll
    for (int u = 0; u < 2; ++u)
#pragma unroll
        for (int sk = 0; sk < 2; ++sk) {
            const bf16x8 pf = pack8(u ? p1 : p0, sk);
#pragma unroll
            for (int mt = 0; mt < 2; ++mt) O[mt] = MFMA32(vf[(u * 2 + sk) * 2 + mt], pf, O[mt]);
        }
}

template <bool DIFF>
__device__ __forceinline__ void attn_item(const Params& p, int l, LAS unsigned char* lds, const int tid,
                                          const bf16_t* __restrict__ Qg, const int qstride,
                                          const bf16_t* __restrict__ Kg, const bf16_t* __restrict__ Vtg, const int nk,
                                          bf16_t* __restrict__ Og, const float lam) {
    const int wave = tid >> 6, lane = tid & 63, r = lane & 31, hh = lane >> 5;
    const int lrow = tid >> 3, lchunk = tid & 7;
    LAS unsigned char* kbuf = lds; LAS unsigned char* vbuf = lds + 2 * ATT_TILEB;
    bf16x8 qf[4];
    const bf16_t* qrow = Qg + (size_t)(wave * 32 + r) * qstride;
#pragma unroll
    for (int ks = 0; ks < 4; ++ks) qf[ks] = *reinterpret_cast<const bf16x8*>(qrow + ks * 16 + hh * 8);
    const float sc = (DIFF ? 0.17677669529663687f : 0.125f) * 1.4426950408889634f;
    f32x16 O0[2], O1[2];
#pragma unroll
    for (int mt = 0; mt < 2; ++mt)
#pragma unroll
        for (int i = 0; i < 16; ++i) { O0[mt][i] = 0.f; O1[mt][i] = 0.f; }
    float m0 = -1e30f, l0 = 0.f, m1 = -1e30f, l1 = 0.f;
    const int ntl = nk / 64;
    u32x4 kr, vr, kn, vn;
    kr = *reinterpret_cast<const u32x4*>(Kg + (size_t)lrow * 64 + lchunk * 8);
    vr = *reinterpret_cast<const u32x4*>(Vtg + (size_t)lrow * nk + lchunk * 8);
    *(LAS u32x4*)(kbuf + lrow * ATT_ROWB + lchunk * 16) = kr;
    *(LAS u32x4*)(vbuf + lrow * ATT_ROWB + lchunk * 16) = vr;
    {
        const int t1 = ntl > 1 ? 1 : 0;
        kr = *reinterpret_cast<const u32x4*>(Kg + (size_t)(t1 * 64 + lrow) * 64 + lchunk * 8);
        vr = *reinterpret_cast<const u32x4*>(Vtg + (size_t)lrow * nk + t1 * 64 + lchunk * 8);
    }
    __syncthreads();
    for (int ti = 0; ti < ntl; ++ti) {
        const int cur = ti & 1;
        {
            const int t2 = ti + 2 < ntl ? ti + 2 : ntl - 1;
            kn = *reinterpret_cast<const u32x4*>(Kg + (size_t)(t2 * 64 + lrow) * 64 + lchunk * 8);
            vn = *reinterpret_cast<const u32x4*>(Vtg + (size_t)lrow * nk + t2 * 64 + lchunk * 8);
        }
        const LAS unsigned char* kb = kbuf + cur * ATT_TILEB; const LAS unsigned char* vb = vbuf + cur * ATT_TILEB;
        bf16x8 ka[2][4];
#pragma unroll
        for (int u = 0; u < 2; ++u)
#pragma unroll
            for (int ks = 0; ks < 4; ++ks) ka[u][ks] = *(const LAS bf16x8*)(kb + (32 * u + r) * ATT_ROWB + (ks * 16 + hh * 8) * 2);
        __builtin_amdgcn_sched_barrier(0);
        bf16x8 vf[8];
        if (!DIFF) {
            f32x16 s0, s1;
#pragma unroll
            for (int i = 0; i < 16; ++i) { s0[i] = 0.f; s1[i] = 0.f; }
#pragma unroll
            for (int ks = 0; ks < 4; ++ks) { s0 = MFMA32(ka[0][ks], qf[ks], s0); s1 = MFMA32(ka[1][ks], qf[ks], s1); }
            v_frags(vb, vf, r, hh);
            __builtin_amdgcn_sched_barrier(0);
            float alpha;
            softmax_tile(s0, s1, sc, m0, l0, alpha, lane);
            if (__builtin_amdgcn_ballot_w64(alpha != 1.f) != 0ull) {
#pragma unroll
                for (int mt = 0; mt < 2; ++mt)
#pragma unroll
                    for (int i = 0; i < 16; ++i) O0[mt][i] *= alpha;
            }
            pv_tile(vf, s0, s1, O0);
        } else {
            f32x16 s0, s1, t0, t1;
#pragma unroll
            for (int i = 0; i < 16; ++i) { s0[i] = 0.f; s1[i] = 0.f; t0[i] = 0.f; t1[i] = 0.f; }
#pragma unroll
            for (int ks = 0; ks < 2; ++ks) {
                s0 = MFMA32(ka[0][ks], qf[ks], s0); s1 = MFMA32(ka[1][ks], qf[ks], s1);
                t0 = MFMA32(ka[0][2 + ks], qf[2 + ks], t0); t1 = MFMA32(ka[1][2 + ks], qf[2 + ks], t1);
            }
            v_frags(vb, vf, r, hh);
            __builtin_amdgcn_sched_barrier(0);
            float alpha;
            softmax_tile(s0, s1, sc, m0, l0, alpha, lane);
            if (__builtin_amdgcn_ballot_w64(alpha != 1.f) != 0ull) {
#pragma unroll
                for (int mt = 0; mt < 2; ++mt)
#pragma unroll
                    for (int i = 0; i < 16; ++i) O0[mt][i] *= alpha;
            }
            pv_tile(vf, s0, s1, O0);
            softmax_tile(t0, t1, sc, m1, l1, alpha, lane);
            if (__builtin_amdgcn_ballot_w64(alpha != 1.f) != 0ull) {
#pragma unroll
                for (int mt = 0; mt < 2; ++mt)
#pragma unroll
                    for (int i = 0; i < 16; ++i) O1[mt][i] *= alpha;
            }
            pv_tile(vf, t0, t1, O1);
        }
        if (ti + 1 < ntl) {
            *(LAS u32x4*)(kbuf + (cur ^ 1) * ATT_TILEB + lrow * ATT_ROWB + lchunk * 16) = kr;
            *(LAS u32x4*)(vbuf + (cur ^ 1) * ATT_TILEB + lrow * ATT_ROWB + lchunk * 16) = vr;
        }
        kr = kn; vr = vn;
        __syncthreads();
    }
    l0 += shfl_x(l0, lane, 32);
    const float inv0 = 1.f / l0;
    LAS unsigned char* ob = lds + wave * 4608;
    if (!DIFF) {
#pragma unroll
        for (int mt = 0; mt < 2; ++mt)
#pragma unroll
            for (int g = 0; g < 4; ++g) {
                u32x2 w;
                w[0] = pack_bf2(O0[mt][4 * g] * inv0, O0[mt][4 * g + 1] * inv0);
                w[1] = pack_bf2(O0[mt][4 * g + 2] * inv0, O0[mt][4 * g + 3] * inv0);
                *(LAS u32x2*)(ob + r * 144 + (32 * mt + 8 * g + 4 * hh) * 2) = w;
            }
    } else {
        l1 += shfl_x(l1, lane, 32);
        const float inv1 = lam / l1;
        float ss = 0.f;
#pragma unroll
        for (int mt = 0; mt < 2; ++mt)
#pragma unroll
            for (int i = 0; i < 16; ++i) { const float o = O0[mt][i] * inv0 - O1[mt][i] * inv1; O0[mt][i] = o; ss += o * o; }
        ss += shfl_x(ss, lane, 32);
        const float rr = rsqrtf(ss * (1.f / 64.f) + EPS) * __builtin_bit_cast(float, __builtin_amdgcn_readfirstlane(__builtin_bit_cast(int, 1.f - lam_init_of(l))));
        const float* sg = p.in[I_SUBLN] + l * 64;
#pragma unroll
        for (int mt = 0; mt < 2; ++mt)
#pragma unroll
            for (int g = 0; g < 4; ++g) {
                const int d0 = 32 * mt + 8 * g + 4 * hh;
                const float4 gg = *reinterpret_cast<const float4*>(sg + d0);
                u32x2 w;
                w[0] = pack_bf2(O0[mt][4 * g] * rr * gg.x, O0[mt][4 * g + 1] * rr * gg.y);
                w[1] = pack_bf2(O0[mt][4 * g + 2] * rr * gg.z, O0[mt][4 * g + 3] * rr * gg.w);
                *(LAS u32x2*)(ob + r * 144 + d0 * 2) = w;
            }
    }
#pragma unroll
    for (int ps = 0; ps < 4; ++ps) {
        const int row = ps * 8 + (lane >> 3), ch = lane & 7;
        *reinterpret_cast<u32x4*>(Og + (size_t)(wave * 32 + row) * D + ch * 8) = *(const LAS u32x4*)(ob + row * 144 + ch * 16);
    }
}

namespace ga {
constexpr float C2 = 0.125f * 1.4426950408889634f;
constexpr int SLOTB = 8192, LDS_K = 0, LDS_V = 3 * SLOTB, LDS_WS = 6 * SLOTB, LDS_OST = LDS_WS + 8 * 256;
typedef __attribute__((address_space(3))) const char* lds_cptr;
typedef short v4i16_t __attribute__((ext_vector_type(4)));
using s16x4 = __attribute__((ext_vector_type(4))) short;
__device__ __forceinline__ int crow(int r, int hi) { return (r & 3) + 8 * (r >> 2) + 4 * hi; }
__device__ __forceinline__ void glds16(const void* g, unsigned lds_base) {
    unsigned sv; asm volatile("s_mov_b32 %0, m0\n\ts_mov_b32 m0, %2\n\ts_nop 0\n\tglobal_load_lds_dwordx4 %1, off\n\ts_mov_b32 m0, %0" : "=&s"(sv) : "v"(g), "s"(lds_base) : "memory"); }
__device__ __forceinline__ void kload2(bf16x8* kf, lds_cptr kp, int d0) { kf[2 * d0] = *(const LAS bf16x8*)(kp + d0 * 2048); kf[2 * d0 + 1] = *(const LAS bf16x8*)(kp + d0 * 2048 + 512); }
__device__ __forceinline__ s16x4 vtr(lds_cptr p) { return __builtin_bit_cast(s16x4, __builtin_amdgcn_ds_read_tr16_b64_v4i16((LAS v4i16_t*)p)); }
#define GA_MX3(a, b, c) __builtin_fmaxf(__builtin_fmaxf((a), (b)), (c))
__device__ __forceinline__ float rowmax(const f32x16& p0, const f32x16& p1) {
    float a = GA_MX3(p0[0], p0[1], p1[0]), b = GA_MX3(p0[2], p0[3], p1[1]); a = GA_MX3(a, p1[2], p1[3]);
#pragma unroll
    for (int r = 4; r < 16; r += 4) { a = GA_MX3(a, p0[r], p0[r + 1]); b = GA_MX3(b, p0[r + 2], p0[r + 3]); a = GA_MX3(a, p1[r], p1[r + 1]); b = GA_MX3(b, p1[r + 2], p1[r + 3]); }
    float m = __builtin_fmaxf(a, b); auto rr = __builtin_amdgcn_permlane32_swap(__float_as_uint(m), __float_as_uint(m), false, false);
    return __builtin_fmaxf(__uint_as_float(rr[0]), __uint_as_float(rr[1])); }
}
#define GA_SBAR() __builtin_amdgcn_sched_barrier(0)
#define GA_PIN(x) asm volatile("" : "+v"(x))
#define GA_WAIT_BAR(N) asm volatile("s_waitcnt vmcnt(" #N ") lgkmcnt(0)\n\ts_barrier" ::: "memory")
#define GA_THR 8
__device__ __forceinline__ void gqa_unit(LAS unsigned char* ldsl, const int tid, const int wid, const bf16_t* __restrict__ Qw0, const int qstride,
                                         const unsigned char* __restrict__ Kimg, const unsigned char* __restrict__ Vimg, const int NT, bf16_t* __restrict__ Og) {
    using namespace ga;
    const int lane = tid & 63, r32 = lane & 31, hi = lane >> 5;
    const bf16_t* Qw = Qw0 + (size_t)(wid * 32) * qstride;
    const unsigned lds0 = (unsigned)(size_t)ldsl; LAS float* wsf = (LAS float*)(ldsl + LDS_WS) + wid * 64;
    const unsigned char* ksrc = Kimg + wid * 1024 + lane * 16;
    const unsigned char* vsrc = Vimg + wid * 1024 + lane * 16;
    const unsigned kdst = lds0 + LDS_K + wid * 1024, vdst = lds0 + LDS_V + wid * 1024;
#define DMA_K(t, slot) glds16(ksrc + (size_t)(t) * SLOTB, (unsigned)__builtin_amdgcn_readfirstlane(kdst + (slot)))
#define DMA_V(t, slot) glds16(vsrc + (size_t)(t) * SLOTB, (unsigned)__builtin_amdgcn_readfirstlane(vdst + (slot)))
    const lds_cptr vp0 = (lds_cptr)ldsl + LDS_V + ((lane >> 4) & 1) * 32 + (lane & 3) * 8 + (4 * hi + ((lane & 15) >> 2)) * 64;
    const lds_cptr kp0 = (lds_cptr)ldsl + LDS_K + hi * 1024 + r32 * 16;
    DMA_K(0, 0); DMA_V(0, 0); DMA_K(1, SLOTB);
    bf16x8 qr[4];
#pragma unroll
    for (int d0 = 0; d0 < 4; ++d0) qr[d0] = *reinterpret_cast<const bf16x8*>(&Qw[(size_t)r32 * qstride + d0 * 16 + hi * 8]);
    float mhat = 0.f, l_reg = 0.f; f32x16 o[2];
#pragma unroll
    for (int i = 0; i < 16; ++i) { o[0][i] = 0.f; o[1][i] = 0.f; }
    f32x16 zero16;
#pragma unroll
    for (int i = 0; i < 16; ++i) zero16[i] = 0.f;
    GA_PIN(zero16);
    bool resc = false;
    f32x16 pA0, pA1, pB0, pB1; bf16x8 kf[8]; s16x4 vlo[8], vhi[8]; u32x4 pw0, pw1, pw2, pw3;
    int sl_prev = 0, sl_cur = 0, sl_next = SLOTB;
#define ROT() do { sl_prev = sl_cur; sl_cur = sl_next; sl_next = (sl_next == 2 * SLOTB) ? 0 : sl_next + SLOTB; } while (0)
#define EX(v) __builtin_amdgcn_exp2f(v)
#define RESC() do { if (resc) { _Pragma("unroll") for (int d_ = 0; d_ < 2; ++d_) _Pragma("unroll") for (int r = 0; r < 16; ++r) o[d_][r] *= wsf[crow(r, hi)]; } } while (0)
    DMA_K(2, 2 * SLOTB);
    GA_WAIT_BAR(3);
    _Pragma("unroll") for (int d0 = 0; d0 < 4; ++d0) kload2(kf, kp0, d0);
    pA0 = MFMA32(kf[0], qr[0], zero16); pA1 = MFMA32(kf[1], qr[0], zero16); pA0 = MFMA32(kf[2], qr[1], pA0); pA1 = MFMA32(kf[3], qr[1], pA1);
    pA0 = MFMA32(kf[4], qr[2], pA0); pA1 = MFMA32(kf[5], qr[2], pA1); pA0 = MFMA32(kf[6], qr[3], pA0); pA1 = MFMA32(kf[7], qr[3], pA1);
    { const float rm = rowmax(pA0, pA1); mhat = rm; const float nmh = -mhat;
#pragma unroll
      for (int r = 0; r < 16; ++r) { pA0[r] = EX(pA0[r] + nmh); pA1[r] = EX(pA1[r] + nmh); }
#pragma unroll
      for (int r = 0; r < 16; ++r) zero16[r] = nmh;
      GA_PIN(zero16); }
    GA_WAIT_BAR(0);
    DMA_K(3, 0); DMA_V(1, SLOTB); ROT();
    _Pragma("unroll") for (int d0 = 0; d0 < 4; ++d0) kload2(kf, kp0 + sl_cur, d0);
    GA_WAIT_BAR(2);
#define PKW(P, i) pack_bf2(P[i], P[i + 1])
#define PAF(k) __builtin_bit_cast(bf16x8, pw##k)
#define VFR(i) (bf16x8){vlo[i][0], vlo[i][1], vlo[i][2], vlo[i][3], vhi[i][0], vhi[i][1], vhi[i][2], vhi[i][3]}
#define VRD(i) do { vlo[i] = vtr(vp_ + (((i) >> 2) * 4096 + ((i) & 3) * 1024)); vhi[i] = vtr(vp_ + (((i) >> 2) * 4096 + ((i) & 3) * 1024 + 512)); } while (0)
#define KRD(G, d0) do { if (G) { kload2(kf, kp0 + sl_next, d0); GA_SBAR(); } } while (0)
#define GAPA(MF, a0, a1, a2, a3, W0, W1, PW) do { MF; sacc += a0; sacc += a1; sacc += a2; sacc += a3; W0; W1; GA_PIN(PW); GA_PIN(sacc); GA_SBAR(); } while (0)
#define GAPB(MF, X, i) do { MF; X[i] = EX(X[i]); X[i + 1] = EX(X[i + 1]); X[i + 2] = EX(X[i + 2]); X[i + 3] = EX(X[i + 3]); GA_PIN(X); GA_SBAR(); } while (0)
#define STEP(C0, C1, P0, P1, t, GK, GV, GL) do { GA_SBAR(); \
    const lds_cptr vp_ = vp0 + sl_prev; \
    VRD(0); GA_SBAR(); float sacc = P0[0] + P0[1]; \
                       GAPA(C0 = MFMA32(kf[0], qr[0], zero16), P0[2], P0[3], P0[4], P0[5],     pw0[0] = PKW(P0, 0),  pw0[1] = PKW(P0, 2),  pw0); \
    VRD(4); GA_SBAR(); GAPA(C1 = MFMA32(kf[1], qr[0], zero16), P0[6], P0[7], P0[8], P0[9],     pw0[2] = PKW(P0, 4),  pw0[3] = PKW(P0, 6),  pw0); \
    VRD(1); GA_SBAR(); GAPA(C0 = MFMA32(kf[2], qr[1], C0),    P0[10], P0[11], P0[12], P0[13], pw1[0] = PKW(P0, 8),  pw1[1] = PKW(P0, 10), pw1); \
    VRD(5); GA_SBAR(); GAPA(C1 = MFMA32(kf[3], qr[1], C1),    P0[14], P0[15], P1[0], P1[1],   pw1[2] = PKW(P0, 12), pw1[3] = PKW(P0, 14), pw1); \
    VRD(2); GA_SBAR(); GAPA(C0 = MFMA32(kf[4], qr[2], C0),    P1[2], P1[3], P1[4], P1[5],     pw2[0] = PKW(P1, 0),  pw2[1] = PKW(P1, 2),  pw2); \
    VRD(6); GA_SBAR(); GAPA(C1 = MFMA32(kf[5], qr[2], C1),    P1[6], P1[7], P1[8], P1[9],     pw2[2] = PKW(P1, 4),  pw2[3] = PKW(P1, 6),  pw2); \
    VRD(3); GA_SBAR(); GAPA(C0 = MFMA32(kf[6], qr[3], C0),    P1[10], P1[11], P1[12], P1[13], pw3[0] = PKW(P1, 8),  pw3[1] = PKW(P1, 10), pw3); \
    VRD(7); GA_SBAR(); GAPA(C1 = MFMA32(kf[7], qr[3], C1),    P1[14], P1[15], 0.f, 0.f,       pw3[2] = PKW(P1, 12), pw3[3] = PKW(P1, 14), pw3); \
    l_reg += sacc; \
    if (GK) DMA_K((t) + 3, sl_cur); if (GV) DMA_V((t) + 1, sl_next); \
    { const float rm = rowmax(C0, C1); resc = false;                                             \
      if (__builtin_expect(__any(rm > (float)GA_THR), 0)) { const float dl = __builtin_fmaxf(rm, 0.f); mhat += dl; \
          const float f = __builtin_amdgcn_exp2f(-dl); l_reg *= f; if (hi == 0) wsf[r32] = f; resc = true; \
          _Pragma("unroll") for (int r_ = 0; r_ < 16; ++r_) { C0[r_] -= dl; C1[r_] -= dl; zero16[r_] = -mhat; } GA_PIN(zero16); } } \
    GA_SBAR(); \
    GAPB(o[0] = MFMA32(PAF(0), VFR(0), o[0]), C0, 0);              GAPB(o[1] = MFMA32(PAF(0), VFR(4), o[1]), C0, 4); \
    KRD(GL, 0); GAPB(o[0] = MFMA32(PAF(1), VFR(1), o[0]), C0, 8);  KRD(GL, 1); GAPB(o[1] = MFMA32(PAF(1), VFR(5), o[1]), C0, 12); \
    KRD(GL, 2); GAPB(o[0] = MFMA32(PAF(2), VFR(2), o[0]), C1, 0);  KRD(GL, 3); GAPB(o[1] = MFMA32(PAF(2), VFR(6), o[1]), C1, 4); \
    GAPB(o[0] = MFMA32(PAF(3), VFR(3), o[0]), C1, 8);              GAPB(o[1] = MFMA32(PAF(3), VFR(7), o[1]), C1, 12); \
    } while (0)
    int t = 1;
    for (; t + 5 < NT; t += 2) {
        STEP(pB0, pB1, pA0, pA1, t, true, true, true);     GA_WAIT_BAR(2); RESC(); ROT();
        STEP(pA0, pA1, pB0, pB1, t + 1, true, true, true); GA_WAIT_BAR(2); RESC(); ROT();
    }
#define ENDW(tt) do { if ((tt) + 3 < NT) { GA_WAIT_BAR(2); } else if ((tt) + 2 < NT) { GA_WAIT_BAR(1); } else { GA_WAIT_BAR(0); } } while (0)
    for (; t + 1 < NT; t += 2) {
        STEP(pB0, pB1, pA0, pA1, t, (t + 3 < NT), (t + 1 < NT), (t + 1 < NT));         ENDW(t);     RESC(); ROT();
        STEP(pA0, pA1, pB0, pB1, t + 1, (t + 4 < NT), (t + 2 < NT), (t + 2 < NT));     ENDW(t + 1); RESC(); ROT();
    }
    STEP(pB0, pB1, pA0, pA1, NT - 1, false, false, false); RESC();
    { float sacc = pB0[0] + pB0[1];
#pragma unroll
      for (int r = 2; r < 16; ++r) sacc += pB0[r];
#pragma unroll
      for (int r = 0; r < 16; ++r) sacc += pB1[r];
      l_reg += sacc;
      pw0 = (u32x4){PKW(pB0, 0), PKW(pB0, 2), PKW(pB0, 4), PKW(pB0, 6)}; pw1 = (u32x4){PKW(pB0, 8), PKW(pB0, 10), PKW(pB0, 12), PKW(pB0, 14)};
      pw2 = (u32x4){PKW(pB1, 0), PKW(pB1, 2), PKW(pB1, 4), PKW(pB1, 6)}; pw3 = (u32x4){PKW(pB1, 8), PKW(pB1, 10), PKW(pB1, 12), PKW(pB1, 14)};
      const lds_cptr vp_ = vp0 + sl_cur; _Pragma("unroll") for (int i = 0; i < 8; ++i) VRD(i);
      o[0] = MFMA32(PAF(0), VFR(0), o[0]); o[1] = MFMA32(PAF(0), VFR(4), o[1]); o[0] = MFMA32(PAF(1), VFR(1), o[0]); o[1] = MFMA32(PAF(1), VFR(5), o[1]);
      o[0] = MFMA32(PAF(2), VFR(2), o[0]); o[1] = MFMA32(PAF(2), VFR(6), o[1]); o[0] = MFMA32(PAF(3), VFR(3), o[0]); o[1] = MFMA32(PAF(3), VFR(7), o[1]); }
    { auto rr = __builtin_amdgcn_permlane32_swap(__float_as_uint(l_reg), __float_as_uint(l_reg), false, false); l_reg = __uint_as_float(rr[0]) + __uint_as_float(rr[1]); }
    if (hi == 0) wsf[32 + r32] = l_reg;
    asm volatile("s_waitcnt lgkmcnt(0)" ::: "memory");
    float rli[16];
#pragma unroll
    for (int r = 0; r < 16; ++r) rli[r] = __builtin_amdgcn_rcpf(wsf[32 + crow(r, hi)]);
    bf16_t* Ow = Og + (size_t)(wid * 32) * D; LAS bf16_t* stg = (LAS bf16_t*)(ldsl + LDS_OST) + wid * 2048;
#pragma unroll
    for (int r = 0; r < 16; ++r) { const int orow = crow(r, hi);
#pragma unroll
        for (int d0 = 0; d0 < 2; ++d0) stg[orow * 64 + d0 * 32 + r32] = f2bf(o[d0][r] * rli[r]); }
    asm volatile("s_waitcnt lgkmcnt(0)" ::: "memory");
#pragma unroll
    for (int i = 0; i < 4; ++i) { const int row = i * 8 + (lane >> 3), ch = lane & 7; *reinterpret_cast<u32x4*>(Ow + (size_t)row * D + ch * 8) = *(const LAS u32x4*)(stg + row * 64 + ch * 8); }
    asm volatile("s_waitcnt lgkmcnt(0)\n\ts_barrier" ::: "memory");
#undef DMA_K
#undef DMA_V
#undef ROT
#undef EX
#undef RESC
#undef PKW
#undef PAF
#undef VFR
#undef VRD
#undef KRD
#undef ENDW
#undef GAPA
#undef GAPB
#undef STEP
}

constexpr int SGU_ROWB = 272;
__device__ __forceinline__ void sgu_item(const Params& p, int l, LAS unsigned char* lds, const int tid, const int t0) {
    const bf16_t* AV = (const bf16_t*)(p.ws + OFF_AV) + (size_t)t0 * 256;
    {
        const int q = tid >> 2, quarter = tid & 3;
        float v[64]; float ss = 0.f;
#pragma unroll
        for (int i = 0; i < 8; ++i) {
            const bf16x8 w = *reinterpret_cast<const bf16x8*>(AV + (size_t)q * 256 + quarter * 64 + i * 8);
#pragma unroll
            for (int j = 0; j < 8; ++j) { v[i * 8 + j] = bf2f((bf16_t)w[j]); ss += v[i * 8 + j] * v[i * 8 + j]; }
        }
        { const int ln = tid & 63; ss += shfl_x(ss, ln, 1); ss += shfl_x(ss, ln, 2); }
        const float rstd = rsqrtf(ss * (1.f / 256.f) + EPS);
        const float* g = p.in[I_SGUNG] + l * 256 + quarter * 64;
#pragma unroll
        for (int i = 0; i < 64; ++i)
            *(LAS bf16_t*)(lds + (quarter * 64 + i) * SGU_ROWB + q * 2) = f2bf(v[i] * rstd * g[i]);
    }
    __syncthreads();
    {
        const int wave = tid >> 6, lane = tid & 63, r = lane & 31, hh = lane >> 5;
        const int g = wave >> 1, ph = wave & 1;
        const bf16_t* W = (const bf16_t*)(p.ws + OFF_SGUW) + ((size_t)l * 4 + g) * 128 * 128;
        f32x16 acc[2][2];
#pragma unroll
        for (int a = 0; a < 2; ++a)
#pragma unroll
            for (int b = 0; b < 2; ++b)
#pragma unroll
                for (int i = 0; i < 16; ++i) acc[a][b][i] = 0.f;
#pragma unroll
        for (int ks = 0; ks < 8; ++ks) {
            bf16x8 af[2], bfr[2];
#pragma unroll
            for (int pt = 0; pt < 2; ++pt) af[pt] = *reinterpret_cast<const bf16x8*>(W + (size_t)(ph * 64 + pt * 32 + r) * 128 + ks * 16 + hh * 8);
#pragma unroll
            for (int ct = 0; ct < 2; ++ct) bfr[ct] = *(const LAS bf16x8*)(lds + (g * 64 + ct * 32 + r) * SGU_ROWB + (ks * 16 + hh * 8) * 2);
#pragma unroll
            for (int pt = 0; pt < 2; ++pt)
#pragma unroll
                for (int ct = 0; ct < 2; ++ct) acc[pt][ct] = MFMA32(af[pt], bfr[ct], acc[pt][ct]);
        }
        const float* bias = p.in[I_SGUB] + (l * 4 + g) * 128;
        const bf16_t* AU = (const bf16_t*)(p.ws + OFF_AU);
        bf16_t* MIX = (bf16_t*)(p.ws + OFF_MIX);
#pragma unroll
        for (int pt = 0; pt < 2; ++pt)
#pragma unroll
            for (int ct = 0; ct < 2; ++ct)
#pragma unroll
                for (int i = 0; i < 16; ++i) {
                    const int pp = ph * 64 + pt * 32 + (i & 3) + 8 * (i >> 2) + 4 * hh, c = g * 64 + ct * 32 + r;
                    const float au = bf2f(AU[(size_t)(t0 + pp) * 256 + c]);
                    MIX[(size_t)(t0 + pp) * D + c] = f2bf(au * (acc[pt][ct][i] + bias[pp]));
                }
    }
    __syncthreads();
}

__device__ void ph_mixers(const Params& p, int lq, unsigned char* ldsraw, const int wv) {
    const int l = lq & 1;
    const int tid0 = opaque_tid(wv);
    LAS unsigned char* lds = (LAS unsigned char*)ldsraw;
    volatile LAS int* qslot = (volatile LAS int*)(ldsraw - LDS_HDR + 64);
    unsigned* qw = (unsigned*)(p.ws + OFF_BAR) + QW_MIX + lq;
    const float lam = __builtin_bit_cast(float, __builtin_amdgcn_readfirstlane(__builtin_bit_cast(int, lam_of(p, l))));
    unsigned char* ws = p.ws;
    for (;;) {
        if (tid0 == 0) *qslot = (int)atomicAdd(qw, 1u);
        __syncthreads();
        const int item = *qslot;
        __syncthreads();
        if (item >= 896) break;
        if (lq >= 2 && PROBE_DUP >= 10) {
            const int cls = item < 128 ? 10 : (item < 384 ? 11 : 12);
            if (cls != PROBE_DUP) continue;
        }
        int tid = tid0; asm volatile("" : "+v"(tid));
        if (item < 128) {
            const int qc = item & 7, h = (item >> 3) & 3, b = item >> 5;
            const int t0 = NPT + b * DSEQ + qc * 256;
            attn_item<true>(p, l, lds, tid, (const bf16_t*)(ws + OFF_DQ) + (size_t)t0 * 256 + h * 64, 256,
                            (const bf16_t*)(ws + OFF_DKS) + ((size_t)b * 4 + h) * NKS * 64, (const bf16_t*)(ws + OFF_DVTS) + ((size_t)b * 4 + h) * 64 * NKS, NKS,
                            (bf16_t*)(ws + OFF_MIX) + (size_t)t0 * D + 256 + h * 64, lam);
        } else if (item < 384) {
            const int it = item - 128, qc = it & 7, hq = (it >> 3) & 7, b = it >> 6, kv = hq >> 2;
            const int t0 = NPT + b * DSEQ + qc * 256;
            gqa_unit(lds, tid, wv, (const bf16_t*)(ws + OFF_GQ) + (size_t)t0 * 512 + hq * 64, 512,
                     ws + OFF_GKS + ((size_t)b * 2 + kv) * NKS * 128, ws + OFF_GVTS + ((size_t)b * 2 + kv) * NKS * 128, NKS / 64,
                     (bf16_t*)(ws + OFF_MIX) + (size_t)t0 * D + 512 + hq * 64);
        } else if (item < 512) {
            sgu_item(p, l, lds, tid, (item - 384) * 128);
        } else if (item < 768) {
            const int it = item - 512, hq = it & 7, b = it >> 3, kv = hq >> 2;
            const int t0 = b * SEQ;
            gqa_unit(lds, tid, wv, (const bf16_t*)(ws + OFF_GQ) + (size_t)t0 * 512 + hq * 64, 512,
                     ws + OFF_GKP + ((size_t)b * 2 + kv) * SEQ * 128, ws + OFF_GVTP + ((size_t)b * 2 + kv) * SEQ * 128, SEQ / 64,
                     (bf16_t*)(ws + OFF_MIX) + (size_t)t0 * D + 512 + hq * 64);
        } else {
            const int it = item - 768, h = it & 3, b = it >> 2;
            const int t0 = b * SEQ;
            attn_item<true>(p, l, lds, tid, (const bf16_t*)(ws + OFF_DQ) + (size_t)t0 * 256 + h * 64, 256,
                            (const bf16_t*)(ws + OFF_DKP) + ((size_t)b * 4 + h) * SEQ * 64, (const bf16_t*)(ws + OFF_DVTP) + ((size_t)b * 4 + h) * 64 * SEQ, SEQ,
                            (bf16_t*)(ws + OFF_MIX) + (size_t)t0 * D + 256 + h * 64, lam);
        }
    }
}


using bf16x2 = __attribute__((ext_vector_type(2))) __bf16;
__device__ __forceinline__ float dot2bf(unsigned a, unsigned b, float c) {
    return __builtin_amdgcn_fdot2_f32_bf16(__builtin_bit_cast(bf16x2, a), __builtin_bit_cast(bf16x2, b), c, false);
}
template <int W>
__device__ __forceinline__ void bfly_stage(float (&part)[64], const int lane) {
    const bool hi = (lane & W) != 0;
#pragma unroll
    for (int k = 0; k < W; ++k) {
        const float keep = hi ? part[k + W] : part[k];
        const float send = hi ? part[k] : part[k + W];
        part[k] = keep + shfl_x(send, lane, W);
    }
}
constexpr int QW_PEER = 4160;
template <int W>
__device__ __forceinline__ void bfly16_stage(float (&v)[16], const int lane, const int bit) {
    const bool hi = (lane & bit) != 0;
#pragma unroll
    for (int k = 0; k < W; ++k) {
        const float keep = hi ? v[k + W] : v[k];
        const float send = hi ? v[k] : v[k + W];
        v[k] = keep + shfl_x(send, lane, bit);
    }
}
template <int W>
__device__ __forceinline__ void bfly16i_stage(int (&v)[16], const int lane, const int bit) {
    const bool hi = (lane & bit) != 0;
#pragma unroll
    for (int k = 0; k < W; ++k) {
        const int keep = hi ? v[k + W] : v[k];
        const int send = hi ? v[k] : v[k + W];
        v[k] = keep + shfl_x(send, lane, bit);
    }
}
template <bool VSIDE> struct PeerTok {
    static __device__ __forceinline__ void issue(const Params& p, const unsigned char* Tslice, const int elo, const int ehi, const int t, const int s,
                                                 const int sub, const int c16, u32x4 (&a)[16], u32x4 (&h)[2]) {
#pragma unroll
        for (int i = 0; i < 16; ++i) {
            const int e = shfl_i(i < 8 ? elo : ehi, (i * 8 + sub) & 63);
            a[i] = *reinterpret_cast<const u32x4*>(Tslice + (((unsigned)e << 7) + (unsigned)c16 * 16u));
        }
        if (!VSIDE) h[0] = *reinterpret_cast<const u32x4*>(p.ws + OFF_H8I + (size_t)t * D + s * 128 + c16 * 16);
    }
    static __device__ __forceinline__ void compute(const Params& p, const int l, const u32x4 w4, const float wsc, const int t, const int s,
                                                   const int lane, const int sub, const int c16, const u32x4 (&a)[16], const u32x4 (&h)[2]) {
        if (!VSIDE) {
            int d[16];
#pragma unroll
            for (int i = 0; i < 16; ++i) {
                int acc = 0;
#pragma unroll
                for (int k = 0; k < 4; ++k) acc = __builtin_amdgcn_sdot4((int)a[i][k], (int)h[0][k], acc, false);
                d[i] = acc;
            }
            bfly16i_stage<8>(d, lane, 4); bfly16i_stage<4>(d, lane, 2); bfly16i_stage<2>(d, lane, 1);
            const int i0 = ((lane & 4) << 1) + ((lane & 2) << 1) + ((lane & 1) << 1);
            int* PART = (int*)(p.ws + OFF_PART) + ((size_t)s * NTOK + t) * 128 + sub * 16 + i0;
            *reinterpret_cast<int2*>(PART) = make_int2(d[0], d[1]);
        } else {
            int acc[16];
#pragma unroll
            for (int i = 0; i < 16; ++i) acc[i] = 0;
#pragma unroll
            for (int g = 0; g < 4; ++g) {
                const int wg = (int)w4[g];
#pragma unroll
                for (int k = 0; k < 4; ++k) {
                    const unsigned r0 = a[4 * g][k], r1 = a[4 * g + 1][k], r2 = a[4 * g + 2][k], r3 = a[4 * g + 3][k];
                    const unsigned x01l = __builtin_amdgcn_perm(r1, r0, 0x05010400u), x01h = __builtin_amdgcn_perm(r1, r0, 0x07030602u);
                    const unsigned x23l = __builtin_amdgcn_perm(r3, r2, 0x05010400u), x23h = __builtin_amdgcn_perm(r3, r2, 0x07030602u);
                    const unsigned t0 = __builtin_amdgcn_perm(x23l, x01l, 0x05040100u), t1 = __builtin_amdgcn_perm(x23l, x01l, 0x07060302u);
                    const unsigned t2 = __builtin_amdgcn_perm(x23h, x01h, 0x05040100u), t3 = __builtin_amdgcn_perm(x23h, x01h, 0x07060302u);
                    acc[4 * k]     = __builtin_amdgcn_sdot4((int)t0, wg, acc[4 * k], false);
                    acc[4 * k + 1] = __builtin_amdgcn_sdot4((int)t1, wg, acc[4 * k + 1], false);
                    acc[4 * k + 2] = __builtin_amdgcn_sdot4((int)t2, wg, acc[4 * k + 2], false);
                    acc[4 * k + 3] = __builtin_amdgcn_sdot4((int)t3, wg, acc[4 * k + 3], false);
                }
            }
            bfly16i_stage<8>(acc, lane, 32); bfly16i_stage<4>(acc, lane, 16); bfly16i_stage<2>(acc, lane, 8);
            const int col = s * 128 + c16 * 16 + ((lane & 32) >> 2) + ((lane & 16) >> 2) + ((lane & 8) >> 2);
            const float* g2 = (const float*)(p.ws + OFF_MOD) + (size_t)(l * 5 + tok_cv(t)) * 6144 + 5 * 1024 + col;
            unsigned* XC = reinterpret_cast<unsigned*>((bf16_t*)(p.ws + OFF_XC) + (size_t)t * D + col);
            const unsigned x = *XC; const float2 g = *reinterpret_cast<const float2*>(g2);
            const float xa = __uint_as_float(x << 16) + g.x * wsc * (float)acc[0], xb = __uint_as_float(x & 0xffff0000u) + g.y * wsc * (float)acc[1];
            *XC = pack_bf2(xa, xb);
            if (l == 0) {
                const float ss = wave_sum(xa * xa + xb * xb);
                if (lane == 0) ((float*)(p.ws + OFF_RSS1))[(size_t)t * 8 + s] = ss;
            }
        }
    }
};
template <bool VSIDE>
__device__ __forceinline__ void peer_slice_stream(const Params& p, const int l, const int s, const int first, const int stride, const int lane) {
    const int sub = lane >> 3, c16 = lane & 7;
    const unsigned char* Ts = p.ws + (VSIDE ? OFF_VT : OFF_UT) + ((size_t)l * 8 + s) * NEXP * 128;
    const int* EIb = (const int*)(p.ws + OFF_EIDX); const unsigned char* WPb = p.ws + OFF_WPAIR; const float* WSb = (const float*)(p.ws + OFF_WSC);
    if (first >= NTOK) return;
    const int cnt = (NTOK - first + stride - 1) / stride;
#define PEER_LOADE(k, elo, ehi, w4, wsc) do { const int _t = min(first + (k) * stride, NTOK - 1); \
        elo = EIb[(size_t)_t * 128 + lane]; ehi = EIb[(size_t)_t * 128 + 64 + lane]; \
        if (VSIDE) { w4 = *reinterpret_cast<const u32x4*>(WPb + (size_t)_t * 128 + sub * 16); wsc = WSb[_t]; } } while (0)
    int e0l, e0h, e1l, e1h, e2l, e2h;
    u32x4 w0 = {0u, 0u, 0u, 0u}, w1 = {0u, 0u, 0u, 0u}, w2 = {0u, 0u, 0u, 0u}; float s0 = 0.f, s1 = 0.f, s2 = 0.f;
    u32x4 A[16], B[16], hA[2], hB[2];
    PEER_LOADE(0, e0l, e0h, w0, s0);
    PEER_LOADE(1, e1l, e1h, w1, s1);
    PeerTok<VSIDE>::issue(p, Ts, e0l, e0h, first, s, sub, c16, A, hA);
    for (int k = 0; k < cnt; k += 2) {
        const int ta = first + k * stride, tb = min(ta + stride, NTOK - 1), tc = min(ta + 2 * stride, NTOK - 1);
        __builtin_amdgcn_sched_barrier(0);
        PEER_LOADE(k + 2, e2l, e2h, w2, s2);
        PeerTok<VSIDE>::issue(p, Ts, e1l, e1h, tb, s, sub, c16, B, hB);
        __builtin_amdgcn_sched_barrier(0);
        PeerTok<VSIDE>::compute(p, l, w0, s0, ta, s, lane, sub, c16, A, hA);
        __builtin_amdgcn_sched_barrier(0);
        e0l = e2l; e0h = e2h; w0 = w2; s0 = s2;
        PEER_LOADE(k + 3, e2l, e2h, w2, s2);
        PeerTok<VSIDE>::issue(p, Ts, e0l, e0h, tc, s, sub, c16, A, hA);
        __builtin_amdgcn_sched_barrier(0);
        if (k + 1 < cnt) PeerTok<VSIDE>::compute(p, l, w1, s1, tb, s, lane, sub, c16, B, hB);
        e1l = e2l; e1h = e2h; w1 = w2; s1 = s2;
    }
#undef PEER_LOADE
}
template <bool VSIDE>
__device__ void ph_peer_sliced(const Params& p, int l, unsigned char* ldsraw, const int wv) {
    const int tid = opaque_tid(wv);
    const int wave = tid >> 6, lane = tid & 63;
    volatile LAS int* hdr = (volatile LAS int*)(ldsraw - LDS_HDR);
    unsigned* bar = (unsigned*)(p.ws + OFF_BAR);
    const int myx = (int)(xb_xcc_id() & 15u);
    if (tid == 0) hdr[16] = (int)atomicAdd(bar + QW_PEER + (l * 2 + (VSIDE ? 1 : 0)) * 16 + myx, 1u);
    __syncthreads();
    const int rank = hdr[16], nloc = (int)hdr[0];
    __syncthreads();
    if (myx < 8) peer_slice_stream<VSIDE>(p, l, myx, rank * 8 + wave, nloc * 8, lane);
    for (int j = 0; j < 8; ++j) {
        if (xb_ld(&bar[XB_XCNT(j)]) == 0u) peer_slice_stream<VSIDE>(p, l, j, (int)blockIdx.x * 8 + wave, (int)gridDim.x * 8, lane);
    }
}
__device__ void ph_peer_pairw(const Params& p, int l, const int wv) {
    const int tid = opaque_tid(wv);
    const int lane = tid & 63;
    const float* USC = (const float*)(p.ws + OFF_USC) + l * NEXP; const float* VSC = (const float*)(p.ws + OFF_VSC) + l * NEXP;
    const int* PART = (const int*)(p.ws + OFF_PART);
    for (size_t i4 = GTID; i4 < (size_t)NTOK * 32; i4 += GNT) {
        const size_t idx = i4 * 4;
        const int t = (int)(idx >> 7), pp = (int)(idx & 127), sub = pp >> 4, i = pp & 15;
        int4 ps[8];
#pragma unroll
        for (int s = 0; s < 8; ++s) ps[s] = *reinterpret_cast<const int4*>(PART + (size_t)s * NTOK * 128 + idx);
        int e[4]; float g[4];
#pragma unroll
        for (int q = 0; q < 4; ++q) {
            const int j = (i + q) * 8 + sub;
            e[q] = ((const int*)(p.ws + OFF_EIDX))[(size_t)t * 128 + j]; g[q] = ((const float*)(p.ws + OFF_EGATE))[(size_t)t * 128 + j];
        }
        const float* rp = (const float*)(p.ws + OFF_RSS2) + ((size_t)l * NTOK + t) * 8;
        const float4 ra = *reinterpret_cast<const float4*>(rp), rb = *reinterpret_cast<const float4*>(rp + 4);
        const float hs = rsqrtf((((ra.x + ra.y) + (ra.z + ra.w)) + ((rb.x + rb.y) + (rb.z + rb.w))) * (1.f / D) + EPS);
        const float* xp = (const float*)(p.ws + OFF_XGS) + (size_t)t * 8;
        const float4 xa = *reinterpret_cast<const float4*>(xp), xb = *reinterpret_cast<const float4*>(xp + 4);
        const float xs[8] = {xa.x, xa.y, xa.z, xa.w, xb.x, xb.y, xb.z, xb.w};
        float sm[4] = {0.f, 0.f, 0.f, 0.f};
#pragma unroll
        for (int s = 0; s < 8; ++s) { sm[0] += xs[s] * (float)ps[s].x; sm[1] += xs[s] * (float)ps[s].y; sm[2] += xs[s] * (float)ps[s].z; sm[3] += xs[s] * (float)ps[s].w; }
        const float* USH = (const float*)(p.ws + OFF_USH) + (size_t)(l * 5 + tok_cv(t)) * NEXP;
        float w[4];
#pragma unroll
        for (int q = 0; q < 4; ++q) w[q] = g[q] * gelu_f(sm[q] * (USC[e[q]] * hs) + USH[e[q]]) * VSC[e[q]];
        float am = fmaxf(fmaxf(fabsf(w[0]), fabsf(w[1])), fmaxf(fabsf(w[2]), fabsf(w[3])));
#pragma unroll
        for (int o = 16; o >= 1; o >>= 1) am = fmaxf(am, shfl_x(am, lane, o));
        const float sc = am > 0.f ? 127.f / am : 1.f;
        *reinterpret_cast<unsigned*>(p.ws + OFF_WPAIR + idx) = pack4_i8(q8(w[0] * sc), q8(w[1] * sc), q8(w[2] * sc), q8(w[3] * sc));
        if (pp == 0) ((float*)(p.ws + OFF_WSC))[t] = am > 0.f ? am * (1.f / 127.f) : 1.f;
    }
}

#define CE_DESC(a, b) do { const float _mx = fmaxf((a), (b)); const float _mn = fminf((a), (b)); (a) = _mx; (b) = _mn; } while (0)
__device__ __forceinline__ void sort16_desc(float (&v)[16]) {
#pragma unroll
    for (int k = 2; k <= 16; k <<= 1)
#pragma unroll
        for (int j = k >> 1; j > 0; j >>= 1)
#pragma unroll
            for (int i = 0; i < 16; ++i) {
                const int m = i ^ j;
                if (m > i) { if ((i & k) == 0) CE_DESC(v[i], v[m]); else CE_DESC(v[m], v[i]); }
            }
}
__device__ __forceinline__ void merge_top16(float (&a)[16], const float (&b)[16]) {
#pragma unroll
    for (int i = 0; i < 16; ++i) a[i] = fmaxf(a[i], b[15 - i]);
#pragma unroll
    for (int j = 8; j > 0; j >>= 1)
#pragma unroll
        for (int i = 0; i < 16; ++i) { const int m = i ^ j; if (m > i) CE_DESC(a[i], a[m]); }
}
__device__ __forceinline__ float key_embed(float v, unsigned lowmask, unsigned idxbits) { return __uint_as_float((__float_as_uint(v) & ~lowmask) | idxbits); }

constexpr int SK_ROWB = 144;
__device__ __forceinline__ void peer_stage1(const LAS unsigned char* SK  , const bf16_t* __restrict__ Qrow  ,
                                            const int r, const int hh, float (&out)[16]) {
    bf16x8 qb[4];
#pragma unroll
    for (int ks = 0; ks < 4; ++ks) qb[ks] = *reinterpret_cast<const bf16x8*>(Qrow + ks * 16 + hh * 8);
    float grp[4][16];
#pragma unroll
    for (int mt = 0; mt < 4; ++mt) {
        f32x16 acc;
#pragma unroll
        for (int i = 0; i < 16; ++i) acc[i] = 0.f;
#pragma unroll
        for (int ks = 0; ks < 4; ++ks) {
            const bf16x8 a = *(const LAS bf16x8*)(SK + (mt * 32 + r) * SK_ROWB + (ks * 16 + hh * 8) * 2);
            acc = MFMA32(a, qb[ks], acc);
        }
        const unsigned hx = (unsigned)hh << 2;
#pragma unroll
        for (int i = 0; i < 16; ++i) {
            const unsigned cn = 32u * mt + (i & 3) + 8u * (i >> 2);
            grp[mt][i] = key_embed(acc[i], 127u, (127u - cn) ^ hx);
        }
        sort16_desc(grp[mt]);
    }
    merge_top16(grp[0], grp[1]); merge_top16(grp[2], grp[3]); merge_top16(grp[0], grp[2]);
    float pb[16];
#pragma unroll
    for (int i = 0; i < 16; ++i) pb[i] = shfl_x(grp[0][i], (hh << 5) | r, 32);
    merge_top16(grp[0], pb);
#pragma unroll
    for (int i = 0; i < 16; ++i) out[i] = grp[0][i];
}

__device__ void ph_peer_select(const Params& p, int l, unsigned char* ldsraw, const int wv) {
    const int tid = opaque_tid(wv);
    const int wave = tid >> 6, lane = tid & 63, r = lane & 31, hh = lane >> 5;
    const int gw = blockIdx.x * 8 + wave, nw = gridDim.x * 8;
    LAS unsigned char* skl = (LAS unsigned char*)ldsraw;
    LAS unsigned char* myl = skl + 2 * 128 * SK_ROWB + wave * 2048 + lane * 32;
    {
        const bf16_t* SKg = (const bf16_t*)(p.ws + OFF_SUBK) + (size_t)l * 2 * 128 * 64;
        for (int i = tid; i < 2 * 128 * 8; i += NT) {
            const int row = i >> 3, ch = i & 7;
            *(LAS u32x4*)(skl + row * SK_ROWB + ch * 16) = *reinterpret_cast<const u32x4*>(SKg + (size_t)row * 64 + ch * 8);
        }
        __syncthreads();
    }
    for (int task = gw; task < (NTOK / 32) * 4; task += nw) {
        const int tg = task >> 2, k = task & 3;
        const int t = tg * 32 + r;
        const bf16_t* Qt = (const bf16_t*)(p.ws + OFF_Q) + (size_t)t * D;
        float sv[2][16];
#pragma unroll
        for (int x = 0; x < 2; ++x) {
            float la[16], lb[16];
            peer_stage1(skl + x * 128 * SK_ROWB, Qt + k * 128 + x * 64, r, hh, la);
            peer_stage1(skl + x * 128 * SK_ROWB, Qt + (k + 4) * 128 + x * 64, r, hh, lb);
#pragma unroll
            for (int i = 0; i < 16; ++i) sv[x][i] = hh ? lb[i] : la[i];
        }
        {
            unsigned w[8];
#pragma unroll
            for (int q = 0; q < 8; ++q) {
                w[q] = 0u;
#pragma unroll
                for (int b = 0; b < 4; ++b) {
                    const int i = q * 4 + b;
                    const unsigned key = __float_as_uint(i < 16 ? sv[0][i] : sv[1][i - 16]);
                    w[q] |= (127u - (key & 127u)) << (8 * b);
                }
            }
            *(LAS u32x4*)(myl) = u32x4{w[0], w[1], w[2], w[3]};
            *(LAS u32x4*)(myl + 16) = u32x4{w[4], w[5], w[6], w[7]};
        }
        float val0[16], val1[16];
#pragma unroll
        for (int i = 0; i < 16; ++i) { val0[i] = __uint_as_float(__float_as_uint(sv[0][i]) & ~127u); val1[i] = __uint_as_float(__float_as_uint(sv[1][i]) & ~127u); }
        float g0[16], g1[16], g2[16], g3[16];
#pragma unroll
        for (int b = 0; b < 16; ++b) g0[b] = key_embed(val0[0] + val1[b], 255u, 255u - (unsigned)b);
#pragma unroll
        for (int b = 0; b < 8; ++b) g1[b] = key_embed(val0[1] + val1[b], 255u, 255u - (16u + b));
#pragma unroll
        for (int b = 0; b < 5; ++b) g1[8 + b] = key_embed(val0[2] + val1[b], 255u, 255u - (32u + b));
#pragma unroll
        for (int b = 0; b < 3; ++b) g1[13 + b] = key_embed(val0[4] + val1[b], 255u, 255u - (64u + b));
#pragma unroll
        for (int b = 0; b < 4; ++b) g2[b] = key_embed(val0[3] + val1[b], 255u, 255u - (48u + b));
#pragma unroll
        for (int a = 5; a < 8; ++a)
#pragma unroll
            for (int b = 0; b < 2; ++b) g2[4 + (a - 5) * 2 + b] = key_embed(val0[a] + val1[b], 255u, 255u - (16u * a + b));
#pragma unroll
        for (int a = 8; a < 14; ++a) g2[10 + (a - 8)] = key_embed(val0[a] + val1[0], 255u, 255u - 16u * a);
        g3[0] = key_embed(val0[14] + val1[0], 255u, 255u - 16u * 14); g3[1] = key_embed(val0[15] + val1[0], 255u, 255u - 16u * 15);
#pragma unroll
        for (int i = 2; i < 16; ++i) g3[i] = -3.0e38f;
        sort16_desc(g1); sort16_desc(g2); sort16_desc(g3);
        merge_top16(g0, g1); merge_top16(g2, g3); merge_top16(g0, g2);
        float gate[16]; int eid[16];
        const float mx = __uint_as_float(__float_as_uint(g0[0]) & ~255u);
        float sum = 0.f;
#pragma unroll
        for (int i = 0; i < 16; ++i) {
            const unsigned key = __float_as_uint(g0[i]);
            gate[i] = __expf(__uint_as_float(key & ~255u) - mx); sum += gate[i];
            const unsigned id = 255u - (key & 255u);
            const unsigned n0 = *(const LAS unsigned char*)(myl + (id >> 4));
            const unsigned n1 = *(const LAS unsigned char*)(myl + 16 + (id & 15u));
            eid[i] = (int)(n0 * 128u + n1);
        }
        const float inv = 1.f / sum;
        const int h = k + 4 * hh;
        int* EI = (int*)(p.ws + OFF_EIDX) + (size_t)t * 128 + h * 16; float* EG = (float*)(p.ws + OFF_EGATE) + (size_t)t * 128 + h * 16;
#pragma unroll
        for (int q = 0; q < 4; ++q) {
            *reinterpret_cast<int4*>(EI + q * 4) = make_int4(eid[q * 4], eid[q * 4 + 1], eid[q * 4 + 2], eid[q * 4 + 3]);
            *reinterpret_cast<float4*>(EG + q * 4) = make_float4(gate[q * 4] * inv, gate[q * 4 + 1] * inv, gate[q * 4 + 2] * inv, gate[q * 4 + 3] * inv);
        }
    }
}

constexpr int LDS_BYTES = LDS_HDR + 3 * 48 * 1024;
__global__ void __launch_bounds__(NT, 2) mk_fwd(Params p) {
    extern __shared__ __attribute__((aligned(16))) unsigned char lds[];
    const int wv = __builtin_amdgcn_readfirstlane((int)(threadIdx.x >> 6));
    volatile LAS unsigned* st = (volatile LAS unsigned*)lds;
    if (threadIdx.x < 4) st[threadIdx.x] = 0u;
    __syncthreads();
    XcdBarrier xb = xcd_barrier_post((unsigned*)(p.ws + OFF_BAR), st);
    int bar_idx = 0;
#define GRID_BAR() do { xcd_barrier(xb); \
        if (PROBE_TS >= 0 && blockIdx.x == 0 && threadIdx.x == 0 && (bar_idx == PROBE_TS - 1 || bar_idx == PROBE_TS)) \
            ((volatile LAS unsigned long long*)(lds + 128))[bar_idx - (PROBE_TS - 1)] = __builtin_amdgcn_s_memrealtime(); \
        ++bar_idx; } while (0)
    if (PROBE_TS == 0 && blockIdx.x == 0 && threadIdx.x == 0) ((volatile LAS unsigned long long*)(lds + 128))[0] = __builtin_amdgcn_s_memrealtime();
    unsigned char* ws = p.ws;
    for (int rep = 0; rep < (PROBE_DUP == 1 ? 2 : 1); ++rep) {
    for (int l = 0; l < 2; ++l) {
        ph_transpose(p.in[I_WIN] + (size_t)l * D * INW, (bf16_t*)(ws + OFF_WIN) + (size_t)l * INW * D, D, INW, lds + LDS_HDR, wv);
        ph_transpose(p.in[I_WOUT] + (size_t)l * D * D, (bf16_t*)(ws + OFF_WOUT) + (size_t)l * D * D, D, D, lds + LDS_HDR, wv);
        ph_transpose(p.in[I_WQ] + (size_t)l * D * D, (bf16_t*)(ws + OFF_WQ) + (size_t)l * D * D, D, D, lds + LDS_HDR, wv);
    }
    ph_convert_i8_rows(p.in[I_PU], ws + OFF_UT, (float*)(ws + OFF_USC), 2 * NEXP, wv);
    ph_convert_i8_rows(p.in[I_PV], ws + OFF_VT, (float*)(ws + OFF_VSC), 2 * NEXP, wv);
    ph_convert(p.in[I_SUBK], (bf16_t*)(ws + OFF_SUBK), 2 * 2 * 128 * 64, wv);
    ph_convert(p.in[I_SGUW], (bf16_t*)(ws + OFF_SGUW), 2 * 4 * 128 * 128, wv);
    ph_mod(p, lds + LDS_HDR, wv);
    ph_rope_tab(p, wv);
    GRID_BAR();
    }
    for (int l = 0; l < 2; ++l) {
        for (int rep = 0; rep < (PROBE_DUP == 3 ? 2 : 1); ++rep) {
        if (l == 0) {
            ph_norm_mod(p, 0, 0, 1, wv);
            ph_cache_prep(p, 0, wv);
            ph_fold_tables(p, lds + LDS_HDR, wv);
            GRID_BAR();
        }
        }
        for (int rep = 0; rep < (PROBE_DUP == 5 ? 2 : 1); ++rep) {
        if (l == 0) gemm_phase<EPI_INPROJ>(p, 0, (const bf16_t*)(ws + OFF_H), (const bf16_t*)(ws + OFF_WIN), INW, lds + LDS_HDR, wv);
        else {
            ph_cache_prep(p, 1, wv);
            gemm_phase<EPI_INPROJ>(p, 1, (const bf16_t*)(ws + OFF_XC), (const bf16_t*)(ws + OFF_WINS), INW, lds + LDS_HDR, wv,
                                   (size_t)INW * D, (const float*)(ws + OFF_RSS1), (const float*)(ws + OFF_BIN));
        }
        GRID_BAR();
        }
        for (int rep = 0; rep < ((PROBE_DUP == 4 || (PROBE_DUP >= 10 && PROBE_DUP <= 12)) ? 2 : 1); ++rep) {
        ph_mixers(p, l + 2 * rep, lds + LDS_HDR, wv);
        GRID_BAR();
        }
        gemm_phase<EPI_WOUT>(p, l, (const bf16_t*)(ws + OFF_MIX), (const bf16_t*)(ws + OFF_WOUT) + (size_t)l * D * D, D, lds + LDS_HDR, wv);
        GRID_BAR();
        for (int rep = 0; rep < (PROBE_DUP == 7 ? 2 : 1); ++rep) {
        gemm_phase<EPI_WQ>(p, l, (const bf16_t*)(ws + OFF_XC), (const bf16_t*)(ws + OFF_WQS) + (size_t)l * 5 * D * D, D, lds + LDS_HDR, wv,
                           (size_t)D * D, (const float*)(ws + OFF_RSS2) + (size_t)l * NTOK * 8, (const float*)(ws + OFF_BQ) + (size_t)l * 5 * D);
        GRID_BAR();
        }
        if (PROBE_DUP == 8) { for (int rep = 0; rep < 10; ++rep) GRID_BAR(); }
        for (int rep = 0; rep < (PROBE_DUP == 2 ? 2 : 1); ++rep) {
        ph_peer_select(p, l, lds + LDS_HDR, wv);
        GRID_BAR();
        }
        ph_peer_sliced<false>(p, l, lds + LDS_HDR, wv);
        GRID_BAR();
        ph_peer_pairw(p, l, wv);
        GRID_BAR();
        ph_peer_sliced<true>(p, l, lds + LDS_HDR, wv);
        GRID_BAR();
    }
    ph_final_norm(p, wv);
    if (PROBE_TS >= 0 && blockIdx.x == 0 && threadIdx.x == 0) {
        asm volatile("s_waitcnt vmcnt(0)" ::: "memory");
        volatile LAS unsigned long long* tsl = (volatile LAS unsigned long long*)(lds + 128);
        p.out[0] += (float)(tsl[1] - tsl[0]) * 0.01f;
    }
}

extern "C" void kernel_launch(void* const* d_in, const int* in_sizes, int n_in,
                              void* d_out, int out_size, void* d_ws, size_t ws_size,
                              hipStream_t stream) {
    static int grid = 0;
    if (grid == 0) {
        if (ws_size < WS_NEED) { fprintf(stderr, "kernel_launch: workspace too small: %zu < %zu\n", ws_size, (size_t)WS_NEED); grid = -1; return; }
        int dev = 0, cus = 0, per_cu = 0;
        (void)hipGetDevice(&dev);
        (void)hipDeviceGetAttribute(&cus, hipDeviceAttributeMultiprocessorCount, dev);
        (void)hipFuncSetAttribute((const void*)mk_fwd, hipFuncAttributeMaxDynamicSharedMemorySize, LDS_BYTES);
        (void)hipOccupancyMaxActiveBlocksPerMultiprocessor(&per_cu, (const void*)mk_fwd, NT, LDS_BYTES);
        if (per_cu < 1) { fprintf(stderr, "kernel_launch: occupancy query reports %d blocks per CU\n", per_cu); grid = -1; return; }
        grid = cus;
    }
    if (grid < 0) return;
    (void)hipMemsetAsync((unsigned char*)d_ws + OFF_BAR, 0, 64 * 1024, stream);
    Params p{};
    for (int i = 0; i < 29; ++i) p.in[i] = (const float*)d_in[i];
    p.out = (float*)d_out; p.ws = (unsigned char*)d_ws;
    void* args[] = {&p};
    hipError_t e = hipLaunchCooperativeKernel((const void*)mk_fwd, dim3(grid), dim3(NT), args, LDS_BYTES, stream);
    if (e != hipSuccess) fprintf(stderr, "kernel_launch: cooperative launch failed: %s (grid %d)\n", hipGetErrorString(e), grid);
}
```

```cpp
#include <hip/hip_runtime.h>
#include <hip/hip_bf16.h>
#include <cstdio>
#include <cstdint>
#include <hip/hip_cooperative_groups.h>
namespace cg = cooperative_groups;

#define PROBE_DUP 0
#define PROBE_TS -1
typedef unsigned short bf16_t;
using bf16x8 = __attribute__((ext_vector_type(8))) short;
using f32x4  = __attribute__((ext_vector_type(4))) float;
using f32x16 = __attribute__((ext_vector_type(16))) float;
using f32x2  = __attribute__((ext_vector_type(2))) float;
using u32x4  = __attribute__((ext_vector_type(4))) unsigned;
using u32x2  = __attribute__((ext_vector_type(2))) unsigned;
using s16x4  = __attribute__((ext_vector_type(4))) short;

constexpr int D      = 1024;
constexpr int NTOK   = 16384;
constexpr int NPT    = 8192;
constexpr int SEQ    = 256;
constexpr int DSEQ   = 2048;
constexpr int PAST   = 512;
constexpr int NKS    = DSEQ + PAST;
constexpr int INW    = 2048;
constexpr int NEXP   = 16384;
constexpr float EPS  = 1e-6f;

constexpr size_t MB = 1024 * 1024;
constexpr size_t OFF_BAR   = 0;
constexpr size_t OFF_MOD   = 64 * 1024;
constexpr size_t OFF_ROPE  = OFF_MOD + 256 * 1024;
constexpr size_t OFF_SUBK  = OFF_ROPE + 1 * MB;
constexpr size_t OFF_SGUW  = OFF_SUBK + 64 * 1024;
constexpr size_t OFF_WIN   = OFF_SGUW + 256 * 1024;
constexpr size_t OFF_WOUT  = OFF_WIN + 8 * MB;
constexpr size_t OFF_WQ    = OFF_WOUT + 4 * MB;
constexpr size_t OFF_UT    = OFF_WQ + 4 * MB;
constexpr size_t OFF_USC   = OFF_UT + 32 * MB;
constexpr size_t OFF_VT    = OFF_UT + 64 * MB;
constexpr size_t OFF_VSC   = OFF_VT + 32 * MB;
constexpr size_t OFF_H     = OFF_VT + 64 * MB;
constexpr size_t OFF_XC    = OFF_H + 32 * MB;
constexpr size_t OFF_R1    = OFF_XC + 64 * MB;
constexpr size_t OFF_AU    = OFF_R1;
constexpr size_t OFF_AV    = OFF_AU + 8 * MB;
constexpr size_t OFF_AVN   = OFF_AV + 8 * MB;
constexpr size_t OFF_DQ    = OFF_AVN + 8 * MB;
constexpr size_t OFF_DKP   = OFF_DQ + 8 * MB;
constexpr size_t OFF_DKS   = OFF_DKP + 4 * MB;
constexpr size_t OFF_DVTP  = OFF_DKS + 5 * MB;
constexpr size_t OFF_DVTS  = OFF_DVTP + 4 * MB;
constexpr size_t OFF_GQ    = OFF_DVTS + 5 * MB;
constexpr size_t OFF_GKP   = OFF_GQ + 16 * MB;
constexpr size_t OFF_GKS   = OFF_GKP + 2 * MB;
constexpr size_t OFF_GVTP  = OFF_GKS + 3 * MB;
constexpr size_t OFF_GVTS  = OFF_GVTP + 2 * MB;
constexpr size_t OFF_MIX   = OFF_GVTS + 3 * MB;
constexpr size_t OFF_R1END = OFF_MIX + 32 * MB;
constexpr size_t OFF_Q     = OFF_R1;
constexpr size_t OFF_EIDX  = OFF_Q + 32 * MB;
constexpr size_t OFF_EGATE = OFF_EIDX + 8 * MB;
constexpr size_t OFF_TOPV  = OFF_EGATE + 8 * MB;
constexpr size_t OFF_TOPI  = OFF_TOPV + 16 * MB;
static_assert(OFF_TOPI + 16 * MB <= OFF_R1END, "peer buffers must fit region 1");
constexpr size_t OFF_PROJ  = OFF_R1END;
constexpr size_t OFF_PART  = OFF_PROJ;
constexpr size_t OFF_WPAIR = OFF_PART + 64 * MB;
constexpr size_t OFF_H8I   = OFF_WPAIR + 8 * MB;
constexpr size_t OFF_HSC   = OFF_H8I + 16 * MB;
constexpr size_t OFF_WSC   = OFF_HSC + 64 * 1024;
constexpr size_t OFF_XGS   = OFF_WSC + 64 * 1024;
constexpr size_t OFF_RSS2  = OFF_XGS + 512 * 1024;
constexpr size_t OFF_RSS1  = OFF_RSS2 + 1 * MB;
constexpr size_t OFF_USH   = OFF_RSS1 + 512 * 1024;
constexpr size_t OFF_BQ    = OFF_USH + 1 * MB;
constexpr size_t OFF_BIN   = OFF_BQ + 64 * 1024;
constexpr size_t OFF_WQS   = OFF_BIN + 64 * 1024;
constexpr size_t OFF_WINS  = OFF_XC + 32 * MB;
static_assert(OFF_WQS + 20 * MB <= OFF_PROJ + 128 * MB, "folded tables must fit");
constexpr size_t WS_NEED   = OFF_PROJ + 128 * MB;
static_assert(WS_NEED <= 512 * MB, "workspace budget");

constexpr size_t OUT_YP  = 0;
constexpr size_t OUT_YS  = 8388608;
constexpr size_t OUT_NDK = 16777216;
constexpr size_t OUT_NDV = OUT_NDK + 4194304;
constexpr size_t OUT_NGK = OUT_NDV + 4194304;
constexpr size_t OUT_NGV = OUT_NGK + 2097152;

struct Params {
    const float* in[29];
    float* out;
    unsigned char* ws;
};
enum { I_XP = 0, I_XS, I_CDK, I_CDV, I_CGK, I_CGV, I_C, I_CCTX, I_ADAW, I_ADAB, I_N1G, I_N2G, I_WIN, I_SGUNG, I_SGUW, I_SGUB,
       I_LQ1, I_LK1, I_LQ2, I_LK2, I_SUBLN, I_QNG, I_KNG, I_WOUT, I_WQ, I_SUBK, I_PU, I_PV, I_FG };

typedef __bf16 hwbf2 __attribute__((ext_vector_type(2)));
__device__ __forceinline__ unsigned pack_bf2(float a, float b) {
    const f32x2 v = {a, b};
    return __builtin_bit_cast(unsigned, __builtin_convertvector(v, hwbf2));
}
__device__ __forceinline__ bf16_t f2bf(float f) { return (bf16_t)(pack_bf2(f, 0.f) & 0xffffu); }
__device__ __forceinline__ float bf2f(bf16_t h) { return __uint_as_float(((unsigned)h) << 16); }
__device__ __forceinline__ float gelu_f(float x) {
    const float k2 = 2.f * 0.7978845608028654f * 1.4426950408889634f;
    const float e = __builtin_amdgcn_exp2f(k2 * (x + 0.044715f * x * x * x));
    return x - x * __builtin_amdgcn_rcpf(e + 1.f);
}
__device__ __forceinline__ int lane_id() { return (int)__builtin_amdgcn_mbcnt_hi(~0u, __builtin_amdgcn_mbcnt_lo(~0u, 0u)); }
__device__ __forceinline__ int lane_id_op() { int l = lane_id(); asm volatile("" : "+v"(l)); return l; }
__device__ __forceinline__ float shfl_i(float v, int src) { return __builtin_bit_cast(float, __builtin_amdgcn_ds_bpermute(src << 2, __builtin_bit_cast(int, v))); }
__device__ __forceinline__ int shfl_i(int v, int src) { return __builtin_amdgcn_ds_bpermute(src << 2, v); }
__device__ __forceinline__ float shfl_x(float v, int lane, int m) { return shfl_i(v, lane ^ m); }
__device__ __forceinline__ int shfl_x(int v, int lane, int m) { return shfl_i(v, lane ^ m); }
__device__ __forceinline__ int q8(float x) { return (int)fminf(fmaxf(rintf(x), -127.f), 127.f); }
__device__ __forceinline__ unsigned pack4_i8(int a, int b, int c, int d) { return (unsigned)(a & 255) | ((unsigned)(b & 255) << 8) | ((unsigned)(c & 255) << 16) | ((unsigned)d << 24); }
#define DPP_F(v, ctrl) __builtin_bit_cast(float, __builtin_amdgcn_update_dpp(0, __builtin_bit_cast(int, (v)), (ctrl), 0xF, 0xF, false))
__device__ __forceinline__ float row16_sum(float v) {
    v += DPP_F(v, 0xB1); v += DPP_F(v, 0x4E); v += DPP_F(v, 0x141); v += DPP_F(v, 0x140);
    return v;
}
__device__ __forceinline__ float row16_max(float v) {
    v = fmaxf(v, DPP_F(v, 0xB1)); v = fmaxf(v, DPP_F(v, 0x4E)); v = fmaxf(v, DPP_F(v, 0x141)); v = fmaxf(v, DPP_F(v, 0x140));
    return v;
}
__device__ __forceinline__ float rdlane_f(float v, int l) { return __builtin_bit_cast(float, __builtin_amdgcn_readlane(__builtin_bit_cast(int, v), l)); }
__device__ __forceinline__ float wave_sum(float v) {
    v = row16_sum(v);
    return (rdlane_f(v, 0) + rdlane_f(v, 16)) + (rdlane_f(v, 32) + rdlane_f(v, 48));
}
__device__ __forceinline__ float wave_max(float v) {
    v = row16_max(v);
    return fmaxf(fmaxf(rdlane_f(v, 0), rdlane_f(v, 16)), fmaxf(rdlane_f(v, 32), rdlane_f(v, 48)));
}
__device__ __forceinline__ int tok_cv(int t) { return t < NPT ? 0 : 1 + ((t - NPT) >> 11); }
__device__ __forceinline__ const float* x_in_row(const Params& p, int t) {
    return t < NPT ? p.in[I_XP] + (size_t)t * D : p.in[I_XS] + (size_t)(t - NPT) * D;
}
__device__ __forceinline__ float lam_init_of(int l) { return l == 0 ? 0.2f : (0.8f - 0.6f * 0.7408182206817179f); }
__device__ __forceinline__ float lam_of(const Params& p, int l) {
    float s1 = 0.f, s2 = 0.f;
    for (int i = 0; i < 32; ++i) {
        s1 += p.in[I_LQ1][l * 32 + i] * p.in[I_LK1][l * 32 + i];
        s2 += p.in[I_LQ2][l * 32 + i] * p.in[I_LK2][l * 32 + i];
    }
    return expf(s1) - expf(s2) + lam_init_of(l);
}


#define XB_TMO      128
#define XB_XCNT(j)  (256  + 64 * (j))
#define XB_XSUB(j)  (1280 + 64 * (j))
#define XB_XGEN(j)  (2304 + 64 * (j))
#define XB_TOP      3328
#define XB_TOPGEN   3392
#define XCD_BAR_WORDS 3456
#define XB_SPIN_CAP (1u << 20)
#define LAS __attribute__((address_space(3)))
typedef int i32x4 __attribute__((ext_vector_type(4)));
__device__ __forceinline__ unsigned xb_ld(unsigned* p)              { return __hip_atomic_load(p, __ATOMIC_RELAXED, __HIP_MEMORY_SCOPE_AGENT); }
__device__ __forceinline__ unsigned xb_add(unsigned* p, unsigned v) { return __hip_atomic_fetch_add(p, v, __ATOMIC_RELAXED, __HIP_MEMORY_SCOPE_AGENT); }
__device__ __forceinline__ unsigned xb_xcc_id() { return (unsigned)__builtin_amdgcn_s_getreg((3 << 11) | 20) & 0xFu; }
#define XB_SPIN(cond, bar) do { unsigned _sp = 0; while (cond) { __builtin_amdgcn_s_sleep(1); \
    if ((++_sp & 255u) == 0u) { if (xb_ld(&(bar)[XB_TMO])) break; if (_sp > XB_SPIN_CAP) { atomicAdd(&(bar)[XB_TMO], 1u); break; } } } } while (0)
struct XcdBarrier { unsigned* bar; unsigned x; volatile LAS unsigned* st; };
__device__ __forceinline__ XcdBarrier xcd_barrier_post(unsigned* bar, volatile LAS unsigned* st) {
    XcdBarrier b; b.bar = bar; b.x = xb_xcc_id(); b.st = st;
    if (threadIdx.x == 0) (void)xb_add(&bar[XB_XCNT(b.x)], 1u);
    return b;
}
__device__ __forceinline__ void xcd_barrier_complete(unsigned* bar, unsigned x, unsigned& nloc, unsigned& nx) {
    const unsigned G = gridDim.x * gridDim.y * gridDim.z;
    unsigned sum, cnt, mine, sp = 0u;
    for (;;) {
        sum = 0u; cnt = 0u; mine = 0u;
#pragma unroll
        for (unsigned j = 0; j < 16; ++j) { const unsigned c = xb_ld(&bar[XB_XCNT(j)]); sum += c; cnt += (c > 0u) ? 1u : 0u; mine = (j == x) ? c : mine; }
        if (sum == G) break;
        __builtin_amdgcn_s_sleep(1);
        if ((++sp & 255u) == 0u) { if (xb_ld(&bar[XB_TMO])) break; if (sp > XB_SPIN_CAP) { atomicAdd(&bar[XB_TMO], 1u); break; } }
    }
    nloc = mine > 0u ? mine : 1u; nx = cnt > 0u ? cnt : 1u;
}
__device__ __forceinline__ void xcd_barrier(const XcdBarrier& b) {
    asm volatile("s_waitcnt vmcnt(0)" ::: "memory");
    __syncthreads();
    if (threadIdx.x == 0) {
        unsigned* bar = b.bar;
        const unsigned bx = xb_xcc_id();
        __builtin_amdgcn_s_waitcnt(0);
        unsigned nloc = b.st[0], nx = b.st[1];
        if (nloc == 0u) { xcd_barrier_complete(bar, bx, nloc, nx); b.st[0] = nloc; b.st[1] = nx; }
        const unsigned old = xb_add(&bar[XB_XSUB(bx)], 1u);
        const unsigned gen = old / nloc;
        if (old + 1u == (gen + 1u) * nloc) {
            __builtin_amdgcn_fence(__ATOMIC_RELEASE, "agent");
            asm volatile("s_waitcnt vmcnt(0)" ::: "memory");
            const unsigned og = xb_add(&bar[XB_TOP], 1u);
            const unsigned tg = og / nx;
            if (og + 1u == (tg + 1u) * nx) xb_add(&bar[XB_TOPGEN], 1u);
            else XB_SPIN(xb_ld(&bar[XB_TOPGEN]) == tg, bar);
            __builtin_amdgcn_fence(__ATOMIC_ACQUIRE, "agent");
            xb_add(&bar[XB_XGEN(bx)], 1u);
            asm volatile("s_waitcnt vmcnt(0)" ::: "memory");
        } else {
            XB_SPIN(xb_ld(&bar[XB_XGEN(bx)]) == gen, bar);
            __builtin_amdgcn_fence(__ATOMIC_ACQUIRE, "agent");
            asm volatile("s_waitcnt vmcnt(0)" ::: "memory");
        }
    }
    __syncthreads();
}

constexpr int NT = 512;
constexpr int LDS_HDR = 1024;
#define GTID ((size_t)blockIdx.x * NT + tid)
__device__ __forceinline__ int opaque_tid(int wv) { int t = (wv << 6) | lane_id(); asm volatile("" : "+v"(t)); return t; }
#define GNT  ((size_t)gridDim.x * NT)

__device__ void ph_transpose(const float* __restrict__ W, bf16_t* __restrict__ Wt, int K, int N, unsigned char* ldsraw, const int wv) {
    const int tid = opaque_tid(wv);
    LAS bf16_t* T = (LAS bf16_t*)ldsraw;
    const int tk = K / 128, tn = N / 64, ntiles = tk * tn;
    for (int tile = blockIdx.x; tile < ntiles; tile += gridDim.x) {
        const int k0 = (tile % tk) * 128, n0 = (tile / tk) * 64;
#pragma unroll 4
        for (int i = 0; i < 16; ++i) {
            const int kl = i * 8 + (tid >> 6), nl = tid & 63;
            T[nl * 130 + kl] = f2bf(W[(size_t)(k0 + kl) * N + n0 + nl]);
        }
        __syncthreads();
        {
            const int nl = tid >> 3, kc = tid & 7;
            unsigned w[8];
#pragma unroll
            for (int i = 0; i < 8; ++i) w[i] = (unsigned)T[nl * 130 + kc * 16 + 2 * i] | ((unsigned)T[nl * 130 + kc * 16 + 2 * i + 1] << 16);
            bf16_t* dst = Wt + (size_t)(n0 + nl) * K + k0 + kc * 16;
            *reinterpret_cast<u32x4*>(dst) = u32x4{w[0], w[1], w[2], w[3]};
            *reinterpret_cast<u32x4*>(dst + 8) = u32x4{w[4], w[5], w[6], w[7]};
        }
        __syncthreads();
    }
}
__device__ void ph_convert(const float* __restrict__ src, bf16_t* __restrict__ dst, size_t n, const int wv) {
    const int tid = opaque_tid(wv);
    for (size_t idx = GTID; idx < n; idx += GNT) dst[idx] = f2bf(src[idx]);
}
__device__ void ph_convert_i8_rows(const float* __restrict__ src, unsigned char* __restrict__ dst, float* __restrict__ scl, int nrows, const int wv) {
    const int tid = opaque_tid(wv);
    const int lane = tid & 63;
    const int gw = blockIdx.x * 8 + (tid >> 6), nw = gridDim.x * 8;
    for (int row0 = gw * 4; row0 < nrows; row0 += nw * 4) {
        float4 f[4][4];
#pragma unroll
        for (int q = 0; q < 4; ++q)
#pragma unroll
            for (int i = 0; i < 4; ++i) f[q][i] = *reinterpret_cast<const float4*>(src + (size_t)(row0 + q) * D + lane * 16 + i * 4);
#pragma unroll
        for (int q = 0; q < 4; ++q) {
            const int row = row0 + q;
            float v[16];
#pragma unroll
            for (int i = 0; i < 4; ++i) { v[i * 4] = f[q][i].x; v[i * 4 + 1] = f[q][i].y; v[i * 4 + 2] = f[q][i].z; v[i * 4 + 3] = f[q][i].w; }
            float am = 0.f;
#pragma unroll
            for (int i = 0; i < 16; ++i) am = fmaxf(am, fabsf(v[i]));
#pragma unroll
            for (int o = 32; o >= 1; o >>= 1) am = fmaxf(am, shfl_x(am, lane, o));
            const float sc = am > 0.f ? 127.f / am : 1.f;
            unsigned w[4];
#pragma unroll
            for (int i = 0; i < 4; ++i) w[i] = pack4_i8(q8(v[i * 4] * sc), q8(v[i * 4 + 1] * sc), q8(v[i * 4 + 2] * sc), q8(v[i * 4 + 3] * sc));
            {
                const int lyr = row >> 14, e = row & (NEXP - 1);
                *reinterpret_cast<u32x4*>(dst + (((size_t)lyr * 8 + (lane >> 3)) * NEXP + e) * 128 + (lane & 7) * 16) = u32x4{w[0], w[1], w[2], w[3]};
            }
            if (lane == 0) scl[row] = am > 0.f ? am * (1.f / 127.f) : 1.f;
        }
    }
}
__device__ void ph_mod(const Params& p, unsigned char* ldsraw, const int wv) {
    const int tid = opaque_tid(wv);
    LAS float* sl = (LAS float*)ldsraw;
    LAS float* red = sl + 5 * 1024;
    for (int i = tid; i < 5 * 1024; i += NT) {
        const int cv = i >> 10, k = i & 1023;
        const float c = cv == 0 ? p.in[I_CCTX][k] : p.in[I_C][(size_t)(cv - 1) * D + k];
        sl[i] = c / (1.f + __expf(-c));
    }
    __syncthreads();
    const int c = tid & 63, ks = tid >> 6;
    for (int item = blockIdx.x; item < 2 * 96; item += gridDim.x) {
        const int l = item / 96, j = (item % 96) * 64 + c;
        const float* W = p.in[I_ADAW] + (size_t)l * D * 6144 + (size_t)(ks * 128) * 6144 + j;
        float acc[5] = {0.f, 0.f, 0.f, 0.f, 0.f};
#pragma unroll 8
        for (int k = 0; k < 128; ++k) {
            const float w = W[(size_t)k * 6144];
#pragma unroll
            for (int cv = 0; cv < 5; ++cv) acc[cv] += sl[cv * 1024 + ks * 128 + k] * w;
        }
#pragma unroll
        for (int cv = 0; cv < 5; ++cv) red[(ks * 5 + cv) * 64 + c] = acc[cv];
        __syncthreads();
        if (tid < 320) {
            const int cv = tid >> 6;
            float sum = p.in[I_ADAB][l * 6144 + j];
#pragma unroll
            for (int q = 0; q < 8; ++q) sum += red[(q * 5 + cv) * 64 + c];
            ((float*)(p.ws + OFF_MOD))[(size_t)(l * 5 + cv) * 6144 + j] = sum;
        }
        __syncthreads();
    }
}
__device__ void ph_rope_tab(const Params& p, const int wv) {
    const int tid = opaque_tid(wv);
    for (size_t idx = GTID; idx < 2048 * 48; idx += GNT) {
        int s = idx / 48, i = idx % 48;
        float* R = (float*)(p.ws + OFF_ROPE);
        double row = (double)(s / 64), col = (double)(s % 64);
        if (i < 16) {
            int q = i & 7; double inv = pow(10000.0, -(double)q / 8.0);
            double ang = (i < 8 ? row : col) * inv;
            R[s * 16 + i] = (float)cos(ang); R[2048 * 16 + s * 16 + i] = (float)sin(ang);
        } else {
            int ii = i - 16; int q = ii & 15; double inv = pow(10000.0, -(double)q / 16.0);
            double ang = (ii < 16 ? row : col) * inv;
            R[2048 * 32 + s * 32 + ii] = (float)cos(ang); R[2048 * 64 + s * 32 + ii] = (float)sin(ang);
        }
    }
}
__device__ void ph_cache_prep(const Params& p, int l, const int wv) {
    const int tid = opaque_tid(wv);
    bf16_t* DKS = (bf16_t*)(p.ws + OFF_DKS); bf16_t* DVTS = (bf16_t*)(p.ws + OFF_DVTS);
    bf16_t* GKS = (bf16_t*)(p.ws + OFF_GKS); bf16_t* GVTS = (bf16_t*)(p.ws + OFF_GVTS);
    for (size_t idx = GTID; idx < 4 * 512 * 256; idx += GNT) {
        int c = idx & 255, pp = (idx >> 8) & 511, b = idx >> 17;
        size_t src = (((size_t)b * 2 + l) * PAST + pp) * 256 + c;
        int h = c >> 6, r = c & 63;
        DKS[(((size_t)b * 4 + h) * NKS + DSEQ + pp) * 64 + r] = f2bf(p.in[I_CDK][src]);
        DVTS[(((size_t)b * 4 + h) * 64 + r) * NKS + DSEQ + pp] = f2bf(p.in[I_CDV][src]);
        if (c < 128) {
            size_t src2 = (((size_t)b * 2 + l) * PAST + pp) * 128 + c;
            int kv = c >> 6;
            const int sq = DSEQ + pp;
            const size_t hb = ((size_t)b * 2 + kv) * NKS * 64 + (size_t)(sq >> 6) * 4096;
            GKS[hb + (r >> 3) * 512 + (sq & 63) * 8 + (r & 7)] = f2bf(p.in[I_CGK][src2]);
            GVTS[hb + (r >> 5) * 2048 + (sq & 63) * 32 + (r & 31)] = f2bf(p.in[I_CGV][src2]);
        }
    }
}
__device__ void ph_fold_tables(const Params& p, unsigned char* ldsraw, const int wv) {
    const int tid = opaque_tid(wv);
    const int lane = tid & 63;
    const int gw = blockIdx.x * 8 + (tid >> 6), nw = gridDim.x * 8;
    const float* MOD = (const float*)(p.ws + OFF_MOD);
    for (size_t idx = GTID; idx < (size_t)(1024 + 1024 + 2048) * 128; idx += GNT) {
        const int row = (int)(idx >> 7), k0 = (int)(idx & 127) * 8;
        const int which = row < 2048 ? 1 : 0, l = row < 1024 ? 0 : 1;
        const int n = row < 2048 ? (row & 1023) : row - 2048, N = row < 2048 ? 1024 : 2048;
        const bf16_t* src = row < 2048 ? (const bf16_t*)(p.ws + OFF_WQ) + ((size_t)l * D + n) * D + k0 : (const bf16_t*)(p.ws + OFF_WIN) + ((size_t)INW + n) * D + k0;
        bf16_t* dst = row < 2048 ? (bf16_t*)(p.ws + OFF_WQS) + ((size_t)l * 5 * D + n) * D + k0 : (bf16_t*)(p.ws + OFF_WINS) + (size_t)n * D + k0;
        const u32x4 w = *reinterpret_cast<const u32x4*>(src);
        const float* gn = p.in[which ? I_N2G : I_N1G] + l * D + k0;
        const float4 ga = *reinterpret_cast<const float4*>(gn), gb = *reinterpret_cast<const float4*>(gn + 4);
        float wf[8];
#pragma unroll
        for (int k = 0; k < 4; ++k) { wf[2 * k] = __uint_as_float(w[k] << 16); wf[2 * k + 1] = __uint_as_float(w[k] & 0xffff0000u); }
        wf[0] *= ga.x; wf[1] *= ga.y; wf[2] *= ga.z; wf[3] *= ga.w; wf[4] *= gb.x; wf[5] *= gb.y; wf[6] *= gb.z; wf[7] *= gb.w;
#pragma unroll
        for (int cv = 0; cv < 5; ++cv) {
            const float* sc = MOD + (size_t)(l * 5 + cv) * 6144 + which * 3072 + 1024 + k0;
            const float4 sa = *reinterpret_cast<const float4*>(sc), sb = *reinterpret_cast<const float4*>(sc + 4);
            *reinterpret_cast<u32x4*>(dst + (size_t)cv * N * D) = u32x4{pack_bf2(wf[0] * (1.f + sa.x), wf[1] * (1.f + sa.y)), pack_bf2(wf[2] * (1.f + sa.z), wf[3] * (1.f + sa.w)),
                                                                         pack_bf2(wf[4] * (1.f + sb.x), wf[5] * (1.f + sb.y)), pack_bf2(wf[6] * (1.f + sb.z), wf[7] * (1.f + sb.w))};
        }
    }
    for (int row = gw; row < 1024 + 1024 + 2048; row += nw) {
        const int which = row < 2048 ? 1 : 0, l = row < 1024 ? 0 : 1;
        const int n = row < 2048 ? (row & 1023) : row - 2048;
        const bf16_t* src = row < 2048 ? (const bf16_t*)(p.ws + OFF_WQ) + ((size_t)l * D + n) * D + lane * 16 : (const bf16_t*)(p.ws + OFF_WIN) + ((size_t)INW + n) * D + lane * 16;
        const u32x4 w0 = *reinterpret_cast<const u32x4*>(src), w1 = *reinterpret_cast<const u32x4*>(src + 8);
        float wf[16];
#pragma unroll
        for (int k = 0; k < 4; ++k) { wf[2 * k] = __uint_as_float(w0[k] << 16); wf[2 * k + 1] = __uint_as_float(w0[k] & 0xffff0000u);
                                      wf[8 + 2 * k] = __uint_as_float(w1[k] << 16); wf[8 + 2 * k + 1] = __uint_as_float(w1[k] & 0xffff0000u); }
#pragma unroll
        for (int cv = 0; cv < 5; ++cv) {
            const float* sh = MOD + (size_t)(l * 5 + cv) * 6144 + which * 3072 + lane * 16;
            float acc = 0.f;
#pragma unroll
            for (int q = 0; q < 4; ++q) {
                const float4 a = *reinterpret_cast<const float4*>(sh + q * 4);
                acc += wf[q * 4] * a.x + wf[q * 4 + 1] * a.y + wf[q * 4 + 2] * a.z + wf[q * 4 + 3] * a.w;
            }
            acc = wave_sum(acc);
            if (lane == 0) {
                if (row < 2048) ((float*)(p.ws + OFF_BQ))[(size_t)(l * 5 + cv) * D + n] = acc;
                else            ((float*)(p.ws + OFF_BIN))[(size_t)cv * INW + n] = acc;
            }
        }
    }
    {
        LAS signed char* s8 = (LAS signed char*)ldsraw;
        LAS float* s8s = (LAS float*)(ldsraw + 10 * 1024);
        const int wave = tid >> 6;
        for (int r = wave; r < 10; r += 8) {
            const float* sh = MOD + (size_t)r * 6144 + 3072 + lane * 16;
            float v[16];
#pragma unroll
            for (int q = 0; q < 4; ++q) { const float4 a = *reinterpret_cast<const float4*>(sh + q * 4); v[q * 4] = a.x; v[q * 4 + 1] = a.y; v[q * 4 + 2] = a.z; v[q * 4 + 3] = a.w; }
            float am = 0.f;
#pragma unroll
            for (int i = 0; i < 16; ++i) am = fmaxf(am, fabsf(v[i]));
            am = wave_max(am);
            const float sc = am > 0.f ? 127.f / am : 1.f;
            u32x4 w;
#pragma unroll
            for (int q = 0; q < 4; ++q) w[q] = pack4_i8(q8(v[q * 4] * sc), q8(v[q * 4 + 1] * sc), q8(v[q * 4 + 2] * sc), q8(v[q * 4 + 3] * sc));
            *(LAS u32x4*)(s8 + r * 1024 + lane * 16) = w;
            if (lane == 0) s8s[r] = am > 0.f ? am * (1.f / 127.f) : 1.f;
        }
        __syncthreads();
        const int fr = lane & 15, fq = lane >> 4;
        for (int task = gw; task < 2 * (NEXP / 16); task += nw) {
            const int l = task >> 10, e0 = (task & 1023) * 16;
            const unsigned char* up = p.ws + OFF_UT + ((size_t)l * 8 * NEXP + e0 + fr) * 128 + fq * 16;
            i32x4 acc = {0, 0, 0, 0};
#pragma unroll
            for (int st = 0; st < 16; ++st) {
                const i32x4 a = *reinterpret_cast<const i32x4*>(up + (size_t)(st >> 1) * NEXP * 128 + (st & 1) * 64);
                i32x4 b = {0, 0, 0, 0};
                if (fr < 5) b = *(const LAS i32x4*)(s8 + (l * 5 + fr) * 1024 + st * 64 + fq * 16);
                acc = __builtin_amdgcn_mfma_i32_16x16x64_i8(a, b, acc, 0, 0, 0);
            }
            if (fr < 5) {
                const float ss = s8s[l * 5 + fr];
#pragma unroll
                for (int r = 0; r < 4; ++r) {
                    const int e = e0 + fq * 4 + r;
                    ((float*)(p.ws + OFF_USH))[(size_t)(l * 5 + fr) * NEXP + e] = (float)acc[r] * ss * ((const float*)(p.ws + OFF_USC))[l * NEXP + e];
                }
            }
        }
        __syncthreads();
    }
}
__device__ void ph_norm_mod(const Params& p, int l, int which, int from_input, const int wv) {
    const int tid = opaque_tid(wv);
    const int lane = tid & 63;
    const int gw = blockIdx.x * 8 + (tid >> 6), nw = gridDim.x * 8;
    const float* g = p.in[which ? I_N2G : I_N1G] + l * D;
    if (from_input) {
        float4 nx[4];
        {
            const int t = gw < NTOK ? gw : NTOK - 1;
            const float* xr = x_in_row(p, t);
#pragma unroll
            for (int i = 0; i < 4; ++i) nx[i] = *reinterpret_cast<const float4*>(xr + i * 256 + lane * 4);
        }
        for (int t = gw; t < NTOK; t += nw) {
            float4 v[4];
#pragma unroll
            for (int i = 0; i < 4; ++i) v[i] = nx[i];
            {
                const int tn = t + nw < NTOK ? t + nw : t;
                const float* xn = x_in_row(p, tn);
#pragma unroll
                for (int i = 0; i < 4; ++i) nx[i] = *reinterpret_cast<const float4*>(xn + i * 256 + lane * 4);
            }
            const float* mod = (const float*)(p.ws + OFF_MOD) + (size_t)(l * 5 + tok_cv(t)) * 6144 + which * 3072;
            float ss = 0.f;
#pragma unroll
            for (int i = 0; i < 4; ++i) ss += v[i].x * v[i].x + v[i].y * v[i].y + v[i].z * v[i].z + v[i].w * v[i].w;
            ss = wave_sum(ss);
            float r = rsqrtf(ss / D + EPS);
            bf16_t* H = (bf16_t*)(p.ws + OFF_H) + (size_t)t * D;
#pragma unroll
            for (int i = 0; i < 4; ++i) {
                int c = i * 256 + lane * 4;
                float4 gg = *reinterpret_cast<const float4*>(g + c), sh = *reinterpret_cast<const float4*>(mod + c), sc = *reinterpret_cast<const float4*>(mod + 1024 + c);
                uint2 o;
                o.x = pack_bf2(v[i].x * r * gg.x * (1.f + sc.x) + sh.x, v[i].y * r * gg.y * (1.f + sc.y) + sh.y);
                o.y = pack_bf2(v[i].z * r * gg.z * (1.f + sc.z) + sh.z, v[i].w * r * gg.w * (1.f + sc.w) + sh.w);
                *reinterpret_cast<uint2*>(H + c) = o;
            }
        }
    } else {
        u32x4 nx[2];
        {
            const int t = gw < NTOK ? gw : NTOK - 1;
            const bf16_t* xr = (const bf16_t*)(p.ws + OFF_XC) + (size_t)t * D + lane * 8;
            nx[0] = *reinterpret_cast<const u32x4*>(xr); nx[1] = *reinterpret_cast<const u32x4*>(xr + 512);
        }
        for (int t = gw; t < NTOK; t += nw) {
            float v[16];
#pragma unroll
            for (int h = 0; h < 2; ++h)
#pragma unroll
                for (int k = 0; k < 4; ++k) { v[h * 8 + 2 * k] = __uint_as_float(nx[h][k] << 16); v[h * 8 + 2 * k + 1] = __uint_as_float(nx[h][k] & 0xffff0000u); }
            {
                const int tn = t + nw < NTOK ? t + nw : t;
                const bf16_t* xn = (const bf16_t*)(p.ws + OFF_XC) + (size_t)tn * D + lane * 8;
                nx[0] = *reinterpret_cast<const u32x4*>(xn); nx[1] = *reinterpret_cast<const u32x4*>(xn + 512);
            }
            const float* mod = (const float*)(p.ws + OFF_MOD) + (size_t)(l * 5 + tok_cv(t)) * 6144 + which * 3072;
            float ss = 0.f;
#pragma unroll
            for (int i = 0; i < 16; ++i) ss += v[i] * v[i];
            ss = wave_sum(ss);
            float r = rsqrtf(ss / D + EPS);
            bf16_t* H = (bf16_t*)(p.ws + OFF_H) + (size_t)t * D;
            float hq[16];
#pragma unroll
            for (int h = 0; h < 2; ++h) {
                const int c = h * 512 + lane * 8;
                float o[8];
#pragma unroll
                for (int q = 0; q < 2; ++q) {
                    const float4 gg = *reinterpret_cast<const float4*>(g + c + q * 4), sh = *reinterpret_cast<const float4*>(mod + c + q * 4), sc = *reinterpret_cast<const float4*>(mod + 1024 + c + q * 4);
                    o[q * 4] = v[h * 8 + q * 4] * r * gg.x * (1.f + sc.x) + sh.x; o[q * 4 + 1] = v[h * 8 + q * 4 + 1] * r * gg.y * (1.f + sc.y) + sh.y;
                    o[q * 4 + 2] = v[h * 8 + q * 4 + 2] * r * gg.z * (1.f + sc.z) + sh.z; o[q * 4 + 3] = v[h * 8 + q * 4 + 3] * r * gg.w * (1.f + sc.w) + sh.w;
                }
                *reinterpret_cast<u32x4*>(H + c) = u32x4{pack_bf2(o[0], o[1]), pack_bf2(o[2], o[3]), pack_bf2(o[4], o[5]), pack_bf2(o[6], o[7])};
#pragma unroll
                for (int q = 0; q < 8; ++q) hq[h * 8 + q] = o[q];
            }
            if (which) {
                float am = 0.f;
#pragma unroll
                for (int i = 0; i < 16; ++i) am = fmaxf(am, fabsf(hq[i]));
#pragma unroll
                for (int o2 = 32; o2 >= 1; o2 >>= 1) am = fmaxf(am, shfl_x(am, lane, o2));
                const float sc8 = am > 0.f ? 127.f / am : 1.f;
#pragma unroll
                for (int h = 0; h < 2; ++h) {
                    uint2 w;
                    w.x = pack4_i8(q8(hq[h * 8] * sc8), q8(hq[h * 8 + 1] * sc8), q8(hq[h * 8 + 2] * sc8), q8(hq[h * 8 + 3] * sc8));
                    w.y = pack4_i8(q8(hq[h * 8 + 4] * sc8), q8(hq[h * 8 + 5] * sc8), q8(hq[h * 8 + 6] * sc8), q8(hq[h * 8 + 7] * sc8));
                    *reinterpret_cast<uint2*>(p.ws + OFF_H8I + (size_t)t * D + h * 512 + lane * 8) = w;
                }
                if (lane == 0) ((float*)(p.ws + OFF_HSC))[t] = am > 0.f ? am * (1.f / 127.f) : 1.f;
            }
        }
    }
}
__device__ void ph_sgu_norm(const Params& p, int l, const int wv) {
    const int tid = opaque_tid(wv);
    const int lane = tid & 63;
    const int gw = blockIdx.x * 8 + (tid >> 6), nw = gridDim.x * 8;
    for (int t = gw; t < NTOK; t += nw) {
        const bf16_t* AV = (const bf16_t*)(p.ws + OFF_AV) + (size_t)t * 256;
        float v[4]; float ss = 0.f;
#pragma unroll
        for (int i = 0; i < 4; ++i) { v[i] = bf2f(AV[i * 64 + lane]); ss += v[i] * v[i]; }
        ss = wave_sum(ss);
        float r = rsqrtf(ss / 256.f + EPS);
#pragma unroll
        for (int i = 0; i < 4; ++i) ((bf16_t*)(p.ws + OFF_AVN))[(size_t)t * 256 + i * 64 + lane] = f2bf(v[i] * r * p.in[I_SGUNG][l * 256 + i * 64 + lane]);
    }
}
__device__ void ph_sgu_mix(const Params& p, int l, const int wv) {
    const int tid = opaque_tid(wv);
    const bf16_t* AVN = (const bf16_t*)(p.ws + OFF_AVN);
    for (size_t idx = GTID; idx < (size_t)NTOK * 256; idx += GNT) {
        int t = (int)(idx >> 8), c = (int)(idx & 255);
        int t0 = t & ~127, pp = t & 127, g = c >> 6;
        const bf16_t* W = (const bf16_t*)(p.ws + OFF_SGUW) + (((size_t)l * 4 + g) * 128 + pp) * 128;
        float acc = 0.f;
        for (int q = 0; q < 128; ++q) acc += bf2f(W[q]) * bf2f(AVN[(size_t)(t0 + q) * 256 + c]);
        acc += p.in[I_SGUB][(l * 4 + g) * 128 + pp];
        float au = bf2f(((const bf16_t*)(p.ws + OFF_AU))[(size_t)t * 256 + c]);
        ((bf16_t*)(p.ws + OFF_MIX))[(size_t)t * D + c] = f2bf(au * acc);
    }
}
__device__ void ph_attn_ref(const Params& p, int l, const int wv) {
    const int tid = opaque_tid(wv);
    const int lane = tid & 63;
    const int gw = blockIdx.x * 8 + (tid >> 6), nw = gridDim.x * 8;
    const float lam = lam_of(p, l);
    for (int item = gw; item < NTOK * 12; item += nw) {
        const int t = item % NTOK, hh = item / NTOK;
        const bool prompt = t < NPT;
        const int b = prompt ? t / SEQ : (t - NPT) / DSEQ;
        const int nk = prompt ? SEQ : NKS;
        if (hh < 4) {
            const int h = hh;
            const bf16_t* K = prompt ? (const bf16_t*)(p.ws + OFF_DKP) + ((size_t)b * 4 + h) * SEQ * 64 : (const bf16_t*)(p.ws + OFF_DKS) + ((size_t)b * 4 + h) * NKS * 64;
            const bf16_t* Vt = prompt ? (const bf16_t*)(p.ws + OFF_DVTP) + ((size_t)b * 4 + h) * 64 * SEQ : (const bf16_t*)(p.ws + OFF_DVTS) + ((size_t)b * 4 + h) * 64 * NKS;
            float q = bf2f(((const bf16_t*)(p.ws + OFF_DQ))[(size_t)t * 256 + h * 64 + lane]);
            const float scale = 0.17677669529663687f;
            float m0 = -1e30f, m1 = -1e30f, l0 = 0.f, l1 = 0.f, a0 = 0.f, a1 = 0.f;
            for (int k = 0; k < nk; ++k) {
                float pr = q * bf2f(K[(size_t)k * 64 + lane]);
#pragma unroll
                for (int o = 16; o >= 1; o >>= 1) pr += shfl_x(pr, lane, o);
                float s0 = shfl_i(pr, 0) * scale, s1 = shfl_i(pr, 32) * scale;
                float v = bf2f(Vt[(size_t)lane * nk + k]);
                float mn0 = fmaxf(m0, s0), mn1 = fmaxf(m1, s1);
                float c0 = expf(m0 - mn0), c1 = expf(m1 - mn1);
                float e0 = expf(s0 - mn0), e1 = expf(s1 - mn1);
                l0 = l0 * c0 + e0; l1 = l1 * c1 + e1;
                a0 = a0 * c0 + e0 * v; a1 = a1 * c1 + e1 * v;
                m0 = mn0; m1 = mn1;
            }
            float o = a0 / l0 - lam * a1 / l1;
            float ss = wave_sum(o * o);
            float r = rsqrtf(ss / 64.f + EPS);
            o = o * r * p.in[I_SUBLN][l * 64 + lane] * (1.f - lam_init_of(l));
            ((bf16_t*)(p.ws + OFF_MIX))[(size_t)t * D + 256 + h * 64 + lane] = f2bf(o);
        } else {
            const int hq = hh - 4, kv = hq >> 2;
            const bf16_t* K = prompt ? (const bf16_t*)(p.ws + OFF_GKP) + ((size_t)b * 2 + kv) * SEQ * 64 : (const bf16_t*)(p.ws + OFF_GKS) + ((size_t)b * 2 + kv) * NKS * 64;
            const bf16_t* Vt = prompt ? (const bf16_t*)(p.ws + OFF_GVTP) + ((size_t)b * 2 + kv) * 64 * SEQ : (const bf16_t*)(p.ws + OFF_GVTS) + ((size_t)b * 2 + kv) * 64 * NKS;
            float q = bf2f(((const bf16_t*)(p.ws + OFF_GQ))[(size_t)t * 512 + hq * 64 + lane]);
            float m = -1e30f, ls = 0.f, a = 0.f;
            for (int k = 0; k < nk; ++k) {
                float s = wave_sum(q * bf2f(K[(size_t)k * 64 + lane])) * 0.125f;
                float v = bf2f(Vt[(size_t)lane * nk + k]);
                float mn = fmaxf(m, s);
                float c = expf(m - mn), e = expf(s - mn);
                ls = ls * c + e; a = a * c + e * v; m = mn;
            }
            ((bf16_t*)(p.ws + OFF_MIX))[(size_t)t * D + 512 + hq * 64 + lane] = f2bf(a / ls);
        }
    }
}
__device__ void ph_peer_scores(const Params& p, int l, const int wv) {
    const int tid = opaque_tid(wv);
    const bf16_t* SK = (const bf16_t*)(p.ws + OFF_SUBK) + (size_t)l * 2 * 128 * 64;
    for (size_t idx = GTID; idx < (size_t)NTOK * 2048; idx += GNT) {
        int t = (int)(idx >> 11), o = (int)(idx & 2047);
        const bf16_t* Q = (const bf16_t*)(p.ws + OFF_Q) + (size_t)t * D;
        int n = o & 127, x = (o >> 7) & 1, h = o >> 8;
        float acc = 0.f;
        for (int k = 0; k < 64; ++k) acc += bf2f(Q[h * 128 + x * 64 + k]) * bf2f(SK[((size_t)x * 128 + n) * 64 + k]);
        ((float*)(p.ws + OFF_PROJ))[idx] = acc;
    }
}
__device__ void ph_peer_top1(const Params& p, const int wv) {
    const int tid = opaque_tid(wv);
    for (size_t idx = GTID; idx < (size_t)NTOK * 16; idx += GNT) {
        const float* SC = (const float*)(p.ws + OFF_PROJ) + idx * 128;
        float* TV = (float*)(p.ws + OFF_TOPV) + idx * 16; int* TI = (int*)(p.ws + OFF_TOPI) + idx * 16;
        float pv = 3.0e38f; int pi = -1;
        for (int r = 0; r < 16; ++r) {
            float bv = -3.0e38f; int bi = -1;
            for (int n = 0; n < 128; ++n) {
                float v = SC[n];
                bool after = (v < pv) || (v == pv && n > pi);
                if (after && (bi < 0 || v > bv)) { bv = v; bi = n; }
            }
            TV[r] = bv; TI[r] = bi; pv = bv; pi = bi;
        }
    }
}
__device__ void ph_peer_top2(const Params& p, const int wv) {
    const int tid = opaque_tid(wv);
    for (size_t idx = GTID; idx < (size_t)NTOK * 8; idx += GNT) {
        const float* TV = (const float*)(p.ws + OFF_TOPV) + idx * 32; const int* TI = (const int*)(p.ws + OFF_TOPI) + idx * 32;
        int* EI = (int*)(p.ws + OFF_EIDX) + idx * 16; float* EG = (float*)(p.ws + OFF_EGATE) + idx * 16;
        float pv = 3.0e38f; int pi = -1; float mx = 0.f, sum = 0.f;
        for (int r = 0; r < 16; ++r) {
            float bv = -3.0e38f; int bi = -1;
            for (int n = 0; n < 256; ++n) {
                float v = TV[n >> 4] + TV[16 + (n & 15)];
                bool after = (v < pv) || (v == pv && n > pi);
                if (after && (bi < 0 || v > bv)) { bv = v; bi = n; }
            }
            if (r == 0) mx = bv;
            float e = expf(bv - mx);
            sum += e;
            EG[r] = e; EI[r] = TI[bi >> 4] * 128 + TI[16 + (bi & 15)];
            pv = bv; pi = bi;
        }
        float inv = 1.f / sum;
        for (int r = 0; r < 16; ++r) EG[r] *= inv;
    }
}
__device__ void ph_peer_apply(const Params& p, int l, unsigned char* lds, const int wv) {
    const int tid = opaque_tid(wv);
    const int sub = tid >> 8, tl = tid & 255;
    const int wave = tl >> 6, lane = tl & 63;
    float* wts = (float*)(lds + 64) + sub * 128; int* eid = (int*)(lds + 64 + 1024) + sub * 128;
    const bf16_t* UT = (const bf16_t*)(p.ws + OFF_UT) + (size_t)l * NEXP * D;
    const bf16_t* VT = (const bf16_t*)(p.ws + OFF_VT) + (size_t)l * NEXP * D;
    const int niter = (NTOK + gridDim.x * 2 - 1) / (gridDim.x * 2);
    for (int it = 0; it < niter; ++it) {
        int t = (it * gridDim.x + blockIdx.x) * 2 + sub;
        const bool valid = t < NTOK; if (!valid) t = NTOK - 1;
        const bf16_t* H = (const bf16_t*)(p.ws + OFF_H) + (size_t)t * D;
        const int* EI = (const int*)(p.ws + OFF_EIDX) + (size_t)t * 128; const float* EG = (const float*)(p.ws + OFF_EGATE) + (size_t)t * 128;
        float hv[16];
#pragma unroll
        for (int i = 0; i < 16; ++i) hv[i] = bf2f(H[lane * 16 + i]);
        for (int jj = 0; jj < 32; ++jj) {
            int j = wave * 32 + jj; int e = EI[j];
            const bf16_t* ur = UT + (size_t)e * D + lane * 16;
            float acc = 0.f;
#pragma unroll
            for (int i = 0; i < 16; ++i) acc += hv[i] * bf2f(ur[i]);
            acc = wave_sum(acc);
            if (lane == 0) { wts[j] = EG[j] * gelu_f(acc); eid[j] = e; }
        }
        __syncthreads();
        float o[4] = {0.f, 0.f, 0.f, 0.f};
        for (int j = 0; j < 128; ++j) {
            const bf16_t* vr = VT + (size_t)eid[j] * D + tl * 4; float w = wts[j];
#pragma unroll
            for (int i = 0; i < 4; ++i) o[i] += w * bf2f(vr[i]);
        }
        const float* mod = (const float*)(p.ws + OFF_MOD) + (size_t)(l * 5 + tok_cv(t)) * 6144 + 5 * 1024;
        float* XC = (float*)(p.ws + OFF_XC) + (size_t)t * D;
        if (valid) {
#pragma unroll
            for (int i = 0; i < 4; ++i) { int c = tl * 4 + i; XC[c] += mod[c] * o[i]; }
        }
        __syncthreads();
    }
}
__device__ void ph_final_norm(const Params& p, const int wv) {
    const int tid = opaque_tid(wv);
    const int lane = tid & 63;
    const int gw = blockIdx.x * 8 + (tid >> 6), nw = gridDim.x * 8;
    u32x4 nx[2];
    {
        const int t = gw < NTOK ? gw : NTOK - 1;
        const bf16_t* xr = (const bf16_t*)(p.ws + OFF_XC) + (size_t)t * D + lane * 8;
        nx[0] = *reinterpret_cast<const u32x4*>(xr); nx[1] = *reinterpret_cast<const u32x4*>(xr + 512);
    }
    for (int t = gw; t < NTOK; t += nw) {
        float v[16];
#pragma unroll
        for (int h = 0; h < 2; ++h)
#pragma unroll
            for (int k = 0; k < 4; ++k) { v[h * 8 + 2 * k] = __uint_as_float(nx[h][k] << 16); v[h * 8 + 2 * k + 1] = __uint_as_float(nx[h][k] & 0xffff0000u); }
        {
            const int tn = t + nw < NTOK ? t + nw : t;
            const bf16_t* xn = (const bf16_t*)(p.ws + OFF_XC) + (size_t)tn * D + lane * 8;
            nx[0] = *reinterpret_cast<const u32x4*>(xn); nx[1] = *reinterpret_cast<const u32x4*>(xn + 512);
        }
        float ss = 0.f;
#pragma unroll
        for (int i = 0; i < 16; ++i) ss += v[i] * v[i];
        ss = wave_sum(ss);
        float r = rsqrtf(ss / D + EPS);
        float* y = p.out + (size_t)t * D;
#pragma unroll
        for (int h = 0; h < 2; ++h) {
            const int c = h * 512 + lane * 8;
#pragma unroll
            for (int q = 0; q < 2; ++q) {
                const float4 g = *reinterpret_cast<const float4*>(p.in[I_FG] + c + q * 4);
                *reinterpret_cast<float4*>(y + c + q * 4) = make_float4(v[h * 8 + q * 4] * r * g.x, v[h * 8 + q * 4 + 1] * r * g.y, v[h * 8 + q * 4 + 2] * r * g.z, v[h * 8 + q * 4 + 3] * r * g.w);
            }
        }
    }
}


namespace g8 {
constexpr int BM = 256, BK = 64, HALF = 128, HT = HALF * BK;
__device__ __forceinline__ int lds_byte(int r, int c) {
    int st = (r >> 4) * 2 + (c >> 5), rr = r & 15, cc = c & 31, ob = rr * 64 + cc * 2;
    return st * 1024 + (ob ^ (((ob >> 9) & 1) << 5));
}
__device__ __forceinline__ void stage_rc(int b, int& R, int& C) {
    int st = b / 1024, sb = b % 1024, swz = sb ^ (((sb >> 9) & 1) << 5);
    R = (st >> 1) * 16 + swz / 64; C = (st & 1) * 32 + (swz % 64) / 2;
}
}
enum { EPI_INPROJ = 0, EPI_WOUT = 1, EPI_WQ = 2 };
constexpr int STG = 132;

__device__ __forceinline__ void store_bf16x32(bf16_t* dst, const float (&v)[32]) {
#pragma unroll
    for (int i = 0; i < 4; ++i) {
        uint4 u;
        u.x = pack_bf2(v[i * 8 + 0], v[i * 8 + 1]); u.y = pack_bf2(v[i * 8 + 2], v[i * 8 + 3]);
        u.z = pack_bf2(v[i * 8 + 4], v[i * 8 + 5]); u.w = pack_bf2(v[i * 8 + 6], v[i * 8 + 7]);
        *reinterpret_cast<uint4*>(dst + i * 8) = u;
    }
}
__device__ __forceinline__ void store_f32x32(float* dst, const float (&v)[32]) {
#pragma unroll
    for (int i = 0; i < 8; ++i) *reinterpret_cast<float4*>(dst + i * 4) = make_float4(v[i * 4], v[i * 4 + 1], v[i * 4 + 2], v[i * 4 + 3]);
}

__device__ __forceinline__ void epi_inproj_xform(const Params& p, int l, int t, int c0, float (&v)[32]) {
    const bool prompt = t < NPT;
    const int s = prompt ? (t & 255) : ((t - NPT) & 2047);
    const float* R = (const float*)(p.ws + OFF_ROPE);
    if (c0 < 512) {
#pragma unroll
        for (int i = 0; i < 32; ++i) v[i] = gelu_f(v[i]);
    } else if (c0 < 1024) {
        if (!prompt) {
            const float* cs = R + s * 16; const float* sn = R + 2048 * 16 + s * 16;
#pragma unroll
            for (int i = 0; i < 16; ++i) {
                float c = cs[i], sv = sn[i], x1 = v[i], x2 = v[i + 16];
                v[i] = x1 * c - x2 * sv; v[i + 16] = x2 * c + x1 * sv;
            }
        }
    } else if (c0 >= 1280 && c0 < 1920) {
        const bool isq = c0 < 1792;
        const int hi = c0 & 32;
        const float* g = p.in[isq ? I_QNG : I_KNG] + l * 64 + hi;
        float ss = 0.f;
#pragma unroll
        for (int i = 0; i < 32; ++i) ss += v[i] * v[i];
        const int ln = lane_id_op();
        ss += shfl_x(ss, ln, 1);
        const float rr = rsqrtf(ss * (1.f / 64.f) + EPS);
#pragma unroll
        for (int i = 0; i < 32; ++i) v[i] = v[i] * rr * g[i];
        if (!prompt) {
            const float* cs = R + 2048 * 32 + s * 32; const float* sn = R + 2048 * 64 + s * 32;
#pragma unroll
            for (int i = 0; i < 32; ++i) {
                float pv = shfl_x(v[i], ln, 1);
                float c = cs[i], sv = sn[i];
                v[i] = hi ? (v[i] * c + pv * sv) : (v[i] * c - pv * sv);
            }
        }
        if (isq) {
#pragma unroll
            for (int i = 0; i < 32; ++i) v[i] *= 0.125f * 1.4426950408889634f;
        }
    }
}
__device__ __forceinline__ void epi_inproj_col(const Params& p, int t0, int c, const LAS float* stc) {
    float v[32];
#pragma unroll
    for (int i = 0; i < 32; ++i) v[i] = stc[i * STG];
    const bool prompt = t0 < NPT;
    const int b = prompt ? (t0 >> 8) : ((t0 - NPT) >> 11);
    const int s = prompt ? (t0 & 255) : ((t0 - NPT) & 2047);
    unsigned char* ws = p.ws;
    bf16_t* dst;
    if (c < 1280) {
        const int cc = c - 1024, h = cc >> 6, d = cc & 63;
        dst = prompt ? (bf16_t*)(ws + OFF_DVTP) + (((size_t)b * 4 + h) * 64 + d) * SEQ + s
                     : (bf16_t*)(ws + OFF_DVTS) + (((size_t)b * 4 + h) * 64 + d) * NKS + s;
    } else {
        const int cc = c - 1920, kv = cc >> 6, d = cc & 63;
        dst = prompt ? (bf16_t*)(ws + OFF_GVTP) + (((size_t)b * 2 + kv) * 64 + d) * SEQ + s
                     : (bf16_t*)(ws + OFF_GVTS) + (((size_t)b * 2 + kv) * 64 + d) * NKS + s;
    }
    store_bf16x32(dst, v);
}

template <int MODE>
__device__ __forceinline__ void gemm_phase(const Params& p, int l, const bf16_t* __restrict__ A, const bf16_t* __restrict__ Bt, const int N, unsigned char* ldsraw, const int wv,
                                           const size_t cvstride = 0, const float* __restrict__ RSS = nullptr, const float* __restrict__ BIAS = nullptr) {
    using namespace g8;
    constexpr int K = 1024, nt = K / BK, BN = 128, TILE_A = BM * BK * 2, TILE_B = BN * BK * 2, STAGE_B = TILE_A + TILE_B;
    LAS unsigned char* lds = (LAS unsigned char*)ldsraw;
    const int tid = opaque_tid(wv), wid = wv, lane = tid & 63;
    const int wr = wid >> 1, wc = wid & 1, fr = lane & 15, fq = lane >> 4;
    unsigned voff[4];
#pragma unroll
    for (int i = 0; i < 4; ++i) voff[i] = (unsigned)((i * 64 + wid * 8 + (lane >> 3)) * K + (((lane & 7) ^ (lane >> 3)) * 8)) * 2u;
    const int aoff = (wr * 64 + fr) * 128 + ((fq ^ (fr & 7)) * 16), boff = (wc * 64 + fr) * 128 + ((fq ^ (fr & 7)) * 16);
    const unsigned ldsw = (unsigned)wid * 1024u;
#define G8_STAGE(buf, kt) do { \
        _Pragma("unroll") for (int _i = 0; _i < 4; ++_i) \
            __builtin_amdgcn_global_load_lds((const unsigned*)((const char*)(Ab + (kt) * BK) + voff[_i]), (LAS unsigned*)(lds + (buf) * STAGE_B + ldsw + _i * 8192), 16, 0, 0); \
        _Pragma("unroll") for (int _i = 0; _i < 2; ++_i) \
            __builtin_amdgcn_global_load_lds((const unsigned*)((const char*)(Bb + (kt) * BK) + voff[_i]), (LAS unsigned*)(lds + (buf) * STAGE_B + TILE_A + ldsw + _i * 8192), 16, 0, 0); } while (0)
#define G8_WAIT_V0() asm volatile("s_waitcnt vmcnt(0)" ::: "memory")
    const int nN = N / BN, nM = NTOK / BM, ntiles = nM * nN;
    const int G = gridDim.x;
    const int vb = (G % 8 == 0) ? (int)(blockIdx.x % 8) * (G / 8) + (int)(blockIdx.x / 8) : (int)blockIdx.x;
    const int tpb = (ntiles + G - 1) / G;
    const bool paneled = (G == 256) && (nN == 8 || nN == 16) && (nM == 64);
    for (int ti = 0; ti < tpb; ++ti) {
        int tile = vb * tpb + ti;
        if (paneled) {
            const int x = vb >> 5, j = vb & 31;
            const int mpx = nN == 16 ? 16 : 8;
            const int m0 = nN == 16 ? (x >> 1) * 16 : x * 8, n0 = nN == 16 ? (x & 1) * 8 : 0;
            const int pm_ = m0 + ti * 4 + (j >> 3), pn_ = n0 + (j & 7);
            tile = (ti * 4 < mpx) ? pm_ * nN + pn_ : ntiles;
        }
        if (tile >= ntiles) break;
        const int pm = tile / nN, pn = tile % nN, brow = pm * BM, bcol = pn * BN;
        const bf16_t* Ab = A + (size_t)brow * K; const bf16_t* Bb = Bt + (size_t)tok_cv(brow) * cvstride + (size_t)bcol * K;
        f32x4 acc[4][4];
#pragma unroll
        for (int m = 0; m < 4; ++m)
#pragma unroll
            for (int n = 0; n < 4; ++n) acc[m][n] = f32x4{0.f, 0.f, 0.f, 0.f};
        G8_WAIT_V0();
        G8_STAGE(0, 0); G8_STAGE(1, 1);
        int cur = 0;
        for (int t = 0; t < nt; ++t) {
            if (t + 1 < nt) asm volatile("s_waitcnt vmcnt(6)" ::: "memory"); else asm volatile("s_waitcnt vmcnt(0)" ::: "memory");
            __builtin_amdgcn_s_barrier();
            if (t + 2 < nt) { const int nb = cur >= 1 ? cur - 1 : 2; G8_STAGE(nb, t + 2); }
            {
                bf16x8 At[2][4], Bf[2][4];
#pragma unroll
                for (int ks = 0; ks < 2; ++ks) {
#pragma unroll
                    for (int m = 0; m < 4; ++m) At[ks][m] = *(const LAS bf16x8*)(lds + cur * STAGE_B + ((aoff + m * 2048) ^ (ks * 64)));
#pragma unroll
                    for (int n = 0; n < 4; ++n) Bf[ks][n] = *(const LAS bf16x8*)(lds + cur * STAGE_B + TILE_A + ((boff + n * 2048) ^ (ks * 64)));
                }
                __builtin_amdgcn_sched_barrier(0);
#pragma unroll
                for (int ks = 0; ks < 2; ++ks)
#pragma unroll
                    for (int m = 0; m < 4; ++m)
#pragma unroll
                        for (int n = 0; n < 4; ++n) acc[m][n] = __builtin_amdgcn_mfma_f32_16x16x32_bf16(At[ks][m], Bf[ks][n], acc[m][n], 0, 0, 0);
                __builtin_amdgcn_sched_barrier(0);
            }
            cur = cur == 2 ? 0 : cur + 1;
        }
        __syncthreads();
        LAS float* st = (LAS float*)lds;
        if (MODE != EPI_WOUT && cvstride != 0) {
            LAS float* rs = st + 256 * STG;
            if (tid < 256) {
                const float* rp = RSS + (size_t)(brow + tid) * 8;
                const float4 a = *reinterpret_cast<const float4*>(rp), b = *reinterpret_cast<const float4*>(rp + 4);
                rs[tid] = rsqrtf((((a.x + a.y) + (a.z + a.w)) + ((b.x + b.y) + (b.z + b.w))) * (1.f / D) + EPS);
            }
            __syncthreads();
            float bz[4];
#pragma unroll
            for (int n = 0; n < 4; ++n) bz[n] = BIAS[(size_t)tok_cv(brow) * N + bcol + wc * 64 + n * 16 + fr];
#pragma unroll
            for (int m = 0; m < 4; ++m)
#pragma unroll
                for (int j = 0; j < 4; ++j) {
                    const float r = rs[wr * 64 + m * 16 + fq * 4 + j];
#pragma unroll
                    for (int n = 0; n < 4; ++n) st[(wr * 64 + m * 16 + fq * 4 + j) * STG + wc * 64 + n * 16 + fr] = acc[m][n][j] * r + bz[n];
                }
        } else {
#pragma unroll
        for (int m = 0; m < 4; ++m)
#pragma unroll
            for (int n = 0; n < 4; ++n)
#pragma unroll
                for (int j = 0; j < 4; ++j)
                    st[(wr * 64 + m * 16 + fq * 4 + j) * STG + wc * 64 + n * 16 + fr] = acc[m][n][j];
        }
        __syncthreads();
        const bool tprompt = brow < NPT;
        const int tb_ = tprompt ? (brow >> 8) : ((brow - NPT) >> 11), ts0 = tprompt ? 0 : ((brow - NPT) & 2047);
        if (MODE == EPI_INPROJ) {
            const bool vtile = (bcol >= 1024 && bcol < 1280);
            if (!vtile) {
#pragma unroll 1
                for (int it = 0; it < 2; ++it) {
                    const int item = it * NT + tid, erow = item >> 2, eseg = item & 3;
                    float v[32];
#pragma unroll
                    for (int i = 0; i < 8; ++i) {
                        const f32x4 f = *(const LAS f32x4*)(st + erow * STG + eseg * 32 + i * 4);
                        v[i * 4] = f[0]; v[i * 4 + 1] = f[1]; v[i * 4 + 2] = f[2]; v[i * 4 + 3] = f[3];
                    }
                    epi_inproj_xform(p, l, brow + erow, bcol + eseg * 32, v);
#pragma unroll
                    for (int i = 0; i < 8; ++i) *(LAS f32x4*)(st + erow * STG + eseg * 32 + i * 4) = f32x4{v[i * 4], v[i * 4 + 1], v[i * 4 + 2], v[i * 4 + 3]};
                }
                __syncthreads();
#pragma unroll 1
                for (int it = 0; it < 8; ++it) {
                    const int item = it * NT + tid, r = item >> 4, c = (item & 15) * 8;
                    const f32x4 f0 = *(const LAS f32x4*)(st + r * STG + c), f1 = *(const LAS f32x4*)(st + r * STG + c + 4);
                    const int t = brow + r, sp = ts0 + r;
                    bf16_t* dst;
                    if (bcol < 512)        dst = (bf16_t*)(p.ws + (bcol < 256 ? OFF_AU : OFF_AV)) + (size_t)t * 256 + (bcol & 255) + c;
                    else if (bcol < 768)   dst = (bf16_t*)(p.ws + OFF_DQ) + (size_t)t * 256 + (bcol - 512) + c;
                    else if (bcol < 1024) { const int cc = bcol - 768 + c, h = cc >> 6;
                                            dst = tprompt ? (bf16_t*)(p.ws + OFF_DKP) + (((size_t)tb_ * 4 + h) * SEQ + sp) * 64 + (cc & 63)
                                                          : (bf16_t*)(p.ws + OFF_DKS) + (((size_t)tb_ * 4 + h) * NKS + sp) * 64 + (cc & 63); }
                    else if (bcol < 1792)  dst = (bf16_t*)(p.ws + OFF_GQ) + (size_t)t * 512 + (bcol - 1280) + c;
                    else                 { const int kv = c >> 6, d0 = c & 63;
                                            const size_t hb = (tprompt ? ((size_t)tb_ * 2 + kv) * SEQ * 64 : ((size_t)tb_ * 2 + kv) * NKS * 64) + (size_t)(sp >> 6) * 4096;
                                            dst = bcol < 1920 ? (bf16_t*)(p.ws + (tprompt ? OFF_GKP : OFF_GKS)) + hb + (d0 >> 3) * 512 + (sp & 63) * 8
                                                              : (bf16_t*)(p.ws + (tprompt ? OFF_GVTP : OFF_GVTS)) + hb + (d0 >> 5) * 2048 + (sp & 63) * 32 + (d0 & 31); }
                    *reinterpret_cast<u32x4*>(dst) = u32x4{pack_bf2(f0[0], f0[1]), pack_bf2(f0[2], f0[3]), pack_bf2(f1[0], f1[1]), pack_bf2(f1[2], f1[3])};
                }
            }
            if (tprompt && ((bcol >= 768 && bcol < 1280) || bcol >= 1792)) {
                float* ob; int rs;
                if (bcol < 1024)      { ob = p.out + OUT_NDK + (((size_t)tb_ * 2 + l) * SEQ) * 256 + (bcol - 768);  rs = 256; }
                else if (bcol < 1280) { ob = p.out + OUT_NDV + (((size_t)tb_ * 2 + l) * SEQ) * 256 + (bcol - 1024); rs = 256; }
                else if (bcol < 1920) { ob = p.out + OUT_NGK + (((size_t)tb_ * 2 + l) * SEQ) * 128;                 rs = 128; }
                else                  { ob = p.out + OUT_NGV + (((size_t)tb_ * 2 + l) * SEQ) * 128;                 rs = 128; }
#pragma unroll 1
                for (int it = 0; it < 16; ++it) {
                    const int item = it * NT + tid, r = item >> 5, c = (item & 31) * 4;
                    *reinterpret_cast<f32x4*>(ob + (size_t)r * rs + c) = *(const LAS f32x4*)(st + r * STG + c);
                }
            }
            if (vtile) {
#pragma unroll 1
                for (int it = 0; it < 2; ++it) {
                    const int item = it * NT + tid, col = item >> 3, run = item & 7;
                    epi_inproj_col(p, brow + run * 32, bcol + col, st + run * 32 * STG + col);
                }
            }
        } else {
#pragma unroll 1
            for (int it = 0; it < 8; ++it) {
                const int item = it * NT + tid, r = item >> 4, c = (item & 15) * 8;
                const f32x4 f0 = *(const LAS f32x4*)(st + r * STG + c), f1 = *(const LAS f32x4*)(st + r * STG + c + 4);
                const int t = brow + r;
                float o[8] = {f0[0], f0[1], f0[2], f0[3], f1[0], f1[1], f1[2], f1[3]};
                if (MODE == EPI_WOUT) {
                    const float* g1 = (const float*)(p.ws + OFF_MOD) + (size_t)(l * 5 + tok_cv(t)) * 6144 + 2048 + bcol + c;
                    const float4 ga = *reinterpret_cast<const float4*>(g1), gb = *reinterpret_cast<const float4*>(g1 + 4);
                    float x[8];
                    if (l == 0) {
                        const float* xr = x_in_row(p, t) + bcol + c;
                        const float4 xa = *reinterpret_cast<const float4*>(xr), xb2 = *reinterpret_cast<const float4*>(xr + 4);
                        x[0] = xa.x; x[1] = xa.y; x[2] = xa.z; x[3] = xa.w; x[4] = xb2.x; x[5] = xb2.y; x[6] = xb2.z; x[7] = xb2.w;
                    } else {
                        const u32x4 xw = *reinterpret_cast<const u32x4*>((const bf16_t*)(p.ws + OFF_XC) + (size_t)t * D + bcol + c);
#pragma unroll
                        for (int k = 0; k < 4; ++k) { x[2 * k] = __uint_as_float(xw[k] << 16); x[2 * k + 1] = __uint_as_float(xw[k] & 0xffff0000u); }
                    }
                    o[0] = x[0] + ga.x * o[0]; o[1] = x[1] + ga.y * o[1]; o[2] = x[2] + ga.z * o[2]; o[3] = x[3] + ga.w * o[3];
                    o[4] = x[4] + gb.x * o[4]; o[5] = x[5] + gb.y * o[5]; o[6] = x[6] + gb.z * o[6]; o[7] = x[7] + gb.w * o[7];
                    const float* gn = p.in[I_N2G] + l * D + bcol + c;
                    const float4 na = *reinterpret_cast<const float4*>(gn), nb = *reinterpret_cast<const float4*>(gn + 4);
                    const float4 sa = *reinterpret_cast<const float4*>(g1 + 2048), sb = *reinterpret_cast<const float4*>(g1 + 2048 + 4);
                    float xg[8] = {o[0] * na.x * (1.f + sa.x), o[1] * na.y * (1.f + sa.y), o[2] * na.z * (1.f + sa.z), o[3] * na.w * (1.f + sa.w),
                                   o[4] * nb.x * (1.f + sb.x), o[5] * nb.y * (1.f + sb.y), o[6] * nb.z * (1.f + sb.z), o[7] * nb.w * (1.f + sb.w)};
                    float ss = 0.f, am = 0.f;
#pragma unroll
                    for (int i = 0; i < 8; ++i) { ss += o[i] * o[i]; am = fmaxf(am, fabsf(xg[i])); }
                    ss = row16_sum(ss); am = row16_max(am);
                    const float sc8 = am > 0.f ? 127.f / am : 1.f;
                    uint2 w8;
                    w8.x = pack4_i8(q8(xg[0] * sc8), q8(xg[1] * sc8), q8(xg[2] * sc8), q8(xg[3] * sc8));
                    w8.y = pack4_i8(q8(xg[4] * sc8), q8(xg[5] * sc8), q8(xg[6] * sc8), q8(xg[7] * sc8));
                    *reinterpret_cast<uint2*>(p.ws + OFF_H8I + (size_t)t * D + bcol + c) = w8;
                    if ((item & 15) == 0) {
                        ((float*)(p.ws + OFF_RSS2))[((size_t)l * NTOK + t) * 8 + pn] = ss;
                        ((float*)(p.ws + OFF_XGS))[(size_t)t * 8 + pn] = am > 0.f ? am * (1.f / 127.f) : 1.f;
                    }
                }
                bf16_t* dst = (bf16_t*)(p.ws + (MODE == EPI_WOUT ? OFF_XC : OFF_Q)) + (size_t)t * D + bcol + c;
                *reinterpret_cast<u32x4*>(dst) = u32x4{pack_bf2(o[0], o[1]), pack_bf2(o[2], o[3]), pack_bf2(o[4], o[5]), pack_bf2(o[6], o[7])};
            }
        }
        __syncthreads();
    }
}


#define MFMA32(a, b, c) __builtin_amdgcn_mfma_f32_32x32x16_bf16((a), (b), (c), 0, 0, 0)
constexpr int ATT_ROWB = 144;
constexpr int ATT_TILEB = 64 * ATT_ROWB;
constexpr int QW_MIX = 4096;

__device__ __forceinline__ bf16x8 pack8(const f32x16& x, int s) {
    const u32x4 w = {pack_bf2(x[8 * s], x[8 * s + 1]), pack_bf2(x[8 * s + 2], x[8 * s + 3]), pack_bf2(x[8 * s + 4], x[8 * s + 5]), pack_bf2(x[8 * s + 6], x[8 * s + 7])};
    return __builtin_bit_cast(bf16x8, w);
}
__device__ __forceinline__ void softmax_tile(f32x16& s0, f32x16& s1, const float sc, float& m, float& l, float& alpha, const int lane) {
    float mx = fmaxf(s0[0], s1[0]);
#pragma unroll
    for (int i = 1; i < 16; ++i) mx = fmaxf(mx, fmaxf(s0[i], s1[i]));
    mx = fmaxf(mx, shfl_x(mx, lane, 32));
    const float mnew = fmaxf(m, mx * sc);
    alpha = __builtin_amdgcn_exp2f(m - mnew);
    m = mnew;
    float ps = 0.f;
#pragma unroll
    for (int i = 0; i < 16; ++i) { s0[i] = __builtin_amdgcn_exp2f(s0[i] * sc - mnew); s1[i] = __builtin_amdgcn_exp2f(s1[i] * sc - mnew); ps += s0[i] + s1[i]; }
    l = l * alpha + ps;
}
__device__ __forceinline__ void v_frags(const LAS unsigned char* vb, bf16x8 (&vf)[8], int r, int hh) {
#pragma unroll
    for (int u = 0; u < 2; ++u)
#pragma unroll
        for (int sk = 0; sk < 2; ++sk)
#pragma unroll
            for (int mt = 0; mt < 2; ++mt) {
                const LAS unsigned char* a = vb + (32 * mt + r) * ATT_ROWB + (32 * u + 16 * sk + 4 * hh) * 2;
                const s16x4 lo = *(const LAS s16x4*)a, hi = *(const LAS s16x4*)(a + 16);
                vf[(u * 2 + sk) * 2 + mt] = bf16x8{lo[0], lo[1], lo[2], lo[3], hi[0], hi[1], hi[2], hi[3]};
            }
}
__device__ __forceinline__ void pv_tile(const bf16x8 (&vf)[8], const f32x16& p0, const f32x16& p1, f32x16 (&O)[2]) {
#pragma unroll
    for (int u = 0; u < 2; ++u)
#pragma unroll
        for (int sk = 0; sk < 2; ++sk) {
            const bf16x8 pf = pack8(u ? p1 : p0, sk);
#pragma unroll
            for (int mt = 0; mt < 2; ++mt) O[mt] = MFMA32(vf[(u * 2 + sk) * 2 + mt], pf, O[mt]);
        }
}

template <bool DIFF>
__device__ __forceinline__ void attn_item(const Params& p, int l, LAS unsigned char* lds, const int tid,
                                          const bf16_t* __restrict__ Qg, const int qstride,
                                          const bf16_t* __restrict__ Kg, const bf16_t* __restrict__ Vtg, const int nk,
                                          bf16_t* __restrict__ Og, const float lam) {
    const int wave = tid >> 6, lane = tid & 63, r = lane & 31, hh = lane >> 5;
    const int lrow = tid >> 3, lchunk = tid & 7;
    LAS unsigned char* kbuf = lds; LAS unsigned char* vbuf = lds + 2 * ATT_TILEB;
    bf16x8 qf[4];
    const bf16_t* qrow = Qg + (size_t)(wave * 32 + r) * qstride;
#pragma unroll
    for (int ks = 0; ks < 4; ++ks) qf[ks] = *reinterpret_cast<const bf16x8*>(qrow + ks * 16 + hh * 8);
    const float sc = (DIFF ? 0.17677669529663687f : 0.125f) * 1.4426950408889634f;
    f32x16 O0[2], O1[2];
#pragma unroll
    for (int mt = 0; mt < 2; ++mt)
#pragma unroll
        for (int i = 0; i < 16; ++i) { O0[mt][i] = 0.f; O1[mt][i] = 0.f; }
    float m0 = -1e30f, l0 = 0.f, m1 = -1e30f, l1 = 0.f;
    const int ntl = nk / 64;
    u32x4 kr, vr, kn, vn;
    kr = *reinterpret_cast<const u32x4*>(Kg + (size_t)lrow * 64 + lchunk * 8);
    vr = *reinterpret_cast<const u32x4*>(Vtg + (size_t)lrow * nk + lchunk * 8);
    *(LAS u32x4*)(kbuf + lrow * ATT_ROWB + lchunk * 16) = kr;
    *(LAS u32x4*)(vbuf + lrow * ATT_ROWB + lchunk * 16) = vr;
    {
        const int t1 = ntl > 1 ? 1 : 0;
        kr = *reinterpret_cast<const u32x4*>(Kg + (size_t)(t1 * 64 + lrow) * 64 + lchunk * 8);
        vr = *reinterpret_cast<const u32x4*>(Vtg + (size_t)lrow * nk + t1 * 64 + lchunk * 8);
    }
    __syncthreads();
    for (int ti = 0; ti < ntl; ++ti) {
        const int cur = ti & 1;
        {
            const int t2 = ti + 2 < ntl ? ti + 2 : ntl - 1;
            kn = *reinterpret_cast<const u32x4*>(Kg + (size_t)(t2 * 64 + lrow) * 64 + lchunk * 8);
            vn = *reinterpret_cast<const u32x4*>(Vtg + (size_t)lrow * nk + t2 * 64 + lchunk * 8);
        }
        const LAS unsigned char* kb = kbuf + cur * ATT_TILEB; const LAS unsigned char* vb = vbuf + cur * ATT_TILEB;
        bf16x8 ka[2][4];
#pragma unroll
        for (int u = 0; u < 2; ++u)
#pragma unroll
            for (int ks = 0; ks < 4; ++ks) ka[u][ks] = *(const LAS bf16x8*)(kb + (32 * u + r) * ATT_ROWB + (ks * 16 + hh * 8) * 2);
        __builtin_amdgcn_sched_barrier(0);
        bf16x8 vf[8];
        if (!DIFF) {
            f32x16 s0, s1;
#pragma unroll
            for (int i = 0; i < 16; ++i) { s0[i] = 0.f; s1[i] = 0.f; }
#pragma unroll
            for (int ks = 0; ks < 4; ++ks) { s0 = MFMA32(ka[0][ks], qf[ks], s0); s1 = MFMA32(ka[1][ks], qf[ks], s1); }
            v_frags(vb, vf, r, hh);
            __builtin_amdgcn_sched_barrier(0);
            float alpha;
            softmax_tile(s0, s1, sc, m0, l0, alpha, lane);
            if (__builtin_amdgcn_ballot_w64(alpha != 1.f) != 0ull) {
#pragma unroll
                for (int mt = 0; mt < 2; ++mt)
#pragma unroll
                    for (int i = 0; i < 16; ++i) O0[mt][i] *= alpha;
            }
            pv_tile(vf, s0, s1, O0);
        } else {
            f32x16 s0, s1, t0, t1;
#pragma unroll
            for (int i = 0; i < 16; ++i) { s0[i] = 0.f; s1[i] = 0.f; t0[i] = 0.f; t1[i] = 0.f; }
#pragma unroll
            for (int ks = 0; ks < 2; ++ks) {
                s0 = MFMA32(ka[0][ks], qf[ks], s0); s1 = MFMA32(ka[1][ks], qf[ks], s1);
                t0 = MFMA32(ka[0][2 + ks], qf[2 + ks], t0); t1 = MFMA32(ka[1][2 + ks], qf[2 + ks], t1);
            }
            v_frags(vb, vf, r, hh);
            __builtin_amdgcn_sched_barrier(0);
            float alpha;
            softmax_tile(s0, s1, sc, m0, l0, alpha, lane);
            if (__builtin_amdgcn_ballot_w64(alpha != 1.f) != 0ull) {
#pragma unroll
                for (int mt = 0; mt < 2; ++mt)
#pragma unroll
                    for (int i = 0; i < 16; ++i) O0[mt][i] *= alpha;
            }
            pv_tile(vf, s0, s1, O0);
            softmax_tile(t0, t1, sc, m1, l1, alpha, lane);
            if (__builtin_amdgcn_ballot_w64(alpha != 1.f) != 0ull) {
#pragma unroll
                for (int mt = 0; mt < 2; ++mt)
#pragma unroll
                    for (int i = 0; i < 16; ++i) O1[mt][i] *= alpha;
            }
            pv_tile(vf, t0, t1, O1);
        }
        if (ti + 1 < ntl) {
            *(LAS u32x4*)(kbuf + (cur ^ 1) * ATT_TILEB + lrow * ATT_ROWB + lchunk * 16) = kr;
            *(LAS u32x4*)(vbuf + (cur ^ 1) * ATT_TILEB + lrow * ATT_ROWB + lchunk * 16) = vr;
        }
        kr = kn; vr = vn;
        __syncthreads();
    }
    l0 += shfl_x(l0, lane, 32);
    const float inv0 = 1.f / l0;
    LAS unsigned char* ob = lds + wave * 4608;
    if (!DIFF) {
#pragma unroll
        for (int mt = 0; mt < 2; ++mt)
#pragma unroll
            for (int g = 0; g < 4; ++g) {
                u32x2 w;
                w[0] = pack_bf2(O0[mt][4 * g] * inv0, O0[mt][4 * g + 1] * inv0);
                w[1] = pack_bf2(O0[mt][4 * g + 2] * inv0, O0[mt][4 * g + 3] * inv0);
                *(LAS u32x2*)(ob + r * 144 + (32 * mt + 8 * g + 4 * hh) * 2) = w;
            }
    } else {
        l1 += shfl_x(l1, lane, 32);
        const float inv1 = lam / l1;
        float ss = 0.f;
#pragma unroll
        for (int mt = 0; mt < 2; ++mt)
#pragma unroll
            for (int i = 0; i < 16; ++i) { const float o = O0[mt][i] * inv0 - O1[mt][i] * inv1; O0[mt][i] = o; ss += o * o; }
        ss += shfl_x(ss, lane, 32);
        const float rr = rsqrtf(ss * (1.f / 64.f) + EPS) * __builtin_bit_cast(float, __builtin_amdgcn_readfirstlane(__builtin_bit_cast(int, 1.f - lam_init_of(l))));
        const float* sg = p.in[I_SUBLN] + l * 64;
#pragma unroll
        for (int mt = 0; mt < 2; ++mt)
#pragma unroll
            for (int g = 0; g < 4; ++g) {
                const int d0 = 32 * mt + 8 * g + 4 * hh;
                const float4 gg = *reinterpret_cast<const float4*>(sg + d0);
                u32x2 w;
                w[0] = pack_bf2(O0[mt][4 * g] * rr * gg.x, O0[mt][4 * g + 1] * rr * gg.y);
                w[1] = pack_bf2(O0[mt][4 * g + 2] * rr * gg.z, O0[mt][4 * g + 3] * rr * gg.w);
                *(LAS u32x2*)(ob + r * 144 + d0 * 2) = w;
            }
    }
#pragma unroll
    for (int ps = 0; ps < 4; ++ps) {
        const int row = ps * 8 + (lane >> 3), ch = lane & 7;
        *reinterpret_cast<u32x4*>(Og + (size_t)(wave * 32 + row) * D + ch * 8) = *(const LAS u32x4*)(ob + row * 144 + ch * 16);
    }
}

namespace ga {
constexpr float C2 = 0.125f * 1.4426950408889634f;
constexpr int SLOTB = 8192, LDS_K = 0, LDS_V = 3 * SLOTB, LDS_WS = 6 * SLOTB, LDS_OST = LDS_WS + 8 * 256;
typedef __attribute__((address_space(3))) const char* lds_cptr;
typedef short v4i16_t __attribute__((ext_vector_type(4)));
using s16x4 = __attribute__((ext_vector_type(4))) short;
__device__ __forceinline__ int crow(int r, int hi) { return (r & 3) + 8 * (r >> 2) + 4 * hi; }
__device__ __forceinline__ void glds16(const void* g, unsigned lds_base) {
    unsigned sv; asm volatile("s_mov_b32 %0, m0\n\ts_mov_b32 m0, %2\n\ts_nop 0\n\tglobal_load_lds_dwordx4 %1, off\n\ts_mov_b32 m0, %0" : "=&s"(sv) : "v"(g), "s"(lds_base) : "memory"); }
__device__ __forceinline__ void kload2(bf16x8* kf, lds_cptr kp, int d0) { kf[2 * d0] = *(const LAS bf16x8*)(kp + d0 * 2048); kf[2 * d0 + 1] = *(const LAS bf16x8*)(kp + d0 * 2048 + 512); }
__device__ __forceinline__ s16x4 vtr(lds_cptr p) { return __builtin_bit_cast(s16x4, __builtin_amdgcn_ds_read_tr16_b64_v4i16((LAS v4i16_t*)p)); }
#define GA_MX3(a, b, c) __builtin_fmaxf(__builtin_fmaxf((a), (b)), (c))
__device__ __forceinline__ float rowmax(const f32x16& p0, const f32x16& p1) {
    float a = GA_MX3(p0[0], p0[1], p1[0]), b = GA_MX3(p0[2], p0[3], p1[1]); a = GA_MX3(a, p1[2], p1[3]);
#pragma unroll
    for (int r = 4; r < 16; r += 4) { a = GA_MX3(a, p0[r], p0[r + 1]); b = GA_MX3(b, p0[r + 2], p0[r + 3]); a = GA_MX3(a, p1[r], p1[r + 1]); b = GA_MX3(b, p1[r + 2], p1[r + 3]); }
    float m = __builtin_fmaxf(a, b); auto rr = __builtin_amdgcn_permlane32_swap(__float_as_uint(m), __float_as_uint(m), false, false);
    return __builtin_fmaxf(__uint_as_float(rr[0]), __uint_as_float(rr[1])); }
}
#define GA_SBAR() __builtin_amdgcn_sched_barrier(0)
#define GA_PIN(x) asm volatile("" : "+v"(x))
#define GA_WAIT_BAR(N) asm volatile("s_waitcnt vmcnt(" #N ") lgkmcnt(0)\n\ts_barrier" ::: "memory")
#define GA_THR 8
__device__ __forceinline__ void gqa_unit(LAS unsigned char* ldsl, const int tid, const int wid, const bf16_t* __restrict__ Qw0, const int qstride,
                                         const unsigned char* __restrict__ Kimg, const unsigned char* __restrict__ Vimg, const int NT, bf16_t* __restrict__ Og) {
    using namespace ga;
    const int lane = tid & 63, r32 = lane & 31, hi = lane >> 5;
    const bf16_t* Qw = Qw0 + (size_t)(wid * 32) * qstride;
    const unsigned lds0 = (unsigned)(size_t)ldsl; LAS float* wsf = (LAS float*)(ldsl + LDS_WS) + wid * 64;
    const unsigned char* ksrc = Kimg + wid * 1024 + lane * 16;
    const unsigned char* vsrc = Vimg + wid * 1024 + lane * 16;
    const unsigned kdst = lds0 + LDS_K + wid * 1024, vdst = lds0 + LDS_V + wid * 1024;
#define DMA_K(t, slot) glds16(ksrc + (size_t)(t) * SLOTB, (unsigned)__builtin_amdgcn_readfirstlane(kdst + (slot)))
#define DMA_V(t, slot) glds16(vsrc + (size_t)(t) * SLOTB, (unsigned)__builtin_amdgcn_readfirstlane(vdst + (slot)))
    const lds_cptr vp0 = (lds_cptr)ldsl + LDS_V + ((lane >> 4) & 1) * 32 + (lane & 3) * 8 + (4 * hi + ((lane & 15) >> 2)) * 64;
    const lds_cptr kp0 = (lds_cptr)ldsl + LDS_K + hi * 1024 + r32 * 16;
    DMA_K(0, 0); DMA_V(0, 0); DMA_K(1, SLOTB);
    bf16x8 qr[4];
#pragma unroll
    for (int d0 = 0; d0 < 4; ++d0) qr[d0] = *reinterpret_cast<const bf16x8*>(&Qw[(size_t)r32 * qstride + d0 * 16 + hi * 8]);
    float mhat = 0.f, l_reg = 0.f; f32x16 o[2];
#pragma unroll
    for (int i = 0; i < 16; ++i) { o[0][i] = 0.f; o[1][i] = 0.f; }
    f32x16 zero16;
#pragma unroll
    for (int i = 0; i < 16; ++i) zero16[i] = 0.f;
    GA_PIN(zero16);
    bool resc = false;
    f32x16 pA0, pA1, pB0, pB1; bf16x8 kf[8]; s16x4 vlo[8], vhi[8]; u32x4 pw0, pw1, pw2, pw3;
    int sl_prev = 0, sl_cur = 0, sl_next = SLOTB;
#define ROT() do { sl_prev = sl_cur; sl_cur = sl_next; sl_next = (sl_next == 2 * SLOTB) ? 0 : sl_next + SLOTB; } while (0)
#define EX(v) __builtin_amdgcn_exp2f(v)
#define RESC() do { if (resc) { _Pragma("unroll") for (int d_ = 0; d_ < 2; ++d_) _Pragma("unroll") for (int r = 0; r < 16; ++r) o[d_][r] *= wsf[crow(r, hi)]; } } while (0)
    DMA_K(2, 2 * SLOTB);
    GA_WAIT_BAR(3);
    _Pragma("unroll") for (int d0 = 0; d0 < 4; ++d0) kload2(kf, kp0, d0);
    pA0 = MFMA32(kf[0], qr[0], zero16); pA1 = MFMA32(kf[1], qr[0], zero16); pA0 = MFMA32(kf[2], qr[1], pA0); pA1 = MFMA32(kf[3], qr[1], pA1);
    pA0 = MFMA32(kf[4], qr[2], pA0); pA1 = MFMA32(kf[5], qr[2], pA1); pA0 = MFMA32(kf[6], qr[3], pA0); pA1 = MFMA32(kf[7], qr[3], pA1);
    { const float rm = rowmax(pA0, pA1); mhat = rm; const float nmh = -mhat;
#pragma unroll
      for (int r = 0; r < 16; ++r) { pA0[r] = EX(pA0[r] + nmh); pA1[r] = EX(pA1[r] + nmh); }
#pragma unroll
      for (int r = 0; r < 16; ++r) zero16[r] = nmh;
      GA_PIN(zero16); }
    GA_WAIT_BAR(0);
    DMA_K(3, 0); DMA_V(1, SLOTB); ROT();
    _Pragma("unroll") for (int d0 = 0; d0 < 4; ++d0) kload2(kf, kp0 + sl_cur, d0);
    GA_WAIT_BAR(2);
#define PKW(P, i) pack_bf2(P[i], P[i + 1])
#define PAF(k) __builtin_bit_cast(bf16x8, pw##k)
#define VFR(i) (bf16x8){vlo[i][0], vlo[i][1], vlo[i][2], vlo[i][3], vhi[i][0], vhi[i][1], vhi[i][2], vhi[i][3]}
#define VRD(i) do { vlo[i] = vtr(vp_ + (((i) >> 2) * 4096 + ((i) & 3) * 1024)); vhi[i] = vtr(vp_ + (((i) >> 2) * 4096 + ((i) & 3) * 1024 + 512)); } while (0)
#define KRD(G, d0) do { if (G) { kload2(kf, kp0 + sl_next, d0); GA_SBAR(); } } while (0)
#define GAPA(MF, a0, a1, a2, a3, W0, W1, PW) do { MF; sacc += a0; sacc += a1; sacc += a2; sacc += a3; W0; W1; GA_PIN(PW); GA_PIN(sacc); GA_SBAR(); } while (0)
#define GAPB(MF, X, i) do { MF; X[i] = EX(X[i]); X[i + 1] = EX(X[i + 1]); X[i + 2] = EX(X[i + 2]); X[i + 3] = EX(X[i + 3]); GA_PIN(X); GA_SBAR(); } while (0)
#define STEP(C0, C1, P0, P1, t, GK, GV, GL) do { GA_SBAR(); \
    const lds_cptr vp_ = vp0 + sl_prev; \
    VRD(0); GA_SBAR(); float sacc = P0[0] + P0[1]; \
                       GAPA(C0 = MFMA32(kf[0], qr[0], zero16), P0[2], P0[3], P0[4], P0[5],     pw0[0] = PKW(P0, 0),  pw0[1] = PKW(P0, 2),  pw0); \
    VRD(4); GA_SBAR(); GAPA(C1 = MFMA32(kf[1], qr[0], zero16), P0[6], P0[7], P0[8], P0[9],     pw0[2] = PKW(P0, 4),  pw0[3] = PKW(P0, 6),  pw0); \
    VRD(1); GA_SBAR(); GAPA(C0 = MFMA32(kf[2], qr[1], C0),    P0[10], P0[11], P0[12], P0[13], pw1[0] = PKW(P0, 8),  pw1[1] = PKW(P0, 10), pw1); \
    VRD(5); GA_SBAR(); GAPA(C1 = MFMA32(kf[3], qr[1], C1),    P0[14], P0[15], P1[0], P1[1],   pw1[2] = PKW(P0, 12), pw1[3] = PKW(P0, 14), pw1); \
    VRD(2); GA_SBAR(); GAPA(C0 = MFMA32(kf[4], qr[2], C0),    P1[2], P1[3], P1[4], P1[5],     pw2[0] = PKW(P1, 0),  pw2[1] = PKW(P1, 2),  pw2); \
    VRD(6); GA_SBAR(); GAPA(C1 = MFMA32(kf[5], qr[2], C1),    P1[6], P1[7], P1[8], P1[9],     pw2[2] = PKW(P1, 4),  pw2[3] = PKW(P1, 6),  pw2); \
    VRD(3); GA_SBAR(); GAPA(C0 = MFMA32(kf[6], qr[3], C0),    P1[10], P1[11], P1[12], P1[13], pw3[0] = PKW(P1, 8),  pw3[1] = PKW(P1, 10), pw3); \
    VRD(7); GA_SBAR(); GAPA(C1 = MFMA32(kf[7], qr[3], C1),    P1[14], P1[15], 0.f, 0.f,       pw3[2] = PKW(P1, 12), pw3[3] = PKW(P1, 14), pw3); \
    l_reg += sacc; \
    if (GK) DMA_K((t) + 3, sl_cur); if (GV) DMA_V((t) + 1, sl_next); \
    { const float rm = rowmax(C0, C1); resc = false;                                             \
      if (__builtin_expect(__any(rm > (float)GA_THR), 0)) { const float dl = __builtin_fmaxf(rm, 0.f); mhat += dl; \
          const float f = __builtin_amdgcn_exp2f(-dl); l_reg *= f; if (hi == 0) wsf[r32] = f; resc = true; \
          _Pragma("unroll") for (int r_ = 0; r_ < 16; ++r_) { C0[r_] -= dl; C1[r_] -= dl; zero16[r_] = -mhat; } GA_PIN(zero16); } } \
    GA_SBAR(); \
    GAPB(o[0] = MFMA32(PAF(0), VFR(0), o[0]), C0, 0);              GAPB(o[1] = MFMA32(PAF(0), VFR(4), o[1]), C0, 4); \
    KRD(GL, 0); GAPB(o[0] = MFMA32(PAF(1), VFR(1), o[0]), C0, 8);  KRD(GL, 1); GAPB(o[1] = MFMA32(PAF(1), VFR(5), o[1]), C0, 12); \
    KRD(GL, 2); GAPB(o[0] = MFMA32(PAF(2), VFR(2), o[0]), C1, 0);  KRD(GL, 3); GAPB(o[1] = MFMA32(PAF(2), VFR(6), o[1]), C1, 4); \
    GAPB(o[0] = MFMA32(PAF(3), VFR(3), o[0]), C1, 8);              GAPB(o[1] = MFMA32(PAF(3), VFR(7), o[1]), C1, 12); \
    } while (0)
    int t = 1;
    for (; t + 5 < NT; t += 2) {
        STEP(pB0, pB1, pA0, pA1, t, true, true, true);     GA_WAIT_BAR(2); RESC(); ROT();
        STEP(pA0, pA1, pB0, pB1, t + 1, true, true, true); GA_WAIT_BAR(2); RESC(); ROT();
    }
#define ENDW(tt) do { if ((tt) + 3 < NT) { GA_WAIT_BAR(2); } else if ((tt) + 2 < NT) { GA_WAIT_BAR(1); } else { GA_WAIT_BAR(0); } } while (0)
    for (; t + 1 < NT; t += 2) {
        STEP(pB0, pB1, pA0, pA1, t, (t + 3 < NT), (t + 1 < NT), (t + 1 < NT));         ENDW(t);     RESC(); ROT();
        STEP(pA0, pA1, pB0, pB1, t + 1, (t + 4 < NT), (t + 2 < NT), (t + 2 < NT));     ENDW(t + 1); RESC(); ROT();
    }
    STEP(pB0, pB1, pA0, pA1, NT - 1, false, false, false); RESC();
    { float sacc = pB0[0] + pB0[1];
#pragma unroll
      for (int r = 2; r < 16; ++r) sacc += pB0[r];
#pragma unroll
      for (int r = 0; r < 16; ++r) sacc += pB1[r];
      l_reg += sacc;
      pw0 = (u32x4){PKW(pB0, 0), PKW(pB0, 2), PKW(pB0, 4), PKW(pB0, 6)}; pw1 = (u32x4){PKW(pB0, 8), PKW(pB0, 10), PKW(pB0, 12), PKW(pB0, 14)};
      pw2 = (u32x4){PKW(pB1, 0), PKW(pB1, 2), PKW(pB1, 4), PKW(pB1, 6)}; pw3 = (u32x4){PKW(pB1, 8), PKW(pB1, 10), PKW(pB1, 12), PKW(pB1, 14)};
      const lds_cptr vp_ = vp0 + sl_cur; _Pragma("unroll") for (int i = 0; i < 8; ++i) VRD(i);
      o[0] = MFMA32(PAF(0), VFR(0), o[0]); o[1] = MFMA32(PAF(0), VFR(4), o[1]); o[0] = MFMA32(PAF(1), VFR(1), o[0]); o[1] = MFMA32(PAF(1), VFR(5), o[1]);
      o[0] = MFMA32(PAF(2), VFR(2), o[0]); o[1] = MFMA32(PAF(2), VFR(6), o[1]); o[0] = MFMA32(PAF(3), VFR(3), o[0]); o[1] = MFMA32(PAF(3), VFR(7), o[1]); }
    { auto rr = __builtin_amdgcn_permlane32_swap(__float_as_uint(l_reg), __float_as_uint(l_reg), false, false); l_reg = __uint_as_float(rr[0]) + __uint_as_float(rr[1]); }
    if (hi == 0) wsf[32 + r32] = l_reg;
    asm volatile("s_waitcnt lgkmcnt(0)" ::: "memory");
    float rli[16];
#pragma unroll
    for (int r = 0; r < 16; ++r) rli[r] = __builtin_amdgcn_rcpf(wsf[32 + crow(r, hi)]);
    bf16_t* Ow = Og + (size_t)(wid * 32) * D; LAS bf16_t* stg = (LAS bf16_t*)(ldsl + LDS_OST) + wid * 2048;
#pragma unroll
    for (int r = 0; r < 16; ++r) { const int orow = crow(r, hi);
#pragma unroll
        for (int d0 = 0; d0 < 2; ++d0) stg[orow * 64 + d0 * 32 + r32] = f2bf(o[d0][r] * rli[r]); }
    asm volatile("s_waitcnt lgkmcnt(0)" ::: "memory");
#pragma unroll
    for (int i = 0; i < 4; ++i) { const int row = i * 8 + (lane >> 3), ch = lane & 7; *reinterpret_cast<u32x4*>(Ow + (size_t)row * D + ch * 8) = *(const LAS u32x4*)(stg + row * 64 + ch * 8); }
    asm volatile("s_waitcnt lgkmcnt(0)\n\ts_barrier" ::: "memory");
#undef DMA_K
#undef DMA_V
#undef ROT
#undef EX
#undef RESC
#undef PKW
#undef PAF
#undef VFR
#undef VRD
#undef KRD
#undef ENDW
#undef GAPA
#undef GAPB
#undef STEP
}

constexpr int SGU_ROWB = 272;
__device__ __forceinline__ void sgu_item(const Params& p, int l, LAS unsigned char* lds, const int tid, const int t0) {
    const bf16_t* AV = (const bf16_t*)(p.ws + OFF_AV) + (size_t)t0 * 256;
    {
        const int q = tid >> 2, quarter = tid & 3;
        float v[64]; float ss = 0.f;
#pragma unroll
        for (int i = 0; i < 8; ++i) {
            const bf16x8 w = *reinterpret_cast<const bf16x8*>(AV + (size_t)q * 256 + quarter * 64 + i * 8);
#pragma unroll
            for (int j = 0; j < 8; ++j) { v[i * 8 + j] = bf2f((bf16_t)w[j]); ss += v[i * 8 + j] * v[i * 8 + j]; }
        }
        { const int ln = tid & 63; ss += shfl_x(ss, ln, 1); ss += shfl_x(ss, ln, 2); }
        const float rstd = rsqrtf(ss * (1.f / 256.f) + EPS);
        const float* g = p.in[I_SGUNG] + l * 256 + quarter * 64;
#pragma unroll
        for (int i = 0; i < 64; ++i)
            *(LAS bf16_t*)(lds + (quarter * 64 + i) * SGU_ROWB + q * 2) = f2bf(v[i] * rstd * g[i]);
    }
    __syncthreads();
    {
        const int wave = tid >> 6, lane = tid & 63, r = lane & 31, hh = lane >> 5;
        const int g = wave >> 1, ph = wave & 1;
        const bf16_t* W = (const bf16_t*)(p.ws + OFF_SGUW) + ((size_t)l * 4 + g) * 128 * 128;
        f32x16 acc[2][2];
#pragma unroll
        for (int a = 0; a < 2; ++a)
#pragma unroll
            for (int b = 0; b < 2; ++b)
#pragma unroll
                for (int i = 0; i < 16; ++i) acc[a][b][i] = 0.f;
#pragma unroll
        for (int ks = 0; ks < 8; ++ks) {
            bf16x8 af[2], bfr[2];
#pragma unroll
            for (int pt = 0; pt < 2; ++pt) af[pt] = *reinterpret_cast<const bf16x8*>(W + (size_t)(ph * 64 + pt * 32 + r) * 128 + ks * 16 + hh * 8);
#pragma unroll
            for (int ct = 0; ct < 2; ++ct) bfr[ct] = *(const LAS bf16x8*)(lds + (g * 64 + ct * 32 + r) * SGU_ROWB + (ks * 16 + hh * 8) * 2);
#pragma unroll
            for (int pt = 0; pt < 2; ++pt)
#pragma unroll
                for (int ct = 0; ct < 2; ++ct) acc[pt][ct] = MFMA32(af[pt], bfr[ct], acc[pt][ct]);
        }
        const float* bias = p.in[I_SGUB] + (l * 4 + g) * 128;
        const bf16_t* AU = (const bf16_t*)(p.ws + OFF_AU);
        bf16_t* MIX = (bf16_t*)(p.ws + OFF_MIX);
#pragma unroll
        for (int pt = 0; pt < 2; ++pt)
#pragma unroll
            for (int ct = 0; ct < 2; ++ct)
#pragma unroll
                for (int i = 0; i < 16; ++i) {
                    const int pp = ph * 64 + pt * 32 + (i & 3) + 8 * (i >> 2) + 4 * hh, c = g * 64 + ct * 32 + r;
                    const float au = bf2f(AU[(size_t)(t0 + pp) * 256 + c]);
                    MIX[(size_t)(t0 + pp) * D + c] = f2bf(au * (acc[pt][ct][i] + bias[pp]));
                }
    }
    __syncthreads();
}

__device__ void ph_mixers(const Params& p, int lq, unsigned char* ldsraw, const int wv) {
    const int l = lq & 1;
    const int tid0 = opaque_tid(wv);
    LAS unsigned char* lds = (LAS unsigned char*)ldsraw;
    volatile LAS int* qslot = (volatile LAS int*)(ldsraw - LDS_HDR + 64);
    unsigned* qw = (unsigned*)(p.ws + OFF_BAR) + QW_MIX + lq;
    const float lam = __builtin_bit_cast(float, __builtin_amdgcn_readfirstlane(__builtin_bit_cast(int, lam_of(p, l))));
    unsigned char* ws = p.ws;
    for (;;) {
        if (tid0 == 0) *qslot = (int)atomicAdd(qw, 1u);
        __syncthreads();
        const int item = *qslot;
        __syncthreads();
        if (item >= 896) break;
        if (lq >= 2 && PROBE_DUP >= 10) {
            const int cls = item < 128 ? 10 : (item < 384 ? 11 : 12);
            if (cls != PROBE_DUP) continue;
        }
        int tid = tid0; asm volatile("" : "+v"(tid));
        if (item < 128) {
            const int qc = item & 7, h = (item >> 3) & 3, b = item >> 5;
            const int t0 = NPT + b * DSEQ + qc * 256;
            attn_item<true>(p, l, lds, tid, (const bf16_t*)(ws + OFF_DQ) + (size_t)t0 * 256 + h * 64, 256,
                            (const bf16_t*)(ws + OFF_DKS) + ((size_t)b * 4 + h) * NKS * 64, (const bf16_t*)(ws + OFF_DVTS) + ((size_t)b * 4 + h) * 64 * NKS, NKS,
                            (bf16_t*)(ws + OFF_MIX) + (size_t)t0 * D + 256 + h * 64, lam);
        } else if (item < 384) {
            const int it = item - 128, qc = it & 7, hq = (it >> 3) & 7, b = it >> 6, kv = hq >> 2;
            const int t0 = NPT + b * DSEQ + qc * 256;
            gqa_unit(lds, tid, wv, (const bf16_t*)(ws + OFF_GQ) + (size_t)t0 * 512 + hq * 64, 512,
                     ws + OFF_GKS + ((size_t)b * 2 + kv) * NKS * 128, ws + OFF_GVTS + ((size_t)b * 2 + kv) * NKS * 128, NKS / 64,
                     (bf16_t*)(ws + OFF_MIX) + (size_t)t0 * D + 512 + hq * 64);
        } else if (item < 512) {
            sgu_item(p, l, lds, tid, (item - 384) * 128);
        } else if (item < 768) {
            const int it = item - 512, hq = it & 7, b = it >> 3, kv = hq >> 2;
            const int t0 = b * SEQ;
            gqa_unit(lds, tid, wv, (const bf16_t*)(ws + OFF_GQ) + (size_t)t0 * 512 + hq * 64, 512,
                     ws + OFF_GKP + ((size_t)b * 2 + kv) * SEQ * 128, ws + OFF_GVTP + ((size_t)b * 2 + kv) * SEQ * 128, SEQ / 64,
                     (bf16_t*)(ws + OFF_MIX) + (size_t)t0 * D + 512 + hq * 64);
        } else {
            const int it = item - 768, h = it & 3, b = it >> 2;
            const int t0 = b * SEQ;
            attn_item<true>(p, l, lds, tid, (const bf16_t*)(ws + OFF_DQ) + (size_t)t0 * 256 + h * 64, 256,
                            (const bf16_t*)(ws + OFF_DKP) + ((size_t)b * 4 + h) * SEQ * 64, (const bf16_t*)(ws + OFF_DVTP) + ((size_t)b * 4 + h) * 64 * SEQ, SEQ,
                            (bf16_t*)(ws + OFF_MIX) + (size_t)t0 * D + 256 + h * 64, lam);
        }
    }
}


using bf16x2 = __attribute__((ext_vector_type(2))) __bf16;
__device__ __forceinline__ float dot2bf(unsigned a, unsigned b, float c) {
    return __builtin_amdgcn_fdot2_f32_bf16(__builtin_bit_cast(bf16x2, a), __builtin_bit_cast(bf16x2, b), c, false);
}
template <int W>
__device__ __forceinline__ void bfly_stage(float (&part)[64], const int lane) {
    const bool hi = (lane & W) != 0;
#pragma unroll
    for (int k = 0; k < W; ++k) {
        const float keep = hi ? part[k + W] : part[k];
        const float send = hi ? part[k] : part[k + W];
        part[k] = keep + shfl_x(send, lane, W);
    }
}
constexpr int QW_PEER = 4160;
template <int W>
__device__ __forceinline__ void bfly16_stage(float (&v)[16], const int lane, const int bit) {
    const bool hi = (lane & bit) != 0;
#pragma unroll
    for (int k = 0; k < W; ++k) {
        const float keep = hi ? v[k + W] : v[k];
        const float send = hi ? v[k] : v[k + W];
        v[k] = keep + shfl_x(send, lane, bit);
    }
}
template <int W>
__device__ __forceinline__ void bfly16i_stage(int (&v)[16], const int lane, const int bit) {
    const bool hi = (lane & bit) != 0;
#pragma unroll
    for (int k = 0; k < W; ++k) {
        const int keep = hi ? v[k + W] : v[k];
        const int send = hi ? v[k] : v[k + W];
        v[k] = keep + shfl_x(send, lane, bit);
    }
}
template <bool VSIDE> struct PeerTok {
    static __device__ __forceinline__ void issue(const Params& p, const unsigned char* Tslice, const int elo, const int ehi, const int t, const int s,
                                                 const int sub, const int c16, u32x4 (&a)[16], u32x4 (&h)[2]) {
#pragma unroll
        for (int i = 0; i < 16; ++i) {
            const int e = shfl_i(i < 8 ? elo : ehi, (i * 8 + sub) & 63);
            a[i] = *reinterpret_cast<const u32x4*>(Tslice + (((unsigned)e << 7) + (unsigned)c16 * 16u));
        }
        if (!VSIDE) h[0] = *reinterpret_cast<const u32x4*>(p.ws + OFF_H8I + (size_t)t * D + s * 128 + c16 * 16);
    }
    static __device__ __forceinline__ void compute(const Params& p, const int l, const u32x4 w4, const float wsc, const int t, const int s,
                                                   const int lane, const int sub, const int c16, const u32x4 (&a)[16], const u32x4 (&h)[2]) {
        if (!VSIDE) {
            int d[16];
#pragma unroll
            for (int i = 0; i < 16; ++i) {
                int acc = 0;
#pragma unroll
                for (int k = 0; k < 4; ++k) acc = __builtin_amdgcn_sdot4((int)a[i][k], (int)h[0][k], acc, false);
                d[i] = acc;
            }
            bfly16i_stage<8>(d, lane, 4); bfly16i_stage<4>(d, lane, 2); bfly16i_stage<2>(d, lane, 1);
            const int i0 = ((lane & 4) << 1) + ((lane & 2) << 1) + ((lane & 1) << 1);
            unsigned* PART = (unsigned*)(p.ws + OFF_PART) + (((size_t)s * NTOK + t) * 128 + sub * 16 + i0) / 2;
            *PART = ((unsigned)((d[0] + 32) >> 6) & 0xffffu) | ((unsigned)((d[1] + 32) >> 6) << 16);
        } else {
            int acc[16];
#pragma unroll
            for (int i = 0; i < 16; ++i) acc[i] = 0;
#pragma unroll
            for (int g = 0; g < 4; ++g) {
                const int wg = (int)w4[g];
#pragma unroll
                for (int k = 0; k < 4; ++k) {
                    const unsigned r0 = a[4 * g][k], r1 = a[4 * g + 1][k], r2 = a[4 * g + 2][k], r3 = a[4 * g + 3][k];
                    const unsigned x01l = __builtin_amdgcn_perm(r1, r0, 0x05010400u), x01h = __builtin_amdgcn_perm(r1, r0, 0x07030602u);
                    const unsigned x23l = __builtin_amdgcn_perm(r3, r2, 0x05010400u), x23h = __builtin_amdgcn_perm(r3, r2, 0x07030602u);
                    const unsigned t0 = __builtin_amdgcn_perm(x23l, x01l, 0x05040100u), t1 = __builtin_amdgcn_perm(x23l, x01l, 0x07060302u);
                    const unsigned t2 = __builtin_amdgcn_perm(x23h, x01h, 0x05040100u), t3 = __builtin_amdgcn_perm(x23h, x01h, 0x07060302u);
                    acc[4 * k]     = __builtin_amdgcn_sdot4((int)t0, wg, acc[4 * k], false);
                    acc[4 * k + 1] = __builtin_amdgcn_sdot4((int)t1, wg, acc[4 * k + 1], false);
                    acc[4 * k + 2] = __builtin_amdgcn_sdot4((int)t2, wg, acc[4 * k + 2], false);
                    acc[4 * k + 3] = __builtin_amdgcn_sdot4((int)t3, wg, acc[4 * k + 3], false);
                }
            }
            bfly16i_stage<8>(acc, lane, 32); bfly16i_stage<4>(acc, lane, 16); bfly16i_stage<2>(acc, lane, 8);
            const int col = s * 128 + c16 * 16 + ((lane & 32) >> 2) + ((lane & 16) >> 2) + ((lane & 8) >> 2);
            const float* g2 = (const float*)(p.ws + OFF_MOD) + (size_t)(l * 5 + tok_cv(t)) * 6144 + 5 * 1024 + col;
            unsigned* XC = reinterpret_cast<unsigned*>((bf16_t*)(p.ws + OFF_XC) + (size_t)t * D + col);
            const unsigned x = *XC; const float2 g = *reinterpret_cast<const float2*>(g2);
            const float xa = __uint_as_float(x << 16) + g.x * wsc * (float)acc[0], xb = __uint_as_float(x & 0xffff0000u) + g.y * wsc * (float)acc[1];
            *XC = pack_bf2(xa, xb);
            if (l == 0) {
                const float ss = wave_sum(xa * xa + xb * xb);
                if (lane == 0) ((float*)(p.ws + OFF_RSS1))[(size_t)t * 8 + s] = ss;
            }
        }
    }
};
template <bool VSIDE>
__device__ __forceinline__ void peer_slice_stream(const Params& p, const int l, const int s, const int first, const int stride, const int lane) {
    const int sub = lane >> 3, c16 = lane & 7;
    const unsigned char* Ts = p.ws + (VSIDE ? OFF_VT : OFF_UT) + ((size_t)l * 8 + s) * NEXP * 128;
    const int* EIb = (const int*)(p.ws + OFF_EIDX); const unsigned char* WPb = p.ws + OFF_WPAIR; const float* WSb = (const float*)(p.ws + OFF_WSC);
    if (first >= NTOK) return;
    const int cnt = (NTOK - first + stride - 1) / stride;
#define PEER_LOADE(k, elo, ehi, w4, wsc) do { const int _t = min(first + (k) * stride, NTOK - 1); \
        elo = EIb[(size_t)_t * 128 + lane]; ehi = EIb[(size_t)_t * 128 + 64 + lane]; \
        if (VSIDE) { w4 = *reinterpret_cast<const u32x4*>(WPb + (size_t)_t * 128 + sub * 16); wsc = WSb[_t]; } } while (0)
    int e0l, e0h, e1l, e1h, e2l, e2h;
    u32x4 w0 = {0u, 0u, 0u, 0u}, w1 = {0u, 0u, 0u, 0u}, w2 = {0u, 0u, 0u, 0u}; float s0 = 0.f, s1 = 0.f, s2 = 0.f;
    u32x4 A[16], B[16], hA[2], hB[2];
    PEER_LOADE(0, e0l, e0h, w0, s0);
    PEER_LOADE(1, e1l, e1h, w1, s1);
    PeerTok<VSIDE>::issue(p, Ts, e0l, e0h, first, s, sub, c16, A, hA);
    for (int k = 0; k < cnt; k += 2) {
        const int ta = first + k * stride, tb = min(ta + stride, NTOK - 1), tc = min(ta + 2 * stride, NTOK - 1);
        __builtin_amdgcn_sched_barrier(0);
        PEER_LOADE(k + 2, e2l, e2h, w2, s2);
        PeerTok<VSIDE>::issue(p, Ts, e1l, e1h, tb, s, sub, c16, B, hB);
        __builtin_amdgcn_sched_barrier(0);
        PeerTok<VSIDE>::compute(p, l, w0, s0, ta, s, lane, sub, c16, A, hA);
        __builtin_amdgcn_sched_barrier(0);
        e0l = e2l; e0h = e2h; w0 = w2; s0 = s2;
        PEER_LOADE(k + 3, e2l, e2h, w2, s2);
        PeerTok<VSIDE>::issue(p, Ts, e0l, e0h, tc, s, sub, c16, A, hA);
        __builtin_amdgcn_sched_barrier(0);
        if (k + 1 < cnt) PeerTok<VSIDE>::compute(p, l, w1, s1, tb, s, lane, sub, c16, B, hB);
        e1l = e2l; e1h = e2h; w1 = w2; s1 = s2;
    }
#undef PEER_LOADE
}
template <bool VSIDE>
__device__ void ph_peer_sliced(const Params& p, int l, unsigned char* ldsraw, const int wv) {
    const int tid = opaque_tid(wv);
    const int wave = tid >> 6, lane = tid & 63;
    volatile LAS int* hdr = (volatile LAS int*)(ldsraw - LDS_HDR);
    unsigned* bar = (unsigned*)(p.ws + OFF_BAR);
    const int myx = (int)(xb_xcc_id() & 15u);
    if (tid == 0) hdr[16] = (int)atomicAdd(bar + QW_PEER + (l * 2 + (VSIDE ? 1 : 0)) * 16 + myx, 1u);
    __syncthreads();
    const int rank = hdr[16], nloc = (int)hdr[0];
    __syncthreads();
    if (myx < 8) peer_slice_stream<VSIDE>(p, l, myx, rank * 8 + wave, nloc * 8, lane);
    for (int j = 0; j < 8; ++j) {
        if (xb_ld(&bar[XB_XCNT(j)]) == 0u) peer_slice_stream<VSIDE>(p, l, j, (int)blockIdx.x * 8 + wave, (int)gridDim.x * 8, lane);
    }
}
__device__ void ph_peer_pairw(const Params& p, int l, const int wv) {
    const int tid = opaque_tid(wv);
    const int lane = tid & 63;
    const float* USC = (const float*)(p.ws + OFF_USC) + l * NEXP; const float* VSC = (const float*)(p.ws + OFF_VSC) + l * NEXP;
    const int* PART = (const int*)(p.ws + OFF_PART);
    for (size_t i4 = GTID; i4 < (size_t)NTOK * 32; i4 += GNT) {
        const size_t idx = i4 * 4;
        const int t = (int)(idx >> 7), pp = (int)(idx & 127), sub = pp >> 4, i = pp & 15;
        int4 ps[8];
#pragma unroll
        for (int s = 0; s < 8; ++s) {
            const uint2 w = *reinterpret_cast<const uint2*>((const unsigned short*)PART + (size_t)s * NTOK * 128 + idx);
            ps[s] = make_int4((int)(w.x << 16) >> 16, (int)w.x >> 16, (int)(w.y << 16) >> 16, (int)w.y >> 16);
        }
        int e[4]; float g[4];
#pragma unroll
        for (int q = 0; q < 4; ++q) {
            const int j = (i + q) * 8 + sub;
            e[q] = ((const int*)(p.ws + OFF_EIDX))[(size_t)t * 128 + j]; g[q] = ((const float*)(p.ws + OFF_EGATE))[(size_t)t * 128 + j];
        }
        const float* rp = (const float*)(p.ws + OFF_RSS2) + ((size_t)l * NTOK + t) * 8;
        const float4 ra = *reinterpret_cast<const float4*>(rp), rb = *reinterpret_cast<const float4*>(rp + 4);
        const float hs = rsqrtf((((ra.x + ra.y) + (ra.z + ra.w)) + ((rb.x + rb.y) + (rb.z + rb.w))) * (1.f / D) + EPS);
        const float* xp = (const float*)(p.ws + OFF_XGS) + (size_t)t * 8;
        const float4 xa = *reinterpret_cast<const float4*>(xp), xb = *reinterpret_cast<const float4*>(xp + 4);
        const float xs[8] = {xa.x, xa.y, xa.z, xa.w, xb.x, xb.y, xb.z, xb.w};
        float sm[4] = {0.f, 0.f, 0.f, 0.f};
#pragma unroll
        for (int s = 0; s < 8; ++s) { sm[0] += xs[s] * (float)ps[s].x; sm[1] += xs[s] * (float)ps[s].y; sm[2] += xs[s] * (float)ps[s].z; sm[3] += xs[s] * (float)ps[s].w; }
#pragma unroll
        for (int q = 0; q < 4; ++q) sm[q] *= 64.f;
        const float* USH = (const float*)(p.ws + OFF_USH) + (size_t)(l * 5 + tok_cv(t)) * NEXP;
        float w[4];
#pragma unroll
        for (int q = 0; q < 4; ++q) w[q] = g[q] * gelu_f(sm[q] * (USC[e[q]] * hs) + USH[e[q]]) * VSC[e[q]];
        float am = fmaxf(fmaxf(fabsf(w[0]), fabsf(w[1])), fmaxf(fabsf(w[2]), fabsf(w[3])));
#pragma unroll
        for (int o = 16; o >= 1; o >>= 1) am = fmaxf(am, shfl_x(am, lane, o));
        const float sc = am > 0.f ? 127.f / am : 1.f;
        *reinterpret_cast<unsigned*>(p.ws + OFF_WPAIR + idx) = pack4_i8(q8(w[0] * sc), q8(w[1] * sc), q8(w[2] * sc), q8(w[3] * sc));
        if (pp == 0) ((float*)(p.ws + OFF_WSC))[t] = am > 0.f ? am * (1.f / 127.f) : 1.f;
    }
}

#define CE_DESC(a, b) do { const float _mx = fmaxf((a), (b)); const float _mn = fminf((a), (b)); (a) = _mx; (b) = _mn; } while (0)
__device__ __forceinline__ void sort16_desc(float (&v)[16]) {
#pragma unroll
    for (int k = 2; k <= 16; k <<= 1)
#pragma unroll
        for (int j = k >> 1; j > 0; j >>= 1)
#pragma unroll
            for (int i = 0; i < 16; ++i) {
                const int m = i ^ j;
                if (m > i) { if ((i & k) == 0) CE_DESC(v[i], v[m]); else CE_DESC(v[m], v[i]); }
            }
}
__device__ __forceinline__ void merge_top16(float (&a)[16], const float (&b)[16]) {
#pragma unroll
    for (int i = 0; i < 16; ++i) a[i] = fmaxf(a[i], b[15 - i]);
#pragma unroll
    for (int j = 8; j > 0; j >>= 1)
#pragma unroll
        for (int i = 0; i < 16; ++i) { const int m = i ^ j; if (m > i) CE_DESC(a[i], a[m]); }
}
__device__ __forceinline__ float key_embed(float v, unsigned lowmask, unsigned idxbits) { return __uint_as_float((__float_as_uint(v) & ~lowmask) | idxbits); }

constexpr int SK_ROWB = 144;
__device__ __forceinline__ void peer_stage1(const LAS unsigned char* SK  , const bf16_t* __restrict__ Qrow  ,
                                            const int r, const int hh, float (&out)[16]) {
    bf16x8 qb[4];
#pragma unroll
    for (int ks = 0; ks < 4; ++ks) qb[ks] = *reinterpret_cast<const bf16x8*>(Qrow + ks * 16 + hh * 8);
    float grp[4][16];
#pragma unroll
    for (int mt = 0; mt < 4; ++mt) {
        f32x16 acc;
#pragma unroll
        for (int i = 0; i < 16; ++i) acc[i] = 0.f;
#pragma unroll
        for (int ks = 0; ks < 4; ++ks) {
            const bf16x8 a = *(const LAS bf16x8*)(SK + (mt * 32 + r) * SK_ROWB + (ks * 16 + hh * 8) * 2);
            acc = MFMA32(a, qb[ks], acc);
        }
        const unsigned hx = (unsigned)hh << 2;
#pragma unroll
        for (int i = 0; i < 16; ++i) {
            const unsigned cn = 32u * mt + (i & 3) + 8u * (i >> 2);
            grp[mt][i] = key_embed(acc[i], 127u, (127u - cn) ^ hx);
        }
        sort16_desc(grp[mt]);
    }
    merge_top16(grp[0], grp[1]); merge_top16(grp[2], grp[3]); merge_top16(grp[0], grp[2]);
    float pb[16];
#pragma unroll
    for (int i = 0; i < 16; ++i) pb[i] = shfl_x(grp[0][i], (hh << 5) | r, 32);
    merge_top16(grp[0], pb);
#pragma unroll
    for (int i = 0; i < 16; ++i) out[i] = grp[0][i];
}

__device__ void ph_peer_select(const Params& p, int l, unsigned char* ldsraw, const int wv) {
    const int tid = opaque_tid(wv);
    const int wave = tid >> 6, lane = tid & 63, r = lane & 31, hh = lane >> 5;
    const int gw = blockIdx.x * 8 + wave, nw = gridDim.x * 8;
    LAS unsigned char* skl = (LAS unsigned char*)ldsraw;
    LAS unsigned char* myl = skl + 2 * 128 * SK_ROWB + wave * 2048 + lane * 32;
    {
        const bf16_t* SKg = (const bf16_t*)(p.ws + OFF_SUBK) + (size_t)l * 2 * 128 * 64;
        for (int i = tid; i < 2 * 128 * 8; i += NT) {
            const int row = i >> 3, ch = i & 7;
            *(LAS u32x4*)(skl + row * SK_ROWB + ch * 16) = *reinterpret_cast<const u32x4*>(SKg + (size_t)row * 64 + ch * 8);
        }
        __syncthreads();
    }
    for (int task = gw; task < (NTOK / 32) * 4; task += nw) {
        const int tg = task >> 2, k = task & 3;
        const int t = tg * 32 + r;
        const bf16_t* Qt = (const bf16_t*)(p.ws + OFF_Q) + (size_t)t * D;
        float sv[2][16];
#pragma unroll
        for (int x = 0; x < 2; ++x) {
            float la[16], lb[16];
            peer_stage1(skl + x * 128 * SK_ROWB, Qt + k * 128 + x * 64, r, hh, la);
            peer_stage1(skl + x * 128 * SK_ROWB, Qt + (k + 4) * 128 + x * 64, r, hh, lb);
#pragma unroll
            for (int i = 0; i < 16; ++i) sv[x][i] = hh ? lb[i] : la[i];
        }
        {
            unsigned w[8];
#pragma unroll
            for (int q = 0; q < 8; ++q) {
                w[q] = 0u;
#pragma unroll
                for (int b = 0; b < 4; ++b) {
                    const int i = q * 4 + b;
                    const unsigned key = __float_as_uint(i < 16 ? sv[0][i] : sv[1][i - 16]);
                    w[q] |= (127u - (key & 127u)) << (8 * b);
                }
            }
            *(LAS u32x4*)(myl) = u32x4{w[0], w[1], w[2], w[3]};
            *(LAS u32x4*)(myl + 16) = u32x4{w[4], w[5], w[6], w[7]};
        }
        float val0[16], val1[16];
#pragma unroll
        for (int i = 0; i < 16; ++i) { val0[i] = __uint_as_float(__float_as_uint(sv[0][i]) & ~127u); val1[i] = __uint_as_float(__float_as_uint(sv[1][i]) & ~127u); }
        float g0[16], g1[16], g2[16], g3[16];
#pragma unroll
        for (int b = 0; b < 16; ++b) g0[b] = key_embed(val0[0] + val1[b], 255u, 255u - (unsigned)b);
#pragma unroll
        for (int b = 0; b < 8; ++b) g1[b] = key_embed(val0[1] + val1[b], 255u, 255u - (16u + b));
#pragma unroll
        for (int b = 0; b < 5; ++b) g1[8 + b] = key_embed(val0[2] + val1[b], 255u, 255u - (32u + b));
#pragma unroll
        for (int b = 0; b < 3; ++b) g1[13 + b] = key_embed(val0[4] + val1[b], 255u, 255u - (64u + b));
#pragma unroll
        for (int b = 0; b < 4; ++b) g2[b] = key_embed(val0[3] + val1[b], 255u, 255u - (48u + b));
#pragma unroll
        for (int a = 5; a < 8; ++a)
#pragma unroll
            for (int b = 0; b < 2; ++b) g2[4 + (a - 5) * 2 + b] = key_embed(val0[a] + val1[b], 255u, 255u - (16u * a + b));
#pragma unroll
        for (int a = 8; a < 14; ++a) g2[10 + (a - 8)] = key_embed(val0[a] + val1[0], 255u, 255u - 16u * a);
        g3[0] = key_embed(val0[14] + val1[0], 255u, 255u - 16u * 14); g3[1] = key_embed(val0[15] + val1[0], 255u, 255u - 16u * 15);
#pragma unroll
        for (int i = 2; i < 16; ++i) g3[i] = -3.0e38f;
        sort16_desc(g1); sort16_desc(g2); sort16_desc(g3);
        merge_top16(g0, g1); merge_top16(g2, g3); merge_top16(g0, g2);
        float gate[16]; int eid[16];
        const float mx = __uint_as_float(__float_as_uint(g0[0]) & ~255u);
        float sum = 0.f;
#pragma unroll
        for (int i = 0; i < 16; ++i) {
            const unsigned key = __float_as_uint(g0[i]);
            gate[i] = __expf(__uint_as_float(key & ~255u) - mx); sum += gate[i];
            const unsigned id = 255u - (key & 255u);
            const unsigned n0 = *(const LAS unsigned char*)(myl + (id >> 4));
            const unsigned n1 = *(const LAS unsigned char*)(myl + 16 + (id & 15u));
            eid[i] = (int)(n0 * 128u + n1);
        }
        const float inv = 1.f / sum;
        const int h = k + 4 * hh;
        int* EI = (int*)(p.ws + OFF_EIDX) + (size_t)t * 128 + h * 16; float* EG = (float*)(p.ws + OFF_EGATE) + (size_t)t * 128 + h * 16;
#pragma unroll
        for (int q = 0; q < 4; ++q) {
            *reinterpret_cast<int4*>(EI + q * 4) = make_int4(eid[q * 4], eid[q * 4 + 1], eid[q * 4 + 2], eid[q * 4 + 3]);
            *reinterpret_cast<float4*>(EG + q * 4) = make_float4(gate[q * 4] * inv, gate[q * 4 + 1] * inv, gate[q * 4 + 2] * inv, gate[q * 4 + 3] * inv);
        }
    }
}

constexpr int LDS_BYTES = LDS_HDR + 3 * 48 * 1024;
__global__ void __launch_bounds__(NT, 2) mk_fwd(Params p) {
    extern __shared__ __attribute__((aligned(16))) unsigned char lds[];
    const int wv = __builtin_amdgcn_readfirstlane((int)(threadIdx.x >> 6));
    volatile LAS unsigned* st = (volatile LAS unsigned*)lds;
    if (threadIdx.x < 4) st[threadIdx.x] = 0u;
    __syncthreads();
    XcdBarrier xb = xcd_barrier_post((unsigned*)(p.ws + OFF_BAR), st);
    int bar_idx = 0;
#define GRID_BAR() do { xcd_barrier(xb); \
        if (PROBE_TS >= 0 && blockIdx.x == 0 && threadIdx.x == 0 && (bar_idx == PROBE_TS - 1 || bar_idx == PROBE_TS)) \
            ((volatile LAS unsigned long long*)(lds + 128))[bar_idx - (PROBE_TS - 1)] = __builtin_amdgcn_s_memrealtime(); \
        ++bar_idx; } while (0)
    if (PROBE_TS == 0 && blockIdx.x == 0 && threadIdx.x == 0) ((volatile LAS unsigned long long*)(lds + 128))[0] = __builtin_amdgcn_s_memrealtime();
    unsigned char* ws = p.ws;
    for (int rep = 0; rep < (PROBE_DUP == 1 ? 2 : 1); ++rep) {
    for (int l = 0; l < 2; ++l) {
        ph_transpose(p.in[I_WIN] + (size_t)l * D * INW, (bf16_t*)(ws + OFF_WIN) + (size_t)l * INW * D, D, INW, lds + LDS_HDR, wv);
        ph_transpose(p.in[I_WOUT] + (size_t)l * D * D, (bf16_t*)(ws + OFF_WOUT) + (size_t)l * D * D, D, D, lds + LDS_HDR, wv);
        ph_transpose(p.in[I_WQ] + (size_t)l * D * D, (bf16_t*)(ws + OFF_WQ) + (size_t)l * D * D, D, D, lds + LDS_HDR, wv);
    }
    ph_convert_i8_rows(p.in[I_PU], ws + OFF_UT, (float*)(ws + OFF_USC), 2 * NEXP, wv);
    ph_convert_i8_rows(p.in[I_PV], ws + OFF_VT, (float*)(ws + OFF_VSC), 2 * NEXP, wv);
    ph_convert(p.in[I_SUBK], (bf16_t*)(ws + OFF_SUBK), 2 * 2 * 128 * 64, wv);
    ph_convert(p.in[I_SGUW], (bf16_t*)(ws + OFF_SGUW), 2 * 4 * 128 * 128, wv);
    ph_mod(p, lds + LDS_HDR, wv);
    ph_rope_tab(p, wv);
    GRID_BAR();
    }
    for (int l = 0; l < 2; ++l) {
        for (int rep = 0; rep < (PROBE_DUP == 3 ? 2 : 1); ++rep) {
        if (l == 0) {
            ph_norm_mod(p, 0, 0, 1, wv);
            ph_cache_prep(p, 0, wv);
            ph_fold_tables(p, lds + LDS_HDR, wv);
            GRID_BAR();
        }
        }
        for (int rep = 0; rep < (PROBE_DUP == 5 ? 2 : 1); ++rep) {
        if (l == 0) gemm_phase<EPI_INPROJ>(p, 0, (const bf16_t*)(ws + OFF_H), (const bf16_t*)(ws + OFF_WIN), INW, lds + LDS_HDR, wv);
        else {
            ph_cache_prep(p, 1, wv);
            gemm_phase<EPI_INPROJ>(p, 1, (const bf16_t*)(ws + OFF_XC), (const bf16_t*)(ws + OFF_WINS), INW, lds + LDS_HDR, wv,
                                   (size_t)INW * D, (const float*)(ws + OFF_RSS1), (const float*)(ws + OFF_BIN));
        }
        GRID_BAR();
        }
        for (int rep = 0; rep < ((PROBE_DUP == 4 || (PROBE_DUP >= 10 && PROBE_DUP <= 12)) ? 2 : 1); ++rep) {
        ph_mixers(p, l + 2 * rep, lds + LDS_HDR, wv);
        GRID_BAR();
        }
        gemm_phase<EPI_WOUT>(p, l, (const bf16_t*)(ws + OFF_MIX), (const bf16_t*)(ws + OFF_WOUT) + (size_t)l * D * D, D, lds + LDS_HDR, wv);
        GRID_BAR();
        for (int rep = 0; rep < (PROBE_DUP == 7 ? 2 : 1); ++rep) {
        gemm_phase<EPI_WQ>(p, l, (const bf16_t*)(ws + OFF_XC), (const bf16_t*)(ws + OFF_WQS) + (size_t)l * 5 * D * D, D, lds + LDS_HDR, wv,
                           (size_t)D * D, (const float*)(ws + OFF_RSS2) + (size_t)l * NTOK * 8, (const float*)(ws + OFF_BQ) + (size_t)l * 5 * D);
        GRID_BAR();
        }
        if (PROBE_DUP == 8) { for (int rep = 0; rep < 10; ++rep) GRID_BAR(); }
        for (int rep = 0; rep < (PROBE_DUP == 2 ? 2 : 1); ++rep) {
        ph_peer_select(p, l, lds + LDS_HDR, wv);
        GRID_BAR();
        }
        ph_peer_sliced<false>(p, l, lds + LDS_HDR, wv);
        GRID_BAR();
        ph_peer_pairw(p, l, wv);
        GRID_BAR();
        ph_peer_sliced<true>(p, l, lds + LDS_HDR, wv);
        GRID_BAR();
    }
    ph_final_norm(p, wv);
    if (PROBE_TS >= 0 && blockIdx.x == 0 && threadIdx.x == 0) {
        asm volatile("s_waitcnt vmcnt(0)" ::: "memory");
        volatile LAS unsigned long long* tsl = (volatile LAS unsigned long long*)(lds + 128);
        p.out[0] += (float)(tsl[1] - tsl[0]) * 0.01f;
    }
}

extern "C" void kernel_launch(void* const* d_in, const int* in_sizes, int n_in,
                              void* d_out, int out_size, void* d_ws, size_t ws_size,
                              hipStream_t stream) {
    static int grid = 0;
    if (grid == 0) {
        if (ws_size < WS_NEED) { fprintf(stderr, "kernel_launch: workspace too small: %zu < %zu\n", ws_size, (size_t)WS_NEED); grid = -1; return; }
        int dev = 0, cus = 0, per_cu = 0;
        (void)hipGetDevice(&dev);
        (void)hipDeviceGetAttribute(&cus, hipDeviceAttributeMultiprocessorCount, dev);
        (void)hipFuncSetAttribute((const void*)mk_fwd, hipFuncAttributeMaxDynamicSharedMemorySize, LDS_BYTES);
        (void)hipOccupancyMaxActiveBlocksPerMultiprocessor(&per_cu, (const void*)mk_fwd, NT, LDS_BYTES);
        if (per_cu < 1) { fprintf(stderr, "kernel_launch: occupancy query reports %d blocks per CU\n", per_cu); grid = -1; return; }
        grid = cus;
    }
    if (grid < 0) return;
    (void)hipMemsetAsync((unsigned char*)d_ws + OFF_BAR, 0, 64 * 1024, stream);
    Params p{};
    for (int i = 0; i < 29; ++i) p.in[i] = (const float*)d_in[i];
    p.out = (float*)d_out; p.ws = (unsigned char*)d_ws;
    void* args[] = {&p};
    hipError_t e = hipLaunchCooperativeKernel((const void*)mk_fwd, dim3(grid), dim3(NT), args, LDS_BYTES, stream);
    if (e != hipSuccess) fprintf(stderr, "kernel_launch: cooperative launch failed: %s (grid %d)\n", hipGetErrorString(e), grid);
}
```

```cpp
#include <hip/hip_runtime.h>
#include <hip/hip_bf16.h>
#include <cstdio>
#include <cstdint>
#include <hip/hip_cooperative_groups.h>
namespace cg = cooperative_groups;

#define PROBE_DUP 0
#define PROBE_TS -1
typedef unsigned short bf16_t;
using bf16x8 = __attribute__((ext_vector_type(8))) short;
using f32x4  = __attribute__((ext_vector_type(4))) float;
using f32x16 = __attribute__((ext_vector_type(16))) float;
using f32x2  = __attribute__((ext_vector_type(2))) float;
using u32x4  = __attribute__((ext_vector_type(4))) unsigned;
using u32x2  = __attribute__((ext_vector_type(2))) unsigned;
using s16x4  = __attribute__((ext_vector_type(4))) short;

constexpr int D      = 1024;
constexpr int NTOK   = 16384;
constexpr int NPT    = 8192;
constexpr int SEQ    = 256;
constexpr int DSEQ   = 2048;
constexpr int PAST   = 512;
constexpr int NKS    = DSEQ + PAST;
constexpr int INW    = 2048;
constexpr int NEXP   = 16384;
constexpr float EPS  = 1e-6f;

constexpr size_t MB = 1024 * 1024;
constexpr size_t OFF_BAR   = 0;
constexpr size_t OFF_MOD   = 64 * 1024;
constexpr size_t OFF_ROPE  = OFF_MOD + 256 * 1024;
constexpr size_t OFF_SUBK  = OFF_ROPE + 1 * MB;
constexpr size_t OFF_SGUW  = OFF_SUBK + 64 * 1024;
constexpr size_t OFF_WIN   = OFF_SGUW + 256 * 1024;
constexpr size_t OFF_WOUT  = OFF_WIN + 8 * MB;
constexpr size_t OFF_WQ    = OFF_WOUT + 4 * MB;
constexpr size_t OFF_UT    = OFF_WQ + 4 * MB;
constexpr size_t OFF_USC   = OFF_UT + 32 * MB;
constexpr size_t OFF_VT    = OFF_UT + 64 * MB;
constexpr size_t OFF_VSC   = OFF_VT + 32 * MB;
constexpr size_t OFF_H     = OFF_VT + 64 * MB;
constexpr size_t OFF_XC    = OFF_H + 32 * MB;
constexpr size_t OFF_R1    = OFF_XC + 64 * MB;
constexpr size_t OFF_AU    = OFF_R1;
constexpr size_t OFF_AV    = OFF_AU + 8 * MB;
constexpr size_t OFF_AVN   = OFF_AV + 8 * MB;
constexpr size_t OFF_DQ    = OFF_AVN + 8 * MB;
constexpr size_t OFF_DKP   = OFF_DQ + 8 * MB;
constexpr size_t OFF_DKS   = OFF_DKP + 4 * MB;
constexpr size_t OFF_DVTP  = OFF_DKS + 5 * MB;
constexpr size_t OFF_DVTS  = OFF_DVTP + 4 * MB;
constexpr size_t OFF_GQ    = OFF_DVTS + 5 * MB;
constexpr size_t OFF_GKP   = OFF_GQ + 16 * MB;
constexpr size_t OFF_GKS   = OFF_GKP + 2 * MB;
constexpr size_t OFF_GVTP  = OFF_GKS + 3 * MB;
constexpr size_t OFF_GVTS  = OFF_GVTP + 2 * MB;
constexpr size_t OFF_MIX   = OFF_GVTS + 3 * MB;
constexpr size_t OFF_R1END = OFF_MIX + 32 * MB;
constexpr size_t OFF_Q     = OFF_R1;
constexpr size_t OFF_EIDX  = OFF_Q + 32 * MB;
constexpr size_t OFF_EGATE = OFF_EIDX + 8 * MB;
constexpr size_t OFF_TOPV  = OFF_EGATE + 8 * MB;
constexpr size_t OFF_TOPI  = OFF_TOPV + 16 * MB;
static_assert(OFF_TOPI + 16 * MB <= OFF_R1END, "peer buffers must fit region 1");
constexpr size_t OFF_PROJ  = OFF_R1END;
constexpr size_t OFF_PART  = OFF_PROJ;
constexpr size_t OFF_WPAIR = OFF_PART + 64 * MB;
constexpr size_t OFF_H8I   = OFF_WPAIR + 8 * MB;
constexpr size_t OFF_HSC   = OFF_H8I + 16 * MB;
constexpr size_t OFF_WSC   = OFF_HSC + 64 * 1024;
constexpr size_t OFF_XGS   = OFF_WSC + 64 * 1024;
constexpr size_t OFF_RSS2  = OFF_XGS + 512 * 1024;
constexpr size_t OFF_RSS1  = OFF_RSS2 + 1 * MB;
constexpr size_t OFF_USH   = OFF_RSS1 + 512 * 1024;
constexpr size_t OFF_BQ    = OFF_USH + 1 * MB;
constexpr size_t OFF_BIN   = OFF_BQ + 64 * 1024;
constexpr size_t OFF_WQS   = OFF_BIN + 64 * 1024;
constexpr size_t OFF_WINS  = OFF_XC + 32 * MB;
static_assert(OFF_WQS + 20 * MB <= OFF_PROJ + 128 * MB, "folded tables must fit");
constexpr size_t WS_NEED   = OFF_PROJ + 128 * MB;
static_assert(WS_NEED <= 512 * MB, "workspace budget");

constexpr size_t OUT_YP  = 0;
constexpr size_t OUT_YS  = 8388608;
constexpr size_t OUT_NDK = 16777216;
constexpr size_t OUT_NDV = OUT_NDK + 4194304;
constexpr size_t OUT_NGK = OUT_NDV + 4194304;
constexpr size_t OUT_NGV = OUT_NGK + 2097152;

struct Params {
    const float* in[29];
    float* out;
    unsigned char* ws;
};
enum { I_XP = 0, I_XS, I_CDK, I_CDV, I_CGK, I_CGV, I_C, I_CCTX, I_ADAW, I_ADAB, I_N1G, I_N2G, I_WIN, I_SGUNG, I_SGUW, I_SGUB,
       I_LQ1, I_LK1, I_LQ2, I_LK2, I_SUBLN, I_QNG, I_KNG, I_WOUT, I_WQ, I_SUBK, I_PU, I_PV, I_FG };

typedef __bf16 hwbf2 __attribute__((ext_vector_type(2)));
__device__ __forceinline__ unsigned pack_bf2(float a, float b) {
    const f32x2 v = {a, b};
    return __builtin_bit_cast(unsigned, __builtin_convertvector(v, hwbf2));
}
__device__ __forceinline__ bf16_t f2bf(float f) { return (bf16_t)(pack_bf2(f, 0.f) & 0xffffu); }
__device__ __forceinline__ float bf2f(bf16_t h) { return __uint_as_float(((unsigned)h) << 16); }
__device__ __forceinline__ float gelu_f(float x) {
    const float k2 = 2.f * 0.7978845608028654f * 1.4426950408889634f;
    const float e = __builtin_amdgcn_exp2f(k2 * (x + 0.044715f * x * x * x));
    return x - x * __builtin_amdgcn_rcpf(e + 1.f);
}
__device__ __forceinline__ int lane_id() { return (int)__builtin_amdgcn_mbcnt_hi(~0u, __builtin_amdgcn_mbcnt_lo(~0u, 0u)); }
__device__ __forceinline__ int lane_id_op() { int l = lane_id(); asm volatile("" : "+v"(l)); return l; }
__device__ __forceinline__ float shfl_i(float v, int src) { return __builtin_bit_cast(float, __builtin_amdgcn_ds_bpermute(src << 2, __builtin_bit_cast(int, v))); }
__device__ __forceinline__ int shfl_i(int v, int src) { return __builtin_amdgcn_ds_bpermute(src << 2, v); }
__device__ __forceinline__ float shfl_x(float v, int lane, int m) { return shfl_i(v, lane ^ m); }
__device__ __forceinline__ int shfl_x(int v, int lane, int m) { return shfl_i(v, lane ^ m); }
__device__ __forceinline__ int q8(float x) { return (int)fminf(fmaxf(rintf(x), -127.f), 127.f); }
__device__ __forceinline__ unsigned pack4_i8(int a, int b, int c, int d) { return (unsigned)(a & 255) | ((unsigned)(b & 255) << 8) | ((unsigned)(c & 255) << 16) | ((unsigned)d << 24); }
#define DPP_F(v, ctrl) __builtin_bit_cast(float, __builtin_amdgcn_update_dpp(0, __builtin_bit_cast(int, (v)), (ctrl), 0xF, 0xF, false))
__device__ __forceinline__ float row16_sum(float v) {
    v += DPP_F(v, 0xB1); v += DPP_F(v, 0x4E); v += DPP_F(v, 0x141); v += DPP_F(v, 0x140);
    return v;
}
__device__ __forceinline__ float row16_max(float v) {
    v = fmaxf(v, DPP_F(v, 0xB1)); v = fmaxf(v, DPP_F(v, 0x4E)); v = fmaxf(v, DPP_F(v, 0x141)); v = fmaxf(v, DPP_F(v, 0x140));
    return v;
}
__device__ __forceinline__ float rdlane_f(float v, int l) { return __builtin_bit_cast(float, __builtin_amdgcn_readlane(__builtin_bit_cast(int, v), l)); }
__device__ __forceinline__ float wave_sum(float v) {
    v = row16_sum(v);
    return (rdlane_f(v, 0) + rdlane_f(v, 16)) + (rdlane_f(v, 32) + rdlane_f(v, 48));
}
__device__ __forceinline__ float wave_max(float v) {
    v = row16_max(v);
    return fmaxf(fmaxf(rdlane_f(v, 0), rdlane_f(v, 16)), fmaxf(rdlane_f(v, 32), rdlane_f(v, 48)));
}
__device__ __forceinline__ int tok_cv(int t) { return t < NPT ? 0 : 1 + ((t - NPT) >> 11); }
__device__ __forceinline__ const float* x_in_row(const Params& p, int t) {
    return t < NPT ? p.in[I_XP] + (size_t)t * D : p.in[I_XS] + (size_t)(t - NPT) * D;
}
__device__ __forceinline__ float lam_init_of(int l) { return l == 0 ? 0.2f : (0.8f - 0.6f * 0.7408182206817179f); }
__device__ __forceinline__ float lam_of(const Params& p, int l) {
    float s1 = 0.f, s2 = 0.f;
    for (int i = 0; i < 32; ++i) {
        s1 += p.in[I_LQ1][l * 32 + i] * p.in[I_LK1][l * 32 + i];
        s2 += p.in[I_LQ2][l * 32 + i] * p.in[I_LK2][l * 32 + i];
    }
    return expf(s1) - expf(s2) + lam_init_of(l);
}


#define XB_TMO      128
#define XB_XCNT(j)  (256  + 64 * (j))
#define XB_XSUB(j)  (1280 + 64 * (j))
#define XB_XGEN(j)  (2304 + 64 * (j))
#define XB_TOP      3328
#define XB_TOPGEN   3392
#define XCD_BAR_WORDS 3456
#define XB_SPIN_CAP (1u << 20)
#define LAS __attribute__((address_space(3)))
typedef int i32x4 __attribute__((ext_vector_type(4)));
__device__ __forceinline__ unsigned xb_ld(unsigned* p)              { return __hip_atomic_load(p, __ATOMIC_RELAXED, __HIP_MEMORY_SCOPE_AGENT); }
__device__ __forceinline__ unsigned xb_add(unsigned* p, unsigned v) { return __hip_atomic_fetch_add(p, v, __ATOMIC_RELAXED, __HIP_MEMORY_SCOPE_AGENT); }
__device__ __forceinline__ unsigned xb_xcc_id() { return (unsigned)__builtin_amdgcn_s_getreg((3 << 11) | 20) & 0xFu; }
#define XB_SPIN(cond, bar) do { unsigned _sp = 0; while (cond) { __builtin_amdgcn_s_sleep(1); \
    if ((++_sp & 255u) == 0u) { if (xb_ld(&(bar)[XB_TMO])) break; if (_sp > XB_SPIN_CAP) { atomicAdd(&(bar)[XB_TMO], 1u); break; } } } } while (0)
struct XcdBarrier { unsigned* bar; unsigned x; volatile LAS unsigned* st; };
__device__ __forceinline__ XcdBarrier xcd_barrier_post(unsigned* bar, volatile LAS unsigned* st) {
    XcdBarrier b; b.bar = bar; b.x = xb_xcc_id(); b.st = st;
    if (threadIdx.x == 0) (void)xb_add(&bar[XB_XCNT(b.x)], 1u);
    return b;
}
__device__ __forceinline__ void xcd_barrier_complete(unsigned* bar, unsigned x, unsigned& nloc, unsigned& nx) {
    const unsigned G = gridDim.x * gridDim.y * gridDim.z;
    unsigned sum, cnt, mine, sp = 0u;
    for (;;) {
        sum = 0u; cnt = 0u; mine = 0u;
#pragma unroll
        for (unsigned j = 0; j < 16; ++j) { const unsigned c = xb_ld(&bar[XB_XCNT(j)]); sum += c; cnt += (c > 0u) ? 1u : 0u; mine = (j == x) ? c : mine; }
        if (sum == G) break;
        __builtin_amdgcn_s_sleep(1);
        if ((++sp & 255u) == 0u) { if (xb_ld(&bar[XB_TMO])) break; if (sp > XB_SPIN_CAP) { atomicAdd(&bar[XB_TMO], 1u); break; } }
    }
    nloc = mine > 0u ? mine : 1u; nx = cnt > 0u ? cnt : 1u;
}
__device__ __forceinline__ void xcd_barrier(const XcdBarrier& b) {
    asm volatile("s_waitcnt vmcnt(0)" ::: "memory");
    __syncthreads();
    if (threadIdx.x == 0) {
        unsigned* bar = b.bar;
        const unsigned bx = xb_xcc_id();
        __builtin_amdgcn_s_waitcnt(0);
        unsigned nloc = b.st[0], nx = b.st[1];
        if (nloc == 0u) { xcd_barrier_complete(bar, bx, nloc, nx); b.st[0] = nloc; b.st[1] = nx; }
        const unsigned old = xb_add(&bar[XB_XSUB(bx)], 1u);
        const unsigned gen = old / nloc;
        if (old + 1u == (gen + 1u) * nloc) {
            __builtin_amdgcn_fence(__ATOMIC_RELEASE, "agent");
            asm volatile("s_waitcnt vmcnt(0)" ::: "memory");
            const unsigned og = xb_add(&bar[XB_TOP], 1u);
            const unsigned tg = og / nx;
            if (og + 1u == (tg + 1u) * nx) xb_add(&bar[XB_TOPGEN], 1u);
            else XB_SPIN(xb_ld(&bar[XB_TOPGEN]) == tg, bar);
            __builtin_amdgcn_fence(__ATOMIC_ACQUIRE, "agent");
            xb_add(&bar[XB_XGEN(bx)], 1u);
            asm volatile("s_waitcnt vmcnt(0)" ::: "memory");
        } else {
            XB_SPIN(xb_ld(&bar[XB_XGEN(bx)]) == gen, bar);
            __builtin_amdgcn_fence(__ATOMIC_ACQUIRE, "agent");
            asm volatile("s_waitcnt vmcnt(0)" ::: "memory");
        }
    }
    __syncthreads();
}

constexpr int NT = 512;
constexpr int LDS_HDR = 1024;
#define GTID ((size_t)blockIdx.x * NT + tid)
__device__ __forceinline__ int opaque_tid(int wv) { int t = (wv << 6) | lane_id(); asm volatile("" : "+v"(t)); return t; }
#define GNT  ((size_t)gridDim.x * NT)

__device__ void ph_transpose_all(const Params& p, unsigned char* ldsraw, const int wv) {
    const int tid = opaque_tid(wv);
    LAS bf16_t* T = (LAS bf16_t*)ldsraw;
    for (int tile = blockIdx.x; tile < 1024; tile += gridDim.x) {
        const int l = tile >> 9, r = tile & 511;
        const float* W; bf16_t* Wt; int N, tl;
        if (r < 256)      { W = p.in[I_WIN] + (size_t)l * D * INW; Wt = (bf16_t*)(p.ws + OFF_WIN) + (size_t)l * INW * D; N = INW; tl = r; }
        else if (r < 384) { W = p.in[I_WOUT] + (size_t)l * D * D;  Wt = (bf16_t*)(p.ws + OFF_WOUT) + (size_t)l * D * D;  N = D;   tl = r - 256; }
        else              { W = p.in[I_WQ] + (size_t)l * D * D;    Wt = (bf16_t*)(p.ws + OFF_WQ) + (size_t)l * D * D;    N = D;   tl = r - 384; }
        const int k0 = (tl & 7) * 128, n0 = (tl >> 3) * 64;
        const int nl0 = tid & 63, kq = tid >> 6;
        float v[16];
#pragma unroll
        for (int i = 0; i < 16; ++i) v[i] = W[(size_t)(k0 + i * 8 + kq) * N + n0 + nl0];
#pragma unroll
        for (int i = 0; i < 16; ++i) T[nl0 * 130 + i * 8 + kq] = f2bf(v[i]);
        __syncthreads();
        {
            const int nl = tid >> 3, kc = tid & 7;
            unsigned w[8];
#pragma unroll
            for (int i = 0; i < 8; ++i) w[i] = (unsigned)T[nl * 130 + kc * 16 + 2 * i] | ((unsigned)T[nl * 130 + kc * 16 + 2 * i + 1] << 16);
            bf16_t* dst = Wt + (size_t)(n0 + nl) * D + k0 + kc * 16;
            *reinterpret_cast<u32x4*>(dst) = u32x4{w[0], w[1], w[2], w[3]};
            *reinterpret_cast<u32x4*>(dst + 8) = u32x4{w[4], w[5], w[6], w[7]};
        }
        __syncthreads();
    }
}
__device__ void ph_convert(const float* __restrict__ src, bf16_t* __restrict__ dst, size_t n, const int wv) {
    const int tid = opaque_tid(wv);
    for (size_t idx = GTID; idx < n; idx += GNT) dst[idx] = f2bf(src[idx]);
}
__device__ void ph_convert_i8_rows(const float* __restrict__ src, unsigned char* __restrict__ dst, float* __restrict__ scl, int nrows, const int wv) {
    const int tid = opaque_tid(wv);
    const int lane = tid & 63;
    const int gw = blockIdx.x * 8 + (tid >> 6), nw = gridDim.x * 8;
    for (int row0 = gw * 4; row0 < nrows; row0 += nw * 4) {
        float4 f[4][4];
#pragma unroll
        for (int q = 0; q < 4; ++q)
#pragma unroll
            for (int i = 0; i < 4; ++i) f[q][i] = *reinterpret_cast<const float4*>(src + (size_t)(row0 + q) * D + lane * 16 + i * 4);
#pragma unroll
        for (int q = 0; q < 4; ++q) {
            const int row = row0 + q;
            float v[16];
#pragma unroll
            for (int i = 0; i < 4; ++i) { v[i * 4] = f[q][i].x; v[i * 4 + 1] = f[q][i].y; v[i * 4 + 2] = f[q][i].z; v[i * 4 + 3] = f[q][i].w; }
            float am = 0.f;
#pragma unroll
            for (int i = 0; i < 16; ++i) am = fmaxf(am, fabsf(v[i]));
#pragma unroll
            for (int o = 32; o >= 1; o >>= 1) am = fmaxf(am, shfl_x(am, lane, o));
            const float sc = am > 0.f ? 127.f / am : 1.f;
            unsigned w[4];
#pragma unroll
            for (int i = 0; i < 4; ++i) w[i] = pack4_i8(q8(v[i * 4] * sc), q8(v[i * 4 + 1] * sc), q8(v[i * 4 + 2] * sc), q8(v[i * 4 + 3] * sc));
            {
                const int lyr = row >> 14, e = row & (NEXP - 1);
                *reinterpret_cast<u32x4*>(dst + (((size_t)lyr * 8 + (lane >> 3)) * NEXP + e) * 128 + (lane & 7) * 16) = u32x4{w[0], w[1], w[2], w[3]};
            }
            if (lane == 0) scl[row] = am > 0.f ? am * (1.f / 127.f) : 1.f;
        }
    }
}
__device__ void ph_mod(const Params& p, unsigned char* ldsraw, const int wv) {
    const int tid = opaque_tid(wv);
    LAS float* sl = (LAS float*)ldsraw;
    LAS float* red = sl + 5 * 1024;
    for (int i = tid; i < 5 * 1024; i += NT) {
        const int cv = i >> 10, k = i & 1023;
        const float c = cv == 0 ? p.in[I_CCTX][k] : p.in[I_C][(size_t)(cv - 1) * D + k];
        sl[i] = c / (1.f + __expf(-c));
    }
    __syncthreads();
    const int c4 = tid & 15, r = tid >> 4;
    for (int item = blockIdx.x; item < 2 * 96; item += gridDim.x) {
        const int l = item / 96, j0 = (item % 96) * 64;
        const float* W = p.in[I_ADAW] + (size_t)l * D * 6144 + (size_t)r * 6144 + j0 + c4 * 4;
        float acc[5][4];
#pragma unroll
        for (int cv = 0; cv < 5; ++cv)
#pragma unroll
            for (int q = 0; q < 4; ++q) acc[cv][q] = 0.f;
#pragma unroll 8
        for (int i = 0; i < 32; ++i) {
            const float4 w = *reinterpret_cast<const float4*>(W + (size_t)i * 32 * 6144);
#pragma unroll
            for (int cv = 0; cv < 5; ++cv) {
                const float sv = sl[cv * 1024 + r + i * 32];
                acc[cv][0] += sv * w.x; acc[cv][1] += sv * w.y; acc[cv][2] += sv * w.z; acc[cv][3] += sv * w.w;
            }
        }
#pragma unroll
        for (int cv = 0; cv < 5; ++cv) *(LAS f32x4*)(red + (r * 5 + cv) * 64 + c4 * 4) = f32x4{acc[cv][0], acc[cv][1], acc[cv][2], acc[cv][3]};
        __syncthreads();
        if (tid < 320) {
            const int cv = tid >> 6, c = tid & 63;
            float sum = p.in[I_ADAB][l * 6144 + j0 + c];
#pragma unroll
            for (int q = 0; q < 32; ++q) sum += red[(q * 5 + cv) * 64 + c];
            ((float*)(p.ws + OFF_MOD))[(size_t)(l * 5 + cv) * 6144 + j0 + c] = sum;
        }
        __syncthreads();
    }
}
__device__ void ph_rope_tab(const Params& p, const int wv) {
    const int tid = opaque_tid(wv);
    for (size_t idx = GTID; idx < 2048 * 48; idx += GNT) {
        int s = idx / 48, i = idx % 48;
        float* R = (float*)(p.ws + OFF_ROPE);
        double row = (double)(s / 64), col = (double)(s % 64);
        if (i < 16) {
            int q = i & 7; double inv = pow(10000.0, -(double)q / 8.0);
            double ang = (i < 8 ? row : col) * inv;
            R[s * 16 + i] = (float)cos(ang); R[2048 * 16 + s * 16 + i] = (float)sin(ang);
        } else {
            int ii = i - 16; int q = ii & 15; double inv = pow(10000.0, -(double)q / 16.0);
            double ang = (ii < 16 ? row : col) * inv;
            R[2048 * 32 + s * 32 + ii] = (float)cos(ang); R[2048 * 64 + s * 32 + ii] = (float)sin(ang);
        }
    }
}
__device__ void ph_cache_prep(const Params& p, int l, const int wv) {
    const int tid = opaque_tid(wv);
    bf16_t* DKS = (bf16_t*)(p.ws + OFF_DKS); bf16_t* DVTS = (bf16_t*)(p.ws + OFF_DVTS);
    bf16_t* GKS = (bf16_t*)(p.ws + OFF_GKS); bf16_t* GVTS = (bf16_t*)(p.ws + OFF_GVTS);
    for (size_t idx = GTID; idx < 4 * 512 * 256; idx += GNT) {
        int c = idx & 255, pp = (idx >> 8) & 511, b = idx >> 17;
        size_t src = (((size_t)b * 2 + l) * PAST + pp) * 256 + c;
        int h = c >> 6, r = c & 63;
        DKS[(((size_t)b * 4 + h) * NKS + DSEQ + pp) * 64 + r] = f2bf(p.in[I_CDK][src]);
        DVTS[(((size_t)b * 4 + h) * 64 + r) * NKS + DSEQ + pp] = f2bf(p.in[I_CDV][src]);
        if (c < 128) {
            size_t src2 = (((size_t)b * 2 + l) * PAST + pp) * 128 + c;
            int kv = c >> 6;
            const int sq = DSEQ + pp;
            const size_t hb = ((size_t)b * 2 + kv) * NKS * 64 + (size_t)(sq >> 6) * 4096;
            GKS[hb + (r >> 3) * 512 + (sq & 63) * 8 + (r & 7)] = f2bf(p.in[I_CGK][src2]);
            GVTS[hb + (r >> 5) * 2048 + (sq & 63) * 32 + (r & 31)] = f2bf(p.in[I_CGV][src2]);
        }
    }
}
__device__ void ph_fold_tables(const Params& p, unsigned char* ldsraw, const int wv) {
    const int tid = opaque_tid(wv);
    const int lane = tid & 63;
    const int gw = blockIdx.x * 8 + (tid >> 6), nw = gridDim.x * 8;
    const float* MOD = (const float*)(p.ws + OFF_MOD);
    for (size_t idx = GTID; idx < (size_t)(1024 + 1024 + 2048) * 128; idx += GNT) {
        const int row = (int)(idx >> 7), k0 = (int)(idx & 127) * 8;
        const int which = row < 2048 ? 1 : 0, l = row < 1024 ? 0 : 1;
        const int n = row < 2048 ? (row & 1023) : row - 2048, N = row < 2048 ? 1024 : 2048;
        const bf16_t* src = row < 2048 ? (const bf16_t*)(p.ws + OFF_WQ) + ((size_t)l * D + n) * D + k0 : (const bf16_t*)(p.ws + OFF_WIN) + ((size_t)INW + n) * D + k0;
        bf16_t* dst = row < 2048 ? (bf16_t*)(p.ws + OFF_WQS) + ((size_t)l * 5 * D + n) * D + k0 : (bf16_t*)(p.ws + OFF_WINS) + (size_t)n * D + k0;
        const u32x4 w = *reinterpret_cast<const u32x4*>(src);
        const float* gn = p.in[which ? I_N2G : I_N1G] + l * D + k0;
        const float4 ga = *reinterpret_cast<const float4*>(gn), gb = *reinterpret_cast<const float4*>(gn + 4);
        float wf[8];
#pragma unroll
        for (int k = 0; k < 4; ++k) { wf[2 * k] = __uint_as_float(w[k] << 16); wf[2 * k + 1] = __uint_as_float(w[k] & 0xffff0000u); }
        wf[0] *= ga.x; wf[1] *= ga.y; wf[2] *= ga.z; wf[3] *= ga.w; wf[4] *= gb.x; wf[5] *= gb.y; wf[6] *= gb.z; wf[7] *= gb.w;
#pragma unroll
        for (int cv = 0; cv < 5; ++cv) {
            const float* sc = MOD + (size_t)(l * 5 + cv) * 6144 + which * 3072 + 1024 + k0;
            const float4 sa = *reinterpret_cast<const float4*>(sc), sb = *reinterpret_cast<const float4*>(sc + 4);
            *reinterpret_cast<u32x4*>(dst + (size_t)cv * N * D) = u32x4{pack_bf2(wf[0] * (1.f + sa.x), wf[1] * (1.f + sa.y)), pack_bf2(wf[2] * (1.f + sa.z), wf[3] * (1.f + sa.w)),
                                                                         pack_bf2(wf[4] * (1.f + sb.x), wf[5] * (1.f + sb.y)), pack_bf2(wf[6] * (1.f + sb.z), wf[7] * (1.f + sb.w))};
        }
    }
    for (int row = gw; row < 1024 + 1024 + 2048; row += nw) {
        const int which = row < 2048 ? 1 : 0, l = row < 1024 ? 0 : 1;
        const int n = row < 2048 ? (row & 1023) : row - 2048;
        const bf16_t* src = row < 2048 ? (const bf16_t*)(p.ws + OFF_WQ) + ((size_t)l * D + n) * D + lane * 16 : (const bf16_t*)(p.ws + OFF_WIN) + ((size_t)INW + n) * D + lane * 16;
        const u32x4 w0 = *reinterpret_cast<const u32x4*>(src), w1 = *reinterpret_cast<const u32x4*>(src + 8);
        float wf[16];
#pragma unroll
        for (int k = 0; k < 4; ++k) { wf[2 * k] = __uint_as_float(w0[k] << 16); wf[2 * k + 1] = __uint_as_float(w0[k] & 0xffff0000u);
                                      wf[8 + 2 * k] = __uint_as_float(w1[k] << 16); wf[8 + 2 * k + 1] = __uint_as_float(w1[k] & 0xffff0000u); }
#pragma unroll
        for (int cv = 0; cv < 5; ++cv) {
            const float* sh = MOD + (size_t)(l * 5 + cv) * 6144 + which * 3072 + lane * 16;
            float acc = 0.f;
#pragma unroll
            for (int q = 0; q < 4; ++q) {
                const float4 a = *reinterpret_cast<const float4*>(sh + q * 4);
                acc += wf[q * 4] * a.x + wf[q * 4 + 1] * a.y + wf[q * 4 + 2] * a.z + wf[q * 4 + 3] * a.w;
            }
            acc = wave_sum(acc);
            if (lane == 0) {
                if (row < 2048) ((float*)(p.ws + OFF_BQ))[(size_t)(l * 5 + cv) * D + n] = acc;
                else            ((float*)(p.ws + OFF_BIN))[(size_t)cv * INW + n] = acc;
            }
        }
    }
}
__device__ void ph_ush(const Params& p, unsigned char* ldsraw, const int wv) {
    const int tid = opaque_tid(wv);
    const int lane = tid & 63;
    const int gw = blockIdx.x * 8 + (tid >> 6), nw = gridDim.x * 8;
    const float* MOD = (const float*)(p.ws + OFF_MOD);
    {
        LAS signed char* s8 = (LAS signed char*)ldsraw;
        LAS float* s8s = (LAS float*)(ldsraw + 10 * 1024);
        const int wave = tid >> 6;
        for (int r = wave; r < 10; r += 8) {
            const float* sh = MOD + (size_t)r * 6144 + 3072 + lane * 16;
            float v[16];
#pragma unroll
            for (int q = 0; q < 4; ++q) { const float4 a = *reinterpret_cast<const float4*>(sh + q * 4); v[q * 4] = a.x; v[q * 4 + 1] = a.y; v[q * 4 + 2] = a.z; v[q * 4 + 3] = a.w; }
            float am = 0.f;
#pragma unroll
            for (int i = 0; i < 16; ++i) am = fmaxf(am, fabsf(v[i]));
            am = wave_max(am);
            const float sc = am > 0.f ? 127.f / am : 1.f;
            u32x4 w;
#pragma unroll
            for (int q = 0; q < 4; ++q) w[q] = pack4_i8(q8(v[q * 4] * sc), q8(v[q * 4 + 1] * sc), q8(v[q * 4 + 2] * sc), q8(v[q * 4 + 3] * sc));
            *(LAS u32x4*)(s8 + r * 1024 + lane * 16) = w;
            if (lane == 0) s8s[r] = am > 0.f ? am * (1.f / 127.f) : 1.f;
        }
        __syncthreads();
        const int fr = lane & 15, fq = lane >> 4;
        for (int task = gw; task < 2 * (NEXP / 16); task += nw) {
            const int l = task >> 10, e0 = (task & 1023) * 16;
            const unsigned char* up = p.ws + OFF_UT + ((size_t)l * 8 * NEXP + e0 + fr) * 128 + fq * 16;
            i32x4 acc = {0, 0, 0, 0};
#pragma unroll
            for (int st = 0; st < 16; ++st) {
                const i32x4 a = *reinterpret_cast<const i32x4*>(up + (size_t)(st >> 1) * NEXP * 128 + (st & 1) * 64);
                i32x4 b = {0, 0, 0, 0};
                if (fr < 5) b = *(const LAS i32x4*)(s8 + (l * 5 + fr) * 1024 + st * 64 + fq * 16);
                acc = __builtin_amdgcn_mfma_i32_16x16x64_i8(a, b, acc, 0, 0, 0);
            }
            if (fr < 5) {
                const float ss = s8s[l * 5 + fr];
#pragma unroll
                for (int r = 0; r < 4; ++r) {
                    const int e = e0 + fq * 4 + r;
                    { float* rec = (float*)(p.ws + OFF_USH) + ((size_t)l * NEXP + e) * 8; rec[2 + fr] = (float)acc[r] * ss * rec[0]; }
                }
            }
        }
        __syncthreads();
    }
}
__device__ void ph_norm_mod(const Params& p, int l, int which, int from_input, const int wv) {
    const int tid = opaque_tid(wv);
    const int lane = tid & 63;
    const int gw = blockIdx.x * 8 + (tid >> 6), nw = gridDim.x * 8;
    const float* g = p.in[which ? I_N2G : I_N1G] + l * D;
    if (from_input) {
        float4 nx[4];
        {
            const int t = gw < NTOK ? gw : NTOK - 1;
            const float* xr = x_in_row(p, t);
#pragma unroll
            for (int i = 0; i < 4; ++i) nx[i] = *reinterpret_cast<const float4*>(xr + i * 256 + lane * 4);
        }
        for (int t = gw; t < NTOK; t += nw) {
            float4 v[4];
#pragma unroll
            for (int i = 0; i < 4; ++i) v[i] = nx[i];
            {
                const int tn = t + nw < NTOK ? t + nw : t;
                const float* xn = x_in_row(p, tn);
#pragma unroll
                for (int i = 0; i < 4; ++i) nx[i] = *reinterpret_cast<const float4*>(xn + i * 256 + lane * 4);
            }
            const float* mod = (const float*)(p.ws + OFF_MOD) + (size_t)(l * 5 + tok_cv(t)) * 6144 + which * 3072;
            float ss = 0.f;
#pragma unroll
            for (int i = 0; i < 4; ++i) ss += v[i].x * v[i].x + v[i].y * v[i].y + v[i].z * v[i].z + v[i].w * v[i].w;
            ss = wave_sum(ss);
            float r = rsqrtf(ss / D + EPS);
            bf16_t* H = (bf16_t*)(p.ws + OFF_H) + (size_t)t * D;
#pragma unroll
            for (int i = 0; i < 4; ++i) {
                int c = i * 256 + lane * 4;
                float4 gg = *reinterpret_cast<const float4*>(g + c), sh = *reinterpret_cast<const float4*>(mod + c), sc = *reinterpret_cast<const float4*>(mod + 1024 + c);
                uint2 o;
                o.x = pack_bf2(v[i].x * r * gg.x * (1.f + sc.x) + sh.x, v[i].y * r * gg.y * (1.f + sc.y) + sh.y);
                o.y = pack_bf2(v[i].z * r * gg.z * (1.f + sc.z) + sh.z, v[i].w * r * gg.w * (1.f + sc.w) + sh.w);
                *reinterpret_cast<uint2*>(H + c) = o;
            }
        }
    } else {
        u32x4 nx[2];
        {
            const int t = gw < NTOK ? gw : NTOK - 1;
            const bf16_t* xr = (const bf16_t*)(p.ws + OFF_XC) + (size_t)t * D + lane * 8;
            nx[0] = *reinterpret_cast<const u32x4*>(xr); nx[1] = *reinterpret_cast<const u32x4*>(xr + 512);
        }
        for (int t = gw; t < NTOK; t += nw) {
            float v[16];
#pragma unroll
            for (int h = 0; h < 2; ++h)
#pragma unroll
                for (int k = 0; k < 4; ++k) { v[h * 8 + 2 * k] = __uint_as_float(nx[h][k] << 16); v[h * 8 + 2 * k + 1] = __uint_as_float(nx[h][k] & 0xffff0000u); }
            {
                const int tn = t + nw < NTOK ? t + nw : t;
                const bf16_t* xn = (const bf16_t*)(p.ws + OFF_XC) + (size_t)tn * D + lane * 8;
                nx[0] = *reinterpret_cast<const u32x4*>(xn); nx[1] = *reinterpret_cast<const u32x4*>(xn + 512);
            }
            const float* mod = (const float*)(p.ws + OFF_MOD) + (size_t)(l * 5 + tok_cv(t)) * 6144 + which * 3072;
            float ss = 0.f;
#pragma unroll
            for (int i = 0; i < 16; ++i) ss += v[i] * v[i];
            ss = wave_sum(ss);
            float r = rsqrtf(ss / D + EPS);
            bf16_t* H = (bf16_t*)(p.ws + OFF_H) + (size_t)t * D;
            float hq[16];
#pragma unroll
            for (int h = 0; h < 2; ++h) {
                const int c = h * 512 + lane * 8;
                float o[8];
#pragma unroll
                for (int q = 0; q < 2; ++q) {
                    const float4 gg = *reinterpret_cast<const float4*>(g + c + q * 4), sh = *reinterpret_cast<const float4*>(mod + c + q * 4), sc = *reinterpret_cast<const float4*>(mod + 1024 + c + q * 4);
                    o[q * 4] = v[h * 8 + q * 4] * r * gg.x * (1.f + sc.x) + sh.x; o[q * 4 + 1] = v[h * 8 + q * 4 + 1] * r * gg.y * (1.f + sc.y) + sh.y;
                    o[q * 4 + 2] = v[h * 8 + q * 4 + 2] * r * gg.z * (1.f + sc.z) + sh.z; o[q * 4 + 3] = v[h * 8 + q * 4 + 3] * r * gg.w * (1.f + sc.w) + sh.w;
                }
                *reinterpret_cast<u32x4*>(H + c) = u32x4{pack_bf2(o[0], o[1]), pack_bf2(o[2], o[3]), pack_bf2(o[4], o[5]), pack_bf2(o[6], o[7])};
#pragma unroll
                for (int q = 0; q < 8; ++q) hq[h * 8 + q] = o[q];
            }
            if (which) {
                float am = 0.f;
#pragma unroll
                for (int i = 0; i < 16; ++i) am = fmaxf(am, fabsf(hq[i]));
#pragma unroll
                for (int o2 = 32; o2 >= 1; o2 >>= 1) am = fmaxf(am, shfl_x(am, lane, o2));
                const float sc8 = am > 0.f ? 127.f / am : 1.f;
#pragma unroll
                for (int h = 0; h < 2; ++h) {
                    uint2 w;
                    w.x = pack4_i8(q8(hq[h * 8] * sc8), q8(hq[h * 8 + 1] * sc8), q8(hq[h * 8 + 2] * sc8), q8(hq[h * 8 + 3] * sc8));
                    w.y = pack4_i8(q8(hq[h * 8 + 4] * sc8), q8(hq[h * 8 + 5] * sc8), q8(hq[h * 8 + 6] * sc8), q8(hq[h * 8 + 7] * sc8));
                    *reinterpret_cast<uint2*>(p.ws + OFF_H8I + (size_t)t * D + h * 512 + lane * 8) = w;
                }
                if (lane == 0) ((float*)(p.ws + OFF_HSC))[t] = am > 0.f ? am * (1.f / 127.f) : 1.f;
            }
        }
    }
}
__device__ void ph_sgu_norm(const Params& p, int l, const int wv) {
    const int tid = opaque_tid(wv);
    const int lane = tid & 63;
    const int gw = blockIdx.x * 8 + (tid >> 6), nw = gridDim.x * 8;
    for (int t = gw; t < NTOK; t += nw) {
        const bf16_t* AV = (const bf16_t*)(p.ws + OFF_AV) + (size_t)t * 256;
        float v[4]; float ss = 0.f;
#pragma unroll
        for (int i = 0; i < 4; ++i) { v[i] = bf2f(AV[i * 64 + lane]); ss += v[i] * v[i]; }
        ss = wave_sum(ss);
        float r = rsqrtf(ss / 256.f + EPS);
#pragma unroll
        for (int i = 0; i < 4; ++i) ((bf16_t*)(p.ws + OFF_AVN))[(size_t)t * 256 + i * 64 + lane] = f2bf(v[i] * r * p.in[I_SGUNG][l * 256 + i * 64 + lane]);
    }
}
__device__ void ph_sgu_mix(const Params& p, int l, const int wv) {
    const int tid = opaque_tid(wv);
    const bf16_t* AVN = (const bf16_t*)(p.ws + OFF_AVN);
    for (size_t idx = GTID; idx < (size_t)NTOK * 256; idx += GNT) {
        int t = (int)(idx >> 8), c = (int)(idx & 255);
        int t0 = t & ~127, pp = t & 127, g = c >> 6;
        const bf16_t* W = (const bf16_t*)(p.ws + OFF_SGUW) + (((size_t)l * 4 + g) * 128 + pp) * 128;
        float acc = 0.f;
        for (int q = 0; q < 128; ++q) acc += bf2f(W[q]) * bf2f(AVN[(size_t)(t0 + q) * 256 + c]);
        acc += p.in[I_SGUB][(l * 4 + g) * 128 + pp];
        float au = bf2f(((const bf16_t*)(p.ws + OFF_AU))[(size_t)t * 256 + c]);
        ((bf16_t*)(p.ws + OFF_MIX))[(size_t)t * D + c] = f2bf(au * acc);
    }
}
__device__ void ph_attn_ref(const Params& p, int l, const int wv) {
    const int tid = opaque_tid(wv);
    const int lane = tid & 63;
    const int gw = blockIdx.x * 8 + (tid >> 6), nw = gridDim.x * 8;
    const float lam = lam_of(p, l);
    for (int item = gw; item < NTOK * 12; item += nw) {
        const int t = item % NTOK, hh = item / NTOK;
        const bool prompt = t < NPT;
        const int b = prompt ? t / SEQ : (t - NPT) / DSEQ;
        const int nk = prompt ? SEQ : NKS;
        if (hh < 4) {
            const int h = hh;
            const bf16_t* K = prompt ? (const bf16_t*)(p.ws + OFF_DKP) + ((size_t)b * 4 + h) * SEQ * 64 : (const bf16_t*)(p.ws + OFF_DKS) + ((size_t)b * 4 + h) * NKS * 64;
            const bf16_t* Vt = prompt ? (const bf16_t*)(p.ws + OFF_DVTP) + ((size_t)b * 4 + h) * 64 * SEQ : (const bf16_t*)(p.ws + OFF_DVTS) + ((size_t)b * 4 + h) * 64 * NKS;
            float q = bf2f(((const bf16_t*)(p.ws + OFF_DQ))[(size_t)t * 256 + h * 64 + lane]);
            const float scale = 0.17677669529663687f;
            float m0 = -1e30f, m1 = -1e30f, l0 = 0.f, l1 = 0.f, a0 = 0.f, a1 = 0.f;
            for (int k = 0; k < nk; ++k) {
                float pr = q * bf2f(K[(size_t)k * 64 + lane]);
#pragma unroll
                for (int o = 16; o >= 1; o >>= 1) pr += shfl_x(pr, lane, o);
                float s0 = shfl_i(pr, 0) * scale, s1 = shfl_i(pr, 32) * scale;
                float v = bf2f(Vt[(size_t)lane * nk + k]);
                float mn0 = fmaxf(m0, s0), mn1 = fmaxf(m1, s1);
                float c0 = expf(m0 - mn0), c1 = expf(m1 - mn1);
                float e0 = expf(s0 - mn0), e1 = expf(s1 - mn1);
                l0 = l0 * c0 + e0; l1 = l1 * c1 + e1;
                a0 = a0 * c0 + e0 * v; a1 = a1 * c1 + e1 * v;
                m0 = mn0; m1 = mn1;
            }
            float o = a0 / l0 - lam * a1 / l1;
            float ss = wave_sum(o * o);
            float r = rsqrtf(ss / 64.f + EPS);
            o = o * r * p.in[I_SUBLN][l * 64 + lane] * (1.f - lam_init_of(l));
            ((bf16_t*)(p.ws + OFF_MIX))[(size_t)t * D + 256 + h * 64 + lane] = f2bf(o);
        } else {
            const int hq = hh - 4, kv = hq >> 2;
            const bf16_t* K = prompt ? (const bf16_t*)(p.ws + OFF_GKP) + ((size_t)b * 2 + kv) * SEQ * 64 : (const bf16_t*)(p.ws + OFF_GKS) + ((size_t)b * 2 + kv) * NKS * 64;
            const bf16_t* Vt = prompt ? (const bf16_t*)(p.ws + OFF_GVTP) + ((size_t)b * 2 + kv) * 64 * SEQ : (const bf16_t*)(p.ws + OFF_GVTS) + ((size_t)b * 2 + kv) * 64 * NKS;
            float q = bf2f(((const bf16_t*)(p.ws + OFF_GQ))[(size_t)t * 512 + hq * 64 + lane]);
            float m = -1e30f, ls = 0.f, a = 0.f;
            for (int k = 0; k < nk; ++k) {
                float s = wave_sum(q * bf2f(K[(size_t)k * 64 + lane])) * 0.125f;
                float v = bf2f(Vt[(size_t)lane * nk + k]);
                float mn = fmaxf(m, s);
                float c = expf(m - mn), e = expf(s - mn);
                ls = ls * c + e; a = a * c + e * v; m = mn;
            }
            ((bf16_t*)(p.ws + OFF_MIX))[(size_t)t * D + 512 + hq * 64 + lane] = f2bf(a / ls);
        }
    }
}
__device__ void ph_peer_scores(const Params& p, int l, const int wv) {
    const int tid = opaque_tid(wv);
    const bf16_t* SK = (const bf16_t*)(p.ws + OFF_SUBK) + (size_t)l * 2 * 128 * 64;
    for (size_t idx = GTID; idx < (size_t)NTOK * 2048; idx += GNT) {
        int t = (int)(idx >> 11), o = (int)(idx & 2047);
        const bf16_t* Q = (const bf16_t*)(p.ws + OFF_Q) + (size_t)t * D;
        int n = o & 127, x = (o >> 7) & 1, h = o >> 8;
        float acc = 0.f;
        for (int k = 0; k < 64; ++k) acc += bf2f(Q[h * 128 + x * 64 + k]) * bf2f(SK[((size_t)x * 128 + n) * 64 + k]);
        ((float*)(p.ws + OFF_PROJ))[idx] = acc;
    }
}
__device__ void ph_peer_top1(const Params& p, const int wv) {
    const int tid = opaque_tid(wv);
    for (size_t idx = GTID; idx < (size_t)NTOK * 16; idx += GNT) {
        const float* SC = (const float*)(p.ws + OFF_PROJ) + idx * 128;
        float* TV = (float*)(p.ws + OFF_TOPV) + idx * 16; int* TI = (int*)(p.ws + OFF_TOPI) + idx * 16;
        float pv = 3.0e38f; int pi = -1;
        for (int r = 0; r < 16; ++r) {
            float bv = -3.0e38f; int bi = -1;
            for (int n = 0; n < 128; ++n) {
                float v = SC[n];
                bool after = (v < pv) || (v == pv && n > pi);
                if (after && (bi < 0 || v > bv)) { bv = v; bi = n; }
            }
            TV[r] = bv; TI[r] = bi; pv = bv; pi = bi;
        }
    }
}
__device__ void ph_peer_top2(const Params& p, const int wv) {
    const int tid = opaque_tid(wv);
    for (size_t idx = GTID; idx < (size_t)NTOK * 8; idx += GNT) {
        const float* TV = (const float*)(p.ws + OFF_TOPV) + idx * 32; const int* TI = (const int*)(p.ws + OFF_TOPI) + idx * 32;
        int* EI = (int*)(p.ws + OFF_EIDX) + idx * 16; float* EG = (float*)(p.ws + OFF_EGATE) + idx * 16;
        float pv = 3.0e38f; int pi = -1; float mx = 0.f, sum = 0.f;
        for (int r = 0; r < 16; ++r) {
            float bv = -3.0e38f; int bi = -1;
            for (int n = 0; n < 256; ++n) {
                float v = TV[n >> 4] + TV[16 + (n & 15)];
                bool after = (v < pv) || (v == pv && n > pi);
                if (after && (bi < 0 || v > bv)) { bv = v; bi = n; }
            }
            if (r == 0) mx = bv;
            float e = expf(bv - mx);
            sum += e;
            EG[r] = e; EI[r] = TI[bi >> 4] * 128 + TI[16 + (bi & 15)];
            pv = bv; pi = bi;
        }
        float inv = 1.f / sum;
        for (int r = 0; r < 16; ++r) EG[r] *= inv;
    }
}
__device__ void ph_peer_apply(const Params& p, int l, unsigned char* lds, const int wv) {
    const int tid = opaque_tid(wv);
    const int sub = tid >> 8, tl = tid & 255;
    const int wave = tl >> 6, lane = tl & 63;
    float* wts = (float*)(lds + 64) + sub * 128; int* eid = (int*)(lds + 64 + 1024) + sub * 128;
    const bf16_t* UT = (const bf16_t*)(p.ws + OFF_UT) + (size_t)l * NEXP * D;
    const bf16_t* VT = (const bf16_t*)(p.ws + OFF_VT) + (size_t)l * NEXP * D;
    const int niter = (NTOK + gridDim.x * 2 - 1) / (gridDim.x * 2);
    for (int it = 0; it < niter; ++it) {
        int t = (it * gridDim.x + blockIdx.x) * 2 + sub;
        const bool valid = t < NTOK; if (!valid) t = NTOK - 1;
        const bf16_t* H = (const bf16_t*)(p.ws + OFF_H) + (size_t)t * D;
        const int* EI = (const int*)(p.ws + OFF_EIDX) + (size_t)t * 128; const float* EG = (const float*)(p.ws + OFF_EGATE) + (size_t)t * 128;
        float hv[16];
#pragma unroll
        for (int i = 0; i < 16; ++i) hv[i] = bf2f(H[lane * 16 + i]);
        for (int jj = 0; jj < 32; ++jj) {
            int j = wave * 32 + jj; int e = EI[j];
            const bf16_t* ur = UT + (size_t)e * D + lane * 16;
            float acc = 0.f;
#pragma unroll
            for (int i = 0; i < 16; ++i) acc += hv[i] * bf2f(ur[i]);
            acc = wave_sum(acc);
            if (lane == 0) { wts[j] = EG[j] * gelu_f(acc); eid[j] = e; }
        }
        __syncthreads();
        float o[4] = {0.f, 0.f, 0.f, 0.f};
        for (int j = 0; j < 128; ++j) {
            const bf16_t* vr = VT + (size_t)eid[j] * D + tl * 4; float w = wts[j];
#pragma unroll
            for (int i = 0; i < 4; ++i) o[i] += w * bf2f(vr[i]);
        }
        const float* mod = (const float*)(p.ws + OFF_MOD) + (size_t)(l * 5 + tok_cv(t)) * 6144 + 5 * 1024;
        float* XC = (float*)(p.ws + OFF_XC) + (size_t)t * D;
        if (valid) {
#pragma unroll
            for (int i = 0; i < 4; ++i) { int c = tl * 4 + i; XC[c] += mod[c] * o[i]; }
        }
        __syncthreads();
    }
}
__device__ void ph_final_norm(const Params& p, const int wv) {
    const int tid = opaque_tid(wv);
    const int lane = tid & 63;
    const int gw = blockIdx.x * 8 + (tid >> 6), nw = gridDim.x * 8;
    u32x4 nx[2];
    {
        const int t = gw < NTOK ? gw : NTOK - 1;
        const bf16_t* xr = (const bf16_t*)(p.ws + OFF_XC) + (size_t)t * D + lane * 8;
        nx[0] = *reinterpret_cast<const u32x4*>(xr); nx[1] = *reinterpret_cast<const u32x4*>(xr + 512);
    }
    for (int t = gw; t < NTOK; t += nw) {
        float v[16];
#pragma unroll
        for (int h = 0; h < 2; ++h)
#pragma unroll
            for (int k = 0; k < 4; ++k) { v[h * 8 + 2 * k] = __uint_as_float(nx[h][k] << 16); v[h * 8 + 2 * k + 1] = __uint_as_float(nx[h][k] & 0xffff0000u); }
        {
            const int tn = t + nw < NTOK ? t + nw : t;
            const bf16_t* xn = (const bf16_t*)(p.ws + OFF_XC) + (size_t)tn * D + lane * 8;
            nx[0] = *reinterpret_cast<const u32x4*>(xn); nx[1] = *reinterpret_cast<const u32x4*>(xn + 512);
        }
        float ss = 0.f;
#pragma unroll
        for (int i = 0; i < 16; ++i) ss += v[i] * v[i];
        ss = wave_sum(ss);
        float r = rsqrtf(ss / D + EPS);
        float* y = p.out + (size_t)t * D;
#pragma unroll
        for (int h = 0; h < 2; ++h) {
            const int c = h * 512 + lane * 8;
#pragma unroll
            for (int q = 0; q < 2; ++q) {
                const float4 g = *reinterpret_cast<const float4*>(p.in[I_FG] + c + q * 4);
                *reinterpret_cast<float4*>(y + c + q * 4) = make_float4(v[h * 8 + q * 4] * r * g.x, v[h * 8 + q * 4 + 1] * r * g.y, v[h * 8 + q * 4 + 2] * r * g.z, v[h * 8 + q * 4 + 3] * r * g.w);
            }
        }
    }
}


namespace g8 {
constexpr int BM = 256, BK = 64, HALF = 128, HT = HALF * BK;
__device__ __forceinline__ int lds_byte(int r, int c) {
    int st = (r >> 4) * 2 + (c >> 5), rr = r & 15, cc = c & 31, ob = rr * 64 + cc * 2;
    return st * 1024 + (ob ^ (((ob >> 9) & 1) << 5));
}
__device__ __forceinline__ void stage_rc(int b, int& R, int& C) {
    int st = b / 1024, sb = b % 1024, swz = sb ^ (((sb >> 9) & 1) << 5);
    R = (st >> 1) * 16 + swz / 64; C = (st & 1) * 32 + (swz % 64) / 2;
}
}
enum { EPI_INPROJ = 0, EPI_WOUT = 1, EPI_WQ = 2 };
constexpr int STG = 132;

__device__ __forceinline__ void store_bf16x32(bf16_t* dst, const float (&v)[32]) {
#pragma unroll
    for (int i = 0; i < 4; ++i) {
        uint4 u;
        u.x = pack_bf2(v[i * 8 + 0], v[i * 8 + 1]); u.y = pack_bf2(v[i * 8 + 2], v[i * 8 + 3]);
        u.z = pack_bf2(v[i * 8 + 4], v[i * 8 + 5]); u.w = pack_bf2(v[i * 8 + 6], v[i * 8 + 7]);
        *reinterpret_cast<uint4*>(dst + i * 8) = u;
    }
}
__device__ __forceinline__ void store_f32x32(float* dst, const float (&v)[32]) {
#pragma unroll
    for (int i = 0; i < 8; ++i) *reinterpret_cast<float4*>(dst + i * 4) = make_float4(v[i * 4], v[i * 4 + 1], v[i * 4 + 2], v[i * 4 + 3]);
}

__device__ __forceinline__ void epi_inproj_xform(const Params& p, int l, int t, int c0, float (&v)[32]) {
    const bool prompt = t < NPT;
    const int s = prompt ? (t & 255) : ((t - NPT) & 2047);
    const float* R = (const float*)(p.ws + OFF_ROPE);
    if (c0 < 512) {
#pragma unroll
        for (int i = 0; i < 32; ++i) v[i] = gelu_f(v[i]);
    } else if (c0 < 1024) {
        if (!prompt) {
            const float* cs = R + s * 16; const float* sn = R + 2048 * 16 + s * 16;
#pragma unroll
            for (int i = 0; i < 16; ++i) {
                float c = cs[i], sv = sn[i], x1 = v[i], x2 = v[i + 16];
                v[i] = x1 * c - x2 * sv; v[i + 16] = x2 * c + x1 * sv;
            }
        }
    } else if (c0 >= 1280 && c0 < 1920) {
        const bool isq = c0 < 1792;
        const int hi = c0 & 32;
        const float* g = p.in[isq ? I_QNG : I_KNG] + l * 64 + hi;
        float ss = 0.f;
#pragma unroll
        for (int i = 0; i < 32; ++i) ss += v[i] * v[i];
        const int ln = lane_id_op();
        ss += shfl_x(ss, ln, 1);
        const float rr = rsqrtf(ss * (1.f / 64.f) + EPS);
#pragma unroll
        for (int i = 0; i < 32; ++i) v[i] = v[i] * rr * g[i];
        if (!prompt) {
            const float* cs = R + 2048 * 32 + s * 32; const float* sn = R + 2048 * 64 + s * 32;
#pragma unroll
            for (int i = 0; i < 32; ++i) {
                float pv = shfl_x(v[i], ln, 1);
                float c = cs[i], sv = sn[i];
                v[i] = hi ? (v[i] * c + pv * sv) : (v[i] * c - pv * sv);
            }
        }
        if (isq) {
#pragma unroll
            for (int i = 0; i < 32; ++i) v[i] *= 0.125f * 1.4426950408889634f;
        }
    }
}
__device__ __forceinline__ void epi_inproj_col(const Params& p, int t0, int c, const LAS float* stc) {
    float v[32];
#pragma unroll
    for (int i = 0; i < 32; ++i) v[i] = stc[i * STG];
    const bool prompt = t0 < NPT;
    const int b = prompt ? (t0 >> 8) : ((t0 - NPT) >> 11);
    const int s = prompt ? (t0 & 255) : ((t0 - NPT) & 2047);
    unsigned char* ws = p.ws;
    bf16_t* dst;
    if (c < 1280) {
        const int cc = c - 1024, h = cc >> 6, d = cc & 63;
        dst = prompt ? (bf16_t*)(ws + OFF_DVTP) + (((size_t)b * 4 + h) * 64 + d) * SEQ + s
                     : (bf16_t*)(ws + OFF_DVTS) + (((size_t)b * 4 + h) * 64 + d) * NKS + s;
    } else {
        const int cc = c - 1920, kv = cc >> 6, d = cc & 63;
        dst = prompt ? (bf16_t*)(ws + OFF_GVTP) + (((size_t)b * 2 + kv) * 64 + d) * SEQ + s
                     : (bf16_t*)(ws + OFF_GVTS) + (((size_t)b * 2 + kv) * 64 + d) * NKS + s;
    }
    store_bf16x32(dst, v);
}

template <int MODE>
__device__ __forceinline__ void gemm_phase(const Params& p, int l, const bf16_t* __restrict__ A, const bf16_t* __restrict__ Bt, const int N, unsigned char* ldsraw, const int wv,
                                           const size_t cvstride = 0, const float* __restrict__ RSS = nullptr, const float* __restrict__ BIAS = nullptr) {
    using namespace g8;
    constexpr int K = 1024, nt = K / BK, BN = 128, TILE_A = BM * BK * 2, TILE_B = BN * BK * 2, STAGE_B = TILE_A + TILE_B;
    LAS unsigned char* lds = (LAS unsigned char*)ldsraw;
    const int tid = opaque_tid(wv), wid = wv, lane = tid & 63;
    const int wr = wid >> 1, wc = wid & 1, fr = lane & 15, fq = lane >> 4;
    unsigned voff[4];
#pragma unroll
    for (int i = 0; i < 4; ++i) voff[i] = (unsigned)((i * 64 + wid * 8 + (lane >> 3)) * K + (((lane & 7) ^ (lane >> 3)) * 8)) * 2u;
    const int aoff = (wr * 64 + fr) * 128 + ((fq ^ (fr & 7)) * 16), boff = (wc * 64 + fr) * 128 + ((fq ^ (fr & 7)) * 16);
    const unsigned ldsw = (unsigned)wid * 1024u;
#define G8_STAGE(buf, kt) do { \
        _Pragma("unroll") for (int _i = 0; _i < 4; ++_i) \
            __builtin_amdgcn_global_load_lds((const unsigned*)((const char*)(Ab + (kt) * BK) + voff[_i]), (LAS unsigned*)(lds + (buf) * STAGE_B + ldsw + _i * 8192), 16, 0, 0); \
        _Pragma("unroll") for (int _i = 0; _i < 2; ++_i) \
            __builtin_amdgcn_global_load_lds((const unsigned*)((const char*)(Bb + (kt) * BK) + voff[_i]), (LAS unsigned*)(lds + (buf) * STAGE_B + TILE_A + ldsw + _i * 8192), 16, 0, 0); } while (0)
#define G8_WAIT_V0() asm volatile("s_waitcnt vmcnt(0)" ::: "memory")
    const int nN = N / BN, nM = NTOK / BM, ntiles = nM * nN;
    const int G = gridDim.x;
    const int vb = (G % 8 == 0) ? (int)(blockIdx.x % 8) * (G / 8) + (int)(blockIdx.x / 8) : (int)blockIdx.x;
    const int tpb = (ntiles + G - 1) / G;
    const bool paneled = (G == 256) && (nN == 8 || nN == 16) && (nM == 64);
    for (int ti = 0; ti < tpb; ++ti) {
        int tile = vb * tpb + ti;
        if (paneled) {
            const int x = vb >> 5, j = vb & 31;
            const int mpx = nN == 16 ? 16 : 8;
            const int m0 = nN == 16 ? (x >> 1) * 16 : x * 8, n0 = nN == 16 ? (x & 1) * 8 : 0;
            const int pm_ = m0 + ti * 4 + (j >> 3), pn_ = n0 + (j & 7);
            tile = (ti * 4 < mpx) ? pm_ * nN + pn_ : ntiles;
        }
        if (tile >= ntiles) break;
        const int pm = tile / nN, pn = tile % nN, brow = pm * BM, bcol = pn * BN;
        const bf16_t* Ab = A + (size_t)brow * K; const bf16_t* Bb = Bt + (size_t)tok_cv(brow) * cvstride + (size_t)bcol * K;
        f32x4 acc[4][4];
#pragma unroll
        for (int m = 0; m < 4; ++m)
#pragma unroll
            for (int n = 0; n < 4; ++n) acc[m][n] = f32x4{0.f, 0.f, 0.f, 0.f};
        G8_WAIT_V0();
        G8_STAGE(0, 0); G8_STAGE(1, 1);
        int cur = 0;
        for (int t = 0; t < nt; ++t) {
            if (t + 1 < nt) asm volatile("s_waitcnt vmcnt(6)" ::: "memory"); else asm volatile("s_waitcnt vmcnt(0)" ::: "memory");
            __builtin_amdgcn_s_barrier();
            if (t + 2 < nt) { const int nb = cur >= 1 ? cur - 1 : 2; G8_STAGE(nb, t + 2); }
            {
                bf16x8 At[2][4], Bf[2][4];
#pragma unroll
                for (int ks = 0; ks < 2; ++ks) {
#pragma unroll
                    for (int m = 0; m < 4; ++m) At[ks][m] = *(const LAS bf16x8*)(lds + cur * STAGE_B + ((aoff + m * 2048) ^ (ks * 64)));
#pragma unroll
                    for (int n = 0; n < 4; ++n) Bf[ks][n] = *(const LAS bf16x8*)(lds + cur * STAGE_B + TILE_A + ((boff + n * 2048) ^ (ks * 64)));
                }
                __builtin_amdgcn_sched_barrier(0);
#pragma unroll
                for (int ks = 0; ks < 2; ++ks)
#pragma unroll
                    for (int m = 0; m < 4; ++m)
#pragma unroll
                        for (int n = 0; n < 4; ++n) acc[m][n] = __builtin_amdgcn_mfma_f32_16x16x32_bf16(At[ks][m], Bf[ks][n], acc[m][n], 0, 0, 0);
                __builtin_amdgcn_sched_barrier(0);
            }
            cur = cur == 2 ? 0 : cur + 1;
        }
        __syncthreads();
        LAS float* st = (LAS float*)lds;
        if (MODE != EPI_WOUT && cvstride != 0) {
            LAS float* rs = st + 256 * STG;
            if (tid < 256) {
                const float* rp = RSS + (size_t)(brow + tid) * 8;
                const float4 a = *reinterpret_cast<const float4*>(rp), b = *reinterpret_cast<const float4*>(rp + 4);
                rs[tid] = rsqrtf((((a.x + a.y) + (a.z + a.w)) + ((b.x + b.y) + (b.z + b.w))) * (1.f / D) + EPS);
            }
            __syncthreads();
            float bz[4];
#pragma unroll
            for (int n = 0; n < 4; ++n) bz[n] = BIAS[(size_t)tok_cv(brow) * N + bcol + wc * 64 + n * 16 + fr];
#pragma unroll
            for (int m = 0; m < 4; ++m)
#pragma unroll
                for (int j = 0; j < 4; ++j) {
                    const float r = rs[wr * 64 + m * 16 + fq * 4 + j];
#pragma unroll
                    for (int n = 0; n < 4; ++n) st[(wr * 64 + m * 16 + fq * 4 + j) * STG + wc * 64 + n * 16 + fr] = acc[m][n][j] * r + bz[n];
                }
        } else {
#pragma unroll
        for (int m = 0; m < 4; ++m)
#pragma unroll
            for (int n = 0; n < 4; ++n)
#pragma unroll
                for (int j = 0; j < 4; ++j)
                    st[(wr * 64 + m * 16 + fq * 4 + j) * STG + wc * 64 + n * 16 + fr] = acc[m][n][j];
        }
        __syncthreads();
        const bool tprompt = brow < NPT;
        const int tb_ = tprompt ? (brow >> 8) : ((brow - NPT) >> 11), ts0 = tprompt ? 0 : ((brow - NPT) & 2047);
        if (MODE == EPI_INPROJ) {
            const bool vtile = (bcol >= 1024 && bcol < 1280);
            if (!vtile) {
#pragma unroll 1
                for (int it = 0; it < 2; ++it) {
                    const int item = it * NT + tid, erow = item >> 2, eseg = item & 3;
                    float v[32];
#pragma unroll
                    for (int i = 0; i < 8; ++i) {
                        const f32x4 f = *(const LAS f32x4*)(st + erow * STG + eseg * 32 + i * 4);
                        v[i * 4] = f[0]; v[i * 4 + 1] = f[1]; v[i * 4 + 2] = f[2]; v[i * 4 + 3] = f[3];
                    }
                    epi_inproj_xform(p, l, brow + erow, bcol + eseg * 32, v);
#pragma unroll
                    for (int i = 0; i < 8; ++i) *(LAS f32x4*)(st + erow * STG + eseg * 32 + i * 4) = f32x4{v[i * 4], v[i * 4 + 1], v[i * 4 + 2], v[i * 4 + 3]};
                }
                __syncthreads();
#pragma unroll 1
                for (int it = 0; it < 8; ++it) {
                    const int item = it * NT + tid, r = item >> 4, c = (item & 15) * 8;
                    const f32x4 f0 = *(const LAS f32x4*)(st + r * STG + c), f1 = *(const LAS f32x4*)(st + r * STG + c + 4);
                    const int t = brow + r, sp = ts0 + r;
                    bf16_t* dst;
                    if (bcol < 512)        dst = (bf16_t*)(p.ws + (bcol < 256 ? OFF_AU : OFF_AV)) + (size_t)t * 256 + (bcol & 255) + c;
                    else if (bcol < 768)   dst = (bf16_t*)(p.ws + OFF_DQ) + (size_t)t * 256 + (bcol - 512) + c;
                    else if (bcol < 1024) { const int cc = bcol - 768 + c, h = cc >> 6;
                                            dst = tprompt ? (bf16_t*)(p.ws + OFF_DKP) + (((size_t)tb_ * 4 + h) * SEQ + sp) * 64 + (cc & 63)
                                                          : (bf16_t*)(p.ws + OFF_DKS) + (((size_t)tb_ * 4 + h) * NKS + sp) * 64 + (cc & 63); }
                    else if (bcol < 1792)  dst = (bf16_t*)(p.ws + OFF_GQ) + (size_t)t * 512 + (bcol - 1280) + c;
                    else                 { const int kv = c >> 6, d0 = c & 63;
                                            const size_t hb = (tprompt ? ((size_t)tb_ * 2 + kv) * SEQ * 64 : ((size_t)tb_ * 2 + kv) * NKS * 64) + (size_t)(sp >> 6) * 4096;
                                            dst = bcol < 1920 ? (bf16_t*)(p.ws + (tprompt ? OFF_GKP : OFF_GKS)) + hb + (d0 >> 3) * 512 + (sp & 63) * 8
                                                              : (bf16_t*)(p.ws + (tprompt ? OFF_GVTP : OFF_GVTS)) + hb + (d0 >> 5) * 2048 + (sp & 63) * 32 + (d0 & 31); }
                    *reinterpret_cast<u32x4*>(dst) = u32x4{pack_bf2(f0[0], f0[1]), pack_bf2(f0[2], f0[3]), pack_bf2(f1[0], f1[1]), pack_bf2(f1[2], f1[3])};
                }
            }
            if (tprompt && ((bcol >= 768 && bcol < 1280) || bcol >= 1792)) {
                float* ob; int rs;
                if (bcol < 1024)      { ob = p.out + OUT_NDK + (((size_t)tb_ * 2 + l) * SEQ) * 256 + (bcol - 768);  rs = 256; }
                else if (bcol < 1280) { ob = p.out + OUT_NDV + (((size_t)tb_ * 2 + l) * SEQ) * 256 + (bcol - 1024); rs = 256; }
                else if (bcol < 1920) { ob = p.out + OUT_NGK + (((size_t)tb_ * 2 + l) * SEQ) * 128;                 rs = 128; }
                else                  { ob = p.out + OUT_NGV + (((size_t)tb_ * 2 + l) * SEQ) * 128;                 rs = 128; }
#pragma unroll 1
                for (int it = 0; it < 16; ++it) {
                    const int item = it * NT + tid, r = item >> 5, c = (item & 31) * 4;
                    *reinterpret_cast<f32x4*>(ob + (size_t)r * rs + c) = *(const LAS f32x4*)(st + r * STG + c);
                }
            }
            if (vtile) {
#pragma unroll 1
                for (int it = 0; it < 2; ++it) {
                    const int item = it * NT + tid, col = item >> 3, run = item & 7;
                    epi_inproj_col(p, brow + run * 32, bcol + col, st + run * 32 * STG + col);
                }
            }
        } else {
#pragma unroll 1
            for (int it = 0; it < 8; ++it) {
                const int item = it * NT + tid, r = item >> 4, c = (item & 15) * 8;
                const f32x4 f0 = *(const LAS f32x4*)(st + r * STG + c), f1 = *(const LAS f32x4*)(st + r * STG + c + 4);
                const int t = brow + r;
                float o[8] = {f0[0], f0[1], f0[2], f0[3], f1[0], f1[1], f1[2], f1[3]};
                if (MODE == EPI_WOUT) {
                    const float* g1 = (const float*)(p.ws + OFF_MOD) + (size_t)(l * 5 + tok_cv(t)) * 6144 + 2048 + bcol + c;
                    const float4 ga = *reinterpret_cast<const float4*>(g1), gb = *reinterpret_cast<const float4*>(g1 + 4);
                    float x[8];
                    if (l == 0) {
                        const float* xr = x_in_row(p, t) + bcol + c;
                        const float4 xa = *reinterpret_cast<const float4*>(xr), xb2 = *reinterpret_cast<const float4*>(xr + 4);
                        x[0] = xa.x; x[1] = xa.y; x[2] = xa.z; x[3] = xa.w; x[4] = xb2.x; x[5] = xb2.y; x[6] = xb2.z; x[7] = xb2.w;
                    } else {
                        const u32x4 xw = *reinterpret_cast<const u32x4*>((const bf16_t*)(p.ws + OFF_XC) + (size_t)t * D + bcol + c);
#pragma unroll
                        for (int k = 0; k < 4; ++k) { x[2 * k] = __uint_as_float(xw[k] << 16); x[2 * k + 1] = __uint_as_float(xw[k] & 0xffff0000u); }
                    }
                    o[0] = x[0] + ga.x * o[0]; o[1] = x[1] + ga.y * o[1]; o[2] = x[2] + ga.z * o[2]; o[3] = x[3] + ga.w * o[3];
                    o[4] = x[4] + gb.x * o[4]; o[5] = x[5] + gb.y * o[5]; o[6] = x[6] + gb.z * o[6]; o[7] = x[7] + gb.w * o[7];
                    const float* gn = p.in[I_N2G] + l * D + bcol + c;
                    const float4 na = *reinterpret_cast<const float4*>(gn), nb = *reinterpret_cast<const float4*>(gn + 4);
                    const float4 sa = *reinterpret_cast<const float4*>(g1 + 2048), sb = *reinterpret_cast<const float4*>(g1 + 2048 + 4);
                    float xg[8] = {o[0] * na.x * (1.f + sa.x), o[1] * na.y * (1.f + sa.y), o[2] * na.z * (1.f + sa.z), o[3] * na.w * (1.f + sa.w),
                                   o[4] * nb.x * (1.f + sb.x), o[5] * nb.y * (1.f + sb.y), o[6] * nb.z * (1.f + sb.z), o[7] * nb.w * (1.f + sb.w)};
                    float ss = 0.f, am = 0.f;
#pragma unroll
                    for (int i = 0; i < 8; ++i) { ss += o[i] * o[i]; am = fmaxf(am, fabsf(xg[i])); }
                    ss = row16_sum(ss); am = row16_max(am);
                    const float sc8 = am > 0.f ? 127.f / am : 1.f;
                    uint2 w8;
                    w8.x = pack4_i8(q8(xg[0] * sc8), q8(xg[1] * sc8), q8(xg[2] * sc8), q8(xg[3] * sc8));
                    w8.y = pack4_i8(q8(xg[4] * sc8), q8(xg[5] * sc8), q8(xg[6] * sc8), q8(xg[7] * sc8));
                    *reinterpret_cast<uint2*>(p.ws + OFF_H8I + (size_t)t * D + bcol + c) = w8;
                    if ((item & 15) == 0) {
                        ((float*)(p.ws + OFF_RSS2))[((size_t)l * NTOK + t) * 8 + pn] = ss;
                        ((float*)(p.ws + OFF_XGS))[(size_t)t * 8 + pn] = am > 0.f ? am * (1.f / 127.f) : 1.f;
                    }
                }
                bf16_t* dst = (bf16_t*)(p.ws + (MODE == EPI_WOUT ? OFF_XC : OFF_Q)) + (size_t)t * D + bcol + c;
                *reinterpret_cast<u32x4*>(dst) = u32x4{pack_bf2(o[0], o[1]), pack_bf2(o[2], o[3]), pack_bf2(o[4], o[5]), pack_bf2(o[6], o[7])};
            }
        }
        __syncthreads();
    }
}


#define MFMA32(a, b, c) __builtin_amdgcn_mfma_f32_32x32x16_bf16((a), (b), (c), 0, 0, 0)
constexpr int ATT_ROWB = 144;
constexpr int ATT_TILEB = 64 * ATT_ROWB;
constexpr int QW_MIX = 4096;

__device__ __forceinline__ bf16x8 pack8(const f32x16& x, int s) {
    const u32x4 w = {pack_bf2(x[8 * s], x[8 * s + 1]), pack_bf2(x[8 * s + 2], x[8 * s + 3]), pack_bf2(x[8 * s + 4], x[8 * s + 5]), pack_bf2(x[8 * s + 6], x[8 * s + 7])};
    return __builtin_bit_cast(bf16x8, w);
}
__device__ __forceinline__ void softmax_tile(f32x16& s0, f32x16& s1, const float sc, float& m, float& l, float& alpha, const int lane) {
    float mx = fmaxf(s0[0], s1[0]);
#pragma unroll
    for (int i = 1; i < 16; ++i) mx = fmaxf(mx, fmaxf(s0[i], s1[i]));
    mx = fmaxf(mx, shfl_x(mx, lane, 32));
    const float mnew = fmaxf(m, mx * sc);
    alpha = __builtin_amdgcn_exp2f(m - mnew);
    m = mnew;
    float ps = 0.f;
#pragma unroll
    for (int i = 0; i < 16; ++i) { s0[i] = __builtin_amdgcn_exp2f(s0[i] * sc - mnew); s1[i] = __builtin_amdgcn_exp2f(s1[i] * sc - mnew); ps += s0[i] + s1[i]; }
    l = l * alpha + ps;
}
__device__ __forceinline__ void v_frags(const LAS unsigned char* vb, bf16x8 (&vf)[8], int r, int hh) {
#pragma unroll
    for (int u = 0; u < 2; ++u)
#pragma unroll
        for (int sk = 0; sk < 2; ++sk)
#pragma unroll
            for (int mt = 0; mt < 2; ++mt) {
                const LAS unsigned char* a = vb + (32 * mt + r) * ATT_ROWB + (32 * u + 16 * sk + 4 * hh) * 2;
                const s16x4 lo = *(const LAS s16x4*)a, hi = *(const LAS s16x4*)(a + 16);
                vf[(u * 2 + sk) * 2 + mt] = bf16x8{lo[0], lo[1], lo[2], lo[3], hi[0], hi[1], hi[2], hi[3]};
            }
}
__device__ __forceinline__ void pv_tile(const bf16x8 (&vf)[8], const f32x16& p0, const f32x16& p1, f32x16 (&O)[2]) {
#pragma unroll
    for (int u = 0; u < 2; ++u)
#pragma unroll
        for (int sk = 0; sk < 2; ++sk) {
            const bf16x8 pf = pack8(u ? p1 : p0, sk);
#pragma unroll
            for (int mt = 0; mt < 2; ++mt) O[mt] = MFMA32(vf[(u * 2 + sk) * 2 + mt], pf, O[mt]);
        }
}

template <bool DIFF>
__device__ __forceinline__ void attn_item(const Params& p, int l, LAS unsigned char* lds, const int tid,
                                          const bf16_t* __restrict__ Qg, const int qstride,
                                          const bf16_t* __restrict__ Kg, const bf16_t* __restrict__ Vtg, const int nk,
                                          bf16_t* __restrict__ Og, const float lam) {
    const int wave = tid >> 6, lane = tid & 63, r = lane & 31, hh = lane >> 5;
    const int lrow = tid >> 3, lchunk = tid & 7;
    LAS unsigned char* kbuf = lds; LAS unsigned char* vbuf = lds + 2 * ATT_TILEB;
    bf16x8 qf[4];
    const bf16_t* qrow = Qg + (size_t)(wave * 32 + r) * qstride;
#pragma unroll
    for (int ks = 0; ks < 4; ++ks) qf[ks] = *reinterpret_cast<const bf16x8*>(qrow + ks * 16 + hh * 8);
    const float sc = (DIFF ? 0.17677669529663687f : 0.125f) * 1.4426950408889634f;
    f32x16 O0[2], O1[2];
#pragma unroll
    for (int mt = 0; mt < 2; ++mt)
#pragma unroll
        for (int i = 0; i < 16; ++i) { O0[mt][i] = 0.f; O1[mt][i] = 0.f; }
    float m0 = -1e30f, l0 = 0.f, m1 = -1e30f, l1 = 0.f;
    const int ntl = nk / 64;
    u32x4 kr, vr, kn, vn;
    kr = *reinterpret_cast<const u32x4*>(Kg + (size_t)lrow * 64 + lchunk * 8);
    vr = *reinterpret_cast<const u32x4*>(Vtg + (size_t)lrow * nk + lchunk * 8);
    *(LAS u32x4*)(kbuf + lrow * ATT_ROWB + lchunk * 16) = kr;
    *(LAS u32x4*)(vbuf + lrow * ATT_ROWB + lchunk * 16) = vr;
    {
        const int t1 = ntl > 1 ? 1 : 0;
        kr = *reinterpret_cast<const u32x4*>(Kg + (size_t)(t1 * 64 + lrow) * 64 + lchunk * 8);
        vr = *reinterpret_cast<const u32x4*>(Vtg + (size_t)lrow * nk + t1 * 64 + lchunk * 8);
    }
    __syncthreads();
    for (int ti = 0; ti < ntl; ++ti) {
        const int cur = ti & 1;
        {
            const int t2 = ti + 2 < ntl ? ti + 2 : ntl - 1;
            kn = *reinterpret_cast<const u32x4*>(Kg + (size_t)(t2 * 64 + lrow) * 64 + lchunk * 8);
            vn = *reinterpret_cast<const u32x4*>(Vtg + (size_t)lrow * nk + t2 * 64 + lchunk * 8);
        }
        const LAS unsigned char* kb = kbuf + cur * ATT_TILEB; const LAS unsigned char* vb = vbuf + cur * ATT_TILEB;
        bf16x8 ka[2][4];
#pragma unroll
        for (int u = 0; u < 2; ++u)
#pragma unroll
            for (int ks = 0; ks < 4; ++ks) ka[u][ks] = *(const LAS bf16x8*)(kb + (32 * u + r) * ATT_ROWB + (ks * 16 + hh * 8) * 2);
        __builtin_amdgcn_sched_barrier(0);
        bf16x8 vf[8];
        if (!DIFF) {
            f32x16 s0, s1;
#pragma unroll
            for (int i = 0; i < 16; ++i) { s0[i] = 0.f; s1[i] = 0.f; }
#pragma unroll
            for (int ks = 0; ks < 4; ++ks) { s0 = MFMA32(ka[0][ks], qf[ks], s0); s1 = MFMA32(ka[1][ks], qf[ks], s1); }
            v_frags(vb, vf, r, hh);
            __builtin_amdgcn_sched_barrier(0);
            float alpha;
            softmax_tile(s0, s1, sc, m0, l0, alpha, lane);
            if (__builtin_amdgcn_ballot_w64(alpha != 1.f) != 0ull) {
#pragma unroll
                for (int mt = 0; mt < 2; ++mt)
#pragma unroll
                    for (int i = 0; i < 16; ++i) O0[mt][i] *= alpha;
            }
            pv_tile(vf, s0, s1, O0);
        } else {
            f32x16 s0, s1, t0, t1;
#pragma unroll
            for (int i = 0; i < 16; ++i) { s0[i] = 0.f; s1[i] = 0.f; t0[i] = 0.f; t1[i] = 0.f; }
#pragma unroll
            for (int ks = 0; ks < 2; ++ks) {
                s0 = MFMA32(ka[0][ks], qf[ks], s0); s1 = MFMA32(ka[1][ks], qf[ks], s1);
                t0 = MFMA32(ka[0][2 + ks], qf[2 + ks], t0); t1 = MFMA32(ka[1][2 + ks], qf[2 + ks], t1);
            }
            v_frags(vb, vf, r, hh);
            __builtin_amdgcn_sched_barrier(0);
            float alpha;
            softmax_tile(s0, s1, sc, m0, l0, alpha, lane);
            if (__builtin_amdgcn_ballot_w64(alpha != 1.f) != 0ull) {
#pragma unroll
                for (int mt = 0; mt < 2; ++mt)
#pragma unroll
                    for (int i = 0; i < 16; ++i) O0[mt][i] *= alpha;
            }
            pv_tile(vf, s0, s1, O0);
            softmax_tile(t0, t1, sc, m1, l1, alpha, lane);
            if (__builtin_amdgcn_ballot_w64(alpha != 1.f) != 0ull) {
#pragma unroll
                for (int mt = 0; mt < 2; ++mt)
#pragma unroll
                    for (int i = 0; i < 16; ++i) O1[mt][i] *= alpha;
            }
            pv_tile(vf, t0, t1, O1);
        }
        if (ti + 1 < ntl) {
            *(LAS u32x4*)(kbuf + (cur ^ 1) * ATT_TILEB + lrow * ATT_ROWB + lchunk * 16) = kr;
            *(LAS u32x4*)(vbuf + (cur ^ 1) * ATT_TILEB + lrow * ATT_ROWB + lchunk * 16) = vr;
        }
        kr = kn; vr = vn;
        __syncthreads();
    }
    l0 += shfl_x(l0, lane, 32);
    const float inv0 = 1.f / l0;
    LAS unsigned char* ob = lds + wave * 4608;
    if (!DIFF) {
#pragma unroll
        for (int mt = 0; mt < 2; ++mt)
#pragma unroll
            for (int g = 0; g < 4; ++g) {
                u32x2 w;
                w[0] = pack_bf2(O0[mt][4 * g] * inv0, O0[mt][4 * g + 1] * inv0);
                w[1] = pack_bf2(O0[mt][4 * g + 2] * inv0, O0[mt][4 * g + 3] * inv0);
                *(LAS u32x2*)(ob + r * 144 + (32 * mt + 8 * g + 4 * hh) * 2) = w;
            }
    } else {
        l1 += shfl_x(l1, lane, 32);
        const float inv1 = lam / l1;
        float ss = 0.f;
#pragma unroll
        for (int mt = 0; mt < 2; ++mt)
#pragma unroll
            for (int i = 0; i < 16; ++i) { const float o = O0[mt][i] * inv0 - O1[mt][i] * inv1; O0[mt][i] = o; ss += o * o; }
        ss += shfl_x(ss, lane, 32);
        const float rr = rsqrtf(ss * (1.f / 64.f) + EPS) * __builtin_bit_cast(float, __builtin_amdgcn_readfirstlane(__builtin_bit_cast(int, 1.f - lam_init_of(l))));
        const float* sg = p.in[I_SUBLN] + l * 64;
#pragma unroll
        for (int mt = 0; mt < 2; ++mt)
#pragma unroll
            for (int g = 0; g < 4; ++g) {
                const int d0 = 32 * mt + 8 * g + 4 * hh;
                const float4 gg = *reinterpret_cast<const float4*>(sg + d0);
                u32x2 w;
                w[0] = pack_bf2(O0[mt][4 * g] * rr * gg.x, O0[mt][4 * g + 1] * rr * gg.y);
                w[1] = pack_bf2(O0[mt][4 * g + 2] * rr * gg.z, O0[mt][4 * g + 3] * rr * gg.w);
                *(LAS u32x2*)(ob + r * 144 + d0 * 2) = w;
            }
    }
#pragma unroll
    for (int ps = 0; ps < 4; ++ps) {
        const int row = ps * 8 + (lane >> 3), ch = lane & 7;
        *reinterpret_cast<u32x4*>(Og + (size_t)(wave * 32 + row) * D + ch * 8) = *(const LAS u32x4*)(ob + row * 144 + ch * 16);
    }
}

namespace ga {
constexpr float C2 = 0.125f * 1.4426950408889634f;
constexpr int SLOTB = 8192, LDS_K = 0, LDS_V = 3 * SLOTB, LDS_WS = 6 * SLOTB, LDS_OST = LDS_WS + 8 * 256;
typedef __attribute__((address_space(3))) const char* lds_cptr;
typedef short v4i16_t __attribute__((ext_vector_type(4)));
using s16x4 = __attribute__((ext_vector_type(4))) short;
__device__ __forceinline__ int crow(int r, int hi) { return (r & 3) + 8 * (r >> 2) + 4 * hi; }
__device__ __forceinline__ void glds16(const void* g, unsigned lds_base) {
    unsigned sv; asm volatile("s_mov_b32 %0, m0\n\ts_mov_b32 m0, %2\n\ts_nop 0\n\tglobal_load_lds_dwordx4 %1, off\n\ts_mov_b32 m0, %0" : "=&s"(sv) : "v"(g), "s"(lds_base) : "memory"); }
__device__ __forceinline__ void kload2(bf16x8* kf, lds_cptr kp, int d0) { kf[2 * d0] = *(const LAS bf16x8*)(kp + d0 * 2048); kf[2 * d0 + 1] = *(const LAS bf16x8*)(kp + d0 * 2048 + 512); }
__device__ __forceinline__ s16x4 vtr(lds_cptr p) { return __builtin_bit_cast(s16x4, __builtin_amdgcn_ds_read_tr16_b64_v4i16((LAS v4i16_t*)p)); }
#define GA_MX3(a, b, c) __builtin_fmaxf(__builtin_fmaxf((a), (b)), (c))
__device__ __forceinline__ float rowmax(const f32x16& p0, const f32x16& p1) {
    float a = GA_MX3(p0[0], p0[1], p1[0]), b = GA_MX3(p0[2], p0[3], p1[1]); a = GA_MX3(a, p1[2], p1[3]);
#pragma unroll
    for (int r = 4; r < 16; r += 4) { a = GA_MX3(a, p0[r], p0[r + 1]); b = GA_MX3(b, p0[r + 2], p0[r + 3]); a = GA_MX3(a, p1[r], p1[r + 1]); b = GA_MX3(b, p1[r + 2], p1[r + 3]); }
    float m = __builtin_fmaxf(a, b); auto rr = __builtin_amdgcn_permlane32_swap(__float_as_uint(m), __float_as_uint(m), false, false);
    return __builtin_fmaxf(__uint_as_float(rr[0]), __uint_as_float(rr[1])); }
}
#define GA_SBAR() __builtin_amdgcn_sched_barrier(0)
#define GA_PIN(x) asm volatile("" : "+v"(x))
#define GA_WAIT_BAR(N) asm volatile("s_waitcnt vmcnt(" #N ") lgkmcnt(0)\n\ts_barrier" ::: "memory")
#define GA_THR 8
__device__ __forceinline__ void gqa_unit(LAS unsigned char* ldsl, const int tid, const int wid, const bf16_t* __restrict__ Qw0, const int qstride,
                                         const unsigned char* __restrict__ Kimg, const unsigned char* __restrict__ Vimg, const int NT, bf16_t* __restrict__ Og) {
    using namespace ga;
    const int lane = tid & 63, r32 = lane & 31, hi = lane >> 5;
    const bf16_t* Qw = Qw0 + (size_t)(wid * 32) * qstride;
    const unsigned lds0 = (unsigned)(size_t)ldsl; LAS float* wsf = (LAS float*)(ldsl + LDS_WS) + wid * 64;
    const unsigned char* ksrc = Kimg + wid * 1024 + lane * 16;
    const unsigned char* vsrc = Vimg + wid * 1024 + lane * 16;
    const unsigned kdst = lds0 + LDS_K + wid * 1024, vdst = lds0 + LDS_V + wid * 1024;
#define DMA_K(t, slot) glds16(ksrc + (size_t)(t) * SLOTB, (unsigned)__builtin_amdgcn_readfirstlane(kdst + (slot)))
#define DMA_V(t, slot) glds16(vsrc + (size_t)(t) * SLOTB, (unsigned)__builtin_amdgcn_readfirstlane(vdst + (slot)))
    const lds_cptr vp0 = (lds_cptr)ldsl + LDS_V + ((lane >> 4) & 1) * 32 + (lane & 3) * 8 + (4 * hi + ((lane & 15) >> 2)) * 64;
    const lds_cptr kp0 = (lds_cptr)ldsl + LDS_K + hi * 1024 + r32 * 16;
    DMA_K(0, 0); DMA_V(0, 0); DMA_K(1, SLOTB);
    bf16x8 qr[4];
#pragma unroll
    for (int d0 = 0; d0 < 4; ++d0) qr[d0] = *reinterpret_cast<const bf16x8*>(&Qw[(size_t)r32 * qstride + d0 * 16 + hi * 8]);
    float mhat = 0.f, l_reg = 0.f; f32x16 o[2];
#pragma unroll
    for (int i = 0; i < 16; ++i) { o[0][i] = 0.f; o[1][i] = 0.f; }
    f32x16 zero16;
#pragma unroll
    for (int i = 0; i < 16; ++i) zero16[i] = 0.f;
    GA_PIN(zero16);
    bool resc = false;
    f32x16 pA0, pA1, pB0, pB1; bf16x8 kf[8]; s16x4 vlo[8], vhi[8]; u32x4 pw0, pw1, pw2, pw3;
    int sl_prev = 0, sl_cur = 0, sl_next = SLOTB;
#define ROT() do { sl_prev = sl_cur; sl_cur = sl_next; sl_next = (sl_next == 2 * SLOTB) ? 0 : sl_next + SLOTB; } while (0)
#define EX(v) __builtin_amdgcn_exp2f(v)
#define RESC() do { if (resc) { _Pragma("unroll") for (int d_ = 0; d_ < 2; ++d_) _Pragma("unroll") for (int r = 0; r < 16; ++r) o[d_][r] *= wsf[crow(r, hi)]; } } while (0)
    DMA_K(2, 2 * SLOTB);
    GA_WAIT_BAR(3);
    _Pragma("unroll") for (int d0 = 0; d0 < 4; ++d0) kload2(kf, kp0, d0);
    pA0 = MFMA32(kf[0], qr[0], zero16); pA1 = MFMA32(kf[1], qr[0], zero16); pA0 = MFMA32(kf[2], qr[1], pA0); pA1 = MFMA32(kf[3], qr[1], pA1);
    pA0 = MFMA32(kf[4], qr[2], pA0); pA1 = MFMA32(kf[5], qr[2], pA1); pA0 = MFMA32(kf[6], qr[3], pA0); pA1 = MFMA32(kf[7], qr[3], pA1);
    { const float rm = rowmax(pA0, pA1); mhat = rm; const float nmh = -mhat;
#pragma unroll
      for (int r = 0; r < 16; ++r) { pA0[r] = EX(pA0[r] + nmh); pA1[r] = EX(pA1[r] + nmh); }
#pragma unroll
      for (int r = 0; r < 16; ++r) zero16[r] = nmh;
      GA_PIN(zero16); }
    GA_WAIT_BAR(0);
    DMA_K(3, 0); DMA_V(1, SLOTB); ROT();
    _Pragma("unroll") for (int d0 = 0; d0 < 4; ++d0) kload2(kf, kp0 + sl_cur, d0);
    GA_WAIT_BAR(2);
#define PKW(P, i) pack_bf2(P[i], P[i + 1])
#define PAF(k) __builtin_bit_cast(bf16x8, pw##k)
#define VFR(i) (bf16x8){vlo[i][0], vlo[i][1], vlo[i][2], vlo[i][3], vhi[i][0], vhi[i][1], vhi[i][2], vhi[i][3]}
#define VRD(i) do { vlo[i] = vtr(vp_ + (((i) >> 2) * 4096 + ((i) & 3) * 1024)); vhi[i] = vtr(vp_ + (((i) >> 2) * 4096 + ((i) & 3) * 1024 + 512)); } while (0)
#define KRD(G, d0) do { if (G) { kload2(kf, kp0 + sl_next, d0); GA_SBAR(); } } while (0)
#define GAPA(MF, a0, a1, a2, a3, W0, W1, PW) do { MF; sacc += a0; sacc += a1; sacc += a2; sacc += a3; W0; W1; GA_PIN(PW); GA_PIN(sacc); GA_SBAR(); } while (0)
#define GAPB(MF, X, i) do { MF; X[i] = EX(X[i]); X[i + 1] = EX(X[i + 1]); X[i + 2] = EX(X[i + 2]); X[i + 3] = EX(X[i + 3]); GA_PIN(X); GA_SBAR(); } while (0)
#define STEP(C0, C1, P0, P1, t, GK, GV, GL) do { GA_SBAR(); \
    const lds_cptr vp_ = vp0 + sl_prev; \
    VRD(0); GA_SBAR(); float sacc = P0[0] + P0[1]; \
                       GAPA(C0 = MFMA32(kf[0], qr[0], zero16), P0[2], P0[3], P0[4], P0[5],     pw0[0] = PKW(P0, 0),  pw0[1] = PKW(P0, 2),  pw0); \
    VRD(4); GA_SBAR(); GAPA(C1 = MFMA32(kf[1], qr[0], zero16), P0[6], P0[7], P0[8], P0[9],     pw0[2] = PKW(P0, 4),  pw0[3] = PKW(P0, 6),  pw0); \
    VRD(1); GA_SBAR(); GAPA(C0 = MFMA32(kf[2], qr[1], C0),    P0[10], P0[11], P0[12], P0[13], pw1[0] = PKW(P0, 8),  pw1[1] = PKW(P0, 10), pw1); \
    VRD(5); GA_SBAR(); GAPA(C1 = MFMA32(kf[3], qr[1], C1),    P0[14], P0[15], P1[0], P1[1],   pw1[2] = PKW(P0, 12), pw1[3] = PKW(P0, 14), pw1); \
    VRD(2); GA_SBAR(); GAPA(C0 = MFMA32(kf[4], qr[2], C0),    P1[2], P1[3], P1[4], P1[5],     pw2[0] = PKW(P1, 0),  pw2[1] = PKW(P1, 2),  pw2); \
    VRD(6); GA_SBAR(); GAPA(C1 = MFMA32(kf[5], qr[2], C1),    P1[6], P1[7], P1[8], P1[9],     pw2[2] = PKW(P1, 4),  pw2[3] = PKW(P1, 6),  pw2); \
    VRD(3); GA_SBAR(); GAPA(C0 = MFMA32(kf[6], qr[3], C0),    P1[10], P1[11], P1[12], P1[13], pw3[0] = PKW(P1, 8),  pw3[1] = PKW(P1, 10), pw3); \
    VRD(7); GA_SBAR(); GAPA(C1 = MFMA32(kf[7], qr[3], C1),    P1[14], P1[15], 0.f, 0.f,       pw3[2] = PKW(P1, 12), pw3[3] = PKW(P1, 14), pw3); \
    l_reg += sacc; \
    if (GK) DMA_K((t) + 3, sl_cur); if (GV) DMA_V((t) + 1, sl_next); \
    { const float rm = rowmax(C0, C1); resc = false;                                             \
      if (__builtin_expect(__any(rm > (float)GA_THR), 0)) { const float dl = __builtin_fmaxf(rm, 0.f); mhat += dl; \
          const float f = __builtin_amdgcn_exp2f(-dl); l_reg *= f; if (hi == 0) wsf[r32] = f; resc = true; \
          _Pragma("unroll") for (int r_ = 0; r_ < 16; ++r_) { C0[r_] -= dl; C1[r_] -= dl; zero16[r_] = -mhat; } GA_PIN(zero16); } } \
    GA_SBAR(); \
    GAPB(o[0] = MFMA32(PAF(0), VFR(0), o[0]), C0, 0);              GAPB(o[1] = MFMA32(PAF(0), VFR(4), o[1]), C0, 4); \
    KRD(GL, 0); GAPB(o[0] = MFMA32(PAF(1), VFR(1), o[0]), C0, 8);  KRD(GL, 1); GAPB(o[1] = MFMA32(PAF(1), VFR(5), o[1]), C0, 12); \
    KRD(GL, 2); GAPB(o[0] = MFMA32(PAF(2), VFR(2), o[0]), C1, 0);  KRD(GL, 3); GAPB(o[1] = MFMA32(PAF(2), VFR(6), o[1]), C1, 4); \
    GAPB(o[0] = MFMA32(PAF(3), VFR(3), o[0]), C1, 8);              GAPB(o[1] = MFMA32(PAF(3), VFR(7), o[1]), C1, 12); \
    } while (0)
    int t = 1;
    for (; t + 5 < NT; t += 2) {
        STEP(pB0, pB1, pA0, pA1, t, true, true, true);     GA_WAIT_BAR(2); RESC(); ROT();
        STEP(pA0, pA1, pB0, pB1, t + 1, true, true, true); GA_WAIT_BAR(2); RESC(); ROT();
    }
#define ENDW(tt) do { if ((tt) + 3 < NT) { GA_WAIT_BAR(2); } else if ((tt) + 2 < NT) { GA_WAIT_BAR(1); } else { GA_WAIT_BAR(0); } } while (0)
    for (; t + 1 < NT; t += 2) {
        STEP(pB0, pB1, pA0, pA1, t, (t + 3 < NT), (t + 1 < NT), (t + 1 < NT));         ENDW(t);     RESC(); ROT();
        STEP(pA0, pA1, pB0, pB1, t + 1, (t + 4 < NT), (t + 2 < NT), (t + 2 < NT));     ENDW(t + 1); RESC(); ROT();
    }
    STEP(pB0, pB1, pA0, pA1, NT - 1, false, false, false); RESC();
    { float sacc = pB0[0] + pB0[1];
#pragma unroll
      for (int r = 2; r < 16; ++r) sacc += pB0[r];
#pragma unroll
      for (int r = 0; r < 16; ++r) sacc += pB1[r];
      l_reg += sacc;
      pw0 = (u32x4){PKW(pB0, 0), PKW(pB0, 2), PKW(pB0, 4), PKW(pB0, 6)}; pw1 = (u32x4){PKW(pB0, 8), PKW(pB0, 10), PKW(pB0, 12), PKW(pB0, 14)};
      pw2 = (u32x4){PKW(pB1, 0), PKW(pB1, 2), PKW(pB1, 4), PKW(pB1, 6)}; pw3 = (u32x4){PKW(pB1, 8), PKW(pB1, 10), PKW(pB1, 12), PKW(pB1, 14)};
      const lds_cptr vp_ = vp0 + sl_cur; _Pragma("unroll") for (int i = 0; i < 8; ++i) VRD(i);
      o[0] = MFMA32(PAF(0), VFR(0), o[0]); o[1] = MFMA32(PAF(0), VFR(4), o[1]); o[0] = MFMA32(PAF(1), VFR(1), o[0]); o[1] = MFMA32(PAF(1), VFR(5), o[1]);
      o[0] = MFMA32(PAF(2), VFR(2), o[0]); o[1] = MFMA32(PAF(2), VFR(6), o[1]); o[0] = MFMA32(PAF(3), VFR(3), o[0]); o[1] = MFMA32(PAF(3), VFR(7), o[1]); }
    { auto rr = __builtin_amdgcn_permlane32_swap(__float_as_uint(l_reg), __float_as_uint(l_reg), false, false); l_reg = __uint_as_float(rr[0]) + __uint_as_float(rr[1]); }
    if (hi == 0) wsf[32 + r32] = l_reg;
    asm volatile("s_waitcnt lgkmcnt(0)" ::: "memory");
    float rli[16];
#pragma unroll
    for (int r = 0; r < 16; ++r) rli[r] = __builtin_amdgcn_rcpf(wsf[32 + crow(r, hi)]);
    bf16_t* Ow = Og + (size_t)(wid * 32) * D; LAS bf16_t* stg = (LAS bf16_t*)(ldsl + LDS_OST) + wid * 2048;
#pragma unroll
    for (int r = 0; r < 16; ++r) { const int orow = crow(r, hi);
#pragma unroll
        for (int d0 = 0; d0 < 2; ++d0) stg[orow * 64 + d0 * 32 + r32] = f2bf(o[d0][r] * rli[r]); }
    asm volatile("s_waitcnt lgkmcnt(0)" ::: "memory");
#pragma unroll
    for (int i = 0; i < 4; ++i) { const int row = i * 8 + (lane >> 3), ch = lane & 7; *reinterpret_cast<u32x4*>(Ow + (size_t)row * D + ch * 8) = *(const LAS u32x4*)(stg + row * 64 + ch * 8); }
    asm volatile("s_waitcnt lgkmcnt(0)\n\ts_barrier" ::: "memory");
#undef DMA_K
#undef DMA_V
#undef ROT
#undef EX
#undef RESC
#undef PKW
#undef PAF
#undef VFR
#undef VRD
#undef KRD
#undef ENDW
#undef GAPA
#undef GAPB
#undef STEP
}

constexpr int SGU_ROWB = 272;
__device__ __forceinline__ void sgu_item(const Params& p, int l, LAS unsigned char* lds, const int tid, const int t0) {
    const bf16_t* AV = (const bf16_t*)(p.ws + OFF_AV) + (size_t)t0 * 256;
    {
        const int q = tid >> 2, quarter = tid & 3;
        float v[64]; float ss = 0.f;
#pragma unroll
        for (int i = 0; i < 8; ++i) {
            const bf16x8 w = *reinterpret_cast<const bf16x8*>(AV + (size_t)q * 256 + quarter * 64 + i * 8);
#pragma unroll
            for (int j = 0; j < 8; ++j) { v[i * 8 + j] = bf2f((bf16_t)w[j]); ss += v[i * 8 + j] * v[i * 8 + j]; }
        }
        { const int ln = tid & 63; ss += shfl_x(ss, ln, 1); ss += shfl_x(ss, ln, 2); }
        const float rstd = rsqrtf(ss * (1.f / 256.f) + EPS);
        const float* g = p.in[I_SGUNG] + l * 256 + quarter * 64;
#pragma unroll
        for (int i = 0; i < 64; ++i)
            *(LAS bf16_t*)(lds + (quarter * 64 + i) * SGU_ROWB + q * 2) = f2bf(v[i] * rstd * g[i]);
    }
    __syncthreads();
    {
        const int wave = tid >> 6, lane = tid & 63, r = lane & 31, hh = lane >> 5;
        const int g = wave >> 1, ph = wave & 1;
        const bf16_t* W = (const bf16_t*)(p.ws + OFF_SGUW) + ((size_t)l * 4 + g) * 128 * 128;
        f32x16 acc[2][2];
#pragma unroll
        for (int a = 0; a < 2; ++a)
#pragma unroll
            for (int b = 0; b < 2; ++b)
#pragma unroll
                for (int i = 0; i < 16; ++i) acc[a][b][i] = 0.f;
#pragma unroll
        for (int ks = 0; ks < 8; ++ks) {
            bf16x8 af[2], bfr[2];
#pragma unroll
            for (int pt = 0; pt < 2; ++pt) af[pt] = *reinterpret_cast<const bf16x8*>(W + (size_t)(ph * 64 + pt * 32 + r) * 128 + ks * 16 + hh * 8);
#pragma unroll
            for (int ct = 0; ct < 2; ++ct) bfr[ct] = *(const LAS bf16x8*)(lds + (g * 64 + ct * 32 + r) * SGU_ROWB + (ks * 16 + hh * 8) * 2);
#pragma unroll
            for (int pt = 0; pt < 2; ++pt)
#pragma unroll
                for (int ct = 0; ct < 2; ++ct) acc[pt][ct] = MFMA32(af[pt], bfr[ct], acc[pt][ct]);
        }
        const float* bias = p.in[I_SGUB] + (l * 4 + g) * 128;
        const bf16_t* AU = (const bf16_t*)(p.ws + OFF_AU);
        bf16_t* MIX = (bf16_t*)(p.ws + OFF_MIX);
#pragma unroll
        for (int pt = 0; pt < 2; ++pt)
#pragma unroll
            for (int ct = 0; ct < 2; ++ct)
#pragma unroll
                for (int i = 0; i < 16; ++i) {
                    const int pp = ph * 64 + pt * 32 + (i & 3) + 8 * (i >> 2) + 4 * hh, c = g * 64 + ct * 32 + r;
                    const float au = bf2f(AU[(size_t)(t0 + pp) * 256 + c]);
                    MIX[(size_t)(t0 + pp) * D + c] = f2bf(au * (acc[pt][ct][i] + bias[pp]));
                }
    }
    __syncthreads();
}

__device__ __forceinline__ void conv_item(const Params& p, const int c, LAS unsigned char* lds, const int tid) {
    const int wave = tid >> 6, lane = tid & 63;
    const bool isu = c < 256;
    const int row00 = (c & 255) * 128, lyr = row00 >> 14;
    const float* src = p.in[isu ? I_PU : I_PV] + (size_t)(row00 + wave * 16) * D + lane * 16;
    unsigned char* dst = p.ws + (isu ? OFF_UT : OFF_VT);
    float* scl = (float*)(p.ws + OFF_USH) + (isu ? 0 : 1);
    float4 f[4][4], g[4][4];
#pragma unroll
    for (int q = 0; q < 4; ++q)
#pragma unroll
        for (int i = 0; i < 4; ++i) f[q][i] = *reinterpret_cast<const float4*>(src + (size_t)q * D + i * 4);
#pragma unroll
    for (int step = 0; step < 4; ++step) {
        if (step < 3) {
#pragma unroll
            for (int q = 0; q < 4; ++q)
#pragma unroll
                for (int i = 0; i < 4; ++i) g[q][i] = *reinterpret_cast<const float4*>(src + (size_t)((step + 1) * 4 + q) * D + i * 4);
        }
        const int row0 = row00 + wave * 16 + step * 4;
#pragma unroll
        for (int q = 0; q < 4; ++q) {
            const int row = row0 + q, e = row & (NEXP - 1);
            float v[16];
#pragma unroll
            for (int i = 0; i < 4; ++i) { v[i * 4] = f[q][i].x; v[i * 4 + 1] = f[q][i].y; v[i * 4 + 2] = f[q][i].z; v[i * 4 + 3] = f[q][i].w; }
            float am = 0.f;
#pragma unroll
            for (int i = 0; i < 16; ++i) am = fmaxf(am, fabsf(v[i]));
            am = wave_max(am);
            const float sc = am > 0.f ? 127.f / am : 1.f;
            unsigned w[4];
#pragma unroll
            for (int i = 0; i < 4; ++i) w[i] = pack4_i8(q8(v[i * 4] * sc), q8(v[i * 4 + 1] * sc), q8(v[i * 4 + 2] * sc), q8(v[i * 4 + 3] * sc));
            *reinterpret_cast<u32x4*>(dst + (((size_t)lyr * 8 + (lane >> 3)) * NEXP + e) * 128 + (lane & 7) * 16) = u32x4{w[0], w[1], w[2], w[3]};
            if (lane == 0) scl[(size_t)row * 8] = am > 0.f ? am * (1.f / 127.f) : 1.f;
        }
        if (step < 3) {
#pragma unroll
            for (int q = 0; q < 4; ++q)
#pragma unroll
                for (int i = 0; i < 4; ++i) f[q][i] = g[q][i];
        }
    }
}

__device__ void ph_mixers(const Params& p, int lq, unsigned char* ldsraw, const int wv) {
    const int l = lq & 1;
    const int tid0 = opaque_tid(wv);
    LAS unsigned char* lds = (LAS unsigned char*)ldsraw;
    volatile LAS int* qslot = (volatile LAS int*)(ldsraw - LDS_HDR + 64);
    unsigned* qw = (unsigned*)(p.ws + OFF_BAR) + QW_MIX + lq;
    const float lam = __builtin_bit_cast(float, __builtin_amdgcn_readfirstlane(__builtin_bit_cast(int, lam_of(p, l))));
    unsigned char* ws = p.ws;
    for (;;) {
        if (tid0 == 0) *qslot = (int)atomicAdd(qw, 1u);
        __syncthreads();
        int item = *qslot;
        __syncthreads();
        if (lq == 0) {
            if (item >= 1536) break;
            const int grp = item / 3, pos = item - grp * 3;
            if (pos == 2) { int tidc = tid0; asm volatile("" : "+v"(tidc)); conv_item(p, grp, lds, tidc); continue; }
            item = grp * 2 + pos;
            if (item >= 896) continue;
        }
        if (item >= 896) break;
        if (lq >= 2 && PROBE_DUP >= 10) {
            const int cls = item < 128 ? 10 : (item < 384 ? 11 : 12);
            if (cls != PROBE_DUP) continue;
        }
        int tid = tid0; asm volatile("" : "+v"(tid));
        if (item < 128) {
            const int qc = item & 7, h = (item >> 3) & 3, b = item >> 5;
            const int t0 = NPT + b * DSEQ + qc * 256;
            attn_item<true>(p, l, lds, tid, (const bf16_t*)(ws + OFF_DQ) + (size_t)t0 * 256 + h * 64, 256,
                            (const bf16_t*)(ws + OFF_DKS) + ((size_t)b * 4 + h) * NKS * 64, (const bf16_t*)(ws + OFF_DVTS) + ((size_t)b * 4 + h) * 64 * NKS, NKS,
                            (bf16_t*)(ws + OFF_MIX) + (size_t)t0 * D + 256 + h * 64, lam);
        } else if (item < 384) {
            const int it = item - 128, qc = it & 7, hq = (it >> 3) & 7, b = it >> 6, kv = hq >> 2;
            const int t0 = NPT + b * DSEQ + qc * 256;
            gqa_unit(lds, tid, wv, (const bf16_t*)(ws + OFF_GQ) + (size_t)t0 * 512 + hq * 64, 512,
                     ws + OFF_GKS + ((size_t)b * 2 + kv) * NKS * 128, ws + OFF_GVTS + ((size_t)b * 2 + kv) * NKS * 128, NKS / 64,
                     (bf16_t*)(ws + OFF_MIX) + (size_t)t0 * D + 512 + hq * 64);
        } else if (item < 512) {
            sgu_item(p, l, lds, tid, (item - 384) * 128);
        } else if (item < 768) {
            const int it = item - 512, hq = it & 7, b = it >> 3, kv = hq >> 2;
            const int t0 = b * SEQ;
            gqa_unit(lds, tid, wv, (const bf16_t*)(ws + OFF_GQ) + (size_t)t0 * 512 + hq * 64, 512,
                     ws + OFF_GKP + ((size_t)b * 2 + kv) * SEQ * 128, ws + OFF_GVTP + ((size_t)b * 2 + kv) * SEQ * 128, SEQ / 64,
                     (bf16_t*)(ws + OFF_MIX) + (size_t)t0 * D + 512 + hq * 64);
        } else {
            const int it = item - 768, h = it & 3, b = it >> 2;
            const int t0 = b * SEQ;
            attn_item<true>(p, l, lds, tid, (const bf16_t*)(ws + OFF_DQ) + (size_t)t0 * 256 + h * 64, 256,
                            (const bf16_t*)(ws + OFF_DKP) + ((size_t)b * 4 + h) * SEQ * 64, (const bf16_t*)(ws + OFF_DVTP) + ((size_t)b * 4 + h) * 64 * SEQ, SEQ,
                            (bf16_t*)(ws + OFF_MIX) + (size_t)t0 * D + 256 + h * 64, lam);
        }
    }
}


using bf16x2 = __attribute__((ext_vector_type(2))) __bf16;
__device__ __forceinline__ float dot2bf(unsigned a, unsigned b, float c) {
    return __builtin_amdgcn_fdot2_f32_bf16(__builtin_bit_cast(bf16x2, a), __builtin_bit_cast(bf16x2, b), c, false);
}
template <int W>
__device__ __forceinline__ void bfly_stage(float (&part)[64], const int lane) {
    const bool hi = (lane & W) != 0;
#pragma unroll
    for (int k = 0; k < W; ++k) {
        const float keep = hi ? part[k + W] : part[k];
        const float send = hi ? part[k] : part[k + W];
        part[k] = keep + shfl_x(send, lane, W);
    }
}
constexpr int QW_PEER = 4160;
template <int W>
__device__ __forceinline__ void bfly16_stage(float (&v)[16], const int lane, const int bit) {
    const bool hi = (lane & bit) != 0;
#pragma unroll
    for (int k = 0; k < W; ++k) {
        const float keep = hi ? v[k + W] : v[k];
        const float send = hi ? v[k] : v[k + W];
        v[k] = keep + shfl_x(send, lane, bit);
    }
}
template <int W>
__device__ __forceinline__ void bfly16i_stage(int (&v)[16], const int lane, const int bit) {
    const bool hi = (lane & bit) != 0;
#pragma unroll
    for (int k = 0; k < W; ++k) {
        const int keep = hi ? v[k + W] : v[k];
        const int send = hi ? v[k] : v[k + W];
        v[k] = keep + shfl_x(send, lane, bit);
    }
}
template <bool VSIDE> struct PeerTok {
    static __device__ __forceinline__ void issue(const Params& p, const unsigned char* Tslice, const int elo, const int ehi, const int t, const int s,
                                                 const int sub, const int c16, u32x4 (&a)[16], u32x4 (&h)[2]) {
#pragma unroll
        for (int i = 0; i < 16; ++i) {
            const int e = shfl_i(i < 8 ? elo : ehi, (i * 8 + sub) & 63);
            a[i] = *reinterpret_cast<const u32x4*>(Tslice + (((unsigned)e << 7) + (unsigned)c16 * 16u));
        }
        if (!VSIDE) h[0] = *reinterpret_cast<const u32x4*>(p.ws + OFF_H8I + (size_t)t * D + s * 128 + c16 * 16);
    }
    static __device__ __forceinline__ void compute(const Params& p, const int l, const u32x4 w4, const float wsc, const int t, const int s,
                                                   const int lane, const int sub, const int c16, const u32x4 (&a)[16], const u32x4 (&h)[2]) {
        if (!VSIDE) {
            int d[16];
#pragma unroll
            for (int i = 0; i < 16; ++i) {
                int acc = 0;
#pragma unroll
                for (int k = 0; k < 4; ++k) acc = __builtin_amdgcn_sdot4((int)a[i][k], (int)h[0][k], acc, false);
                d[i] = acc;
            }
            bfly16i_stage<8>(d, lane, 4); bfly16i_stage<4>(d, lane, 2); bfly16i_stage<2>(d, lane, 1);
            const int i0 = ((lane & 4) << 1) + ((lane & 2) << 1) + ((lane & 1) << 1);
            unsigned* PART = (unsigned*)(p.ws + OFF_PART) + (((size_t)s * NTOK + t) * 128 + sub * 16 + i0) / 2;
            *PART = ((unsigned)((d[0] + 32) >> 6) & 0xffffu) | ((unsigned)((d[1] + 32) >> 6) << 16);
        } else {
            int acc[16];
#pragma unroll
            for (int i = 0; i < 16; ++i) acc[i] = 0;
#pragma unroll
            for (int g = 0; g < 4; ++g) {
                const int wg = (int)w4[g];
#pragma unroll
                for (int k = 0; k < 4; ++k) {
                    const unsigned r0 = a[4 * g][k], r1 = a[4 * g + 1][k], r2 = a[4 * g + 2][k], r3 = a[4 * g + 3][k];
                    const unsigned x01l = __builtin_amdgcn_perm(r1, r0, 0x05010400u), x01h = __builtin_amdgcn_perm(r1, r0, 0x07030602u);
                    const unsigned x23l = __builtin_amdgcn_perm(r3, r2, 0x05010400u), x23h = __builtin_amdgcn_perm(r3, r2, 0x07030602u);
                    const unsigned t0 = __builtin_amdgcn_perm(x23l, x01l, 0x05040100u), t1 = __builtin_amdgcn_perm(x23l, x01l, 0x07060302u);
                    const unsigned t2 = __builtin_amdgcn_perm(x23h, x01h, 0x05040100u), t3 = __builtin_amdgcn_perm(x23h, x01h, 0x07060302u);
                    acc[4 * k]     = __builtin_amdgcn_sdot4((int)t0, wg, acc[4 * k], false);
                    acc[4 * k + 1] = __builtin_amdgcn_sdot4((int)t1, wg, acc[4 * k + 1], false);
                    acc[4 * k + 2] = __builtin_amdgcn_sdot4((int)t2, wg, acc[4 * k + 2], false);
                    acc[4 * k + 3] = __builtin_amdgcn_sdot4((int)t3, wg, acc[4 * k + 3], false);
                }
            }
            bfly16i_stage<8>(acc, lane, 32); bfly16i_stage<4>(acc, lane, 16); bfly16i_stage<2>(acc, lane, 8);
            const int col = s * 128 + c16 * 16 + ((lane & 32) >> 2) + ((lane & 16) >> 2) + ((lane & 8) >> 2);
            const float* g2 = (const float*)(p.ws + OFF_MOD) + (size_t)(l * 5 + tok_cv(t)) * 6144 + 5 * 1024 + col;
            unsigned* XC = reinterpret_cast<unsigned*>((bf16_t*)(p.ws + OFF_XC) + (size_t)t * D + col);
            const unsigned x = *XC; const float2 g = *reinterpret_cast<const float2*>(g2);
            const float xa = __uint_as_float(x << 16) + g.x * wsc * (float)acc[0], xb = __uint_as_float(x & 0xffff0000u) + g.y * wsc * (float)acc[1];
            *XC = pack_bf2(xa, xb);
            if (l == 0) {
                const float ss = wave_sum(xa * xa + xb * xb);
                if (lane == 0) ((float*)(p.ws + OFF_RSS1))[(size_t)t * 8 + s] = ss;
            }
        }
    }
};
template <bool VSIDE>
__device__ __forceinline__ void peer_slice_stream(const Params& p, const int l, const int s, const int first, const int stride, const int lane) {
    const int sub = lane >> 3, c16 = lane & 7;
    const unsigned char* Ts = p.ws + (VSIDE ? OFF_VT : OFF_UT) + ((size_t)l * 8 + s) * NEXP * 128;
    const int* EIb = (const int*)(p.ws + OFF_EIDX); const unsigned char* WPb = p.ws + OFF_WPAIR; const float* WSb = (const float*)(p.ws + OFF_WSC);
    if (first >= NTOK) return;
    const int cnt = (NTOK - first + stride - 1) / stride;
#define PEER_LOADE(k, elo, ehi, w4, wsc) do { const int _t = min(first + (k) * stride, NTOK - 1); \
        elo = EIb[(size_t)_t * 128 + lane]; ehi = EIb[(size_t)_t * 128 + 64 + lane]; \
        if (VSIDE) { w4 = *reinterpret_cast<const u32x4*>(WPb + (size_t)_t * 128 + sub * 16); wsc = WSb[_t]; } } while (0)
    int e0l, e0h, e1l, e1h, e2l, e2h;
    u32x4 w0 = {0u, 0u, 0u, 0u}, w1 = {0u, 0u, 0u, 0u}, w2 = {0u, 0u, 0u, 0u}; float s0 = 0.f, s1 = 0.f, s2 = 0.f;
    u32x4 A[16], B[16], hA[2], hB[2];
    PEER_LOADE(0, e0l, e0h, w0, s0);
    PEER_LOADE(1, e1l, e1h, w1, s1);
    PeerTok<VSIDE>::issue(p, Ts, e0l, e0h, first, s, sub, c16, A, hA);
    for (int k = 0; k < cnt; k += 2) {
        const int ta = first + k * stride, tb = min(ta + stride, NTOK - 1), tc = min(ta + 2 * stride, NTOK - 1);
        __builtin_amdgcn_sched_barrier(0);
        PEER_LOADE(k + 2, e2l, e2h, w2, s2);
        PeerTok<VSIDE>::issue(p, Ts, e1l, e1h, tb, s, sub, c16, B, hB);
        __builtin_amdgcn_sched_barrier(0);
        PeerTok<VSIDE>::compute(p, l, w0, s0, ta, s, lane, sub, c16, A, hA);
        __builtin_amdgcn_sched_barrier(0);
        e0l = e2l; e0h = e2h; w0 = w2; s0 = s2;
        PEER_LOADE(k + 3, e2l, e2h, w2, s2);
        PeerTok<VSIDE>::issue(p, Ts, e0l, e0h, tc, s, sub, c16, A, hA);
        __builtin_amdgcn_sched_barrier(0);
        if (k + 1 < cnt) PeerTok<VSIDE>::compute(p, l, w1, s1, tb, s, lane, sub, c16, B, hB);
        e1l = e2l; e1h = e2h; w1 = w2; s1 = s2;
    }
#undef PEER_LOADE
}
template <bool VSIDE>
__device__ void ph_peer_sliced(const Params& p, int l, unsigned char* ldsraw, const int wv) {
    const int tid = opaque_tid(wv);
    const int wave = tid >> 6, lane = tid & 63;
    volatile LAS int* hdr = (volatile LAS int*)(ldsraw - LDS_HDR);
    unsigned* bar = (unsigned*)(p.ws + OFF_BAR);
    const int myx = (int)(xb_xcc_id() & 15u);
    if (tid == 0) hdr[16] = (int)atomicAdd(bar + QW_PEER + (l * 2 + (VSIDE ? 1 : 0)) * 16 + myx, 1u);
    __syncthreads();
    const int rank = hdr[16], nloc = (int)hdr[0];
    __syncthreads();
    if (myx < 8) peer_slice_stream<VSIDE>(p, l, myx, rank * 8 + wave, nloc * 8, lane);
    for (int j = 0; j < 8; ++j) {
        if (xb_ld(&bar[XB_XCNT(j)]) == 0u) peer_slice_stream<VSIDE>(p, l, j, (int)blockIdx.x * 8 + wave, (int)gridDim.x * 8, lane);
    }
}
__device__ void ph_peer_pairw(const Params& p, int l, const int wv) {
    const int tid = opaque_tid(wv);
    const int lane = tid & 63;
    const float* EREC = (const float*)(p.ws + OFF_USH) + (size_t)l * NEXP * 8;
    const unsigned short* PART = (const unsigned short*)(p.ws + OFF_PART);
    constexpr size_t NIT = (size_t)NTOK * 32;
    for (size_t i4 = GTID; i4 < NIT; i4 += 2 * GNT) {
        size_t idx[2]; int t[2], e[2][4]; float g[2][4]; uint2 ps[2][8]; float4 ra[2], rb[2], xa[2], xb[2];
#pragma unroll
        for (int u = 0; u < 2; ++u) {
            const size_t iu = i4 + (size_t)u * GNT < NIT ? i4 + (size_t)u * GNT : i4;
            idx[u] = iu * 4; t[u] = (int)(idx[u] >> 7);
            const int pp = (int)(idx[u] & 127), sub = pp >> 4, i = pp & 15;
#pragma unroll
            for (int s = 0; s < 8; ++s) ps[u][s] = *reinterpret_cast<const uint2*>(PART + (size_t)s * NTOK * 128 + idx[u]);
#pragma unroll
            for (int q = 0; q < 4; ++q) {
                const int j = (i + q) * 8 + sub;
                e[u][q] = ((const int*)(p.ws + OFF_EIDX))[(size_t)t[u] * 128 + j]; g[u][q] = ((const float*)(p.ws + OFF_EGATE))[(size_t)t[u] * 128 + j];
            }
            const float* rp = (const float*)(p.ws + OFF_RSS2) + ((size_t)l * NTOK + t[u]) * 8;
            ra[u] = *reinterpret_cast<const float4*>(rp); rb[u] = *reinterpret_cast<const float4*>(rp + 4);
            const float* xp = (const float*)(p.ws + OFF_XGS) + (size_t)t[u] * 8;
            xa[u] = *reinterpret_cast<const float4*>(xp); xb[u] = *reinterpret_cast<const float4*>(xp + 4);
        }
        float4 r0[2][4], r1[2][4];
#pragma unroll
        for (int u = 0; u < 2; ++u)
#pragma unroll
            for (int q = 0; q < 4; ++q) {
                const float* rec = EREC + (size_t)e[u][q] * 8;
                r0[u][q] = *reinterpret_cast<const float4*>(rec); r1[u][q] = *reinterpret_cast<const float4*>(rec + 4);
            }
#pragma unroll
        for (int u = 0; u < 2; ++u) {
            const float hs = rsqrtf((((ra[u].x + ra[u].y) + (ra[u].z + ra[u].w)) + ((rb[u].x + rb[u].y) + (rb[u].z + rb[u].w))) * (1.f / D) + EPS);
            const float xs[8] = {xa[u].x, xa[u].y, xa[u].z, xa[u].w, xb[u].x, xb[u].y, xb[u].z, xb[u].w};
            float sm[4] = {0.f, 0.f, 0.f, 0.f};
#pragma unroll
            for (int s = 0; s < 8; ++s) {
                const uint2 w = ps[u][s];
                sm[0] += xs[s] * (float)((int)(w.x << 16) >> 16); sm[1] += xs[s] * (float)((int)w.x >> 16);
                sm[2] += xs[s] * (float)((int)(w.y << 16) >> 16); sm[3] += xs[s] * (float)((int)w.y >> 16);
            }
            const int cvt = tok_cv(t[u]);
            float w[4];
#pragma unroll
            for (int q = 0; q < 4; ++q) {
                const float4 ra4 = r0[u][q], rb4 = r1[u][q];
                const float ush = cvt == 0 ? ra4.z : (cvt == 1 ? ra4.w : (cvt == 2 ? rb4.x : (cvt == 3 ? rb4.y : rb4.z)));
                w[q] = g[u][q] * gelu_f(sm[q] * 64.f * (ra4.x * hs) + ush) * ra4.y;
            }
            float am = fmaxf(fmaxf(fabsf(w[0]), fabsf(w[1])), fmaxf(fabsf(w[2]), fabsf(w[3])));
            am = row16_max(am); am = fmaxf(am, shfl_x(am, lane, 16));
            const float sc = am > 0.f ? 127.f / am : 1.f;
            *reinterpret_cast<unsigned*>(p.ws + OFF_WPAIR + idx[u]) = pack4_i8(q8(w[0] * sc), q8(w[1] * sc), q8(w[2] * sc), q8(w[3] * sc));
            if ((idx[u] & 127) == 0) ((float*)(p.ws + OFF_WSC))[t[u]] = am > 0.f ? am * (1.f / 127.f) : 1.f;
        }
    }
}

#define CE_DESC(a, b) do { const float _mx = fmaxf((a), (b)); const float _mn = fminf((a), (b)); (a) = _mx; (b) = _mn; } while (0)
__device__ __forceinline__ void sort16_desc(float (&v)[16]) {
#pragma unroll
    for (int k = 2; k <= 16; k <<= 1)
#pragma unroll
        for (int j = k >> 1; j > 0; j >>= 1)
#pragma unroll
            for (int i = 0; i < 16; ++i) {
                const int m = i ^ j;
                if (m > i) { if ((i & k) == 0) CE_DESC(v[i], v[m]); else CE_DESC(v[m], v[i]); }
            }
}
__device__ __forceinline__ void merge_top16(float (&a)[16], const float (&b)[16]) {
#pragma unroll
    for (int i = 0; i < 16; ++i) a[i] = fmaxf(a[i], b[15 - i]);
#pragma unroll
    for (int j = 8; j > 0; j >>= 1)
#pragma unroll
        for (int i = 0; i < 16; ++i) { const int m = i ^ j; if (m > i) CE_DESC(a[i], a[m]); }
}
__device__ __forceinline__ float key_embed(float v, unsigned lowmask, unsigned idxbits) { return __uint_as_float((__float_as_uint(v) & ~lowmask) | idxbits); }

constexpr int SK_ROWB = 144;
__device__ __forceinline__ void peer_stage1(const LAS unsigned char* SK  , const bf16_t* __restrict__ Qrow  ,
                                            const int r, const int hh, float (&out)[16]) {
    bf16x8 qb[4];
#pragma unroll
    for (int ks = 0; ks < 4; ++ks) qb[ks] = *reinterpret_cast<const bf16x8*>(Qrow + ks * 16 + hh * 8);
    float grp[4][16];
#pragma unroll
    for (int mt = 0; mt < 4; ++mt) {
        f32x16 acc;
#pragma unroll
        for (int i = 0; i < 16; ++i) acc[i] = 0.f;
#pragma unroll
        for (int ks = 0; ks < 4; ++ks) {
            const bf16x8 a = *(const LAS bf16x8*)(SK + (mt * 32 + r) * SK_ROWB + (ks * 16 + hh * 8) * 2);
            acc = MFMA32(a, qb[ks], acc);
        }
        const unsigned hx = (unsigned)hh << 2;
#pragma unroll
        for (int i = 0; i < 16; ++i) {
            const unsigned cn = 32u * mt + (i & 3) + 8u * (i >> 2);
            grp[mt][i] = key_embed(acc[i], 127u, (127u - cn) ^ hx);
        }
        sort16_desc(grp[mt]);
    }
    merge_top16(grp[0], grp[1]); merge_top16(grp[2], grp[3]); merge_top16(grp[0], grp[2]);
    float pb[16];
#pragma unroll
    for (int i = 0; i < 16; ++i) pb[i] = shfl_x(grp[0][i], (hh << 5) | r, 32);
    merge_top16(grp[0], pb);
#pragma unroll
    for (int i = 0; i < 16; ++i) out[i] = grp[0][i];
}

__device__ void ph_peer_select(const Params& p, int l, unsigned char* ldsraw, const int wv) {
    const int tid = opaque_tid(wv);
    const int wave = tid >> 6, lane = tid & 63, r = lane & 31, hh = lane >> 5;
    const int gw = blockIdx.x * 8 + wave, nw = gridDim.x * 8;
    LAS unsigned char* skl = (LAS unsigned char*)ldsraw;
    LAS unsigned char* myl = skl + 2 * 128 * SK_ROWB + wave * 2048 + lane * 32;
    {
        const bf16_t* SKg = (const bf16_t*)(p.ws + OFF_SUBK) + (size_t)l * 2 * 128 * 64;
        for (int i = tid; i < 2 * 128 * 8; i += NT) {
            const int row = i >> 3, ch = i & 7;
            *(LAS u32x4*)(skl + row * SK_ROWB + ch * 16) = *reinterpret_cast<const u32x4*>(SKg + (size_t)row * 64 + ch * 8);
        }
        __syncthreads();
    }
    for (int task = gw; task < (NTOK / 32) * 4; task += nw) {
        const int tg = task >> 2, k = task & 3;
        const int t = tg * 32 + r;
        const bf16_t* Qt = (const bf16_t*)(p.ws + OFF_Q) + (size_t)t * D;
        float sv[2][16];
#pragma unroll
        for (int x = 0; x < 2; ++x) {
            float la[16], lb[16];
            peer_stage1(skl + x * 128 * SK_ROWB, Qt + k * 128 + x * 64, r, hh, la);
            peer_stage1(skl + x * 128 * SK_ROWB, Qt + (k + 4) * 128 + x * 64, r, hh, lb);
#pragma unroll
            for (int i = 0; i < 16; ++i) sv[x][i] = hh ? lb[i] : la[i];
        }
        {
            unsigned w[8];
#pragma unroll
            for (int q = 0; q < 8; ++q) {
                w[q] = 0u;
#pragma unroll
                for (int b = 0; b < 4; ++b) {
                    const int i = q * 4 + b;
                    const unsigned key = __float_as_uint(i < 16 ? sv[0][i] : sv[1][i - 16]);
                    w[q] |= (127u - (key & 127u)) << (8 * b);
                }
            }
            *(LAS u32x4*)(myl) = u32x4{w[0], w[1], w[2], w[3]};
            *(LAS u32x4*)(myl + 16) = u32x4{w[4], w[5], w[6], w[7]};
        }
        float val0[16], val1[16];
#pragma unroll
        for (int i = 0; i < 16; ++i) { val0[i] = __uint_as_float(__float_as_uint(sv[0][i]) & ~127u); val1[i] = __uint_as_float(__float_as_uint(sv[1][i]) & ~127u); }
        float g0[16], g1[16], g2[16], g3[16];
#pragma unroll
        for (int b = 0; b < 16; ++b) g0[b] = key_embed(val0[0] + val1[b], 255u, 255u - (unsigned)b);
#pragma unroll
        for (int b = 0; b < 8; ++b) g1[b] = key_embed(val0[1] + val1[b], 255u, 255u - (16u + b));
#pragma unroll
        for (int b = 0; b < 5; ++b) g1[8 + b] = key_embed(val0[2] + val1[b], 255u, 255u - (32u + b));
#pragma unroll
        for (int b = 0; b < 3; ++b) g1[13 + b] = key_embed(val0[4] + val1[b], 255u, 255u - (64u + b));
#pragma unroll
        for (int b = 0; b < 4; ++b) g2[b] = key_embed(val0[3] + val1[b], 255u, 255u - (48u + b));
#pragma unroll
        for (int a = 5; a < 8; ++a)
#pragma unroll
            for (int b = 0; b < 2; ++b) g2[4 + (a - 5) * 2 + b] = key_embed(val0[a] + val1[b], 255u, 255u - (16u * a + b));
#pragma unroll
        for (int a = 8; a < 14; ++a) g2[10 + (a - 8)] = key_embed(val0[a] + val1[0], 255u, 255u - 16u * a);
        g3[0] = key_embed(val0[14] + val1[0], 255u, 255u - 16u * 14); g3[1] = key_embed(val0[15] + val1[0], 255u, 255u - 16u * 15);
#pragma unroll
        for (int i = 2; i < 16; ++i) g3[i] = -3.0e38f;
        sort16_desc(g1); sort16_desc(g2); sort16_desc(g3);
        merge_top16(g0, g1); merge_top16(g2, g3); merge_top16(g0, g2);
        float gate[16]; int eid[16];
        const float mx = __uint_as_float(__float_as_uint(g0[0]) & ~255u);
        float sum = 0.f;
#pragma unroll
        for (int i = 0; i < 16; ++i) {
            const unsigned key = __float_as_uint(g0[i]);
            gate[i] = __expf(__uint_as_float(key & ~255u) - mx); sum += gate[i];
            const unsigned id = 255u - (key & 255u);
            const unsigned n0 = *(const LAS unsigned char*)(myl + (id >> 4));
            const unsigned n1 = *(const LAS unsigned char*)(myl + 16 + (id & 15u));
            eid[i] = (int)(n0 * 128u + n1);
        }
        const float inv = 1.f / sum;
        const int h = k + 4 * hh;
        int* EI = (int*)(p.ws + OFF_EIDX) + (size_t)t * 128 + h * 16; float* EG = (float*)(p.ws + OFF_EGATE) + (size_t)t * 128 + h * 16;
#pragma unroll
        for (int q = 0; q < 4; ++q) {
            *reinterpret_cast<int4*>(EI + q * 4) = make_int4(eid[q * 4], eid[q * 4 + 1], eid[q * 4 + 2], eid[q * 4 + 3]);
            *reinterpret_cast<float4*>(EG + q * 4) = make_float4(gate[q * 4] * inv, gate[q * 4 + 1] * inv, gate[q * 4 + 2] * inv, gate[q * 4 + 3] * inv);
        }
    }
}

constexpr int LDS_BYTES = LDS_HDR + 3 * 48 * 1024;
__global__ void __launch_bounds__(NT, 2) mk_fwd(Params p) {
    extern __shared__ __attribute__((aligned(16))) unsigned char lds[];
    const int wv = __builtin_amdgcn_readfirstlane((int)(threadIdx.x >> 6));
    volatile LAS unsigned* st = (volatile LAS unsigned*)lds;
    if (threadIdx.x < 4) st[threadIdx.x] = 0u;
    __syncthreads();
    XcdBarrier xb = xcd_barrier_post((unsigned*)(p.ws + OFF_BAR), st);
    int bar_idx = 0;
#define GRID_BAR() do { xcd_barrier(xb); \
        if (PROBE_TS >= 0 && blockIdx.x == 0 && threadIdx.x == 0 && (bar_idx == PROBE_TS - 1 || bar_idx == PROBE_TS)) \
            ((volatile LAS unsigned long long*)(lds + 128))[bar_idx - (PROBE_TS - 1)] = __builtin_amdgcn_s_memrealtime(); \
        ++bar_idx; } while (0)
    if (PROBE_TS == 0 && blockIdx.x == 0 && threadIdx.x == 0) ((volatile LAS unsigned long long*)(lds + 128))[0] = __builtin_amdgcn_s_memrealtime();
    unsigned char* ws = p.ws;
    for (int rep = 0; rep < (PROBE_DUP == 1 ? 2 : 1); ++rep) {
    ph_transpose_all(p, lds + LDS_HDR, wv);
    ph_convert(p.in[I_SUBK], (bf16_t*)(ws + OFF_SUBK), 2 * 2 * 128 * 64, wv);
    ph_convert(p.in[I_SGUW], (bf16_t*)(ws + OFF_SGUW), 2 * 4 * 128 * 128, wv);
    ph_mod(p, lds + LDS_HDR, wv);
    ph_rope_tab(p, wv);
    GRID_BAR();
    }
    for (int l = 0; l < 2; ++l) {
        for (int rep = 0; rep < (PROBE_DUP == 3 ? 2 : 1); ++rep) {
        if (l == 0) {
            ph_norm_mod(p, 0, 0, 1, wv);
            ph_cache_prep(p, 0, wv);
            ph_fold_tables(p, lds + LDS_HDR, wv);
            GRID_BAR();
        }
        }
        for (int rep = 0; rep < (PROBE_DUP == 5 ? 2 : 1); ++rep) {
        if (l == 0) gemm_phase<EPI_INPROJ>(p, 0, (const bf16_t*)(ws + OFF_H), (const bf16_t*)(ws + OFF_WIN), INW, lds + LDS_HDR, wv);
        else {
            ph_cache_prep(p, 1, wv);
            gemm_phase<EPI_INPROJ>(p, 1, (const bf16_t*)(ws + OFF_XC), (const bf16_t*)(ws + OFF_WINS), INW, lds + LDS_HDR, wv,
                                   (size_t)INW * D, (const float*)(ws + OFF_RSS1), (const float*)(ws + OFF_BIN));
        }
        GRID_BAR();
        }
        for (int rep = 0; rep < ((PROBE_DUP == 4 || (PROBE_DUP >= 10 && PROBE_DUP <= 12)) ? 2 : 1); ++rep) {
        ph_mixers(p, l + 2 * rep, lds + LDS_HDR, wv);
        GRID_BAR();
        }
        if (l == 0) ph_ush(p, lds + LDS_HDR, wv);
        gemm_phase<EPI_WOUT>(p, l, (const bf16_t*)(ws + OFF_MIX), (const bf16_t*)(ws + OFF_WOUT) + (size_t)l * D * D, D, lds + LDS_HDR, wv);
        GRID_BAR();
        for (int rep = 0; rep < (PROBE_DUP == 7 ? 2 : 1); ++rep) {
        gemm_phase<EPI_WQ>(p, l, (const bf16_t*)(ws + OFF_XC), (const bf16_t*)(ws + OFF_WQS) + (size_t)l * 5 * D * D, D, lds + LDS_HDR, wv,
                           (size_t)D * D, (const float*)(ws + OFF_RSS2) + (size_t)l * NTOK * 8, (const float*)(ws + OFF_BQ) + (size_t)l * 5 * D);
        GRID_BAR();
        }
        if (PROBE_DUP == 8) { for (int rep = 0; rep < 10; ++rep) GRID_BAR(); }
        for (int rep = 0; rep < (PROBE_DUP == 2 ? 2 : 1); ++rep) {
        ph_peer_select(p, l, lds + LDS_HDR, wv);
        GRID_BAR();
        }
        ph_peer_sliced<false>(p, l, lds + LDS_HDR, wv);
        GRID_BAR();
        ph_peer_pairw(p, l, wv);
        GRID_BAR();
        ph_peer_sliced<true>(p, l, lds + LDS_HDR, wv);
        GRID_BAR();
    }
    ph_final_norm(p, wv);
    if (PROBE_TS >= 0 && blockIdx.x == 0 && threadIdx.x == 0) {
        asm volatile("s_waitcnt vmcnt(0)" ::: "memory");
        volatile LAS unsigned long long* tsl = (volatile LAS unsigned long long*)(lds + 128);
        p.out[0] += (float)(tsl[1] - tsl[0]) * 0.01f;
    }
}

extern "C" void kernel_launch(void* const* d_in, const int* in_sizes, int n_in,
                              void* d_out, int out_size, void* d_ws, size_t ws_size,
                              hipStream_t stream) {
    static int grid = 0;
    if (grid == 0) {
        if (ws_size < WS_NEED) { fprintf(stderr, "kernel_launch: workspace too small: %zu < %zu\n", ws_size, (size_t)WS_NEED); grid = -1; return; }
        int dev = 0, cus = 0, per_cu = 0;
        (void)hipGetDevice(&dev);
        (void)hipDeviceGetAttribute(&cus, hipDeviceAttributeMultiprocessorCount, dev);
        (void)hipFuncSetAttribute((const void*)mk_fwd, hipFuncAttributeMaxDynamicSharedMemorySize, LDS_BYTES);
        (void)hipOccupancyMaxActiveBlocksPerMultiprocessor(&per_cu, (const void*)mk_fwd, NT, LDS_BYTES);
        if (per_cu < 1) { fprintf(stderr, "kernel_launch: occupancy query reports %d blocks per CU\n", per_cu); grid = -1; return; }
        grid = cus;
    }
    if (grid < 0) return;
    (void)hipMemsetAsync((unsigned char*)d_ws + OFF_BAR, 0, 64 * 1024, stream);
    Params p{};
    for (int i = 0; i < 29; ++i) p.in[i] = (const float*)d_in[i];
    p.out = (float*)d_out; p.ws = (unsigned char*)d_ws;
    void* args[] = {&p};
    hipError_t e = hipLaunchCooperativeKernel((const void*)mk_fwd, dim3(grid), dim3(NT), args, LDS_BYTES, stream);
    if (e != hipSuccess) fprintf(stderr, "kernel_launch: cooperative launch failed: %s (grid %d)\n", hipGetErrorString(e), grid);
}
```

```cpp
#include <hip/hip_runtime.h>
#include <hip/hip_bf16.h>
#include <cstdio>
#include <cstdint>
#include <hip/hip_cooperative_groups.h>
namespace cg = cooperative_groups;

#define PROBE_DUP 0
#define PROBE_TS -1
typedef unsigned short bf16_t;
using bf16x8 = __attribute__((ext_vector_type(8))) short;
using f32x4  = __attribute__((ext_vector_type(4))) float;
using f32x16 = __attribute__((ext_vector_type(16))) float;
using f32x2  = __attribute__((ext_vector_type(2))) float;
using u32x4  = __attribute__((ext_vector_type(4))) unsigned;
using u32x2  = __attribute__((ext_vector_type(2))) unsigned;
using s16x4  = __attribute__((ext_vector_type(4))) short;

constexpr int D      = 1024;
constexpr int NTOK   = 16384;
constexpr int NPT    = 8192;
constexpr int SEQ    = 256;
constexpr int DSEQ   = 2048;
constexpr int PAST   = 512;
constexpr int NKS    = DSEQ + PAST;
constexpr int INW    = 2048;
constexpr int NEXP   = 16384;
constexpr float EPS  = 1e-6f;

constexpr size_t MB = 1024 * 1024;
constexpr size_t OFF_BAR   = 0;
constexpr size_t OFF_MOD   = 64 * 1024;
constexpr size_t OFF_ROPE  = OFF_MOD + 256 * 1024;
constexpr size_t OFF_SUBK  = OFF_ROPE + 1 * MB;
constexpr size_t OFF_SGUW  = OFF_SUBK + 64 * 1024;
constexpr size_t OFF_WIN   = OFF_SGUW + 256 * 1024;
constexpr size_t OFF_WOUT  = OFF_WIN + 8 * MB;
constexpr size_t OFF_WQ    = OFF_WOUT + 4 * MB;
constexpr size_t OFF_UT    = OFF_WQ + 4 * MB;
constexpr size_t OFF_USC   = OFF_UT + 32 * MB;
constexpr size_t OFF_VT    = OFF_UT + 64 * MB;
constexpr size_t OFF_VSC   = OFF_VT + 32 * MB;
constexpr size_t OFF_H     = OFF_VT + 64 * MB;
constexpr size_t OFF_XC    = OFF_H + 32 * MB;
constexpr size_t OFF_R1    = OFF_XC + 64 * MB;
constexpr size_t OFF_AU    = OFF_R1;
constexpr size_t OFF_AV    = OFF_AU + 8 * MB;
constexpr size_t OFF_AVN   = OFF_AV + 8 * MB;
constexpr size_t OFF_DQ    = OFF_AVN + 8 * MB;
constexpr size_t OFF_DKP   = OFF_DQ + 8 * MB;
constexpr size_t OFF_DKS   = OFF_DKP + 4 * MB;
constexpr size_t OFF_DVTP  = OFF_DKS + 5 * MB;
constexpr size_t OFF_DVTS  = OFF_DVTP + 4 * MB;
constexpr size_t OFF_GQ    = OFF_DVTS + 5 * MB;
constexpr size_t OFF_GKP   = OFF_GQ + 16 * MB;
constexpr size_t OFF_GKS   = OFF_GKP + 2 * MB;
constexpr size_t OFF_GVTP  = OFF_GKS + 3 * MB;
constexpr size_t OFF_GVTS  = OFF_GVTP + 2 * MB;
constexpr size_t OFF_MIX   = OFF_GVTS + 3 * MB;
constexpr size_t OFF_R1END = OFF_MIX + 32 * MB;
constexpr size_t OFF_Q     = OFF_R1;
constexpr size_t OFF_EIDX  = OFF_Q + 32 * MB;
constexpr size_t OFF_EGATE = OFF_EIDX + 8 * MB;
constexpr size_t OFF_TOPV  = OFF_EGATE + 8 * MB;
constexpr size_t OFF_TOPI  = OFF_TOPV + 16 * MB;
static_assert(OFF_TOPI + 16 * MB <= OFF_R1END, "peer buffers must fit region 1");
constexpr size_t OFF_PROJ  = OFF_R1END;
constexpr size_t OFF_PART  = OFF_PROJ;
constexpr size_t OFF_WPAIR = OFF_PART + 64 * MB;
constexpr size_t OFF_H8I   = OFF_WPAIR + 8 * MB;
constexpr size_t OFF_HSC   = OFF_H8I + 16 * MB;
constexpr size_t OFF_WSC   = OFF_HSC + 64 * 1024;
constexpr size_t OFF_XGS   = OFF_WSC + 64 * 1024;
constexpr size_t OFF_RSS2  = OFF_XGS + 512 * 1024;
constexpr size_t OFF_RSS1  = OFF_RSS2 + 1 * MB;
constexpr size_t OFF_USH   = OFF_RSS1 + 512 * 1024;
constexpr size_t OFF_BQ    = OFF_USH + 1 * MB;
constexpr size_t OFF_BIN   = OFF_BQ + 64 * 1024;
constexpr size_t OFF_WQS   = OFF_BIN + 64 * 1024;
constexpr size_t OFF_WINS  = OFF_XC + 32 * MB;
static_assert(OFF_WQS + 20 * MB <= OFF_PROJ + 128 * MB, "folded tables must fit");
constexpr size_t WS_NEED   = OFF_PROJ + 128 * MB;
static_assert(WS_NEED <= 512 * MB, "workspace budget");

constexpr size_t OUT_YP  = 0;
constexpr size_t OUT_YS  = 8388608;
constexpr size_t OUT_NDK = 16777216;
constexpr size_t OUT_NDV = OUT_NDK + 4194304;
constexpr size_t OUT_NGK = OUT_NDV + 4194304;
constexpr size_t OUT_NGV = OUT_NGK + 2097152;

struct Params {
    const float* in[29];
    float* out;
    unsigned char* ws;
};
enum { I_XP = 0, I_XS, I_CDK, I_CDV, I_CGK, I_CGV, I_C, I_CCTX, I_ADAW, I_ADAB, I_N1G, I_N2G, I_WIN, I_SGUNG, I_SGUW, I_SGUB,
       I_LQ1, I_LK1, I_LQ2, I_LK2, I_SUBLN, I_QNG, I_KNG, I_WOUT, I_WQ, I_SUBK, I_PU, I_PV, I_FG };

typedef __bf16 hwbf2 __attribute__((ext_vector_type(2)));
__device__ __forceinline__ unsigned pack_bf2(float a, float b) {
    const f32x2 v = {a, b};
    return __builtin_bit_cast(unsigned, __builtin_convertvector(v, hwbf2));
}
__device__ __forceinline__ bf16_t f2bf(float f) { return (bf16_t)(pack_bf2(f, 0.f) & 0xffffu); }
__device__ __forceinline__ float bf2f(bf16_t h) { return __uint_as_float(((unsigned)h) << 16); }
__device__ __forceinline__ float gelu_f(float x) {
    const float k2 = 2.f * 0.7978845608028654f * 1.4426950408889634f;
    const float e = __builtin_amdgcn_exp2f(k2 * (x + 0.044715f * x * x * x));
    return x - x * __builtin_amdgcn_rcpf(e + 1.f);
}
__device__ __forceinline__ int lane_id() { return (int)__builtin_amdgcn_mbcnt_hi(~0u, __builtin_amdgcn_mbcnt_lo(~0u, 0u)); }
__device__ __forceinline__ int lane_id_op() { int l = lane_id(); asm volatile("" : "+v"(l)); return l; }
__device__ __forceinline__ float shfl_i(float v, int src) { return __builtin_bit_cast(float, __builtin_amdgcn_ds_bpermute(src << 2, __builtin_bit_cast(int, v))); }
__device__ __forceinline__ int shfl_i(int v, int src) { return __builtin_amdgcn_ds_bpermute(src << 2, v); }
__device__ __forceinline__ float shfl_x(float v, int lane, int m) { return shfl_i(v, lane ^ m); }
__device__ __forceinline__ int shfl_x(int v, int lane, int m) { return shfl_i(v, lane ^ m); }
__device__ __forceinline__ int q8(float x) { return (int)fminf(fmaxf(rintf(x), -127.f), 127.f); }
__device__ __forceinline__ unsigned pack4_i8(int a, int b, int c, int d) { return (unsigned)(a & 255) | ((unsigned)(b & 255) << 8) | ((unsigned)(c & 255) << 16) | ((unsigned)d << 24); }
#define DPP_F(v, ctrl) __builtin_bit_cast(float, __builtin_amdgcn_update_dpp(0, __builtin_bit_cast(int, (v)), (ctrl), 0xF, 0xF, false))
__device__ __forceinline__ float row16_sum(float v) {
    v += DPP_F(v, 0xB1); v += DPP_F(v, 0x4E); v += DPP_F(v, 0x141); v += DPP_F(v, 0x140);
    return v;
}
__device__ __forceinline__ float row16_max(float v) {
    v = fmaxf(v, DPP_F(v, 0xB1)); v = fmaxf(v, DPP_F(v, 0x4E)); v = fmaxf(v, DPP_F(v, 0x141)); v = fmaxf(v, DPP_F(v, 0x140));
    return v;
}
__device__ __forceinline__ float rdlane_f(float v, int l) { return __builtin_bit_cast(float, __builtin_amdgcn_readlane(__builtin_bit_cast(int, v), l)); }
__device__ __forceinline__ float wave_sum(float v) {
    v = row16_sum(v);
    return (rdlane_f(v, 0) + rdlane_f(v, 16)) + (rdlane_f(v, 32) + rdlane_f(v, 48));
}
__device__ __forceinline__ float wave_max(float v) {
    v = row16_max(v);
    return fmaxf(fmaxf(rdlane_f(v, 0), rdlane_f(v, 16)), fmaxf(rdlane_f(v, 32), rdlane_f(v, 48)));
}
__device__ __forceinline__ int tok_cv(int t) { return t < NPT ? 0 : 1 + ((t - NPT) >> 11); }
__device__ __forceinline__ const float* x_in_row(const Params& p, int t) {
    return t < NPT ? p.in[I_XP] + (size_t)t * D : p.in[I_XS] + (size_t)(t - NPT) * D;
}
__device__ __forceinline__ float lam_init_of(int l) { return l == 0 ? 0.2f : (0.8f - 0.6f * 0.7408182206817179f); }
__device__ __forceinline__ float lam_of(const Params& p, int l) {
    float s1 = 0.f, s2 = 0.f;
    for (int i = 0; i < 32; ++i) {
        s1 += p.in[I_LQ1][l * 32 + i] * p.in[I_LK1][l * 32 + i];
        s2 += p.in[I_LQ2][l * 32 + i] * p.in[I_LK2][l * 32 + i];
    }
    return expf(s1) - expf(s2) + lam_init_of(l);
}


#define XB_TMO      128
#define XB_XCNT(j)  (256  + 64 * (j))
#define XB_XSUB(j)  (1280 + 64 * (j))
#define XB_XGEN(j)  (2304 + 64 * (j))
#define XB_TOP      3328
#define XB_TOPGEN   3392
#define XCD_BAR_WORDS 3456
#define XB_SPIN_CAP (1u << 20)
#define LAS __attribute__((address_space(3)))
typedef int i32x4 __attribute__((ext_vector_type(4)));
__device__ __forceinline__ unsigned xb_ld(unsigned* p)              { return __hip_atomic_load(p, __ATOMIC_RELAXED, __HIP_MEMORY_SCOPE_AGENT); }
__device__ __forceinline__ unsigned xb_add(unsigned* p, unsigned v) { return __hip_atomic_fetch_add(p, v, __ATOMIC_RELAXED, __HIP_MEMORY_SCOPE_AGENT); }
__device__ __forceinline__ unsigned xb_xcc_id() { return (unsigned)__builtin_amdgcn_s_getreg((3 << 11) | 20) & 0xFu; }
#define XB_SPIN(cond, bar) do { unsigned _sp = 0; while (cond) { __builtin_amdgcn_s_sleep(1); \
    if ((++_sp & 255u) == 0u) { if (xb_ld(&(bar)[XB_TMO])) break; if (_sp > XB_SPIN_CAP) { atomicAdd(&(bar)[XB_TMO], 1u); break; } } } } while (0)
struct XcdBarrier { unsigned* bar; unsigned x; volatile LAS unsigned* st; };
__device__ __forceinline__ XcdBarrier xcd_barrier_post(unsigned* bar, volatile LAS unsigned* st) {
    XcdBarrier b; b.bar = bar; b.x = xb_xcc_id(); b.st = st;
    if (threadIdx.x == 0) (void)xb_add(&bar[XB_XCNT(b.x)], 1u);
    return b;
}
__device__ __forceinline__ void xcd_barrier_complete(unsigned* bar, unsigned x, unsigned& nloc, unsigned& nx) {
    const unsigned G = gridDim.x * gridDim.y * gridDim.z;
    unsigned sum, cnt, mine, sp = 0u;
    for (;;) {
        sum = 0u; cnt = 0u; mine = 0u;
#pragma unroll
        for (unsigned j = 0; j < 16; ++j) { const unsigned c = xb_ld(&bar[XB_XCNT(j)]); sum += c; cnt += (c > 0u) ? 1u : 0u; mine = (j == x) ? c : mine; }
        if (sum == G) break;
        __builtin_amdgcn_s_sleep(1);
        if ((++sp & 255u) == 0u) { if (xb_ld(&bar[XB_TMO])) break; if (sp > XB_SPIN_CAP) { atomicAdd(&bar[XB_TMO], 1u); break; } }
    }
    nloc = mine > 0u ? mine : 1u; nx = cnt > 0u ? cnt : 1u;
}
__device__ __forceinline__ void xcd_barrier(const XcdBarrier& b) {
    asm volatile("s_waitcnt vmcnt(0)" ::: "memory");
    __syncthreads();
    if (threadIdx.x == 0) {
        unsigned* bar = b.bar;
        const unsigned bx = xb_xcc_id();
        __builtin_amdgcn_s_waitcnt(0);
        unsigned nloc = b.st[0], nx = b.st[1];
        if (nloc == 0u) { xcd_barrier_complete(bar, bx, nloc, nx); b.st[0] = nloc; b.st[1] = nx; }
        const unsigned old = xb_add(&bar[XB_XSUB(bx)], 1u);
        const unsigned gen = old / nloc;
        if (old + 1u == (gen + 1u) * nloc) {
            __builtin_amdgcn_fence(__ATOMIC_RELEASE, "agent");
            asm volatile("s_waitcnt vmcnt(0)" ::: "memory");
            const unsigned og = xb_add(&bar[XB_TOP], 1u);
            const unsigned tg = og / nx;
            if (og + 1u == (tg + 1u) * nx) xb_add(&bar[XB_TOPGEN], 1u);
            else XB_SPIN(xb_ld(&bar[XB_TOPGEN]) == tg, bar);
            __builtin_amdgcn_fence(__ATOMIC_ACQUIRE, "agent");
            xb_add(&bar[XB_XGEN(bx)], 1u);
            asm volatile("s_waitcnt vmcnt(0)" ::: "memory");
        } else {
            XB_SPIN(xb_ld(&bar[XB_XGEN(bx)]) == gen, bar);
            __builtin_amdgcn_fence(__ATOMIC_ACQUIRE, "agent");
            asm volatile("s_waitcnt vmcnt(0)" ::: "memory");
        }
    }
    __syncthreads();
}

constexpr int NT = 512;
constexpr int LDS_HDR = 1024;
#define GTID ((size_t)blockIdx.x * NT + tid)
__device__ __forceinline__ int opaque_tid(int wv) { int t = (wv << 6) | lane_id(); asm volatile("" : "+v"(t)); return t; }
#define GNT  ((size_t)gridDim.x * NT)

__device__ void ph_transpose_all(const Params& p, unsigned char* ldsraw, const int wv) {
    const int tid = opaque_tid(wv);
    LAS bf16_t* T = (LAS bf16_t*)ldsraw;
    for (int tile = blockIdx.x; tile < 1024; tile += gridDim.x) {
        const int l = tile >> 9, r = tile & 511;
        const float* W; bf16_t* Wt; int N, tl;
        if (r < 256)      { W = p.in[I_WIN] + (size_t)l * D * INW; Wt = (bf16_t*)(p.ws + OFF_WIN) + (size_t)l * INW * D; N = INW; tl = r; }
        else if (r < 384) { W = p.in[I_WOUT] + (size_t)l * D * D;  Wt = (bf16_t*)(p.ws + OFF_WOUT) + (size_t)l * D * D;  N = D;   tl = r - 256; }
        else              { W = p.in[I_WQ] + (size_t)l * D * D;    Wt = (bf16_t*)(p.ws + OFF_WQ) + (size_t)l * D * D;    N = D;   tl = r - 384; }
        const int k0 = (tl & 7) * 128, n0 = (tl >> 3) * 64;
        const int nl0 = tid & 63, kq = tid >> 6;
        float v[16];
#pragma unroll
        for (int i = 0; i < 16; ++i) v[i] = W[(size_t)(k0 + i * 8 + kq) * N + n0 + nl0];
#pragma unroll
        for (int i = 0; i < 16; ++i) T[nl0 * 130 + i * 8 + kq] = f2bf(v[i]);
        __syncthreads();
        {
            const int nl = tid >> 3, kc = tid & 7;
            unsigned w[8];
#pragma unroll
            for (int i = 0; i < 8; ++i) w[i] = (unsigned)T[nl * 130 + kc * 16 + 2 * i] | ((unsigned)T[nl * 130 + kc * 16 + 2 * i + 1] << 16);
            bf16_t* dst = Wt + (size_t)(n0 + nl) * D + k0 + kc * 16;
            *reinterpret_cast<u32x4*>(dst) = u32x4{w[0], w[1], w[2], w[3]};
            *reinterpret_cast<u32x4*>(dst + 8) = u32x4{w[4], w[5], w[6], w[7]};
        }
        __syncthreads();
    }
}
__device__ void ph_convert(const float* __restrict__ src, bf16_t* __restrict__ dst, size_t n, const int wv) {
    const int tid = opaque_tid(wv);
    for (size_t idx = GTID; idx < n; idx += GNT) dst[idx] = f2bf(src[idx]);
}
__device__ void ph_convert_i8_rows(const float* __restrict__ src, unsigned char* __restrict__ dst, float* __restrict__ scl, int nrows, const int wv) {
    const int tid = opaque_tid(wv);
    const int lane = tid & 63;
    const int gw = blockIdx.x * 8 + (tid >> 6), nw = gridDim.x * 8;
    for (int row0 = gw * 4; row0 < nrows; row0 += nw * 4) {
        float4 f[4][4];
#pragma unroll
        for (int q = 0; q < 4; ++q)
#pragma unroll
            for (int i = 0; i < 4; ++i) f[q][i] = *reinterpret_cast<const float4*>(src + (size_t)(row0 + q) * D + lane * 16 + i * 4);
#pragma unroll
        for (int q = 0; q < 4; ++q) {
            const int row = row0 + q;
            float v[16];
#pragma unroll
            for (int i = 0; i < 4; ++i) { v[i * 4] = f[q][i].x; v[i * 4 + 1] = f[q][i].y; v[i * 4 + 2] = f[q][i].z; v[i * 4 + 3] = f[q][i].w; }
            float am = 0.f;
#pragma unroll
            for (int i = 0; i < 16; ++i) am = fmaxf(am, fabsf(v[i]));
#pragma unroll
            for (int o = 32; o >= 1; o >>= 1) am = fmaxf(am, shfl_x(am, lane, o));
            const float sc = am > 0.f ? 127.f / am : 1.f;
            unsigned w[4];
#pragma unroll
            for (int i = 0; i < 4; ++i) w[i] = pack4_i8(q8(v[i * 4] * sc), q8(v[i * 4 + 1] * sc), q8(v[i * 4 + 2] * sc), q8(v[i * 4 + 3] * sc));
            {
                const int lyr = row >> 14, e = row & (NEXP - 1);
                *reinterpret_cast<u32x4*>(dst + (((size_t)lyr * 8 + (lane >> 3)) * NEXP + e) * 128 + (lane & 7) * 16) = u32x4{w[0], w[1], w[2], w[3]};
            }
            if (lane == 0) scl[row] = am > 0.f ? am * (1.f / 127.f) : 1.f;
        }
    }
}
__device__ void ph_mod(const Params& p, unsigned char* ldsraw, const int wv) {
    const int tid = opaque_tid(wv);
    LAS float* sl = (LAS float*)ldsraw;
    LAS float* red = sl + 5 * 1024;
    for (int i = tid; i < 5 * 1024; i += NT) {
        const int cv = i >> 10, k = i & 1023;
        const float c = cv == 0 ? p.in[I_CCTX][k] : p.in[I_C][(size_t)(cv - 1) * D + k];
        sl[i] = c / (1.f + __expf(-c));
    }
    __syncthreads();
    const int c4 = tid & 15, r = tid >> 4;
    for (int item = blockIdx.x; item < 2 * 96; item += gridDim.x) {
        const int l = item / 96, j0 = (item % 96) * 64;
        const float* W = p.in[I_ADAW] + (size_t)l * D * 6144 + (size_t)r * 6144 + j0 + c4 * 4;
        float acc[5][4];
#pragma unroll
        for (int cv = 0; cv < 5; ++cv)
#pragma unroll
            for (int q = 0; q < 4; ++q) acc[cv][q] = 0.f;
#pragma unroll 8
        for (int i = 0; i < 32; ++i) {
            const float4 w = *reinterpret_cast<const float4*>(W + (size_t)i * 32 * 6144);
#pragma unroll
            for (int cv = 0; cv < 5; ++cv) {
                const float sv = sl[cv * 1024 + r + i * 32];
                acc[cv][0] += sv * w.x; acc[cv][1] += sv * w.y; acc[cv][2] += sv * w.z; acc[cv][3] += sv * w.w;
            }
        }
#pragma unroll
        for (int cv = 0; cv < 5; ++cv) *(LAS f32x4*)(red + (r * 5 + cv) * 64 + c4 * 4) = f32x4{acc[cv][0], acc[cv][1], acc[cv][2], acc[cv][3]};
        __syncthreads();
        if (tid < 320) {
            const int cv = tid >> 6, c = tid & 63;
            float sum = p.in[I_ADAB][l * 6144 + j0 + c];
#pragma unroll
            for (int q = 0; q < 32; ++q) sum += red[(q * 5 + cv) * 64 + c];
            ((float*)(p.ws + OFF_MOD))[(size_t)(l * 5 + cv) * 6144 + j0 + c] = sum;
        }
        __syncthreads();
    }
}
__device__ void ph_rope_tab(const Params& p, const int wv) {
    const int tid = opaque_tid(wv);
    for (size_t idx = GTID; idx < 2048 * 48; idx += GNT) {
        int s = idx / 48, i = idx % 48;
        float* R = (float*)(p.ws + OFF_ROPE);
        double row = (double)(s / 64), col = (double)(s % 64);
        if (i < 16) {
            int q = i & 7; double inv = pow(10000.0, -(double)q / 8.0);
            double ang = (i < 8 ? row : col) * inv;
            R[s * 16 + i] = (float)cos(ang); R[2048 * 16 + s * 16 + i] = (float)sin(ang);
        } else {
            int ii = i - 16; int q = ii & 15; double inv = pow(10000.0, -(double)q / 16.0);
            double ang = (ii < 16 ? row : col) * inv;
            R[2048 * 32 + s * 32 + ii] = (float)cos(ang); R[2048 * 64 + s * 32 + ii] = (float)sin(ang);
        }
    }
}
__device__ void ph_cache_prep(const Params& p, int l, const int wv) {
    const int tid = opaque_tid(wv);
    bf16_t* DKS = (bf16_t*)(p.ws + OFF_DKS); bf16_t* DVTS = (bf16_t*)(p.ws + OFF_DVTS);
    bf16_t* GKS = (bf16_t*)(p.ws + OFF_GKS); bf16_t* GVTS = (bf16_t*)(p.ws + OFF_GVTS);
    for (size_t idx = GTID; idx < 4 * 512 * 256; idx += GNT) {
        int c = idx & 255, pp = (idx >> 8) & 511, b = idx >> 17;
        size_t src = (((size_t)b * 2 + l) * PAST + pp) * 256 + c;
        int h = c >> 6, r = c & 63;
        DKS[(((size_t)b * 4 + h) * NKS + DSEQ + pp) * 64 + r] = f2bf(p.in[I_CDK][src]);
        DVTS[(((size_t)b * 4 + h) * 64 + r) * NKS + DSEQ + pp] = f2bf(p.in[I_CDV][src]);
        if (c < 128) {
            size_t src2 = (((size_t)b * 2 + l) * PAST + pp) * 128 + c;
            int kv = c >> 6;
            const int sq = DSEQ + pp;
            const size_t hb = ((size_t)b * 2 + kv) * NKS * 64 + (size_t)(sq >> 6) * 4096;
            GKS[hb + (r >> 3) * 512 + (sq & 63) * 8 + (r & 7)] = f2bf(p.in[I_CGK][src2]);
            GVTS[hb + (r >> 5) * 2048 + (sq & 63) * 32 + (r & 31)] = f2bf(p.in[I_CGV][src2]);
        }
    }
}
__device__ void ph_fold_tables(const Params& p, unsigned char* ldsraw, const int wv) {
    const int tid = opaque_tid(wv);
    const int lane = tid & 63;
    const int gw = blockIdx.x * 8 + (tid >> 6), nw = gridDim.x * 8;
    const float* MOD = (const float*)(p.ws + OFF_MOD);
    for (size_t idx = GTID; idx < (size_t)(1024 + 1024 + 2048) * 128; idx += GNT) {
        const int row = (int)(idx >> 7), k0 = (int)(idx & 127) * 8;
        const int which = row < 2048 ? 1 : 0, l = row < 1024 ? 0 : 1;
        const int n = row < 2048 ? (row & 1023) : row - 2048, N = row < 2048 ? 1024 : 2048;
        const bf16_t* src = row < 2048 ? (const bf16_t*)(p.ws + OFF_WQ) + ((size_t)l * D + n) * D + k0 : (const bf16_t*)(p.ws + OFF_WIN) + ((size_t)INW + n) * D + k0;
        bf16_t* dst = row < 2048 ? (bf16_t*)(p.ws + OFF_WQS) + ((size_t)l * 5 * D + n) * D + k0 : (bf16_t*)(p.ws + OFF_WINS) + (size_t)n * D + k0;
        const u32x4 w = *reinterpret_cast<const u32x4*>(src);
        const float* gn = p.in[which ? I_N2G : I_N1G] + l * D + k0;
        const float4 ga = *reinterpret_cast<const float4*>(gn), gb = *reinterpret_cast<const float4*>(gn + 4);
        float wf[8];
#pragma unroll
        for (int k = 0; k < 4; ++k) { wf[2 * k] = __uint_as_float(w[k] << 16); wf[2 * k + 1] = __uint_as_float(w[k] & 0xffff0000u); }
        wf[0] *= ga.x; wf[1] *= ga.y; wf[2] *= ga.z; wf[3] *= ga.w; wf[4] *= gb.x; wf[5] *= gb.y; wf[6] *= gb.z; wf[7] *= gb.w;
#pragma unroll
        for (int cv = 0; cv < 5; ++cv) {
            const float* sc = MOD + (size_t)(l * 5 + cv) * 6144 + which * 3072 + 1024 + k0;
            const float4 sa = *reinterpret_cast<const float4*>(sc), sb = *reinterpret_cast<const float4*>(sc + 4);
            *reinterpret_cast<u32x4*>(dst + (size_t)cv * N * D) = u32x4{pack_bf2(wf[0] * (1.f + sa.x), wf[1] * (1.f + sa.y)), pack_bf2(wf[2] * (1.f + sa.z), wf[3] * (1.f + sa.w)),
                                                                         pack_bf2(wf[4] * (1.f + sb.x), wf[5] * (1.f + sb.y)), pack_bf2(wf[6] * (1.f + sb.z), wf[7] * (1.f + sb.w))};
        }
    }
    for (int row = gw; row < 1024 + 1024 + 2048; row += nw) {
        const int which = row < 2048 ? 1 : 0, l = row < 1024 ? 0 : 1;
        const int n = row < 2048 ? (row & 1023) : row - 2048;
        const bf16_t* src = row < 2048 ? (const bf16_t*)(p.ws + OFF_WQ) + ((size_t)l * D + n) * D + lane * 16 : (const bf16_t*)(p.ws + OFF_WIN) + ((size_t)INW + n) * D + lane * 16;
        const u32x4 w0 = *reinterpret_cast<const u32x4*>(src), w1 = *reinterpret_cast<const u32x4*>(src + 8);
        float wf[16];
#pragma unroll
        for (int k = 0; k < 4; ++k) { wf[2 * k] = __uint_as_float(w0[k] << 16); wf[2 * k + 1] = __uint_as_float(w0[k] & 0xffff0000u);
                                      wf[8 + 2 * k] = __uint_as_float(w1[k] << 16); wf[8 + 2 * k + 1] = __uint_as_float(w1[k] & 0xffff0000u); }
#pragma unroll
        for (int cv = 0; cv < 5; ++cv) {
            const float* sh = MOD + (size_t)(l * 5 + cv) * 6144 + which * 3072 + lane * 16;
            float acc = 0.f;
#pragma unroll
            for (int q = 0; q < 4; ++q) {
                const float4 a = *reinterpret_cast<const float4*>(sh + q * 4);
                acc += wf[q * 4] * a.x + wf[q * 4 + 1] * a.y + wf[q * 4 + 2] * a.z + wf[q * 4 + 3] * a.w;
            }
            acc = wave_sum(acc);
            if (lane == 0) {
                if (row < 2048) ((float*)(p.ws + OFF_BQ))[(size_t)(l * 5 + cv) * D + n] = acc;
                else            ((float*)(p.ws + OFF_BIN))[(size_t)cv * INW + n] = acc;
            }
        }
    }
}
__device__ void ph_ush(const Params& p, unsigned char* ldsraw, const int wv) {
    const int tid = opaque_tid(wv);
    const int lane = tid & 63;
    const int gw = blockIdx.x * 8 + (tid >> 6), nw = gridDim.x * 8;
    const float* MOD = (const float*)(p.ws + OFF_MOD);
    {
        LAS signed char* s8 = (LAS signed char*)ldsraw;
        LAS float* s8s = (LAS float*)(ldsraw + 10 * 1024);
        const int wave = tid >> 6;
        for (int r = wave; r < 10; r += 8) {
            const float* sh = MOD + (size_t)r * 6144 + 3072 + lane * 16;
            float v[16];
#pragma unroll
            for (int q = 0; q < 4; ++q) { const float4 a = *reinterpret_cast<const float4*>(sh + q * 4); v[q * 4] = a.x; v[q * 4 + 1] = a.y; v[q * 4 + 2] = a.z; v[q * 4 + 3] = a.w; }
            float am = 0.f;
#pragma unroll
            for (int i = 0; i < 16; ++i) am = fmaxf(am, fabsf(v[i]));
            am = wave_max(am);
            const float sc = am > 0.f ? 127.f / am : 1.f;
            u32x4 w;
#pragma unroll
            for (int q = 0; q < 4; ++q) w[q] = pack4_i8(q8(v[q * 4] * sc), q8(v[q * 4 + 1] * sc), q8(v[q * 4 + 2] * sc), q8(v[q * 4 + 3] * sc));
            *(LAS u32x4*)(s8 + r * 1024 + lane * 16) = w;
            if (lane == 0) s8s[r] = am > 0.f ? am * (1.f / 127.f) : 1.f;
        }
        __syncthreads();
        const int fr = lane & 15, fq = lane >> 4;
        for (int task = gw; task < 2 * (NEXP / 16); task += nw) {
            const int l = task >> 10, e0 = (task & 1023) * 16;
            const unsigned char* up = p.ws + OFF_UT + ((size_t)l * 8 * NEXP + e0 + fr) * 128 + fq * 16;
            i32x4 acc = {0, 0, 0, 0};
#pragma unroll
            for (int st = 0; st < 16; ++st) {
                const i32x4 a = *reinterpret_cast<const i32x4*>(up + (size_t)(st >> 1) * NEXP * 128 + (st & 1) * 64);
                i32x4 b = {0, 0, 0, 0};
                if (fr < 5) b = *(const LAS i32x4*)(s8 + (l * 5 + fr) * 1024 + st * 64 + fq * 16);
                acc = __builtin_amdgcn_mfma_i32_16x16x64_i8(a, b, acc, 0, 0, 0);
            }
            if (fr < 5) {
                const float ss = s8s[l * 5 + fr];
#pragma unroll
                for (int r = 0; r < 4; ++r) {
                    const int e = e0 + fq * 4 + r;
                    { float* rec = (float*)(p.ws + OFF_USH) + ((size_t)l * NEXP + e) * 8; rec[2 + fr] = (float)acc[r] * ss * rec[0]; }
                }
            }
        }
        __syncthreads();
    }
}
__device__ void ph_norm_mod(const Params& p, int l, int which, int from_input, const int wv) {
    const int tid = opaque_tid(wv);
    const int lane = tid & 63;
    const int gw = blockIdx.x * 8 + (tid >> 6), nw = gridDim.x * 8;
    const float* g = p.in[which ? I_N2G : I_N1G] + l * D;
    if (from_input) {
        float4 nx[4];
        {
            const int t = gw < NTOK ? gw : NTOK - 1;
            const float* xr = x_in_row(p, t);
#pragma unroll
            for (int i = 0; i < 4; ++i) nx[i] = *reinterpret_cast<const float4*>(xr + i * 256 + lane * 4);
        }
        for (int t = gw; t < NTOK; t += nw) {
            float4 v[4];
#pragma unroll
            for (int i = 0; i < 4; ++i) v[i] = nx[i];
            {
                const int tn = t + nw < NTOK ? t + nw : t;
                const float* xn = x_in_row(p, tn);
#pragma unroll
                for (int i = 0; i < 4; ++i) nx[i] = *reinterpret_cast<const float4*>(xn + i * 256 + lane * 4);
            }
            const float* mod = (const float*)(p.ws + OFF_MOD) + (size_t)(l * 5 + tok_cv(t)) * 6144 + which * 3072;
            float ss = 0.f;
#pragma unroll
            for (int i = 0; i < 4; ++i) ss += v[i].x * v[i].x + v[i].y * v[i].y + v[i].z * v[i].z + v[i].w * v[i].w;
            ss = wave_sum(ss);
            float r = rsqrtf(ss / D + EPS);
            bf16_t* H = (bf16_t*)(p.ws + OFF_H) + (size_t)t * D;
#pragma unroll
            for (int i = 0; i < 4; ++i) {
                int c = i * 256 + lane * 4;
                float4 gg = *reinterpret_cast<const float4*>(g + c), sh = *reinterpret_cast<const float4*>(mod + c), sc = *reinterpret_cast<const float4*>(mod + 1024 + c);
                uint2 o;
                o.x = pack_bf2(v[i].x * r * gg.x * (1.f + sc.x) + sh.x, v[i].y * r * gg.y * (1.f + sc.y) + sh.y);
                o.y = pack_bf2(v[i].z * r * gg.z * (1.f + sc.z) + sh.z, v[i].w * r * gg.w * (1.f + sc.w) + sh.w);
                *reinterpret_cast<uint2*>(H + c) = o;
            }
        }
    } else {
        u32x4 nx[2];
        {
            const int t = gw < NTOK ? gw : NTOK - 1;
            const bf16_t* xr = (const bf16_t*)(p.ws + OFF_XC) + (size_t)t * D + lane * 8;
            nx[0] = *reinterpret_cast<const u32x4*>(xr); nx[1] = *reinterpret_cast<const u32x4*>(xr + 512);
        }
        for (int t = gw; t < NTOK; t += nw) {
            float v[16];
#pragma unroll
            for (int h = 0; h < 2; ++h)
#pragma unroll
                for (int k = 0; k < 4; ++k) { v[h * 8 + 2 * k] = __uint_as_float(nx[h][k] << 16); v[h * 8 + 2 * k + 1] = __uint_as_float(nx[h][k] & 0xffff0000u); }
            {
                const int tn = t + nw < NTOK ? t + nw : t;
                const bf16_t* xn = (const bf16_t*)(p.ws + OFF_XC) + (size_t)tn * D + lane * 8;
                nx[0] = *reinterpret_cast<const u32x4*>(xn); nx[1] = *reinterpret_cast<const u32x4*>(xn + 512);
            }
            const float* mod = (const float*)(p.ws + OFF_MOD) + (size_t)(l * 5 + tok_cv(t)) * 6144 + which * 3072;
            float ss = 0.f;
#pragma unroll
            for (int i = 0; i < 16; ++i) ss += v[i] * v[i];
            ss = wave_sum(ss);
            float r = rsqrtf(ss / D + EPS);
            bf16_t* H = (bf16_t*)(p.ws + OFF_H) + (size_t)t * D;
            float hq[16];
#pragma unroll
            for (int h = 0; h < 2; ++h) {
                const int c = h * 512 + lane * 8;
                float o[8];
#pragma unroll
                for (int q = 0; q < 2; ++q) {
                    const float4 gg = *reinterpret_cast<const float4*>(g + c + q * 4), sh = *reinterpret_cast<const float4*>(mod + c + q * 4), sc = *reinterpret_cast<const float4*>(mod + 1024 + c + q * 4);
                    o[q * 4] = v[h * 8 + q * 4] * r * gg.x * (1.f + sc.x) + sh.x; o[q * 4 + 1] = v[h * 8 + q * 4 + 1] * r * gg.y * (1.f + sc.y) + sh.y;
                    o[q * 4 + 2] = v[h * 8 + q * 4 + 2] * r * gg.z * (1.f + sc.z) + sh.z; o[q * 4 + 3] = v[h * 8 + q * 4 + 3] * r * gg.w * (1.f + sc.w) + sh.w;
                }
                *reinterpret_cast<u32x4*>(H + c) = u32x4{pack_bf2(o[0], o[1]), pack_bf2(o[2], o[3]), pack_bf2(o[4], o[5]), pack_bf2(o[6], o[7])};
#pragma unroll
                for (int q = 0; q < 8; ++q) hq[h * 8 + q] = o[q];
            }
            if (which) {
                float am = 0.f;
#pragma unroll
                for (int i = 0; i < 16; ++i) am = fmaxf(am, fabsf(hq[i]));
#pragma unroll
                for (int o2 = 32; o2 >= 1; o2 >>= 1) am = fmaxf(am, shfl_x(am, lane, o2));
                const float sc8 = am > 0.f ? 127.f / am : 1.f;
#pragma unroll
                for (int h = 0; h < 2; ++h) {
                    uint2 w;
                    w.x = pack4_i8(q8(hq[h * 8] * sc8), q8(hq[h * 8 + 1] * sc8), q8(hq[h * 8 + 2] * sc8), q8(hq[h * 8 + 3] * sc8));
                    w.y = pack4_i8(q8(hq[h * 8 + 4] * sc8), q8(hq[h * 8 + 5] * sc8), q8(hq[h * 8 + 6] * sc8), q8(hq[h * 8 + 7] * sc8));
                    *reinterpret_cast<uint2*>(p.ws + OFF_H8I + (size_t)t * D + h * 512 + lane * 8) = w;
                }
                if (lane == 0) ((float*)(p.ws + OFF_HSC))[t] = am > 0.f ? am * (1.f / 127.f) : 1.f;
            }
        }
    }
}
__device__ void ph_sgu_norm(const Params& p, int l, const int wv) {
    const int tid = opaque_tid(wv);
    const int lane = tid & 63;
    const int gw = blockIdx.x * 8 + (tid >> 6), nw = gridDim.x * 8;
    for (int t = gw; t < NTOK; t += nw) {
        const bf16_t* AV = (const bf16_t*)(p.ws + OFF_AV) + (size_t)t * 256;
        float v[4]; float ss = 0.f;
#pragma unroll
        for (int i = 0; i < 4; ++i) { v[i] = bf2f(AV[i * 64 + lane]); ss += v[i] * v[i]; }
        ss = wave_sum(ss);
        float r = rsqrtf(ss / 256.f + EPS);
#pragma unroll
        for (int i = 0; i < 4; ++i) ((bf16_t*)(p.ws + OFF_AVN))[(size_t)t * 256 + i * 64 + lane] = f2bf(v[i] * r * p.in[I_SGUNG][l * 256 + i * 64 + lane]);
    }
}
__device__ void ph_sgu_mix(const Params& p, int l, const int wv) {
    const int tid = opaque_tid(wv);
    const bf16_t* AVN = (const bf16_t*)(p.ws + OFF_AVN);
    for (size_t idx = GTID; idx < (size_t)NTOK * 256; idx += GNT) {
        int t = (int)(idx >> 8), c = (int)(idx & 255);
        int t0 = t & ~127, pp = t & 127, g = c >> 6;
        const bf16_t* W = (const bf16_t*)(p.ws + OFF_SGUW) + (((size_t)l * 4 + g) * 128 + pp) * 128;
        float acc = 0.f;
        for (int q = 0; q < 128; ++q) acc += bf2f(W[q]) * bf2f(AVN[(size_t)(t0 + q) * 256 + c]);
        acc += p.in[I_SGUB][(l * 4 + g) * 128 + pp];
        float au = bf2f(((const bf16_t*)(p.ws + OFF_AU))[(size_t)t * 256 + c]);
        ((bf16_t*)(p.ws + OFF_MIX))[(size_t)t * D + c] = f2bf(au * acc);
    }
}
__device__ void ph_attn_ref(const Params& p, int l, const int wv) {
    const int tid = opaque_tid(wv);
    const int lane = tid & 63;
    const int gw = blockIdx.x * 8 + (tid >> 6), nw = gridDim.x * 8;
    const float lam = lam_of(p, l);
    for (int item = gw; item < NTOK * 12; item += nw) {
        const int t = item % NTOK, hh = item / NTOK;
        const bool prompt = t < NPT;
        const int b = prompt ? t / SEQ : (t - NPT) / DSEQ;
        const int nk = prompt ? SEQ : NKS;
        if (hh < 4) {
            const int h = hh;
            const bf16_t* K = prompt ? (const bf16_t*)(p.ws + OFF_DKP) + ((size_t)b * 4 + h) * SEQ * 64 : (const bf16_t*)(p.ws + OFF_DKS) + ((size_t)b * 4 + h) * NKS * 64;
            const bf16_t* Vt = prompt ? (const bf16_t*)(p.ws + OFF_DVTP) + ((size_t)b * 4 + h) * 64 * SEQ : (const bf16_t*)(p.ws + OFF_DVTS) + ((size_t)b * 4 + h) * 64 * NKS;
            float q = bf2f(((const bf16_t*)(p.ws + OFF_DQ))[(size_t)t * 256 + h * 64 + lane]);
            const float scale = 0.17677669529663687f;
            float m0 = -1e30f, m1 = -1e30f, l0 = 0.f, l1 = 0.f, a0 = 0.f, a1 = 0.f;
            for (int k = 0; k < nk; ++k) {
                float pr = q * bf2f(K[(size_t)k * 64 + lane]);
#pragma unroll
                for (int o = 16; o >= 1; o >>= 1) pr += shfl_x(pr, lane, o);
                float s0 = shfl_i(pr, 0) * scale, s1 = shfl_i(pr, 32) * scale;
                float v = bf2f(Vt[(size_t)lane * nk + k]);
                float mn0 = fmaxf(m0, s0), mn1 = fmaxf(m1, s1);
                float c0 = expf(m0 - mn0), c1 = expf(m1 - mn1);
                float e0 = expf(s0 - mn0), e1 = expf(s1 - mn1);
                l0 = l0 * c0 + e0; l1 = l1 * c1 + e1;
                a0 = a0 * c0 + e0 * v; a1 = a1 * c1 + e1 * v;
                m0 = mn0; m1 = mn1;
            }
            float o = a0 / l0 - lam * a1 / l1;
            float ss = wave_sum(o * o);
            float r = rsqrtf(ss / 64.f + EPS);
            o = o * r * p.in[I_SUBLN][l * 64 + lane] * (1.f - lam_init_of(l));
            ((bf16_t*)(p.ws + OFF_MIX))[(size_t)t * D + 256 + h * 64 + lane] = f2bf(o);
        } else {
            const int hq = hh - 4, kv = hq >> 2;
            const bf16_t* K = prompt ? (const bf16_t*)(p.ws + OFF_GKP) + ((size_t)b * 2 + kv) * SEQ * 64 : (const bf16_t*)(p.ws + OFF_GKS) + ((size_t)b * 2 + kv) * NKS * 64;
            const bf16_t* Vt = prompt ? (const bf16_t*)(p.ws + OFF_GVTP) + ((size_t)b * 2 + kv) * 64 * SEQ : (const bf16_t*)(p.ws + OFF_GVTS) + ((size_t)b * 2 + kv) * 64 * NKS;
            float q = bf2f(((const bf16_t*)(p.ws + OFF_GQ))[(size_t)t * 512 + hq * 64 + lane]);
            float m = -1e30f, ls = 0.f, a = 0.f;
            for (int k = 0; k < nk; ++k) {
                float s = wave_sum(q * bf2f(K[(size_t)k * 64 + lane])) * 0.125f;
                float v = bf2f(Vt[(size_t)lane * nk + k]);
                float mn = fmaxf(m, s);
                float c = expf(m - mn), e = expf(s - mn);
                ls = ls * c + e; a = a * c + e * v; m = mn;
            }
            ((bf16_t*)(p.ws + OFF_MIX))[(size_t)t * D + 512 + hq * 64 + lane] = f2bf(a / ls);
        }
    }
}
__device__ void ph_peer_scores(const Params& p, int l, const int wv) {
    const int tid = opaque_tid(wv);
    const bf16_t* SK = (const bf16_t*)(p.ws + OFF_SUBK) + (size_t)l * 2 * 128 * 64;
    for (size_t idx = GTID; idx < (size_t)NTOK * 2048; idx += GNT) {
        int t = (int)(idx >> 11), o = (int)(idx & 2047);
        const bf16_t* Q = (const bf16_t*)(p.ws + OFF_Q) + (size_t)t * D;
        int n = o & 127, x = (o >> 7) & 1, h = o >> 8;
        float acc = 0.f;
        for (int k = 0; k < 64; ++k) acc += bf2f(Q[h * 128 + x * 64 + k]) * bf2f(SK[((size_t)x * 128 + n) * 64 + k]);
        ((float*)(p.ws + OFF_PROJ))[idx] = acc;
    }
}
__device__ void ph_peer_top1(const Params& p, const int wv) {
    const int tid = opaque_tid(wv);
    for (size_t idx = GTID; idx < (size_t)NTOK * 16; idx += GNT) {
        const float* SC = (const float*)(p.ws + OFF_PROJ) + idx * 128;
        float* TV = (float*)(p.ws + OFF_TOPV) + idx * 16; int* TI = (int*)(p.ws + OFF_TOPI) + idx * 16;
        float pv = 3.0e38f; int pi = -1;
        for (int r = 0; r < 16; ++r) {
            float bv = -3.0e38f; int bi = -1;
            for (int n = 0; n < 128; ++n) {
                float v = SC[n];
                bool after = (v < pv) || (v == pv && n > pi);
                if (after && (bi < 0 || v > bv)) { bv = v; bi = n; }
            }
            TV[r] = bv; TI[r] = bi; pv = bv; pi = bi;
        }
    }
}
__device__ void ph_peer_top2(const Params& p, const int wv) {
    const int tid = opaque_tid(wv);
    for (size_t idx = GTID; idx < (size_t)NTOK * 8; idx += GNT) {
        const float* TV = (const float*)(p.ws + OFF_TOPV) + idx * 32; const int* TI = (const int*)(p.ws + OFF_TOPI) + idx * 32;
        int* EI = (int*)(p.ws + OFF_EIDX) + idx * 16; float* EG = (float*)(p.ws + OFF_EGATE) + idx * 16;
        float pv = 3.0e38f; int pi = -1; float mx = 0.f, sum = 0.f;
        for (int r = 0; r < 16; ++r) {
            float bv = -3.0e38f; int bi = -1;
            for (int n = 0; n < 256; ++n) {
                float v = TV[n >> 4] + TV[16 + (n & 15)];
                bool after = (v < pv) || (v == pv && n > pi);
                if (after && (bi < 0 || v > bv)) { bv = v; bi = n; }
            }
            if (r == 0) mx = bv;
            float e = expf(bv - mx);
            sum += e;
            EG[r] = e; EI[r] = TI[bi >> 4] * 128 + TI[16 + (bi & 15)];
            pv = bv; pi = bi;
        }
        float inv = 1.f / sum;
        for (int r = 0; r < 16; ++r) EG[r] *= inv;
    }
}
__device__ void ph_peer_apply(const Params& p, int l, unsigned char* lds, const int wv) {
    const int tid = opaque_tid(wv);
    const int sub = tid >> 8, tl = tid & 255;
    const int wave = tl >> 6, lane = tl & 63;
    float* wts = (float*)(lds + 64) + sub * 128; int* eid = (int*)(lds + 64 + 1024) + sub * 128;
    const bf16_t* UT = (const bf16_t*)(p.ws + OFF_UT) + (size_t)l * NEXP * D;
    const bf16_t* VT = (const bf16_t*)(p.ws + OFF_VT) + (size_t)l * NEXP * D;
    const int niter = (NTOK + gridDim.x * 2 - 1) / (gridDim.x * 2);
    for (int it = 0; it < niter; ++it) {
        int t = (it * gridDim.x + blockIdx.x) * 2 + sub;
        const bool valid = t < NTOK; if (!valid) t = NTOK - 1;
        const bf16_t* H = (const bf16_t*)(p.ws + OFF_H) + (size_t)t * D;
        const int* EI = (const int*)(p.ws + OFF_EIDX) + (size_t)t * 128; const float* EG = (const float*)(p.ws + OFF_EGATE) + (size_t)t * 128;
        float hv[16];
#pragma unroll
        for (int i = 0; i < 16; ++i) hv[i] = bf2f(H[lane * 16 + i]);
        for (int jj = 0; jj < 32; ++jj) {
            int j = wave * 32 + jj; int e = EI[j];
            const bf16_t* ur = UT + (size_t)e * D + lane * 16;
            float acc = 0.f;
#pragma unroll
            for (int i = 0; i < 16; ++i) acc += hv[i] * bf2f(ur[i]);
            acc = wave_sum(acc);
            if (lane == 0) { wts[j] = EG[j] * gelu_f(acc); eid[j] = e; }
        }
        __syncthreads();
        float o[4] = {0.f, 0.f, 0.f, 0.f};
        for (int j = 0; j < 128; ++j) {
            const bf16_t* vr = VT + (size_t)eid[j] * D + tl * 4; float w = wts[j];
#pragma unroll
            for (int i = 0; i < 4; ++i) o[i] += w * bf2f(vr[i]);
        }
        const float* mod = (const float*)(p.ws + OFF_MOD) + (size_t)(l * 5 + tok_cv(t)) * 6144 + 5 * 1024;
        float* XC = (float*)(p.ws + OFF_XC) + (size_t)t * D;
        if (valid) {
#pragma unroll
            for (int i = 0; i < 4; ++i) { int c = tl * 4 + i; XC[c] += mod[c] * o[i]; }
        }
        __syncthreads();
    }
}
__device__ void ph_final_norm(const Params& p, const int wv) {
    const int tid = opaque_tid(wv);
    const int lane = tid & 63;
    const int gw = blockIdx.x * 8 + (tid >> 6), nw = gridDim.x * 8;
    u32x4 nx[2];
    {
        const int t = gw < NTOK ? gw : NTOK - 1;
        const bf16_t* xr = (const bf16_t*)(p.ws + OFF_XC) + (size_t)t * D + lane * 8;
        nx[0] = *reinterpret_cast<const u32x4*>(xr); nx[1] = *reinterpret_cast<const u32x4*>(xr + 512);
    }
    for (int t = gw; t < NTOK; t += nw) {
        float v[16];
#pragma unroll
        for (int h = 0; h < 2; ++h)
#pragma unroll
            for (int k = 0; k < 4; ++k) { v[h * 8 + 2 * k] = __uint_as_float(nx[h][k] << 16); v[h * 8 + 2 * k + 1] = __uint_as_float(nx[h][k] & 0xffff0000u); }
        {
            const int tn = t + nw < NTOK ? t + nw : t;
            const bf16_t* xn = (const bf16_t*)(p.ws + OFF_XC) + (size_t)tn * D + lane * 8;
            nx[0] = *reinterpret_cast<const u32x4*>(xn); nx[1] = *reinterpret_cast<const u32x4*>(xn + 512);
        }
        float ss = 0.f;
#pragma unroll
        for (int i = 0; i < 16; ++i) ss += v[i] * v[i];
        ss = wave_sum(ss);
        float r = rsqrtf(ss / D + EPS);
        float* y = p.out + (size_t)t * D;
#pragma unroll
        for (int h = 0; h < 2; ++h) {
            const int c = h * 512 + lane * 8;
#pragma unroll
            for (int q = 0; q < 2; ++q) {
                const float4 g = *reinterpret_cast<const float4*>(p.in[I_FG] + c + q * 4);
                *reinterpret_cast<float4*>(y + c + q * 4) = make_float4(v[h * 8 + q * 4] * r * g.x, v[h * 8 + q * 4 + 1] * r * g.y, v[h * 8 + q * 4 + 2] * r * g.z, v[h * 8 + q * 4 + 3] * r * g.w);
            }
        }
    }
}


namespace g8 {
constexpr int BM = 256, BK = 64, HALF = 128, HT = HALF * BK;
__device__ __forceinline__ int lds_byte(int r, int c) {
    int st = (r >> 4) * 2 + (c >> 5), rr = r & 15, cc = c & 31, ob = rr * 64 + cc * 2;
    return st * 1024 + (ob ^ (((ob >> 9) & 1) << 5));
}
__device__ __forceinline__ void stage_rc(int b, int& R, int& C) {
    int st = b / 1024, sb = b % 1024, swz = sb ^ (((sb >> 9) & 1) << 5);
    R = (st >> 1) * 16 + swz / 64; C = (st & 1) * 32 + (swz % 64) / 2;
}
}
enum { EPI_INPROJ = 0, EPI_WOUT = 1, EPI_WQ = 2 };
constexpr int STG = 132;

__device__ __forceinline__ void store_bf16x32(bf16_t* dst, const float (&v)[32]) {
#pragma unroll
    for (int i = 0; i < 4; ++i) {
        uint4 u;
        u.x = pack_bf2(v[i * 8 + 0], v[i * 8 + 1]); u.y = pack_bf2(v[i * 8 + 2], v[i * 8 + 3]);
        u.z = pack_bf2(v[i * 8 + 4], v[i * 8 + 5]); u.w = pack_bf2(v[i * 8 + 6], v[i * 8 + 7]);
        *reinterpret_cast<uint4*>(dst + i * 8) = u;
    }
}
__device__ __forceinline__ void store_f32x32(float* dst, const float (&v)[32]) {
#pragma unroll
    for (int i = 0; i < 8; ++i) *reinterpret_cast<float4*>(dst + i * 4) = make_float4(v[i * 4], v[i * 4 + 1], v[i * 4 + 2], v[i * 4 + 3]);
}

__device__ __forceinline__ void epi_inproj_xform(const Params& p, int l, int t, int c0, float (&v)[32]) {
    const bool prompt = t < NPT;
    const int s = prompt ? (t & 255) : ((t - NPT) & 2047);
    const float* R = (const float*)(p.ws + OFF_ROPE);
    if (c0 < 512) {
#pragma unroll
        for (int i = 0; i < 32; ++i) v[i] = gelu_f(v[i]);
    } else if (c0 < 1024) {
        if (!prompt) {
            const float* cs = R + s * 16; const float* sn = R + 2048 * 16 + s * 16;
#pragma unroll
            for (int i = 0; i < 16; ++i) {
                float c = cs[i], sv = sn[i], x1 = v[i], x2 = v[i + 16];
                v[i] = x1 * c - x2 * sv; v[i + 16] = x2 * c + x1 * sv;
            }
        }
    } else if (c0 >= 1280 && c0 < 1920) {
        const bool isq = c0 < 1792;
        const int hi = c0 & 32;
        const float* g = p.in[isq ? I_QNG : I_KNG] + l * 64 + hi;
        float ss = 0.f;
#pragma unroll
        for (int i = 0; i < 32; ++i) ss += v[i] * v[i];
        const int ln = lane_id_op();
        ss += shfl_x(ss, ln, 1);
        const float rr = rsqrtf(ss * (1.f / 64.f) + EPS);
#pragma unroll
        for (int i = 0; i < 32; ++i) v[i] = v[i] * rr * g[i];
        if (!prompt) {
            const float* cs = R + 2048 * 32 + s * 32; const float* sn = R + 2048 * 64 + s * 32;
#pragma unroll
            for (int i = 0; i < 32; ++i) {
                float pv = shfl_x(v[i], ln, 1);
                float c = cs[i], sv = sn[i];
                v[i] = hi ? (v[i] * c + pv * sv) : (v[i] * c - pv * sv);
            }
        }
        if (isq) {
#pragma unroll
            for (int i = 0; i < 32; ++i) v[i] *= 0.125f * 1.4426950408889634f;
        }
    }
}
__device__ __forceinline__ void epi_inproj_col(const Params& p, int t0, int c, const LAS float* stc) {
    float v[32];
#pragma unroll
    for (int i = 0; i < 32; ++i) v[i] = stc[i * STG];
    const bool prompt = t0 < NPT;
    const int b = prompt ? (t0 >> 8) : ((t0 - NPT) >> 11);
    const int s = prompt ? (t0 & 255) : ((t0 - NPT) & 2047);
    unsigned char* ws = p.ws;
    bf16_t* dst;
    if (c < 1280) {
        const int cc = c - 1024, h = cc >> 6, d = cc & 63;
        dst = prompt ? (bf16_t*)(ws + OFF_DVTP) + (((size_t)b * 4 + h) * 64 + d) * SEQ + s
                     : (bf16_t*)(ws + OFF_DVTS) + (((size_t)b * 4 + h) * 64 + d) * NKS + s;
    } else {
        const int cc = c - 1920, kv = cc >> 6, d = cc & 63;
        dst = prompt ? (bf16_t*)(ws + OFF_GVTP) + (((size_t)b * 2 + kv) * 64 + d) * SEQ + s
                     : (bf16_t*)(ws + OFF_GVTS) + (((size_t)b * 2 + kv) * 64 + d) * NKS + s;
    }
    store_bf16x32(dst, v);
}

template <int MODE>
__device__ __forceinline__ void gemm_phase(const Params& p, int l, const bf16_t* __restrict__ A, const bf16_t* __restrict__ Bt, const int N, unsigned char* ldsraw, const int wv,
                                           const size_t cvstride = 0, const float* __restrict__ RSS = nullptr, const float* __restrict__ BIAS = nullptr) {
    using namespace g8;
    constexpr int K = 1024, nt = K / BK, BN = 128, TILE_A = BM * BK * 2, TILE_B = BN * BK * 2, STAGE_B = TILE_A + TILE_B;
    LAS unsigned char* lds = (LAS unsigned char*)ldsraw;
    const int tid = opaque_tid(wv), wid = wv, lane = tid & 63;
    const int wr = wid >> 1, wc = wid & 1, fr = lane & 15, fq = lane >> 4;
    unsigned voff[4];
#pragma unroll
    for (int i = 0; i < 4; ++i) voff[i] = (unsigned)((i * 64 + wid * 8 + (lane >> 3)) * K + (((lane & 7) ^ (lane >> 3)) * 8)) * 2u;
    const int aoff = (wr * 64 + fr) * 128 + ((fq ^ (fr & 7)) * 16), boff = (wc * 64 + fr) * 128 + ((fq ^ (fr & 7)) * 16);
    const unsigned ldsw = (unsigned)wid * 1024u;
#define G8_STAGE(buf, kt) do { \
        _Pragma("unroll") for (int _i = 0; _i < 4; ++_i) \
            __builtin_amdgcn_global_load_lds((const unsigned*)((const char*)(Ab + (kt) * BK) + voff[_i]), (LAS unsigned*)(lds + (buf) * STAGE_B + ldsw + _i * 8192), 16, 0, 0); \
        _Pragma("unroll") for (int _i = 0; _i < 2; ++_i) \
            __builtin_amdgcn_global_load_lds((const unsigned*)((const char*)(Bb + (kt) * BK) + voff[_i]), (LAS unsigned*)(lds + (buf) * STAGE_B + TILE_A + ldsw + _i * 8192), 16, 0, 0); } while (0)
#define G8_WAIT_V0() asm volatile("s_waitcnt vmcnt(0)" ::: "memory")
    const int nN = N / BN, nM = NTOK / BM, ntiles = nM * nN;
    const int G = gridDim.x;
    const int vb = (G % 8 == 0) ? (int)(blockIdx.x % 8) * (G / 8) + (int)(blockIdx.x / 8) : (int)blockIdx.x;
    const int tpb = (ntiles + G - 1) / G;
    const bool paneled = (G == 256) && (nN == 8 || nN == 16) && (nM == 64);
    for (int ti = 0; ti < tpb; ++ti) {
        int tile = vb * tpb + ti;
        if (paneled) {
            const int x = vb >> 5, j = vb & 31;
            const int mpx = nN == 16 ? 16 : 8;
            const int m0 = nN == 16 ? (x >> 1) * 16 : x * 8, n0 = nN == 16 ? (x & 1) * 8 : 0;
            const int pm_ = m0 + ti * 4 + (j >> 3), pn_ = n0 + (j & 7);
            tile = (ti * 4 < mpx) ? pm_ * nN + pn_ : ntiles;
        }
        if (tile >= ntiles) break;
        const int pm = tile / nN, pn = tile % nN, brow = pm * BM, bcol = pn * BN;
        const bf16_t* Ab = A + (size_t)brow * K; const bf16_t* Bb = Bt + (size_t)tok_cv(brow) * cvstride + (size_t)bcol * K;
        f32x4 acc[4][4];
#pragma unroll
        for (int m = 0; m < 4; ++m)
#pragma unroll
            for (int n = 0; n < 4; ++n) acc[m][n] = f32x4{0.f, 0.f, 0.f, 0.f};
        G8_WAIT_V0();
        float4 rsa = make_float4(0.f, 0.f, 0.f, 0.f), rsb = rsa; float bz[4] = {0.f, 0.f, 0.f, 0.f};
        if (MODE != EPI_WOUT && cvstride != 0) {
            const float* rp = RSS + (size_t)(brow + (tid & 255)) * 8;
            rsa = *reinterpret_cast<const float4*>(rp); rsb = *reinterpret_cast<const float4*>(rp + 4);
#pragma unroll
            for (int n = 0; n < 4; ++n) bz[n] = BIAS[(size_t)tok_cv(brow) * N + bcol + wc * 64 + n * 16 + fr];
        }
        G8_STAGE(0, 0); G8_STAGE(1, 1);
        int cur = 0;
        for (int t = 0; t < nt; ++t) {
            if (t + 1 < nt) asm volatile("s_waitcnt vmcnt(6)" ::: "memory"); else asm volatile("s_waitcnt vmcnt(0)" ::: "memory");
            __builtin_amdgcn_s_barrier();
            if (t + 2 < nt) { const int nb = cur >= 1 ? cur - 1 : 2; G8_STAGE(nb, t + 2); }
            {
                bf16x8 At[2][4], Bf[2][4];
#pragma unroll
                for (int ks = 0; ks < 2; ++ks) {
#pragma unroll
                    for (int m = 0; m < 4; ++m) At[ks][m] = *(const LAS bf16x8*)(lds + cur * STAGE_B + ((aoff + m * 2048) ^ (ks * 64)));
#pragma unroll
                    for (int n = 0; n < 4; ++n) Bf[ks][n] = *(const LAS bf16x8*)(lds + cur * STAGE_B + TILE_A + ((boff + n * 2048) ^ (ks * 64)));
                }
                __builtin_amdgcn_sched_barrier(0);
#pragma unroll
                for (int ks = 0; ks < 2; ++ks)
#pragma unroll
                    for (int m = 0; m < 4; ++m)
#pragma unroll
                        for (int n = 0; n < 4; ++n) acc[m][n] = __builtin_amdgcn_mfma_f32_16x16x32_bf16(At[ks][m], Bf[ks][n], acc[m][n], 0, 0, 0);
                __builtin_amdgcn_sched_barrier(0);
            }
            cur = cur == 2 ? 0 : cur + 1;
        }
        __syncthreads();
        LAS float* st = (LAS float*)lds;
        if (MODE != EPI_WOUT && cvstride != 0) {
            LAS float* rs = st + 256 * STG;
            if (tid < 256) rs[tid] = rsqrtf((((rsa.x + rsa.y) + (rsa.z + rsa.w)) + ((rsb.x + rsb.y) + (rsb.z + rsb.w))) * (1.f / D) + EPS);
            __syncthreads();
#pragma unroll
            for (int m = 0; m < 4; ++m)
#pragma unroll
                for (int j = 0; j < 4; ++j) {
                    const float r = rs[wr * 64 + m * 16 + fq * 4 + j];
#pragma unroll
                    for (int n = 0; n < 4; ++n) st[(wr * 64 + m * 16 + fq * 4 + j) * STG + wc * 64 + n * 16 + fr] = acc[m][n][j] * r + bz[n];
                }
        } else {
#pragma unroll
        for (int m = 0; m < 4; ++m)
#pragma unroll
            for (int n = 0; n < 4; ++n)
#pragma unroll
                for (int j = 0; j < 4; ++j)
                    st[(wr * 64 + m * 16 + fq * 4 + j) * STG + wc * 64 + n * 16 + fr] = acc[m][n][j];
        }
        __syncthreads();
        const bool tprompt = brow < NPT;
        const int tb_ = tprompt ? (brow >> 8) : ((brow - NPT) >> 11), ts0 = tprompt ? 0 : ((brow - NPT) & 2047);
        if (MODE == EPI_INPROJ) {
            const bool vtile = (bcol >= 1024 && bcol < 1280);
            if (!vtile) {
#pragma unroll 1
                for (int it = 0; it < 2; ++it) {
                    const int item = it * NT + tid, erow = item >> 2, eseg = item & 3;
                    float v[32];
#pragma unroll
                    for (int i = 0; i < 8; ++i) {
                        const f32x4 f = *(const LAS f32x4*)(st + erow * STG + eseg * 32 + i * 4);
                        v[i * 4] = f[0]; v[i * 4 + 1] = f[1]; v[i * 4 + 2] = f[2]; v[i * 4 + 3] = f[3];
                    }
                    epi_inproj_xform(p, l, brow + erow, bcol + eseg * 32, v);
#pragma unroll
                    for (int i = 0; i < 8; ++i) *(LAS f32x4*)(st + erow * STG + eseg * 32 + i * 4) = f32x4{v[i * 4], v[i * 4 + 1], v[i * 4 + 2], v[i * 4 + 3]};
                }
                __syncthreads();
#pragma unroll 1
                for (int it = 0; it < 8; ++it) {
                    const int item = it * NT + tid, r = item >> 4, c = (item & 15) * 8;
                    const f32x4 f0 = *(const LAS f32x4*)(st + r * STG + c), f1 = *(const LAS f32x4*)(st + r * STG + c + 4);
                    const int t = brow + r, sp = ts0 + r;
                    bf16_t* dst;
                    if (bcol < 512)        dst = (bf16_t*)(p.ws + (bcol < 256 ? OFF_AU : OFF_AV)) + (size_t)t * 256 + (bcol & 255) + c;
                    else if (bcol < 768)   dst = (bf16_t*)(p.ws + OFF_DQ) + (size_t)t * 256 + (bcol - 512) + c;
                    else if (bcol < 1024) { const int cc = bcol - 768 + c, h = cc >> 6;
                                            dst = tprompt ? (bf16_t*)(p.ws + OFF_DKP) + (((size_t)tb_ * 4 + h) * SEQ + sp) * 64 + (cc & 63)
                                                          : (bf16_t*)(p.ws + OFF_DKS) + (((size_t)tb_ * 4 + h) * NKS + sp) * 64 + (cc & 63); }
                    else if (bcol < 1792)  dst = (bf16_t*)(p.ws + OFF_GQ) + (size_t)t * 512 + (bcol - 1280) + c;
                    else                 { const int kv = c >> 6, d0 = c & 63;
                                            const size_t hb = (tprompt ? ((size_t)tb_ * 2 + kv) * SEQ * 64 : ((size_t)tb_ * 2 + kv) * NKS * 64) + (size_t)(sp >> 6) * 4096;
                                            dst = bcol < 1920 ? (bf16_t*)(p.ws + (tprompt ? OFF_GKP : OFF_GKS)) + hb + (d0 >> 3) * 512 + (sp & 63) * 8
                                                              : (bf16_t*)(p.ws + (tprompt ? OFF_GVTP : OFF_GVTS)) + hb + (d0 >> 5) * 2048 + (sp & 63) * 32 + (d0 & 31); }
                    *reinterpret_cast<u32x4*>(dst) = u32x4{pack_bf2(f0[0], f0[1]), pack_bf2(f0[2], f0[3]), pack_bf2(f1[0], f1[1]), pack_bf2(f1[2], f1[3])};
                }
            }
            if (tprompt && ((bcol >= 768 && bcol < 1280) || bcol >= 1792)) {
                float* ob; int rs;
                if (bcol < 1024)      { ob = p.out + OUT_NDK + (((size_t)tb_ * 2 + l) * SEQ) * 256 + (bcol - 768);  rs = 256; }
                else if (bcol < 1280) { ob = p.out + OUT_NDV + (((size_t)tb_ * 2 + l) * SEQ) * 256 + (bcol - 1024); rs = 256; }
                else if (bcol < 1920) { ob = p.out + OUT_NGK + (((size_t)tb_ * 2 + l) * SEQ) * 128;                 rs = 128; }
                else                  { ob = p.out + OUT_NGV + (((size_t)tb_ * 2 + l) * SEQ) * 128;                 rs = 128; }
#pragma unroll 1
                for (int it = 0; it < 16; ++it) {
                    const int item = it * NT + tid, r = item >> 5, c = (item & 31) * 4;
                    *reinterpret_cast<f32x4*>(ob + (size_t)r * rs + c) = *(const LAS f32x4*)(st + r * STG + c);
                }
            }
            if (vtile) {
#pragma unroll 1
                for (int it = 0; it < 2; ++it) {
                    const int item = it * NT + tid, col = item >> 3, run = item & 7;
                    epi_inproj_col(p, brow + run * 32, bcol + col, st + run * 32 * STG + col);
                }
            }
        } else {
            float4 ga = make_float4(0.f, 0.f, 0.f, 0.f), gb = ga, na = ga, nb = ga, sa = ga, sb = ga;
            float4 xna = ga, xnb = ga; u32x4 xnw = {0u, 0u, 0u, 0u};
            if (MODE == EPI_WOUT) {
                const int c = (tid & 15) * 8;
                const float* g1 = (const float*)(p.ws + OFF_MOD) + (size_t)(l * 5 + tok_cv(brow)) * 6144 + 2048 + bcol + c;
                ga = *reinterpret_cast<const float4*>(g1); gb = *reinterpret_cast<const float4*>(g1 + 4);
                sa = *reinterpret_cast<const float4*>(g1 + 2048); sb = *reinterpret_cast<const float4*>(g1 + 2048 + 4);
                const float* gn = p.in[I_N2G] + l * D + bcol + c;
                na = *reinterpret_cast<const float4*>(gn); nb = *reinterpret_cast<const float4*>(gn + 4);
                const int t = brow + (tid >> 4);
                if (l == 0) { const float* xr = x_in_row(p, t) + bcol + c; xna = *reinterpret_cast<const float4*>(xr); xnb = *reinterpret_cast<const float4*>(xr + 4); }
                else xnw = *reinterpret_cast<const u32x4*>((const bf16_t*)(p.ws + OFF_XC) + (size_t)t * D + bcol + c);
            }
#pragma unroll 1
            for (int it = 0; it < 8; ++it) {
                const int item = it * NT + tid, r = item >> 4, c = (item & 15) * 8;
                const f32x4 f0 = *(const LAS f32x4*)(st + r * STG + c), f1 = *(const LAS f32x4*)(st + r * STG + c + 4);
                const int t = brow + r;
                float o[8] = {f0[0], f0[1], f0[2], f0[3], f1[0], f1[1], f1[2], f1[3]};
                if (MODE == EPI_WOUT) {
                    float x[8];
                    if (l == 0) { x[0] = xna.x; x[1] = xna.y; x[2] = xna.z; x[3] = xna.w; x[4] = xnb.x; x[5] = xnb.y; x[6] = xnb.z; x[7] = xnb.w; }
                    else {
#pragma unroll
                        for (int k = 0; k < 4; ++k) { x[2 * k] = __uint_as_float(xnw[k] << 16); x[2 * k + 1] = __uint_as_float(xnw[k] & 0xffff0000u); }
                    }
                    {
                        const int tn = brow + (((it < 7 ? it + 1 : it) * NT + tid) >> 4);
                        if (l == 0) { const float* xr = x_in_row(p, tn) + bcol + c; xna = *reinterpret_cast<const float4*>(xr); xnb = *reinterpret_cast<const float4*>(xr + 4); }
                        else xnw = *reinterpret_cast<const u32x4*>((const bf16_t*)(p.ws + OFF_XC) + (size_t)tn * D + bcol + c);
                    }
                    o[0] = x[0] + ga.x * o[0]; o[1] = x[1] + ga.y * o[1]; o[2] = x[2] + ga.z * o[2]; o[3] = x[3] + ga.w * o[3];
                    o[4] = x[4] + gb.x * o[4]; o[5] = x[5] + gb.y * o[5]; o[6] = x[6] + gb.z * o[6]; o[7] = x[7] + gb.w * o[7];
                    float xg[8] = {o[0] * na.x * (1.f + sa.x), o[1] * na.y * (1.f + sa.y), o[2] * na.z * (1.f + sa.z), o[3] * na.w * (1.f + sa.w),
                                   o[4] * nb.x * (1.f + sb.x), o[5] * nb.y * (1.f + sb.y), o[6] * nb.z * (1.f + sb.z), o[7] * nb.w * (1.f + sb.w)};
                    float ss = 0.f, am = 0.f;
#pragma unroll
                    for (int i = 0; i < 8; ++i) { ss += o[i] * o[i]; am = fmaxf(am, fabsf(xg[i])); }
                    ss = row16_sum(ss); am = row16_max(am);
                    const float sc8 = am > 0.f ? 127.f / am : 1.f;
                    uint2 w8;
                    w8.x = pack4_i8(q8(xg[0] * sc8), q8(xg[1] * sc8), q8(xg[2] * sc8), q8(xg[3] * sc8));
                    w8.y = pack4_i8(q8(xg[4] * sc8), q8(xg[5] * sc8), q8(xg[6] * sc8), q8(xg[7] * sc8));
                    *reinterpret_cast<uint2*>(p.ws + OFF_H8I + (size_t)t * D + bcol + c) = w8;
                    if ((item & 15) == 0) {
                        ((float*)(p.ws + OFF_RSS2))[((size_t)l * NTOK + t) * 8 + pn] = ss;
                        ((float*)(p.ws + OFF_XGS))[(size_t)t * 8 + pn] = am > 0.f ? am * (1.f / 127.f) : 1.f;
                    }
                }
                bf16_t* dst = (bf16_t*)(p.ws + (MODE == EPI_WOUT ? OFF_XC : OFF_Q)) + (size_t)t * D + bcol + c;
                *reinterpret_cast<u32x4*>(dst) = u32x4{pack_bf2(o[0], o[1]), pack_bf2(o[2], o[3]), pack_bf2(o[4], o[5]), pack_bf2(o[6], o[7])};
            }
        }
        __syncthreads();
    }
}


template <int MODE>
__device__ __forceinline__ void gemm_phase2(const Params& p, int l, const bf16_t* __restrict__ A, const bf16_t* __restrict__ Bt, const int N, unsigned char* ldsraw, const int wv,
                                            const size_t cvstride = 0, const float* __restrict__ RSS = nullptr, const float* __restrict__ BIAS = nullptr) {
    using namespace g8;
    constexpr int K = 1024, nt = K / BK, HTB = HALF * BK * 2;
    LAS unsigned char* lds = (LAS unsigned char*)ldsraw;
    const int tid = opaque_tid(wv), wid = wv, lane = tid & 63;
    const int wr = wid >> 2, wc = wid & 3, fr = lane & 15, fq = lane >> 4;
    unsigned voffA[2];
#pragma unroll
    for (int i = 0; i < 2; ++i) { int R, C; stage_rc(tid * 16 + i * 8192, R, C); voffA[i] = (unsigned)(R * K + C) * 2u; }
    constexpr size_t kstep = (size_t)(BK * 2), hstep = (size_t)HALF * K * 2, tstep = 2 * hstep;
    const unsigned ldsw = (unsigned)wid * 1024u;
    const int aoff = lds_byte(wr * 64 + fr, fq * 8), boff = lds_byte(wc * 32 + fr, fq * 8);
#define PG8_SA(b, h) (((b) * 2 + (h)) * HTB)
#define PG8_SB(b, h) ((4 + (b) * 2 + (h)) * HTB)
#define PG8_STAGE(bufoff, gbase) do { _Pragma("unroll") for (int _i = 0; _i < 2; ++_i) \
        __builtin_amdgcn_global_load_lds((const unsigned*)((const char*)(gbase) + voffA[_i]), (LAS unsigned*)(lds + (bufoff) + ldsw + _i * 8192), 16, 0, 0); } while (0)
#define PG8_LDA(dst, b, h) do { _Pragma("unroll") for (int m = 0; m < 4; ++m) _Pragma("unroll") for (int k = 0; k < 2; ++k) dst[m][k] = *(const LAS bf16x8*)(lds + PG8_SA(b, h) + aoff + m * 2048 + k * 1024); } while (0)
#define PG8_LDB(dst, b, h) do { _Pragma("unroll") for (int n = 0; n < 2; ++n) _Pragma("unroll") for (int k = 0; k < 2; ++k) dst[n][k] = *(const LAS bf16x8*)(lds + PG8_SB(b, h) + boff + n * 2048 + k * 1024); } while (0)
#define PG8_MMA(ai, bj, At_, Bt_) do { __builtin_amdgcn_s_setprio(1); _Pragma("unroll") for (int m = 0; m < 4; ++m) _Pragma("unroll") for (int n = 0; n < 2; ++n) _Pragma("unroll") for (int k = 0; k < 2; ++k) \
        acc[ai][bj][m][n] = __builtin_amdgcn_mfma_f32_16x16x32_bf16(Bt_[n][k], At_[m][k], acc[ai][bj][m][n], 0, 0, 0); __builtin_amdgcn_s_setprio(0); } while (0)
#define PG8_WAIT_V(n) asm volatile("s_waitcnt vmcnt(" #n ")" ::: "memory")
#define PG8_WAIT_L(n) asm volatile("s_waitcnt lgkmcnt(" #n ")" ::: "memory")
#define PG8_BAR __builtin_amdgcn_s_barrier()
#define PG8_SCHED __builtin_amdgcn_sched_barrier(0)
    const int nN = N / 256, nM = NTOK / BM, ntiles = nM * nN;
    const int G = gridDim.x;
    const int vb = (G % 8 == 0) ? (int)(blockIdx.x % 8) * (G / 8) + (int)(blockIdx.x / 8) : (int)blockIdx.x;
    const int tpb = (ntiles + G - 1) / G;
    const bool paneled = (G == 256) && (nN == 4 || nN == 8) && (nM == 64);
    for (int ti = 0; ti < tpb; ++ti) {
        int tile = vb * tpb + ti;
        if (paneled) {
            const int x = vb >> 5, j = vb & 31;
            const int pm_ = nN == 8 ? x * 8 + ti * 4 + (j >> 3) : x * 8 + (j >> 2), pn_ = nN == 8 ? (j & 7) : (j & 3);
            tile = (nN == 8 ? ti < 2 : ti < 1) ? pm_ * nN + pn_ : ntiles;
        }
        if (tile >= ntiles) break;
        const int pm = tile / nN, pn = tile % nN, brow = pm * BM;
        const char* cA = (const char*)(A + (size_t)brow * K);
        const char* cB = (const char*)(Bt + (size_t)tok_cv(brow) * cvstride + (size_t)pn * 256 * K);
        f32x4 acc[2][2][4][2];
#pragma unroll
        for (int a = 0; a < 2; ++a)
#pragma unroll
            for (int b = 0; b < 2; ++b)
#pragma unroll
                for (int m = 0; m < 4; ++m)
#pragma unroll
                    for (int n = 0; n < 2; ++n) acc[a][b][m][n] = f32x4{0.f, 0.f, 0.f, 0.f};
        asm volatile("s_waitcnt vmcnt(0)" ::: "memory");
        {
            bf16x8 At[4][2], B0[2][2], B1[2][2];
            PG8_STAGE(PG8_SB(0, 0), cB); PG8_STAGE(PG8_SA(0, 0), cA); PG8_STAGE(PG8_SB(0, 1), cB + hstep); PG8_STAGE(PG8_SA(0, 1), cA + hstep);
            if (wr == 1) PG8_BAR;
            PG8_WAIT_V(4); PG8_BAR;
            PG8_STAGE(PG8_SB(1, 0), cB + kstep); PG8_STAGE(PG8_SA(1, 0), cA + kstep); PG8_STAGE(PG8_SB(1, 1), cB + hstep + kstep);
            PG8_WAIT_V(6); PG8_BAR;
            for (int t = 0; t < nt; t += 2) {
                const bool last = (t == nt - 2);
                const char* a1 = cA + (size_t)(t + 1) * kstep;
                const char* a2 = last ? cA : cA + (size_t)(t + 2) * kstep; const char* b2 = last ? cB : cB + (size_t)(t + 2) * kstep;
                const char* a3 = a2 + kstep; const char* b3 = b2 + kstep;
                PG8_LDB(B0, 0, 0); PG8_SCHED; PG8_LDA(At, 0, 0); PG8_STAGE(PG8_SA(1, 1), a1 + hstep);
                PG8_WAIT_L(8); PG8_BAR; PG8_WAIT_L(0); PG8_MMA(0, 0, At, B0); PG8_BAR; PG8_SCHED;
                PG8_LDB(B1, 0, 1); PG8_STAGE(PG8_SB(0, 0), b2);
                PG8_BAR; PG8_WAIT_L(0); PG8_MMA(0, 1, At, B1); PG8_BAR;
                PG8_LDA(At, 0, 1); PG8_STAGE(PG8_SA(0, 0), a2);
                PG8_BAR; PG8_WAIT_L(0); PG8_MMA(1, 0, At, B0); PG8_BAR; PG8_SCHED;
                PG8_STAGE(PG8_SB(0, 1), b2 + hstep);
                PG8_WAIT_V(6); PG8_BAR; PG8_MMA(1, 1, At, B1); PG8_BAR;
                PG8_LDB(B0, 1, 0); PG8_SCHED; PG8_LDA(At, 1, 0); PG8_STAGE(PG8_SA(0, 1), a2 + hstep);
                PG8_WAIT_L(8); PG8_BAR; PG8_WAIT_L(0); PG8_MMA(0, 0, At, B0); PG8_BAR; PG8_SCHED;
                PG8_LDB(B1, 1, 1); PG8_STAGE(PG8_SB(1, 0), b3);
                PG8_BAR; PG8_WAIT_L(0); PG8_MMA(0, 1, At, B1); PG8_BAR;
                PG8_LDA(At, 1, 1); PG8_STAGE(PG8_SA(1, 0), a3);
                PG8_BAR; PG8_WAIT_L(0); PG8_MMA(1, 0, At, B0); PG8_BAR; PG8_SCHED;
                PG8_STAGE(PG8_SB(1, 1), b3 + hstep);
                PG8_WAIT_V(6); PG8_BAR; PG8_MMA(1, 1, At, B1); PG8_BAR;
            }
            PG8_WAIT_V(0);
            if (wr == 0) PG8_BAR;
            PG8_BAR;
        }
        LAS float* st = (LAS float*)lds;
#pragma unroll 1
        for (int hb = 0; hb < 2; ++hb) {
            const int bcol = pn * 256 + hb * 128;
            if (MODE != EPI_WOUT && cvstride != 0) {
                LAS float* rs = st + 256 * STG;
                if (tid < 256) {
                    const float* rp = RSS + (size_t)(brow + tid) * 8;
                    const float4 a = *reinterpret_cast<const float4*>(rp), b = *reinterpret_cast<const float4*>(rp + 4);
                    rs[tid] = rsqrtf((((a.x + a.y) + (a.z + a.w)) + ((b.x + b.y) + (b.z + b.w))) * (1.f / D) + EPS);
                }
                __syncthreads();
#pragma unroll
                for (int n = 0; n < 2; ++n) {
                    const float4 bz = *reinterpret_cast<const float4*>(BIAS + (size_t)tok_cv(brow) * N + bcol + wc * 32 + n * 16 + fq * 4);
#pragma unroll
                    for (int a = 0; a < 2; ++a)
#pragma unroll
                        for (int m = 0; m < 4; ++m) {
                            const int row = a * 128 + wr * 64 + m * 16 + fr;
                            const float r = rs[row];
                            const f32x4 v = hb == 0 ? acc[a][0][m][n] : acc[a][1][m][n];
                            *(LAS f32x4*)(st + row * STG + wc * 32 + n * 16 + fq * 4) = f32x4{v[0] * r + bz.x, v[1] * r + bz.y, v[2] * r + bz.z, v[3] * r + bz.w};
                        }
                }
            } else {
#pragma unroll
                for (int a = 0; a < 2; ++a)
#pragma unroll
                    for (int m = 0; m < 4; ++m)
#pragma unroll
                        for (int n = 0; n < 2; ++n)
                            *(LAS f32x4*)(st + (a * 128 + wr * 64 + m * 16 + fr) * STG + wc * 32 + n * 16 + fq * 4) = hb == 0 ? acc[a][0][m][n] : acc[a][1][m][n];
            }
            __syncthreads();
            const bool tprompt = brow < NPT;
            const int tb_ = tprompt ? (brow >> 8) : ((brow - NPT) >> 11), ts0 = tprompt ? 0 : ((brow - NPT) & 2047);
            if (MODE == EPI_INPROJ) {
                const bool vtile = (bcol >= 1024 && bcol < 1280);
                if (!vtile) {
    #pragma unroll 1
                    for (int it = 0; it < 2; ++it) {
                        const int item = it * NT + tid, erow = item >> 2, eseg = item & 3;
                        float v[32];
    #pragma unroll
                        for (int i = 0; i < 8; ++i) {
                            const f32x4 f = *(const LAS f32x4*)(st + erow * STG + eseg * 32 + i * 4);
                            v[i * 4] = f[0]; v[i * 4 + 1] = f[1]; v[i * 4 + 2] = f[2]; v[i * 4 + 3] = f[3];
                        }
                        epi_inproj_xform(p, l, brow + erow, bcol + eseg * 32, v);
    #pragma unroll
                        for (int i = 0; i < 8; ++i) *(LAS f32x4*)(st + erow * STG + eseg * 32 + i * 4) = f32x4{v[i * 4], v[i * 4 + 1], v[i * 4 + 2], v[i * 4 + 3]};
                    }
                    __syncthreads();
    #pragma unroll 1
                    for (int it = 0; it < 8; ++it) {
                        const int item = it * NT + tid, r = item >> 4, c = (item & 15) * 8;
                        const f32x4 f0 = *(const LAS f32x4*)(st + r * STG + c), f1 = *(const LAS f32x4*)(st + r * STG + c + 4);
                        const int t = brow + r, sp = ts0 + r;
                        bf16_t* dst;
                        if (bcol < 512)        dst = (bf16_t*)(p.ws + (bcol < 256 ? OFF_AU : OFF_AV)) + (size_t)t * 256 + (bcol & 255) + c;
                        else if (bcol < 768)   dst = (bf16_t*)(p.ws + OFF_DQ) + (size_t)t * 256 + (bcol - 512) + c;
                        else if (bcol < 1024) { const int cc = bcol - 768 + c, h = cc >> 6;
                                                dst = tprompt ? (bf16_t*)(p.ws + OFF_DKP) + (((size_t)tb_ * 4 + h) * SEQ + sp) * 64 + (cc & 63)
                                                              : (bf16_t*)(p.ws + OFF_DKS) + (((size_t)tb_ * 4 + h) * NKS + sp) * 64 + (cc & 63); }
                        else if (bcol < 1792)  dst = (bf16_t*)(p.ws + OFF_GQ) + (size_t)t * 512 + (bcol - 1280) + c;
                        else                 { const int kv = c >> 6, d0 = c & 63;
                                                const size_t hb = (tprompt ? ((size_t)tb_ * 2 + kv) * SEQ * 64 : ((size_t)tb_ * 2 + kv) * NKS * 64) + (size_t)(sp >> 6) * 4096;
                                                dst = bcol < 1920 ? (bf16_t*)(p.ws + (tprompt ? OFF_GKP : OFF_GKS)) + hb + (d0 >> 3) * 512 + (sp & 63) * 8
                                                                  : (bf16_t*)(p.ws + (tprompt ? OFF_GVTP : OFF_GVTS)) + hb + (d0 >> 5) * 2048 + (sp & 63) * 32 + (d0 & 31); }
                        *reinterpret_cast<u32x4*>(dst) = u32x4{pack_bf2(f0[0], f0[1]), pack_bf2(f0[2], f0[3]), pack_bf2(f1[0], f1[1]), pack_bf2(f1[2], f1[3])};
                    }
                }
                if (tprompt && ((bcol >= 768 && bcol < 1280) || bcol >= 1792)) {
                    float* ob; int rs;
                    if (bcol < 1024)      { ob = p.out + OUT_NDK + (((size_t)tb_ * 2 + l) * SEQ) * 256 + (bcol - 768);  rs = 256; }
                    else if (bcol < 1280) { ob = p.out + OUT_NDV + (((size_t)tb_ * 2 + l) * SEQ) * 256 + (bcol - 1024); rs = 256; }
                    else if (bcol < 1920) { ob = p.out + OUT_NGK + (((size_t)tb_ * 2 + l) * SEQ) * 128;                 rs = 128; }
                    else                  { ob = p.out + OUT_NGV + (((size_t)tb_ * 2 + l) * SEQ) * 128;                 rs = 128; }
    #pragma unroll 1
                    for (int it = 0; it < 16; ++it) {
                        const int item = it * NT + tid, r = item >> 5, c = (item & 31) * 4;
                        *reinterpret_cast<f32x4*>(ob + (size_t)r * rs + c) = *(const LAS f32x4*)(st + r * STG + c);
                    }
                }
                if (vtile) {
    #pragma unroll 1
                    for (int it = 0; it < 2; ++it) {
                        const int item = it * NT + tid, col = item >> 3, run = item & 7;
                        epi_inproj_col(p, brow + run * 32, bcol + col, st + run * 32 * STG + col);
                    }
                }
            } else {
                float4 ga = make_float4(0.f, 0.f, 0.f, 0.f), gb = ga, na = ga, nb = ga, sa = ga, sb = ga;
                float4 xna = ga, xnb = ga; u32x4 xnw = {0u, 0u, 0u, 0u};
                if (MODE == EPI_WOUT) {
                    const int c = (tid & 15) * 8;
                    const float* g1 = (const float*)(p.ws + OFF_MOD) + (size_t)(l * 5 + tok_cv(brow)) * 6144 + 2048 + bcol + c;
                    ga = *reinterpret_cast<const float4*>(g1); gb = *reinterpret_cast<const float4*>(g1 + 4);
                    sa = *reinterpret_cast<const float4*>(g1 + 2048); sb = *reinterpret_cast<const float4*>(g1 + 2048 + 4);
                    const float* gn = p.in[I_N2G] + l * D + bcol + c;
                    na = *reinterpret_cast<const float4*>(gn); nb = *reinterpret_cast<const float4*>(gn + 4);
                    const int t = brow + (tid >> 4);
                    if (l == 0) { const float* xr = x_in_row(p, t) + bcol + c; xna = *reinterpret_cast<const float4*>(xr); xnb = *reinterpret_cast<const float4*>(xr + 4); }
                    else xnw = *reinterpret_cast<const u32x4*>((const bf16_t*)(p.ws + OFF_XC) + (size_t)t * D + bcol + c);
                }
    #pragma unroll 1
                for (int it = 0; it < 8; ++it) {
                    const int item = it * NT + tid, r = item >> 4, c = (item & 15) * 8;
                    const f32x4 f0 = *(const LAS f32x4*)(st + r * STG + c), f1 = *(const LAS f32x4*)(st + r * STG + c + 4);
                    const int t = brow + r;
                    float o[8] = {f0[0], f0[1], f0[2], f0[3], f1[0], f1[1], f1[2], f1[3]};
                    if (MODE == EPI_WOUT) {
                        float x[8];
                        if (l == 0) { x[0] = xna.x; x[1] = xna.y; x[2] = xna.z; x[3] = xna.w; x[4] = xnb.x; x[5] = xnb.y; x[6] = xnb.z; x[7] = xnb.w; }
                        else {
    #pragma unroll
                            for (int k = 0; k < 4; ++k) { x[2 * k] = __uint_as_float(xnw[k] << 16); x[2 * k + 1] = __uint_as_float(xnw[k] & 0xffff0000u); }
                        }
                        {
                            const int tn = brow + (((it < 7 ? it + 1 : it) * NT + tid) >> 4);
                            if (l == 0) { const float* xr = x_in_row(p, tn) + bcol + c; xna = *reinterpret_cast<const float4*>(xr); xnb = *reinterpret_cast<const float4*>(xr + 4); }
                            else xnw = *reinterpret_cast<const u32x4*>((const bf16_t*)(p.ws + OFF_XC) + (size_t)tn * D + bcol + c);
                        }
                        o[0] = x[0] + ga.x * o[0]; o[1] = x[1] + ga.y * o[1]; o[2] = x[2] + ga.z * o[2]; o[3] = x[3] + ga.w * o[3];
                        o[4] = x[4] + gb.x * o[4]; o[5] = x[5] + gb.y * o[5]; o[6] = x[6] + gb.z * o[6]; o[7] = x[7] + gb.w * o[7];
                        float xg[8] = {o[0] * na.x * (1.f + sa.x), o[1] * na.y * (1.f + sa.y), o[2] * na.z * (1.f + sa.z), o[3] * na.w * (1.f + sa.w),
                                       o[4] * nb.x * (1.f + sb.x), o[5] * nb.y * (1.f + sb.y), o[6] * nb.z * (1.f + sb.z), o[7] * nb.w * (1.f + sb.w)};
                        float ss = 0.f, am = 0.f;
    #pragma unroll
                        for (int i = 0; i < 8; ++i) { ss += o[i] * o[i]; am = fmaxf(am, fabsf(xg[i])); }
                        ss = row16_sum(ss); am = row16_max(am);
                        const float sc8 = am > 0.f ? 127.f / am : 1.f;
                        uint2 w8;
                        w8.x = pack4_i8(q8(xg[0] * sc8), q8(xg[1] * sc8), q8(xg[2] * sc8), q8(xg[3] * sc8));
                        w8.y = pack4_i8(q8(xg[4] * sc8), q8(xg[5] * sc8), q8(xg[6] * sc8), q8(xg[7] * sc8));
                        *reinterpret_cast<uint2*>(p.ws + OFF_H8I + (size_t)t * D + bcol + c) = w8;
                        if ((item & 15) == 0) {
                            ((float*)(p.ws + OFF_RSS2))[((size_t)l * NTOK + t) * 8 + (bcol >> 7)] = ss;
                            ((float*)(p.ws + OFF_XGS))[(size_t)t * 8 + (bcol >> 7)] = am > 0.f ? am * (1.f / 127.f) : 1.f;
                        }
                    }
                    bf16_t* dst = (bf16_t*)(p.ws + (MODE == EPI_WOUT ? OFF_XC : OFF_Q)) + (size_t)t * D + bcol + c;
                    *reinterpret_cast<u32x4*>(dst) = u32x4{pack_bf2(o[0], o[1]), pack_bf2(o[2], o[3]), pack_bf2(o[4], o[5]), pack_bf2(o[6], o[7])};
                }
            }
            __syncthreads();
        }
    }
#undef PG8_SA
#undef PG8_SB
#undef PG8_STAGE
#undef PG8_LDA
#undef PG8_LDB
#undef PG8_MMA
#undef PG8_WAIT_V
#undef PG8_WAIT_L
#undef PG8_BAR
#undef PG8_SCHED
}

#define MFMA32(a, b, c) __builtin_amdgcn_mfma_f32_32x32x16_bf16((a), (b), (c), 0, 0, 0)
constexpr int ATT_ROWB = 144;
constexpr int ATT_TILEB = 64 * ATT_ROWB;
constexpr int QW_MIX = 4096;

__device__ __forceinline__ bf16x8 pack8(const f32x16& x, int s) {
    const u32x4 w = {pack_bf2(x[8 * s], x[8 * s + 1]), pack_bf2(x[8 * s + 2], x[8 * s + 3]), pack_bf2(x[8 * s + 4], x[8 * s + 5]), pack_bf2(x[8 * s + 6], x[8 * s + 7])};
    return __builtin_bit_cast(bf16x8, w);
}
__device__ __forceinline__ void softmax_tile(f32x16& s0, f32x16& s1, const float sc, float& m, float& l, float& alpha, const int lane) {
    float mx = fmaxf(s0[0], s1[0]);
#pragma unroll
    for (int i = 1; i < 16; ++i) mx = fmaxf(mx, fmaxf(s0[i], s1[i]));
    mx = fmaxf(mx, shfl_x(mx, lane, 32));
    const float mnew = fmaxf(m, mx * sc);
    alpha = __builtin_amdgcn_exp2f(m - mnew);
    m = mnew;
    float ps = 0.f;
#pragma unroll
    for (int i = 0; i < 16; ++i) { s0[i] = __builtin_amdgcn_exp2f(s0[i] * sc - mnew); s1[i] = __builtin_amdgcn_exp2f(s1[i] * sc - mnew); ps += s0[i] + s1[i]; }
    l = l * alpha + ps;
}
__device__ __forceinline__ void v_frags(const LAS unsigned char* vb, bf16x8 (&vf)[8], int r, int hh) {
#pragma unroll
    for (int u = 0; u < 2; ++u)
#pragma unroll
        for (int sk = 0; sk < 2; ++sk)
#pragma unroll
            for (int mt = 0; mt < 2; ++mt) {
                const LAS unsigned char* a = vb + (32 * mt + r) * ATT_ROWB + (32 * u + 16 * sk + 4 * hh) * 2;
                const s16x4 lo = *(const LAS s16x4*)a, hi = *(const LAS s16x4*)(a + 16);
                vf[(u * 2 + sk) * 2 + mt] = bf16x8{lo[0], lo[1], lo[2], lo[3], hi[0], hi[1], hi[2], hi[3]};
            }
}
__device__ __forceinline__ void pv_tile(const bf16x8 (&vf)[8], const f32x16& p0, const f32x16& p1, f32x16 (&O)[2]) {
#pragma unroll
    for (int u = 0; u < 2; ++u)
#pragma unroll
        for (int sk = 0; sk < 2; ++sk) {
            const bf16x8 pf = pack8(u ? p1 : p0, sk);
#pragma unroll
            for (int mt = 0; mt < 2; ++mt) O[mt] = MFMA32(vf[(u * 2 + sk) * 2 + mt], pf, O[mt]);
        }
}

template <bool DIFF>
__device__ __forceinline__ void attn_item(const Params& p, int l, LAS unsigned char* lds, const int tid,
                                          const bf16_t* __restrict__ Qg, const int qstride,
                                          const bf16_t* __restrict__ Kg, const bf16_t* __restrict__ Vtg, const int nk,
                                          bf16_t* __restrict__ Og, const float lam) {
    const int wave = tid >> 6, lane = tid & 63, r = lane & 31, hh = lane >> 5;
    const int lrow = tid >> 3, lchunk = tid & 7;
    LAS unsigned char* kbuf = lds; LAS unsigned char* vbuf = lds + 2 * ATT_TILEB;
    bf16x8 qf[4];
    const bf16_t* qrow = Qg + (size_t)(wave * 32 + r) * qstride;
#pragma unroll
    for (int ks = 0; ks < 4; ++ks) qf[ks] = *reinterpret_cast<const bf16x8*>(qrow + ks * 16 + hh * 8);
    const float sc = (DIFF ? 0.17677669529663687f : 0.125f) * 1.4426950408889634f;
    f32x16 O0[2], O1[2];
#pragma unroll
    for (int mt = 0; mt < 2; ++mt)
#pragma unroll
        for (int i = 0; i < 16; ++i) { O0[mt][i] = 0.f; O1[mt][i] = 0.f; }
    float m0 = -1e30f, l0 = 0.f, m1 = -1e30f, l1 = 0.f;
    const int ntl = nk / 64;
    u32x4 kr, vr, kn, vn;
    kr = *reinterpret_cast<const u32x4*>(Kg + (size_t)lrow * 64 + lchunk * 8);
    vr = *reinterpret_cast<const u32x4*>(Vtg + (size_t)lrow * nk + lchunk * 8);
    *(LAS u32x4*)(kbuf + lrow * ATT_ROWB + lchunk * 16) = kr;
    *(LAS u32x4*)(vbuf + lrow * ATT_ROWB + lchunk * 16) = vr;
    {
        const int t1 = ntl > 1 ? 1 : 0;
        kr = *reinterpret_cast<const u32x4*>(Kg + (size_t)(t1 * 64 + lrow) * 64 + lchunk * 8);
        vr = *reinterpret_cast<const u32x4*>(Vtg + (size_t)lrow * nk + t1 * 64 + lchunk * 8);
    }
    __syncthreads();
    for (int ti = 0; ti < ntl; ++ti) {
        const int cur = ti & 1;
        {
            const int t2 = ti + 2 < ntl ? ti + 2 : ntl - 1;
            kn = *reinterpret_cast<const u32x4*>(Kg + (size_t)(t2 * 64 + lrow) * 64 + lchunk * 8);
            vn = *reinterpret_cast<const u32x4*>(Vtg + (size_t)lrow * nk + t2 * 64 + lchunk * 8);
        }
        const LAS unsigned char* kb = kbuf + cur * ATT_TILEB; const LAS unsigned char* vb = vbuf + cur * ATT_TILEB;
        bf16x8 ka[2][4];
#pragma unroll
        for (int u = 0; u < 2; ++u)
#pragma unroll
            for (int ks = 0; ks < 4; ++ks) ka[u][ks] = *(const LAS bf16x8*)(kb + (32 * u + r) * ATT_ROWB + (ks * 16 + hh * 8) * 2);
        __builtin_amdgcn_sched_barrier(0);
        bf16x8 vf[8];
        if (!DIFF) {
            f32x16 s0, s1;
#pragma unroll
            for (int i = 0; i < 16; ++i) { s0[i] = 0.f; s1[i] = 0.f; }
#pragma unroll
            for (int ks = 0; ks < 4; ++ks) { s0 = MFMA32(ka[0][ks], qf[ks], s0); s1 = MFMA32(ka[1][ks], qf[ks], s1); }
            v_frags(vb, vf, r, hh);
            __builtin_amdgcn_sched_barrier(0);
            float alpha;
            softmax_tile(s0, s1, sc, m0, l0, alpha, lane);
            if (__builtin_amdgcn_ballot_w64(alpha != 1.f) != 0ull) {
#pragma unroll
                for (int mt = 0; mt < 2; ++mt)
#pragma unroll
                    for (int i = 0; i < 16; ++i) O0[mt][i] *= alpha;
            }
            pv_tile(vf, s0, s1, O0);
        } else {
            f32x16 s0, s1, t0, t1;
#pragma unroll
            for (int i = 0; i < 16; ++i) { s0[i] = 0.f; s1[i] = 0.f; t0[i] = 0.f; t1[i] = 0.f; }
#pragma unroll
            for (int ks = 0; ks < 2; ++ks) {
                s0 = MFMA32(ka[0][ks], qf[ks], s0); s1 = MFMA32(ka[1][ks], qf[ks], s1);
                t0 = MFMA32(ka[0][2 + ks], qf[2 + ks], t0); t1 = MFMA32(ka[1][2 + ks], qf[2 + ks], t1);
            }
            v_frags(vb, vf, r, hh);
            __builtin_amdgcn_sched_barrier(0);
            float alpha;
            softmax_tile(s0, s1, sc, m0, l0, alpha, lane);
            if (__builtin_amdgcn_ballot_w64(alpha != 1.f) != 0ull) {
#pragma unroll
                for (int mt = 0; mt < 2; ++mt)
#pragma unroll
                    for (int i = 0; i < 16; ++i) O0[mt][i] *= alpha;
            }
            pv_tile(vf, s0, s1, O0);
            softmax_tile(t0, t1, sc, m1, l1, alpha, lane);
            if (__builtin_amdgcn_ballot_w64(alpha != 1.f) != 0ull) {
#pragma unroll
                for (int mt = 0; mt < 2; ++mt)
#pragma unroll
                    for (int i = 0; i < 16; ++i) O1[mt][i] *= alpha;
            }
            pv_tile(vf, t0, t1, O1);
        }
        if (ti + 1 < ntl) {
            *(LAS u32x4*)(kbuf + (cur ^ 1) * ATT_TILEB + lrow * ATT_ROWB + lchunk * 16) = kr;
            *(LAS u32x4*)(vbuf + (cur ^ 1) * ATT_TILEB + lrow * ATT_ROWB + lchunk * 16) = vr;
        }
        kr = kn; vr = vn;
        __syncthreads();
    }
    l0 += shfl_x(l0, lane, 32);
    const float inv0 = 1.f / l0;
    LAS unsigned char* ob = lds + wave * 4608;
    if (!DIFF) {
#pragma unroll
        for (int mt = 0; mt < 2; ++mt)
#pragma unroll
            for (int g = 0; g < 4; ++g) {
                u32x2 w;
                w[0] = pack_bf2(O0[mt][4 * g] * inv0, O0[mt][4 * g + 1] * inv0);
                w[1] = pack_bf2(O0[mt][4 * g + 2] * inv0, O0[mt][4 * g + 3] * inv0);
                *(LAS u32x2*)(ob + r * 144 + (32 * mt + 8 * g + 4 * hh) * 2) = w;
            }
    } else {
        l1 += shfl_x(l1, lane, 32);
        const float inv1 = lam / l1;
        float ss = 0.f;
#pragma unroll
        for (int mt = 0; mt < 2; ++mt)
#pragma unroll
            for (int i = 0; i < 16; ++i) { const float o = O0[mt][i] * inv0 - O1[mt][i] * inv1; O0[mt][i] = o; ss += o * o; }
        ss += shfl_x(ss, lane, 32);
        const float rr = rsqrtf(ss * (1.f / 64.f) + EPS) * __builtin_bit_cast(float, __builtin_amdgcn_readfirstlane(__builtin_bit_cast(int, 1.f - lam_init_of(l))));
        const float* sg = p.in[I_SUBLN] + l * 64;
#pragma unroll
        for (int mt = 0; mt < 2; ++mt)
#pragma unroll
            for (int g = 0; g < 4; ++g) {
                const int d0 = 32 * mt + 8 * g + 4 * hh;
                const float4 gg = *reinterpret_cast<const float4*>(sg + d0);
                u32x2 w;
                w[0] = pack_bf2(O0[mt][4 * g] * rr * gg.x, O0[mt][4 * g + 1] * rr * gg.y);
                w[1] = pack_bf2(O0[mt][4 * g + 2] * rr * gg.z, O0[mt][4 * g + 3] * rr * gg.w);
                *(LAS u32x2*)(ob + r * 144 + d0 * 2) = w;
            }
    }
#pragma unroll
    for (int ps = 0; ps < 4; ++ps) {
        const int row = ps * 8 + (lane >> 3), ch = lane & 7;
        *reinterpret_cast<u32x4*>(Og + (size_t)(wave * 32 + row) * D + ch * 8) = *(const LAS u32x4*)(ob + row * 144 + ch * 16);
    }
}

namespace ga {
constexpr float C2 = 0.125f * 1.4426950408889634f;
constexpr int SLOTB = 8192, LDS_K = 0, LDS_V = 3 * SLOTB, LDS_WS = 6 * SLOTB, LDS_OST = LDS_WS + 8 * 256;
typedef __attribute__((address_space(3))) const char* lds_cptr;
typedef short v4i16_t __attribute__((ext_vector_type(4)));
using s16x4 = __attribute__((ext_vector_type(4))) short;
__device__ __forceinline__ int crow(int r, int hi) { return (r & 3) + 8 * (r >> 2) + 4 * hi; }
__device__ __forceinline__ void glds16(const void* g, unsigned lds_base) {
    unsigned sv; asm volatile("s_mov_b32 %0, m0\n\ts_mov_b32 m0, %2\n\ts_nop 0\n\tglobal_load_lds_dwordx4 %1, off\n\ts_mov_b32 m0, %0" : "=&s"(sv) : "v"(g), "s"(lds_base) : "memory"); }
__device__ __forceinline__ void kload2(bf16x8* kf, lds_cptr kp, int d0) { kf[2 * d0] = *(const LAS bf16x8*)(kp + d0 * 2048); kf[2 * d0 + 1] = *(const LAS bf16x8*)(kp + d0 * 2048 + 512); }
__device__ __forceinline__ s16x4 vtr(lds_cptr p) { return __builtin_bit_cast(s16x4, __builtin_amdgcn_ds_read_tr16_b64_v4i16((LAS v4i16_t*)p)); }
#define GA_MX3(a, b, c) __builtin_fmaxf(__builtin_fmaxf((a), (b)), (c))
__device__ __forceinline__ float rowmax(const f32x16& p0, const f32x16& p1) {
    float a = GA_MX3(p0[0], p0[1], p1[0]), b = GA_MX3(p0[2], p0[3], p1[1]); a = GA_MX3(a, p1[2], p1[3]);
#pragma unroll
    for (int r = 4; r < 16; r += 4) { a = GA_MX3(a, p0[r], p0[r + 1]); b = GA_MX3(b, p0[r + 2], p0[r + 3]); a = GA_MX3(a, p1[r], p1[r + 1]); b = GA_MX3(b, p1[r + 2], p1[r + 3]); }
    float m = __builtin_fmaxf(a, b); auto rr = __builtin_amdgcn_permlane32_swap(__float_as_uint(m), __float_as_uint(m), false, false);
    return __builtin_fmaxf(__uint_as_float(rr[0]), __uint_as_float(rr[1])); }
}
#define GA_SBAR() __builtin_amdgcn_sched_barrier(0)
#define GA_PIN(x) asm volatile("" : "+v"(x))
#define GA_WAIT_BAR(N) asm volatile("s_waitcnt vmcnt(" #N ") lgkmcnt(0)\n\ts_barrier" ::: "memory")
#define GA_THR 8
__device__ __forceinline__ void gqa_unit(LAS unsigned char* ldsl, const int tid, const int wid, const bf16_t* __restrict__ Qw0, const int qstride,
                                         const unsigned char* __restrict__ Kimg, const unsigned char* __restrict__ Vimg, const int NT, bf16_t* __restrict__ Og) {
    using namespace ga;
    const int lane = tid & 63, r32 = lane & 31, hi = lane >> 5;
    const bf16_t* Qw = Qw0 + (size_t)(wid * 32) * qstride;
    const unsigned lds0 = (unsigned)(size_t)ldsl; LAS float* wsf = (LAS float*)(ldsl + LDS_WS) + wid * 64;
    const unsigned char* ksrc = Kimg + wid * 1024 + lane * 16;
    const unsigned char* vsrc = Vimg + wid * 1024 + lane * 16;
    const unsigned kdst = lds0 + LDS_K + wid * 1024, vdst = lds0 + LDS_V + wid * 1024;
#define DMA_K(t, slot) glds16(ksrc + (size_t)(t) * SLOTB, (unsigned)__builtin_amdgcn_readfirstlane(kdst + (slot)))
#define DMA_V(t, slot) glds16(vsrc + (size_t)(t) * SLOTB, (unsigned)__builtin_amdgcn_readfirstlane(vdst + (slot)))
    const lds_cptr vp0 = (lds_cptr)ldsl + LDS_V + ((lane >> 4) & 1) * 32 + (lane & 3) * 8 + (4 * hi + ((lane & 15) >> 2)) * 64;
    const lds_cptr kp0 = (lds_cptr)ldsl + LDS_K + hi * 1024 + r32 * 16;
    DMA_K(0, 0); DMA_V(0, 0); DMA_K(1, SLOTB);
    bf16x8 qr[4];
#pragma unroll
    for (int d0 = 0; d0 < 4; ++d0) qr[d0] = *reinterpret_cast<const bf16x8*>(&Qw[(size_t)r32 * qstride + d0 * 16 + hi * 8]);
    float mhat = 0.f, l_reg = 0.f; f32x16 o[2];
#pragma unroll
    for (int i = 0; i < 16; ++i) { o[0][i] = 0.f; o[1][i] = 0.f; }
    f32x16 zero16;
#pragma unroll
    for (int i = 0; i < 16; ++i) zero16[i] = 0.f;
    GA_PIN(zero16);
    bool resc = false;
    f32x16 pA0, pA1, pB0, pB1; bf16x8 kf[8]; s16x4 vlo[8], vhi[8]; u32x4 pw0, pw1, pw2, pw3;
    int sl_prev = 0, sl_cur = 0, sl_next = SLOTB;
#define ROT() do { sl_prev = sl_cur; sl_cur = sl_next; sl_next = (sl_next == 2 * SLOTB) ? 0 : sl_next + SLOTB; } while (0)
#define EX(v) __builtin_amdgcn_exp2f(v)
#define RESC() do { if (resc) { _Pragma("unroll") for (int d_ = 0; d_ < 2; ++d_) _Pragma("unroll") for (int r = 0; r < 16; ++r) o[d_][r] *= wsf[crow(r, hi)]; } } while (0)
    DMA_K(2, 2 * SLOTB);
    GA_WAIT_BAR(3);
    _Pragma("unroll") for (int d0 = 0; d0 < 4; ++d0) kload2(kf, kp0, d0);
    pA0 = MFMA32(kf[0], qr[0], zero16); pA1 = MFMA32(kf[1], qr[0], zero16); pA0 = MFMA32(kf[2], qr[1], pA0); pA1 = MFMA32(kf[3], qr[1], pA1);
    pA0 = MFMA32(kf[4], qr[2], pA0); pA1 = MFMA32(kf[5], qr[2], pA1); pA0 = MFMA32(kf[6], qr[3], pA0); pA1 = MFMA32(kf[7], qr[3], pA1);
    { const float rm = rowmax(pA0, pA1); mhat = rm; const float nmh = -mhat;
#pragma unroll
      for (int r = 0; r < 16; ++r) { pA0[r] = EX(pA0[r] + nmh); pA1[r] = EX(pA1[r] + nmh); }
#pragma unroll
      for (int r = 0; r < 16; ++r) zero16[r] = nmh;
      GA_PIN(zero16); }
    GA_WAIT_BAR(0);
    DMA_K(3, 0); DMA_V(1, SLOTB); ROT();
    _Pragma("unroll") for (int d0 = 0; d0 < 4; ++d0) kload2(kf, kp0 + sl_cur, d0);
    GA_WAIT_BAR(2);
#define PKW(P, i) pack_bf2(P[i], P[i + 1])
#define PAF(k) __builtin_bit_cast(bf16x8, pw##k)
#define VFR(i) (bf16x8){vlo[i][0], vlo[i][1], vlo[i][2], vlo[i][3], vhi[i][0], vhi[i][1], vhi[i][2], vhi[i][3]}
#define VRD(i) do { vlo[i] = vtr(vp_ + (((i) >> 2) * 4096 + ((i) & 3) * 1024)); vhi[i] = vtr(vp_ + (((i) >> 2) * 4096 + ((i) & 3) * 1024 + 512)); } while (0)
#define KRD(G, d0) do { if (G) { kload2(kf, kp0 + sl_next, d0); GA_SBAR(); } } while (0)
#define GAPA(MF, a0, a1, a2, a3, W0, W1, PW) do { MF; sacc += a0; sacc += a1; sacc += a2; sacc += a3; W0; W1; GA_PIN(PW); GA_PIN(sacc); GA_SBAR(); } while (0)
#define GAPB(MF, X, i) do { MF; X[i] = EX(X[i]); X[i + 1] = EX(X[i + 1]); X[i + 2] = EX(X[i + 2]); X[i + 3] = EX(X[i + 3]); GA_PIN(X); GA_SBAR(); } while (0)
#define STEP(C0, C1, P0, P1, t, GK, GV, GL) do { GA_SBAR(); \
    const lds_cptr vp_ = vp0 + sl_prev; \
    VRD(0); GA_SBAR(); float sacc = P0[0] + P0[1]; \
                       GAPA(C0 = MFMA32(kf[0], qr[0], zero16), P0[2], P0[3], P0[4], P0[5],     pw0[0] = PKW(P0, 0),  pw0[1] = PKW(P0, 2),  pw0); \
    VRD(4); GA_SBAR(); GAPA(C1 = MFMA32(kf[1], qr[0], zero16), P0[6], P0[7], P0[8], P0[9],     pw0[2] = PKW(P0, 4),  pw0[3] = PKW(P0, 6),  pw0); \
    VRD(1); GA_SBAR(); GAPA(C0 = MFMA32(kf[2], qr[1], C0),    P0[10], P0[11], P0[12], P0[13], pw1[0] = PKW(P0, 8),  pw1[1] = PKW(P0, 10), pw1); \
    VRD(5); GA_SBAR(); GAPA(C1 = MFMA32(kf[3], qr[1], C1),    P0[14], P0[15], P1[0], P1[1],   pw1[2] = PKW(P0, 12), pw1[3] = PKW(P0, 14), pw1); \
    VRD(2); GA_SBAR(); GAPA(C0 = MFMA32(kf[4], qr[2], C0),    P1[2], P1[3], P1[4], P1[5],     pw2[0] = PKW(P1, 0),  pw2[1] = PKW(P1, 2),  pw2); \
    VRD(6); GA_SBAR(); GAPA(C1 = MFMA32(kf[5], qr[2], C1),    P1[6], P1[7], P1[8], P1[9],     pw2[2] = PKW(P1, 4),  pw2[3] = PKW(P1, 6),  pw2); \
    VRD(3); GA_SBAR(); GAPA(C0 = MFMA32(kf[6], qr[3], C0),    P1[10], P1[11], P1[12], P1[13], pw3[0] = PKW(P1, 8),  pw3[1] = PKW(P1, 10), pw3); \
    VRD(7); GA_SBAR(); GAPA(C1 = MFMA32(kf[7], qr[3], C1),    P1[14], P1[15], 0.f, 0.f,       pw3[2] = PKW(P1, 12), pw3[3] = PKW(P1, 14), pw3); \
    l_reg += sacc; \
    if (GK) DMA_K((t) + 3, sl_cur); if (GV) DMA_V((t) + 1, sl_next); \
    { const float rm = rowmax(C0, C1); resc = false;                                             \
      if (__builtin_expect(__any(rm > (float)GA_THR), 0)) { const float dl = __builtin_fmaxf(rm, 0.f); mhat += dl; \
          const float f = __builtin_amdgcn_exp2f(-dl); l_reg *= f; if (hi == 0) wsf[r32] = f; resc = true; \
          _Pragma("unroll") for (int r_ = 0; r_ < 16; ++r_) { C0[r_] -= dl; C1[r_] -= dl; zero16[r_] = -mhat; } GA_PIN(zero16); } } \
    GA_SBAR(); \
    GAPB(o[0] = MFMA32(PAF(0), VFR(0), o[0]), C0, 0);              GAPB(o[1] = MFMA32(PAF(0), VFR(4), o[1]), C0, 4); \
    KRD(GL, 0); GAPB(o[0] = MFMA32(PAF(1), VFR(1), o[0]), C0, 8);  KRD(GL, 1); GAPB(o[1] = MFMA32(PAF(1), VFR(5), o[1]), C0, 12); \
    KRD(GL, 2); GAPB(o[0] = MFMA32(PAF(2), VFR(2), o[0]), C1, 0);  KRD(GL, 3); GAPB(o[1] = MFMA32(PAF(2), VFR(6), o[1]), C1, 4); \
    GAPB(o[0] = MFMA32(PAF(3), VFR(3), o[0]), C1, 8);              GAPB(o[1] = MFMA32(PAF(3), VFR(7), o[1]), C1, 12); \
    } while (0)
    int t = 1;
    for (; t + 5 < NT; t += 2) {
        STEP(pB0, pB1, pA0, pA1, t, true, true, true);     GA_WAIT_BAR(2); RESC(); ROT();
        STEP(pA0, pA1, pB0, pB1, t + 1, true, true, true); GA_WAIT_BAR(2); RESC(); ROT();
    }
#define ENDW(tt) do { if ((tt) + 3 < NT) { GA_WAIT_BAR(2); } else if ((tt) + 2 < NT) { GA_WAIT_BAR(1); } else { GA_WAIT_BAR(0); } } while (0)
    for (; t + 1 < NT; t += 2) {
        STEP(pB0, pB1, pA0, pA1, t, (t + 3 < NT), (t + 1 < NT), (t + 1 < NT));         ENDW(t);     RESC(); ROT();
        STEP(pA0, pA1, pB0, pB1, t + 1, (t + 4 < NT), (t + 2 < NT), (t + 2 < NT));     ENDW(t + 1); RESC(); ROT();
    }
    STEP(pB0, pB1, pA0, pA1, NT - 1, false, false, false); RESC();
    { float sacc = pB0[0] + pB0[1];
#pragma unroll
      for (int r = 2; r < 16; ++r) sacc += pB0[r];
#pragma unroll
      for (int r = 0; r < 16; ++r) sacc += pB1[r];
      l_reg += sacc;
      pw0 = (u32x4){PKW(pB0, 0), PKW(pB0, 2), PKW(pB0, 4), PKW(pB0, 6)}; pw1 = (u32x4){PKW(pB0, 8), PKW(pB0, 10), PKW(pB0, 12), PKW(pB0, 14)};
      pw2 = (u32x4){PKW(pB1, 0), PKW(pB1, 2), PKW(pB1, 4), PKW(pB1, 6)}; pw3 = (u32x4){PKW(pB1, 8), PKW(pB1, 10), PKW(pB1, 12), PKW(pB1, 14)};
      const lds_cptr vp_ = vp0 + sl_cur; _Pragma("unroll") for (int i = 0; i < 8; ++i) VRD(i);
      o[0] = MFMA32(PAF(0), VFR(0), o[0]); o[1] = MFMA32(PAF(0), VFR(4), o[1]); o[0] = MFMA32(PAF(1), VFR(1), o[0]); o[1] = MFMA32(PAF(1), VFR(5), o[1]);
      o[0] = MFMA32(PAF(2), VFR(2), o[0]); o[1] = MFMA32(PAF(2), VFR(6), o[1]); o[0] = MFMA32(PAF(3), VFR(3), o[0]); o[1] = MFMA32(PAF(3), VFR(7), o[1]); }
    { auto rr = __builtin_amdgcn_permlane32_swap(__float_as_uint(l_reg), __float_as_uint(l_reg), false, false); l_reg = __uint_as_float(rr[0]) + __uint_as_float(rr[1]); }
    if (hi == 0) wsf[32 + r32] = l_reg;
    asm volatile("s_waitcnt lgkmcnt(0)" ::: "memory");
    float rli[16];
#pragma unroll
    for (int r = 0; r < 16; ++r) rli[r] = __builtin_amdgcn_rcpf(wsf[32 + crow(r, hi)]);
    bf16_t* Ow = Og + (size_t)(wid * 32) * D; LAS bf16_t* stg = (LAS bf16_t*)(ldsl + LDS_OST) + wid * 2048;
#pragma unroll
    for (int r = 0; r < 16; ++r) { const int orow = crow(r, hi);
#pragma unroll
        for (int d0 = 0; d0 < 2; ++d0) stg[orow * 64 + d0 * 32 + r32] = f2bf(o[d0][r] * rli[r]); }
    asm volatile("s_waitcnt lgkmcnt(0)" ::: "memory");
#pragma unroll
    for (int i = 0; i < 4; ++i) { const int row = i * 8 + (lane >> 3), ch = lane & 7; *reinterpret_cast<u32x4*>(Ow + (size_t)row * D + ch * 8) = *(const LAS u32x4*)(stg + row * 64 + ch * 8); }
    asm volatile("s_waitcnt lgkmcnt(0)\n\ts_barrier" ::: "memory");
#undef DMA_K
#undef DMA_V
#undef ROT
#undef EX
#undef RESC
#undef PKW
#undef PAF
#undef VFR
#undef VRD
#undef KRD
#undef ENDW
#undef GAPA
#undef GAPB
#undef STEP
}

constexpr int SGU_ROWB = 272;
__device__ __forceinline__ void sgu_item(const Params& p, int l, LAS unsigned char* lds, const int tid, const int t0) {
    const bf16_t* AV = (const bf16_t*)(p.ws + OFF_AV) + (size_t)t0 * 256;
    {
        const int q = tid >> 2, quarter = tid & 3;
        float v[64]; float ss = 0.f;
#pragma unroll
        for (int i = 0; i < 8; ++i) {
            const bf16x8 w = *reinterpret_cast<const bf16x8*>(AV + (size_t)q * 256 + quarter * 64 + i * 8);
#pragma unroll
            for (int j = 0; j < 8; ++j) { v[i * 8 + j] = bf2f((bf16_t)w[j]); ss += v[i * 8 + j] * v[i * 8 + j]; }
        }
        { const int ln = tid & 63; ss += shfl_x(ss, ln, 1); ss += shfl_x(ss, ln, 2); }
        const float rstd = rsqrtf(ss * (1.f / 256.f) + EPS);
        const float* g = p.in[I_SGUNG] + l * 256 + quarter * 64;
#pragma unroll
        for (int i = 0; i < 64; ++i)
            *(LAS bf16_t*)(lds + (quarter * 64 + i) * SGU_ROWB + q * 2) = f2bf(v[i] * rstd * g[i]);
    }
    __syncthreads();
    {
        const int wave = tid >> 6, lane = tid & 63, r = lane & 31, hh = lane >> 5;
        const int g = wave >> 1, ph = wave & 1;
        const bf16_t* W = (const bf16_t*)(p.ws + OFF_SGUW) + ((size_t)l * 4 + g) * 128 * 128;
        f32x16 acc[2][2];
#pragma unroll
        for (int a = 0; a < 2; ++a)
#pragma unroll
            for (int b = 0; b < 2; ++b)
#pragma unroll
                for (int i = 0; i < 16; ++i) acc[a][b][i] = 0.f;
#pragma unroll
        for (int ks = 0; ks < 8; ++ks) {
            bf16x8 af[2], bfr[2];
#pragma unroll
            for (int pt = 0; pt < 2; ++pt) af[pt] = *reinterpret_cast<const bf16x8*>(W + (size_t)(ph * 64 + pt * 32 + r) * 128 + ks * 16 + hh * 8);
#pragma unroll
            for (int ct = 0; ct < 2; ++ct) bfr[ct] = *(const LAS bf16x8*)(lds + (g * 64 + ct * 32 + r) * SGU_ROWB + (ks * 16 + hh * 8) * 2);
#pragma unroll
            for (int pt = 0; pt < 2; ++pt)
#pragma unroll
                for (int ct = 0; ct < 2; ++ct) acc[pt][ct] = MFMA32(af[pt], bfr[ct], acc[pt][ct]);
        }
        const float* bias = p.in[I_SGUB] + (l * 4 + g) * 128;
        const bf16_t* AU = (const bf16_t*)(p.ws + OFF_AU);
        bf16_t* MIX = (bf16_t*)(p.ws + OFF_MIX);
#pragma unroll
        for (int pt = 0; pt < 2; ++pt)
#pragma unroll
            for (int ct = 0; ct < 2; ++ct)
#pragma unroll
                for (int i = 0; i < 16; ++i) {
                    const int pp = ph * 64 + pt * 32 + (i & 3) + 8 * (i >> 2) + 4 * hh, c = g * 64 + ct * 32 + r;
                    const float au = bf2f(AU[(size_t)(t0 + pp) * 256 + c]);
                    MIX[(size_t)(t0 + pp) * D + c] = f2bf(au * (acc[pt][ct][i] + bias[pp]));
                }
    }
    __syncthreads();
}

__device__ __forceinline__ void conv_item(const Params& p, const int c, LAS unsigned char* lds, const int tid) {
    const int wave = tid >> 6, lane = tid & 63;
    const bool isu = c < 256;
    const int row00 = (c & 255) * 128, lyr = row00 >> 14;
    const float* src = p.in[isu ? I_PU : I_PV] + (size_t)(row00 + wave * 16) * D + lane * 16;
    unsigned char* dst = p.ws + (isu ? OFF_UT : OFF_VT);
    float* scl = (float*)(p.ws + OFF_USH) + (isu ? 0 : 1);
    float4 f[4][4], g[4][4];
#pragma unroll
    for (int q = 0; q < 4; ++q)
#pragma unroll
        for (int i = 0; i < 4; ++i) f[q][i] = *reinterpret_cast<const float4*>(src + (size_t)q * D + i * 4);
#pragma unroll
    for (int step = 0; step < 4; ++step) {
        if (step < 3) {
#pragma unroll
            for (int q = 0; q < 4; ++q)
#pragma unroll
                for (int i = 0; i < 4; ++i) g[q][i] = *reinterpret_cast<const float4*>(src + (size_t)((step + 1) * 4 + q) * D + i * 4);
        }
        const int row0 = row00 + wave * 16 + step * 4;
#pragma unroll
        for (int q = 0; q < 4; ++q) {
            const int row = row0 + q, e = row & (NEXP - 1);
            float v[16];
#pragma unroll
            for (int i = 0; i < 4; ++i) { v[i * 4] = f[q][i].x; v[i * 4 + 1] = f[q][i].y; v[i * 4 + 2] = f[q][i].z; v[i * 4 + 3] = f[q][i].w; }
            float am = 0.f;
#pragma unroll
            for (int i = 0; i < 16; ++i) am = fmaxf(am, fabsf(v[i]));
            am = wave_max(am);
            const float sc = am > 0.f ? 127.f / am : 1.f;
            unsigned w[4];
#pragma unroll
            for (int i = 0; i < 4; ++i) w[i] = pack4_i8(q8(v[i * 4] * sc), q8(v[i * 4 + 1] * sc), q8(v[i * 4 + 2] * sc), q8(v[i * 4 + 3] * sc));
            *reinterpret_cast<u32x4*>(dst + (((size_t)lyr * 8 + (lane >> 3)) * NEXP + e) * 128 + (lane & 7) * 16) = u32x4{w[0], w[1], w[2], w[3]};
            if (lane == 0) scl[(size_t)row * 8] = am > 0.f ? am * (1.f / 127.f) : 1.f;
        }
        if (step < 3) {
#pragma unroll
            for (int q = 0; q < 4; ++q)
#pragma unroll
                for (int i = 0; i < 4; ++i) f[q][i] = g[q][i];
        }
    }
}

__device__ void ph_mixers(const Params& p, int lq, unsigned char* ldsraw, const int wv) {
    const int l = lq & 1;
    const int tid0 = opaque_tid(wv);
    LAS unsigned char* lds = (LAS unsigned char*)ldsraw;
    volatile LAS int* qslot = (volatile LAS int*)(ldsraw - LDS_HDR + 64);
    unsigned* qw = (unsigned*)(p.ws + OFF_BAR) + QW_MIX + lq;
    const float lam = __builtin_bit_cast(float, __builtin_amdgcn_readfirstlane(__builtin_bit_cast(int, lam_of(p, l))));
    unsigned char* ws = p.ws;
    for (;;) {
        if (tid0 == 0) *qslot = (int)atomicAdd(qw, 1u);
        __syncthreads();
        int item = *qslot;
        __syncthreads();
        if (lq == 0) {
            if (item >= 1536) break;
            const int grp = item / 3, pos = item - grp * 3;
            if (pos == 2) { int tidc = tid0; asm volatile("" : "+v"(tidc)); conv_item(p, grp, lds, tidc); continue; }
            item = grp * 2 + pos;
            if (item >= 896) continue;
        }
        if (item >= 896) break;
        if (lq >= 2 && PROBE_DUP >= 10) {
            const int cls = item < 128 ? 10 : (item < 384 ? 11 : 12);
            if (cls != PROBE_DUP) continue;
        }
        int tid = tid0; asm volatile("" : "+v"(tid));
        if (item < 128) {
            const int qc = item & 7, h = (item >> 3) & 3, b = item >> 5;
            const int t0 = NPT + b * DSEQ + qc * 256;
            attn_item<true>(p, l, lds, tid, (const bf16_t*)(ws + OFF_DQ) + (size_t)t0 * 256 + h * 64, 256,
                            (const bf16_t*)(ws + OFF_DKS) + ((size_t)b * 4 + h) * NKS * 64, (const bf16_t*)(ws + OFF_DVTS) + ((size_t)b * 4 + h) * 64 * NKS, NKS,
                            (bf16_t*)(ws + OFF_MIX) + (size_t)t0 * D + 256 + h * 64, lam);
        } else if (item < 384) {
            const int it = item - 128, qc = it & 7, hq = (it >> 3) & 7, b = it >> 6, kv = hq >> 2;
            const int t0 = NPT + b * DSEQ + qc * 256;
            gqa_unit(lds, tid, wv, (const bf16_t*)(ws + OFF_GQ) + (size_t)t0 * 512 + hq * 64, 512,
                     ws + OFF_GKS + ((size_t)b * 2 + kv) * NKS * 128, ws + OFF_GVTS + ((size_t)b * 2 + kv) * NKS * 128, NKS / 64,
                     (bf16_t*)(ws + OFF_MIX) + (size_t)t0 * D + 512 + hq * 64);
        } else if (item < 512) {
            sgu_item(p, l, lds, tid, (item - 384) * 128);
        } else if (item < 768) {
            const int it = item - 512, hq = it & 7, b = it >> 3, kv = hq >> 2;
            const int t0 = b * SEQ;
            gqa_unit(lds, tid, wv, (const bf16_t*)(ws + OFF_GQ) + (size_t)t0 * 512 + hq * 64, 512,
                     ws + OFF_GKP + ((size_t)b * 2 + kv) * SEQ * 128, ws + OFF_GVTP + ((size_t)b * 2 + kv) * SEQ * 128, SEQ / 64,
                     (bf16_t*)(ws + OFF_MIX) + (size_t)t0 * D + 512 + hq * 64);
        } else {
            const int it = item - 768, h = it & 3, b = it >> 2;
            const int t0 = b * SEQ;
            attn_item<true>(p, l, lds, tid, (const bf16_t*)(ws + OFF_DQ) + (size_t)t0 * 256 + h * 64, 256,
                            (const bf16_t*)(ws + OFF_DKP) + ((size_t)b * 4 + h) * SEQ * 64, (const bf16_t*)(ws + OFF_DVTP) + ((size_t)b * 4 + h) * 64 * SEQ, SEQ,
                            (bf16_t*)(ws + OFF_MIX) + (size_t)t0 * D + 256 + h * 64, lam);
        }
    }
}


using bf16x2 = __attribute__((ext_vector_type(2))) __bf16;
__device__ __forceinline__ float dot2bf(unsigned a, unsigned b, float c) {
    return __builtin_amdgcn_fdot2_f32_bf16(__builtin_bit_cast(bf16x2, a), __builtin_bit_cast(bf16x2, b), c, false);
}
template <int W>
__device__ __forceinline__ void bfly_stage(float (&part)[64], const int lane) {
    const bool hi = (lane & W) != 0;
#pragma unroll
    for (int k = 0; k < W; ++k) {
        const float keep = hi ? part[k + W] : part[k];
        const float send = hi ? part[k] : part[k + W];
        part[k] = keep + shfl_x(send, lane, W);
    }
}
constexpr int QW_PEER = 4160;
template <int W>
__device__ __forceinline__ void bfly16_stage(float (&v)[16], const int lane, const int bit) {
    const bool hi = (lane & bit) != 0;
#pragma unroll
    for (int k = 0; k < W; ++k) {
        const float keep = hi ? v[k + W] : v[k];
        const float send = hi ? v[k] : v[k + W];
        v[k] = keep + shfl_x(send, lane, bit);
    }
}
template <int W>
__device__ __forceinline__ void bfly16i_stage(int (&v)[16], const int lane, const int bit) {
    const bool hi = (lane & bit) != 0;
#pragma unroll
    for (int k = 0; k < W; ++k) {
        const int keep = hi ? v[k + W] : v[k];
        const int send = hi ? v[k] : v[k + W];
        v[k] = keep + shfl_x(send, lane, bit);
    }
}
template <bool VSIDE> struct PeerTok {
    static __device__ __forceinline__ void issue(const Params& p, const unsigned char* Tslice, const int elo, const int ehi, const int t, const int s,
                                                 const int sub, const int c16, u32x4 (&a)[16], u32x4 (&h)[2]) {
#pragma unroll
        for (int i = 0; i < 16; ++i) {
            const int e = shfl_i(i < 8 ? elo : ehi, (i * 8 + sub) & 63);
            a[i] = *reinterpret_cast<const u32x4*>(Tslice + (((unsigned)e << 7) + (unsigned)c16 * 16u));
        }
        if (!VSIDE) h[0] = *reinterpret_cast<const u32x4*>(p.ws + OFF_H8I + (size_t)t * D + s * 128 + c16 * 16);
    }
    static __device__ __forceinline__ void compute(const Params& p, const int l, const u32x4 w4, const float wsc, const int t, const int s,
                                                   const int lane, const int sub, const int c16, const u32x4 (&a)[16], const u32x4 (&h)[2]) {
        if (!VSIDE) {
            int d[16];
#pragma unroll
            for (int i = 0; i < 16; ++i) {
                int acc = 0;
#pragma unroll
                for (int k = 0; k < 4; ++k) acc = __builtin_amdgcn_sdot4((int)a[i][k], (int)h[0][k], acc, false);
                d[i] = acc;
            }
            bfly16i_stage<8>(d, lane, 4); bfly16i_stage<4>(d, lane, 2); bfly16i_stage<2>(d, lane, 1);
            const int i0 = ((lane & 4) << 1) + ((lane & 2) << 1) + ((lane & 1) << 1);
            unsigned* PART = (unsigned*)(p.ws + OFF_PART) + (((size_t)s * NTOK + t) * 128 + sub * 16 + i0) / 2;
            *PART = ((unsigned)((d[0] + 32) >> 6) & 0xffffu) | ((unsigned)((d[1] + 32) >> 6) << 16);
        } else {
            int acc[16];
#pragma unroll
            for (int i = 0; i < 16; ++i) acc[i] = 0;
#pragma unroll
            for (int g = 0; g < 4; ++g) {
                const int wg = (int)w4[g];
#pragma unroll
                for (int k = 0; k < 4; ++k) {
                    const unsigned r0 = a[4 * g][k], r1 = a[4 * g + 1][k], r2 = a[4 * g + 2][k], r3 = a[4 * g + 3][k];
                    const unsigned x01l = __builtin_amdgcn_perm(r1, r0, 0x05010400u), x01h = __builtin_amdgcn_perm(r1, r0, 0x07030602u);
                    const unsigned x23l = __builtin_amdgcn_perm(r3, r2, 0x05010400u), x23h = __builtin_amdgcn_perm(r3, r2, 0x07030602u);
                    const unsigned t0 = __builtin_amdgcn_perm(x23l, x01l, 0x05040100u), t1 = __builtin_amdgcn_perm(x23l, x01l, 0x07060302u);
                    const unsigned t2 = __builtin_amdgcn_perm(x23h, x01h, 0x05040100u), t3 = __builtin_amdgcn_perm(x23h, x01h, 0x07060302u);
                    acc[4 * k]     = __builtin_amdgcn_sdot4((int)t0, wg, acc[4 * k], false);
                    acc[4 * k + 1] = __builtin_amdgcn_sdot4((int)t1, wg, acc[4 * k + 1], false);
                    acc[4 * k + 2] = __builtin_amdgcn_sdot4((int)t2, wg, acc[4 * k + 2], false);
                    acc[4 * k + 3] = __builtin_amdgcn_sdot4((int)t3, wg, acc[4 * k + 3], false);
                }
            }
            bfly16i_stage<8>(acc, lane, 32); bfly16i_stage<4>(acc, lane, 16); bfly16i_stage<2>(acc, lane, 8);
            const int col = s * 128 + c16 * 16 + ((lane & 32) >> 2) + ((lane & 16) >> 2) + ((lane & 8) >> 2);
            const float* g2 = (const float*)(p.ws + OFF_MOD) + (size_t)(l * 5 + tok_cv(t)) * 6144 + 5 * 1024 + col;
            unsigned* XC = reinterpret_cast<unsigned*>((bf16_t*)(p.ws + OFF_XC) + (size_t)t * D + col);
            const unsigned x = *XC; const float2 g = *reinterpret_cast<const float2*>(g2);
            const float xa = __uint_as_float(x << 16) + g.x * wsc * (float)acc[0], xb = __uint_as_float(x & 0xffff0000u) + g.y * wsc * (float)acc[1];
            *XC = pack_bf2(xa, xb);
            if (l == 0) {
                const float ss = wave_sum(xa * xa + xb * xb);
                if (lane == 0) ((float*)(p.ws + OFF_RSS1))[(size_t)t * 8 + s] = ss;
            }
        }
    }
};
template <bool VSIDE>
__device__ __forceinline__ void peer_slice_stream(const Params& p, const int l, const int s, const int first, const int stride, const int lane) {
    const int sub = lane >> 3, c16 = lane & 7;
    const unsigned char* Ts = p.ws + (VSIDE ? OFF_VT : OFF_UT) + ((size_t)l * 8 + s) * NEXP * 128;
    const int* EIb = (const int*)(p.ws + OFF_EIDX); const unsigned char* WPb = p.ws + OFF_WPAIR; const float* WSb = (const float*)(p.ws + OFF_WSC);
    if (first >= NTOK) return;
    const int cnt = (NTOK - first + stride - 1) / stride;
#define PEER_LOADE(k, elo, ehi, w4, wsc) do { const int _t = min(first + (k) * stride, NTOK - 1); \
        elo = EIb[(size_t)_t * 128 + lane]; ehi = EIb[(size_t)_t * 128 + 64 + lane]; \
        if (VSIDE) { w4 = *reinterpret_cast<const u32x4*>(WPb + (size_t)_t * 128 + sub * 16); wsc = WSb[_t]; } } while (0)
    int e0l, e0h, e1l, e1h, e2l, e2h;
    u32x4 w0 = {0u, 0u, 0u, 0u}, w1 = {0u, 0u, 0u, 0u}, w2 = {0u, 0u, 0u, 0u}; float s0 = 0.f, s1 = 0.f, s2 = 0.f;
    u32x4 A[16], B[16], hA[2], hB[2];
    PEER_LOADE(0, e0l, e0h, w0, s0);
    PEER_LOADE(1, e1l, e1h, w1, s1);
    PeerTok<VSIDE>::issue(p, Ts, e0l, e0h, first, s, sub, c16, A, hA);
    for (int k = 0; k < cnt; k += 2) {
        const int ta = first + k * stride, tb = min(ta + stride, NTOK - 1), tc = min(ta + 2 * stride, NTOK - 1);
        __builtin_amdgcn_sched_barrier(0);
        PEER_LOADE(k + 2, e2l, e2h, w2, s2);
        PeerTok<VSIDE>::issue(p, Ts, e1l, e1h, tb, s, sub, c16, B, hB);
        __builtin_amdgcn_sched_barrier(0);
        PeerTok<VSIDE>::compute(p, l, w0, s0, ta, s, lane, sub, c16, A, hA);
        __builtin_amdgcn_sched_barrier(0);
        e0l = e2l; e0h = e2h; w0 = w2; s0 = s2;
        PEER_LOADE(k + 3, e2l, e2h, w2, s2);
        PeerTok<VSIDE>::issue(p, Ts, e0l, e0h, tc, s, sub, c16, A, hA);
        __builtin_amdgcn_sched_barrier(0);
        if (k + 1 < cnt) PeerTok<VSIDE>::compute(p, l, w1, s1, tb, s, lane, sub, c16, B, hB);
        e1l = e2l; e1h = e2h; w1 = w2; s1 = s2;
    }
#undef PEER_LOADE
}
template <bool VSIDE>
__device__ void ph_peer_sliced(const Params& p, int l, unsigned char* ldsraw, const int wv) {
    const int tid = opaque_tid(wv);
    const int wave = tid >> 6, lane = tid & 63;
    volatile LAS int* hdr = (volatile LAS int*)(ldsraw - LDS_HDR);
    unsigned* bar = (unsigned*)(p.ws + OFF_BAR);
    const int myx = (int)(xb_xcc_id() & 15u);
    if (tid == 0) hdr[16] = (int)atomicAdd(bar + QW_PEER + (l * 2 + (VSIDE ? 1 : 0)) * 16 + myx, 1u);
    __syncthreads();
    const int rank = hdr[16], nloc = (int)hdr[0];
    __syncthreads();
    if (myx < 8) peer_slice_stream<VSIDE>(p, l, myx, rank * 8 + wave, nloc * 8, lane);
    for (int j = 0; j < 8; ++j) {
        if (xb_ld(&bar[XB_XCNT(j)]) == 0u) peer_slice_stream<VSIDE>(p, l, j, (int)blockIdx.x * 8 + wave, (int)gridDim.x * 8, lane);
    }
}
__device__ void ph_peer_pairw(const Params& p, int l, const int wv) {
    const int tid = opaque_tid(wv);
    const int lane = tid & 63;
    const float* EREC = (const float*)(p.ws + OFF_USH) + (size_t)l * NEXP * 8;
    const unsigned short* PART = (const unsigned short*)(p.ws + OFF_PART);
    constexpr size_t NIT = (size_t)NTOK * 32;
    for (size_t i4 = GTID; i4 < NIT; i4 += 2 * GNT) {
        size_t idx[2]; int t[2], e[2][4]; float g[2][4]; uint2 ps[2][8]; float4 ra[2], rb[2], xa[2], xb[2];
#pragma unroll
        for (int u = 0; u < 2; ++u) {
            const size_t iu = i4 + (size_t)u * GNT < NIT ? i4 + (size_t)u * GNT : i4;
            idx[u] = iu * 4; t[u] = (int)(idx[u] >> 7);
            const int pp = (int)(idx[u] & 127), sub = pp >> 4, i = pp & 15;
#pragma unroll
            for (int s = 0; s < 8; ++s) ps[u][s] = *reinterpret_cast<const uint2*>(PART + (size_t)s * NTOK * 128 + idx[u]);
#pragma unroll
            for (int q = 0; q < 4; ++q) {
                const int j = (i + q) * 8 + sub;
                e[u][q] = ((const int*)(p.ws + OFF_EIDX))[(size_t)t[u] * 128 + j]; g[u][q] = ((const float*)(p.ws + OFF_EGATE))[(size_t)t[u] * 128 + j];
            }
            const float* rp = (const float*)(p.ws + OFF_RSS2) + ((size_t)l * NTOK + t[u]) * 8;
            ra[u] = *reinterpret_cast<const float4*>(rp); rb[u] = *reinterpret_cast<const float4*>(rp + 4);
            const float* xp = (const float*)(p.ws + OFF_XGS) + (size_t)t[u] * 8;
            xa[u] = *reinterpret_cast<const float4*>(xp); xb[u] = *reinterpret_cast<const float4*>(xp + 4);
        }
        float4 r0[2][4], r1[2][4];
#pragma unroll
        for (int u = 0; u < 2; ++u)
#pragma unroll
            for (int q = 0; q < 4; ++q) {
                const float* rec = EREC + (size_t)e[u][q] * 8;
                r0[u][q] = *reinterpret_cast<const float4*>(rec); r1[u][q] = *reinterpret_cast<const float4*>(rec + 4);
            }
#pragma unroll
        for (int u = 0; u < 2; ++u) {
            const float hs = rsqrtf((((ra[u].x + ra[u].y) + (ra[u].z + ra[u].w)) + ((rb[u].x + rb[u].y) + (rb[u].z + rb[u].w))) * (1.f / D) + EPS);
            const float xs[8] = {xa[u].x, xa[u].y, xa[u].z, xa[u].w, xb[u].x, xb[u].y, xb[u].z, xb[u].w};
            float sm[4] = {0.f, 0.f, 0.f, 0.f};
#pragma unroll
            for (int s = 0; s < 8; ++s) {
                const uint2 w = ps[u][s];
                sm[0] += xs[s] * (float)((int)(w.x << 16) >> 16); sm[1] += xs[s] * (float)((int)w.x >> 16);
                sm[2] += xs[s] * (float)((int)(w.y << 16) >> 16); sm[3] += xs[s] * (float)((int)w.y >> 16);
            }
            const int cvt = tok_cv(t[u]);
            float w[4];
#pragma unroll
            for (int q = 0; q < 4; ++q) {
                const float4 ra4 = r0[u][q], rb4 = r1[u][q];
                const float ush = cvt == 0 ? ra4.z : (cvt == 1 ? ra4.w : (cvt == 2 ? rb4.x : (cvt == 3 ? rb4.y : rb4.z)));
                w[q] = g[u][q] * gelu_f(sm[q] * 64.f * (ra4.x * hs) + ush) * ra4.y;
            }
            float am = fmaxf(fmaxf(fabsf(w[0]), fabsf(w[1])), fmaxf(fabsf(w[2]), fabsf(w[3])));
            am = row16_max(am); am = fmaxf(am, shfl_x(am, lane, 16));
            const float sc = am > 0.f ? 127.f / am : 1.f;
            *reinterpret_cast<unsigned*>(p.ws + OFF_WPAIR + idx[u]) = pack4_i8(q8(w[0] * sc), q8(w[1] * sc), q8(w[2] * sc), q8(w[3] * sc));
            if ((idx[u] & 127) == 0) ((float*)(p.ws + OFF_WSC))[t[u]] = am > 0.f ? am * (1.f / 127.f) : 1.f;
        }
    }
}

#define CE_DESC(a, b) do { const float _mx = fmaxf((a), (b)); const float _mn = fminf((a), (b)); (a) = _mx; (b) = _mn; } while (0)
__device__ __forceinline__ void sort16_desc(float (&v)[16]) {
#pragma unroll
    for (int k = 2; k <= 16; k <<= 1)
#pragma unroll
        for (int j = k >> 1; j > 0; j >>= 1)
#pragma unroll
            for (int i = 0; i < 16; ++i) {
                const int m = i ^ j;
                if (m > i) { if ((i & k) == 0) CE_DESC(v[i], v[m]); else CE_DESC(v[m], v[i]); }
            }
}
__device__ __forceinline__ void merge_top16(float (&a)[16], const float (&b)[16]) {
#pragma unroll
    for (int i = 0; i < 16; ++i) a[i] = fmaxf(a[i], b[15 - i]);
#pragma unroll
    for (int j = 8; j > 0; j >>= 1)
#pragma unroll
        for (int i = 0; i < 16; ++i) { const int m = i ^ j; if (m > i) CE_DESC(a[i], a[m]); }
}
__device__ __forceinline__ float key_embed(float v, unsigned lowmask, unsigned idxbits) { return __uint_as_float((__float_as_uint(v) & ~lowmask) | idxbits); }

constexpr int SK_ROWB = 144;
__device__ __forceinline__ void peer_qload(const bf16_t* __restrict__ Qrow  , const int hh, bf16x8 (&qb)[4]) {
#pragma unroll
    for (int ks = 0; ks < 4; ++ks) qb[ks] = *reinterpret_cast<const bf16x8*>(Qrow + ks * 16 + hh * 8);
}
__device__ __forceinline__ void peer_stage1(const LAS unsigned char* SK  , const bf16x8 (&qb)[4]  ,
                                            const int r, const int hh, float (&out)[16]) {
    float grp[4][16];
#pragma unroll
    for (int mt = 0; mt < 4; ++mt) {
        f32x16 acc;
#pragma unroll
        for (int i = 0; i < 16; ++i) acc[i] = 0.f;
#pragma unroll
        for (int ks = 0; ks < 4; ++ks) {
            const bf16x8 a = *(const LAS bf16x8*)(SK + (mt * 32 + r) * SK_ROWB + (ks * 16 + hh * 8) * 2);
            acc = MFMA32(a, qb[ks], acc);
        }
        const unsigned hx = (unsigned)hh << 2;
#pragma unroll
        for (int i = 0; i < 16; ++i) {
            const unsigned cn = 32u * mt + (i & 3) + 8u * (i >> 2);
            grp[mt][i] = key_embed(acc[i], 127u, (127u - cn) ^ hx);
        }
        sort16_desc(grp[mt]);
    }
    merge_top16(grp[0], grp[1]); merge_top16(grp[2], grp[3]); merge_top16(grp[0], grp[2]);
    float pb[16];
#pragma unroll
    for (int i = 0; i < 16; ++i) pb[i] = shfl_x(grp[0][i], (hh << 5) | r, 32);
    merge_top16(grp[0], pb);
#pragma unroll
    for (int i = 0; i < 16; ++i) out[i] = grp[0][i];
}

__device__ void ph_peer_select(const Params& p, int l, unsigned char* ldsraw, const int wv) {
    const int tid = opaque_tid(wv);
    const int wave = tid >> 6, lane = tid & 63, r = lane & 31, hh = lane >> 5;
    const int gw = blockIdx.x * 8 + wave, nw = gridDim.x * 8;
    LAS unsigned char* skl = (LAS unsigned char*)ldsraw;
    LAS unsigned char* myl = skl + 2 * 128 * SK_ROWB + wave * 2048 + lane * 32;
    {
        const bf16_t* SKg = (const bf16_t*)(p.ws + OFF_SUBK) + (size_t)l * 2 * 128 * 64;
        for (int i = tid; i < 2 * 128 * 8; i += NT) {
            const int row = i >> 3, ch = i & 7;
            *(LAS u32x4*)(skl + row * SK_ROWB + ch * 16) = *reinterpret_cast<const u32x4*>(SKg + (size_t)row * 64 + ch * 8);
        }
        __syncthreads();
    }
    for (int task = gw; task < (NTOK / 32) * 4; task += nw) {
        const int tg = task >> 2, k = task & 3;
        const int t = tg * 32 + r;
        const bf16_t* Qt = (const bf16_t*)(p.ws + OFF_Q) + (size_t)t * D;
        float sv[2][16];
        {
            bf16x8 qa[4], qb2[4];
            float la[16], lb[16];
            peer_qload(Qt + k * 128, hh, qa);
            peer_qload(Qt + (k + 4) * 128, hh, qb2);
            peer_stage1(skl, qa, r, hh, la);
            peer_qload(Qt + k * 128 + 64, hh, qa);
            peer_stage1(skl, qb2, r, hh, lb);
            peer_qload(Qt + (k + 4) * 128 + 64, hh, qb2);
#pragma unroll
            for (int i = 0; i < 16; ++i) sv[0][i] = hh ? lb[i] : la[i];
            peer_stage1(skl + 128 * SK_ROWB, qa, r, hh, la);
            peer_stage1(skl + 128 * SK_ROWB, qb2, r, hh, lb);
#pragma unroll
            for (int i = 0; i < 16; ++i) sv[1][i] = hh ? lb[i] : la[i];
        }
        {
            unsigned w[8];
#pragma unroll
            for (int q = 0; q < 8; ++q) {
                w[q] = 0u;
#pragma unroll
                for (int b = 0; b < 4; ++b) {
                    const int i = q * 4 + b;
                    const unsigned key = __float_as_uint(i < 16 ? sv[0][i] : sv[1][i - 16]);
                    w[q] |= (127u - (key & 127u)) << (8 * b);
                }
            }
            *(LAS u32x4*)(myl) = u32x4{w[0], w[1], w[2], w[3]};
            *(LAS u32x4*)(myl + 16) = u32x4{w[4], w[5], w[6], w[7]};
        }
        float val0[16], val1[16];
#pragma unroll
        for (int i = 0; i < 16; ++i) { val0[i] = __uint_as_float(__float_as_uint(sv[0][i]) & ~127u); val1[i] = __uint_as_float(__float_as_uint(sv[1][i]) & ~127u); }
        float g0[16], g1[16], g2[16], g3[16];
#pragma unroll
        for (int b = 0; b < 16; ++b) g0[b] = key_embed(val0[0] + val1[b], 255u, 255u - (unsigned)b);
#pragma unroll
        for (int b = 0; b < 8; ++b) g1[b] = key_embed(val0[1] + val1[b], 255u, 255u - (16u + b));
#pragma unroll
        for (int b = 0; b < 5; ++b) g1[8 + b] = key_embed(val0[2] + val1[b], 255u, 255u - (32u + b));
#pragma unroll
        for (int b = 0; b < 3; ++b) g1[13 + b] = key_embed(val0[4] + val1[b], 255u, 255u - (64u + b));
#pragma unroll
        for (int b = 0; b < 4; ++b) g2[b] = key_embed(val0[3] + val1[b], 255u, 255u - (48u + b));
#pragma unroll
        for (int a = 5; a < 8; ++a)
#pragma unroll
            for (int b = 0; b < 2; ++b) g2[4 + (a - 5) * 2 + b] = key_embed(val0[a] + val1[b], 255u, 255u - (16u * a + b));
#pragma unroll
        for (int a = 8; a < 14; ++a) g2[10 + (a - 8)] = key_embed(val0[a] + val1[0], 255u, 255u - 16u * a);
        g3[0] = key_embed(val0[14] + val1[0], 255u, 255u - 16u * 14); g3[1] = key_embed(val0[15] + val1[0], 255u, 255u - 16u * 15);
#pragma unroll
        for (int i = 2; i < 16; ++i) g3[i] = -3.0e38f;
        sort16_desc(g1); sort16_desc(g2); sort16_desc(g3);
        merge_top16(g0, g1); merge_top16(g2, g3); merge_top16(g0, g2);
        float gate[16]; int eid[16];
        const float mx = __uint_as_float(__float_as_uint(g0[0]) & ~255u);
        float sum = 0.f;
#pragma unroll
        for (int i = 0; i < 16; ++i) {
            const unsigned key = __float_as_uint(g0[i]);
            gate[i] = __expf(__uint_as_float(key & ~255u) - mx); sum += gate[i];
            const unsigned id = 255u - (key & 255u);
            const unsigned n0 = *(const LAS unsigned char*)(myl + (id >> 4));
            const unsigned n1 = *(const LAS unsigned char*)(myl + 16 + (id & 15u));
            eid[i] = (int)(n0 * 128u + n1);
        }
        const float inv = 1.f / sum;
        const int h = k + 4 * hh;
        int* EI = (int*)(p.ws + OFF_EIDX) + (size_t)t * 128 + h * 16; float* EG = (float*)(p.ws + OFF_EGATE) + (size_t)t * 128 + h * 16;
#pragma unroll
        for (int q = 0; q < 4; ++q) {
            *reinterpret_cast<int4*>(EI + q * 4) = make_int4(eid[q * 4], eid[q * 4 + 1], eid[q * 4 + 2], eid[q * 4 + 3]);
            *reinterpret_cast<float4*>(EG + q * 4) = make_float4(gate[q * 4] * inv, gate[q * 4 + 1] * inv, gate[q * 4 + 2] * inv, gate[q * 4 + 3] * inv);
        }
    }
}

constexpr int LDS_BYTES = LDS_HDR + 3 * 48 * 1024;
__global__ void __launch_bounds__(NT, 2) mk_fwd(Params p) {
    extern __shared__ __attribute__((aligned(16))) unsigned char lds[];
    const int wv = __builtin_amdgcn_readfirstlane((int)(threadIdx.x >> 6));
    volatile LAS unsigned* st = (volatile LAS unsigned*)lds;
    if (threadIdx.x < 4) st[threadIdx.x] = 0u;
    __syncthreads();
    XcdBarrier xb = xcd_barrier_post((unsigned*)(p.ws + OFF_BAR), st);
    int bar_idx = 0;
#define GRID_BAR() do { xcd_barrier(xb); \
        if (PROBE_TS >= 0 && blockIdx.x == 0 && threadIdx.x == 0 && (bar_idx == PROBE_TS - 1 || bar_idx == PROBE_TS)) \
            ((volatile LAS unsigned long long*)(lds + 128))[bar_idx - (PROBE_TS - 1)] = __builtin_amdgcn_s_memrealtime(); \
        ++bar_idx; } while (0)
    if (PROBE_TS == 0 && blockIdx.x == 0 && threadIdx.x == 0) ((volatile LAS unsigned long long*)(lds + 128))[0] = __builtin_amdgcn_s_memrealtime();
    unsigned char* ws = p.ws;
    for (int rep = 0; rep < (PROBE_DUP == 1 ? 2 : 1); ++rep) {
    ph_transpose_all(p, lds + LDS_HDR, wv);
    ph_convert(p.in[I_SUBK], (bf16_t*)(ws + OFF_SUBK), 2 * 2 * 128 * 64, wv);
    ph_convert(p.in[I_SGUW], (bf16_t*)(ws + OFF_SGUW), 2 * 4 * 128 * 128, wv);
    ph_mod(p, lds + LDS_HDR, wv);
    ph_rope_tab(p, wv);
    GRID_BAR();
    }
    for (int l = 0; l < 2; ++l) {
        for (int rep = 0; rep < (PROBE_DUP == 3 ? 2 : 1); ++rep) {
        if (l == 0) {
            ph_norm_mod(p, 0, 0, 1, wv);
            ph_cache_prep(p, 0, wv);
            ph_fold_tables(p, lds + LDS_HDR, wv);
            GRID_BAR();
        }
        }
        for (int rep = 0; rep < (PROBE_DUP == 5 ? 2 : 1); ++rep) {
        if (l == 0) gemm_phase<EPI_INPROJ>(p, 0, (const bf16_t*)(ws + OFF_H), (const bf16_t*)(ws + OFF_WIN), INW, lds + LDS_HDR, wv);
        else {
            ph_cache_prep(p, 1, wv);
            gemm_phase<EPI_INPROJ>(p, 1, (const bf16_t*)(ws + OFF_XC), (const bf16_t*)(ws + OFF_WINS), INW, lds + LDS_HDR, wv,
                                   (size_t)INW * D, (const float*)(ws + OFF_RSS1), (const float*)(ws + OFF_BIN));
        }
        GRID_BAR();
        }
        for (int rep = 0; rep < ((PROBE_DUP == 4 || (PROBE_DUP >= 10 && PROBE_DUP <= 12)) ? 2 : 1); ++rep) {
        ph_mixers(p, l + 2 * rep, lds + LDS_HDR, wv);
        GRID_BAR();
        }
        if (l == 0) ph_ush(p, lds + LDS_HDR, wv);
        gemm_phase2<EPI_WOUT>(p, l, (const bf16_t*)(ws + OFF_MIX), (const bf16_t*)(ws + OFF_WOUT) + (size_t)l * D * D, D, lds + LDS_HDR, wv);
        GRID_BAR();
        for (int rep = 0; rep < (PROBE_DUP == 7 ? 2 : 1); ++rep) {
        gemm_phase2<EPI_WQ>(p, l, (const bf16_t*)(ws + OFF_XC), (const bf16_t*)(ws + OFF_WQS) + (size_t)l * 5 * D * D, D, lds + LDS_HDR, wv,
                           (size_t)D * D, (const float*)(ws + OFF_RSS2) + (size_t)l * NTOK * 8, (const float*)(ws + OFF_BQ) + (size_t)l * 5 * D);
        GRID_BAR();
        }
        if (PROBE_DUP == 8) { for (int rep = 0; rep < 10; ++rep) GRID_BAR(); }
        for (int rep = 0; rep < (PROBE_DUP == 2 ? 2 : 1); ++rep) {
        ph_peer_select(p, l, lds + LDS_HDR, wv);
        GRID_BAR();
        }
        ph_peer_sliced<false>(p, l, lds + LDS_HDR, wv);
        GRID_BAR();
        ph_peer_pairw(p, l, wv);
        GRID_BAR();
        ph_peer_sliced<true>(p, l, lds + LDS_HDR, wv);
        GRID_BAR();
    }
    ph_final_norm(p, wv);
    if (PROBE_TS >= 0 && blockIdx.x == 0 && threadIdx.x == 0) {
        asm volatile("s_waitcnt vmcnt(0)" ::: "memory");
        volatile LAS unsigned long long* tsl = (volatile LAS unsigned long long*)(lds + 128);
        p.out[0] += (float)(tsl[1] - tsl[0]) * 0.01f;
    }
}

extern "C" void kernel_launch(void* const* d_in, const int* in_sizes, int n_in,
                              void* d_out, int out_size, void* d_ws, size_t ws_size,
                              hipStream_t stream) {
    static int grid = 0;
    if (grid == 0) {
        if (ws_size < WS_NEED) { fprintf(stderr, "kernel_launch: workspace too small: %zu < %zu\n", ws_size, (size_t)WS_NEED); grid = -1; return; }
        int dev = 0, cus = 0, per_cu = 0;
        (void)hipGetDevice(&dev);
        (void)hipDeviceGetAttribute(&cus, hipDeviceAttributeMultiprocessorCount, dev);
        (void)hipFuncSetAttribute((const void*)mk_fwd, hipFuncAttributeMaxDynamicSharedMemorySize, LDS_BYTES);
        (void)hipOccupancyMaxActiveBlocksPerMultiprocessor(&per_cu, (const void*)mk_fwd, NT, LDS_BYTES);
        if (per_cu < 1) { fprintf(stderr, "kernel_launch: occupancy query reports %d blocks per CU\n", per_cu); grid = -1; return; }
        grid = cus;
    }
    if (grid < 0) return;
    (void)hipMemsetAsync((unsigned char*)d_ws + OFF_BAR, 0, 64 * 1024, stream);
    Params p{};
    for (int i = 0; i < 29; ++i) p.in[i] = (const float*)d_in[i];
    p.out = (float*)d_out; p.ws = (unsigned char*)d_ws;
    void* args[] = {&p};
    hipError_t e = hipLaunchCooperativeKernel((const void*)mk_fwd, dim3(grid), dim3(NT), args, LDS_BYTES, stream);
    if (e != hipSuccess) fprintf(stderr, "kernel_launch: cooperative launch failed: %s (grid %d)\n", hipGetErrorString(e), grid);
}
```

```cpp
#include <hip/hip_runtime.h>
#include <hip/hip_bf16.h>
#include <cstdio>
#include <cstdint>
#include <hip/hip_cooperative_groups.h>
namespace cg = cooperative_groups;

#define PROBE_DUP 0
#define PROBE_TS -1
typedef unsigned short bf16_t;
using bf16x8 = __attribute__((ext_vector_type(8))) short;
using f32x4  = __attribute__((ext_vector_type(4))) float;
using f32x16 = __attribute__((ext_vector_type(16))) float;
using f32x2  = __attribute__((ext_vector_type(2))) float;
using u32x4  = __attribute__((ext_vector_type(4))) unsigned;
using u32x2  = __attribute__((ext_vector_type(2))) unsigned;
using s16x4  = __attribute__((ext_vector_type(4))) short;

constexpr int D      = 1024;
constexpr int NTOK   = 16384;
constexpr int NPT    = 8192;
constexpr int SEQ    = 256;
constexpr int DSEQ   = 2048;
constexpr int PAST   = 512;
constexpr int NKS    = DSEQ + PAST;
constexpr int INW    = 2048;
constexpr int NEXP   = 16384;
constexpr float EPS  = 1e-6f;

constexpr size_t MB = 1024 * 1024;
constexpr size_t OFF_BAR   = 0;
constexpr size_t OFF_MOD   = 64 * 1024;
constexpr size_t OFF_ROPE  = OFF_MOD + 256 * 1024;
constexpr size_t OFF_SUBK  = OFF_ROPE + 1 * MB;
constexpr size_t OFF_SGUW  = OFF_SUBK + 64 * 1024;
constexpr size_t OFF_WIN   = OFF_SGUW + 256 * 1024;
constexpr size_t OFF_WOUT  = OFF_WIN + 8 * MB;
constexpr size_t OFF_WQ    = OFF_WOUT + 4 * MB;
constexpr size_t OFF_UT    = OFF_WQ + 4 * MB;
constexpr size_t OFF_USC   = OFF_UT + 32 * MB;
constexpr size_t OFF_VT    = OFF_UT + 64 * MB;
constexpr size_t OFF_VSC   = OFF_VT + 32 * MB;
constexpr size_t OFF_H     = OFF_VT + 64 * MB;
constexpr size_t OFF_XC    = OFF_H + 32 * MB;
constexpr size_t OFF_R1    = OFF_XC + 64 * MB;
constexpr size_t OFF_AU    = OFF_R1;
constexpr size_t OFF_AV    = OFF_AU + 8 * MB;
constexpr size_t OFF_AVN   = OFF_AV + 8 * MB;
constexpr size_t OFF_DQ    = OFF_AVN + 8 * MB;
constexpr size_t OFF_DKP   = OFF_DQ + 8 * MB;
constexpr size_t OFF_DKS   = OFF_DKP + 4 * MB;
constexpr size_t OFF_DVTP  = OFF_DKS + 5 * MB;
constexpr size_t OFF_DVTS  = OFF_DVTP + 4 * MB;
constexpr size_t OFF_GQ    = OFF_DVTS + 5 * MB;
constexpr size_t OFF_GKP   = OFF_GQ + 16 * MB;
constexpr size_t OFF_GKS   = OFF_GKP + 2 * MB;
constexpr size_t OFF_GVTP  = OFF_GKS + 3 * MB;
constexpr size_t OFF_GVTS  = OFF_GVTP + 2 * MB;
constexpr size_t OFF_MIX   = OFF_GVTS + 3 * MB;
constexpr size_t OFF_R1END = OFF_MIX + 32 * MB;
constexpr size_t OFF_Q     = OFF_R1;
constexpr size_t OFF_EIDX  = OFF_Q + 32 * MB;
constexpr size_t OFF_EGATE = OFF_EIDX + 8 * MB;
constexpr size_t OFF_TOPV  = OFF_EGATE + 8 * MB;
constexpr size_t OFF_TOPI  = OFF_TOPV + 16 * MB;
static_assert(OFF_TOPI + 16 * MB <= OFF_R1END, "peer buffers must fit region 1");
constexpr size_t OFF_PROJ  = OFF_R1END;
constexpr size_t OFF_PART  = OFF_PROJ;
constexpr size_t OFF_WPAIR = OFF_PART + 64 * MB;
constexpr size_t OFF_H8I   = OFF_WPAIR + 8 * MB;
constexpr size_t OFF_HSC   = OFF_H8I + 16 * MB;
constexpr size_t OFF_WSC   = OFF_HSC + 64 * 1024;
constexpr size_t OFF_XGS   = OFF_WSC + 64 * 1024;
constexpr size_t OFF_RSS2  = OFF_XGS + 512 * 1024;
constexpr size_t OFF_RSS1  = OFF_RSS2 + 1 * MB;
constexpr size_t OFF_USH   = OFF_RSS1 + 512 * 1024;
constexpr size_t OFF_BQ    = OFF_USH + 1 * MB;
constexpr size_t OFF_BIN   = OFF_BQ + 64 * 1024;
constexpr size_t OFF_WQS   = OFF_BIN + 64 * 1024;
constexpr size_t OFF_WINS  = OFF_XC + 32 * MB;
static_assert(OFF_WQS + 20 * MB <= OFF_PROJ + 128 * MB, "folded tables must fit");
constexpr size_t WS_NEED   = OFF_PROJ + 128 * MB;
static_assert(WS_NEED <= 512 * MB, "workspace budget");

constexpr size_t OUT_YP  = 0;
constexpr size_t OUT_YS  = 8388608;
constexpr size_t OUT_NDK = 16777216;
constexpr size_t OUT_NDV = OUT_NDK + 4194304;
constexpr size_t OUT_NGK = OUT_NDV + 4194304;
constexpr size_t OUT_NGV = OUT_NGK + 2097152;

struct Params {
    const float* in[29];
    float* out;
    unsigned char* ws;
};
enum { I_XP = 0, I_XS, I_CDK, I_CDV, I_CGK, I_CGV, I_C, I_CCTX, I_ADAW, I_ADAB, I_N1G, I_N2G, I_WIN, I_SGUNG, I_SGUW, I_SGUB,
       I_LQ1, I_LK1, I_LQ2, I_LK2, I_SUBLN, I_QNG, I_KNG, I_WOUT, I_WQ, I_SUBK, I_PU, I_PV, I_FG };

typedef __bf16 hwbf2 __attribute__((ext_vector_type(2)));
__device__ __forceinline__ unsigned pack_bf2(float a, float b) {
    const f32x2 v = {a, b};
    return __builtin_bit_cast(unsigned, __builtin_convertvector(v, hwbf2));
}
__device__ __forceinline__ bf16_t f2bf(float f) { return (bf16_t)(pack_bf2(f, 0.f) & 0xffffu); }
__device__ __forceinline__ float bf2f(bf16_t h) { return __uint_as_float(((unsigned)h) << 16); }
__device__ __forceinline__ float gelu_f(float x) {
    const float k2 = 2.f * 0.7978845608028654f * 1.4426950408889634f;
    const float e = __builtin_amdgcn_exp2f(k2 * (x + 0.044715f * x * x * x));
    return x - x * __builtin_amdgcn_rcpf(e + 1.f);
}
__device__ __forceinline__ int lane_id() { return (int)__builtin_amdgcn_mbcnt_hi(~0u, __builtin_amdgcn_mbcnt_lo(~0u, 0u)); }
__device__ __forceinline__ int lane_id_op() { int l = lane_id(); asm volatile("" : "+v"(l)); return l; }
__device__ __forceinline__ float shfl_i(float v, int src) { return __builtin_bit_cast(float, __builtin_amdgcn_ds_bpermute(src << 2, __builtin_bit_cast(int, v))); }
__device__ __forceinline__ int shfl_i(int v, int src) { return __builtin_amdgcn_ds_bpermute(src << 2, v); }
__device__ __forceinline__ float shfl_x(float v, int lane, int m) { return shfl_i(v, lane ^ m); }
__device__ __forceinline__ int shfl_x(int v, int lane, int m) { return shfl_i(v, lane ^ m); }
__device__ __forceinline__ int q8(float x) { return (int)fminf(fmaxf(rintf(x), -127.f), 127.f); }
__device__ __forceinline__ unsigned pack4_i8(int a, int b, int c, int d) { return (unsigned)(a & 255) | ((unsigned)(b & 255) << 8) | ((unsigned)(c & 255) << 16) | ((unsigned)d << 24); }
#define DPP_F(v, ctrl) __builtin_bit_cast(float, __builtin_amdgcn_update_dpp(0, __builtin_bit_cast(int, (v)), (ctrl), 0xF, 0xF, false))
__device__ __forceinline__ float row16_sum(float v) {
    v += DPP_F(v, 0xB1); v += DPP_F(v, 0x4E); v += DPP_F(v, 0x141); v += DPP_F(v, 0x140);
    return v;
}
__device__ __forceinline__ float row16_max(float v) {
    v = fmaxf(v, DPP_F(v, 0xB1)); v = fmaxf(v, DPP_F(v, 0x4E)); v = fmaxf(v, DPP_F(v, 0x141)); v = fmaxf(v, DPP_F(v, 0x140));
    return v;
}
__device__ __forceinline__ float rdlane_f(float v, int l) { return __builtin_bit_cast(float, __builtin_amdgcn_readlane(__builtin_bit_cast(int, v), l)); }
__device__ __forceinline__ float wave_sum(float v) {
    v = row16_sum(v);
    return (rdlane_f(v, 0) + rdlane_f(v, 16)) + (rdlane_f(v, 32) + rdlane_f(v, 48));
}
__device__ __forceinline__ float wave_max(float v) {
    v = row16_max(v);
    return fmaxf(fmaxf(rdlane_f(v, 0), rdlane_f(v, 16)), fmaxf(rdlane_f(v, 32), rdlane_f(v, 48)));
}
__device__ __forceinline__ int tok_cv(int t) { return t < NPT ? 0 : 1 + ((t - NPT) >> 11); }
__device__ __forceinline__ const float* x_in_row(const Params& p, int t) {
    return t < NPT ? p.in[I_XP] + (size_t)t * D : p.in[I_XS] + (size_t)(t - NPT) * D;
}
__device__ __forceinline__ float lam_init_of(int l) { return l == 0 ? 0.2f : (0.8f - 0.6f * 0.7408182206817179f); }
__device__ __forceinline__ float lam_of(const Params& p, int l) {
    float s1 = 0.f, s2 = 0.f;
    for (int i = 0; i < 32; ++i) {
        s1 += p.in[I_LQ1][l * 32 + i] * p.in[I_LK1][l * 32 + i];
        s2 += p.in[I_LQ2][l * 32 + i] * p.in[I_LK2][l * 32 + i];
    }
    return expf(s1) - expf(s2) + lam_init_of(l);
}


#define XB_TMO      128
#define XB_XCNT(j)  (256  + 64 * (j))
#define XB_XSUB(j)  (1280 + 64 * (j))
#define XB_XGEN(j)  (2304 + 64 * (j))
#define XB_TOP      3328
#define XB_TOPGEN   3392
#define XCD_BAR_WORDS 3456
#define XB_SPIN_CAP (1u << 20)
#define LAS __attribute__((address_space(3)))
typedef int i32x4 __attribute__((ext_vector_type(4)));
__device__ __forceinline__ unsigned xb_ld(unsigned* p)              { return __hip_atomic_load(p, __ATOMIC_RELAXED, __HIP_MEMORY_SCOPE_AGENT); }
__device__ __forceinline__ unsigned xb_add(unsigned* p, unsigned v) { return __hip_atomic_fetch_add(p, v, __ATOMIC_RELAXED, __HIP_MEMORY_SCOPE_AGENT); }
__device__ __forceinline__ unsigned xb_xcc_id() { return (unsigned)__builtin_amdgcn_s_getreg((3 << 11) | 20) & 0xFu; }
#define XB_SPIN(cond, bar) do { unsigned _sp = 0; while (cond) { __builtin_amdgcn_s_sleep(1); \
    if ((++_sp & 255u) == 0u) { if (xb_ld(&(bar)[XB_TMO])) break; if (_sp > XB_SPIN_CAP) { atomicAdd(&(bar)[XB_TMO], 1u); break; } } } } while (0)
struct XcdBarrier { unsigned* bar; unsigned x; volatile LAS unsigned* st; };
__device__ __forceinline__ XcdBarrier xcd_barrier_post(unsigned* bar, volatile LAS unsigned* st) {
    XcdBarrier b; b.bar = bar; b.x = xb_xcc_id(); b.st = st;
    if (threadIdx.x == 0) (void)xb_add(&bar[XB_XCNT(b.x)], 1u);
    return b;
}
__device__ __forceinline__ void xcd_barrier_complete(unsigned* bar, unsigned x, unsigned& nloc, unsigned& nx) {
    const unsigned G = gridDim.x * gridDim.y * gridDim.z;
    unsigned sum, cnt, mine, sp = 0u;
    for (;;) {
        sum = 0u; cnt = 0u; mine = 0u;
#pragma unroll
        for (unsigned j = 0; j < 16; ++j) { const unsigned c = xb_ld(&bar[XB_XCNT(j)]); sum += c; cnt += (c > 0u) ? 1u : 0u; mine = (j == x) ? c : mine; }
        if (sum == G) break;
        __builtin_amdgcn_s_sleep(1);
        if ((++sp & 255u) == 0u) { if (xb_ld(&bar[XB_TMO])) break; if (sp > XB_SPIN_CAP) { atomicAdd(&bar[XB_TMO], 1u); break; } }
    }
    nloc = mine > 0u ? mine : 1u; nx = cnt > 0u ? cnt : 1u;
}
__device__ __forceinline__ void xcd_barrier(const XcdBarrier& b) {
    asm volatile("s_waitcnt vmcnt(0)" ::: "memory");
    __syncthreads();
    if (threadIdx.x == 0) {
        unsigned* bar = b.bar;
        const unsigned bx = xb_xcc_id();
        __builtin_amdgcn_s_waitcnt(0);
        unsigned nloc = b.st[0], nx = b.st[1];
        if (nloc == 0u) { xcd_barrier_complete(bar, bx, nloc, nx); b.st[0] = nloc; b.st[1] = nx; }
        const unsigned old = xb_add(&bar[XB_XSUB(bx)], 1u);
        const unsigned gen = old / nloc;
        if (old + 1u == (gen + 1u) * nloc) {
            __builtin_amdgcn_fence(__ATOMIC_RELEASE, "agent");
            asm volatile("s_waitcnt vmcnt(0)" ::: "memory");
            const unsigned og = xb_add(&bar[XB_TOP], 1u);
            const unsigned tg = og / nx;
            if (og + 1u == (tg + 1u) * nx) xb_add(&bar[XB_TOPGEN], 1u);
            else XB_SPIN(xb_ld(&bar[XB_TOPGEN]) == tg, bar);
            __builtin_amdgcn_fence(__ATOMIC_ACQUIRE, "agent");
            xb_add(&bar[XB_XGEN(bx)], 1u);
            asm volatile("s_waitcnt vmcnt(0)" ::: "memory");
        } else {
            XB_SPIN(xb_ld(&bar[XB_XGEN(bx)]) == gen, bar);
            __builtin_amdgcn_fence(__ATOMIC_ACQUIRE, "agent");
            asm volatile("s_waitcnt vmcnt(0)" ::: "memory");
        }
    }
    __syncthreads();
}

constexpr int NT = 512;
constexpr int LDS_HDR = 1024;
#define GTID ((size_t)blockIdx.x * NT + tid)
__device__ __forceinline__ int opaque_tid(int wv) { int t = (wv << 6) | lane_id(); asm volatile("" : "+v"(t)); return t; }
#define GNT  ((size_t)gridDim.x * NT)

__device__ void ph_transpose_all(const Params& p, unsigned char* ldsraw, const int wv) {
    const int tid = opaque_tid(wv);
    LAS bf16_t* T = (LAS bf16_t*)ldsraw;
    for (int tile = blockIdx.x; tile < 1024; tile += gridDim.x) {
        const int l = tile >> 9, r = tile & 511;
        const float* W; bf16_t* Wt; int N, tl;
        if (r < 256)      { W = p.in[I_WIN] + (size_t)l * D * INW; Wt = (bf16_t*)(p.ws + OFF_WIN) + (size_t)l * INW * D; N = INW; tl = r; }
        else if (r < 384) { W = p.in[I_WOUT] + (size_t)l * D * D;  Wt = (bf16_t*)(p.ws + OFF_WOUT) + (size_t)l * D * D;  N = D;   tl = r - 256; }
        else              { W = p.in[I_WQ] + (size_t)l * D * D;    Wt = (bf16_t*)(p.ws + OFF_WQ) + (size_t)l * D * D;    N = D;   tl = r - 384; }
        const int k0 = (tl & 7) * 128, n0 = (tl >> 3) * 64;
        const int nl0 = tid & 63, kq = tid >> 6;
        float v[16];
#pragma unroll
        for (int i = 0; i < 16; ++i) v[i] = W[(size_t)(k0 + i * 8 + kq) * N + n0 + nl0];
#pragma unroll
        for (int i = 0; i < 16; ++i) T[nl0 * 130 + i * 8 + kq] = f2bf(v[i]);
        __syncthreads();
        {
            const int nl = tid >> 3, kc = tid & 7;
            unsigned w[8];
#pragma unroll
            for (int i = 0; i < 8; ++i) w[i] = (unsigned)T[nl * 130 + kc * 16 + 2 * i] | ((unsigned)T[nl * 130 + kc * 16 + 2 * i + 1] << 16);
            bf16_t* dst = Wt + (size_t)(n0 + nl) * D + k0 + kc * 16;
            *reinterpret_cast<u32x4*>(dst) = u32x4{w[0], w[1], w[2], w[3]};
            *reinterpret_cast<u32x4*>(dst + 8) = u32x4{w[4], w[5], w[6], w[7]};
        }
        __syncthreads();
    }
}
__device__ void ph_convert(const float* __restrict__ src, bf16_t* __restrict__ dst, size_t n, const int wv) {
    const int tid = opaque_tid(wv);
    for (size_t idx = GTID; idx < n; idx += GNT) dst[idx] = f2bf(src[idx]);
}
__device__ void ph_convert_i8_rows(const float* __restrict__ src, unsigned char* __restrict__ dst, float* __restrict__ scl, int nrows, const int wv) {
    const int tid = opaque_tid(wv);
    const int lane = tid & 63;
    const int gw = blockIdx.x * 8 + (tid >> 6), nw = gridDim.x * 8;
    for (int row0 = gw * 4; row0 < nrows; row0 += nw * 4) {
        float4 f[4][4];
#pragma unroll
        for (int q = 0; q < 4; ++q)
#pragma unroll
            for (int i = 0; i < 4; ++i) f[q][i] = *reinterpret_cast<const float4*>(src + (size_t)(row0 + q) * D + lane * 16 + i * 4);
#pragma unroll
        for (int q = 0; q < 4; ++q) {
            const int row = row0 + q;
            float v[16];
#pragma unroll
            for (int i = 0; i < 4; ++i) { v[i * 4] = f[q][i].x; v[i * 4 + 1] = f[q][i].y; v[i * 4 + 2] = f[q][i].z; v[i * 4 + 3] = f[q][i].w; }
            float am = 0.f;
#pragma unroll
            for (int i = 0; i < 16; ++i) am = fmaxf(am, fabsf(v[i]));
#pragma unroll
            for (int o = 32; o >= 1; o >>= 1) am = fmaxf(am, shfl_x(am, lane, o));
            const float sc = am > 0.f ? 127.f / am : 1.f;
            unsigned w[4];
#pragma unroll
            for (int i = 0; i < 4; ++i) w[i] = pack4_i8(q8(v[i * 4] * sc), q8(v[i * 4 + 1] * sc), q8(v[i * 4 + 2] * sc), q8(v[i * 4 + 3] * sc));
            {
                const int lyr = row >> 14, e = row & (NEXP - 1);
                *reinterpret_cast<u32x4*>(dst + (((size_t)lyr * 8 + (lane >> 3)) * NEXP + e) * 128 + (lane & 7) * 16) = u32x4{w[0], w[1], w[2], w[3]};
            }
            if (lane == 0) scl[row] = am > 0.f ? am * (1.f / 127.f) : 1.f;
        }
    }
}
__device__ void ph_mod(const Params& p, unsigned char* ldsraw, const int wv) {
    const int tid = opaque_tid(wv);
    LAS float* sl = (LAS float*)ldsraw;
    LAS float* red = sl + 5 * 1024;
    for (int i = tid; i < 5 * 1024; i += NT) {
        const int cv = i >> 10, k = i & 1023;
        const float c = cv == 0 ? p.in[I_CCTX][k] : p.in[I_C][(size_t)(cv - 1) * D + k];
        sl[i] = c / (1.f + __expf(-c));
    }
    __syncthreads();
    const int c4 = tid & 15, r = tid >> 4;
    for (int item = blockIdx.x; item < 2 * 96; item += gridDim.x) {
        const int l = item / 96, j0 = (item % 96) * 64;
        const float* W = p.in[I_ADAW] + (size_t)l * D * 6144 + (size_t)r * 6144 + j0 + c4 * 4;
        float acc[5][4];
#pragma unroll
        for (int cv = 0; cv < 5; ++cv)
#pragma unroll
            for (int q = 0; q < 4; ++q) acc[cv][q] = 0.f;
#pragma unroll 8
        for (int i = 0; i < 32; ++i) {
            const float4 w = *reinterpret_cast<const float4*>(W + (size_t)i * 32 * 6144);
#pragma unroll
            for (int cv = 0; cv < 5; ++cv) {
                const float sv = sl[cv * 1024 + r + i * 32];
                acc[cv][0] += sv * w.x; acc[cv][1] += sv * w.y; acc[cv][2] += sv * w.z; acc[cv][3] += sv * w.w;
            }
        }
#pragma unroll
        for (int cv = 0; cv < 5; ++cv) *(LAS f32x4*)(red + (r * 5 + cv) * 64 + c4 * 4) = f32x4{acc[cv][0], acc[cv][1], acc[cv][2], acc[cv][3]};
        __syncthreads();
        if (tid < 320) {
            const int cv = tid >> 6, c = tid & 63;
            float sum = p.in[I_ADAB][l * 6144 + j0 + c];
#pragma unroll
            for (int q = 0; q < 32; ++q) sum += red[(q * 5 + cv) * 64 + c];
            ((float*)(p.ws + OFF_MOD))[(size_t)(l * 5 + cv) * 6144 + j0 + c] = sum;
        }
        __syncthreads();
    }
}
__device__ void ph_rope_tab(const Params& p, const int wv) {
    const int tid = opaque_tid(wv);
    for (size_t idx = GTID; idx < 2048 * 48; idx += GNT) {
        int s = idx / 48, i = idx % 48;
        float* R = (float*)(p.ws + OFF_ROPE);
        double row = (double)(s / 64), col = (double)(s % 64);
        if (i < 16) {
            int q = i & 7; double inv = pow(10000.0, -(double)q / 8.0);
            double ang = (i < 8 ? row : col) * inv;
            R[s * 16 + i] = (float)cos(ang); R[2048 * 16 + s * 16 + i] = (float)sin(ang);
        } else {
            int ii = i - 16; int q = ii & 15; double inv = pow(10000.0, -(double)q / 16.0);
            double ang = (ii < 16 ? row : col) * inv;
            R[2048 * 32 + s * 32 + ii] = (float)cos(ang); R[2048 * 64 + s * 32 + ii] = (float)sin(ang);
        }
    }
}
__device__ void ph_cache_prep(const Params& p, int l, const int wv) {
    asm volatile("" : "+s"(l));
    const int tid = opaque_tid(wv);
    bf16_t* DKS = (bf16_t*)(p.ws + OFF_DKS); bf16_t* DVTS = (bf16_t*)(p.ws + OFF_DVTS);
    bf16_t* GKS = (bf16_t*)(p.ws + OFF_GKS); bf16_t* GVTS = (bf16_t*)(p.ws + OFF_GVTS);
    for (size_t idx = GTID; idx < 4 * 512 * 256; idx += GNT) {
        int c = idx & 255, pp = (idx >> 8) & 511, b = idx >> 17;
        size_t src = (((size_t)b * 2 + l) * PAST + pp) * 256 + c;
        int h = c >> 6, r = c & 63;
        DKS[(((size_t)b * 4 + h) * NKS + DSEQ + pp) * 64 + r] = f2bf(p.in[I_CDK][src]);
        DVTS[(((size_t)b * 4 + h) * 64 + r) * NKS + DSEQ + pp] = f2bf(p.in[I_CDV][src]);
        if (c < 128) {
            size_t src2 = (((size_t)b * 2 + l) * PAST + pp) * 128 + c;
            int kv = c >> 6;
            const int sq = DSEQ + pp;
            const size_t hb = ((size_t)b * 2 + kv) * NKS * 64 + (size_t)(sq >> 6) * 4096;
            GKS[hb + (r >> 3) * 512 + (sq & 63) * 8 + (r & 7)] = f2bf(p.in[I_CGK][src2]);
            GVTS[hb + (r >> 5) * 2048 + (sq & 63) * 32 + (r & 31)] = f2bf(p.in[I_CGV][src2]);
        }
    }
}
__device__ void ph_fold_tables(const Params& p, unsigned char* ldsraw, const int wv) {
    const int tid = opaque_tid(wv);
    const int lane = tid & 63;
    const int gw = blockIdx.x * 8 + (tid >> 6), nw = gridDim.x * 8;
    const float* MOD = (const float*)(p.ws + OFF_MOD);
    for (size_t idx = GTID; idx < (size_t)(1024 + 1024 + 2048) * 128; idx += GNT) {
        const int row = (int)(idx >> 7), k0 = (int)(idx & 127) * 8;
        const int which = row < 2048 ? 1 : 0, l = row < 1024 ? 0 : 1;
        const int n = row < 2048 ? (row & 1023) : row - 2048, N = row < 2048 ? 1024 : 2048;
        const bf16_t* src = row < 2048 ? (const bf16_t*)(p.ws + OFF_WQ) + ((size_t)l * D + n) * D + k0 : (const bf16_t*)(p.ws + OFF_WIN) + ((size_t)INW + n) * D + k0;
        bf16_t* dst = row < 2048 ? (bf16_t*)(p.ws + OFF_WQS) + ((size_t)l * 5 * D + n) * D + k0 : (bf16_t*)(p.ws + OFF_WINS) + (size_t)n * D + k0;
        const u32x4 w = *reinterpret_cast<const u32x4*>(src);
        const float* gn = p.in[which ? I_N2G : I_N1G] + l * D + k0;
        const float4 ga = *reinterpret_cast<const float4*>(gn), gb = *reinterpret_cast<const float4*>(gn + 4);
        float wf[8];
#pragma unroll
        for (int k = 0; k < 4; ++k) { wf[2 * k] = __uint_as_float(w[k] << 16); wf[2 * k + 1] = __uint_as_float(w[k] & 0xffff0000u); }
        wf[0] *= ga.x; wf[1] *= ga.y; wf[2] *= ga.z; wf[3] *= ga.w; wf[4] *= gb.x; wf[5] *= gb.y; wf[6] *= gb.z; wf[7] *= gb.w;
#pragma unroll
        for (int cv = 0; cv < 5; ++cv) {
            const float* sc = MOD + (size_t)(l * 5 + cv) * 6144 + which * 3072 + 1024 + k0;
            const float4 sa = *reinterpret_cast<const float4*>(sc), sb = *reinterpret_cast<const float4*>(sc + 4);
            *reinterpret_cast<u32x4*>(dst + (size_t)cv * N * D) = u32x4{pack_bf2(wf[0] * (1.f + sa.x), wf[1] * (1.f + sa.y)), pack_bf2(wf[2] * (1.f + sa.z), wf[3] * (1.f + sa.w)),
                                                                         pack_bf2(wf[4] * (1.f + sb.x), wf[5] * (1.f + sb.y)), pack_bf2(wf[6] * (1.f + sb.z), wf[7] * (1.f + sb.w))};
        }
    }
    for (int row = gw; row < 1024 + 1024 + 2048; row += nw) {
        const int which = row < 2048 ? 1 : 0, l = row < 1024 ? 0 : 1;
        const int n = row < 2048 ? (row & 1023) : row - 2048;
        const bf16_t* src = row < 2048 ? (const bf16_t*)(p.ws + OFF_WQ) + ((size_t)l * D + n) * D + lane * 16 : (const bf16_t*)(p.ws + OFF_WIN) + ((size_t)INW + n) * D + lane * 16;
        const u32x4 w0 = *reinterpret_cast<const u32x4*>(src), w1 = *reinterpret_cast<const u32x4*>(src + 8);
        float wf[16];
#pragma unroll
        for (int k = 0; k < 4; ++k) { wf[2 * k] = __uint_as_float(w0[k] << 16); wf[2 * k + 1] = __uint_as_float(w0[k] & 0xffff0000u);
                                      wf[8 + 2 * k] = __uint_as_float(w1[k] << 16); wf[8 + 2 * k + 1] = __uint_as_float(w1[k] & 0xffff0000u); }
#pragma unroll
        for (int cv = 0; cv < 5; ++cv) {
            const float* sh = MOD + (size_t)(l * 5 + cv) * 6144 + which * 3072 + lane * 16;
            float acc = 0.f;
#pragma unroll
            for (int q = 0; q < 4; ++q) {
                const float4 a = *reinterpret_cast<const float4*>(sh + q * 4);
                acc += wf[q * 4] * a.x + wf[q * 4 + 1] * a.y + wf[q * 4 + 2] * a.z + wf[q * 4 + 3] * a.w;
            }
            acc = wave_sum(acc);
            if (lane == 0) {
                if (row < 2048) ((float*)(p.ws + OFF_BQ))[(size_t)(l * 5 + cv) * D + n] = acc;
                else            ((float*)(p.ws + OFF_BIN))[(size_t)cv * INW + n] = acc;
            }
        }
    }
}
__device__ void ph_ush(const Params& p, unsigned char* ldsraw, const int wv) {
    const int tid = opaque_tid(wv);
    const int lane = tid & 63;
    const int gw = blockIdx.x * 8 + (tid >> 6), nw = gridDim.x * 8;
    const float* MOD = (const float*)(p.ws + OFF_MOD);
    {
        LAS signed char* s8 = (LAS signed char*)ldsraw;
        LAS float* s8s = (LAS float*)(ldsraw + 10 * 1024);
        const int wave = tid >> 6;
        for (int r = wave; r < 10; r += 8) {
            const float* sh = MOD + (size_t)r * 6144 + 3072 + lane * 16;
            float v[16];
#pragma unroll
            for (int q = 0; q < 4; ++q) { const float4 a = *reinterpret_cast<const float4*>(sh + q * 4); v[q * 4] = a.x; v[q * 4 + 1] = a.y; v[q * 4 + 2] = a.z; v[q * 4 + 3] = a.w; }
            float am = 0.f;
#pragma unroll
            for (int i = 0; i < 16; ++i) am = fmaxf(am, fabsf(v[i]));
            am = wave_max(am);
            const float sc = am > 0.f ? 127.f / am : 1.f;
            u32x4 w;
#pragma unroll
            for (int q = 0; q < 4; ++q) w[q] = pack4_i8(q8(v[q * 4] * sc), q8(v[q * 4 + 1] * sc), q8(v[q * 4 + 2] * sc), q8(v[q * 4 + 3] * sc));
            *(LAS u32x4*)(s8 + r * 1024 + lane * 16) = w;
            if (lane == 0) s8s[r] = am > 0.f ? am * (1.f / 127.f) : 1.f;
        }
        __syncthreads();
        const int fr = lane & 15, fq = lane >> 4;
        for (int task = gw; task < 2 * (NEXP / 16); task += nw) {
            const int l = task >> 10, e0 = (task & 1023) * 16;
            const unsigned char* up = p.ws + OFF_UT + ((size_t)l * 8 * NEXP + e0 + fr) * 128 + fq * 16;
            i32x4 acc = {0, 0, 0, 0};
#pragma unroll
            for (int st = 0; st < 16; ++st) {
                const i32x4 a = *reinterpret_cast<const i32x4*>(up + (size_t)(st >> 1) * NEXP * 128 + (st & 1) * 64);
                i32x4 b = {0, 0, 0, 0};
                if (fr < 5) b = *(const LAS i32x4*)(s8 + (l * 5 + fr) * 1024 + st * 64 + fq * 16);
                acc = __builtin_amdgcn_mfma_i32_16x16x64_i8(a, b, acc, 0, 0, 0);
            }
            if (fr < 5) {
                const float ss = s8s[l * 5 + fr];
#pragma unroll
                for (int r = 0; r < 4; ++r) {
                    const int e = e0 + fq * 4 + r;
                    { float* rec = (float*)(p.ws + OFF_USH) + ((size_t)l * NEXP + e) * 8; rec[2 + fr] = (float)acc[r] * ss * rec[0]; }
                }
            }
        }
        __syncthreads();
    }
}
__device__ void ph_norm_mod(const Params& p, int l, int which, int from_input, const int wv) {
    const int tid = opaque_tid(wv);
    const int lane = tid & 63;
    const int gw = blockIdx.x * 8 + (tid >> 6), nw = gridDim.x * 8;
    const float* g = p.in[which ? I_N2G : I_N1G] + l * D;
    if (from_input) {
        float4 nx[4];
        {
            const int t = gw < NTOK ? gw : NTOK - 1;
            const float* xr = x_in_row(p, t);
#pragma unroll
            for (int i = 0; i < 4; ++i) nx[i] = *reinterpret_cast<const float4*>(xr + i * 256 + lane * 4);
        }
        for (int t = gw; t < NTOK; t += nw) {
            float4 v[4];
#pragma unroll
            for (int i = 0; i < 4; ++i) v[i] = nx[i];
            {
                const int tn = t + nw < NTOK ? t + nw : t;
                const float* xn = x_in_row(p, tn);
#pragma unroll
                for (int i = 0; i < 4; ++i) nx[i] = *reinterpret_cast<const float4*>(xn + i * 256 + lane * 4);
            }
            const float* mod = (const float*)(p.ws + OFF_MOD) + (size_t)(l * 5 + tok_cv(t)) * 6144 + which * 3072;
            float ss = 0.f;
#pragma unroll
            for (int i = 0; i < 4; ++i) ss += v[i].x * v[i].x + v[i].y * v[i].y + v[i].z * v[i].z + v[i].w * v[i].w;
            ss = wave_sum(ss);
            float r = rsqrtf(ss / D + EPS);
            bf16_t* H = (bf16_t*)(p.ws + OFF_H) + (size_t)t * D;
#pragma unroll
            for (int i = 0; i < 4; ++i) {
                int c = i * 256 + lane * 4;
                float4 gg = *reinterpret_cast<const float4*>(g + c), sh = *reinterpret_cast<const float4*>(mod + c), sc = *reinterpret_cast<const float4*>(mod + 1024 + c);
                uint2 o;
                o.x = pack_bf2(v[i].x * r * gg.x * (1.f + sc.x) + sh.x, v[i].y * r * gg.y * (1.f + sc.y) + sh.y);
                o.y = pack_bf2(v[i].z * r * gg.z * (1.f + sc.z) + sh.z, v[i].w * r * gg.w * (1.f + sc.w) + sh.w);
                *reinterpret_cast<uint2*>(H + c) = o;
            }
        }
    } else {
        u32x4 nx[2];
        {
            const int t = gw < NTOK ? gw : NTOK - 1;
            const bf16_t* xr = (const bf16_t*)(p.ws + OFF_XC) + (size_t)t * D + lane * 8;
            nx[0] = *reinterpret_cast<const u32x4*>(xr); nx[1] = *reinterpret_cast<const u32x4*>(xr + 512);
        }
        for (int t = gw; t < NTOK; t += nw) {
            float v[16];
#pragma unroll
            for (int h = 0; h < 2; ++h)
#pragma unroll
                for (int k = 0; k < 4; ++k) { v[h * 8 + 2 * k] = __uint_as_float(nx[h][k] << 16); v[h * 8 + 2 * k + 1] = __uint_as_float(nx[h][k] & 0xffff0000u); }
            {
                const int tn = t + nw < NTOK ? t + nw : t;
                const bf16_t* xn = (const bf16_t*)(p.ws + OFF_XC) + (size_t)tn * D + lane * 8;
                nx[0] = *reinterpret_cast<const u32x4*>(xn); nx[1] = *reinterpret_cast<const u32x4*>(xn + 512);
            }
            const float* mod = (const float*)(p.ws + OFF_MOD) + (size_t)(l * 5 + tok_cv(t)) * 6144 + which * 3072;
            float ss = 0.f;
#pragma unroll
            for (int i = 0; i < 16; ++i) ss += v[i] * v[i];
            ss = wave_sum(ss);
            float r = rsqrtf(ss / D + EPS);
            bf16_t* H = (bf16_t*)(p.ws + OFF_H) + (size_t)t * D;
            float hq[16];
#pragma unroll
            for (int h = 0; h < 2; ++h) {
                const int c = h * 512 + lane * 8;
                float o[8];
#pragma unroll
                for (int q = 0; q < 2; ++q) {
                    const float4 gg = *reinterpret_cast<const float4*>(g + c + q * 4), sh = *reinterpret_cast<const float4*>(mod + c + q * 4), sc = *reinterpret_cast<const float4*>(mod + 1024 + c + q * 4);
                    o[q * 4] = v[h * 8 + q * 4] * r * gg.x * (1.f + sc.x) + sh.x; o[q * 4 + 1] = v[h * 8 + q * 4 + 1] * r * gg.y * (1.f + sc.y) + sh.y;
                    o[q * 4 + 2] = v[h * 8 + q * 4 + 2] * r * gg.z * (1.f + sc.z) + sh.z; o[q * 4 + 3] = v[h * 8 + q * 4 + 3] * r * gg.w * (1.f + sc.w) + sh.w;
                }
                *reinterpret_cast<u32x4*>(H + c) = u32x4{pack_bf2(o[0], o[1]), pack_bf2(o[2], o[3]), pack_bf2(o[4], o[5]), pack_bf2(o[6], o[7])};
#pragma unroll
                for (int q = 0; q < 8; ++q) hq[h * 8 + q] = o[q];
            }
            if (which) {
                float am = 0.f;
#pragma unroll
                for (int i = 0; i < 16; ++i) am = fmaxf(am, fabsf(hq[i]));
#pragma unroll
                for (int o2 = 32; o2 >= 1; o2 >>= 1) am = fmaxf(am, shfl_x(am, lane, o2));
                const float sc8 = am > 0.f ? 127.f / am : 1.f;
#pragma unroll
                for (int h = 0; h < 2; ++h) {
                    uint2 w;
                    w.x = pack4_i8(q8(hq[h * 8] * sc8), q8(hq[h * 8 + 1] * sc8), q8(hq[h * 8 + 2] * sc8), q8(hq[h * 8 + 3] * sc8));
                    w.y = pack4_i8(q8(hq[h * 8 + 4] * sc8), q8(hq[h * 8 + 5] * sc8), q8(hq[h * 8 + 6] * sc8), q8(hq[h * 8 + 7] * sc8));
                    *reinterpret_cast<uint2*>(p.ws + OFF_H8I + (size_t)t * D + h * 512 + lane * 8) = w;
                }
                if (lane == 0) ((float*)(p.ws + OFF_HSC))[t] = am > 0.f ? am * (1.f / 127.f) : 1.f;
            }
        }
    }
}
__device__ void ph_sgu_norm(const Params& p, int l, const int wv) {
    const int tid = opaque_tid(wv);
    const int lane = tid & 63;
    const int gw = blockIdx.x * 8 + (tid >> 6), nw = gridDim.x * 8;
    for (int t = gw; t < NTOK; t += nw) {
        const bf16_t* AV = (const bf16_t*)(p.ws + OFF_AV) + (size_t)t * 256;
        float v[4]; float ss = 0.f;
#pragma unroll
        for (int i = 0; i < 4; ++i) { v[i] = bf2f(AV[i * 64 + lane]); ss += v[i] * v[i]; }
        ss = wave_sum(ss);
        float r = rsqrtf(ss / 256.f + EPS);
#pragma unroll
        for (int i = 0; i < 4; ++i) ((bf16_t*)(p.ws + OFF_AVN))[(size_t)t * 256 + i * 64 + lane] = f2bf(v[i] * r * p.in[I_SGUNG][l * 256 + i * 64 + lane]);
    }
}
__device__ void ph_sgu_mix(const Params& p, int l, const int wv) {
    const int tid = opaque_tid(wv);
    const bf16_t* AVN = (const bf16_t*)(p.ws + OFF_AVN);
    for (size_t idx = GTID; idx < (size_t)NTOK * 256; idx += GNT) {
        int t = (int)(idx >> 8), c = (int)(idx & 255);
        int t0 = t & ~127, pp = t & 127, g = c >> 6;
        const bf16_t* W = (const bf16_t*)(p.ws + OFF_SGUW) + (((size_t)l * 4 + g) * 128 + pp) * 128;
        float acc = 0.f;
        for (int q = 0; q < 128; ++q) acc += bf2f(W[q]) * bf2f(AVN[(size_t)(t0 + q) * 256 + c]);
        acc += p.in[I_SGUB][(l * 4 + g) * 128 + pp];
        float au = bf2f(((const bf16_t*)(p.ws + OFF_AU))[(size_t)t * 256 + c]);
        ((bf16_t*)(p.ws + OFF_MIX))[(size_t)t * D + c] = f2bf(au * acc);
    }
}
__device__ void ph_attn_ref(const Params& p, int l, const int wv) {
    const int tid = opaque_tid(wv);
    const int lane = tid & 63;
    const int gw = blockIdx.x * 8 + (tid >> 6), nw = gridDim.x * 8;
    const float lam = lam_of(p, l);
    for (int item = gw; item < NTOK * 12; item += nw) {
        const int t = item % NTOK, hh = item / NTOK;
        const bool prompt = t < NPT;
        const int b = prompt ? t / SEQ : (t - NPT) / DSEQ;
        const int nk = prompt ? SEQ : NKS;
        if (hh < 4) {
            const int h = hh;
            const bf16_t* K = prompt ? (const bf16_t*)(p.ws + OFF_DKP) + ((size_t)b * 4 + h) * SEQ * 64 : (const bf16_t*)(p.ws + OFF_DKS) + ((size_t)b * 4 + h) * NKS * 64;
            const bf16_t* Vt = prompt ? (const bf16_t*)(p.ws + OFF_DVTP) + ((size_t)b * 4 + h) * 64 * SEQ : (const bf16_t*)(p.ws + OFF_DVTS) + ((size_t)b * 4 + h) * 64 * NKS;
            float q = bf2f(((const bf16_t*)(p.ws + OFF_DQ))[(size_t)t * 256 + h * 64 + lane]);
            const float scale = 0.17677669529663687f;
            float m0 = -1e30f, m1 = -1e30f, l0 = 0.f, l1 = 0.f, a0 = 0.f, a1 = 0.f;
            for (int k = 0; k < nk; ++k) {
                float pr = q * bf2f(K[(size_t)k * 64 + lane]);
#pragma unroll
                for (int o = 16; o >= 1; o >>= 1) pr += shfl_x(pr, lane, o);
                float s0 = shfl_i(pr, 0) * scale, s1 = shfl_i(pr, 32) * scale;
                float v = bf2f(Vt[(size_t)lane * nk + k]);
                float mn0 = fmaxf(m0, s0), mn1 = fmaxf(m1, s1);
                float c0 = expf(m0 - mn0), c1 = expf(m1 - mn1);
                float e0 = expf(s0 - mn0), e1 = expf(s1 - mn1);
                l0 = l0 * c0 + e0; l1 = l1 * c1 + e1;
                a0 = a0 * c0 + e0 * v; a1 = a1 * c1 + e1 * v;
                m0 = mn0; m1 = mn1;
            }
            float o = a0 / l0 - lam * a1 / l1;
            float ss = wave_sum(o * o);
            float r = rsqrtf(ss / 64.f + EPS);
            o = o * r * p.in[I_SUBLN][l * 64 + lane] * (1.f - lam_init_of(l));
            ((bf16_t*)(p.ws + OFF_MIX))[(size_t)t * D + 256 + h * 64 + lane] = f2bf(o);
        } else {
            const int hq = hh - 4, kv = hq >> 2;
            const bf16_t* K = prompt ? (const bf16_t*)(p.ws + OFF_GKP) + ((size_t)b * 2 + kv) * SEQ * 64 : (const bf16_t*)(p.ws + OFF_GKS) + ((size_t)b * 2 + kv) * NKS * 64;
            const bf16_t* Vt = prompt ? (const bf16_t*)(p.ws + OFF_GVTP) + ((size_t)b * 2 + kv) * 64 * SEQ : (const bf16_t*)(p.ws + OFF_GVTS) + ((size_t)b * 2 + kv) * 64 * NKS;
            float q = bf2f(((const bf16_t*)(p.ws + OFF_GQ))[(size_t)t * 512 + hq * 64 + lane]);
            float m = -1e30f, ls = 0.f, a = 0.f;
            for (int k = 0; k < nk; ++k) {
                float s = wave_sum(q * bf2f(K[(size_t)k * 64 + lane])) * 0.125f;
                float v = bf2f(Vt[(size_t)lane * nk + k]);
                float mn = fmaxf(m, s);
                float c = expf(m - mn), e = expf(s - mn);
                ls = ls * c + e; a = a * c + e * v; m = mn;
            }
            ((bf16_t*)(p.ws + OFF_MIX))[(size_t)t * D + 512 + hq * 64 + lane] = f2bf(a / ls);
        }
    }
}
__device__ void ph_peer_scores(const Params& p, int l, const int wv) {
    const int tid = opaque_tid(wv);
    const bf16_t* SK = (const bf16_t*)(p.ws + OFF_SUBK) + (size_t)l * 2 * 128 * 64;
    for (size_t idx = GTID; idx < (size_t)NTOK * 2048; idx += GNT) {
        int t = (int)(idx >> 11), o = (int)(idx & 2047);
        const bf16_t* Q = (const bf16_t*)(p.ws + OFF_Q) + (size_t)t * D;
        int n = o & 127, x = (o >> 7) & 1, h = o >> 8;
        float acc = 0.f;
        for (int k = 0; k < 64; ++k) acc += bf2f(Q[h * 128 + x * 64 + k]) * bf2f(SK[((size_t)x * 128 + n) * 64 + k]);
        ((float*)(p.ws + OFF_PROJ))[idx] = acc;
    }
}
__device__ void ph_peer_top1(const Params& p, const int wv) {
    const int tid = opaque_tid(wv);
    for (size_t idx = GTID; idx < (size_t)NTOK * 16; idx += GNT) {
        const float* SC = (const float*)(p.ws + OFF_PROJ) + idx * 128;
        float* TV = (float*)(p.ws + OFF_TOPV) + idx * 16; int* TI = (int*)(p.ws + OFF_TOPI) + idx * 16;
        float pv = 3.0e38f; int pi = -1;
        for (int r = 0; r < 16; ++r) {
            float bv = -3.0e38f; int bi = -1;
            for (int n = 0; n < 128; ++n) {
                float v = SC[n];
                bool after = (v < pv) || (v == pv && n > pi);
                if (after && (bi < 0 || v > bv)) { bv = v; bi = n; }
            }
            TV[r] = bv; TI[r] = bi; pv = bv; pi = bi;
        }
    }
}
__device__ void ph_peer_top2(const Params& p, const int wv) {
    const int tid = opaque_tid(wv);
    for (size_t idx = GTID; idx < (size_t)NTOK * 8; idx += GNT) {
        const float* TV = (const float*)(p.ws + OFF_TOPV) + idx * 32; const int* TI = (const int*)(p.ws + OFF_TOPI) + idx * 32;
        int* EI = (int*)(p.ws + OFF_EIDX) + idx * 16; float* EG = (float*)(p.ws + OFF_EGATE) + idx * 16;
        float pv = 3.0e38f; int pi = -1; float mx = 0.f, sum = 0.f;
        for (int r = 0; r < 16; ++r) {
            float bv = -3.0e38f; int bi = -1;
            for (int n = 0; n < 256; ++n) {
                float v = TV[n >> 4] + TV[16 + (n & 15)];
                bool after = (v < pv) || (v == pv && n > pi);
                if (after && (bi < 0 || v > bv)) { bv = v; bi = n; }
            }
            if (r == 0) mx = bv;
            float e = expf(bv - mx);
            sum += e;
            EG[r] = e; EI[r] = TI[bi >> 4] * 128 + TI[16 + (bi & 15)];
            pv = bv; pi = bi;
        }
        float inv = 1.f / sum;
        for (int r = 0; r < 16; ++r) EG[r] *= inv;
    }
}
__device__ void ph_peer_apply(const Params& p, int l, unsigned char* lds, const int wv) {
    const int tid = opaque_tid(wv);
    const int sub = tid >> 8, tl = tid & 255;
    const int wave = tl >> 6, lane = tl & 63;
    float* wts = (float*)(lds + 64) + sub * 128; int* eid = (int*)(lds + 64 + 1024) + sub * 128;
    const bf16_t* UT = (const bf16_t*)(p.ws + OFF_UT) + (size_t)l * NEXP * D;
    const bf16_t* VT = (const bf16_t*)(p.ws + OFF_VT) + (size_t)l * NEXP * D;
    const int niter = (NTOK + gridDim.x * 2 - 1) / (gridDim.x * 2);
    for (int it = 0; it < niter; ++it) {
        int t = (it * gridDim.x + blockIdx.x) * 2 + sub;
        const bool valid = t < NTOK; if (!valid) t = NTOK - 1;
        const bf16_t* H = (const bf16_t*)(p.ws + OFF_H) + (size_t)t * D;
        const int* EI = (const int*)(p.ws + OFF_EIDX) + (size_t)t * 128; const float* EG = (const float*)(p.ws + OFF_EGATE) + (size_t)t * 128;
        float hv[16];
#pragma unroll
        for (int i = 0; i < 16; ++i) hv[i] = bf2f(H[lane * 16 + i]);
        for (int jj = 0; jj < 32; ++jj) {
            int j = wave * 32 + jj; int e = EI[j];
            const bf16_t* ur = UT + (size_t)e * D + lane * 16;
            float acc = 0.f;
#pragma unroll
            for (int i = 0; i < 16; ++i) acc += hv[i] * bf2f(ur[i]);
            acc = wave_sum(acc);
            if (lane == 0) { wts[j] = EG[j] * gelu_f(acc); eid[j] = e; }
        }
        __syncthreads();
        float o[4] = {0.f, 0.f, 0.f, 0.f};
        for (int j = 0; j < 128; ++j) {
            const bf16_t* vr = VT + (size_t)eid[j] * D + tl * 4; float w = wts[j];
#pragma unroll
            for (int i = 0; i < 4; ++i) o[i] += w * bf2f(vr[i]);
        }
        const float* mod = (const float*)(p.ws + OFF_MOD) + (size_t)(l * 5 + tok_cv(t)) * 6144 + 5 * 1024;
        float* XC = (float*)(p.ws + OFF_XC) + (size_t)t * D;
        if (valid) {
#pragma unroll
            for (int i = 0; i < 4; ++i) { int c = tl * 4 + i; XC[c] += mod[c] * o[i]; }
        }
        __syncthreads();
    }
}
__device__ void ph_final_norm(const Params& p, const int wv) {
    const int tid = opaque_tid(wv);
    const int lane = tid & 63;
    const int gw = blockIdx.x * 8 + (tid >> 6), nw = gridDim.x * 8;
    u32x4 nx[2];
    {
        const int t = gw < NTOK ? gw : NTOK - 1;
        const bf16_t* xr = (const bf16_t*)(p.ws + OFF_XC) + (size_t)t * D + lane * 8;
        nx[0] = *reinterpret_cast<const u32x4*>(xr); nx[1] = *reinterpret_cast<const u32x4*>(xr + 512);
    }
    for (int t = gw; t < NTOK; t += nw) {
        float v[16];
#pragma unroll
        for (int h = 0; h < 2; ++h)
#pragma unroll
            for (int k = 0; k < 4; ++k) { v[h * 8 + 2 * k] = __uint_as_float(nx[h][k] << 16); v[h * 8 + 2 * k + 1] = __uint_as_float(nx[h][k] & 0xffff0000u); }
        {
            const int tn = t + nw < NTOK ? t + nw : t;
            const bf16_t* xn = (const bf16_t*)(p.ws + OFF_XC) + (size_t)tn * D + lane * 8;
            nx[0] = *reinterpret_cast<const u32x4*>(xn); nx[1] = *reinterpret_cast<const u32x4*>(xn + 512);
        }
        float ss = 0.f;
#pragma unroll
        for (int i = 0; i < 16; ++i) ss += v[i] * v[i];
        ss = wave_sum(ss);
        float r = rsqrtf(ss / D + EPS);
        float* y = p.out + (size_t)t * D;
#pragma unroll
        for (int h = 0; h < 2; ++h) {
            const int c = h * 512 + lane * 8;
#pragma unroll
            for (int q = 0; q < 2; ++q) {
                const float4 g = *reinterpret_cast<const float4*>(p.in[I_FG] + c + q * 4);
                *reinterpret_cast<float4*>(y + c + q * 4) = make_float4(v[h * 8 + q * 4] * r * g.x, v[h * 8 + q * 4 + 1] * r * g.y, v[h * 8 + q * 4 + 2] * r * g.z, v[h * 8 + q * 4 + 3] * r * g.w);
            }
        }
    }
}


namespace g8 {
constexpr int BM = 256, BK = 64, HALF = 128, HT = HALF * BK;
__device__ __forceinline__ int lds_byte(int r, int c) {
    int st = (r >> 4) * 2 + (c >> 5), rr = r & 15, cc = c & 31, ob = rr * 64 + cc * 2;
    return st * 1024 + (ob ^ (((ob >> 9) & 1) << 5));
}
__device__ __forceinline__ void stage_rc(int b, int& R, int& C) {
    int st = b / 1024, sb = b % 1024, swz = sb ^ (((sb >> 9) & 1) << 5);
    R = (st >> 1) * 16 + swz / 64; C = (st & 1) * 32 + (swz % 64) / 2;
}
}
enum { EPI_INPROJ = 0, EPI_WOUT = 1, EPI_WQ = 2 };
constexpr int STG = 132;

__device__ __forceinline__ void store_bf16x32(bf16_t* dst, const float (&v)[32]) {
#pragma unroll
    for (int i = 0; i < 4; ++i) {
        uint4 u;
        u.x = pack_bf2(v[i * 8 + 0], v[i * 8 + 1]); u.y = pack_bf2(v[i * 8 + 2], v[i * 8 + 3]);
        u.z = pack_bf2(v[i * 8 + 4], v[i * 8 + 5]); u.w = pack_bf2(v[i * 8 + 6], v[i * 8 + 7]);
        *reinterpret_cast<uint4*>(dst + i * 8) = u;
    }
}
__device__ __forceinline__ void store_f32x32(float* dst, const float (&v)[32]) {
#pragma unroll
    for (int i = 0; i < 8; ++i) *reinterpret_cast<float4*>(dst + i * 4) = make_float4(v[i * 4], v[i * 4 + 1], v[i * 4 + 2], v[i * 4 + 3]);
}

__device__ __forceinline__ void epi_inproj_xform(const Params& p, int l, int t, int c0, float (&v)[32]) {
    const bool prompt = t < NPT;
    const int s = prompt ? (t & 255) : ((t - NPT) & 2047);
    const float* R = (const float*)(p.ws + OFF_ROPE);
    if (c0 < 512) {
#pragma unroll
        for (int i = 0; i < 32; ++i) v[i] = gelu_f(v[i]);
    } else if (c0 < 1024) {
        if (!prompt) {
            const float* cs = R + s * 16; const float* sn = R + 2048 * 16 + s * 16;
#pragma unroll
            for (int i = 0; i < 16; ++i) {
                float c = cs[i], sv = sn[i], x1 = v[i], x2 = v[i + 16];
                v[i] = x1 * c - x2 * sv; v[i + 16] = x2 * c + x1 * sv;
            }
        }
    } else if (c0 >= 1280 && c0 < 1920) {
        const bool isq = c0 < 1792;
        const int hi = c0 & 32;
        const float* g = p.in[isq ? I_QNG : I_KNG] + l * 64 + hi;
        float ss = 0.f;
#pragma unroll
        for (int i = 0; i < 32; ++i) ss += v[i] * v[i];
        const int ln = lane_id_op();
        ss += shfl_x(ss, ln, 1);
        const float rr = rsqrtf(ss * (1.f / 64.f) + EPS);
#pragma unroll
        for (int i = 0; i < 32; ++i) v[i] = v[i] * rr * g[i];
        if (!prompt) {
            const float* cs = R + 2048 * 32 + s * 32; const float* sn = R + 2048 * 64 + s * 32;
#pragma unroll
            for (int i = 0; i < 32; ++i) {
                float pv = shfl_x(v[i], ln, 1);
                float c = cs[i], sv = sn[i];
                v[i] = hi ? (v[i] * c + pv * sv) : (v[i] * c - pv * sv);
            }
        }
        if (isq) {
#pragma unroll
            for (int i = 0; i < 32; ++i) v[i] *= 0.125f * 1.4426950408889634f;
        }
    }
}
__device__ __forceinline__ void epi_inproj_col(const Params& p, int t0, int c, const LAS float* stc) {
    float v[32];
#pragma unroll
    for (int i = 0; i < 32; ++i) v[i] = stc[i * STG];
    const bool prompt = t0 < NPT;
    const int b = prompt ? (t0 >> 8) : ((t0 - NPT) >> 11);
    const int s = prompt ? (t0 & 255) : ((t0 - NPT) & 2047);
    unsigned char* ws = p.ws;
    bf16_t* dst;
    if (c < 1280) {
        const int cc = c - 1024, h = cc >> 6, d = cc & 63;
        dst = prompt ? (bf16_t*)(ws + OFF_DVTP) + (((size_t)b * 4 + h) * 64 + d) * SEQ + s
                     : (bf16_t*)(ws + OFF_DVTS) + (((size_t)b * 4 + h) * 64 + d) * NKS + s;
    } else {
        const int cc = c - 1920, kv = cc >> 6, d = cc & 63;
        dst = prompt ? (bf16_t*)(ws + OFF_GVTP) + (((size_t)b * 2 + kv) * 64 + d) * SEQ + s
                     : (bf16_t*)(ws + OFF_GVTS) + (((size_t)b * 2 + kv) * 64 + d) * NKS + s;
    }
    store_bf16x32(dst, v);
}

template <int MODE>
__device__ __forceinline__ void gemm_phase(const Params& p, int l, const bf16_t* __restrict__ A, const bf16_t* __restrict__ Bt, const int N, unsigned char* ldsraw, const int wv,
                                           const size_t cvstride = 0, const float* __restrict__ RSS = nullptr, const float* __restrict__ BIAS = nullptr) {
    using namespace g8;
    constexpr int K = 1024, nt = K / BK, BN = 128, TILE_A = BM * BK * 2, TILE_B = BN * BK * 2, STAGE_B = TILE_A + TILE_B;
    LAS unsigned char* lds = (LAS unsigned char*)ldsraw;
    const int tid = opaque_tid(wv), wid = wv, lane = tid & 63;
    const int wr = wid >> 1, wc = wid & 1, fr = lane & 15, fq = lane >> 4;
    unsigned voff[4];
#pragma unroll
    for (int i = 0; i < 4; ++i) voff[i] = (unsigned)((i * 64 + wid * 8 + (lane >> 3)) * K + (((lane & 7) ^ (lane >> 3)) * 8)) * 2u;
    const int aoff = (wr * 64 + fr) * 128 + ((fq ^ (fr & 7)) * 16), boff = (wc * 64 + fr) * 128 + ((fq ^ (fr & 7)) * 16);
    const unsigned ldsw = (unsigned)wid * 1024u;
#define G8_STAGE(buf, kt) do { \
        _Pragma("unroll") for (int _i = 0; _i < 4; ++_i) \
            __builtin_amdgcn_global_load_lds((const unsigned*)((const char*)(Ab + (kt) * BK) + voff[_i]), (LAS unsigned*)(lds + (buf) * STAGE_B + ldsw + _i * 8192), 16, 0, 0); \
        _Pragma("unroll") for (int _i = 0; _i < 2; ++_i) \
            __builtin_amdgcn_global_load_lds((const unsigned*)((const char*)(Bb + (kt) * BK) + voff[_i]), (LAS unsigned*)(lds + (buf) * STAGE_B + TILE_A + ldsw + _i * 8192), 16, 0, 0); } while (0)
#define G8_WAIT_V0() asm volatile("s_waitcnt vmcnt(0)" ::: "memory")
    const int nN = N / BN, nM = NTOK / BM, ntiles = nM * nN;
    const int G = gridDim.x;
    const int vb = (G % 8 == 0) ? (int)(blockIdx.x % 8) * (G / 8) + (int)(blockIdx.x / 8) : (int)blockIdx.x;
    const int tpb = (ntiles + G - 1) / G;
    const bool paneled = (G == 256) && (nN == 8 || nN == 16) && (nM == 64);
    for (int ti = 0; ti < tpb; ++ti) {
        int tile = vb * tpb + ti;
        if (paneled) {
            const int x = vb >> 5, j = vb & 31;
            const int mpx = nN == 16 ? 16 : 8;
            const int m0 = nN == 16 ? (x >> 1) * 16 : x * 8, n0 = nN == 16 ? (x & 1) * 8 : 0;
            const int pm_ = m0 + ti * 4 + (j >> 3), pn_ = n0 + (j & 7);
            tile = (ti * 4 < mpx) ? pm_ * nN + pn_ : ntiles;
        }
        if (tile >= ntiles) break;
        const int pm = tile / nN, pn = tile % nN, brow = pm * BM, bcol = pn * BN;
        const bf16_t* Ab = A + (size_t)brow * K; const bf16_t* Bb = Bt + (size_t)tok_cv(brow) * cvstride + (size_t)bcol * K;
        f32x4 acc[4][4];
#pragma unroll
        for (int m = 0; m < 4; ++m)
#pragma unroll
            for (int n = 0; n < 4; ++n) acc[m][n] = f32x4{0.f, 0.f, 0.f, 0.f};
        G8_WAIT_V0();
        float4 rsa = make_float4(0.f, 0.f, 0.f, 0.f), rsb = rsa; float bz[4] = {0.f, 0.f, 0.f, 0.f};
        if (MODE != EPI_WOUT && cvstride != 0) {
            const float* rp = RSS + (size_t)(brow + (tid & 255)) * 8;
            rsa = *reinterpret_cast<const float4*>(rp); rsb = *reinterpret_cast<const float4*>(rp + 4);
#pragma unroll
            for (int n = 0; n < 4; ++n) bz[n] = BIAS[(size_t)tok_cv(brow) * N + bcol + wc * 64 + n * 16 + fr];
        }
        G8_STAGE(0, 0); G8_STAGE(1, 1);
        int cur = 0;
        for (int t = 0; t < nt; ++t) {
            if (t + 1 < nt) asm volatile("s_waitcnt vmcnt(6)" ::: "memory"); else asm volatile("s_waitcnt vmcnt(0)" ::: "memory");
            __builtin_amdgcn_s_barrier();
            if (t + 2 < nt) { const int nb = cur >= 1 ? cur - 1 : 2; G8_STAGE(nb, t + 2); }
            {
                bf16x8 At[2][4], Bf[2][4];
#pragma unroll
                for (int ks = 0; ks < 2; ++ks) {
#pragma unroll
                    for (int m = 0; m < 4; ++m) At[ks][m] = *(const LAS bf16x8*)(lds + cur * STAGE_B + ((aoff + m * 2048) ^ (ks * 64)));
#pragma unroll
                    for (int n = 0; n < 4; ++n) Bf[ks][n] = *(const LAS bf16x8*)(lds + cur * STAGE_B + TILE_A + ((boff + n * 2048) ^ (ks * 64)));
                }
                __builtin_amdgcn_sched_barrier(0);
#pragma unroll
                for (int ks = 0; ks < 2; ++ks)
#pragma unroll
                    for (int m = 0; m < 4; ++m)
#pragma unroll
                        for (int n = 0; n < 4; ++n) acc[m][n] = __builtin_amdgcn_mfma_f32_16x16x32_bf16(At[ks][m], Bf[ks][n], acc[m][n], 0, 0, 0);
                __builtin_amdgcn_sched_barrier(0);
            }
            cur = cur == 2 ? 0 : cur + 1;
        }
        __syncthreads();
        LAS float* st = (LAS float*)lds;
        if (MODE != EPI_WOUT && cvstride != 0) {
            LAS float* rs = st + 256 * STG;
            if (tid < 256) rs[tid] = rsqrtf((((rsa.x + rsa.y) + (rsa.z + rsa.w)) + ((rsb.x + rsb.y) + (rsb.z + rsb.w))) * (1.f / D) + EPS);
            __syncthreads();
#pragma unroll
            for (int m = 0; m < 4; ++m)
#pragma unroll
                for (int j = 0; j < 4; ++j) {
                    const float r = rs[wr * 64 + m * 16 + fq * 4 + j];
#pragma unroll
                    for (int n = 0; n < 4; ++n) st[(wr * 64 + m * 16 + fq * 4 + j) * STG + wc * 64 + n * 16 + fr] = acc[m][n][j] * r + bz[n];
                }
        } else {
#pragma unroll
        for (int m = 0; m < 4; ++m)
#pragma unroll
            for (int n = 0; n < 4; ++n)
#pragma unroll
                for (int j = 0; j < 4; ++j)
                    st[(wr * 64 + m * 16 + fq * 4 + j) * STG + wc * 64 + n * 16 + fr] = acc[m][n][j];
        }
        __syncthreads();
        const bool tprompt = brow < NPT;
        const int tb_ = tprompt ? (brow >> 8) : ((brow - NPT) >> 11), ts0 = tprompt ? 0 : ((brow - NPT) & 2047);
        if (MODE == EPI_INPROJ) {
            const bool vtile = (bcol >= 1024 && bcol < 1280);
            if (!vtile) {
#pragma unroll 1
                for (int it = 0; it < 2; ++it) {
                    const int item = it * NT + tid, erow = item >> 2, eseg = item & 3;
                    float v[32];
#pragma unroll
                    for (int i = 0; i < 8; ++i) {
                        const f32x4 f = *(const LAS f32x4*)(st + erow * STG + eseg * 32 + i * 4);
                        v[i * 4] = f[0]; v[i * 4 + 1] = f[1]; v[i * 4 + 2] = f[2]; v[i * 4 + 3] = f[3];
                    }
                    epi_inproj_xform(p, l, brow + erow, bcol + eseg * 32, v);
#pragma unroll
                    for (int i = 0; i < 8; ++i) *(LAS f32x4*)(st + erow * STG + eseg * 32 + i * 4) = f32x4{v[i * 4], v[i * 4 + 1], v[i * 4 + 2], v[i * 4 + 3]};
                }
                __syncthreads();
#pragma unroll 1
                for (int it = 0; it < 8; ++it) {
                    const int item = it * NT + tid, r = item >> 4, c = (item & 15) * 8;
                    const f32x4 f0 = *(const LAS f32x4*)(st + r * STG + c), f1 = *(const LAS f32x4*)(st + r * STG + c + 4);
                    const int t = brow + r, sp = ts0 + r;
                    bf16_t* dst;
                    if (bcol < 512)        dst = (bf16_t*)(p.ws + (bcol < 256 ? OFF_AU : OFF_AV)) + (size_t)t * 256 + (bcol & 255) + c;
                    else if (bcol < 768)   dst = (bf16_t*)(p.ws + OFF_DQ) + (size_t)t * 256 + (bcol - 512) + c;
                    else if (bcol < 1024) { const int cc = bcol - 768 + c, h = cc >> 6;
                                            dst = tprompt ? (bf16_t*)(p.ws + OFF_DKP) + (((size_t)tb_ * 4 + h) * SEQ + sp) * 64 + (cc & 63)
                                                          : (bf16_t*)(p.ws + OFF_DKS) + (((size_t)tb_ * 4 + h) * NKS + sp) * 64 + (cc & 63); }
                    else if (bcol < 1792)  dst = (bf16_t*)(p.ws + OFF_GQ) + (size_t)t * 512 + (bcol - 1280) + c;
                    else                 { const int kv = c >> 6, d0 = c & 63;
                                            const size_t hb = (tprompt ? ((size_t)tb_ * 2 + kv) * SEQ * 64 : ((size_t)tb_ * 2 + kv) * NKS * 64) + (size_t)(sp >> 6) * 4096;
                                            dst = bcol < 1920 ? (bf16_t*)(p.ws + (tprompt ? OFF_GKP : OFF_GKS)) + hb + (d0 >> 3) * 512 + (sp & 63) * 8
                                                              : (bf16_t*)(p.ws + (tprompt ? OFF_GVTP : OFF_GVTS)) + hb + (d0 >> 5) * 2048 + (sp & 63) * 32 + (d0 & 31); }
                    *reinterpret_cast<u32x4*>(dst) = u32x4{pack_bf2(f0[0], f0[1]), pack_bf2(f0[2], f0[3]), pack_bf2(f1[0], f1[1]), pack_bf2(f1[2], f1[3])};
                }
            }
            if (tprompt && ((bcol >= 768 && bcol < 1280) || bcol >= 1792)) {
                float* ob; int rs;
                if (bcol < 1024)      { ob = p.out + OUT_NDK + (((size_t)tb_ * 2 + l) * SEQ) * 256 + (bcol - 768);  rs = 256; }
                else if (bcol < 1280) { ob = p.out + OUT_NDV + (((size_t)tb_ * 2 + l) * SEQ) * 256 + (bcol - 1024); rs = 256; }
                else if (bcol < 1920) { ob = p.out + OUT_NGK + (((size_t)tb_ * 2 + l) * SEQ) * 128;                 rs = 128; }
                else                  { ob = p.out + OUT_NGV + (((size_t)tb_ * 2 + l) * SEQ) * 128;                 rs = 128; }
#pragma unroll 1
                for (int it = 0; it < 16; ++it) {
                    const int item = it * NT + tid, r = item >> 5, c = (item & 31) * 4;
                    *reinterpret_cast<f32x4*>(ob + (size_t)r * rs + c) = *(const LAS f32x4*)(st + r * STG + c);
                }
            }
            if (vtile) {
#pragma unroll 1
                for (int it = 0; it < 2; ++it) {
                    const int item = it * NT + tid, col = item >> 3, run = item & 7;
                    epi_inproj_col(p, brow + run * 32, bcol + col, st + run * 32 * STG + col);
                }
            }
        } else {
            float4 ga = make_float4(0.f, 0.f, 0.f, 0.f), gb = ga, na = ga, nb = ga, sa = ga, sb = ga;
            float4 xna = ga, xnb = ga; u32x4 xnw = {0u, 0u, 0u, 0u};
            if (MODE == EPI_WOUT) {
                const int c = (tid & 15) * 8;
                const float* g1 = (const float*)(p.ws + OFF_MOD) + (size_t)(l * 5 + tok_cv(brow)) * 6144 + 2048 + bcol + c;
                ga = *reinterpret_cast<const float4*>(g1); gb = *reinterpret_cast<const float4*>(g1 + 4);
                sa = *reinterpret_cast<const float4*>(g1 + 2048); sb = *reinterpret_cast<const float4*>(g1 + 2048 + 4);
                const float* gn = p.in[I_N2G] + l * D + bcol + c;
                na = *reinterpret_cast<const float4*>(gn); nb = *reinterpret_cast<const float4*>(gn + 4);
                const int t = brow + (tid >> 4);
                if (l == 0) { const float* xr = x_in_row(p, t) + bcol + c; xna = *reinterpret_cast<const float4*>(xr); xnb = *reinterpret_cast<const float4*>(xr + 4); }
                else xnw = *reinterpret_cast<const u32x4*>((const bf16_t*)(p.ws + OFF_XC) + (size_t)t * D + bcol + c);
            }
#pragma unroll 1
            for (int it = 0; it < 8; ++it) {
                const int item = it * NT + tid, r = item >> 4, c = (item & 15) * 8;
                const f32x4 f0 = *(const LAS f32x4*)(st + r * STG + c), f1 = *(const LAS f32x4*)(st + r * STG + c + 4);
                const int t = brow + r;
                float o[8] = {f0[0], f0[1], f0[2], f0[3], f1[0], f1[1], f1[2], f1[3]};
                if (MODE == EPI_WOUT) {
                    float x[8];
                    if (l == 0) { x[0] = xna.x; x[1] = xna.y; x[2] = xna.z; x[3] = xna.w; x[4] = xnb.x; x[5] = xnb.y; x[6] = xnb.z; x[7] = xnb.w; }
                    else {
#pragma unroll
                        for (int k = 0; k < 4; ++k) { x[2 * k] = __uint_as_float(xnw[k] << 16); x[2 * k + 1] = __uint_as_float(xnw[k] & 0xffff0000u); }
                    }
                    {
                        const int tn = brow + (((it < 7 ? it + 1 : it) * NT + tid) >> 4);
                        if (l == 0) { const float* xr = x_in_row(p, tn) + bcol + c; xna = *reinterpret_cast<const float4*>(xr); xnb = *reinterpret_cast<const float4*>(xr + 4); }
                        else xnw = *reinterpret_cast<const u32x4*>((const bf16_t*)(p.ws + OFF_XC) + (size_t)tn * D + bcol + c);
                    }
                    o[0] = x[0] + ga.x * o[0]; o[1] = x[1] + ga.y * o[1]; o[2] = x[2] + ga.z * o[2]; o[3] = x[3] + ga.w * o[3];
                    o[4] = x[4] + gb.x * o[4]; o[5] = x[5] + gb.y * o[5]; o[6] = x[6] + gb.z * o[6]; o[7] = x[7] + gb.w * o[7];
                    float xg[8] = {o[0] * na.x * (1.f + sa.x), o[1] * na.y * (1.f + sa.y), o[2] * na.z * (1.f + sa.z), o[3] * na.w * (1.f + sa.w),
                                   o[4] * nb.x * (1.f + sb.x), o[5] * nb.y * (1.f + sb.y), o[6] * nb.z * (1.f + sb.z), o[7] * nb.w * (1.f + sb.w)};
                    float ss = 0.f, am = 0.f;
#pragma unroll
                    for (int i = 0; i < 8; ++i) { ss += o[i] * o[i]; am = fmaxf(am, fabsf(xg[i])); }
                    ss = row16_sum(ss); am = row16_max(am);
                    const float sc8 = am > 0.f ? 127.f / am : 1.f;
                    uint2 w8;
                    w8.x = pack4_i8(q8(xg[0] * sc8), q8(xg[1] * sc8), q8(xg[2] * sc8), q8(xg[3] * sc8));
                    w8.y = pack4_i8(q8(xg[4] * sc8), q8(xg[5] * sc8), q8(xg[6] * sc8), q8(xg[7] * sc8));
                    *reinterpret_cast<uint2*>(p.ws + OFF_H8I + (size_t)t * D + bcol + c) = w8;
                    if ((item & 15) == 0) {
                        ((float*)(p.ws + OFF_RSS2))[((size_t)l * NTOK + t) * 8 + pn] = ss;
                        ((float*)(p.ws + OFF_XGS))[(size_t)t * 8 + pn] = am > 0.f ? am * (1.f / 127.f) : 1.f;
                    }
                }
                bf16_t* dst = (bf16_t*)(p.ws + (MODE == EPI_WOUT ? OFF_XC : OFF_Q)) + (size_t)t * D + bcol + c;
                *reinterpret_cast<u32x4*>(dst) = u32x4{pack_bf2(o[0], o[1]), pack_bf2(o[2], o[3]), pack_bf2(o[4], o[5]), pack_bf2(o[6], o[7])};
            }
        }
        __syncthreads();
    }
}


template <int MODE>
__device__ __forceinline__ void gemm_phase2(const Params& p, int l_in, const bf16_t* __restrict__ A_in, const bf16_t* __restrict__ Bt_in, const int N, unsigned char* ldsraw, const int wv,
                                            const size_t cvstride = 0, const float* __restrict__ RSS_in = nullptr, const float* __restrict__ BIAS_in = nullptr) {
    using namespace g8;
    int l = l_in; asm volatile("" : "+s"(l));
    const bf16_t* A = A_in; const bf16_t* Bt = Bt_in; const float* RSS = RSS_in; const float* BIAS = BIAS_in;
    asm volatile("" : "+s"(A), "+s"(Bt), "+s"(RSS), "+s"(BIAS));
    constexpr int K = 1024, nt = K / BK, HTB = HALF * BK * 2;
    LAS unsigned char* lds = (LAS unsigned char*)ldsraw;
    const int tid = opaque_tid(wv), wid = wv, lane = tid & 63;
    const int wr = wid >> 2, wc = wid & 3, fr = lane & 15, fq = lane >> 4;
    unsigned voffA[2];
#pragma unroll
    for (int i = 0; i < 2; ++i) { int R, C; stage_rc(tid * 16 + i * 8192, R, C); voffA[i] = (unsigned)(R * K + C) * 2u; }
    constexpr size_t kstep = (size_t)(BK * 2), hstep = (size_t)HALF * K * 2, tstep = 2 * hstep;
    const unsigned ldsw = (unsigned)wid * 1024u;
    const int aoff = lds_byte(wr * 64 + fr, fq * 8), boff = lds_byte(wc * 32 + fr, fq * 8);
#define PG8_SA(b, h) (((b) * 2 + (h)) * HTB)
#define PG8_SB(b, h) ((4 + (b) * 2 + (h)) * HTB)
#define PG8_STAGE(bufoff, gbase) do { _Pragma("unroll") for (int _i = 0; _i < 2; ++_i) \
        __builtin_amdgcn_global_load_lds((const unsigned*)((const char*)(gbase) + voffA[_i]), (LAS unsigned*)(lds + (bufoff) + ldsw + _i * 8192), 16, 0, 0); } while (0)
#define PG8_LDA(dst, b, h) do { _Pragma("unroll") for (int m = 0; m < 4; ++m) _Pragma("unroll") for (int k = 0; k < 2; ++k) dst[m][k] = *(const LAS bf16x8*)(lds + PG8_SA(b, h) + aoff + m * 2048 + k * 1024); } while (0)
#define PG8_LDB(dst, b, h) do { _Pragma("unroll") for (int n = 0; n < 2; ++n) _Pragma("unroll") for (int k = 0; k < 2; ++k) dst[n][k] = *(const LAS bf16x8*)(lds + PG8_SB(b, h) + boff + n * 2048 + k * 1024); } while (0)
#define PG8_MMA(ai, bj, At_, Bt_) do { __builtin_amdgcn_s_setprio(1); _Pragma("unroll") for (int m = 0; m < 4; ++m) _Pragma("unroll") for (int n = 0; n < 2; ++n) _Pragma("unroll") for (int k = 0; k < 2; ++k) \
        acc[ai][bj][m][n] = __builtin_amdgcn_mfma_f32_16x16x32_bf16(Bt_[n][k], At_[m][k], acc[ai][bj][m][n], 0, 0, 0); __builtin_amdgcn_s_setprio(0); } while (0)
#define PG8_WAIT_V(n) asm volatile("s_waitcnt vmcnt(" #n ")" ::: "memory")
#define PG8_WAIT_L(n) asm volatile("s_waitcnt lgkmcnt(" #n ")" ::: "memory")
#define PG8_BAR __builtin_amdgcn_s_barrier()
#define PG8_SCHED __builtin_amdgcn_sched_barrier(0)
    const int nN = N / 256, nM = NTOK / BM, ntiles = nM * nN;
    const int G = gridDim.x;
    const int vb = (G % 8 == 0) ? (int)(blockIdx.x % 8) * (G / 8) + (int)(blockIdx.x / 8) : (int)blockIdx.x;
    const int tpb = (ntiles + G - 1) / G;
    const bool paneled = (G == 256) && (nN == 4 || nN == 8) && (nM == 64);
    for (int ti = 0; ti < tpb; ++ti) {
        int tile = vb * tpb + ti;
        if (paneled) {
            const int x = vb >> 5, j = vb & 31;
            const int pm_ = nN == 8 ? x * 8 + ti * 4 + (j >> 3) : x * 8 + (j >> 2), pn_ = nN == 8 ? (j & 7) : (j & 3);
            tile = (nN == 8 ? ti < 2 : ti < 1) ? pm_ * nN + pn_ : ntiles;
        }
        if (tile >= ntiles) break;
        const int pm = tile / nN, pn = tile % nN, brow = pm * BM;
        const char* cA = (const char*)(A + (size_t)brow * K);
        const char* cB = (const char*)(Bt + (size_t)tok_cv(brow) * cvstride + (size_t)pn * 256 * K);
        f32x4 acc[2][2][4][2];
#pragma unroll
        for (int a = 0; a < 2; ++a)
#pragma unroll
            for (int b = 0; b < 2; ++b)
#pragma unroll
                for (int m = 0; m < 4; ++m)
#pragma unroll
                    for (int n = 0; n < 2; ++n) acc[a][b][m][n] = f32x4{0.f, 0.f, 0.f, 0.f};
        asm volatile("s_waitcnt vmcnt(0)" ::: "memory");
        {
            bf16x8 At[4][2], B0[2][2], B1[2][2];
            PG8_STAGE(PG8_SB(0, 0), cB); PG8_STAGE(PG8_SA(0, 0), cA); PG8_STAGE(PG8_SB(0, 1), cB + hstep); PG8_STAGE(PG8_SA(0, 1), cA + hstep);
            if (wr == 1) PG8_BAR;
            PG8_WAIT_V(4); PG8_BAR;
            PG8_STAGE(PG8_SB(1, 0), cB + kstep); PG8_STAGE(PG8_SA(1, 0), cA + kstep); PG8_STAGE(PG8_SB(1, 1), cB + hstep + kstep);
            PG8_WAIT_V(6); PG8_BAR;
            for (int t = 0; t < nt; t += 2) {
                const bool last = (t == nt - 2);
                const char* a1 = cA + (size_t)(t + 1) * kstep;
                const char* a2 = last ? cA : cA + (size_t)(t + 2) * kstep; const char* b2 = last ? cB : cB + (size_t)(t + 2) * kstep;
                const char* a3 = a2 + kstep; const char* b3 = b2 + kstep;
                PG8_LDB(B0, 0, 0); PG8_SCHED; PG8_LDA(At, 0, 0); PG8_STAGE(PG8_SA(1, 1), a1 + hstep);
                PG8_WAIT_L(8); PG8_BAR; PG8_WAIT_L(0); PG8_MMA(0, 0, At, B0); PG8_BAR; PG8_SCHED;
                PG8_LDB(B1, 0, 1); PG8_STAGE(PG8_SB(0, 0), b2);
                PG8_BAR; PG8_WAIT_L(0); PG8_MMA(0, 1, At, B1); PG8_BAR;
                PG8_LDA(At, 0, 1); PG8_STAGE(PG8_SA(0, 0), a2);
                PG8_BAR; PG8_WAIT_L(0); PG8_MMA(1, 0, At, B0); PG8_BAR; PG8_SCHED;
                PG8_STAGE(PG8_SB(0, 1), b2 + hstep);
                PG8_WAIT_V(6); PG8_BAR; PG8_MMA(1, 1, At, B1); PG8_BAR;
                PG8_LDB(B0, 1, 0); PG8_SCHED; PG8_LDA(At, 1, 0); PG8_STAGE(PG8_SA(0, 1), a2 + hstep);
                PG8_WAIT_L(8); PG8_BAR; PG8_WAIT_L(0); PG8_MMA(0, 0, At, B0); PG8_BAR; PG8_SCHED;
                PG8_LDB(B1, 1, 1); PG8_STAGE(PG8_SB(1, 0), b3);
                PG8_BAR; PG8_WAIT_L(0); PG8_MMA(0, 1, At, B1); PG8_BAR;
                PG8_LDA(At, 1, 1); PG8_STAGE(PG8_SA(1, 0), a3);
                PG8_BAR; PG8_WAIT_L(0); PG8_MMA(1, 0, At, B0); PG8_BAR; PG8_SCHED;
                PG8_STAGE(PG8_SB(1, 1), b3 + hstep);
                PG8_WAIT_V(6); PG8_BAR; PG8_MMA(1, 1, At, B1); PG8_BAR;
            }
            PG8_WAIT_V(0);
            if (wr == 0) PG8_BAR;
            PG8_BAR;
        }
        unsigned pk1[2][4][2][2];
        if (MODE == EPI_INPROJ) {
#pragma unroll
            for (int a = 0; a < 2; ++a)
#pragma unroll
                for (int m = 0; m < 4; ++m)
#pragma unroll
                    for (int n = 0; n < 2; ++n) { pk1[a][m][n][0] = pack_bf2(acc[a][1][m][n][0], acc[a][1][m][n][1]); pk1[a][m][n][1] = pack_bf2(acc[a][1][m][n][2], acc[a][1][m][n][3]); }
        }
#define ACC_H(a, m, n) (hb == 0 ? acc[a][0][m][n] : (MODE == EPI_INPROJ ? f32x4{__uint_as_float(pk1[a][m][n][0] << 16), __uint_as_float(pk1[a][m][n][0] & 0xffff0000u), \
                                                                            __uint_as_float(pk1[a][m][n][1] << 16), __uint_as_float(pk1[a][m][n][1] & 0xffff0000u)} : acc[a][1][m][n]))
        LAS float* st = (LAS float*)lds;
#pragma unroll 1
        for (int hb = 0; hb < 2; ++hb) {
            const int bcol = pn * 256 + hb * 128;
            const int tid = opaque_tid(wv), lane = tid & 63, fr = lane & 15, fq = lane >> 4;
            if (MODE != EPI_WOUT && cvstride != 0) {
                LAS float* rs = st + 256 * STG;
                if (tid < 256) {
                    const float* rp = RSS + (size_t)(brow + tid) * 8;
                    const float4 a = *reinterpret_cast<const float4*>(rp), b = *reinterpret_cast<const float4*>(rp + 4);
                    rs[tid] = rsqrtf((((a.x + a.y) + (a.z + a.w)) + ((b.x + b.y) + (b.z + b.w))) * (1.f / D) + EPS);
                }
                __syncthreads();
#pragma unroll
                for (int n = 0; n < 2; ++n) {
                    const float4 bz = *reinterpret_cast<const float4*>(BIAS + (size_t)tok_cv(brow) * N + bcol + wc * 32 + n * 16 + fq * 4);
#pragma unroll
                    for (int a = 0; a < 2; ++a)
#pragma unroll
                        for (int m = 0; m < 4; ++m) {
                            const int row = a * 128 + wr * 64 + m * 16 + fr;
                            const float r = rs[row];
                            const f32x4 v = ACC_H(a, m, n);
                            *(LAS f32x4*)(st + row * STG + wc * 32 + n * 16 + fq * 4) = f32x4{v[0] * r + bz.x, v[1] * r + bz.y, v[2] * r + bz.z, v[3] * r + bz.w};
                        }
                }
            } else {
#pragma unroll
                for (int a = 0; a < 2; ++a)
#pragma unroll
                    for (int m = 0; m < 4; ++m)
#pragma unroll
                        for (int n = 0; n < 2; ++n)
                            *(LAS f32x4*)(st + (a * 128 + wr * 64 + m * 16 + fr) * STG + wc * 32 + n * 16 + fq * 4) = ACC_H(a, m, n);
            }
            __syncthreads();
            const bool tprompt = brow < NPT;
            const int tb_ = tprompt ? (brow >> 8) : ((brow - NPT) >> 11), ts0 = tprompt ? 0 : ((brow - NPT) & 2047);
            if (MODE == EPI_INPROJ) {
                const bool vtile = (bcol >= 1024 && bcol < 1280);
                if (!vtile) {
    #pragma unroll 1
                    for (int it = 0; it < 2; ++it) {
                        const int item = it * NT + tid, erow = item >> 2, eseg = item & 3;
                        float v[32];
    #pragma unroll
                        for (int i = 0; i < 8; ++i) {
                            const f32x4 f = *(const LAS f32x4*)(st + erow * STG + eseg * 32 + i * 4);
                            v[i * 4] = f[0]; v[i * 4 + 1] = f[1]; v[i * 4 + 2] = f[2]; v[i * 4 + 3] = f[3];
                        }
                        epi_inproj_xform(p, l, brow + erow, bcol + eseg * 32, v);
    #pragma unroll
                        for (int i = 0; i < 8; ++i) *(LAS f32x4*)(st + erow * STG + eseg * 32 + i * 4) = f32x4{v[i * 4], v[i * 4 + 1], v[i * 4 + 2], v[i * 4 + 3]};
                    }
                    __syncthreads();
    #pragma unroll 1
                    for (int it = 0; it < 8; ++it) {
                        const int item = it * NT + tid, r = item >> 4, c = (item & 15) * 8;
                        const f32x4 f0 = *(const LAS f32x4*)(st + r * STG + c), f1 = *(const LAS f32x4*)(st + r * STG + c + 4);
                        const int t = brow + r, sp = ts0 + r;
                        bf16_t* dst;
                        if (bcol < 512)        dst = (bf16_t*)(p.ws + (bcol < 256 ? OFF_AU : OFF_AV)) + (size_t)t * 256 + (bcol & 255) + c;
                        else if (bcol < 768)   dst = (bf16_t*)(p.ws + OFF_DQ) + (size_t)t * 256 + (bcol - 512) + c;
                        else if (bcol < 1024) { const int cc = bcol - 768 + c, h = cc >> 6;
                                                dst = tprompt ? (bf16_t*)(p.ws + OFF_DKP) + (((size_t)tb_ * 4 + h) * SEQ + sp) * 64 + (cc & 63)
                                                              : (bf16_t*)(p.ws + OFF_DKS) + (((size_t)tb_ * 4 + h) * NKS + sp) * 64 + (cc & 63); }
                        else if (bcol < 1792)  dst = (bf16_t*)(p.ws + OFF_GQ) + (size_t)t * 512 + (bcol - 1280) + c;
                        else                 { const int kv = c >> 6, d0 = c & 63;
                                                const size_t hb = (tprompt ? ((size_t)tb_ * 2 + kv) * SEQ * 64 : ((size_t)tb_ * 2 + kv) * NKS * 64) + (size_t)(sp >> 6) * 4096;
                                                dst = bcol < 1920 ? (bf16_t*)(p.ws + (tprompt ? OFF_GKP : OFF_GKS)) + hb + (d0 >> 3) * 512 + (sp & 63) * 8
                                                                  : (bf16_t*)(p.ws + (tprompt ? OFF_GVTP : OFF_GVTS)) + hb + (d0 >> 5) * 2048 + (sp & 63) * 32 + (d0 & 31); }
                        *reinterpret_cast<u32x4*>(dst) = u32x4{pack_bf2(f0[0], f0[1]), pack_bf2(f0[2], f0[3]), pack_bf2(f1[0], f1[1]), pack_bf2(f1[2], f1[3])};
                    }
                }
                if (tprompt && ((bcol >= 768 && bcol < 1280) || bcol >= 1792)) {
                    float* ob; int rs;
                    if (bcol < 1024)      { ob = p.out + OUT_NDK + (((size_t)tb_ * 2 + l) * SEQ) * 256 + (bcol - 768);  rs = 256; }
                    else if (bcol < 1280) { ob = p.out + OUT_NDV + (((size_t)tb_ * 2 + l) * SEQ) * 256 + (bcol - 1024); rs = 256; }
                    else if (bcol < 1920) { ob = p.out + OUT_NGK + (((size_t)tb_ * 2 + l) * SEQ) * 128;                 rs = 128; }
                    else                  { ob = p.out + OUT_NGV + (((size_t)tb_ * 2 + l) * SEQ) * 128;                 rs = 128; }
    #pragma unroll 1
                    for (int it = 0; it < 16; ++it) {
                        const int item = it * NT + tid, r = item >> 5, c = (item & 31) * 4;
                        *reinterpret_cast<f32x4*>(ob + (size_t)r * rs + c) = *(const LAS f32x4*)(st + r * STG + c);
                    }
                }
                if (vtile) {
    #pragma unroll 1
                    for (int it = 0; it < 2; ++it) {
                        const int item = it * NT + tid, col = item >> 3, run = item & 7;
                        epi_inproj_col(p, brow + run * 32, bcol + col, st + run * 32 * STG + col);
                    }
                }
            } else {
                float4 ga = make_float4(0.f, 0.f, 0.f, 0.f), gb = ga, na = ga, nb = ga, sa = ga, sb = ga;
                float4 xna = ga, xnb = ga; u32x4 xnw = {0u, 0u, 0u, 0u};
                if (MODE == EPI_WOUT) {
                    const int c = (tid & 15) * 8;
                    const float* g1 = (const float*)(p.ws + OFF_MOD) + (size_t)(l * 5 + tok_cv(brow)) * 6144 + 2048 + bcol + c;
                    ga = *reinterpret_cast<const float4*>(g1); gb = *reinterpret_cast<const float4*>(g1 + 4);
                    sa = *reinterpret_cast<const float4*>(g1 + 2048); sb = *reinterpret_cast<const float4*>(g1 + 2048 + 4);
                    const float* gn = p.in[I_N2G] + l * D + bcol + c;
                    na = *reinterpret_cast<const float4*>(gn); nb = *reinterpret_cast<const float4*>(gn + 4);
                    const int t = brow + (tid >> 4);
                    if (l == 0) { const float* xr = x_in_row(p, t) + bcol + c; xna = *reinterpret_cast<const float4*>(xr); xnb = *reinterpret_cast<const float4*>(xr + 4); }
                    else xnw = *reinterpret_cast<const u32x4*>((const bf16_t*)(p.ws + OFF_XC) + (size_t)t * D + bcol + c);
                }
    #pragma unroll 1
                for (int it = 0; it < 8; ++it) {
                    const int item = it * NT + tid, r = item >> 4, c = (item & 15) * 8;
                    const f32x4 f0 = *(const LAS f32x4*)(st + r * STG + c), f1 = *(const LAS f32x4*)(st + r * STG + c + 4);
                    const int t = brow + r;
                    float o[8] = {f0[0], f0[1], f0[2], f0[3], f1[0], f1[1], f1[2], f1[3]};
                    if (MODE == EPI_WOUT) {
                        float x[8];
                        if (l == 0) { x[0] = xna.x; x[1] = xna.y; x[2] = xna.z; x[3] = xna.w; x[4] = xnb.x; x[5] = xnb.y; x[6] = xnb.z; x[7] = xnb.w; }
                        else {
    #pragma unroll
                            for (int k = 0; k < 4; ++k) { x[2 * k] = __uint_as_float(xnw[k] << 16); x[2 * k + 1] = __uint_as_float(xnw[k] & 0xffff0000u); }
                        }
                        {
                            const int tn = brow + (((it < 7 ? it + 1 : it) * NT + tid) >> 4);
                            if (l == 0) { const float* xr = x_in_row(p, tn) + bcol + c; xna = *reinterpret_cast<const float4*>(xr); xnb = *reinterpret_cast<const float4*>(xr + 4); }
                            else xnw = *reinterpret_cast<const u32x4*>((const bf16_t*)(p.ws + OFF_XC) + (size_t)tn * D + bcol + c);
                        }
                        o[0] = x[0] + ga.x * o[0]; o[1] = x[1] + ga.y * o[1]; o[2] = x[2] + ga.z * o[2]; o[3] = x[3] + ga.w * o[3];
                        o[4] = x[4] + gb.x * o[4]; o[5] = x[5] + gb.y * o[5]; o[6] = x[6] + gb.z * o[6]; o[7] = x[7] + gb.w * o[7];
                        float xg[8] = {o[0] * na.x * (1.f + sa.x), o[1] * na.y * (1.f + sa.y), o[2] * na.z * (1.f + sa.z), o[3] * na.w * (1.f + sa.w),
                                       o[4] * nb.x * (1.f + sb.x), o[5] * nb.y * (1.f + sb.y), o[6] * nb.z * (1.f + sb.z), o[7] * nb.w * (1.f + sb.w)};
                        float ss = 0.f, am = 0.f;
    #pragma unroll
                        for (int i = 0; i < 8; ++i) { ss += o[i] * o[i]; am = fmaxf(am, fabsf(xg[i])); }
                        ss = row16_sum(ss); am = row16_max(am);
                        const float sc8 = am > 0.f ? 127.f / am : 1.f;
                        uint2 w8;
                        w8.x = pack4_i8(q8(xg[0] * sc8), q8(xg[1] * sc8), q8(xg[2] * sc8), q8(xg[3] * sc8));
                        w8.y = pack4_i8(q8(xg[4] * sc8), q8(xg[5] * sc8), q8(xg[6] * sc8), q8(xg[7] * sc8));
                        *reinterpret_cast<uint2*>(p.ws + OFF_H8I + (size_t)t * D + bcol + c) = w8;
                        if ((item & 15) == 0) {
                            ((float*)(p.ws + OFF_RSS2))[((size_t)l * NTOK + t) * 8 + (bcol >> 7)] = ss;
                            ((float*)(p.ws + OFF_XGS))[(size_t)t * 8 + (bcol >> 7)] = am > 0.f ? am * (1.f / 127.f) : 1.f;
                        }
                    }
                    bf16_t* dst = (bf16_t*)(p.ws + (MODE == EPI_WOUT ? OFF_XC : OFF_Q)) + (size_t)t * D + bcol + c;
                    *reinterpret_cast<u32x4*>(dst) = u32x4{pack_bf2(o[0], o[1]), pack_bf2(o[2], o[3]), pack_bf2(o[4], o[5]), pack_bf2(o[6], o[7])};
                }
            }
            __syncthreads();
        }
    }
#undef ACC_H
#undef PG8_SA
#undef PG8_SB
#undef PG8_STAGE
#undef PG8_LDA
#undef PG8_LDB
#undef PG8_MMA
#undef PG8_WAIT_V
#undef PG8_WAIT_L
#undef PG8_BAR
#undef PG8_SCHED
}

#define MFMA32(a, b, c) __builtin_amdgcn_mfma_f32_32x32x16_bf16((a), (b), (c), 0, 0, 0)
constexpr int ATT_ROWB = 144;
constexpr int ATT_TILEB = 64 * ATT_ROWB;
constexpr int QW_MIX = 4096;

__device__ __forceinline__ bf16x8 pack8(const f32x16& x, int s) {
    const u32x4 w = {pack_bf2(x[8 * s], x[8 * s + 1]), pack_bf2(x[8 * s + 2], x[8 * s + 3]), pack_bf2(x[8 * s + 4], x[8 * s + 5]), pack_bf2(x[8 * s + 6], x[8 * s + 7])};
    return __builtin_bit_cast(bf16x8, w);
}
__device__ __forceinline__ void softmax_tile(f32x16& s0, f32x16& s1, const float sc, float& m, float& l, float& alpha, const int lane) {
    float mx = fmaxf(s0[0], s1[0]);
#pragma unroll
    for (int i = 1; i < 16; ++i) mx = fmaxf(mx, fmaxf(s0[i], s1[i]));
    mx = fmaxf(mx, shfl_x(mx, lane, 32));
    const float mnew = fmaxf(m, mx * sc);
    alpha = __builtin_amdgcn_exp2f(m - mnew);
    m = mnew;
    float ps = 0.f;
#pragma unroll
    for (int i = 0; i < 16; ++i) { s0[i] = __builtin_amdgcn_exp2f(s0[i] * sc - mnew); s1[i] = __builtin_amdgcn_exp2f(s1[i] * sc - mnew); ps += s0[i] + s1[i]; }
    l = l * alpha + ps;
}
__device__ __forceinline__ void v_frags(const LAS unsigned char* vb, bf16x8 (&vf)[8], int r, int hh) {
#pragma unroll
    for (int u = 0; u < 2; ++u)
#pragma unroll
        for (int sk = 0; sk < 2; ++sk)
#pragma unroll
            for (int mt = 0; mt < 2; ++mt) {
                const LAS unsigned char* a = vb + (32 * mt + r) * ATT_ROWB + (32 * u + 16 * sk + 4 * hh) * 2;
                const s16x4 lo = *(const LAS s16x4*)a, hi = *(const LAS s16x4*)(a + 16);
                vf[(u * 2 + sk) * 2 + mt] = bf16x8{lo[0], lo[1], lo[2], lo[3], hi[0], hi[1], hi[2], hi[3]};
            }
}
__device__ __forceinline__ void pv_tile(const bf16x8 (&vf)[8], const f32x16& p0, const f32x16& p1, f32x16 (&O)[2]) {
#pragma unroll
    for (int u = 0; u < 2; ++u)
#pragma unroll
        for (int sk = 0; sk < 2; ++sk) {
            const bf16x8 pf = pack8(u ? p1 : p0, sk);
#pragma unroll
            for (int mt = 0; mt < 2; ++mt) O[mt] = MFMA32(vf[(u * 2 + sk) * 2 + mt], pf, O[mt]);
        }
}

template <bool DIFF>
__device__ __forceinline__ void attn_item(const Params& p, int l, LAS unsigned char* lds, const int tid,
                                          const bf16_t* __restrict__ Qg, const int qstride,
                                          const bf16_t* __restrict__ Kg, const bf16_t* __restrict__ Vtg, const int nk,
                                          bf16_t* __restrict__ Og, const float lam) {
    const int wave = tid >> 6, lane = tid & 63, r = lane & 31, hh = lane >> 5;
    const int lrow = tid >> 3, lchunk = tid & 7;
    LAS unsigned char* kbuf = lds; LAS unsigned char* vbuf = lds + 2 * ATT_TILEB;
    bf16x8 qf[4];
    const bf16_t* qrow = Qg + (size_t)(wave * 32 + r) * qstride;
#pragma unroll
    for (int ks = 0; ks < 4; ++ks) qf[ks] = *reinterpret_cast<const bf16x8*>(qrow + ks * 16 + hh * 8);
    const float sc = (DIFF ? 0.17677669529663687f : 0.125f) * 1.4426950408889634f;
    f32x16 O0[2], O1[2];
#pragma unroll
    for (int mt = 0; mt < 2; ++mt)
#pragma unroll
        for (int i = 0; i < 16; ++i) { O0[mt][i] = 0.f; O1[mt][i] = 0.f; }
    float m0 = -1e30f, l0 = 0.f, m1 = -1e30f, l1 = 0.f;
    const int ntl = nk / 64;
    u32x4 kr, vr, kn, vn;
    kr = *reinterpret_cast<const u32x4*>(Kg + (size_t)lrow * 64 + lchunk * 8);
    vr = *reinterpret_cast<const u32x4*>(Vtg + (size_t)lrow * nk + lchunk * 8);
    *(LAS u32x4*)(kbuf + lrow * ATT_ROWB + lchunk * 16) = kr;
    *(LAS u32x4*)(vbuf + lrow * ATT_ROWB + lchunk * 16) = vr;
    {
        const int t1 = ntl > 1 ? 1 : 0;
        kr = *reinterpret_cast<const u32x4*>(Kg + (size_t)(t1 * 64 + lrow) * 64 + lchunk * 8);
        vr = *reinterpret_cast<const u32x4*>(Vtg + (size_t)lrow * nk + t1 * 64 + lchunk * 8);
    }
    __syncthreads();
    for (int ti = 0; ti < ntl; ++ti) {
        const int cur = ti & 1;
        {
            const int t2 = ti + 2 < ntl ? ti + 2 : ntl - 1;
            kn = *reinterpret_cast<const u32x4*>(Kg + (size_t)(t2 * 64 + lrow) * 64 + lchunk * 8);
            vn = *reinterpret_cast<const u32x4*>(Vtg + (size_t)lrow * nk + t2 * 64 + lchunk * 8);
        }
        const LAS unsigned char* kb = kbuf + cur * ATT_TILEB; const LAS unsigned char* vb = vbuf + cur * ATT_TILEB;
        bf16x8 ka[2][4];
#pragma unroll
        for (int u = 0; u < 2; ++u)
#pragma unroll
            for (int ks = 0; ks < 4; ++ks) ka[u][ks] = *(const LAS bf16x8*)(kb + (32 * u + r) * ATT_ROWB + (ks * 16 + hh * 8) * 2);
        __builtin_amdgcn_sched_barrier(0);
        bf16x8 vf[8];
        if (!DIFF) {
            f32x16 s0, s1;
#pragma unroll
            for (int i = 0; i < 16; ++i) { s0[i] = 0.f; s1[i] = 0.f; }
#pragma unroll
            for (int ks = 0; ks < 4; ++ks) { s0 = MFMA32(ka[0][ks], qf[ks], s0); s1 = MFMA32(ka[1][ks], qf[ks], s1); }
            v_frags(vb, vf, r, hh);
            __builtin_amdgcn_sched_barrier(0);
            float alpha;
            softmax_tile(s0, s1, sc, m0, l0, alpha, lane);
            if (__builtin_amdgcn_ballot_w64(alpha != 1.f) != 0ull) {
#pragma unroll
                for (int mt = 0; mt < 2; ++mt)
#pragma unroll
                    for (int i = 0; i < 16; ++i) O0[mt][i] *= alpha;
            }
            pv_tile(vf, s0, s1, O0);
        } else {
            f32x16 s0, s1, t0, t1;
#pragma unroll
            for (int i = 0; i < 16; ++i) { s0[i] = 0.f; s1[i] = 0.f; t0[i] = 0.f; t1[i] = 0.f; }
#pragma unroll
            for (int ks = 0; ks < 2; ++ks) {
                s0 = MFMA32(ka[0][ks], qf[ks], s0); s1 = MFMA32(ka[1][ks], qf[ks], s1);
                t0 = MFMA32(ka[0][2 + ks], qf[2 + ks], t0); t1 = MFMA32(ka[1][2 + ks], qf[2 + ks], t1);
            }
            v_frags(vb, vf, r, hh);
            __builtin_amdgcn_sched_barrier(0);
            float alpha;
            softmax_tile(s0, s1, sc, m0, l0, alpha, lane);
            if (__builtin_amdgcn_ballot_w64(alpha != 1.f) != 0ull) {
#pragma unroll
                for (int mt = 0; mt < 2; ++mt)
#pragma unroll
                    for (int i = 0; i < 16; ++i) O0[mt][i] *= alpha;
            }
            pv_tile(vf, s0, s1, O0);
            softmax_tile(t0, t1, sc, m1, l1, alpha, lane);
            if (__builtin_amdgcn_ballot_w64(alpha != 1.f) != 0ull) {
#pragma unroll
                for (int mt = 0; mt < 2; ++mt)
#pragma unroll
                    for (int i = 0; i < 16; ++i) O1[mt][i] *= alpha;
            }
            pv_tile(vf, t0, t1, O1);
        }
        if (ti + 1 < ntl) {
            *(LAS u32x4*)(kbuf + (cur ^ 1) * ATT_TILEB + lrow * ATT_ROWB + lchunk * 16) = kr;
            *(LAS u32x4*)(vbuf + (cur ^ 1) * ATT_TILEB + lrow * ATT_ROWB + lchunk * 16) = vr;
        }
        kr = kn; vr = vn;
        __syncthreads();
    }
    l0 += shfl_x(l0, lane, 32);
    const float inv0 = 1.f / l0;
    LAS unsigned char* ob = lds + wave * 4608;
    if (!DIFF) {
#pragma unroll
        for (int mt = 0; mt < 2; ++mt)
#pragma unroll
            for (int g = 0; g < 4; ++g) {
                u32x2 w;
                w[0] = pack_bf2(O0[mt][4 * g] * inv0, O0[mt][4 * g + 1] * inv0);
                w[1] = pack_bf2(O0[mt][4 * g + 2] * inv0, O0[mt][4 * g + 3] * inv0);
                *(LAS u32x2*)(ob + r * 144 + (32 * mt + 8 * g + 4 * hh) * 2) = w;
            }
    } else {
        l1 += shfl_x(l1, lane, 32);
        const float inv1 = lam / l1;
        float ss = 0.f;
#pragma unroll
        for (int mt = 0; mt < 2; ++mt)
#pragma unroll
            for (int i = 0; i < 16; ++i) { const float o = O0[mt][i] * inv0 - O1[mt][i] * inv1; O0[mt][i] = o; ss += o * o; }
        ss += shfl_x(ss, lane, 32);
        const float rr = rsqrtf(ss * (1.f / 64.f) + EPS) * __builtin_bit_cast(float, __builtin_amdgcn_readfirstlane(__builtin_bit_cast(int, 1.f - lam_init_of(l))));
        const float* sg = p.in[I_SUBLN] + l * 64;
#pragma unroll
        for (int mt = 0; mt < 2; ++mt)
#pragma unroll
            for (int g = 0; g < 4; ++g) {
                const int d0 = 32 * mt + 8 * g + 4 * hh;
                const float4 gg = *reinterpret_cast<const float4*>(sg + d0);
                u32x2 w;
                w[0] = pack_bf2(O0[mt][4 * g] * rr * gg.x, O0[mt][4 * g + 1] * rr * gg.y);
                w[1] = pack_bf2(O0[mt][4 * g + 2] * rr * gg.z, O0[mt][4 * g + 3] * rr * gg.w);
                *(LAS u32x2*)(ob + r * 144 + d0 * 2) = w;
            }
    }
#pragma unroll
    for (int ps = 0; ps < 4; ++ps) {
        const int row = ps * 8 + (lane >> 3), ch = lane & 7;
        *reinterpret_cast<u32x4*>(Og + (size_t)(wave * 32 + row) * D + ch * 8) = *(const LAS u32x4*)(ob + row * 144 + ch * 16);
    }
}

namespace ga {
constexpr float C2 = 0.125f * 1.4426950408889634f;
constexpr int SLOTB = 8192, LDS_K = 0, LDS_V = 3 * SLOTB, LDS_WS = 6 * SLOTB, LDS_OST = LDS_WS + 8 * 256;
typedef __attribute__((address_space(3))) const char* lds_cptr;
typedef short v4i16_t __attribute__((ext_vector_type(4)));
using s16x4 = __attribute__((ext_vector_type(4))) short;
__device__ __forceinline__ int crow(int r, int hi) { return (r & 3) + 8 * (r >> 2) + 4 * hi; }
__device__ __forceinline__ void glds16(const void* g, unsigned lds_base) {
    unsigned sv; asm volatile("s_mov_b32 %0, m0\n\ts_mov_b32 m0, %2\n\ts_nop 0\n\tglobal_load_lds_dwordx4 %1, off\n\ts_mov_b32 m0, %0" : "=&s"(sv) : "v"(g), "s"(lds_base) : "memory"); }
__device__ __forceinline__ void kload2(bf16x8* kf, lds_cptr kp, int d0) { kf[2 * d0] = *(const LAS bf16x8*)(kp + d0 * 2048); kf[2 * d0 + 1] = *(const LAS bf16x8*)(kp + d0 * 2048 + 512); }
__device__ __forceinline__ s16x4 vtr(lds_cptr p) { return __builtin_bit_cast(s16x4, __builtin_amdgcn_ds_read_tr16_b64_v4i16((LAS v4i16_t*)p)); }
#define GA_MX3(a, b, c) __builtin_fmaxf(__builtin_fmaxf((a), (b)), (c))
__device__ __forceinline__ float rowmax(const f32x16& p0, const f32x16& p1) {
    float a = GA_MX3(p0[0], p0[1], p1[0]), b = GA_MX3(p0[2], p0[3], p1[1]); a = GA_MX3(a, p1[2], p1[3]);
#pragma unroll
    for (int r = 4; r < 16; r += 4) { a = GA_MX3(a, p0[r], p0[r + 1]); b = GA_MX3(b, p0[r + 2], p0[r + 3]); a = GA_MX3(a, p1[r], p1[r + 1]); b = GA_MX3(b, p1[r + 2], p1[r + 3]); }
    float m = __builtin_fmaxf(a, b); auto rr = __builtin_amdgcn_permlane32_swap(__float_as_uint(m), __float_as_uint(m), false, false);
    return __builtin_fmaxf(__uint_as_float(rr[0]), __uint_as_float(rr[1])); }
}
#define GA_SBAR() __builtin_amdgcn_sched_barrier(0)
#define GA_PIN(x) asm volatile("" : "+v"(x))
#define GA_WAIT_BAR(N) asm volatile("s_waitcnt vmcnt(" #N ") lgkmcnt(0)\n\ts_barrier" ::: "memory")
#define GA_THR 8
__device__ __forceinline__ void gqa_unit(LAS unsigned char* ldsl, const int tid, const int wid, const bf16_t* __restrict__ Qw0, const int qstride,
                                         const unsigned char* __restrict__ Kimg, const unsigned char* __restrict__ Vimg, const int NT, bf16_t* __restrict__ Og) {
    using namespace ga;
    const int lane = tid & 63, r32 = lane & 31, hi = lane >> 5;
    const bf16_t* Qw = Qw0 + (size_t)(wid * 32) * qstride;
    const unsigned lds0 = (unsigned)(size_t)ldsl; LAS float* wsf = (LAS float*)(ldsl + LDS_WS) + wid * 64;
    const unsigned char* ksrc = Kimg + wid * 1024 + lane * 16;
    const unsigned char* vsrc = Vimg + wid * 1024 + lane * 16;
    const unsigned kdst = lds0 + LDS_K + wid * 1024, vdst = lds0 + LDS_V + wid * 1024;
#define DMA_K(t, slot) glds16(ksrc + (size_t)(t) * SLOTB, (unsigned)__builtin_amdgcn_readfirstlane(kdst + (slot)))
#define DMA_V(t, slot) glds16(vsrc + (size_t)(t) * SLOTB, (unsigned)__builtin_amdgcn_readfirstlane(vdst + (slot)))
    const lds_cptr vp0 = (lds_cptr)ldsl + LDS_V + ((lane >> 4) & 1) * 32 + (lane & 3) * 8 + (4 * hi + ((lane & 15) >> 2)) * 64;
    const lds_cptr kp0 = (lds_cptr)ldsl + LDS_K + hi * 1024 + r32 * 16;
    DMA_K(0, 0); DMA_V(0, 0); DMA_K(1, SLOTB);
    bf16x8 qr[4];
#pragma unroll
    for (int d0 = 0; d0 < 4; ++d0) qr[d0] = *reinterpret_cast<const bf16x8*>(&Qw[(size_t)r32 * qstride + d0 * 16 + hi * 8]);
    float mhat = 0.f, l_reg = 0.f; f32x16 o[2];
#pragma unroll
    for (int i = 0; i < 16; ++i) { o[0][i] = 0.f; o[1][i] = 0.f; }
    f32x16 zero16;
#pragma unroll
    for (int i = 0; i < 16; ++i) zero16[i] = 0.f;
    GA_PIN(zero16);
    bool resc = false;
    f32x16 pA0, pA1, pB0, pB1; bf16x8 kf[8]; s16x4 vlo[8], vhi[8]; u32x4 pw0, pw1, pw2, pw3;
    int sl_prev = 0, sl_cur = 0, sl_next = SLOTB;
#define ROT() do { sl_prev = sl_cur; sl_cur = sl_next; sl_next = (sl_next == 2 * SLOTB) ? 0 : sl_next + SLOTB; } while (0)
#define EX(v) __builtin_amdgcn_exp2f(v)
#define RESC() do { if (resc) { _Pragma("unroll") for (int d_ = 0; d_ < 2; ++d_) _Pragma("unroll") for (int r = 0; r < 16; ++r) o[d_][r] *= wsf[crow(r, hi)]; } } while (0)
    DMA_K(2, 2 * SLOTB);
    GA_WAIT_BAR(3);
    _Pragma("unroll") for (int d0 = 0; d0 < 4; ++d0) kload2(kf, kp0, d0);
    pA0 = MFMA32(kf[0], qr[0], zero16); pA1 = MFMA32(kf[1], qr[0], zero16); pA0 = MFMA32(kf[2], qr[1], pA0); pA1 = MFMA32(kf[3], qr[1], pA1);
    pA0 = MFMA32(kf[4], qr[2], pA0); pA1 = MFMA32(kf[5], qr[2], pA1); pA0 = MFMA32(kf[6], qr[3], pA0); pA1 = MFMA32(kf[7], qr[3], pA1);
    { const float rm = rowmax(pA0, pA1); mhat = rm; const float nmh = -mhat;
#pragma unroll
      for (int r = 0; r < 16; ++r) { pA0[r] = EX(pA0[r] + nmh); pA1[r] = EX(pA1[r] + nmh); }
#pragma unroll
      for (int r = 0; r < 16; ++r) zero16[r] = nmh;
      GA_PIN(zero16); }
    GA_WAIT_BAR(0);
    DMA_K(3, 0); DMA_V(1, SLOTB); ROT();
    _Pragma("unroll") for (int d0 = 0; d0 < 4; ++d0) kload2(kf, kp0 + sl_cur, d0);
    GA_WAIT_BAR(2);
#define PKW(P, i) pack_bf2(P[i], P[i + 1])
#define PAF(k) __builtin_bit_cast(bf16x8, pw##k)
#define VFR(i) (bf16x8){vlo[i][0], vlo[i][1], vlo[i][2], vlo[i][3], vhi[i][0], vhi[i][1], vhi[i][2], vhi[i][3]}
#define VRD(i) do { vlo[i] = vtr(vp_ + (((i) >> 2) * 4096 + ((i) & 3) * 1024)); vhi[i] = vtr(vp_ + (((i) >> 2) * 4096 + ((i) & 3) * 1024 + 512)); } while (0)
#define KRD(G, d0) do { if (G) { kload2(kf, kp0 + sl_next, d0); GA_SBAR(); } } while (0)
#define GAPA(MF, a0, a1, a2, a3, W0, W1, PW) do { MF; sacc += a0; sacc += a1; sacc += a2; sacc += a3; W0; W1; GA_PIN(PW); GA_PIN(sacc); GA_SBAR(); } while (0)
#define GAPB(MF, X, i) do { MF; X[i] = EX(X[i]); X[i + 1] = EX(X[i + 1]); X[i + 2] = EX(X[i + 2]); X[i + 3] = EX(X[i + 3]); GA_PIN(X); GA_SBAR(); } while (0)
#define STEP(C0, C1, P0, P1, t, GK, GV, GL) do { GA_SBAR(); \
    const lds_cptr vp_ = vp0 + sl_prev; \
    VRD(0); GA_SBAR(); float sacc = P0[0] + P0[1]; \
                       GAPA(C0 = MFMA32(kf[0], qr[0], zero16), P0[2], P0[3], P0[4], P0[5],     pw0[0] = PKW(P0, 0),  pw0[1] = PKW(P0, 2),  pw0); \
    VRD(4); GA_SBAR(); GAPA(C1 = MFMA32(kf[1], qr[0], zero16), P0[6], P0[7], P0[8], P0[9],     pw0[2] = PKW(P0, 4),  pw0[3] = PKW(P0, 6),  pw0); \
    VRD(1); GA_SBAR(); GAPA(C0 = MFMA32(kf[2], qr[1], C0),    P0[10], P0[11], P0[12], P0[13], pw1[0] = PKW(P0, 8),  pw1[1] = PKW(P0, 10), pw1); \
    VRD(5); GA_SBAR(); GAPA(C1 = MFMA32(kf[3], qr[1], C1),    P0[14], P0[15], P1[0], P1[1],   pw1[2] = PKW(P0, 12), pw1[3] = PKW(P0, 14), pw1); \
    VRD(2); GA_SBAR(); GAPA(C0 = MFMA32(kf[4], qr[2], C0),    P1[2], P1[3], P1[4], P1[5],     pw2[0] = PKW(P1, 0),  pw2[1] = PKW(P1, 2),  pw2); \
    VRD(6); GA_SBAR(); GAPA(C1 = MFMA32(kf[5], qr[2], C1),    P1[6], P1[7], P1[8], P1[9],     pw2[2] = PKW(P1, 4),  pw2[3] = PKW(P1, 6),  pw2); \
    VRD(3); GA_SBAR(); GAPA(C0 = MFMA32(kf[6], qr[3], C0),    P1[10], P1[11], P1[12], P1[13], pw3[0] = PKW(P1, 8),  pw3[1] = PKW(P1, 10), pw3); \
    VRD(7); GA_SBAR(); GAPA(C1 = MFMA32(kf[7], qr[3], C1),    P1[14], P1[15], 0.f, 0.f,       pw3[2] = PKW(P1, 12), pw3[3] = PKW(P1, 14), pw3); \
    l_reg += sacc; \
    if (GK) DMA_K((t) + 3, sl_cur); if (GV) DMA_V((t) + 1, sl_next); \
    { const float rm = rowmax(C0, C1); resc = false;                                             \
      if (__builtin_expect(__any(rm > (float)GA_THR), 0)) { const float dl = __builtin_fmaxf(rm, 0.f); mhat += dl; \
          const float f = __builtin_amdgcn_exp2f(-dl); l_reg *= f; if (hi == 0) wsf[r32] = f; resc = true; \
          _Pragma("unroll") for (int r_ = 0; r_ < 16; ++r_) { C0[r_] -= dl; C1[r_] -= dl; zero16[r_] = -mhat; } GA_PIN(zero16); } } \
    GA_SBAR(); \
    GAPB(o[0] = MFMA32(PAF(0), VFR(0), o[0]), C0, 0);              GAPB(o[1] = MFMA32(PAF(0), VFR(4), o[1]), C0, 4); \
    KRD(GL, 0); GAPB(o[0] = MFMA32(PAF(1), VFR(1), o[0]), C0, 8);  KRD(GL, 1); GAPB(o[1] = MFMA32(PAF(1), VFR(5), o[1]), C0, 12); \
    KRD(GL, 2); GAPB(o[0] = MFMA32(PAF(2), VFR(2), o[0]), C1, 0);  KRD(GL, 3); GAPB(o[1] = MFMA32(PAF(2), VFR(6), o[1]), C1, 4); \
    GAPB(o[0] = MFMA32(PAF(3), VFR(3), o[0]), C1, 8);              GAPB(o[1] = MFMA32(PAF(3), VFR(7), o[1]), C1, 12); \
    } while (0)
    int t = 1;
    for (; t + 5 < NT; t += 2) {
        STEP(pB0, pB1, pA0, pA1, t, true, true, true);     GA_WAIT_BAR(2); RESC(); ROT();
        STEP(pA0, pA1, pB0, pB1, t + 1, true, true, true); GA_WAIT_BAR(2); RESC(); ROT();
    }
#define ENDW(tt) do { if ((tt) + 3 < NT) { GA_WAIT_BAR(2); } else if ((tt) + 2 < NT) { GA_WAIT_BAR(1); } else { GA_WAIT_BAR(0); } } while (0)
    for (; t + 1 < NT; t += 2) {
        STEP(pB0, pB1, pA0, pA1, t, (t + 3 < NT), (t + 1 < NT), (t + 1 < NT));         ENDW(t);     RESC(); ROT();
        STEP(pA0, pA1, pB0, pB1, t + 1, (t + 4 < NT), (t + 2 < NT), (t + 2 < NT));     ENDW(t + 1); RESC(); ROT();
    }
    STEP(pB0, pB1, pA0, pA1, NT - 1, false, false, false); RESC();
    { float sacc = pB0[0] + pB0[1];
#pragma unroll
      for (int r = 2; r < 16; ++r) sacc += pB0[r];
#pragma unroll
      for (int r = 0; r < 16; ++r) sacc += pB1[r];
      l_reg += sacc;
      pw0 = (u32x4){PKW(pB0, 0), PKW(pB0, 2), PKW(pB0, 4), PKW(pB0, 6)}; pw1 = (u32x4){PKW(pB0, 8), PKW(pB0, 10), PKW(pB0, 12), PKW(pB0, 14)};
      pw2 = (u32x4){PKW(pB1, 0), PKW(pB1, 2), PKW(pB1, 4), PKW(pB1, 6)}; pw3 = (u32x4){PKW(pB1, 8), PKW(pB1, 10), PKW(pB1, 12), PKW(pB1, 14)};
      const lds_cptr vp_ = vp0 + sl_cur; _Pragma("unroll") for (int i = 0; i < 8; ++i) VRD(i);
      o[0] = MFMA32(PAF(0), VFR(0), o[0]); o[1] = MFMA32(PAF(0), VFR(4), o[1]); o[0] = MFMA32(PAF(1), VFR(1), o[0]); o[1] = MFMA32(PAF(1), VFR(5), o[1]);
      o[0] = MFMA32(PAF(2), VFR(2), o[0]); o[1] = MFMA32(PAF(2), VFR(6), o[1]); o[0] = MFMA32(PAF(3), VFR(3), o[0]); o[1] = MFMA32(PAF(3), VFR(7), o[1]); }
    { auto rr = __builtin_amdgcn_permlane32_swap(__float_as_uint(l_reg), __float_as_uint(l_reg), false, false); l_reg = __uint_as_float(rr[0]) + __uint_as_float(rr[1]); }
    if (hi == 0) wsf[32 + r32] = l_reg;
    asm volatile("s_waitcnt lgkmcnt(0)" ::: "memory");
    float rli[16];
#pragma unroll
    for (int r = 0; r < 16; ++r) rli[r] = __builtin_amdgcn_rcpf(wsf[32 + crow(r, hi)]);
    bf16_t* Ow = Og + (size_t)(wid * 32) * D; LAS bf16_t* stg = (LAS bf16_t*)(ldsl + LDS_OST) + wid * 2048;
#pragma unroll
    for (int r = 0; r < 16; ++r) { const int orow = crow(r, hi);
#pragma unroll
        for (int d0 = 0; d0 < 2; ++d0) stg[orow * 64 + d0 * 32 + r32] = f2bf(o[d0][r] * rli[r]); }
    asm volatile("s_waitcnt lgkmcnt(0)" ::: "memory");
#pragma unroll
    for (int i = 0; i < 4; ++i) { const int row = i * 8 + (lane >> 3), ch = lane & 7; *reinterpret_cast<u32x4*>(Ow + (size_t)row * D + ch * 8) = *(const LAS u32x4*)(stg + row * 64 + ch * 8); }
    asm volatile("s_waitcnt lgkmcnt(0)\n\ts_barrier" ::: "memory");
#undef DMA_K
#undef DMA_V
#undef ROT
#undef EX
#undef RESC
#undef PKW
#undef PAF
#undef VFR
#undef VRD
#undef KRD
#undef ENDW
#undef GAPA
#undef GAPB
#undef STEP
}

constexpr int SGU_ROWB = 272;
__device__ __forceinline__ void sgu_item(const Params& p, int l, LAS unsigned char* lds, const int tid, const int t0) {
    const bf16_t* AV = (const bf16_t*)(p.ws + OFF_AV) + (size_t)t0 * 256;
    {
        const int q = tid >> 2, quarter = tid & 3;
        float v[64]; float ss = 0.f;
#pragma unroll
        for (int i = 0; i < 8; ++i) {
            const bf16x8 w = *reinterpret_cast<const bf16x8*>(AV + (size_t)q * 256 + quarter * 64 + i * 8);
#pragma unroll
            for (int j = 0; j < 8; ++j) { v[i * 8 + j] = bf2f((bf16_t)w[j]); ss += v[i * 8 + j] * v[i * 8 + j]; }
        }
        { const int ln = tid & 63; ss += shfl_x(ss, ln, 1); ss += shfl_x(ss, ln, 2); }
        const float rstd = rsqrtf(ss * (1.f / 256.f) + EPS);
        const float* g = p.in[I_SGUNG] + l * 256 + quarter * 64;
#pragma unroll
        for (int i = 0; i < 64; ++i)
            *(LAS bf16_t*)(lds + (quarter * 64 + i) * SGU_ROWB + q * 2) = f2bf(v[i] * rstd * g[i]);
    }
    __syncthreads();
    {
        const int wave = tid >> 6, lane = tid & 63, r = lane & 31, hh = lane >> 5;
        const int g = wave >> 1, ph = wave & 1;
        const bf16_t* W = (const bf16_t*)(p.ws + OFF_SGUW) + ((size_t)l * 4 + g) * 128 * 128;
        f32x16 acc[2][2];
#pragma unroll
        for (int a = 0; a < 2; ++a)
#pragma unroll
            for (int b = 0; b < 2; ++b)
#pragma unroll
                for (int i = 0; i < 16; ++i) acc[a][b][i] = 0.f;
#pragma unroll
        for (int ks = 0; ks < 8; ++ks) {
            bf16x8 af[2], bfr[2];
#pragma unroll
            for (int pt = 0; pt < 2; ++pt) af[pt] = *reinterpret_cast<const bf16x8*>(W + (size_t)(ph * 64 + pt * 32 + r) * 128 + ks * 16 + hh * 8);
#pragma unroll
            for (int ct = 0; ct < 2; ++ct) bfr[ct] = *(const LAS bf16x8*)(lds + (g * 64 + ct * 32 + r) * SGU_ROWB + (ks * 16 + hh * 8) * 2);
#pragma unroll
            for (int pt = 0; pt < 2; ++pt)
#pragma unroll
                for (int ct = 0; ct < 2; ++ct) acc[pt][ct] = MFMA32(af[pt], bfr[ct], acc[pt][ct]);
        }
        const float* bias = p.in[I_SGUB] + (l * 4 + g) * 128;
        const bf16_t* AU = (const bf16_t*)(p.ws + OFF_AU);
        bf16_t* MIX = (bf16_t*)(p.ws + OFF_MIX);
#pragma unroll
        for (int pt = 0; pt < 2; ++pt)
#pragma unroll
            for (int ct = 0; ct < 2; ++ct)
#pragma unroll
                for (int i = 0; i < 16; ++i) {
                    const int pp = ph * 64 + pt * 32 + (i & 3) + 8 * (i >> 2) + 4 * hh, c = g * 64 + ct * 32 + r;
                    const float au = bf2f(AU[(size_t)(t0 + pp) * 256 + c]);
                    MIX[(size_t)(t0 + pp) * D + c] = f2bf(au * (acc[pt][ct][i] + bias[pp]));
                }
    }
    __syncthreads();
}

__device__ __forceinline__ void conv_item(const Params& p, const int c, LAS unsigned char* lds, const int tid) {
    const int wave = tid >> 6, lane = tid & 63;
    const bool isu = c < 256;
    const int row00 = (c & 255) * 128, lyr = row00 >> 14;
    const float* src = p.in[isu ? I_PU : I_PV] + (size_t)(row00 + wave * 16) * D + lane * 16;
    unsigned char* dst = p.ws + (isu ? OFF_UT : OFF_VT);
    float* scl = (float*)(p.ws + OFF_USH) + (isu ? 0 : 1);
    float4 f[4][4], g[4][4];
#pragma unroll
    for (int q = 0; q < 4; ++q)
#pragma unroll
        for (int i = 0; i < 4; ++i) f[q][i] = *reinterpret_cast<const float4*>(src + (size_t)q * D + i * 4);
#pragma unroll
    for (int step = 0; step < 4; ++step) {
        if (step < 3) {
#pragma unroll
            for (int q = 0; q < 4; ++q)
#pragma unroll
                for (int i = 0; i < 4; ++i) g[q][i] = *reinterpret_cast<const float4*>(src + (size_t)((step + 1) * 4 + q) * D + i * 4);
        }
        const int row0 = row00 + wave * 16 + step * 4;
#pragma unroll
        for (int q = 0; q < 4; ++q) {
            const int row = row0 + q, e = row & (NEXP - 1);
            float v[16];
#pragma unroll
            for (int i = 0; i < 4; ++i) { v[i * 4] = f[q][i].x; v[i * 4 + 1] = f[q][i].y; v[i * 4 + 2] = f[q][i].z; v[i * 4 + 3] = f[q][i].w; }
            float am = 0.f;
#pragma unroll
            for (int i = 0; i < 16; ++i) am = fmaxf(am, fabsf(v[i]));
            am = wave_max(am);
            const float sc = am > 0.f ? 127.f / am : 1.f;
            unsigned w[4];
#pragma unroll
            for (int i = 0; i < 4; ++i) w[i] = pack4_i8(q8(v[i * 4] * sc), q8(v[i * 4 + 1] * sc), q8(v[i * 4 + 2] * sc), q8(v[i * 4 + 3] * sc));
            *reinterpret_cast<u32x4*>(dst + (((size_t)lyr * 8 + (lane >> 3)) * NEXP + e) * 128 + (lane & 7) * 16) = u32x4{w[0], w[1], w[2], w[3]};
            if (lane == 0) scl[(size_t)row * 8] = am > 0.f ? am * (1.f / 127.f) : 1.f;
        }
        if (step < 3) {
#pragma unroll
            for (int q = 0; q < 4; ++q)
#pragma unroll
                for (int i = 0; i < 4; ++i) f[q][i] = g[q][i];
        }
    }
}

__device__ void ph_mixers(const Params& p, int lq, unsigned char* ldsraw, const int wv) {
    asm volatile("" : "+s"(lq));
    const int l = lq & 1;
    const int tid0 = opaque_tid(wv);
    LAS unsigned char* lds = (LAS unsigned char*)ldsraw;
    volatile LAS int* qslot = (volatile LAS int*)(ldsraw - LDS_HDR + 64);
    unsigned* qw = (unsigned*)(p.ws + OFF_BAR) + QW_MIX + lq;
    const float lam = __builtin_bit_cast(float, __builtin_amdgcn_readfirstlane(__builtin_bit_cast(int, lam_of(p, l))));
    unsigned char* ws = p.ws;
    for (;;) {
        if (tid0 == 0) *qslot = (int)atomicAdd(qw, 1u);
        __syncthreads();
        int item = *qslot;
        __syncthreads();
        if (lq == 0) {
            if (item >= 1536) break;
            const int grp = item / 3, pos = item - grp * 3;
            if (pos == 2) { int tidc = tid0; asm volatile("" : "+v"(tidc)); conv_item(p, grp, lds, tidc); continue; }
            item = grp * 2 + pos;
            if (item >= 896) continue;
        }
        if (item >= 896) break;
        if (lq >= 2 && PROBE_DUP >= 10) {
            const int cls = item < 128 ? 10 : (item < 384 ? 11 : 12);
            if (cls != PROBE_DUP) continue;
        }
        int tid = tid0; asm volatile("" : "+v"(tid));
        if (item < 128) {
            const int qc = item & 7, h = (item >> 3) & 3, b = item >> 5;
            const int t0 = NPT + b * DSEQ + qc * 256;
            attn_item<true>(p, l, lds, tid, (const bf16_t*)(ws + OFF_DQ) + (size_t)t0 * 256 + h * 64, 256,
                            (const bf16_t*)(ws + OFF_DKS) + ((size_t)b * 4 + h) * NKS * 64, (const bf16_t*)(ws + OFF_DVTS) + ((size_t)b * 4 + h) * 64 * NKS, NKS,
                            (bf16_t*)(ws + OFF_MIX) + (size_t)t0 * D + 256 + h * 64, lam);
        } else if (item < 384) {
            const int it = item - 128, qc = it & 7, hq = (it >> 3) & 7, b = it >> 6, kv = hq >> 2;
            const int t0 = NPT + b * DSEQ + qc * 256;
            gqa_unit(lds, tid, wv, (const bf16_t*)(ws + OFF_GQ) + (size_t)t0 * 512 + hq * 64, 512,
                     ws + OFF_GKS + ((size_t)b * 2 + kv) * NKS * 128, ws + OFF_GVTS + ((size_t)b * 2 + kv) * NKS * 128, NKS / 64,
                     (bf16_t*)(ws + OFF_MIX) + (size_t)t0 * D + 512 + hq * 64);
        } else if (item < 512) {
            sgu_item(p, l, lds, tid, (item - 384) * 128);
        } else if (item < 768) {
            const int it = item - 512, hq = it & 7, b = it >> 3, kv = hq >> 2;
            const int t0 = b * SEQ;
            gqa_unit(lds, tid, wv, (const bf16_t*)(ws + OFF_GQ) + (size_t)t0 * 512 + hq * 64, 512,
                     ws + OFF_GKP + ((size_t)b * 2 + kv) * SEQ * 128, ws + OFF_GVTP + ((size_t)b * 2 + kv) * SEQ * 128, SEQ / 64,
                     (bf16_t*)(ws + OFF_MIX) + (size_t)t0 * D + 512 + hq * 64);
        } else {
            const int it = item - 768, h = it & 3, b = it >> 2;
            const int t0 = b * SEQ;
            attn_item<true>(p, l, lds, tid, (const bf16_t*)(ws + OFF_DQ) + (size_t)t0 * 256 + h * 64, 256,
                            (const bf16_t*)(ws + OFF_DKP) + ((size_t)b * 4 + h) * SEQ * 64, (const bf16_t*)(ws + OFF_DVTP) + ((size_t)b * 4 + h) * 64 * SEQ, SEQ,
                            (bf16_t*)(ws + OFF_MIX) + (size_t)t0 * D + 256 + h * 64, lam);
        }
    }
}


using bf16x2 = __attribute__((ext_vector_type(2))) __bf16;
__device__ __forceinline__ float dot2bf(unsigned a, unsigned b, float c) {
    return __builtin_amdgcn_fdot2_f32_bf16(__builtin_bit_cast(bf16x2, a), __builtin_bit_cast(bf16x2, b), c, false);
}
template <int W>
__device__ __forceinline__ void bfly_stage(float (&part)[64], const int lane) {
    const bool hi = (lane & W) != 0;
#pragma unroll
    for (int k = 0; k < W; ++k) {
        const float keep = hi ? part[k + W] : part[k];
        const float send = hi ? part[k] : part[k + W];
        part[k] = keep + shfl_x(send, lane, W);
    }
}
constexpr int QW_PEER = 4160;
template <int W>
__device__ __forceinline__ void bfly16_stage(float (&v)[16], const int lane, const int bit) {
    const bool hi = (lane & bit) != 0;
#pragma unroll
    for (int k = 0; k < W; ++k) {
        const float keep = hi ? v[k + W] : v[k];
        const float send = hi ? v[k] : v[k + W];
        v[k] = keep + shfl_x(send, lane, bit);
    }
}
template <int W>
__device__ __forceinline__ void bfly16i_stage(int (&v)[16], const int lane, const int bit) {
    const bool hi = (lane & bit) != 0;
#pragma unroll
    for (int k = 0; k < W; ++k) {
        const int keep = hi ? v[k + W] : v[k];
        const int send = hi ? v[k] : v[k + W];
        v[k] = keep + shfl_x(send, lane, bit);
    }
}
template <bool VSIDE> struct PeerTok {
    static __device__ __forceinline__ void issue(const Params& p, const unsigned char* Tslice, const int elo, const int ehi, const int t, const int s,
                                                 const int sub, const int c16, u32x4 (&a)[16], u32x4 (&h)[2]) {
#pragma unroll
        for (int i = 0; i < 16; ++i) {
            const int e = shfl_i(i < 8 ? elo : ehi, (i * 8 + sub) & 63);
            a[i] = *reinterpret_cast<const u32x4*>(Tslice + (((unsigned)e << 7) + (unsigned)c16 * 16u));
        }
        if (!VSIDE) h[0] = *reinterpret_cast<const u32x4*>(p.ws + OFF_H8I + (size_t)t * D + s * 128 + c16 * 16);
    }
    static __device__ __forceinline__ void compute(const Params& p, const int l, const u32x4 w4, const float wsc, const int t, const int s,
                                                   const int lane, const int sub, const int c16, const u32x4 (&a)[16], const u32x4 (&h)[2]) {
        if (!VSIDE) {
            int d[16];
#pragma unroll
            for (int i = 0; i < 16; ++i) {
                int acc = 0;
#pragma unroll
                for (int k = 0; k < 4; ++k) acc = __builtin_amdgcn_sdot4((int)a[i][k], (int)h[0][k], acc, false);
                d[i] = acc;
            }
            bfly16i_stage<8>(d, lane, 4); bfly16i_stage<4>(d, lane, 2); bfly16i_stage<2>(d, lane, 1);
            const int i0 = ((lane & 4) << 1) + ((lane & 2) << 1) + ((lane & 1) << 1);
            unsigned* PART = (unsigned*)(p.ws + OFF_PART) + (((size_t)s * NTOK + t) * 128 + sub * 16 + i0) / 2;
            *PART = ((unsigned)((d[0] + 32) >> 6) & 0xffffu) | ((unsigned)((d[1] + 32) >> 6) << 16);
        } else {
            int acc[16];
#pragma unroll
            for (int i = 0; i < 16; ++i) acc[i] = 0;
#pragma unroll
            for (int g = 0; g < 4; ++g) {
                const int wg = (int)w4[g];
#pragma unroll
                for (int k = 0; k < 4; ++k) {
                    const unsigned r0 = a[4 * g][k], r1 = a[4 * g + 1][k], r2 = a[4 * g + 2][k], r3 = a[4 * g + 3][k];
                    const unsigned x01l = __builtin_amdgcn_perm(r1, r0, 0x05010400u), x01h = __builtin_amdgcn_perm(r1, r0, 0x07030602u);
                    const unsigned x23l = __builtin_amdgcn_perm(r3, r2, 0x05010400u), x23h = __builtin_amdgcn_perm(r3, r2, 0x07030602u);
                    const unsigned t0 = __builtin_amdgcn_perm(x23l, x01l, 0x05040100u), t1 = __builtin_amdgcn_perm(x23l, x01l, 0x07060302u);
                    const unsigned t2 = __builtin_amdgcn_perm(x23h, x01h, 0x05040100u), t3 = __builtin_amdgcn_perm(x23h, x01h, 0x07060302u);
                    acc[4 * k]     = __builtin_amdgcn_sdot4((int)t0, wg, acc[4 * k], false);
                    acc[4 * k + 1] = __builtin_amdgcn_sdot4((int)t1, wg, acc[4 * k + 1], false);
                    acc[4 * k + 2] = __builtin_amdgcn_sdot4((int)t2, wg, acc[4 * k + 2], false);
                    acc[4 * k + 3] = __builtin_amdgcn_sdot4((int)t3, wg, acc[4 * k + 3], false);
                }
            }
            bfly16i_stage<8>(acc, lane, 32); bfly16i_stage<4>(acc, lane, 16); bfly16i_stage<2>(acc, lane, 8);
            const int col = s * 128 + c16 * 16 + ((lane & 32) >> 2) + ((lane & 16) >> 2) + ((lane & 8) >> 2);
            const float* g2 = (const float*)(p.ws + OFF_MOD) + (size_t)(l * 5 + tok_cv(t)) * 6144 + 5 * 1024 + col;
            unsigned* XC = reinterpret_cast<unsigned*>((bf16_t*)(p.ws + OFF_XC) + (size_t)t * D + col);
            const unsigned x = *XC; const float2 g = *reinterpret_cast<const float2*>(g2);
            const float xa = __uint_as_float(x << 16) + g.x * wsc * (float)acc[0], xb = __uint_as_float(x & 0xffff0000u) + g.y * wsc * (float)acc[1];
            *XC = pack_bf2(xa, xb);
            if (l == 0) {
                const float ss = wave_sum(xa * xa + xb * xb);
                if (lane == 0) ((float*)(p.ws + OFF_RSS1))[(size_t)t * 8 + s] = ss;
            }
        }
    }
};
template <bool VSIDE>
__device__ __forceinline__ void peer_slice_stream(const Params& p, const int l, const int s, const int first, const int stride, const int lane) {
    const int sub = lane >> 3, c16 = lane & 7;
    const unsigned char* Ts = p.ws + (VSIDE ? OFF_VT : OFF_UT) + ((size_t)l * 8 + s) * NEXP * 128;
    const int* EIb = (const int*)(p.ws + OFF_EIDX); const unsigned char* WPb = p.ws + OFF_WPAIR; const float* WSb = (const float*)(p.ws + OFF_WSC);
    if (first >= NTOK) return;
    const int cnt = (NTOK - first + stride - 1) / stride;
#define PEER_LOADE(k, elo, ehi, w4, wsc) do { const int _t = min(first + (k) * stride, NTOK - 1); \
        elo = EIb[(size_t)_t * 128 + lane]; ehi = EIb[(size_t)_t * 128 + 64 + lane]; \
        if (VSIDE) { w4 = *reinterpret_cast<const u32x4*>(WPb + (size_t)_t * 128 + sub * 16); wsc = WSb[_t]; } } while (0)
    int e0l, e0h, e1l, e1h, e2l, e2h;
    u32x4 w0 = {0u, 0u, 0u, 0u}, w1 = {0u, 0u, 0u, 0u}, w2 = {0u, 0u, 0u, 0u}; float s0 = 0.f, s1 = 0.f, s2 = 0.f;
    u32x4 A[16], B[16], hA[2], hB[2];
    PEER_LOADE(0, e0l, e0h, w0, s0);
    PEER_LOADE(1, e1l, e1h, w1, s1);
    PeerTok<VSIDE>::issue(p, Ts, e0l, e0h, first, s, sub, c16, A, hA);
    for (int k = 0; k < cnt; k += 2) {
        const int ta = first + k * stride, tb = min(ta + stride, NTOK - 1), tc = min(ta + 2 * stride, NTOK - 1);
        __builtin_amdgcn_sched_barrier(0);
        PEER_LOADE(k + 2, e2l, e2h, w2, s2);
        PeerTok<VSIDE>::issue(p, Ts, e1l, e1h, tb, s, sub, c16, B, hB);
        __builtin_amdgcn_sched_barrier(0);
        PeerTok<VSIDE>::compute(p, l, w0, s0, ta, s, lane, sub, c16, A, hA);
        __builtin_amdgcn_sched_barrier(0);
        e0l = e2l; e0h = e2h; w0 = w2; s0 = s2;
        PEER_LOADE(k + 3, e2l, e2h, w2, s2);
        PeerTok<VSIDE>::issue(p, Ts, e0l, e0h, tc, s, sub, c16, A, hA);
        __builtin_amdgcn_sched_barrier(0);
        if (k + 1 < cnt) PeerTok<VSIDE>::compute(p, l, w1, s1, tb, s, lane, sub, c16, B, hB);
        e1l = e2l; e1h = e2h; w1 = w2; s1 = s2;
    }
#undef PEER_LOADE
}
template <bool VSIDE>
__device__ void ph_peer_sliced(const Params& p, int l, unsigned char* ldsraw, const int wv) {
    asm volatile("" : "+s"(l));
    const int tid = opaque_tid(wv);
    const int wave = tid >> 6, lane = tid & 63;
    volatile LAS int* hdr = (volatile LAS int*)(ldsraw - LDS_HDR);
    unsigned* bar = (unsigned*)(p.ws + OFF_BAR);
    const int myx = (int)(xb_xcc_id() & 15u);
    if (tid == 0) hdr[16] = (int)atomicAdd(bar + QW_PEER + (l * 2 + (VSIDE ? 1 : 0)) * 16 + myx, 1u);
    __syncthreads();
    const int rank = hdr[16], nloc = (int)hdr[0];
    __syncthreads();
    if (myx < 8) peer_slice_stream<VSIDE>(p, l, myx, rank * 8 + wave, nloc * 8, lane);
    for (int j = 0; j < 8; ++j) {
        if (xb_ld(&bar[XB_XCNT(j)]) == 0u) peer_slice_stream<VSIDE>(p, l, j, (int)blockIdx.x * 8 + wave, (int)gridDim.x * 8, lane);
    }
}
__device__ void ph_peer_pairw(const Params& p, int l, const int wv) {
    asm volatile("" : "+s"(l));
    const int tid = opaque_tid(wv);
    const int lane = tid & 63;
    const float* EREC = (const float*)(p.ws + OFF_USH) + (size_t)l * NEXP * 8;
    const unsigned short* PART = (const unsigned short*)(p.ws + OFF_PART);
    constexpr size_t NIT = (size_t)NTOK * 32;
    for (size_t i4 = GTID; i4 < NIT; i4 += 2 * GNT) {
        size_t idx[2]; int t[2], e[2][4]; float g[2][4]; uint2 ps[2][8]; float4 ra[2], rb[2], xa[2], xb[2];
#pragma unroll
        for (int u = 0; u < 2; ++u) {
            const size_t iu = i4 + (size_t)u * GNT < NIT ? i4 + (size_t)u * GNT : i4;
            idx[u] = iu * 4; t[u] = (int)(idx[u] >> 7);
            const int pp = (int)(idx[u] & 127), sub = pp >> 4, i = pp & 15;
#pragma unroll
            for (int s = 0; s < 8; ++s) ps[u][s] = *reinterpret_cast<const uint2*>(PART + (size_t)s * NTOK * 128 + idx[u]);
#pragma unroll
            for (int q = 0; q < 4; ++q) {
                const int j = (i + q) * 8 + sub;
                e[u][q] = ((const int*)(p.ws + OFF_EIDX))[(size_t)t[u] * 128 + j]; g[u][q] = ((const float*)(p.ws + OFF_EGATE))[(size_t)t[u] * 128 + j];
            }
            const float* rp = (const float*)(p.ws + OFF_RSS2) + ((size_t)l * NTOK + t[u]) * 8;
            ra[u] = *reinterpret_cast<const float4*>(rp); rb[u] = *reinterpret_cast<const float4*>(rp + 4);
            const float* xp = (const float*)(p.ws + OFF_XGS) + (size_t)t[u] * 8;
            xa[u] = *reinterpret_cast<const float4*>(xp); xb[u] = *reinterpret_cast<const float4*>(xp + 4);
        }
        float4 r0[2][4], r1[2][4];
#pragma unroll
        for (int u = 0; u < 2; ++u)
#pragma unroll
            for (int q = 0; q < 4; ++q) {
                const float* rec = EREC + (size_t)e[u][q] * 8;
                r0[u][q] = *reinterpret_cast<const float4*>(rec); r1[u][q] = *reinterpret_cast<const float4*>(rec + 4);
            }
#pragma unroll
        for (int u = 0; u < 2; ++u) {
            const float hs = rsqrtf((((ra[u].x + ra[u].y) + (ra[u].z + ra[u].w)) + ((rb[u].x + rb[u].y) + (rb[u].z + rb[u].w))) * (1.f / D) + EPS);
            const float xs[8] = {xa[u].x, xa[u].y, xa[u].z, xa[u].w, xb[u].x, xb[u].y, xb[u].z, xb[u].w};
            float sm[4] = {0.f, 0.f, 0.f, 0.f};
#pragma unroll
            for (int s = 0; s < 8; ++s) {
                const uint2 w = ps[u][s];
                sm[0] += xs[s] * (float)((int)(w.x << 16) >> 16); sm[1] += xs[s] * (float)((int)w.x >> 16);
                sm[2] += xs[s] * (float)((int)(w.y << 16) >> 16); sm[3] += xs[s] * (float)((int)w.y >> 16);
            }
            const int cvt = tok_cv(t[u]);
            float w[4];
#pragma unroll
            for (int q = 0; q < 4; ++q) {
                const float4 ra4 = r0[u][q], rb4 = r1[u][q];
                const float ush = cvt == 0 ? ra4.z : (cvt == 1 ? ra4.w : (cvt == 2 ? rb4.x : (cvt == 3 ? rb4.y : rb4.z)));
                w[q] = g[u][q] * gelu_f(sm[q] * 64.f * (ra4.x * hs) + ush) * ra4.y;
            }
            float am = fmaxf(fmaxf(fabsf(w[0]), fabsf(w[1])), fmaxf(fabsf(w[2]), fabsf(w[3])));
            am = row16_max(am); am = fmaxf(am, shfl_x(am, lane, 16));
            const float sc = am > 0.f ? 127.f / am : 1.f;
            *reinterpret_cast<unsigned*>(p.ws + OFF_WPAIR + idx[u]) = pack4_i8(q8(w[0] * sc), q8(w[1] * sc), q8(w[2] * sc), q8(w[3] * sc));
            if ((idx[u] & 127) == 0) ((float*)(p.ws + OFF_WSC))[t[u]] = am > 0.f ? am * (1.f / 127.f) : 1.f;
        }
    }
}

#define CE_DESC(a, b) do { const float _mx = fmaxf((a), (b)); const float _mn = fminf((a), (b)); (a) = _mx; (b) = _mn; } while (0)
__device__ __forceinline__ void sort16_desc(float (&v)[16]) {
#pragma unroll
    for (int k = 2; k <= 16; k <<= 1)
#pragma unroll
        for (int j = k >> 1; j > 0; j >>= 1)
#pragma unroll
            for (int i = 0; i < 16; ++i) {
                const int m = i ^ j;
                if (m > i) { if ((i & k) == 0) CE_DESC(v[i], v[m]); else CE_DESC(v[m], v[i]); }
            }
}
__device__ __forceinline__ void merge_top16(float (&a)[16], const float (&b)[16]) {
#pragma unroll
    for (int i = 0; i < 16; ++i) a[i] = fmaxf(a[i], b[15 - i]);
#pragma unroll
    for (int j = 8; j > 0; j >>= 1)
#pragma unroll
        for (int i = 0; i < 16; ++i) { const int m = i ^ j; if (m > i) CE_DESC(a[i], a[m]); }
}
__device__ __forceinline__ float key_embed(float v, unsigned lowmask, unsigned idxbits) { return __uint_as_float((__float_as_uint(v) & ~lowmask) | idxbits); }

constexpr int SK_ROWB = 144;
__device__ __forceinline__ void peer_qload(const bf16_t* __restrict__ Qrow  , const int hh, bf16x8 (&qb)[4]) {
#pragma unroll
    for (int ks = 0; ks < 4; ++ks) qb[ks] = *reinterpret_cast<const bf16x8*>(Qrow + ks * 16 + hh * 8);
}
__device__ __forceinline__ void peer_stage1(const LAS unsigned char* SK  , const bf16x8 (&qb)[4]  ,
                                            const int r, const int hh, float (&out)[16]) {
    float grp[4][16];
#pragma unroll
    for (int mt = 0; mt < 4; ++mt) {
        f32x16 acc;
#pragma unroll
        for (int i = 0; i < 16; ++i) acc[i] = 0.f;
#pragma unroll
        for (int ks = 0; ks < 4; ++ks) {
            const bf16x8 a = *(const LAS bf16x8*)(SK + (mt * 32 + r) * SK_ROWB + (ks * 16 + hh * 8) * 2);
            acc = MFMA32(a, qb[ks], acc);
        }
        const unsigned hx = (unsigned)hh << 2;
#pragma unroll
        for (int i = 0; i < 16; ++i) {
            const unsigned cn = 32u * mt + (i & 3) + 8u * (i >> 2);
            grp[mt][i] = key_embed(acc[i], 127u, (127u - cn) ^ hx);
        }
        sort16_desc(grp[mt]);
    }
    merge_top16(grp[0], grp[1]); merge_top16(grp[2], grp[3]); merge_top16(grp[0], grp[2]);
    float pb[16];
#pragma unroll
    for (int i = 0; i < 16; ++i) pb[i] = shfl_x(grp[0][i], (hh << 5) | r, 32);
    merge_top16(grp[0], pb);
#pragma unroll
    for (int i = 0; i < 16; ++i) out[i] = grp[0][i];
}

__device__ void ph_peer_select(const Params& p, int l, unsigned char* ldsraw, const int wv) {
    asm volatile("" : "+s"(l));
    const int tid = opaque_tid(wv);
    const int wave = tid >> 6, lane = tid & 63, r = lane & 31, hh = lane >> 5;
    const int gw = blockIdx.x * 8 + wave, nw = gridDim.x * 8;
    LAS unsigned char* skl = (LAS unsigned char*)ldsraw;
    LAS unsigned char* myl = skl + 2 * 128 * SK_ROWB + wave * 2048 + lane * 32;
    {
        const bf16_t* SKg = (const bf16_t*)(p.ws + OFF_SUBK) + (size_t)l * 2 * 128 * 64;
        for (int i = tid; i < 2 * 128 * 8; i += NT) {
            const int row = i >> 3, ch = i & 7;
            *(LAS u32x4*)(skl + row * SK_ROWB + ch * 16) = *reinterpret_cast<const u32x4*>(SKg + (size_t)row * 64 + ch * 8);
        }
        __syncthreads();
    }
    for (int task = gw; task < (NTOK / 32) * 4; task += nw) {
        const int tg = task >> 2, k = task & 3;
        const int t = tg * 32 + r;
        const bf16_t* Qt = (const bf16_t*)(p.ws + OFF_Q) + (size_t)t * D;
        float sv[2][16];
        {
            bf16x8 qa[4], qb2[4];
            float la[16], lb[16];
            peer_qload(Qt + k * 128, hh, qa);
            peer_qload(Qt + (k + 4) * 128, hh, qb2);
            peer_stage1(skl, qa, r, hh, la);
            peer_qload(Qt + k * 128 + 64, hh, qa);
            peer_stage1(skl, qb2, r, hh, lb);
            peer_qload(Qt + (k + 4) * 128 + 64, hh, qb2);
#pragma unroll
            for (int i = 0; i < 16; ++i) sv[0][i] = hh ? lb[i] : la[i];
            peer_stage1(skl + 128 * SK_ROWB, qa, r, hh, la);
            peer_stage1(skl + 128 * SK_ROWB, qb2, r, hh, lb);
#pragma unroll
            for (int i = 0; i < 16; ++i) sv[1][i] = hh ? lb[i] : la[i];
        }
        {
            unsigned w[8];
#pragma unroll
            for (int q = 0; q < 8; ++q) {
                w[q] = 0u;
#pragma unroll
                for (int b = 0; b < 4; ++b) {
                    const int i = q * 4 + b;
                    const unsigned key = __float_as_uint(i < 16 ? sv[0][i] : sv[1][i - 16]);
                    w[q] |= (127u - (key & 127u)) << (8 * b);
                }
            }
            *(LAS u32x4*)(myl) = u32x4{w[0], w[1], w[2], w[3]};
            *(LAS u32x4*)(myl + 16) = u32x4{w[4], w[5], w[6], w[7]};
        }
        float val0[16], val1[16];
#pragma unroll
        for (int i = 0; i < 16; ++i) { val0[i] = __uint_as_float(__float_as_uint(sv[0][i]) & ~127u); val1[i] = __uint_as_float(__float_as_uint(sv[1][i]) & ~127u); }
        float g0[16], g1[16], g2[16], g3[16];
#pragma unroll
        for (int b = 0; b < 16; ++b) g0[b] = key_embed(val0[0] + val1[b], 255u, 255u - (unsigned)b);
#pragma unroll
        for (int b = 0; b < 8; ++b) g1[b] = key_embed(val0[1] + val1[b], 255u, 255u - (16u + b));
#pragma unroll
        for (int b = 0; b < 5; ++b) g1[8 + b] = key_embed(val0[2] + val1[b], 255u, 255u - (32u + b));
#pragma unroll
        for (int b = 0; b < 3; ++b) g1[13 + b] = key_embed(val0[4] + val1[b], 255u, 255u - (64u + b));
#pragma unroll
        for (int b = 0; b < 4; ++b) g2[b] = key_embed(val0[3] + val1[b], 255u, 255u - (48u + b));
#pragma unroll
        for (int a = 5; a < 8; ++a)
#pragma unroll
            for (int b = 0; b < 2; ++b) g2[4 + (a - 5) * 2 + b] = key_embed(val0[a] + val1[b], 255u, 255u - (16u * a + b));
#pragma unroll
        for (int a = 8; a < 14; ++a) g2[10 + (a - 8)] = key_embed(val0[a] + val1[0], 255u, 255u - 16u * a);
        g3[0] = key_embed(val0[14] + val1[0], 255u, 255u - 16u * 14); g3[1] = key_embed(val0[15] + val1[0], 255u, 255u - 16u * 15);
#pragma unroll
        for (int i = 2; i < 16; ++i) g3[i] = -3.0e38f;
        sort16_desc(g1); sort16_desc(g2); sort16_desc(g3);
        merge_top16(g0, g1); merge_top16(g2, g3); merge_top16(g0, g2);
        float gate[16]; int eid[16];
        const float mx = __uint_as_float(__float_as_uint(g0[0]) & ~255u);
        float sum = 0.f;
#pragma unroll
        for (int i = 0; i < 16; ++i) {
            const unsigned key = __float_as_uint(g0[i]);
            gate[i] = __expf(__uint_as_float(key & ~255u) - mx); sum += gate[i];
            const unsigned id = 255u - (key & 255u);
            const unsigned n0 = *(const LAS unsigned char*)(myl + (id >> 4));
            const unsigned n1 = *(const LAS unsigned char*)(myl + 16 + (id & 15u));
            eid[i] = (int)(n0 * 128u + n1);
        }
        const float inv = 1.f / sum;
        const int h = k + 4 * hh;
        int* EI = (int*)(p.ws + OFF_EIDX) + (size_t)t * 128 + h * 16; float* EG = (float*)(p.ws + OFF_EGATE) + (size_t)t * 128 + h * 16;
#pragma unroll
        for (int q = 0; q < 4; ++q) {
            *reinterpret_cast<int4*>(EI + q * 4) = make_int4(eid[q * 4], eid[q * 4 + 1], eid[q * 4 + 2], eid[q * 4 + 3]);
            *reinterpret_cast<float4*>(EG + q * 4) = make_float4(gate[q * 4] * inv, gate[q * 4 + 1] * inv, gate[q * 4 + 2] * inv, gate[q * 4 + 3] * inv);
        }
    }
}

constexpr int LDS_BYTES = LDS_HDR + 3 * 48 * 1024;
__global__ void __launch_bounds__(NT, 2) mk_fwd(Params p) {
    extern __shared__ __attribute__((aligned(16))) unsigned char lds[];
    const int wv = __builtin_amdgcn_readfirstlane((int)(threadIdx.x >> 6));
    volatile LAS unsigned* st = (volatile LAS unsigned*)lds;
    if (threadIdx.x < 4) st[threadIdx.x] = 0u;
    __syncthreads();
    XcdBarrier xb = xcd_barrier_post((unsigned*)(p.ws + OFF_BAR), st);
    int bar_idx = 0;
#define GRID_BAR() do { xcd_barrier(xb); \
        if (PROBE_TS >= 0 && blockIdx.x == 0 && threadIdx.x == 0 && (bar_idx == PROBE_TS - 1 || bar_idx == PROBE_TS)) \
            ((volatile LAS unsigned long long*)(lds + 128))[bar_idx - (PROBE_TS - 1)] = __builtin_amdgcn_s_memrealtime(); \
        ++bar_idx; } while (0)
    if (PROBE_TS == 0 && blockIdx.x == 0 && threadIdx.x == 0) ((volatile LAS unsigned long long*)(lds + 128))[0] = __builtin_amdgcn_s_memrealtime();
    unsigned char* ws = p.ws;
    for (int rep = 0; rep < (PROBE_DUP == 1 ? 2 : 1); ++rep) {
    ph_transpose_all(p, lds + LDS_HDR, wv);
    ph_convert(p.in[I_SUBK], (bf16_t*)(ws + OFF_SUBK), 2 * 2 * 128 * 64, wv);
    ph_convert(p.in[I_SGUW], (bf16_t*)(ws + OFF_SGUW), 2 * 4 * 128 * 128, wv);
    ph_mod(p, lds + LDS_HDR, wv);
    ph_rope_tab(p, wv);
    GRID_BAR();
    }
    for (int l = 0; l < 2; ++l) {
        for (int rep = 0; rep < (PROBE_DUP == 3 ? 2 : 1); ++rep) {
        if (l == 0) {
            ph_norm_mod(p, 0, 0, 1, wv);
            ph_cache_prep(p, 0, wv);
            ph_fold_tables(p, lds + LDS_HDR, wv);
            GRID_BAR();
        }
        }
        for (int rep = 0; rep < (PROBE_DUP == 5 ? 2 : 1); ++rep) {
        if (l == 1) ph_cache_prep(p, 1, wv);
        gemm_phase2<EPI_INPROJ>(p, l, (const bf16_t*)(ws + (l == 0 ? OFF_H : OFF_XC)), (const bf16_t*)(ws + (l == 0 ? OFF_WIN : OFF_WINS)), INW, lds + LDS_HDR, wv,
                                l == 0 ? (size_t)0 : (size_t)INW * D, (const float*)(ws + OFF_RSS1), (const float*)(ws + OFF_BIN));
        GRID_BAR();
        }
        for (int rep = 0; rep < ((PROBE_DUP == 4 || (PROBE_DUP >= 10 && PROBE_DUP <= 12)) ? 2 : 1); ++rep) {
        ph_mixers(p, l + 2 * rep, lds + LDS_HDR, wv);
        GRID_BAR();
        }
        if (l == 0) ph_ush(p, lds + LDS_HDR, wv);
        gemm_phase2<EPI_WOUT>(p, l, (const bf16_t*)(ws + OFF_MIX), (const bf16_t*)(ws + OFF_WOUT) + (size_t)l * D * D, D, lds + LDS_HDR, wv);
        GRID_BAR();
        for (int rep = 0; rep < (PROBE_DUP == 7 ? 2 : 1); ++rep) {
        gemm_phase2<EPI_WQ>(p, l, (const bf16_t*)(ws + OFF_XC), (const bf16_t*)(ws + OFF_WQS) + (size_t)l * 5 * D * D, D, lds + LDS_HDR, wv,
                           (size_t)D * D, (const float*)(ws + OFF_RSS2) + (size_t)l * NTOK * 8, (const float*)(ws + OFF_BQ) + (size_t)l * 5 * D);
        GRID_BAR();
        }
        if (PROBE_DUP == 8) { for (int rep = 0; rep < 10; ++rep) GRID_BAR(); }
        for (int rep = 0; rep < (PROBE_DUP == 2 ? 2 : 1); ++rep) {
        ph_peer_select(p, l, lds + LDS_HDR, wv);
        GRID_BAR();
        }
        ph_peer_sliced<false>(p, l, lds + LDS_HDR, wv);
        GRID_BAR();
        ph_peer_pairw(p, l, wv);
        GRID_BAR();
        ph_peer_sliced<true>(p, l, lds + LDS_HDR, wv);
        GRID_BAR();
    }
    ph_final_norm(p, wv);
    if (PROBE_TS >= 0 && blockIdx.x == 0 && threadIdx.x == 0) {
        asm volatile("s_waitcnt vmcnt(0)" ::: "memory");
        volatile LAS unsigned long long* tsl = (volatile LAS unsigned long long*)(lds + 128);
        p.out[0] += (float)(tsl[1] - tsl[0]) * 0.01f;
    }
}

extern "C" void kernel_launch(void* const* d_in, const int* in_sizes, int n_in,
                              void* d_out, int out_size, void* d_ws, size_t ws_size,
                              hipStream_t stream) {
    static int grid = 0;
    if (grid == 0) {
        if (ws_size < WS_NEED) { fprintf(stderr, "kernel_launch: workspace too small: %zu < %zu\n", ws_size, (size_t)WS_NEED); grid = -1; return; }
        int dev = 0, cus = 0, per_cu = 0;
        (void)hipGetDevice(&dev);
        (void)hipDeviceGetAttribute(&cus, hipDeviceAttributeMultiprocessorCount, dev);
        (void)hipFuncSetAttribute((const void*)mk_fwd, hipFuncAttributeMaxDynamicSharedMemorySize, LDS_BYTES);
        (void)hipOccupancyMaxActiveBlocksPerMultiprocessor(&per_cu, (const void*)mk_fwd, NT, LDS_BYTES);
        if (per_cu < 1) { fprintf(stderr, "kernel_launch: occupancy query reports %d blocks per CU\n", per_cu); grid = -1; return; }
        grid = cus;
    }
    if (grid < 0) return;
    (void)hipMemsetAsync((unsigned char*)d_ws + OFF_BAR, 0, 64 * 1024, stream);
    Params p{};
    for (int i = 0; i < 29; ++i) p.in[i] = (const float*)d_in[i];
    p.out = (float*)d_out; p.ws = (unsigned char*)d_ws;
    void* args[] = {&p};
    hipError_t e = hipLaunchCooperativeKernel((const void*)mk_fwd, dim3(grid), dim3(NT), args, LDS_BYTES, stream);
    if (e != hipSuccess) fprintf(stderr, "kernel_launch: cooperative launch failed: %s (grid %d)\n", hipGetErrorString(e), grid);
}
```

```cpp
#include <hip/hip_runtime.h>
#include <hip/hip_bf16.h>
#include <cstdio>
#include <cstdint>
#include <hip/hip_cooperative_groups.h>
namespace cg = cooperative_groups;

#define PROBE_DUP 0
#define PROBE_TS -1
typedef unsigned short bf16_t;
using bf16x8 = __attribute__((ext_vector_type(8))) short;
using f32x4  = __attribute__((ext_vector_type(4))) float;
using f32x16 = __attribute__((ext_vector_type(16))) float;
using f32x2  = __attribute__((ext_vector_type(2))) float;
using u32x4  = __attribute__((ext_vector_type(4))) unsigned;
using u32x2  = __attribute__((ext_vector_type(2))) unsigned;
using s16x4  = __attribute__((ext_vector_type(4))) short;

constexpr int D      = 1024;
constexpr int NTOK   = 16384;
constexpr int NPT    = 8192;
constexpr int SEQ    = 256;
constexpr int DSEQ   = 2048;
constexpr int PAST   = 512;
constexpr int NKS    = DSEQ + PAST;
constexpr int INW    = 2048;
constexpr int NEXP   = 16384;
constexpr float EPS  = 1e-6f;

constexpr size_t MB = 1024 * 1024;
constexpr size_t OFF_BAR   = 0;
constexpr size_t OFF_MOD   = 64 * 1024;
constexpr size_t OFF_ROPE  = OFF_MOD + 256 * 1024;
constexpr size_t OFF_SUBK  = OFF_ROPE + 1 * MB;
constexpr size_t OFF_SGUW  = OFF_SUBK + 64 * 1024;
constexpr size_t OFF_WIN   = OFF_SGUW + 256 * 1024;
constexpr size_t OFF_WOUT  = OFF_WIN + 8 * MB;
constexpr size_t OFF_WQ    = OFF_WOUT + 4 * MB;
constexpr size_t OFF_UT    = OFF_WQ + 4 * MB;
constexpr size_t OFF_USC   = OFF_UT + 32 * MB;
constexpr size_t OFF_VT    = OFF_UT + 64 * MB;
constexpr size_t OFF_VSC   = OFF_VT + 32 * MB;
constexpr size_t OFF_H     = OFF_VT + 64 * MB;
constexpr size_t OFF_XC    = OFF_H + 32 * MB;
constexpr size_t OFF_R1    = OFF_XC + 64 * MB;
constexpr size_t OFF_AU    = OFF_R1;
constexpr size_t OFF_AV    = OFF_AU + 8 * MB;
constexpr size_t OFF_AVN   = OFF_AV + 8 * MB;
constexpr size_t OFF_DQ    = OFF_AVN + 8 * MB;
constexpr size_t OFF_DKP   = OFF_DQ + 8 * MB;
constexpr size_t OFF_DKS   = OFF_DKP + 4 * MB;
constexpr size_t OFF_DVTP  = OFF_DKS + 5 * MB;
constexpr size_t OFF_DVTS  = OFF_DVTP + 4 * MB;
constexpr size_t OFF_GQ    = OFF_DVTS + 5 * MB;
constexpr size_t OFF_GKP   = OFF_GQ + 16 * MB;
constexpr size_t OFF_GKS   = OFF_GKP + 2 * MB;
constexpr size_t OFF_GVTP  = OFF_GKS + 3 * MB;
constexpr size_t OFF_GVTS  = OFF_GVTP + 2 * MB;
constexpr size_t OFF_MIX   = OFF_GVTS + 3 * MB;
constexpr size_t OFF_R1END = OFF_MIX + 32 * MB;
constexpr size_t OFF_Q     = OFF_R1;
constexpr size_t OFF_EIDX  = OFF_Q + 32 * MB;
constexpr size_t OFF_EGATE = OFF_EIDX + 8 * MB;
constexpr size_t OFF_TOPV  = OFF_EGATE + 8 * MB;
constexpr size_t OFF_TOPI  = OFF_TOPV + 16 * MB;
static_assert(OFF_TOPI + 16 * MB <= OFF_R1END, "peer buffers must fit region 1");
constexpr size_t OFF_PROJ  = OFF_R1END;
constexpr size_t OFF_PART  = OFF_PROJ;
constexpr size_t OFF_WPAIR = OFF_PART + 64 * MB;
constexpr size_t OFF_H8I   = OFF_WPAIR + 8 * MB;
constexpr size_t OFF_HSC   = OFF_H8I + 16 * MB;
constexpr size_t OFF_WSC   = OFF_HSC + 64 * 1024;
constexpr size_t OFF_XGS   = OFF_WSC + 64 * 1024;
constexpr size_t OFF_RSS2  = OFF_XGS + 512 * 1024;
constexpr size_t OFF_RSS1  = OFF_RSS2 + 1 * MB;
constexpr size_t OFF_USH   = OFF_RSS1 + 512 * 1024;
constexpr size_t OFF_BQ    = OFF_USH + 1 * MB;
constexpr size_t OFF_BIN   = OFF_BQ + 64 * 1024;
constexpr size_t OFF_WQS   = OFF_BIN + 64 * 1024;
constexpr size_t OFF_WINS  = OFF_XC + 32 * MB;
static_assert(OFF_WQS + 20 * MB <= OFF_PROJ + 128 * MB, "folded tables must fit");
constexpr size_t WS_NEED   = OFF_PROJ + 128 * MB;
static_assert(WS_NEED <= 512 * MB, "workspace budget");

constexpr size_t OUT_YP  = 0;
constexpr size_t OUT_YS  = 8388608;
constexpr size_t OUT_NDK = 16777216;
constexpr size_t OUT_NDV = OUT_NDK + 4194304;
constexpr size_t OUT_NGK = OUT_NDV + 4194304;
constexpr size_t OUT_NGV = OUT_NGK + 2097152;

struct Params {
    const float* in[29];
    float* out;
    unsigned char* ws;
};
enum { I_XP = 0, I_XS, I_CDK, I_CDV, I_CGK, I_CGV, I_C, I_CCTX, I_ADAW, I_ADAB, I_N1G, I_N2G, I_WIN, I_SGUNG, I_SGUW, I_SGUB,
       I_LQ1, I_LK1, I_LQ2, I_LK2, I_SUBLN, I_QNG, I_KNG, I_WOUT, I_WQ, I_SUBK, I_PU, I_PV, I_FG };

typedef __bf16 hwbf2 __attribute__((ext_vector_type(2)));
__device__ __forceinline__ unsigned pack_bf2(float a, float b) {
    const f32x2 v = {a, b};
    return __builtin_bit_cast(unsigned, __builtin_convertvector(v, hwbf2));
}
__device__ __forceinline__ bf16_t f2bf(float f) { return (bf16_t)(pack_bf2(f, 0.f) & 0xffffu); }
__device__ __forceinline__ float bf2f(bf16_t h) { return __uint_as_float(((unsigned)h) << 16); }
__device__ __forceinline__ float gelu_f(float x) {
    const float k2 = 2.f * 0.7978845608028654f * 1.4426950408889634f;
    const float e = __builtin_amdgcn_exp2f(k2 * (x + 0.044715f * x * x * x));
    return x - x * __builtin_amdgcn_rcpf(e + 1.f);
}
__device__ __forceinline__ int lane_id() { return (int)__builtin_amdgcn_mbcnt_hi(~0u, __builtin_amdgcn_mbcnt_lo(~0u, 0u)); }
__device__ __forceinline__ int lane_id_op() { int l = lane_id(); asm volatile("" : "+v"(l)); return l; }
__device__ __forceinline__ float shfl_i(float v, int src) { return __builtin_bit_cast(float, __builtin_amdgcn_ds_bpermute(src << 2, __builtin_bit_cast(int, v))); }
__device__ __forceinline__ int shfl_i(int v, int src) { return __builtin_amdgcn_ds_bpermute(src << 2, v); }
__device__ __forceinline__ float shfl_x(float v, int lane, int m) { return shfl_i(v, lane ^ m); }
__device__ __forceinline__ int shfl_x(int v, int lane, int m) { return shfl_i(v, lane ^ m); }
__device__ __forceinline__ int q8(float x) { return (int)fminf(fmaxf(rintf(x), -127.f), 127.f); }
__device__ __forceinline__ unsigned pack4_i8(int a, int b, int c, int d) { return (unsigned)(a & 255) | ((unsigned)(b & 255) << 8) | ((unsigned)(c & 255) << 16) | ((unsigned)d << 24); }
#define DPP_F(v, ctrl) __builtin_bit_cast(float, __builtin_amdgcn_update_dpp(0, __builtin_bit_cast(int, (v)), (ctrl), 0xF, 0xF, false))
__device__ __forceinline__ float row16_sum(float v) {
    v += DPP_F(v, 0xB1); v += DPP_F(v, 0x4E); v += DPP_F(v, 0x141); v += DPP_F(v, 0x140);
    return v;
}
__device__ __forceinline__ float row16_max(float v) {
    v = fmaxf(v, DPP_F(v, 0xB1)); v = fmaxf(v, DPP_F(v, 0x4E)); v = fmaxf(v, DPP_F(v, 0x141)); v = fmaxf(v, DPP_F(v, 0x140));
    return v;
}
__device__ __forceinline__ float rdlane_f(float v, int l) { return __builtin_bit_cast(float, __builtin_amdgcn_readlane(__builtin_bit_cast(int, v), l)); }
__device__ __forceinline__ float wave_sum(float v) {
    v = row16_sum(v);
    return (rdlane_f(v, 0) + rdlane_f(v, 16)) + (rdlane_f(v, 32) + rdlane_f(v, 48));
}
__device__ __forceinline__ float wave_max(float v) {
    v = row16_max(v);
    return fmaxf(fmaxf(rdlane_f(v, 0), rdlane_f(v, 16)), fmaxf(rdlane_f(v, 32), rdlane_f(v, 48)));
}
__device__ __forceinline__ int tok_cv(int t) { return t < NPT ? 0 : 1 + ((t - NPT) >> 11); }
__device__ __forceinline__ const float* x_in_row(const Params& p, int t) {
    return t < NPT ? p.in[I_XP] + (size_t)t * D : p.in[I_XS] + (size_t)(t - NPT) * D;
}
__device__ __forceinline__ float lam_init_of(int l) { return l == 0 ? 0.2f : (0.8f - 0.6f * 0.7408182206817179f); }
__device__ __forceinline__ float lam_of(const Params& p, int l) {
    float s1 = 0.f, s2 = 0.f;
    for (int i = 0; i < 32; ++i) {
        s1 += p.in[I_LQ1][l * 32 + i] * p.in[I_LK1][l * 32 + i];
        s2 += p.in[I_LQ2][l * 32 + i] * p.in[I_LK2][l * 32 + i];
    }
    return expf(s1) - expf(s2) + lam_init_of(l);
}


#define XB_TMO      128
#define XB_XCNT(j)  (256  + 64 * (j))
#define XB_XSUB(j)  (1280 + 64 * (j))
#define XB_XGEN(j)  (2304 + 64 * (j))
#define XB_TOP      3328
#define XB_TOPGEN   3392
#define XCD_BAR_WORDS 3456
#define XB_SPIN_CAP (1u << 20)
#define LAS __attribute__((address_space(3)))
typedef int i32x4 __attribute__((ext_vector_type(4)));
__device__ __forceinline__ unsigned xb_ld(unsigned* p)              { return __hip_atomic_load(p, __ATOMIC_RELAXED, __HIP_MEMORY_SCOPE_AGENT); }
__device__ __forceinline__ unsigned xb_add(unsigned* p, unsigned v) { return __hip_atomic_fetch_add(p, v, __ATOMIC_RELAXED, __HIP_MEMORY_SCOPE_AGENT); }
__device__ __forceinline__ unsigned xb_xcc_id() { return (unsigned)__builtin_amdgcn_s_getreg((3 << 11) | 20) & 0xFu; }
#define XB_SPIN(cond, bar) do { unsigned _sp = 0; while (cond) { __builtin_amdgcn_s_sleep(1); \
    if ((++_sp & 255u) == 0u) { if (xb_ld(&(bar)[XB_TMO])) break; if (_sp > XB_SPIN_CAP) { atomicAdd(&(bar)[XB_TMO], 1u); break; } } } } while (0)
struct XcdBarrier { unsigned* bar; unsigned x; volatile LAS unsigned* st; };
__device__ __forceinline__ XcdBarrier xcd_barrier_post(unsigned* bar, volatile LAS unsigned* st) {
    XcdBarrier b; b.bar = bar; b.x = xb_xcc_id(); b.st = st;
    if (threadIdx.x == 0) (void)xb_add(&bar[XB_XCNT(b.x)], 1u);
    return b;
}
__device__ __forceinline__ void xcd_barrier_complete(unsigned* bar, unsigned x, unsigned& nloc, unsigned& nx) {
    const unsigned G = gridDim.x * gridDim.y * gridDim.z;
    unsigned sum, cnt, mine, sp = 0u;
    for (;;) {
        sum = 0u; cnt = 0u; mine = 0u;
#pragma unroll
        for (unsigned j = 0; j < 16; ++j) { const unsigned c = xb_ld(&bar[XB_XCNT(j)]); sum += c; cnt += (c > 0u) ? 1u : 0u; mine = (j == x) ? c : mine; }
        if (sum == G) break;
        __builtin_amdgcn_s_sleep(1);
        if ((++sp & 255u) == 0u) { if (xb_ld(&bar[XB_TMO])) break; if (sp > XB_SPIN_CAP) { atomicAdd(&bar[XB_TMO], 1u); break; } }
    }
    nloc = mine > 0u ? mine : 1u; nx = cnt > 0u ? cnt : 1u;
}
__device__ __forceinline__ void xcd_barrier(const XcdBarrier& b) {
    asm volatile("s_waitcnt vmcnt(0)" ::: "memory");
    __syncthreads();
    if (threadIdx.x == 0) {
        unsigned* bar = b.bar;
        const unsigned bx = xb_xcc_id();
        __builtin_amdgcn_s_waitcnt(0);
        unsigned nloc = b.st[0], nx = b.st[1];
        if (nloc == 0u) { xcd_barrier_complete(bar, bx, nloc, nx); b.st[0] = nloc; b.st[1] = nx; }
        const unsigned old = xb_add(&bar[XB_XSUB(bx)], 1u);
        const unsigned gen = old / nloc;
        if (old + 1u == (gen + 1u) * nloc) {
            __builtin_amdgcn_fence(__ATOMIC_RELEASE, "agent");
            asm volatile("s_waitcnt vmcnt(0)" ::: "memory");
            const unsigned og = xb_add(&bar[XB_TOP], 1u);
            const unsigned tg = og / nx;
            if (og + 1u == (tg + 1u) * nx) xb_add(&bar[XB_TOPGEN], 1u);
            else XB_SPIN(xb_ld(&bar[XB_TOPGEN]) == tg, bar);
            __builtin_amdgcn_fence(__ATOMIC_ACQUIRE, "agent");
            xb_add(&bar[XB_XGEN(bx)], 1u);
            asm volatile("s_waitcnt vmcnt(0)" ::: "memory");
        } else {
            XB_SPIN(xb_ld(&bar[XB_XGEN(bx)]) == gen, bar);
            __builtin_amdgcn_fence(__ATOMIC_ACQUIRE, "agent");
            asm volatile("s_waitcnt vmcnt(0)" ::: "memory");
        }
    }
    __syncthreads();
}

constexpr int NT = 512;
constexpr int LDS_HDR = 1024;
#define GTID ((size_t)blockIdx.x * NT + tid)
__device__ __forceinline__ int opaque_tid(int wv) { int t = (wv << 6) | lane_id(); asm volatile("" : "+v"(t)); return t; }
#define GNT  ((size_t)gridDim.x * NT)

__device__ void ph_transpose_all(const Params& p, unsigned char* ldsraw, const int wv) {
    const int tid = opaque_tid(wv);
    LAS bf16_t* T = (LAS bf16_t*)ldsraw;
    for (int tile = blockIdx.x; tile < 1024; tile += gridDim.x) {
        const int l = tile >> 9, r = tile & 511;
        const float* W; bf16_t* Wt; int N, tl;
        if (r < 256)      { W = p.in[I_WIN] + (size_t)l * D * INW; Wt = (bf16_t*)(p.ws + OFF_WIN) + (size_t)l * INW * D; N = INW; tl = r; }
        else if (r < 384) { W = p.in[I_WOUT] + (size_t)l * D * D;  Wt = (bf16_t*)(p.ws + OFF_WOUT) + (size_t)l * D * D;  N = D;   tl = r - 256; }
        else              { W = p.in[I_WQ] + (size_t)l * D * D;    Wt = (bf16_t*)(p.ws + OFF_WQ) + (size_t)l * D * D;    N = D;   tl = r - 384; }
        const int k0 = (tl & 7) * 128, n0 = (tl >> 3) * 64;
        const int nl0 = tid & 63, kq = tid >> 6;
        float v[16];
#pragma unroll
        for (int i = 0; i < 16; ++i) v[i] = W[(size_t)(k0 + i * 8 + kq) * N + n0 + nl0];
#pragma unroll
        for (int i = 0; i < 16; ++i) T[nl0 * 130 + i * 8 + kq] = f2bf(v[i]);
        __syncthreads();
        {
            const int nl = tid >> 3, kc = tid & 7;
            unsigned w[8];
#pragma unroll
            for (int i = 0; i < 8; ++i) w[i] = (unsigned)T[nl * 130 + kc * 16 + 2 * i] | ((unsigned)T[nl * 130 + kc * 16 + 2 * i + 1] << 16);
            bf16_t* dst = Wt + (size_t)(n0 + nl) * D + k0 + kc * 16;
            *reinterpret_cast<u32x4*>(dst) = u32x4{w[0], w[1], w[2], w[3]};
            *reinterpret_cast<u32x4*>(dst + 8) = u32x4{w[4], w[5], w[6], w[7]};
        }
        __syncthreads();
    }
}
__device__ void ph_convert(const float* __restrict__ src, bf16_t* __restrict__ dst, size_t n, const int wv) {
    const int tid = opaque_tid(wv);
    for (size_t idx = GTID; idx < n; idx += GNT) dst[idx] = f2bf(src[idx]);
}
__device__ void ph_convert_i8_rows(const float* __restrict__ src, unsigned char* __restrict__ dst, float* __restrict__ scl, int nrows, const int wv) {
    const int tid = opaque_tid(wv);
    const int lane = tid & 63;
    const int gw = blockIdx.x * 8 + (tid >> 6), nw = gridDim.x * 8;
    for (int row0 = gw * 4; row0 < nrows; row0 += nw * 4) {
        float4 f[4][4];
#pragma unroll
        for (int q = 0; q < 4; ++q)
#pragma unroll
            for (int i = 0; i < 4; ++i) f[q][i] = *reinterpret_cast<const float4*>(src + (size_t)(row0 + q) * D + lane * 16 + i * 4);
#pragma unroll
        for (int q = 0; q < 4; ++q) {
            const int row = row0 + q;
            float v[16];
#pragma unroll
            for (int i = 0; i < 4; ++i) { v[i * 4] = f[q][i].x; v[i * 4 + 1] = f[q][i].y; v[i * 4 + 2] = f[q][i].z; v[i * 4 + 3] = f[q][i].w; }
            float am = 0.f;
#pragma unroll
            for (int i = 0; i < 16; ++i) am = fmaxf(am, fabsf(v[i]));
#pragma unroll
            for (int o = 32; o >= 1; o >>= 1) am = fmaxf(am, shfl_x(am, lane, o));
            const float sc = am > 0.f ? 127.f / am : 1.f;
            unsigned w[4];
#pragma unroll
            for (int i = 0; i < 4; ++i) w[i] = pack4_i8(q8(v[i * 4] * sc), q8(v[i * 4 + 1] * sc), q8(v[i * 4 + 2] * sc), q8(v[i * 4 + 3] * sc));
            {
                const int lyr = row >> 14, e = row & (NEXP - 1);
                *reinterpret_cast<u32x4*>(dst + (((size_t)lyr * 8 + (lane >> 3)) * NEXP + e) * 128 + (lane & 7) * 16) = u32x4{w[0], w[1], w[2], w[3]};
            }
            if (lane == 0) scl[row] = am > 0.f ? am * (1.f / 127.f) : 1.f;
        }
    }
}
__device__ void ph_mod(const Params& p, unsigned char* ldsraw, const int wv) {
    const int tid = opaque_tid(wv);
    LAS float* sl = (LAS float*)ldsraw;
    LAS float* red = sl + 5 * 1024;
    for (int i = tid; i < 5 * 1024; i += NT) {
        const int cv = i >> 10, k = i & 1023;
        const float c = cv == 0 ? p.in[I_CCTX][k] : p.in[I_C][(size_t)(cv - 1) * D + k];
        sl[i] = c / (1.f + __expf(-c));
    }
    __syncthreads();
    const int c4 = tid & 15, r = tid >> 4;
    for (int item = blockIdx.x; item < 2 * 96; item += gridDim.x) {
        const int l = item / 96, j0 = (item % 96) * 64;
        const float* W = p.in[I_ADAW] + (size_t)l * D * 6144 + (size_t)r * 6144 + j0 + c4 * 4;
        float acc[5][4];
#pragma unroll
        for (int cv = 0; cv < 5; ++cv)
#pragma unroll
            for (int q = 0; q < 4; ++q) acc[cv][q] = 0.f;
#pragma unroll 8
        for (int i = 0; i < 32; ++i) {
            const float4 w = *reinterpret_cast<const float4*>(W + (size_t)i * 32 * 6144);
#pragma unroll
            for (int cv = 0; cv < 5; ++cv) {
                const float sv = sl[cv * 1024 + r + i * 32];
                acc[cv][0] += sv * w.x; acc[cv][1] += sv * w.y; acc[cv][2] += sv * w.z; acc[cv][3] += sv * w.w;
            }
        }
#pragma unroll
        for (int cv = 0; cv < 5; ++cv) *(LAS f32x4*)(red + (r * 5 + cv) * 64 + c4 * 4) = f32x4{acc[cv][0], acc[cv][1], acc[cv][2], acc[cv][3]};
        __syncthreads();
        if (tid < 320) {
            const int cv = tid >> 6, c = tid & 63;
            float sum = p.in[I_ADAB][l * 6144 + j0 + c];
#pragma unroll
            for (int q = 0; q < 32; ++q) sum += red[(q * 5 + cv) * 64 + c];
            ((float*)(p.ws + OFF_MOD))[(size_t)(l * 5 + cv) * 6144 + j0 + c] = sum;
        }
        __syncthreads();
    }
}
__device__ void ph_rope_tab(const Params& p, const int wv) {
    const int tid = opaque_tid(wv);
    for (size_t idx = GTID; idx < 2048 * 48; idx += GNT) {
        int s = idx / 48, i = idx % 48;
        float* R = (float*)(p.ws + OFF_ROPE);
        double row = (double)(s / 64), col = (double)(s % 64);
        if (i < 16) {
            int q = i & 7; double inv = pow(10000.0, -(double)q / 8.0);
            double ang = (i < 8 ? row : col) * inv;
            R[s * 16 + i] = (float)cos(ang); R[2048 * 16 + s * 16 + i] = (float)sin(ang);
        } else {
            int ii = i - 16; int q = ii & 15; double inv = pow(10000.0, -(double)q / 16.0);
            double ang = (ii < 16 ? row : col) * inv;
            R[2048 * 32 + s * 32 + ii] = (float)cos(ang); R[2048 * 64 + s * 32 + ii] = (float)sin(ang);
        }
    }
}
__device__ void ph_cache_prep(const Params& p, int l, const int wv) {
    asm volatile("" : "+s"(l));
    const int tid = opaque_tid(wv);
    bf16_t* DKS = (bf16_t*)(p.ws + OFF_DKS); bf16_t* DVTS = (bf16_t*)(p.ws + OFF_DVTS);
    bf16_t* GKS = (bf16_t*)(p.ws + OFF_GKS); bf16_t* GVTS = (bf16_t*)(p.ws + OFF_GVTS);
    constexpr size_t NEL = 4 * 512 * 256;
    for (size_t base = GTID; base < NEL; base += 4 * GNT) {
        float dk[4], dv[4], gk[4], gv[4];
#pragma unroll
        for (int u = 0; u < 4; ++u) {
            const size_t idx = base + (size_t)u * GNT < NEL ? base + (size_t)u * GNT : base;
            const int c = idx & 255, pp = (idx >> 8) & 511, b = idx >> 17;
            const size_t src = (((size_t)b * 2 + l) * PAST + pp) * 256 + c;
            dk[u] = p.in[I_CDK][src]; dv[u] = p.in[I_CDV][src];
            const size_t src2 = (((size_t)b * 2 + l) * PAST + pp) * 128 + (c & 127);
            gk[u] = p.in[I_CGK][src2]; gv[u] = p.in[I_CGV][src2];
        }
        __builtin_amdgcn_sched_barrier(0);
#pragma unroll
        for (int u = 0; u < 4; ++u) {
            const size_t idx = base + (size_t)u * GNT < NEL ? base + (size_t)u * GNT : base;
            const int c = idx & 255, pp = (idx >> 8) & 511, b = idx >> 17;
            const int h = c >> 6, r = c & 63;
            DKS[(((size_t)b * 4 + h) * NKS + DSEQ + pp) * 64 + r] = f2bf(dk[u]);
            DVTS[(((size_t)b * 4 + h) * 64 + r) * NKS + DSEQ + pp] = f2bf(dv[u]);
            if (c < 128) {
                const int kv = c >> 6;
                const int sq = DSEQ + pp;
                const size_t hb = ((size_t)b * 2 + kv) * NKS * 64 + (size_t)(sq >> 6) * 4096;
                GKS[hb + (r >> 3) * 512 + (sq & 63) * 8 + (r & 7)] = f2bf(gk[u]);
                GVTS[hb + (r >> 5) * 2048 + (sq & 63) * 32 + (r & 31)] = f2bf(gv[u]);
            }
        }
    }
}
__device__ __forceinline__ void fold_item(const Params& p, const int c, const int tid) {
    const int lane = tid & 63;
    const int row0 = c * 32;
    const float* MOD = (const float*)(p.ws + OFF_MOD);
    {
        const int k0 = (tid & 127) * 8;
        const int which = row0 < 2048 ? 1 : 0, l = row0 < 1024 ? 0 : 1, N = row0 < 2048 ? 1024 : 2048;
        const float* gn = p.in[which ? I_N2G : I_N1G] + l * D + k0;
        const float4 ga = *reinterpret_cast<const float4*>(gn), gb = *reinterpret_cast<const float4*>(gn + 4);
        float gg[5][8];
#pragma unroll
        for (int cv = 0; cv < 5; ++cv) {
            const float* sc = MOD + (size_t)(l * 5 + cv) * 6144 + which * 3072 + 1024 + k0;
            const float4 sa = *reinterpret_cast<const float4*>(sc), sb = *reinterpret_cast<const float4*>(sc + 4);
            gg[cv][0] = ga.x * (1.f + sa.x); gg[cv][1] = ga.y * (1.f + sa.y); gg[cv][2] = ga.z * (1.f + sa.z); gg[cv][3] = ga.w * (1.f + sa.w);
            gg[cv][4] = gb.x * (1.f + sb.x); gg[cv][5] = gb.y * (1.f + sb.y); gg[cv][6] = gb.z * (1.f + sb.z); gg[cv][7] = gb.w * (1.f + sb.w);
        }
        u32x4 w[8];
#pragma unroll
        for (int j = 0; j < 8; ++j) {
            const int row = row0 + (tid >> 7) + 4 * j, n = row0 < 2048 ? (row & 1023) : row - 2048;
            const bf16_t* src = row0 < 2048 ? (const bf16_t*)(p.ws + OFF_WQ) + ((size_t)l * D + n) * D + k0 : (const bf16_t*)(p.ws + OFF_WIN) + ((size_t)INW + n) * D + k0;
            w[j] = *reinterpret_cast<const u32x4*>(src);
        }
        __builtin_amdgcn_sched_barrier(0);
#pragma unroll
        for (int j = 0; j < 8; ++j) {
            const int row = row0 + (tid >> 7) + 4 * j, n = row0 < 2048 ? (row & 1023) : row - 2048;
            bf16_t* dst = row0 < 2048 ? (bf16_t*)(p.ws + OFF_WQS) + ((size_t)l * 5 * D + n) * D + k0 : (bf16_t*)(p.ws + OFF_WINS) + (size_t)n * D + k0;
            float wf[8];
#pragma unroll
            for (int k = 0; k < 4; ++k) { wf[2 * k] = __uint_as_float(w[j][k] << 16); wf[2 * k + 1] = __uint_as_float(w[j][k] & 0xffff0000u); }
#pragma unroll
            for (int cv = 0; cv < 5; ++cv)
                *reinterpret_cast<u32x4*>(dst + (size_t)cv * N * D) = u32x4{pack_bf2(wf[0] * gg[cv][0], wf[1] * gg[cv][1]), pack_bf2(wf[2] * gg[cv][2], wf[3] * gg[cv][3]),
                                                                             pack_bf2(wf[4] * gg[cv][4], wf[5] * gg[cv][5]), pack_bf2(wf[6] * gg[cv][6], wf[7] * gg[cv][7])};
        }
    }
    for (int row = row0 + (tid >> 6); row < row0 + 32; row += 8) {
        const int which = row < 2048 ? 1 : 0, l = row < 1024 ? 0 : 1;
        const int n = row < 2048 ? (row & 1023) : row - 2048;
        const bf16_t* src = row < 2048 ? (const bf16_t*)(p.ws + OFF_WQ) + ((size_t)l * D + n) * D + lane * 16 : (const bf16_t*)(p.ws + OFF_WIN) + ((size_t)INW + n) * D + lane * 16;
        const u32x4 w0 = *reinterpret_cast<const u32x4*>(src), w1 = *reinterpret_cast<const u32x4*>(src + 8);
        float wf[16];
#pragma unroll
        for (int k = 0; k < 4; ++k) { wf[2 * k] = __uint_as_float(w0[k] << 16); wf[2 * k + 1] = __uint_as_float(w0[k] & 0xffff0000u);
                                      wf[8 + 2 * k] = __uint_as_float(w1[k] << 16); wf[8 + 2 * k + 1] = __uint_as_float(w1[k] & 0xffff0000u); }
#pragma unroll
        for (int cv = 0; cv < 5; ++cv) {
            const float* sh = MOD + (size_t)(l * 5 + cv) * 6144 + which * 3072 + lane * 16;
            float acc = 0.f;
#pragma unroll
            for (int q = 0; q < 4; ++q) {
                const float4 a = *reinterpret_cast<const float4*>(sh + q * 4);
                acc += wf[q * 4] * a.x + wf[q * 4 + 1] * a.y + wf[q * 4 + 2] * a.z + wf[q * 4 + 3] * a.w;
            }
            acc = wave_sum(acc);
            if (lane == 0) {
                if (row < 2048) ((float*)(p.ws + OFF_BQ))[(size_t)(l * 5 + cv) * D + n] = acc;
                else            ((float*)(p.ws + OFF_BIN))[(size_t)cv * INW + n] = acc;
            }
        }
    }
}
__device__ void ph_ush(const Params& p, unsigned char* ldsraw, const int wv) {
    const int tid = opaque_tid(wv);
    const int lane = tid & 63;
    const int gw = blockIdx.x * 8 + (tid >> 6), nw = gridDim.x * 8;
    const float* MOD = (const float*)(p.ws + OFF_MOD);
    {
        LAS signed char* s8 = (LAS signed char*)ldsraw;
        LAS float* s8s = (LAS float*)(ldsraw + 10 * 1024);
        const int wave = tid >> 6;
        for (int r = wave; r < 10; r += 8) {
            const float* sh = MOD + (size_t)r * 6144 + 3072 + lane * 16;
            float v[16];
#pragma unroll
            for (int q = 0; q < 4; ++q) { const float4 a = *reinterpret_cast<const float4*>(sh + q * 4); v[q * 4] = a.x; v[q * 4 + 1] = a.y; v[q * 4 + 2] = a.z; v[q * 4 + 3] = a.w; }
            float am = 0.f;
#pragma unroll
            for (int i = 0; i < 16; ++i) am = fmaxf(am, fabsf(v[i]));
            am = wave_max(am);
            const float sc = am > 0.f ? 127.f / am : 1.f;
            u32x4 w;
#pragma unroll
            for (int q = 0; q < 4; ++q) w[q] = pack4_i8(q8(v[q * 4] * sc), q8(v[q * 4 + 1] * sc), q8(v[q * 4 + 2] * sc), q8(v[q * 4 + 3] * sc));
            *(LAS u32x4*)(s8 + r * 1024 + lane * 16) = w;
            if (lane == 0) s8s[r] = am > 0.f ? am * (1.f / 127.f) : 1.f;
        }
        __syncthreads();
        const int fr = lane & 15, fq = lane >> 4;
        for (int task = gw; task < 2 * (NEXP / 16); task += nw) {
            const int l = task >> 10, e0 = (task & 1023) * 16;
            const unsigned char* up = p.ws + OFF_UT + ((size_t)l * 8 * NEXP + e0 + fr) * 128 + fq * 16;
            i32x4 acc = {0, 0, 0, 0};
#pragma unroll
            for (int st = 0; st < 16; ++st) {
                const i32x4 a = *reinterpret_cast<const i32x4*>(up + (size_t)(st >> 1) * NEXP * 128 + (st & 1) * 64);
                i32x4 b = {0, 0, 0, 0};
                if (fr < 5) b = *(const LAS i32x4*)(s8 + (l * 5 + fr) * 1024 + st * 64 + fq * 16);
                acc = __builtin_amdgcn_mfma_i32_16x16x64_i8(a, b, acc, 0, 0, 0);
            }
            if (fr < 5) {
                const float ss = s8s[l * 5 + fr];
#pragma unroll
                for (int r = 0; r < 4; ++r) {
                    const int e = e0 + fq * 4 + r;
                    { float* rec = (float*)(p.ws + OFF_USH) + ((size_t)l * NEXP + e) * 8; rec[2 + fr] = (float)acc[r] * ss * rec[0]; }
                }
            }
        }
        __syncthreads();
    }
}
__device__ void ph_norm_mod(const Params& p, int l, int which, int from_input, const int wv) {
    const int tid = opaque_tid(wv);
    const int lane = tid & 63;
    const int gw = blockIdx.x * 8 + (tid >> 6), nw = gridDim.x * 8;
    const float* g = p.in[which ? I_N2G : I_N1G] + l * D;
    if (from_input) {
        float4 nx[4];
        {
            const int t = gw < NTOK ? gw : NTOK - 1;
            const float* xr = x_in_row(p, t);
#pragma unroll
            for (int i = 0; i < 4; ++i) nx[i] = *reinterpret_cast<const float4*>(xr + i * 256 + lane * 4);
        }
        for (int t = gw; t < NTOK; t += nw) {
            float4 v[4];
#pragma unroll
            for (int i = 0; i < 4; ++i) v[i] = nx[i];
            {
                const int tn = t + nw < NTOK ? t + nw : t;
                const float* xn = x_in_row(p, tn);
#pragma unroll
                for (int i = 0; i < 4; ++i) nx[i] = *reinterpret_cast<const float4*>(xn + i * 256 + lane * 4);
            }
            const float* mod = (const float*)(p.ws + OFF_MOD) + (size_t)(l * 5 + tok_cv(t)) * 6144 + which * 3072;
            float ss = 0.f;
#pragma unroll
            for (int i = 0; i < 4; ++i) ss += v[i].x * v[i].x + v[i].y * v[i].y + v[i].z * v[i].z + v[i].w * v[i].w;
            ss = wave_sum(ss);
            float r = rsqrtf(ss / D + EPS);
            bf16_t* H = (bf16_t*)(p.ws + OFF_H) + (size_t)t * D;
#pragma unroll
            for (int i = 0; i < 4; ++i) {
                int c = i * 256 + lane * 4;
                float4 gg = *reinterpret_cast<const float4*>(g + c), sh = *reinterpret_cast<const float4*>(mod + c), sc = *reinterpret_cast<const float4*>(mod + 1024 + c);
                uint2 o;
                o.x = pack_bf2(v[i].x * r * gg.x * (1.f + sc.x) + sh.x, v[i].y * r * gg.y * (1.f + sc.y) + sh.y);
                o.y = pack_bf2(v[i].z * r * gg.z * (1.f + sc.z) + sh.z, v[i].w * r * gg.w * (1.f + sc.w) + sh.w);
                *reinterpret_cast<uint2*>(H + c) = o;
            }
        }
    } else {
        u32x4 nx[2];
        {
            const int t = gw < NTOK ? gw : NTOK - 1;
            const bf16_t* xr = (const bf16_t*)(p.ws + OFF_XC) + (size_t)t * D + lane * 8;
            nx[0] = *reinterpret_cast<const u32x4*>(xr); nx[1] = *reinterpret_cast<const u32x4*>(xr + 512);
        }
        for (int t = gw; t < NTOK; t += nw) {
            float v[16];
#pragma unroll
            for (int h = 0; h < 2; ++h)
#pragma unroll
                for (int k = 0; k < 4; ++k) { v[h * 8 + 2 * k] = __uint_as_float(nx[h][k] << 16); v[h * 8 + 2 * k + 1] = __uint_as_float(nx[h][k] & 0xffff0000u); }
            {
                const int tn = t + nw < NTOK ? t + nw : t;
                const bf16_t* xn = (const bf16_t*)(p.ws + OFF_XC) + (size_t)tn * D + lane * 8;
                nx[0] = *reinterpret_cast<const u32x4*>(xn); nx[1] = *reinterpret_cast<const u32x4*>(xn + 512);
            }
            const float* mod = (const float*)(p.ws + OFF_MOD) + (size_t)(l * 5 + tok_cv(t)) * 6144 + which * 3072;
            float ss = 0.f;
#pragma unroll
            for (int i = 0; i < 16; ++i) ss += v[i] * v[i];
            ss = wave_sum(ss);
            float r = rsqrtf(ss / D + EPS);
            bf16_t* H = (bf16_t*)(p.ws + OFF_H) + (size_t)t * D;
            float hq[16];
#pragma unroll
            for (int h = 0; h < 2; ++h) {
                const int c = h * 512 + lane * 8;
                float o[8];
#pragma unroll
                for (int q = 0; q < 2; ++q) {
                    const float4 gg = *reinterpret_cast<const float4*>(g + c + q * 4), sh = *reinterpret_cast<const float4*>(mod + c + q * 4), sc = *reinterpret_cast<const float4*>(mod + 1024 + c + q * 4);
                    o[q * 4] = v[h * 8 + q * 4] * r * gg.x * (1.f + sc.x) + sh.x; o[q * 4 + 1] = v[h * 8 + q * 4 + 1] * r * gg.y * (1.f + sc.y) + sh.y;
                    o[q * 4 + 2] = v[h * 8 + q * 4 + 2] * r * gg.z * (1.f + sc.z) + sh.z; o[q * 4 + 3] = v[h * 8 + q * 4 + 3] * r * gg.w * (1.f + sc.w) + sh.w;
                }
                *reinterpret_cast<u32x4*>(H + c) = u32x4{pack_bf2(o[0], o[1]), pack_bf2(o[2], o[3]), pack_bf2(o[4], o[5]), pack_bf2(o[6], o[7])};
#pragma unroll
                for (int q = 0; q < 8; ++q) hq[h * 8 + q] = o[q];
            }
            if (which) {
                float am = 0.f;
#pragma unroll
                for (int i = 0; i < 16; ++i) am = fmaxf(am, fabsf(hq[i]));
#pragma unroll
                for (int o2 = 32; o2 >= 1; o2 >>= 1) am = fmaxf(am, shfl_x(am, lane, o2));
                const float sc8 = am > 0.f ? 127.f / am : 1.f;
#pragma unroll
                for (int h = 0; h < 2; ++h) {
                    uint2 w;
                    w.x = pack4_i8(q8(hq[h * 8] * sc8), q8(hq[h * 8 + 1] * sc8), q8(hq[h * 8 + 2] * sc8), q8(hq[h * 8 + 3] * sc8));
                    w.y = pack4_i8(q8(hq[h * 8 + 4] * sc8), q8(hq[h * 8 + 5] * sc8), q8(hq[h * 8 + 6] * sc8), q8(hq[h * 8 + 7] * sc8));
                    *reinterpret_cast<uint2*>(p.ws + OFF_H8I + (size_t)t * D + h * 512 + lane * 8) = w;
                }
                if (lane == 0) ((float*)(p.ws + OFF_HSC))[t] = am > 0.f ? am * (1.f / 127.f) : 1.f;
            }
        }
    }
}
__device__ void ph_sgu_norm(const Params& p, int l, const int wv) {
    const int tid = opaque_tid(wv);
    const int lane = tid & 63;
    const int gw = blockIdx.x * 8 + (tid >> 6), nw = gridDim.x * 8;
    for (int t = gw; t < NTOK; t += nw) {
        const bf16_t* AV = (const bf16_t*)(p.ws + OFF_AV) + (size_t)t * 256;
        float v[4]; float ss = 0.f;
#pragma unroll
        for (int i = 0; i < 4; ++i) { v[i] = bf2f(AV[i * 64 + lane]); ss += v[i] * v[i]; }
        ss = wave_sum(ss);
        float r = rsqrtf(ss / 256.f + EPS);
#pragma unroll
        for (int i = 0; i < 4; ++i) ((bf16_t*)(p.ws + OFF_AVN))[(size_t)t * 256 + i * 64 + lane] = f2bf(v[i] * r * p.in[I_SGUNG][l * 256 + i * 64 + lane]);
    }
}
__device__ void ph_sgu_mix(const Params& p, int l, const int wv) {
    const int tid = opaque_tid(wv);
    const bf16_t* AVN = (const bf16_t*)(p.ws + OFF_AVN);
    for (size_t idx = GTID; idx < (size_t)NTOK * 256; idx += GNT) {
        int t = (int)(idx >> 8), c = (int)(idx & 255);
        int t0 = t & ~127, pp = t & 127, g = c >> 6;
        const bf16_t* W = (const bf16_t*)(p.ws + OFF_SGUW) + (((size_t)l * 4 + g) * 128 + pp) * 128;
        float acc = 0.f;
        for (int q = 0; q < 128; ++q) acc += bf2f(W[q]) * bf2f(AVN[(size_t)(t0 + q) * 256 + c]);
        acc += p.in[I_SGUB][(l * 4 + g) * 128 + pp];
        float au = bf2f(((const bf16_t*)(p.ws + OFF_AU))[(size_t)t * 256 + c]);
        ((bf16_t*)(p.ws + OFF_MIX))[(size_t)t * D + c] = f2bf(au * acc);
    }
}
__device__ void ph_attn_ref(const Params& p, int l, const int wv) {
    const int tid = opaque_tid(wv);
    const int lane = tid & 63;
    const int gw = blockIdx.x * 8 + (tid >> 6), nw = gridDim.x * 8;
    const float lam = lam_of(p, l);
    for (int item = gw; item < NTOK * 12; item += nw) {
        const int t = item % NTOK, hh = item / NTOK;
        const bool prompt = t < NPT;
        const int b = prompt ? t / SEQ : (t - NPT) / DSEQ;
        const int nk = prompt ? SEQ : NKS;
        if (hh < 4) {
            const int h = hh;
            const bf16_t* K = prompt ? (const bf16_t*)(p.ws + OFF_DKP) + ((size_t)b * 4 + h) * SEQ * 64 : (const bf16_t*)(p.ws + OFF_DKS) + ((size_t)b * 4 + h) * NKS * 64;
            const bf16_t* Vt = prompt ? (const bf16_t*)(p.ws + OFF_DVTP) + ((size_t)b * 4 + h) * 64 * SEQ : (const bf16_t*)(p.ws + OFF_DVTS) + ((size_t)b * 4 + h) * 64 * NKS;
            float q = bf2f(((const bf16_t*)(p.ws + OFF_DQ))[(size_t)t * 256 + h * 64 + lane]);
            const float scale = 0.17677669529663687f;
            float m0 = -1e30f, m1 = -1e30f, l0 = 0.f, l1 = 0.f, a0 = 0.f, a1 = 0.f;
            for (int k = 0; k < nk; ++k) {
                float pr = q * bf2f(K[(size_t)k * 64 + lane]);
#pragma unroll
                for (int o = 16; o >= 1; o >>= 1) pr += shfl_x(pr, lane, o);
                float s0 = shfl_i(pr, 0) * scale, s1 = shfl_i(pr, 32) * scale;
                float v = bf2f(Vt[(size_t)lane * nk + k]);
                float mn0 = fmaxf(m0, s0), mn1 = fmaxf(m1, s1);
                float c0 = expf(m0 - mn0), c1 = expf(m1 - mn1);
                float e0 = expf(s0 - mn0), e1 = expf(s1 - mn1);
                l0 = l0 * c0 + e0; l1 = l1 * c1 + e1;
                a0 = a0 * c0 + e0 * v; a1 = a1 * c1 + e1 * v;
                m0 = mn0; m1 = mn1;
            }
            float o = a0 / l0 - lam * a1 / l1;
            float ss = wave_sum(o * o);
            float r = rsqrtf(ss / 64.f + EPS);
            o = o * r * p.in[I_SUBLN][l * 64 + lane] * (1.f - lam_init_of(l));
            ((bf16_t*)(p.ws + OFF_MIX))[(size_t)t * D + 256 + h * 64 + lane] = f2bf(o);
        } else {
            const int hq = hh - 4, kv = hq >> 2;
            const bf16_t* K = prompt ? (const bf16_t*)(p.ws + OFF_GKP) + ((size_t)b * 2 + kv) * SEQ * 64 : (const bf16_t*)(p.ws + OFF_GKS) + ((size_t)b * 2 + kv) * NKS * 64;
            const bf16_t* Vt = prompt ? (const bf16_t*)(p.ws + OFF_GVTP) + ((size_t)b * 2 + kv) * 64 * SEQ : (const bf16_t*)(p.ws + OFF_GVTS) + ((size_t)b * 2 + kv) * 64 * NKS;
            float q = bf2f(((const bf16_t*)(p.ws + OFF_GQ))[(size_t)t * 512 + hq * 64 + lane]);
            float m = -1e30f, ls = 0.f, a = 0.f;
            for (int k = 0; k < nk; ++k) {
                float s = wave_sum(q * bf2f(K[(size_t)k * 64 + lane])) * 0.125f;
                float v = bf2f(Vt[(size_t)lane * nk + k]);
                float mn = fmaxf(m, s);
                float c = expf(m - mn), e = expf(s - mn);
                ls = ls * c + e; a = a * c + e * v; m = mn;
            }
            ((bf16_t*)(p.ws + OFF_MIX))[(size_t)t * D + 512 + hq * 64 + lane] = f2bf(a / ls);
        }
    }
}
__device__ void ph_peer_scores(const Params& p, int l, const int wv) {
    const int tid = opaque_tid(wv);
    const bf16_t* SK = (const bf16_t*)(p.ws + OFF_SUBK) + (size_t)l * 2 * 128 * 64;
    for (size_t idx = GTID; idx < (size_t)NTOK * 2048; idx += GNT) {
        int t = (int)(idx >> 11), o = (int)(idx & 2047);
        const bf16_t* Q = (const bf16_t*)(p.ws + OFF_Q) + (size_t)t * D;
        int n = o & 127, x = (o >> 7) & 1, h = o >> 8;
        float acc = 0.f;
        for (int k = 0; k < 64; ++k) acc += bf2f(Q[h * 128 + x * 64 + k]) * bf2f(SK[((size_t)x * 128 + n) * 64 + k]);
        ((float*)(p.ws + OFF_PROJ))[idx] = acc;
    }
}
__device__ void ph_peer_top1(const Params& p, const int wv) {
    const int tid = opaque_tid(wv);
    for (size_t idx = GTID; idx < (size_t)NTOK * 16; idx += GNT) {
        const float* SC = (const float*)(p.ws + OFF_PROJ) + idx * 128;
        float* TV = (float*)(p.ws + OFF_TOPV) + idx * 16; int* TI = (int*)(p.ws + OFF_TOPI) + idx * 16;
        float pv = 3.0e38f; int pi = -1;
        for (int r = 0; r < 16; ++r) {
            float bv = -3.0e38f; int bi = -1;
            for (int n = 0; n < 128; ++n) {
                float v = SC[n];
                bool after = (v < pv) || (v == pv && n > pi);
                if (after && (bi < 0 || v > bv)) { bv = v; bi = n; }
            }
            TV[r] = bv; TI[r] = bi; pv = bv; pi = bi;
        }
    }
}
__device__ void ph_peer_top2(const Params& p, const int wv) {
    const int tid = opaque_tid(wv);
    for (size_t idx = GTID; idx < (size_t)NTOK * 8; idx += GNT) {
        const float* TV = (const float*)(p.ws + OFF_TOPV) + idx * 32; const int* TI = (const int*)(p.ws + OFF_TOPI) + idx * 32;
        int* EI = (int*)(p.ws + OFF_EIDX) + idx * 16; float* EG = (float*)(p.ws + OFF_EGATE) + idx * 16;
        float pv = 3.0e38f; int pi = -1; float mx = 0.f, sum = 0.f;
        for (int r = 0; r < 16; ++r) {
            float bv = -3.0e38f; int bi = -1;
            for (int n = 0; n < 256; ++n) {
                float v = TV[n >> 4] + TV[16 + (n & 15)];
                bool after = (v < pv) || (v == pv && n > pi);
                if (after && (bi < 0 || v > bv)) { bv = v; bi = n; }
            }
            if (r == 0) mx = bv;
            float e = expf(bv - mx);
            sum += e;
            EG[r] = e; EI[r] = TI[bi >> 4] * 128 + TI[16 + (bi & 15)];
            pv = bv; pi = bi;
        }
        float inv = 1.f / sum;
        for (int r = 0; r < 16; ++r) EG[r] *= inv;
    }
}
__device__ void ph_peer_apply(const Params& p, int l, unsigned char* lds, const int wv) {
    const int tid = opaque_tid(wv);
    const int sub = tid >> 8, tl = tid & 255;
    const int wave = tl >> 6, lane = tl & 63;
    float* wts = (float*)(lds + 64) + sub * 128; int* eid = (int*)(lds + 64 + 1024) + sub * 128;
    const bf16_t* UT = (const bf16_t*)(p.ws + OFF_UT) + (size_t)l * NEXP * D;
    const bf16_t* VT = (const bf16_t*)(p.ws + OFF_VT) + (size_t)l * NEXP * D;
    const int niter = (NTOK + gridDim.x * 2 - 1) / (gridDim.x * 2);
    for (int it = 0; it < niter; ++it) {
        int t = (it * gridDim.x + blockIdx.x) * 2 + sub;
        const bool valid = t < NTOK; if (!valid) t = NTOK - 1;
        const bf16_t* H = (const bf16_t*)(p.ws + OFF_H) + (size_t)t * D;
        const int* EI = (const int*)(p.ws + OFF_EIDX) + (size_t)t * 128; const float* EG = (const float*)(p.ws + OFF_EGATE) + (size_t)t * 128;
        float hv[16];
#pragma unroll
        for (int i = 0; i < 16; ++i) hv[i] = bf2f(H[lane * 16 + i]);
        for (int jj = 0; jj < 32; ++jj) {
            int j = wave * 32 + jj; int e = EI[j];
            const bf16_t* ur = UT + (size_t)e * D + lane * 16;
            float acc = 0.f;
#pragma unroll
            for (int i = 0; i < 16; ++i) acc += hv[i] * bf2f(ur[i]);
            acc = wave_sum(acc);
            if (lane == 0) { wts[j] = EG[j] * gelu_f(acc); eid[j] = e; }
        }
        __syncthreads();
        float o[4] = {0.f, 0.f, 0.f, 0.f};
        for (int j = 0; j < 128; ++j) {
            const bf16_t* vr = VT + (size_t)eid[j] * D + tl * 4; float w = wts[j];
#pragma unroll
            for (int i = 0; i < 4; ++i) o[i] += w * bf2f(vr[i]);
        }
        const float* mod = (const float*)(p.ws + OFF_MOD) + (size_t)(l * 5 + tok_cv(t)) * 6144 + 5 * 1024;
        float* XC = (float*)(p.ws + OFF_XC) + (size_t)t * D;
        if (valid) {
#pragma unroll
            for (int i = 0; i < 4; ++i) { int c = tl * 4 + i; XC[c] += mod[c] * o[i]; }
        }
        __syncthreads();
    }
}
__device__ void ph_final_norm(const Params& p, const int wv) {
    const int tid = opaque_tid(wv);
    const int lane = tid & 63;
    const int gw = blockIdx.x * 8 + (tid >> 6), nw = gridDim.x * 8;
    u32x4 nx[2];
    {
        const int t = gw < NTOK ? gw : NTOK - 1;
        const bf16_t* xr = (const bf16_t*)(p.ws + OFF_XC) + (size_t)t * D + lane * 8;
        nx[0] = *reinterpret_cast<const u32x4*>(xr); nx[1] = *reinterpret_cast<const u32x4*>(xr + 512);
    }
    for (int t = gw; t < NTOK; t += nw) {
        float v[16];
#pragma unroll
        for (int h = 0; h < 2; ++h)
#pragma unroll
            for (int k = 0; k < 4; ++k) { v[h * 8 + 2 * k] = __uint_as_float(nx[h][k] << 16); v[h * 8 + 2 * k + 1] = __uint_as_float(nx[h][k] & 0xffff0000u); }
        {
            const int tn = t + nw < NTOK ? t + nw : t;
            const bf16_t* xn = (const bf16_t*)(p.ws + OFF_XC) + (size_t)tn * D + lane * 8;
            nx[0] = *reinterpret_cast<const u32x4*>(xn); nx[1] = *reinterpret_cast<const u32x4*>(xn + 512);
        }
        float ss = 0.f;
#pragma unroll
        for (int i = 0; i < 16; ++i) ss += v[i] * v[i];
        ss = wave_sum(ss);
        float r = rsqrtf(ss / D + EPS);
        float* y = p.out + (size_t)t * D;
#pragma unroll
        for (int h = 0; h < 2; ++h) {
            const int c = h * 512 + lane * 8;
#pragma unroll
            for (int q = 0; q < 2; ++q) {
                const float4 g = *reinterpret_cast<const float4*>(p.in[I_FG] + c + q * 4);
                *reinterpret_cast<float4*>(y + c + q * 4) = make_float4(v[h * 8 + q * 4] * r * g.x, v[h * 8 + q * 4 + 1] * r * g.y, v[h * 8 + q * 4 + 2] * r * g.z, v[h * 8 + q * 4 + 3] * r * g.w);
            }
        }
    }
}


namespace g8 {
constexpr int BM = 256, BK = 64, HALF = 128, HT = HALF * BK;
__device__ __forceinline__ int lds_byte(int r, int c) {
    int st = (r >> 4) * 2 + (c >> 5), rr = r & 15, cc = c & 31, ob = rr * 64 + cc * 2;
    return st * 1024 + (ob ^ (((ob >> 9) & 1) << 5));
}
__device__ __forceinline__ void stage_rc(int b, int& R, int& C) {
    int st = b / 1024, sb = b % 1024, swz = sb ^ (((sb >> 9) & 1) << 5);
    R = (st >> 1) * 16 + swz / 64; C = (st & 1) * 32 + (swz % 64) / 2;
}
}
enum { EPI_INPROJ = 0, EPI_WOUT = 1, EPI_WQ = 2 };
constexpr int STG = 132;

__device__ __forceinline__ void store_bf16x32(bf16_t* dst, const float (&v)[32]) {
#pragma unroll
    for (int i = 0; i < 4; ++i) {
        uint4 u;
        u.x = pack_bf2(v[i * 8 + 0], v[i * 8 + 1]); u.y = pack_bf2(v[i * 8 + 2], v[i * 8 + 3]);
        u.z = pack_bf2(v[i * 8 + 4], v[i * 8 + 5]); u.w = pack_bf2(v[i * 8 + 6], v[i * 8 + 7]);
        *reinterpret_cast<uint4*>(dst + i * 8) = u;
    }
}
__device__ __forceinline__ void store_f32x32(float* dst, const float (&v)[32]) {
#pragma unroll
    for (int i = 0; i < 8; ++i) *reinterpret_cast<float4*>(dst + i * 4) = make_float4(v[i * 4], v[i * 4 + 1], v[i * 4 + 2], v[i * 4 + 3]);
}

__device__ __forceinline__ void epi_inproj_xform(const Params& p, int l, int t, int c0, float (&v)[32]) {
    const bool prompt = t < NPT;
    const int s = prompt ? (t & 255) : ((t - NPT) & 2047);
    const float* R = (const float*)(p.ws + OFF_ROPE);
    if (c0 < 512) {
#pragma unroll
        for (int i = 0; i < 32; ++i) v[i] = gelu_f(v[i]);
    } else if (c0 < 1024) {
        if (!prompt) {
            const float* cs = R + s * 16; const float* sn = R + 2048 * 16 + s * 16;
#pragma unroll
            for (int i = 0; i < 16; ++i) {
                float c = cs[i], sv = sn[i], x1 = v[i], x2 = v[i + 16];
                v[i] = x1 * c - x2 * sv; v[i + 16] = x2 * c + x1 * sv;
            }
        }
    } else if (c0 >= 1280 && c0 < 1920) {
        const bool isq = c0 < 1792;
        const int hi = c0 & 32;
        const float* g = p.in[isq ? I_QNG : I_KNG] + l * 64 + hi;
        float ss = 0.f;
#pragma unroll
        for (int i = 0; i < 32; ++i) ss += v[i] * v[i];
        const int ln = lane_id_op();
        ss += DPP_F(ss, 0xB1);
        const float rr = rsqrtf(ss * (1.f / 64.f) + EPS);
#pragma unroll
        for (int i = 0; i < 32; ++i) v[i] = v[i] * rr * g[i];
        if (!prompt) {
            const float* cs = R + 2048 * 32 + s * 32; const float* sn = R + 2048 * 64 + s * 32;
#pragma unroll
            for (int i = 0; i < 32; ++i) {
                float pv = DPP_F(v[i], 0xB1);
                float c = cs[i], sv = sn[i];
                v[i] = hi ? (v[i] * c + pv * sv) : (v[i] * c - pv * sv);
            }
        }
        if (isq) {
#pragma unroll
            for (int i = 0; i < 32; ++i) v[i] *= 0.125f * 1.4426950408889634f;
        }
    }
}
__device__ __forceinline__ void epi_inproj_col(const Params& p, int t0, int c, const LAS float* stc) {
    float v[32];
#pragma unroll
    for (int i = 0; i < 32; ++i) v[i] = stc[i * STG];
    const bool prompt = t0 < NPT;
    const int b = prompt ? (t0 >> 8) : ((t0 - NPT) >> 11);
    const int s = prompt ? (t0 & 255) : ((t0 - NPT) & 2047);
    unsigned char* ws = p.ws;
    bf16_t* dst;
    if (c < 1280) {
        const int cc = c - 1024, h = cc >> 6, d = cc & 63;
        dst = prompt ? (bf16_t*)(ws + OFF_DVTP) + (((size_t)b * 4 + h) * 64 + d) * SEQ + s
                     : (bf16_t*)(ws + OFF_DVTS) + (((size_t)b * 4 + h) * 64 + d) * NKS + s;
    } else {
        const int cc = c - 1920, kv = cc >> 6, d = cc & 63;
        dst = prompt ? (bf16_t*)(ws + OFF_GVTP) + (((size_t)b * 2 + kv) * 64 + d) * SEQ + s
                     : (bf16_t*)(ws + OFF_GVTS) + (((size_t)b * 2 + kv) * 64 + d) * NKS + s;
    }
    store_bf16x32(dst, v);
}

template <int MODE>
__device__ __forceinline__ void gemm_phase(const Params& p, int l, const bf16_t* __restrict__ A, const bf16_t* __restrict__ Bt, const int N, unsigned char* ldsraw, const int wv,
                                           const size_t cvstride = 0, const float* __restrict__ RSS = nullptr, const float* __restrict__ BIAS = nullptr) {
    using namespace g8;
    constexpr int K = 1024, nt = K / BK, BN = 128, TILE_A = BM * BK * 2, TILE_B = BN * BK * 2, STAGE_B = TILE_A + TILE_B;
    LAS unsigned char* lds = (LAS unsigned char*)ldsraw;
    const int tid = opaque_tid(wv), wid = wv, lane = tid & 63;
    const int wr = wid >> 1, wc = wid & 1, fr = lane & 15, fq = lane >> 4;
    unsigned voff[4];
#pragma unroll
    for (int i = 0; i < 4; ++i) voff[i] = (unsigned)((i * 64 + wid * 8 + (lane >> 3)) * K + (((lane & 7) ^ (lane >> 3)) * 8)) * 2u;
    const int aoff = (wr * 64 + fr) * 128 + ((fq ^ (fr & 7)) * 16), boff = (wc * 64 + fr) * 128 + ((fq ^ (fr & 7)) * 16);
    const unsigned ldsw = (unsigned)wid * 1024u;
#define G8_STAGE(buf, kt) do { \
        _Pragma("unroll") for (int _i = 0; _i < 4; ++_i) \
            __builtin_amdgcn_global_load_lds((const unsigned*)((const char*)(Ab + (kt) * BK) + voff[_i]), (LAS unsigned*)(lds + (buf) * STAGE_B + ldsw + _i * 8192), 16, 0, 0); \
        _Pragma("unroll") for (int _i = 0; _i < 2; ++_i) \
            __builtin_amdgcn_global_load_lds((const unsigned*)((const char*)(Bb + (kt) * BK) + voff[_i]), (LAS unsigned*)(lds + (buf) * STAGE_B + TILE_A + ldsw + _i * 8192), 16, 0, 0); } while (0)
#define G8_WAIT_V0() asm volatile("s_waitcnt vmcnt(0)" ::: "memory")
    const int nN = N / BN, nM = NTOK / BM, ntiles = nM * nN;
    const int G = gridDim.x;
    const int vb = (G % 8 == 0) ? (int)(blockIdx.x % 8) * (G / 8) + (int)(blockIdx.x / 8) : (int)blockIdx.x;
    const int tpb = (ntiles + G - 1) / G;
    const bool paneled = (G == 256) && (nN == 8 || nN == 16) && (nM == 64);
    for (int ti = 0; ti < tpb; ++ti) {
        int tile = vb * tpb + ti;
        if (paneled) {
            const int x = vb >> 5, j = vb & 31;
            const int mpx = nN == 16 ? 16 : 8;
            const int m0 = nN == 16 ? (x >> 1) * 16 : x * 8, n0 = nN == 16 ? (x & 1) * 8 : 0;
            const int pm_ = m0 + ti * 4 + (j >> 3), pn_ = n0 + (j & 7);
            tile = (ti * 4 < mpx) ? pm_ * nN + pn_ : ntiles;
        }
        if (tile >= ntiles) break;
        const int pm = tile / nN, pn = tile % nN, brow = pm * BM, bcol = pn * BN;
        const bf16_t* Ab = A + (size_t)brow * K; const bf16_t* Bb = Bt + (size_t)tok_cv(brow) * cvstride + (size_t)bcol * K;
        f32x4 acc[4][4];
#pragma unroll
        for (int m = 0; m < 4; ++m)
#pragma unroll
            for (int n = 0; n < 4; ++n) acc[m][n] = f32x4{0.f, 0.f, 0.f, 0.f};
        G8_WAIT_V0();
        float4 rsa = make_float4(0.f, 0.f, 0.f, 0.f), rsb = rsa; float bz[4] = {0.f, 0.f, 0.f, 0.f};
        if (MODE != EPI_WOUT && cvstride != 0) {
            const float* rp = RSS + (size_t)(brow + (tid & 255)) * 8;
            rsa = *reinterpret_cast<const float4*>(rp); rsb = *reinterpret_cast<const float4*>(rp + 4);
#pragma unroll
            for (int n = 0; n < 4; ++n) bz[n] = BIAS[(size_t)tok_cv(brow) * N + bcol + wc * 64 + n * 16 + fr];
        }
        G8_STAGE(0, 0); G8_STAGE(1, 1);
        int cur = 0;
        for (int t = 0; t < nt; ++t) {
            if (t + 1 < nt) asm volatile("s_waitcnt vmcnt(6)" ::: "memory"); else asm volatile("s_waitcnt vmcnt(0)" ::: "memory");
            __builtin_amdgcn_s_barrier();
            if (t + 2 < nt) { const int nb = cur >= 1 ? cur - 1 : 2; G8_STAGE(nb, t + 2); }
            {
                bf16x8 At[2][4], Bf[2][4];
#pragma unroll
                for (int ks = 0; ks < 2; ++ks) {
#pragma unroll
                    for (int m = 0; m < 4; ++m) At[ks][m] = *(const LAS bf16x8*)(lds + cur * STAGE_B + ((aoff + m * 2048) ^ (ks * 64)));
#pragma unroll
                    for (int n = 0; n < 4; ++n) Bf[ks][n] = *(const LAS bf16x8*)(lds + cur * STAGE_B + TILE_A + ((boff + n * 2048) ^ (ks * 64)));
                }
                __builtin_amdgcn_sched_barrier(0);
#pragma unroll
                for (int ks = 0; ks < 2; ++ks)
#pragma unroll
                    for (int m = 0; m < 4; ++m)
#pragma unroll
                        for (int n = 0; n < 4; ++n) acc[m][n] = __builtin_amdgcn_mfma_f32_16x16x32_bf16(At[ks][m], Bf[ks][n], acc[m][n], 0, 0, 0);
                __builtin_amdgcn_sched_barrier(0);
            }
            cur = cur == 2 ? 0 : cur + 1;
        }
        __syncthreads();
        LAS float* st = (LAS float*)lds;
        if (MODE != EPI_WOUT && cvstride != 0) {
            LAS float* rs = st + 256 * STG;
            if (tid < 256) rs[tid] = rsqrtf((((rsa.x + rsa.y) + (rsa.z + rsa.w)) + ((rsb.x + rsb.y) + (rsb.z + rsb.w))) * (1.f / D) + EPS);
            __syncthreads();
#pragma unroll
            for (int m = 0; m < 4; ++m)
#pragma unroll
                for (int j = 0; j < 4; ++j) {
                    const float r = rs[wr * 64 + m * 16 + fq * 4 + j];
#pragma unroll
                    for (int n = 0; n < 4; ++n) st[(wr * 64 + m * 16 + fq * 4 + j) * STG + wc * 64 + n * 16 + fr] = acc[m][n][j] * r + bz[n];
                }
        } else {
#pragma unroll
        for (int m = 0; m < 4; ++m)
#pragma unroll
            for (int n = 0; n < 4; ++n)
#pragma unroll
                for (int j = 0; j < 4; ++j)
                    st[(wr * 64 + m * 16 + fq * 4 + j) * STG + wc * 64 + n * 16 + fr] = acc[m][n][j];
        }
        __syncthreads();
        const bool tprompt = brow < NPT;
        const int tb_ = tprompt ? (brow >> 8) : ((brow - NPT) >> 11), ts0 = tprompt ? 0 : ((brow - NPT) & 2047);
        if (MODE == EPI_INPROJ) {
            const bool vtile = (bcol >= 1024 && bcol < 1280);
            if (!vtile) {
#pragma unroll 1
                for (int it = 0; it < 2; ++it) {
                    const int item = it * NT + tid, erow = item >> 2, eseg = item & 3;
                    float v[32];
#pragma unroll
                    for (int i = 0; i < 8; ++i) {
                        const f32x4 f = *(const LAS f32x4*)(st + erow * STG + eseg * 32 + i * 4);
                        v[i * 4] = f[0]; v[i * 4 + 1] = f[1]; v[i * 4 + 2] = f[2]; v[i * 4 + 3] = f[3];
                    }
                    epi_inproj_xform(p, l, brow + erow, bcol + eseg * 32, v);
#pragma unroll
                    for (int i = 0; i < 8; ++i) *(LAS f32x4*)(st + erow * STG + eseg * 32 + i * 4) = f32x4{v[i * 4], v[i * 4 + 1], v[i * 4 + 2], v[i * 4 + 3]};
                }
                __syncthreads();
#pragma unroll 1
                for (int it = 0; it < 8; ++it) {
                    const int item = it * NT + tid, r = item >> 4, c = (item & 15) * 8;
                    const f32x4 f0 = *(const LAS f32x4*)(st + r * STG + c), f1 = *(const LAS f32x4*)(st + r * STG + c + 4);
                    const int t = brow + r, sp = ts0 + r;
                    bf16_t* dst;
                    if (bcol < 512)        dst = (bf16_t*)(p.ws + (bcol < 256 ? OFF_AU : OFF_AV)) + (size_t)t * 256 + (bcol & 255) + c;
                    else if (bcol < 768)   dst = (bf16_t*)(p.ws + OFF_DQ) + (size_t)t * 256 + (bcol - 512) + c;
                    else if (bcol < 1024) { const int cc = bcol - 768 + c, h = cc >> 6;
                                            dst = tprompt ? (bf16_t*)(p.ws + OFF_DKP) + (((size_t)tb_ * 4 + h) * SEQ + sp) * 64 + (cc & 63)
                                                          : (bf16_t*)(p.ws + OFF_DKS) + (((size_t)tb_ * 4 + h) * NKS + sp) * 64 + (cc & 63); }
                    else if (bcol < 1792)  dst = (bf16_t*)(p.ws + OFF_GQ) + (size_t)t * 512 + (bcol - 1280) + c;
                    else                 { const int kv = c >> 6, d0 = c & 63;
                                            const size_t hb = (tprompt ? ((size_t)tb_ * 2 + kv) * SEQ * 64 : ((size_t)tb_ * 2 + kv) * NKS * 64) + (size_t)(sp >> 6) * 4096;
                                            dst = bcol < 1920 ? (bf16_t*)(p.ws + (tprompt ? OFF_GKP : OFF_GKS)) + hb + (d0 >> 3) * 512 + (sp & 63) * 8
                                                              : (bf16_t*)(p.ws + (tprompt ? OFF_GVTP : OFF_GVTS)) + hb + (d0 >> 5) * 2048 + (sp & 63) * 32 + (d0 & 31); }
                    *reinterpret_cast<u32x4*>(dst) = u32x4{pack_bf2(f0[0], f0[1]), pack_bf2(f0[2], f0[3]), pack_bf2(f1[0], f1[1]), pack_bf2(f1[2], f1[3])};
                }
            }
            if (tprompt && ((bcol >= 768 && bcol < 1280) || bcol >= 1792)) {
                float* ob; int rs;
                if (bcol < 1024)      { ob = p.out + OUT_NDK + (((size_t)tb_ * 2 + l) * SEQ) * 256 + (bcol - 768);  rs = 256; }
                else if (bcol < 1280) { ob = p.out + OUT_NDV + (((size_t)tb_ * 2 + l) * SEQ) * 256 + (bcol - 1024); rs = 256; }
                else if (bcol < 1920) { ob = p.out + OUT_NGK + (((size_t)tb_ * 2 + l) * SEQ) * 128;                 rs = 128; }
                else                  { ob = p.out + OUT_NGV + (((size_t)tb_ * 2 + l) * SEQ) * 128;                 rs = 128; }
#pragma unroll 1
                for (int it = 0; it < 16; ++it) {
                    const int item = it * NT + tid, r = item >> 5, c = (item & 31) * 4;
                    *reinterpret_cast<f32x4*>(ob + (size_t)r * rs + c) = *(const LAS f32x4*)(st + r * STG + c);
                }
            }
            if (vtile) {
#pragma unroll 1
                for (int it = 0; it < 2; ++it) {
                    const int item = it * NT + tid, col = item >> 3, run = item & 7;
                    epi_inproj_col(p, brow + run * 32, bcol + col, st + run * 32 * STG + col);
                }
            }
        } else {
            float4 ga = make_float4(0.f, 0.f, 0.f, 0.f), gb = ga, na = ga, nb = ga, sa = ga, sb = ga;
            float4 xna = ga, xnb = ga; u32x4 xnw = {0u, 0u, 0u, 0u};
            if (MODE == EPI_WOUT) {
                const int c = (tid & 15) * 8;
                const float* g1 = (const float*)(p.ws + OFF_MOD) + (size_t)(l * 5 + tok_cv(brow)) * 6144 + 2048 + bcol + c;
                ga = *reinterpret_cast<const float4*>(g1); gb = *reinterpret_cast<const float4*>(g1 + 4);
                sa = *reinterpret_cast<const float4*>(g1 + 2048); sb = *reinterpret_cast<const float4*>(g1 + 2048 + 4);
                const float* gn = p.in[I_N2G] + l * D + bcol + c;
                na = *reinterpret_cast<const float4*>(gn); nb = *reinterpret_cast<const float4*>(gn + 4);
                const int t = brow + (tid >> 4);
                if (l == 0) { const float* xr = x_in_row(p, t) + bcol + c; xna = *reinterpret_cast<const float4*>(xr); xnb = *reinterpret_cast<const float4*>(xr + 4); }
                else xnw = *reinterpret_cast<const u32x4*>((const bf16_t*)(p.ws + OFF_XC) + (size_t)t * D + bcol + c);
            }
#pragma unroll 1
            for (int it = 0; it < 8; ++it) {
                const int item = it * NT + tid, r = item >> 4, c = (item & 15) * 8;
                const f32x4 f0 = *(const LAS f32x4*)(st + r * STG + c), f1 = *(const LAS f32x4*)(st + r * STG + c + 4);
                const int t = brow + r;
                float o[8] = {f0[0], f0[1], f0[2], f0[3], f1[0], f1[1], f1[2], f1[3]};
                if (MODE == EPI_WOUT) {
                    float x[8];
                    if (l == 0) { x[0] = xna.x; x[1] = xna.y; x[2] = xna.z; x[3] = xna.w; x[4] = xnb.x; x[5] = xnb.y; x[6] = xnb.z; x[7] = xnb.w; }
                    else {
#pragma unroll
                        for (int k = 0; k < 4; ++k) { x[2 * k] = __uint_as_float(xnw[k] << 16); x[2 * k + 1] = __uint_as_float(xnw[k] & 0xffff0000u); }
                    }
                    {
                        const int tn = brow + (((it < 7 ? it + 1 : it) * NT + tid) >> 4);
                        if (l == 0) { const float* xr = x_in_row(p, tn) + bcol + c; xna = *reinterpret_cast<const float4*>(xr); xnb = *reinterpret_cast<const float4*>(xr + 4); }
                        else xnw = *reinterpret_cast<const u32x4*>((const bf16_t*)(p.ws + OFF_XC) + (size_t)tn * D + bcol + c);
                    }
                    o[0] = x[0] + ga.x * o[0]; o[1] = x[1] + ga.y * o[1]; o[2] = x[2] + ga.z * o[2]; o[3] = x[3] + ga.w * o[3];
                    o[4] = x[4] + gb.x * o[4]; o[5] = x[5] + gb.y * o[5]; o[6] = x[6] + gb.z * o[6]; o[7] = x[7] + gb.w * o[7];
                    float xg[8] = {o[0] * na.x * (1.f + sa.x), o[1] * na.y * (1.f + sa.y), o[2] * na.z * (1.f + sa.z), o[3] * na.w * (1.f + sa.w),
                                   o[4] * nb.x * (1.f + sb.x), o[5] * nb.y * (1.f + sb.y), o[6] * nb.z * (1.f + sb.z), o[7] * nb.w * (1.f + sb.w)};
                    float ss = 0.f, am = 0.f;
#pragma unroll
                    for (int i = 0; i < 8; ++i) { ss += o[i] * o[i]; am = fmaxf(am, fabsf(xg[i])); }
                    ss = row16_sum(ss); am = row16_max(am);
                    const float sc8 = am > 0.f ? 127.f / am : 1.f;
                    uint2 w8;
                    w8.x = pack4_i8(q8(xg[0] * sc8), q8(xg[1] * sc8), q8(xg[2] * sc8), q8(xg[3] * sc8));
                    w8.y = pack4_i8(q8(xg[4] * sc8), q8(xg[5] * sc8), q8(xg[6] * sc8), q8(xg[7] * sc8));
                    *reinterpret_cast<uint2*>(p.ws + OFF_H8I + (size_t)t * D + bcol + c) = w8;
                    if ((item & 15) == 0) {
                        ((float*)(p.ws + OFF_RSS2))[((size_t)l * NTOK + t) * 8 + pn] = ss;
                        ((float*)(p.ws + OFF_XGS))[(size_t)t * 8 + pn] = am > 0.f ? am * (1.f / 127.f) : 1.f;
                    }
                }
                bf16_t* dst = (bf16_t*)(p.ws + (MODE == EPI_WOUT ? OFF_XC : OFF_Q)) + (size_t)t * D + bcol + c;
                *reinterpret_cast<u32x4*>(dst) = u32x4{pack_bf2(o[0], o[1]), pack_bf2(o[2], o[3]), pack_bf2(o[4], o[5]), pack_bf2(o[6], o[7])};
            }
        }
        __syncthreads();
    }
}


template <int MODE>
__device__ __forceinline__ void gemm_phase2(const Params& p, int l_in, const bf16_t* __restrict__ A_in, const bf16_t* __restrict__ Bt_in, const int N, unsigned char* ldsraw, const int wv,
                                            const size_t cvstride = 0, const float* __restrict__ RSS_in = nullptr, const float* __restrict__ BIAS_in = nullptr) {
    using namespace g8;
    int l = l_in; asm volatile("" : "+s"(l));
    const bf16_t* A = A_in; const bf16_t* Bt = Bt_in; const float* RSS = RSS_in; const float* BIAS = BIAS_in;
    asm volatile("" : "+s"(A), "+s"(Bt), "+s"(RSS), "+s"(BIAS));
    constexpr int K = 1024, nt = K / BK, HTB = HALF * BK * 2;
    LAS unsigned char* lds = (LAS unsigned char*)ldsraw;
    const int tid = opaque_tid(wv), wid = wv, lane = tid & 63;
    const int wr = wid >> 2, wc = wid & 3, fr = lane & 15, fq = lane >> 4;
    unsigned voffA[2];
#pragma unroll
    for (int i = 0; i < 2; ++i) { int R, C; stage_rc(tid * 16 + i * 8192, R, C); voffA[i] = (unsigned)(R * K + C) * 2u; }
    constexpr size_t kstep = (size_t)(BK * 2), hstep = (size_t)HALF * K * 2, tstep = 2 * hstep;
    const unsigned ldsw = (unsigned)wid * 1024u;
    const int aoff = lds_byte(wr * 64 + fr, fq * 8), boff = lds_byte(wc * 32 + fr, fq * 8);
#define PG8_SA(b, h) (((b) * 2 + (h)) * HTB)
#define PG8_SB(b, h) ((4 + (b) * 2 + (h)) * HTB)
#define PG8_STAGE(bufoff, gbase) do { _Pragma("unroll") for (int _i = 0; _i < 2; ++_i) \
        __builtin_amdgcn_global_load_lds((const unsigned*)((const char*)(gbase) + voffA[_i]), (LAS unsigned*)(lds + (bufoff) + ldsw + _i * 8192), 16, 0, 0); } while (0)
#define PG8_LDA(dst, b, h) do { _Pragma("unroll") for (int m = 0; m < 4; ++m) _Pragma("unroll") for (int k = 0; k < 2; ++k) dst[m][k] = *(const LAS bf16x8*)(lds + PG8_SA(b, h) + aoff + m * 2048 + k * 1024); } while (0)
#define PG8_LDB(dst, b, h) do { _Pragma("unroll") for (int n = 0; n < 2; ++n) _Pragma("unroll") for (int k = 0; k < 2; ++k) dst[n][k] = *(const LAS bf16x8*)(lds + PG8_SB(b, h) + boff + n * 2048 + k * 1024); } while (0)
#define PG8_MMA(ai, bj, At_, Bt_) do { __builtin_amdgcn_s_setprio(1); _Pragma("unroll") for (int m = 0; m < 4; ++m) _Pragma("unroll") for (int n = 0; n < 2; ++n) _Pragma("unroll") for (int k = 0; k < 2; ++k) \
        acc[ai][bj][m][n] = __builtin_amdgcn_mfma_f32_16x16x32_bf16(Bt_[n][k], At_[m][k], acc[ai][bj][m][n], 0, 0, 0); __builtin_amdgcn_s_setprio(0); } while (0)
#define PG8_WAIT_V(n) asm volatile("s_waitcnt vmcnt(" #n ")" ::: "memory")
#define PG8_WAIT_L(n) asm volatile("s_waitcnt lgkmcnt(" #n ")" ::: "memory")
#define PG8_BAR __builtin_amdgcn_s_barrier()
#define PG8_SCHED __builtin_amdgcn_sched_barrier(0)
    const int nN = N / 256, nM = NTOK / BM, ntiles = nM * nN;
    const int G = gridDim.x;
    const int vb = (G % 8 == 0) ? (int)(blockIdx.x % 8) * (G / 8) + (int)(blockIdx.x / 8) : (int)blockIdx.x;
    const int tpb = (ntiles + G - 1) / G;
    const bool paneled = (G == 256) && (nN == 4 || nN == 8) && (nM == 64);
    for (int ti = 0; ti < tpb; ++ti) {
        int tile = vb * tpb + ti;
        if (paneled) {
            const int x = vb >> 5, j = vb & 31;
            const int pm_ = nN == 8 ? x * 8 + ti * 4 + (j >> 3) : x * 8 + (j >> 2), pn_ = nN == 8 ? (ti == 0 ? (j & 7) : (int)((0x24365701u >> (4 * (j & 7))) & 7u)) : (j & 3);
            tile = (nN == 8 ? ti < 2 : ti < 1) ? pm_ * nN + pn_ : ntiles;
        }
        if (tile >= ntiles) break;
        const int pm = tile / nN, pn = tile % nN, brow = pm * BM;
        const char* cA = (const char*)(A + (size_t)brow * K);
        const char* cB = (const char*)(Bt + (size_t)tok_cv(brow) * cvstride + (size_t)pn * 256 * K);
        f32x4 acc[2][2][4][2];
#pragma unroll
        for (int a = 0; a < 2; ++a)
#pragma unroll
            for (int b = 0; b < 2; ++b)
#pragma unroll
                for (int m = 0; m < 4; ++m)
#pragma unroll
                    for (int n = 0; n < 2; ++n) acc[a][b][m][n] = f32x4{0.f, 0.f, 0.f, 0.f};
        if (MODE != EPI_WOUT && cvstride != 0) {
            LAS float* rsp = (LAS float*)lds + 256 * STG;
            const int tp = opaque_tid(wv);
            float val;
            if (tp < 256) {
                const float* rp = RSS + (size_t)(brow + tp) * 8;
                const float4 a = *reinterpret_cast<const float4*>(rp), b = *reinterpret_cast<const float4*>(rp + 4);
                val = rsqrtf((((a.x + a.y) + (a.z + a.w)) + ((b.x + b.y) + (b.z + b.w))) * (1.f / D) + EPS);
            } else val = BIAS[(size_t)tok_cv(brow) * N + pn * 256 + (tp - 256)];
            rsp[tp] = val;
        }
        asm volatile("s_waitcnt vmcnt(0)" ::: "memory");
        {
            bf16x8 At[4][2], B0[2][2], B1[2][2];
            PG8_STAGE(PG8_SB(0, 0), cB); PG8_STAGE(PG8_SB(0, 1), cB + hstep); PG8_STAGE(PG8_SA(0, 0), cA); PG8_STAGE(PG8_SA(0, 1), cA + hstep);
            if (wr == 1) PG8_BAR;
            PG8_WAIT_V(2); PG8_BAR;
            PG8_STAGE(PG8_SB(1, 0), cB + kstep); PG8_STAGE(PG8_SA(1, 0), cA + kstep); PG8_STAGE(PG8_SB(1, 1), cB + hstep + kstep);
            PG8_WAIT_V(6); PG8_BAR;
            for (int t = 0; t < nt; t += 2) {
                const bool last = (t == nt - 2);
                const char* a1 = cA + (size_t)(t + 1) * kstep;
                const char* a2 = last ? cA : cA + (size_t)(t + 2) * kstep; const char* b2 = last ? cB : cB + (size_t)(t + 2) * kstep;
                const char* a3 = a2 + kstep; const char* b3 = b2 + kstep;
                PG8_LDB(B0, 0, 0); PG8_LDB(B1, 0, 1); PG8_SCHED; PG8_LDA(At, 0, 0); PG8_STAGE(PG8_SA(1, 1), a1 + hstep);
                PG8_WAIT_V(8); PG8_WAIT_L(0); PG8_BAR; PG8_MMA(0, 0, At, B0); PG8_MMA(0, 1, At, B1); PG8_BAR; PG8_SCHED;
                PG8_LDA(At, 0, 1); PG8_STAGE(PG8_SB(0, 0), b2); PG8_STAGE(PG8_SB(0, 1), b2 + hstep); PG8_STAGE(PG8_SA(0, 0), a2);
                PG8_WAIT_V(8); PG8_WAIT_L(0); PG8_BAR; PG8_MMA(1, 0, At, B0); PG8_MMA(1, 1, At, B1); PG8_BAR; PG8_SCHED;
                PG8_LDB(B0, 1, 0); PG8_LDB(B1, 1, 1); PG8_SCHED; PG8_LDA(At, 1, 0); PG8_STAGE(PG8_SA(0, 1), a2 + hstep);
                PG8_WAIT_V(8); PG8_WAIT_L(0); PG8_BAR; PG8_MMA(0, 0, At, B0); PG8_MMA(0, 1, At, B1); PG8_BAR; PG8_SCHED;
                PG8_LDA(At, 1, 1); PG8_STAGE(PG8_SB(1, 0), b3); PG8_STAGE(PG8_SB(1, 1), b3 + hstep); PG8_STAGE(PG8_SA(1, 0), a3);
                PG8_WAIT_V(8); PG8_WAIT_L(0); PG8_BAR; PG8_MMA(1, 0, At, B0); PG8_MMA(1, 1, At, B1); PG8_BAR; PG8_SCHED;
            }
            PG8_WAIT_V(0);
            if (wr == 0) PG8_BAR;
            PG8_BAR;
        }
#define ACC_H(a, m, n) (hb == 0 ? acc[a][0][m][n] : acc[a][1][m][n])
        LAS float* st = (LAS float*)lds;
#pragma unroll 1
        for (int hb = 0; hb < 2; ++hb) {
            const int bcol = pn * 256 + hb * 128;
            const int tid = opaque_tid(wv), lane = tid & 63, fr = lane & 15, fq = lane >> 4;
            if (MODE != EPI_WOUT && cvstride != 0) {
                LAS float* rs = st + 256 * STG;
#pragma unroll
                for (int n = 0; n < 2; ++n) {
                    const f32x4 bq = *(const LAS f32x4*)(rs + 256 + hb * 128 + wc * 32 + n * 16 + fq * 4);
                    const float4 bz = make_float4(bq[0], bq[1], bq[2], bq[3]);
#pragma unroll
                    for (int a = 0; a < 2; ++a)
#pragma unroll
                        for (int m = 0; m < 4; ++m) {
                            const int row = a * 128 + wr * 64 + m * 16 + fr;
                            const float r = rs[row];
                            const f32x4 v = ACC_H(a, m, n);
                            *(LAS f32x4*)(st + row * STG + wc * 32 + n * 16 + fq * 4) = f32x4{v[0] * r + bz.x, v[1] * r + bz.y, v[2] * r + bz.z, v[3] * r + bz.w};
                        }
                }
            } else {
#pragma unroll
                for (int a = 0; a < 2; ++a)
#pragma unroll
                    for (int m = 0; m < 4; ++m)
#pragma unroll
                        for (int n = 0; n < 2; ++n)
                            *(LAS f32x4*)(st + (a * 128 + wr * 64 + m * 16 + fr) * STG + wc * 32 + n * 16 + fq * 4) = ACC_H(a, m, n);
            }
            __syncthreads();
            const bool tprompt = brow < NPT;
            const int tb_ = tprompt ? (brow >> 8) : ((brow - NPT) >> 11), ts0 = tprompt ? 0 : ((brow - NPT) & 2047);
            if (MODE == EPI_INPROJ) {
                const bool vtile = (bcol >= 1024 && bcol < 1280);
                if (!vtile) {
    #pragma unroll 1
                    for (int it = 0; it < 2; ++it) {
                        const int item = it * NT + tid, erow = item >> 2, eseg = item & 3;
                        float v[32];
    #pragma unroll
                        for (int i = 0; i < 8; ++i) {
                            const f32x4 f = *(const LAS f32x4*)(st + erow * STG + eseg * 32 + i * 4);
                            v[i * 4] = f[0]; v[i * 4 + 1] = f[1]; v[i * 4 + 2] = f[2]; v[i * 4 + 3] = f[3];
                        }
                        epi_inproj_xform(p, l, brow + erow, bcol + eseg * 32, v);
    #pragma unroll
                        for (int i = 0; i < 8; ++i) *(LAS f32x4*)(st + erow * STG + eseg * 32 + i * 4) = f32x4{v[i * 4], v[i * 4 + 1], v[i * 4 + 2], v[i * 4 + 3]};
                    }
                    __syncthreads();
    #pragma unroll 1
                    for (int it = 0; it < 8; ++it) {
                        const int item = it * NT + tid, r = item >> 4, c = (item & 15) * 8;
                        const f32x4 f0 = *(const LAS f32x4*)(st + r * STG + c), f1 = *(const LAS f32x4*)(st + r * STG + c + 4);
                        const int t = brow + r, sp = ts0 + r;
                        bf16_t* dst;
                        if (bcol < 512)        dst = (bf16_t*)(p.ws + (bcol < 256 ? OFF_AU : OFF_AV)) + (size_t)t * 256 + (bcol & 255) + c;
                        else if (bcol < 768)   dst = (bf16_t*)(p.ws + OFF_DQ) + (size_t)t * 256 + (bcol - 512) + c;
                        else if (bcol < 1024) { const int cc = bcol - 768 + c, h = cc >> 6;
                                                dst = tprompt ? (bf16_t*)(p.ws + OFF_DKP) + (((size_t)tb_ * 4 + h) * SEQ + sp) * 64 + (cc & 63)
                                                              : (bf16_t*)(p.ws + OFF_DKS) + (((size_t)tb_ * 4 + h) * NKS + sp) * 64 + (cc & 63); }
                        else if (bcol < 1792)  dst = (bf16_t*)(p.ws + OFF_GQ) + (size_t)t * 512 + (bcol - 1280) + c;
                        else                 { const int kv = c >> 6, d0 = c & 63;
                                                const size_t hb = (tprompt ? ((size_t)tb_ * 2 + kv) * SEQ * 64 : ((size_t)tb_ * 2 + kv) * NKS * 64) + (size_t)(sp >> 6) * 4096;
                                                dst = bcol < 1920 ? (bf16_t*)(p.ws + (tprompt ? OFF_GKP : OFF_GKS)) + hb + (d0 >> 3) * 512 + (sp & 63) * 8
                                                                  : (bf16_t*)(p.ws + (tprompt ? OFF_GVTP : OFF_GVTS)) + hb + (d0 >> 5) * 2048 + (sp & 63) * 32 + (d0 & 31); }
                        *reinterpret_cast<u32x4*>(dst) = u32x4{pack_bf2(f0[0], f0[1]), pack_bf2(f0[2], f0[3]), pack_bf2(f1[0], f1[1]), pack_bf2(f1[2], f1[3])};
                    }
                }
                if (tprompt && ((bcol >= 768 && bcol < 1280) || bcol >= 1792)) {
                    float* ob; int rs;
                    if (bcol < 1024)      { ob = p.out + OUT_NDK + (((size_t)tb_ * 2 + l) * SEQ) * 256 + (bcol - 768);  rs = 256; }
                    else if (bcol < 1280) { ob = p.out + OUT_NDV + (((size_t)tb_ * 2 + l) * SEQ) * 256 + (bcol - 1024); rs = 256; }
                    else if (bcol < 1920) { ob = p.out + OUT_NGK + (((size_t)tb_ * 2 + l) * SEQ) * 128;                 rs = 128; }
                    else                  { ob = p.out + OUT_NGV + (((size_t)tb_ * 2 + l) * SEQ) * 128;                 rs = 128; }
    #pragma unroll 1
                    for (int it = 0; it < 16; ++it) {
                        const int item = it * NT + tid, r = item >> 5, c = (item & 31) * 4;
                        *reinterpret_cast<f32x4*>(ob + (size_t)r * rs + c) = *(const LAS f32x4*)(st + r * STG + c);
                    }
                }
                if (vtile) {
    #pragma unroll 1
                    for (int it = 0; it < 2; ++it) {
                        const int item = it * NT + tid, col = item >> 3, run = item & 7;
                        epi_inproj_col(p, brow + run * 32, bcol + col, st + run * 32 * STG + col);
                    }
                }
            } else {
                float4 ga = make_float4(0.f, 0.f, 0.f, 0.f), gb = ga, na = ga, nb = ga, sa = ga, sb = ga;
                float4 xna = ga, xnb = ga; u32x4 xnw = {0u, 0u, 0u, 0u};
                if (MODE == EPI_WOUT) {
                    const int c = (tid & 15) * 8;
                    const float* g1 = (const float*)(p.ws + OFF_MOD) + (size_t)(l * 5 + tok_cv(brow)) * 6144 + 2048 + bcol + c;
                    ga = *reinterpret_cast<const float4*>(g1); gb = *reinterpret_cast<const float4*>(g1 + 4);
                    sa = *reinterpret_cast<const float4*>(g1 + 2048); sb = *reinterpret_cast<const float4*>(g1 + 2048 + 4);
                    const float* gn = p.in[I_N2G] + l * D + bcol + c;
                    na = *reinterpret_cast<const float4*>(gn); nb = *reinterpret_cast<const float4*>(gn + 4);
                    const int t = brow + (tid >> 4);
                    if (l == 0) { const float* xr = x_in_row(p, t) + bcol + c; xna = *reinterpret_cast<const float4*>(xr); xnb = *reinterpret_cast<const float4*>(xr + 4); }
                    else xnw = *reinterpret_cast<const u32x4*>((const bf16_t*)(p.ws + OFF_XC) + (size_t)t * D + bcol + c);
                }
    #pragma unroll 1
                for (int it = 0; it < 8; ++it) {
                    const int item = it * NT + tid, r = item >> 4, c = (item & 15) * 8;
                    const f32x4 f0 = *(const LAS f32x4*)(st + r * STG + c), f1 = *(const LAS f32x4*)(st + r * STG + c + 4);
                    const int t = brow + r;
                    float o[8] = {f0[0], f0[1], f0[2], f0[3], f1[0], f1[1], f1[2], f1[3]};
                    if (MODE == EPI_WOUT) {
                        float x[8];
                        if (l == 0) { x[0] = xna.x; x[1] = xna.y; x[2] = xna.z; x[3] = xna.w; x[4] = xnb.x; x[5] = xnb.y; x[6] = xnb.z; x[7] = xnb.w; }
                        else {
    #pragma unroll
                            for (int k = 0; k < 4; ++k) { x[2 * k] = __uint_as_float(xnw[k] << 16); x[2 * k + 1] = __uint_as_float(xnw[k] & 0xffff0000u); }
                        }
                        {
                            const int tn = brow + (((it < 7 ? it + 1 : it) * NT + tid) >> 4);
                            if (l == 0) { const float* xr = x_in_row(p, tn) + bcol + c; xna = *reinterpret_cast<const float4*>(xr); xnb = *reinterpret_cast<const float4*>(xr + 4); }
                            else xnw = *reinterpret_cast<const u32x4*>((const bf16_t*)(p.ws + OFF_XC) + (size_t)tn * D + bcol + c);
                        }
                        o[0] = x[0] + ga.x * o[0]; o[1] = x[1] + ga.y * o[1]; o[2] = x[2] + ga.z * o[2]; o[3] = x[3] + ga.w * o[3];
                        o[4] = x[4] + gb.x * o[4]; o[5] = x[5] + gb.y * o[5]; o[6] = x[6] + gb.z * o[6]; o[7] = x[7] + gb.w * o[7];
                        float xg[8] = {o[0] * na.x * (1.f + sa.x), o[1] * na.y * (1.f + sa.y), o[2] * na.z * (1.f + sa.z), o[3] * na.w * (1.f + sa.w),
                                       o[4] * nb.x * (1.f + sb.x), o[5] * nb.y * (1.f + sb.y), o[6] * nb.z * (1.f + sb.z), o[7] * nb.w * (1.f + sb.w)};
                        float ss = 0.f, am = 0.f;
    #pragma unroll
                        for (int i = 0; i < 8; ++i) { ss += o[i] * o[i]; am = fmaxf(am, fabsf(xg[i])); }
                        ss = row16_sum(ss); am = row16_max(am);
                        const float sc8 = am > 0.f ? 127.f / am : 1.f;
                        uint2 w8;
                        w8.x = pack4_i8(q8(xg[0] * sc8), q8(xg[1] * sc8), q8(xg[2] * sc8), q8(xg[3] * sc8));
                        w8.y = pack4_i8(q8(xg[4] * sc8), q8(xg[5] * sc8), q8(xg[6] * sc8), q8(xg[7] * sc8));
                        *reinterpret_cast<uint2*>(p.ws + OFF_H8I + (size_t)t * D + bcol + c) = w8;
                        if ((item & 15) == 0) {
                            ((float*)(p.ws + OFF_RSS2))[((size_t)l * NTOK + t) * 8 + (bcol >> 7)] = ss;
                            ((float*)(p.ws + OFF_XGS))[(size_t)t * 8 + (bcol >> 7)] = am > 0.f ? am * (1.f / 127.f) : 1.f;
                        }
                    }
                    bf16_t* dst = (bf16_t*)(p.ws + (MODE == EPI_WOUT ? OFF_XC : OFF_Q)) + (size_t)t * D + bcol + c;
                    *reinterpret_cast<u32x4*>(dst) = u32x4{pack_bf2(o[0], o[1]), pack_bf2(o[2], o[3]), pack_bf2(o[4], o[5]), pack_bf2(o[6], o[7])};
                }
            }
            __syncthreads();
        }
    }
#undef ACC_H
#undef PG8_SA
#undef PG8_SB
#undef PG8_STAGE
#undef PG8_LDA
#undef PG8_LDB
#undef PG8_MMA
#undef PG8_WAIT_V
#undef PG8_WAIT_L
#undef PG8_BAR
#undef PG8_SCHED
}

#define MFMA32(a, b, c) __builtin_amdgcn_mfma_f32_32x32x16_bf16((a), (b), (c), 0, 0, 0)
constexpr int ATT_ROWB = 144;
constexpr int ATT_TILEB = 64 * ATT_ROWB;
constexpr int QW_MIX = 4096;

__device__ __forceinline__ bf16x8 pack8(const f32x16& x, int s) {
    const u32x4 w = {pack_bf2(x[8 * s], x[8 * s + 1]), pack_bf2(x[8 * s + 2], x[8 * s + 3]), pack_bf2(x[8 * s + 4], x[8 * s + 5]), pack_bf2(x[8 * s + 6], x[8 * s + 7])};
    return __builtin_bit_cast(bf16x8, w);
}
__device__ __forceinline__ void softmax_tile(f32x16& s0, f32x16& s1, const float sc, float& m, float& l, float& alpha, const int lane) {
    float mx = fmaxf(s0[0], s1[0]);
#pragma unroll
    for (int i = 1; i < 16; ++i) mx = fmaxf(mx, fmaxf(s0[i], s1[i]));
    mx = fmaxf(mx, shfl_x(mx, lane, 32));
    const float mnew = fmaxf(m, mx * sc);
    alpha = __builtin_amdgcn_exp2f(m - mnew);
    m = mnew;
    float ps = 0.f;
#pragma unroll
    for (int i = 0; i < 16; ++i) { s0[i] = __builtin_amdgcn_exp2f(s0[i] * sc - mnew); s1[i] = __builtin_amdgcn_exp2f(s1[i] * sc - mnew); ps += s0[i] + s1[i]; }
    l = l * alpha + ps;
}
__device__ __forceinline__ void v_frags(const LAS unsigned char* vb, bf16x8 (&vf)[8], int r, int hh) {
#pragma unroll
    for (int u = 0; u < 2; ++u)
#pragma unroll
        for (int sk = 0; sk < 2; ++sk)
#pragma unroll
            for (int mt = 0; mt < 2; ++mt) {
                const LAS unsigned char* a = vb + (32 * mt + r) * ATT_ROWB + (32 * u + 16 * sk + 4 * hh) * 2;
                const s16x4 lo = *(const LAS s16x4*)a, hi = *(const LAS s16x4*)(a + 16);
                vf[(u * 2 + sk) * 2 + mt] = bf16x8{lo[0], lo[1], lo[2], lo[3], hi[0], hi[1], hi[2], hi[3]};
            }
}
__device__ __forceinline__ void pv_tile(const bf16x8 (&vf)[8], const f32x16& p0, const f32x16& p1, f32x16 (&O)[2]) {
#pragma unroll
    for (int u = 0; u < 2; ++u)
#pragma unroll
        for (int sk = 0; sk < 2; ++sk) {
            const bf16x8 pf = pack8(u ? p1 : p0, sk);
#pragma unroll
            for (int mt = 0; mt < 2; ++mt) O[mt] = MFMA32(vf[(u * 2 + sk) * 2 + mt], pf, O[mt]);
        }
}

template <bool DIFF>
__device__ __forceinline__ void attn_item(const Params& p, int l, LAS unsigned char* lds, const int tid,
                                          const bf16_t* __restrict__ Qg, const int qstride,
                                          const bf16_t* __restrict__ Kg, const bf16_t* __restrict__ Vtg, const int nk,
                                          bf16_t* __restrict__ Og, const float lam) {
    const int wave = tid >> 6, lane = tid & 63, r = lane & 31, hh = lane >> 5;
    const int lrow = tid >> 3, lchunk = tid & 7;
    LAS unsigned char* kbuf = lds; LAS unsigned char* vbuf = lds + 2 * ATT_TILEB;
    bf16x8 qf[4];
    const bf16_t* qrow = Qg + (size_t)(wave * 32 + r) * qstride;
#pragma unroll
    for (int ks = 0; ks < 4; ++ks) qf[ks] = *reinterpret_cast<const bf16x8*>(qrow + ks * 16 + hh * 8);
    const float sc = (DIFF ? 0.17677669529663687f : 0.125f) * 1.4426950408889634f;
    f32x16 O0[2], O1[2];
#pragma unroll
    for (int mt = 0; mt < 2; ++mt)
#pragma unroll
        for (int i = 0; i < 16; ++i) { O0[mt][i] = 0.f; O1[mt][i] = 0.f; }
    float m0 = -1e30f, l0 = 0.f, m1 = -1e30f, l1 = 0.f;
    const int ntl = nk / 64;
    u32x4 kr, vr, kn, vn;
    kr = *reinterpret_cast<const u32x4*>(Kg + (size_t)lrow * 64 + lchunk * 8);
    vr = *reinterpret_cast<const u32x4*>(Vtg + (size_t)lrow * nk + lchunk * 8);
    *(LAS u32x4*)(kbuf + lrow * ATT_ROWB + lchunk * 16) = kr;
    *(LAS u32x4*)(vbuf + lrow * ATT_ROWB + lchunk * 16) = vr;
    {
        const int t1 = ntl > 1 ? 1 : 0;
        kr = *reinterpret_cast<const u32x4*>(Kg + (size_t)(t1 * 64 + lrow) * 64 + lchunk * 8);
        vr = *reinterpret_cast<const u32x4*>(Vtg + (size_t)lrow * nk + t1 * 64 + lchunk * 8);
    }
    __syncthreads();
    for (int ti = 0; ti < ntl; ++ti) {
        const int cur = ti & 1;
        {
            const int t2 = ti + 2 < ntl ? ti + 2 : ntl - 1;
            kn = *reinterpret_cast<const u32x4*>(Kg + (size_t)(t2 * 64 + lrow) * 64 + lchunk * 8);
            vn = *reinterpret_cast<const u32x4*>(Vtg + (size_t)lrow * nk + t2 * 64 + lchunk * 8);
        }
        const LAS unsigned char* kb = kbuf + cur * ATT_TILEB; const LAS unsigned char* vb = vbuf + cur * ATT_TILEB;
        bf16x8 ka[2][4];
#pragma unroll
        for (int u = 0; u < 2; ++u)
#pragma unroll
            for (int ks = 0; ks < 4; ++ks) ka[u][ks] = *(const LAS bf16x8*)(kb + (32 * u + r) * ATT_ROWB + (ks * 16 + hh * 8) * 2);
        __builtin_amdgcn_sched_barrier(0);
        bf16x8 vf[8];
        if (!DIFF) {
            f32x16 s0, s1;
#pragma unroll
            for (int i = 0; i < 16; ++i) { s0[i] = 0.f; s1[i] = 0.f; }
#pragma unroll
            for (int ks = 0; ks < 4; ++ks) { s0 = MFMA32(ka[0][ks], qf[ks], s0); s1 = MFMA32(ka[1][ks], qf[ks], s1); }
            v_frags(vb, vf, r, hh);
            __builtin_amdgcn_sched_barrier(0);
            float alpha;
            softmax_tile(s0, s1, sc, m0, l0, alpha, lane);
            if (__builtin_amdgcn_ballot_w64(alpha != 1.f) != 0ull) {
#pragma unroll
                for (int mt = 0; mt < 2; ++mt)
#pragma unroll
                    for (int i = 0; i < 16; ++i) O0[mt][i] *= alpha;
            }
            pv_tile(vf, s0, s1, O0);
        } else {
            f32x16 s0, s1, t0, t1;
#pragma unroll
            for (int i = 0; i < 16; ++i) { s0[i] = 0.f; s1[i] = 0.f; t0[i] = 0.f; t1[i] = 0.f; }
#pragma unroll
            for (int ks = 0; ks < 2; ++ks) {
                s0 = MFMA32(ka[0][ks], qf[ks], s0); s1 = MFMA32(ka[1][ks], qf[ks], s1);
                t0 = MFMA32(ka[0][2 + ks], qf[2 + ks], t0); t1 = MFMA32(ka[1][2 + ks], qf[2 + ks], t1);
            }
            v_frags(vb, vf, r, hh);
            __builtin_amdgcn_sched_barrier(0);
            float alpha;
            softmax_tile(s0, s1, sc, m0, l0, alpha, lane);
            if (__builtin_amdgcn_ballot_w64(alpha != 1.f) != 0ull) {
#pragma unroll
                for (int mt = 0; mt < 2; ++mt)
#pragma unroll
                    for (int i = 0; i < 16; ++i) O0[mt][i] *= alpha;
            }
            pv_tile(vf, s0, s1, O0);
            softmax_tile(t0, t1, sc, m1, l1, alpha, lane);
            if (__builtin_amdgcn_ballot_w64(alpha != 1.f) != 0ull) {
#pragma unroll
                for (int mt = 0; mt < 2; ++mt)
#pragma unroll
                    for (int i = 0; i < 16; ++i) O1[mt][i] *= alpha;
            }
            pv_tile(vf, t0, t1, O1);
        }
        if (ti + 1 < ntl) {
            *(LAS u32x4*)(kbuf + (cur ^ 1) * ATT_TILEB + lrow * ATT_ROWB + lchunk * 16) = kr;
            *(LAS u32x4*)(vbuf + (cur ^ 1) * ATT_TILEB + lrow * ATT_ROWB + lchunk * 16) = vr;
        }
        kr = kn; vr = vn;
        __syncthreads();
    }
    l0 += shfl_x(l0, lane, 32);
    const float inv0 = 1.f / l0;
    LAS unsigned char* ob = lds + wave * 4608;
    if (!DIFF) {
#pragma unroll
        for (int mt = 0; mt < 2; ++mt)
#pragma unroll
            for (int g = 0; g < 4; ++g) {
                u32x2 w;
                w[0] = pack_bf2(O0[mt][4 * g] * inv0, O0[mt][4 * g + 1] * inv0);
                w[1] = pack_bf2(O0[mt][4 * g + 2] * inv0, O0[mt][4 * g + 3] * inv0);
                *(LAS u32x2*)(ob + r * 144 + (32 * mt + 8 * g + 4 * hh) * 2) = w;
            }
    } else {
        l1 += shfl_x(l1, lane, 32);
        const float inv1 = lam / l1;
        float ss = 0.f;
#pragma unroll
        for (int mt = 0; mt < 2; ++mt)
#pragma unroll
            for (int i = 0; i < 16; ++i) { const float o = O0[mt][i] * inv0 - O1[mt][i] * inv1; O0[mt][i] = o; ss += o * o; }
        ss += shfl_x(ss, lane, 32);
        const float rr = rsqrtf(ss * (1.f / 64.f) + EPS) * __builtin_bit_cast(float, __builtin_amdgcn_readfirstlane(__builtin_bit_cast(int, 1.f - lam_init_of(l))));
        const float* sg = p.in[I_SUBLN] + l * 64;
#pragma unroll
        for (int mt = 0; mt < 2; ++mt)
#pragma unroll
            for (int g = 0; g < 4; ++g) {
                const int d0 = 32 * mt + 8 * g + 4 * hh;
                const float4 gg = *reinterpret_cast<const float4*>(sg + d0);
                u32x2 w;
                w[0] = pack_bf2(O0[mt][4 * g] * rr * gg.x, O0[mt][4 * g + 1] * rr * gg.y);
                w[1] = pack_bf2(O0[mt][4 * g + 2] * rr * gg.z, O0[mt][4 * g + 3] * rr * gg.w);
                *(LAS u32x2*)(ob + r * 144 + d0 * 2) = w;
            }
    }
#pragma unroll
    for (int ps = 0; ps < 4; ++ps) {
        const int row = ps * 8 + (lane >> 3), ch = lane & 7;
        *reinterpret_cast<u32x4*>(Og + (size_t)(wave * 32 + row) * D + ch * 8) = *(const LAS u32x4*)(ob + row * 144 + ch * 16);
    }
}

namespace ga {
constexpr float C2 = 0.125f * 1.4426950408889634f;
constexpr int SLOTB = 8192, LDS_K = 0, LDS_V = 3 * SLOTB, LDS_WS = 6 * SLOTB, LDS_OST = LDS_WS + 8 * 256;
typedef __attribute__((address_space(3))) const char* lds_cptr;
typedef short v4i16_t __attribute__((ext_vector_type(4)));
using s16x4 = __attribute__((ext_vector_type(4))) short;
__device__ __forceinline__ int crow(int r, int hi) { return (r & 3) + 8 * (r >> 2) + 4 * hi; }
__device__ __forceinline__ void glds4(const void* g, unsigned lds_base) {
    unsigned sv; asm volatile("s_mov_b32 %0, m0\n\ts_mov_b32 m0, %2\n\ts_nop 0\n\tglobal_load_lds_dword %1, off\n\ts_mov_b32 m0, %0" : "=&s"(sv) : "v"(g), "s"(lds_base) : "memory"); }
__device__ __forceinline__ void glds16(const void* g, unsigned lds_base) {
    unsigned sv; asm volatile("s_mov_b32 %0, m0\n\ts_mov_b32 m0, %2\n\ts_nop 0\n\tglobal_load_lds_dwordx4 %1, off\n\ts_mov_b32 m0, %0" : "=&s"(sv) : "v"(g), "s"(lds_base) : "memory"); }
__device__ __forceinline__ void kload2(bf16x8* kf, lds_cptr kp, int d0) { kf[2 * d0] = *(const LAS bf16x8*)(kp + d0 * 2048); kf[2 * d0 + 1] = *(const LAS bf16x8*)(kp + d0 * 2048 + 512); }
__device__ __forceinline__ s16x4 vtr(lds_cptr p) { return __builtin_bit_cast(s16x4, __builtin_amdgcn_ds_read_tr16_b64_v4i16((LAS v4i16_t*)p)); }
#define GA_MX3(a, b, c) __builtin_fmaxf(__builtin_fmaxf((a), (b)), (c))
__device__ __forceinline__ float rowmax(const f32x16& p0, const f32x16& p1) {
    float a = GA_MX3(p0[0], p0[1], p1[0]), b = GA_MX3(p0[2], p0[3], p1[1]); a = GA_MX3(a, p1[2], p1[3]);
#pragma unroll
    for (int r = 4; r < 16; r += 4) { a = GA_MX3(a, p0[r], p0[r + 1]); b = GA_MX3(b, p0[r + 2], p0[r + 3]); a = GA_MX3(a, p1[r], p1[r + 1]); b = GA_MX3(b, p1[r + 2], p1[r + 3]); }
    float m = __builtin_fmaxf(a, b); auto rr = __builtin_amdgcn_permlane32_swap(__float_as_uint(m), __float_as_uint(m), false, false);
    return __builtin_fmaxf(__uint_as_float(rr[0]), __uint_as_float(rr[1])); }
}
#define GA_SBAR() __builtin_amdgcn_sched_barrier(0)
#define GA_PIN(x) asm volatile("" : "+v"(x))
#define GA_WAIT_BAR(N) asm volatile("s_waitcnt vmcnt(" #N ") lgkmcnt(0)\n\ts_barrier" ::: "memory")
#define GA_THR 8
__device__ __forceinline__ void gqa_unit(LAS unsigned char* ldsl, const int tid, const int wid, const bf16_t* __restrict__ Qw0, const int qstride,
                                         const unsigned char* __restrict__ Kimg, const unsigned char* __restrict__ Vimg, const int NT, bf16_t* __restrict__ Og) {
    using namespace ga;
    const int lane = tid & 63, r32 = lane & 31, hi = lane >> 5;
    const bf16_t* Qw = Qw0 + (size_t)(wid * 32) * qstride;
    const unsigned lds0 = (unsigned)(size_t)ldsl; LAS float* wsf = (LAS float*)(ldsl + LDS_WS) + wid * 64;
    const unsigned char* ksrc = Kimg + wid * 1024 + lane * 16;
    const unsigned char* vsrc = Vimg + wid * 1024 + lane * 16;
    const unsigned kdst = lds0 + LDS_K + wid * 1024, vdst = lds0 + LDS_V + wid * 1024;
#define DMA_K(t, slot) glds16(ksrc + (size_t)(t) * SLOTB, (unsigned)__builtin_amdgcn_readfirstlane(kdst + (slot)))
#define DMA_V(t, slot) glds16(vsrc + (size_t)(t) * SLOTB, (unsigned)__builtin_amdgcn_readfirstlane(vdst + (slot)))
    const lds_cptr vp0 = (lds_cptr)ldsl + LDS_V + ((lane >> 4) & 1) * 32 + (lane & 3) * 8 + (4 * hi + ((lane & 15) >> 2)) * 64;
    const lds_cptr kp0 = (lds_cptr)ldsl + LDS_K + hi * 1024 + r32 * 16;
    DMA_K(0, 0); DMA_V(0, 0); DMA_K(1, SLOTB);
    bf16x8 qr[4];
#pragma unroll
    for (int d0 = 0; d0 < 4; ++d0) qr[d0] = *reinterpret_cast<const bf16x8*>(&Qw[(size_t)r32 * qstride + d0 * 16 + hi * 8]);
    float mhat = 0.f, l_reg = 0.f; f32x16 o[2];
#pragma unroll
    for (int i = 0; i < 16; ++i) { o[0][i] = 0.f; o[1][i] = 0.f; }
    f32x16 zero16;
#pragma unroll
    for (int i = 0; i < 16; ++i) zero16[i] = 0.f;
    GA_PIN(zero16);
    bool resc = false;
    f32x16 pA0, pA1, pB0, pB1; bf16x8 kf[8]; s16x4 vlo[8], vhi[8]; u32x4 pw0, pw1, pw2, pw3;
    int sl_prev = 0, sl_cur = 0, sl_next = SLOTB;
#define ROT() do { sl_prev = sl_cur; sl_cur = sl_next; sl_next = (sl_next == 2 * SLOTB) ? 0 : sl_next + SLOTB; } while (0)
#define EX(v) __builtin_amdgcn_exp2f(v)
#define RESC() do { if (resc) { _Pragma("unroll") for (int d_ = 0; d_ < 2; ++d_) _Pragma("unroll") for (int r = 0; r < 16; ++r) o[d_][r] *= wsf[crow(r, hi)]; } } while (0)
    DMA_K(2, 2 * SLOTB);
    GA_WAIT_BAR(3);
    _Pragma("unroll") for (int d0 = 0; d0 < 4; ++d0) kload2(kf, kp0, d0);
    pA0 = MFMA32(kf[0], qr[0], zero16); pA1 = MFMA32(kf[1], qr[0], zero16); pA0 = MFMA32(kf[2], qr[1], pA0); pA1 = MFMA32(kf[3], qr[1], pA1);
    pA0 = MFMA32(kf[4], qr[2], pA0); pA1 = MFMA32(kf[5], qr[2], pA1); pA0 = MFMA32(kf[6], qr[3], pA0); pA1 = MFMA32(kf[7], qr[3], pA1);
    { const float rm = rowmax(pA0, pA1); mhat = rm; const float nmh = -mhat;
#pragma unroll
      for (int r = 0; r < 16; ++r) { pA0[r] = EX(pA0[r] + nmh); pA1[r] = EX(pA1[r] + nmh); }
#pragma unroll
      for (int r = 0; r < 16; ++r) zero16[r] = nmh;
      GA_PIN(zero16); }
    GA_WAIT_BAR(0);
    DMA_K(3, 0); DMA_V(1, SLOTB); ROT();
    _Pragma("unroll") for (int d0 = 0; d0 < 4; ++d0) kload2(kf, kp0 + sl_cur, d0);
    GA_WAIT_BAR(2);
#define PKW(P, i) pack_bf2(P[i], P[i + 1])
#define PAF(k) __builtin_bit_cast(bf16x8, pw##k)
#define VFR(i) (bf16x8){vlo[i][0], vlo[i][1], vlo[i][2], vlo[i][3], vhi[i][0], vhi[i][1], vhi[i][2], vhi[i][3]}
#define VRD(i) do { vlo[i] = vtr(vp_ + (((i) >> 2) * 4096 + ((i) & 3) * 1024)); vhi[i] = vtr(vp_ + (((i) >> 2) * 4096 + ((i) & 3) * 1024 + 512)); } while (0)
#define KRD(G, d0) do { if (G) { kload2(kf, kp0 + sl_next, d0); GA_SBAR(); } } while (0)
#define GAPA(MF, a0, a1, a2, a3, W0, W1, PW) do { MF; sacc += a0; sacc += a1; sacc += a2; sacc += a3; W0; W1; GA_PIN(PW); GA_PIN(sacc); GA_SBAR(); } while (0)
#define GAPB(MF, X, i) do { MF; X[i] = EX(X[i]); X[i + 1] = EX(X[i + 1]); X[i + 2] = EX(X[i + 2]); X[i + 3] = EX(X[i + 3]); GA_PIN(X); GA_SBAR(); } while (0)
#define STEP(C0, C1, P0, P1, t, GK, GV, GL) do { GA_SBAR(); \
    const lds_cptr vp_ = vp0 + sl_prev; \
    VRD(0); GA_SBAR(); float sacc = P0[0] + P0[1]; \
                       GAPA(C0 = MFMA32(kf[0], qr[0], zero16), P0[2], P0[3], P0[4], P0[5],     pw0[0] = PKW(P0, 0),  pw0[1] = PKW(P0, 2),  pw0); \
    VRD(4); GA_SBAR(); GAPA(C1 = MFMA32(kf[1], qr[0], zero16), P0[6], P0[7], P0[8], P0[9],     pw0[2] = PKW(P0, 4),  pw0[3] = PKW(P0, 6),  pw0); \
    VRD(1); GA_SBAR(); GAPA(C0 = MFMA32(kf[2], qr[1], C0),    P0[10], P0[11], P0[12], P0[13], pw1[0] = PKW(P0, 8),  pw1[1] = PKW(P0, 10), pw1); \
    VRD(5); GA_SBAR(); GAPA(C1 = MFMA32(kf[3], qr[1], C1),    P0[14], P0[15], P1[0], P1[1],   pw1[2] = PKW(P0, 12), pw1[3] = PKW(P0, 14), pw1); \
    VRD(2); GA_SBAR(); GAPA(C0 = MFMA32(kf[4], qr[2], C0),    P1[2], P1[3], P1[4], P1[5],     pw2[0] = PKW(P1, 0),  pw2[1] = PKW(P1, 2),  pw2); \
    VRD(6); GA_SBAR(); GAPA(C1 = MFMA32(kf[5], qr[2], C1),    P1[6], P1[7], P1[8], P1[9],     pw2[2] = PKW(P1, 4),  pw2[3] = PKW(P1, 6),  pw2); \
    VRD(3); GA_SBAR(); GAPA(C0 = MFMA32(kf[6], qr[3], C0),    P1[10], P1[11], P1[12], P1[13], pw3[0] = PKW(P1, 8),  pw3[1] = PKW(P1, 10), pw3); \
    VRD(7); GA_SBAR(); GAPA(C1 = MFMA32(kf[7], qr[3], C1),    P1[14], P1[15], 0.f, 0.f,       pw3[2] = PKW(P1, 12), pw3[3] = PKW(P1, 14), pw3); \
    l_reg += sacc; \
    if (GK) DMA_K((t) + 3, sl_cur); if (GV) DMA_V((t) + 1, sl_next); \
    { const float rm = rowmax(C0, C1); resc = false;                                             \
      if (__builtin_expect(__any(rm > (float)GA_THR), 0)) { const float dl = __builtin_fmaxf(rm, 0.f); mhat += dl; \
          const float f = __builtin_amdgcn_exp2f(-dl); l_reg *= f; if (hi == 0) wsf[r32] = f; resc = true; \
          _Pragma("unroll") for (int r_ = 0; r_ < 16; ++r_) { C0[r_] -= dl; C1[r_] -= dl; zero16[r_] = -mhat; } GA_PIN(zero16); } } \
    GA_SBAR(); \
    GAPB(o[0] = MFMA32(PAF(0), VFR(0), o[0]), C0, 0);              GAPB(o[1] = MFMA32(PAF(0), VFR(4), o[1]), C0, 4); \
    KRD(GL, 0); GAPB(o[0] = MFMA32(PAF(1), VFR(1), o[0]), C0, 8);  KRD(GL, 1); GAPB(o[1] = MFMA32(PAF(1), VFR(5), o[1]), C0, 12); \
    KRD(GL, 2); GAPB(o[0] = MFMA32(PAF(2), VFR(2), o[0]), C1, 0);  KRD(GL, 3); GAPB(o[1] = MFMA32(PAF(2), VFR(6), o[1]), C1, 4); \
    GAPB(o[0] = MFMA32(PAF(3), VFR(3), o[0]), C1, 8);              GAPB(o[1] = MFMA32(PAF(3), VFR(7), o[1]), C1, 12); \
    } while (0)
    int t = 1;
    for (; t + 5 < NT; t += 2) {
        STEP(pB0, pB1, pA0, pA1, t, true, true, true);     GA_WAIT_BAR(2); RESC(); ROT();
        STEP(pA0, pA1, pB0, pB1, t + 1, true, true, true); GA_WAIT_BAR(2); RESC(); ROT();
    }
#define ENDW(tt) do { if ((tt) + 3 < NT) { GA_WAIT_BAR(2); } else if ((tt) + 2 < NT) { GA_WAIT_BAR(1); } else { GA_WAIT_BAR(0); } } while (0)
    for (; t + 1 < NT; t += 2) {
        STEP(pB0, pB1, pA0, pA1, t, (t + 3 < NT), (t + 1 < NT), (t + 1 < NT));         ENDW(t);     RESC(); ROT();
        STEP(pA0, pA1, pB0, pB1, t + 1, (t + 4 < NT), (t + 2 < NT), (t + 2 < NT));     ENDW(t + 1); RESC(); ROT();
    }
    STEP(pB0, pB1, pA0, pA1, NT - 1, false, false, false); RESC();
    { float sacc = pB0[0] + pB0[1];
#pragma unroll
      for (int r = 2; r < 16; ++r) sacc += pB0[r];
#pragma unroll
      for (int r = 0; r < 16; ++r) sacc += pB1[r];
      l_reg += sacc;
      pw0 = (u32x4){PKW(pB0, 0), PKW(pB0, 2), PKW(pB0, 4), PKW(pB0, 6)}; pw1 = (u32x4){PKW(pB0, 8), PKW(pB0, 10), PKW(pB0, 12), PKW(pB0, 14)};
      pw2 = (u32x4){PKW(pB1, 0), PKW(pB1, 2), PKW(pB1, 4), PKW(pB1, 6)}; pw3 = (u32x4){PKW(pB1, 8), PKW(pB1, 10), PKW(pB1, 12), PKW(pB1, 14)};
      const lds_cptr vp_ = vp0 + sl_cur; _Pragma("unroll") for (int i = 0; i < 8; ++i) VRD(i);
      o[0] = MFMA32(PAF(0), VFR(0), o[0]); o[1] = MFMA32(PAF(0), VFR(4), o[1]); o[0] = MFMA32(PAF(1), VFR(1), o[0]); o[1] = MFMA32(PAF(1), VFR(5), o[1]);
      o[0] = MFMA32(PAF(2), VFR(2), o[0]); o[1] = MFMA32(PAF(2), VFR(6), o[1]); o[0] = MFMA32(PAF(3), VFR(3), o[0]); o[1] = MFMA32(PAF(3), VFR(7), o[1]); }
    { auto rr = __builtin_amdgcn_permlane32_swap(__float_as_uint(l_reg), __float_as_uint(l_reg), false, false); l_reg = __uint_as_float(rr[0]) + __uint_as_float(rr[1]); }
    if (hi == 0) wsf[32 + r32] = l_reg;
    asm volatile("s_waitcnt lgkmcnt(0)" ::: "memory");
    float rli[16];
#pragma unroll
    for (int r = 0; r < 16; ++r) rli[r] = __builtin_amdgcn_rcpf(wsf[32 + crow(r, hi)]);
    bf16_t* Ow = Og + (size_t)(wid * 32) * D; LAS bf16_t* stg = (LAS bf16_t*)(ldsl + LDS_OST) + wid * 2048;
#pragma unroll
    for (int r = 0; r < 16; ++r) { const int orow = crow(r, hi);
#pragma unroll
        for (int d0 = 0; d0 < 2; ++d0) stg[orow * 64 + d0 * 32 + r32] = f2bf(o[d0][r] * rli[r]); }
    asm volatile("s_waitcnt lgkmcnt(0)" ::: "memory");
#pragma unroll
    for (int i = 0; i < 4; ++i) { const int row = i * 8 + (lane >> 3), ch = lane & 7; *reinterpret_cast<u32x4*>(Ow + (size_t)row * D + ch * 8) = *(const LAS u32x4*)(stg + row * 64 + ch * 8); }
    asm volatile("s_waitcnt lgkmcnt(0)\n\ts_barrier" ::: "memory");
#undef DMA_K
#undef DMA_V
#undef ROT
#undef EX
#undef RESC
#undef PKW
#undef PAF
#undef VFR
#undef VRD
#undef KRD
#undef ENDW
#undef GAPA
#undef GAPB
#undef STEP
}

constexpr int SGU_ROWB = 272;
__device__ __forceinline__ void sgu_item(const Params& p, int l, LAS unsigned char* lds, const int tid, const int t0) {
    const bf16_t* AV = (const bf16_t*)(p.ws + OFF_AV) + (size_t)t0 * 256;
    {
        const int q = tid >> 2, quarter = tid & 3;
        float v[64]; float ss = 0.f;
        bf16x8 wv[8];
#pragma unroll
        for (int i = 0; i < 8; ++i) wv[i] = *reinterpret_cast<const bf16x8*>(AV + (size_t)q * 256 + quarter * 64 + i * 8);
        __builtin_amdgcn_sched_barrier(0);
#pragma unroll
        for (int i = 0; i < 8; ++i) {
#pragma unroll
            for (int j = 0; j < 8; ++j) { v[i * 8 + j] = bf2f((bf16_t)wv[i][j]); ss += v[i * 8 + j] * v[i * 8 + j]; }
        }
        { ss += DPP_F(ss, 0xB1); ss += DPP_F(ss, 0x4E); }
        const float rstd = rsqrtf(ss * (1.f / 256.f) + EPS);
        const float* g = p.in[I_SGUNG] + l * 256 + quarter * 64;
#pragma unroll
        for (int i = 0; i < 64; ++i)
            *(LAS bf16_t*)(lds + (quarter * 64 + i) * SGU_ROWB + q * 2) = f2bf(v[i] * rstd * g[i]);
    }
    __syncthreads();
    {
        const int wave = tid >> 6, lane = tid & 63, r = lane & 31, hh = lane >> 5;
        const int g = wave >> 1, ph = wave & 1;
        const bf16_t* W = (const bf16_t*)(p.ws + OFF_SGUW) + ((size_t)l * 4 + g) * 128 * 128;
        f32x16 acc[2][2];
#pragma unroll
        for (int a = 0; a < 2; ++a)
#pragma unroll
            for (int b = 0; b < 2; ++b)
#pragma unroll
                for (int i = 0; i < 16; ++i) acc[a][b][i] = 0.f;
        bf16x8 afa[8][2];
#pragma unroll
        for (int ks = 0; ks < 8; ++ks)
#pragma unroll
            for (int pt = 0; pt < 2; ++pt) afa[ks][pt] = *reinterpret_cast<const bf16x8*>(W + (size_t)(ph * 64 + pt * 32 + r) * 128 + ks * 16 + hh * 8);
        const float* bias = p.in[I_SGUB] + (l * 4 + g) * 128;
        const bf16_t* AU = (const bf16_t*)(p.ws + OFF_AU);
        bf16_t* MIX = (bf16_t*)(p.ws + OFF_MIX);
        bf16_t auv[2][2][16]; float bz[2][16];
#pragma unroll
        for (int pt = 0; pt < 2; ++pt)
#pragma unroll
            for (int i = 0; i < 16; ++i) {
                const int pp = ph * 64 + pt * 32 + (i & 3) + 8 * (i >> 2) + 4 * hh;
                bz[pt][i] = bias[pp];
#pragma unroll
                for (int ct = 0; ct < 2; ++ct) auv[pt][ct][i] = AU[(size_t)(t0 + pp) * 256 + g * 64 + ct * 32 + r];
            }
        __builtin_amdgcn_sched_barrier(0);
#pragma unroll
        for (int ks = 0; ks < 8; ++ks) {
            bf16x8 bfr[2];
#pragma unroll
            for (int ct = 0; ct < 2; ++ct) bfr[ct] = *(const LAS bf16x8*)(lds + (g * 64 + ct * 32 + r) * SGU_ROWB + (ks * 16 + hh * 8) * 2);
#pragma unroll
            for (int pt = 0; pt < 2; ++pt)
#pragma unroll
                for (int ct = 0; ct < 2; ++ct) acc[pt][ct] = MFMA32(afa[ks][pt], bfr[ct], acc[pt][ct]);
        }
#pragma unroll
        for (int pt = 0; pt < 2; ++pt)
#pragma unroll
            for (int ct = 0; ct < 2; ++ct)
#pragma unroll
                for (int i = 0; i < 16; ++i) {
                    const int pp = ph * 64 + pt * 32 + (i & 3) + 8 * (i >> 2) + 4 * hh, c = g * 64 + ct * 32 + r;
                    MIX[(size_t)(t0 + pp) * D + c] = f2bf(bf2f(auv[pt][ct][i]) * (acc[pt][ct][i] + bz[pt][i]));
                }
    }
    __syncthreads();
}

__device__ __forceinline__ void conv_item(const Params& p, const int c, LAS unsigned char* lds, const int tid) {
    const int wave = tid >> 6, lane = tid & 63;
    const bool isu = c < 256;
    const int row00 = (c & 255) * 128, lyr = row00 >> 14;
    const float* src = p.in[isu ? I_PU : I_PV] + (size_t)(row00 + wave * 16) * D + lane * 16;
    unsigned char* dst = p.ws + (isu ? OFF_UT : OFF_VT);
    float* scl = (float*)(p.ws + OFF_USH) + (isu ? 0 : 1);
    float4 f[4][4], g[4][4];
#pragma unroll
    for (int q = 0; q < 4; ++q)
#pragma unroll
        for (int i = 0; i < 4; ++i) f[q][i] = *reinterpret_cast<const float4*>(src + (size_t)q * D + i * 4);
#pragma unroll
    for (int step = 0; step < 4; ++step) {
        if (step < 3) {
#pragma unroll
            for (int q = 0; q < 4; ++q)
#pragma unroll
                for (int i = 0; i < 4; ++i) g[q][i] = *reinterpret_cast<const float4*>(src + (size_t)((step + 1) * 4 + q) * D + i * 4);
        }
        const int row0 = row00 + wave * 16 + step * 4;
#pragma unroll
        for (int q = 0; q < 4; ++q) {
            const int row = row0 + q, e = row & (NEXP - 1);
            float v[16];
#pragma unroll
            for (int i = 0; i < 4; ++i) { v[i * 4] = f[q][i].x; v[i * 4 + 1] = f[q][i].y; v[i * 4 + 2] = f[q][i].z; v[i * 4 + 3] = f[q][i].w; }
            float am = 0.f;
#pragma unroll
            for (int i = 0; i < 16; ++i) am = fmaxf(am, fabsf(v[i]));
            am = wave_max(am);
            const float sc = am > 0.f ? 127.f / am : 1.f;
            unsigned w[4];
#pragma unroll
            for (int i = 0; i < 4; ++i) w[i] = pack4_i8(q8(v[i * 4] * sc), q8(v[i * 4 + 1] * sc), q8(v[i * 4 + 2] * sc), q8(v[i * 4 + 3] * sc));
            *reinterpret_cast<u32x4*>(dst + (((size_t)lyr * 8 + (lane >> 3)) * NEXP + e) * 128 + (lane & 7) * 16) = u32x4{w[0], w[1], w[2], w[3]};
            if (lane == 0) scl[(size_t)row * 8] = am > 0.f ? am * (1.f / 127.f) : 1.f;
        }
        if (step < 3) {
#pragma unroll
            for (int q = 0; q < 4; ++q)
#pragma unroll
                for (int i = 0; i < 4; ++i) f[q][i] = g[q][i];
        }
    }
}

__device__ void ph_mixers(const Params& p, int lq, unsigned char* ldsraw, const int wv) {
    asm volatile("" : "+s"(lq));
    const int l = lq & 1;
    const int tid0 = opaque_tid(wv);
    LAS unsigned char* lds = (LAS unsigned char*)ldsraw;
    volatile LAS int* qslot = (volatile LAS int*)(ldsraw - LDS_HDR + 64);
    unsigned* qw = (unsigned*)(p.ws + OFF_BAR) + QW_MIX + lq;
    const float lam = __builtin_bit_cast(float, __builtin_amdgcn_readfirstlane(__builtin_bit_cast(int, lam_of(p, l))));
    unsigned char* ws = p.ws;
    bool first = true;
    for (;;) {
        int item;
        if (first) { item = (int)blockIdx.x; first = false; }
        else {
            if (tid0 == 0) *qslot = (int)(gridDim.x + atomicAdd(qw, 1u));
            __syncthreads();
            item = *qslot;
            __syncthreads();
        }
        if (lq == 0) {
            if (item >= 1536) break;
            if (item < 1280) {
                const int grp = item >> 1;
                if (item & 1) { int tidc = tid0; asm volatile("" : "+v"(tidc)); if (grp < 128) fold_item(p, grp, tidc); else conv_item(p, grp - 128, lds, tidc); continue; }
                item = grp;
            } else item = 640 + (item - 1280);
        }
        if (item >= 896) break;
        if (lq >= 2 && PROBE_DUP >= 10) {
            const int cls = item < 128 ? 10 : (item < 384 ? 11 : 12);
            if (cls != PROBE_DUP) continue;
        }
        int tid = tid0; asm volatile("" : "+v"(tid));
        if (item < 128) {
            const int qc = item & 7, h = (item >> 3) & 3, b = item >> 5;
            const int t0 = NPT + b * DSEQ + qc * 256;
            attn_item<true>(p, l, lds, tid, (const bf16_t*)(ws + OFF_DQ) + (size_t)t0 * 256 + h * 64, 256,
                            (const bf16_t*)(ws + OFF_DKS) + ((size_t)b * 4 + h) * NKS * 64, (const bf16_t*)(ws + OFF_DVTS) + ((size_t)b * 4 + h) * 64 * NKS, NKS,
                            (bf16_t*)(ws + OFF_MIX) + (size_t)t0 * D + 256 + h * 64, lam);
        } else if (item < 384) {
            const int it = item - 128, qc = it & 7, hq = (it >> 3) & 7, b = it >> 6, kv = hq >> 2;
            const int t0 = NPT + b * DSEQ + qc * 256;
            gqa_unit(lds, tid, wv, (const bf16_t*)(ws + OFF_GQ) + (size_t)t0 * 512 + hq * 64, 512,
                     ws + OFF_GKS + ((size_t)b * 2 + kv) * NKS * 128, ws + OFF_GVTS + ((size_t)b * 2 + kv) * NKS * 128, NKS / 64,
                     (bf16_t*)(ws + OFF_MIX) + (size_t)t0 * D + 512 + hq * 64);
        } else if (item < 512) {
            sgu_item(p, l, lds, tid, (item - 384) * 128);
        } else if (item < 768) {
            const int it = item - 512, hq = it & 7, b = it >> 3, kv = hq >> 2;
            const int t0 = b * SEQ;
            gqa_unit(lds, tid, wv, (const bf16_t*)(ws + OFF_GQ) + (size_t)t0 * 512 + hq * 64, 512,
                     ws + OFF_GKP + ((size_t)b * 2 + kv) * SEQ * 128, ws + OFF_GVTP + ((size_t)b * 2 + kv) * SEQ * 128, SEQ / 64,
                     (bf16_t*)(ws + OFF_MIX) + (size_t)t0 * D + 512 + hq * 64);
        } else {
            const int it = item - 768, h = it & 3, b = it >> 2;
            const int t0 = b * SEQ;
            attn_item<true>(p, l, lds, tid, (const bf16_t*)(ws + OFF_DQ) + (size_t)t0 * 256 + h * 64, 256,
                            (const bf16_t*)(ws + OFF_DKP) + ((size_t)b * 4 + h) * SEQ * 64, (const bf16_t*)(ws + OFF_DVTP) + ((size_t)b * 4 + h) * 64 * SEQ, SEQ,
                            (bf16_t*)(ws + OFF_MIX) + (size_t)t0 * D + 256 + h * 64, lam);
        }
    }
}


using bf16x2 = __attribute__((ext_vector_type(2))) __bf16;
__device__ __forceinline__ float dot2bf(unsigned a, unsigned b, float c) {
    return __builtin_amdgcn_fdot2_f32_bf16(__builtin_bit_cast(bf16x2, a), __builtin_bit_cast(bf16x2, b), c, false);
}
template <int W>
__device__ __forceinline__ void bfly_stage(float (&part)[64], const int lane) {
    const bool hi = (lane & W) != 0;
#pragma unroll
    for (int k = 0; k < W; ++k) {
        const float keep = hi ? part[k + W] : part[k];
        const float send = hi ? part[k] : part[k + W];
        part[k] = keep + shfl_x(send, lane, W);
    }
}
constexpr int QW_GRP = 4352;
constexpr int QW_PEER = 4160;
template <int W>
__device__ __forceinline__ void bfly16_stage(float (&v)[16], const int lane, const int bit) {
    const bool hi = (lane & bit) != 0;
#pragma unroll
    for (int k = 0; k < W; ++k) {
        const float keep = hi ? v[k + W] : v[k];
        const float send = hi ? v[k] : v[k + W];
        v[k] = keep + shfl_x(send, lane, bit);
    }
}
template <int W>
__device__ __forceinline__ void bfly16i_stage(int (&v)[16], const int lane, const int bit) {
    const bool hi = (lane & bit) != 0;
#pragma unroll
    for (int k = 0; k < W; ++k) {
        const int keep = hi ? v[k + W] : v[k];
        const int send = hi ? v[k] : v[k + W];
        v[k] = keep + shfl_x(send, lane, bit);
    }
}
template <bool VSIDE> struct PeerTok {
    static __device__ __forceinline__ void issue(const Params& p, const unsigned char* Tslice, const int elo, const int ehi, const int t, const int s,
                                                 const int sub, const int c16, u32x4 (&a)[16], u32x4 (&h)[2]) {
#pragma unroll
        for (int i = 0; i < 16; ++i) {
            const int e = shfl_i(i < 8 ? elo : ehi, (i * 8 + sub) & 63);
            a[i] = *reinterpret_cast<const u32x4*>(Tslice + (((unsigned)e << 7) + (unsigned)c16 * 16u));
        }
        if (!VSIDE) h[0] = *reinterpret_cast<const u32x4*>(p.ws + OFF_H8I + (size_t)t * D + s * 128 + c16 * 16);
    }
    static __device__ __forceinline__ void compute(const Params& p, const int l, const u32x4 w4, const float wsc, const int t, const int s,
                                                   const int lane, const int sub, const int c16, const u32x4 (&a)[16], const u32x4 (&h)[2]) {
        if (!VSIDE) {
            int d[16];
#pragma unroll
            for (int i = 0; i < 16; ++i) {
                int acc = 0;
#pragma unroll
                for (int k = 0; k < 4; ++k) acc = __builtin_amdgcn_sdot4((int)a[i][k], (int)h[0][k], acc, false);
                d[i] = acc;
            }
            bfly16i_stage<8>(d, lane, 4); bfly16i_stage<4>(d, lane, 2); bfly16i_stage<2>(d, lane, 1);
            const int i0 = ((lane & 4) << 1) + ((lane & 2) << 1) + ((lane & 1) << 1);
            unsigned* PART = (unsigned*)(p.ws + OFF_PART) + (((size_t)s * NTOK + t) * 128 + sub * 16 + i0) / 2;
            *PART = ((unsigned)((d[0] + 32) >> 6) & 0xffffu) | ((unsigned)((d[1] + 32) >> 6) << 16);
        } else {
            int acc[16];
#pragma unroll
            for (int i = 0; i < 16; ++i) acc[i] = 0;
#pragma unroll
            for (int g = 0; g < 4; ++g) {
                const int wg = (int)w4[g];
#pragma unroll
                for (int k = 0; k < 4; ++k) {
                    const unsigned r0 = a[4 * g][k], r1 = a[4 * g + 1][k], r2 = a[4 * g + 2][k], r3 = a[4 * g + 3][k];
                    const unsigned x01l = __builtin_amdgcn_perm(r1, r0, 0x05010400u), x01h = __builtin_amdgcn_perm(r1, r0, 0x07030602u);
                    const unsigned x23l = __builtin_amdgcn_perm(r3, r2, 0x05010400u), x23h = __builtin_amdgcn_perm(r3, r2, 0x07030602u);
                    const unsigned t0 = __builtin_amdgcn_perm(x23l, x01l, 0x05040100u), t1 = __builtin_amdgcn_perm(x23l, x01l, 0x07060302u);
                    const unsigned t2 = __builtin_amdgcn_perm(x23h, x01h, 0x05040100u), t3 = __builtin_amdgcn_perm(x23h, x01h, 0x07060302u);
                    acc[4 * k]     = __builtin_amdgcn_sdot4((int)t0, wg, acc[4 * k], false);
                    acc[4 * k + 1] = __builtin_amdgcn_sdot4((int)t1, wg, acc[4 * k + 1], false);
                    acc[4 * k + 2] = __builtin_amdgcn_sdot4((int)t2, wg, acc[4 * k + 2], false);
                    acc[4 * k + 3] = __builtin_amdgcn_sdot4((int)t3, wg, acc[4 * k + 3], false);
                }
            }
            bfly16i_stage<8>(acc, lane, 32); bfly16i_stage<4>(acc, lane, 16); bfly16i_stage<2>(acc, lane, 8);
            const int col = s * 128 + c16 * 16 + ((lane & 32) >> 2) + ((lane & 16) >> 2) + ((lane & 8) >> 2);
            const float* g2 = (const float*)(p.ws + OFF_MOD) + (size_t)(l * 5 + tok_cv(t)) * 6144 + 5 * 1024 + col;
            unsigned* XC = reinterpret_cast<unsigned*>((bf16_t*)(p.ws + OFF_XC) + (size_t)t * D + col);
            const unsigned x = *XC; const float2 g = *reinterpret_cast<const float2*>(g2);
            const float xa = __uint_as_float(x << 16) + g.x * wsc * (float)acc[0], xb = __uint_as_float(x & 0xffff0000u) + g.y * wsc * (float)acc[1];
            *XC = pack_bf2(xa, xb);
            if (l == 0) {
                const float ss = wave_sum(xa * xa + xb * xb);
                if (lane == 0) ((float*)(p.ws + OFF_RSS1))[(size_t)t * 8 + s] = ss;
            }
        }
    }
};
template <bool VSIDE>
__device__ __forceinline__ void peer_slice_stream(const Params& p, const int l, const int s, const int first, const int stride, const int lane) {
    const int sub = lane >> 3, c16 = lane & 7;
    const unsigned char* Ts = p.ws + (VSIDE ? OFF_VT : OFF_UT) + ((size_t)l * 8 + s) * NEXP * 128;
    const int* EIb = (const int*)(p.ws + OFF_EIDX); const unsigned char* WPb = p.ws + OFF_WPAIR; const float* WSb = (const float*)(p.ws + OFF_WSC);
    if (first >= NTOK) return;
    const int cnt = (NTOK - first + stride - 1) / stride;
#define PEER_LOADE(k, elo, ehi, w4, wsc) do { const int _t = min(first + (k) * stride, NTOK - 1); \
        elo = EIb[(size_t)_t * 128 + lane]; ehi = EIb[(size_t)_t * 128 + 64 + lane]; \
        if (VSIDE) { w4 = *reinterpret_cast<const u32x4*>(WPb + (size_t)_t * 128 + sub * 16); wsc = WSb[_t]; } } while (0)
    int e0l, e0h, e1l, e1h, e2l, e2h;
    u32x4 w0 = {0u, 0u, 0u, 0u}, w1 = {0u, 0u, 0u, 0u}, w2 = {0u, 0u, 0u, 0u}; float s0 = 0.f, s1 = 0.f, s2 = 0.f;
    u32x4 A[16], B[16], hA[2], hB[2];
    PEER_LOADE(0, e0l, e0h, w0, s0);
    PEER_LOADE(1, e1l, e1h, w1, s1);
    PeerTok<VSIDE>::issue(p, Ts, e0l, e0h, first, s, sub, c16, A, hA);
    for (int k = 0; k < cnt; k += 2) {
        const int ta = first + k * stride, tb = min(ta + stride, NTOK - 1), tc = min(ta + 2 * stride, NTOK - 1);
        __builtin_amdgcn_sched_barrier(0);
        __builtin_amdgcn_s_setprio(3);
        PEER_LOADE(k + 2, e2l, e2h, w2, s2);
        PeerTok<VSIDE>::issue(p, Ts, e1l, e1h, tb, s, sub, c16, B, hB);
        __builtin_amdgcn_s_setprio(0);
        __builtin_amdgcn_sched_barrier(0);
        PeerTok<VSIDE>::compute(p, l, w0, s0, ta, s, lane, sub, c16, A, hA);
        __builtin_amdgcn_sched_barrier(0);
        e0l = e2l; e0h = e2h; w0 = w2; s0 = s2;
        __builtin_amdgcn_s_setprio(3);
        PEER_LOADE(k + 3, e2l, e2h, w2, s2);
        PeerTok<VSIDE>::issue(p, Ts, e0l, e0h, tc, s, sub, c16, A, hA);
        __builtin_amdgcn_s_setprio(0);
        __builtin_amdgcn_sched_barrier(0);
        if (k + 1 < cnt) PeerTok<VSIDE>::compute(p, l, w1, s1, tb, s, lane, sub, c16, B, hB);
        e1l = e2l; e1h = e2h; w1 = w2; s1 = s2;
    }
#undef PEER_LOADE
}
typedef int v2i32_t __attribute__((ext_vector_type(2)));
__device__ __forceinline__ void peer_vstream_lds(const Params& p, const int l, const int s, const int first, const int stride, const int lane, LAS unsigned char* R, LAS unsigned char* RG) {
    const unsigned char* Ts = p.ws + OFF_VT + ((size_t)l * 8 + s) * NEXP * 128;
    const int* EIb = (const int*)(p.ws + OFF_EIDX); const unsigned char* WPb = p.ws + OFF_WPAIR; const float* WSb = (const float*)(p.ws + OFF_WSC);
    if (first >= NTOK) return;
    const int cnt = (NTOK - first + stride - 1) / stride;
    const int gsub = lane >> 3;
    const unsigned gch = (unsigned)(((lane & 7) ^ gsub) * 16);
    const int G = lane >> 4, rr = (lane & 15) >> 1, hh = lane & 1;
    const LAS unsigned char* tr0 = R + rr * 128 + ((G ^ rr) * 16) + hh * 8;
    const LAS unsigned char* tr1 = R + rr * 128 + (((4 + G) ^ rr) * 16) + hh * 8;
    const bf16_t* XCs = (const bf16_t*)(p.ws + OFF_XC) + s * 128;
    const unsigned ldsR = (unsigned)(size_t)R, ldsG = (unsigned)(size_t)RG;
    float gt0[5], gt1[5];
#pragma unroll
    for (int cv = 0; cv < 5; ++cv) { const float* _g = (const float*)(p.ws + OFF_MOD) + (size_t)(l * 5 + cv) * 6144 + 5 * 1024 + s * 128 + lane; gt0[cv] = _g[0]; gt1[cv] = _g[64]; }
#define PV_PRE_E(k) do { const int _t = min(first + (k) * stride, NTOK - 1); const unsigned _b = (unsigned)__builtin_amdgcn_readfirstlane((int)(ldsG + ((k) % 3) * 1024)); \
        ga::glds4(EIb + (size_t)_t * 128 + lane, _b); ga::glds4(EIb + (size_t)_t * 128 + 64 + lane, _b + 256); } while (0)
#define PV_PRE_W(k) do { const int _t = min(first + (k) * stride, NTOK - 1); const unsigned _b = (unsigned)__builtin_amdgcn_readfirstlane((int)(ldsG + ((k) % 3) * 1024)); \
        if (lane < 8) ga::glds16(WPb + (size_t)_t * 128 + lane * 16, _b + 512); \
        ga::glds4((const unsigned*)(XCs + (size_t)_t * D) + lane, _b + 640); \
        if (lane == 0) ga::glds4(WSb + _t, _b + 896); } while (0)
#define PV_DMA(k) do { unsigned _off[16]; const LAS unsigned* _eb = (const LAS unsigned*)(RG + ((k) % 3) * 1024); \
        _Pragma("unroll") for (int _q = 0; _q < 16; ++_q) _off[_q] = (_eb[(_q & 1) * 64 + gsub * 8 + (_q >> 1)] << 7) + gch;                \
        asm volatile("s_waitcnt lgkmcnt(0)" ::: "memory"); __builtin_amdgcn_sched_barrier(0); \
        __builtin_amdgcn_s_setprio(3); \
        _Pragma("unroll") for (int _q = 0; _q < 16; ++_q) ga::glds16(Ts + _off[_q], (unsigned)__builtin_amdgcn_readfirstlane((int)(ldsR + _q * 1024))); \
        __builtin_amdgcn_s_setprio(0); } while (0)
    PV_PRE_E(0); PV_PRE_E(1); PV_PRE_W(0);
    asm volatile("s_waitcnt vmcnt(0)" ::: "memory");
    PV_DMA(0);
    PV_PRE_E(2); PV_PRE_W(1);
    for (int k = 0; k < cnt; ++k) {
        const int t = first + k * stride;
        if (k == 0) asm volatile("s_waitcnt vmcnt(5)" ::: "memory"); else if (l == 0) asm volatile("s_waitcnt vmcnt(8)" ::: "memory"); else asm volatile("s_waitcnt vmcnt(7)" ::: "memory");
        v2i32_t T0[16], T1[16];
#pragma unroll
        for (int sb = 0; sb < 16; ++sb) {
            T0[sb] = __builtin_amdgcn_ds_read_tr8_b64_v2i32((LAS v2i32_t*)(tr0 + sb * 1024));
            T1[sb] = __builtin_amdgcn_ds_read_tr8_b64_v2i32((LAS v2i32_t*)(tr1 + sb * 1024));
        }
        const LAS unsigned char* rg = RG + (k % 3) * 1024;
        const float scA = *(const LAS float*)(rg + 896);
        const bf16_t xA0 = *(const LAS bf16_t*)(rg + 640 + lane * 2), xA1 = *(const LAS bf16_t*)(rg + 640 + 128 + lane * 2);
        asm volatile("s_waitcnt lgkmcnt(0)" ::: "memory");
        if (k + 1 < cnt) PV_DMA(k + 1);
        PV_PRE_E(k + 3); PV_PRE_W(k + 2);
        int acc0 = 0, acc1 = 0;
#pragma unroll
        for (int sp = 0; sp < 8; ++sp) {
            const u32x4 wq = *(const LAS u32x4*)(rg + 512 + sp * 16);
            acc0 = __builtin_amdgcn_sdot4(T0[2 * sp][0], (int)wq[0], acc0, false); acc0 = __builtin_amdgcn_sdot4(T0[2 * sp][1], (int)wq[1], acc0, false);
            acc1 = __builtin_amdgcn_sdot4(T1[2 * sp][0], (int)wq[0], acc1, false); acc1 = __builtin_amdgcn_sdot4(T1[2 * sp][1], (int)wq[1], acc1, false);
            acc0 = __builtin_amdgcn_sdot4(T0[2 * sp + 1][0], (int)wq[2], acc0, false); acc0 = __builtin_amdgcn_sdot4(T0[2 * sp + 1][1], (int)wq[3], acc0, false);
            acc1 = __builtin_amdgcn_sdot4(T1[2 * sp + 1][0], (int)wq[2], acc1, false); acc1 = __builtin_amdgcn_sdot4(T1[2 * sp + 1][1], (int)wq[3], acc1, false);
        }
        const int cv = tok_cv(t);
        const float gA0 = cv == 0 ? gt0[0] : (cv == 1 ? gt0[1] : (cv == 2 ? gt0[2] : (cv == 3 ? gt0[3] : gt0[4])));
        const float gA1 = cv == 0 ? gt1[0] : (cv == 1 ? gt1[1] : (cv == 2 ? gt1[2] : (cv == 3 ? gt1[3] : gt1[4])));
        const float xa = bf2f(xA0) + gA0 * scA * (float)acc0, xb = bf2f(xA1) + gA1 * scA * (float)acc1;
        bf16_t* XCw = (bf16_t*)(p.ws + OFF_XC) + (size_t)t * D + s * 128 + lane;
        XCw[0] = f2bf(xa); XCw[64] = f2bf(xb);
        if (l == 0) {
            const float ss = wave_sum(xa * xa + xb * xb);
            if (lane == 0) ((float*)(p.ws + OFF_RSS1))[(size_t)t * 8 + s] = ss;
        }
    }
    asm volatile("s_waitcnt vmcnt(0)" ::: "memory");
#undef PV_PRE_E
#undef PV_PRE_W
#undef PV_DMA
}
template <bool VSIDE>
__device__ void ph_peer_sliced(const Params& p, int l, unsigned char* ldsraw, const int wv) {
    asm volatile("" : "+s"(l));
    const int tid = opaque_tid(wv);
    const int wave = tid >> 6, lane = tid & 63;
    volatile LAS int* hdr = (volatile LAS int*)(ldsraw - LDS_HDR);
    unsigned* bar = (unsigned*)(p.ws + OFF_BAR);
    const int myx = (int)(xb_xcc_id() & 15u);
    if (tid == 0 && hdr[17] == 0) {
        unsigned cnt[8];
#pragma unroll
        for (int j = 0; j < 8; ++j) cnt[j] = xb_ld(&bar[XB_XCNT(j)]);
        const int rk = (int)atomicAdd(bar + QW_PEER + myx, 1u);
        int m = 0;
#pragma unroll
        for (int j = 0; j < 8; ++j) m |= (cnt[j] == 0u ? 1 : 0) << j;
        hdr[18] = m; hdr[17] = rk + 1;
    }
    __syncthreads();
    const int rank = hdr[17] - 1, nloc = (int)hdr[0];
    const int emask = __builtin_amdgcn_readfirstlane(hdr[18]);
    __syncthreads();
    if (VSIDE) {
        LAS unsigned char* R = (LAS unsigned char*)ldsraw + wave * 19456;
        LAS unsigned char* RG = R + 16384;
        if (myx < 8) peer_vstream_lds(p, l, myx, rank * 8 + wave, nloc * 8, lane, R, RG);
        for (int j = 0; j < 8; ++j) {
            if ((emask >> j) & 1) peer_vstream_lds(p, l, j, (int)blockIdx.x * 8 + wave, (int)gridDim.x * 8, lane, R, RG);
        }
    } else {
        if (myx < 8) peer_slice_stream<VSIDE>(p, l, myx, rank * 8 + wave, nloc * 8, lane);
        for (int j = 0; j < 8; ++j) {
            if ((emask >> j) & 1) peer_slice_stream<VSIDE>(p, l, j, (int)blockIdx.x * 8 + wave, (int)gridDim.x * 8, lane);
        }
    }
}
__device__ void ph_peer_pairw(const Params& p, int l, const int wv) {
    asm volatile("" : "+s"(l));
    const int tid = opaque_tid(wv);
    const int lane = tid & 63;
    const float* EREC = (const float*)(p.ws + OFF_USH) + (size_t)l * NEXP * 8;
    const unsigned short* PART = (const unsigned short*)(p.ws + OFF_PART);
    constexpr size_t NIT = (size_t)NTOK * 32;
    for (size_t i4 = GTID; i4 < NIT; i4 += 2 * GNT) {
        size_t idx[2]; int t[2], e[2][4]; float g[2][4]; uint2 ps[2][8]; float4 ra[2], rb[2], xa[2], xb[2];
#pragma unroll
        for (int u = 0; u < 2; ++u) {
            const size_t iu = i4 + (size_t)u * GNT < NIT ? i4 + (size_t)u * GNT : i4;
            idx[u] = iu * 4; t[u] = (int)(idx[u] >> 7);
            const int pp = (int)(idx[u] & 127), sub = pp >> 4, i = pp & 15;
#pragma unroll
            for (int q = 0; q < 4; ++q) {
                const int j = (i + q) * 8 + sub;
                e[u][q] = ((const int*)(p.ws + OFF_EIDX))[(size_t)t[u] * 128 + j];
            }
        }
#pragma unroll
        for (int u = 0; u < 2; ++u) {
            const int pp = (int)(idx[u] & 127), sub = pp >> 4, i = pp & 15;
#pragma unroll
            for (int q = 0; q < 4; ++q) g[u][q] = ((const float*)(p.ws + OFF_EGATE))[(size_t)t[u] * 128 + (i + q) * 8 + sub];
#pragma unroll
            for (int s = 0; s < 8; ++s) ps[u][s] = *reinterpret_cast<const uint2*>(PART + (size_t)s * NTOK * 128 + idx[u]);
            const float* rp = (const float*)(p.ws + OFF_RSS2) + ((size_t)l * NTOK + t[u]) * 8;
            ra[u] = *reinterpret_cast<const float4*>(rp); rb[u] = *reinterpret_cast<const float4*>(rp + 4);
            const float* xp = (const float*)(p.ws + OFF_XGS) + (size_t)t[u] * 8;
            xa[u] = *reinterpret_cast<const float4*>(xp); xb[u] = *reinterpret_cast<const float4*>(xp + 4);
        }
        float4 r0[2][4], r1[2][4];
#pragma unroll
        for (int u = 0; u < 2; ++u)
#pragma unroll
            for (int q = 0; q < 4; ++q) {
                const float* rec = EREC + (size_t)e[u][q] * 8;
                r0[u][q] = *reinterpret_cast<const float4*>(rec); r1[u][q] = *reinterpret_cast<const float4*>(rec + 4);
            }
#pragma unroll
        for (int u = 0; u < 2; ++u) {
            const float hs = rsqrtf((((ra[u].x + ra[u].y) + (ra[u].z + ra[u].w)) + ((rb[u].x + rb[u].y) + (rb[u].z + rb[u].w))) * (1.f / D) + EPS);
            const float xs[8] = {xa[u].x, xa[u].y, xa[u].z, xa[u].w, xb[u].x, xb[u].y, xb[u].z, xb[u].w};
            float sm[4] = {0.f, 0.f, 0.f, 0.f};
#pragma unroll
            for (int s = 0; s < 8; ++s) {
                const uint2 w = ps[u][s];
                sm[0] += xs[s] * (float)((int)(w.x << 16) >> 16); sm[1] += xs[s] * (float)((int)w.x >> 16);
                sm[2] += xs[s] * (float)((int)(w.y << 16) >> 16); sm[3] += xs[s] * (float)((int)w.y >> 16);
            }
            const int cvt = tok_cv(t[u]);
            float w[4];
#pragma unroll
            for (int q = 0; q < 4; ++q) {
                const float4 ra4 = r0[u][q], rb4 = r1[u][q];
                const float ush = cvt == 0 ? ra4.z : (cvt == 1 ? ra4.w : (cvt == 2 ? rb4.x : (cvt == 3 ? rb4.y : rb4.z)));
                w[q] = g[u][q] * gelu_f(sm[q] * 64.f * (ra4.x * hs) + ush) * ra4.y;
            }
            float am = fmaxf(fmaxf(fabsf(w[0]), fabsf(w[1])), fmaxf(fabsf(w[2]), fabsf(w[3])));
            am = row16_max(am); am = fmaxf(am, shfl_x(am, lane, 16));
            const float sc = am > 0.f ? 127.f / am : 1.f;
            *reinterpret_cast<unsigned*>(p.ws + OFF_WPAIR + idx[u]) = pack4_i8(q8(w[0] * sc), q8(w[1] * sc), q8(w[2] * sc), q8(w[3] * sc));
            if ((idx[u] & 127) == 0) ((float*)(p.ws + OFF_WSC))[t[u]] = am > 0.f ? am * (1.f / 127.f) : 1.f;
        }
    }
}

#define CE_DESC(a, b) do { const float _mx = fmaxf((a), (b)); const float _mn = fminf((a), (b)); (a) = _mx; (b) = _mn; } while (0)
__device__ __forceinline__ void sort16_desc(float (&v)[16]) {
#pragma unroll
    for (int k = 2; k <= 16; k <<= 1)
#pragma unroll
        for (int j = k >> 1; j > 0; j >>= 1)
#pragma unroll
            for (int i = 0; i < 16; ++i) {
                const int m = i ^ j;
                if (m > i) { if ((i & k) == 0) CE_DESC(v[i], v[m]); else CE_DESC(v[m], v[i]); }
            }
}
__device__ __forceinline__ void merge_top16(float (&a)[16], const float (&b)[16]) {
#pragma unroll
    for (int i = 0; i < 16; ++i) a[i] = fmaxf(a[i], b[15 - i]);
#pragma unroll
    for (int j = 8; j > 0; j >>= 1)
#pragma unroll
        for (int i = 0; i < 16; ++i) { const int m = i ^ j; if (m > i) CE_DESC(a[i], a[m]); }
}
__device__ __forceinline__ float key_embed(float v, unsigned lowmask, unsigned idxbits) { return __uint_as_float((__float_as_uint(v) & ~lowmask) | idxbits); }

constexpr int SK_ROWB = 144;
__device__ __forceinline__ void peer_qload(const bf16_t* __restrict__ Qrow  , const int hh, bf16x8 (&qb)[4]) {
#pragma unroll
    for (int ks = 0; ks < 4; ++ks) qb[ks] = *reinterpret_cast<const bf16x8*>(Qrow + ks * 16 + hh * 8);
}
__device__ __forceinline__ void peer_stage1(const LAS unsigned char* SK  , const bf16x8 (&qb)[4]  ,
                                            const int r, const int hh, float (&out)[16]) {
    float grp[4][16];
#pragma unroll
    for (int mt = 0; mt < 4; ++mt) {
        f32x16 acc;
#pragma unroll
        for (int i = 0; i < 16; ++i) acc[i] = 0.f;
#pragma unroll
        for (int ks = 0; ks < 4; ++ks) {
            const bf16x8 a = *(const LAS bf16x8*)(SK + (mt * 32 + r) * SK_ROWB + (ks * 16 + hh * 8) * 2);
            acc = MFMA32(a, qb[ks], acc);
        }
        const unsigned hx = (unsigned)hh << 2;
#pragma unroll
        for (int i = 0; i < 16; ++i) {
            const unsigned cn = 32u * mt + (i & 3) + 8u * (i >> 2);
            grp[mt][i] = key_embed(acc[i], 127u, (127u - cn) ^ hx);
        }
        sort16_desc(grp[mt]);
    }
    merge_top16(grp[0], grp[1]); merge_top16(grp[2], grp[3]); merge_top16(grp[0], grp[2]);
    float pb[16];
#pragma unroll
    for (int i = 0; i < 16; ++i) pb[i] = shfl_x(grp[0][i], (hh << 5) | r, 32);
    merge_top16(grp[0], pb);
#pragma unroll
    for (int i = 0; i < 16; ++i) out[i] = grp[0][i];
}

__device__ void ph_peer_select(const Params& p, int l, unsigned char* ldsraw, const int wv) {
    asm volatile("" : "+s"(l));
    const int tid = opaque_tid(wv);
    const int wave = tid >> 6, lane = tid & 63, r = lane & 31, hh = lane >> 5;
    const int gw = blockIdx.x * 8 + wave, nw = gridDim.x * 8;
    LAS unsigned char* skl = (LAS unsigned char*)ldsraw;
    LAS unsigned char* myl = skl + 2 * 128 * SK_ROWB + wave * 2048 + lane * 32;
    {
        const bf16_t* SKg = (const bf16_t*)(p.ws + OFF_SUBK) + (size_t)l * 2 * 128 * 64;
        for (int i = tid; i < 2 * 128 * 8; i += NT) {
            const int row = i >> 3, ch = i & 7;
            *(LAS u32x4*)(skl + row * SK_ROWB + ch * 16) = *reinterpret_cast<const u32x4*>(SKg + (size_t)row * 64 + ch * 8);
        }
        __syncthreads();
    }
    const bool local = gridDim.x == 256;
    for (int task = local ? 0 : gw; task < (NTOK / 32) * 4; task += nw) {
        int tg, hA, hB;
        if (local) {
            const int vb = (int)(blockIdx.x % 8) * 32 + (int)(blockIdx.x / 8), x = vb >> 5, j = vb & 31;
            tg = (x * 8 + (j >> 2)) * 8 + wave; hA = 2 * (j & 3); hB = hA + 1;
        } else { tg = task >> 2; hA = task & 3; hB = hA + 4; }
        const int t = tg * 32 + r;
        const bf16_t* Qt = (const bf16_t*)(p.ws + OFF_Q) + (size_t)t * D;
        float sv[2][16];
        {
            bf16x8 qa[4], qb2[4];
            float la[16], lb[16];
            peer_qload(Qt + hA * 128, hh, qa);
            peer_qload(Qt + hB * 128, hh, qb2);
            peer_stage1(skl, qa, r, hh, la);
            peer_qload(Qt + hA * 128 + 64, hh, qa);
            peer_stage1(skl, qb2, r, hh, lb);
            peer_qload(Qt + hB * 128 + 64, hh, qb2);
#pragma unroll
            for (int i = 0; i < 16; ++i) sv[0][i] = hh ? lb[i] : la[i];
            peer_stage1(skl + 128 * SK_ROWB, qa, r, hh, la);
            peer_stage1(skl + 128 * SK_ROWB, qb2, r, hh, lb);
#pragma unroll
            for (int i = 0; i < 16; ++i) sv[1][i] = hh ? lb[i] : la[i];
        }
        {
            unsigned w[8];
#pragma unroll
            for (int q = 0; q < 8; ++q) {
                w[q] = 0u;
#pragma unroll
                for (int b = 0; b < 4; ++b) {
                    const int i = q * 4 + b;
                    const unsigned key = __float_as_uint(i < 16 ? sv[0][i] : sv[1][i - 16]);
                    w[q] |= (127u - (key & 127u)) << (8 * b);
                }
            }
            *(LAS u32x4*)(myl) = u32x4{w[0], w[1], w[2], w[3]};
            *(LAS u32x4*)(myl + 16) = u32x4{w[4], w[5], w[6], w[7]};
        }
        float val0[16], val1[16];
#pragma unroll
        for (int i = 0; i < 16; ++i) { val0[i] = __uint_as_float(__float_as_uint(sv[0][i]) & ~127u); val1[i] = __uint_as_float(__float_as_uint(sv[1][i]) & ~127u); }
        float g0[16], g1[16], g2[16], g3[16];
#pragma unroll
        for (int b = 0; b < 16; ++b) g0[b] = key_embed(val0[0] + val1[b], 255u, 255u - (unsigned)b);
#pragma unroll
        for (int b = 0; b < 8; ++b) g1[b] = key_embed(val0[1] + val1[b], 255u, 255u - (16u + b));
#pragma unroll
        for (int b = 0; b < 5; ++b) g1[8 + b] = key_embed(val0[2] + val1[b], 255u, 255u - (32u + b));
#pragma unroll
        for (int b = 0; b < 3; ++b) g1[13 + b] = key_embed(val0[4] + val1[b], 255u, 255u - (64u + b));
#pragma unroll
        for (int b = 0; b < 4; ++b) g2[b] = key_embed(val0[3] + val1[b], 255u, 255u - (48u + b));
#pragma unroll
        for (int a = 5; a < 8; ++a)
#pragma unroll
            for (int b = 0; b < 2; ++b) g2[4 + (a - 5) * 2 + b] = key_embed(val0[a] + val1[b], 255u, 255u - (16u * a + b));
#pragma unroll
        for (int a = 8; a < 14; ++a) g2[10 + (a - 8)] = key_embed(val0[a] + val1[0], 255u, 255u - 16u * a);
        g3[0] = key_embed(val0[14] + val1[0], 255u, 255u - 16u * 14); g3[1] = key_embed(val0[15] + val1[0], 255u, 255u - 16u * 15);
#pragma unroll
        for (int i = 2; i < 16; ++i) g3[i] = -3.0e38f;
        sort16_desc(g1); sort16_desc(g2); sort16_desc(g3);
        merge_top16(g0, g1); merge_top16(g2, g3); merge_top16(g0, g2);
        float gate[16]; int eid[16];
        const float mx = __uint_as_float(__float_as_uint(g0[0]) & ~255u);
        float sum = 0.f;
#pragma unroll
        for (int i = 0; i < 16; ++i) {
            const unsigned key = __float_as_uint(g0[i]);
            gate[i] = __expf(__uint_as_float(key & ~255u) - mx); sum += gate[i];
            const unsigned id = 255u - (key & 255u);
            const unsigned n0 = *(const LAS unsigned char*)(myl + (id >> 4));
            const unsigned n1 = *(const LAS unsigned char*)(myl + 16 + (id & 15u));
            eid[i] = (int)(n0 * 128u + n1);
        }
        const float inv = 1.f / sum;
        const int h = hh ? hB : hA;
        int* EI = (int*)(p.ws + OFF_EIDX) + (size_t)t * 128 + h * 16; float* EG = (float*)(p.ws + OFF_EGATE) + (size_t)t * 128 + h * 16;
#pragma unroll
        for (int q = 0; q < 4; ++q) {
            *reinterpret_cast<int4*>(EI + q * 4) = make_int4(eid[q * 4], eid[q * 4 + 1], eid[q * 4 + 2], eid[q * 4 + 3]);
            *reinterpret_cast<float4*>(EG + q * 4) = make_float4(gate[q * 4] * inv, gate[q * 4 + 1] * inv, gate[q * 4 + 2] * inv, gate[q * 4 + 3] * inv);
        }
        if (local) break;
    }
}

constexpr int LDS_BYTES = LDS_HDR + 8 * 19456;
__global__ void __launch_bounds__(NT, 2) mk_fwd(Params p) {
    extern __shared__ __attribute__((aligned(16))) unsigned char lds[];
    const int wv = __builtin_amdgcn_readfirstlane((int)(threadIdx.x >> 6));
    volatile LAS unsigned* st = (volatile LAS unsigned*)lds;
    if (threadIdx.x < 32) st[threadIdx.x] = 0u;
    __syncthreads();
    XcdBarrier xb = xcd_barrier_post((unsigned*)(p.ws + OFF_BAR), st);
    int bar_idx = 0;
#define GRID_BAR() do { xcd_barrier(xb); \
        if (PROBE_TS >= 0 && blockIdx.x == 0 && threadIdx.x == 0 && (bar_idx == PROBE_TS - 1 || bar_idx == PROBE_TS)) \
            ((volatile LAS unsigned long long*)(lds + 128))[bar_idx - (PROBE_TS - 1)] = __builtin_amdgcn_s_memrealtime(); \
        ++bar_idx; } while (0)
    if (PROBE_TS == 0 && blockIdx.x == 0 && threadIdx.x == 0) ((volatile LAS unsigned long long*)(lds + 128))[0] = __builtin_amdgcn_s_memrealtime();
    unsigned char* ws = p.ws;
    for (int rep = 0; rep < (PROBE_DUP == 1 ? 2 : 1); ++rep) {
    ph_mod(p, lds + LDS_HDR, wv);
    if (blockIdx.x < 32) {
        asm volatile("s_waitcnt vmcnt(0)" ::: "memory");
        __syncthreads();
        if (threadIdx.x == 0) {
            __builtin_amdgcn_fence(__ATOMIC_RELEASE, "agent");
            asm volatile("s_waitcnt vmcnt(0)" ::: "memory");
            (void)xb_add((unsigned*)(ws + OFF_BAR) + QW_GRP + 200 * 16, 1u);
        }
    }
    ph_transpose_all(p, lds + LDS_HDR, wv);
    ph_convert(p.in[I_SUBK], (bf16_t*)(ws + OFF_SUBK), 2 * 2 * 128 * 64, wv);
    ph_convert(p.in[I_SGUW], (bf16_t*)(ws + OFF_SGUW), 2 * 4 * 128 * 128, wv);
    ph_rope_tab(p, wv);
    }
    for (int l = 0; l < 2; ++l) {
        for (int rep = 0; rep < (PROBE_DUP == 3 ? 2 : 1); ++rep) {
        if (l == 0) {
            ph_cache_prep(p, 0, wv);
            __syncthreads();
            if (threadIdx.x == 0) {
                unsigned* bar = (unsigned*)(ws + OFF_BAR);
                const unsigned npub = gridDim.x < 32u ? gridDim.x : 32u;
                XB_SPIN(xb_ld(bar + QW_GRP + 200 * 16) < npub, bar);
                __builtin_amdgcn_fence(__ATOMIC_ACQUIRE, "agent");
                asm volatile("s_waitcnt vmcnt(0)" ::: "memory");
            }
            __syncthreads();
            ph_norm_mod(p, 0, 0, 1, wv);
            GRID_BAR();
        }
        }
        for (int rep = 0; rep < (PROBE_DUP == 5 ? 2 : 1); ++rep) {
        if (l == 1) ph_cache_prep(p, 1, wv);
        gemm_phase2<EPI_INPROJ>(p, l, (const bf16_t*)(ws + (l == 0 ? OFF_H : OFF_XC)), (const bf16_t*)(ws + (l == 0 ? OFF_WIN : OFF_WINS)), INW, lds + LDS_HDR, wv,
                                l == 0 ? (size_t)0 : (size_t)INW * D, (const float*)(ws + OFF_RSS1), (const float*)(ws + OFF_BIN));
        GRID_BAR();
        }
        for (int rep = 0; rep < ((PROBE_DUP == 4 || (PROBE_DUP >= 10 && PROBE_DUP <= 12)) ? 2 : 1); ++rep) {
        ph_mixers(p, l + 2 * rep, lds + LDS_HDR, wv);
        GRID_BAR();
        }
        if (l == 0) ph_ush(p, lds + LDS_HDR, wv);
        gemm_phase2<EPI_WOUT>(p, l, (const bf16_t*)(ws + OFF_MIX), (const bf16_t*)(ws + OFF_WOUT) + (size_t)l * D * D, D, lds + LDS_HDR, wv);
        if (gridDim.x == 256) {
            asm volatile("s_waitcnt vmcnt(0)" ::: "memory");
            __syncthreads();
            if (threadIdx.x == 0) {
                unsigned* bar = (unsigned*)(ws + OFF_BAR);
                const int vb = (int)(blockIdx.x % 8) * 32 + (int)(blockIdx.x / 8);
                unsigned* c = bar + QW_GRP + (l * 64 + (vb >> 5) * 8 + ((vb & 31) >> 2)) * 16;
                __builtin_amdgcn_fence(__ATOMIC_RELEASE, "agent");
                asm volatile("s_waitcnt vmcnt(0)" ::: "memory");
                (void)xb_add(c, 1u);
                XB_SPIN(xb_ld(c) < 4u, bar);
                __builtin_amdgcn_fence(__ATOMIC_ACQUIRE, "agent");
                asm volatile("s_waitcnt vmcnt(0)" ::: "memory");
            }
            __syncthreads();
        } else GRID_BAR();
        for (int rep = 0; rep < (PROBE_DUP == 7 ? 2 : 1); ++rep) {
        gemm_phase2<EPI_WQ>(p, l, (const bf16_t*)(ws + OFF_XC), (const bf16_t*)(ws + OFF_WQS) + (size_t)l * 5 * D * D, D, lds + LDS_HDR, wv,
                           (size_t)D * D, (const float*)(ws + OFF_RSS2) + (size_t)l * NTOK * 8, (const float*)(ws + OFF_BQ) + (size_t)l * 5 * D);
        if (gridDim.x == 256) { asm volatile("s_waitcnt vmcnt(0)" ::: "memory"); __syncthreads(); }
        else GRID_BAR();
        }
        if (PROBE_DUP == 8) { for (int rep = 0; rep < 10; ++rep) GRID_BAR(); }
        for (int rep = 0; rep < (PROBE_DUP == 2 ? 2 : 1); ++rep) {
        ph_peer_select(p, l, lds + LDS_HDR, wv);
        GRID_BAR();
        }
        ph_peer_sliced<false>(p, l, lds + LDS_HDR, wv);
        GRID_BAR();
        ph_peer_pairw(p, l, wv);
        GRID_BAR();
        ph_peer_sliced<true>(p, l, lds + LDS_HDR, wv);
        GRID_BAR();
    }
    ph_final_norm(p, wv);
    if (PROBE_TS >= 0 && blockIdx.x == 0 && threadIdx.x == 0) {
        asm volatile("s_waitcnt vmcnt(0)" ::: "memory");
        volatile LAS unsigned long long* tsl = (volatile LAS unsigned long long*)(lds + 128);
        p.out[0] += (float)(tsl[1] - tsl[0]) * 0.01f;
    }
}

extern "C" void kernel_launch(void* const* d_in, const int* in_sizes, int n_in,
                              void* d_out, int out_size, void* d_ws, size_t ws_size,
                              hipStream_t stream) {
    static int grid = 0;
    if (grid == 0) {
        if (ws_size < WS_NEED) { fprintf(stderr, "kernel_launch: workspace too small: %zu < %zu\n", ws_size, (size_t)WS_NEED); grid = -1; return; }
        int dev = 0, cus = 0, per_cu = 0;
        (void)hipGetDevice(&dev);
        (void)hipDeviceGetAttribute(&cus, hipDeviceAttributeMultiprocessorCount, dev);
        (void)hipFuncSetAttribute((const void*)mk_fwd, hipFuncAttributeMaxDynamicSharedMemorySize, LDS_BYTES);
        (void)hipOccupancyMaxActiveBlocksPerMultiprocessor(&per_cu, (const void*)mk_fwd, NT, LDS_BYTES);
        if (per_cu < 1) { fprintf(stderr, "kernel_launch: occupancy query reports %d blocks per CU\n", per_cu); grid = -1; return; }
        grid = cus;
    }
    if (grid < 0) return;
    (void)hipMemsetAsync((unsigned char*)d_ws + OFF_BAR, 0, 64 * 1024, stream);
    Params p{};
    for (int i = 0; i < 29; ++i) p.in[i] = (const float*)d_in[i];
    p.out = (float*)d_out; p.ws = (unsigned char*)d_ws;
    void* args[] = {&p};
    hipError_t e = hipLaunchCooperativeKernel((const void*)mk_fwd, dim3(grid), dim3(NT), args, LDS_BYTES, stream);
    if (e != hipSuccess) fprintf(stderr, "kernel_launch: cooperative launch failed: %s (grid %d)\n", hipGetErrorString(e), grid);
}
```
